# Optimizing an MI355X kernel written in HIP

```python
import jax, jax.numpy as jnp
from jax import lax
import numpy as np


D_MODEL = 2048
BATCH = 1
SEQ = 16384
DEPTH = 1

ATT_HEAD_DIM = 128
N_ATT_HEADS = D_MODEL // 256
N_KV_HEADS = max(1, N_ATT_HEADS // 4)
ATT_ROPE_DIM = ATT_HEAD_DIM // 4
IDX_HEAD_DIM = 64
N_IDX_HEADS = D_MODEL // 128
IDX_ROPE_DIM = IDX_HEAD_DIM // 4
IDX_TOPK = 256
Q_BLOCK = 128
ROPE_THETA = 500000.0
MAX_POS_OFFSET = 1024
HGRN_KDIM = 128
HGRN_VDIM = 128
N_HGRN_HEADS = D_MODEL // 256
HGRN_CHUNK = 64
N_BRANCHES = 2
ATT_WIDTH = N_ATT_HEADS * ATT_HEAD_DIM
HGRN_WIDTH = N_HGRN_HEADS * HGRN_VDIM
N_EXPERTS = 32
MOE_TOPK = 4
D_EXPERT = D_MODEL
SWIGLU_LIMIT = 7.0
SWIGLU_ALPHA = 1.702
MOE_BLOCK = 128
NORM_EPS = 1e-5

IN_WIDTHS = (
    N_ATT_HEADS * ATT_HEAD_DIM,
    N_KV_HEADS * ATT_HEAD_DIM,
    N_KV_HEADS * ATT_HEAD_DIM,
    N_IDX_HEADS * IDX_HEAD_DIM,
    IDX_HEAD_DIM,
    N_IDX_HEADS,
    N_HGRN_HEADS * HGRN_KDIM,
    N_HGRN_HEADS * HGRN_KDIM,
    N_HGRN_HEADS * HGRN_VDIM,
    N_HGRN_HEADS * HGRN_VDIM,
    N_BRANCHES * D_MODEL,
)
D_IN = sum(IN_WIDTHS)

kernel_name = "hybrid_dsa_hgrn2_moe_adaln_block"


def rms_norm(x, g):
    xf = x.astype(jnp.float32)
    y = xf * lax.rsqrt(jnp.mean(xf * xf, axis=-1, keepdims=True) + NORM_EPS)
    return (y * g.astype(jnp.float32)).astype(x.dtype)


def layer_norm(x, g, b):
    xf = x.astype(jnp.float32)
    mu = jnp.mean(xf, axis=-1, keepdims=True)
    var = jnp.mean(jnp.square(xf - mu), axis=-1, keepdims=True)
    y = (xf - mu) * lax.rsqrt(var + NORM_EPS)
    return (y * g.astype(jnp.float32) + b.astype(jnp.float32)).astype(x.dtype)


def partial_rope(x, pos, rot_dim):
    half = rot_dim // 2
    inv_freq = jnp.power(ROPE_THETA, -jnp.arange(half, dtype=jnp.float32) * 2.0 / rot_dim)
    ang = pos.astype(jnp.float32)[..., None] * inv_freq
    cos = jnp.cos(ang)[:, :, None, :].astype(x.dtype)
    sin = jnp.sin(ang)[:, :, None, :].astype(x.dtype)
    x1 = x[..., :half]
    x2 = x[..., half:rot_dim]
    return jnp.concatenate([x1 * cos - x2 * sin, x2 * cos + x1 * sin, x[..., rot_dim:]], axis=-1)


def dsa_attention(q, k, v, q_idx, k_idx, w_idx, topk):
    B, S, H, Dh = q.shape
    G = k.shape[2]
    R = H // G
    nblk = S // Q_BLOCK
    scale = Dh ** -0.5
    key_pos = jnp.arange(S)
    gather = jax.vmap(lambda t, i: t[i])

    def to_blocks(a):
        return a.reshape((B, nblk, Q_BLOCK) + a.shape[2:]).swapaxes(0, 1)

    def block(args):
        qb, qib, wb, start = args
        qpos = start + jnp.arange(Q_BLOCK)
        causal = key_pos[None, :] <= qpos[:, None]
        dots = jnp.einsum('bqhd,bsd->bqhs', qib, k_idx)
        scores = jnp.einsum('bqh,bqhs->bqs', wb, jax.nn.relu(dots)).astype(jnp.float32)
        scores = jnp.where(causal[None], scores, -jnp.inf)
        _, sel = lax.top_k(scores, topk)
        valid = sel <= qpos[None, :, None]
        ks = gather(k, sel)
        vs = gather(v, sel)
        qg = qb.reshape(B, Q_BLOCK, G, R, Dh)
        logits = jnp.einsum('bqgrd,bqkgd->bqgrk', qg, ks).astype(jnp.float32) * scale
        logits = jnp.where(valid[:, :, None, None, :], logits, -jnp.inf)
        p = jax.nn.softmax(logits, axis=-1).astype(v.dtype)
        o = jnp.einsum('bqgrk,bqkgd->bqgrd', p, vs)
        return o.reshape(B, Q_BLOCK, H * Dh)

    starts = jnp.arange(nblk) * Q_BLOCK
    out = lax.map(block, (to_blocks(q), to_blocks(q_idx), to_blocks(w_idx), starts))
    return out.swapaxes(0, 1).reshape(B, S, H * Dh)


def hgrn2(q, f_logit, i, lb):
    B, S, _ = q.shape
    Hh, dk, dv, C = N_HGRN_HEADS, HGRN_KDIM, HGRN_VDIM, HGRN_CHUNK
    nC = S // C
    qf = jax.nn.silu(q.astype(jnp.float32))
    f = lb + (1.0 - lb) * jax.nn.sigmoid(f_logit.astype(jnp.float32))
    logf = jnp.log(f)
    kf = 1.0 - f
    vf = i.astype(jnp.float32)

    def heads(a, d):
        return a.reshape(B, nC, C, Hh, d).transpose(1, 0, 3, 2, 4)

    causal = jnp.tril(jnp.ones((C, C), dtype=bool))

    def step(state, xs):
        qc, kc, vc, gc = xs
        b = jnp.cumsum(gc, axis=2)
        o_inter = jnp.einsum('bhtd,bhde->bhte', qc * jnp.exp(b), state)
        diff = b[:, :, :, None, :] - b[:, :, None, :, :]
        decay = jnp.exp(jnp.where(causal[:, :, None], diff, -jnp.inf))
        A = jnp.einsum('bhtd,bhtsd,bhsd->bhts', qc, decay, kc)
        o = o_inter + jnp.einsum('bhts,bhse->bhte', A, vc)
        b_last = b[:, :, -1:, :]
        state = (jnp.exp(b_last[:, :, 0, :])[..., None] * state
                 + jnp.einsum('bhsd,bhse->bhde', kc * jnp.exp(b_last - b), vc))
        return state, o

    s0 = jnp.zeros((B, Hh, dk, dv), jnp.float32)
    _, o = lax.scan(step, s0, (heads(qf, dk), heads(kf, dk), heads(vf, dv), heads(logf, dk)))
    return o.transpose(1, 0, 3, 2, 4).reshape(B, S, Hh, dv).astype(q.dtype)


def mixer(h, pos, w_in, idx_knorm_g, idx_knorm_b, lb, hgrn_norm_g, w_proj_att, w_proj_hgrn, w_out):
    B, S, D = h.shape
    proj = h @ w_in
    split_pts = np.cumsum(np.array(IN_WIDTHS))[:-1].tolist()
    q, k, v, qi, ki, wi, hq, hf, hi, hg, gates = jnp.split(proj, split_pts, axis=-1)
    q = partial_rope(q.reshape(B, S, N_ATT_HEADS, ATT_HEAD_DIM), pos, ATT_ROPE_DIM)
    k = partial_rope(k.reshape(B, S, N_KV_HEADS, ATT_HEAD_DIM), pos, ATT_ROPE_DIM)
    v = v.reshape(B, S, N_KV_HEADS, ATT_HEAD_DIM)
    qi = partial_rope(qi.reshape(B, S, N_IDX_HEADS, IDX_HEAD_DIM), pos, IDX_ROPE_DIM)
    ki = layer_norm(ki, idx_knorm_g, idx_knorm_b)
    ki = partial_rope(ki[:, :, None, :], pos, IDX_ROPE_DIM)[:, :, 0, :]
    wi = wi * (N_IDX_HEADS ** -0.5 * IDX_HEAD_DIM ** -0.5)
    topk = min(IDX_TOPK, S // 4)
    att = dsa_attention(q, k, v, qi, ki, wi, topk)
    rec = hgrn2(hq, hf, hi, lb)
    rec = rms_norm(rec, hgrn_norm_g) * jax.nn.silu(hg.reshape(B, S, N_HGRN_HEADS, HGRN_VDIM))
    rec = rec.reshape(B, S, HGRN_WIDTH)
    g_att, g_rec = jnp.split(jax.nn.sigmoid(gates), N_BRANCHES, axis=-1)
    merged = g_att * (att @ w_proj_att) + g_rec * (rec @ w_proj_hgrn)
    return merged @ w_out


def moe(h, w_router, b_router, w1, b1, w2, b2):
    B, S, D = h.shape
    xt = h.reshape(-1, D)
    N = xt.shape[0]
    logits = (xt @ w_router).astype(jnp.float32) + b_router.astype(jnp.float32)
    top_v, top_e = lax.top_k(logits, MOE_TOPK)
    gate = jax.nn.softmax(top_v, axis=-1)
    flat_e = top_e.reshape(-1)
    flat_tok = jnp.repeat(jnp.arange(N, dtype=jnp.int32), MOE_TOPK)
    flat_gate = gate.reshape(-1)
    order = jnp.argsort(flat_e)
    se, stok, sg = flat_e[order], flat_tok[order], flat_gate[order]
    counts = jnp.bincount(flat_e, length=N_EXPERTS)
    start = jnp.cumsum(counts) - counts
    pcounts = (counts + MOE_BLOCK - 1) // MOE_BLOCK * MOE_BLOCK
    pend = jnp.cumsum(pcounts)
    pstart = pend - pcounts
    n_assign = N * MOE_TOPK
    dest = pstart[se] + jnp.arange(n_assign, dtype=jnp.int32) - start[se]
    nblk = -(-n_assign // MOE_BLOCK) + N_EXPERTS
    P = nblk * MOE_BLOCK
    buf_tok = jnp.zeros((P,), jnp.int32).at[dest].set(stok)
    blk_e = jnp.clip(jnp.searchsorted(pend, jnp.arange(nblk) * MOE_BLOCK, side='right'), 0, N_EXPERTS - 1)
    xb = xt[buf_tok].reshape(nblk, MOE_BLOCK, D)

    def expert_block(args):
        xe, e = args
        u = xe @ w1[e] + b1[e]
        ug, ul = jnp.split(u, 2, axis=-1)
        ug = jnp.minimum(ug, SWIGLU_LIMIT)
        ul = jnp.clip(ul, -SWIGLU_LIMIT, SWIGLU_LIMIT)
        a = ug * jax.nn.sigmoid(SWIGLU_ALPHA * ug) * (ul + 1.0)
        return a @ w2[e] + b2[e]

    yb = lax.map(expert_block, (xb, blk_e)).reshape(P, D)
    y = yb[dest] * sg[:, None].astype(yb.dtype)
    out = jnp.zeros((N, D), h.dtype).at[stok].add(y)
    return out.reshape(B, S, D)


def setup_inputs(seed: int = 0) -> dict:
    key = jax.random.key(seed)
    ks = jax.random.split(key, 24)
    f32 = jnp.float32

    def nrm(k, shape, scale):
        return jax.random.normal(k, shape, f32) * scale

    D = D_MODEL
    offset = jax.random.randint(ks[2], (BATCH, 1), 0, MAX_POS_OFFSET, dtype=jnp.int32)
    positions = (offset + jnp.arange(SEQ, dtype=jnp.int32)[None, :]).astype(jnp.int32)
    return {
        'x': nrm(ks[0], (BATCH, SEQ, D), 1.0),
        'c': nrm(ks[1], (BATCH, D), 1.0),
        'positions': positions,
        'w_ada': nrm(ks[3], (DEPTH, D, 6 * D), 0.5 * D ** -0.5),
        'b_ada': nrm(ks[4], (DEPTH, 6 * D), 0.02),
        'norm1_g': 1.0 + nrm(ks[5], (DEPTH, D), 0.02),
        'w_in': nrm(ks[6], (DEPTH, D, D_IN), D ** -0.5),
        'idx_knorm_g': 1.0 + nrm(ks[7], (DEPTH, IDX_HEAD_DIM), 0.02),
        'idx_knorm_b': nrm(ks[8], (DEPTH, IDX_HEAD_DIM), 0.02),
        'hgrn_lb_logits': nrm(ks[9], (DEPTH + 1, N_HGRN_HEADS * HGRN_KDIM), 0.5),
        'hgrn_norm_g': 1.0 + nrm(ks[10], (DEPTH, HGRN_VDIM), 0.02),
        'w_proj_att': nrm(ks[11], (DEPTH, ATT_WIDTH, D), ATT_WIDTH ** -0.5),
        'w_proj_hgrn': nrm(ks[12], (DEPTH, HGRN_WIDTH, D), HGRN_WIDTH ** -0.5),
        'w_out': nrm(ks[13], (DEPTH, D, D), D ** -0.5),
        'norm2_g': 1.0 + nrm(ks[14], (DEPTH, D), 0.02),
        'w_router': nrm(ks[15], (DEPTH, D, N_EXPERTS), D ** -0.5),
        'b_router': nrm(ks[16], (DEPTH, N_EXPERTS), 0.01),
        'w1': nrm(ks[17], (DEPTH, N_EXPERTS, D, 2 * D_EXPERT), D ** -0.5),
        'b1': nrm(ks[18], (DEPTH, N_EXPERTS, 2 * D_EXPERT), 0.02),
        'w2': nrm(ks[19], (DEPTH, N_EXPERTS, D_EXPERT, D), D_EXPERT ** -0.5),
        'b2': nrm(ks[20], (DEPTH, N_EXPERTS, D), 0.02),
        'final_norm_g': 1.0 + nrm(ks[21], (D,), 0.02),
    }


def reference(x, c, positions, w_ada, b_ada, norm1_g, w_in, idx_knorm_g, idx_knorm_b,
              hgrn_lb_logits, hgrn_norm_g, w_proj_att, w_proj_hgrn, w_out, norm2_g,
              w_router, b_router, w1, b1, w2, b2, final_norm_g):
    lb_all = jnp.cumsum(jax.nn.softmax(hgrn_lb_logits.astype(jnp.float32), axis=0), axis=0)
    cs = jax.nn.silu(c)
    for l in range(DEPTH):
        mod = cs @ w_ada[l] + b_ada[l]
        sh1, sc1, gt1, sh2, sc2, gt2 = [m[:, None, :] for m in jnp.split(mod, 6, axis=-1)]
        h = rms_norm(x, norm1_g[l]) * (1.0 + sc1) + sh1
        x = x + gt1 * mixer(h, positions, w_in[l], idx_knorm_g[l], idx_knorm_b[l], lb_all[l],
                            hgrn_norm_g[l], w_proj_att[l], w_proj_hgrn[l], w_out[l])
        h = rms_norm(x, norm2_g[l]) * (1.0 + sc2) + sh2
        x = x + gt2 * moe(h, w_router[l], b_router[l], w1[l], b1[l], w2[l], b2[l])
    return rms_norm(x, final_norm_g)
```

```cpp
#include <hip/hip_runtime.h>
#include <cstdio>
#include <cstdint>

#define GAS __attribute__((address_space(1)))
#define LAS __attribute__((address_space(3)))
typedef unsigned short bf16_t;
typedef short bf16x8 __attribute__((ext_vector_type(8)));
typedef float f32x4 __attribute__((ext_vector_type(4)));
typedef float f32x2 __attribute__((ext_vector_type(2)));
typedef float f32x16 __attribute__((ext_vector_type(16)));
typedef unsigned u32x4 __attribute__((ext_vector_type(4)));
typedef unsigned u32x2 __attribute__((ext_vector_type(2)));
typedef int i32x4 __attribute__((ext_vector_type(4)));

constexpr int S = 16384, D = 2048, DIN = 10832, DINP = 11008, NEXP = 32, DFF = 2048;
constexpr int NWAVES = 8, NTHR = 512;
constexpr int CQ = 0, CK = 1024, CV = 1280, CQI = 1536, CKI = 2560, CWI = 2624, CHQ = 2816, CHF = 3840, CHI = 4864, CHG = 5888, CGA = 6912, CGR = 8960;
constexpr int PMAX = 65536 + NEXP * 256;
constexpr float NORM_EPS = 1e-5f;

constexpr size_t MiB = 1u << 20;
constexpr size_t al256(size_t x) { return (x + 255) & ~(size_t)255; }
constexpr size_t WS_CTL = 0, CTL_BYTES = 1 * MiB;
constexpr size_t WS_MOD = WS_CTL + CTL_BYTES;
constexpr size_t WS_TOPE = WS_MOD + 64 * 1024;
constexpr size_t WS_GATE = WS_TOPE + (size_t)S * 16;
constexpr size_t WS_SLOT = WS_GATE + (size_t)S * 16;
constexpr size_t WS_WIN_T = WS_SLOT + (size_t)S * 16;
constexpr size_t WS_WA_T = WS_WIN_T + (size_t)DINP * D * 2;
constexpr size_t WS_WH_T = WS_WA_T + (size_t)2048 * 1024 * 2;
constexpr size_t WS_WO_T = WS_WH_T + (size_t)2048 * 1024 * 2;
constexpr size_t WS_W1_T = WS_WO_T + (size_t)2048 * 2048 * 2;
constexpr size_t WS_W2_T = WS_W1_T + (size_t)NEXP * 4096 * 2048 * 2;
constexpr size_t WS_H = WS_W2_T + (size_t)NEXP * 2048 * 2048 * 2;
constexpr size_t WS_PROJ = WS_H + (size_t)S * D * 2;
constexpr size_t WS_KI = WS_PROJ + (size_t)S * DINP * 2;
constexpr size_t WS_KC = WS_KI + (size_t)S * 64 * 2;
constexpr size_t WS_VC = WS_KC + (size_t)S * 256 * 2;
constexpr size_t WS_ST = WS_VC + (size_t)S * 256 * 2;
constexpr size_t WS_DC = WS_ST + (size_t)256 * 8 * 128 * 128 * 4;
constexpr size_t WS_SEL = WS_DC + (size_t)256 * 8 * 128 * 4;
constexpr size_t WS_ATT = WS_SEL + (size_t)S * 256 * 4;
constexpr size_t WS_REC = WS_ATT + (size_t)S * 1024 * 2;
constexpr size_t WS_MERGED = WS_REC + (size_t)S * 1024 * 2;
constexpr size_t WS_X1 = WS_MERGED + (size_t)S * 2048 * 2;
constexpr size_t WS_SCORES = WS_X1 + (size_t)S * 2048 * 4;
constexpr size_t WS_XB = WS_SCORES;
constexpr size_t WS_ACT = WS_XB + (size_t)PMAX * 2048 * 2;
constexpr size_t WS_YB = WS_ACT + (size_t)PMAX * 2048 * 2;
constexpr size_t WS_END = WS_SCORES + (size_t)S * S * 4;
static_assert(WS_YB + (size_t)PMAX * 2048 * 2 <= WS_END, "MoE buffers overlay the score matrix");
static_assert(WS_END <= (size_t)4096 * MiB, "workspace");
constexpr int CW_BAR = 4096, CW_CNT = 8192, CW_FILL = 8448;

constexpr int LDS_BYTES = 147456;
constexpr int LDS_MISC = LDS_BYTES - 512;

__device__ __forceinline__ unsigned cvt_pk_bf16(float lo, float hi) { unsigned r; asm volatile("v_cvt_pk_bf16_f32 %0, %1, %2" : "=v"(r) : "v"(lo), "v"(hi)); return r; }
__device__ __forceinline__ float bf_lo(unsigned u) { return __uint_as_float(u << 16); }
__device__ __forceinline__ float bf_hi(unsigned u) { return __uint_as_float(u & 0xffff0000u); }
__device__ __forceinline__ float bf2f(bf16_t b) { return __uint_as_float(((unsigned)b) << 16); }
__device__ __forceinline__ float wave_sum(float v) {
#pragma unroll
    for (int o = 1; o < 64; o <<= 1) v += __shfl_xor(v, o);
    return v;
}
__device__ __forceinline__ float wave_max(float v) {
#pragma unroll
    for (int o = 1; o < 64; o <<= 1) v = fmaxf(v, __shfl_xor(v, o));
    return v;
}
__device__ __forceinline__ float sigmoidf_(float x) { return 1.0f / (1.0f + __expf(-x)); }
__device__ __forceinline__ float siluf_(float x) { return x / (1.0f + __expf(-x)); }
#define LDS_WAIT() asm volatile("s_waitcnt lgkmcnt(0)" ::: "memory")
#define VM_WAIT() asm volatile("s_waitcnt vmcnt(0)" ::: "memory")

#define XB_TMO      128
#define XB_XCNT(j)  (256  + 64 * (j))
#define XB_XSUB(j)  (1280 + 64 * (j))
#define XB_XGEN(j)  (2304 + 64 * (j))
#define XB_TOP      3328
#define XB_TOPGEN   3392
#define XCD_BAR_WORDS 3456
#define XB_SPIN_CAP (1u << 22)

__device__ __forceinline__ unsigned xb_ld(unsigned* p)              { return __hip_atomic_load(p, __ATOMIC_RELAXED, __HIP_MEMORY_SCOPE_AGENT); }
__device__ __forceinline__ unsigned xb_add(unsigned* p, unsigned v) { return __hip_atomic_fetch_add(p, v, __ATOMIC_RELAXED, __HIP_MEMORY_SCOPE_AGENT); }
__device__ __forceinline__ unsigned xb_xcc_id() { return (unsigned)__builtin_amdgcn_s_getreg((3 << 11) | 20) & 0xFu; }
#define XB_SPIN(cond, bar) do { unsigned _sp = 0; while (cond) { __builtin_amdgcn_s_sleep(1); \
    if ((++_sp & 255u) == 0u) { if (xb_ld(&(bar)[XB_TMO])) break; if (_sp > XB_SPIN_CAP) { atomicAdd(&(bar)[XB_TMO], 1u); break; } } } } while (0)

struct XcdBarrier { unsigned* bar; unsigned x; volatile LAS unsigned* st; };

__device__ __forceinline__ XcdBarrier xcd_barrier_post(unsigned* bar, volatile LAS unsigned* st) {
    XcdBarrier b; b.bar = bar; b.x = xb_xcc_id(); b.st = st;
    if (threadIdx.x == 0) (void)xb_add(&bar[XB_XCNT(b.x)], 1u);
    return b;
}
__device__ __forceinline__ void xcd_barrier_complete(unsigned* bar, unsigned x, unsigned& nloc, unsigned& nx) {
    const unsigned G = gridDim.x * gridDim.y * gridDim.z;
    unsigned sum, cnt, mine, sp = 0u;
    for (;;) {
        sum = 0u; cnt = 0u; mine = 0u;
#pragma unroll
        for (unsigned j = 0; j < 16; ++j) { const unsigned c = xb_ld(&bar[XB_XCNT(j)]); sum += c; cnt += (c > 0u) ? 1u : 0u; mine = (j == x) ? c : mine; }
        if (sum == G) break;
        __builtin_amdgcn_s_sleep(1);
        if ((++sp & 255u) == 0u) { if (xb_ld(&bar[XB_TMO])) break; if (sp > XB_SPIN_CAP) { atomicAdd(&bar[XB_TMO], 1u); break; } }
    }
    nloc = mine > 0u ? mine : 1u; nx = cnt > 0u ? cnt : 1u;
}
__device__ __forceinline__ void xcd_barrier(const XcdBarrier& b) {
    asm volatile("s_waitcnt vmcnt(0)" ::: "memory");
    __syncthreads();
    if (threadIdx.x == 0) {
        unsigned* bar = b.bar;
        __builtin_amdgcn_s_waitcnt(0);
        unsigned nloc = b.st[0], nx = b.st[1];
        if (nloc == 0u) { xcd_barrier_complete(bar, b.x, nloc, nx); b.st[0] = nloc; b.st[1] = nx; }
        const unsigned old = xb_add(&bar[XB_XSUB(b.x)], 1u);
        const unsigned gen = old / nloc;
        if (old + 1u == (gen + 1u) * nloc) {
            __builtin_amdgcn_fence(__ATOMIC_RELEASE, "agent");
            asm volatile("s_waitcnt vmcnt(0)" ::: "memory");
            const unsigned og = xb_add(&bar[XB_TOP], 1u);
            const unsigned tg = og / nx;
            if (og + 1u == (tg + 1u) * nx) xb_add(&bar[XB_TOPGEN], 1u);
            else XB_SPIN(xb_ld(&bar[XB_TOPGEN]) == tg, bar);
            __builtin_amdgcn_fence(__ATOMIC_ACQUIRE, "agent");
            xb_add(&bar[XB_XGEN(b.x)], 1u);
            asm volatile("s_waitcnt vmcnt(0)" ::: "memory");
        } else {
            XB_SPIN(xb_ld(&bar[XB_XGEN(b.x)]) == gen, bar);
            __builtin_amdgcn_fence(__ATOMIC_ACQUIRE, "agent");
            asm volatile("s_waitcnt vmcnt(0)" ::: "memory");
        }
    }
    __syncthreads();
}

namespace pg8 {
constexpr int BM = 256, BK = 64, HALF = 128, HTB = HALF * BK * 2, STAGE_BYTES = 8 * HTB, NXCD = 8, WGM = 8;
__host__ __device__ __forceinline__ int lds_byte(int r, int c) { const int st = (r >> 4) * 2 + (c >> 5), rr = r & 15, cc = c & 31, ob = rr * 64 + cc * 2; return st * 1024 + (ob ^ (((ob >> 9) & 1) << 5)); }
__host__ __device__ __forceinline__ void stage_rc(int b, int& R, int& C) { const int st = b / 1024, sb = b % 1024, swz = sb ^ (((sb >> 9) & 1) << 5); R = (st >> 1) * 16 + swz / 64; C = (st & 1) * 32 + (swz % 64) / 2; }
__host__ __device__ __forceinline__ int perm32(int rho) { const int n = rho >> 4, i = rho & 15; return 8 * (i >> 2) + 4 * n + (i & 3); }

struct Unit { int pm, pn, e; };
struct Gemm { const bf16_t* A; const bf16_t* Bt; int K; size_t estride; };

struct StaticOrder {
    int nM, nN, nwg, G, c, i;
    __device__ void init(int M, int N, int G_, int c_) { nM = M / BM; nN = N / BM; nwg = nM * nN; G = G_; c = c_; i = 0; }
    __device__ bool next(Unit& u) {
        const long L = (long)i * G + c; ++i; if (L >= nwg) return false;
        int wgid = (int)L; { const int q = nwg / NXCD, r = nwg % NXCD, xcd = wgid % NXCD, off = wgid / NXCD; wgid = (xcd < r ? xcd * (q + 1) : r * (q + 1) + (xcd - r) * q) + off; }
        const int nig = WGM * nN, gid = wgid / nig, fm = gid * WGM, gsz = (nM - fm) < WGM ? (nM - fm) : WGM;
        u.pm = fm + ((wgid % nig) % gsz); u.pn = (wgid % nig) / gsz; u.e = 0; return true;
    }
};
struct MoeOrder {
    int nPanels, nN, G, c, i; const LAS int* panel_e;
    __device__ void init(int nPanels_, int nN_, int G_, int c_, const LAS int* pe) { nPanels = nPanels_; nN = nN_; G = G_; c = c_; i = 0; panel_e = pe; }
    __device__ bool next(Unit& u) {
        const int PB = 256 / nN;
        const int nblk = (nPanels + PB - 1) / PB;
        for (;;) {
            const long L = (long)i * G + c; ++i;
            const int blk = (int)(L >> 8), r = (int)(L & 255), x = r & 7, j = r >> 3;
            if (blk >= nblk) return false;
            int pm, pn;
            if (nN == 16) { pm = blk * 16 + 4 * (x >> 1) + (j & 3); pn = 8 * (x & 1) + (j >> 2); }
            else          { pm = blk * 32 + 4 * x + (j & 3);        pn = j >> 2; }
            if (pm < nPanels) { u.pm = pm; u.pn = pn; u.e = panel_e[pm]; return true; }
        }
    }
};

template <class Epi, class Sched>
__device__ __forceinline__ void gemm_phase(LAS unsigned char* lds, const Gemm g, Sched& S, const Epi& E) {
    const int tid = threadIdx.x, wid = __builtin_amdgcn_readfirstlane(tid >> 6), lane = tid & 63, wr = wid >> 2, wc = wid & 3, fr = lane & 15, fq = lane >> 4;
    const int K = g.K, nt = K / BK;
    unsigned voffA[2], voffB[2];
#pragma unroll
    for (int i = 0; i < 2; ++i) { int R, C; stage_rc(tid * 16 + i * 8192, R, C); const int Rb = Epi::PERM ? ((R & ~31) + perm32(R & 31)) : R;
        voffA[i] = (unsigned)(R * K + C) * 2u; voffB[i] = (unsigned)(Rb * K + C) * 2u; }
    const size_t kstep = (size_t)(BK * 2);
    const size_t hstep = (size_t)HALF * K * 2;
    const size_t tstep = 2 * hstep;
    const unsigned ldsw = (unsigned)wid * 1024u;
    const int aoff = lds_byte(wr * 64 + fr, fq * 8), boff = lds_byte(wc * 32 + fr, fq * 8);
#define PG8_SA(b, h) (((b) * 2 + (h)) * HTB)
#define PG8_SB(b, h) ((4 + (b) * 2 + (h)) * HTB)
#define PG8_STAGE(bufoff, gbase, voff) do { _Pragma("unroll") for (int _i = 0; _i < 2; ++_i) \
        __builtin_amdgcn_global_load_lds((const unsigned*)((const char*)(gbase) + (voff)[_i]), (LAS unsigned*)(lds + (bufoff) + ldsw + _i * 8192), 16, 0, 0); } while (0)
#define PG8_LDA(dst, b, h) do { _Pragma("unroll") for (int m = 0; m < 4; ++m) _Pragma("unroll") for (int k = 0; k < 2; ++k) dst[m][k] = *(const LAS bf16x8*)(lds + PG8_SA(b, h) + aoff + m * 2048 + k * 1024); } while (0)
#define PG8_LDB(dst, b, h) do { _Pragma("unroll") for (int n = 0; n < 2; ++n) _Pragma("unroll") for (int k = 0; k < 2; ++k) dst[n][k] = *(const LAS bf16x8*)(lds + PG8_SB(b, h) + boff + n * 2048 + k * 1024); } while (0)
#define PG8_MMA(ai, bj, At, Bt) do { __builtin_amdgcn_s_setprio(1); _Pragma("unroll") for (int m = 0; m < 4; ++m) _Pragma("unroll") for (int n = 0; n < 2; ++n) _Pragma("unroll") for (int k = 0; k < 2; ++k) \
        acc[ai][bj][m][n] = __builtin_amdgcn_mfma_f32_16x16x32_bf16(Bt[n][k], At[m][k], acc[ai][bj][m][n], 0, 0, 0); __builtin_amdgcn_s_setprio(0); } while (0)
#define PG8_WAIT_V(n) asm volatile("s_waitcnt vmcnt(" #n ")" ::: "memory")
#define PG8_WAIT_L(n) asm volatile("s_waitcnt lgkmcnt(" #n ")" ::: "memory")
#define PG8_BAR __builtin_amdgcn_s_barrier()
#define PG8_SCHED __builtin_amdgcn_sched_barrier(0)
    Unit cur, nxt;
    if (!S.next(cur)) return;
    f32x4 acc[2][2][4][2];
#pragma unroll
    for (int a = 0; a < 2; ++a)
#pragma unroll
        for (int b = 0; b < 2; ++b)
#pragma unroll
            for (int m = 0; m < 4; ++m)
#pragma unroll
                for (int n = 0; n < 2; ++n) acc[a][b][m][n] = (f32x4){0.f, 0.f, 0.f, 0.f};
    bf16x8 At[4][2], B0[2][2], B1[2][2];
    const char* cA = (const char*)g.A + (size_t)cur.pm * tstep; const char* cB = (const char*)g.Bt + (size_t)cur.e * g.estride + (size_t)cur.pn * tstep;
    PG8_STAGE(PG8_SB(0, 0), cB, voffB); PG8_STAGE(PG8_SB(0, 1), cB + hstep, voffB); PG8_STAGE(PG8_SA(0, 0), cA, voffA); PG8_STAGE(PG8_SA(0, 1), cA + hstep, voffA);
    if (wr == 1) PG8_BAR;
    PG8_WAIT_V(2); PG8_BAR;
    PG8_STAGE(PG8_SB(1, 0), cB + kstep, voffB); PG8_STAGE(PG8_SA(1, 0), cA + kstep, voffA); PG8_STAGE(PG8_SB(1, 1), cB + hstep + kstep, voffB);
    PG8_WAIT_V(6); PG8_BAR;
    for (;;) {
        const bool has_next = S.next(nxt);
        const char* nA = has_next ? (const char*)g.A + (size_t)nxt.pm * tstep : cA;
        const char* nB = has_next ? (const char*)g.Bt + (size_t)nxt.e * g.estride + (size_t)nxt.pn * tstep : cB;
        for (int t = 0; t < nt; t += 2) {
            const bool last = (t == nt - 2);
            const char* a1 = cA + (size_t)(t + 1) * kstep;
            const char* a2 = last ? nA : cA + (size_t)(t + 2) * kstep; const char* b2 = last ? nB : cB + (size_t)(t + 2) * kstep;
            const char* a3 = a2 + kstep; const char* b3 = b2 + kstep;
            PG8_LDB(B0, 0, 0); PG8_LDB(B1, 0, 1); PG8_SCHED; PG8_LDA(At, 0, 0); PG8_STAGE(PG8_SA(1, 1), a1 + hstep, voffA);
            PG8_WAIT_V(8); PG8_WAIT_L(0); PG8_BAR; PG8_MMA(0, 0, At, B0); PG8_MMA(0, 1, At, B1); PG8_BAR; PG8_SCHED;
            PG8_LDA(At, 0, 1); PG8_STAGE(PG8_SB(0, 0), b2, voffB); PG8_STAGE(PG8_SB(0, 1), b2 + hstep, voffB); PG8_STAGE(PG8_SA(0, 0), a2, voffA);
            PG8_WAIT_V(8); PG8_WAIT_L(0); PG8_BAR; PG8_MMA(1, 0, At, B0); PG8_MMA(1, 1, At, B1); PG8_BAR; PG8_SCHED;
            PG8_LDB(B0, 1, 0); PG8_LDB(B1, 1, 1); PG8_SCHED; PG8_LDA(At, 1, 0); PG8_STAGE(PG8_SA(0, 1), a2 + hstep, voffA);
            PG8_WAIT_V(8); PG8_WAIT_L(0); PG8_BAR; PG8_MMA(0, 0, At, B0); PG8_MMA(0, 1, At, B1); PG8_BAR; PG8_SCHED;
            PG8_LDA(At, 1, 1); PG8_STAGE(PG8_SB(1, 0), b3, voffB); PG8_STAGE(PG8_SB(1, 1), b3 + hstep, voffB); PG8_STAGE(PG8_SA(1, 0), a3, voffA);
            PG8_WAIT_V(8); PG8_WAIT_L(0); PG8_BAR; PG8_MMA(1, 0, At, B0); PG8_MMA(1, 1, At, B1); PG8_BAR; PG8_SCHED;
        }
        if (wr == 0) PG8_BAR;
        E(acc, cur, wr, wc, fr, fq);
        if (!has_next) break;
#pragma unroll
        for (int a = 0; a < 2; ++a)
#pragma unroll
            for (int b = 0; b < 2; ++b)
#pragma unroll
                for (int m = 0; m < 4; ++m)
#pragma unroll
                    for (int n = 0; n < 2; ++n) acc[a][b][m][n] = (f32x4){0.f, 0.f, 0.f, 0.f};
        cur = nxt; cA = nA; cB = nB;
        if (wr == 1) PG8_BAR;
    }
    PG8_WAIT_V(0);
    PG8_BAR;
#undef PG8_SA
#undef PG8_SB
#undef PG8_STAGE
#undef PG8_LDA
#undef PG8_LDB
#undef PG8_MMA
#undef PG8_WAIT_V
#undef PG8_WAIT_L
#undef PG8_BAR
#undef PG8_SCHED
}

struct EpiBf16 {
    static constexpr bool PERM = true;
    bf16_t* O; int ldc; const float* bias; int bias_estride;
    __device__ __forceinline__ void operator()(const f32x4 (&acc)[2][2][4][2], const Unit& u, int wr, int wc, int fr, int fq) const {
        const int row0 = u.pm * BM + wr * 64 + fr; const int col0 = u.pn * BM + wc * 32 + 8 * fq;
        f32x4 bv[2][2];
#pragma unroll
        for (int bj = 0; bj < 2; ++bj)
#pragma unroll
            for (int n = 0; n < 2; ++n) bv[bj][n] = bias ? *(const f32x4*)(bias + (size_t)u.e * bias_estride + col0 + bj * HALF + 4 * n) : (f32x4){0.f, 0.f, 0.f, 0.f};
#pragma unroll
        for (int ai = 0; ai < 2; ++ai)
#pragma unroll
            for (int m = 0; m < 4; ++m) { bf16_t* rowp = O + (size_t)(row0 + ai * HALF + m * 16) * ldc + col0;
#pragma unroll
                for (int bj = 0; bj < 2; ++bj) { const f32x4 v0 = acc[ai][bj][m][0] + bv[bj][0], v1 = acc[ai][bj][m][1] + bv[bj][1];
                    u32x4 w; w.x = cvt_pk_bf16(v0[0], v0[1]); w.y = cvt_pk_bf16(v0[2], v0[3]); w.z = cvt_pk_bf16(v1[0], v1[1]); w.w = cvt_pk_bf16(v1[2], v1[3]);
                    *(u32x4*)(rowp + bj * HALF) = w; } }
    }
};
__device__ __forceinline__ float swiglu1(float ug, float ul) {
    ug = fminf(ug, 7.0f); ul = fminf(fmaxf(ul, -7.0f), 7.0f);
    return ug * (1.0f / (1.0f + __expf(-1.702f * ug))) * (ul + 1.0f);
}
struct EpiSwiglu {
    static constexpr bool PERM = true;
    bf16_t* O; const float* b1;
    __device__ __forceinline__ void operator()(const f32x4 (&acc)[2][2][4][2], const Unit& u, int wr, int wc, int fr, int fq) const {
        const int row0 = u.pm * BM + wr * 64 + fr; const int c0 = u.pn * 128 + wc * 32 + 8 * fq;
        const float* bg = b1 + (size_t)u.e * 4096 + c0; const float* bl = bg + 2048;
        f32x4 bgv[2], blv[2];
#pragma unroll
        for (int n = 0; n < 2; ++n) { bgv[n] = *(const f32x4*)(bg + 4 * n); blv[n] = *(const f32x4*)(bl + 4 * n); }
#pragma unroll
        for (int ai = 0; ai < 2; ++ai)
#pragma unroll
            for (int m = 0; m < 4; ++m) {
                float a[8];
#pragma unroll
                for (int n = 0; n < 2; ++n)
#pragma unroll
                    for (int j = 0; j < 4; ++j) a[4 * n + j] = swiglu1(acc[ai][0][m][n][j] + bgv[n][j], acc[ai][1][m][n][j] + blv[n][j]);
                u32x4 w; w.x = cvt_pk_bf16(a[0], a[1]); w.y = cvt_pk_bf16(a[2], a[3]); w.z = cvt_pk_bf16(a[4], a[5]); w.w = cvt_pk_bf16(a[6], a[7]);
                *(u32x4*)(O + (size_t)(row0 + ai * HALF + m * 16) * 2048 + c0) = w;
            }
    }
};

struct EpiGate {
    static constexpr bool PERM = true;
    bf16_t* O; const bf16_t* Gt; int accum;
    __device__ __forceinline__ void operator()(const f32x4 (&acc)[2][2][4][2], const Unit& u, int wr, int wc, int fr, int fq) const {
        const int row0 = u.pm * BM + wr * 64 + fr; const int col0 = u.pn * BM + wc * 32 + 8 * fq;
#pragma unroll
        for (int ai = 0; ai < 2; ++ai)
#pragma unroll
            for (int m = 0; m < 4; ++m) { const size_t row = (size_t)(row0 + ai * HALF + m * 16);
#pragma unroll
                for (int bj = 0; bj < 2; ++bj) { const int c = col0 + bj * HALF;
                    const u32x4 gw = *(const u32x4*)(Gt + row * DINP + c);
                    float r[8];
#pragma unroll
                    for (int q = 0; q < 4; ++q) { r[2 * q] = sigmoidf_(bf_lo(gw[q])) * acc[ai][bj][m][q >> 1][(2 * q) & 3]; r[2 * q + 1] = sigmoidf_(bf_hi(gw[q])) * acc[ai][bj][m][q >> 1][(2 * q + 1) & 3]; }
                    bf16_t* op = O + row * 2048 + c;
                    if (accum) { const u32x4 ow = *(const u32x4*)op;
#pragma unroll
                        for (int q = 0; q < 4; ++q) { r[2 * q] += bf_lo(ow[q]); r[2 * q + 1] += bf_hi(ow[q]); } }
                    u32x4 w; w.x = cvt_pk_bf16(r[0], r[1]); w.y = cvt_pk_bf16(r[2], r[3]); w.z = cvt_pk_bf16(r[4], r[5]); w.w = cvt_pk_bf16(r[6], r[7]);
                    *(u32x4*)op = w; } }
    }
};
struct EpiResid {
    static constexpr bool PERM = false;
    const float* x; const float* gt; float* X1;
    __device__ __forceinline__ void operator()(const f32x4 (&acc)[2][2][4][2], const Unit& u, int wr, int wc, int fr, int fq) const {
        const int row0 = u.pm * BM + wr * 64 + fr; const int col0 = u.pn * BM + wc * 32 + 4 * fq;
#pragma unroll
        for (int ai = 0; ai < 2; ++ai)
#pragma unroll
            for (int m = 0; m < 4; ++m) { const size_t row = (size_t)(row0 + ai * HALF + m * 16);
#pragma unroll
                for (int bj = 0; bj < 2; ++bj)
#pragma unroll
                    for (int n = 0; n < 2; ++n) { const int c = col0 + bj * HALF + n * 16;
                        const f32x4 xv = *(const f32x4*)(x + row * 2048 + c), g = *(const f32x4*)(gt + c);
                        *(f32x4*)(X1 + row * 2048 + c) = xv + g * acc[ai][bj][m][n]; } }
    }
};
}

struct Args { const void* in[22]; float* out; unsigned char* ws; int ph_lo, ph_hi, flags, pad; };
enum { PH_PRO = 0, PH_H, PH_INPROJ, PH_POST, PH_SCORE, PH_SELECT, PH_ATTN, PH_OP1, PH_OP2, PH_WOUT, PH_ROUTER, PH_SCATTER, PH_MOE1, PH_MOE2, PH_FINAL, NPH };
constexpr int FLAG_MIXER = 1, FLAG_ATT = 2, FLAG_MOE = 4;

__device__ __forceinline__ int dest_row(int mode, int n) {
    if (mode == 1) return n < 2640 ? n : n + 176;
    if (mode == 2) { const int g = n >> 11, c = n & 2047; return (c >> 7) * 256 + g * 128 + (c & 127); }
    return n;
}
__device__ __forceinline__ void convert_item(const float* __restrict__ W, int K, int N, bf16_t* WT, int mode, int item, int lane, LAS unsigned char* scr) {
    const int nblk = (N + 63) >> 6; const int kb = item / nblk, nb = item - kb * nblk; const int k0 = kb * 128, n0 = nb * 64;
    const int c4 = lane & 15, kr = lane >> 4;
    const bool ok = (n0 + 4 * c4) < N;
    const float* src = W + (size_t)(k0 + 2 * kr) * N + n0 + 4 * c4;
#pragma unroll 4
    for (int i = 0; i < 16; ++i) {
        f32x4 v0 = (f32x4){0.f, 0.f, 0.f, 0.f}, v1 = v0;
        if (ok) { v0 = *(const f32x4*)(src + (size_t)(8 * i) * N); v1 = *(const f32x4*)(src + (size_t)(8 * i + 1) * N); }
        const int kk = 8 * i + 2 * kr;
#pragma unroll
        for (int e = 0; e < 4; ++e) *(LAS unsigned*)(scr + (4 * c4 + e) * 272 + kk * 2) = cvt_pk_bf16(v0[e], v1[e]);
    }
    LDS_WAIT(); asm volatile("" ::: "memory");
#pragma unroll 4
    for (int j = 0; j < 16; ++j) {
        const int q = j * 64 + lane, n = q >> 4, ch = q & 15;
        const u32x4 v = *(const LAS u32x4*)(scr + n * 272 + ch * 16);
        if (n0 + n < N) *(u32x4*)(WT + (size_t)dest_row(mode, n0 + n) * K + k0 + ch * 8) = v;
    }
    LDS_WAIT(); asm volatile("" ::: "memory");
}


__device__ __forceinline__ bf16_t f2bf(float f) { unsigned u = __float_as_uint(f); return (bf16_t)((u + 0x7fffu + ((u >> 16) & 1u)) >> 16); }
__device__ __forceinline__ float bfx(const u32x4& w, int i) { const unsigned u = w[i >> 1]; return (i & 1) ? bf_hi(u) : bf_lo(u); }
__device__ __forceinline__ void rope_sc(float pos, float inv, float& sn, float& cs) {
    const float ang = pos * inv;
    const double a = (double)ang; const double n = __builtin_rint(a * 0.15915494309189535); const float r = (float)(a - n * 6.283185307179586);
    sn = sinf(r); cs = cosf(r);
}
__device__ __forceinline__ void post_token(bf16_t* PROJ, bf16_t* KI, bf16_t* KC, bf16_t* VC, const int* positions, const float* kng, const float* knb, int t, int lane) {
    const float pos = (float)positions[t];
    bf16_t* row = PROJ + (size_t)t * DINP;
    float sn, cs;
#pragma unroll
    for (int i = 0; i < 2; ++i) {
        const int pp = lane + 64 * i, hd = pp >> 4, ii = pp & 15;
        rope_sc(pos, powf(500000.0f, -(float)ii * (1.0f / 16.0f)), sn, cs);
        bf16_t* p = row + CQ + hd * 128 + ii; const float a = bf2f(p[0]), b = bf2f(p[16]);
        p[0] = f2bf(a * cs - b * sn); p[16] = f2bf(b * cs + a * sn);
    }
#pragma unroll
    for (int i = 0; i < 2; ++i) {
        const int pp = lane + 64 * i, hd = pp >> 3, ii = pp & 7;
        rope_sc(pos, powf(500000.0f, -(float)ii * (1.0f / 8.0f)), sn, cs);
        bf16_t* p = row + CQI + hd * 64 + ii; const float a = bf2f(p[0]), b = bf2f(p[8]);
        p[0] = f2bf(a * cs - b * sn); p[8] = f2bf(b * cs + a * sn);
    }
    if (lane < 32) {
        const int g = lane >> 4, ii = lane & 15;
        rope_sc(pos, powf(500000.0f, -(float)ii * (1.0f / 16.0f)), sn, cs);
        const bf16_t* p = row + CK + g * 128 + ii; const float a = bf2f(p[0]), b = bf2f(p[16]);
        bf16_t* o = KC + (size_t)t * 256 + g * 128 + ii; o[0] = f2bf(a * cs - b * sn); o[16] = f2bf(b * cs + a * sn);
    }
#pragma unroll
    for (int i = 0; i < 3; ++i) { const int idx = lane + 64 * i, g = idx / 96, r = idx - g * 96; KC[(size_t)t * 256 + g * 128 + 32 + r] = row[CK + g * 128 + 32 + r]; }
    *(u32x2*)(VC + (size_t)t * 256 + 4 * lane) = *(const u32x2*)(row + CV + 4 * lane);
    {
        const float v = bf2f(row[CKI + lane]);
        const float mean = wave_sum(v) * (1.0f / 64.0f); const float d = v - mean; const float var = wave_sum(d * d) * (1.0f / 64.0f);
        const float y = d * rsqrtf(var + NORM_EPS) * kng[lane] + knb[lane];
        const float other = __shfl_xor(y, 8);
        rope_sc(pos, powf(500000.0f, -(float)(lane & 7) * (1.0f / 8.0f)), sn, cs);
        float o = y;
        if (lane < 8) o = y * cs - other * sn; else if (lane < 16) o = y * cs + other * sn;
        KI[(size_t)t * 64 + lane] = f2bf(o);
    }
}

constexpr int HG_GB = 0, HG_Q1 = 33792, HG_Q2 = 51200, HG_K2 = 68608, HG_VT = 86016, HG_PB = 104448, HG_LB = 113664;
__device__ __forceinline__ void hgrn_cumsum(LAS unsigned char* lds, const bf16_t* PROJ, const float* lb_logits, int c, int h, int tid) {
    LAS float* GB = (LAS float*)(lds + HG_GB); LAS float* LB = (LAS float*)(lds + HG_LB);
    if (tid < 128) { const float l0 = lb_logits[h * 128 + tid], l1 = lb_logits[1024 + h * 128 + tid]; LB[tid] = 1.0f / (1.0f + expf(l1 - l0)); }
    __syncthreads();
    const int t = tid >> 3, dseg = tid & 7;
    const bf16_t* p = PROJ + (size_t)(c * 64 + t) * DINP + CHF + h * 128 + 16 * dseg;
    const u32x4 w0 = *(const u32x4*)p, w1 = *(const u32x4*)(p + 8);
#pragma unroll
    for (int i = 0; i < 16; ++i) { const float z = i < 8 ? bfx(w0, i) : bfx(w1, i - 8); const float lb = LB[16 * dseg + i]; GB[t * 128 + 16 * dseg + i] = logf(lb + (1.0f - lb) * sigmoidf_(z)); }
    __syncthreads();
    if (tid < 128) { float a = 0.f;
#pragma unroll 8
        for (int tt = 0; tt < 64; ++tt) { a += GB[tt * 128 + tid]; GB[tt * 128 + tid] = a; } }
    __syncthreads();
}
__device__ __forceinline__ void hgrn_vt(LAS unsigned char* lds, const bf16_t* PROJ, int c, int h, int tid) {
    const int s2 = tid & 31, eg = tid >> 5;
    const bf16_t* p = PROJ + (size_t)(c * 64 + 2 * s2) * DINP + CHI + h * 128 + 8 * eg;
    const u32x4 a = *(const u32x4*)p, b = *(const u32x4*)(p + DINP);
#pragma unroll
    for (int i = 0; i < 8; ++i) { const unsigned lo = (i & 1) ? (a[i >> 1] >> 16) : (a[i >> 1] & 0xffffu), hi = (i & 1) ? (b[i >> 1] >> 16) : (b[i >> 1] & 0xffffu);
        *(LAS unsigned*)(lds + HG_VT + (8 * eg + i) * 144 + s2 * 4) = lo | (hi << 16); }
}
__device__ __forceinline__ void hgrn_l1(LAS unsigned char* lds, const bf16_t* PROJ, const float* lb_logits, float* ST, float* DC, int c, int h, int tid, int wave, int lane) {
    hgrn_cumsum(lds, PROJ, lb_logits, c, h, tid);
    const LAS float* GB = (const LAS float*)(lds + HG_GB); const LAS float* LB = (const LAS float*)(lds + HG_LB);
    {
        const int s2 = tid & 31, dg = tid >> 5;
        const bf16_t* p = PROJ + (size_t)(c * 64 + 2 * s2) * DINP + CHF + h * 128 + 8 * dg;
        const u32x4 a = *(const u32x4*)p, b = *(const u32x4*)(p + DINP);
#pragma unroll
        for (int i = 0; i < 8; ++i) { const int d = 8 * dg + i; const float lb = LB[d], b63 = GB[63 * 128 + d];
            const float k0 = (1.0f - lb) * (1.0f - sigmoidf_(bfx(a, i))), k1 = (1.0f - lb) * (1.0f - sigmoidf_(bfx(b, i)));
            const float v0 = k0 * __expf(b63 - GB[(2 * s2) * 128 + d]), v1 = k1 * __expf(b63 - GB[(2 * s2 + 1) * 128 + d]);
            *(LAS unsigned*)(lds + HG_Q1 + d * 144 + s2 * 4) = cvt_pk_bf16(v0, v1); }
    }
    hgrn_vt(lds, PROJ, c, h, tid);
    __syncthreads();
    const int fr = lane & 15, fq = lane >> 4;
    bf16x8 af[2];
#pragma unroll
    for (int ks = 0; ks < 2; ++ks) af[ks] = *(const LAS bf16x8*)(lds + HG_VT + (16 * wave + fr) * 144 + (32 * ks + 8 * fq) * 2);
    float* dst = ST + ((size_t)(c * 8 + h) * 128) * 128;
#pragma unroll 2
    for (int dt = 0; dt < 8; ++dt) {
        f32x4 acc = (f32x4){0.f, 0.f, 0.f, 0.f};
#pragma unroll
        for (int ks = 0; ks < 2; ++ks) { const bf16x8 bfr = *(const LAS bf16x8*)(lds + HG_Q1 + (16 * dt + fr) * 144 + (32 * ks + 8 * fq) * 2); acc = __builtin_amdgcn_mfma_f32_16x16x32_bf16(af[ks], bfr, acc, 0, 0, 0); }
#pragma unroll
        for (int r = 0; r < 4; ++r) dst[(size_t)(16 * wave + 4 * fq + r) * 128 + 16 * dt + fr] = acc[r];
    }
    if (tid < 128) DC[(size_t)(c * 8 + h) * 128 + tid] = __expf(GB[63 * 128 + tid]);
    __syncthreads();
}
__device__ __forceinline__ void hgrn_l3(LAS unsigned char* lds, const bf16_t* PROJ, const float* lb_logits, const float* ST, const float* norm_g, bf16_t* REC, int c, int h, int tid, int wave, int lane) {
    hgrn_cumsum(lds, PROJ, lb_logits, c, h, tid);
    const LAS float* GB = (const LAS float*)(lds + HG_GB); const LAS float* LB = (const LAS float*)(lds + HG_LB);
    {
        const int t = tid >> 3, dseg = tid & 7;
        const bf16_t* pf = PROJ + (size_t)(c * 64 + t) * DINP + CHF + h * 128 + 16 * dseg; const bf16_t* pq = pf - CHF + CHQ;
        const u32x4 f0 = *(const u32x4*)pf, f1 = *(const u32x4*)(pf + 8), q0 = *(const u32x4*)pq, q1 = *(const u32x4*)(pq + 8);
        unsigned o1[8], o2[8], o3[8];
#pragma unroll
        for (int i = 0; i < 16; i += 2) {
            float a1[2], a2[2], a3[2];
#pragma unroll
            for (int j = 0; j < 2; ++j) { const int d = 16 * dseg + i + j; const float lb = LB[d], b = GB[t * 128 + d], br = GB[31 * 128 + d];
                const float z = (i + j) < 8 ? bfx(f0, i + j) : bfx(f1, i + j - 8), qv = (i + j) < 8 ? bfx(q0, i + j) : bfx(q1, i + j - 8);
                const float k = (1.0f - lb) * (1.0f - sigmoidf_(z)), q = siluf_(qv);
                a1[j] = q * __expf(b); a2[j] = q * __expf(b - br); a3[j] = k * __expf(br - b); }
            o1[i >> 1] = cvt_pk_bf16(a1[0], a1[1]); o2[i >> 1] = cvt_pk_bf16(a2[0], a2[1]); o3[i >> 1] = cvt_pk_bf16(a3[0], a3[1]);
        }
        LAS u32x4* d1 = (LAS u32x4*)(lds + HG_Q1 + t * 272 + dseg * 32); LAS u32x4* d2 = (LAS u32x4*)(lds + HG_Q2 + t * 272 + dseg * 32); LAS u32x4* d3 = (LAS u32x4*)(lds + HG_K2 + t * 272 + dseg * 32);
        d1[0] = (u32x4){o1[0], o1[1], o1[2], o1[3]}; d1[1] = (u32x4){o1[4], o1[5], o1[6], o1[7]};
        d2[0] = (u32x4){o2[0], o2[1], o2[2], o2[3]}; d2[1] = (u32x4){o2[4], o2[5], o2[6], o2[7]};
        d3[0] = (u32x4){o3[0], o3[1], o3[2], o3[3]}; d3[1] = (u32x4){o3[4], o3[5], o3[6], o3[7]};
    }
    hgrn_vt(lds, PROJ, c, h, tid);
    __syncthreads();
    const int fr = lane & 15, fq = lane >> 4;
#pragma unroll
    for (int q = 0; q < 2; ++q) {
        const int tile = 2 * wave + q, tt = tile >> 2, stl = tile & 3;
        f32x4 acc = (f32x4){0.f, 0.f, 0.f, 0.f};
#pragma unroll
        for (int ks = 0; ks < 4; ++ks) { const bf16x8 a = *(const LAS bf16x8*)(lds + HG_Q2 + (16 * tt + fr) * 272 + (32 * ks + 8 * fq) * 2), b = *(const LAS bf16x8*)(lds + HG_K2 + (16 * stl + fr) * 272 + (32 * ks + 8 * fq) * 2);
            acc = __builtin_amdgcn_mfma_f32_16x16x32_bf16(a, b, acc, 0, 0, 0); }
#pragma unroll
        for (int r = 0; r < 4; ++r) { const int t = 16 * tt + 4 * fq + r, s = 16 * stl + fr; *(LAS bf16_t*)(lds + HG_PB + t * 144 + s * 2) = f2bf(s <= t ? acc[r] : 0.f); }
    }
    __syncthreads();
    {
        bf16x8 b1[2], b2[4];
#pragma unroll
        for (int ks = 0; ks < 2; ++ks) b1[ks] = *(const LAS bf16x8*)(lds + HG_VT + (16 * wave + fr) * 144 + (32 * ks + 8 * fq) * 2);
        const float* sp = ST + ((size_t)(c * 8 + h) * 128 + 16 * wave + fr) * 128 + 8 * fq;
#pragma unroll
        for (int ks = 0; ks < 4; ++ks) { const f32x4 x0 = *(const f32x4*)(sp + 32 * ks), x1 = *(const f32x4*)(sp + 32 * ks + 4);
            u32x4 w; w.x = cvt_pk_bf16(x0[0], x0[1]); w.y = cvt_pk_bf16(x0[2], x0[3]); w.z = cvt_pk_bf16(x1[0], x1[1]); w.w = cvt_pk_bf16(x1[2], x1[3]); b2[ks] = __builtin_bit_cast(bf16x8, w); }
        LAS float* OB = (LAS float*)(lds + HG_GB);
#pragma unroll
        for (int tt = 0; tt < 4; ++tt) {
            f32x4 acc = (f32x4){0.f, 0.f, 0.f, 0.f};
#pragma unroll
            for (int ks = 0; ks < 2; ++ks) { const bf16x8 a = *(const LAS bf16x8*)(lds + HG_PB + (16 * tt + fr) * 144 + (32 * ks + 8 * fq) * 2); acc = __builtin_amdgcn_mfma_f32_16x16x32_bf16(a, b1[ks], acc, 0, 0, 0); }
#pragma unroll
            for (int ks = 0; ks < 4; ++ks) { const bf16x8 a = *(const LAS bf16x8*)(lds + HG_Q1 + (16 * tt + fr) * 272 + (32 * ks + 8 * fq) * 2); acc = __builtin_amdgcn_mfma_f32_16x16x32_bf16(a, b2[ks], acc, 0, 0, 0); }
#pragma unroll
            for (int r = 0; r < 4; ++r) OB[(16 * tt + 4 * fq + r) * 132 + 16 * wave + fr] = acc[r];
        }
    }
    __syncthreads();
    {
        const int t = tid >> 3, es = tid & 7; const LAS float* OB = (const LAS float*)(lds + HG_GB);
        float o[16]; float ss = 0.f;
#pragma unroll
        for (int i = 0; i < 16; ++i) { o[i] = OB[t * 132 + 16 * es + i]; ss += o[i] * o[i]; }
        ss += __shfl_xor(ss, 1); ss += __shfl_xor(ss, 2); ss += __shfl_xor(ss, 4);
        const float rstd = rsqrtf(ss * (1.0f / 128.0f) + NORM_EPS);
        const bf16_t* pg = PROJ + (size_t)(c * 64 + t) * DINP + CHG + h * 128 + 16 * es;
        const u32x4 g0 = *(const u32x4*)pg, g1 = *(const u32x4*)(pg + 8);
        unsigned w[8];
#pragma unroll
        for (int i = 0; i < 16; i += 2) { const float ga = i < 8 ? bfx(g0, i) : bfx(g1, i - 8), gb = (i + 1) < 8 ? bfx(g0, i + 1) : bfx(g1, i + 1 - 8);
            w[i >> 1] = cvt_pk_bf16(o[i] * rstd * norm_g[16 * es + i] * siluf_(ga), o[i + 1] * rstd * norm_g[16 * es + i + 1] * siluf_(gb)); }
        u32x4* dst = (u32x4*)(REC + (size_t)(c * 64 + t) * 1024 + h * 128 + 16 * es);
        dst[0] = (u32x4){w[0], w[1], w[2], w[3]}; dst[1] = (u32x4){w[4], w[5], w[6], w[7]};
    }
    __syncthreads();
}

__device__ __forceinline__ void score_block(LAS unsigned char* lds, const bf16_t* PROJ, const bf16_t* KI, float* SCORES, int qb, int tid, int wave, int lane) {
    const int t0 = qb * 32, nkt = (t0 >> 7) + 1;
    const int r = lane & 31, hh = lane >> 5;
    bf16x8 Af[2][4]; float wv[2][16];
#pragma unroll
    for (int p = 0; p < 2; ++p) {
        const int tq = t0 + 4 * wave + 2 * p + (r >> 4); const bf16_t* qrow = PROJ + (size_t)tq * DINP + CQI + (r & 15) * 64 + 8 * hh;
#pragma unroll
        for (int ks = 0; ks < 4; ++ks) Af[p][ks] = *(const bf16x8*)(qrow + 16 * ks);
#pragma unroll
        for (int reg = 0; reg < 16; ++reg) { const int row = (reg & 3) + 8 * (reg >> 2) + 4 * hh; const int tw = t0 + 4 * wave + 2 * p + (row >> 4);
            wv[p][reg] = bf2f(PROJ[(size_t)tw * DINP + CWI + (row & 15)]) * (1.0f / 32.0f); }
    }
    u32x4 stg[2];
#pragma unroll
    for (int i = 0; i < 2; ++i) { const int q = tid + 512 * i; stg[i] = *(const u32x4*)(KI + (size_t)(q >> 3) * 64 + (q & 7) * 8); }
#pragma unroll
    for (int i = 0; i < 2; ++i) { const int q = tid + 512 * i; *(LAS u32x4*)(lds + (q >> 3) * 144 + (q & 7) * 16) = stg[i]; }
    __syncthreads();
    for (int kt = 0; kt < nkt; ++kt) {
        const LAS unsigned char* buf = lds + (kt & 1) * 18432;
        if (kt + 1 < nkt) {
#pragma unroll
            for (int i = 0; i < 2; ++i) { const int q = tid + 512 * i; stg[i] = *(const u32x4*)(KI + (size_t)((kt + 1) * 128 + (q >> 3)) * 64 + (q & 7) * 8); }
        }
#pragma unroll 1
        for (int cb = 0; cb < 4; ++cb) {
            bf16x8 Bf[4];
#pragma unroll
            for (int ks = 0; ks < 4; ++ks) Bf[ks] = *(const LAS bf16x8*)(buf + (32 * cb + r) * 144 + (16 * ks + 8 * hh) * 2);
#pragma unroll
            for (int p = 0; p < 2; ++p) {
                f32x16 acc;
#pragma unroll
                for (int i = 0; i < 16; ++i) acc[i] = 0.f;
#pragma unroll
                for (int ks = 0; ks < 4; ++ks) acc = __builtin_amdgcn_mfma_f32_32x32x16_bf16(Af[p][ks], Bf[ks], acc, 0, 0, 0);
                float p0 = 0.f, p1 = 0.f;
#pragma unroll
                for (int reg = 0; reg < 8; ++reg) { p0 += wv[p][reg] * fmaxf(acc[reg], 0.f); p1 += wv[p][reg + 8] * fmaxf(acc[reg + 8], 0.f); }
                const float send = hh ? p0 : p1; const float recv = __shfl_xor(send, 32); const float mine = (hh ? p1 : p0) + recv;
                const int tq = t0 + 4 * wave + 2 * p + hh;
                SCORES[(size_t)tq * S + kt * 128 + 32 * cb + r] = mine;
            }
        }
        if (kt + 1 < nkt) {
#pragma unroll
            for (int i = 0; i < 2; ++i) { const int q = tid + 512 * i; *(LAS u32x4*)(lds + ((kt + 1) & 1) * 18432 + (q >> 3) * 144 + (q & 7) * 16) = stg[i]; }
        }
        __syncthreads();
    }
}

__device__ __forceinline__ void select_pair(LAS unsigned char* lds, const float* SCORES, int* SEL, int ta, int tid, int wave, int lane) {
    LAS float* redf = (LAS float*)lds;
    LAS int* cnt = (LAS int*)(lds + 256);
    LAS int* wcnt = (LAS int*)(lds + 512);
    const float NINF = -__builtin_inff();
    float v[2][32];
    const int nj = ((ta + 1) >> 9) + 1;
#pragma unroll
    for (int r = 0; r < 2; ++r) { const int t = ta + r; const float* row = SCORES + (size_t)t * S;
#pragma unroll
        for (int j = 0; j < 32; ++j) { const int idx = tid + 512 * j; v[r][j] = (j < nj && idx <= t) ? row[idx] : NINF; } }
    float lo[2], hi[2], tau[2]; bool done[2];
#pragma unroll
    for (int r = 0; r < 2; ++r) { float mx = NINF, mn = __builtin_inff();
#pragma unroll
        for (int j = 0; j < 32; ++j) { mx = fmaxf(mx, v[r][j]); mn = fminf(mn, v[r][j] == NINF ? __builtin_inff() : v[r][j]); }
        mx = wave_max(mx); mn = -wave_max(-mn);
        if (lane == 0) { redf[(r * 2 + 0) * 8 + wave] = mn; redf[(r * 2 + 1) * 8 + wave] = mx; } }
    __syncthreads();
#pragma unroll
    for (int r = 0; r < 2; ++r) { float mn = redf[(r * 2) * 8], mx = redf[(r * 2 + 1) * 8];
#pragma unroll
        for (int w = 1; w < 8; ++w) { mn = fminf(mn, redf[(r * 2) * 8 + w]); mx = fmaxf(mx, redf[(r * 2 + 1) * 8 + w]); }
        lo[r] = mn; hi[r] = mx; tau[r] = mn; done[r] = false; }
    for (int it = 0; it < 80; ++it) {
        float mid[2];
#pragma unroll
        for (int r = 0; r < 2; ++r) { mid[r] = 0.5f * (lo[r] + hi[r]); if (!done[r] && !(mid[r] > lo[r] && mid[r] < hi[r])) { done[r] = true; tau[r] = lo[r]; } }
        if (done[0] && done[1]) break;
#pragma unroll
        for (int r = 0; r < 2; ++r) { int c = 0;
#pragma unroll
            for (int j = 0; j < 32; ++j) if (j < nj) c += __popcll(__ballot(v[r][j] >= mid[r]));
            if (lane == 0) cnt[((it & 1) * 2 + r) * 8 + wave] = c; }
        __syncthreads();
#pragma unroll
        for (int r = 0; r < 2; ++r) { int tot = 0;
#pragma unroll
            for (int w = 0; w < 8; ++w) tot += cnt[((it & 1) * 2 + r) * 8 + w];
            if (!done[r]) { if (tot == 256) { done[r] = true; tau[r] = mid[r]; } else if (tot > 256) lo[r] = mid[r]; else hi[r] = mid[r]; } }
    }
#pragma unroll
    for (int r = 0; r < 2; ++r) { int c = 0;
#pragma unroll
        for (int j = 0; j < 32; ++j) if (j < nj) c += __popcll(__ballot(v[r][j] >= tau[r]));
        if (lane == 0) wcnt[r * 8 + wave] = c; }
    __syncthreads();
#pragma unroll
    for (int r = 0; r < 2; ++r) { int base = 0;
        for (int w = 0; w < wave; ++w) base += wcnt[r * 8 + w];
        int* dst = SEL + (size_t)(ta + r) * 256;
#pragma unroll
        for (int j = 0; j < 32; ++j) if (j < nj) { const bool pred = v[r][j] >= tau[r]; const unsigned long long mask = __ballot(pred);
            const int pos = base + __popcll(mask & ((1ull << lane) - 1ull)); if (pred && pos < 256) dst[pos] = tid + 512 * j; base += __popcll(mask); } }
    __syncthreads();
}

__device__ __forceinline__ void attn_query(LAS unsigned char* wl, const bf16_t* PROJ, const bf16_t* KC, const bf16_t* VC, const int* SEL, bf16_t* ATT, int t, int lane) {
    LAS int* selw = (LAS int*)wl; LAS float* L = (LAS float*)(wl + 1024);
    const int nsel = t < 255 ? t + 1 : 256;
#pragma unroll
    for (int i = 0; i < 4; ++i) { const int idx = lane + 64 * i; int s = (t >= 256) ? SEL[(size_t)t * 256 + idx] : idx; s = s < 0 ? 0 : (s > t ? t : s); if (idx >= nsel) s = 0; selw[idx] = s; }
    const int fr = lane & 15, fq = lane >> 4;
    bf16x8 qf[2][4];
#pragma unroll
    for (int g = 0; g < 2; ++g)
#pragma unroll
        for (int ks = 0; ks < 4; ++ks) { const bf16x8 z = {0, 0, 0, 0, 0, 0, 0, 0}; qf[g][ks] = fr < 4 ? *(const bf16x8*)(PROJ + (size_t)t * DINP + CQ + (4 * g + fr) * 128 + 32 * ks + 8 * fq) : z; }
    const float scale = 0.08838834764831845f;
    const int nkt = (nsel + 15) >> 4;
    for (int kt = 0; kt < 16; ++kt) {
        if (kt < nkt) {
            const int key = selw[16 * kt + fr]; const bf16_t* kp = KC + (size_t)key * 256 + 8 * fq;
            bf16x8 kf[2][4];
#pragma unroll
            for (int g = 0; g < 2; ++g)
#pragma unroll
                for (int ks = 0; ks < 4; ++ks) kf[g][ks] = *(const bf16x8*)(kp + g * 128 + 32 * ks);
#pragma unroll
            for (int g = 0; g < 2; ++g) { f32x4 acc = (f32x4){0.f, 0.f, 0.f, 0.f};
#pragma unroll
                for (int ks = 0; ks < 4; ++ks) acc = __builtin_amdgcn_mfma_f32_16x16x32_bf16(qf[g][ks], kf[g][ks], acc, 0, 0, 0);
                if (fq == 0) {
#pragma unroll
                    for (int r = 0; r < 4; ++r) L[(4 * g + r) * 256 + 16 * kt + fr] = (16 * kt + fr < nsel) ? acc[r] * scale : -__builtin_inff(); } }
        } else if (fq == 0) {
#pragma unroll
            for (int r = 0; r < 8; ++r) L[r * 256 + 16 * kt + fr] = -__builtin_inff();
        }
    }
    float p[8][4];
#pragma unroll
    for (int hd = 0; hd < 8; ++hd) { float m = -__builtin_inff();
#pragma unroll
        for (int i = 0; i < 4; ++i) { p[hd][i] = L[hd * 256 + lane + 64 * i]; m = fmaxf(m, p[hd][i]); }
        m = wave_max(m); float s = 0.f;
#pragma unroll
        for (int i = 0; i < 4; ++i) { p[hd][i] = __expf(p[hd][i] - m); s += p[hd][i]; }
        s = 1.0f / wave_sum(s);
#pragma unroll
        for (int i = 0; i < 4; ++i) p[hd][i] *= s; }
#pragma unroll
    for (int i = 0; i < 4; ++i)
#pragma unroll
        for (int g = 0; g < 2; ++g) *(LAS f32x4*)(L + ((g * 256 + lane + 64 * i) * 4)) = (f32x4){p[4 * g][i], p[4 * g + 1][i], p[4 * g + 2][i], p[4 * g + 3][i]};
    float o[2][4][2];
#pragma unroll
    for (int g = 0; g < 2; ++g)
#pragma unroll
        for (int hh = 0; hh < 4; ++hh) { o[g][hh][0] = 0.f; o[g][hh][1] = 0.f; }
    const int kend = (nsel + 3) & ~3;
    for (int kk = 0; kk < kend; kk += 4) {
        const i32x4 k4 = *(const LAS i32x4*)(selw + kk); const int ks4[4] = {k4[0], k4[1], k4[2], k4[3]};
        unsigned vw[4][2];
#pragma unroll
        for (int u = 0; u < 4; ++u) { const int key = __builtin_amdgcn_readfirstlane(ks4[u]);
#pragma unroll
            for (int g = 0; g < 2; ++g) vw[u][g] = *(const unsigned*)(VC + (size_t)key * 256 + g * 128 + 2 * lane); }
#pragma unroll
        for (int u = 0; u < 4; ++u)
#pragma unroll
            for (int g = 0; g < 2; ++g) { const f32x4 p4 = *(const LAS f32x4*)(L + (g * 256 + kk + u) * 4); const float v0 = bf_lo(vw[u][g]), v1 = bf_hi(vw[u][g]);
#pragma unroll
                for (int hh = 0; hh < 4; ++hh) { o[g][hh][0] += p4[hh] * v0; o[g][hh][1] += p4[hh] * v1; } }
    }
#pragma unroll
    for (int g = 0; g < 2; ++g)
#pragma unroll
        for (int hh = 0; hh < 4; ++hh) *(unsigned*)(ATT + (size_t)t * 1024 + (4 * g + hh) * 128 + 2 * lane) = cvt_pk_bf16(o[g][hh][0], o[g][hh][1]);
}

__global__ void __launch_bounds__(NTHR, 2) fwd_kernel(Args args) {
    extern __shared__ __attribute__((aligned(16))) unsigned char lds_raw[];
    LAS unsigned char* lds = (LAS unsigned char*)lds_raw;
    volatile LAS unsigned* MISC = (volatile LAS unsigned*)(lds + LDS_MISC);
    const int tid = threadIdx.x, lane = tid & 63, wave = __builtin_amdgcn_readfirstlane(tid >> 6);
    const int G = gridDim.x, wg = blockIdx.x;
    unsigned char* ws = args.ws;
    unsigned* ctl = (unsigned*)(ws + WS_CTL);
    const int lo = args.ph_lo, hi = args.ph_hi, flags = args.flags;
    const float* x = (const float*)args.in[0]; const float* cvec = (const float*)args.in[1]; const int* positions = (const int*)args.in[2];
    const float* w_ada = (const float*)args.in[3]; const float* b_ada = (const float*)args.in[4]; const float* norm1_g = (const float*)args.in[5];
    const float* w_in = (const float*)args.in[6]; const float* idx_knorm_g = (const float*)args.in[7]; const float* idx_knorm_b = (const float*)args.in[8];
    const float* lb_logits = (const float*)args.in[9]; const float* hgrn_norm_g = (const float*)args.in[10];
    const float* w_proj_att = (const float*)args.in[11]; const float* w_proj_hgrn = (const float*)args.in[12]; const float* w_out = (const float*)args.in[13];
    const float* norm2_g = (const float*)args.in[14]; const float* w_router = (const float*)args.in[15]; const float* b_router = (const float*)args.in[16];
    const float* w1 = (const float*)args.in[17]; const float* b1 = (const float*)args.in[18]; const float* w2 = (const float*)args.in[19]; const float* b2 = (const float*)args.in[20];
    const float* final_g = (const float*)args.in[21];
    float* out = args.out;
    float* MOD = (float*)(ws + WS_MOD); int* TOPE = (int*)(ws + WS_TOPE); float* GATE = (float*)(ws + WS_GATE); int* SLOT = (int*)(ws + WS_SLOT);
    bf16_t* WIN_T = (bf16_t*)(ws + WS_WIN_T); bf16_t* WA_T = (bf16_t*)(ws + WS_WA_T); bf16_t* WH_T = (bf16_t*)(ws + WS_WH_T); bf16_t* WO_T = (bf16_t*)(ws + WS_WO_T);
    bf16_t* W1_T = (bf16_t*)(ws + WS_W1_T); bf16_t* W2_T = (bf16_t*)(ws + WS_W2_T);
    bf16_t* HB = (bf16_t*)(ws + WS_H); bf16_t* PROJ = (bf16_t*)(ws + WS_PROJ);
    float* X1 = (float*)(ws + WS_X1);
    bf16_t* XB = (bf16_t*)(ws + WS_XB); bf16_t* ACT = (bf16_t*)(ws + WS_ACT); bf16_t* YB = (bf16_t*)(ws + WS_YB);
    bf16_t* KI = (bf16_t*)(ws + WS_KI); bf16_t* KC = (bf16_t*)(ws + WS_KC); bf16_t* VC = (bf16_t*)(ws + WS_VC);
    float* ST = (float*)(ws + WS_ST); float* DC = (float*)(ws + WS_DC); int* SEL = (int*)(ws + WS_SEL);
    bf16_t* ATT = (bf16_t*)(ws + WS_ATT); bf16_t* REC = (bf16_t*)(ws + WS_REC); bf16_t* MERGED = (bf16_t*)(ws + WS_MERGED); float* SCORES = (float*)(ws + WS_SCORES);

    for (int u = tid; u < 128; u += NTHR) MISC[u] = 0u;
    __syncthreads();
    const bool one_launch = (hi - lo) > 1;
    XcdBarrier bar; bar.bar = ctl + CW_BAR; bar.x = 0; bar.st = MISC + 8;
    if (one_launch) bar = xcd_barrier_post(ctl + CW_BAR, MISC + 8);
#define IN(k) (lo <= (k) && (k) < hi)
#define SEAM(k) do { if (IN(k) && IN((k) + 1)) xcd_barrier(bar); } while (0)

    const float* x1src = (flags & FLAG_MIXER) ? (const float*)X1 : x;

    if (IN(PH_PRO)) {
        if (wg < 192) {
            LAS float* red = (LAS float*)lds;
            const int col = wg * 64 + lane; float acc = 0.f;
            for (int k = wave; k < D; k += 64) {
                float wv[8], cv[8];
#pragma unroll
                for (int i = 0; i < 8; ++i) { wv[i] = w_ada[(size_t)(k + 8 * i) * (6 * D) + col]; cv[i] = cvec[k + 8 * i]; }
#pragma unroll
                for (int i = 0; i < 8; ++i) acc += siluf_(cv[i]) * wv[i];
            }
            red[wave * 64 + lane] = acc;
            __syncthreads();
            if (tid < 64) { float s = b_ada[col]; for (int w = 0; w < 8; ++w) s += red[w * 64 + tid]; MOD[col] = s; }
            __syncthreads();
        }
        LAS unsigned char* scr = lds + wave * 17408;
        const int gw = wg * NWAVES + wave, NGW = G * NWAVES;
        if (flags & FLAG_MIXER) {
            constexpr int NB_IN = (DIN + 63) / 64;
            for (int it = gw; it < 16 * NB_IN; it += NGW) convert_item(w_in, 2048, DIN, WIN_T, 1, it, lane, scr);
            for (int it = gw; it < 8 * 32; it += NGW) convert_item(w_proj_att, 1024, 2048, WA_T, 0, it, lane, scr);
            for (int it = gw; it < 8 * 32; it += NGW) convert_item(w_proj_hgrn, 1024, 2048, WH_T, 0, it, lane, scr);
            for (int it = gw; it < 16 * 32; it += NGW) convert_item(w_out, 2048, 2048, WO_T, 0, it, lane, scr);
            for (size_t i = (size_t)wg * NTHR + tid; i < (size_t)176 * 2048 * 2 / 16; i += (size_t)G * NTHR) ((u32x4*)(WIN_T + (size_t)2640 * 2048))[i] = (u32x4){0u, 0u, 0u, 0u};
        }
        if (flags & FLAG_MOE) {
            constexpr int I1 = (2048 / 128) * (4096 / 64), I2 = (2048 / 128) * (2048 / 64);
            for (int it = gw; it < NEXP * I1; it += NGW) { const int e = it / I1, r = it - e * I1; convert_item(w1 + (size_t)e * 2048 * 4096, 2048, 4096, W1_T + (size_t)e * 4096 * 2048, 2, r, lane, scr); }
            for (int it = gw; it < NEXP * I2; it += NGW) { const int e = it / I2, r = it - e * I2; convert_item(w2 + (size_t)e * 2048 * 2048, 2048, 2048, W2_T + (size_t)e * 2048 * 2048, 0, r, lane, scr); }
        }
    }
    SEAM(PH_PRO);

    if (flags & FLAG_MIXER) {
    if (IN(PH_H)) {
        const float* sh1 = MOD; const float* sc1 = MOD + D;
        const int gw = wg * NWAVES + wave, NGW = G * NWAVES;
        f32x4 gs[8], sh[8];
#pragma unroll
        for (int j = 0; j < 8; ++j) { const int c = 4 * lane + 256 * j; const f32x4 g = *(const f32x4*)(norm1_g + c), sc = *(const f32x4*)(sc1 + c); sh[j] = *(const f32x4*)(sh1 + c);
#pragma unroll
            for (int e = 0; e < 4; ++e) gs[j][e] = g[e] * (1.0f + sc[e]); }
        for (int t = gw; t < S; t += NGW) {
            const f32x4* xr = (const f32x4*)(x + (size_t)t * D) + lane;
            f32x4 v[8]; float ss = 0.f;
#pragma unroll
            for (int j = 0; j < 8; ++j) { v[j] = xr[64 * j]; ss += (v[j][0] * v[j][0] + v[j][1] * v[j][1]) + (v[j][2] * v[j][2] + v[j][3] * v[j][3]); }
            const float rstd = rsqrtf(wave_sum(ss) * (1.0f / D) + NORM_EPS);
#pragma unroll
            for (int j = 0; j < 8; ++j) { const f32x4 h = v[j] * rstd * gs[j] + sh[j]; u32x2 w; w.x = cvt_pk_bf16(h[0], h[1]); w.y = cvt_pk_bf16(h[2], h[3]);
                *(u32x2*)(HB + (size_t)t * D + 4 * lane + 256 * j) = w; }
        }
    }
    SEAM(PH_H);
    if (IN(PH_INPROJ)) {
        pg8::Gemm g{HB, WIN_T, 2048, 0}; pg8::StaticOrder So; So.init(S, DINP, G, wg);
        pg8::EpiBf16 E{PROJ, DINP, nullptr, 0};
        pg8::gemm_phase<pg8::EpiBf16, pg8::StaticOrder>(lds, g, So, E);
    }
    SEAM(PH_INPROJ);
    if (IN(PH_POST)) {
        const int gw = wg * NWAVES + wave, NGW = G * NWAVES;
        for (int t = gw; t < S; t += NGW) post_token(PROJ, KI, KC, VC, positions, idx_knorm_g, idx_knorm_b, t, lane);
        __syncthreads();
        for (int u = wg; u < 2048; u += G) hgrn_l1(lds, PROJ, lb_logits, ST, DC, u >> 3, u & 7, tid, wave, lane);
    }
    SEAM(PH_POST);
    if (IN(PH_SCORE)) {
        for (int idx = wg * NTHR + tid; idx < 8 * 128 * 128; idx += G * NTHR) {
            const int h = idx >> 14, d = idx & 127; float s = 0.f;
            float* sp = ST + idx; const float* dp = DC + h * 128 + d;
            for (int c = 0; c < 256; c += 8) {
                float l[8], dc[8];
#pragma unroll
                for (int i = 0; i < 8; ++i) { l[i] = sp[(size_t)(c + i) * 131072]; dc[i] = dp[(size_t)(c + i) * 1024]; }
#pragma unroll
                for (int i = 0; i < 8; ++i) { sp[(size_t)(c + i) * 131072] = s; s = dc[i] * s + l[i]; }
            }
        }
        if (flags & FLAG_ATT) {
            for (int j = wg; j < 252; j += G) { score_block(lds, PROJ, KI, SCORES, 8 + j, tid, wave, lane); score_block(lds, PROJ, KI, SCORES, 511 - j, tid, wave, lane); }
        }
    }
    SEAM(PH_SCORE);
    if (IN(PH_SELECT)) {
        for (int u = wg; u < 2048; u += G) hgrn_l3(lds, PROJ, lb_logits, ST, hgrn_norm_g, REC, u >> 3, u & 7, tid, wave, lane);
        if (flags & FLAG_ATT) {
            for (int pi = wg; pi < (S - 256) / 2; pi += G) select_pair(lds, SCORES, SEL, 256 + 2 * pi, tid, wave, lane);
        }
    }
    SEAM(PH_SELECT);
    if (IN(PH_ATTN)) {
        const int gw = wg * NWAVES + wave, NGW = G * NWAVES;
        if (flags & FLAG_ATT) {
            for (int t = gw; t < S; t += NGW) attn_query(lds + wave * 9216, PROJ, KC, VC, SEL, ATT, t, lane);
        } else {
            for (size_t i = (size_t)wg * NTHR + tid; i < (size_t)S * 1024 * 2 / 16; i += (size_t)G * NTHR) ((u32x4*)ATT)[i] = (u32x4){0u, 0u, 0u, 0u};
        }
    }
    SEAM(PH_ATTN);
    if (IN(PH_OP1)) {
        pg8::Gemm g{ATT, WA_T, 1024, 0}; pg8::StaticOrder So; So.init(S, 2048, G, wg);
        pg8::EpiGate E{MERGED, PROJ + CGA, 0};
        pg8::gemm_phase<pg8::EpiGate, pg8::StaticOrder>(lds, g, So, E);
    }
    SEAM(PH_OP1);
    if (IN(PH_OP2)) {
        pg8::Gemm g{REC, WH_T, 1024, 0}; pg8::StaticOrder So; So.init(S, 2048, G, wg);
        pg8::EpiGate E{MERGED, PROJ + CGR, 1};
        pg8::gemm_phase<pg8::EpiGate, pg8::StaticOrder>(lds, g, So, E);
    }
    SEAM(PH_OP2);
    if (IN(PH_WOUT)) {
        pg8::Gemm g{MERGED, WO_T, 2048, 0}; pg8::StaticOrder So; So.init(S, 2048, G, wg);
        pg8::EpiResid E{x, MOD + 2 * D, X1};
        pg8::gemm_phase<pg8::EpiResid, pg8::StaticOrder>(lds, g, So, E);
    }
    SEAM(PH_WOUT);
    }

    if (IN(PH_ROUTER) && (flags & FLAG_MOE)) {
        LAS float* hs = (LAS float*)lds;
        volatile LAS unsigned* lcnt = MISC + 32;
        const float* sh2 = MOD + 3 * D; const float* sc2 = MOD + 4 * D;
        if (tid < 32) lcnt[tid] = 0u;
        __syncthreads();
        for (int grp = wg; grp < S / 16; grp += G) {
#pragma unroll 1
            for (int q = 0; q < 2; ++q) {
                const int tl = 2 * wave + q, t = grp * 16 + tl;
                const f32x4* xr = (const f32x4*)(x1src + (size_t)t * D) + lane;
                f32x4 v[8]; float ss = 0.f;
#pragma unroll
                for (int j = 0; j < 8; ++j) { v[j] = xr[64 * j]; ss += (v[j][0] * v[j][0] + v[j][1] * v[j][1]) + (v[j][2] * v[j][2] + v[j][3] * v[j][3]); }
                const float rstd = rsqrtf(wave_sum(ss) * (1.0f / D) + NORM_EPS);
#pragma unroll
                for (int j = 0; j < 8; ++j) {
                    const int c = 4 * lane + 256 * j;
                    const f32x4 g = *(const f32x4*)(norm2_g + c), sc = *(const f32x4*)(sc2 + c), sh = *(const f32x4*)(sh2 + c);
                    f32x4 h;
#pragma unroll
                    for (int e = 0; e < 4; ++e) h[e] = v[j][e] * rstd * g[e] * (1.0f + sc[e]) + sh[e];
                    *(LAS f32x4*)(hs + tl * 2048 + c) = h;
                    u32x2 w; w.x = cvt_pk_bf16(h[0], h[1]); w.y = cvt_pk_bf16(h[2], h[3]);
                    *(u32x2*)(HB + (size_t)t * D + c) = w;
                }
            }
            __syncthreads();
            {
                const int tl = tid >> 5, e = tid & 31, t = grp * 16 + tl;
                float a0 = 0.f, a1 = 0.f, a2 = 0.f, a3 = 0.f;
                const LAS float* hrow = hs + tl * 2048; const float* wr = w_router + e;
#pragma unroll 4
                for (int c = 0; c < D; c += 4) {
                    const f32x4 hv = *(const LAS f32x4*)(hrow + c);
                    a0 += hv[0] * wr[(size_t)(c + 0) * 32]; a1 += hv[1] * wr[(size_t)(c + 1) * 32]; a2 += hv[2] * wr[(size_t)(c + 2) * 32]; a3 += hv[3] * wr[(size_t)(c + 3) * 32];
                }
                float v = ((a0 + a1) + (a2 + a3)) + b_router[e];
                float tv[4]; int ti[4];
#pragma unroll
                for (int k = 0; k < 4; ++k) {
                    float bv = v; int bi = e;
#pragma unroll
                    for (int o = 16; o >= 1; o >>= 1) { const float ov = __shfl_xor(bv, o); const int oi = __shfl_xor(bi, o); if (ov > bv || (ov == bv && oi < bi)) { bv = ov; bi = oi; } }
                    tv[k] = bv; ti[k] = bi; if (e == bi) v = -__builtin_inff();
                }
                if (e == 0) {
                    const float e1 = __expf(tv[1] - tv[0]), e2 = __expf(tv[2] - tv[0]), e3 = __expf(tv[3] - tv[0]); const float inv = 1.0f / (1.0f + e1 + e2 + e3);
                    *(int4*)(TOPE + (size_t)t * 4) = make_int4(ti[0], ti[1], ti[2], ti[3]);
                    *(f32x4*)(GATE + (size_t)t * 4) = (f32x4){inv, e1 * inv, e2 * inv, e3 * inv};
#pragma unroll
                    for (int k = 0; k < 4; ++k) __hip_atomic_fetch_add((LAS unsigned*)&lcnt[ti[k]], 1u, __ATOMIC_RELAXED, __HIP_MEMORY_SCOPE_WORKGROUP);
                }
            }
            __syncthreads();
        }
        if (tid < 32) { const unsigned c = lcnt[tid]; if (c) __hip_atomic_fetch_add(ctl + CW_CNT + tid, c, __ATOMIC_RELAXED, __HIP_MEMORY_SCOPE_AGENT); }
    }
    SEAM(PH_ROUTER);

    if (IN(PH_SCATTER) && (flags & FLAG_MOE)) {
        volatile LAS unsigned* lcnt = MISC + 32; volatile LAS unsigned* lbase = MISC + 64; LAS int* pstart = (LAS int*)(lds + 1024); LAS int* slot_l = (LAS int*)(lds + 2048);
        if (tid == 0) { int p = 0; for (int e = 0; e < NEXP; ++e) { pstart[e] = p; p += (int)((__hip_atomic_load(ctl + CW_CNT + e, __ATOMIC_RELAXED, __HIP_MEMORY_SCOPE_AGENT) + 255u) & ~255u); } }
        if (tid < 32) lcnt[tid] = 0u;
        __syncthreads();
        for (int blk = wg; blk < S / 64; blk += G) {
            int e = 0, lrank = 0;
            if (tid < 256) { e = TOPE[(size_t)blk * 256 + tid]; lrank = (int)__hip_atomic_fetch_add((LAS unsigned*)&lcnt[e], 1u, __ATOMIC_RELAXED, __HIP_MEMORY_SCOPE_WORKGROUP); }
            __syncthreads();
            if (tid < 32) { const unsigned c = lcnt[tid]; lbase[tid] = c ? __hip_atomic_fetch_add(ctl + CW_FILL + tid, c, __ATOMIC_RELAXED, __HIP_MEMORY_SCOPE_AGENT) : 0u; }
            __syncthreads();
            if (tid < 256) { const int slot = pstart[e] + (int)lbase[e] + lrank; SLOT[(size_t)blk * 256 + tid] = slot; slot_l[tid] = slot; }
            __syncthreads();
            for (int a = wave; a < 256; a += NWAVES) {
                const int t = blk * 64 + (a >> 2), slot = slot_l[a];
                const u32x4* src = (const u32x4*)(HB + (size_t)t * D) + lane; u32x4* dst = (u32x4*)(XB + (size_t)slot * D) + lane;
#pragma unroll
                for (int j = 0; j < 4; ++j) dst[64 * j] = src[64 * j];
            }
            if (tid < 32) lcnt[tid] = 0u;
            __syncthreads();
        }
    }
    SEAM(PH_SCATTER);

    if ((IN(PH_MOE1) || IN(PH_MOE2)) && (flags & FLAG_MOE)) {
        LAS int* panel_e = (LAS int*)(lds + 131072 + 2048);
        LAS int* npan = (LAS int*)(lds + 131072 + 2048 + 2048);
        __syncthreads();
        if (tid == 0) { int p = 0; for (int e = 0; e < NEXP; ++e) { const int np = (int)((__hip_atomic_load(ctl + CW_CNT + e, __ATOMIC_RELAXED, __HIP_MEMORY_SCOPE_AGENT) + 255u) >> 8); for (int q = 0; q < np; ++q) panel_e[p + q] = e; p += np; } npan[0] = p; }
        __syncthreads();
        const int nPanels = npan[0];
        if (IN(PH_MOE1)) {
            pg8::Gemm g{XB, W1_T, 2048, (size_t)4096 * 2048 * 2}; pg8::MoeOrder So; So.init(nPanels, 16, G, wg, panel_e);
            pg8::EpiSwiglu E{ACT, b1};
            pg8::gemm_phase<pg8::EpiSwiglu, pg8::MoeOrder>(lds, g, So, E);
        }
        SEAM(PH_MOE1);
        if (IN(PH_MOE2)) {
            pg8::Gemm g{ACT, W2_T, 2048, (size_t)2048 * 2048 * 2}; pg8::MoeOrder So; So.init(nPanels, 8, G, wg, panel_e);
            pg8::EpiBf16 E{YB, 2048, b2, 2048};
            pg8::gemm_phase<pg8::EpiBf16, pg8::MoeOrder>(lds, g, So, E);
        }
    }
    SEAM(PH_MOE2);

    if (IN(PH_FINAL)) {
        const float* gt2 = MOD + 5 * D;
        const int gw = wg * NWAVES + wave, NGW = G * NWAVES;
        for (int t = gw; t < S; t += NGW) {
            const f32x4* xr = (const f32x4*)(x1src + (size_t)t * D) + lane;
            f32x4 v[8];
#pragma unroll
            for (int j = 0; j < 8; ++j) v[j] = xr[64 * j];
            if (flags & FLAG_MOE) {
                f32x4 m[8];
#pragma unroll
                for (int j = 0; j < 8; ++j) m[j] = (f32x4){0.f, 0.f, 0.f, 0.f};
                const int4 sl = *(const int4*)(SLOT + (size_t)t * 4); const f32x4 gt = *(const f32x4*)(GATE + (size_t)t * 4);
                const int sls[4] = {sl.x, sl.y, sl.z, sl.w};
#pragma unroll
                for (int k = 0; k < 4; ++k) {
                    const u32x2* yr = (const u32x2*)(YB + (size_t)sls[k] * D) + lane; const float gk = gt[k];
#pragma unroll
                    for (int j = 0; j < 8; ++j) { const u32x2 w = yr[64 * j]; m[j][0] += gk * bf_lo(w.x); m[j][1] += gk * bf_hi(w.x); m[j][2] += gk * bf_lo(w.y); m[j][3] += gk * bf_hi(w.y); }
                }
#pragma unroll
                for (int j = 0; j < 8; ++j) { const f32x4 g2 = *(const f32x4*)(gt2 + 4 * lane + 256 * j); v[j] = v[j] + g2 * m[j]; }
            }
            float ss = 0.f;
#pragma unroll
            for (int j = 0; j < 8; ++j) ss += (v[j][0] * v[j][0] + v[j][1] * v[j][1]) + (v[j][2] * v[j][2] + v[j][3] * v[j][3]);
            const float rstd = rsqrtf(wave_sum(ss) * (1.0f / D) + NORM_EPS);
            f32x4* orow = (f32x4*)(out + (size_t)t * D) + lane;
#pragma unroll
            for (int j = 0; j < 8; ++j) { const f32x4 fg = *(const f32x4*)(final_g + 4 * lane + 256 * j); orow[64 * j] = v[j] * rstd * fg; }
        }
    }
#undef IN
#undef SEAM
}

#ifndef MK_ONE_LAUNCH
#define MK_ONE_LAUNCH 1
#endif
#ifndef MK_FLAGS
#define MK_FLAGS (FLAG_MOE | FLAG_MIXER | FLAG_ATT)
#endif
extern "C" void kernel_launch(void* const* d_in, const int* in_sizes, int n_in, void* d_out, int out_size, void* d_ws, size_t ws_size, hipStream_t stream) {
    static int grid = 0;
    if (grid == 0) {
        if (n_in != 22 || out_size != S * D || ws_size < WS_END) { fprintf(stderr, "kernel_launch: unexpected shapes: n_in %d out %d ws %zu (need %zu)\n", n_in, out_size, ws_size, (size_t)WS_END); grid = -1; return; }
        int dev = 0, cus = 0, per_cu = 0;
        if (hipGetDevice(&dev) != hipSuccess || hipDeviceGetAttribute(&cus, hipDeviceAttributeMultiprocessorCount, dev) != hipSuccess) { grid = -1; return; }
        if (hipFuncSetAttribute((const void*)fwd_kernel, hipFuncAttributeMaxDynamicSharedMemorySize, LDS_BYTES) != hipSuccess) { fprintf(stderr, "kernel_launch: hipFuncSetAttribute failed\n"); grid = -1; return; }
        if (hipOccupancyMaxActiveBlocksPerMultiprocessor(&per_cu, (const void*)fwd_kernel, NTHR, LDS_BYTES) != hipSuccess || per_cu < 1) { fprintf(stderr, "kernel_launch: occupancy query says %d\n", per_cu); (void)hipGetLastError(); grid = -1; return; }
        grid = cus;
    }
    if (grid < 0) return;
    (void)in_sizes;
    hipMemsetAsync((char*)d_ws + WS_CTL, 0, CTL_BYTES, stream);
    Args a{};
    for (int i = 0; i < 22; ++i) a.in[i] = d_in[i];
    a.out = (float*)d_out; a.ws = (unsigned char*)d_ws; a.flags = MK_FLAGS; a.pad = 0;
#if MK_ONE_LAUNCH
    a.ph_lo = 0; a.ph_hi = NPH;
    hipLaunchKernelGGL(fwd_kernel, dim3(grid), dim3(NTHR), LDS_BYTES, stream, a);
#else
    for (int p = 0; p < NPH; ++p) { a.ph_lo = p; a.ph_hi = p + 1; hipLaunchKernelGGL(fwd_kernel, dim3(grid), dim3(NTHR), LDS_BYTES, stream, a); }
#endif
}
```

```cpp
#include <hip/hip_runtime.h>
#include <cstdio>
#include <cstdint>

#define GAS __attribute__((address_space(1)))
#define LAS __attribute__((address_space(3)))
typedef unsigned short bf16_t;
typedef short bf16x8 __attribute__((ext_vector_type(8)));
typedef float f32x4 __attribute__((ext_vector_type(4)));
typedef float f32x2 __attribute__((ext_vector_type(2)));
typedef float f32x16 __attribute__((ext_vector_type(16)));
typedef unsigned u32x4 __attribute__((ext_vector_type(4)));
typedef unsigned u32x2 __attribute__((ext_vector_type(2)));
typedef int i32x4 __attribute__((ext_vector_type(4)));

constexpr int S = 16384, D = 2048, DIN = 10832, DINP = 11008, NEXP = 32, DFF = 2048;
constexpr int NWAVES = 8, NTHR = 512;
constexpr int CQ = 0, CK = 1024, CV = 1280, CQI = 1536, CKI = 2560, CWI = 2624, CHQ = 2816, CHF = 3840, CHI = 4864, CHG = 5888, CGA = 6912, CGR = 8960;
constexpr int PMAX = 65536 + NEXP * 256;
constexpr float NORM_EPS = 1e-5f;

constexpr size_t MiB = 1u << 20;
constexpr size_t al256(size_t x) { return (x + 255) & ~(size_t)255; }
constexpr size_t WS_CTL = 0, CTL_BYTES = 1 * MiB;
constexpr size_t WS_MOD = WS_CTL + CTL_BYTES;
constexpr size_t WS_TOPE = WS_MOD + 64 * 1024;
constexpr size_t WS_GATE = WS_TOPE + (size_t)S * 16;
constexpr size_t WS_SLOT = WS_GATE + (size_t)S * 16;
constexpr size_t WS_WIN_T = WS_SLOT + (size_t)S * 16;
constexpr size_t WS_WA_T = WS_WIN_T + (size_t)DINP * D * 2;
constexpr size_t WS_WH_T = WS_WA_T + (size_t)2048 * 1024 * 2;
constexpr size_t WS_WO_T = WS_WH_T + (size_t)2048 * 1024 * 2;
constexpr size_t WS_W1_T = WS_WO_T + (size_t)2048 * 2048 * 2;
constexpr size_t WS_W2_T = WS_W1_T + (size_t)NEXP * 4096 * 2048 * 2;
constexpr size_t WS_H = WS_W2_T + (size_t)NEXP * 2048 * 2048 * 2;
constexpr size_t WS_PROJ = WS_H + (size_t)S * D * 2;
constexpr size_t WS_KI = WS_PROJ + (size_t)S * DINP * 2;
constexpr size_t WS_KC = WS_KI + (size_t)S * 64 * 2;
constexpr size_t WS_VC = WS_KC + (size_t)S * 256 * 2;
constexpr size_t WS_ST = WS_VC + (size_t)S * 256 * 2;
constexpr size_t WS_DC = WS_ST + (size_t)256 * 8 * 128 * 128 * 4;
constexpr size_t WS_SEL = WS_DC + (size_t)256 * 8 * 128 * 4;
constexpr size_t WS_ATT = WS_SEL + (size_t)S * 256 * 4;
constexpr size_t WS_REC = WS_ATT + (size_t)S * 1024 * 2;
constexpr size_t WS_MERGED = WS_REC + (size_t)S * 1024 * 2;
constexpr size_t WS_X1 = WS_MERGED + (size_t)S * 2048 * 2;
constexpr size_t WS_SCORES = WS_X1 + (size_t)S * 2048 * 4;
constexpr size_t WS_XB = WS_SCORES;
constexpr size_t WS_ACT = WS_XB + (size_t)PMAX * 2048 * 2;
constexpr size_t WS_YB = WS_ACT + (size_t)PMAX * 2048 * 2;
constexpr size_t WS_END = WS_SCORES + (size_t)S * S * 4;
static_assert(WS_YB + (size_t)PMAX * 2048 * 2 <= WS_END, "MoE buffers overlay the score matrix");
static_assert(WS_END <= (size_t)4096 * MiB, "workspace");
constexpr int CW_BAR = 4096, CW_CNT = 8192, CW_FILL = 8448;

constexpr int LDS_BYTES = 147456;
constexpr int LDS_MISC = LDS_BYTES - 512;

__device__ __forceinline__ unsigned cvt_pk_bf16(float lo, float hi) { unsigned r; asm volatile("v_cvt_pk_bf16_f32 %0, %1, %2" : "=v"(r) : "v"(lo), "v"(hi)); return r; }
__device__ __forceinline__ float bf_lo(unsigned u) { return __uint_as_float(u << 16); }
__device__ __forceinline__ float bf_hi(unsigned u) { return __uint_as_float(u & 0xffff0000u); }
__device__ __forceinline__ float bf2f(bf16_t b) { return __uint_as_float(((unsigned)b) << 16); }
__device__ __forceinline__ float wave_sum(float v) {
#pragma unroll
    for (int o = 1; o < 64; o <<= 1) v += __shfl_xor(v, o);
    return v;
}
__device__ __forceinline__ float wave_max(float v) {
#pragma unroll
    for (int o = 1; o < 64; o <<= 1) v = fmaxf(v, __shfl_xor(v, o));
    return v;
}
__device__ __forceinline__ float sigmoidf_(float x) { return 1.0f / (1.0f + __expf(-x)); }
__device__ __forceinline__ float siluf_(float x) { return x / (1.0f + __expf(-x)); }
#define LDS_WAIT() asm volatile("s_waitcnt lgkmcnt(0)" ::: "memory")
#define VM_WAIT() asm volatile("s_waitcnt vmcnt(0)" ::: "memory")

#define XB_TMO      128
#define XB_XCNT(j)  (256  + 64 * (j))
#define XB_XSUB(j)  (1280 + 64 * (j))
#define XB_XGEN(j)  (2304 + 64 * (j))
#define XB_TOP      3328
#define XB_TOPGEN   3392
#define XCD_BAR_WORDS 3456
#define XB_SPIN_CAP (1u << 22)

__device__ __forceinline__ unsigned xb_ld(unsigned* p)              { return __hip_atomic_load(p, __ATOMIC_RELAXED, __HIP_MEMORY_SCOPE_AGENT); }
__device__ __forceinline__ unsigned xb_add(unsigned* p, unsigned v) { return __hip_atomic_fetch_add(p, v, __ATOMIC_RELAXED, __HIP_MEMORY_SCOPE_AGENT); }
__device__ __forceinline__ unsigned xb_xcc_id() { return (unsigned)__builtin_amdgcn_s_getreg((3 << 11) | 20) & 0xFu; }
#define XB_SPIN(cond, bar) do { unsigned _sp = 0; while (cond) { __builtin_amdgcn_s_sleep(1); \
    if ((++_sp & 255u) == 0u) { if (xb_ld(&(bar)[XB_TMO])) break; if (_sp > XB_SPIN_CAP) { atomicAdd(&(bar)[XB_TMO], 1u); break; } } } } while (0)

struct XcdBarrier { unsigned* bar; unsigned x; volatile LAS unsigned* st; };

__device__ __forceinline__ XcdBarrier xcd_barrier_post(unsigned* bar, volatile LAS unsigned* st) {
    XcdBarrier b; b.bar = bar; b.x = xb_xcc_id(); b.st = st;
    if (threadIdx.x == 0) (void)xb_add(&bar[XB_XCNT(b.x)], 1u);
    return b;
}
__device__ __forceinline__ void xcd_barrier_complete(unsigned* bar, unsigned x, unsigned& nloc, unsigned& nx) {
    const unsigned G = gridDim.x * gridDim.y * gridDim.z;
    unsigned sum, cnt, mine, sp = 0u;
    for (;;) {
        sum = 0u; cnt = 0u; mine = 0u;
#pragma unroll
        for (unsigned j = 0; j < 16; ++j) { const unsigned c = xb_ld(&bar[XB_XCNT(j)]); sum += c; cnt += (c > 0u) ? 1u : 0u; mine = (j == x) ? c : mine; }
        if (sum == G) break;
        __builtin_amdgcn_s_sleep(1);
        if ((++sp & 255u) == 0u) { if (xb_ld(&bar[XB_TMO])) break; if (sp > XB_SPIN_CAP) { atomicAdd(&bar[XB_TMO], 1u); break; } }
    }
    nloc = mine > 0u ? mine : 1u; nx = cnt > 0u ? cnt : 1u;
}
__device__ __forceinline__ void xcd_barrier(const XcdBarrier& b) {
    asm volatile("s_waitcnt vmcnt(0)" ::: "memory");
    __syncthreads();
    if (threadIdx.x == 0) {
        unsigned* bar = b.bar;
        __builtin_amdgcn_s_waitcnt(0);
        unsigned nloc = b.st[0], nx = b.st[1];
        if (nloc == 0u) { xcd_barrier_complete(bar, b.x, nloc, nx); b.st[0] = nloc; b.st[1] = nx; }
        const unsigned old = xb_add(&bar[XB_XSUB(b.x)], 1u);
        const unsigned gen = old / nloc;
        if (old + 1u == (gen + 1u) * nloc) {
            __builtin_amdgcn_fence(__ATOMIC_RELEASE, "agent");
            asm volatile("s_waitcnt vmcnt(0)" ::: "memory");
            const unsigned og = xb_add(&bar[XB_TOP], 1u);
            const unsigned tg = og / nx;
            if (og + 1u == (tg + 1u) * nx) xb_add(&bar[XB_TOPGEN], 1u);
            else XB_SPIN(xb_ld(&bar[XB_TOPGEN]) == tg, bar);
            __builtin_amdgcn_fence(__ATOMIC_ACQUIRE, "agent");
            xb_add(&bar[XB_XGEN(b.x)], 1u);
            asm volatile("s_waitcnt vmcnt(0)" ::: "memory");
        } else {
            XB_SPIN(xb_ld(&bar[XB_XGEN(b.x)]) == gen, bar);
            __builtin_amdgcn_fence(__ATOMIC_ACQUIRE, "agent");
            asm volatile("s_waitcnt vmcnt(0)" ::: "memory");
        }
    }
    __syncthreads();
}

namespace pg8 {
constexpr int BM = 256, BK = 64, HALF = 128, HTB = HALF * BK * 2, STAGE_BYTES = 8 * HTB, NXCD = 8, WGM = 8;
__host__ __device__ __forceinline__ int lds_byte(int r, int c) { const int st = (r >> 4) * 2 + (c >> 5), rr = r & 15, cc = c & 31, ob = rr * 64 + cc * 2; return st * 1024 + (ob ^ (((ob >> 9) & 1) << 5)); }
__host__ __device__ __forceinline__ void stage_rc(int b, int& R, int& C) { const int st = b / 1024, sb = b % 1024, swz = sb ^ (((sb >> 9) & 1) << 5); R = (st >> 1) * 16 + swz / 64; C = (st & 1) * 32 + (swz % 64) / 2; }
__host__ __device__ __forceinline__ int perm32(int rho) { const int n = rho >> 4, i = rho & 15; return 8 * (i >> 2) + 4 * n + (i & 3); }

struct Unit { int pm, pn, e; };
struct Gemm { const bf16_t* A; const bf16_t* Bt; int K; size_t estride; };

struct StaticOrder {
    int nM, nN, nwg, G, c, i;
    __device__ void init(int M, int N, int G_, int c_) { nM = M / BM; nN = N / BM; nwg = nM * nN; G = G_; c = c_; i = 0; }
    __device__ bool next(Unit& u) {
        const long L = (long)i * G + c; ++i; if (L >= nwg) return false;
        int wgid = (int)L; { const int q = nwg / NXCD, r = nwg % NXCD, xcd = wgid % NXCD, off = wgid / NXCD; wgid = (xcd < r ? xcd * (q + 1) : r * (q + 1) + (xcd - r) * q) + off; }
        const int nig = WGM * nN, gid = wgid / nig, fm = gid * WGM, gsz = (nM - fm) < WGM ? (nM - fm) : WGM;
        u.pm = fm + ((wgid % nig) % gsz); u.pn = (wgid % nig) / gsz; u.e = 0; return true;
    }
};
struct MoeOrder {
    int nPanels, nN, G, c, i; const LAS int* panel_e;
    __device__ void init(int nPanels_, int nN_, int G_, int c_, const LAS int* pe) { nPanels = nPanels_; nN = nN_; G = G_; c = c_; i = 0; panel_e = pe; }
    __device__ bool next(Unit& u) {
        const int PB = 256 / nN;
        const int nblk = (nPanels + PB - 1) / PB;
        for (;;) {
            const long L = (long)i * G + c; ++i;
            const int blk = (int)(L >> 8), r = (int)(L & 255), x = r & 7, j = r >> 3;
            if (blk >= nblk) return false;
            int pm, pn;
            if (nN == 16) { pm = blk * 16 + 4 * (x >> 1) + (j & 3); pn = 8 * (x & 1) + (j >> 2); }
            else          { pm = blk * 32 + 4 * x + (j & 3);        pn = j >> 2; }
            if (pm < nPanels) { u.pm = pm; u.pn = pn; u.e = panel_e[pm]; return true; }
        }
    }
};

template <class Epi, class Sched>
__device__ __forceinline__ void gemm_phase(LAS unsigned char* lds, const Gemm g, Sched& S, const Epi& E) {
    const int tid = threadIdx.x, wid = __builtin_amdgcn_readfirstlane(tid >> 6), lane = tid & 63, wr = wid >> 2, wc = wid & 3, fr = lane & 15, fq = lane >> 4;
    const int K = g.K, nt = K / BK;
    unsigned voffA[2], voffB[2];
#pragma unroll
    for (int i = 0; i < 2; ++i) { int R, C; stage_rc(tid * 16 + i * 8192, R, C); const int Rb = Epi::PERM ? ((R & ~31) + perm32(R & 31)) : R;
        voffA[i] = (unsigned)(R * K + C) * 2u; voffB[i] = (unsigned)(Rb * K + C) * 2u; }
    const size_t kstep = (size_t)(BK * 2);
    const size_t hstep = (size_t)HALF * K * 2;
    const size_t tstep = 2 * hstep;
    const unsigned ldsw = (unsigned)wid * 1024u;
    const int aoff = lds_byte(wr * 64 + fr, fq * 8), boff = lds_byte(wc * 32 + fr, fq * 8);
#define PG8_SA(b, h) (((b) * 2 + (h)) * HTB)
#define PG8_SB(b, h) ((4 + (b) * 2 + (h)) * HTB)
#define PG8_STAGE(bufoff, gbase, voff) do { _Pragma("unroll") for (int _i = 0; _i < 2; ++_i) \
        __builtin_amdgcn_global_load_lds((const unsigned*)((const char*)(gbase) + (voff)[_i]), (LAS unsigned*)(lds + (bufoff) + ldsw + _i * 8192), 16, 0, 0); } while (0)
#define PG8_LDA(dst, b, h) do { _Pragma("unroll") for (int m = 0; m < 4; ++m) _Pragma("unroll") for (int k = 0; k < 2; ++k) dst[m][k] = *(const LAS bf16x8*)(lds + PG8_SA(b, h) + aoff + m * 2048 + k * 1024); } while (0)
#define PG8_LDB(dst, b, h) do { _Pragma("unroll") for (int n = 0; n < 2; ++n) _Pragma("unroll") for (int k = 0; k < 2; ++k) dst[n][k] = *(const LAS bf16x8*)(lds + PG8_SB(b, h) + boff + n * 2048 + k * 1024); } while (0)
#define PG8_MMA(ai, bj, At, Bt) do { __builtin_amdgcn_s_setprio(1); _Pragma("unroll") for (int m = 0; m < 4; ++m) _Pragma("unroll") for (int n = 0; n < 2; ++n) _Pragma("unroll") for (int k = 0; k < 2; ++k) \
        acc[ai][bj][m][n] = __builtin_amdgcn_mfma_f32_16x16x32_bf16(Bt[n][k], At[m][k], acc[ai][bj][m][n], 0, 0, 0); __builtin_amdgcn_s_setprio(0); } while (0)
#define PG8_WAIT_V(n) asm volatile("s_waitcnt vmcnt(" #n ")" ::: "memory")
#define PG8_WAIT_L(n) asm volatile("s_waitcnt lgkmcnt(" #n ")" ::: "memory")
#define PG8_BAR __builtin_amdgcn_s_barrier()
#define PG8_SCHED __builtin_amdgcn_sched_barrier(0)
    Unit cur, nxt;
    if (!S.next(cur)) return;
    f32x4 acc[2][2][4][2];
#pragma unroll
    for (int a = 0; a < 2; ++a)
#pragma unroll
        for (int b = 0; b < 2; ++b)
#pragma unroll
            for (int m = 0; m < 4; ++m)
#pragma unroll
                for (int n = 0; n < 2; ++n) acc[a][b][m][n] = (f32x4){0.f, 0.f, 0.f, 0.f};
    bf16x8 At[4][2], B0[2][2], B1[2][2];
    const char* cA = (const char*)g.A + (size_t)cur.pm * tstep; const char* cB = (const char*)g.Bt + (size_t)cur.e * g.estride + (size_t)cur.pn * tstep;
    PG8_STAGE(PG8_SB(0, 0), cB, voffB); PG8_STAGE(PG8_SB(0, 1), cB + hstep, voffB); PG8_STAGE(PG8_SA(0, 0), cA, voffA); PG8_STAGE(PG8_SA(0, 1), cA + hstep, voffA);
    if (wr == 1) PG8_BAR;
    PG8_WAIT_V(2); PG8_BAR;
    PG8_STAGE(PG8_SB(1, 0), cB + kstep, voffB); PG8_STAGE(PG8_SA(1, 0), cA + kstep, voffA); PG8_STAGE(PG8_SB(1, 1), cB + hstep + kstep, voffB);
    PG8_WAIT_V(6); PG8_BAR;
    for (;;) {
        const bool has_next = S.next(nxt);
        const char* nA = has_next ? (const char*)g.A + (size_t)nxt.pm * tstep : cA;
        const char* nB = has_next ? (const char*)g.Bt + (size_t)nxt.e * g.estride + (size_t)nxt.pn * tstep : cB;
        for (int t = 0; t < nt; t += 2) {
            const bool last = (t == nt - 2);
            const char* a1 = cA + (size_t)(t + 1) * kstep;
            const char* a2 = last ? nA : cA + (size_t)(t + 2) * kstep; const char* b2 = last ? nB : cB + (size_t)(t + 2) * kstep;
            const char* a3 = a2 + kstep; const char* b3 = b2 + kstep;
            PG8_LDB(B0, 0, 0); PG8_LDB(B1, 0, 1); PG8_SCHED; PG8_LDA(At, 0, 0); PG8_STAGE(PG8_SA(1, 1), a1 + hstep, voffA);
            PG8_WAIT_V(8); PG8_WAIT_L(0); PG8_BAR; PG8_MMA(0, 0, At, B0); PG8_MMA(0, 1, At, B1); PG8_BAR; PG8_SCHED;
            PG8_LDA(At, 0, 1); PG8_STAGE(PG8_SB(0, 0), b2, voffB); PG8_STAGE(PG8_SB(0, 1), b2 + hstep, voffB); PG8_STAGE(PG8_SA(0, 0), a2, voffA);
            PG8_WAIT_V(8); PG8_WAIT_L(0); PG8_BAR; PG8_MMA(1, 0, At, B0); PG8_MMA(1, 1, At, B1); PG8_BAR; PG8_SCHED;
            PG8_LDB(B0, 1, 0); PG8_LDB(B1, 1, 1); PG8_SCHED; PG8_LDA(At, 1, 0); PG8_STAGE(PG8_SA(0, 1), a2 + hstep, voffA);
            PG8_WAIT_V(8); PG8_WAIT_L(0); PG8_BAR; PG8_MMA(0, 0, At, B0); PG8_MMA(0, 1, At, B1); PG8_BAR; PG8_SCHED;
            PG8_LDA(At, 1, 1); PG8_STAGE(PG8_SB(1, 0), b3, voffB); PG8_STAGE(PG8_SB(1, 1), b3 + hstep, voffB); PG8_STAGE(PG8_SA(1, 0), a3, voffA);
            PG8_WAIT_V(8); PG8_WAIT_L(0); PG8_BAR; PG8_MMA(1, 0, At, B0); PG8_MMA(1, 1, At, B1); PG8_BAR; PG8_SCHED;
        }
        if (wr == 0) PG8_BAR;
        E(acc, cur, wr, wc, fr, fq);
        if (!has_next) break;
#pragma unroll
        for (int a = 0; a < 2; ++a)
#pragma unroll
            for (int b = 0; b < 2; ++b)
#pragma unroll
                for (int m = 0; m < 4; ++m)
#pragma unroll
                    for (int n = 0; n < 2; ++n) acc[a][b][m][n] = (f32x4){0.f, 0.f, 0.f, 0.f};
        cur = nxt; cA = nA; cB = nB;
        if (wr == 1) PG8_BAR;
    }
    PG8_WAIT_V(0);
    PG8_BAR;
#undef PG8_SA
#undef PG8_SB
#undef PG8_STAGE
#undef PG8_LDA
#undef PG8_LDB
#undef PG8_MMA
#undef PG8_WAIT_V
#undef PG8_WAIT_L
#undef PG8_BAR
#undef PG8_SCHED
}

struct EpiBf16 {
    static constexpr bool PERM = true;
    bf16_t* O; int ldc; const float* bias; int bias_estride;
    __device__ __forceinline__ void operator()(const f32x4 (&acc)[2][2][4][2], const Unit& u, int wr, int wc, int fr, int fq) const {
        const int row0 = u.pm * BM + wr * 64 + fr; const int col0 = u.pn * BM + wc * 32 + 8 * fq;
        f32x4 bv[2][2];
#pragma unroll
        for (int bj = 0; bj < 2; ++bj)
#pragma unroll
            for (int n = 0; n < 2; ++n) bv[bj][n] = bias ? *(const f32x4*)(bias + (size_t)u.e * bias_estride + col0 + bj * HALF + 4 * n) : (f32x4){0.f, 0.f, 0.f, 0.f};
#pragma unroll
        for (int ai = 0; ai < 2; ++ai)
#pragma unroll
            for (int m = 0; m < 4; ++m) { bf16_t* rowp = O + (size_t)(row0 + ai * HALF + m * 16) * ldc + col0;
#pragma unroll
                for (int bj = 0; bj < 2; ++bj) { const f32x4 v0 = acc[ai][bj][m][0] + bv[bj][0], v1 = acc[ai][bj][m][1] + bv[bj][1];
                    u32x4 w; w.x = cvt_pk_bf16(v0[0], v0[1]); w.y = cvt_pk_bf16(v0[2], v0[3]); w.z = cvt_pk_bf16(v1[0], v1[1]); w.w = cvt_pk_bf16(v1[2], v1[3]);
                    *(u32x4*)(rowp + bj * HALF) = w; } }
    }
};
__device__ __forceinline__ float swiglu1(float ug, float ul) {
    ug = fminf(ug, 7.0f); ul = fminf(fmaxf(ul, -7.0f), 7.0f);
    return ug * (1.0f / (1.0f + __expf(-1.702f * ug))) * (ul + 1.0f);
}
struct EpiSwiglu {
    static constexpr bool PERM = true;
    bf16_t* O; const float* b1;
    __device__ __forceinline__ void operator()(const f32x4 (&acc)[2][2][4][2], const Unit& u, int wr, int wc, int fr, int fq) const {
        const int row0 = u.pm * BM + wr * 64 + fr; const int c0 = u.pn * 128 + wc * 32 + 8 * fq;
        const float* bg = b1 + (size_t)u.e * 4096 + c0; const float* bl = bg + 2048;
        f32x4 bgv[2], blv[2];
#pragma unroll
        for (int n = 0; n < 2; ++n) { bgv[n] = *(const f32x4*)(bg + 4 * n); blv[n] = *(const f32x4*)(bl + 4 * n); }
#pragma unroll
        for (int ai = 0; ai < 2; ++ai)
#pragma unroll
            for (int m = 0; m < 4; ++m) {
                float a[8];
#pragma unroll
                for (int n = 0; n < 2; ++n)
#pragma unroll
                    for (int j = 0; j < 4; ++j) a[4 * n + j] = swiglu1(acc[ai][0][m][n][j] + bgv[n][j], acc[ai][1][m][n][j] + blv[n][j]);
                u32x4 w; w.x = cvt_pk_bf16(a[0], a[1]); w.y = cvt_pk_bf16(a[2], a[3]); w.z = cvt_pk_bf16(a[4], a[5]); w.w = cvt_pk_bf16(a[6], a[7]);
                *(u32x4*)(O + (size_t)(row0 + ai * HALF + m * 16) * 2048 + c0) = w;
            }
    }
};

struct EpiGate {
    static constexpr bool PERM = true;
    bf16_t* O; const bf16_t* Gt; int accum;
    __device__ __forceinline__ void operator()(const f32x4 (&acc)[2][2][4][2], const Unit& u, int wr, int wc, int fr, int fq) const {
        const int row0 = u.pm * BM + wr * 64 + fr; const int col0 = u.pn * BM + wc * 32 + 8 * fq;
#pragma unroll
        for (int ai = 0; ai < 2; ++ai)
#pragma unroll
            for (int m = 0; m < 4; ++m) { const size_t row = (size_t)(row0 + ai * HALF + m * 16);
#pragma unroll
                for (int bj = 0; bj < 2; ++bj) { const int c = col0 + bj * HALF;
                    const u32x4 gw = *(const u32x4*)(Gt + row * DINP + c);
                    float r[8];
#pragma unroll
                    for (int q = 0; q < 4; ++q) { r[2 * q] = sigmoidf_(bf_lo(gw[q])) * acc[ai][bj][m][q >> 1][(2 * q) & 3]; r[2 * q + 1] = sigmoidf_(bf_hi(gw[q])) * acc[ai][bj][m][q >> 1][(2 * q + 1) & 3]; }
                    bf16_t* op = O + row * 2048 + c;
                    if (accum) { const u32x4 ow = *(const u32x4*)op;
#pragma unroll
                        for (int q = 0; q < 4; ++q) { r[2 * q] += bf_lo(ow[q]); r[2 * q + 1] += bf_hi(ow[q]); } }
                    u32x4 w; w.x = cvt_pk_bf16(r[0], r[1]); w.y = cvt_pk_bf16(r[2], r[3]); w.z = cvt_pk_bf16(r[4], r[5]); w.w = cvt_pk_bf16(r[6], r[7]);
                    *(u32x4*)op = w; } }
    }
};
struct EpiResid {
    static constexpr bool PERM = false;
    const float* x; const float* gt; float* X1;
    __device__ __forceinline__ void operator()(const f32x4 (&acc)[2][2][4][2], const Unit& u, int wr, int wc, int fr, int fq) const {
        const int row0 = u.pm * BM + wr * 64 + fr; const int col0 = u.pn * BM + wc * 32 + 4 * fq;
#pragma unroll
        for (int ai = 0; ai < 2; ++ai)
#pragma unroll
            for (int m = 0; m < 4; ++m) { const size_t row = (size_t)(row0 + ai * HALF + m * 16);
#pragma unroll
                for (int bj = 0; bj < 2; ++bj)
#pragma unroll
                    for (int n = 0; n < 2; ++n) { const int c = col0 + bj * HALF + n * 16;
                        const f32x4 xv = *(const f32x4*)(x + row * 2048 + c), g = *(const f32x4*)(gt + c);
                        *(f32x4*)(X1 + row * 2048 + c) = xv + g * acc[ai][bj][m][n]; } }
    }
};
}

#ifndef MK_REP
#define MK_REP 0
#endif
struct Args { const void* in[22]; float* out; unsigned char* ws; int ph_lo, ph_hi, flags, pad; };
enum { PH_PRO = 0, PH_H, PH_INPROJ, PH_POST, PH_SCORE, PH_SELECT, PH_ATTN, PH_OP1, PH_OP2, PH_WOUT, PH_ROUTER, PH_SCATTER, PH_MOE1, PH_MOE2, PH_FINAL, NPH };
constexpr int FLAG_MIXER = 1, FLAG_ATT = 2, FLAG_MOE = 4;

__device__ __forceinline__ int dest_row(int mode, int n) {
    if (mode == 1) return n < 2640 ? n : n + 176;
    if (mode == 2) { const int g = n >> 11, c = n & 2047; return (c >> 7) * 256 + g * 128 + (c & 127); }
    return n;
}
__device__ __forceinline__ void convert_item(const float* __restrict__ W, int K, int N, bf16_t* WT, int mode, int item, int lane, LAS unsigned char* scr) {
    const int nblk = (N + 63) >> 6; const int kb = item / nblk, nb = item - kb * nblk; const int k0 = kb * 128, n0 = nb * 64;
    const int c4 = lane & 15, kr = lane >> 4;
    const bool ok = (n0 + 4 * c4) < N;
    const float* src = W + (size_t)(k0 + 2 * kr) * N + n0 + 4 * c4;
#pragma unroll 4
    for (int i = 0; i < 16; ++i) {
        f32x4 v0 = (f32x4){0.f, 0.f, 0.f, 0.f}, v1 = v0;
        if (ok) { v0 = *(const f32x4*)(src + (size_t)(8 * i) * N); v1 = *(const f32x4*)(src + (size_t)(8 * i + 1) * N); }
        const int kk = 8 * i + 2 * kr;
#pragma unroll
        for (int e = 0; e < 4; ++e) *(LAS unsigned*)(scr + (4 * c4 + e) * 272 + kk * 2) = cvt_pk_bf16(v0[e], v1[e]);
    }
    LDS_WAIT(); asm volatile("" ::: "memory");
#pragma unroll 4
    for (int j = 0; j < 16; ++j) {
        const int q = j * 64 + lane, n = q >> 4, ch = q & 15;
        const u32x4 v = *(const LAS u32x4*)(scr + n * 272 + ch * 16);
        if (n0 + n < N) *(u32x4*)(WT + (size_t)dest_row(mode, n0 + n) * K + k0 + ch * 8) = v;
    }
    LDS_WAIT(); asm volatile("" ::: "memory");
}


__device__ __forceinline__ bf16_t f2bf(float f) { unsigned u = __float_as_uint(f); return (bf16_t)((u + 0x7fffu + ((u >> 16) & 1u)) >> 16); }
__device__ __forceinline__ float bfx(const u32x4& w, int i) { const unsigned u = w[i >> 1]; return (i & 1) ? bf_hi(u) : bf_lo(u); }
__device__ __forceinline__ void rope_sc(float pos, float inv, float& sn, float& cs) {
    const float ang = pos * inv;
    const double a = (double)ang; const double n = __builtin_rint(a * 0.15915494309189535); const float r = (float)(a - n * 6.283185307179586);
    sn = sinf(r); cs = cosf(r);
}
__device__ __forceinline__ void post_token(bf16_t* PROJ, bf16_t* KI, bf16_t* KC, bf16_t* VC, const int* positions, const float* kng, const float* knb, int t, int lane) {
    const float pos = (float)positions[t];
    bf16_t* row = PROJ + (size_t)t * DINP;
    float sn, cs;
#pragma unroll
    for (int i = 0; i < 2; ++i) {
        const int pp = lane + 64 * i, hd = pp >> 4, ii = pp & 15;
        rope_sc(pos, powf(500000.0f, -(float)ii * (1.0f / 16.0f)), sn, cs);
        bf16_t* p = row + CQ + hd * 128 + ii; const float a = bf2f(p[0]), b = bf2f(p[16]);
        p[0] = f2bf(a * cs - b * sn); p[16] = f2bf(b * cs + a * sn);
    }
#pragma unroll
    for (int i = 0; i < 2; ++i) {
        const int pp = lane + 64 * i, hd = pp >> 3, ii = pp & 7;
        rope_sc(pos, powf(500000.0f, -(float)ii * (1.0f / 8.0f)), sn, cs);
        bf16_t* p = row + CQI + hd * 64 + ii; const float a = bf2f(p[0]), b = bf2f(p[8]);
        p[0] = f2bf(a * cs - b * sn); p[8] = f2bf(b * cs + a * sn);
    }
    if (lane < 32) {
        const int g = lane >> 4, ii = lane & 15;
        rope_sc(pos, powf(500000.0f, -(float)ii * (1.0f / 16.0f)), sn, cs);
        const bf16_t* p = row + CK + g * 128 + ii; const float a = bf2f(p[0]), b = bf2f(p[16]);
        bf16_t* o = KC + (size_t)t * 256 + g * 128 + ii; o[0] = f2bf(a * cs - b * sn); o[16] = f2bf(b * cs + a * sn);
    }
#pragma unroll
    for (int i = 0; i < 3; ++i) { const int idx = lane + 64 * i, g = idx / 96, r = idx - g * 96; KC[(size_t)t * 256 + g * 128 + 32 + r] = row[CK + g * 128 + 32 + r]; }
    *(u32x2*)(VC + (size_t)t * 256 + 4 * lane) = *(const u32x2*)(row + CV + 4 * lane);
    {
        const float v = bf2f(row[CKI + lane]);
        const float mean = wave_sum(v) * (1.0f / 64.0f); const float d = v - mean; const float var = wave_sum(d * d) * (1.0f / 64.0f);
        const float y = d * rsqrtf(var + NORM_EPS) * kng[lane] + knb[lane];
        const float other = __shfl_xor(y, 8);
        rope_sc(pos, powf(500000.0f, -(float)(lane & 7) * (1.0f / 8.0f)), sn, cs);
        float o = y;
        if (lane < 8) o = y * cs - other * sn; else if (lane < 16) o = y * cs + other * sn;
        KI[(size_t)t * 64 + lane] = f2bf(o);
    }
}

constexpr int HG_GB = 0, HG_Q1 = 33792, HG_Q2 = 51200, HG_K2 = 68608, HG_VT = 86016, HG_PB = 104448, HG_LB = 113664;
__device__ __forceinline__ void hgrn_cumsum(LAS unsigned char* lds, const bf16_t* PROJ, const float* lb_logits, int c, int h, int tid) {
    LAS float* GB = (LAS float*)(lds + HG_GB); LAS float* LB = (LAS float*)(lds + HG_LB);
    if (tid < 128) { const float l0 = lb_logits[h * 128 + tid], l1 = lb_logits[1024 + h * 128 + tid]; LB[tid] = 1.0f / (1.0f + expf(l1 - l0)); }
    __syncthreads();
    const int t = tid >> 3, dseg = tid & 7;
    const bf16_t* p = PROJ + (size_t)(c * 64 + t) * DINP + CHF + h * 128 + 16 * dseg;
    const u32x4 w0 = *(const u32x4*)p, w1 = *(const u32x4*)(p + 8);
#pragma unroll
    for (int i = 0; i < 16; ++i) { const float z = i < 8 ? bfx(w0, i) : bfx(w1, i - 8); const float lb = LB[16 * dseg + i]; GB[t * 128 + 16 * dseg + i] = logf(lb + (1.0f - lb) * sigmoidf_(z)); }
    __syncthreads();
    if (tid < 128) { float a = 0.f;
#pragma unroll 8
        for (int tt = 0; tt < 64; ++tt) { a += GB[tt * 128 + tid]; GB[tt * 128 + tid] = a; } }
    __syncthreads();
}
__device__ __forceinline__ void hgrn_vt(LAS unsigned char* lds, const bf16_t* PROJ, int c, int h, int tid) {
    const int s2 = tid & 31, eg = tid >> 5;
    const bf16_t* p = PROJ + (size_t)(c * 64 + 2 * s2) * DINP + CHI + h * 128 + 8 * eg;
    const u32x4 a = *(const u32x4*)p, b = *(const u32x4*)(p + DINP);
#pragma unroll
    for (int i = 0; i < 8; ++i) { const unsigned lo = (i & 1) ? (a[i >> 1] >> 16) : (a[i >> 1] & 0xffffu), hi = (i & 1) ? (b[i >> 1] >> 16) : (b[i >> 1] & 0xffffu);
        *(LAS unsigned*)(lds + HG_VT + (8 * eg + i) * 144 + s2 * 4) = lo | (hi << 16); }
}
__device__ __forceinline__ void hgrn_l1(LAS unsigned char* lds, const bf16_t* PROJ, const float* lb_logits, float* ST, float* DC, int c, int h, int tid, int wave, int lane) {
    hgrn_cumsum(lds, PROJ, lb_logits, c, h, tid);
    const LAS float* GB = (const LAS float*)(lds + HG_GB); const LAS float* LB = (const LAS float*)(lds + HG_LB);
    {
        const int s2 = tid & 31, dg = tid >> 5;
        const bf16_t* p = PROJ + (size_t)(c * 64 + 2 * s2) * DINP + CHF + h * 128 + 8 * dg;
        const u32x4 a = *(const u32x4*)p, b = *(const u32x4*)(p + DINP);
#pragma unroll
        for (int i = 0; i < 8; ++i) { const int d = 8 * dg + i; const float lb = LB[d], b63 = GB[63 * 128 + d];
            const float k0 = (1.0f - lb) * (1.0f - sigmoidf_(bfx(a, i))), k1 = (1.0f - lb) * (1.0f - sigmoidf_(bfx(b, i)));
            const float v0 = k0 * __expf(b63 - GB[(2 * s2) * 128 + d]), v1 = k1 * __expf(b63 - GB[(2 * s2 + 1) * 128 + d]);
            *(LAS unsigned*)(lds + HG_Q1 + d * 144 + s2 * 4) = cvt_pk_bf16(v0, v1); }
    }
    hgrn_vt(lds, PROJ, c, h, tid);
    __syncthreads();
    const int fr = lane & 15, fq = lane >> 4;
    bf16x8 af[2];
#pragma unroll
    for (int ks = 0; ks < 2; ++ks) af[ks] = *(const LAS bf16x8*)(lds + HG_VT + (16 * wave + fr) * 144 + (32 * ks + 8 * fq) * 2);
    float* dst = ST + ((size_t)(c * 8 + h) * 128) * 128;
#pragma unroll 2
    for (int dt = 0; dt < 8; ++dt) {
        f32x4 acc = (f32x4){0.f, 0.f, 0.f, 0.f};
#pragma unroll
        for (int ks = 0; ks < 2; ++ks) { const bf16x8 bfr = *(const LAS bf16x8*)(lds + HG_Q1 + (16 * dt + fr) * 144 + (32 * ks + 8 * fq) * 2); acc = __builtin_amdgcn_mfma_f32_16x16x32_bf16(af[ks], bfr, acc, 0, 0, 0); }
#pragma unroll
        for (int r = 0; r < 4; ++r) dst[(size_t)(16 * wave + 4 * fq + r) * 128 + 16 * dt + fr] = acc[r];
    }
    if (tid < 128) DC[(size_t)(c * 8 + h) * 128 + tid] = __expf(GB[63 * 128 + tid]);
    __syncthreads();
}
__device__ __forceinline__ void hgrn_l3(LAS unsigned char* lds, const bf16_t* PROJ, const float* lb_logits, const float* ST, const float* norm_g, bf16_t* REC, int c, int h, int tid, int wave, int lane) {
    hgrn_cumsum(lds, PROJ, lb_logits, c, h, tid);
    const LAS float* GB = (const LAS float*)(lds + HG_GB); const LAS float* LB = (const LAS float*)(lds + HG_LB);
    {
        const int t = tid >> 3, dseg = tid & 7;
        const bf16_t* pf = PROJ + (size_t)(c * 64 + t) * DINP + CHF + h * 128 + 16 * dseg; const bf16_t* pq = pf - CHF + CHQ;
        const u32x4 f0 = *(const u32x4*)pf, f1 = *(const u32x4*)(pf + 8), q0 = *(const u32x4*)pq, q1 = *(const u32x4*)(pq + 8);
        unsigned o1[8], o2[8], o3[8];
#pragma unroll
        for (int i = 0; i < 16; i += 2) {
            float a1[2], a2[2], a3[2];
#pragma unroll
            for (int j = 0; j < 2; ++j) { const int d = 16 * dseg + i + j; const float lb = LB[d], b = GB[t * 128 + d], br = GB[31 * 128 + d];
                const float z = (i + j) < 8 ? bfx(f0, i + j) : bfx(f1, i + j - 8), qv = (i + j) < 8 ? bfx(q0, i + j) : bfx(q1, i + j - 8);
                const float k = (1.0f - lb) * (1.0f - sigmoidf_(z)), q = siluf_(qv);
                a1[j] = q * __expf(b); a2[j] = q * __expf(b - br); a3[j] = k * __expf(br - b); }
            o1[i >> 1] = cvt_pk_bf16(a1[0], a1[1]); o2[i >> 1] = cvt_pk_bf16(a2[0], a2[1]); o3[i >> 1] = cvt_pk_bf16(a3[0], a3[1]);
        }
        LAS u32x4* d1 = (LAS u32x4*)(lds + HG_Q1 + t * 272 + dseg * 32); LAS u32x4* d2 = (LAS u32x4*)(lds + HG_Q2 + t * 272 + dseg * 32); LAS u32x4* d3 = (LAS u32x4*)(lds + HG_K2 + t * 272 + dseg * 32);
        d1[0] = (u32x4){o1[0], o1[1], o1[2], o1[3]}; d1[1] = (u32x4){o1[4], o1[5], o1[6], o1[7]};
        d2[0] = (u32x4){o2[0], o2[1], o2[2], o2[3]}; d2[1] = (u32x4){o2[4], o2[5], o2[6], o2[7]};
        d3[0] = (u32x4){o3[0], o3[1], o3[2], o3[3]}; d3[1] = (u32x4){o3[4], o3[5], o3[6], o3[7]};
    }
    hgrn_vt(lds, PROJ, c, h, tid);
    __syncthreads();
    const int fr = lane & 15, fq = lane >> 4;
#pragma unroll
    for (int q = 0; q < 2; ++q) {
        const int tile = 2 * wave + q, tt = tile >> 2, stl = tile & 3;
        f32x4 acc = (f32x4){0.f, 0.f, 0.f, 0.f};
#pragma unroll
        for (int ks = 0; ks < 4; ++ks) { const bf16x8 a = *(const LAS bf16x8*)(lds + HG_Q2 + (16 * tt + fr) * 272 + (32 * ks + 8 * fq) * 2), b = *(const LAS bf16x8*)(lds + HG_K2 + (16 * stl + fr) * 272 + (32 * ks + 8 * fq) * 2);
            acc = __builtin_amdgcn_mfma_f32_16x16x32_bf16(a, b, acc, 0, 0, 0); }
#pragma unroll
        for (int r = 0; r < 4; ++r) { const int t = 16 * tt + 4 * fq + r, s = 16 * stl + fr; *(LAS bf16_t*)(lds + HG_PB + t * 144 + s * 2) = f2bf(s <= t ? acc[r] : 0.f); }
    }
    __syncthreads();
    {
        bf16x8 b1[2], b2[4];
#pragma unroll
        for (int ks = 0; ks < 2; ++ks) b1[ks] = *(const LAS bf16x8*)(lds + HG_VT + (16 * wave + fr) * 144 + (32 * ks + 8 * fq) * 2);
        const float* sp = ST + ((size_t)(c * 8 + h) * 128 + 16 * wave + fr) * 128 + 8 * fq;
#pragma unroll
        for (int ks = 0; ks < 4; ++ks) { const f32x4 x0 = *(const f32x4*)(sp + 32 * ks), x1 = *(const f32x4*)(sp + 32 * ks + 4);
            u32x4 w; w.x = cvt_pk_bf16(x0[0], x0[1]); w.y = cvt_pk_bf16(x0[2], x0[3]); w.z = cvt_pk_bf16(x1[0], x1[1]); w.w = cvt_pk_bf16(x1[2], x1[3]); b2[ks] = __builtin_bit_cast(bf16x8, w); }
        LAS float* OB = (LAS float*)(lds + HG_GB);
#pragma unroll
        for (int tt = 0; tt < 4; ++tt) {
            f32x4 acc = (f32x4){0.f, 0.f, 0.f, 0.f};
#pragma unroll
            for (int ks = 0; ks < 2; ++ks) { const bf16x8 a = *(const LAS bf16x8*)(lds + HG_PB + (16 * tt + fr) * 144 + (32 * ks + 8 * fq) * 2); acc = __builtin_amdgcn_mfma_f32_16x16x32_bf16(a, b1[ks], acc, 0, 0, 0); }
#pragma unroll
            for (int ks = 0; ks < 4; ++ks) { const bf16x8 a = *(const LAS bf16x8*)(lds + HG_Q1 + (16 * tt + fr) * 272 + (32 * ks + 8 * fq) * 2); acc = __builtin_amdgcn_mfma_f32_16x16x32_bf16(a, b2[ks], acc, 0, 0, 0); }
#pragma unroll
            for (int r = 0; r < 4; ++r) OB[(16 * tt + 4 * fq + r) * 132 + 16 * wave + fr] = acc[r];
        }
    }
    __syncthreads();
    {
        const int t = tid >> 3, es = tid & 7; const LAS float* OB = (const LAS float*)(lds + HG_GB);
        float o[16]; float ss = 0.f;
#pragma unroll
        for (int i = 0; i < 16; ++i) { o[i] = OB[t * 132 + 16 * es + i]; ss += o[i] * o[i]; }
        ss += __shfl_xor(ss, 1); ss += __shfl_xor(ss, 2); ss += __shfl_xor(ss, 4);
        const float rstd = rsqrtf(ss * (1.0f / 128.0f) + NORM_EPS);
        const bf16_t* pg = PROJ + (size_t)(c * 64 + t) * DINP + CHG + h * 128 + 16 * es;
        const u32x4 g0 = *(const u32x4*)pg, g1 = *(const u32x4*)(pg + 8);
        unsigned w[8];
#pragma unroll
        for (int i = 0; i < 16; i += 2) { const float ga = i < 8 ? bfx(g0, i) : bfx(g1, i - 8), gb = (i + 1) < 8 ? bfx(g0, i + 1) : bfx(g1, i + 1 - 8);
            w[i >> 1] = cvt_pk_bf16(o[i] * rstd * norm_g[16 * es + i] * siluf_(ga), o[i + 1] * rstd * norm_g[16 * es + i + 1] * siluf_(gb)); }
        u32x4* dst = (u32x4*)(REC + (size_t)(c * 64 + t) * 1024 + h * 128 + 16 * es);
        dst[0] = (u32x4){w[0], w[1], w[2], w[3]}; dst[1] = (u32x4){w[4], w[5], w[6], w[7]};
    }
    __syncthreads();
}

__device__ __forceinline__ void score_block(LAS unsigned char* lds, const bf16_t* PROJ, const bf16_t* KI, float* SCORES, int qb, int tid, int wave, int lane) {
    const int t0 = qb * 32, nkt = (t0 >> 7) + 1;
    const int r = lane & 31, hh = lane >> 5;
    bf16x8 Af[2][4]; float wv[2][16];
#pragma unroll
    for (int p = 0; p < 2; ++p) {
        const int tq = t0 + 4 * wave + 2 * p + (r >> 4); const bf16_t* qrow = PROJ + (size_t)tq * DINP + CQI + (r & 15) * 64 + 8 * hh;
#pragma unroll
        for (int ks = 0; ks < 4; ++ks) Af[p][ks] = *(const bf16x8*)(qrow + 16 * ks);
#pragma unroll
        for (int reg = 0; reg < 16; ++reg) { const int row = (reg & 3) + 8 * (reg >> 2) + 4 * hh; const int tw = t0 + 4 * wave + 2 * p + (row >> 4);
            wv[p][reg] = bf2f(PROJ[(size_t)tw * DINP + CWI + (row & 15)]) * (1.0f / 32.0f); }
    }
    const u32x2 tagsw = __builtin_amdgcn_permlane32_swap(0u, 1u, false, false); const int qsel = (int)tagsw[0];
    u32x4 stg[2];
#pragma unroll
    for (int i = 0; i < 2; ++i) { const int q = tid + 512 * i; stg[i] = *(const u32x4*)(KI + (size_t)(q >> 3) * 64 + (q & 7) * 8); }
#pragma unroll
    for (int i = 0; i < 2; ++i) { const int q = tid + 512 * i; *(LAS u32x4*)(lds + (q >> 3) * 144 + (q & 7) * 16) = stg[i]; }
    __syncthreads();
    for (int kt = 0; kt < nkt; ++kt) {
        const LAS unsigned char* buf = lds + (kt & 1) * 18432;
        if (kt + 1 < nkt) {
#pragma unroll
            for (int i = 0; i < 2; ++i) { const int q = tid + 512 * i; stg[i] = *(const u32x4*)(KI + (size_t)((kt + 1) * 128 + (q >> 3)) * 64 + (q & 7) * 8); }
        }
#pragma unroll 1
        for (int cb = 0; cb < 4; ++cb) {
            bf16x8 Bf[4];
#pragma unroll
            for (int ks = 0; ks < 4; ++ks) Bf[ks] = *(const LAS bf16x8*)(buf + (32 * cb + r) * 144 + (16 * ks + 8 * hh) * 2);
#pragma unroll
            for (int p = 0; p < 2; ++p) {
                f32x16 acc;
#pragma unroll
                for (int i = 0; i < 16; ++i) acc[i] = 0.f;
#pragma unroll
                for (int ks = 0; ks < 4; ++ks) acc = __builtin_amdgcn_mfma_f32_32x32x16_bf16(Af[p][ks], Bf[ks], acc, 0, 0, 0);
                float p0 = 0.f, p1 = 0.f;
#pragma unroll
                for (int reg = 0; reg < 8; ++reg) { p0 += wv[p][reg] * fmaxf(acc[reg], 0.f); p1 += wv[p][reg + 8] * fmaxf(acc[reg + 8], 0.f); }
                const u32x2 sw = __builtin_amdgcn_permlane32_swap(__float_as_uint(p0), __float_as_uint(p1), false, false);
                const float mine = __uint_as_float(sw[0]) + __uint_as_float(sw[1]);
                const int tq = t0 + 4 * wave + 2 * p + qsel;
                SCORES[(size_t)tq * S + kt * 128 + 32 * cb + r] = mine;
            }
        }
        if (kt + 1 < nkt) {
#pragma unroll
            for (int i = 0; i < 2; ++i) { const int q = tid + 512 * i; *(LAS u32x4*)(lds + ((kt + 1) & 1) * 18432 + (q >> 3) * 144 + (q & 7) * 16) = stg[i]; }
        }
        __syncthreads();
    }
}

__device__ __forceinline__ float wave_kth16(const float (&v)[16], int K) {
    const float NINF = -__builtin_inff();
    float mx = NINF, mn = __builtin_inff();
#pragma unroll
    for (int j = 0; j < 16; ++j) { mx = fmaxf(mx, v[j]); mn = fminf(mn, v[j] == NINF ? __builtin_inff() : v[j]); }
    mx = wave_max(mx); mn = -wave_max(-mn);
    int c = 0;
#pragma unroll
    for (int j = 0; j < 16; ++j) c += __popcll(__ballot(v[j] >= mx));
    if (c >= K) return mx;
    float lo = mn, hi = mx, tau = mn;
    for (int it = 0; it < 64; ++it) {
        const float mid = 0.5f * (lo + hi);
        if (!(mid > lo && mid < hi)) { tau = lo; break; }
        c = 0;
#pragma unroll
        for (int j = 0; j < 16; ++j) c += __popcll(__ballot(v[j] >= mid));
        if (c == K) { tau = mid; break; }
        if (c > K) lo = mid; else hi = mid;
        tau = lo;
    }
    return tau;
}
__device__ __forceinline__ int lanes_below(unsigned long long mask) { return (int)__builtin_amdgcn_mbcnt_hi((unsigned)(mask >> 32), __builtin_amdgcn_mbcnt_lo((unsigned)mask, 0u)); }
__device__ __forceinline__ void select_row(LAS unsigned char* wl, const float* SCORES, int t, int lane) {
    LAS int* selw = (LAS int*)wl; LAS float* cval = (LAS float*)(wl + 1024); LAS int* cidx = (LAS int*)(wl + 5120);
    const float NINF = -__builtin_inff();
    const float* row = SCORES + (size_t)t * S; const int n = t + 1;
    float c[16]; int N;
    if (n <= 1024) {
#pragma unroll
        for (int j = 0; j < 16; ++j) { const int i = lane + 64 * j; c[j] = i < n ? row[i] : NINF; }
        N = -1;
    } else {
        const int m = n >> 4; float s[16];
#pragma unroll
        for (int j = 0; j < 16; ++j) { const int i = lane + 64 * j; s[j] = i < m ? row[16 * i + 7] : NINF; }
        int K = 32, cnt = 0;
        for (;;) {
            const float tlo = (K >= m) ? NINF : wave_kth16(s, K);
            cnt = 0;
            const int nq = (n + 255) >> 8;
            for (int q0 = 0; q0 < nq; q0 += 4) {
                f32x4 v[4];
#pragma unroll
                for (int u = 0; u < 4; ++u) { const int e = 4 * (lane + 64 * (q0 + u)); v[u] = (e <= t) ? *(const f32x4*)(row + e) : (f32x4){NINF, NINF, NINF, NINF}; }
#pragma unroll
                for (int u = 0; u < 4; ++u) { const int e = 4 * (lane + 64 * (q0 + u));
#pragma unroll
                    for (int k = 0; k < 4; ++k) { const bool pred = (e + k <= t) && (v[u][k] >= tlo); const unsigned long long mask = __ballot(pred);
                        if (mask) { const int pos = cnt + lanes_below(mask); if (pred && pos < 1024) { cval[pos] = v[u][k]; cidx[pos] = e + k; } cnt += __popcll(mask); } } }
            }
            if (cnt >= 256 || K >= m) break;
            K *= 2;
        }
        N = cnt < 1024 ? cnt : 1024;
#pragma unroll
        for (int j = 0; j < 16; ++j) { const int i = lane + 64 * j; c[j] = i < N ? cval[i] : NINF; }
    }
    const float tau = wave_kth16(c, 256);
    int base = 0;
#pragma unroll
    for (int j = 0; j < 16; ++j) { const bool pred = c[j] >= tau; const unsigned long long mask = __ballot(pred);
        if (mask) { const int pos = base + lanes_below(mask); if (pred && pos < 256) selw[pos] = (N < 0) ? (lane + 64 * j) : cidx[lane + 64 * j]; base += __popcll(mask); } }
}

__device__ __forceinline__ void attn_query(LAS unsigned char* wl, const bf16_t* PROJ, const bf16_t* KC, const bf16_t* VC, bf16_t* ATT, int t, int lane) {
    LAS int* selw = (LAS int*)wl; LAS float* L = (LAS float*)(wl + 1024);
    const int nsel = t < 255 ? t + 1 : 256;
    const int fr = lane & 15, fq = lane >> 4;
    bf16x8 qf[2][4];
#pragma unroll
    for (int g = 0; g < 2; ++g)
#pragma unroll
        for (int ks = 0; ks < 4; ++ks) { const bf16x8 z = {0, 0, 0, 0, 0, 0, 0, 0}; qf[g][ks] = fr < 4 ? *(const bf16x8*)(PROJ + (size_t)t * DINP + CQ + (4 * g + fr) * 128 + 32 * ks + 8 * fq) : z; }
    const float scale = 0.08838834764831845f;
    const int nkt = (nsel + 15) >> 4;
    for (int kt = 0; kt < 16; ++kt) {
        if (kt < nkt) {
            const int key = selw[16 * kt + fr]; const bf16_t* kp = KC + (size_t)key * 256 + 8 * fq;
            bf16x8 kf[2][4];
#pragma unroll
            for (int g = 0; g < 2; ++g)
#pragma unroll
                for (int ks = 0; ks < 4; ++ks) kf[g][ks] = *(const bf16x8*)(kp + g * 128 + 32 * ks);
#pragma unroll
            for (int g = 0; g < 2; ++g) { f32x4 acc = (f32x4){0.f, 0.f, 0.f, 0.f};
#pragma unroll
                for (int ks = 0; ks < 4; ++ks) acc = __builtin_amdgcn_mfma_f32_16x16x32_bf16(qf[g][ks], kf[g][ks], acc, 0, 0, 0);
                if (fq == 0) {
#pragma unroll
                    for (int r = 0; r < 4; ++r) L[(4 * g + r) * 256 + 16 * kt + fr] = (16 * kt + fr < nsel) ? acc[r] * scale : -__builtin_inff(); } }
        } else if (fq == 0) {
#pragma unroll
            for (int r = 0; r < 8; ++r) L[r * 256 + 16 * kt + fr] = -__builtin_inff();
        }
    }
    float p[8][4];
#pragma unroll
    for (int hd = 0; hd < 8; ++hd) { float m = -__builtin_inff();
#pragma unroll
        for (int i = 0; i < 4; ++i) { p[hd][i] = L[hd * 256 + lane + 64 * i]; m = fmaxf(m, p[hd][i]); }
        m = wave_max(m); float s = 0.f;
#pragma unroll
        for (int i = 0; i < 4; ++i) { p[hd][i] = __expf(p[hd][i] - m); s += p[hd][i]; }
        s = 1.0f / wave_sum(s);
#pragma unroll
        for (int i = 0; i < 4; ++i) p[hd][i] *= s; }
#pragma unroll
    for (int i = 0; i < 4; ++i)
#pragma unroll
        for (int g = 0; g < 2; ++g) *(LAS f32x4*)(L + ((g * 256 + lane + 64 * i) * 4)) = (f32x4){p[4 * g][i], p[4 * g + 1][i], p[4 * g + 2][i], p[4 * g + 3][i]};
    const int gl = lane >> 5;
    float o[4][4];
#pragma unroll
    for (int hh = 0; hh < 4; ++hh)
#pragma unroll
        for (int d = 0; d < 4; ++d) o[hh][d] = 0.f;
    const int kend = (nsel + 3) & ~3;
    for (int kk = 0; kk < kend; kk += 4) {
        const i32x4 k4 = *(const LAS i32x4*)(selw + kk); const int ks4[4] = {k4[0], k4[1], k4[2], k4[3]};
        u32x2 vw[4];
#pragma unroll
        for (int u = 0; u < 4; ++u) { const int key = __builtin_amdgcn_readfirstlane(ks4[u]); vw[u] = *(const u32x2*)(VC + (size_t)key * 256 + 4 * lane); }
#pragma unroll
        for (int u = 0; u < 4; ++u) { const f32x4 p4 = *(const LAS f32x4*)(L + (gl * 256 + kk + u) * 4);
            const float v0 = bf_lo(vw[u].x), v1 = bf_hi(vw[u].x), v2 = bf_lo(vw[u].y), v3 = bf_hi(vw[u].y);
#pragma unroll
            for (int hh = 0; hh < 4; ++hh) { o[hh][0] += p4[hh] * v0; o[hh][1] += p4[hh] * v1; o[hh][2] += p4[hh] * v2; o[hh][3] += p4[hh] * v3; } }
    }
#pragma unroll
    for (int hh = 0; hh < 4; ++hh) { u32x2 w; w.x = cvt_pk_bf16(o[hh][0], o[hh][1]); w.y = cvt_pk_bf16(o[hh][2], o[hh][3]);
        *(u32x2*)(ATT + (size_t)t * 1024 + (4 * gl + hh) * 128 + 4 * (lane & 31)) = w; }
}

__global__ void __launch_bounds__(NTHR, 2) fwd_kernel(Args args) {
    extern __shared__ __attribute__((aligned(16))) unsigned char lds_raw[];
    LAS unsigned char* lds = (LAS unsigned char*)lds_raw;
    volatile LAS unsigned* MISC = (volatile LAS unsigned*)(lds + LDS_MISC);
    const int tid = threadIdx.x, lane = tid & 63, wave = __builtin_amdgcn_readfirstlane(tid >> 6);
    const int G = gridDim.x, wg = blockIdx.x;
    unsigned char* ws = args.ws;
    unsigned* ctl = (unsigned*)(ws + WS_CTL);
    const int lo = args.ph_lo, hi = args.ph_hi, flags = args.flags;
    const float* x = (const float*)args.in[0]; const float* cvec = (const float*)args.in[1]; const int* positions = (const int*)args.in[2];
    const float* w_ada = (const float*)args.in[3]; const float* b_ada = (const float*)args.in[4]; const float* norm1_g = (const float*)args.in[5];
    const float* w_in = (const float*)args.in[6]; const float* idx_knorm_g = (const float*)args.in[7]; const float* idx_knorm_b = (const float*)args.in[8];
    const float* lb_logits = (const float*)args.in[9]; const float* hgrn_norm_g = (const float*)args.in[10];
    const float* w_proj_att = (const float*)args.in[11]; const float* w_proj_hgrn = (const float*)args.in[12]; const float* w_out = (const float*)args.in[13];
    const float* norm2_g = (const float*)args.in[14]; const float* w_router = (const float*)args.in[15]; const float* b_router = (const float*)args.in[16];
    const float* w1 = (const float*)args.in[17]; const float* b1 = (const float*)args.in[18]; const float* w2 = (const float*)args.in[19]; const float* b2 = (const float*)args.in[20];
    const float* final_g = (const float*)args.in[21];
    float* out = args.out;
    float* MOD = (float*)(ws + WS_MOD); int* TOPE = (int*)(ws + WS_TOPE); float* GATE = (float*)(ws + WS_GATE); int* SLOT = (int*)(ws + WS_SLOT);
    bf16_t* WIN_T = (bf16_t*)(ws + WS_WIN_T); bf16_t* WA_T = (bf16_t*)(ws + WS_WA_T); bf16_t* WH_T = (bf16_t*)(ws + WS_WH_T); bf16_t* WO_T = (bf16_t*)(ws + WS_WO_T);
    bf16_t* W1_T = (bf16_t*)(ws + WS_W1_T); bf16_t* W2_T = (bf16_t*)(ws + WS_W2_T);
    bf16_t* HB = (bf16_t*)(ws + WS_H); bf16_t* PROJ = (bf16_t*)(ws + WS_PROJ);
    float* X1 = (float*)(ws + WS_X1);
    bf16_t* XB = (bf16_t*)(ws + WS_XB); bf16_t* ACT = (bf16_t*)(ws + WS_ACT); bf16_t* YB = (bf16_t*)(ws + WS_YB);
    bf16_t* KI = (bf16_t*)(ws + WS_KI); bf16_t* KC = (bf16_t*)(ws + WS_KC); bf16_t* VC = (bf16_t*)(ws + WS_VC);
    float* ST = (float*)(ws + WS_ST); float* DC = (float*)(ws + WS_DC); int* SEL = (int*)(ws + WS_SEL);
    bf16_t* ATT = (bf16_t*)(ws + WS_ATT); bf16_t* REC = (bf16_t*)(ws + WS_REC); bf16_t* MERGED = (bf16_t*)(ws + WS_MERGED); float* SCORES = (float*)(ws + WS_SCORES);

    for (int u = tid; u < 128; u += NTHR) MISC[u] = 0u;
    __syncthreads();
    const bool one_launch = (hi - lo) > 1;
    XcdBarrier bar; bar.bar = ctl + CW_BAR; bar.x = 0; bar.st = MISC + 8;
    if (one_launch) bar = xcd_barrier_post(ctl + CW_BAR, MISC + 8);
#define IN(k) (lo <= (k) && (k) < hi)
#define NREP(k) ((((MK_REP) >> (k)) & 1) + 1)
#define SEAM(k) do { if (IN(k) && IN((k) + 1)) xcd_barrier(bar); } while (0)

    const float* x1src = (flags & FLAG_MIXER) ? (const float*)X1 : x;

    if (IN(PH_PRO)) {
        if (wg < 192) {
            LAS float* red = (LAS float*)lds;
            const int col = wg * 64 + lane; float acc = 0.f;
            for (int k = wave; k < D; k += 64) {
                float wv[8], cv[8];
#pragma unroll
                for (int i = 0; i < 8; ++i) { wv[i] = w_ada[(size_t)(k + 8 * i) * (6 * D) + col]; cv[i] = cvec[k + 8 * i]; }
#pragma unroll
                for (int i = 0; i < 8; ++i) acc += siluf_(cv[i]) * wv[i];
            }
            red[wave * 64 + lane] = acc;
            __syncthreads();
            if (tid < 64) { float s = b_ada[col]; for (int w = 0; w < 8; ++w) s += red[w * 64 + tid]; MOD[col] = s; }
            __syncthreads();
        }
        LAS unsigned char* scr = lds + wave * 17408;
        const int gw = wg * NWAVES + wave, NGW = G * NWAVES;
        for (int rep = 0; rep < NREP(PH_PRO); ++rep) {
        if (flags & FLAG_MIXER) {
            constexpr int NB_IN = (DIN + 63) / 64;
            for (int it = gw; it < 16 * NB_IN; it += NGW) convert_item(w_in, 2048, DIN, WIN_T, 1, it, lane, scr);
            for (int it = gw; it < 8 * 32; it += NGW) convert_item(w_proj_att, 1024, 2048, WA_T, 0, it, lane, scr);
            for (int it = gw; it < 8 * 32; it += NGW) convert_item(w_proj_hgrn, 1024, 2048, WH_T, 0, it, lane, scr);
            for (int it = gw; it < 16 * 32; it += NGW) convert_item(w_out, 2048, 2048, WO_T, 0, it, lane, scr);
            for (size_t i = (size_t)wg * NTHR + tid; i < (size_t)176 * 2048 * 2 / 16; i += (size_t)G * NTHR) ((u32x4*)(WIN_T + (size_t)2640 * 2048))[i] = (u32x4){0u, 0u, 0u, 0u};
        }
        if (flags & FLAG_MOE) {
            constexpr int I1 = (2048 / 128) * (4096 / 64), I2 = (2048 / 128) * (2048 / 64);
            for (int it = gw; it < NEXP * I1; it += NGW) { const int e = it / I1, r = it - e * I1; convert_item(w1 + (size_t)e * 2048 * 4096, 2048, 4096, W1_T + (size_t)e * 4096 * 2048, 2, r, lane, scr); }
            for (int it = gw; it < NEXP * I2; it += NGW) { const int e = it / I2, r = it - e * I2; convert_item(w2 + (size_t)e * 2048 * 2048, 2048, 2048, W2_T + (size_t)e * 2048 * 2048, 0, r, lane, scr); }
        }
        }
    }
    SEAM(PH_PRO);

    if (flags & FLAG_MIXER) {
    if (IN(PH_H)) {
        const float* sh1 = MOD; const float* sc1 = MOD + D;
        const int gw = wg * NWAVES + wave, NGW = G * NWAVES;
        f32x4 gs[8], sh[8];
#pragma unroll
        for (int j = 0; j < 8; ++j) { const int c = 4 * lane + 256 * j; const f32x4 g = *(const f32x4*)(norm1_g + c), sc = *(const f32x4*)(sc1 + c); sh[j] = *(const f32x4*)(sh1 + c);
#pragma unroll
            for (int e = 0; e < 4; ++e) gs[j][e] = g[e] * (1.0f + sc[e]); }
        for (int t = gw; t < S; t += NGW) {
            const f32x4* xr = (const f32x4*)(x + (size_t)t * D) + lane;
            f32x4 v[8]; float ss = 0.f;
#pragma unroll
            for (int j = 0; j < 8; ++j) { v[j] = xr[64 * j]; ss += (v[j][0] * v[j][0] + v[j][1] * v[j][1]) + (v[j][2] * v[j][2] + v[j][3] * v[j][3]); }
            const float rstd = rsqrtf(wave_sum(ss) * (1.0f / D) + NORM_EPS);
#pragma unroll
            for (int j = 0; j < 8; ++j) { const f32x4 h = v[j] * rstd * gs[j] + sh[j]; u32x2 w; w.x = cvt_pk_bf16(h[0], h[1]); w.y = cvt_pk_bf16(h[2], h[3]);
                *(u32x2*)(HB + (size_t)t * D + 4 * lane + 256 * j) = w; }
        }
    }
    SEAM(PH_H);
    if (IN(PH_INPROJ)) for (int rep = 0; rep < NREP(PH_INPROJ); ++rep) {
        pg8::Gemm g{HB, WIN_T, 2048, 0}; pg8::StaticOrder So; So.init(S, DINP, G, wg);
        pg8::EpiBf16 E{PROJ, DINP, nullptr, 0};
        pg8::gemm_phase<pg8::EpiBf16, pg8::StaticOrder>(lds, g, So, E);
    }
    SEAM(PH_INPROJ);
    if (IN(PH_POST)) {
        const int gw = wg * NWAVES + wave, NGW = G * NWAVES;
        for (int t = gw; t < S; t += NGW) post_token(PROJ, KI, KC, VC, positions, idx_knorm_g, idx_knorm_b, t, lane);
        __syncthreads();
        for (int u = wg; u < 2048; u += G) hgrn_l1(lds, PROJ, lb_logits, ST, DC, u >> 3, u & 7, tid, wave, lane);
    }
    SEAM(PH_POST);
    if (IN(PH_SCORE)) {
        for (int idx = wg * NTHR + tid; idx < 8 * 128 * 128; idx += G * NTHR) {
            const int h = idx >> 14, d = idx & 127; float s = 0.f;
            float* sp = ST + idx; const float* dp = DC + h * 128 + d;
            for (int c = 0; c < 256; c += 8) {
                float l[8], dc[8];
#pragma unroll
                for (int i = 0; i < 8; ++i) { l[i] = sp[(size_t)(c + i) * 131072]; dc[i] = dp[(size_t)(c + i) * 1024]; }
#pragma unroll
                for (int i = 0; i < 8; ++i) { sp[(size_t)(c + i) * 131072] = s; s = dc[i] * s + l[i]; }
            }
        }
        if (flags & FLAG_ATT) for (int rep = 0; rep < NREP(PH_SCORE); ++rep) {
            for (int j = wg; j < 252; j += G) { score_block(lds, PROJ, KI, SCORES, 8 + j, tid, wave, lane); score_block(lds, PROJ, KI, SCORES, 511 - j, tid, wave, lane); }
        }
    }
    SEAM(PH_SCORE);
    if (IN(PH_SELECT)) {
        for (int u = wg; u < 2048; u += G) hgrn_l3(lds, PROJ, lb_logits, ST, hgrn_norm_g, REC, u >> 3, u & 7, tid, wave, lane);
    }
    SEAM(PH_SELECT);
    if (IN(PH_ATTN)) {
        const int gw = wg * NWAVES + wave, NGW = G * NWAVES;
        if (flags & FLAG_ATT) for (int rep = 0; rep < NREP(PH_ATTN); ++rep) {
            for (int t = gw; t < S; t += NGW) {
                LAS unsigned char* wl = lds + wave * 9216;
                if (t >= 256) select_row(wl, SCORES, t, lane);
                else {
#pragma unroll
                    for (int i = 0; i < 4; ++i) { const int idx = lane + 64 * i; ((LAS int*)wl)[idx] = idx <= t ? idx : 0; }
                }
                attn_query(wl, PROJ, KC, VC, ATT, t, lane);
            }
        } else {
            for (size_t i = (size_t)wg * NTHR + tid; i < (size_t)S * 1024 * 2 / 16; i += (size_t)G * NTHR) ((u32x4*)ATT)[i] = (u32x4){0u, 0u, 0u, 0u};
        }
    }
    SEAM(PH_ATTN);
    if (IN(PH_OP1)) {
        pg8::Gemm g{ATT, WA_T, 1024, 0}; pg8::StaticOrder So; So.init(S, 2048, G, wg);
        pg8::EpiGate E{MERGED, PROJ + CGA, 0};
        pg8::gemm_phase<pg8::EpiGate, pg8::StaticOrder>(lds, g, So, E);
    }
    SEAM(PH_OP1);
    if (IN(PH_OP2)) {
        pg8::Gemm g{REC, WH_T, 1024, 0}; pg8::StaticOrder So; So.init(S, 2048, G, wg);
        pg8::EpiGate E{MERGED, PROJ + CGR, 1};
        pg8::gemm_phase<pg8::EpiGate, pg8::StaticOrder>(lds, g, So, E);
    }
    SEAM(PH_OP2);
    if (IN(PH_WOUT)) {
        pg8::Gemm g{MERGED, WO_T, 2048, 0}; pg8::StaticOrder So; So.init(S, 2048, G, wg);
        pg8::EpiResid E{x, MOD + 2 * D, X1};
        pg8::gemm_phase<pg8::EpiResid, pg8::StaticOrder>(lds, g, So, E);
    }
    SEAM(PH_WOUT);
    }

    if (IN(PH_ROUTER) && (flags & FLAG_MOE)) {
        LAS float* hs = (LAS float*)lds;
        volatile LAS unsigned* lcnt = MISC + 32;
        const float* sh2 = MOD + 3 * D; const float* sc2 = MOD + 4 * D;
        if (tid < 32) lcnt[tid] = 0u;
        __syncthreads();
        for (int grp = wg; grp < S / 16; grp += G) {
#pragma unroll 1
            for (int q = 0; q < 2; ++q) {
                const int tl = 2 * wave + q, t = grp * 16 + tl;
                const f32x4* xr = (const f32x4*)(x1src + (size_t)t * D) + lane;
                f32x4 v[8]; float ss = 0.f;
#pragma unroll
                for (int j = 0; j < 8; ++j) { v[j] = xr[64 * j]; ss += (v[j][0] * v[j][0] + v[j][1] * v[j][1]) + (v[j][2] * v[j][2] + v[j][3] * v[j][3]); }
                const float rstd = rsqrtf(wave_sum(ss) * (1.0f / D) + NORM_EPS);
#pragma unroll
                for (int j = 0; j < 8; ++j) {
                    const int c = 4 * lane + 256 * j;
                    const f32x4 g = *(const f32x4*)(norm2_g + c), sc = *(const f32x4*)(sc2 + c), sh = *(const f32x4*)(sh2 + c);
                    f32x4 h;
#pragma unroll
                    for (int e = 0; e < 4; ++e) h[e] = v[j][e] * rstd * g[e] * (1.0f + sc[e]) + sh[e];
                    *(LAS f32x4*)(hs + tl * 2048 + c) = h;
                    u32x2 w; w.x = cvt_pk_bf16(h[0], h[1]); w.y = cvt_pk_bf16(h[2], h[3]);
                    *(u32x2*)(HB + (size_t)t * D + c) = w;
                }
            }
            __syncthreads();
            {
                const int tl = tid >> 5, e = tid & 31, t = grp * 16 + tl;
                float a0 = 0.f, a1 = 0.f, a2 = 0.f, a3 = 0.f;
                const LAS float* hrow = hs + tl * 2048; const float* wr = w_router + e;
#pragma unroll 4
                for (int c = 0; c < D; c += 4) {
                    const f32x4 hv = *(const LAS f32x4*)(hrow + c);
                    a0 += hv[0] * wr[(size_t)(c + 0) * 32]; a1 += hv[1] * wr[(size_t)(c + 1) * 32]; a2 += hv[2] * wr[(size_t)(c + 2) * 32]; a3 += hv[3] * wr[(size_t)(c + 3) * 32];
                }
                float v = ((a0 + a1) + (a2 + a3)) + b_router[e];
                float tv[4]; int ti[4];
#pragma unroll
                for (int k = 0; k < 4; ++k) {
                    float bv = v; int bi = e;
#pragma unroll
                    for (int o = 16; o >= 1; o >>= 1) { const float ov = __shfl_xor(bv, o); const int oi = __shfl_xor(bi, o); if (ov > bv || (ov == bv && oi < bi)) { bv = ov; bi = oi; } }
                    tv[k] = bv; ti[k] = bi; if (e == bi) v = -__builtin_inff();
                }
                if (e == 0) {
                    const float e1 = __expf(tv[1] - tv[0]), e2 = __expf(tv[2] - tv[0]), e3 = __expf(tv[3] - tv[0]); const float inv = 1.0f / (1.0f + e1 + e2 + e3);
                    *(int4*)(TOPE + (size_t)t * 4) = make_int4(ti[0], ti[1], ti[2], ti[3]);
                    *(f32x4*)(GATE + (size_t)t * 4) = (f32x4){inv, e1 * inv, e2 * inv, e3 * inv};
#pragma unroll
                    for (int k = 0; k < 4; ++k) __hip_atomic_fetch_add((LAS unsigned*)&lcnt[ti[k]], 1u, __ATOMIC_RELAXED, __HIP_MEMORY_SCOPE_WORKGROUP);
                }
            }
            __syncthreads();
        }
        if (tid < 32) { const unsigned c = lcnt[tid]; if (c) __hip_atomic_fetch_add(ctl + CW_CNT + tid, c, __ATOMIC_RELAXED, __HIP_MEMORY_SCOPE_AGENT); }
    }
    SEAM(PH_ROUTER);

    if (IN(PH_SCATTER) && (flags & FLAG_MOE)) {
        volatile LAS unsigned* lcnt = MISC + 32; volatile LAS unsigned* lbase = MISC + 64; LAS int* pstart = (LAS int*)(lds + 1024); LAS int* slot_l = (LAS int*)(lds + 2048);
        if (tid == 0) { int p = 0; for (int e = 0; e < NEXP; ++e) { pstart[e] = p; p += (int)((__hip_atomic_load(ctl + CW_CNT + e, __ATOMIC_RELAXED, __HIP_MEMORY_SCOPE_AGENT) + 255u) & ~255u); } }
        if (tid < 32) lcnt[tid] = 0u;
        __syncthreads();
        for (int blk = wg; blk < S / 64; blk += G) {
            int e = 0, lrank = 0;
            if (tid < 256) { e = TOPE[(size_t)blk * 256 + tid]; lrank = (int)__hip_atomic_fetch_add((LAS unsigned*)&lcnt[e], 1u, __ATOMIC_RELAXED, __HIP_MEMORY_SCOPE_WORKGROUP); }
            __syncthreads();
            if (tid < 32) { const unsigned c = lcnt[tid]; lbase[tid] = c ? __hip_atomic_fetch_add(ctl + CW_FILL + tid, c, __ATOMIC_RELAXED, __HIP_MEMORY_SCOPE_AGENT) : 0u; }
            __syncthreads();
            if (tid < 256) { const int slot = pstart[e] + (int)lbase[e] + lrank; SLOT[(size_t)blk * 256 + tid] = slot; slot_l[tid] = slot; }
            __syncthreads();
            for (int a = wave; a < 256; a += NWAVES) {
                const int t = blk * 64 + (a >> 2), slot = slot_l[a];
                const u32x4* src = (const u32x4*)(HB + (size_t)t * D) + lane; u32x4* dst = (u32x4*)(XB + (size_t)slot * D) + lane;
#pragma unroll
                for (int j = 0; j < 4; ++j) dst[64 * j] = src[64 * j];
            }
            if (tid < 32) lcnt[tid] = 0u;
            __syncthreads();
        }
    }
    SEAM(PH_SCATTER);

    if ((IN(PH_MOE1) || IN(PH_MOE2)) && (flags & FLAG_MOE)) {
        LAS int* panel_e = (LAS int*)(lds + 131072 + 2048);
        LAS int* npan = (LAS int*)(lds + 131072 + 2048 + 2048);
        __syncthreads();
        if (tid == 0) { int p = 0; for (int e = 0; e < NEXP; ++e) { const int np = (int)((__hip_atomic_load(ctl + CW_CNT + e, __ATOMIC_RELAXED, __HIP_MEMORY_SCOPE_AGENT) + 255u) >> 8); for (int q = 0; q < np; ++q) panel_e[p + q] = e; p += np; } npan[0] = p; }
        __syncthreads();
        const int nPanels = npan[0];
        if (IN(PH_MOE1)) for (int rep = 0; rep < NREP(PH_MOE1); ++rep) {
            pg8::Gemm g{XB, W1_T, 2048, (size_t)4096 * 2048 * 2}; pg8::MoeOrder So; So.init(nPanels, 16, G, wg, panel_e);
            pg8::EpiSwiglu E{ACT, b1};
            pg8::gemm_phase<pg8::EpiSwiglu, pg8::MoeOrder>(lds, g, So, E);
        }
        SEAM(PH_MOE1);
        if (IN(PH_MOE2)) for (int rep = 0; rep < NREP(PH_MOE2); ++rep) {
            pg8::Gemm g{ACT, W2_T, 2048, (size_t)2048 * 2048 * 2}; pg8::MoeOrder So; So.init(nPanels, 8, G, wg, panel_e);
            pg8::EpiBf16 E{YB, 2048, b2, 2048};
            pg8::gemm_phase<pg8::EpiBf16, pg8::MoeOrder>(lds, g, So, E);
        }
    }
    SEAM(PH_MOE2);

    if (IN(PH_FINAL)) {
        const float* gt2 = MOD + 5 * D;
        const int gw = wg * NWAVES + wave, NGW = G * NWAVES;
        for (int t = gw; t < S; t += NGW) {
            const f32x4* xr = (const f32x4*)(x1src + (size_t)t * D) + lane;
            f32x4 v[8];
#pragma unroll
            for (int j = 0; j < 8; ++j) v[j] = xr[64 * j];
            if (flags & FLAG_MOE) {
                f32x4 m[8];
#pragma unroll
                for (int j = 0; j < 8; ++j) m[j] = (f32x4){0.f, 0.f, 0.f, 0.f};
                const int4 sl = *(const int4*)(SLOT + (size_t)t * 4); const f32x4 gt = *(const f32x4*)(GATE + (size_t)t * 4);
                const int sls[4] = {sl.x, sl.y, sl.z, sl.w};
#pragma unroll
                for (int k = 0; k < 4; ++k) {
                    const u32x2* yr = (const u32x2*)(YB + (size_t)sls[k] * D) + lane; const float gk = gt[k];
#pragma unroll
                    for (int j = 0; j < 8; ++j) { const u32x2 w = yr[64 * j]; m[j][0] += gk * bf_lo(w.x); m[j][1] += gk * bf_hi(w.x); m[j][2] += gk * bf_lo(w.y); m[j][3] += gk * bf_hi(w.y); }
                }
#pragma unroll
                for (int j = 0; j < 8; ++j) { const f32x4 g2 = *(const f32x4*)(gt2 + 4 * lane + 256 * j); v[j] = v[j] + g2 * m[j]; }
            }
            float ss = 0.f;
#pragma unroll
            for (int j = 0; j < 8; ++j) ss += (v[j][0] * v[j][0] + v[j][1] * v[j][1]) + (v[j][2] * v[j][2] + v[j][3] * v[j][3]);
            const float rstd = rsqrtf(wave_sum(ss) * (1.0f / D) + NORM_EPS);
            f32x4* orow = (f32x4*)(out + (size_t)t * D) + lane;
#pragma unroll
            for (int j = 0; j < 8; ++j) { const f32x4 fg = *(const f32x4*)(final_g + 4 * lane + 256 * j); orow[64 * j] = v[j] * rstd * fg; }
        }
    }
#undef IN
#undef SEAM
}

#ifndef MK_ONE_LAUNCH
#define MK_ONE_LAUNCH 1
#endif
#ifndef MK_FLAGS
#define MK_FLAGS (FLAG_MOE | FLAG_MIXER | FLAG_ATT)
#endif
extern "C" void kernel_launch(void* const* d_in, const int* in_sizes, int n_in, void* d_out, int out_size, void* d_ws, size_t ws_size, hipStream_t stream) {
    static int grid = 0;
    if (grid == 0) {
        if (n_in != 22 || out_size != S * D || ws_size < WS_END) { fprintf(stderr, "kernel_launch: unexpected shapes: n_in %d out %d ws %zu (need %zu)\n", n_in, out_size, ws_size, (size_t)WS_END); grid = -1; return; }
        int dev = 0, cus = 0, per_cu = 0;
        if (hipGetDevice(&dev) != hipSuccess || hipDeviceGetAttribute(&cus, hipDeviceAttributeMultiprocessorCount, dev) != hipSuccess) { grid = -1; return; }
        if (hipFuncSetAttribute((const void*)fwd_kernel, hipFuncAttributeMaxDynamicSharedMemorySize, LDS_BYTES) != hipSuccess) { fprintf(stderr, "kernel_launch: hipFuncSetAttribute failed\n"); grid = -1; return; }
        if (hipOccupancyMaxActiveBlocksPerMultiprocessor(&per_cu, (const void*)fwd_kernel, NTHR, LDS_BYTES) != hipSuccess || per_cu < 1) { fprintf(stderr, "kernel_launch: occupancy query says %d\n", per_cu); (void)hipGetLastError(); grid = -1; return; }
        grid = cus;
    }
    if (grid < 0) return;
    (void)in_sizes;
    hipMemsetAsync((char*)d_ws + WS_CTL, 0, CTL_BYTES, stream);
    Args a{};
    for (int i = 0; i < 22; ++i) a.in[i] = d_in[i];
    a.out = (float*)d_out; a.ws = (unsigned char*)d_ws; a.flags = MK_FLAGS; a.pad = 0;
#if MK_ONE_LAUNCH
    a.ph_lo = 0; a.ph_hi = NPH;
    hipLaunchKernelGGL(fwd_kernel, dim3(grid), dim3(NTHR), LDS_BYTES, stream, a);
#else
    for (int p = 0; p < NPH; ++p) { a.ph_lo = p; a.ph_hi = p + 1; hipLaunchKernelGGL(fwd_kernel, dim3(grid), dim3(NTHR), LDS_BYTES, stream, a); }
#endif
}
```

```cpp
#include <hip/hip_runtime.h>
#include <cstdio>
#include <cstdint>

#define GAS __attribute__((address_space(1)))
#define LAS __attribute__((address_space(3)))
typedef unsigned short bf16_t;
typedef short bf16x8 __attribute__((ext_vector_type(8)));
typedef float f32x4 __attribute__((ext_vector_type(4)));
typedef float f32x2 __attribute__((ext_vector_type(2)));
typedef float f32x16 __attribute__((ext_vector_type(16)));
typedef unsigned u32x4 __attribute__((ext_vector_type(4)));
typedef unsigned u32x2 __attribute__((ext_vector_type(2)));
typedef int i32x4 __attribute__((ext_vector_type(4)));
typedef int i32x8 __attribute__((ext_vector_type(8)));

constexpr int S = 16384, D = 2048, DIN = 10832, DINP = 11008, NEXP = 32, DFF = 2048;
constexpr int NWAVES = 8, NTHR = 512;
constexpr int CQ = 0, CK = 1024, CV = 1280, CQI = 1536, CKI = 2560, CWI = 2624, CHQ = 2816, CHF = 3840, CHI = 4864, CHG = 5888, CGA = 6912, CGR = 8960;
constexpr int PMAX = 65536 + NEXP * 256;
constexpr float NORM_EPS = 1e-5f;

constexpr size_t MiB = 1u << 20;
constexpr size_t al256(size_t x) { return (x + 255) & ~(size_t)255; }
constexpr size_t WS_CTL = 0, CTL_BYTES = 1 * MiB;
constexpr size_t WS_MOD = WS_CTL + CTL_BYTES;
constexpr size_t WS_TOPE = WS_MOD + 64 * 1024;
constexpr size_t WS_GATE = WS_TOPE + (size_t)S * 16;
constexpr size_t WS_SLOT = WS_GATE + (size_t)S * 16;
constexpr size_t WS_WIN_T = WS_SLOT + (size_t)S * 16;
constexpr size_t WS_WA_T = WS_WIN_T + (size_t)DINP * D * 2;
constexpr size_t WS_WH_T = WS_WA_T + (size_t)2048 * 1024 * 2;
constexpr size_t WS_WO_T = WS_WH_T + (size_t)2048 * 1024 * 2;
constexpr size_t WS_W1_T = WS_WO_T + (size_t)2048 * 2048 * 2;
constexpr size_t WS_W2_T = WS_W1_T + (size_t)NEXP * 4096 * 2048 * 2;
constexpr size_t WS_H = WS_W2_T + (size_t)NEXP * 2048 * 2048 * 2;
constexpr size_t WS_PROJ = WS_H + (size_t)S * D * 2;
constexpr size_t WS_KI = WS_PROJ + (size_t)S * DINP * 2;
constexpr size_t WS_KC = WS_KI + (size_t)S * 64 * 2;
constexpr size_t WS_VC = WS_KC + (size_t)S * 256 * 2;
constexpr size_t WS_ST = WS_VC + (size_t)S * 256 * 2;
constexpr size_t WS_DC = WS_ST + (size_t)256 * 8 * 128 * 128 * 4;
constexpr size_t WS_SEL = WS_DC + (size_t)256 * 8 * 128 * 4;
constexpr size_t WS_ATT = WS_SEL + (size_t)S * 256 * 4;
constexpr size_t WS_REC = WS_ATT + (size_t)S * 1024 * 2;
constexpr size_t WS_MERGED = WS_REC + (size_t)S * 1024 * 2;
constexpr size_t WS_X1 = WS_MERGED + (size_t)S * 2048 * 2;
constexpr size_t WS_SCORES = WS_X1 + (size_t)S * 2048 * 4;
constexpr size_t WS_XB = WS_SCORES;
constexpr size_t WS_ACT = WS_XB + (size_t)PMAX * 2048 * 2;
constexpr size_t WS_YB = WS_ACT + (size_t)PMAX * 2048 * 2;
constexpr size_t WS_END = WS_SCORES + (size_t)S * S * 4;
static_assert(WS_YB + (size_t)PMAX * 2048 * 2 <= WS_END, "MoE buffers overlay the score matrix");
static_assert(WS_END <= (size_t)4096 * MiB, "workspace");
constexpr int CW_BAR = 4096, CW_CNT = 8192, CW_FILL = 8448;

constexpr int LDS_BYTES = 147456;
constexpr int LDS_MISC = LDS_BYTES - 512;

__device__ __forceinline__ unsigned cvt_pk_bf16(float lo, float hi) { unsigned r; asm volatile("v_cvt_pk_bf16_f32 %0, %1, %2" : "=v"(r) : "v"(lo), "v"(hi)); return r; }
__device__ __forceinline__ float bf_lo(unsigned u) { return __uint_as_float(u << 16); }
__device__ __forceinline__ float bf_hi(unsigned u) { return __uint_as_float(u & 0xffff0000u); }
__device__ __forceinline__ float bf2f(bf16_t b) { return __uint_as_float(((unsigned)b) << 16); }
__device__ __forceinline__ float wave_sum(float v) {
#pragma unroll
    for (int o = 1; o < 64; o <<= 1) v += __shfl_xor(v, o);
    return v;
}
__device__ __forceinline__ float wave_max(float v) {
#pragma unroll
    for (int o = 1; o < 64; o <<= 1) v = fmaxf(v, __shfl_xor(v, o));
    return v;
}
__device__ __forceinline__ float sigmoidf_(float x) { return __builtin_amdgcn_rcpf(1.0f + __expf(-x)); }
__device__ __forceinline__ float siluf_(float x) { return x * __builtin_amdgcn_rcpf(1.0f + __expf(-x)); }
__device__ __forceinline__ unsigned pack4_fp8(float a, float b, float c, float d) { int w = 0; w = __builtin_amdgcn_cvt_pk_fp8_f32(a, b, w, false); w = __builtin_amdgcn_cvt_pk_fp8_f32(c, d, w, true); return (unsigned)w; }
constexpr float W8_SCALE = 64.0f, ACT8_SCALE = 4.0f;
#define LDS_WAIT() asm volatile("s_waitcnt lgkmcnt(0)" ::: "memory")
#define VM_WAIT() asm volatile("s_waitcnt vmcnt(0)" ::: "memory")

#define XB_TMO      128
#define XB_XCNT(j)  (256  + 64 * (j))
#define XB_XSUB(j)  (1280 + 64 * (j))
#define XB_XGEN(j)  (2304 + 64 * (j))
#define XB_TOP      3328
#define XB_TOPGEN   3392
#define XCD_BAR_WORDS 3456
#define XB_SPIN_CAP (1u << 22)

__device__ __forceinline__ unsigned xb_ld(unsigned* p)              { return __hip_atomic_load(p, __ATOMIC_RELAXED, __HIP_MEMORY_SCOPE_AGENT); }
__device__ __forceinline__ unsigned xb_add(unsigned* p, unsigned v) { return __hip_atomic_fetch_add(p, v, __ATOMIC_RELAXED, __HIP_MEMORY_SCOPE_AGENT); }
__device__ __forceinline__ unsigned xb_xcc_id() { return (unsigned)__builtin_amdgcn_s_getreg((3 << 11) | 20) & 0xFu; }
#define XB_SPIN(cond, bar) do { unsigned _sp = 0; while (cond) { __builtin_amdgcn_s_sleep(1); \
    if ((++_sp & 255u) == 0u) { if (xb_ld(&(bar)[XB_TMO])) break; if (_sp > XB_SPIN_CAP) { atomicAdd(&(bar)[XB_TMO], 1u); break; } } } } while (0)

struct XcdBarrier { unsigned* bar; unsigned x; volatile LAS unsigned* st; };

__device__ __forceinline__ XcdBarrier xcd_barrier_post(unsigned* bar, volatile LAS unsigned* st) {
    XcdBarrier b; b.bar = bar; b.x = xb_xcc_id(); b.st = st;
    if (threadIdx.x == 0) (void)xb_add(&bar[XB_XCNT(b.x)], 1u);
    return b;
}
__device__ __forceinline__ void xcd_barrier_complete(unsigned* bar, unsigned x, unsigned& nloc, unsigned& nx) {
    const unsigned G = gridDim.x * gridDim.y * gridDim.z;
    unsigned sum, cnt, mine, sp = 0u;
    for (;;) {
        sum = 0u; cnt = 0u; mine = 0u;
#pragma unroll
        for (unsigned j = 0; j < 16; ++j) { const unsigned c = xb_ld(&bar[XB_XCNT(j)]); sum += c; cnt += (c > 0u) ? 1u : 0u; mine = (j == x) ? c : mine; }
        if (sum == G) break;
        __builtin_amdgcn_s_sleep(1);
        if ((++sp & 255u) == 0u) { if (xb_ld(&bar[XB_TMO])) break; if (sp > XB_SPIN_CAP) { atomicAdd(&bar[XB_TMO], 1u); break; } }
    }
    nloc = mine > 0u ? mine : 1u; nx = cnt > 0u ? cnt : 1u;
}
__device__ __forceinline__ void xcd_barrier(const XcdBarrier& b) {
    asm volatile("s_waitcnt vmcnt(0)" ::: "memory");
    __syncthreads();
    if (threadIdx.x == 0) {
        unsigned* bar = b.bar;
        __builtin_amdgcn_s_waitcnt(0);
        unsigned nloc = b.st[0], nx = b.st[1];
        if (nloc == 0u) { xcd_barrier_complete(bar, b.x, nloc, nx); b.st[0] = nloc; b.st[1] = nx; }
        const unsigned old = xb_add(&bar[XB_XSUB(b.x)], 1u);
        const unsigned gen = old / nloc;
        if (old + 1u == (gen + 1u) * nloc) {
            __builtin_amdgcn_fence(__ATOMIC_RELEASE, "agent");
            asm volatile("s_waitcnt vmcnt(0)" ::: "memory");
            const unsigned og = xb_add(&bar[XB_TOP], 1u);
            const unsigned tg = og / nx;
            if (og + 1u == (tg + 1u) * nx) xb_add(&bar[XB_TOPGEN], 1u);
            else XB_SPIN(xb_ld(&bar[XB_TOPGEN]) == tg, bar);
            __builtin_amdgcn_fence(__ATOMIC_ACQUIRE, "agent");
            xb_add(&bar[XB_XGEN(b.x)], 1u);
            asm volatile("s_waitcnt vmcnt(0)" ::: "memory");
        } else {
            XB_SPIN(xb_ld(&bar[XB_XGEN(b.x)]) == gen, bar);
            __builtin_amdgcn_fence(__ATOMIC_ACQUIRE, "agent");
            asm volatile("s_waitcnt vmcnt(0)" ::: "memory");
        }
    }
    __syncthreads();
}

namespace pg8 {
constexpr int BM = 256, BK = 64, HALF = 128, HTB = HALF * BK * 2, STAGE_BYTES = 8 * HTB, NXCD = 8, WGM = 8;
__host__ __device__ __forceinline__ int lds_byte(int r, int c) { const int st = (r >> 4) * 2 + (c >> 5), rr = r & 15, cc = c & 31, ob = rr * 64 + cc * 2; return st * 1024 + (ob ^ (((ob >> 9) & 1) << 5)); }
__host__ __device__ __forceinline__ void stage_rc(int b, int& R, int& C) { const int st = b / 1024, sb = b % 1024, swz = sb ^ (((sb >> 9) & 1) << 5); R = (st >> 1) * 16 + swz / 64; C = (st & 1) * 32 + (swz % 64) / 2; }
__host__ __device__ __forceinline__ int perm32(int rho) { const int n = rho >> 4, i = rho & 15; return 8 * (i >> 2) + 4 * n + (i & 3); }

struct Unit { int pm, pn, e; };
struct Gemm { const void* A; const void* Bt; int K; size_t estride; };

struct StaticOrder {
    int nM, nN, nwg, G, c, i;
    __device__ void init(int M, int N, int G_, int c_) { nM = M / BM; nN = N / BM; nwg = nM * nN; G = G_; c = c_; i = 0; }
    __device__ bool next(Unit& u) {
        const long L = (long)i * G + c; ++i; if (L >= nwg) return false;
        int wgid = (int)L; { const int q = nwg / NXCD, r = nwg % NXCD, xcd = wgid % NXCD, off = wgid / NXCD; wgid = (xcd < r ? xcd * (q + 1) : r * (q + 1) + (xcd - r) * q) + off; }
        const int nig = WGM * nN, gid = wgid / nig, fm = gid * WGM, gsz = (nM - fm) < WGM ? (nM - fm) : WGM;
        u.pm = fm + ((wgid % nig) % gsz); u.pn = (wgid % nig) / gsz; u.e = 0; return true;
    }
};
struct MoeOrder {
    int nPanels, nN, G, c, i; const LAS int* panel_e;
    __device__ void init(int nPanels_, int nN_, int G_, int c_, const LAS int* pe) { nPanels = nPanels_; nN = nN_; G = G_; c = c_; i = 0; panel_e = pe; }
    __device__ bool next(Unit& u) {
        const int PB = 256 / nN;
        const int nblk = (nPanels + PB - 1) / PB;
        for (;;) {
            const long L = (long)i * G + c; ++i;
            const int blk = (int)(L >> 8), r = (int)(L & 255), x = r & 7, j = r >> 3;
            if (blk >= nblk) return false;
            int pm, pn;
            if (nN == 16) { pm = blk * 16 + 4 * (x >> 1) + (j & 3); pn = 8 * (x & 1) + (j >> 2); }
            else          { pm = blk * 32 + 4 * x + (j & 3);        pn = j >> 2; }
            if (pm < nPanels) { u.pm = pm; u.pn = pn; u.e = panel_e[pm]; return true; }
        }
    }
};

template <class Epi, class Sched, bool FP8 = false>
__device__ __forceinline__ void gemm_phase(LAS unsigned char* lds, const Gemm g, Sched& S, const Epi& E) {
    const int tid = threadIdx.x, wid = __builtin_amdgcn_readfirstlane(tid >> 6), lane = tid & 63, wr = wid >> 2, wc = wid & 3, fr = lane & 15, fq = lane >> 4;
    const int K = g.K; const int pitch = FP8 ? K : 2 * K; const int nt = pitch / 128;
    unsigned voffA[2], voffB[2];
#pragma unroll
    for (int i = 0; i < 2; ++i) { int R, C; stage_rc(tid * 16 + i * 8192, R, C); const int Rb = Epi::PERM ? ((R & ~31) + perm32(R & 31)) : R;
        voffA[i] = (unsigned)(R * pitch + C * 2); voffB[i] = (unsigned)(Rb * pitch + C * 2); }
    const size_t kstep = (size_t)(BK * 2);
    const size_t hstep = (size_t)HALF * pitch;
    const size_t tstep = 2 * hstep;
    const unsigned ldsw = (unsigned)wid * 1024u;
    const int aoff = lds_byte(wr * 64 + fr, fq * 8), boff = lds_byte(wc * 32 + fr, fq * 8);
#define PG8_SA(b, h) (((b) * 2 + (h)) * HTB)
#define PG8_SB(b, h) ((4 + (b) * 2 + (h)) * HTB)
#define PG8_STAGE(bufoff, gbase, voff) do { _Pragma("unroll") for (int _i = 0; _i < 2; ++_i) \
        __builtin_amdgcn_global_load_lds((const unsigned*)((const char*)(gbase) + (voff)[_i]), (LAS unsigned*)(lds + (bufoff) + ldsw + _i * 8192), 16, 0, 0); } while (0)
#define PG8_LD8(p) __builtin_shufflevector(*(const LAS i32x4*)(p), *(const LAS i32x4*)((p) + 1024), 0, 1, 2, 3, 4, 5, 6, 7)
#define PG8_LDA(dst, b, h) do { _Pragma("unroll") for (int m = 0; m < 4; ++m) { if constexpr (FP8) dst##8[m] = PG8_LD8(lds + PG8_SA(b, h) + aoff + m * 2048); \
        else { _Pragma("unroll") for (int k = 0; k < 2; ++k) dst[m][k] = *(const LAS bf16x8*)(lds + PG8_SA(b, h) + aoff + m * 2048 + k * 1024); } } } while (0)
#define PG8_LDB(dst, b, h) do { _Pragma("unroll") for (int n = 0; n < 2; ++n) { if constexpr (FP8) dst##8[n] = PG8_LD8(lds + PG8_SB(b, h) + boff + n * 2048); \
        else { _Pragma("unroll") for (int k = 0; k < 2; ++k) dst[n][k] = *(const LAS bf16x8*)(lds + PG8_SB(b, h) + boff + n * 2048 + k * 1024); } } } while (0)
#define PG8_MMA(ai, bj, At, Bt) do { __builtin_amdgcn_s_setprio(1); _Pragma("unroll") for (int m = 0; m < 4; ++m) _Pragma("unroll") for (int n = 0; n < 2; ++n) { \
        if constexpr (FP8) asm volatile("v_mfma_scale_f32_16x16x128_f8f6f4 %0, %1, %2, %0, %3, %3 op_sel_hi:[0,0,0]" : "+v"(acc[ai][bj][m][n]) : "v"(Bt##8[n]), "v"(At##8[m]), "v"(scl1)); \
        else { _Pragma("unroll") for (int k = 0; k < 2; ++k) acc[ai][bj][m][n] = __builtin_amdgcn_mfma_f32_16x16x32_bf16(Bt[n][k], At[m][k], acc[ai][bj][m][n], 0, 0, 0); } } \
        __builtin_amdgcn_s_setprio(0); } while (0)
#define PG8_WAIT_V(n) asm volatile("s_waitcnt vmcnt(" #n ")" ::: "memory")
#define PG8_WAIT_L(n) asm volatile("s_waitcnt lgkmcnt(" #n ")" ::: "memory")
#define PG8_BAR __builtin_amdgcn_s_barrier()
#define PG8_SCHED __builtin_amdgcn_sched_barrier(0)
    Unit cur, nxt;
    if (!S.next(cur)) return;
    const unsigned scl1 = 0x7f7f7f7fu;
    f32x4 acc[2][2][4][2];
#pragma unroll
    for (int a = 0; a < 2; ++a)
#pragma unroll
        for (int b = 0; b < 2; ++b)
#pragma unroll
            for (int m = 0; m < 4; ++m)
#pragma unroll
                for (int n = 0; n < 2; ++n) acc[a][b][m][n] = (f32x4){0.f, 0.f, 0.f, 0.f};
    bf16x8 At[4][2], B0[2][2], B1[2][2]; i32x8 At8[4], B08[2], B18[2];
    const char* cA = (const char*)g.A + (size_t)cur.pm * tstep; const char* cB = (const char*)g.Bt + (size_t)cur.e * g.estride + (size_t)cur.pn * tstep;
    PG8_STAGE(PG8_SB(0, 0), cB, voffB); PG8_STAGE(PG8_SB(0, 1), cB + hstep, voffB); PG8_STAGE(PG8_SA(0, 0), cA, voffA); PG8_STAGE(PG8_SA(0, 1), cA + hstep, voffA);
    if (wr == 1) PG8_BAR;
    PG8_WAIT_V(2); PG8_BAR;
    PG8_STAGE(PG8_SB(1, 0), cB + kstep, voffB); PG8_STAGE(PG8_SA(1, 0), cA + kstep, voffA); PG8_STAGE(PG8_SB(1, 1), cB + hstep + kstep, voffB);
    PG8_WAIT_V(6); PG8_BAR;
    for (;;) {
        const bool has_next = S.next(nxt);
        const char* nA = has_next ? (const char*)g.A + (size_t)nxt.pm * tstep : cA;
        const char* nB = has_next ? (const char*)g.Bt + (size_t)nxt.e * g.estride + (size_t)nxt.pn * tstep : cB;
        for (int t = 0; t < nt; t += 2) {
            const bool last = (t == nt - 2);
            const char* a1 = cA + (size_t)(t + 1) * kstep;
            const char* a2 = last ? nA : cA + (size_t)(t + 2) * kstep; const char* b2 = last ? nB : cB + (size_t)(t + 2) * kstep;
            const char* a3 = a2 + kstep; const char* b3 = b2 + kstep;
            PG8_LDB(B0, 0, 0); PG8_LDB(B1, 0, 1); PG8_SCHED; PG8_LDA(At, 0, 0); PG8_STAGE(PG8_SA(1, 1), a1 + hstep, voffA);
            PG8_WAIT_V(8); PG8_WAIT_L(0); PG8_BAR; PG8_MMA(0, 0, At, B0); PG8_MMA(0, 1, At, B1); PG8_BAR; PG8_SCHED;
            PG8_LDA(At, 0, 1); PG8_STAGE(PG8_SB(0, 0), b2, voffB); PG8_STAGE(PG8_SB(0, 1), b2 + hstep, voffB); PG8_STAGE(PG8_SA(0, 0), a2, voffA);
            PG8_WAIT_V(8); PG8_WAIT_L(0); PG8_BAR; PG8_MMA(1, 0, At, B0); PG8_MMA(1, 1, At, B1); PG8_BAR; PG8_SCHED;
            PG8_LDB(B0, 1, 0); PG8_LDB(B1, 1, 1); PG8_SCHED; PG8_LDA(At, 1, 0); PG8_STAGE(PG8_SA(0, 1), a2 + hstep, voffA);
            PG8_WAIT_V(8); PG8_WAIT_L(0); PG8_BAR; PG8_MMA(0, 0, At, B0); PG8_MMA(0, 1, At, B1); PG8_BAR; PG8_SCHED;
            PG8_LDA(At, 1, 1); PG8_STAGE(PG8_SB(1, 0), b3, voffB); PG8_STAGE(PG8_SB(1, 1), b3 + hstep, voffB); PG8_STAGE(PG8_SA(1, 0), a3, voffA);
            PG8_WAIT_V(8); PG8_WAIT_L(0); PG8_BAR; PG8_MMA(1, 0, At, B0); PG8_MMA(1, 1, At, B1); PG8_BAR; PG8_SCHED;
        }
        if (wr == 0) PG8_BAR;
        if constexpr (FP8) {
#pragma unroll
            for (int a = 0; a < 2; ++a)
#pragma unroll
                for (int b = 0; b < 2; ++b) asm volatile("s_nop 15" : "+v"(acc[a][b][0][0]), "+v"(acc[a][b][0][1]), "+v"(acc[a][b][1][0]), "+v"(acc[a][b][1][1]), "+v"(acc[a][b][2][0]), "+v"(acc[a][b][2][1]), "+v"(acc[a][b][3][0]), "+v"(acc[a][b][3][1]));
        }
        E(acc, cur, wr, wc, fr, fq);
        if (!has_next) break;
#pragma unroll
        for (int a = 0; a < 2; ++a)
#pragma unroll
            for (int b = 0; b < 2; ++b)
#pragma unroll
                for (int m = 0; m < 4; ++m)
#pragma unroll
                    for (int n = 0; n < 2; ++n) acc[a][b][m][n] = (f32x4){0.f, 0.f, 0.f, 0.f};
        cur = nxt; cA = nA; cB = nB;
        if (wr == 1) PG8_BAR;
    }
    PG8_WAIT_V(0);
    PG8_BAR;
#undef PG8_SA
#undef PG8_SB
#undef PG8_STAGE
#undef PG8_LDA
#undef PG8_LDB
#undef PG8_MMA
#undef PG8_LD8
#undef PG8_WAIT_V
#undef PG8_WAIT_L
#undef PG8_BAR
#undef PG8_SCHED
}

struct EpiBf16 {
    static constexpr bool PERM = true;
    bf16_t* O; int ldc; const float* bias; int bias_estride; float ascale;
    __device__ __forceinline__ void operator()(const f32x4 (&acc)[2][2][4][2], const Unit& u, int wr, int wc, int fr, int fq) const {
        const int row0 = u.pm * BM + wr * 64 + fr; const int col0 = u.pn * BM + wc * 32 + 8 * fq;
        f32x4 bv[2][2];
#pragma unroll
        for (int bj = 0; bj < 2; ++bj)
#pragma unroll
            for (int n = 0; n < 2; ++n) bv[bj][n] = bias ? *(const f32x4*)(bias + (size_t)u.e * bias_estride + col0 + bj * HALF + 4 * n) : (f32x4){0.f, 0.f, 0.f, 0.f};
#pragma unroll
        for (int ai = 0; ai < 2; ++ai)
#pragma unroll
            for (int m = 0; m < 4; ++m) { bf16_t* rowp = O + (size_t)(row0 + ai * HALF + m * 16) * ldc + col0;
#pragma unroll
                for (int bj = 0; bj < 2; ++bj) { const f32x4 v0 = acc[ai][bj][m][0] * ascale + bv[bj][0], v1 = acc[ai][bj][m][1] * ascale + bv[bj][1];
                    u32x4 w; w.x = cvt_pk_bf16(v0[0], v0[1]); w.y = cvt_pk_bf16(v0[2], v0[3]); w.z = cvt_pk_bf16(v1[0], v1[1]); w.w = cvt_pk_bf16(v1[2], v1[3]);
                    *(u32x4*)(rowp + bj * HALF) = w; } }
    }
};
__device__ __forceinline__ float swiglu1(float ug, float ul) {
    ug = fminf(ug, 7.0f); ul = fminf(fmaxf(ul, -7.0f), 7.0f);
    return ug * __builtin_amdgcn_rcpf(1.0f + __expf(-1.702f * ug)) * (ul + 1.0f);
}
struct EpiSwiglu {
    static constexpr bool PERM = true;
    unsigned char* O; const float* b1;
    __device__ __forceinline__ void operator()(const f32x4 (&acc)[2][2][4][2], const Unit& u, int wr, int wc, int fr, int fq) const {
        const int row0 = u.pm * BM + wr * 64 + fr; const int c0 = u.pn * 128 + wc * 32 + 8 * fq;
        const float* bg = b1 + (size_t)u.e * 4096 + c0; const float* bl = bg + 2048;
        f32x4 bgv[2], blv[2];
#pragma unroll
        for (int n = 0; n < 2; ++n) { bgv[n] = *(const f32x4*)(bg + 4 * n); blv[n] = *(const f32x4*)(bl + 4 * n); }
#pragma unroll
        for (int ai = 0; ai < 2; ++ai)
#pragma unroll
            for (int m = 0; m < 4; ++m) {
                float a[8];
#pragma unroll
                for (int n = 0; n < 2; ++n)
#pragma unroll
                    for (int j = 0; j < 4; ++j) a[4 * n + j] = ACT8_SCALE * swiglu1(acc[ai][0][m][n][j] * (1.0f / W8_SCALE) + bgv[n][j], acc[ai][1][m][n][j] * (1.0f / W8_SCALE) + blv[n][j]);
                u32x2 w; w.x = pack4_fp8(a[0], a[1], a[2], a[3]); w.y = pack4_fp8(a[4], a[5], a[6], a[7]);
                *(u32x2*)(O + (size_t)(row0 + ai * HALF + m * 16) * 2048 + c0) = w;
            }
    }
};

struct EpiGate {
    static constexpr bool PERM = true;
    bf16_t* O; const bf16_t* Gt; int accum;
    __device__ __forceinline__ void operator()(const f32x4 (&acc)[2][2][4][2], const Unit& u, int wr, int wc, int fr, int fq) const {
        const int row0 = u.pm * BM + wr * 64 + fr; const int col0 = u.pn * BM + wc * 32 + 8 * fq;
#pragma unroll
        for (int ai = 0; ai < 2; ++ai)
#pragma unroll
            for (int m = 0; m < 4; ++m) { const size_t row = (size_t)(row0 + ai * HALF + m * 16);
#pragma unroll
                for (int bj = 0; bj < 2; ++bj) { const int c = col0 + bj * HALF;
                    const u32x4 gw = *(const u32x4*)(Gt + row * DINP + c);
                    float r[8];
#pragma unroll
                    for (int q = 0; q < 4; ++q) { r[2 * q] = sigmoidf_(bf_lo(gw[q])) * acc[ai][bj][m][q >> 1][(2 * q) & 3]; r[2 * q + 1] = sigmoidf_(bf_hi(gw[q])) * acc[ai][bj][m][q >> 1][(2 * q + 1) & 3]; }
                    bf16_t* op = O + row * 2048 + c;
                    if (accum) { const u32x4 ow = *(const u32x4*)op;
#pragma unroll
                        for (int q = 0; q < 4; ++q) { r[2 * q] += bf_lo(ow[q]); r[2 * q + 1] += bf_hi(ow[q]); } }
                    u32x4 w; w.x = cvt_pk_bf16(r[0], r[1]); w.y = cvt_pk_bf16(r[2], r[3]); w.z = cvt_pk_bf16(r[4], r[5]); w.w = cvt_pk_bf16(r[6], r[7]);
                    *(u32x4*)op = w; } }
    }
};
struct EpiResid {
    static constexpr bool PERM = false;
    const float* x; const float* gt; float* X1;
    __device__ __forceinline__ void operator()(const f32x4 (&acc)[2][2][4][2], const Unit& u, int wr, int wc, int fr, int fq) const {
        const int row0 = u.pm * BM + wr * 64 + fr; const int col0 = u.pn * BM + wc * 32 + 4 * fq;
#pragma unroll
        for (int ai = 0; ai < 2; ++ai)
#pragma unroll
            for (int m = 0; m < 4; ++m) { const size_t row = (size_t)(row0 + ai * HALF + m * 16);
#pragma unroll
                for (int bj = 0; bj < 2; ++bj)
#pragma unroll
                    for (int n = 0; n < 2; ++n) { const int c = col0 + bj * HALF + n * 16;
                        const f32x4 xv = *(const f32x4*)(x + row * 2048 + c), g = *(const f32x4*)(gt + c);
                        *(f32x4*)(X1 + row * 2048 + c) = xv + g * acc[ai][bj][m][n]; } }
    }
};
}

#ifndef MK_REP
#define MK_REP 0
#endif
struct Args { const void* in[22]; float* out; unsigned char* ws; int ph_lo, ph_hi, flags, pad; };
enum { PH_PRO = 0, PH_H, PH_INPROJ, PH_POST, PH_SCORE, PH_SELECT, PH_ATTN, PH_OP1, PH_OP2, PH_WOUT, PH_ROUTER, PH_SCATTER, PH_MOE1, PH_MOE2, PH_FINAL, NPH };
constexpr int FLAG_MIXER = 1, FLAG_ATT = 2, FLAG_MOE = 4;

__device__ __forceinline__ int dest_row(int mode, int n) {
    if (mode == 1) return n < 2640 ? n : n + 176;
    if (mode == 2) { const int g = n >> 11, c = n & 2047; return (c >> 7) * 256 + g * 128 + (c & 127); }
    return n;
}
__device__ __forceinline__ void convert_item(const float* __restrict__ W, int K, int N, bf16_t* WT, int mode, int item, int lane, LAS unsigned char* scr) {
    const int nblk = (N + 63) >> 6; const int kb = item / nblk, nb = item - kb * nblk; const int k0 = kb * 128, n0 = nb * 64;
    const int c4 = lane & 15, kr = lane >> 4;
    const bool ok = (n0 + 4 * c4) < N;
    const float* src = W + (size_t)(k0 + 2 * kr) * N + n0 + 4 * c4;
#pragma unroll 4
    for (int i = 0; i < 16; ++i) {
        f32x4 v0 = (f32x4){0.f, 0.f, 0.f, 0.f}, v1 = v0;
        if (ok) { v0 = *(const f32x4*)(src + (size_t)(8 * i) * N); v1 = *(const f32x4*)(src + (size_t)(8 * i + 1) * N); }
        const int kk = 8 * i + 2 * kr;
#pragma unroll
        for (int e = 0; e < 4; ++e) *(LAS unsigned*)(scr + (4 * c4 + e) * 272 + kk * 2) = cvt_pk_bf16(v0[e], v1[e]);
    }
    LDS_WAIT(); asm volatile("" ::: "memory");
#pragma unroll 4
    for (int j = 0; j < 16; ++j) {
        const int q = j * 64 + lane, n = q >> 4, ch = q & 15;
        const u32x4 v = *(const LAS u32x4*)(scr + n * 272 + ch * 16);
        if (n0 + n < N) *(u32x4*)(WT + (size_t)dest_row(mode, n0 + n) * K + k0 + ch * 8) = v;
    }
    LDS_WAIT(); asm volatile("" ::: "memory");
}


__device__ __forceinline__ bf16_t f2bf(float f) { unsigned u = __float_as_uint(f); return (bf16_t)((u + 0x7fffu + ((u >> 16) & 1u)) >> 16); }
__device__ __forceinline__ float bfx(const u32x4& w, int i) { const unsigned u = w[i >> 1]; return (i & 1) ? bf_hi(u) : bf_lo(u); }
__device__ __forceinline__ void rope_sc(float pos, float inv, float& sn, float& cs) {
    const float ang = pos * inv;
    const double a = (double)ang; const double n = __builtin_rint(a * 0.15915494309189535); const float r = (float)(a - n * 6.283185307179586);
    sn = sinf(r); cs = cosf(r);
}
__device__ __forceinline__ void post_token(bf16_t* PROJ, bf16_t* KI, bf16_t* KC, bf16_t* VC, const int* positions, const float* kng, const float* knb, int t, int lane) {
    const float pos = (float)positions[t];
    bf16_t* row = PROJ + (size_t)t * DINP;
    float sn, cs;
#pragma unroll
    for (int i = 0; i < 2; ++i) {
        const int pp = lane + 64 * i, hd = pp >> 4, ii = pp & 15;
        rope_sc(pos, powf(500000.0f, -(float)ii * (1.0f / 16.0f)), sn, cs);
        bf16_t* p = row + CQ + hd * 128 + ii; const float a = bf2f(p[0]), b = bf2f(p[16]);
        p[0] = f2bf(a * cs - b * sn); p[16] = f2bf(b * cs + a * sn);
    }
#pragma unroll
    for (int i = 0; i < 2; ++i) {
        const int pp = lane + 64 * i, hd = pp >> 3, ii = pp & 7;
        rope_sc(pos, powf(500000.0f, -(float)ii * (1.0f / 8.0f)), sn, cs);
        bf16_t* p = row + CQI + hd * 64 + ii; const float a = bf2f(p[0]), b = bf2f(p[8]);
        p[0] = f2bf(a * cs - b * sn); p[8] = f2bf(b * cs + a * sn);
    }
    if (lane < 32) {
        const int g = lane >> 4, ii = lane & 15;
        rope_sc(pos, powf(500000.0f, -(float)ii * (1.0f / 16.0f)), sn, cs);
        const bf16_t* p = row + CK + g * 128 + ii; const float a = bf2f(p[0]), b = bf2f(p[16]);
        bf16_t* o = KC + (size_t)t * 256 + g * 128 + ii; o[0] = f2bf(a * cs - b * sn); o[16] = f2bf(b * cs + a * sn);
    }
#pragma unroll
    for (int i = 0; i < 3; ++i) { const int idx = lane + 64 * i, g = idx / 96, r = idx - g * 96; KC[(size_t)t * 256 + g * 128 + 32 + r] = row[CK + g * 128 + 32 + r]; }
    *(u32x2*)(VC + (size_t)t * 256 + 4 * lane) = *(const u32x2*)(row + CV + 4 * lane);
    {
        const float v = bf2f(row[CKI + lane]);
        const float mean = wave_sum(v) * (1.0f / 64.0f); const float d = v - mean; const float var = wave_sum(d * d) * (1.0f / 64.0f);
        const float y = d * rsqrtf(var + NORM_EPS) * kng[lane] + knb[lane];
        const float other = __shfl_xor(y, 8);
        rope_sc(pos, powf(500000.0f, -(float)(lane & 7) * (1.0f / 8.0f)), sn, cs);
        float o = y;
        if (lane < 8) o = y * cs - other * sn; else if (lane < 16) o = y * cs + other * sn;
        KI[(size_t)t * 64 + lane] = f2bf(o);
    }
}

constexpr int HG_GB = 0, HG_Q1 = 33792, HG_Q2 = 51200, HG_K2 = 68608, HG_VT = 86016, HG_PB = 104448, HG_LB = 113664;
__device__ __forceinline__ void hgrn_cumsum(LAS unsigned char* lds, const bf16_t* PROJ, const float* lb_logits, int c, int h, int tid) {
    LAS float* GB = (LAS float*)(lds + HG_GB); LAS float* LB = (LAS float*)(lds + HG_LB);
    if (tid < 128) { const float l0 = lb_logits[h * 128 + tid], l1 = lb_logits[1024 + h * 128 + tid]; LB[tid] = 1.0f / (1.0f + expf(l1 - l0)); }
    __syncthreads();
    const int t = tid >> 3, dseg = tid & 7;
    const bf16_t* p = PROJ + (size_t)(c * 64 + t) * DINP + CHF + h * 128 + 16 * dseg;
    const u32x4 w0 = *(const u32x4*)p, w1 = *(const u32x4*)(p + 8);
#pragma unroll
    for (int i = 0; i < 16; ++i) { const float z = i < 8 ? bfx(w0, i) : bfx(w1, i - 8); const float lb = LB[16 * dseg + i]; GB[t * 128 + 16 * dseg + i] = logf(lb + (1.0f - lb) * sigmoidf_(z)); }
    __syncthreads();
    if (tid < 128) { float a = 0.f;
#pragma unroll 8
        for (int tt = 0; tt < 64; ++tt) { a += GB[tt * 128 + tid]; GB[tt * 128 + tid] = a; } }
    __syncthreads();
}
__device__ __forceinline__ void hgrn_vt(LAS unsigned char* lds, const bf16_t* PROJ, int c, int h, int tid) {
    const int s2 = tid & 31, eg = tid >> 5;
    const bf16_t* p = PROJ + (size_t)(c * 64 + 2 * s2) * DINP + CHI + h * 128 + 8 * eg;
    const u32x4 a = *(const u32x4*)p, b = *(const u32x4*)(p + DINP);
#pragma unroll
    for (int i = 0; i < 8; ++i) { const unsigned lo = (i & 1) ? (a[i >> 1] >> 16) : (a[i >> 1] & 0xffffu), hi = (i & 1) ? (b[i >> 1] >> 16) : (b[i >> 1] & 0xffffu);
        *(LAS unsigned*)(lds + HG_VT + (8 * eg + i) * 144 + s2 * 4) = lo | (hi << 16); }
}
__device__ __forceinline__ void hgrn_l1(LAS unsigned char* lds, const bf16_t* PROJ, const float* lb_logits, float* ST, float* DC, int c, int h, int tid, int wave, int lane) {
    hgrn_cumsum(lds, PROJ, lb_logits, c, h, tid);
    const LAS float* GB = (const LAS float*)(lds + HG_GB); const LAS float* LB = (const LAS float*)(lds + HG_LB);
    {
        const int s2 = tid & 31, dg = tid >> 5;
        const bf16_t* p = PROJ + (size_t)(c * 64 + 2 * s2) * DINP + CHF + h * 128 + 8 * dg;
        const u32x4 a = *(const u32x4*)p, b = *(const u32x4*)(p + DINP);
#pragma unroll
        for (int i = 0; i < 8; ++i) { const int d = 8 * dg + i; const float lb = LB[d], b63 = GB[63 * 128 + d];
            const float k0 = (1.0f - lb) * (1.0f - sigmoidf_(bfx(a, i))), k1 = (1.0f - lb) * (1.0f - sigmoidf_(bfx(b, i)));
            const float v0 = k0 * __expf(b63 - GB[(2 * s2) * 128 + d]), v1 = k1 * __expf(b63 - GB[(2 * s2 + 1) * 128 + d]);
            *(LAS unsigned*)(lds + HG_Q1 + d * 144 + s2 * 4) = cvt_pk_bf16(v0, v1); }
    }
    hgrn_vt(lds, PROJ, c, h, tid);
    __syncthreads();
    const int fr = lane & 15, fq = lane >> 4;
    bf16x8 af[2];
#pragma unroll
    for (int ks = 0; ks < 2; ++ks) af[ks] = *(const LAS bf16x8*)(lds + HG_VT + (16 * wave + fr) * 144 + (32 * ks + 8 * fq) * 2);
    float* dst = ST + ((size_t)(c * 8 + h) * 128) * 128;
#pragma unroll 2
    for (int dt = 0; dt < 8; ++dt) {
        f32x4 acc = (f32x4){0.f, 0.f, 0.f, 0.f};
#pragma unroll
        for (int ks = 0; ks < 2; ++ks) { const bf16x8 bfr = *(const LAS bf16x8*)(lds + HG_Q1 + (16 * dt + fr) * 144 + (32 * ks + 8 * fq) * 2); acc = __builtin_amdgcn_mfma_f32_16x16x32_bf16(af[ks], bfr, acc, 0, 0, 0); }
#pragma unroll
        for (int r = 0; r < 4; ++r) dst[(size_t)(16 * wave + 4 * fq + r) * 128 + 16 * dt + fr] = acc[r];
    }
    if (tid < 128) DC[(size_t)(c * 8 + h) * 128 + tid] = __expf(GB[63 * 128 + tid]);
    __syncthreads();
}
__device__ __forceinline__ void hgrn_l3(LAS unsigned char* lds, const bf16_t* PROJ, const float* lb_logits, const float* ST, const float* norm_g, bf16_t* REC, int c, int h, int tid, int wave, int lane) {
    hgrn_cumsum(lds, PROJ, lb_logits, c, h, tid);
    const LAS float* GB = (const LAS float*)(lds + HG_GB); const LAS float* LB = (const LAS float*)(lds + HG_LB);
    {
        const int t = tid >> 3, dseg = tid & 7;
        const bf16_t* pf = PROJ + (size_t)(c * 64 + t) * DINP + CHF + h * 128 + 16 * dseg; const bf16_t* pq = pf - CHF + CHQ;
        const u32x4 f0 = *(const u32x4*)pf, f1 = *(const u32x4*)(pf + 8), q0 = *(const u32x4*)pq, q1 = *(const u32x4*)(pq + 8);
        unsigned o1[8], o2[8], o3[8];
#pragma unroll
        for (int i = 0; i < 16; i += 2) {
            float a1[2], a2[2], a3[2];
#pragma unroll
            for (int j = 0; j < 2; ++j) { const int d = 16 * dseg + i + j; const float lb = LB[d], b = GB[t * 128 + d], br = GB[31 * 128 + d];
                const float z = (i + j) < 8 ? bfx(f0, i + j) : bfx(f1, i + j - 8), qv = (i + j) < 8 ? bfx(q0, i + j) : bfx(q1, i + j - 8);
                const float k = (1.0f - lb) * (1.0f - sigmoidf_(z)), q = siluf_(qv);
                a1[j] = q * __expf(b); a2[j] = q * __expf(b - br); a3[j] = k * __expf(br - b); }
            o1[i >> 1] = cvt_pk_bf16(a1[0], a1[1]); o2[i >> 1] = cvt_pk_bf16(a2[0], a2[1]); o3[i >> 1] = cvt_pk_bf16(a3[0], a3[1]);
        }
        LAS u32x4* d1 = (LAS u32x4*)(lds + HG_Q1 + t * 272 + dseg * 32); LAS u32x4* d2 = (LAS u32x4*)(lds + HG_Q2 + t * 272 + dseg * 32); LAS u32x4* d3 = (LAS u32x4*)(lds + HG_K2 + t * 272 + dseg * 32);
        d1[0] = (u32x4){o1[0], o1[1], o1[2], o1[3]}; d1[1] = (u32x4){o1[4], o1[5], o1[6], o1[7]};
        d2[0] = (u32x4){o2[0], o2[1], o2[2], o2[3]}; d2[1] = (u32x4){o2[4], o2[5], o2[6], o2[7]};
        d3[0] = (u32x4){o3[0], o3[1], o3[2], o3[3]}; d3[1] = (u32x4){o3[4], o3[5], o3[6], o3[7]};
    }
    hgrn_vt(lds, PROJ, c, h, tid);
    __syncthreads();
    const int fr = lane & 15, fq = lane >> 4;
#pragma unroll
    for (int q = 0; q < 2; ++q) {
        const int tile = 2 * wave + q, tt = tile >> 2, stl = tile & 3;
        f32x4 acc = (f32x4){0.f, 0.f, 0.f, 0.f};
#pragma unroll
        for (int ks = 0; ks < 4; ++ks) { const bf16x8 a = *(const LAS bf16x8*)(lds + HG_Q2 + (16 * tt + fr) * 272 + (32 * ks + 8 * fq) * 2), b = *(const LAS bf16x8*)(lds + HG_K2 + (16 * stl + fr) * 272 + (32 * ks + 8 * fq) * 2);
            acc = __builtin_amdgcn_mfma_f32_16x16x32_bf16(a, b, acc, 0, 0, 0); }
#pragma unroll
        for (int r = 0; r < 4; ++r) { const int t = 16 * tt + 4 * fq + r, s = 16 * stl + fr; *(LAS bf16_t*)(lds + HG_PB + t * 144 + s * 2) = f2bf(s <= t ? acc[r] : 0.f); }
    }
    __syncthreads();
    {
        bf16x8 b1[2], b2[4];
#pragma unroll
        for (int ks = 0; ks < 2; ++ks) b1[ks] = *(const LAS bf16x8*)(lds + HG_VT + (16 * wave + fr) * 144 + (32 * ks + 8 * fq) * 2);
        const float* sp = ST + ((size_t)(c * 8 + h) * 128 + 16 * wave + fr) * 128 + 8 * fq;
#pragma unroll
        for (int ks = 0; ks < 4; ++ks) { const f32x4 x0 = *(const f32x4*)(sp + 32 * ks), x1 = *(const f32x4*)(sp + 32 * ks + 4);
            u32x4 w; w.x = cvt_pk_bf16(x0[0], x0[1]); w.y = cvt_pk_bf16(x0[2], x0[3]); w.z = cvt_pk_bf16(x1[0], x1[1]); w.w = cvt_pk_bf16(x1[2], x1[3]); b2[ks] = __builtin_bit_cast(bf16x8, w); }
        LAS float* OB = (LAS float*)(lds + HG_GB);
#pragma unroll
        for (int tt = 0; tt < 4; ++tt) {
            f32x4 acc = (f32x4){0.f, 0.f, 0.f, 0.f};
#pragma unroll
            for (int ks = 0; ks < 2; ++ks) { const bf16x8 a = *(const LAS bf16x8*)(lds + HG_PB + (16 * tt + fr) * 144 + (32 * ks + 8 * fq) * 2); acc = __builtin_amdgcn_mfma_f32_16x16x32_bf16(a, b1[ks], acc, 0, 0, 0); }
#pragma unroll
            for (int ks = 0; ks < 4; ++ks) { const bf16x8 a = *(const LAS bf16x8*)(lds + HG_Q1 + (16 * tt + fr) * 272 + (32 * ks + 8 * fq) * 2); acc = __builtin_amdgcn_mfma_f32_16x16x32_bf16(a, b2[ks], acc, 0, 0, 0); }
#pragma unroll
            for (int r = 0; r < 4; ++r) OB[(16 * tt + 4 * fq + r) * 132 + 16 * wave + fr] = acc[r];
        }
    }
    __syncthreads();
    {
        const int t = tid >> 3, es = tid & 7; const LAS float* OB = (const LAS float*)(lds + HG_GB);
        float o[16]; float ss = 0.f;
#pragma unroll
        for (int i = 0; i < 16; ++i) { o[i] = OB[t * 132 + 16 * es + i]; ss += o[i] * o[i]; }
        ss += __shfl_xor(ss, 1); ss += __shfl_xor(ss, 2); ss += __shfl_xor(ss, 4);
        const float rstd = rsqrtf(ss * (1.0f / 128.0f) + NORM_EPS);
        const bf16_t* pg = PROJ + (size_t)(c * 64 + t) * DINP + CHG + h * 128 + 16 * es;
        const u32x4 g0 = *(const u32x4*)pg, g1 = *(const u32x4*)(pg + 8);
        unsigned w[8];
#pragma unroll
        for (int i = 0; i < 16; i += 2) { const float ga = i < 8 ? bfx(g0, i) : bfx(g1, i - 8), gb = (i + 1) < 8 ? bfx(g0, i + 1) : bfx(g1, i + 1 - 8);
            w[i >> 1] = cvt_pk_bf16(o[i] * rstd * norm_g[16 * es + i] * siluf_(ga), o[i + 1] * rstd * norm_g[16 * es + i + 1] * siluf_(gb)); }
        u32x4* dst = (u32x4*)(REC + (size_t)(c * 64 + t) * 1024 + h * 128 + 16 * es);
        dst[0] = (u32x4){w[0], w[1], w[2], w[3]}; dst[1] = (u32x4){w[4], w[5], w[6], w[7]};
    }
    __syncthreads();
}

__device__ __forceinline__ void score_block(LAS unsigned char* lds, const bf16_t* PROJ, const bf16_t* KI, float* SCORES, int qb, int tid, int wave, int lane) {
    const int t0 = qb * 32, nkt = (t0 >> 7) + 1;
    const int r = lane & 31, hh = lane >> 5;
    bf16x8 Af[2][4]; float wv[2][16];
#pragma unroll
    for (int p = 0; p < 2; ++p) {
        const int tq = t0 + 4 * wave + 2 * p + (r >> 4); const bf16_t* qrow = PROJ + (size_t)tq * DINP + CQI + (r & 15) * 64 + 8 * hh;
#pragma unroll
        for (int ks = 0; ks < 4; ++ks) Af[p][ks] = *(const bf16x8*)(qrow + 16 * ks);
#pragma unroll
        for (int reg = 0; reg < 16; ++reg) { const int row = (reg & 3) + 8 * (reg >> 2) + 4 * hh; const int tw = t0 + 4 * wave + 2 * p + (row >> 4);
            wv[p][reg] = bf2f(PROJ[(size_t)tw * DINP + CWI + (row & 15)]) * (1.0f / 32.0f); }
    }
    const u32x2 tagsw = __builtin_amdgcn_permlane32_swap(0u, 1u, false, false); const int qsel = (int)tagsw[0];
    u32x4 stg[2];
#pragma unroll
    for (int i = 0; i < 2; ++i) { const int q = tid + 512 * i; stg[i] = *(const u32x4*)(KI + (size_t)(q >> 3) * 64 + (q & 7) * 8); }
#pragma unroll
    for (int i = 0; i < 2; ++i) { const int q = tid + 512 * i; *(LAS u32x4*)(lds + (q >> 3) * 144 + (q & 7) * 16) = stg[i]; }
    __syncthreads();
    for (int kt = 0; kt < nkt; ++kt) {
        const LAS unsigned char* buf = lds + (kt & 1) * 18432;
        if (kt + 1 < nkt) {
#pragma unroll
            for (int i = 0; i < 2; ++i) { const int q = tid + 512 * i; stg[i] = *(const u32x4*)(KI + (size_t)((kt + 1) * 128 + (q >> 3)) * 64 + (q & 7) * 8); }
        }
#pragma unroll 1
        for (int cb = 0; cb < 4; ++cb) {
            bf16x8 Bf[4];
#pragma unroll
            for (int ks = 0; ks < 4; ++ks) Bf[ks] = *(const LAS bf16x8*)(buf + (32 * cb + r) * 144 + (16 * ks + 8 * hh) * 2);
#pragma unroll
            for (int p = 0; p < 2; ++p) {
                f32x16 acc;
#pragma unroll
                for (int i = 0; i < 16; ++i) acc[i] = 0.f;
#pragma unroll
                for (int ks = 0; ks < 4; ++ks) acc = __builtin_amdgcn_mfma_f32_32x32x16_bf16(Af[p][ks], Bf[ks], acc, 0, 0, 0);
                float p0 = 0.f, p1 = 0.f;
#pragma unroll
                for (int reg = 0; reg < 8; ++reg) { p0 += wv[p][reg] * fmaxf(acc[reg], 0.f); p1 += wv[p][reg + 8] * fmaxf(acc[reg + 8], 0.f); }
                const u32x2 sw = __builtin_amdgcn_permlane32_swap(__float_as_uint(p0), __float_as_uint(p1), false, false);
                const float mine = __uint_as_float(sw[0]) + __uint_as_float(sw[1]);
                const int tq = t0 + 4 * wave + 2 * p + qsel;
                SCORES[(size_t)tq * S + kt * 128 + 32 * cb + r] = mine;
            }
        }
        if (kt + 1 < nkt) {
#pragma unroll
            for (int i = 0; i < 2; ++i) { const int q = tid + 512 * i; *(LAS u32x4*)(lds + ((kt + 1) & 1) * 18432 + (q >> 3) * 144 + (q & 7) * 16) = stg[i]; }
        }
        __syncthreads();
    }
}

__device__ __forceinline__ float wave_kth16(const float (&v)[16], int K) {
    const float NINF = -__builtin_inff();
    float mx = NINF, mn = __builtin_inff();
#pragma unroll
    for (int j = 0; j < 16; ++j) { mx = fmaxf(mx, v[j]); mn = fminf(mn, v[j] == NINF ? __builtin_inff() : v[j]); }
    mx = wave_max(mx); mn = -wave_max(-mn);
    int c = 0;
#pragma unroll
    for (int j = 0; j < 16; ++j) c += __popcll(__ballot(v[j] >= mx));
    if (c >= K) return mx;
    float lo = mn, hi = mx, tau = mn;
    for (int it = 0; it < 64; ++it) {
        const float mid = 0.5f * (lo + hi);
        if (!(mid > lo && mid < hi)) { tau = lo; break; }
        c = 0;
#pragma unroll
        for (int j = 0; j < 16; ++j) c += __popcll(__ballot(v[j] >= mid));
        if (c == K) { tau = mid; break; }
        if (c > K) lo = mid; else hi = mid;
        tau = lo;
    }
    return tau;
}
__device__ __forceinline__ int lanes_below(unsigned long long mask) { return (int)__builtin_amdgcn_mbcnt_hi((unsigned)(mask >> 32), __builtin_amdgcn_mbcnt_lo((unsigned)mask, 0u)); }
__device__ __forceinline__ void select_row(LAS unsigned char* wl, const float* SCORES, int t, int lane) {
    LAS int* selw = (LAS int*)wl; LAS float* cval = (LAS float*)(wl + 1024); LAS int* cidx = (LAS int*)(wl + 5120);
    const float NINF = -__builtin_inff();
    const float* row = SCORES + (size_t)t * S; const int n = t + 1;
    float c[16]; int N;
    if (n <= 1024) {
#pragma unroll
        for (int j = 0; j < 16; ++j) { const int i = lane + 64 * j; c[j] = i < n ? row[i] : NINF; }
        N = -1;
    } else {
        const int m = n >> 4; float s[16];
#pragma unroll
        for (int j = 0; j < 16; ++j) { const int i = lane + 64 * j; s[j] = i < m ? row[16 * i + 7] : NINF; }
        int K = 32, cnt = 0;
        for (;;) {
            const float tlo = (K >= m) ? NINF : wave_kth16(s, K);
            cnt = 0;
            const int nq = (n + 255) >> 8;
            for (int q0 = 0; q0 < nq; q0 += 4) {
                f32x4 v[4];
#pragma unroll
                for (int u = 0; u < 4; ++u) { const int e = 4 * (lane + 64 * (q0 + u)); v[u] = (e <= t) ? *(const f32x4*)(row + e) : (f32x4){NINF, NINF, NINF, NINF}; }
#pragma unroll
                for (int u = 0; u < 4; ++u) { const int e = 4 * (lane + 64 * (q0 + u));
#pragma unroll
                    for (int k = 0; k < 4; ++k) { const bool pred = (e + k <= t) && (v[u][k] >= tlo); const unsigned long long mask = __ballot(pred);
                        if (mask) { const int pos = cnt + lanes_below(mask); if (pred && pos < 1024) { cval[pos] = v[u][k]; cidx[pos] = e + k; } cnt += __popcll(mask); } } }
            }
            if (cnt >= 256 || K >= m) break;
            K *= 2;
        }
        N = cnt < 1024 ? cnt : 1024;
#pragma unroll
        for (int j = 0; j < 16; ++j) { const int i = lane + 64 * j; c[j] = i < N ? cval[i] : NINF; }
    }
    const float tau = wave_kth16(c, 256);
    int base = 0;
#pragma unroll
    for (int j = 0; j < 16; ++j) { const bool pred = c[j] >= tau; const unsigned long long mask = __ballot(pred);
        if (mask) { const int pos = base + lanes_below(mask); if (pred && pos < 256) selw[pos] = (N < 0) ? (lane + 64 * j) : cidx[lane + 64 * j]; base += __popcll(mask); } }
}

__device__ __forceinline__ void attn_query(LAS unsigned char* wl, const bf16_t* PROJ, const bf16_t* KC, const bf16_t* VC, bf16_t* ATT, int t, int lane) {
    LAS int* selw = (LAS int*)wl; LAS float* L = (LAS float*)(wl + 1024);
    const int nsel = t < 255 ? t + 1 : 256;
    const int fr = lane & 15, fq = lane >> 4;
    bf16x8 qf[2][4];
#pragma unroll
    for (int g = 0; g < 2; ++g)
#pragma unroll
        for (int ks = 0; ks < 4; ++ks) { const bf16x8 z = {0, 0, 0, 0, 0, 0, 0, 0}; qf[g][ks] = fr < 4 ? *(const bf16x8*)(PROJ + (size_t)t * DINP + CQ + (4 * g + fr) * 128 + 32 * ks + 8 * fq) : z; }
    const float scale = 0.08838834764831845f;
    const int nkt = (nsel + 15) >> 4;
    for (int kt = 0; kt < 16; ++kt) {
        if (kt < nkt) {
            const int key = selw[16 * kt + fr]; const bf16_t* kp = KC + (size_t)key * 256 + 8 * fq;
            bf16x8 kf[2][4];
#pragma unroll
            for (int g = 0; g < 2; ++g)
#pragma unroll
                for (int ks = 0; ks < 4; ++ks) kf[g][ks] = *(const bf16x8*)(kp + g * 128 + 32 * ks);
#pragma unroll
            for (int g = 0; g < 2; ++g) { f32x4 acc = (f32x4){0.f, 0.f, 0.f, 0.f};
#pragma unroll
                for (int ks = 0; ks < 4; ++ks) acc = __builtin_amdgcn_mfma_f32_16x16x32_bf16(qf[g][ks], kf[g][ks], acc, 0, 0, 0);
                if (fq == 0) {
#pragma unroll
                    for (int r = 0; r < 4; ++r) L[(4 * g + r) * 256 + 16 * kt + fr] = (16 * kt + fr < nsel) ? acc[r] * scale : -__builtin_inff(); } }
        } else if (fq == 0) {
#pragma unroll
            for (int r = 0; r < 8; ++r) L[r * 256 + 16 * kt + fr] = -__builtin_inff();
        }
    }
    float p[8][4];
#pragma unroll
    for (int hd = 0; hd < 8; ++hd) { float m = -__builtin_inff();
#pragma unroll
        for (int i = 0; i < 4; ++i) { p[hd][i] = L[hd * 256 + lane + 64 * i]; m = fmaxf(m, p[hd][i]); }
        m = wave_max(m); float s = 0.f;
#pragma unroll
        for (int i = 0; i < 4; ++i) { p[hd][i] = __expf(p[hd][i] - m); s += p[hd][i]; }
        s = 1.0f / wave_sum(s);
#pragma unroll
        for (int i = 0; i < 4; ++i) p[hd][i] *= s; }
#pragma unroll
    for (int i = 0; i < 4; ++i)
#pragma unroll
        for (int g = 0; g < 2; ++g) *(LAS f32x4*)(L + ((g * 256 + lane + 64 * i) * 4)) = (f32x4){p[4 * g][i], p[4 * g + 1][i], p[4 * g + 2][i], p[4 * g + 3][i]};
    const int gl = lane >> 5;
    float o[4][4];
#pragma unroll
    for (int hh = 0; hh < 4; ++hh)
#pragma unroll
        for (int d = 0; d < 4; ++d) o[hh][d] = 0.f;
    const int kend = (nsel + 3) & ~3;
    for (int kk = 0; kk < kend; kk += 4) {
        const i32x4 k4 = *(const LAS i32x4*)(selw + kk); const int ks4[4] = {k4[0], k4[1], k4[2], k4[3]};
        u32x2 vw[4];
#pragma unroll
        for (int u = 0; u < 4; ++u) { const int key = __builtin_amdgcn_readfirstlane(ks4[u]); vw[u] = *(const u32x2*)(VC + (size_t)key * 256 + 4 * lane); }
#pragma unroll
        for (int u = 0; u < 4; ++u) { const f32x4 p4 = *(const LAS f32x4*)(L + (gl * 256 + kk + u) * 4);
            const float v0 = bf_lo(vw[u].x), v1 = bf_hi(vw[u].x), v2 = bf_lo(vw[u].y), v3 = bf_hi(vw[u].y);
#pragma unroll
            for (int hh = 0; hh < 4; ++hh) { o[hh][0] += p4[hh] * v0; o[hh][1] += p4[hh] * v1; o[hh][2] += p4[hh] * v2; o[hh][3] += p4[hh] * v3; } }
    }
#pragma unroll
    for (int hh = 0; hh < 4; ++hh) { u32x2 w; w.x = cvt_pk_bf16(o[hh][0], o[hh][1]); w.y = cvt_pk_bf16(o[hh][2], o[hh][3]);
        *(u32x2*)(ATT + (size_t)t * 1024 + (4 * gl + hh) * 128 + 4 * (lane & 31)) = w; }
}

__device__ __forceinline__ void convert_item8(const float* __restrict__ W, int K, int N, unsigned char* WT, int mode, int item, int lane, LAS unsigned char* scr) {
    const int nblk = N >> 6; const int kb = item / nblk, nb = item - kb * nblk; const int k0 = kb * 128, n0 = nb * 64;
    const int c4 = lane & 15, kr = lane >> 4;
    const float* src = W + (size_t)(k0 + 4 * kr) * N + n0 + 4 * c4;
#pragma unroll 2
    for (int i = 0; i < 8; ++i) {
        f32x4 v[4];
#pragma unroll
        for (int r = 0; r < 4; ++r) v[r] = *(const f32x4*)(src + (size_t)(16 * i + r) * N);
        const int kk = 16 * i + 4 * kr;
#pragma unroll
        for (int e = 0; e < 4; ++e) *(LAS unsigned*)(scr + (4 * c4 + e) * 144 + kk) = pack4_fp8(v[0][e] * W8_SCALE, v[1][e] * W8_SCALE, v[2][e] * W8_SCALE, v[3][e] * W8_SCALE);
    }
    LDS_WAIT(); asm volatile("" ::: "memory");
#pragma unroll 4
    for (int j = 0; j < 8; ++j) {
        const int q = j * 64 + lane, n = q >> 3, ch = q & 7;
        const u32x4 v = *(const LAS u32x4*)(scr + n * 144 + ch * 16);
        *(u32x4*)(WT + (size_t)dest_row(mode, n0 + n) * K + k0 + ch * 16) = v;
    }
    LDS_WAIT(); asm volatile("" ::: "memory");
}

__global__ void __launch_bounds__(NTHR, 2) fwd_kernel(Args args) {
    extern __shared__ __attribute__((aligned(16))) unsigned char lds_raw[];
    LAS unsigned char* lds = (LAS unsigned char*)lds_raw;
    volatile LAS unsigned* MISC = (volatile LAS unsigned*)(lds + LDS_MISC);
    const int tid = threadIdx.x, lane = tid & 63, wave = __builtin_amdgcn_readfirstlane(tid >> 6);
    const int G = gridDim.x, wg = blockIdx.x;
    unsigned char* ws = args.ws;
    unsigned* ctl = (unsigned*)(ws + WS_CTL);
    const int lo = args.ph_lo, hi = args.ph_hi, flags = args.flags;
    const float* x = (const float*)args.in[0]; const float* cvec = (const float*)args.in[1]; const int* positions = (const int*)args.in[2];
    const float* w_ada = (const float*)args.in[3]; const float* b_ada = (const float*)args.in[4]; const float* norm1_g = (const float*)args.in[5];
    const float* w_in = (const float*)args.in[6]; const float* idx_knorm_g = (const float*)args.in[7]; const float* idx_knorm_b = (const float*)args.in[8];
    const float* lb_logits = (const float*)args.in[9]; const float* hgrn_norm_g = (const float*)args.in[10];
    const float* w_proj_att = (const float*)args.in[11]; const float* w_proj_hgrn = (const float*)args.in[12]; const float* w_out = (const float*)args.in[13];
    const float* norm2_g = (const float*)args.in[14]; const float* w_router = (const float*)args.in[15]; const float* b_router = (const float*)args.in[16];
    const float* w1 = (const float*)args.in[17]; const float* b1 = (const float*)args.in[18]; const float* w2 = (const float*)args.in[19]; const float* b2 = (const float*)args.in[20];
    const float* final_g = (const float*)args.in[21];
    float* out = args.out;
    float* MOD = (float*)(ws + WS_MOD); int* TOPE = (int*)(ws + WS_TOPE); float* GATE = (float*)(ws + WS_GATE); int* SLOT = (int*)(ws + WS_SLOT);
    bf16_t* WIN_T = (bf16_t*)(ws + WS_WIN_T); bf16_t* WA_T = (bf16_t*)(ws + WS_WA_T); bf16_t* WH_T = (bf16_t*)(ws + WS_WH_T); bf16_t* WO_T = (bf16_t*)(ws + WS_WO_T);
    unsigned char* W1_T = ws + WS_W1_T; unsigned char* W2_T = ws + WS_W2_T;
    bf16_t* HB = (bf16_t*)(ws + WS_H); bf16_t* PROJ = (bf16_t*)(ws + WS_PROJ);
    float* X1 = (float*)(ws + WS_X1);
    unsigned char* XB = ws + WS_XB; unsigned char* ACT = ws + WS_ACT; bf16_t* YB = (bf16_t*)(ws + WS_YB);
    unsigned char* H8 = ws + WS_H;
    bf16_t* KI = (bf16_t*)(ws + WS_KI); bf16_t* KC = (bf16_t*)(ws + WS_KC); bf16_t* VC = (bf16_t*)(ws + WS_VC);
    float* ST = (float*)(ws + WS_ST); float* DC = (float*)(ws + WS_DC); int* SEL = (int*)(ws + WS_SEL);
    bf16_t* ATT = (bf16_t*)(ws + WS_ATT); bf16_t* REC = (bf16_t*)(ws + WS_REC); bf16_t* MERGED = (bf16_t*)(ws + WS_MERGED); float* SCORES = (float*)(ws + WS_SCORES);

    for (int u = tid; u < 128; u += NTHR) MISC[u] = 0u;
    __syncthreads();
    const bool one_launch = (hi - lo) > 1;
    XcdBarrier bar; bar.bar = ctl + CW_BAR; bar.x = 0; bar.st = MISC + 8;
    if (one_launch) bar = xcd_barrier_post(ctl + CW_BAR, MISC + 8);
#define IN(k) (lo <= (k) && (k) < hi)
#define NREP(k) ((((MK_REP) >> (k)) & 1) + 1)
#define SEAM(k) do { if (IN(k) && IN((k) + 1)) xcd_barrier(bar); } while (0)

    const float* x1src = (flags & FLAG_MIXER) ? (const float*)X1 : x;

    if (IN(PH_PRO)) {
        if (wg < 192) {
            LAS float* red = (LAS float*)lds;
            const int col = wg * 64 + lane; float acc = 0.f;
            for (int k = wave; k < D; k += 64) {
                float wv[8], cv[8];
#pragma unroll
                for (int i = 0; i < 8; ++i) { wv[i] = w_ada[(size_t)(k + 8 * i) * (6 * D) + col]; cv[i] = cvec[k + 8 * i]; }
#pragma unroll
                for (int i = 0; i < 8; ++i) acc += siluf_(cv[i]) * wv[i];
            }
            red[wave * 64 + lane] = acc;
            __syncthreads();
            if (tid < 64) { float s = b_ada[col]; for (int w = 0; w < 8; ++w) s += red[w * 64 + tid]; MOD[col] = s; }
            __syncthreads();
        }
        LAS unsigned char* scr = lds + wave * 17408;
        const int gw = wg * NWAVES + wave, NGW = G * NWAVES;
        for (int rep = 0; rep < NREP(PH_PRO); ++rep) {
        if (flags & FLAG_MIXER) {
            constexpr int NB_IN = (DIN + 63) / 64;
            for (int it = gw; it < 16 * NB_IN; it += NGW) convert_item(w_in, 2048, DIN, WIN_T, 1, it, lane, scr);
            for (int it = gw; it < 8 * 32; it += NGW) convert_item(w_proj_att, 1024, 2048, WA_T, 0, it, lane, scr);
            for (int it = gw; it < 8 * 32; it += NGW) convert_item(w_proj_hgrn, 1024, 2048, WH_T, 0, it, lane, scr);
            for (int it = gw; it < 16 * 32; it += NGW) convert_item(w_out, 2048, 2048, WO_T, 0, it, lane, scr);
            for (size_t i = (size_t)wg * NTHR + tid; i < (size_t)176 * 2048 * 2 / 16; i += (size_t)G * NTHR) ((u32x4*)(WIN_T + (size_t)2640 * 2048))[i] = (u32x4){0u, 0u, 0u, 0u};
        }
        if (flags & FLAG_MOE) {
            constexpr int I1 = (2048 / 128) * (4096 / 64), I2 = (2048 / 128) * (2048 / 64);
            for (int it = gw; it < NEXP * I1; it += NGW) { const int e = it / I1, r = it - e * I1; convert_item8(w1 + (size_t)e * 2048 * 4096, 2048, 4096, W1_T + (size_t)e * 4096 * 2048, 2, r, lane, scr); }
            for (int it = gw; it < NEXP * I2; it += NGW) { const int e = it / I2, r = it - e * I2; convert_item8(w2 + (size_t)e * 2048 * 2048, 2048, 2048, W2_T + (size_t)e * 2048 * 2048, 0, r, lane, scr); }
        }
        }
    }
    SEAM(PH_PRO);

    if (flags & FLAG_MIXER) {
    if (IN(PH_H)) {
        const float* sh1 = MOD; const float* sc1 = MOD + D;
        const int gw = wg * NWAVES + wave, NGW = G * NWAVES;
        f32x4 gs[8], sh[8];
#pragma unroll
        for (int j = 0; j < 8; ++j) { const int c = 4 * lane + 256 * j; const f32x4 g = *(const f32x4*)(norm1_g + c), sc = *(const f32x4*)(sc1 + c); sh[j] = *(const f32x4*)(sh1 + c);
#pragma unroll
            for (int e = 0; e < 4; ++e) gs[j][e] = g[e] * (1.0f + sc[e]); }
        for (int t = gw; t < S; t += NGW) {
            const f32x4* xr = (const f32x4*)(x + (size_t)t * D) + lane;
            f32x4 v[8]; float ss = 0.f;
#pragma unroll
            for (int j = 0; j < 8; ++j) { v[j] = xr[64 * j]; ss += (v[j][0] * v[j][0] + v[j][1] * v[j][1]) + (v[j][2] * v[j][2] + v[j][3] * v[j][3]); }
            const float rstd = rsqrtf(wave_sum(ss) * (1.0f / D) + NORM_EPS);
#pragma unroll
            for (int j = 0; j < 8; ++j) { const f32x4 h = v[j] * rstd * gs[j] + sh[j]; u32x2 w; w.x = cvt_pk_bf16(h[0], h[1]); w.y = cvt_pk_bf16(h[2], h[3]);
                *(u32x2*)(HB + (size_t)t * D + 4 * lane + 256 * j) = w; }
        }
    }
    SEAM(PH_H);
    if (IN(PH_INPROJ)) for (int rep = 0; rep < NREP(PH_INPROJ); ++rep) {
        pg8::Gemm g{HB, WIN_T, 2048, 0}; pg8::StaticOrder So; So.init(S, DINP, G, wg);
        pg8::EpiBf16 E{PROJ, DINP, nullptr, 0, 1.0f};
        pg8::gemm_phase<pg8::EpiBf16, pg8::StaticOrder>(lds, g, So, E);
    }
    SEAM(PH_INPROJ);
    if (IN(PH_POST)) {
        const int gw = wg * NWAVES + wave, NGW = G * NWAVES;
        for (int t = gw; t < S; t += NGW) post_token(PROJ, KI, KC, VC, positions, idx_knorm_g, idx_knorm_b, t, lane);
        __syncthreads();
        for (int u = wg; u < 2048; u += G) hgrn_l1(lds, PROJ, lb_logits, ST, DC, u >> 3, u & 7, tid, wave, lane);
    }
    SEAM(PH_POST);
    if (IN(PH_SCORE)) {
        for (int idx = wg * NTHR + tid; idx < 8 * 128 * 128; idx += G * NTHR) {
            const int h = idx >> 14, d = idx & 127; float s = 0.f;
            float* sp = ST + idx; const float* dp = DC + h * 128 + d;
            for (int c = 0; c < 256; c += 8) {
                float l[8], dc[8];
#pragma unroll
                for (int i = 0; i < 8; ++i) { l[i] = sp[(size_t)(c + i) * 131072]; dc[i] = dp[(size_t)(c + i) * 1024]; }
#pragma unroll
                for (int i = 0; i < 8; ++i) { sp[(size_t)(c + i) * 131072] = s; s = dc[i] * s + l[i]; }
            }
        }
        if (flags & FLAG_ATT) for (int rep = 0; rep < NREP(PH_SCORE); ++rep) {
            for (int j = wg; j < 252; j += G) { score_block(lds, PROJ, KI, SCORES, 8 + j, tid, wave, lane); score_block(lds, PROJ, KI, SCORES, 511 - j, tid, wave, lane); }
        }
    }
    SEAM(PH_SCORE);
    if (IN(PH_SELECT)) {
        for (int u = wg; u < 2048; u += G) hgrn_l3(lds, PROJ, lb_logits, ST, hgrn_norm_g, REC, u >> 3, u & 7, tid, wave, lane);
    }
    SEAM(PH_SELECT);
    if (IN(PH_ATTN)) {
        const int gw = wg * NWAVES + wave, NGW = G * NWAVES;
        if (flags & FLAG_ATT) for (int rep = 0; rep < NREP(PH_ATTN); ++rep) {
            for (int t = gw; t < S; t += NGW) {
                LAS unsigned char* wl = lds + wave * 9216;
                if (t >= 256) select_row(wl, SCORES, t, lane);
                else {
#pragma unroll
                    for (int i = 0; i < 4; ++i) { const int idx = lane + 64 * i; ((LAS int*)wl)[idx] = idx <= t ? idx : 0; }
                }
                attn_query(wl, PROJ, KC, VC, ATT, t, lane);
            }
        } else {
            for (size_t i = (size_t)wg * NTHR + tid; i < (size_t)S * 1024 * 2 / 16; i += (size_t)G * NTHR) ((u32x4*)ATT)[i] = (u32x4){0u, 0u, 0u, 0u};
        }
    }
    SEAM(PH_ATTN);
    if (IN(PH_OP1)) {
        pg8::Gemm g{ATT, WA_T, 1024, 0}; pg8::StaticOrder So; So.init(S, 2048, G, wg);
        pg8::EpiGate E{MERGED, PROJ + CGA, 0};
        pg8::gemm_phase<pg8::EpiGate, pg8::StaticOrder>(lds, g, So, E);
    }
    SEAM(PH_OP1);
    if (IN(PH_OP2)) {
        pg8::Gemm g{REC, WH_T, 1024, 0}; pg8::StaticOrder So; So.init(S, 2048, G, wg);
        pg8::EpiGate E{MERGED, PROJ + CGR, 1};
        pg8::gemm_phase<pg8::EpiGate, pg8::StaticOrder>(lds, g, So, E);
    }
    SEAM(PH_OP2);
    if (IN(PH_WOUT)) {
        pg8::Gemm g{MERGED, WO_T, 2048, 0}; pg8::StaticOrder So; So.init(S, 2048, G, wg);
        pg8::EpiResid E{x, MOD + 2 * D, X1};
        pg8::gemm_phase<pg8::EpiResid, pg8::StaticOrder>(lds, g, So, E);
    }
    SEAM(PH_WOUT);
    }

    if (IN(PH_ROUTER) && (flags & FLAG_MOE)) {
        LAS float* hs = (LAS float*)lds;
        volatile LAS unsigned* lcnt = MISC + 32;
        const float* sh2 = MOD + 3 * D; const float* sc2 = MOD + 4 * D;
        if (tid < 32) lcnt[tid] = 0u;
        __syncthreads();
        for (int grp = wg; grp < S / 16; grp += G) {
#pragma unroll 1
            for (int q = 0; q < 2; ++q) {
                const int tl = 2 * wave + q, t = grp * 16 + tl;
                const f32x4* xr = (const f32x4*)(x1src + (size_t)t * D) + lane;
                f32x4 v[8]; float ss = 0.f;
#pragma unroll
                for (int j = 0; j < 8; ++j) { v[j] = xr[64 * j]; ss += (v[j][0] * v[j][0] + v[j][1] * v[j][1]) + (v[j][2] * v[j][2] + v[j][3] * v[j][3]); }
                const float rstd = rsqrtf(wave_sum(ss) * (1.0f / D) + NORM_EPS);
#pragma unroll
                for (int j = 0; j < 8; ++j) {
                    const int c = 4 * lane + 256 * j;
                    const f32x4 g = *(const f32x4*)(norm2_g + c), sc = *(const f32x4*)(sc2 + c), sh = *(const f32x4*)(sh2 + c);
                    f32x4 h;
#pragma unroll
                    for (int e = 0; e < 4; ++e) h[e] = v[j][e] * rstd * g[e] * (1.0f + sc[e]) + sh[e];
                    *(LAS f32x4*)(hs + tl * 2048 + c) = h;
                    *(unsigned*)(H8 + (size_t)t * D + c) = pack4_fp8(h[0], h[1], h[2], h[3]);
                }
            }
            __syncthreads();
            {
                const int tl = tid >> 5, e = tid & 31, t = grp * 16 + tl;
                float a0 = 0.f, a1 = 0.f, a2 = 0.f, a3 = 0.f;
                const LAS float* hrow = hs + tl * 2048; const float* wr = w_router + e;
#pragma unroll 4
                for (int c = 0; c < D; c += 4) {
                    const f32x4 hv = *(const LAS f32x4*)(hrow + c);
                    a0 += hv[0] * wr[(size_t)(c + 0) * 32]; a1 += hv[1] * wr[(size_t)(c + 1) * 32]; a2 += hv[2] * wr[(size_t)(c + 2) * 32]; a3 += hv[3] * wr[(size_t)(c + 3) * 32];
                }
                float v = ((a0 + a1) + (a2 + a3)) + b_router[e];
                float tv[4]; int ti[4];
#pragma unroll
                for (int k = 0; k < 4; ++k) {
                    float bv = v; int bi = e;
#pragma unroll
                    for (int o = 16; o >= 1; o >>= 1) { const float ov = __shfl_xor(bv, o); const int oi = __shfl_xor(bi, o); if (ov > bv || (ov == bv && oi < bi)) { bv = ov; bi = oi; } }
                    tv[k] = bv; ti[k] = bi; if (e == bi) v = -__builtin_inff();
                }
                if (e == 0) {
                    const float e1 = __expf(tv[1] - tv[0]), e2 = __expf(tv[2] - tv[0]), e3 = __expf(tv[3] - tv[0]); const float inv = 1.0f / (1.0f + e1 + e2 + e3);
                    *(int4*)(TOPE + (size_t)t * 4) = make_int4(ti[0], ti[1], ti[2], ti[3]);
                    *(f32x4*)(GATE + (size_t)t * 4) = (f32x4){inv, e1 * inv, e2 * inv, e3 * inv};
#pragma unroll
                    for (int k = 0; k < 4; ++k) __hip_atomic_fetch_add((LAS unsigned*)&lcnt[ti[k]], 1u, __ATOMIC_RELAXED, __HIP_MEMORY_SCOPE_WORKGROUP);
                }
            }
            __syncthreads();
        }
        if (tid < 32) { const unsigned c = lcnt[tid]; if (c) __hip_atomic_fetch_add(ctl + CW_CNT + tid, c, __ATOMIC_RELAXED, __HIP_MEMORY_SCOPE_AGENT); }
    }
    SEAM(PH_ROUTER);

    if (IN(PH_SCATTER) && (flags & FLAG_MOE)) {
        volatile LAS unsigned* lcnt = MISC + 32; volatile LAS unsigned* lbase = MISC + 64; LAS int* pstart = (LAS int*)(lds + 1024); LAS int* slot_l = (LAS int*)(lds + 2048);
        if (tid == 0) { int p = 0; for (int e = 0; e < NEXP; ++e) { pstart[e] = p; p += (int)((__hip_atomic_load(ctl + CW_CNT + e, __ATOMIC_RELAXED, __HIP_MEMORY_SCOPE_AGENT) + 255u) & ~255u); } }
        if (tid < 32) lcnt[tid] = 0u;
        __syncthreads();
        for (int blk = wg; blk < S / 64; blk += G) {
            int e = 0, lrank = 0;
            if (tid < 256) { e = TOPE[(size_t)blk * 256 + tid]; lrank = (int)__hip_atomic_fetch_add((LAS unsigned*)&lcnt[e], 1u, __ATOMIC_RELAXED, __HIP_MEMORY_SCOPE_WORKGROUP); }
            __syncthreads();
            if (tid < 32) { const unsigned c = lcnt[tid]; lbase[tid] = c ? __hip_atomic_fetch_add(ctl + CW_FILL + tid, c, __ATOMIC_RELAXED, __HIP_MEMORY_SCOPE_AGENT) : 0u; }
            __syncthreads();
            if (tid < 256) { const int slot = pstart[e] + (int)lbase[e] + lrank; SLOT[(size_t)blk * 256 + tid] = slot; slot_l[tid] = slot; }
            __syncthreads();
            for (int a = wave; a < 256; a += NWAVES) {
                const int t = blk * 64 + (a >> 2), slot = slot_l[a];
                const u32x4* src = (const u32x4*)(H8 + (size_t)t * D) + lane; u32x4* dst = (u32x4*)(XB + (size_t)slot * D) + lane;
#pragma unroll
                for (int j = 0; j < 2; ++j) dst[64 * j] = src[64 * j];
            }
            if (tid < 32) lcnt[tid] = 0u;
            __syncthreads();
        }
    }
    SEAM(PH_SCATTER);

    if ((IN(PH_MOE1) || IN(PH_MOE2)) && (flags & FLAG_MOE)) {
        LAS int* panel_e = (LAS int*)(lds + 131072 + 2048);
        LAS int* npan = (LAS int*)(lds + 131072 + 2048 + 2048);
        __syncthreads();
        if (tid == 0) { int p = 0; for (int e = 0; e < NEXP; ++e) { const int np = (int)((__hip_atomic_load(ctl + CW_CNT + e, __ATOMIC_RELAXED, __HIP_MEMORY_SCOPE_AGENT) + 255u) >> 8); for (int q = 0; q < np; ++q) panel_e[p + q] = e; p += np; } npan[0] = p; }
        __syncthreads();
        const int nPanels = npan[0];
        if (IN(PH_MOE1)) for (int rep = 0; rep < NREP(PH_MOE1); ++rep) {
            pg8::Gemm g{XB, W1_T, 2048, (size_t)4096 * 2048}; pg8::MoeOrder So; So.init(nPanels, 16, G, wg, panel_e);
            pg8::EpiSwiglu E{ACT, b1};
            pg8::gemm_phase<pg8::EpiSwiglu, pg8::MoeOrder, true>(lds, g, So, E);
        }
        SEAM(PH_MOE1);
        if (IN(PH_MOE2)) for (int rep = 0; rep < NREP(PH_MOE2); ++rep) {
            pg8::Gemm g{ACT, W2_T, 2048, (size_t)2048 * 2048}; pg8::MoeOrder So; So.init(nPanels, 8, G, wg, panel_e);
            pg8::EpiBf16 E{YB, 2048, b2, 2048, 1.0f / (W8_SCALE * ACT8_SCALE)};
            pg8::gemm_phase<pg8::EpiBf16, pg8::MoeOrder, true>(lds, g, So, E);
        }
    }
    SEAM(PH_MOE2);

    if (IN(PH_FINAL)) {
        const float* gt2 = MOD + 5 * D;
        const int gw = wg * NWAVES + wave, NGW = G * NWAVES;
        for (int t = gw; t < S; t += NGW) {
            const f32x4* xr = (const f32x4*)(x1src + (size_t)t * D) + lane;
            f32x4 v[8];
#pragma unroll
            for (int j = 0; j < 8; ++j) v[j] = xr[64 * j];
            if (flags & FLAG_MOE) {
                f32x4 m[8];
#pragma unroll
                for (int j = 0; j < 8; ++j) m[j] = (f32x4){0.f, 0.f, 0.f, 0.f};
                const int4 sl = *(const int4*)(SLOT + (size_t)t * 4); const f32x4 gt = *(const f32x4*)(GATE + (size_t)t * 4);
                const int sls[4] = {sl.x, sl.y, sl.z, sl.w};
#pragma unroll
                for (int k = 0; k < 4; ++k) {
                    const u32x2* yr = (const u32x2*)(YB + (size_t)sls[k] * D) + lane; const float gk = gt[k];
#pragma unroll
                    for (int j = 0; j < 8; ++j) { const u32x2 w = yr[64 * j]; m[j][0] += gk * bf_lo(w.x); m[j][1] += gk * bf_hi(w.x); m[j][2] += gk * bf_lo(w.y); m[j][3] += gk * bf_hi(w.y); }
                }
#pragma unroll
                for (int j = 0; j < 8; ++j) { const f32x4 g2 = *(const f32x4*)(gt2 + 4 * lane + 256 * j); v[j] = v[j] + g2 * m[j]; }
            }
            float ss = 0.f;
#pragma unroll
            for (int j = 0; j < 8; ++j) ss += (v[j][0] * v[j][0] + v[j][1] * v[j][1]) + (v[j][2] * v[j][2] + v[j][3] * v[j][3]);
            const float rstd = rsqrtf(wave_sum(ss) * (1.0f / D) + NORM_EPS);
            f32x4* orow = (f32x4*)(out + (size_t)t * D) + lane;
#pragma unroll
            for (int j = 0; j < 8; ++j) { const f32x4 fg = *(const f32x4*)(final_g + 4 * lane + 256 * j); orow[64 * j] = v[j] * rstd * fg; }
        }
    }
#undef IN
#undef SEAM
}

#ifndef MK_ONE_LAUNCH
#define MK_ONE_LAUNCH 1
#endif
#ifndef MK_FLAGS
#define MK_FLAGS (FLAG_MOE | FLAG_MIXER | FLAG_ATT)
#endif
extern "C" void kernel_launch(void* const* d_in, const int* in_sizes, int n_in, void* d_out, int out_size, void* d_ws, size_t ws_size, hipStream_t stream) {
    static int grid = 0;
    if (grid == 0) {
        if (n_in != 22 || out_size != S * D || ws_size < WS_END) { fprintf(stderr, "kernel_launch: unexpected shapes: n_in %d out %d ws %zu (need %zu)\n", n_in, out_size, ws_size, (size_t)WS_END); grid = -1; return; }
        int dev = 0, cus = 0, per_cu = 0;
        if (hipGetDevice(&dev) != hipSuccess || hipDeviceGetAttribute(&cus, hipDeviceAttributeMultiprocessorCount, dev) != hipSuccess) { grid = -1; return; }
        if (hipFuncSetAttribute((const void*)fwd_kernel, hipFuncAttributeMaxDynamicSharedMemorySize, LDS_BYTES) != hipSuccess) { fprintf(stderr, "kernel_launch: hipFuncSetAttribute failed\n"); grid = -1; return; }
        if (hipOccupancyMaxActiveBlocksPerMultiprocessor(&per_cu, (const void*)fwd_kernel, NTHR, LDS_BYTES) != hipSuccess || per_cu < 1) { fprintf(stderr, "kernel_launch: occupancy query says %d\n", per_cu); (void)hipGetLastError(); grid = -1; return; }
        grid = cus;
    }
    if (grid < 0) return;
    (void)in_sizes;
    hipMemsetAsync((char*)d_ws + WS_CTL, 0, CTL_BYTES, stream);
    Args a{};
    for (int i = 0; i < 22; ++i) a.in[i] = d_in[i];
    a.out = (float*)d_out; a.ws = (unsigned char*)d_ws; a.flags = MK_FLAGS; a.pad = 0;
#if MK_ONE_LAUNCH
    a.ph_lo = 0; a.ph_hi = NPH;
    hipLaunchKernelGGL(fwd_kernel, dim3(grid), dim3(NTHR), LDS_BYTES, stream, a);
#else
    for (int p = 0; p < NPH; ++p) { a.ph_lo = p; a.ph_hi = p + 1; hipLaunchKernelGGL(fwd_kernel, dim3(grid), dim3(NTHR), LDS_BYTES, stream, a); }
#endif
}
```

```cpp
#include <hip/hip_runtime.h>
#include <cstdio>
#include <cstdint>

#define GAS __attribute__((address_space(1)))
#define LAS __attribute__((address_space(3)))
typedef unsigned short bf16_t;
typedef short bf16x8 __attribute__((ext_vector_type(8)));
typedef float f32x4 __attribute__((ext_vector_type(4)));
typedef float f32x2 __attribute__((ext_vector_type(2)));
typedef float f32x16 __attribute__((ext_vector_type(16)));
typedef unsigned u32x4 __attribute__((ext_vector_type(4)));
typedef unsigned u32x2 __attribute__((ext_vector_type(2)));
typedef int i32x4 __attribute__((ext_vector_type(4)));
typedef int i32x8 __attribute__((ext_vector_type(8)));

constexpr int S = 16384, D = 2048, DIN = 10832, DINP = 11008, NEXP = 32, DFF = 2048;
constexpr int NWAVES = 8, NTHR = 512;
constexpr int CQ = 0, CK = 1024, CV = 1280, CQI = 1536, CKI = 2560, CWI = 2624, CHQ = 2816, CHF = 3840, CHI = 4864, CHG = 5888, CGA = 6912, CGR = 8960;
constexpr int PMAX = 65536 + NEXP * 256;
constexpr float NORM_EPS = 1e-5f;

constexpr size_t MiB = 1u << 20;
constexpr size_t al256(size_t x) { return (x + 255) & ~(size_t)255; }
constexpr size_t WS_CTL = 0, CTL_BYTES = 1 * MiB;
constexpr size_t WS_MOD = WS_CTL + CTL_BYTES;
constexpr size_t WS_TOPE = WS_MOD + 64 * 1024;
constexpr size_t WS_GATE = WS_TOPE + (size_t)S * 16;
constexpr size_t WS_SLOT = WS_GATE + (size_t)S * 16;
constexpr size_t WS_WIN_T = WS_SLOT + (size_t)S * 16;
constexpr size_t WS_WA_T = WS_WIN_T + (size_t)DINP * D * 2;
constexpr size_t WS_WH_T = WS_WA_T + (size_t)2048 * 1024 * 2;
constexpr size_t WS_WO_T = WS_WH_T + (size_t)2048 * 1024 * 2;
constexpr size_t WS_W1_T = WS_WO_T + (size_t)2048 * 2048 * 2;
constexpr size_t WS_W2_T = WS_W1_T + (size_t)NEXP * 4096 * 2048 * 2;
constexpr size_t WS_H = WS_W2_T + (size_t)NEXP * 2048 * 2048 * 2;
constexpr size_t WS_PROJ = WS_H + (size_t)S * D * 2;
constexpr size_t WS_KI = WS_PROJ + (size_t)S * DINP * 2;
constexpr size_t WS_KC = WS_KI + (size_t)S * 64 * 2;
constexpr size_t WS_VC = WS_KC + (size_t)S * 256 * 2;
constexpr size_t WS_ST = WS_VC + (size_t)S * 256 * 2;
constexpr size_t WS_DC = WS_ST + (size_t)256 * 8 * 128 * 128 * 4;
constexpr size_t WS_SEL = WS_DC + (size_t)256 * 8 * 128 * 4;
constexpr size_t WS_ATT = WS_SEL + (size_t)S * 256 * 4;
constexpr size_t WS_REC = WS_ATT + (size_t)S * 1024 * 2;
constexpr size_t WS_MERGED = WS_REC + (size_t)S * 1024 * 2;
constexpr size_t WS_X1 = WS_MERGED + (size_t)S * 2048 * 2;
constexpr size_t WS_SCORES = WS_X1 + (size_t)S * 2048 * 4;
constexpr size_t WS_XB = WS_SCORES;
constexpr size_t WS_ACT = WS_XB + (size_t)PMAX * 2048 * 2;
constexpr size_t WS_YB = WS_ACT + (size_t)PMAX * 2048 * 2;
constexpr size_t WS_END = WS_SCORES + (size_t)S * S * 4;
static_assert(WS_YB + (size_t)PMAX * 2048 * 2 <= WS_END, "MoE buffers overlay the score matrix");
static_assert(WS_END <= (size_t)4096 * MiB, "workspace");
constexpr int CW_BAR = 4096, CW_CNT = 8192, CW_FILL = 8448;
constexpr size_t WS_TOKS = WS_SEL;

constexpr int LDS_BYTES = 155648;
constexpr int LDS_MISC = LDS_BYTES - 512;

__device__ __forceinline__ unsigned cvt_pk_bf16(float lo, float hi) { unsigned r; asm volatile("v_cvt_pk_bf16_f32 %0, %1, %2" : "=v"(r) : "v"(lo), "v"(hi)); return r; }
__device__ __forceinline__ float bf_lo(unsigned u) { return __uint_as_float(u << 16); }
__device__ __forceinline__ float bf_hi(unsigned u) { return __uint_as_float(u & 0xffff0000u); }
__device__ __forceinline__ float bf2f(bf16_t b) { return __uint_as_float(((unsigned)b) << 16); }
__device__ __forceinline__ float wave_sum(float v) {
#pragma unroll
    for (int o = 1; o < 64; o <<= 1) v += __shfl_xor(v, o);
    return v;
}
__device__ __forceinline__ float wave_max(float v) {
#pragma unroll
    for (int o = 1; o < 64; o <<= 1) v = fmaxf(v, __shfl_xor(v, o));
    return v;
}
__device__ __forceinline__ float sigmoidf_(float x) { return __builtin_amdgcn_rcpf(1.0f + __expf(-x)); }
__device__ __forceinline__ float siluf_(float x) { return x * __builtin_amdgcn_rcpf(1.0f + __expf(-x)); }
__device__ __forceinline__ unsigned pack4_fp8(float a, float b, float c, float d) { int w = 0; w = __builtin_amdgcn_cvt_pk_fp8_f32(a, b, w, false); w = __builtin_amdgcn_cvt_pk_fp8_f32(c, d, w, true); return (unsigned)w; }
constexpr float W8_SCALE = 64.0f, ACT8_SCALE = 4.0f;
__device__ __forceinline__ float relu_i(float x) { const int i = __float_as_int(x); return __int_as_float(i > 0 ? i : 0); }
#define LDS_WAIT() asm volatile("s_waitcnt lgkmcnt(0)" ::: "memory")
#define VM_WAIT() asm volatile("s_waitcnt vmcnt(0)" ::: "memory")

#define XB_TMO      128
#define XB_XCNT(j)  (256  + 64 * (j))
#define XB_XSUB(j)  (1280 + 64 * (j))
#define XB_XGEN(j)  (2304 + 64 * (j))
#define XB_TOP      3328
#define XB_TOPGEN   3392
#define XCD_BAR_WORDS 3456
#define XB_SPIN_CAP (1u << 22)

__device__ __forceinline__ unsigned xb_ld(unsigned* p)              { return __hip_atomic_load(p, __ATOMIC_RELAXED, __HIP_MEMORY_SCOPE_AGENT); }
__device__ __forceinline__ unsigned xb_add(unsigned* p, unsigned v) { return __hip_atomic_fetch_add(p, v, __ATOMIC_RELAXED, __HIP_MEMORY_SCOPE_AGENT); }
__device__ __forceinline__ unsigned xb_xcc_id() { return (unsigned)__builtin_amdgcn_s_getreg((3 << 11) | 20) & 0xFu; }
#define XB_SPIN(cond, bar) do { unsigned _sp = 0; while (cond) { __builtin_amdgcn_s_sleep(1); \
    if ((++_sp & 255u) == 0u) { if (xb_ld(&(bar)[XB_TMO])) break; if (_sp > XB_SPIN_CAP) { atomicAdd(&(bar)[XB_TMO], 1u); break; } } } } while (0)

struct XcdBarrier { unsigned* bar; unsigned x; volatile LAS unsigned* st; };

__device__ __forceinline__ XcdBarrier xcd_barrier_post(unsigned* bar, volatile LAS unsigned* st) {
    XcdBarrier b; b.bar = bar; b.x = xb_xcc_id(); b.st = st;
    if (threadIdx.x == 0) (void)xb_add(&bar[XB_XCNT(b.x)], 1u);
    return b;
}
__device__ __forceinline__ void xcd_barrier_complete(unsigned* bar, unsigned x, unsigned& nloc, unsigned& nx) {
    const unsigned G = gridDim.x * gridDim.y * gridDim.z;
    unsigned sum, cnt, mine, sp = 0u;
    for (;;) {
        sum = 0u; cnt = 0u; mine = 0u;
#pragma unroll
        for (unsigned j = 0; j < 16; ++j) { const unsigned c = xb_ld(&bar[XB_XCNT(j)]); sum += c; cnt += (c > 0u) ? 1u : 0u; mine = (j == x) ? c : mine; }
        if (sum == G) break;
        __builtin_amdgcn_s_sleep(1);
        if ((++sp & 255u) == 0u) { if (xb_ld(&bar[XB_TMO])) break; if (sp > XB_SPIN_CAP) { atomicAdd(&bar[XB_TMO], 1u); break; } }
    }
    nloc = mine > 0u ? mine : 1u; nx = cnt > 0u ? cnt : 1u;
}
__device__ __forceinline__ void xcd_barrier(const XcdBarrier& b) {
    asm volatile("s_waitcnt vmcnt(0)" ::: "memory");
    __syncthreads();
    if (threadIdx.x == 0) {
        unsigned* bar = b.bar;
        __builtin_amdgcn_s_waitcnt(0);
        unsigned nloc = b.st[0], nx = b.st[1];
        if (nloc == 0u) { xcd_barrier_complete(bar, b.x, nloc, nx); b.st[0] = nloc; b.st[1] = nx; }
        const unsigned old = xb_add(&bar[XB_XSUB(b.x)], 1u);
        const unsigned gen = old / nloc;
        if (old + 1u == (gen + 1u) * nloc) {
            __builtin_amdgcn_fence(__ATOMIC_RELEASE, "agent");
            asm volatile("s_waitcnt vmcnt(0)" ::: "memory");
            const unsigned og = xb_add(&bar[XB_TOP], 1u);
            const unsigned tg = og / nx;
            if (og + 1u == (tg + 1u) * nx) xb_add(&bar[XB_TOPGEN], 1u);
            else XB_SPIN(xb_ld(&bar[XB_TOPGEN]) == tg, bar);
            __builtin_amdgcn_fence(__ATOMIC_ACQUIRE, "agent");
            xb_add(&bar[XB_XGEN(b.x)], 1u);
            asm volatile("s_waitcnt vmcnt(0)" ::: "memory");
        } else {
            XB_SPIN(xb_ld(&bar[XB_XGEN(b.x)]) == gen, bar);
            __builtin_amdgcn_fence(__ATOMIC_ACQUIRE, "agent");
            asm volatile("s_waitcnt vmcnt(0)" ::: "memory");
        }
    }
    __syncthreads();
}

namespace pg8 {
constexpr int BM = 256, BK = 64, HALF = 128, HTB = HALF * BK * 2, STAGE_BYTES = 8 * HTB, NXCD = 8, WGM = 8;
__host__ __device__ __forceinline__ int lds_byte(int r, int c) { const int st = (r >> 4) * 2 + (c >> 5), rr = r & 15, cc = c & 31, ob = rr * 64 + cc * 2; return st * 1024 + (ob ^ (((ob >> 9) & 1) << 5)); }
__host__ __device__ __forceinline__ void stage_rc(int b, int& R, int& C) { const int st = b / 1024, sb = b % 1024, swz = sb ^ (((sb >> 9) & 1) << 5); R = (st >> 1) * 16 + swz / 64; C = (st & 1) * 32 + (swz % 64) / 2; }
__host__ __device__ __forceinline__ int perm32(int rho) { const int n = rho >> 4, i = rho & 15; return 8 * (i >> 2) + 4 * n + (i & 3); }

struct Unit { int pm, pn, e; };
struct Gemm { const void* A; const void* Bt; int K; size_t estride; const int* arow; };

struct StaticOrder {
    int nM, nN, nwg, G, c, i;
    __device__ void init(int M, int N, int G_, int c_) { nM = M / BM; nN = N / BM; nwg = nM * nN; G = G_; c = c_; i = 0; }
    __device__ bool next(Unit& u) {
        const long L = (long)i * G + c; ++i; if (L >= nwg) return false;
        int wgid = (int)L; { const int q = nwg / NXCD, r = nwg % NXCD, xcd = wgid % NXCD, off = wgid / NXCD; wgid = (xcd < r ? xcd * (q + 1) : r * (q + 1) + (xcd - r) * q) + off; }
        const int nig = WGM * nN, gid = wgid / nig, fm = gid * WGM, gsz = (nM - fm) < WGM ? (nM - fm) : WGM;
        u.pm = fm + ((wgid % nig) % gsz); u.pn = (wgid % nig) / gsz; u.e = 0; return true;
    }
};
struct MoeOrder {
    int nPanels, nN, G, c, i; const LAS int* panel_e;
    __device__ void init(int nPanels_, int nN_, int G_, int c_, const LAS int* pe) { nPanels = nPanels_; nN = nN_; G = G_; c = c_; i = 0; panel_e = pe; }
    __device__ bool next(Unit& u) {
        const int PB = 256 / nN;
        const int nblk = (nPanels + PB - 1) / PB;
        for (;;) {
            const long L = (long)i * G + c; ++i;
            const int blk = (int)(L >> 8), r = (int)(L & 255), x = r & 7, j = r >> 3;
            if (blk >= nblk) return false;
            int pm, pn;
            if (nN == 16) { pm = blk * 16 + 4 * (x >> 1) + (j & 3); pn = 8 * (x & 1) + (j >> 2); }
            else          { pm = blk * 32 + 4 * x + (j & 3);        pn = j >> 2; }
            if (pm < nPanels) { u.pm = pm; u.pn = pn; u.e = panel_e[pm]; return true; }
        }
    }
};

template <class Epi, class Sched, bool FP8 = false>
__device__ __forceinline__ void gemm_phase(LAS unsigned char* lds, const Gemm g, Sched& S, const Epi& E) {
    const int tid = threadIdx.x, wid = __builtin_amdgcn_readfirstlane(tid >> 6), lane = tid & 63, wr = wid >> 2, wc = wid & 3, fr = lane & 15, fq = lane >> 4;
    const int K = g.K; const int pitch = FP8 ? K : 2 * K; const int nt = pitch / 128;
    unsigned voffA[2], voffB[2];
#pragma unroll
    for (int i = 0; i < 2; ++i) { int R, C; stage_rc(tid * 16 + i * 8192, R, C); const int Rb = Epi::PERM ? ((R & ~31) + perm32(R & 31)) : R;
        voffA[i] = (unsigned)(R * pitch + C * 2); voffB[i] = (unsigned)(Rb * pitch + C * 2); }
    const size_t kstep = (size_t)(BK * 2);
    const size_t hstep = (size_t)HALF * pitch;
    const size_t tstep = 2 * hstep;
    int RA[2], CA[2];
#pragma unroll
    for (int i = 0; i < 2; ++i) stage_rc(tid * 16 + i * 8192, RA[i], CA[i]);
    const bool gather = g.arow != nullptr;
    const size_t hsA = gather ? 0 : hstep;
    unsigned vA0[2] = {voffA[0], voffA[1]}, vA1[2] = {voffA[0], voffA[1]}, nA0[2] = {voffA[0], voffA[1]}, nA1[2] = {voffA[0], voffA[1]};
#define PG8_AOFF(dst0, dst1, u) do { if (gather) { _Pragma("unroll") for (int i = 0; i < 2; ++i) { \
        dst0[i] = (unsigned)g.arow[(u).pm * 256 + RA[i]] * (unsigned)pitch + (unsigned)(CA[i] * 2); dst1[i] = (unsigned)g.arow[(u).pm * 256 + 128 + RA[i]] * (unsigned)pitch + (unsigned)(CA[i] * 2); } } } while (0)
    const unsigned ldsw = (unsigned)wid * 1024u;
    const int aoff = lds_byte(wr * 64 + fr, fq * 8), boff = lds_byte(wc * 32 + fr, fq * 8);
#define PG8_SA(b, h) (((b) * 2 + (h)) * HTB)
#define PG8_SB(b, h) ((4 + (b) * 2 + (h)) * HTB)
#define PG8_STAGE(bufoff, gbase, voff) do { _Pragma("unroll") for (int _i = 0; _i < 2; ++_i) \
        __builtin_amdgcn_global_load_lds((const unsigned*)((const char*)(gbase) + (voff)[_i]), (LAS unsigned*)(lds + (bufoff) + ldsw + _i * 8192), 16, 0, 0); } while (0)
#define PG8_LD8(p) __builtin_shufflevector(*(const LAS i32x4*)(p), *(const LAS i32x4*)((p) + 1024), 0, 1, 2, 3, 4, 5, 6, 7)
#define PG8_LDA(dst, b, h) do { _Pragma("unroll") for (int m = 0; m < 4; ++m) { if constexpr (FP8) dst##8[m] = PG8_LD8(lds + PG8_SA(b, h) + aoff + m * 2048); \
        else { _Pragma("unroll") for (int k = 0; k < 2; ++k) dst[m][k] = *(const LAS bf16x8*)(lds + PG8_SA(b, h) + aoff + m * 2048 + k * 1024); } } } while (0)
#define PG8_LDB(dst, b, h) do { _Pragma("unroll") for (int n = 0; n < 2; ++n) { if constexpr (FP8) dst##8[n] = PG8_LD8(lds + PG8_SB(b, h) + boff + n * 2048); \
        else { _Pragma("unroll") for (int k = 0; k < 2; ++k) dst[n][k] = *(const LAS bf16x8*)(lds + PG8_SB(b, h) + boff + n * 2048 + k * 1024); } } } while (0)
#define PG8_MMA(ai, bj, At, Bt) do { __builtin_amdgcn_s_setprio(1); _Pragma("unroll") for (int m = 0; m < 4; ++m) _Pragma("unroll") for (int n = 0; n < 2; ++n) { \
        if constexpr (FP8) asm volatile("v_mfma_scale_f32_16x16x128_f8f6f4 %0, %1, %2, %0, %3, %3 op_sel_hi:[0,0,0]" : "+v"(acc[ai][bj][m][n]) : "v"(Bt##8[n]), "v"(At##8[m]), "v"(scl1)); \
        else { _Pragma("unroll") for (int k = 0; k < 2; ++k) acc[ai][bj][m][n] = __builtin_amdgcn_mfma_f32_16x16x32_bf16(Bt[n][k], At[m][k], acc[ai][bj][m][n], 0, 0, 0); } } \
        __builtin_amdgcn_s_setprio(0); } while (0)
#define PG8_WAIT_V(n) asm volatile("s_waitcnt vmcnt(" #n ")" ::: "memory")
#define PG8_WAIT_L(n) asm volatile("s_waitcnt lgkmcnt(" #n ")" ::: "memory")
#define PG8_BAR __builtin_amdgcn_s_barrier()
#define PG8_SCHED __builtin_amdgcn_sched_barrier(0)
    Unit cur, nxt;
    if (!S.next(cur)) return;
    const unsigned scl1 = 0x7f7f7f7fu;
    f32x4 acc[2][2][4][2];
#pragma unroll
    for (int a = 0; a < 2; ++a)
#pragma unroll
        for (int b = 0; b < 2; ++b)
#pragma unroll
            for (int m = 0; m < 4; ++m)
#pragma unroll
                for (int n = 0; n < 2; ++n) acc[a][b][m][n] = (f32x4){0.f, 0.f, 0.f, 0.f};
    bf16x8 At[4][2], B0[2][2], B1[2][2]; i32x8 At8[4], B08[2], B18[2];
    const char* cA = (const char*)g.A + (gather ? (size_t)0 : (size_t)cur.pm * tstep); const char* cB = (const char*)g.Bt + (size_t)cur.e * g.estride + (size_t)cur.pn * tstep;
    PG8_AOFF(vA0, vA1, cur);
    PG8_STAGE(PG8_SB(0, 0), cB, voffB); PG8_STAGE(PG8_SB(0, 1), cB + hstep, voffB); PG8_STAGE(PG8_SA(0, 0), cA, vA0); PG8_STAGE(PG8_SA(0, 1), cA + hsA, vA1);
    if (wr == 1) PG8_BAR;
    PG8_WAIT_V(2); PG8_BAR;
    PG8_STAGE(PG8_SB(1, 0), cB + kstep, voffB); PG8_STAGE(PG8_SA(1, 0), cA + kstep, vA0); PG8_STAGE(PG8_SB(1, 1), cB + hstep + kstep, voffB);
    PG8_WAIT_V(6); PG8_BAR;
    for (;;) {
        const bool has_next = S.next(nxt);
        const char* nA = has_next ? (const char*)g.A + (gather ? (size_t)0 : (size_t)nxt.pm * tstep) : cA;
        if (has_next) PG8_AOFF(nA0, nA1, nxt);
        const char* nB = has_next ? (const char*)g.Bt + (size_t)nxt.e * g.estride + (size_t)nxt.pn * tstep : cB;
        for (int t = 0; t < nt; t += 2) {
            const bool last = (t == nt - 2);
            const char* a1 = cA + (size_t)(t + 1) * kstep;
            const char* a2 = last ? nA : cA + (size_t)(t + 2) * kstep; const char* b2 = last ? nB : cB + (size_t)(t + 2) * kstep;
            const char* a3 = a2 + kstep; const char* b3 = b2 + kstep;
            PG8_LDB(B0, 0, 0); PG8_LDB(B1, 0, 1); PG8_SCHED; PG8_LDA(At, 0, 0); PG8_STAGE(PG8_SA(1, 1), a1 + hsA, vA1);
            if (last && has_next) { vA0[0] = nA0[0]; vA0[1] = nA0[1]; vA1[0] = nA1[0]; vA1[1] = nA1[1]; }
            PG8_WAIT_V(8); PG8_WAIT_L(0); PG8_BAR; PG8_MMA(0, 0, At, B0); PG8_MMA(0, 1, At, B1); PG8_BAR; PG8_SCHED;
            PG8_LDA(At, 0, 1); PG8_STAGE(PG8_SB(0, 0), b2, voffB); PG8_STAGE(PG8_SB(0, 1), b2 + hstep, voffB); PG8_STAGE(PG8_SA(0, 0), a2, vA0);
            PG8_WAIT_V(8); PG8_WAIT_L(0); PG8_BAR; PG8_MMA(1, 0, At, B0); PG8_MMA(1, 1, At, B1); PG8_BAR; PG8_SCHED;
            PG8_LDB(B0, 1, 0); PG8_LDB(B1, 1, 1); PG8_SCHED; PG8_LDA(At, 1, 0); PG8_STAGE(PG8_SA(0, 1), a2 + hsA, vA1);
            PG8_WAIT_V(8); PG8_WAIT_L(0); PG8_BAR; PG8_MMA(0, 0, At, B0); PG8_MMA(0, 1, At, B1); PG8_BAR; PG8_SCHED;
            PG8_LDA(At, 1, 1); PG8_STAGE(PG8_SB(1, 0), b3, voffB); PG8_STAGE(PG8_SB(1, 1), b3 + hstep, voffB); PG8_STAGE(PG8_SA(1, 0), a3, vA0);
            PG8_WAIT_V(8); PG8_WAIT_L(0); PG8_BAR; PG8_MMA(1, 0, At, B0); PG8_MMA(1, 1, At, B1); PG8_BAR; PG8_SCHED;
        }
        if (wr == 0) PG8_BAR;
        if constexpr (FP8) {
#pragma unroll
            for (int a = 0; a < 2; ++a)
#pragma unroll
                for (int b = 0; b < 2; ++b) asm volatile("s_nop 15" : "+v"(acc[a][b][0][0]), "+v"(acc[a][b][0][1]), "+v"(acc[a][b][1][0]), "+v"(acc[a][b][1][1]), "+v"(acc[a][b][2][0]), "+v"(acc[a][b][2][1]), "+v"(acc[a][b][3][0]), "+v"(acc[a][b][3][1]));
        }
        E(acc, cur, wr, wc, fr, fq);
        if (!has_next) break;
#pragma unroll
        for (int a = 0; a < 2; ++a)
#pragma unroll
            for (int b = 0; b < 2; ++b)
#pragma unroll
                for (int m = 0; m < 4; ++m)
#pragma unroll
                    for (int n = 0; n < 2; ++n) acc[a][b][m][n] = (f32x4){0.f, 0.f, 0.f, 0.f};
        cur = nxt; cA = nA; cB = nB;
        if (wr == 1) PG8_BAR;
    }
    PG8_WAIT_V(0);
    PG8_BAR;
#undef PG8_AOFF
#undef PG8_SA
#undef PG8_SB
#undef PG8_STAGE
#undef PG8_LDA
#undef PG8_LDB
#undef PG8_MMA
#undef PG8_LD8
#undef PG8_WAIT_V
#undef PG8_WAIT_L
#undef PG8_BAR
#undef PG8_SCHED
}

struct EpiBf16 {
    static constexpr bool PERM = true;
    bf16_t* O; int ldc; const float* bias; int bias_estride; float ascale;
    __device__ __forceinline__ void operator()(const f32x4 (&acc)[2][2][4][2], const Unit& u, int wr, int wc, int fr, int fq) const {
        const int row0 = u.pm * BM + wr * 64 + fr; const int col0 = u.pn * BM + wc * 32 + 8 * fq;
        f32x4 bv[2][2];
#pragma unroll
        for (int bj = 0; bj < 2; ++bj)
#pragma unroll
            for (int n = 0; n < 2; ++n) bv[bj][n] = bias ? *(const f32x4*)(bias + (size_t)u.e * bias_estride + col0 + bj * HALF + 4 * n) : (f32x4){0.f, 0.f, 0.f, 0.f};
#pragma unroll
        for (int ai = 0; ai < 2; ++ai)
#pragma unroll
            for (int m = 0; m < 4; ++m) { bf16_t* rowp = O + (size_t)(row0 + ai * HALF + m * 16) * ldc + col0;
#pragma unroll
                for (int bj = 0; bj < 2; ++bj) { const f32x4 v0 = acc[ai][bj][m][0] * ascale + bv[bj][0], v1 = acc[ai][bj][m][1] * ascale + bv[bj][1];
                    u32x4 w; w.x = cvt_pk_bf16(v0[0], v0[1]); w.y = cvt_pk_bf16(v0[2], v0[3]); w.z = cvt_pk_bf16(v1[0], v1[1]); w.w = cvt_pk_bf16(v1[2], v1[3]);
                    *(u32x4*)(rowp + bj * HALF) = w; } }
    }
};
__device__ __forceinline__ float swiglu1(float ug, float ul) {
    ug = fminf(ug, 7.0f); ul = fminf(fmaxf(ul, -7.0f), 7.0f);
    return ug * __builtin_amdgcn_rcpf(1.0f + __expf(-1.702f * ug)) * (ul + 1.0f);
}
struct EpiSwiglu {
    static constexpr bool PERM = true;
    unsigned char* O; const float* b1;
    __device__ __forceinline__ void operator()(const f32x4 (&acc)[2][2][4][2], const Unit& u, int wr, int wc, int fr, int fq) const {
        const int row0 = u.pm * BM + wr * 64 + fr; const int c0 = u.pn * 128 + wc * 32 + 8 * fq;
        const float* bg = b1 + (size_t)u.e * 4096 + c0; const float* bl = bg + 2048;
        f32x4 bgv[2], blv[2];
#pragma unroll
        for (int n = 0; n < 2; ++n) { bgv[n] = *(const f32x4*)(bg + 4 * n); blv[n] = *(const f32x4*)(bl + 4 * n); }
#pragma unroll
        for (int ai = 0; ai < 2; ++ai)
#pragma unroll
            for (int m = 0; m < 4; ++m) {
                float a[8];
#pragma unroll
                for (int n = 0; n < 2; ++n)
#pragma unroll
                    for (int j = 0; j < 4; ++j) a[4 * n + j] = ACT8_SCALE * swiglu1(acc[ai][0][m][n][j] * (1.0f / W8_SCALE) + bgv[n][j], acc[ai][1][m][n][j] * (1.0f / W8_SCALE) + blv[n][j]);
                u32x2 w; w.x = pack4_fp8(a[0], a[1], a[2], a[3]); w.y = pack4_fp8(a[4], a[5], a[6], a[7]);
                *(u32x2*)(O + (size_t)(row0 + ai * HALF + m * 16) * 2048 + c0) = w;
            }
    }
};

struct EpiGate {
    static constexpr bool PERM = true;
    bf16_t* O; const bf16_t* Gt; int accum;
    __device__ __forceinline__ void operator()(const f32x4 (&acc)[2][2][4][2], const Unit& u, int wr, int wc, int fr, int fq) const {
        const int row0 = u.pm * BM + wr * 64 + fr; const int col0 = u.pn * BM + wc * 32 + 8 * fq;
#pragma unroll
        for (int ai = 0; ai < 2; ++ai)
#pragma unroll
            for (int m = 0; m < 4; ++m) { const size_t row = (size_t)(row0 + ai * HALF + m * 16);
#pragma unroll
                for (int bj = 0; bj < 2; ++bj) { const int c = col0 + bj * HALF;
                    const u32x4 gw = *(const u32x4*)(Gt + row * DINP + c);
                    float r[8];
#pragma unroll
                    for (int q = 0; q < 4; ++q) { r[2 * q] = sigmoidf_(bf_lo(gw[q])) * acc[ai][bj][m][q >> 1][(2 * q) & 3]; r[2 * q + 1] = sigmoidf_(bf_hi(gw[q])) * acc[ai][bj][m][q >> 1][(2 * q + 1) & 3]; }
                    bf16_t* op = O + row * 2048 + c;
                    if (accum) { const u32x4 ow = *(const u32x4*)op;
#pragma unroll
                        for (int q = 0; q < 4; ++q) { r[2 * q] += bf_lo(ow[q]); r[2 * q + 1] += bf_hi(ow[q]); } }
                    u32x4 w; w.x = cvt_pk_bf16(r[0], r[1]); w.y = cvt_pk_bf16(r[2], r[3]); w.z = cvt_pk_bf16(r[4], r[5]); w.w = cvt_pk_bf16(r[6], r[7]);
                    *(u32x4*)op = w; } }
    }
};
struct EpiResid {
    static constexpr bool PERM = false;
    const float* x; const float* gt; float* X1;
    __device__ __forceinline__ void operator()(const f32x4 (&acc)[2][2][4][2], const Unit& u, int wr, int wc, int fr, int fq) const {
        const int row0 = u.pm * BM + wr * 64 + fr; const int col0 = u.pn * BM + wc * 32 + 4 * fq;
#pragma unroll
        for (int ai = 0; ai < 2; ++ai)
#pragma unroll
            for (int m = 0; m < 4; ++m) { const size_t row = (size_t)(row0 + ai * HALF + m * 16);
#pragma unroll
                for (int bj = 0; bj < 2; ++bj)
#pragma unroll
                    for (int n = 0; n < 2; ++n) { const int c = col0 + bj * HALF + n * 16;
                        const f32x4 xv = *(const f32x4*)(x + row * 2048 + c), g = *(const f32x4*)(gt + c);
                        *(f32x4*)(X1 + row * 2048 + c) = xv + g * acc[ai][bj][m][n]; } }
    }
};
}

#ifndef MK_REP
#define MK_REP 0
#endif
#ifndef MK_REP2
#define MK_REP2 0
#endif
struct Args { const void* in[22]; float* out; unsigned char* ws; int ph_lo, ph_hi, flags, pad; };
enum { PH_PRO = 0, PH_H, PH_INPROJ, PH_POST, PH_SCORE, PH_SELECT, PH_ATTN, PH_OP1, PH_OP2, PH_WOUT, PH_ROUTER, PH_SCATTER, PH_MOE1, PH_MOE2, PH_FINAL, NPH };
constexpr int FLAG_MIXER = 1, FLAG_ATT = 2, FLAG_MOE = 4;

__device__ __forceinline__ int dest_row(int mode, int n) {
    if (mode == 1) return n < 2640 ? n : n + 176;
    if (mode == 2) { const int g = n >> 11, c = n & 2047; return (c >> 7) * 256 + g * 128 + (c & 127); }
    return n;
}
__device__ __forceinline__ void convert_item(const float* __restrict__ W, int K, int N, bf16_t* WT, int mode, int item, int lane, LAS unsigned char* scr) {
    const int nblk = (N + 63) >> 6; const int kb = item / nblk, nb = item - kb * nblk; const int k0 = kb * 128, n0 = nb * 64;
    const int c4 = lane & 15, kr = lane >> 4;
    const bool ok = (n0 + 4 * c4) < N;
    const float* src = W + (size_t)(k0 + 2 * kr) * N + n0 + 4 * c4;
#pragma unroll 4
    for (int i = 0; i < 16; ++i) {
        f32x4 v0 = (f32x4){0.f, 0.f, 0.f, 0.f}, v1 = v0;
        if (ok) { v0 = *(const f32x4*)(src + (size_t)(8 * i) * N); v1 = *(const f32x4*)(src + (size_t)(8 * i + 1) * N); }
        const int kk = 8 * i + 2 * kr;
#pragma unroll
        for (int e = 0; e < 4; ++e) *(LAS unsigned*)(scr + (4 * c4 + e) * 272 + kk * 2) = cvt_pk_bf16(v0[e], v1[e]);
    }
    LDS_WAIT(); asm volatile("" ::: "memory");
#pragma unroll 4
    for (int j = 0; j < 16; ++j) {
        const int q = j * 64 + lane, n = q >> 4, ch = q & 15;
        const u32x4 v = *(const LAS u32x4*)(scr + n * 272 + ch * 16);
        if (n0 + n < N) *(u32x4*)(WT + (size_t)dest_row(mode, n0 + n) * K + k0 + ch * 8) = v;
    }
    LDS_WAIT(); asm volatile("" ::: "memory");
}


__device__ __forceinline__ bf16_t f2bf(float f) { unsigned u = __float_as_uint(f); return (bf16_t)((u + 0x7fffu + ((u >> 16) & 1u)) >> 16); }
__device__ __forceinline__ float bfx(const u32x4& w, int i) { const unsigned u = w[i >> 1]; return (i & 1) ? bf_hi(u) : bf_lo(u); }
__device__ __forceinline__ void rope_sc(float pos, float inv, float& sn, float& cs) {
    const float ang = pos * inv;
    const double a = (double)ang; const double n = __builtin_rint(a * 0.15915494309189535); const float r = (float)(a - n * 6.283185307179586);
    sn = sinf(r); cs = cosf(r);
}
__device__ __forceinline__ void post_token(bf16_t* PROJ, bf16_t* KI, bf16_t* KC, bf16_t* VC, const int* positions, const float* kng, const float* knb, int t, int lane) {
    const float pos = (float)positions[t];
    bf16_t* row = PROJ + (size_t)t * DINP;
    float sn, cs;
#pragma unroll
    for (int i = 0; i < 2; ++i) {
        const int pp = lane + 64 * i, hd = pp >> 4, ii = pp & 15;
        rope_sc(pos, powf(500000.0f, -(float)ii * (1.0f / 16.0f)), sn, cs);
        bf16_t* p = row + CQ + hd * 128 + ii; const float a = bf2f(p[0]), b = bf2f(p[16]);
        p[0] = f2bf(a * cs - b * sn); p[16] = f2bf(b * cs + a * sn);
    }
#pragma unroll
    for (int i = 0; i < 2; ++i) {
        const int pp = lane + 64 * i, hd = pp >> 3, ii = pp & 7;
        rope_sc(pos, powf(500000.0f, -(float)ii * (1.0f / 8.0f)), sn, cs);
        bf16_t* p = row + CQI + hd * 64 + ii; const float a = bf2f(p[0]), b = bf2f(p[8]);
        p[0] = f2bf(a * cs - b * sn); p[8] = f2bf(b * cs + a * sn);
    }
    if (lane < 32) {
        const int g = lane >> 4, ii = lane & 15;
        rope_sc(pos, powf(500000.0f, -(float)ii * (1.0f / 16.0f)), sn, cs);
        const bf16_t* p = row + CK + g * 128 + ii; const float a = bf2f(p[0]), b = bf2f(p[16]);
        bf16_t* o = KC + (size_t)t * 256 + g * 128 + ii; o[0] = f2bf(a * cs - b * sn); o[16] = f2bf(b * cs + a * sn);
    }
#pragma unroll
    for (int i = 0; i < 3; ++i) { const int idx = lane + 64 * i, g = idx / 96, r = idx - g * 96; KC[(size_t)t * 256 + g * 128 + 32 + r] = row[CK + g * 128 + 32 + r]; }
    *(u32x2*)(VC + (size_t)t * 256 + 4 * lane) = *(const u32x2*)(row + CV + 4 * lane);
    {
        const float v = bf2f(row[CKI + lane]);
        const float mean = wave_sum(v) * (1.0f / 64.0f); const float d = v - mean; const float var = wave_sum(d * d) * (1.0f / 64.0f);
        const float y = d * rsqrtf(var + NORM_EPS) * kng[lane] + knb[lane];
        const float other = __shfl_xor(y, 8);
        rope_sc(pos, powf(500000.0f, -(float)(lane & 7) * (1.0f / 8.0f)), sn, cs);
        float o = y;
        if (lane < 8) o = y * cs - other * sn; else if (lane < 16) o = y * cs + other * sn;
        KI[(size_t)t * 64 + lane] = f2bf(o);
    }
}

constexpr int HG_GB = 0, HG_Q1 = 33792, HG_Q2 = 51200, HG_K2 = 68608, HG_VT = 86016, HG_PB = 104448, HG_LB = 113664;
__device__ __forceinline__ void hgrn_cumsum(LAS unsigned char* lds, const bf16_t* PROJ, const float* lb_logits, int c, int h, int tid) {
    LAS float* GB = (LAS float*)(lds + HG_GB); LAS float* LB = (LAS float*)(lds + HG_LB);
    if (tid < 128) { const float l0 = lb_logits[h * 128 + tid], l1 = lb_logits[1024 + h * 128 + tid]; LB[tid] = 1.0f / (1.0f + expf(l1 - l0)); }
    __syncthreads();
    const int t = tid >> 3, dseg = tid & 7;
    const bf16_t* p = PROJ + (size_t)(c * 64 + t) * DINP + CHF + h * 128 + 16 * dseg;
    const u32x4 w0 = *(const u32x4*)p, w1 = *(const u32x4*)(p + 8);
#pragma unroll
    for (int i = 0; i < 16; ++i) { const float z = i < 8 ? bfx(w0, i) : bfx(w1, i - 8); const float lb = LB[16 * dseg + i]; GB[t * 128 + 16 * dseg + i] = logf(lb + (1.0f - lb) * sigmoidf_(z)); }
    __syncthreads();
    if (tid < 128) { float a = 0.f;
#pragma unroll 8
        for (int tt = 0; tt < 64; ++tt) { a += GB[tt * 128 + tid]; GB[tt * 128 + tid] = a; } }
    __syncthreads();
}
__device__ __forceinline__ void hgrn_vt(LAS unsigned char* lds, const bf16_t* PROJ, int c, int h, int tid) {
    const int s2 = tid & 31, eg = tid >> 5;
    const bf16_t* p = PROJ + (size_t)(c * 64 + 2 * s2) * DINP + CHI + h * 128 + 8 * eg;
    const u32x4 a = *(const u32x4*)p, b = *(const u32x4*)(p + DINP);
#pragma unroll
    for (int i = 0; i < 8; ++i) { const unsigned lo = (i & 1) ? (a[i >> 1] >> 16) : (a[i >> 1] & 0xffffu), hi = (i & 1) ? (b[i >> 1] >> 16) : (b[i >> 1] & 0xffffu);
        *(LAS unsigned*)(lds + HG_VT + (8 * eg + i) * 144 + s2 * 4) = lo | (hi << 16); }
}
__device__ __forceinline__ void hgrn_l1(LAS unsigned char* lds, const bf16_t* PROJ, const float* lb_logits, float* ST, float* DC, int c, int h, int tid, int wave, int lane) {
    hgrn_cumsum(lds, PROJ, lb_logits, c, h, tid);
    const LAS float* GB = (const LAS float*)(lds + HG_GB); const LAS float* LB = (const LAS float*)(lds + HG_LB);
    {
        const int s2 = tid & 31, dg = tid >> 5;
        const bf16_t* p = PROJ + (size_t)(c * 64 + 2 * s2) * DINP + CHF + h * 128 + 8 * dg;
        const u32x4 a = *(const u32x4*)p, b = *(const u32x4*)(p + DINP);
#pragma unroll
        for (int i = 0; i < 8; ++i) { const int d = 8 * dg + i; const float lb = LB[d], b63 = GB[63 * 128 + d];
            const float k0 = (1.0f - lb) * (1.0f - sigmoidf_(bfx(a, i))), k1 = (1.0f - lb) * (1.0f - sigmoidf_(bfx(b, i)));
            const float v0 = k0 * __expf(b63 - GB[(2 * s2) * 128 + d]), v1 = k1 * __expf(b63 - GB[(2 * s2 + 1) * 128 + d]);
            *(LAS unsigned*)(lds + HG_Q1 + d * 144 + s2 * 4) = cvt_pk_bf16(v0, v1); }
    }
    hgrn_vt(lds, PROJ, c, h, tid);
    __syncthreads();
    const int fr = lane & 15, fq = lane >> 4;
    bf16x8 af[2];
#pragma unroll
    for (int ks = 0; ks < 2; ++ks) af[ks] = *(const LAS bf16x8*)(lds + HG_VT + (16 * wave + fr) * 144 + (32 * ks + 8 * fq) * 2);
    float* dst = ST + ((size_t)(c * 8 + h) * 128) * 128;
#pragma unroll 2
    for (int dt = 0; dt < 8; ++dt) {
        f32x4 acc = (f32x4){0.f, 0.f, 0.f, 0.f};
#pragma unroll
        for (int ks = 0; ks < 2; ++ks) { const bf16x8 bfr = *(const LAS bf16x8*)(lds + HG_Q1 + (16 * dt + fr) * 144 + (32 * ks + 8 * fq) * 2); acc = __builtin_amdgcn_mfma_f32_16x16x32_bf16(af[ks], bfr, acc, 0, 0, 0); }
#pragma unroll
        for (int r = 0; r < 4; ++r) dst[(size_t)(16 * wave + 4 * fq + r) * 128 + 16 * dt + fr] = acc[r];
    }
    if (tid < 128) DC[(size_t)(c * 8 + h) * 128 + tid] = __expf(GB[63 * 128 + tid]);
    __syncthreads();
}
__device__ __forceinline__ void hgrn_l3(LAS unsigned char* lds, const bf16_t* PROJ, const float* lb_logits, const float* ST, const float* norm_g, bf16_t* REC, int c, int h, int tid, int wave, int lane) {
    hgrn_cumsum(lds, PROJ, lb_logits, c, h, tid);
    const LAS float* GB = (const LAS float*)(lds + HG_GB); const LAS float* LB = (const LAS float*)(lds + HG_LB);
    {
        const int t = tid >> 3, dseg = tid & 7;
        const bf16_t* pf = PROJ + (size_t)(c * 64 + t) * DINP + CHF + h * 128 + 16 * dseg; const bf16_t* pq = pf - CHF + CHQ;
        const u32x4 f0 = *(const u32x4*)pf, f1 = *(const u32x4*)(pf + 8), q0 = *(const u32x4*)pq, q1 = *(const u32x4*)(pq + 8);
        unsigned o1[8], o2[8], o3[8];
#pragma unroll
        for (int i = 0; i < 16; i += 2) {
            float a1[2], a2[2], a3[2];
#pragma unroll
            for (int j = 0; j < 2; ++j) { const int d = 16 * dseg + i + j; const float lb = LB[d], b = GB[t * 128 + d], br = GB[31 * 128 + d];
                const float z = (i + j) < 8 ? bfx(f0, i + j) : bfx(f1, i + j - 8), qv = (i + j) < 8 ? bfx(q0, i + j) : bfx(q1, i + j - 8);
                const float k = (1.0f - lb) * (1.0f - sigmoidf_(z)), q = siluf_(qv);
                a1[j] = q * __expf(b); a2[j] = q * __expf(b - br); a3[j] = k * __expf(br - b); }
            o1[i >> 1] = cvt_pk_bf16(a1[0], a1[1]); o2[i >> 1] = cvt_pk_bf16(a2[0], a2[1]); o3[i >> 1] = cvt_pk_bf16(a3[0], a3[1]);
        }
        LAS u32x4* d1 = (LAS u32x4*)(lds + HG_Q1 + t * 272 + dseg * 32); LAS u32x4* d2 = (LAS u32x4*)(lds + HG_Q2 + t * 272 + dseg * 32); LAS u32x4* d3 = (LAS u32x4*)(lds + HG_K2 + t * 272 + dseg * 32);
        d1[0] = (u32x4){o1[0], o1[1], o1[2], o1[3]}; d1[1] = (u32x4){o1[4], o1[5], o1[6], o1[7]};
        d2[0] = (u32x4){o2[0], o2[1], o2[2], o2[3]}; d2[1] = (u32x4){o2[4], o2[5], o2[6], o2[7]};
        d3[0] = (u32x4){o3[0], o3[1], o3[2], o3[3]}; d3[1] = (u32x4){o3[4], o3[5], o3[6], o3[7]};
    }
    hgrn_vt(lds, PROJ, c, h, tid);
    __syncthreads();
    const int fr = lane & 15, fq = lane >> 4;
#pragma unroll
    for (int q = 0; q < 2; ++q) {
        const int tile = 2 * wave + q, tt = tile >> 2, stl = tile & 3;
        f32x4 acc = (f32x4){0.f, 0.f, 0.f, 0.f};
#pragma unroll
        for (int ks = 0; ks < 4; ++ks) { const bf16x8 a = *(const LAS bf16x8*)(lds + HG_Q2 + (16 * tt + fr) * 272 + (32 * ks + 8 * fq) * 2), b = *(const LAS bf16x8*)(lds + HG_K2 + (16 * stl + fr) * 272 + (32 * ks + 8 * fq) * 2);
            acc = __builtin_amdgcn_mfma_f32_16x16x32_bf16(a, b, acc, 0, 0, 0); }
#pragma unroll
        for (int r = 0; r < 4; ++r) { const int t = 16 * tt + 4 * fq + r, s = 16 * stl + fr; *(LAS bf16_t*)(lds + HG_PB + t * 144 + s * 2) = f2bf(s <= t ? acc[r] : 0.f); }
    }
    __syncthreads();
    {
        bf16x8 b1[2], b2[4];
#pragma unroll
        for (int ks = 0; ks < 2; ++ks) b1[ks] = *(const LAS bf16x8*)(lds + HG_VT + (16 * wave + fr) * 144 + (32 * ks + 8 * fq) * 2);
        const float* sp = ST + ((size_t)(c * 8 + h) * 128 + 16 * wave + fr) * 128 + 8 * fq;
#pragma unroll
        for (int ks = 0; ks < 4; ++ks) { const f32x4 x0 = *(const f32x4*)(sp + 32 * ks), x1 = *(const f32x4*)(sp + 32 * ks + 4);
            u32x4 w; w.x = cvt_pk_bf16(x0[0], x0[1]); w.y = cvt_pk_bf16(x0[2], x0[3]); w.z = cvt_pk_bf16(x1[0], x1[1]); w.w = cvt_pk_bf16(x1[2], x1[3]); b2[ks] = __builtin_bit_cast(bf16x8, w); }
        LAS float* OB = (LAS float*)(lds + HG_GB);
#pragma unroll
        for (int tt = 0; tt < 4; ++tt) {
            f32x4 acc = (f32x4){0.f, 0.f, 0.f, 0.f};
#pragma unroll
            for (int ks = 0; ks < 2; ++ks) { const bf16x8 a = *(const LAS bf16x8*)(lds + HG_PB + (16 * tt + fr) * 144 + (32 * ks + 8 * fq) * 2); acc = __builtin_amdgcn_mfma_f32_16x16x32_bf16(a, b1[ks], acc, 0, 0, 0); }
#pragma unroll
            for (int ks = 0; ks < 4; ++ks) { const bf16x8 a = *(const LAS bf16x8*)(lds + HG_Q1 + (16 * tt + fr) * 272 + (32 * ks + 8 * fq) * 2); acc = __builtin_amdgcn_mfma_f32_16x16x32_bf16(a, b2[ks], acc, 0, 0, 0); }
#pragma unroll
            for (int r = 0; r < 4; ++r) OB[(16 * tt + 4 * fq + r) * 132 + 16 * wave + fr] = acc[r];
        }
    }
    __syncthreads();
    {
        const int t = tid >> 3, es = tid & 7; const LAS float* OB = (const LAS float*)(lds + HG_GB);
        float o[16]; float ss = 0.f;
#pragma unroll
        for (int i = 0; i < 16; ++i) { o[i] = OB[t * 132 + 16 * es + i]; ss += o[i] * o[i]; }
        ss += __shfl_xor(ss, 1); ss += __shfl_xor(ss, 2); ss += __shfl_xor(ss, 4);
        const float rstd = rsqrtf(ss * (1.0f / 128.0f) + NORM_EPS);
        const bf16_t* pg = PROJ + (size_t)(c * 64 + t) * DINP + CHG + h * 128 + 16 * es;
        const u32x4 g0 = *(const u32x4*)pg, g1 = *(const u32x4*)(pg + 8);
        unsigned w[8];
#pragma unroll
        for (int i = 0; i < 16; i += 2) { const float ga = i < 8 ? bfx(g0, i) : bfx(g1, i - 8), gb = (i + 1) < 8 ? bfx(g0, i + 1) : bfx(g1, i + 1 - 8);
            w[i >> 1] = cvt_pk_bf16(o[i] * rstd * norm_g[16 * es + i] * siluf_(ga), o[i + 1] * rstd * norm_g[16 * es + i + 1] * siluf_(gb)); }
        u32x4* dst = (u32x4*)(REC + (size_t)(c * 64 + t) * 1024 + h * 128 + 16 * es);
        dst[0] = (u32x4){w[0], w[1], w[2], w[3]}; dst[1] = (u32x4){w[4], w[5], w[6], w[7]};
    }
    __syncthreads();
}

constexpr int SC_KT = 0, SC_SB = 36864, SC_SPITCH = 132;
__device__ __forceinline__ void score_flush(LAS unsigned char* lds, float* SCORES, int t0, int kt, int tid) {
    const LAS float* sb = (const LAS float*)(lds + SC_SB + (kt & 1) * (32 * SC_SPITCH * 4));
    const int row = tid >> 4, seg = tid & 15;
    const f32x4 a = *(const LAS f32x4*)(sb + row * SC_SPITCH + seg * 8), b = *(const LAS f32x4*)(sb + row * SC_SPITCH + seg * 8 + 4);
    float* dst = SCORES + (size_t)(t0 + row) * S + kt * 128 + seg * 8;
    *(f32x4*)dst = a; *(f32x4*)(dst + 4) = b;
}
__device__ __forceinline__ void score_block(LAS unsigned char* lds, const bf16_t* PROJ, const bf16_t* KI, float* SCORES, int qb, int tid, int wave, int lane) {
    const int t0 = qb * 32, nkt = (t0 >> 7) + 1;
    const int r = lane & 31, hh = lane >> 5;
    bf16x8 Af[2][4]; float wv[2][16]; f32x2 wv2[2][8];
#pragma unroll
    for (int p = 0; p < 2; ++p) {
        const int tq = t0 + 4 * wave + 2 * p + (r >> 4); const bf16_t* qrow = PROJ + (size_t)tq * DINP + CQI + (r & 15) * 64 + 8 * hh;
#pragma unroll
        for (int ks = 0; ks < 4; ++ks) Af[p][ks] = *(const bf16x8*)(qrow + 16 * ks);
#pragma unroll
        for (int reg = 0; reg < 16; ++reg) { const int row = (reg & 3) + 8 * (reg >> 2) + 4 * hh; const int tw = t0 + 4 * wave + 2 * p + (row >> 4);
            wv[p][reg] = bf2f(PROJ[(size_t)tw * DINP + CWI + (row & 15)]) * (1.0f / 32.0f); }
#pragma unroll
        for (int i = 0; i < 8; ++i) wv2[p][i] = (f32x2){wv[p][2 * i], wv[p][2 * i + 1]};
    }
    const u32x2 tagsw = __builtin_amdgcn_permlane32_swap(0u, 1u, false, false); const int qsel = (int)tagsw[0];
    u32x4 stg[2];
#pragma unroll
    for (int i = 0; i < 2; ++i) { const int q = tid + 512 * i; stg[i] = *(const u32x4*)(KI + (size_t)(q >> 3) * 64 + (q & 7) * 8); }
#pragma unroll
    for (int i = 0; i < 2; ++i) { const int q = tid + 512 * i; *(LAS u32x4*)(lds + SC_KT + (q >> 3) * 144 + (q & 7) * 16) = stg[i]; }
    __syncthreads();
    for (int kt = 0; kt < nkt; ++kt) {
        const LAS unsigned char* buf = lds + SC_KT + (kt & 1) * 18432;
        LAS float* sb = (LAS float*)(lds + SC_SB + (kt & 1) * (32 * SC_SPITCH * 4));
        if (kt > 0) score_flush(lds, SCORES, t0, kt - 1, tid);
        if (kt + 1 < nkt) {
#pragma unroll
            for (int i = 0; i < 2; ++i) { const int q = tid + 512 * i; stg[i] = *(const u32x4*)(KI + (size_t)((kt + 1) * 128 + (q >> 3)) * 64 + (q & 7) * 8); }
        }
        for (int rep2 = 0; rep2 < ((MK_REP2) & 1) + 1; ++rep2) {
        f32x16 accP[2], accC[2];
#define SC_MFMA(cb) do { bf16x8 Bf[4]; _Pragma("unroll") for (int ks = 0; ks < 4; ++ks) Bf[ks] = *(const LAS bf16x8*)(buf + (32 * (cb) + r) * 144 + (16 * ks + 8 * hh) * 2); \
            _Pragma("unroll") for (int p = 0; p < 2; ++p) { _Pragma("unroll") for (int i = 0; i < 16; ++i) accC[p][i] = 0.f; \
                _Pragma("unroll") for (int ks = 0; ks < 4; ++ks) accC[p] = __builtin_amdgcn_mfma_f32_32x32x16_bf16(Af[p][ks], Bf[ks], accC[p], 0, 0, 0); } } while (0)
#define SC_RED(acc, cb) do { _Pragma("unroll") for (int p = 0; p < 2; ++p) { f32x2 s0 = {0.f, 0.f}, s1 = {0.f, 0.f}; \
            _Pragma("unroll") for (int reg = 0; reg < 8; reg += 2) { const f32x2 r0 = {relu_i(acc[p][reg]), relu_i(acc[p][reg + 1])}; const f32x2 r1 = {relu_i(acc[p][reg + 8]), relu_i(acc[p][reg + 9])}; \
                s0 = __builtin_elementwise_fma(wv2[p][reg >> 1], r0, s0); s1 = __builtin_elementwise_fma(wv2[p][4 + (reg >> 1)], r1, s1); } \
            const float p0 = s0[0] + s0[1], p1 = s1[0] + s1[1]; \
            const u32x2 sw = __builtin_amdgcn_permlane32_swap(__float_as_uint(p0), __float_as_uint(p1), false, false); \
            sb[(4 * wave + 2 * p + qsel) * SC_SPITCH + 32 * (cb) + r] = __uint_as_float(sw[0]) + __uint_as_float(sw[1]); } } while (0)
#define SC_INTERLEAVE() do { _Pragma("unroll") for (int i = 0; i < 8; ++i) { __builtin_amdgcn_sched_group_barrier(0x008, 1, 0); __builtin_amdgcn_sched_group_barrier(0x002, 8, 0); } } while (0)
        SC_MFMA(0);
        accP[0] = accC[0]; accP[1] = accC[1]; SC_MFMA(1); SC_RED(accP, 0); SC_INTERLEAVE();
        accP[0] = accC[0]; accP[1] = accC[1]; SC_MFMA(2); SC_RED(accP, 1); SC_INTERLEAVE();
        accP[0] = accC[0]; accP[1] = accC[1]; SC_MFMA(3); SC_RED(accP, 2); SC_INTERLEAVE();
        SC_RED(accC, 3);
#undef SC_MFMA
#undef SC_RED
#undef SC_INTERLEAVE
        }
        if (kt + 1 < nkt) {
#pragma unroll
            for (int i = 0; i < 2; ++i) { const int q = tid + 512 * i; *(LAS u32x4*)(lds + SC_KT + ((kt + 1) & 1) * 18432 + (q >> 3) * 144 + (q & 7) * 16) = stg[i]; }
        }
        __syncthreads();
    }
    score_flush(lds, SCORES, t0, nkt - 1, tid);
    __syncthreads();
}

__device__ __forceinline__ float wave_kth16(const float (&v)[16], int K) {
    const float NINF = -__builtin_inff();
    float mx = NINF, mn = __builtin_inff();
#pragma unroll
    for (int j = 0; j < 16; ++j) { mx = fmaxf(mx, v[j]); mn = fminf(mn, v[j] == NINF ? __builtin_inff() : v[j]); }
    mx = wave_max(mx); mn = -wave_max(-mn);
    int c = 0;
#pragma unroll
    for (int j = 0; j < 16; ++j) c += __popcll(__ballot(v[j] >= mx));
    if (c >= K) return mx;
    float lo = mn, hi = mx, tau = mn;
    for (int it = 0; it < 64; ++it) {
        const float mid = 0.5f * (lo + hi);
        if (!(mid > lo && mid < hi)) { tau = lo; break; }
        c = 0;
#pragma unroll
        for (int j = 0; j < 16; ++j) c += __popcll(__ballot(v[j] >= mid));
        if (c == K) { tau = mid; break; }
        if (c > K) lo = mid; else hi = mid;
        tau = lo;
    }
    return tau;
}
__device__ __forceinline__ int lanes_below(unsigned long long mask) { return (int)__builtin_amdgcn_mbcnt_hi((unsigned)(mask >> 32), __builtin_amdgcn_mbcnt_lo((unsigned)mask, 0u)); }
__device__ __forceinline__ void select_row(LAS unsigned char* wl, const float* SCORES, int t, int lane) {
    LAS int* selw = (LAS int*)wl; LAS float* cval = (LAS float*)(wl + 1024); LAS int* cidx = (LAS int*)(wl + 5120);
    const float NINF = -__builtin_inff();
    const float* row = SCORES + (size_t)t * S; const int n = t + 1;
    float c[16]; int N;
    if (n <= 1024) {
#pragma unroll
        for (int j = 0; j < 16; ++j) { const int i = lane + 64 * j; c[j] = i < n ? row[i] : NINF; }
        N = -1;
    } else {
        const int m = n >> 4; float s[16];
#pragma unroll
        for (int j = 0; j < 16; ++j) { const int i = lane + 64 * j; s[j] = i < m ? row[16 * i + 7] : NINF; }
        int K = 32, cnt = 0;
        for (;;) {
            const float tlo = (K >= m) ? NINF : wave_kth16(s, K);
            cnt = 0;
            const int nq = (n + 255) >> 8;
            for (int q0 = 0; q0 < nq; q0 += 8) {
                f32x4 v[8];
#pragma unroll
                for (int u = 0; u < 8; ++u) { const int e = 4 * (lane + 64 * (q0 + u)); v[u] = (e <= t) ? *(const f32x4*)(row + e) : (f32x4){NINF, NINF, NINF, NINF}; }
#pragma unroll
                for (int u = 0; u < 8; ++u) { const int e = 4 * (lane + 64 * (q0 + u));
#pragma unroll
                    for (int k = 0; k < 4; ++k) { const bool pred = (e + k <= t) && (v[u][k] >= tlo); const unsigned long long mask = __ballot(pred);
                        if (mask) { const int pos = cnt + lanes_below(mask); if (pred && pos < 1024) { cval[pos] = v[u][k]; cidx[pos] = e + k; } cnt += __popcll(mask); } } }
            }
            if (cnt >= 256 || K >= m) break;
            K *= 2;
        }
        N = cnt < 1024 ? cnt : 1024;
#pragma unroll
        for (int j = 0; j < 16; ++j) { const int i = lane + 64 * j; c[j] = i < N ? cval[i] : NINF; }
    }
    const float tau = wave_kth16(c, 256);
    int base = 0;
#pragma unroll
    for (int j = 0; j < 16; ++j) { const bool pred = c[j] >= tau; const unsigned long long mask = __ballot(pred);
        if (mask) { const int pos = base + lanes_below(mask); if (pred && pos < 256) selw[pos] = (N < 0) ? (lane + 64 * j) : cidx[lane + 64 * j]; base += __popcll(mask); } }
}

__device__ __forceinline__ void attn_query(LAS unsigned char* wl, const bf16_t* PROJ, const bf16_t* KC, const bf16_t* VC, bf16_t* ATT, int t, int lane) {
    LAS int* selw = (LAS int*)wl; LAS float* L = (LAS float*)(wl + 1024);
    const int nsel = t < 255 ? t + 1 : 256;
    const int fr = lane & 15, fq = lane >> 4;
    bf16x8 qf[2][4];
#pragma unroll
    for (int g = 0; g < 2; ++g)
#pragma unroll
        for (int ks = 0; ks < 4; ++ks) { const bf16x8 z = {0, 0, 0, 0, 0, 0, 0, 0}; qf[g][ks] = fr < 4 ? *(const bf16x8*)(PROJ + (size_t)t * DINP + CQ + (4 * g + fr) * 128 + 32 * ks + 8 * fq) : z; }
    const float scale = 0.08838834764831845f;
    const int nkt = (nsel + 15) >> 4;
    for (int kt0 = 0; kt0 < 16; kt0 += 2) {
        bf16x8 kf[2][2][4];
#pragma unroll
        for (int u = 0; u < 2; ++u) { const int kt = kt0 + u;
            if (kt < nkt) { const int key = selw[16 * kt + fr]; const bf16_t* kp = KC + (size_t)key * 256 + 8 * fq;
#pragma unroll
                for (int g = 0; g < 2; ++g)
#pragma unroll
                    for (int ks = 0; ks < 4; ++ks) kf[u][g][ks] = *(const bf16x8*)(kp + g * 128 + 32 * ks); } }
#pragma unroll
        for (int u = 0; u < 2; ++u) { const int kt = kt0 + u;
            if (kt < nkt) {
#pragma unroll
                for (int g = 0; g < 2; ++g) { f32x4 acc = (f32x4){0.f, 0.f, 0.f, 0.f};
#pragma unroll
                    for (int ks = 0; ks < 4; ++ks) acc = __builtin_amdgcn_mfma_f32_16x16x32_bf16(qf[g][ks], kf[u][g][ks], acc, 0, 0, 0);
                    if (fq == 0) {
#pragma unroll
                        for (int r = 0; r < 4; ++r) L[(4 * g + r) * 256 + 16 * kt + fr] = (16 * kt + fr < nsel) ? acc[r] * scale : -__builtin_inff(); } }
            } else if (fq == 0) {
#pragma unroll
                for (int r = 0; r < 8; ++r) L[r * 256 + 16 * kt + fr] = -__builtin_inff();
            } }
    }
    float p[8][4];
#pragma unroll
    for (int hd = 0; hd < 8; ++hd) { float m = -__builtin_inff();
#pragma unroll
        for (int i = 0; i < 4; ++i) { p[hd][i] = L[hd * 256 + lane + 64 * i]; m = fmaxf(m, p[hd][i]); }
        m = wave_max(m); float s = 0.f;
#pragma unroll
        for (int i = 0; i < 4; ++i) { p[hd][i] = __expf(p[hd][i] - m); s += p[hd][i]; }
        s = 1.0f / wave_sum(s);
#pragma unroll
        for (int i = 0; i < 4; ++i) p[hd][i] *= s; }
#pragma unroll
    for (int i = 0; i < 4; ++i)
#pragma unroll
        for (int g = 0; g < 2; ++g) *(LAS f32x4*)(L + ((g * 256 + lane + 64 * i) * 4)) = (f32x4){p[4 * g][i], p[4 * g + 1][i], p[4 * g + 2][i], p[4 * g + 3][i]};
    const int gl = lane >> 5;
    float o[4][4];
#pragma unroll
    for (int hh = 0; hh < 4; ++hh)
#pragma unroll
        for (int d = 0; d < 4; ++d) o[hh][d] = 0.f;
    const int kend = (nsel + 15) & ~15;
    u32x2 vw[2][16];
#define PV_LOAD(buf, kk0) do { _Pragma("unroll") for (int u4 = 0; u4 < 4; ++u4) { const i32x4 k4 = *(const LAS i32x4*)(selw + (kk0) + 4 * u4); \
        _Pragma("unroll") for (int e = 0; e < 4; ++e) { const int key = __builtin_amdgcn_readfirstlane(k4[e]); vw[buf][4 * u4 + e] = *(const u32x2*)(VC + (size_t)key * 256 + 4 * lane); } } } while (0)
#define PV_COMP(buf, kk0) do { _Pragma("unroll") for (int u = 0; u < 16; ++u) { const f32x4 p4 = *(const LAS f32x4*)(L + (gl * 256 + (kk0) + u) * 4); \
        const float v0 = bf_lo(vw[buf][u].x), v1 = bf_hi(vw[buf][u].x), v2 = bf_lo(vw[buf][u].y), v3 = bf_hi(vw[buf][u].y); \
        _Pragma("unroll") for (int hh = 0; hh < 4; ++hh) { o[hh][0] += p4[hh] * v0; o[hh][1] += p4[hh] * v1; o[hh][2] += p4[hh] * v2; o[hh][3] += p4[hh] * v3; } } } while (0)
    PV_LOAD(0, 0);
    for (int kk = 0; kk < kend; kk += 32) {
        if (kk + 16 < kend) PV_LOAD(1, kk + 16);
        PV_COMP(0, kk);
        if (kk + 16 < kend) { if (kk + 32 < kend) PV_LOAD(0, kk + 32); PV_COMP(1, kk + 16); }
    }
#undef PV_LOAD
#undef PV_COMP
#pragma unroll
    for (int hh = 0; hh < 4; ++hh) { u32x2 w; w.x = cvt_pk_bf16(o[hh][0], o[hh][1]); w.y = cvt_pk_bf16(o[hh][2], o[hh][3]);
        *(u32x2*)(ATT + (size_t)t * 1024 + (4 * gl + hh) * 128 + 4 * (lane & 31)) = w; }
}

__device__ __forceinline__ void convert_item8(const float* __restrict__ W, int K, int N, unsigned char* WT, int mode, int item, int lane, LAS unsigned char* scr) {
    const int nblk = N >> 6; const int kb = item / nblk, nb = item - kb * nblk; const int k0 = kb * 128, n0 = nb * 64;
    const int c4 = lane & 15, kr = lane >> 4;
    const float* src = W + (size_t)(k0 + 4 * kr) * N + n0 + 4 * c4;
#pragma unroll 2
    for (int i = 0; i < 8; ++i) {
        f32x4 v[4];
#pragma unroll
        for (int r = 0; r < 4; ++r) v[r] = *(const f32x4*)(src + (size_t)(16 * i + r) * N);
        const int kk = 16 * i + 4 * kr;
#pragma unroll
        for (int e = 0; e < 4; ++e) *(LAS unsigned*)(scr + (4 * c4 + e) * 144 + kk) = pack4_fp8(v[0][e] * W8_SCALE, v[1][e] * W8_SCALE, v[2][e] * W8_SCALE, v[3][e] * W8_SCALE);
    }
    LDS_WAIT(); asm volatile("" ::: "memory");
#pragma unroll 4
    for (int j = 0; j < 8; ++j) {
        const int q = j * 64 + lane, n = q >> 3, ch = q & 7;
        const u32x4 v = *(const LAS u32x4*)(scr + n * 144 + ch * 16);
        *(u32x4*)(WT + (size_t)dest_row(mode, n0 + n) * K + k0 + ch * 16) = v;
    }
    LDS_WAIT(); asm volatile("" ::: "memory");
}

__global__ void __launch_bounds__(NTHR, 2) fwd_kernel(Args args) {
    extern __shared__ __attribute__((aligned(16))) unsigned char lds_raw[];
    LAS unsigned char* lds = (LAS unsigned char*)lds_raw;
    volatile LAS unsigned* MISC = (volatile LAS unsigned*)(lds + LDS_MISC);
    const int tid = threadIdx.x, lane = tid & 63, wave = __builtin_amdgcn_readfirstlane(tid >> 6);
    const int G = gridDim.x, wg = blockIdx.x;
    unsigned char* ws = args.ws;
    unsigned* ctl = (unsigned*)(ws + WS_CTL);
    const int lo = args.ph_lo, hi = args.ph_hi, flags = args.flags;
    const float* x = (const float*)args.in[0]; const float* cvec = (const float*)args.in[1]; const int* positions = (const int*)args.in[2];
    const float* w_ada = (const float*)args.in[3]; const float* b_ada = (const float*)args.in[4]; const float* norm1_g = (const float*)args.in[5];
    const float* w_in = (const float*)args.in[6]; const float* idx_knorm_g = (const float*)args.in[7]; const float* idx_knorm_b = (const float*)args.in[8];
    const float* lb_logits = (const float*)args.in[9]; const float* hgrn_norm_g = (const float*)args.in[10];
    const float* w_proj_att = (const float*)args.in[11]; const float* w_proj_hgrn = (const float*)args.in[12]; const float* w_out = (const float*)args.in[13];
    const float* norm2_g = (const float*)args.in[14]; const float* w_router = (const float*)args.in[15]; const float* b_router = (const float*)args.in[16];
    const float* w1 = (const float*)args.in[17]; const float* b1 = (const float*)args.in[18]; const float* w2 = (const float*)args.in[19]; const float* b2 = (const float*)args.in[20];
    const float* final_g = (const float*)args.in[21];
    float* out = args.out;
    float* MOD = (float*)(ws + WS_MOD); int* TOPE = (int*)(ws + WS_TOPE); float* GATE = (float*)(ws + WS_GATE); int* SLOT = (int*)(ws + WS_SLOT);
    bf16_t* WIN_T = (bf16_t*)(ws + WS_WIN_T); bf16_t* WA_T = (bf16_t*)(ws + WS_WA_T); bf16_t* WH_T = (bf16_t*)(ws + WS_WH_T); bf16_t* WO_T = (bf16_t*)(ws + WS_WO_T);
    unsigned char* W1_T = ws + WS_W1_T; unsigned char* W2_T = ws + WS_W2_T;
    bf16_t* HB = (bf16_t*)(ws + WS_H); bf16_t* PROJ = (bf16_t*)(ws + WS_PROJ);
    float* X1 = (float*)(ws + WS_X1);
    unsigned char* XB = ws + WS_XB; unsigned char* ACT = ws + WS_ACT; bf16_t* YB = (bf16_t*)(ws + WS_YB);
    int* TOKS = (int*)(ws + WS_TOKS);
    unsigned char* H8 = ws + WS_H;
    bf16_t* KI = (bf16_t*)(ws + WS_KI); bf16_t* KC = (bf16_t*)(ws + WS_KC); bf16_t* VC = (bf16_t*)(ws + WS_VC);
    float* ST = (float*)(ws + WS_ST); float* DC = (float*)(ws + WS_DC); int* SEL = (int*)(ws + WS_SEL);
    bf16_t* ATT = (bf16_t*)(ws + WS_ATT); bf16_t* REC = (bf16_t*)(ws + WS_REC); bf16_t* MERGED = (bf16_t*)(ws + WS_MERGED); float* SCORES = (float*)(ws + WS_SCORES);

    for (int u = tid; u < 128; u += NTHR) MISC[u] = 0u;
    __syncthreads();
    const bool one_launch = (hi - lo) > 1;
    XcdBarrier bar; bar.bar = ctl + CW_BAR; bar.x = 0; bar.st = MISC + 8;
    if (one_launch) bar = xcd_barrier_post(ctl + CW_BAR, MISC + 8);
#define IN(k) (lo <= (k) && (k) < hi)
#define NREP(k) ((((MK_REP) >> (k)) & 1) + 1)
#define SEAM(k) do { if (IN(k) && IN((k) + 1)) xcd_barrier(bar); } while (0)

    const float* x1src = (flags & FLAG_MIXER) ? (const float*)X1 : x;

    if (IN(PH_PRO)) {
        if (wg < 192) {
            LAS float* red = (LAS float*)lds;
            const int col = wg * 64 + lane; float acc = 0.f;
            for (int k = wave; k < D; k += 64) {
                float wv[8], cv[8];
#pragma unroll
                for (int i = 0; i < 8; ++i) { wv[i] = w_ada[(size_t)(k + 8 * i) * (6 * D) + col]; cv[i] = cvec[k + 8 * i]; }
#pragma unroll
                for (int i = 0; i < 8; ++i) acc += siluf_(cv[i]) * wv[i];
            }
            red[wave * 64 + lane] = acc;
            __syncthreads();
            if (tid < 64) { float s = b_ada[col]; for (int w = 0; w < 8; ++w) s += red[w * 64 + tid]; MOD[col] = s; }
            __syncthreads();
        }
        LAS unsigned char* scr = lds + wave * 17408;
        const int gw = wg * NWAVES + wave, NGW = G * NWAVES;
        for (int rep = 0; rep < NREP(PH_PRO); ++rep) {
        if (flags & FLAG_MIXER) {
            constexpr int NB_IN = (DIN + 63) / 64;
            for (int it = gw; it < 16 * NB_IN; it += NGW) convert_item(w_in, 2048, DIN, WIN_T, 1, it, lane, scr);
            for (int it = gw; it < 8 * 32; it += NGW) convert_item(w_proj_att, 1024, 2048, WA_T, 0, it, lane, scr);
            for (int it = gw; it < 8 * 32; it += NGW) convert_item(w_proj_hgrn, 1024, 2048, WH_T, 0, it, lane, scr);
            for (int it = gw; it < 16 * 32; it += NGW) convert_item(w_out, 2048, 2048, WO_T, 0, it, lane, scr);
            for (size_t i = (size_t)wg * NTHR + tid; i < (size_t)176 * 2048 * 2 / 16; i += (size_t)G * NTHR) ((u32x4*)(WIN_T + (size_t)2640 * 2048))[i] = (u32x4){0u, 0u, 0u, 0u};
        }
        if (flags & FLAG_MOE) {
            constexpr int I1 = (2048 / 128) * (4096 / 64), I2 = (2048 / 128) * (2048 / 64);
            for (int it = gw; it < NEXP * I1; it += NGW) { const int e = it / I1, r = it - e * I1; convert_item8(w1 + (size_t)e * 2048 * 4096, 2048, 4096, W1_T + (size_t)e * 4096 * 2048, 2, r, lane, scr); }
            for (int it = gw; it < NEXP * I2; it += NGW) { const int e = it / I2, r = it - e * I2; convert_item8(w2 + (size_t)e * 2048 * 2048, 2048, 2048, W2_T + (size_t)e * 2048 * 2048, 0, r, lane, scr); }
        }
        }
    }
    SEAM(PH_PRO);

    if (flags & FLAG_MIXER) {
    if (IN(PH_H)) {
        const float* sh1 = MOD; const float* sc1 = MOD + D;
        const int gw = wg * NWAVES + wave, NGW = G * NWAVES;
        f32x4 gs[8], sh[8];
#pragma unroll
        for (int j = 0; j < 8; ++j) { const int c = 4 * lane + 256 * j; const f32x4 g = *(const f32x4*)(norm1_g + c), sc = *(const f32x4*)(sc1 + c); sh[j] = *(const f32x4*)(sh1 + c);
#pragma unroll
            for (int e = 0; e < 4; ++e) gs[j][e] = g[e] * (1.0f + sc[e]); }
        for (int rep = 0; rep < NREP(PH_H); ++rep)
        for (int t = gw; t < S; t += NGW) {
            const f32x4* xr = (const f32x4*)(x + (size_t)t * D) + lane;
            f32x4 v[8]; float ss = 0.f;
#pragma unroll
            for (int j = 0; j < 8; ++j) { v[j] = xr[64 * j]; ss += (v[j][0] * v[j][0] + v[j][1] * v[j][1]) + (v[j][2] * v[j][2] + v[j][3] * v[j][3]); }
            const float rstd = rsqrtf(wave_sum(ss) * (1.0f / D) + NORM_EPS);
#pragma unroll
            for (int j = 0; j < 8; ++j) { const f32x4 h = v[j] * rstd * gs[j] + sh[j]; u32x2 w; w.x = cvt_pk_bf16(h[0], h[1]); w.y = cvt_pk_bf16(h[2], h[3]);
                *(u32x2*)(HB + (size_t)t * D + 4 * lane + 256 * j) = w; }
        }
    }
    SEAM(PH_H);
    if (IN(PH_INPROJ)) for (int rep = 0; rep < NREP(PH_INPROJ); ++rep) {
        pg8::Gemm g{HB, WIN_T, 2048, 0, nullptr}; pg8::StaticOrder So; So.init(S, DINP, G, wg);
        pg8::EpiBf16 E{PROJ, DINP, nullptr, 0, 1.0f};
        pg8::gemm_phase<pg8::EpiBf16, pg8::StaticOrder>(lds, g, So, E);
    }
    SEAM(PH_INPROJ);
    if (IN(PH_POST)) {
        const int gw = wg * NWAVES + wave, NGW = G * NWAVES;
        for (int t = gw; t < S; t += NGW) post_token(PROJ, KI, KC, VC, positions, idx_knorm_g, idx_knorm_b, t, lane);
        __syncthreads();
        for (int rep = 0; rep < NREP(PH_POST); ++rep)
        for (int u = wg; u < 2048; u += G) hgrn_l1(lds, PROJ, lb_logits, ST, DC, u >> 3, u & 7, tid, wave, lane);
    }
    SEAM(PH_POST);
    if (IN(PH_SCORE)) {
        for (int idx = wg * NTHR + tid; idx < 8 * 128 * 128; idx += G * NTHR) {
            const int h = idx >> 14, d = idx & 127; float s = 0.f;
            float* sp = ST + idx; const float* dp = DC + h * 128 + d;
            for (int c = 0; c < 256; c += 8) {
                float l[8], dc[8];
#pragma unroll
                for (int i = 0; i < 8; ++i) { l[i] = sp[(size_t)(c + i) * 131072]; dc[i] = dp[(size_t)(c + i) * 1024]; }
#pragma unroll
                for (int i = 0; i < 8; ++i) { sp[(size_t)(c + i) * 131072] = s; s = dc[i] * s + l[i]; }
            }
        }
        if (flags & FLAG_ATT) for (int rep = 0; rep < NREP(PH_SCORE); ++rep) {
            for (int j = wg; j < 252; j += G) { score_block(lds, PROJ, KI, SCORES, 8 + j, tid, wave, lane); score_block(lds, PROJ, KI, SCORES, 511 - j, tid, wave, lane); }
        }
    }
    SEAM(PH_SCORE);
    if (IN(PH_SELECT)) {
        for (int rep = 0; rep < NREP(PH_SELECT); ++rep)
        for (int u = wg; u < 2048; u += G) hgrn_l3(lds, PROJ, lb_logits, ST, hgrn_norm_g, REC, u >> 3, u & 7, tid, wave, lane);
    }
    SEAM(PH_SELECT);
    if (IN(PH_ATTN)) {
        const int gw = wg * NWAVES + wave, NGW = G * NWAVES;
        if (flags & FLAG_ATT) for (int rep = 0; rep < NREP(PH_ATTN); ++rep) {
            for (int t = gw; t < S; t += NGW) {
                LAS unsigned char* wl = lds + wave * 9216;
                if (t >= 256) { for (int rep2 = 0; rep2 < (((MK_REP2) >> 1) & 1) + 1; ++rep2) select_row(wl, SCORES, t, lane); }
                else {
#pragma unroll
                    for (int i = 0; i < 4; ++i) { const int idx = lane + 64 * i; ((LAS int*)wl)[idx] = idx <= t ? idx : 0; }
                }
                for (int rep2 = 0; rep2 < (((MK_REP2) >> 2) & 1) + 1; ++rep2) attn_query(wl, PROJ, KC, VC, ATT, t, lane);
            }
        } else {
            for (size_t i = (size_t)wg * NTHR + tid; i < (size_t)S * 1024 * 2 / 16; i += (size_t)G * NTHR) ((u32x4*)ATT)[i] = (u32x4){0u, 0u, 0u, 0u};
        }
    }
    SEAM(PH_ATTN);
    if (IN(PH_OP1)) {
        pg8::Gemm g{ATT, WA_T, 1024, 0, nullptr}; pg8::StaticOrder So; So.init(S, 2048, G, wg);
        pg8::EpiGate E{MERGED, PROJ + CGA, 0};
        pg8::gemm_phase<pg8::EpiGate, pg8::StaticOrder>(lds, g, So, E);
    }
    SEAM(PH_OP1);
    if (IN(PH_OP2)) {
        pg8::Gemm g{REC, WH_T, 1024, 0, nullptr}; pg8::StaticOrder So; So.init(S, 2048, G, wg);
        pg8::EpiGate E{MERGED, PROJ + CGR, 1};
        pg8::gemm_phase<pg8::EpiGate, pg8::StaticOrder>(lds, g, So, E);
    }
    SEAM(PH_OP2);
    if (IN(PH_WOUT)) {
        pg8::Gemm g{MERGED, WO_T, 2048, 0, nullptr}; pg8::StaticOrder So; So.init(S, 2048, G, wg);
        pg8::EpiResid E{x, MOD + 2 * D, X1};
        pg8::gemm_phase<pg8::EpiResid, pg8::StaticOrder>(lds, g, So, E);
    }
    SEAM(PH_WOUT);
    }

    if (IN(PH_ROUTER) && (flags & FLAG_MOE)) {
        LAS float* hs = (LAS float*)lds;
        volatile LAS unsigned* lcnt = MISC + 32;
        const float* sh2 = MOD + 3 * D; const float* sc2 = MOD + 4 * D;
        if (tid < 32) lcnt[tid] = 0u;
        __syncthreads();
        for (int grp = wg; grp < S / 16; grp += G) {
#pragma unroll 1
            for (int q = 0; q < 2; ++q) {
                const int tl = 2 * wave + q, t = grp * 16 + tl;
                const f32x4* xr = (const f32x4*)(x1src + (size_t)t * D) + lane;
                f32x4 v[8]; float ss = 0.f;
#pragma unroll
                for (int j = 0; j < 8; ++j) { v[j] = xr[64 * j]; ss += (v[j][0] * v[j][0] + v[j][1] * v[j][1]) + (v[j][2] * v[j][2] + v[j][3] * v[j][3]); }
                const float rstd = rsqrtf(wave_sum(ss) * (1.0f / D) + NORM_EPS);
#pragma unroll
                for (int j = 0; j < 8; ++j) {
                    const int c = 4 * lane + 256 * j;
                    const f32x4 g = *(const f32x4*)(norm2_g + c), sc = *(const f32x4*)(sc2 + c), sh = *(const f32x4*)(sh2 + c);
                    f32x4 h;
#pragma unroll
                    for (int e = 0; e < 4; ++e) h[e] = v[j][e] * rstd * g[e] * (1.0f + sc[e]) + sh[e];
                    *(LAS f32x4*)(hs + tl * 2048 + c) = h;
                    *(unsigned*)(H8 + (size_t)t * D + c) = pack4_fp8(h[0], h[1], h[2], h[3]);
                }
            }
            __syncthreads();
            {
                LAS float* part = (LAS float*)(lds + 131072);
                const int fr = lane & 15, fq = lane >> 4;
                f32x4 acc0 = (f32x4){0.f, 0.f, 0.f, 0.f}, acc1 = acc0;
                const LAS float* hrow = hs + fr * 2048 + wave * 256 + 4 * fq; const float* wrp = w_router + (size_t)(wave * 256 + 4 * fq) * 32 + fr;
#pragma unroll 2
                for (int i = 0; i < 16; ++i) {
                    const f32x4 a4 = *(const LAS f32x4*)(hrow + 16 * i);
                    float b0[4], b1[4];
#pragma unroll
                    for (int s = 0; s < 4; ++s) { b0[s] = wrp[(size_t)(16 * i + s) * 32]; b1[s] = wrp[(size_t)(16 * i + s) * 32 + 16]; }
#pragma unroll
                    for (int s = 0; s < 4; ++s) { acc0 = __builtin_amdgcn_mfma_f32_16x16x4f32(a4[s], b0[s], acc0, 0, 0, 0); acc1 = __builtin_amdgcn_mfma_f32_16x16x4f32(a4[s], b1[s], acc1, 0, 0, 0); }
                }
#pragma unroll
                for (int r = 0; r < 4; ++r) { part[(wave * 16 + 4 * fq + r) * 32 + fr] = acc0[r]; part[(wave * 16 + 4 * fq + r) * 32 + 16 + fr] = acc1[r]; }
                __syncthreads();
                const int tl = tid >> 5, e = tid & 31, t = grp * 16 + tl;
                float v = b_router[e];
#pragma unroll
                for (int w = 0; w < 8; ++w) v += part[(w * 16 + tl) * 32 + e];
                float tv[4]; int ti[4];
#pragma unroll
                for (int k = 0; k < 4; ++k) {
                    float bv = v; int bi = e;
#pragma unroll
                    for (int o = 16; o >= 1; o >>= 1) { const float ov = __shfl_xor(bv, o); const int oi = __shfl_xor(bi, o); if (ov > bv || (ov == bv && oi < bi)) { bv = ov; bi = oi; } }
                    tv[k] = bv; ti[k] = bi; if (e == bi) v = -__builtin_inff();
                }
                if (e == 0) {
                    const float e1 = __expf(tv[1] - tv[0]), e2 = __expf(tv[2] - tv[0]), e3 = __expf(tv[3] - tv[0]); const float inv = 1.0f / (1.0f + e1 + e2 + e3);
                    *(int4*)(TOPE + (size_t)t * 4) = make_int4(ti[0], ti[1], ti[2], ti[3]);
                    *(f32x4*)(GATE + (size_t)t * 4) = (f32x4){inv, e1 * inv, e2 * inv, e3 * inv};
#pragma unroll
                    for (int k = 0; k < 4; ++k) __hip_atomic_fetch_add((LAS unsigned*)&lcnt[ti[k]], 1u, __ATOMIC_RELAXED, __HIP_MEMORY_SCOPE_WORKGROUP);
                }
            }
            __syncthreads();
        }
        if (tid < 32) { const unsigned c = lcnt[tid]; if (c) __hip_atomic_fetch_add(ctl + CW_CNT + tid, c, __ATOMIC_RELAXED, __HIP_MEMORY_SCOPE_AGENT); }
    }
    SEAM(PH_ROUTER);

    if (IN(PH_SCATTER) && (flags & FLAG_MOE)) {
        volatile LAS unsigned* lcnt = MISC + 32; volatile LAS unsigned* lbase = MISC + 64; LAS int* pstart = (LAS int*)(lds + 1024); LAS int* pcnt = (LAS int*)(lds + 1280);
        if (tid == 0) { int p = 0; for (int e = 0; e < NEXP; ++e) { const int c = (int)__hip_atomic_load(ctl + CW_CNT + e, __ATOMIC_RELAXED, __HIP_MEMORY_SCOPE_AGENT); pstart[e] = p; pcnt[e] = c; p += (c + 255) & ~255; } }
        if (tid < 32) lcnt[tid] = 0u;
        __syncthreads();
        if (wg < NEXP) { const int e = wg; for (int s = pstart[e] + pcnt[e] + tid; s < pstart[e] + ((pcnt[e] + 255) & ~255); s += NTHR) TOKS[s] = 0; }
        for (int blk = wg; blk < S / 64; blk += G) {
            int e = 0, lrank = 0;
            if (tid < 256) { e = TOPE[(size_t)blk * 256 + tid]; lrank = (int)__hip_atomic_fetch_add((LAS unsigned*)&lcnt[e], 1u, __ATOMIC_RELAXED, __HIP_MEMORY_SCOPE_WORKGROUP); }
            __syncthreads();
            if (tid < 32) { const unsigned c = lcnt[tid]; lbase[tid] = c ? __hip_atomic_fetch_add(ctl + CW_FILL + tid, c, __ATOMIC_RELAXED, __HIP_MEMORY_SCOPE_AGENT) : 0u; }
            __syncthreads();
            if (tid < 256) { const int slot = pstart[e] + (int)lbase[e] + lrank; SLOT[(size_t)blk * 256 + tid] = slot; TOKS[slot] = blk * 64 + (tid >> 2); }
            __syncthreads();
            if (tid < 32) lcnt[tid] = 0u;
            __syncthreads();
        }
    }
    SEAM(PH_SCATTER);

    if ((IN(PH_MOE1) || IN(PH_MOE2)) && (flags & FLAG_MOE)) {
        LAS int* panel_e = (LAS int*)(lds + 131072 + 2048);
        LAS int* npan = (LAS int*)(lds + 131072 + 2048 + 2048);
        __syncthreads();
        if (tid == 0) { int p = 0; for (int e = 0; e < NEXP; ++e) { const int np = (int)((__hip_atomic_load(ctl + CW_CNT + e, __ATOMIC_RELAXED, __HIP_MEMORY_SCOPE_AGENT) + 255u) >> 8); for (int q = 0; q < np; ++q) panel_e[p + q] = e; p += np; } npan[0] = p; }
        __syncthreads();
        const int nPanels = npan[0];
        if (IN(PH_MOE1)) for (int rep = 0; rep < NREP(PH_MOE1); ++rep) {
            pg8::Gemm g{H8, W1_T, 2048, (size_t)4096 * 2048, TOKS}; pg8::MoeOrder So; So.init(nPanels, 16, G, wg, panel_e);
            pg8::EpiSwiglu E{ACT, b1};
            pg8::gemm_phase<pg8::EpiSwiglu, pg8::MoeOrder, true>(lds, g, So, E);
        }
        SEAM(PH_MOE1);
        if (IN(PH_MOE2)) for (int rep = 0; rep < NREP(PH_MOE2); ++rep) {
            pg8::Gemm g{ACT, W2_T, 2048, (size_t)2048 * 2048, nullptr}; pg8::MoeOrder So; So.init(nPanels, 8, G, wg, panel_e);
            pg8::EpiBf16 E{YB, 2048, b2, 2048, 1.0f / (W8_SCALE * ACT8_SCALE)};
            pg8::gemm_phase<pg8::EpiBf16, pg8::MoeOrder, true>(lds, g, So, E);
        }
    }
    SEAM(PH_MOE2);

    if (IN(PH_FINAL)) {
        const float* gt2 = MOD + 5 * D;
        const int gw = wg * NWAVES + wave, NGW = G * NWAVES;
        for (int rep = 0; rep < NREP(PH_FINAL); ++rep)
        for (int t = gw; t < S; t += NGW) {
            const f32x4* xr = (const f32x4*)(x1src + (size_t)t * D) + lane;
            f32x4 v[8];
#pragma unroll
            for (int j = 0; j < 8; ++j) v[j] = xr[64 * j];
            if (flags & FLAG_MOE) {
                f32x4 m[8];
#pragma unroll
                for (int j = 0; j < 8; ++j) m[j] = (f32x4){0.f, 0.f, 0.f, 0.f};
                const int4 sl = *(const int4*)(SLOT + (size_t)t * 4); const f32x4 gt = *(const f32x4*)(GATE + (size_t)t * 4);
                const int sls[4] = {sl.x, sl.y, sl.z, sl.w};
#pragma unroll
                for (int k = 0; k < 4; ++k) {
                    const u32x2* yr = (const u32x2*)(YB + (size_t)sls[k] * D) + lane; const float gk = gt[k];
#pragma unroll
                    for (int j = 0; j < 8; ++j) { const u32x2 w = yr[64 * j]; m[j][0] += gk * bf_lo(w.x); m[j][1] += gk * bf_hi(w.x); m[j][2] += gk * bf_lo(w.y); m[j][3] += gk * bf_hi(w.y); }
                }
#pragma unroll
                for (int j = 0; j < 8; ++j) { const f32x4 g2 = *(const f32x4*)(gt2 + 4 * lane + 256 * j); v[j] = v[j] + g2 * m[j]; }
            }
            float ss = 0.f;
#pragma unroll
            for (int j = 0; j < 8; ++j) ss += (v[j][0] * v[j][0] + v[j][1] * v[j][1]) + (v[j][2] * v[j][2] + v[j][3] * v[j][3]);
            const float rstd = rsqrtf(wave_sum(ss) * (1.0f / D) + NORM_EPS);
            f32x4* orow = (f32x4*)(out + (size_t)t * D) + lane;
#pragma unroll
            for (int j = 0; j < 8; ++j) { const f32x4 fg = *(const f32x4*)(final_g + 4 * lane + 256 * j); orow[64 * j] = v[j] * rstd * fg; }
        }
    }
#undef IN
#undef SEAM
}

#ifndef MK_ONE_LAUNCH
#define MK_ONE_LAUNCH 1
#endif
#ifndef MK_FLAGS
#define MK_FLAGS (FLAG_MOE | FLAG_MIXER | FLAG_ATT)
#endif
extern "C" void kernel_launch(void* const* d_in, const int* in_sizes, int n_in, void* d_out, int out_size, void* d_ws, size_t ws_size, hipStream_t stream) {
    static int grid = 0;
    if (grid == 0) {
        if (n_in != 22 || out_size != S * D || ws_size < WS_END) { fprintf(stderr, "kernel_launch: unexpected shapes: n_in %d out %d ws %zu (need %zu)\n", n_in, out_size, ws_size, (size_t)WS_END); grid = -1; return; }
        int dev = 0, cus = 0, per_cu = 0;
        if (hipGetDevice(&dev) != hipSuccess || hipDeviceGetAttribute(&cus, hipDeviceAttributeMultiprocessorCount, dev) != hipSuccess) { grid = -1; return; }
        if (hipFuncSetAttribute((const void*)fwd_kernel, hipFuncAttributeMaxDynamicSharedMemorySize, LDS_BYTES) != hipSuccess) { fprintf(stderr, "kernel_launch: hipFuncSetAttribute failed\n"); grid = -1; return; }
        if (hipOccupancyMaxActiveBlocksPerMultiprocessor(&per_cu, (const void*)fwd_kernel, NTHR, LDS_BYTES) != hipSuccess || per_cu < 1) { fprintf(stderr, "kernel_launch: occupancy query says %d\n", per_cu); (void)hipGetLastError(); grid = -1; return; }
        grid = cus;
    }
    if (grid < 0) return;
    (void)in_sizes;
    hipMemsetAsync((char*)d_ws + WS_CTL, 0, CTL_BYTES, stream);
    Args a{};
    for (int i = 0; i < 22; ++i) a.in[i] = d_in[i];
    a.out = (float*)d_out; a.ws = (unsigned char*)d_ws; a.flags = MK_FLAGS; a.pad = 0;
#if MK_ONE_LAUNCH
    a.ph_lo = 0; a.ph_hi = NPH;
    hipLaunchKernelGGL(fwd_kernel, dim3(grid), dim3(NTHR), LDS_BYTES, stream, a);
#else
    for (int p = 0; p < NPH; ++p) { a.ph_lo = p; a.ph_hi = p + 1; hipLaunchKernelGGL(fwd_kernel, dim3(grid), dim3(NTHR), LDS_BYTES, stream, a); }
#endif
}
```

```cpp
#include <hip/hip_runtime.h>
#include <cstdio>
#include <cstdint>

#define GAS __attribute__((address_space(1)))
#define LAS __attribute__((address_space(3)))
typedef unsigned short bf16_t;
typedef short bf16x8 __attribute__((ext_vector_type(8)));
typedef float f32x4 __attribute__((ext_vector_type(4)));
typedef float f32x2 __attribute__((ext_vector_type(2)));
typedef float f32x16 __attribute__((ext_vector_type(16)));
typedef unsigned u32x4 __attribute__((ext_vector_type(4)));
typedef unsigned u32x2 __attribute__((ext_vector_type(2)));
typedef int i32x4 __attribute__((ext_vector_type(4)));
typedef int i32x8 __attribute__((ext_vector_type(8)));
typedef short s16x4 __attribute__((ext_vector_type(4)));

constexpr int S = 16384, D = 2048, DIN = 10832, DINP = 11008, NEXP = 32, DFF = 2048;
constexpr int NWAVES = 8, NTHR = 512;
constexpr int CQ = 0, CK = 1024, CV = 1280, CQI = 1536, CKI = 2560, CWI = 2624, CHQ = 2816, CHF = 3840, CHI = 4864, CHG = 5888, CGA = 6912, CGR = 8960;
constexpr int PMAX = 65536 + NEXP * 256;
constexpr float NORM_EPS = 1e-5f;

constexpr size_t MiB = 1u << 20;
constexpr size_t al256(size_t x) { return (x + 255) & ~(size_t)255; }
constexpr size_t WS_CTL = 0, CTL_BYTES = 1 * MiB;
constexpr size_t WS_MOD = WS_CTL + CTL_BYTES;
constexpr size_t WS_TOPE = WS_MOD + 64 * 1024;
constexpr size_t WS_GATE = WS_TOPE + (size_t)S * 16;
constexpr size_t WS_SLOT = WS_GATE + (size_t)S * 16;
constexpr size_t WS_WIN_T = WS_SLOT + (size_t)S * 16;
constexpr size_t WS_WA_T = WS_WIN_T + (size_t)DINP * D * 2;
constexpr size_t WS_WH_T = WS_WA_T + (size_t)2048 * 1024 * 2;
constexpr size_t WS_WO_T = WS_WH_T + (size_t)2048 * 1024 * 2;
constexpr size_t WS_W1_T = WS_WO_T + (size_t)2048 * 2048 * 2;
constexpr size_t WS_W2_T = WS_W1_T + (size_t)NEXP * 4096 * 2048 * 2;
constexpr size_t WS_H = WS_W2_T + (size_t)NEXP * 2048 * 2048 * 2;
constexpr size_t WS_PROJ = WS_H + (size_t)S * D * 2;
constexpr size_t WS_KI = WS_PROJ + (size_t)S * DINP * 2;
constexpr size_t WS_KC = WS_KI + (size_t)S * 64 * 2;
constexpr size_t WS_VC = WS_KC + (size_t)S * 256 * 2;
constexpr size_t WS_ST = WS_VC + (size_t)S * 256 * 2;
constexpr size_t WS_DC = WS_ST + (size_t)256 * 8 * 128 * 128 * 4;
constexpr size_t WS_SEL = WS_DC + (size_t)256 * 8 * 128 * 4;
constexpr size_t WS_ATT = WS_SEL + (size_t)S * 256 * 4;
constexpr size_t WS_REC = WS_ATT + (size_t)S * 1024 * 2;
constexpr size_t WS_MERGED = WS_REC + (size_t)S * 1024 * 2;
constexpr size_t WS_X1 = WS_MERGED + (size_t)S * 2048 * 2;
constexpr size_t WS_SCORES = WS_X1 + (size_t)S * 2048 * 4;
constexpr size_t WS_XB = WS_SCORES;
constexpr size_t WS_ACT = WS_XB + (size_t)PMAX * 2048 * 2;
constexpr size_t WS_YB = WS_ACT + (size_t)PMAX * 2048 * 2;
constexpr size_t WS_END = WS_SCORES + (size_t)S * S * 4;
static_assert(WS_YB + (size_t)PMAX * 2048 * 2 <= WS_END, "MoE buffers overlay the score matrix");
static_assert(WS_END <= (size_t)4096 * MiB, "workspace");
constexpr int CW_BAR = 4096, CW_CNT = 8192, CW_FILL = 8448;
constexpr size_t WS_TOKS = WS_SEL;

constexpr int LDS_BYTES = 155648;
constexpr int LDS_MISC = LDS_BYTES - 512;

__device__ __forceinline__ unsigned cvt_pk_bf16(float lo, float hi) { unsigned r; asm volatile("v_cvt_pk_bf16_f32 %0, %1, %2" : "=v"(r) : "v"(lo), "v"(hi)); return r; }
__device__ __forceinline__ float bf_lo(unsigned u) { return __uint_as_float(u << 16); }
__device__ __forceinline__ float bf_hi(unsigned u) { return __uint_as_float(u & 0xffff0000u); }
__device__ __forceinline__ float bf2f(bf16_t b) { return __uint_as_float(((unsigned)b) << 16); }
__device__ __forceinline__ float wave_sum(float v) {
#pragma unroll
    for (int o = 1; o < 64; o <<= 1) v += __shfl_xor(v, o);
    return v;
}
__device__ __forceinline__ float wave_max(float v) {
#pragma unroll
    for (int o = 1; o < 64; o <<= 1) v = fmaxf(v, __shfl_xor(v, o));
    return v;
}
__device__ __forceinline__ float sigmoidf_(float x) { return __builtin_amdgcn_rcpf(1.0f + __expf(-x)); }
__device__ __forceinline__ float siluf_(float x) { return x * __builtin_amdgcn_rcpf(1.0f + __expf(-x)); }
__device__ __forceinline__ unsigned pack4_fp8(float a, float b, float c, float d) { int w = 0; w = __builtin_amdgcn_cvt_pk_fp8_f32(a, b, w, false); w = __builtin_amdgcn_cvt_pk_fp8_f32(c, d, w, true); return (unsigned)w; }
constexpr float W8_SCALE = 64.0f, ACT8_SCALE = 4.0f;
__device__ __forceinline__ float relu_i(float x) { const int i = __float_as_int(x); return __int_as_float(i > 0 ? i : 0); }
#define LDS_WAIT() asm volatile("s_waitcnt lgkmcnt(0)" ::: "memory")
#define VM_WAIT() asm volatile("s_waitcnt vmcnt(0)" ::: "memory")

#define XB_TMO      128
#define XB_XCNT(j)  (256  + 64 * (j))
#define XB_XSUB(j)  (1280 + 64 * (j))
#define XB_XGEN(j)  (2304 + 64 * (j))
#define XB_TOP      3328
#define XB_TOPGEN   3392
#define XCD_BAR_WORDS 3456
#define XB_SPIN_CAP (1u << 22)

__device__ __forceinline__ unsigned xb_ld(unsigned* p)              { return __hip_atomic_load(p, __ATOMIC_RELAXED, __HIP_MEMORY_SCOPE_AGENT); }
__device__ __forceinline__ unsigned xb_add(unsigned* p, unsigned v) { return __hip_atomic_fetch_add(p, v, __ATOMIC_RELAXED, __HIP_MEMORY_SCOPE_AGENT); }
__device__ __forceinline__ unsigned xb_xcc_id() { return (unsigned)__builtin_amdgcn_s_getreg((3 << 11) | 20) & 0xFu; }
#define XB_SPIN(cond, bar) do { unsigned _sp = 0; while (cond) { __builtin_amdgcn_s_sleep(1); \
    if ((++_sp & 255u) == 0u) { if (xb_ld(&(bar)[XB_TMO])) break; if (_sp > XB_SPIN_CAP) { atomicAdd(&(bar)[XB_TMO], 1u); break; } } } } while (0)

struct XcdBarrier { unsigned* bar; unsigned x; volatile LAS unsigned* st; };

__device__ __forceinline__ XcdBarrier xcd_barrier_post(unsigned* bar, volatile LAS unsigned* st) {
    XcdBarrier b; b.bar = bar; b.x = xb_xcc_id(); b.st = st;
    if (threadIdx.x == 0) (void)xb_add(&bar[XB_XCNT(b.x)], 1u);
    return b;
}
__device__ __forceinline__ void xcd_barrier_complete(unsigned* bar, unsigned x, unsigned& nloc, unsigned& nx) {
    const unsigned G = gridDim.x * gridDim.y * gridDim.z;
    unsigned sum, cnt, mine, sp = 0u;
    for (;;) {
        sum = 0u; cnt = 0u; mine = 0u;
#pragma unroll
        for (unsigned j = 0; j < 16; ++j) { const unsigned c = xb_ld(&bar[XB_XCNT(j)]); sum += c; cnt += (c > 0u) ? 1u : 0u; mine = (j == x) ? c : mine; }
        if (sum == G) break;
        __builtin_amdgcn_s_sleep(1);
        if ((++sp & 255u) == 0u) { if (xb_ld(&bar[XB_TMO])) break; if (sp > XB_SPIN_CAP) { atomicAdd(&bar[XB_TMO], 1u); break; } }
    }
    nloc = mine > 0u ? mine : 1u; nx = cnt > 0u ? cnt : 1u;
}
__device__ __forceinline__ void xcd_barrier(const XcdBarrier& b) {
    asm volatile("s_waitcnt vmcnt(0)" ::: "memory");
    __syncthreads();
    if (threadIdx.x == 0) {
        unsigned* bar = b.bar;
        __builtin_amdgcn_s_waitcnt(0);
        unsigned nloc = b.st[0], nx = b.st[1];
        if (nloc == 0u) { xcd_barrier_complete(bar, b.x, nloc, nx); b.st[0] = nloc; b.st[1] = nx; }
        const unsigned old = xb_add(&bar[XB_XSUB(b.x)], 1u);
        const unsigned gen = old / nloc;
        if (old + 1u == (gen + 1u) * nloc) {
            __builtin_amdgcn_fence(__ATOMIC_RELEASE, "agent");
            asm volatile("s_waitcnt vmcnt(0)" ::: "memory");
            const unsigned og = xb_add(&bar[XB_TOP], 1u);
            const unsigned tg = og / nx;
            if (og + 1u == (tg + 1u) * nx) xb_add(&bar[XB_TOPGEN], 1u);
            else XB_SPIN(xb_ld(&bar[XB_TOPGEN]) == tg, bar);
            __builtin_amdgcn_fence(__ATOMIC_ACQUIRE, "agent");
            xb_add(&bar[XB_XGEN(b.x)], 1u);
            asm volatile("s_waitcnt vmcnt(0)" ::: "memory");
        } else {
            XB_SPIN(xb_ld(&bar[XB_XGEN(b.x)]) == gen, bar);
            __builtin_amdgcn_fence(__ATOMIC_ACQUIRE, "agent");
            asm volatile("s_waitcnt vmcnt(0)" ::: "memory");
        }
    }
    __syncthreads();
}

namespace pg8 {
constexpr int BM = 256, BK = 64, HALF = 128, HTB = HALF * BK * 2, STAGE_BYTES = 8 * HTB, NXCD = 8, WGM = 8;
__host__ __device__ __forceinline__ int lds_byte(int r, int c) { const int st = (r >> 4) * 2 + (c >> 5), rr = r & 15, cc = c & 31, ob = rr * 64 + cc * 2; return st * 1024 + (ob ^ (((ob >> 9) & 1) << 5)); }
__host__ __device__ __forceinline__ void stage_rc(int b, int& R, int& C) { const int st = b / 1024, sb = b % 1024, swz = sb ^ (((sb >> 9) & 1) << 5); R = (st >> 1) * 16 + swz / 64; C = (st & 1) * 32 + (swz % 64) / 2; }
__host__ __device__ __forceinline__ int perm32(int rho) { const int n = rho >> 4, i = rho & 15; return 8 * (i >> 2) + 4 * n + (i & 3); }

struct Unit { int pm, pn, e; };
struct Gemm { const void* A; const void* Bt; int K; size_t estride; const int* arow; };

struct StaticOrder {
    int nM, nN, nwg, G, c, i;
    __device__ void init(int M, int N, int G_, int c_) { nM = M / BM; nN = N / BM; nwg = nM * nN; G = G_; c = c_; i = 0; }
    __device__ bool next(Unit& u) {
        const long L = (long)i * G + c; ++i; if (L >= nwg) return false;
        int wgid = (int)L; { const int q = nwg / NXCD, r = nwg % NXCD, xcd = wgid % NXCD, off = wgid / NXCD; wgid = (xcd < r ? xcd * (q + 1) : r * (q + 1) + (xcd - r) * q) + off; }
        const int nig = WGM * nN, gid = wgid / nig, fm = gid * WGM, gsz = (nM - fm) < WGM ? (nM - fm) : WGM;
        u.pm = fm + ((wgid % nig) % gsz); u.pn = (wgid % nig) / gsz; u.e = 0; return true;
    }
};
struct MoeOrder {
    int nPanels, nN, G, c, i; const LAS int* panel_e;
    __device__ void init(int nPanels_, int nN_, int G_, int c_, const LAS int* pe) { nPanels = nPanels_; nN = nN_; G = G_; c = c_; i = 0; panel_e = pe; }
    __device__ bool next(Unit& u) {
        const int PB = 256 / nN;
        const int nblk = (nPanels + PB - 1) / PB;
        for (;;) {
            const long L = (long)i * G + c; ++i;
            const int blk = (int)(L >> 8), r = (int)(L & 255), x = r & 7, j = r >> 3;
            if (blk >= nblk) return false;
            int pm, pn;
            if (nN == 16) { pm = blk * 16 + 4 * (x >> 1) + (j & 3); pn = 8 * (x & 1) + (j >> 2); }
            else          { pm = blk * 32 + 4 * x + (j & 3);        pn = j >> 2; }
            if (pm < nPanels) { u.pm = pm; u.pn = pn; u.e = panel_e[pm]; return true; }
        }
    }
};

template <class Epi, class Sched, bool FP8 = false>
__device__ __forceinline__ void gemm_phase(LAS unsigned char* lds, const Gemm g, Sched& S, const Epi& E) {
    const int tid = threadIdx.x, wid = __builtin_amdgcn_readfirstlane(tid >> 6), lane = tid & 63, wr = wid >> 2, wc = wid & 3, fr = lane & 15, fq = lane >> 4;
    const int K = g.K; const int pitch = FP8 ? K : 2 * K; const int nt = pitch / 128;
    unsigned voffA[2], voffB[2];
#pragma unroll
    for (int i = 0; i < 2; ++i) { int R, C; stage_rc(tid * 16 + i * 8192, R, C); const int Rb = Epi::PERM ? ((R & ~31) + perm32(R & 31)) : R;
        voffA[i] = (unsigned)(R * pitch + C * 2); voffB[i] = (unsigned)(Rb * pitch + C * 2); }
    const size_t kstep = (size_t)(BK * 2);
    const size_t hstep = (size_t)HALF * pitch;
    const size_t tstep = 2 * hstep;
    int RA[2], CA[2];
#pragma unroll
    for (int i = 0; i < 2; ++i) stage_rc(tid * 16 + i * 8192, RA[i], CA[i]);
    const bool gather = g.arow != nullptr;
    const size_t hsA = gather ? 0 : hstep;
    unsigned vA0[2] = {voffA[0], voffA[1]}, vA1[2] = {voffA[0], voffA[1]}, nA0[2] = {voffA[0], voffA[1]}, nA1[2] = {voffA[0], voffA[1]};
#define PG8_AOFF(dst0, dst1, u) do { if (gather) { _Pragma("unroll") for (int i = 0; i < 2; ++i) { \
        dst0[i] = (unsigned)g.arow[(u).pm * 256 + RA[i]] * (unsigned)pitch + (unsigned)(CA[i] * 2); dst1[i] = (unsigned)g.arow[(u).pm * 256 + 128 + RA[i]] * (unsigned)pitch + (unsigned)(CA[i] * 2); } } } while (0)
    const unsigned ldsw = (unsigned)wid * 1024u;
    const int aoff = lds_byte(wr * 64 + fr, fq * 8), boff = lds_byte(wc * 32 + fr, fq * 8);
#define PG8_SA(b, h) (((b) * 2 + (h)) * HTB)
#define PG8_SB(b, h) ((4 + (b) * 2 + (h)) * HTB)
#define PG8_STAGE(bufoff, gbase, voff) do { _Pragma("unroll") for (int _i = 0; _i < 2; ++_i) \
        __builtin_amdgcn_global_load_lds((const unsigned*)((const char*)(gbase) + (voff)[_i]), (LAS unsigned*)(lds + (bufoff) + ldsw + _i * 8192), 16, 0, 0); } while (0)
#define PG8_LD8(p) __builtin_shufflevector(*(const LAS i32x4*)(p), *(const LAS i32x4*)((p) + 1024), 0, 1, 2, 3, 4, 5, 6, 7)
#define PG8_LDA(dst, b, h) do { _Pragma("unroll") for (int m = 0; m < 4; ++m) { if constexpr (FP8) dst##8[m] = PG8_LD8(lds + PG8_SA(b, h) + aoff + m * 2048); \
        else { _Pragma("unroll") for (int k = 0; k < 2; ++k) dst[m][k] = *(const LAS bf16x8*)(lds + PG8_SA(b, h) + aoff + m * 2048 + k * 1024); } } } while (0)
#define PG8_LDB(dst, b, h) do { _Pragma("unroll") for (int n = 0; n < 2; ++n) { if constexpr (FP8) dst##8[n] = PG8_LD8(lds + PG8_SB(b, h) + boff + n * 2048); \
        else { _Pragma("unroll") for (int k = 0; k < 2; ++k) dst[n][k] = *(const LAS bf16x8*)(lds + PG8_SB(b, h) + boff + n * 2048 + k * 1024); } } } while (0)
#define PG8_MMA(ai, bj, At, Bt) do { __builtin_amdgcn_s_setprio(1); _Pragma("unroll") for (int m = 0; m < 4; ++m) _Pragma("unroll") for (int n = 0; n < 2; ++n) { \
        if constexpr (FP8) asm volatile("v_mfma_scale_f32_16x16x128_f8f6f4 %0, %1, %2, %0, %3, %3 op_sel_hi:[0,0,0]" : "+v"(acc[ai][bj][m][n]) : "v"(Bt##8[n]), "v"(At##8[m]), "v"(scl1)); \
        else { _Pragma("unroll") for (int k = 0; k < 2; ++k) acc[ai][bj][m][n] = __builtin_amdgcn_mfma_f32_16x16x32_bf16(Bt[n][k], At[m][k], acc[ai][bj][m][n], 0, 0, 0); } } \
        __builtin_amdgcn_s_setprio(0); } while (0)
#define PG8_WAIT_V(n) asm volatile("s_waitcnt vmcnt(" #n ")" ::: "memory")
#define PG8_WAIT_L(n) asm volatile("s_waitcnt lgkmcnt(" #n ")" ::: "memory")
#define PG8_BAR __builtin_amdgcn_s_barrier()
#define PG8_SCHED __builtin_amdgcn_sched_barrier(0)
    Unit cur, nxt;
    if (!S.next(cur)) return;
    const unsigned scl1 = 0x7f7f7f7fu;
    f32x4 acc[2][2][4][2];
#pragma unroll
    for (int a = 0; a < 2; ++a)
#pragma unroll
        for (int b = 0; b < 2; ++b)
#pragma unroll
            for (int m = 0; m < 4; ++m)
#pragma unroll
                for (int n = 0; n < 2; ++n) acc[a][b][m][n] = (f32x4){0.f, 0.f, 0.f, 0.f};
    bf16x8 At[4][2], B0[2][2], B1[2][2]; i32x8 At8[4], B08[2], B18[2];
    const char* cA = (const char*)g.A + (gather ? (size_t)0 : (size_t)cur.pm * tstep); const char* cB = (const char*)g.Bt + (size_t)cur.e * g.estride + (size_t)cur.pn * tstep;
    PG8_AOFF(vA0, vA1, cur);
    PG8_STAGE(PG8_SB(0, 0), cB, voffB); PG8_STAGE(PG8_SB(0, 1), cB + hstep, voffB); PG8_STAGE(PG8_SA(0, 0), cA, vA0); PG8_STAGE(PG8_SA(0, 1), cA + hsA, vA1);
    if (wr == 1) PG8_BAR;
    PG8_WAIT_V(2); PG8_BAR;
    PG8_STAGE(PG8_SB(1, 0), cB + kstep, voffB); PG8_STAGE(PG8_SA(1, 0), cA + kstep, vA0); PG8_STAGE(PG8_SB(1, 1), cB + hstep + kstep, voffB);
    PG8_WAIT_V(6); PG8_BAR;
    for (;;) {
        const bool has_next = S.next(nxt);
        const char* nA = has_next ? (const char*)g.A + (gather ? (size_t)0 : (size_t)nxt.pm * tstep) : cA;
        if (has_next) PG8_AOFF(nA0, nA1, nxt);
        const char* nB = has_next ? (const char*)g.Bt + (size_t)nxt.e * g.estride + (size_t)nxt.pn * tstep : cB;
        for (int t = 0; t < nt; t += 2) {
            const bool last = (t == nt - 2);
            const char* a1 = cA + (size_t)(t + 1) * kstep;
            const char* a2 = last ? nA : cA + (size_t)(t + 2) * kstep; const char* b2 = last ? nB : cB + (size_t)(t + 2) * kstep;
            const char* a3 = a2 + kstep; const char* b3 = b2 + kstep;
            PG8_LDB(B0, 0, 0); PG8_LDB(B1, 0, 1); PG8_SCHED; PG8_LDA(At, 0, 0); PG8_STAGE(PG8_SA(1, 1), a1 + hsA, vA1);
            if (last && has_next) { vA0[0] = nA0[0]; vA0[1] = nA0[1]; vA1[0] = nA1[0]; vA1[1] = nA1[1]; }
            PG8_WAIT_V(8); PG8_WAIT_L(0); PG8_BAR; PG8_MMA(0, 0, At, B0); PG8_MMA(0, 1, At, B1); PG8_BAR; PG8_SCHED;
            PG8_LDA(At, 0, 1); PG8_STAGE(PG8_SB(0, 0), b2, voffB); PG8_STAGE(PG8_SB(0, 1), b2 + hstep, voffB); PG8_STAGE(PG8_SA(0, 0), a2, vA0);
            PG8_WAIT_V(8); PG8_WAIT_L(0); PG8_BAR; PG8_MMA(1, 0, At, B0); PG8_MMA(1, 1, At, B1); PG8_BAR; PG8_SCHED;
            PG8_LDB(B0, 1, 0); PG8_LDB(B1, 1, 1); PG8_SCHED; PG8_LDA(At, 1, 0); PG8_STAGE(PG8_SA(0, 1), a2 + hsA, vA1);
            PG8_WAIT_V(8); PG8_WAIT_L(0); PG8_BAR; PG8_MMA(0, 0, At, B0); PG8_MMA(0, 1, At, B1); PG8_BAR; PG8_SCHED;
            PG8_LDA(At, 1, 1); PG8_STAGE(PG8_SB(1, 0), b3, voffB); PG8_STAGE(PG8_SB(1, 1), b3 + hstep, voffB); PG8_STAGE(PG8_SA(1, 0), a3, vA0);
            PG8_WAIT_V(8); PG8_WAIT_L(0); PG8_BAR; PG8_MMA(1, 0, At, B0); PG8_MMA(1, 1, At, B1); PG8_BAR; PG8_SCHED;
        }
        if (wr == 0) PG8_BAR;
        if constexpr (FP8) {
#pragma unroll
            for (int a = 0; a < 2; ++a)
#pragma unroll
                for (int b = 0; b < 2; ++b) asm volatile("s_nop 15" : "+v"(acc[a][b][0][0]), "+v"(acc[a][b][0][1]), "+v"(acc[a][b][1][0]), "+v"(acc[a][b][1][1]), "+v"(acc[a][b][2][0]), "+v"(acc[a][b][2][1]), "+v"(acc[a][b][3][0]), "+v"(acc[a][b][3][1]));
        }
        E(acc, cur, wr, wc, fr, fq);
        if (!has_next) break;
#pragma unroll
        for (int a = 0; a < 2; ++a)
#pragma unroll
            for (int b = 0; b < 2; ++b)
#pragma unroll
                for (int m = 0; m < 4; ++m)
#pragma unroll
                    for (int n = 0; n < 2; ++n) acc[a][b][m][n] = (f32x4){0.f, 0.f, 0.f, 0.f};
        cur = nxt; cA = nA; cB = nB;
        if (wr == 1) PG8_BAR;
    }
    PG8_WAIT_V(0);
    PG8_BAR;
#undef PG8_AOFF
#undef PG8_SA
#undef PG8_SB
#undef PG8_STAGE
#undef PG8_LDA
#undef PG8_LDB
#undef PG8_MMA
#undef PG8_LD8
#undef PG8_WAIT_V
#undef PG8_WAIT_L
#undef PG8_BAR
#undef PG8_SCHED
}

struct EpiBf16 {
    static constexpr bool PERM = true;
    bf16_t* O; int ldc; const float* bias; int bias_estride; float ascale;
    __device__ __forceinline__ void operator()(const f32x4 (&acc)[2][2][4][2], const Unit& u, int wr, int wc, int fr, int fq) const {
        const int row0 = u.pm * BM + wr * 64 + fr; const int col0 = u.pn * BM + wc * 32 + 8 * fq;
        f32x4 bv[2][2];
#pragma unroll
        for (int bj = 0; bj < 2; ++bj)
#pragma unroll
            for (int n = 0; n < 2; ++n) bv[bj][n] = bias ? *(const f32x4*)(bias + (size_t)u.e * bias_estride + col0 + bj * HALF + 4 * n) : (f32x4){0.f, 0.f, 0.f, 0.f};
#pragma unroll
        for (int ai = 0; ai < 2; ++ai)
#pragma unroll
            for (int m = 0; m < 4; ++m) { bf16_t* rowp = O + (size_t)(row0 + ai * HALF + m * 16) * ldc + col0;
#pragma unroll
                for (int bj = 0; bj < 2; ++bj) { const f32x4 v0 = acc[ai][bj][m][0] * ascale + bv[bj][0], v1 = acc[ai][bj][m][1] * ascale + bv[bj][1];
                    u32x4 w; w.x = cvt_pk_bf16(v0[0], v0[1]); w.y = cvt_pk_bf16(v0[2], v0[3]); w.z = cvt_pk_bf16(v1[0], v1[1]); w.w = cvt_pk_bf16(v1[2], v1[3]);
                    *(u32x4*)(rowp + bj * HALF) = w; } }
    }
};
__device__ __forceinline__ float swiglu1(float ug, float ul) {
    ug = fminf(ug, 7.0f); ul = fminf(fmaxf(ul, -7.0f), 7.0f);
    return ug * __builtin_amdgcn_rcpf(1.0f + __expf(-1.702f * ug)) * (ul + 1.0f);
}
struct EpiSwiglu {
    static constexpr bool PERM = true;
    unsigned char* O; const float* b1;
    __device__ __forceinline__ void operator()(const f32x4 (&acc)[2][2][4][2], const Unit& u, int wr, int wc, int fr, int fq) const {
        const int row0 = u.pm * BM + wr * 64 + fr; const int c0 = u.pn * 128 + wc * 32 + 8 * fq;
        const float* bg = b1 + (size_t)u.e * 4096 + c0; const float* bl = bg + 2048;
        f32x4 bgv[2], blv[2];
#pragma unroll
        for (int n = 0; n < 2; ++n) { bgv[n] = *(const f32x4*)(bg + 4 * n); blv[n] = *(const f32x4*)(bl + 4 * n); }
#pragma unroll
        for (int ai = 0; ai < 2; ++ai)
#pragma unroll
            for (int m = 0; m < 4; ++m) {
                float a[8];
#pragma unroll
                for (int n = 0; n < 2; ++n)
#pragma unroll
                    for (int j = 0; j < 4; ++j) a[4 * n + j] = ACT8_SCALE * swiglu1(acc[ai][0][m][n][j] * (1.0f / W8_SCALE) + bgv[n][j], acc[ai][1][m][n][j] * (1.0f / W8_SCALE) + blv[n][j]);
                u32x2 w; w.x = pack4_fp8(a[0], a[1], a[2], a[3]); w.y = pack4_fp8(a[4], a[5], a[6], a[7]);
                *(u32x2*)(O + (size_t)(row0 + ai * HALF + m * 16) * 2048 + c0) = w;
            }
    }
};

struct EpiGate {
    static constexpr bool PERM = true;
    bf16_t* O; const bf16_t* Gt; int accum;
    __device__ __forceinline__ void operator()(const f32x4 (&acc)[2][2][4][2], const Unit& u, int wr, int wc, int fr, int fq) const {
        const int row0 = u.pm * BM + wr * 64 + fr; const int col0 = u.pn * BM + wc * 32 + 8 * fq;
#pragma unroll
        for (int ai = 0; ai < 2; ++ai)
#pragma unroll
            for (int m = 0; m < 4; ++m) { const size_t row = (size_t)(row0 + ai * HALF + m * 16);
#pragma unroll
                for (int bj = 0; bj < 2; ++bj) { const int c = col0 + bj * HALF;
                    const u32x4 gw = *(const u32x4*)(Gt + row * DINP + c);
                    float r[8];
#pragma unroll
                    for (int q = 0; q < 4; ++q) { r[2 * q] = sigmoidf_(bf_lo(gw[q])) * acc[ai][bj][m][q >> 1][(2 * q) & 3]; r[2 * q + 1] = sigmoidf_(bf_hi(gw[q])) * acc[ai][bj][m][q >> 1][(2 * q + 1) & 3]; }
                    bf16_t* op = O + row * 2048 + c;
                    if (accum) { const u32x4 ow = *(const u32x4*)op;
#pragma unroll
                        for (int q = 0; q < 4; ++q) { r[2 * q] += bf_lo(ow[q]); r[2 * q + 1] += bf_hi(ow[q]); } }
                    u32x4 w; w.x = cvt_pk_bf16(r[0], r[1]); w.y = cvt_pk_bf16(r[2], r[3]); w.z = cvt_pk_bf16(r[4], r[5]); w.w = cvt_pk_bf16(r[6], r[7]);
                    *(u32x4*)op = w; } }
    }
};
struct EpiResid {
    static constexpr bool PERM = false;
    const float* x; const float* gt; float* X1;
    __device__ __forceinline__ void operator()(const f32x4 (&acc)[2][2][4][2], const Unit& u, int wr, int wc, int fr, int fq) const {
        const int row0 = u.pm * BM + wr * 64 + fr; const int col0 = u.pn * BM + wc * 32 + 4 * fq;
#pragma unroll
        for (int ai = 0; ai < 2; ++ai)
#pragma unroll
            for (int m = 0; m < 4; ++m) { const size_t row = (size_t)(row0 + ai * HALF + m * 16);
#pragma unroll
                for (int bj = 0; bj < 2; ++bj)
#pragma unroll
                    for (int n = 0; n < 2; ++n) { const int c = col0 + bj * HALF + n * 16;
                        const f32x4 xv = *(const f32x4*)(x + row * 2048 + c), g = *(const f32x4*)(gt + c);
                        *(f32x4*)(X1 + row * 2048 + c) = xv + g * acc[ai][bj][m][n]; } }
    }
};
}

#ifndef MK_REP
#define MK_REP 0
#endif
#ifndef MK_REP2
#define MK_REP2 0
#endif
struct Args { const void* in[22]; float* out; unsigned char* ws; int ph_lo, ph_hi, flags, pad; };
enum { PH_PRO = 0, PH_H, PH_INPROJ, PH_POST, PH_SCORE, PH_SELECT, PH_ATTN, PH_OP1, PH_OP2, PH_WOUT, PH_ROUTER, PH_SCATTER, PH_MOE1, PH_MOE2, PH_FINAL, NPH };
constexpr int FLAG_MIXER = 1, FLAG_ATT = 2, FLAG_MOE = 4;

__device__ __forceinline__ int dest_row(int mode, int n) {
    if (mode == 1) return n < 2640 ? n : n + 176;
    if (mode == 2) { const int g = n >> 11, c = n & 2047; return (c >> 7) * 256 + g * 128 + (c & 127); }
    return n;
}
__device__ __forceinline__ void convert_item(const float* __restrict__ W, int K, int N, bf16_t* WT, int mode, int item, int lane, LAS unsigned char* scr) {
    const int nblk = (N + 63) >> 6; const int kb = item / nblk, nb = item - kb * nblk; const int k0 = kb * 128, n0 = nb * 64;
    const int c4 = lane & 15, kr = lane >> 4;
    const bool ok = (n0 + 4 * c4) < N;
    const float* src = W + (size_t)(k0 + 2 * kr) * N + n0 + 4 * c4;
#pragma unroll 4
    for (int i = 0; i < 16; ++i) {
        f32x4 v0 = (f32x4){0.f, 0.f, 0.f, 0.f}, v1 = v0;
        if (ok) { v0 = *(const f32x4*)(src + (size_t)(8 * i) * N); v1 = *(const f32x4*)(src + (size_t)(8 * i + 1) * N); }
        const int kk = 8 * i + 2 * kr;
#pragma unroll
        for (int e = 0; e < 4; ++e) *(LAS unsigned*)(scr + (4 * c4 + e) * 272 + kk * 2) = cvt_pk_bf16(v0[e], v1[e]);
    }
    LDS_WAIT(); asm volatile("" ::: "memory");
#pragma unroll 4
    for (int j = 0; j < 16; ++j) {
        const int q = j * 64 + lane, n = q >> 4, ch = q & 15;
        const u32x4 v = *(const LAS u32x4*)(scr + n * 272 + ch * 16);
        if (n0 + n < N) *(u32x4*)(WT + (size_t)dest_row(mode, n0 + n) * K + k0 + ch * 8) = v;
    }
    LDS_WAIT(); asm volatile("" ::: "memory");
}


__device__ __forceinline__ bf16_t f2bf(float f) { unsigned u = __float_as_uint(f); return (bf16_t)((u + 0x7fffu + ((u >> 16) & 1u)) >> 16); }
__device__ __forceinline__ float bfx(const u32x4& w, int i) { const unsigned u = w[i >> 1]; return (i & 1) ? bf_hi(u) : bf_lo(u); }
__device__ __forceinline__ void rope_sc(float pos, float inv, float& sn, float& cs) {
    const float ang = pos * inv;
    const double a = (double)ang; const double n = __builtin_rint(a * 0.15915494309189535); const float r = (float)(a - n * 6.283185307179586);
    sn = sinf(r); cs = cosf(r);
}
__device__ __forceinline__ void post_token(bf16_t* PROJ, bf16_t* KI, bf16_t* KC, bf16_t* VC, const int* positions, const float* kng, const float* knb, int t, int lane) {
    const float pos = (float)positions[t];
    bf16_t* row = PROJ + (size_t)t * DINP;
    float sn, cs;
#pragma unroll
    for (int i = 0; i < 2; ++i) {
        const int pp = lane + 64 * i, hd = pp >> 4, ii = pp & 15;
        rope_sc(pos, powf(500000.0f, -(float)ii * (1.0f / 16.0f)), sn, cs);
        bf16_t* p = row + CQ + hd * 128 + ii; const float a = bf2f(p[0]), b = bf2f(p[16]);
        p[0] = f2bf(a * cs - b * sn); p[16] = f2bf(b * cs + a * sn);
    }
#pragma unroll
    for (int i = 0; i < 2; ++i) {
        const int pp = lane + 64 * i, hd = pp >> 3, ii = pp & 7;
        rope_sc(pos, powf(500000.0f, -(float)ii * (1.0f / 8.0f)), sn, cs);
        bf16_t* p = row + CQI + hd * 64 + ii; const float a = bf2f(p[0]), b = bf2f(p[8]);
        p[0] = f2bf(a * cs - b * sn); p[8] = f2bf(b * cs + a * sn);
    }
    if (lane < 32) {
        const int g = lane >> 4, ii = lane & 15;
        rope_sc(pos, powf(500000.0f, -(float)ii * (1.0f / 16.0f)), sn, cs);
        const bf16_t* p = row + CK + g * 128 + ii; const float a = bf2f(p[0]), b = bf2f(p[16]);
        bf16_t* o = KC + (size_t)t * 256 + g * 128 + ii; o[0] = f2bf(a * cs - b * sn); o[16] = f2bf(b * cs + a * sn);
    }
#pragma unroll
    for (int i = 0; i < 3; ++i) { const int idx = lane + 64 * i, g = idx / 96, r = idx - g * 96; KC[(size_t)t * 256 + g * 128 + 32 + r] = row[CK + g * 128 + 32 + r]; }
    *(u32x2*)(VC + (size_t)t * 256 + 4 * lane) = *(const u32x2*)(row + CV + 4 * lane);
    {
        const float v = bf2f(row[CKI + lane]);
        const float mean = wave_sum(v) * (1.0f / 64.0f); const float d = v - mean; const float var = wave_sum(d * d) * (1.0f / 64.0f);
        const float y = d * rsqrtf(var + NORM_EPS) * kng[lane] + knb[lane];
        const float other = __shfl_xor(y, 8);
        rope_sc(pos, powf(500000.0f, -(float)(lane & 7) * (1.0f / 8.0f)), sn, cs);
        float o = y;
        if (lane < 8) o = y * cs - other * sn; else if (lane < 16) o = y * cs + other * sn;
        KI[(size_t)t * 64 + lane] = f2bf(o);
    }
}

constexpr int HG_GB = 0, HG_Q1 = 33792, HG_Q2 = 51200, HG_K2 = 68608, HG_VT = 86016, HG_PB = 104448, HG_LB = 113664;
__device__ __forceinline__ void hgrn_cumsum(LAS unsigned char* lds, const bf16_t* PROJ, const float* lb_logits, int c, int h, int tid) {
    LAS float* GB = (LAS float*)(lds + HG_GB); LAS float* LB = (LAS float*)(lds + HG_LB);
    if (tid < 128) { const float l0 = lb_logits[h * 128 + tid], l1 = lb_logits[1024 + h * 128 + tid]; LB[tid] = 1.0f / (1.0f + expf(l1 - l0)); }
    __syncthreads();
    const int t = tid >> 3, dseg = tid & 7;
    const bf16_t* p = PROJ + (size_t)(c * 64 + t) * DINP + CHF + h * 128 + 16 * dseg;
    const u32x4 w0 = *(const u32x4*)p, w1 = *(const u32x4*)(p + 8);
#pragma unroll
    for (int i = 0; i < 16; ++i) { const float z = i < 8 ? bfx(w0, i) : bfx(w1, i - 8); const float lb = LB[16 * dseg + i]; GB[t * 128 + 16 * dseg + i] = logf(lb + (1.0f - lb) * sigmoidf_(z)); }
    __syncthreads();
    if (tid < 128) { float a = 0.f;
#pragma unroll 8
        for (int tt = 0; tt < 64; ++tt) { a += GB[tt * 128 + tid]; GB[tt * 128 + tid] = a; } }
    __syncthreads();
}
__device__ __forceinline__ void hgrn_vt(LAS unsigned char* lds, const bf16_t* PROJ, int c, int h, int tid) {
    const int s2 = tid & 31, eg = tid >> 5;
    const bf16_t* p = PROJ + (size_t)(c * 64 + 2 * s2) * DINP + CHI + h * 128 + 8 * eg;
    const u32x4 a = *(const u32x4*)p, b = *(const u32x4*)(p + DINP);
#pragma unroll
    for (int i = 0; i < 8; ++i) { const unsigned lo = (i & 1) ? (a[i >> 1] >> 16) : (a[i >> 1] & 0xffffu), hi = (i & 1) ? (b[i >> 1] >> 16) : (b[i >> 1] & 0xffffu);
        *(LAS unsigned*)(lds + HG_VT + (8 * eg + i) * 144 + s2 * 4) = lo | (hi << 16); }
}
__device__ __forceinline__ void hgrn_l1(LAS unsigned char* lds, const bf16_t* PROJ, const float* lb_logits, float* ST, float* DC, int c, int h, int tid, int wave, int lane) {
    hgrn_cumsum(lds, PROJ, lb_logits, c, h, tid);
    const LAS float* GB = (const LAS float*)(lds + HG_GB); const LAS float* LB = (const LAS float*)(lds + HG_LB);
    {
        const int s2 = tid & 31, dg = tid >> 5;
        const bf16_t* p = PROJ + (size_t)(c * 64 + 2 * s2) * DINP + CHF + h * 128 + 8 * dg;
        const u32x4 a = *(const u32x4*)p, b = *(const u32x4*)(p + DINP);
#pragma unroll
        for (int i = 0; i < 8; ++i) { const int d = 8 * dg + i; const float lb = LB[d], b63 = GB[63 * 128 + d];
            const float k0 = (1.0f - lb) * (1.0f - sigmoidf_(bfx(a, i))), k1 = (1.0f - lb) * (1.0f - sigmoidf_(bfx(b, i)));
            const float v0 = k0 * __expf(b63 - GB[(2 * s2) * 128 + d]), v1 = k1 * __expf(b63 - GB[(2 * s2 + 1) * 128 + d]);
            *(LAS unsigned*)(lds + HG_Q1 + d * 144 + s2 * 4) = cvt_pk_bf16(v0, v1); }
    }
    hgrn_vt(lds, PROJ, c, h, tid);
    __syncthreads();
    const int fr = lane & 15, fq = lane >> 4;
    bf16x8 af[2];
#pragma unroll
    for (int ks = 0; ks < 2; ++ks) af[ks] = *(const LAS bf16x8*)(lds + HG_VT + (16 * wave + fr) * 144 + (32 * ks + 8 * fq) * 2);
    float* dst = ST + ((size_t)(c * 8 + h) * 128) * 128;
#pragma unroll 2
    for (int dt = 0; dt < 8; ++dt) {
        f32x4 acc = (f32x4){0.f, 0.f, 0.f, 0.f};
#pragma unroll
        for (int ks = 0; ks < 2; ++ks) { const bf16x8 bfr = *(const LAS bf16x8*)(lds + HG_Q1 + (16 * dt + fr) * 144 + (32 * ks + 8 * fq) * 2); acc = __builtin_amdgcn_mfma_f32_16x16x32_bf16(af[ks], bfr, acc, 0, 0, 0); }
#pragma unroll
        for (int r = 0; r < 4; ++r) dst[(size_t)(16 * wave + 4 * fq + r) * 128 + 16 * dt + fr] = acc[r];
    }
    if (tid < 128) DC[(size_t)(c * 8 + h) * 128 + tid] = __expf(GB[63 * 128 + tid]);
    __syncthreads();
}
__device__ __forceinline__ void hgrn_l3(LAS unsigned char* lds, const bf16_t* PROJ, const float* lb_logits, const float* ST, const float* norm_g, bf16_t* REC, int c, int h, int tid, int wave, int lane) {
    hgrn_cumsum(lds, PROJ, lb_logits, c, h, tid);
    const LAS float* GB = (const LAS float*)(lds + HG_GB); const LAS float* LB = (const LAS float*)(lds + HG_LB);
    {
        const int t = tid >> 3, dseg = tid & 7;
        const bf16_t* pf = PROJ + (size_t)(c * 64 + t) * DINP + CHF + h * 128 + 16 * dseg; const bf16_t* pq = pf - CHF + CHQ;
        const u32x4 f0 = *(const u32x4*)pf, f1 = *(const u32x4*)(pf + 8), q0 = *(const u32x4*)pq, q1 = *(const u32x4*)(pq + 8);
        unsigned o1[8], o2[8], o3[8];
#pragma unroll
        for (int i = 0; i < 16; i += 2) {
            float a1[2], a2[2], a3[2];
#pragma unroll
            for (int j = 0; j < 2; ++j) { const int d = 16 * dseg + i + j; const float lb = LB[d], b = GB[t * 128 + d], br = GB[31 * 128 + d];
                const float z = (i + j) < 8 ? bfx(f0, i + j) : bfx(f1, i + j - 8), qv = (i + j) < 8 ? bfx(q0, i + j) : bfx(q1, i + j - 8);
                const float k = (1.0f - lb) * (1.0f - sigmoidf_(z)), q = siluf_(qv);
                a1[j] = q * __expf(b); a2[j] = q * __expf(b - br); a3[j] = k * __expf(br - b); }
            o1[i >> 1] = cvt_pk_bf16(a1[0], a1[1]); o2[i >> 1] = cvt_pk_bf16(a2[0], a2[1]); o3[i >> 1] = cvt_pk_bf16(a3[0], a3[1]);
        }
        LAS u32x4* d1 = (LAS u32x4*)(lds + HG_Q1 + t * 272 + dseg * 32); LAS u32x4* d2 = (LAS u32x4*)(lds + HG_Q2 + t * 272 + dseg * 32); LAS u32x4* d3 = (LAS u32x4*)(lds + HG_K2 + t * 272 + dseg * 32);
        d1[0] = (u32x4){o1[0], o1[1], o1[2], o1[3]}; d1[1] = (u32x4){o1[4], o1[5], o1[6], o1[7]};
        d2[0] = (u32x4){o2[0], o2[1], o2[2], o2[3]}; d2[1] = (u32x4){o2[4], o2[5], o2[6], o2[7]};
        d3[0] = (u32x4){o3[0], o3[1], o3[2], o3[3]}; d3[1] = (u32x4){o3[4], o3[5], o3[6], o3[7]};
    }
    hgrn_vt(lds, PROJ, c, h, tid);
    __syncthreads();
    const int fr = lane & 15, fq = lane >> 4;
#pragma unroll
    for (int q = 0; q < 2; ++q) {
        const int tile = 2 * wave + q, tt = tile >> 2, stl = tile & 3;
        f32x4 acc = (f32x4){0.f, 0.f, 0.f, 0.f};
#pragma unroll
        for (int ks = 0; ks < 4; ++ks) { const bf16x8 a = *(const LAS bf16x8*)(lds + HG_Q2 + (16 * tt + fr) * 272 + (32 * ks + 8 * fq) * 2), b = *(const LAS bf16x8*)(lds + HG_K2 + (16 * stl + fr) * 272 + (32 * ks + 8 * fq) * 2);
            acc = __builtin_amdgcn_mfma_f32_16x16x32_bf16(a, b, acc, 0, 0, 0); }
#pragma unroll
        for (int r = 0; r < 4; ++r) { const int t = 16 * tt + 4 * fq + r, s = 16 * stl + fr; *(LAS bf16_t*)(lds + HG_PB + t * 144 + s * 2) = f2bf(s <= t ? acc[r] : 0.f); }
    }
    __syncthreads();
    {
        bf16x8 b1[2], b2[4];
#pragma unroll
        for (int ks = 0; ks < 2; ++ks) b1[ks] = *(const LAS bf16x8*)(lds + HG_VT + (16 * wave + fr) * 144 + (32 * ks + 8 * fq) * 2);
        const float* sp = ST + ((size_t)(c * 8 + h) * 128 + 16 * wave + fr) * 128 + 8 * fq;
#pragma unroll
        for (int ks = 0; ks < 4; ++ks) { const f32x4 x0 = *(const f32x4*)(sp + 32 * ks), x1 = *(const f32x4*)(sp + 32 * ks + 4);
            u32x4 w; w.x = cvt_pk_bf16(x0[0], x0[1]); w.y = cvt_pk_bf16(x0[2], x0[3]); w.z = cvt_pk_bf16(x1[0], x1[1]); w.w = cvt_pk_bf16(x1[2], x1[3]); b2[ks] = __builtin_bit_cast(bf16x8, w); }
        LAS float* OB = (LAS float*)(lds + HG_GB);
#pragma unroll
        for (int tt = 0; tt < 4; ++tt) {
            f32x4 acc = (f32x4){0.f, 0.f, 0.f, 0.f};
#pragma unroll
            for (int ks = 0; ks < 2; ++ks) { const bf16x8 a = *(const LAS bf16x8*)(lds + HG_PB + (16 * tt + fr) * 144 + (32 * ks + 8 * fq) * 2); acc = __builtin_amdgcn_mfma_f32_16x16x32_bf16(a, b1[ks], acc, 0, 0, 0); }
#pragma unroll
            for (int ks = 0; ks < 4; ++ks) { const bf16x8 a = *(const LAS bf16x8*)(lds + HG_Q1 + (16 * tt + fr) * 272 + (32 * ks + 8 * fq) * 2); acc = __builtin_amdgcn_mfma_f32_16x16x32_bf16(a, b2[ks], acc, 0, 0, 0); }
#pragma unroll
            for (int r = 0; r < 4; ++r) OB[(16 * tt + 4 * fq + r) * 132 + 16 * wave + fr] = acc[r];
        }
    }
    __syncthreads();
    {
        const int t = tid >> 3, es = tid & 7; const LAS float* OB = (const LAS float*)(lds + HG_GB);
        float o[16]; float ss = 0.f;
#pragma unroll
        for (int i = 0; i < 16; ++i) { o[i] = OB[t * 132 + 16 * es + i]; ss += o[i] * o[i]; }
        ss += __shfl_xor(ss, 1); ss += __shfl_xor(ss, 2); ss += __shfl_xor(ss, 4);
        const float rstd = rsqrtf(ss * (1.0f / 128.0f) + NORM_EPS);
        const bf16_t* pg = PROJ + (size_t)(c * 64 + t) * DINP + CHG + h * 128 + 16 * es;
        const u32x4 g0 = *(const u32x4*)pg, g1 = *(const u32x4*)(pg + 8);
        unsigned w[8];
#pragma unroll
        for (int i = 0; i < 16; i += 2) { const float ga = i < 8 ? bfx(g0, i) : bfx(g1, i - 8), gb = (i + 1) < 8 ? bfx(g0, i + 1) : bfx(g1, i + 1 - 8);
            w[i >> 1] = cvt_pk_bf16(o[i] * rstd * norm_g[16 * es + i] * siluf_(ga), o[i + 1] * rstd * norm_g[16 * es + i + 1] * siluf_(gb)); }
        u32x4* dst = (u32x4*)(REC + (size_t)(c * 64 + t) * 1024 + h * 128 + 16 * es);
        dst[0] = (u32x4){w[0], w[1], w[2], w[3]}; dst[1] = (u32x4){w[4], w[5], w[6], w[7]};
    }
    __syncthreads();
}

constexpr int SC_KT = 0, SC_SB = 36864, SC_SPITCH = 132;
__device__ __forceinline__ unsigned pk_f16(float a, float b) { return __builtin_bit_cast(unsigned, __builtin_amdgcn_cvt_pkrtz(a, b)); }
__device__ __forceinline__ void score_flush(LAS unsigned char* lds, unsigned short* SCORES, int t0, int kt, int tid) {
    const LAS float* sb = (const LAS float*)(lds + SC_SB + (kt & 1) * (32 * SC_SPITCH * 4));
    const int row = tid >> 4, seg = tid & 15;
    const f32x4 a = *(const LAS f32x4*)(sb + row * SC_SPITCH + seg * 8), b = *(const LAS f32x4*)(sb + row * SC_SPITCH + seg * 8 + 4);
    unsigned short* dst = SCORES + (size_t)(t0 + row) * S + kt * 128 + seg * 8;
    *(u32x4*)dst = (u32x4){pk_f16(a[0], a[1]), pk_f16(a[2], a[3]), pk_f16(b[0], b[1]), pk_f16(b[2], b[3])};
}
__device__ __forceinline__ void score_block(LAS unsigned char* lds, const bf16_t* PROJ, const bf16_t* KI, unsigned short* SCORES, int qb, int tid, int wave, int lane) {
    const int t0 = qb * 32, nkt = (t0 >> 7) + 1;
    const int r = lane & 31, hh = lane >> 5;
    bf16x8 Af[2][4]; float wv[2][16]; f32x2 wv2[2][8];
#pragma unroll
    for (int p = 0; p < 2; ++p) {
        const int tq = t0 + 4 * wave + 2 * p + (r >> 4); const bf16_t* qrow = PROJ + (size_t)tq * DINP + CQI + (r & 15) * 64 + 8 * hh;
#pragma unroll
        for (int ks = 0; ks < 4; ++ks) Af[p][ks] = *(const bf16x8*)(qrow + 16 * ks);
#pragma unroll
        for (int reg = 0; reg < 16; ++reg) { const int row = (reg & 3) + 8 * (reg >> 2) + 4 * hh; const int tw = t0 + 4 * wave + 2 * p + (row >> 4);
            wv[p][reg] = bf2f(PROJ[(size_t)tw * DINP + CWI + (row & 15)]) * (1.0f / 32.0f); }
#pragma unroll
        for (int i = 0; i < 8; ++i) wv2[p][i] = (f32x2){wv[p][2 * i], wv[p][2 * i + 1]};
    }
    const u32x2 tagsw = __builtin_amdgcn_permlane32_swap(0u, 1u, false, false); const int qsel = (int)tagsw[0];
    u32x4 stg[2];
#pragma unroll
    for (int i = 0; i < 2; ++i) { const int q = tid + 512 * i; stg[i] = *(const u32x4*)(KI + (size_t)(q >> 3) * 64 + (q & 7) * 8); }
#pragma unroll
    for (int i = 0; i < 2; ++i) { const int q = tid + 512 * i; *(LAS u32x4*)(lds + SC_KT + (q >> 3) * 144 + (q & 7) * 16) = stg[i]; }
    __syncthreads();
    for (int kt = 0; kt < nkt; ++kt) {
        const LAS unsigned char* buf = lds + SC_KT + (kt & 1) * 18432;
        LAS float* sb = (LAS float*)(lds + SC_SB + (kt & 1) * (32 * SC_SPITCH * 4));
        if (kt > 0) score_flush(lds, SCORES, t0, kt - 1, tid);
        if (kt + 1 < nkt) {
#pragma unroll
            for (int i = 0; i < 2; ++i) { const int q = tid + 512 * i; stg[i] = *(const u32x4*)(KI + (size_t)((kt + 1) * 128 + (q >> 3)) * 64 + (q & 7) * 8); }
        }
        for (int rep2 = 0; rep2 < ((MK_REP2) & 1) + 1; ++rep2) {
        f32x16 accP[2], accC[2];
#define SC_MFMA(cb) do { bf16x8 Bf[4]; _Pragma("unroll") for (int ks = 0; ks < 4; ++ks) Bf[ks] = *(const LAS bf16x8*)(buf + (32 * (cb) + r) * 144 + (16 * ks + 8 * hh) * 2); \
            _Pragma("unroll") for (int p = 0; p < 2; ++p) { _Pragma("unroll") for (int i = 0; i < 16; ++i) accC[p][i] = 0.f; \
                _Pragma("unroll") for (int ks = 0; ks < 4; ++ks) accC[p] = __builtin_amdgcn_mfma_f32_32x32x16_bf16(Af[p][ks], Bf[ks], accC[p], 0, 0, 0); } } while (0)
#define SC_RED(acc, cb) do { _Pragma("unroll") for (int p = 0; p < 2; ++p) { f32x2 s0 = {0.f, 0.f}, s1 = {0.f, 0.f}; \
            _Pragma("unroll") for (int reg = 0; reg < 8; reg += 2) { const f32x2 r0 = {relu_i(acc[p][reg]), relu_i(acc[p][reg + 1])}; const f32x2 r1 = {relu_i(acc[p][reg + 8]), relu_i(acc[p][reg + 9])}; \
                s0 = __builtin_elementwise_fma(wv2[p][reg >> 1], r0, s0); s1 = __builtin_elementwise_fma(wv2[p][4 + (reg >> 1)], r1, s1); } \
            const float p0 = s0[0] + s0[1], p1 = s1[0] + s1[1]; \
            const u32x2 sw = __builtin_amdgcn_permlane32_swap(__float_as_uint(p0), __float_as_uint(p1), false, false); \
            sb[(4 * wave + 2 * p + qsel) * SC_SPITCH + 32 * (cb) + r] = __uint_as_float(sw[0]) + __uint_as_float(sw[1]); } } while (0)
#define SC_INTERLEAVE() do { _Pragma("unroll") for (int i = 0; i < 8; ++i) { __builtin_amdgcn_sched_group_barrier(0x008, 1, 0); __builtin_amdgcn_sched_group_barrier(0x002, 8, 0); } } while (0)
        SC_MFMA(0);
        accP[0] = accC[0]; accP[1] = accC[1]; SC_MFMA(1); SC_RED(accP, 0); SC_INTERLEAVE();
        accP[0] = accC[0]; accP[1] = accC[1]; SC_MFMA(2); SC_RED(accP, 1); SC_INTERLEAVE();
        accP[0] = accC[0]; accP[1] = accC[1]; SC_MFMA(3); SC_RED(accP, 2); SC_INTERLEAVE();
        SC_RED(accC, 3);
#undef SC_MFMA
#undef SC_RED
#undef SC_INTERLEAVE
        }
        if (kt + 1 < nkt) {
#pragma unroll
            for (int i = 0; i < 2; ++i) { const int q = tid + 512 * i; *(LAS u32x4*)(lds + SC_KT + ((kt + 1) & 1) * 18432 + (q >> 3) * 144 + (q & 7) * 16) = stg[i]; }
        }
        __syncthreads();
    }
    score_flush(lds, SCORES, t0, nkt - 1, tid);
    __syncthreads();
}

__device__ __forceinline__ float wave_kth16(const float (&v)[16], int K) {
    const float NINF = -__builtin_inff();
    float mx = NINF, mn = __builtin_inff();
#pragma unroll
    for (int j = 0; j < 16; ++j) { mx = fmaxf(mx, v[j]); mn = fminf(mn, v[j] == NINF ? __builtin_inff() : v[j]); }
    mx = wave_max(mx); mn = -wave_max(-mn);
    int c = 0;
#pragma unroll
    for (int j = 0; j < 16; ++j) c += __popcll(__ballot(v[j] >= mx));
    if (c >= K) return mx;
    float lo = mn, hi = mx, tau = mn;
    for (int it = 0; it < 64; ++it) {
        const float mid = 0.5f * (lo + hi);
        if (!(mid > lo && mid < hi)) { tau = lo; break; }
        c = 0;
#pragma unroll
        for (int j = 0; j < 16; ++j) c += __popcll(__ballot(v[j] >= mid));
        if (c == K) { tau = mid; break; }
        if (c > K) lo = mid; else hi = mid;
        tau = lo;
    }
    return tau;
}
__device__ __forceinline__ int lanes_below(unsigned long long mask) { return (int)__builtin_amdgcn_mbcnt_hi((unsigned)(mask >> 32), __builtin_amdgcn_mbcnt_lo((unsigned)mask, 0u)); }
__device__ __forceinline__ float h2f(unsigned short h) { return (float)__builtin_bit_cast(_Float16, h); }
__device__ __forceinline__ float h2f_lo(unsigned u) { return h2f((unsigned short)(u & 0xffffu)); }
__device__ __forceinline__ float h2f_hi(unsigned u) { return h2f((unsigned short)(u >> 16)); }
__device__ __forceinline__ void select_row(LAS unsigned char* wl, const unsigned short* SCORES, int t, int lane) {
    LAS int* selw = (LAS int*)wl; LAS float* cval = (LAS float*)(wl + 1024); LAS int* cidx = (LAS int*)(wl + 5120);
    const float NINF = -__builtin_inff();
    const unsigned short* row = SCORES + (size_t)t * S; const int n = t + 1;
    float c[16]; int N;
    if (n <= 1024) {
#pragma unroll
        for (int j = 0; j < 16; ++j) { const int i = lane + 64 * j; c[j] = i < n ? h2f(row[i]) : NINF; }
        N = -1;
    } else {
        const int m = n >> 4; float s[16];
#pragma unroll
        for (int j = 0; j < 16; ++j) { const int i = lane + 64 * j; s[j] = i < m ? h2f(row[16 * i + 7]) : NINF; }
        int K = 32, cnt = 0;
        for (;;) {
            const float tlo = (K >= m) ? NINF : wave_kth16(s, K);
            cnt = 0;
            const int nq = (n + 511) >> 9;
            for (int q0 = 0; q0 < nq; q0 += 4) {
                u32x4 v[4];
#pragma unroll
                for (int u = 0; u < 4; ++u) { const int e = 8 * (lane + 64 * (q0 + u)); v[u] = (e <= t) ? *(const u32x4*)(row + e) : (u32x4){0xfc00fc00u, 0xfc00fc00u, 0xfc00fc00u, 0xfc00fc00u}; }
#pragma unroll
                for (int u = 0; u < 4; ++u) { const int e = 8 * (lane + 64 * (q0 + u));
#pragma unroll
                    for (int k = 0; k < 8; ++k) { const float x = (k & 1) ? h2f_hi(v[u][k >> 1]) : h2f_lo(v[u][k >> 1]);
                        const bool pred = (e + k <= t) && (x >= tlo); const unsigned long long mask = __ballot(pred);
                        if (mask) { const int pos = cnt + lanes_below(mask); if (pred && pos < 1024) { cval[pos] = x; cidx[pos] = e + k; } cnt += __popcll(mask); } } }
            }
            if (cnt >= 256 || K >= m) break;
            K *= 2;
        }
        N = cnt < 1024 ? cnt : 1024;
#pragma unroll
        for (int j = 0; j < 16; ++j) { const int i = lane + 64 * j; c[j] = i < N ? cval[i] : NINF; }
    }
    const float tau = wave_kth16(c, 256);
    int base = 0;
#pragma unroll
    for (int j = 0; j < 16; ++j) { const bool pred = c[j] >= tau; const unsigned long long mask = __ballot(pred);
        if (mask) { const int pos = base + lanes_below(mask); if (pred && pos < 256) selw[pos] = (N < 0) ? (lane + 64 * j) : cidx[lane + 64 * j]; base += __popcll(mask); } }
}

__device__ __forceinline__ void attn_query(LAS unsigned char* wl, const bf16_t* PROJ, const bf16_t* KC, const bf16_t* VC, bf16_t* ATT, int t, int lane) {
    LAS int* selw = (LAS int*)wl; LAS float* L = (LAS float*)(wl + 1024);
    const int nsel = t < 255 ? t + 1 : 256;
    const int fr = lane & 15, fq = lane >> 4;
    bf16x8 qf[2][4];
#pragma unroll
    for (int g = 0; g < 2; ++g)
#pragma unroll
        for (int ks = 0; ks < 4; ++ks) { const bf16x8 z = {0, 0, 0, 0, 0, 0, 0, 0}; qf[g][ks] = fr < 4 ? *(const bf16x8*)(PROJ + (size_t)t * DINP + CQ + (4 * g + fr) * 128 + 64 * (ks >> 1) + 16 * fq + 8 * (ks & 1)) : z; }
    const float scale = 0.08838834764831845f;
    const int nkt = (nsel + 15) >> 4;
    for (int kt0 = 0; kt0 < 16; kt0 += 2) {
        bf16x8 kf[2][2][4];
#pragma unroll
        for (int u = 0; u < 2; ++u) { const int kt = kt0 + u;
            if (kt < nkt) { const int key = selw[16 * kt + fr]; const bf16_t* kp = KC + (size_t)key * 256 + 16 * fq;
#pragma unroll
                for (int g = 0; g < 2; ++g)
#pragma unroll
                    for (int ks = 0; ks < 4; ++ks) kf[u][g][ks] = *(const bf16x8*)(kp + g * 128 + 64 * (ks >> 1) + 8 * (ks & 1)); } }
#pragma unroll
        for (int u = 0; u < 2; ++u) { const int kt = kt0 + u;
            if (kt < nkt) {
#pragma unroll
                for (int g = 0; g < 2; ++g) { f32x4 acc = (f32x4){0.f, 0.f, 0.f, 0.f};
#pragma unroll
                    for (int ks = 0; ks < 4; ++ks) acc = __builtin_amdgcn_mfma_f32_16x16x32_bf16(qf[g][ks], kf[u][g][ks], acc, 0, 0, 0);
                    if (fq == 0) {
#pragma unroll
                        for (int r = 0; r < 4; ++r) L[(4 * g + r) * 256 + 16 * kt + fr] = (16 * kt + fr < nsel) ? acc[r] * scale : -__builtin_inff(); } }
            } else if (fq == 0) {
#pragma unroll
                for (int r = 0; r < 8; ++r) L[r * 256 + 16 * kt + fr] = -__builtin_inff();
            } }
    }
    float p[8][4];
#pragma unroll
    for (int hd = 0; hd < 8; ++hd) { float m = -__builtin_inff();
#pragma unroll
        for (int i = 0; i < 4; ++i) { p[hd][i] = L[hd * 256 + lane + 64 * i]; m = fmaxf(m, p[hd][i]); }
        m = wave_max(m); float s = 0.f;
#pragma unroll
        for (int i = 0; i < 4; ++i) { p[hd][i] = __expf(p[hd][i] - m); s += p[hd][i]; }
        s = 1.0f / wave_sum(s);
#pragma unroll
        for (int i = 0; i < 4; ++i) p[hd][i] *= s; }
    LAS bf16_t* Pb = (LAS bf16_t*)(wl + 1024);
#pragma unroll
    for (int hd = 0; hd < 8; ++hd)
#pragma unroll
        for (int i = 0; i < 4; ++i) Pb[hd * 256 + lane + 64 * i] = f2bf(p[hd][i]);
    LAS unsigned char* VT = wl + 9216;
    const int half = lane >> 5, l31 = lane & 31, ii = lane & 15, kq = lane >> 4;
    f32x4 acc[16];
#pragma unroll
    for (int nt = 0; nt < 16; ++nt) acc[nt] = (f32x4){0.f, 0.f, 0.f, 0.f};
    const int nch = (nsel + 15) >> 4;
    u32x4 vw[2][8];
#define PV_LOAD(buf, c) do { _Pragma("unroll") for (int u = 0; u < 8; ++u) { const unsigned off_ = (unsigned)selw[16 * (c) + 2 * u + half] * 512u + 16u * (unsigned)l31; vw[buf][u] = *(const u32x4*)((const char*)VC + off_); } } while (0)
#define PV_COMP(buf, c) do { _Pragma("unroll") for (int u = 0; u < 8; ++u) *(LAS u32x4*)(VT + (2 * u + half) * 528 + 16 * l31) = vw[buf][u]; \
        s16x4 pa[2]; _Pragma("unroll") for (int g = 0; g < 2; ++g) { const s16x4 r_ = *(const LAS s16x4*)(Pb + (g * 4 + (ii & 3)) * 256 + 16 * (c) + 4 * kq); pa[g] = ii < 4 ? r_ : (s16x4){0, 0, 0, 0}; } \
        _Pragma("unroll") for (int nt = 0; nt < 16; ++nt) { const s16x4 b_ = __builtin_amdgcn_ds_read_tr16_b64_v4i16((LAS s16x4*)(VT + (4 * kq + (ii >> 2)) * 528 + (16 * nt + 4 * (ii & 3)) * 2)); \
            acc[nt] = __builtin_amdgcn_mfma_f32_16x16x16bf16_1k(pa[nt >> 3], b_, acc[nt], 0, 0, 0); } } while (0)
    PV_LOAD(0, 0);
    for (int c = 0; c < nch; c += 2) {
        if (c + 1 < nch) PV_LOAD(1, c + 1);
        __builtin_amdgcn_sched_barrier(0);
        PV_COMP(0, c);
        if (c + 1 < nch) { if (c + 2 < nch) PV_LOAD(0, c + 2); __builtin_amdgcn_sched_barrier(0); PV_COMP(1, c + 1); }
    }
#undef PV_LOAD
#undef PV_COMP
    LAS float* OB = (LAS float*)(wl + 1024 + 4096);
    if (kq == 0) {
#pragma unroll
        for (int nt = 0; nt < 16; ++nt)
#pragma unroll
            for (int r = 0; r < 4; ++r) OB[(4 * (nt >> 3) + r) * 128 + 16 * (nt & 7) + ii] = acc[nt][r];
    }
    {
        const f32x4 a0 = *(const LAS f32x4*)(OB + 16 * lane), a1 = *(const LAS f32x4*)(OB + 16 * lane + 4), a2 = *(const LAS f32x4*)(OB + 16 * lane + 8), a3 = *(const LAS f32x4*)(OB + 16 * lane + 12);
        u32x4 w0, w1; w0.x = cvt_pk_bf16(a0[0], a0[1]); w0.y = cvt_pk_bf16(a0[2], a0[3]); w0.z = cvt_pk_bf16(a1[0], a1[1]); w0.w = cvt_pk_bf16(a1[2], a1[3]);
        w1.x = cvt_pk_bf16(a2[0], a2[1]); w1.y = cvt_pk_bf16(a2[2], a2[3]); w1.z = cvt_pk_bf16(a3[0], a3[1]); w1.w = cvt_pk_bf16(a3[2], a3[3]);
        u32x4* dst = (u32x4*)(ATT + (size_t)t * 1024 + 16 * lane); dst[0] = w0; dst[1] = w1;
    }
}


__device__ __forceinline__ void convert_item8(const float* __restrict__ W, int K, int N, unsigned char* WT, int mode, int item, int lane, LAS unsigned char* scr) {
    const int nblk = N >> 6; const int kb = item / nblk, nb = item - kb * nblk; const int k0 = kb * 256, n0 = nb * 64;
    const int c4 = lane & 15, kr = lane >> 4;
    const float* src = W + (size_t)(k0 + 4 * kr) * N + n0 + 4 * c4;
#pragma unroll 4
    for (int i = 0; i < 16; ++i) {
        f32x4 v[4];
#pragma unroll
        for (int r = 0; r < 4; ++r) v[r] = __builtin_nontemporal_load((const f32x4*)(src + (size_t)(16 * i + r) * N));
        const int kk = 16 * i + 4 * kr;
#pragma unroll
        for (int e = 0; e < 4; ++e) *(LAS unsigned*)(scr + (4 * c4 + e) * 272 + kk) = pack4_fp8(v[0][e] * W8_SCALE, v[1][e] * W8_SCALE, v[2][e] * W8_SCALE, v[3][e] * W8_SCALE);
    }
    LDS_WAIT(); asm volatile("" ::: "memory");
#pragma unroll 4
    for (int j = 0; j < 16; ++j) {
        const int q = j * 64 + lane, n = q >> 4, ch = q & 15;
        const u32x4 v = *(const LAS u32x4*)(scr + n * 272 + ch * 16);
        *(u32x4*)(WT + (size_t)dest_row(mode, n0 + n) * K + k0 + ch * 16) = v;
    }
    LDS_WAIT(); asm volatile("" ::: "memory");
}

__global__ void __launch_bounds__(NTHR, 2) fwd_kernel(Args args) {
    extern __shared__ __attribute__((aligned(16))) unsigned char lds_raw[];
    LAS unsigned char* lds = (LAS unsigned char*)lds_raw;
    volatile LAS unsigned* MISC = (volatile LAS unsigned*)(lds + LDS_MISC);
    const int tid = threadIdx.x, lane = tid & 63, wave = __builtin_amdgcn_readfirstlane(tid >> 6);
    const int G = gridDim.x, wg = blockIdx.x;
    unsigned char* ws = args.ws;
    unsigned* ctl = (unsigned*)(ws + WS_CTL);
    const int lo = args.ph_lo, hi = args.ph_hi, flags = args.flags;
    const float* x = (const float*)args.in[0]; const float* cvec = (const float*)args.in[1]; const int* positions = (const int*)args.in[2];
    const float* w_ada = (const float*)args.in[3]; const float* b_ada = (const float*)args.in[4]; const float* norm1_g = (const float*)args.in[5];
    const float* w_in = (const float*)args.in[6]; const float* idx_knorm_g = (const float*)args.in[7]; const float* idx_knorm_b = (const float*)args.in[8];
    const float* lb_logits = (const float*)args.in[9]; const float* hgrn_norm_g = (const float*)args.in[10];
    const float* w_proj_att = (const float*)args.in[11]; const float* w_proj_hgrn = (const float*)args.in[12]; const float* w_out = (const float*)args.in[13];
    const float* norm2_g = (const float*)args.in[14]; const float* w_router = (const float*)args.in[15]; const float* b_router = (const float*)args.in[16];
    const float* w1 = (const float*)args.in[17]; const float* b1 = (const float*)args.in[18]; const float* w2 = (const float*)args.in[19]; const float* b2 = (const float*)args.in[20];
    const float* final_g = (const float*)args.in[21];
    float* out = args.out;
    float* MOD = (float*)(ws + WS_MOD); int* TOPE = (int*)(ws + WS_TOPE); float* GATE = (float*)(ws + WS_GATE); int* SLOT = (int*)(ws + WS_SLOT);
    bf16_t* WIN_T = (bf16_t*)(ws + WS_WIN_T); bf16_t* WA_T = (bf16_t*)(ws + WS_WA_T); bf16_t* WH_T = (bf16_t*)(ws + WS_WH_T); bf16_t* WO_T = (bf16_t*)(ws + WS_WO_T);
    unsigned char* W1_T = ws + WS_W1_T; unsigned char* W2_T = ws + WS_W2_T;
    bf16_t* HB = (bf16_t*)(ws + WS_H); bf16_t* PROJ = (bf16_t*)(ws + WS_PROJ);
    float* X1 = (float*)(ws + WS_X1);
    unsigned char* XB = ws + WS_XB; unsigned char* ACT = ws + WS_ACT; bf16_t* YB = (bf16_t*)(ws + WS_YB);
    int* TOKS = (int*)(ws + WS_TOKS);
    unsigned char* H8 = ws + WS_H;
    bf16_t* KI = (bf16_t*)(ws + WS_KI); bf16_t* KC = (bf16_t*)(ws + WS_KC); bf16_t* VC = (bf16_t*)(ws + WS_VC);
    float* ST = (float*)(ws + WS_ST); float* DC = (float*)(ws + WS_DC); int* SEL = (int*)(ws + WS_SEL);
    bf16_t* ATT = (bf16_t*)(ws + WS_ATT); bf16_t* REC = (bf16_t*)(ws + WS_REC); bf16_t* MERGED = (bf16_t*)(ws + WS_MERGED); unsigned short* SCORES = (unsigned short*)(ws + WS_SCORES);

    for (int u = tid; u < 128; u += NTHR) MISC[u] = 0u;
    __syncthreads();
    const bool one_launch = (hi - lo) > 1;
    XcdBarrier bar; bar.bar = ctl + CW_BAR; bar.x = 0; bar.st = MISC + 8;
    if (one_launch) bar = xcd_barrier_post(ctl + CW_BAR, MISC + 8);
#define IN(k) (lo <= (k) && (k) < hi)
#define NREP(k) ((((MK_REP) >> (k)) & 1) + 1)
#define SEAM(k) do { if (IN(k) && IN((k) + 1)) xcd_barrier(bar); } while (0)

    const float* x1src = (flags & FLAG_MIXER) ? (const float*)X1 : x;

    if (IN(PH_PRO)) {
        for (int cb = wg; cb < 256; cb += G) {
            LAS float* red = (LAS float*)lds;
            const int c4 = tid % 12, kg = tid / 12;
            f32x4 acc = (f32x4){0.f, 0.f, 0.f, 0.f};
            if (kg < 42) {
                const float* wp = w_ada + (size_t)cb * 48 + 4 * c4;
#pragma unroll 7
                for (int j = 0; j < 49; ++j) { const int k = kg + 42 * j; if (k < D) { const f32x4 v = __builtin_nontemporal_load((const f32x4*)(wp + (size_t)k * (6 * D))); acc += siluf_(cvec[k]) * v; } }
                *(LAS f32x4*)(red + kg * 48 + 4 * c4) = acc;
            }
            __syncthreads();
            if (tid < 48) { float s = b_ada[cb * 48 + tid];
#pragma unroll 6
                for (int q = 0; q < 42; ++q) s += red[q * 48 + tid];
                MOD[cb * 48 + tid] = s; }
            __syncthreads();
        }
        LAS unsigned char* scr = lds + wave * 17408;
        const int gw = wg * NWAVES + wave, NGW = G * NWAVES;
        for (int rep = 0; rep < NREP(PH_PRO); ++rep) {
        if (flags & FLAG_MIXER) {
            constexpr int NB_IN = (DIN + 63) / 64;
            for (int it = gw; it < 16 * NB_IN; it += NGW) convert_item(w_in, 2048, DIN, WIN_T, 1, it, lane, scr);
            for (int it = gw; it < 8 * 32; it += NGW) convert_item(w_proj_att, 1024, 2048, WA_T, 0, it, lane, scr);
            for (int it = gw; it < 8 * 32; it += NGW) convert_item(w_proj_hgrn, 1024, 2048, WH_T, 0, it, lane, scr);
            for (int it = gw; it < 16 * 32; it += NGW) convert_item(w_out, 2048, 2048, WO_T, 0, it, lane, scr);
            for (size_t i = (size_t)wg * NTHR + tid; i < (size_t)176 * 2048 * 2 / 16; i += (size_t)G * NTHR) ((u32x4*)(WIN_T + (size_t)2640 * 2048))[i] = (u32x4){0u, 0u, 0u, 0u};
        }
        if (flags & FLAG_MOE) {
            constexpr int I1 = (2048 / 256) * (4096 / 64), I2 = (2048 / 256) * (2048 / 64);
            for (int it = gw; it < NEXP * I1; it += NGW) { const int e = it / I1, r = it - e * I1; convert_item8(w1 + (size_t)e * 2048 * 4096, 2048, 4096, W1_T + (size_t)e * 4096 * 2048, 2, r, lane, scr); }
            for (int it = gw; it < NEXP * I2; it += NGW) { const int e = it / I2, r = it - e * I2; convert_item8(w2 + (size_t)e * 2048 * 2048, 2048, 2048, W2_T + (size_t)e * 2048 * 2048, 0, r, lane, scr); }
        }
        }
    }
    SEAM(PH_PRO);

    if (flags & FLAG_MIXER) {
    if (IN(PH_H)) {
        const float* sh1 = MOD; const float* sc1 = MOD + D;
        const int gw = wg * NWAVES + wave, NGW = G * NWAVES;
        f32x4 gs[8], sh[8];
#pragma unroll
        for (int j = 0; j < 8; ++j) { const int c = 4 * lane + 256 * j; const f32x4 g = *(const f32x4*)(norm1_g + c), sc = *(const f32x4*)(sc1 + c); sh[j] = *(const f32x4*)(sh1 + c);
#pragma unroll
            for (int e = 0; e < 4; ++e) gs[j][e] = g[e] * (1.0f + sc[e]); }
        for (int rep = 0; rep < NREP(PH_H); ++rep)
        for (int t = gw; t < S; t += NGW) {
            const f32x4* xr = (const f32x4*)(x + (size_t)t * D) + lane;
            f32x4 v[8]; float ss = 0.f;
#pragma unroll
            for (int j = 0; j < 8; ++j) { v[j] = xr[64 * j]; ss += (v[j][0] * v[j][0] + v[j][1] * v[j][1]) + (v[j][2] * v[j][2] + v[j][3] * v[j][3]); }
            const float rstd = rsqrtf(wave_sum(ss) * (1.0f / D) + NORM_EPS);
#pragma unroll
            for (int j = 0; j < 8; ++j) { const f32x4 h = v[j] * rstd * gs[j] + sh[j]; u32x2 w; w.x = cvt_pk_bf16(h[0], h[1]); w.y = cvt_pk_bf16(h[2], h[3]);
                *(u32x2*)(HB + (size_t)t * D + 4 * lane + 256 * j) = w; }
        }
    }
    SEAM(PH_H);
    if (IN(PH_INPROJ)) for (int rep = 0; rep < NREP(PH_INPROJ); ++rep) {
        pg8::Gemm g{HB, WIN_T, 2048, 0, nullptr}; pg8::StaticOrder So; So.init(S, DINP, G, wg);
        pg8::EpiBf16 E{PROJ, DINP, nullptr, 0, 1.0f};
        pg8::gemm_phase<pg8::EpiBf16, pg8::StaticOrder>(lds, g, So, E);
    }
    SEAM(PH_INPROJ);
    if (IN(PH_POST)) {
        const int gw = wg * NWAVES + wave, NGW = G * NWAVES;
        for (int t = gw; t < S; t += NGW) post_token(PROJ, KI, KC, VC, positions, idx_knorm_g, idx_knorm_b, t, lane);
        __syncthreads();
        for (int rep = 0; rep < NREP(PH_POST); ++rep)
        for (int u = wg; u < 2048; u += G) hgrn_l1(lds, PROJ, lb_logits, ST, DC, u >> 3, u & 7, tid, wave, lane);
    }
    SEAM(PH_POST);
    if (IN(PH_SCORE)) {
        for (int idx = wg * NTHR + tid; idx < 8 * 128 * 128; idx += G * NTHR) {
            const int h = idx >> 14, d = idx & 127; float s = 0.f;
            float* sp = ST + idx; const float* dp = DC + h * 128 + d;
            for (int c = 0; c < 256; c += 8) {
                float l[8], dc[8];
#pragma unroll
                for (int i = 0; i < 8; ++i) { l[i] = sp[(size_t)(c + i) * 131072]; dc[i] = dp[(size_t)(c + i) * 1024]; }
#pragma unroll
                for (int i = 0; i < 8; ++i) { sp[(size_t)(c + i) * 131072] = s; s = dc[i] * s + l[i]; }
            }
        }
        if (flags & FLAG_ATT) for (int rep = 0; rep < NREP(PH_SCORE); ++rep) {
            for (int j = wg; j < 252; j += G) { score_block(lds, PROJ, KI, SCORES, 8 + j, tid, wave, lane); score_block(lds, PROJ, KI, SCORES, 511 - j, tid, wave, lane); }
        }
    }
    SEAM(PH_SCORE);
    if (IN(PH_SELECT)) {
        for (int rep = 0; rep < NREP(PH_SELECT); ++rep)
        for (int u = wg; u < 2048; u += G) hgrn_l3(lds, PROJ, lb_logits, ST, hgrn_norm_g, REC, u >> 3, u & 7, tid, wave, lane);
    }
    SEAM(PH_SELECT);
    if (IN(PH_ATTN)) {
        const int gw = wg * NWAVES + wave, NGW = G * NWAVES;
        if (flags & FLAG_ATT) for (int rep = 0; rep < NREP(PH_ATTN); ++rep) {
            for (int t = gw; t < S; t += NGW) {
                LAS unsigned char* wl = lds + wave * 17664;
                if (t >= 256) { for (int rep2 = 0; rep2 < (((MK_REP2) >> 1) & 1) + 1; ++rep2) select_row(wl, SCORES, t, lane); }
                else {
#pragma unroll
                    for (int i = 0; i < 4; ++i) { const int idx = lane + 64 * i; ((LAS int*)wl)[idx] = idx <= t ? idx : 0; }
                }
                for (int rep2 = 0; rep2 < (((MK_REP2) >> 2) & 1) + 1; ++rep2) attn_query(wl, PROJ, KC, VC, ATT, t, lane);
            }
        } else {
            for (size_t i = (size_t)wg * NTHR + tid; i < (size_t)S * 1024 * 2 / 16; i += (size_t)G * NTHR) ((u32x4*)ATT)[i] = (u32x4){0u, 0u, 0u, 0u};
        }
    }
    SEAM(PH_ATTN);
    if (IN(PH_OP1)) {
        pg8::Gemm g{ATT, WA_T, 1024, 0, nullptr}; pg8::StaticOrder So; So.init(S, 2048, G, wg);
        pg8::EpiGate E{MERGED, PROJ + CGA, 0};
        pg8::gemm_phase<pg8::EpiGate, pg8::StaticOrder>(lds, g, So, E);
    }
    SEAM(PH_OP1);
    if (IN(PH_OP2)) {
        pg8::Gemm g{REC, WH_T, 1024, 0, nullptr}; pg8::StaticOrder So; So.init(S, 2048, G, wg);
        pg8::EpiGate E{MERGED, PROJ + CGR, 1};
        pg8::gemm_phase<pg8::EpiGate, pg8::StaticOrder>(lds, g, So, E);
    }
    SEAM(PH_OP2);
    if (IN(PH_WOUT)) {
        pg8::Gemm g{MERGED, WO_T, 2048, 0, nullptr}; pg8::StaticOrder So; So.init(S, 2048, G, wg);
        pg8::EpiResid E{x, MOD + 2 * D, X1};
        pg8::gemm_phase<pg8::EpiResid, pg8::StaticOrder>(lds, g, So, E);
    }
    SEAM(PH_WOUT);
    }

    if (IN(PH_ROUTER) && (flags & FLAG_MOE)) {
        LAS float* hs = (LAS float*)lds;
        volatile LAS unsigned* lcnt = MISC + 32;
        const float* sh2 = MOD + 3 * D; const float* sc2 = MOD + 4 * D;
        if (tid < 32) lcnt[tid] = 0u;
        __syncthreads();
        for (int grp = wg; grp < S / 16; grp += G) {
#pragma unroll 1
            for (int q = 0; q < 2; ++q) {
                const int tl = 2 * wave + q, t = grp * 16 + tl;
                const f32x4* xr = (const f32x4*)(x1src + (size_t)t * D) + lane;
                f32x4 v[8]; float ss = 0.f;
#pragma unroll
                for (int j = 0; j < 8; ++j) { v[j] = xr[64 * j]; ss += (v[j][0] * v[j][0] + v[j][1] * v[j][1]) + (v[j][2] * v[j][2] + v[j][3] * v[j][3]); }
                const float rstd = rsqrtf(wave_sum(ss) * (1.0f / D) + NORM_EPS);
#pragma unroll
                for (int j = 0; j < 8; ++j) {
                    const int c = 4 * lane + 256 * j;
                    const f32x4 g = *(const f32x4*)(norm2_g + c), sc = *(const f32x4*)(sc2 + c), sh = *(const f32x4*)(sh2 + c);
                    f32x4 h;
#pragma unroll
                    for (int e = 0; e < 4; ++e) h[e] = v[j][e] * rstd * g[e] * (1.0f + sc[e]) + sh[e];
                    *(LAS f32x4*)(hs + tl * 2048 + c) = h;
                    *(unsigned*)(H8 + (size_t)t * D + c) = pack4_fp8(h[0], h[1], h[2], h[3]);
                }
            }
            __syncthreads();
            {
                LAS float* part = (LAS float*)(lds + 131072);
                const int fr = lane & 15, fq = lane >> 4;
                f32x4 acc0 = (f32x4){0.f, 0.f, 0.f, 0.f}, acc1 = acc0;
                const LAS float* hrow = hs + fr * 2048 + wave * 256 + 4 * fq; const float* wrp = w_router + (size_t)(wave * 256 + 4 * fq) * 32 + fr;
#pragma unroll 2
                for (int i = 0; i < 16; ++i) {
                    const f32x4 a4 = *(const LAS f32x4*)(hrow + 16 * i);
                    float b0[4], b1[4];
#pragma unroll
                    for (int s = 0; s < 4; ++s) { b0[s] = wrp[(size_t)(16 * i + s) * 32]; b1[s] = wrp[(size_t)(16 * i + s) * 32 + 16]; }
#pragma unroll
                    for (int s = 0; s < 4; ++s) { acc0 = __builtin_amdgcn_mfma_f32_16x16x4f32(a4[s], b0[s], acc0, 0, 0, 0); acc1 = __builtin_amdgcn_mfma_f32_16x16x4f32(a4[s], b1[s], acc1, 0, 0, 0); }
                }
#pragma unroll
                for (int r = 0; r < 4; ++r) { part[(wave * 16 + 4 * fq + r) * 32 + fr] = acc0[r]; part[(wave * 16 + 4 * fq + r) * 32 + 16 + fr] = acc1[r]; }
                __syncthreads();
                const int tl = tid >> 5, e = tid & 31, t = grp * 16 + tl;
                float v = b_router[e];
#pragma unroll
                for (int w = 0; w < 8; ++w) v += part[(w * 16 + tl) * 32 + e];
                float tv[4]; int ti[4];
#pragma unroll
                for (int k = 0; k < 4; ++k) {
                    float bv = v; int bi = e;
#pragma unroll
                    for (int o = 16; o >= 1; o >>= 1) { const float ov = __shfl_xor(bv, o); const int oi = __shfl_xor(bi, o); if (ov > bv || (ov == bv && oi < bi)) { bv = ov; bi = oi; } }
                    tv[k] = bv; ti[k] = bi; if (e == bi) v = -__builtin_inff();
                }
                if (e == 0) {
                    const float e1 = __expf(tv[1] - tv[0]), e2 = __expf(tv[2] - tv[0]), e3 = __expf(tv[3] - tv[0]); const float inv = 1.0f / (1.0f + e1 + e2 + e3);
                    *(int4*)(TOPE + (size_t)t * 4) = make_int4(ti[0], ti[1], ti[2], ti[3]);
                    *(f32x4*)(GATE + (size_t)t * 4) = (f32x4){inv, e1 * inv, e2 * inv, e3 * inv};
#pragma unroll
                    for (int k = 0; k < 4; ++k) __hip_atomic_fetch_add((LAS unsigned*)&lcnt[ti[k]], 1u, __ATOMIC_RELAXED, __HIP_MEMORY_SCOPE_WORKGROUP);
                }
            }
            __syncthreads();
        }
        if (tid < 32) { const unsigned c = lcnt[tid]; if (c) __hip_atomic_fetch_add(ctl + CW_CNT + tid, c, __ATOMIC_RELAXED, __HIP_MEMORY_SCOPE_AGENT); }
    }
    SEAM(PH_ROUTER);

    if (IN(PH_SCATTER) && (flags & FLAG_MOE)) {
        volatile LAS unsigned* lcnt = MISC + 32; volatile LAS unsigned* lbase = MISC + 64; LAS int* pstart = (LAS int*)(lds + 1024); LAS int* pcnt = (LAS int*)(lds + 1280);
        if (tid == 0) { int p = 0; for (int e = 0; e < NEXP; ++e) { const int c = (int)__hip_atomic_load(ctl + CW_CNT + e, __ATOMIC_RELAXED, __HIP_MEMORY_SCOPE_AGENT); pstart[e] = p; pcnt[e] = c; p += (c + 255) & ~255; } }
        if (tid < 32) lcnt[tid] = 0u;
        __syncthreads();
        if (wg < NEXP) { const int e = wg; for (int s = pstart[e] + pcnt[e] + tid; s < pstart[e] + ((pcnt[e] + 255) & ~255); s += NTHR) TOKS[s] = 0; }
        for (int blk = wg; blk < S / 64; blk += G) {
            int e = 0, lrank = 0;
            if (tid < 256) { e = TOPE[(size_t)blk * 256 + tid]; lrank = (int)__hip_atomic_fetch_add((LAS unsigned*)&lcnt[e], 1u, __ATOMIC_RELAXED, __HIP_MEMORY_SCOPE_WORKGROUP); }
            __syncthreads();
            if (tid < 32) { const unsigned c = lcnt[tid]; lbase[tid] = c ? __hip_atomic_fetch_add(ctl + CW_FILL + tid, c, __ATOMIC_RELAXED, __HIP_MEMORY_SCOPE_AGENT) : 0u; }
            __syncthreads();
            if (tid < 256) { const int slot = pstart[e] + (int)lbase[e] + lrank; SLOT[(size_t)blk * 256 + tid] = slot; TOKS[slot] = blk * 64 + (tid >> 2); }
            __syncthreads();
            if (tid < 32) lcnt[tid] = 0u;
            __syncthreads();
        }
    }
    SEAM(PH_SCATTER);

    if ((IN(PH_MOE1) || IN(PH_MOE2)) && (flags & FLAG_MOE)) {
        LAS int* panel_e = (LAS int*)(lds + 131072 + 2048);
        LAS int* npan = (LAS int*)(lds + 131072 + 2048 + 2048);
        __syncthreads();
        if (tid == 0) { int p = 0; for (int e = 0; e < NEXP; ++e) { const int np = (int)((__hip_atomic_load(ctl + CW_CNT + e, __ATOMIC_RELAXED, __HIP_MEMORY_SCOPE_AGENT) + 255u) >> 8); for (int q = 0; q < np; ++q) panel_e[p + q] = e; p += np; } npan[0] = p; }
        __syncthreads();
        const int nPanels = npan[0];
        if (IN(PH_MOE1)) for (int rep = 0; rep < NREP(PH_MOE1); ++rep) {
            pg8::Gemm g{H8, W1_T, 2048, (size_t)4096 * 2048, TOKS}; pg8::MoeOrder So; So.init(nPanels, 16, G, wg, panel_e);
            pg8::EpiSwiglu E{ACT, b1};
            pg8::gemm_phase<pg8::EpiSwiglu, pg8::MoeOrder, true>(lds, g, So, E);
        }
        SEAM(PH_MOE1);
        if (IN(PH_MOE2)) for (int rep = 0; rep < NREP(PH_MOE2); ++rep) {
            pg8::Gemm g{ACT, W2_T, 2048, (size_t)2048 * 2048, nullptr}; pg8::MoeOrder So; So.init(nPanels, 8, G, wg, panel_e);
            pg8::EpiBf16 E{YB, 2048, b2, 2048, 1.0f / (W8_SCALE * ACT8_SCALE)};
            pg8::gemm_phase<pg8::EpiBf16, pg8::MoeOrder, true>(lds, g, So, E);
        }
    }
    SEAM(PH_MOE2);

    if (IN(PH_FINAL)) {
        const float* gt2 = MOD + 5 * D;
        const int gw = wg * NWAVES + wave, NGW = G * NWAVES;
        for (int rep = 0; rep < NREP(PH_FINAL); ++rep)
        for (int t = gw; t < S; t += NGW) {
            const f32x4* xr = (const f32x4*)(x1src + (size_t)t * D) + lane;
            f32x4 v[8];
#pragma unroll
            for (int j = 0; j < 8; ++j) v[j] = xr[64 * j];
            if (flags & FLAG_MOE) {
                f32x4 m[8];
#pragma unroll
                for (int j = 0; j < 8; ++j) m[j] = (f32x4){0.f, 0.f, 0.f, 0.f};
                const int4 sl = *(const int4*)(SLOT + (size_t)t * 4); const f32x4 gt = *(const f32x4*)(GATE + (size_t)t * 4);
                const int sls[4] = {sl.x, sl.y, sl.z, sl.w};
#pragma unroll
                for (int k = 0; k < 4; ++k) {
                    const u32x2* yr = (const u32x2*)(YB + (size_t)sls[k] * D) + lane; const float gk = gt[k];
#pragma unroll
                    for (int j = 0; j < 8; ++j) { const u32x2 w = yr[64 * j]; m[j][0] += gk * bf_lo(w.x); m[j][1] += gk * bf_hi(w.x); m[j][2] += gk * bf_lo(w.y); m[j][3] += gk * bf_hi(w.y); }
                }
#pragma unroll
                for (int j = 0; j < 8; ++j) { const f32x4 g2 = *(const f32x4*)(gt2 + 4 * lane + 256 * j); v[j] = v[j] + g2 * m[j]; }
            }
            float ss = 0.f;
#pragma unroll
            for (int j = 0; j < 8; ++j) ss += (v[j][0] * v[j][0] + v[j][1] * v[j][1]) + (v[j][2] * v[j][2] + v[j][3] * v[j][3]);
            const float rstd = rsqrtf(wave_sum(ss) * (1.0f / D) + NORM_EPS);
            f32x4* orow = (f32x4*)(out + (size_t)t * D) + lane;
#pragma unroll
            for (int j = 0; j < 8; ++j) { const f32x4 fg = *(const f32x4*)(final_g + 4 * lane + 256 * j); orow[64 * j] = v[j] * rstd * fg; }
        }
    }
#undef IN
#undef SEAM
}

#ifndef MK_ONE_LAUNCH
#define MK_ONE_LAUNCH 1
#endif
#ifndef MK_FLAGS
#define MK_FLAGS (FLAG_MOE | FLAG_MIXER | FLAG_ATT)
#endif
extern "C" void kernel_launch(void* const* d_in, const int* in_sizes, int n_in, void* d_out, int out_size, void* d_ws, size_t ws_size, hipStream_t stream) {
    static int grid = 0;
    if (grid == 0) {
        if (n_in != 22 || out_size != S * D || ws_size < WS_END) { fprintf(stderr, "kernel_launch: unexpected shapes: n_in %d out %d ws %zu (need %zu)\n", n_in, out_size, ws_size, (size_t)WS_END); grid = -1; return; }
        int dev = 0, cus = 0, per_cu = 0;
        if (hipGetDevice(&dev) != hipSuccess || hipDeviceGetAttribute(&cus, hipDeviceAttributeMultiprocessorCount, dev) != hipSuccess) { grid = -1; return; }
        if (hipFuncSetAttribute((const void*)fwd_kernel, hipFuncAttributeMaxDynamicSharedMemorySize, LDS_BYTES) != hipSuccess) { fprintf(stderr, "kernel_launch: hipFuncSetAttribute failed\n"); grid = -1; return; }
        if (hipOccupancyMaxActiveBlocksPerMultiprocessor(&per_cu, (const void*)fwd_kernel, NTHR, LDS_BYTES) != hipSuccess || per_cu < 1) { fprintf(stderr, "kernel_launch: occupancy query says %d\n", per_cu); (void)hipGetLastError(); grid = -1; return; }
        grid = cus;
    }
    if (grid < 0) return;
    (void)in_sizes;
    hipMemsetAsync((char*)d_ws + WS_CTL, 0, CTL_BYTES, stream);
    Args a{};
    for (int i = 0; i < 22; ++i) a.in[i] = d_in[i];
    a.out = (float*)d_out; a.ws = (unsigned char*)d_ws; a.flags = MK_FLAGS; a.pad = 0;
#if MK_ONE_LAUNCH
    a.ph_lo = 0; a.ph_hi = NPH;
    hipLaunchKernelGGL(fwd_kernel, dim3(grid), dim3(NTHR), LDS_BYTES, stream, a);
#else
    for (int p = 0; p < NPH; ++p) { a.ph_lo = p; a.ph_hi = p + 1; hipLaunchKernelGGL(fwd_kernel, dim3(grid), dim3(NTHR), LDS_BYTES, stream, a); }
#endif
}
```

```cpp
#include <hip/hip_runtime.h>
#include <cstdio>
#include <cstdint>

#define GAS __attribute__((address_space(1)))
#define LAS __attribute__((address_space(3)))
typedef unsigned short bf16_t;
typedef short bf16x8 __attribute__((ext_vector_type(8)));
typedef float f32x4 __attribute__((ext_vector_type(4)));
typedef float f32x2 __attribute__((ext_vector_type(2)));
typedef float f32x16 __attribute__((ext_vector_type(16)));
typedef unsigned u32x4 __attribute__((ext_vector_type(4)));
typedef unsigned u32x2 __attribute__((ext_vector_type(2)));
typedef int i32x4 __attribute__((ext_vector_type(4)));
typedef int i32x8 __attribute__((ext_vector_type(8)));
typedef short s16x4 __attribute__((ext_vector_type(4)));
typedef short s16x2 __attribute__((ext_vector_type(2)));

constexpr int S = 16384, D = 2048, DIN = 10832, DINP = 11008, NEXP = 32, DFF = 2048;
constexpr int NWAVES = 8, NTHR = 512;
constexpr int CQ = 0, CK = 1024, CV = 1280, CQI = 1536, CKI = 2560, CWI = 2624, CHQ = 2816, CHF = 3840, CHI = 4864, CHG = 5888, CGA = 6912, CGR = 8960;
constexpr int PMAX = 65536 + NEXP * 256;
constexpr float NORM_EPS = 1e-5f;

constexpr size_t MiB = 1u << 20;
constexpr size_t al256(size_t x) { return (x + 255) & ~(size_t)255; }
constexpr size_t WS_CTL = 0, CTL_BYTES = 1 * MiB;
constexpr size_t WS_MOD = WS_CTL + CTL_BYTES;
constexpr size_t WS_TOPE = WS_MOD + 64 * 1024;
constexpr size_t WS_GATE = WS_TOPE + (size_t)S * 16;
constexpr size_t WS_SLOT = WS_GATE + (size_t)S * 16;
constexpr size_t WS_WIN_T = WS_SLOT + (size_t)S * 16;
constexpr size_t WS_WA_T = WS_WIN_T + (size_t)DINP * D * 2;
constexpr size_t WS_WH_T = WS_WA_T + (size_t)2048 * 1024 * 2;
constexpr size_t WS_WO_T = WS_WH_T + (size_t)2048 * 1024 * 2;
constexpr size_t WS_W1_T = WS_WO_T + (size_t)2048 * 2048 * 2;
constexpr size_t WS_W2_T = WS_W1_T + (size_t)NEXP * 4096 * 2048 * 2;
constexpr size_t WS_H = WS_W2_T + (size_t)NEXP * 2048 * 2048 * 2;
constexpr size_t WS_PROJ = WS_H + (size_t)S * D * 2;
constexpr size_t WS_KI = WS_PROJ + (size_t)S * DINP * 2;
constexpr size_t WS_KC = WS_KI + (size_t)S * 64 * 2;
constexpr size_t WS_VC = WS_KC + (size_t)S * 256 * 2;
constexpr size_t WS_ST = WS_VC + (size_t)S * 256 * 2;
constexpr size_t WS_DC = WS_ST + (size_t)256 * 8 * 128 * 128 * 4;
constexpr size_t WS_SEL = WS_DC + (size_t)256 * 8 * 128 * 4;
constexpr size_t WS_ATT = WS_SEL + (size_t)S * 256 * 4;
constexpr size_t WS_REC = WS_ATT + (size_t)S * 1024 * 2;
constexpr size_t WS_MERGED = WS_REC + (size_t)S * 1024 * 2;
constexpr size_t WS_X1 = WS_MERGED + (size_t)S * 2048 * 2;
constexpr size_t WS_SCORES = WS_X1 + (size_t)S * 2048 * 4;
constexpr size_t WS_XB = WS_SCORES;
constexpr size_t WS_ACT = WS_XB + (size_t)PMAX * 2048 * 2;
constexpr size_t WS_YB = WS_ACT + (size_t)PMAX * 2048 * 2;
constexpr size_t WS_END = WS_SCORES + (size_t)S * S * 4;
static_assert(WS_YB + (size_t)PMAX * 2048 * 2 <= WS_END, "MoE buffers overlay the score matrix");
static_assert(WS_END <= (size_t)4096 * MiB, "workspace");
constexpr int CW_BAR = 4096, CW_CNT = 8192, CW_FILL = 8448;
constexpr size_t WS_TOKS = WS_SEL;

constexpr int LDS_BYTES = 155648;
constexpr int LDS_MISC = LDS_BYTES - 512;

__device__ __forceinline__ unsigned cvt_pk_bf16(float lo, float hi) { unsigned r; asm volatile("v_cvt_pk_bf16_f32 %0, %1, %2" : "=v"(r) : "v"(lo), "v"(hi)); return r; }
__device__ __forceinline__ float bf_lo(unsigned u) { return __uint_as_float(u << 16); }
__device__ __forceinline__ float bf_hi(unsigned u) { return __uint_as_float(u & 0xffff0000u); }
__device__ __forceinline__ float bf2f(bf16_t b) { return __uint_as_float(((unsigned)b) << 16); }
__device__ __forceinline__ float wave_sum(float v) {
#pragma unroll
    for (int o = 1; o < 64; o <<= 1) v += __shfl_xor(v, o);
    return v;
}
__device__ __forceinline__ float wave_max(float v) {
#pragma unroll
    for (int o = 1; o < 64; o <<= 1) v = fmaxf(v, __shfl_xor(v, o));
    return v;
}
__device__ __forceinline__ float sigmoidf_(float x) { return __builtin_amdgcn_rcpf(1.0f + __expf(-x)); }
__device__ __forceinline__ float siluf_(float x) { return x * __builtin_amdgcn_rcpf(1.0f + __expf(-x)); }
__device__ __forceinline__ unsigned pack4_fp8(float a, float b, float c, float d) { int w = 0; w = __builtin_amdgcn_cvt_pk_fp8_f32(a, b, w, false); w = __builtin_amdgcn_cvt_pk_fp8_f32(c, d, w, true); return (unsigned)w; }
constexpr float W8_SCALE = 64.0f, ACT8_SCALE = 4.0f;
__device__ __forceinline__ float relu_i(float x) { const int i = __float_as_int(x); return __int_as_float(i > 0 ? i : 0); }
#define LDS_WAIT() asm volatile("s_waitcnt lgkmcnt(0)" ::: "memory")
#define VM_WAIT() asm volatile("s_waitcnt vmcnt(0)" ::: "memory")

#define XB_TMO      128
#define XB_XCNT(j)  (256  + 64 * (j))
#define XB_XSUB(j)  (1280 + 64 * (j))
#define XB_XGEN(j)  (2304 + 64 * (j))
#define XB_TOP      3328
#define XB_TOPGEN   3392
#define XCD_BAR_WORDS 3456
#define XB_SPIN_CAP (1u << 22)

__device__ __forceinline__ unsigned xb_ld(unsigned* p)              { return __hip_atomic_load(p, __ATOMIC_RELAXED, __HIP_MEMORY_SCOPE_AGENT); }
__device__ __forceinline__ unsigned xb_add(unsigned* p, unsigned v) { return __hip_atomic_fetch_add(p, v, __ATOMIC_RELAXED, __HIP_MEMORY_SCOPE_AGENT); }
__device__ __forceinline__ unsigned xb_xcc_id() { return (unsigned)__builtin_amdgcn_s_getreg((3 << 11) | 20) & 0xFu; }
#define XB_SPIN(cond, bar) do { unsigned _sp = 0; while (cond) { __builtin_amdgcn_s_sleep(1); \
    if ((++_sp & 255u) == 0u) { if (xb_ld(&(bar)[XB_TMO])) break; if (_sp > XB_SPIN_CAP) { atomicAdd(&(bar)[XB_TMO], 1u); break; } } } } while (0)

struct XcdBarrier { unsigned* bar; unsigned x; volatile LAS unsigned* st; };

__device__ __forceinline__ XcdBarrier xcd_barrier_post(unsigned* bar, volatile LAS unsigned* st) {
    XcdBarrier b; b.bar = bar; b.x = xb_xcc_id(); b.st = st;
    if (threadIdx.x == 0) (void)xb_add(&bar[XB_XCNT(b.x)], 1u);
    return b;
}
__device__ __forceinline__ void xcd_barrier_complete(unsigned* bar, unsigned x, unsigned& nloc, unsigned& nx) {
    const unsigned G = gridDim.x * gridDim.y * gridDim.z;
    unsigned sum, cnt, mine, sp = 0u;
    for (;;) {
        sum = 0u; cnt = 0u; mine = 0u;
#pragma unroll
        for (unsigned j = 0; j < 16; ++j) { const unsigned c = xb_ld(&bar[XB_XCNT(j)]); sum += c; cnt += (c > 0u) ? 1u : 0u; mine = (j == x) ? c : mine; }
        if (sum == G) break;
        __builtin_amdgcn_s_sleep(1);
        if ((++sp & 255u) == 0u) { if (xb_ld(&bar[XB_TMO])) break; if (sp > XB_SPIN_CAP) { atomicAdd(&bar[XB_TMO], 1u); break; } }
    }
    nloc = mine > 0u ? mine : 1u; nx = cnt > 0u ? cnt : 1u;
}
__device__ __forceinline__ void xcd_barrier(const XcdBarrier& b) {
    asm volatile("s_waitcnt vmcnt(0)" ::: "memory");
    __syncthreads();
    if (threadIdx.x == 0) {
        unsigned* bar = b.bar;
        __builtin_amdgcn_s_waitcnt(0);
        unsigned nloc = b.st[0], nx = b.st[1];
        if (nloc == 0u) { xcd_barrier_complete(bar, b.x, nloc, nx); b.st[0] = nloc; b.st[1] = nx; }
        const unsigned old = xb_add(&bar[XB_XSUB(b.x)], 1u);
        const unsigned gen = old / nloc;
        if (old + 1u == (gen + 1u) * nloc) {
            __builtin_amdgcn_fence(__ATOMIC_RELEASE, "agent");
            asm volatile("s_waitcnt vmcnt(0)" ::: "memory");
            const unsigned og = xb_add(&bar[XB_TOP], 1u);
            const unsigned tg = og / nx;
            if (og + 1u == (tg + 1u) * nx) xb_add(&bar[XB_TOPGEN], 1u);
            else XB_SPIN(xb_ld(&bar[XB_TOPGEN]) == tg, bar);
            __builtin_amdgcn_fence(__ATOMIC_ACQUIRE, "agent");
            xb_add(&bar[XB_XGEN(b.x)], 1u);
            asm volatile("s_waitcnt vmcnt(0)" ::: "memory");
        } else {
            XB_SPIN(xb_ld(&bar[XB_XGEN(b.x)]) == gen, bar);
            __builtin_amdgcn_fence(__ATOMIC_ACQUIRE, "agent");
            asm volatile("s_waitcnt vmcnt(0)" ::: "memory");
        }
    }
    __syncthreads();
}

namespace pg8 {
constexpr int BM = 256, BK = 64, HALF = 128, HTB = HALF * BK * 2, STAGE_BYTES = 8 * HTB, NXCD = 8, WGM = 8;
__host__ __device__ __forceinline__ int lds_byte(int r, int c) { const int st = (r >> 4) * 2 + (c >> 5), rr = r & 15, cc = c & 31, ob = rr * 64 + cc * 2; return st * 1024 + (ob ^ (((ob >> 9) & 1) << 5)); }
__host__ __device__ __forceinline__ void stage_rc(int b, int& R, int& C) { const int st = b / 1024, sb = b % 1024, swz = sb ^ (((sb >> 9) & 1) << 5); R = (st >> 1) * 16 + swz / 64; C = (st & 1) * 32 + (swz % 64) / 2; }
__host__ __device__ __forceinline__ int perm32(int rho) { const int n = rho >> 4, i = rho & 15; return 8 * (i >> 2) + 4 * n + (i & 3); }

struct Unit { int pm, pn, e; };
struct Gemm { const void* A; const void* Bt; int K; size_t estride; const int* arow; };

struct StaticOrder {
    int nM, nN, nwg, G, c, i;
    __device__ void init(int M, int N, int G_, int c_) { nM = M / BM; nN = N / BM; nwg = nM * nN; G = G_; c = c_; i = 0; }
    __device__ bool next(Unit& u) {
        const long L = (long)i * G + c; ++i; if (L >= nwg) return false;
        int wgid = (int)L; { const int q = nwg / NXCD, r = nwg % NXCD, xcd = wgid % NXCD, off = wgid / NXCD; wgid = (xcd < r ? xcd * (q + 1) : r * (q + 1) + (xcd - r) * q) + off; }
        const int nig = WGM * nN, gid = wgid / nig, fm = gid * WGM, gsz = (nM - fm) < WGM ? (nM - fm) : WGM;
        u.pm = fm + ((wgid % nig) % gsz); u.pn = (wgid % nig) / gsz; u.e = 0; return true;
    }
};
struct MoeOrder {
    int nPanels, nN, G, c, i; const LAS int* panel_e;
    __device__ void init(int nPanels_, int nN_, int G_, int c_, const LAS int* pe) { nPanels = nPanels_; nN = nN_; G = G_; c = c_; i = 0; panel_e = pe; }
    __device__ bool next(Unit& u) {
        const int PB = 256 / nN;
        const int nblk = (nPanels + PB - 1) / PB;
        for (;;) {
            const long L = (long)i * G + c; ++i;
            const int blk = (int)(L >> 8), r = (int)(L & 255), x = r & 7, j = r >> 3;
            if (blk >= nblk) return false;
            int pm, pn;
            if (nN == 16) { pm = blk * 16 + 4 * (x >> 1) + (j & 3); pn = 8 * (x & 1) + (j >> 2); }
            else          { pm = blk * 32 + 4 * x + (j & 3);        pn = j >> 2; }
            if (pm < nPanels) { u.pm = pm; u.pn = pn; u.e = panel_e[pm]; return true; }
        }
    }
};

template <class Epi, class Sched, bool FP8 = false>
__device__ __forceinline__ void gemm_phase(LAS unsigned char* lds, const Gemm g, Sched& S, const Epi& E) {
    const int tid = threadIdx.x, wid = __builtin_amdgcn_readfirstlane(tid >> 6), lane = tid & 63, wr = wid >> 2, wc = wid & 3, fr = lane & 15, fq = lane >> 4;
    const int K = g.K; const int pitch = FP8 ? K : 2 * K; const int nt = pitch / 128;
    unsigned voffA[2], voffB[2];
#pragma unroll
    for (int i = 0; i < 2; ++i) { int R, C; stage_rc(tid * 16 + i * 8192, R, C); const int Rb = Epi::PERM ? ((R & ~31) + perm32(R & 31)) : R;
        voffA[i] = (unsigned)(R * pitch + C * 2); voffB[i] = (unsigned)(Rb * pitch + C * 2); }
    const size_t kstep = (size_t)(BK * 2);
    const size_t hstep = (size_t)HALF * pitch;
    const size_t tstep = 2 * hstep;
    int RA[2], CA[2];
#pragma unroll
    for (int i = 0; i < 2; ++i) stage_rc(tid * 16 + i * 8192, RA[i], CA[i]);
    const bool gather = g.arow != nullptr;
    const size_t hsA = gather ? 0 : hstep;
    unsigned vA0[2] = {voffA[0], voffA[1]}, vA1[2] = {voffA[0], voffA[1]}, nA0[2] = {voffA[0], voffA[1]}, nA1[2] = {voffA[0], voffA[1]};
#define PG8_AOFF(dst0, dst1, u) do { if (gather) { _Pragma("unroll") for (int i = 0; i < 2; ++i) { \
        dst0[i] = (unsigned)g.arow[(u).pm * 256 + RA[i]] * (unsigned)pitch + (unsigned)(CA[i] * 2); dst1[i] = (unsigned)g.arow[(u).pm * 256 + 128 + RA[i]] * (unsigned)pitch + (unsigned)(CA[i] * 2); } } } while (0)
    const unsigned ldsw = (unsigned)wid * 1024u;
    const int aoff = lds_byte(wr * 64 + fr, fq * 8), boff = lds_byte(wc * 32 + fr, fq * 8);
#define PG8_SA(b, h) (((b) * 2 + (h)) * HTB)
#define PG8_SB(b, h) ((4 + (b) * 2 + (h)) * HTB)
#define PG8_STAGE(bufoff, gbase, voff) do { _Pragma("unroll") for (int _i = 0; _i < 2; ++_i) \
        __builtin_amdgcn_global_load_lds((const unsigned*)((const char*)(gbase) + (voff)[_i]), (LAS unsigned*)(lds + (bufoff) + ldsw + _i * 8192), 16, 0, 0); } while (0)
#define PG8_LD8(p) __builtin_shufflevector(*(const LAS i32x4*)(p), *(const LAS i32x4*)((p) + 1024), 0, 1, 2, 3, 4, 5, 6, 7)
#define PG8_LDA(dst, b, h) do { _Pragma("unroll") for (int m = 0; m < 4; ++m) { if constexpr (FP8) dst##8[m] = PG8_LD8(lds + PG8_SA(b, h) + aoff + m * 2048); \
        else { _Pragma("unroll") for (int k = 0; k < 2; ++k) dst[m][k] = *(const LAS bf16x8*)(lds + PG8_SA(b, h) + aoff + m * 2048 + k * 1024); } } } while (0)
#define PG8_LDB(dst, b, h) do { _Pragma("unroll") for (int n = 0; n < 2; ++n) { if constexpr (FP8) dst##8[n] = PG8_LD8(lds + PG8_SB(b, h) + boff + n * 2048); \
        else { _Pragma("unroll") for (int k = 0; k < 2; ++k) dst[n][k] = *(const LAS bf16x8*)(lds + PG8_SB(b, h) + boff + n * 2048 + k * 1024); } } } while (0)
#define PG8_MMA(ai, bj, At, Bt) do { __builtin_amdgcn_s_setprio(1); _Pragma("unroll") for (int m = 0; m < 4; ++m) _Pragma("unroll") for (int n = 0; n < 2; ++n) { \
        if constexpr (FP8) asm volatile("v_mfma_scale_f32_16x16x128_f8f6f4 %0, %1, %2, %0, %3, %3 op_sel_hi:[0,0,0]" : "+v"(acc[ai][bj][m][n]) : "v"(Bt##8[n]), "v"(At##8[m]), "v"(scl1)); \
        else { _Pragma("unroll") for (int k = 0; k < 2; ++k) acc[ai][bj][m][n] = __builtin_amdgcn_mfma_f32_16x16x32_bf16(Bt[n][k], At[m][k], acc[ai][bj][m][n], 0, 0, 0); } } \
        __builtin_amdgcn_s_setprio(0); } while (0)
#define PG8_WAIT_V(n) asm volatile("s_waitcnt vmcnt(" #n ")" ::: "memory")
#define PG8_WAIT_L(n) asm volatile("s_waitcnt lgkmcnt(" #n ")" ::: "memory")
#define PG8_BAR __builtin_amdgcn_s_barrier()
#define PG8_SCHED __builtin_amdgcn_sched_barrier(0)
    Unit cur, nxt;
    if (!S.next(cur)) return;
    const unsigned scl1 = 0x7f7f7f7fu;
    f32x4 acc[2][2][4][2];
#pragma unroll
    for (int a = 0; a < 2; ++a)
#pragma unroll
        for (int b = 0; b < 2; ++b)
#pragma unroll
            for (int m = 0; m < 4; ++m)
#pragma unroll
                for (int n = 0; n < 2; ++n) acc[a][b][m][n] = (f32x4){0.f, 0.f, 0.f, 0.f};
    bf16x8 At[4][2], B0[2][2], B1[2][2]; i32x8 At8[4], B08[2], B18[2];
    const char* cA = (const char*)g.A + (gather ? (size_t)0 : (size_t)cur.pm * tstep); const char* cB = (const char*)g.Bt + (size_t)cur.e * g.estride + (size_t)cur.pn * tstep;
    PG8_AOFF(vA0, vA1, cur);
    PG8_STAGE(PG8_SB(0, 0), cB, voffB); PG8_STAGE(PG8_SB(0, 1), cB + hstep, voffB); PG8_STAGE(PG8_SA(0, 0), cA, vA0); PG8_STAGE(PG8_SA(0, 1), cA + hsA, vA1);
    if (wr == 1) PG8_BAR;
    PG8_WAIT_V(2); PG8_BAR;
    PG8_STAGE(PG8_SB(1, 0), cB + kstep, voffB); PG8_STAGE(PG8_SA(1, 0), cA + kstep, vA0); PG8_STAGE(PG8_SB(1, 1), cB + hstep + kstep, voffB);
    PG8_WAIT_V(6); PG8_BAR;
    for (;;) {
        const bool has_next = S.next(nxt);
        const char* nA = has_next ? (const char*)g.A + (gather ? (size_t)0 : (size_t)nxt.pm * tstep) : cA;
        if (has_next) PG8_AOFF(nA0, nA1, nxt);
        const char* nB = has_next ? (const char*)g.Bt + (size_t)nxt.e * g.estride + (size_t)nxt.pn * tstep : cB;
        for (int t = 0; t < nt; t += 2) {
            const bool last = (t == nt - 2);
            const char* a1 = cA + (size_t)(t + 1) * kstep;
            const char* a2 = last ? nA : cA + (size_t)(t + 2) * kstep; const char* b2 = last ? nB : cB + (size_t)(t + 2) * kstep;
            const char* a3 = a2 + kstep; const char* b3 = b2 + kstep;
            PG8_LDB(B0, 0, 0); PG8_LDB(B1, 0, 1); PG8_SCHED; PG8_LDA(At, 0, 0); PG8_STAGE(PG8_SA(1, 1), a1 + hsA, vA1);
            if (last && has_next) { vA0[0] = nA0[0]; vA0[1] = nA0[1]; vA1[0] = nA1[0]; vA1[1] = nA1[1]; }
            PG8_WAIT_V(8); PG8_WAIT_L(0); PG8_BAR; PG8_MMA(0, 0, At, B0); PG8_MMA(0, 1, At, B1); PG8_BAR; PG8_SCHED;
            PG8_LDA(At, 0, 1); PG8_STAGE(PG8_SB(0, 0), b2, voffB); PG8_STAGE(PG8_SB(0, 1), b2 + hstep, voffB); PG8_STAGE(PG8_SA(0, 0), a2, vA0);
            PG8_WAIT_V(8); PG8_WAIT_L(0); PG8_BAR; PG8_MMA(1, 0, At, B0); PG8_MMA(1, 1, At, B1); PG8_BAR; PG8_SCHED;
            PG8_LDB(B0, 1, 0); PG8_LDB(B1, 1, 1); PG8_SCHED; PG8_LDA(At, 1, 0); PG8_STAGE(PG8_SA(0, 1), a2 + hsA, vA1);
            PG8_WAIT_V(8); PG8_WAIT_L(0); PG8_BAR; PG8_MMA(0, 0, At, B0); PG8_MMA(0, 1, At, B1); PG8_BAR; PG8_SCHED;
            PG8_LDA(At, 1, 1); PG8_STAGE(PG8_SB(1, 0), b3, voffB); PG8_STAGE(PG8_SB(1, 1), b3 + hstep, voffB); PG8_STAGE(PG8_SA(1, 0), a3, vA0);
            PG8_WAIT_V(8); PG8_WAIT_L(0); PG8_BAR; PG8_MMA(1, 0, At, B0); PG8_MMA(1, 1, At, B1); PG8_BAR; PG8_SCHED;
        }
        if (wr == 0) PG8_BAR;
        if constexpr (FP8) {
#pragma unroll
            for (int a = 0; a < 2; ++a)
#pragma unroll
                for (int b = 0; b < 2; ++b) asm volatile("s_nop 15" : "+v"(acc[a][b][0][0]), "+v"(acc[a][b][0][1]), "+v"(acc[a][b][1][0]), "+v"(acc[a][b][1][1]), "+v"(acc[a][b][2][0]), "+v"(acc[a][b][2][1]), "+v"(acc[a][b][3][0]), "+v"(acc[a][b][3][1]));
        }
        E(acc, cur, wr, wc, fr, fq);
        if (!has_next) break;
#pragma unroll
        for (int a = 0; a < 2; ++a)
#pragma unroll
            for (int b = 0; b < 2; ++b)
#pragma unroll
                for (int m = 0; m < 4; ++m)
#pragma unroll
                    for (int n = 0; n < 2; ++n) acc[a][b][m][n] = (f32x4){0.f, 0.f, 0.f, 0.f};
        cur = nxt; cA = nA; cB = nB;
        if (wr == 1) PG8_BAR;
    }
    PG8_WAIT_V(0);
    PG8_BAR;
#undef PG8_AOFF
#undef PG8_SA
#undef PG8_SB
#undef PG8_STAGE
#undef PG8_LDA
#undef PG8_LDB
#undef PG8_MMA
#undef PG8_LD8
#undef PG8_WAIT_V
#undef PG8_WAIT_L
#undef PG8_BAR
#undef PG8_SCHED
}

struct EpiBf16 {
    static constexpr bool PERM = true;
    bf16_t* O; int ldc; const float* bias; int bias_estride; float ascale;
    __device__ __forceinline__ void operator()(const f32x4 (&acc)[2][2][4][2], const Unit& u, int wr, int wc, int fr, int fq) const {
        const int row0 = u.pm * BM + wr * 64 + fr; const int col0 = u.pn * BM + wc * 32 + 8 * fq;
        f32x4 bv[2][2];
#pragma unroll
        for (int bj = 0; bj < 2; ++bj)
#pragma unroll
            for (int n = 0; n < 2; ++n) bv[bj][n] = bias ? *(const f32x4*)(bias + (size_t)u.e * bias_estride + col0 + bj * HALF + 4 * n) : (f32x4){0.f, 0.f, 0.f, 0.f};
#pragma unroll
        for (int ai = 0; ai < 2; ++ai)
#pragma unroll
            for (int m = 0; m < 4; ++m) { bf16_t* rowp = O + (size_t)(row0 + ai * HALF + m * 16) * ldc + col0;
#pragma unroll
                for (int bj = 0; bj < 2; ++bj) { const f32x4 v0 = acc[ai][bj][m][0] * ascale + bv[bj][0], v1 = acc[ai][bj][m][1] * ascale + bv[bj][1];
                    u32x4 w; w.x = cvt_pk_bf16(v0[0], v0[1]); w.y = cvt_pk_bf16(v0[2], v0[3]); w.z = cvt_pk_bf16(v1[0], v1[1]); w.w = cvt_pk_bf16(v1[2], v1[3]);
                    *(u32x4*)(rowp + bj * HALF) = w; } }
    }
};
__device__ __forceinline__ float swiglu1(float ug, float ul) {
    ug = fminf(ug, 7.0f); ul = fminf(fmaxf(ul, -7.0f), 7.0f);
    return ug * __builtin_amdgcn_rcpf(1.0f + __expf(-1.702f * ug)) * (ul + 1.0f);
}
struct EpiSwiglu {
    static constexpr bool PERM = true;
    unsigned char* O; const float* b1;
    __device__ __forceinline__ void operator()(const f32x4 (&acc)[2][2][4][2], const Unit& u, int wr, int wc, int fr, int fq) const {
        const int row0 = u.pm * BM + wr * 64 + fr; const int c0 = u.pn * 128 + wc * 32 + 8 * fq;
        const float* bg = b1 + (size_t)u.e * 4096 + c0; const float* bl = bg + 2048;
        f32x4 bgv[2], blv[2];
#pragma unroll
        for (int n = 0; n < 2; ++n) { bgv[n] = *(const f32x4*)(bg + 4 * n); blv[n] = *(const f32x4*)(bl + 4 * n); }
#pragma unroll
        for (int ai = 0; ai < 2; ++ai)
#pragma unroll
            for (int m = 0; m < 4; ++m) {
                float a[8];
#pragma unroll
                for (int n = 0; n < 2; ++n)
#pragma unroll
                    for (int j = 0; j < 4; ++j) a[4 * n + j] = ACT8_SCALE * swiglu1(acc[ai][0][m][n][j] * (1.0f / W8_SCALE) + bgv[n][j], acc[ai][1][m][n][j] * (1.0f / W8_SCALE) + blv[n][j]);
                u32x2 w; w.x = pack4_fp8(a[0], a[1], a[2], a[3]); w.y = pack4_fp8(a[4], a[5], a[6], a[7]);
                *(u32x2*)(O + (size_t)(row0 + ai * HALF + m * 16) * 2048 + c0) = w;
            }
    }
};

struct EpiGate {
    static constexpr bool PERM = true;
    bf16_t* O; const bf16_t* Gt; int accum;
    __device__ __forceinline__ void operator()(const f32x4 (&acc)[2][2][4][2], const Unit& u, int wr, int wc, int fr, int fq) const {
        const int row0 = u.pm * BM + wr * 64 + fr; const int col0 = u.pn * BM + wc * 32 + 8 * fq;
#pragma unroll
        for (int ai = 0; ai < 2; ++ai)
#pragma unroll
            for (int m = 0; m < 4; ++m) { const size_t row = (size_t)(row0 + ai * HALF + m * 16);
#pragma unroll
                for (int bj = 0; bj < 2; ++bj) { const int c = col0 + bj * HALF;
                    const u32x4 gw = *(const u32x4*)(Gt + row * DINP + c);
                    float r[8];
#pragma unroll
                    for (int q = 0; q < 4; ++q) { r[2 * q] = sigmoidf_(bf_lo(gw[q])) * acc[ai][bj][m][q >> 1][(2 * q) & 3]; r[2 * q + 1] = sigmoidf_(bf_hi(gw[q])) * acc[ai][bj][m][q >> 1][(2 * q + 1) & 3]; }
                    bf16_t* op = O + row * 2048 + c;
                    if (accum) { const u32x4 ow = *(const u32x4*)op;
#pragma unroll
                        for (int q = 0; q < 4; ++q) { r[2 * q] += bf_lo(ow[q]); r[2 * q + 1] += bf_hi(ow[q]); } }
                    u32x4 w; w.x = cvt_pk_bf16(r[0], r[1]); w.y = cvt_pk_bf16(r[2], r[3]); w.z = cvt_pk_bf16(r[4], r[5]); w.w = cvt_pk_bf16(r[6], r[7]);
                    *(u32x4*)op = w; } }
    }
};
struct EpiResid {
    static constexpr bool PERM = false;
    const float* x; const float* gt; float* X1;
    __device__ __forceinline__ void operator()(const f32x4 (&acc)[2][2][4][2], const Unit& u, int wr, int wc, int fr, int fq) const {
        const int row0 = u.pm * BM + wr * 64 + fr; const int col0 = u.pn * BM + wc * 32 + 4 * fq;
#pragma unroll
        for (int ai = 0; ai < 2; ++ai)
#pragma unroll
            for (int m = 0; m < 4; ++m) { const size_t row = (size_t)(row0 + ai * HALF + m * 16);
#pragma unroll
                for (int bj = 0; bj < 2; ++bj)
#pragma unroll
                    for (int n = 0; n < 2; ++n) { const int c = col0 + bj * HALF + n * 16;
                        const f32x4 xv = *(const f32x4*)(x + row * 2048 + c), g = *(const f32x4*)(gt + c);
                        *(f32x4*)(X1 + row * 2048 + c) = xv + g * acc[ai][bj][m][n]; } }
    }
};
}

#ifndef MK_REP
#define MK_REP 0
#endif
#ifndef MK_REP2
#define MK_REP2 0
#endif
struct Args { const void* in[22]; float* out; unsigned char* ws; int ph_lo, ph_hi, flags, pad; };
enum { PH_PRO = 0, PH_H, PH_INPROJ, PH_POST, PH_SCORE, PH_SELECT, PH_ATTN, PH_OP1, PH_OP2, PH_WOUT, PH_ROUTER, PH_SCATTER, PH_MOE1, PH_MOE2, PH_FINAL, NPH };
constexpr int FLAG_MIXER = 1, FLAG_ATT = 2, FLAG_MOE = 4;

__device__ __forceinline__ int dest_row(int mode, int n) {
    if (mode == 1) return n < 2640 ? n : n + 176;
    if (mode == 2) { const int g = n >> 11, c = n & 2047; return (c >> 7) * 256 + g * 128 + (c & 127); }
    return n;
}
__device__ __forceinline__ void convert_item(const float* __restrict__ W, int K, int N, bf16_t* WT, int mode, int item, int lane, LAS unsigned char* scr) {
    const int nblk = (N + 63) >> 6; const int kb = item / nblk, nb = item - kb * nblk; const int k0 = kb * 128, n0 = nb * 64;
    const int c4 = lane & 15, kr = lane >> 4;
    const bool ok = (n0 + 4 * c4) < N;
    const float* src = W + (size_t)(k0 + 2 * kr) * N + n0 + 4 * c4;
#pragma unroll 4
    for (int i = 0; i < 16; ++i) {
        f32x4 v0 = (f32x4){0.f, 0.f, 0.f, 0.f}, v1 = v0;
        if (ok) { v0 = *(const f32x4*)(src + (size_t)(8 * i) * N); v1 = *(const f32x4*)(src + (size_t)(8 * i + 1) * N); }
        const int kk = 8 * i + 2 * kr;
#pragma unroll
        for (int e = 0; e < 4; ++e) *(LAS unsigned*)(scr + (4 * c4 + e) * 272 + kk * 2) = cvt_pk_bf16(v0[e], v1[e]);
    }
    LDS_WAIT(); asm volatile("" ::: "memory");
#pragma unroll 4
    for (int j = 0; j < 16; ++j) {
        const int q = j * 64 + lane, n = q >> 4, ch = q & 15;
        const u32x4 v = *(const LAS u32x4*)(scr + n * 272 + ch * 16);
        if (n0 + n < N) *(u32x4*)(WT + (size_t)dest_row(mode, n0 + n) * K + k0 + ch * 8) = v;
    }
    LDS_WAIT(); asm volatile("" ::: "memory");
}


__device__ __forceinline__ bf16_t f2bf(float f) { unsigned u = __float_as_uint(f); return (bf16_t)((u + 0x7fffu + ((u >> 16) & 1u)) >> 16); }
__device__ __forceinline__ float bfx(const u32x4& w, int i) { const unsigned u = w[i >> 1]; return (i & 1) ? bf_hi(u) : bf_lo(u); }
__device__ __forceinline__ void rope_sc(float pos, float inv, float& sn, float& cs) {
    const float ang = pos * inv;
    const double a = (double)ang; const double n = __builtin_rint(a * 0.15915494309189535); const float r = (float)(a - n * 6.283185307179586);
    sn = sinf(r); cs = cosf(r);
}
__device__ __forceinline__ void post_token(bf16_t* PROJ, bf16_t* KI, bf16_t* KC, bf16_t* VC, const int* positions, const float* kng, const float* knb, int t, int lane) {
    const float pos = (float)positions[t];
    bf16_t* row = PROJ + (size_t)t * DINP;
    float sn, cs;
#pragma unroll
    for (int i = 0; i < 2; ++i) {
        const int pp = lane + 64 * i, hd = pp >> 4, ii = pp & 15;
        rope_sc(pos, powf(500000.0f, -(float)ii * (1.0f / 16.0f)), sn, cs);
        bf16_t* p = row + CQ + hd * 128 + ii; const float a = bf2f(p[0]), b = bf2f(p[16]);
        p[0] = f2bf(a * cs - b * sn); p[16] = f2bf(b * cs + a * sn);
    }
#pragma unroll
    for (int i = 0; i < 2; ++i) {
        const int pp = lane + 64 * i, hd = pp >> 3, ii = pp & 7;
        rope_sc(pos, powf(500000.0f, -(float)ii * (1.0f / 8.0f)), sn, cs);
        bf16_t* p = row + CQI + hd * 64 + ii; const float a = bf2f(p[0]), b = bf2f(p[8]);
        p[0] = f2bf(a * cs - b * sn); p[8] = f2bf(b * cs + a * sn);
    }
    if (lane < 32) {
        const int g = lane >> 4, ii = lane & 15;
        rope_sc(pos, powf(500000.0f, -(float)ii * (1.0f / 16.0f)), sn, cs);
        const bf16_t* p = row + CK + g * 128 + ii; const float a = bf2f(p[0]), b = bf2f(p[16]);
        bf16_t* o = KC + (size_t)t * 256 + g * 128 + ii; o[0] = f2bf(a * cs - b * sn); o[16] = f2bf(b * cs + a * sn);
    }
#pragma unroll
    for (int i = 0; i < 3; ++i) { const int idx = lane + 64 * i, g = idx / 96, r = idx - g * 96; KC[(size_t)t * 256 + g * 128 + 32 + r] = row[CK + g * 128 + 32 + r]; }
    *(u32x2*)(VC + (size_t)t * 256 + 4 * lane) = *(const u32x2*)(row + CV + 4 * lane);
    {
        const float v = bf2f(row[CKI + lane]);
        const float mean = wave_sum(v) * (1.0f / 64.0f); const float d = v - mean; const float var = wave_sum(d * d) * (1.0f / 64.0f);
        const float y = d * rsqrtf(var + NORM_EPS) * kng[lane] + knb[lane];
        const float other = __shfl_xor(y, 8);
        rope_sc(pos, powf(500000.0f, -(float)(lane & 7) * (1.0f / 8.0f)), sn, cs);
        float o = y;
        if (lane < 8) o = y * cs - other * sn; else if (lane < 16) o = y * cs + other * sn;
        KI[(size_t)t * 64 + lane] = f2bf(o);
    }
}

constexpr int HG_GB = 0, HG_Q1 = 33792, HG_Q2 = 51200, HG_K2 = 68608, HG_VT = 86016, HG_PB = 104448, HG_LB = 113664;
__device__ __forceinline__ void hgrn_cumsum(LAS unsigned char* lds, const u32x4& w0, const u32x4& w1, float l0, float l1, int tid) {
    LAS float* GB = (LAS float*)(lds + HG_GB); LAS float* LB = (LAS float*)(lds + HG_LB); LAS float* SEG = (LAS float*)(lds + HG_LB + 512);
    if (tid < 128) LB[tid] = 1.0f / (1.0f + expf(l1 - l0));
    __syncthreads();
    const int t = tid >> 3, dseg = tid & 7;
#pragma unroll
    for (int i = 0; i < 16; ++i) { const float z = i < 8 ? bfx(w0, i) : bfx(w1, i - 8); const float lb = LB[16 * dseg + i]; GB[t * 128 + 16 * dseg + i] = logf(lb + (1.0f - lb) * sigmoidf_(z)); }
    __syncthreads();
    const int d = tid & 127, tq = tid >> 7;
    float z[16];
#pragma unroll
    for (int i = 0; i < 16; ++i) z[i] = GB[(16 * tq + i) * 128 + d];
    float a = 0.f;
#pragma unroll
    for (int i = 0; i < 16; ++i) { a += z[i]; z[i] = a; }
    SEG[tq * 128 + d] = a;
    __syncthreads();
    float pre = 0.f;
    for (int q = 0; q < tq; ++q) pre += SEG[q * 128 + d];
#pragma unroll
    for (int i = 0; i < 16; ++i) GB[(16 * tq + i) * 128 + d] = z[i] + pre;
    __syncthreads();
}
__device__ __forceinline__ void hgrn_vt(LAS unsigned char* lds, const u32x4& a, const u32x4& b, int tid) {
    const int s2 = tid & 31, eg = tid >> 5;
#pragma unroll
    for (int i = 0; i < 8; ++i) { const unsigned lo = (i & 1) ? (a[i >> 1] >> 16) : (a[i >> 1] & 0xffffu), hi = (i & 1) ? (b[i >> 1] >> 16) : (b[i >> 1] & 0xffffu);
        *(LAS unsigned*)(lds + HG_VT + (8 * eg + i) * 144 + s2 * 4) = lo | (hi << 16); }
}
__device__ __forceinline__ void hgrn_l1(LAS unsigned char* lds, const bf16_t* PROJ, const float* lb_logits, float* ST, float* DC, int c, int h, int tid, int wave, int lane) {
    const int t = tid >> 3, dseg = tid & 7, s2 = tid & 31, dg = tid >> 5;
    const bf16_t* pf = PROJ + (size_t)(c * 64 + t) * DINP + CHF + h * 128 + 16 * dseg;
    const bf16_t* pk = PROJ + (size_t)(c * 64 + 2 * s2) * DINP + CHF + h * 128 + 8 * dg;
    const u32x4 w0 = *(const u32x4*)pf, w1 = *(const u32x4*)(pf + 8);
    const u32x4 ka = *(const u32x4*)pk, kb = *(const u32x4*)(pk + DINP);
    const u32x4 va = *(const u32x4*)(pk - CHF + CHI), vb = *(const u32x4*)(pk - CHF + CHI + DINP);
    const float l0 = lb_logits[h * 128 + (tid & 127)], l1 = lb_logits[1024 + h * 128 + (tid & 127)];
    hgrn_cumsum(lds, w0, w1, l0, l1, tid);
    const LAS float* GB = (const LAS float*)(lds + HG_GB); const LAS float* LB = (const LAS float*)(lds + HG_LB);
    {
#pragma unroll
        for (int i = 0; i < 8; ++i) { const int d = 8 * dg + i; const float lb = LB[d], b63 = GB[63 * 128 + d];
            const float k0 = (1.0f - lb) * (1.0f - sigmoidf_(bfx(ka, i))), k1 = (1.0f - lb) * (1.0f - sigmoidf_(bfx(kb, i)));
            const float v0 = k0 * __expf(b63 - GB[(2 * s2) * 128 + d]), v1 = k1 * __expf(b63 - GB[(2 * s2 + 1) * 128 + d]);
            *(LAS unsigned*)(lds + HG_Q1 + d * 144 + s2 * 4) = cvt_pk_bf16(v0, v1); }
    }
    hgrn_vt(lds, va, vb, tid);
    __syncthreads();
    const int fr = lane & 15, fq = lane >> 4;
    bf16x8 af[2];
#pragma unroll
    for (int ks = 0; ks < 2; ++ks) af[ks] = *(const LAS bf16x8*)(lds + HG_VT + (16 * wave + fr) * 144 + (32 * ks + 8 * fq) * 2);
    float* dst = ST + ((size_t)(c * 8 + h) * 128) * 128;
#pragma unroll 2
    for (int dt = 0; dt < 8; ++dt) {
        f32x4 acc = (f32x4){0.f, 0.f, 0.f, 0.f};
#pragma unroll
        for (int ks = 0; ks < 2; ++ks) { const bf16x8 bfr = *(const LAS bf16x8*)(lds + HG_Q1 + (16 * dt + fr) * 144 + (32 * ks + 8 * fq) * 2); acc = __builtin_amdgcn_mfma_f32_16x16x32_bf16(af[ks], bfr, acc, 0, 0, 0); }
#pragma unroll
        for (int r = 0; r < 4; ++r) dst[(size_t)(16 * wave + 4 * fq + r) * 128 + 16 * dt + fr] = acc[r];
    }
    if (tid < 128) DC[(size_t)(c * 8 + h) * 128 + tid] = __expf(GB[63 * 128 + tid]);
    __syncthreads();
}
__device__ __forceinline__ void hgrn_l3(LAS unsigned char* lds, const bf16_t* PROJ, const float* lb_logits, const float* ST, const float* norm_g, bf16_t* REC, int c, int h, int tid, int wave, int lane) {
    const int t = tid >> 3, dseg = tid & 7, s2 = tid & 31, eg = tid >> 5, fr = lane & 15, fq = lane >> 4;
    const bf16_t* pf = PROJ + (size_t)(c * 64 + t) * DINP + CHF + h * 128 + 16 * dseg;
    const u32x4 f0 = *(const u32x4*)pf, f1 = *(const u32x4*)(pf + 8), q0 = *(const u32x4*)(pf - CHF + CHQ), q1 = *(const u32x4*)(pf - CHF + CHQ + 8);
    const u32x4 g0 = *(const u32x4*)(pf - CHF + CHG), g1 = *(const u32x4*)(pf - CHF + CHG + 8);
    const bf16_t* pv = PROJ + (size_t)(c * 64 + 2 * s2) * DINP + CHI + h * 128 + 8 * eg;
    const u32x4 va = *(const u32x4*)pv, vb = *(const u32x4*)(pv + DINP);
    const float* sp = ST + ((size_t)(c * 8 + h) * 128 + 16 * wave + fr) * 128 + 8 * fq;
    f32x4 sx[4][2];
#pragma unroll
    for (int ks = 0; ks < 4; ++ks) { sx[ks][0] = *(const f32x4*)(sp + 32 * ks); sx[ks][1] = *(const f32x4*)(sp + 32 * ks + 4); }
    const float l0 = lb_logits[h * 128 + (tid & 127)], l1 = lb_logits[1024 + h * 128 + (tid & 127)];
    hgrn_cumsum(lds, f0, f1, l0, l1, tid);
    const LAS float* GB = (const LAS float*)(lds + HG_GB); const LAS float* LB = (const LAS float*)(lds + HG_LB);
    {
        unsigned o1[8], o2[8], o3[8];
#pragma unroll
        for (int i = 0; i < 16; i += 2) {
            float a1[2], a2[2], a3[2];
#pragma unroll
            for (int j = 0; j < 2; ++j) { const int d = 16 * dseg + i + j; const float lb = LB[d], b = GB[t * 128 + d], br = GB[31 * 128 + d];
                const float z = (i + j) < 8 ? bfx(f0, i + j) : bfx(f1, i + j - 8), qv = (i + j) < 8 ? bfx(q0, i + j) : bfx(q1, i + j - 8);
                const float k = (1.0f - lb) * (1.0f - sigmoidf_(z)), q = siluf_(qv);
                a1[j] = q * __expf(b); a2[j] = q * __expf(b - br); a3[j] = k * __expf(br - b); }
            o1[i >> 1] = cvt_pk_bf16(a1[0], a1[1]); o2[i >> 1] = cvt_pk_bf16(a2[0], a2[1]); o3[i >> 1] = cvt_pk_bf16(a3[0], a3[1]);
        }
        LAS u32x4* d1 = (LAS u32x4*)(lds + HG_Q1 + t * 272 + dseg * 32); LAS u32x4* d2 = (LAS u32x4*)(lds + HG_Q2 + t * 272 + dseg * 32); LAS u32x4* d3 = (LAS u32x4*)(lds + HG_K2 + t * 272 + dseg * 32);
        d1[0] = (u32x4){o1[0], o1[1], o1[2], o1[3]}; d1[1] = (u32x4){o1[4], o1[5], o1[6], o1[7]};
        d2[0] = (u32x4){o2[0], o2[1], o2[2], o2[3]}; d2[1] = (u32x4){o2[4], o2[5], o2[6], o2[7]};
        d3[0] = (u32x4){o3[0], o3[1], o3[2], o3[3]}; d3[1] = (u32x4){o3[4], o3[5], o3[6], o3[7]};
    }
    hgrn_vt(lds, va, vb, tid);
    __syncthreads();
#pragma unroll
    for (int q = 0; q < 2; ++q) {
        const int tile = 2 * wave + q, tt = tile >> 2, stl = tile & 3;
        f32x4 acc = (f32x4){0.f, 0.f, 0.f, 0.f};
#pragma unroll
        for (int ks = 0; ks < 4; ++ks) { const bf16x8 a = *(const LAS bf16x8*)(lds + HG_Q2 + (16 * tt + fr) * 272 + (32 * ks + 8 * fq) * 2), b = *(const LAS bf16x8*)(lds + HG_K2 + (16 * stl + fr) * 272 + (32 * ks + 8 * fq) * 2);
            acc = __builtin_amdgcn_mfma_f32_16x16x32_bf16(a, b, acc, 0, 0, 0); }
#pragma unroll
        for (int r = 0; r < 4; ++r) { const int tr_ = 16 * tt + 4 * fq + r, s = 16 * stl + fr; *(LAS bf16_t*)(lds + HG_PB + tr_ * 144 + s * 2) = f2bf(s <= tr_ ? acc[r] : 0.f); }
    }
    __syncthreads();
    {
        bf16x8 b1[2], b2[4];
#pragma unroll
        for (int ks = 0; ks < 2; ++ks) b1[ks] = *(const LAS bf16x8*)(lds + HG_VT + (16 * wave + fr) * 144 + (32 * ks + 8 * fq) * 2);
#pragma unroll
        for (int ks = 0; ks < 4; ++ks) { const f32x4 x0 = sx[ks][0], x1 = sx[ks][1];
            u32x4 w; w.x = cvt_pk_bf16(x0[0], x0[1]); w.y = cvt_pk_bf16(x0[2], x0[3]); w.z = cvt_pk_bf16(x1[0], x1[1]); w.w = cvt_pk_bf16(x1[2], x1[3]); b2[ks] = __builtin_bit_cast(bf16x8, w); }
        LAS float* OB = (LAS float*)(lds + HG_GB);
#pragma unroll
        for (int tt = 0; tt < 4; ++tt) {
            f32x4 acc = (f32x4){0.f, 0.f, 0.f, 0.f};
#pragma unroll
            for (int ks = 0; ks < 2; ++ks) { const bf16x8 a = *(const LAS bf16x8*)(lds + HG_PB + (16 * tt + fr) * 144 + (32 * ks + 8 * fq) * 2); acc = __builtin_amdgcn_mfma_f32_16x16x32_bf16(a, b1[ks], acc, 0, 0, 0); }
#pragma unroll
            for (int ks = 0; ks < 4; ++ks) { const bf16x8 a = *(const LAS bf16x8*)(lds + HG_Q1 + (16 * tt + fr) * 272 + (32 * ks + 8 * fq) * 2); acc = __builtin_amdgcn_mfma_f32_16x16x32_bf16(a, b2[ks], acc, 0, 0, 0); }
#pragma unroll
            for (int r = 0; r < 4; ++r) OB[(16 * tt + 4 * fq + r) * 132 + 16 * wave + fr] = acc[r];
        }
    }
    __syncthreads();
    {
        const int es = dseg; const LAS float* OB = (const LAS float*)(lds + HG_GB);
        float o[16]; float ss = 0.f;
#pragma unroll
        for (int i = 0; i < 16; ++i) { o[i] = OB[t * 132 + 16 * es + i]; ss += o[i] * o[i]; }
        ss += __shfl_xor(ss, 1); ss += __shfl_xor(ss, 2); ss += __shfl_xor(ss, 4);
        const float rstd = rsqrtf(ss * (1.0f / 128.0f) + NORM_EPS);
        unsigned w[8];
#pragma unroll
        for (int i = 0; i < 16; i += 2) { const float ga = i < 8 ? bfx(g0, i) : bfx(g1, i - 8), gb = (i + 1) < 8 ? bfx(g0, i + 1) : bfx(g1, i + 1 - 8);
            w[i >> 1] = cvt_pk_bf16(o[i] * rstd * norm_g[16 * es + i] * siluf_(ga), o[i + 1] * rstd * norm_g[16 * es + i + 1] * siluf_(gb)); }
        u32x4* dst = (u32x4*)(REC + (size_t)(c * 64 + t) * 1024 + h * 128 + 16 * es);
        dst[0] = (u32x4){w[0], w[1], w[2], w[3]}; dst[1] = (u32x4){w[4], w[5], w[6], w[7]};
    }
    __syncthreads();
}

constexpr int SC_KT = 0, SC_SB = 36864, SC_SPITCH = 132;
__device__ __forceinline__ unsigned pk_f16(float a, float b) { return __builtin_bit_cast(unsigned, __builtin_amdgcn_cvt_pkrtz(a, b)); }
__device__ __forceinline__ void score_flush(LAS unsigned char* lds, unsigned short* SCORES, int t0, int kt, int tid) {
    const LAS float* sb = (const LAS float*)(lds + SC_SB + (kt & 1) * (32 * SC_SPITCH * 4));
    const int row = tid >> 4, seg = tid & 15;
    const f32x4 a = *(const LAS f32x4*)(sb + row * SC_SPITCH + seg * 8), b = *(const LAS f32x4*)(sb + row * SC_SPITCH + seg * 8 + 4);
    unsigned short* dst = SCORES + (size_t)(t0 + row) * S + kt * 128 + seg * 8;
    *(u32x4*)dst = (u32x4){pk_f16(a[0], a[1]), pk_f16(a[2], a[3]), pk_f16(b[0], b[1]), pk_f16(b[2], b[3])};
}
__device__ __forceinline__ void score_block(LAS unsigned char* lds, const bf16_t* PROJ, const bf16_t* KI, unsigned short* SCORES, int qb, int tid, int wave, int lane) {
    const int t0 = qb * 32, nkt = (t0 >> 7) + 1;
    const int r = lane & 31, hh = lane >> 5;
    bf16x8 Af[2][4]; float wv[2][16]; f32x2 wv2[2][8];
#pragma unroll
    for (int p = 0; p < 2; ++p) {
        const int tq = t0 + 4 * wave + 2 * p + (r >> 4); const bf16_t* qrow = PROJ + (size_t)tq * DINP + CQI + (r & 15) * 64 + 8 * hh;
#pragma unroll
        for (int ks = 0; ks < 4; ++ks) Af[p][ks] = *(const bf16x8*)(qrow + 16 * ks);
#pragma unroll
        for (int reg = 0; reg < 16; ++reg) { const int row = (reg & 3) + 8 * (reg >> 2) + 4 * hh; const int tw = t0 + 4 * wave + 2 * p + (row >> 4);
            wv[p][reg] = bf2f(PROJ[(size_t)tw * DINP + CWI + (row & 15)]) * (1.0f / 32.0f); }
#pragma unroll
        for (int i = 0; i < 8; ++i) wv2[p][i] = (f32x2){wv[p][2 * i], wv[p][2 * i + 1]};
    }
    const u32x2 tagsw = __builtin_amdgcn_permlane32_swap(0u, 1u, false, false); const int qsel = (int)tagsw[0];
    u32x4 stg[2];
#pragma unroll
    for (int i = 0; i < 2; ++i) { const int q = tid + 512 * i; stg[i] = *(const u32x4*)(KI + (size_t)(q >> 3) * 64 + (q & 7) * 8); }
#pragma unroll
    for (int i = 0; i < 2; ++i) { const int q = tid + 512 * i; *(LAS u32x4*)(lds + SC_KT + (q >> 3) * 144 + (q & 7) * 16) = stg[i]; }
    __syncthreads();
    for (int kt = 0; kt < nkt; ++kt) {
        const LAS unsigned char* buf = lds + SC_KT + (kt & 1) * 18432;
        LAS float* sb = (LAS float*)(lds + SC_SB + (kt & 1) * (32 * SC_SPITCH * 4));
        if (kt > 0) score_flush(lds, SCORES, t0, kt - 1, tid);
        if (kt + 1 < nkt) {
#pragma unroll
            for (int i = 0; i < 2; ++i) { const int q = tid + 512 * i; stg[i] = *(const u32x4*)(KI + (size_t)((kt + 1) * 128 + (q >> 3)) * 64 + (q & 7) * 8); }
        }
        for (int rep2 = 0; rep2 < ((MK_REP2) & 1) + 1; ++rep2) {
        f32x16 accP[2], accC[2];
#define SC_MFMA(cb) do { bf16x8 Bf[4]; _Pragma("unroll") for (int ks = 0; ks < 4; ++ks) Bf[ks] = *(const LAS bf16x8*)(buf + (32 * (cb) + r) * 144 + (16 * ks + 8 * hh) * 2); \
            _Pragma("unroll") for (int p = 0; p < 2; ++p) { _Pragma("unroll") for (int i = 0; i < 16; ++i) accC[p][i] = 0.f; \
                _Pragma("unroll") for (int ks = 0; ks < 4; ++ks) accC[p] = __builtin_amdgcn_mfma_f32_32x32x16_bf16(Af[p][ks], Bf[ks], accC[p], 0, 0, 0); } } while (0)
#define SC_RED(acc, cb) do { _Pragma("unroll") for (int p = 0; p < 2; ++p) { f32x2 s0 = {0.f, 0.f}, s1 = {0.f, 0.f}; \
            _Pragma("unroll") for (int reg = 0; reg < 8; reg += 2) { const f32x2 r0 = {relu_i(acc[p][reg]), relu_i(acc[p][reg + 1])}; const f32x2 r1 = {relu_i(acc[p][reg + 8]), relu_i(acc[p][reg + 9])}; \
                s0 = __builtin_elementwise_fma(wv2[p][reg >> 1], r0, s0); s1 = __builtin_elementwise_fma(wv2[p][4 + (reg >> 1)], r1, s1); } \
            const float p0 = s0[0] + s0[1], p1 = s1[0] + s1[1]; \
            const u32x2 sw = __builtin_amdgcn_permlane32_swap(__float_as_uint(p0), __float_as_uint(p1), false, false); \
            sb[(4 * wave + 2 * p + qsel) * SC_SPITCH + 32 * (cb) + r] = __uint_as_float(sw[0]) + __uint_as_float(sw[1]); } } while (0)
#define SC_INTERLEAVE() do { _Pragma("unroll") for (int i = 0; i < 8; ++i) { __builtin_amdgcn_sched_group_barrier(0x008, 1, 0); __builtin_amdgcn_sched_group_barrier(0x002, 8, 0); } } while (0)
        SC_MFMA(0);
        accP[0] = accC[0]; accP[1] = accC[1]; SC_MFMA(1); SC_RED(accP, 0); SC_INTERLEAVE();
        accP[0] = accC[0]; accP[1] = accC[1]; SC_MFMA(2); SC_RED(accP, 1); SC_INTERLEAVE();
        accP[0] = accC[0]; accP[1] = accC[1]; SC_MFMA(3); SC_RED(accP, 2); SC_INTERLEAVE();
        SC_RED(accC, 3);
#undef SC_MFMA
#undef SC_RED
#undef SC_INTERLEAVE
        }
        if (kt + 1 < nkt) {
#pragma unroll
            for (int i = 0; i < 2; ++i) { const int q = tid + 512 * i; *(LAS u32x4*)(lds + SC_KT + ((kt + 1) & 1) * 18432 + (q >> 3) * 144 + (q & 7) * 16) = stg[i]; }
        }
        __syncthreads();
    }
    score_flush(lds, SCORES, t0, nkt - 1, tid);
    __syncthreads();
}

__device__ __forceinline__ float wave_kth16(const float (&v)[16], int K) {
    const float NINF = -__builtin_inff();
    float mx = NINF, mn = __builtin_inff();
#pragma unroll
    for (int j = 0; j < 16; ++j) { mx = fmaxf(mx, v[j]); mn = fminf(mn, v[j] == NINF ? __builtin_inff() : v[j]); }
    mx = wave_max(mx); mn = -wave_max(-mn);
    int c = 0;
#pragma unroll
    for (int j = 0; j < 16; ++j) c += __popcll(__ballot(v[j] >= mx));
    if (c >= K) return mx;
    float lo = mn, hi = mx, tau = mn;
    for (int it = 0; it < 64; ++it) {
        const float mid = 0.5f * (lo + hi);
        if (!(mid > lo && mid < hi)) { tau = lo; break; }
        c = 0;
#pragma unroll
        for (int j = 0; j < 16; ++j) c += __popcll(__ballot(v[j] >= mid));
        if (c == K) { tau = mid; break; }
        if (c > K) lo = mid; else hi = mid;
        tau = lo;
    }
    return tau;
}
__device__ __forceinline__ int lanes_below(unsigned long long mask) { return (int)__builtin_amdgcn_mbcnt_hi((unsigned)(mask >> 32), __builtin_amdgcn_mbcnt_lo((unsigned)mask, 0u)); }
__device__ __forceinline__ float h2f(unsigned short h) { return (float)__builtin_bit_cast(_Float16, h); }
__device__ __forceinline__ float h2f_lo(unsigned u) { return h2f((unsigned short)(u & 0xffffu)); }
__device__ __forceinline__ float h2f_hi(unsigned u) { return h2f((unsigned short)(u >> 16)); }
__device__ __forceinline__ void select_row(LAS unsigned char* wl, const unsigned short* SCORES, int t, int lane) {
    LAS int* selw = (LAS int*)wl; LAS float* cval = (LAS float*)(wl + 1024); LAS int* cidx = (LAS int*)(wl + 5120);
    const float NINF = -__builtin_inff();
    const unsigned short* row = SCORES + (size_t)t * S; const int n = t + 1;
    float c[16]; int N;
    if (n <= 1024) {
#pragma unroll
        for (int j = 0; j < 16; ++j) { const int i = lane + 64 * j; c[j] = i < n ? h2f(row[i]) : NINF; }
        N = -1;
    } else {
        const int m = n >> 4; float s[16];
#pragma unroll
        for (int j = 0; j < 16; ++j) { const int i = lane + 64 * j; s[j] = i < m ? h2f(row[16 * i + 7]) : NINF; }
        int K = 32, cnt = 0;
        for (;;) {
            const float tlo = (K >= m) ? NINF : wave_kth16(s, K);
            cnt = 0;
            const int nq = (n + 511) >> 9;
            if (tlo > 0.f) {
                const unsigned T16 = pk_f16(tlo, tlo);
                for (int q0 = 0; q0 < nq; q0 += 4) {
                    u32x4 v[4];
#pragma unroll
                    for (int u = 0; u < 4; ++u) { const int e = 8 * (lane + 64 * (q0 + u)); v[u] = (e <= t) ? *(const u32x4*)(row + e) : (u32x4){0xfc00fc00u, 0xfc00fc00u, 0xfc00fc00u, 0xfc00fc00u}; }
#pragma unroll
                    for (int u = 0; u < 4; ++u) { const int e = 8 * (lane + 64 * (q0 + u));
                        unsigned m8 = 0;
#pragma unroll
                        for (int w = 0; w < 4; ++w) { const unsigned vw_ = v[u][w];
                            const s16x2 d = __builtin_elementwise_sub_sat(__builtin_bit_cast(s16x2, vw_), __builtin_bit_cast(s16x2, T16));
                            const unsigned mm = ~__builtin_bit_cast(unsigned, d); m8 |= (((mm >> 15) & 1u) | ((mm >> 30) & 2u)) << (2 * w); }
                        const int nv = t + 1 - e; if (nv < 8) m8 &= nv > 0 ? ((1u << nv) - 1u) : 0u;
                        for (;;) { const bool has = m8 != 0u; const unsigned long long mask = __ballot(has); if (!mask) break;
                            const int pos = cnt + lanes_below(mask);
                            if (has) { const int k = __builtin_ctz(m8); m8 &= m8 - 1u; if (pos < 1024) cidx[pos] = e + k; }
                            cnt += __popcll(mask); } }
                }
            } else {
                for (int q0 = 0; q0 < nq; q0 += 4) {
                    u32x4 v[4];
#pragma unroll
                    for (int u = 0; u < 4; ++u) { const int e = 8 * (lane + 64 * (q0 + u)); v[u] = (e <= t) ? *(const u32x4*)(row + e) : (u32x4){0xfc00fc00u, 0xfc00fc00u, 0xfc00fc00u, 0xfc00fc00u}; }
#pragma unroll
                    for (int u = 0; u < 4; ++u) { const int e = 8 * (lane + 64 * (q0 + u));
#pragma unroll
                        for (int k = 0; k < 8; ++k) { const float x = (k & 1) ? h2f_hi(v[u][k >> 1]) : h2f_lo(v[u][k >> 1]);
                            const bool pred = (e + k <= t) && (x >= tlo); const unsigned long long mask = __ballot(pred);
                            if (mask) { const int pos = cnt + lanes_below(mask); if (pred && pos < 1024) cidx[pos] = e + k; cnt += __popcll(mask); } } }
                }
            }
            if (cnt >= 256 || K >= m) break;
            K *= 2;
        }
        N = cnt < 1024 ? cnt : 1024;
#pragma unroll
        for (int j = 0; j < 16; ++j) { const int i = lane + 64 * j; c[j] = i < N ? h2f(row[cidx[i]]) : NINF; }
    }
    const float tau = wave_kth16(c, 256);
    int base = 0;
#pragma unroll
    for (int j = 0; j < 16; ++j) { const bool pred = c[j] >= tau; const unsigned long long mask = __ballot(pred);
        if (mask) { const int pos = base + lanes_below(mask); if (pred && pos < 256) selw[pos] = (N < 0) ? (lane + 64 * j) : cidx[lane + 64 * j]; base += __popcll(mask); } }
}

__device__ __forceinline__ void attn_query(LAS unsigned char* wl, const bf16_t* PROJ, const bf16_t* KC, const bf16_t* VC, bf16_t* ATT, int t, int lane) {
    LAS int* selw = (LAS int*)wl; LAS float* L = (LAS float*)(wl + 1024);
    const int nsel = t < 255 ? t + 1 : 256;
    const int fr = lane & 15, fq = lane >> 4;
    bf16x8 qf[2][4];
#pragma unroll
    for (int g = 0; g < 2; ++g)
#pragma unroll
        for (int ks = 0; ks < 4; ++ks) { const bf16x8 z = {0, 0, 0, 0, 0, 0, 0, 0}; qf[g][ks] = fr < 4 ? *(const bf16x8*)(PROJ + (size_t)t * DINP + CQ + (4 * g + fr) * 128 + 64 * (ks >> 1) + 16 * fq + 8 * (ks & 1)) : z; }
    const float scale = 0.08838834764831845f;
    const int nkt = (nsel + 15) >> 4;
    {
        LAS unsigned char* KT = wl + 9216;
        const int half_ = lane >> 5, l31_ = lane & 31;
        u32x4 kw[3][8];
#define QK_LOAD(buf, kt) do { _Pragma("unroll") for (int u = 0; u < 8; ++u) { const unsigned off_ = (unsigned)selw[16 * (kt) + 2 * u + half_] * 512u + 16u * (unsigned)l31_; kw[buf][u] = *(const u32x4*)((const char*)KC + off_); } } while (0)
#define QK_COMP(buf, kt) do { _Pragma("unroll") for (int u = 0; u < 8; ++u) *(LAS u32x4*)(KT + (2 * u + half_) * 528 + 16 * l31_) = kw[buf][u]; \
        _Pragma("unroll") for (int g = 0; g < 2; ++g) { f32x4 acc = (f32x4){0.f, 0.f, 0.f, 0.f}; \
            _Pragma("unroll") for (int ks = 0; ks < 4; ++ks) { const bf16x8 kf_ = *(const LAS bf16x8*)(KT + fr * 528 + g * 256 + (64 * (ks >> 1) + 16 * fq + 8 * (ks & 1)) * 2); \
                acc = __builtin_amdgcn_mfma_f32_16x16x32_bf16(qf[g][ks], kf_, acc, 0, 0, 0); } \
            if (fq == 0) { _Pragma("unroll") for (int r = 0; r < 4; ++r) L[(4 * g + r) * 256 + 16 * (kt) + fr] = (16 * (kt) + fr < nsel) ? acc[r] * scale : -__builtin_inff(); } } } while (0)
        QK_LOAD(0, 0); if (1 < nkt) QK_LOAD(1, 1);
        for (int kt = 0; kt < nkt; kt += 3) {
            if (kt + 2 < nkt) QK_LOAD(2, kt + 2);
            __builtin_amdgcn_sched_barrier(0);
            QK_COMP(0, kt);
            if (kt + 1 < nkt) { if (kt + 3 < nkt) QK_LOAD(0, kt + 3); __builtin_amdgcn_sched_barrier(0); QK_COMP(1, kt + 1); }
            if (kt + 2 < nkt) { if (kt + 4 < nkt) QK_LOAD(1, kt + 4); __builtin_amdgcn_sched_barrier(0); QK_COMP(2, kt + 2); }
        }
#undef QK_LOAD
#undef QK_COMP
        if (fq == 0) { for (int kt = nkt; kt < 16; ++kt) {
#pragma unroll
            for (int r = 0; r < 8; ++r) L[r * 256 + 16 * kt + fr] = -__builtin_inff(); } }
    }
    float p[8][4];
#pragma unroll
    for (int hd = 0; hd < 8; ++hd) { float m = -__builtin_inff();
#pragma unroll
        for (int i = 0; i < 4; ++i) { p[hd][i] = L[hd * 256 + lane + 64 * i]; m = fmaxf(m, p[hd][i]); }
        m = wave_max(m); float s = 0.f;
#pragma unroll
        for (int i = 0; i < 4; ++i) { p[hd][i] = __expf(p[hd][i] - m); s += p[hd][i]; }
        s = 1.0f / wave_sum(s);
#pragma unroll
        for (int i = 0; i < 4; ++i) p[hd][i] *= s; }
    LAS bf16_t* Pb = (LAS bf16_t*)(wl + 1024);
#pragma unroll
    for (int hd = 0; hd < 8; ++hd)
#pragma unroll
        for (int i = 0; i < 4; ++i) Pb[hd * 256 + lane + 64 * i] = f2bf(p[hd][i]);
    LAS unsigned char* VT = wl + 9216;
    const int half = lane >> 5, l31 = lane & 31, ii = lane & 15, kq = lane >> 4;
    f32x4 acc[16];
#pragma unroll
    for (int nt = 0; nt < 16; ++nt) acc[nt] = (f32x4){0.f, 0.f, 0.f, 0.f};
    const int nch = (nsel + 15) >> 4;
    u32x4 vw[3][8];
#define PV_LOAD(buf, c) do { _Pragma("unroll") for (int u = 0; u < 8; ++u) { const unsigned off_ = (unsigned)selw[16 * (c) + 2 * u + half] * 512u + 16u * (unsigned)l31; vw[buf][u] = *(const u32x4*)((const char*)VC + off_); } } while (0)
#define PV_COMP(buf, c) do { _Pragma("unroll") for (int u = 0; u < 8; ++u) *(LAS u32x4*)(VT + (2 * u + half) * 528 + 16 * l31) = vw[buf][u]; \
        s16x4 pa[2]; _Pragma("unroll") for (int g = 0; g < 2; ++g) { const s16x4 r_ = *(const LAS s16x4*)(Pb + (g * 4 + (ii & 3)) * 256 + 16 * (c) + 4 * kq); pa[g] = ii < 4 ? r_ : (s16x4){0, 0, 0, 0}; } \
        _Pragma("unroll") for (int nt = 0; nt < 16; ++nt) { const s16x4 b_ = __builtin_amdgcn_ds_read_tr16_b64_v4i16((LAS s16x4*)(VT + (4 * kq + (ii >> 2)) * 528 + (16 * nt + 4 * (ii & 3)) * 2)); \
            acc[nt] = __builtin_amdgcn_mfma_f32_16x16x16bf16_1k(pa[nt >> 3], b_, acc[nt], 0, 0, 0); } } while (0)
    PV_LOAD(0, 0); if (1 < nch) PV_LOAD(1, 1);
    for (int c = 0; c < nch; c += 3) {
        if (c + 2 < nch) PV_LOAD(2, c + 2);
        __builtin_amdgcn_sched_barrier(0);
        PV_COMP(0, c);
        if (c + 1 < nch) { if (c + 3 < nch) PV_LOAD(0, c + 3); __builtin_amdgcn_sched_barrier(0); PV_COMP(1, c + 1); }
        if (c + 2 < nch) { if (c + 4 < nch) PV_LOAD(1, c + 4); __builtin_amdgcn_sched_barrier(0); PV_COMP(2, c + 2); }
    }
#undef PV_LOAD
#undef PV_COMP
    LAS float* OB = (LAS float*)(wl + 1024 + 4096);
    if (kq == 0) {
#pragma unroll
        for (int nt = 0; nt < 16; ++nt)
#pragma unroll
            for (int r = 0; r < 4; ++r) OB[(4 * (nt >> 3) + r) * 128 + 16 * (nt & 7) + ii] = acc[nt][r];
    }
    {
        const f32x4 a0 = *(const LAS f32x4*)(OB + 16 * lane), a1 = *(const LAS f32x4*)(OB + 16 * lane + 4), a2 = *(const LAS f32x4*)(OB + 16 * lane + 8), a3 = *(const LAS f32x4*)(OB + 16 * lane + 12);
        u32x4 w0, w1; w0.x = cvt_pk_bf16(a0[0], a0[1]); w0.y = cvt_pk_bf16(a0[2], a0[3]); w0.z = cvt_pk_bf16(a1[0], a1[1]); w0.w = cvt_pk_bf16(a1[2], a1[3]);
        w1.x = cvt_pk_bf16(a2[0], a2[1]); w1.y = cvt_pk_bf16(a2[2], a2[3]); w1.z = cvt_pk_bf16(a3[0], a3[1]); w1.w = cvt_pk_bf16(a3[2], a3[3]);
        u32x4* dst = (u32x4*)(ATT + (size_t)t * 1024 + 16 * lane); dst[0] = w0; dst[1] = w1;
    }
}


__device__ __forceinline__ void convert_item8(const float* __restrict__ W, int K, int N, unsigned char* WT, int mode, int item, int lane, LAS unsigned char* scr) {
    const int nblk = N >> 6; const int kb = item / nblk, nb = item - kb * nblk; const int k0 = kb * 256, n0 = nb * 64;
    const int c4 = lane & 15, kr = lane >> 4;
    const float* src = W + (size_t)(k0 + 4 * kr) * N + n0 + 4 * c4;
#pragma unroll 4
    for (int i = 0; i < 16; ++i) {
        f32x4 v[4];
#pragma unroll
        for (int r = 0; r < 4; ++r) v[r] = __builtin_nontemporal_load((const f32x4*)(src + (size_t)(16 * i + r) * N));
        const int kk = 16 * i + 4 * kr;
#pragma unroll
        for (int e = 0; e < 4; ++e) *(LAS unsigned*)(scr + (4 * c4 + e) * 272 + kk) = pack4_fp8(v[0][e] * W8_SCALE, v[1][e] * W8_SCALE, v[2][e] * W8_SCALE, v[3][e] * W8_SCALE);
    }
    LDS_WAIT(); asm volatile("" ::: "memory");
#pragma unroll 4
    for (int j = 0; j < 16; ++j) {
        const int q = j * 64 + lane, n = q >> 4, ch = q & 15;
        const u32x4 v = *(const LAS u32x4*)(scr + n * 272 + ch * 16);
        *(u32x4*)(WT + (size_t)dest_row(mode, n0 + n) * K + k0 + ch * 16) = v;
    }
    LDS_WAIT(); asm volatile("" ::: "memory");
}

__global__ void __launch_bounds__(NTHR, 2) fwd_kernel(Args args) {
    extern __shared__ __attribute__((aligned(16))) unsigned char lds_raw[];
    LAS unsigned char* lds = (LAS unsigned char*)lds_raw;
    volatile LAS unsigned* MISC = (volatile LAS unsigned*)(lds + LDS_MISC);
    const int tid = threadIdx.x, lane = tid & 63, wave = __builtin_amdgcn_readfirstlane(tid >> 6);
    const int G = gridDim.x, wg = blockIdx.x;
    unsigned char* ws = args.ws;
    unsigned* ctl = (unsigned*)(ws + WS_CTL);
    const int lo = args.ph_lo, hi = args.ph_hi, flags = args.flags;
    const float* x = (const float*)args.in[0]; const float* cvec = (const float*)args.in[1]; const int* positions = (const int*)args.in[2];
    const float* w_ada = (const float*)args.in[3]; const float* b_ada = (const float*)args.in[4]; const float* norm1_g = (const float*)args.in[5];
    const float* w_in = (const float*)args.in[6]; const float* idx_knorm_g = (const float*)args.in[7]; const float* idx_knorm_b = (const float*)args.in[8];
    const float* lb_logits = (const float*)args.in[9]; const float* hgrn_norm_g = (const float*)args.in[10];
    const float* w_proj_att = (const float*)args.in[11]; const float* w_proj_hgrn = (const float*)args.in[12]; const float* w_out = (const float*)args.in[13];
    const float* norm2_g = (const float*)args.in[14]; const float* w_router = (const float*)args.in[15]; const float* b_router = (const float*)args.in[16];
    const float* w1 = (const float*)args.in[17]; const float* b1 = (const float*)args.in[18]; const float* w2 = (const float*)args.in[19]; const float* b2 = (const float*)args.in[20];
    const float* final_g = (const float*)args.in[21];
    float* out = args.out;
    float* MOD = (float*)(ws + WS_MOD); int* TOPE = (int*)(ws + WS_TOPE); float* GATE = (float*)(ws + WS_GATE); int* SLOT = (int*)(ws + WS_SLOT);
    bf16_t* WIN_T = (bf16_t*)(ws + WS_WIN_T); bf16_t* WA_T = (bf16_t*)(ws + WS_WA_T); bf16_t* WH_T = (bf16_t*)(ws + WS_WH_T); bf16_t* WO_T = (bf16_t*)(ws + WS_WO_T);
    unsigned char* W1_T = ws + WS_W1_T; unsigned char* W2_T = ws + WS_W2_T;
    bf16_t* HB = (bf16_t*)(ws + WS_H); bf16_t* PROJ = (bf16_t*)(ws + WS_PROJ);
    float* X1 = (float*)(ws + WS_X1);
    unsigned char* XB = ws + WS_XB; unsigned char* ACT = ws + WS_ACT; bf16_t* YB = (bf16_t*)(ws + WS_YB);
    int* TOKS = (int*)(ws + WS_TOKS);
    unsigned char* H8 = ws + WS_H;
    bf16_t* KI = (bf16_t*)(ws + WS_KI); bf16_t* KC = (bf16_t*)(ws + WS_KC); bf16_t* VC = (bf16_t*)(ws + WS_VC);
    float* ST = (float*)(ws + WS_ST); float* DC = (float*)(ws + WS_DC); int* SEL = (int*)(ws + WS_SEL);
    bf16_t* ATT = (bf16_t*)(ws + WS_ATT); bf16_t* REC = (bf16_t*)(ws + WS_REC); bf16_t* MERGED = (bf16_t*)(ws + WS_MERGED); unsigned short* SCORES = (unsigned short*)(ws + WS_SCORES);

    for (int u = tid; u < 128; u += NTHR) MISC[u] = 0u;
    __syncthreads();
    const bool one_launch = (hi - lo) > 1;
    XcdBarrier bar; bar.bar = ctl + CW_BAR; bar.x = 0; bar.st = MISC + 8;
    if (one_launch) bar = xcd_barrier_post(ctl + CW_BAR, MISC + 8);
#define IN(k) (lo <= (k) && (k) < hi)
#define NREP(k) ((((MK_REP) >> (k)) & 1) + 1)
#define SEAM(k) do { if (IN(k) && IN((k) + 1)) xcd_barrier(bar); } while (0)

    const float* x1src = (flags & FLAG_MIXER) ? (const float*)X1 : x;

    if (IN(PH_PRO)) {
        for (int cb = wg; cb < 256; cb += G) {
            LAS float* red = (LAS float*)lds;
            const int c4 = tid % 12, kg = tid / 12;
            f32x4 acc = (f32x4){0.f, 0.f, 0.f, 0.f};
            if (kg < 42) {
                const float* wp = w_ada + (size_t)cb * 48 + 4 * c4;
#pragma unroll 7
                for (int j = 0; j < 49; ++j) { const int k = kg + 42 * j; if (k < D) { const f32x4 v = __builtin_nontemporal_load((const f32x4*)(wp + (size_t)k * (6 * D))); acc += siluf_(cvec[k]) * v; } }
                *(LAS f32x4*)(red + kg * 48 + 4 * c4) = acc;
            }
            __syncthreads();
            if (tid < 48) { float s = b_ada[cb * 48 + tid];
#pragma unroll 6
                for (int q = 0; q < 42; ++q) s += red[q * 48 + tid];
                MOD[cb * 48 + tid] = s; }
            __syncthreads();
        }
        LAS unsigned char* scr = lds + wave * 17408;
        const int gw = wg * NWAVES + wave, NGW = G * NWAVES;
        for (int rep = 0; rep < NREP(PH_PRO); ++rep) {
        if (flags & FLAG_MIXER) {
            constexpr int NB_IN = (DIN + 63) / 64;
            for (int it = gw; it < 16 * NB_IN; it += NGW) convert_item(w_in, 2048, DIN, WIN_T, 1, it, lane, scr);
            for (int it = gw; it < 8 * 32; it += NGW) convert_item(w_proj_att, 1024, 2048, WA_T, 0, it, lane, scr);
            for (int it = gw; it < 8 * 32; it += NGW) convert_item(w_proj_hgrn, 1024, 2048, WH_T, 0, it, lane, scr);
            for (int it = gw; it < 16 * 32; it += NGW) convert_item(w_out, 2048, 2048, WO_T, 0, it, lane, scr);
            for (size_t i = (size_t)wg * NTHR + tid; i < (size_t)176 * 2048 * 2 / 16; i += (size_t)G * NTHR) ((u32x4*)(WIN_T + (size_t)2640 * 2048))[i] = (u32x4){0u, 0u, 0u, 0u};
        }
        if (flags & FLAG_MOE) {
            constexpr int I1 = (2048 / 256) * (4096 / 64), I2 = (2048 / 256) * (2048 / 64);
            for (int it = gw; it < NEXP * I1; it += NGW) { const int e = it / I1, r = it - e * I1; convert_item8(w1 + (size_t)e * 2048 * 4096, 2048, 4096, W1_T + (size_t)e * 4096 * 2048, 2, r, lane, scr); }
            for (int it = gw; it < NEXP * I2; it += NGW) { const int e = it / I2, r = it - e * I2; convert_item8(w2 + (size_t)e * 2048 * 2048, 2048, 2048, W2_T + (size_t)e * 2048 * 2048, 0, r, lane, scr); }
        }
        }
    }
    SEAM(PH_PRO);

    if (flags & FLAG_MIXER) {
    if (IN(PH_H)) {
        const float* sh1 = MOD; const float* sc1 = MOD + D;
        const int gw = wg * NWAVES + wave, NGW = G * NWAVES;
        f32x4 gs[8], sh[8];
#pragma unroll
        for (int j = 0; j < 8; ++j) { const int c = 4 * lane + 256 * j; const f32x4 g = *(const f32x4*)(norm1_g + c), sc = *(const f32x4*)(sc1 + c); sh[j] = *(const f32x4*)(sh1 + c);
#pragma unroll
            for (int e = 0; e < 4; ++e) gs[j][e] = g[e] * (1.0f + sc[e]); }
        for (int rep = 0; rep < NREP(PH_H); ++rep)
        for (int t = gw; t < S; t += NGW) {
            const f32x4* xr = (const f32x4*)(x + (size_t)t * D) + lane;
            f32x4 v[8]; float ss = 0.f;
#pragma unroll
            for (int j = 0; j < 8; ++j) { v[j] = xr[64 * j]; ss += (v[j][0] * v[j][0] + v[j][1] * v[j][1]) + (v[j][2] * v[j][2] + v[j][3] * v[j][3]); }
            const float rstd = rsqrtf(wave_sum(ss) * (1.0f / D) + NORM_EPS);
#pragma unroll
            for (int j = 0; j < 8; ++j) { const f32x4 h = v[j] * rstd * gs[j] + sh[j]; u32x2 w; w.x = cvt_pk_bf16(h[0], h[1]); w.y = cvt_pk_bf16(h[2], h[3]);
                *(u32x2*)(HB + (size_t)t * D + 4 * lane + 256 * j) = w; }
        }
    }
    SEAM(PH_H);
    if (IN(PH_INPROJ)) for (int rep = 0; rep < NREP(PH_INPROJ); ++rep) {
        pg8::Gemm g{HB, WIN_T, 2048, 0, nullptr}; pg8::StaticOrder So; So.init(S, DINP, G, wg);
        pg8::EpiBf16 E{PROJ, DINP, nullptr, 0, 1.0f};
        pg8::gemm_phase<pg8::EpiBf16, pg8::StaticOrder>(lds, g, So, E);
    }
    SEAM(PH_INPROJ);
    if (IN(PH_POST)) {
        const int gw = wg * NWAVES + wave, NGW = G * NWAVES;
        for (int t = gw; t < S; t += NGW) post_token(PROJ, KI, KC, VC, positions, idx_knorm_g, idx_knorm_b, t, lane);
        __syncthreads();
        for (int rep = 0; rep < NREP(PH_POST); ++rep)
        for (int u = wg; u < 2048; u += G) hgrn_l1(lds, PROJ, lb_logits, ST, DC, u >> 3, u & 7, tid, wave, lane);
    }
    SEAM(PH_POST);
    if (IN(PH_SCORE)) {
        for (int idx = wg * NTHR + tid; idx < 8 * 128 * 128; idx += G * NTHR) {
            const int h = idx >> 14, d = idx & 127; float s = 0.f;
            float* sp = ST + idx; const float* dp = DC + h * 128 + d;
            for (int c = 0; c < 256; c += 8) {
                float l[8], dc[8];
#pragma unroll
                for (int i = 0; i < 8; ++i) { l[i] = sp[(size_t)(c + i) * 131072]; dc[i] = dp[(size_t)(c + i) * 1024]; }
#pragma unroll
                for (int i = 0; i < 8; ++i) { sp[(size_t)(c + i) * 131072] = s; s = dc[i] * s + l[i]; }
            }
        }
        if (flags & FLAG_ATT) for (int rep = 0; rep < NREP(PH_SCORE); ++rep) {
            for (int j = wg; j < 252; j += G) { score_block(lds, PROJ, KI, SCORES, 8 + j, tid, wave, lane); score_block(lds, PROJ, KI, SCORES, 511 - j, tid, wave, lane); }
        }
    }
    SEAM(PH_SCORE);
    if (IN(PH_ATTN)) {
        const int gw = wg * NWAVES + wave, NGW = G * NWAVES;
        for (int rep = 0; rep < NREP(PH_SELECT); ++rep)
        for (int u = wg; u < 2048; u += G) hgrn_l3(lds, PROJ, lb_logits, ST, hgrn_norm_g, REC, u >> 3, u & 7, tid, wave, lane);
        if (flags & FLAG_ATT) for (int rep = 0; rep < NREP(PH_ATTN); ++rep) {
            for (int t = gw; t < S; t += NGW) {
                LAS unsigned char* wl = lds + wave * 17664;
                if (t >= 256) { for (int rep2 = 0; rep2 < (((MK_REP2) >> 1) & 1) + 1; ++rep2) select_row(wl, SCORES, t, lane); }
                else {
#pragma unroll
                    for (int i = 0; i < 4; ++i) { const int idx = lane + 64 * i; ((LAS int*)wl)[idx] = idx <= t ? idx : 0; }
                }
                for (int rep2 = 0; rep2 < (((MK_REP2) >> 2) & 1) + 1; ++rep2) attn_query(wl, PROJ, KC, VC, ATT, t, lane);
            }
        } else {
            for (size_t i = (size_t)wg * NTHR + tid; i < (size_t)S * 1024 * 2 / 16; i += (size_t)G * NTHR) ((u32x4*)ATT)[i] = (u32x4){0u, 0u, 0u, 0u};
        }
    }
    SEAM(PH_ATTN);
    if (IN(PH_OP1)) {
        pg8::Gemm g{ATT, WA_T, 1024, 0, nullptr}; pg8::StaticOrder So; So.init(S, 2048, G, wg);
        pg8::EpiGate E{MERGED, PROJ + CGA, 0};
        pg8::gemm_phase<pg8::EpiGate, pg8::StaticOrder>(lds, g, So, E);
    }
    if (IN(PH_OP1) && IN(PH_OP2)) { VM_WAIT(); __syncthreads(); }
    if (IN(PH_OP2)) {
        pg8::Gemm g{REC, WH_T, 1024, 0, nullptr}; pg8::StaticOrder So; So.init(S, 2048, G, wg);
        pg8::EpiGate E{MERGED, PROJ + CGR, 1};
        pg8::gemm_phase<pg8::EpiGate, pg8::StaticOrder>(lds, g, So, E);
    }
    SEAM(PH_OP2);
    if (IN(PH_WOUT)) {
        pg8::Gemm g{MERGED, WO_T, 2048, 0, nullptr}; pg8::StaticOrder So; So.init(S, 2048, G, wg);
        pg8::EpiResid E{x, MOD + 2 * D, X1};
        pg8::gemm_phase<pg8::EpiResid, pg8::StaticOrder>(lds, g, So, E);
    }
    SEAM(PH_WOUT);
    }

    if (IN(PH_ROUTER) && (flags & FLAG_MOE)) {
        LAS float* hs = (LAS float*)lds;
        volatile LAS unsigned* lcnt = MISC + 32;
        const float* sh2 = MOD + 3 * D; const float* sc2 = MOD + 4 * D;
        if (tid < 32) lcnt[tid] = 0u;
        __syncthreads();
        for (int grp = wg; grp < S / 16; grp += G) {
#pragma unroll 1
            for (int q = 0; q < 2; ++q) {
                const int tl = 2 * wave + q, t = grp * 16 + tl;
                const f32x4* xr = (const f32x4*)(x1src + (size_t)t * D) + lane;
                f32x4 v[8]; float ss = 0.f;
#pragma unroll
                for (int j = 0; j < 8; ++j) { v[j] = xr[64 * j]; ss += (v[j][0] * v[j][0] + v[j][1] * v[j][1]) + (v[j][2] * v[j][2] + v[j][3] * v[j][3]); }
                const float rstd = rsqrtf(wave_sum(ss) * (1.0f / D) + NORM_EPS);
#pragma unroll
                for (int j = 0; j < 8; ++j) {
                    const int c = 4 * lane + 256 * j;
                    const f32x4 g = *(const f32x4*)(norm2_g + c), sc = *(const f32x4*)(sc2 + c), sh = *(const f32x4*)(sh2 + c);
                    f32x4 h;
#pragma unroll
                    for (int e = 0; e < 4; ++e) h[e] = v[j][e] * rstd * g[e] * (1.0f + sc[e]) + sh[e];
                    *(LAS f32x4*)(hs + tl * 2048 + c) = h;
                    *(unsigned*)(H8 + (size_t)t * D + c) = pack4_fp8(h[0], h[1], h[2], h[3]);
                }
            }
            __syncthreads();
            {
                LAS float* part = (LAS float*)(lds + 131072);
                const int fr = lane & 15, fq = lane >> 4;
                f32x4 acc0 = (f32x4){0.f, 0.f, 0.f, 0.f}, acc1 = acc0;
                const LAS float* hrow = hs + fr * 2048 + wave * 256 + 4 * fq; const float* wrp = w_router + (size_t)(wave * 256 + 4 * fq) * 32 + fr;
#pragma unroll 2
                for (int i = 0; i < 16; ++i) {
                    const f32x4 a4 = *(const LAS f32x4*)(hrow + 16 * i);
                    float b0[4], b1[4];
#pragma unroll
                    for (int s = 0; s < 4; ++s) { b0[s] = wrp[(size_t)(16 * i + s) * 32]; b1[s] = wrp[(size_t)(16 * i + s) * 32 + 16]; }
#pragma unroll
                    for (int s = 0; s < 4; ++s) { acc0 = __builtin_amdgcn_mfma_f32_16x16x4f32(a4[s], b0[s], acc0, 0, 0, 0); acc1 = __builtin_amdgcn_mfma_f32_16x16x4f32(a4[s], b1[s], acc1, 0, 0, 0); }
                }
#pragma unroll
                for (int r = 0; r < 4; ++r) { part[(wave * 16 + 4 * fq + r) * 32 + fr] = acc0[r]; part[(wave * 16 + 4 * fq + r) * 32 + 16 + fr] = acc1[r]; }
                __syncthreads();
                const int tl = tid >> 5, e = tid & 31, t = grp * 16 + tl;
                float v = b_router[e];
#pragma unroll
                for (int w = 0; w < 8; ++w) v += part[(w * 16 + tl) * 32 + e];
                float tv[4]; int ti[4];
#pragma unroll
                for (int k = 0; k < 4; ++k) {
                    float bv = v; int bi = e;
#pragma unroll
                    for (int o = 16; o >= 1; o >>= 1) { const float ov = __shfl_xor(bv, o); const int oi = __shfl_xor(bi, o); if (ov > bv || (ov == bv && oi < bi)) { bv = ov; bi = oi; } }
                    tv[k] = bv; ti[k] = bi; if (e == bi) v = -__builtin_inff();
                }
                if (e == 0) {
                    const float e1 = __expf(tv[1] - tv[0]), e2 = __expf(tv[2] - tv[0]), e3 = __expf(tv[3] - tv[0]); const float inv = 1.0f / (1.0f + e1 + e2 + e3);
                    *(int4*)(TOPE + (size_t)t * 4) = make_int4(ti[0], ti[1], ti[2], ti[3]);
                    *(f32x4*)(GATE + (size_t)t * 4) = (f32x4){inv, e1 * inv, e2 * inv, e3 * inv};
#pragma unroll
                    for (int k = 0; k < 4; ++k) __hip_atomic_fetch_add((LAS unsigned*)&lcnt[ti[k]], 1u, __ATOMIC_RELAXED, __HIP_MEMORY_SCOPE_WORKGROUP);
                }
            }
            __syncthreads();
        }
        if (tid < 32) { const unsigned c = lcnt[tid]; if (c) __hip_atomic_fetch_add(ctl + CW_CNT + tid, c, __ATOMIC_RELAXED, __HIP_MEMORY_SCOPE_AGENT); }
    }
    SEAM(PH_ROUTER);

    if (IN(PH_SCATTER) && (flags & FLAG_MOE)) {
        volatile LAS unsigned* lcnt = MISC + 32; volatile LAS unsigned* lbase = MISC + 64; LAS int* pstart = (LAS int*)(lds + 1024); LAS int* pcnt = (LAS int*)(lds + 1280);
        if (tid == 0) { int p = 0; for (int e = 0; e < NEXP; ++e) { const int c = (int)__hip_atomic_load(ctl + CW_CNT + e, __ATOMIC_RELAXED, __HIP_MEMORY_SCOPE_AGENT); pstart[e] = p; pcnt[e] = c; p += (c + 255) & ~255; } }
        if (tid < 32) lcnt[tid] = 0u;
        __syncthreads();
        if (wg < NEXP) { const int e = wg; for (int s = pstart[e] + pcnt[e] + tid; s < pstart[e] + ((pcnt[e] + 255) & ~255); s += NTHR) TOKS[s] = 0; }
        for (int blk = wg; blk < S / 64; blk += G) {
            int e = 0, lrank = 0;
            if (tid < 256) { e = TOPE[(size_t)blk * 256 + tid]; lrank = (int)__hip_atomic_fetch_add((LAS unsigned*)&lcnt[e], 1u, __ATOMIC_RELAXED, __HIP_MEMORY_SCOPE_WORKGROUP); }
            __syncthreads();
            if (tid < 32) { const unsigned c = lcnt[tid]; lbase[tid] = c ? __hip_atomic_fetch_add(ctl + CW_FILL + tid, c, __ATOMIC_RELAXED, __HIP_MEMORY_SCOPE_AGENT) : 0u; }
            __syncthreads();
            if (tid < 256) { const int slot = pstart[e] + (int)lbase[e] + lrank; SLOT[(size_t)blk * 256 + tid] = slot; TOKS[slot] = blk * 64 + (tid >> 2); }
            __syncthreads();
            if (tid < 32) lcnt[tid] = 0u;
            __syncthreads();
        }
    }
    SEAM(PH_SCATTER);

    if ((IN(PH_MOE1) || IN(PH_MOE2)) && (flags & FLAG_MOE)) {
        LAS int* panel_e = (LAS int*)(lds + 131072 + 2048);
        LAS int* npan = (LAS int*)(lds + 131072 + 2048 + 2048);
        __syncthreads();
        if (tid == 0) { int p = 0; for (int e = 0; e < NEXP; ++e) { const int np = (int)((__hip_atomic_load(ctl + CW_CNT + e, __ATOMIC_RELAXED, __HIP_MEMORY_SCOPE_AGENT) + 255u) >> 8); for (int q = 0; q < np; ++q) panel_e[p + q] = e; p += np; } npan[0] = p; }
        __syncthreads();
        const int nPanels = npan[0];
        if (IN(PH_MOE1)) for (int rep = 0; rep < NREP(PH_MOE1); ++rep) {
            pg8::Gemm g{H8, W1_T, 2048, (size_t)4096 * 2048, TOKS}; pg8::MoeOrder So; So.init(nPanels, 16, G, wg, panel_e);
            pg8::EpiSwiglu E{ACT, b1};
            pg8::gemm_phase<pg8::EpiSwiglu, pg8::MoeOrder, true>(lds, g, So, E);
        }
        SEAM(PH_MOE1);
        if (IN(PH_MOE2)) for (int rep = 0; rep < NREP(PH_MOE2); ++rep) {
            pg8::Gemm g{ACT, W2_T, 2048, (size_t)2048 * 2048, nullptr}; pg8::MoeOrder So; So.init(nPanels, 8, G, wg, panel_e);
            pg8::EpiBf16 E{YB, 2048, b2, 2048, 1.0f / (W8_SCALE * ACT8_SCALE)};
            pg8::gemm_phase<pg8::EpiBf16, pg8::MoeOrder, true>(lds, g, So, E);
        }
    }
    SEAM(PH_MOE2);

    if (IN(PH_FINAL)) {
        const float* gt2 = MOD + 5 * D;
        const int gw = wg * NWAVES + wave, NGW = G * NWAVES;
        for (int rep = 0; rep < NREP(PH_FINAL); ++rep)
        for (int t = gw; t < S; t += NGW) {
            const f32x4* xr = (const f32x4*)(x1src + (size_t)t * D) + lane;
            f32x4 v[8];
#pragma unroll
            for (int j = 0; j < 8; ++j) v[j] = xr[64 * j];
            if (flags & FLAG_MOE) {
                f32x4 m[8];
#pragma unroll
                for (int j = 0; j < 8; ++j) m[j] = (f32x4){0.f, 0.f, 0.f, 0.f};
                const int4 sl = *(const int4*)(SLOT + (size_t)t * 4); const f32x4 gt = *(const f32x4*)(GATE + (size_t)t * 4);
                const int sls[4] = {sl.x, sl.y, sl.z, sl.w};
#pragma unroll
                for (int k = 0; k < 4; ++k) {
                    const u32x2* yr = (const u32x2*)(YB + (size_t)sls[k] * D) + lane; const float gk = gt[k];
#pragma unroll
                    for (int j = 0; j < 8; ++j) { const u32x2 w = yr[64 * j]; m[j][0] += gk * bf_lo(w.x); m[j][1] += gk * bf_hi(w.x); m[j][2] += gk * bf_lo(w.y); m[j][3] += gk * bf_hi(w.y); }
                }
#pragma unroll
                for (int j = 0; j < 8; ++j) { const f32x4 g2 = *(const f32x4*)(gt2 + 4 * lane + 256 * j); v[j] = v[j] + g2 * m[j]; }
            }
            float ss = 0.f;
#pragma unroll
            for (int j = 0; j < 8; ++j) ss += (v[j][0] * v[j][0] + v[j][1] * v[j][1]) + (v[j][2] * v[j][2] + v[j][3] * v[j][3]);
            const float rstd = rsqrtf(wave_sum(ss) * (1.0f / D) + NORM_EPS);
            f32x4* orow = (f32x4*)(out + (size_t)t * D) + lane;
#pragma unroll
            for (int j = 0; j < 8; ++j) { const f32x4 fg = *(const f32x4*)(final_g + 4 * lane + 256 * j); orow[64 * j] = v[j] * rstd * fg; }
        }
    }
#undef IN
#undef SEAM
}

#ifndef MK_ONE_LAUNCH
#define MK_ONE_LAUNCH 1
#endif
#ifndef MK_FLAGS
#define MK_FLAGS (FLAG_MOE | FLAG_MIXER | FLAG_ATT)
#endif
extern "C" void kernel_launch(void* const* d_in, const int* in_sizes, int n_in, void* d_out, int out_size, void* d_ws, size_t ws_size, hipStream_t stream) {
    static int grid = 0;
    if (grid == 0) {
        if (n_in != 22 || out_size != S * D || ws_size < WS_END) { fprintf(stderr, "kernel_launch: unexpected shapes: n_in %d out %d ws %zu (need %zu)\n", n_in, out_size, ws_size, (size_t)WS_END); grid = -1; return; }
        int dev = 0, cus = 0, per_cu = 0;
        if (hipGetDevice(&dev) != hipSuccess || hipDeviceGetAttribute(&cus, hipDeviceAttributeMultiprocessorCount, dev) != hipSuccess) { grid = -1; return; }
        if (hipFuncSetAttribute((const void*)fwd_kernel, hipFuncAttributeMaxDynamicSharedMemorySize, LDS_BYTES) != hipSuccess) { fprintf(stderr, "kernel_launch: hipFuncSetAttribute failed\n"); grid = -1; return; }
        if (hipOccupancyMaxActiveBlocksPerMultiprocessor(&per_cu, (const void*)fwd_kernel, NTHR, LDS_BYTES) != hipSuccess || per_cu < 1) { fprintf(stderr, "kernel_launch: occupancy query says %d\n", per_cu); (void)hipGetLastError(); grid = -1; return; }
        grid = cus;
    }
    if (grid < 0) return;
    (void)in_sizes;
    hipMemsetAsync((char*)d_ws + WS_CTL, 0, CTL_BYTES, stream);
    Args a{};
    for (int i = 0; i < 22; ++i) a.in[i] = d_in[i];
    a.out = (float*)d_out; a.ws = (unsigned char*)d_ws; a.flags = MK_FLAGS; a.pad = 0;
#if MK_ONE_LAUNCH
    a.ph_lo = 0; a.ph_hi = NPH;
    hipLaunchKernelGGL(fwd_kernel, dim3(grid), dim3(NTHR), LDS_BYTES, stream, a);
#else
    for (int p = 0; p < NPH; ++p) { a.ph_lo = p; a.ph_hi = p + 1; hipLaunchKernelGGL(fwd_kernel, dim3(grid), dim3(NTHR), LDS_BYTES, stream, a); }
#endif
}
```

```cpp
#include <hip/hip_runtime.h>
#include <cstdio>
#include <cstdint>

#define GAS __attribute__((address_space(1)))
#define LAS __attribute__((address_space(3)))
typedef unsigned short bf16_t;
typedef short bf16x8 __attribute__((ext_vector_type(8)));
typedef float f32x4 __attribute__((ext_vector_type(4)));
typedef float f32x2 __attribute__((ext_vector_type(2)));
typedef float f32x16 __attribute__((ext_vector_type(16)));
typedef unsigned u32x4 __attribute__((ext_vector_type(4)));
typedef unsigned u32x2 __attribute__((ext_vector_type(2)));
typedef int i32x4 __attribute__((ext_vector_type(4)));
typedef int i32x8 __attribute__((ext_vector_type(8)));
typedef short s16x4 __attribute__((ext_vector_type(4)));
typedef short s16x2 __attribute__((ext_vector_type(2)));

constexpr int S = 16384, D = 2048, DIN = 10832, DINP = 11008, NEXP = 32, DFF = 2048;
constexpr int NWAVES = 8, NTHR = 512;
constexpr int CQ = 0, CK = 1024, CV = 1280, CQI = 1536, CKI = 2560, CWI = 2624, CHQ = 2816, CHF = 3840, CHI = 4864, CHG = 5888, CGA = 6912, CGR = 8960;
constexpr int PMAX = 65536 + NEXP * 256;
constexpr float NORM_EPS = 1e-5f;

constexpr size_t MiB = 1u << 20;
constexpr size_t al256(size_t x) { return (x + 255) & ~(size_t)255; }
constexpr size_t WS_CTL = 0, CTL_BYTES = 1 * MiB;
constexpr size_t WS_MOD = WS_CTL + CTL_BYTES;
constexpr size_t WS_TOPE = WS_MOD + 64 * 1024;
constexpr size_t WS_GATE = WS_TOPE + (size_t)S * 16;
constexpr size_t WS_SLOT = WS_GATE + (size_t)S * 16;
constexpr size_t WS_WIN_T = WS_SLOT + (size_t)S * 16;
constexpr size_t WS_WA_T = WS_WIN_T + (size_t)DINP * D * 2;
constexpr size_t WS_WH_T = WS_WA_T + (size_t)2048 * 1024 * 2;
constexpr size_t WS_WO_T = WS_WH_T + (size_t)2048 * 1024 * 2;
constexpr size_t WS_W1_T = WS_WO_T + (size_t)2048 * 2048 * 2;
constexpr size_t WS_W2_T = WS_W1_T + (size_t)NEXP * 4096 * 2048 * 2;
constexpr size_t WS_H = WS_W2_T + (size_t)NEXP * 2048 * 2048 * 2;
constexpr size_t WS_PROJ = WS_H + (size_t)S * D * 2;
constexpr size_t WS_KI = WS_PROJ + (size_t)S * DINP * 2;
constexpr size_t WS_KC = WS_KI + (size_t)S * 64 * 2;
constexpr size_t WS_VC = WS_KC + (size_t)S * 256 * 2;
constexpr size_t WS_ST = WS_VC + (size_t)S * 256 * 2;
constexpr size_t WS_DC = WS_ST + (size_t)256 * 8 * 128 * 128 * 4;
constexpr size_t WS_SEL = WS_DC + (size_t)256 * 8 * 128 * 4;
constexpr size_t WS_ATT = WS_SEL + (size_t)S * 256 * 4;
constexpr size_t WS_REC = WS_ATT + (size_t)S * 1024 * 2;
constexpr size_t WS_MERGED = WS_REC + (size_t)S * 1024 * 2;
constexpr size_t WS_X1 = WS_MERGED + (size_t)S * 2048 * 2;
constexpr size_t WS_SCORES = WS_X1 + (size_t)S * 2048 * 4;
constexpr size_t WS_XB = WS_SCORES;
constexpr size_t WS_ACT = WS_XB + (size_t)PMAX * 2048 * 2;
constexpr size_t WS_YB = WS_ACT + (size_t)PMAX * 2048 * 2;
constexpr size_t WS_END = WS_SCORES + (size_t)S * S * 4;
static_assert(WS_YB + (size_t)PMAX * 2048 * 2 <= WS_END, "MoE buffers overlay the score matrix");
static_assert(WS_END <= (size_t)4096 * MiB, "workspace");
constexpr int CW_BAR = 4096, CW_CNT = 8192, CW_FILL = 8448;
constexpr size_t WS_TOKS = WS_SEL;

constexpr int LDS_BYTES = 155648;
constexpr int LDS_MISC = LDS_BYTES - 512;

__device__ __forceinline__ unsigned cvt_pk_bf16(float lo, float hi) { unsigned r; asm volatile("v_cvt_pk_bf16_f32 %0, %1, %2" : "=v"(r) : "v"(lo), "v"(hi)); return r; }
__device__ __forceinline__ float bf_lo(unsigned u) { return __uint_as_float(u << 16); }
__device__ __forceinline__ float bf_hi(unsigned u) { return __uint_as_float(u & 0xffff0000u); }
__device__ __forceinline__ float bf2f(bf16_t b) { return __uint_as_float(((unsigned)b) << 16); }
__device__ __forceinline__ float wave_sum(float v) {
#pragma unroll
    for (int o = 1; o < 64; o <<= 1) v += __shfl_xor(v, o);
    return v;
}
__device__ __forceinline__ float wave_max(float v) {
#pragma unroll
    for (int o = 1; o < 64; o <<= 1) v = fmaxf(v, __shfl_xor(v, o));
    return v;
}
__device__ __forceinline__ float sigmoidf_(float x) { return __builtin_amdgcn_rcpf(1.0f + __expf(-x)); }
__device__ __forceinline__ float siluf_(float x) { return x * __builtin_amdgcn_rcpf(1.0f + __expf(-x)); }
__device__ __forceinline__ unsigned pack4_fp8(float a, float b, float c, float d) { int w = 0; w = __builtin_amdgcn_cvt_pk_fp8_f32(a, b, w, false); w = __builtin_amdgcn_cvt_pk_fp8_f32(c, d, w, true); return (unsigned)w; }
constexpr float W8_SCALE = 64.0f, ACT8_SCALE = 4.0f;
__device__ __forceinline__ float relu_i(float x) { const int i = __float_as_int(x); return __int_as_float(i > 0 ? i : 0); }
#define LDS_WAIT() asm volatile("s_waitcnt lgkmcnt(0)" ::: "memory")
#define VM_WAIT() asm volatile("s_waitcnt vmcnt(0)" ::: "memory")

#define XB_TMO      128
#define XB_XCNT(j)  (256  + 64 * (j))
#define XB_XSUB(j)  (1280 + 64 * (j))
#define XB_XGEN(j)  (2304 + 64 * (j))
#define XB_TOP      3328
#define XB_TOPGEN   3392
#define XCD_BAR_WORDS 3456
#define XB_SPIN_CAP (1u << 22)

__device__ __forceinline__ unsigned xb_ld(unsigned* p)              { return __hip_atomic_load(p, __ATOMIC_RELAXED, __HIP_MEMORY_SCOPE_AGENT); }
__device__ __forceinline__ unsigned xb_add(unsigned* p, unsigned v) { return __hip_atomic_fetch_add(p, v, __ATOMIC_RELAXED, __HIP_MEMORY_SCOPE_AGENT); }
__device__ __forceinline__ unsigned xb_xcc_id() { return (unsigned)__builtin_amdgcn_s_getreg((3 << 11) | 20) & 0xFu; }
#define XB_SPIN(cond, bar) do { unsigned _sp = 0; while (cond) { __builtin_amdgcn_s_sleep(1); \
    if ((++_sp & 255u) == 0u) { if (xb_ld(&(bar)[XB_TMO])) break; if (_sp > XB_SPIN_CAP) { atomicAdd(&(bar)[XB_TMO], 1u); break; } } } } while (0)

struct XcdBarrier { unsigned* bar; unsigned x; volatile LAS unsigned* st; };

__device__ __forceinline__ XcdBarrier xcd_barrier_post(unsigned* bar, volatile LAS unsigned* st) {
    XcdBarrier b; b.bar = bar; b.x = xb_xcc_id(); b.st = st;
    if (threadIdx.x == 0) (void)xb_add(&bar[XB_XCNT(b.x)], 1u);
    return b;
}
__device__ __forceinline__ void xcd_barrier_complete(unsigned* bar, unsigned x, unsigned& nloc, unsigned& nx) {
    const unsigned G = gridDim.x * gridDim.y * gridDim.z;
    unsigned sum, cnt, mine, sp = 0u;
    for (;;) {
        sum = 0u; cnt = 0u; mine = 0u;
#pragma unroll
        for (unsigned j = 0; j < 16; ++j) { const unsigned c = xb_ld(&bar[XB_XCNT(j)]); sum += c; cnt += (c > 0u) ? 1u : 0u; mine = (j == x) ? c : mine; }
        if (sum == G) break;
        __builtin_amdgcn_s_sleep(1);
        if ((++sp & 255u) == 0u) { if (xb_ld(&bar[XB_TMO])) break; if (sp > XB_SPIN_CAP) { atomicAdd(&bar[XB_TMO], 1u); break; } }
    }
    nloc = mine > 0u ? mine : 1u; nx = cnt > 0u ? cnt : 1u;
}
__device__ __forceinline__ void xcd_barrier(const XcdBarrier& b) {
    asm volatile("s_waitcnt vmcnt(0)" ::: "memory");
    __syncthreads();
    if (threadIdx.x == 0) {
        unsigned* bar = b.bar;
        __builtin_amdgcn_s_waitcnt(0);
        unsigned nloc = b.st[0], nx = b.st[1];
        if (nloc == 0u) { xcd_barrier_complete(bar, b.x, nloc, nx); b.st[0] = nloc; b.st[1] = nx; }
        const unsigned old = xb_add(&bar[XB_XSUB(b.x)], 1u);
        const unsigned gen = old / nloc;
        if (old + 1u == (gen + 1u) * nloc) {
            __builtin_amdgcn_fence(__ATOMIC_RELEASE, "agent");
            asm volatile("s_waitcnt vmcnt(0)" ::: "memory");
            const unsigned og = xb_add(&bar[XB_TOP], 1u);
            const unsigned tg = og / nx;
            if (og + 1u == (tg + 1u) * nx) xb_add(&bar[XB_TOPGEN], 1u);
            else XB_SPIN(xb_ld(&bar[XB_TOPGEN]) == tg, bar);
            __builtin_amdgcn_fence(__ATOMIC_ACQUIRE, "agent");
            xb_add(&bar[XB_XGEN(b.x)], 1u);
            asm volatile("s_waitcnt vmcnt(0)" ::: "memory");
        } else {
            XB_SPIN(xb_ld(&bar[XB_XGEN(b.x)]) == gen, bar);
            __builtin_amdgcn_fence(__ATOMIC_ACQUIRE, "agent");
            asm volatile("s_waitcnt vmcnt(0)" ::: "memory");
        }
    }
    __syncthreads();
}

namespace pg8 {
constexpr int BM = 256, BK = 64, HALF = 128, HTB = HALF * BK * 2, STAGE_BYTES = 8 * HTB, NXCD = 8, WGM = 8;
__host__ __device__ __forceinline__ int lds_byte(int r, int c) { const int st = (r >> 4) * 2 + (c >> 5), rr = r & 15, cc = c & 31, ob = rr * 64 + cc * 2; return st * 1024 + (ob ^ (((ob >> 9) & 1) << 5)); }
__host__ __device__ __forceinline__ void stage_rc(int b, int& R, int& C) { const int st = b / 1024, sb = b % 1024, swz = sb ^ (((sb >> 9) & 1) << 5); R = (st >> 1) * 16 + swz / 64; C = (st & 1) * 32 + (swz % 64) / 2; }
__host__ __device__ __forceinline__ int perm32(int rho) { const int n = rho >> 4, i = rho & 15; return 8 * (i >> 2) + 4 * n + (i & 3); }

struct Unit { int pm, pn, e; };
struct Gemm { const void* A; const void* Bt; int K; size_t estride; const int* arow; };

struct StaticOrder {
    int nM, nN, nwg, G, c, i;
    __device__ void init(int M, int N, int G_, int c_) { nM = M / BM; nN = N / BM; nwg = nM * nN; G = G_; c = c_; i = 0; }
    __device__ bool next(Unit& u) {
        const long L = (long)i * G + c; ++i; if (L >= nwg) return false;
        int wgid = (int)L; { const int q = nwg / NXCD, r = nwg % NXCD, xcd = wgid % NXCD, off = wgid / NXCD; wgid = (xcd < r ? xcd * (q + 1) : r * (q + 1) + (xcd - r) * q) + off; }
        const int nig = WGM * nN, gid = wgid / nig, fm = gid * WGM, gsz = (nM - fm) < WGM ? (nM - fm) : WGM;
        u.pm = fm + ((wgid % nig) % gsz); u.pn = (wgid % nig) / gsz; u.e = 0; return true;
    }
};
struct MoeOrder {
    int nPanels, nN, G, c, i; const LAS int* panel_e;
    __device__ void init(int nPanels_, int nN_, int G_, int c_, const LAS int* pe) { nPanels = nPanels_; nN = nN_; G = G_; c = c_; i = 0; panel_e = pe; }
    __device__ bool next(Unit& u) {
        const int PB = 256 / nN;
        const int nblk = (nPanels + PB - 1) / PB;
        for (;;) {
            const long L = (long)i * G + c; ++i;
            const int blk = (int)(L >> 8), r = (int)(L & 255), x = r & 7, j = r >> 3;
            if (blk >= nblk) return false;
            int pm, pn;
            if (nN == 16) { pm = blk * 16 + 4 * (x >> 1) + (j & 3); pn = 8 * (x & 1) + (j >> 2); }
            else          { pm = blk * 32 + 4 * x + (j & 3);        pn = j >> 2; }
            if (pm < nPanels) { u.pm = pm; u.pn = pn; u.e = panel_e[pm]; return true; }
        }
    }
};

template <class Epi, class Sched, bool FP8 = false>
__device__ __forceinline__ void gemm_phase(LAS unsigned char* lds, const Gemm g, Sched& S, const Epi& E) {
    const int tid = threadIdx.x, wid = __builtin_amdgcn_readfirstlane(tid >> 6), lane = tid & 63, wr = wid >> 2, wc = wid & 3, fr = lane & 15, fq = lane >> 4;
    const int K = g.K; const int pitch = FP8 ? K : 2 * K; const int nt = pitch / 128;
    unsigned voffA[2], voffB[2];
#pragma unroll
    for (int i = 0; i < 2; ++i) { int R, C; stage_rc(tid * 16 + i * 8192, R, C); const int Rb = Epi::PERM ? ((R & ~31) + perm32(R & 31)) : R;
        voffA[i] = (unsigned)(R * pitch + C * 2); voffB[i] = (unsigned)(Rb * pitch + C * 2); }
    const size_t kstep = (size_t)(BK * 2);
    const size_t hstep = (size_t)HALF * pitch;
    const size_t tstep = 2 * hstep;
    int RA[2], CA[2];
#pragma unroll
    for (int i = 0; i < 2; ++i) stage_rc(tid * 16 + i * 8192, RA[i], CA[i]);
    const bool gather = g.arow != nullptr;
    const size_t hsA = gather ? 0 : hstep;
    unsigned vA0[2] = {voffA[0], voffA[1]}, vA1[2] = {voffA[0], voffA[1]}, nA0[2] = {voffA[0], voffA[1]}, nA1[2] = {voffA[0], voffA[1]};
#define PG8_AOFF(dst0, dst1, u) do { if (gather) { _Pragma("unroll") for (int i = 0; i < 2; ++i) { \
        dst0[i] = (unsigned)g.arow[(u).pm * 256 + RA[i]] * (unsigned)pitch + (unsigned)(CA[i] * 2); dst1[i] = (unsigned)g.arow[(u).pm * 256 + 128 + RA[i]] * (unsigned)pitch + (unsigned)(CA[i] * 2); } } } while (0)
    const unsigned ldsw = (unsigned)wid * 1024u;
    const int aoff = lds_byte(wr * 64 + fr, fq * 8), boff = lds_byte(wc * 32 + fr, fq * 8);
#define PG8_SA(b, h) (((b) * 2 + (h)) * HTB)
#define PG8_SB(b, h) ((4 + (b) * 2 + (h)) * HTB)
#define PG8_STAGE(bufoff, gbase, voff) do { _Pragma("unroll") for (int _i = 0; _i < 2; ++_i) \
        __builtin_amdgcn_global_load_lds((const unsigned*)((const char*)(gbase) + (voff)[_i]), (LAS unsigned*)(lds + (bufoff) + ldsw + _i * 8192), 16, 0, 0); } while (0)
#define PG8_LD8(p) __builtin_shufflevector(*(const LAS i32x4*)(p), *(const LAS i32x4*)((p) + 1024), 0, 1, 2, 3, 4, 5, 6, 7)
#define PG8_LDA(dst, b, h) do { _Pragma("unroll") for (int m = 0; m < 4; ++m) { if constexpr (FP8) dst##8[m] = PG8_LD8(lds + PG8_SA(b, h) + aoff + m * 2048); \
        else { _Pragma("unroll") for (int k = 0; k < 2; ++k) dst[m][k] = *(const LAS bf16x8*)(lds + PG8_SA(b, h) + aoff + m * 2048 + k * 1024); } } } while (0)
#define PG8_LDB(dst, b, h) do { _Pragma("unroll") for (int n = 0; n < 2; ++n) { if constexpr (FP8) dst##8[n] = PG8_LD8(lds + PG8_SB(b, h) + boff + n * 2048); \
        else { _Pragma("unroll") for (int k = 0; k < 2; ++k) dst[n][k] = *(const LAS bf16x8*)(lds + PG8_SB(b, h) + boff + n * 2048 + k * 1024); } } } while (0)
#define PG8_MMA(ai, bj, At, Bt) do { __builtin_amdgcn_s_setprio(1); _Pragma("unroll") for (int m = 0; m < 4; ++m) _Pragma("unroll") for (int n = 0; n < 2; ++n) { \
        if constexpr (FP8) asm volatile("v_mfma_scale_f32_16x16x128_f8f6f4 %0, %1, %2, %0, %3, %3 op_sel_hi:[0,0,0]" : "+v"(acc[ai][bj][m][n]) : "v"(Bt##8[n]), "v"(At##8[m]), "v"(scl1)); \
        else { _Pragma("unroll") for (int k = 0; k < 2; ++k) acc[ai][bj][m][n] = __builtin_amdgcn_mfma_f32_16x16x32_bf16(Bt[n][k], At[m][k], acc[ai][bj][m][n], 0, 0, 0); } } \
        __builtin_amdgcn_s_setprio(0); } while (0)
#define PG8_WAIT_V(n) asm volatile("s_waitcnt vmcnt(" #n ")" ::: "memory")
#define PG8_WAIT_L(n) asm volatile("s_waitcnt lgkmcnt(" #n ")" ::: "memory")
#define PG8_BAR __builtin_amdgcn_s_barrier()
#define PG8_SCHED __builtin_amdgcn_sched_barrier(0)
    Unit cur, nxt;
    if (!S.next(cur)) return;
    const unsigned scl1 = 0x7f7f7f7fu;
    f32x4 acc[2][2][4][2];
#pragma unroll
    for (int a = 0; a < 2; ++a)
#pragma unroll
        for (int b = 0; b < 2; ++b)
#pragma unroll
            for (int m = 0; m < 4; ++m)
#pragma unroll
                for (int n = 0; n < 2; ++n) acc[a][b][m][n] = (f32x4){0.f, 0.f, 0.f, 0.f};
    bf16x8 At[4][2], B0[2][2], B1[2][2]; i32x8 At8[4], B08[2], B18[2];
    const char* cA = (const char*)g.A + (gather ? (size_t)0 : (size_t)cur.pm * tstep); const char* cB = (const char*)g.Bt + (size_t)cur.e * g.estride + (size_t)cur.pn * tstep;
    PG8_AOFF(vA0, vA1, cur);
    PG8_STAGE(PG8_SB(0, 0), cB, voffB); PG8_STAGE(PG8_SB(0, 1), cB + hstep, voffB); PG8_STAGE(PG8_SA(0, 0), cA, vA0); PG8_STAGE(PG8_SA(0, 1), cA + hsA, vA1);
    if (wr == 1) PG8_BAR;
    PG8_WAIT_V(2); PG8_BAR;
    PG8_STAGE(PG8_SB(1, 0), cB + kstep, voffB); PG8_STAGE(PG8_SA(1, 0), cA + kstep, vA0); PG8_STAGE(PG8_SB(1, 1), cB + hstep + kstep, voffB);
    PG8_WAIT_V(6); PG8_BAR;
    for (;;) {
        const bool has_next = S.next(nxt);
        const char* nA = has_next ? (const char*)g.A + (gather ? (size_t)0 : (size_t)nxt.pm * tstep) : cA;
        if (has_next) PG8_AOFF(nA0, nA1, nxt);
        const char* nB = has_next ? (const char*)g.Bt + (size_t)nxt.e * g.estride + (size_t)nxt.pn * tstep : cB;
        for (int t = 0; t < nt; t += 2) {
            const bool last = (t == nt - 2);
            const char* a1 = cA + (size_t)(t + 1) * kstep;
            const char* a2 = last ? nA : cA + (size_t)(t + 2) * kstep; const char* b2 = last ? nB : cB + (size_t)(t + 2) * kstep;
            const char* a3 = a2 + kstep; const char* b3 = b2 + kstep;
            PG8_LDB(B0, 0, 0); PG8_LDB(B1, 0, 1); PG8_SCHED; PG8_LDA(At, 0, 0); PG8_STAGE(PG8_SA(1, 1), a1 + hsA, vA1);
            if (last && has_next) { vA0[0] = nA0[0]; vA0[1] = nA0[1]; vA1[0] = nA1[0]; vA1[1] = nA1[1]; }
            PG8_WAIT_V(8); PG8_WAIT_L(0); PG8_BAR; PG8_MMA(0, 0, At, B0); PG8_MMA(0, 1, At, B1); PG8_BAR; PG8_SCHED;
            PG8_LDA(At, 0, 1); PG8_STAGE(PG8_SB(0, 0), b2, voffB); PG8_STAGE(PG8_SB(0, 1), b2 + hstep, voffB); PG8_STAGE(PG8_SA(0, 0), a2, vA0);
            PG8_WAIT_V(8); PG8_WAIT_L(0); PG8_BAR; PG8_MMA(1, 0, At, B0); PG8_MMA(1, 1, At, B1); PG8_BAR; PG8_SCHED;
            PG8_LDB(B0, 1, 0); PG8_LDB(B1, 1, 1); PG8_SCHED; PG8_LDA(At, 1, 0); PG8_STAGE(PG8_SA(0, 1), a2 + hsA, vA1);
            PG8_WAIT_V(8); PG8_WAIT_L(0); PG8_BAR; PG8_MMA(0, 0, At, B0); PG8_MMA(0, 1, At, B1); PG8_BAR; PG8_SCHED;
            PG8_LDA(At, 1, 1); PG8_STAGE(PG8_SB(1, 0), b3, voffB); PG8_STAGE(PG8_SB(1, 1), b3 + hstep, voffB); PG8_STAGE(PG8_SA(1, 0), a3, vA0);
            PG8_WAIT_V(8); PG8_WAIT_L(0); PG8_BAR; PG8_MMA(1, 0, At, B0); PG8_MMA(1, 1, At, B1); PG8_BAR; PG8_SCHED;
        }
        if (wr == 0) PG8_BAR;
        if constexpr (FP8) {
#pragma unroll
            for (int a = 0; a < 2; ++a)
#pragma unroll
                for (int b = 0; b < 2; ++b) asm volatile("s_nop 15" : "+v"(acc[a][b][0][0]), "+v"(acc[a][b][0][1]), "+v"(acc[a][b][1][0]), "+v"(acc[a][b][1][1]), "+v"(acc[a][b][2][0]), "+v"(acc[a][b][2][1]), "+v"(acc[a][b][3][0]), "+v"(acc[a][b][3][1]));
        }
        E(acc, cur, wr, wc, fr, fq);
        if (!has_next) break;
#pragma unroll
        for (int a = 0; a < 2; ++a)
#pragma unroll
            for (int b = 0; b < 2; ++b)
#pragma unroll
                for (int m = 0; m < 4; ++m)
#pragma unroll
                    for (int n = 0; n < 2; ++n) acc[a][b][m][n] = (f32x4){0.f, 0.f, 0.f, 0.f};
        cur = nxt; cA = nA; cB = nB;
        if (wr == 1) PG8_BAR;
    }
    PG8_WAIT_V(0);
    PG8_BAR;
#undef PG8_AOFF
#undef PG8_SA
#undef PG8_SB
#undef PG8_STAGE
#undef PG8_LDA
#undef PG8_LDB
#undef PG8_MMA
#undef PG8_LD8
#undef PG8_WAIT_V
#undef PG8_WAIT_L
#undef PG8_BAR
#undef PG8_SCHED
}

struct EpiBf16 {
    static constexpr bool PERM = true;
    bf16_t* O; int ldc; const float* bias; int bias_estride; float ascale; int skip_from, skip_cols;
    __device__ __forceinline__ void operator()(const f32x4 (&acc)[2][2][4][2], const Unit& u, int wr, int wc, int fr, int fq) const {
        const int row0 = u.pm * BM + wr * 64 + fr; const int col0 = u.pn * BM + wc * 32 + 8 * fq + (u.pn >= skip_from ? skip_cols : 0);
        f32x4 bv[2][2];
#pragma unroll
        for (int bj = 0; bj < 2; ++bj)
#pragma unroll
            for (int n = 0; n < 2; ++n) bv[bj][n] = bias ? *(const f32x4*)(bias + (size_t)u.e * bias_estride + col0 + bj * HALF + 4 * n) : (f32x4){0.f, 0.f, 0.f, 0.f};
#pragma unroll
        for (int ai = 0; ai < 2; ++ai)
#pragma unroll
            for (int m = 0; m < 4; ++m) { bf16_t* rowp = O + (size_t)(row0 + ai * HALF + m * 16) * ldc + col0;
#pragma unroll
                for (int bj = 0; bj < 2; ++bj) { const f32x4 v0 = acc[ai][bj][m][0] * ascale + bv[bj][0], v1 = acc[ai][bj][m][1] * ascale + bv[bj][1];
                    u32x4 w; w.x = cvt_pk_bf16(v0[0], v0[1]); w.y = cvt_pk_bf16(v0[2], v0[3]); w.z = cvt_pk_bf16(v1[0], v1[1]); w.w = cvt_pk_bf16(v1[2], v1[3]);
                    *(u32x4*)(rowp + bj * HALF) = w; } }
    }
};
__device__ __forceinline__ float swiglu1(float ug, float ul) {
    ug = fminf(ug, 7.0f); ul = fminf(fmaxf(ul, -7.0f), 7.0f);
    return ug * __builtin_amdgcn_rcpf(1.0f + __expf(-1.702f * ug)) * (ul + 1.0f);
}
struct EpiSwiglu {
    static constexpr bool PERM = true;
    unsigned char* O; const float* b1;
    __device__ __forceinline__ void operator()(const f32x4 (&acc)[2][2][4][2], const Unit& u, int wr, int wc, int fr, int fq) const {
        const int row0 = u.pm * BM + wr * 64 + fr; const int c0 = u.pn * 128 + wc * 32 + 8 * fq;
        const float* bg = b1 + (size_t)u.e * 4096 + c0; const float* bl = bg + 2048;
        f32x4 bgv[2], blv[2];
#pragma unroll
        for (int n = 0; n < 2; ++n) { bgv[n] = *(const f32x4*)(bg + 4 * n); blv[n] = *(const f32x4*)(bl + 4 * n); }
#pragma unroll
        for (int ai = 0; ai < 2; ++ai)
#pragma unroll
            for (int m = 0; m < 4; ++m) {
                float a[8];
#pragma unroll
                for (int n = 0; n < 2; ++n)
#pragma unroll
                    for (int j = 0; j < 4; ++j) a[4 * n + j] = ACT8_SCALE * swiglu1(acc[ai][0][m][n][j] * (1.0f / W8_SCALE) + bgv[n][j], acc[ai][1][m][n][j] * (1.0f / W8_SCALE) + blv[n][j]);
                u32x2 w; w.x = pack4_fp8(a[0], a[1], a[2], a[3]); w.y = pack4_fp8(a[4], a[5], a[6], a[7]);
                *(u32x2*)(O + (size_t)(row0 + ai * HALF + m * 16) * 2048 + c0) = w;
            }
    }
};

struct EpiGate {
    static constexpr bool PERM = true;
    bf16_t* O; const bf16_t* Gt; int accum;
    __device__ __forceinline__ void operator()(const f32x4 (&acc)[2][2][4][2], const Unit& u, int wr, int wc, int fr, int fq) const {
        const int row0 = u.pm * BM + wr * 64 + fr; const int col0 = u.pn * BM + wc * 32 + 8 * fq;
#pragma unroll
        for (int ai = 0; ai < 2; ++ai)
#pragma unroll
            for (int m = 0; m < 4; ++m) { const size_t row = (size_t)(row0 + ai * HALF + m * 16);
#pragma unroll
                for (int bj = 0; bj < 2; ++bj) { const int c = col0 + bj * HALF;
                    const u32x4 gw = *(const u32x4*)(Gt + row * DINP + c);
                    float r[8];
#pragma unroll
                    for (int q = 0; q < 4; ++q) { r[2 * q] = sigmoidf_(bf_lo(gw[q])) * acc[ai][bj][m][q >> 1][(2 * q) & 3]; r[2 * q + 1] = sigmoidf_(bf_hi(gw[q])) * acc[ai][bj][m][q >> 1][(2 * q + 1) & 3]; }
                    bf16_t* op = O + row * 2048 + c;
                    if (accum) { const u32x4 ow = *(const u32x4*)op;
#pragma unroll
                        for (int q = 0; q < 4; ++q) { r[2 * q] += bf_lo(ow[q]); r[2 * q + 1] += bf_hi(ow[q]); } }
                    u32x4 w; w.x = cvt_pk_bf16(r[0], r[1]); w.y = cvt_pk_bf16(r[2], r[3]); w.z = cvt_pk_bf16(r[4], r[5]); w.w = cvt_pk_bf16(r[6], r[7]);
                    *(u32x4*)op = w; } }
    }
};
struct EpiResid {
    static constexpr bool PERM = false;
    const float* x; const float* gt; float* X1;
    __device__ __forceinline__ void operator()(const f32x4 (&acc)[2][2][4][2], const Unit& u, int wr, int wc, int fr, int fq) const {
        const int row0 = u.pm * BM + wr * 64 + fr; const int col0 = u.pn * BM + wc * 32 + 4 * fq;
#pragma unroll
        for (int ai = 0; ai < 2; ++ai)
#pragma unroll
            for (int m = 0; m < 4; ++m) { const size_t row = (size_t)(row0 + ai * HALF + m * 16);
#pragma unroll
                for (int bj = 0; bj < 2; ++bj)
#pragma unroll
                    for (int n = 0; n < 2; ++n) { const int c = col0 + bj * HALF + n * 16;
                        const f32x4 xv = *(const f32x4*)(x + row * 2048 + c), g = *(const f32x4*)(gt + c);
                        *(f32x4*)(X1 + row * 2048 + c) = xv + g * acc[ai][bj][m][n]; } }
    }
};
}

#ifndef MK_REP
#define MK_REP 0
#endif
#ifndef MK_REP2
#define MK_REP2 0
#endif
struct Args { const void* in[22]; float* out; unsigned char* ws; int ph_lo, ph_hi, flags, pad; };
enum { PH_PRO = 0, PH_H, PH_INPROJ, PH_POST, PH_SCORE, PH_SELECT, PH_ATTN, PH_OP1, PH_OP2, PH_WOUT, PH_ROUTER, PH_SCATTER, PH_MOE1, PH_MOE2, PH_FINAL, NPH };
constexpr int FLAG_MIXER = 1, FLAG_ATT = 2, FLAG_MOE = 4;

__device__ __forceinline__ int dest_row(int mode, int n) {
    if (mode == 1) return n < 2640 ? n : n + 176;
    if (mode == 2) { const int g = n >> 11, c = n & 2047; return (c >> 7) * 256 + g * 128 + (c & 127); }
    return n;
}
__device__ __forceinline__ void convert_item(const float* __restrict__ W, int K, int N, int ld, bf16_t* WT, int mode, int item, int lane, LAS unsigned char* scr) {
    const int nblk = (N + 63) >> 6; const int kb = item / nblk, nb = item - kb * nblk; const int k0 = kb * 128, n0 = nb * 64;
    const int c4 = lane & 15, kr = lane >> 4;
    const bool ok = (n0 + 4 * c4) < N;
    const float* src = W + (size_t)(k0 + 2 * kr) * ld + n0 + 4 * c4;
#pragma unroll 4
    for (int i = 0; i < 16; ++i) {
        f32x4 v0 = (f32x4){0.f, 0.f, 0.f, 0.f}, v1 = v0;
        if (ok) { v0 = *(const f32x4*)(src + (size_t)(8 * i) * ld); v1 = *(const f32x4*)(src + (size_t)(8 * i + 1) * ld); }
        const int kk = 8 * i + 2 * kr;
#pragma unroll
        for (int e = 0; e < 4; ++e) *(LAS unsigned*)(scr + (4 * c4 + e) * 272 + kk * 2) = cvt_pk_bf16(v0[e], v1[e]);
    }
    LDS_WAIT(); asm volatile("" ::: "memory");
#pragma unroll 4
    for (int j = 0; j < 16; ++j) {
        const int q = j * 64 + lane, n = q >> 4, ch = q & 15;
        const u32x4 v = *(const LAS u32x4*)(scr + n * 272 + ch * 16);
        if (n0 + n < N) *(u32x4*)(WT + (size_t)dest_row(mode, n0 + n) * K + k0 + ch * 8) = v;
    }
    LDS_WAIT(); asm volatile("" ::: "memory");
}


__device__ __forceinline__ bf16_t f2bf(float f) { unsigned u = __float_as_uint(f); return (bf16_t)((u + 0x7fffu + ((u >> 16) & 1u)) >> 16); }
__device__ __forceinline__ float bfx(const u32x4& w, int i) { const unsigned u = w[i >> 1]; return (i & 1) ? bf_hi(u) : bf_lo(u); }
__device__ __forceinline__ void rope_sc(float pos, float inv, float& sn, float& cs) {
    const float ang = pos * inv;
    const double a = (double)ang; const double n = __builtin_rint(a * 0.15915494309189535); const float r = (float)(a - n * 6.283185307179586);
    sn = sinf(r); cs = cosf(r);
}
__device__ __forceinline__ void post_token(bf16_t* PROJ, bf16_t* KI, bf16_t* KC, bf16_t* VC, const int* positions, const float* kng, const float* knb, int t, int lane) {
    const float pos = (float)positions[t];
    bf16_t* row = PROJ + (size_t)t * DINP;
    float sn, cs;
#pragma unroll
    for (int i = 0; i < 2; ++i) {
        const int pp = lane + 64 * i, hd = pp >> 4, ii = pp & 15;
        rope_sc(pos, powf(500000.0f, -(float)ii * (1.0f / 16.0f)), sn, cs);
        bf16_t* p = row + CQ + hd * 128 + ii; const float a = bf2f(p[0]), b = bf2f(p[16]);
        p[0] = f2bf(a * cs - b * sn); p[16] = f2bf(b * cs + a * sn);
    }
#pragma unroll
    for (int i = 0; i < 2; ++i) {
        const int pp = lane + 64 * i, hd = pp >> 3, ii = pp & 7;
        rope_sc(pos, powf(500000.0f, -(float)ii * (1.0f / 8.0f)), sn, cs);
        bf16_t* p = row + CQI + hd * 64 + ii; const float a = bf2f(p[0]), b = bf2f(p[8]);
        p[0] = f2bf(a * cs - b * sn); p[8] = f2bf(b * cs + a * sn);
    }
    if (lane < 32) {
        const int g = lane >> 4, ii = lane & 15;
        rope_sc(pos, powf(500000.0f, -(float)ii * (1.0f / 16.0f)), sn, cs);
        const bf16_t* p = row + CK + g * 128 + ii; const float a = bf2f(p[0]), b = bf2f(p[16]);
        bf16_t* o = KC + (size_t)t * 256 + g * 128 + ii; o[0] = f2bf(a * cs - b * sn); o[16] = f2bf(b * cs + a * sn);
    }
#pragma unroll
    for (int i = 0; i < 3; ++i) { const int idx = lane + 64 * i, g = idx / 96, r = idx - g * 96; KC[(size_t)t * 256 + g * 128 + 32 + r] = row[CK + g * 128 + 32 + r]; }
    *(u32x2*)(VC + (size_t)t * 256 + 4 * lane) = *(const u32x2*)(row + CV + 4 * lane);
    {
        const float v = bf2f(row[CKI + lane]);
        const float mean = wave_sum(v) * (1.0f / 64.0f); const float d = v - mean; const float var = wave_sum(d * d) * (1.0f / 64.0f);
        const float y = d * rsqrtf(var + NORM_EPS) * kng[lane] + knb[lane];
        const float other = __shfl_xor(y, 8);
        rope_sc(pos, powf(500000.0f, -(float)(lane & 7) * (1.0f / 8.0f)), sn, cs);
        float o = y;
        if (lane < 8) o = y * cs - other * sn; else if (lane < 16) o = y * cs + other * sn;
        KI[(size_t)t * 64 + lane] = f2bf(o);
    }
}

constexpr int HG_GB = 0, HG_Q1 = 33792, HG_Q2 = 51200, HG_K2 = 68608, HG_VT = 86016, HG_PB = 104448, HG_LB = 113664;
__device__ __forceinline__ void hgrn_cumsum(LAS unsigned char* lds, const u32x4& w0, const u32x4& w1, float l0, float l1, int tid) {
    LAS float* GB = (LAS float*)(lds + HG_GB); LAS float* LB = (LAS float*)(lds + HG_LB); LAS float* SEG = (LAS float*)(lds + HG_LB + 512);
    if (tid < 128) LB[tid] = 1.0f / (1.0f + expf(l1 - l0));
    __syncthreads();
    const int t = tid >> 3, dseg = tid & 7;
#pragma unroll
    for (int i = 0; i < 16; ++i) { const float z = i < 8 ? bfx(w0, i) : bfx(w1, i - 8); const float lb = LB[16 * dseg + i]; GB[t * 128 + 16 * dseg + i] = logf(lb + (1.0f - lb) * sigmoidf_(z)); }
    __syncthreads();
    const int d = tid & 127, tq = tid >> 7;
    float z[16];
#pragma unroll
    for (int i = 0; i < 16; ++i) z[i] = GB[(16 * tq + i) * 128 + d];
    float a = 0.f;
#pragma unroll
    for (int i = 0; i < 16; ++i) { a += z[i]; z[i] = a; }
    SEG[tq * 128 + d] = a;
    __syncthreads();
    float pre = 0.f;
    for (int q = 0; q < tq; ++q) pre += SEG[q * 128 + d];
#pragma unroll
    for (int i = 0; i < 16; ++i) GB[(16 * tq + i) * 128 + d] = z[i] + pre;
    __syncthreads();
}
__device__ __forceinline__ void hgrn_vt(LAS unsigned char* lds, const u32x4& a, const u32x4& b, int tid) {
    const int s2 = tid & 31, eg = tid >> 5;
#pragma unroll
    for (int i = 0; i < 8; ++i) { const unsigned lo = (i & 1) ? (a[i >> 1] >> 16) : (a[i >> 1] & 0xffffu), hi = (i & 1) ? (b[i >> 1] >> 16) : (b[i >> 1] & 0xffffu);
        *(LAS unsigned*)(lds + HG_VT + (8 * eg + i) * 144 + s2 * 4) = lo | (hi << 16); }
}
__device__ __forceinline__ void hgrn_l1(LAS unsigned char* lds, const bf16_t* PROJ, const float* lb_logits, float* ST, float* DC, int c, int h, int tid, int wave, int lane) {
    const int t = tid >> 3, dseg = tid & 7, s2 = tid & 31, dg = tid >> 5;
    const bf16_t* pf = PROJ + (size_t)(c * 64 + t) * DINP + CHF + h * 128 + 16 * dseg;
    const bf16_t* pk = PROJ + (size_t)(c * 64 + 2 * s2) * DINP + CHF + h * 128 + 8 * dg;
    const u32x4 w0 = *(const u32x4*)pf, w1 = *(const u32x4*)(pf + 8);
    const u32x4 ka = *(const u32x4*)pk, kb = *(const u32x4*)(pk + DINP);
    const u32x4 va = *(const u32x4*)(pk - CHF + CHI), vb = *(const u32x4*)(pk - CHF + CHI + DINP);
    const float l0 = lb_logits[h * 128 + (tid & 127)], l1 = lb_logits[1024 + h * 128 + (tid & 127)];
    hgrn_cumsum(lds, w0, w1, l0, l1, tid);
    const LAS float* GB = (const LAS float*)(lds + HG_GB); const LAS float* LB = (const LAS float*)(lds + HG_LB);
    {
#pragma unroll
        for (int i = 0; i < 8; ++i) { const int d = 8 * dg + i; const float lb = LB[d], b63 = GB[63 * 128 + d];
            const float k0 = (1.0f - lb) * (1.0f - sigmoidf_(bfx(ka, i))), k1 = (1.0f - lb) * (1.0f - sigmoidf_(bfx(kb, i)));
            const float v0 = k0 * __expf(b63 - GB[(2 * s2) * 128 + d]), v1 = k1 * __expf(b63 - GB[(2 * s2 + 1) * 128 + d]);
            *(LAS unsigned*)(lds + HG_Q1 + d * 144 + s2 * 4) = cvt_pk_bf16(v0, v1); }
    }
    hgrn_vt(lds, va, vb, tid);
    __syncthreads();
    const int fr = lane & 15, fq = lane >> 4;
    bf16x8 af[2];
#pragma unroll
    for (int ks = 0; ks < 2; ++ks) af[ks] = *(const LAS bf16x8*)(lds + HG_VT + (16 * wave + fr) * 144 + (32 * ks + 8 * fq) * 2);
    float* dst = ST + ((size_t)(c * 8 + h) * 128) * 128;
#pragma unroll 2
    for (int dt = 0; dt < 8; ++dt) {
        f32x4 acc = (f32x4){0.f, 0.f, 0.f, 0.f};
#pragma unroll
        for (int ks = 0; ks < 2; ++ks) { const bf16x8 bfr = *(const LAS bf16x8*)(lds + HG_Q1 + (16 * dt + fr) * 144 + (32 * ks + 8 * fq) * 2); acc = __builtin_amdgcn_mfma_f32_16x16x32_bf16(af[ks], bfr, acc, 0, 0, 0); }
#pragma unroll
        for (int r = 0; r < 4; ++r) dst[(size_t)(16 * wave + 4 * fq + r) * 128 + 16 * dt + fr] = acc[r];
    }
    if (tid < 128) DC[(size_t)(c * 8 + h) * 128 + tid] = __expf(GB[63 * 128 + tid]);
    __syncthreads();
}
__device__ __forceinline__ void hgrn_l3(LAS unsigned char* lds, const bf16_t* PROJ, const float* lb_logits, const float* ST, const float* norm_g, bf16_t* REC, int c, int h, int tid, int wave, int lane) {
    const int t = tid >> 3, dseg = tid & 7, s2 = tid & 31, eg = tid >> 5, fr = lane & 15, fq = lane >> 4;
    const bf16_t* pf = PROJ + (size_t)(c * 64 + t) * DINP + CHF + h * 128 + 16 * dseg;
    const u32x4 f0 = *(const u32x4*)pf, f1 = *(const u32x4*)(pf + 8), q0 = *(const u32x4*)(pf - CHF + CHQ), q1 = *(const u32x4*)(pf - CHF + CHQ + 8);
    const u32x4 g0 = *(const u32x4*)(pf - CHF + CHG), g1 = *(const u32x4*)(pf - CHF + CHG + 8);
    const bf16_t* pv = PROJ + (size_t)(c * 64 + 2 * s2) * DINP + CHI + h * 128 + 8 * eg;
    const u32x4 va = *(const u32x4*)pv, vb = *(const u32x4*)(pv + DINP);
    const float* sp = ST + ((size_t)(c * 8 + h) * 128 + 16 * wave + fr) * 128 + 8 * fq;
    f32x4 sx[4][2];
#pragma unroll
    for (int ks = 0; ks < 4; ++ks) { sx[ks][0] = *(const f32x4*)(sp + 32 * ks); sx[ks][1] = *(const f32x4*)(sp + 32 * ks + 4); }
    const float l0 = lb_logits[h * 128 + (tid & 127)], l1 = lb_logits[1024 + h * 128 + (tid & 127)];
    hgrn_cumsum(lds, f0, f1, l0, l1, tid);
    const LAS float* GB = (const LAS float*)(lds + HG_GB); const LAS float* LB = (const LAS float*)(lds + HG_LB);
    {
        unsigned o1[8], o2[8], o3[8];
#pragma unroll
        for (int i = 0; i < 16; i += 2) {
            float a1[2], a2[2], a3[2];
#pragma unroll
            for (int j = 0; j < 2; ++j) { const int d = 16 * dseg + i + j; const float lb = LB[d], b = GB[t * 128 + d], br = GB[31 * 128 + d];
                const float z = (i + j) < 8 ? bfx(f0, i + j) : bfx(f1, i + j - 8), qv = (i + j) < 8 ? bfx(q0, i + j) : bfx(q1, i + j - 8);
                const float k = (1.0f - lb) * (1.0f - sigmoidf_(z)), q = siluf_(qv);
                a1[j] = q * __expf(b); a2[j] = q * __expf(b - br); a3[j] = k * __expf(br - b); }
            o1[i >> 1] = cvt_pk_bf16(a1[0], a1[1]); o2[i >> 1] = cvt_pk_bf16(a2[0], a2[1]); o3[i >> 1] = cvt_pk_bf16(a3[0], a3[1]);
        }
        LAS u32x4* d1 = (LAS u32x4*)(lds + HG_Q1 + t * 272 + dseg * 32); LAS u32x4* d2 = (LAS u32x4*)(lds + HG_Q2 + t * 272 + dseg * 32); LAS u32x4* d3 = (LAS u32x4*)(lds + HG_K2 + t * 272 + dseg * 32);
        d1[0] = (u32x4){o1[0], o1[1], o1[2], o1[3]}; d1[1] = (u32x4){o1[4], o1[5], o1[6], o1[7]};
        d2[0] = (u32x4){o2[0], o2[1], o2[2], o2[3]}; d2[1] = (u32x4){o2[4], o2[5], o2[6], o2[7]};
        d3[0] = (u32x4){o3[0], o3[1], o3[2], o3[3]}; d3[1] = (u32x4){o3[4], o3[5], o3[6], o3[7]};
    }
    hgrn_vt(lds, va, vb, tid);
    __syncthreads();
#pragma unroll
    for (int q = 0; q < 2; ++q) {
        const int tile = 2 * wave + q, tt = tile >> 2, stl = tile & 3;
        f32x4 acc = (f32x4){0.f, 0.f, 0.f, 0.f};
#pragma unroll
        for (int ks = 0; ks < 4; ++ks) { const bf16x8 a = *(const LAS bf16x8*)(lds + HG_Q2 + (16 * tt + fr) * 272 + (32 * ks + 8 * fq) * 2), b = *(const LAS bf16x8*)(lds + HG_K2 + (16 * stl + fr) * 272 + (32 * ks + 8 * fq) * 2);
            acc = __builtin_amdgcn_mfma_f32_16x16x32_bf16(a, b, acc, 0, 0, 0); }
#pragma unroll
        for (int r = 0; r < 4; ++r) { const int tr_ = 16 * tt + 4 * fq + r, s = 16 * stl + fr; *(LAS bf16_t*)(lds + HG_PB + tr_ * 144 + s * 2) = f2bf(s <= tr_ ? acc[r] : 0.f); }
    }
    __syncthreads();
    {
        bf16x8 b1[2], b2[4];
#pragma unroll
        for (int ks = 0; ks < 2; ++ks) b1[ks] = *(const LAS bf16x8*)(lds + HG_VT + (16 * wave + fr) * 144 + (32 * ks + 8 * fq) * 2);
#pragma unroll
        for (int ks = 0; ks < 4; ++ks) { const f32x4 x0 = sx[ks][0], x1 = sx[ks][1];
            u32x4 w; w.x = cvt_pk_bf16(x0[0], x0[1]); w.y = cvt_pk_bf16(x0[2], x0[3]); w.z = cvt_pk_bf16(x1[0], x1[1]); w.w = cvt_pk_bf16(x1[2], x1[3]); b2[ks] = __builtin_bit_cast(bf16x8, w); }
        LAS float* OB = (LAS float*)(lds + HG_GB);
#pragma unroll
        for (int tt = 0; tt < 4; ++tt) {
            f32x4 acc = (f32x4){0.f, 0.f, 0.f, 0.f};
#pragma unroll
            for (int ks = 0; ks < 2; ++ks) { const bf16x8 a = *(const LAS bf16x8*)(lds + HG_PB + (16 * tt + fr) * 144 + (32 * ks + 8 * fq) * 2); acc = __builtin_amdgcn_mfma_f32_16x16x32_bf16(a, b1[ks], acc, 0, 0, 0); }
#pragma unroll
            for (int ks = 0; ks < 4; ++ks) { const bf16x8 a = *(const LAS bf16x8*)(lds + HG_Q1 + (16 * tt + fr) * 272 + (32 * ks + 8 * fq) * 2); acc = __builtin_amdgcn_mfma_f32_16x16x32_bf16(a, b2[ks], acc, 0, 0, 0); }
#pragma unroll
            for (int r = 0; r < 4; ++r) OB[(16 * tt + 4 * fq + r) * 132 + 16 * wave + fr] = acc[r];
        }
    }
    __syncthreads();
    {
        const int es = dseg; const LAS float* OB = (const LAS float*)(lds + HG_GB);
        float o[16]; float ss = 0.f;
#pragma unroll
        for (int i = 0; i < 16; ++i) { o[i] = OB[t * 132 + 16 * es + i]; ss += o[i] * o[i]; }
        ss += __shfl_xor(ss, 1); ss += __shfl_xor(ss, 2); ss += __shfl_xor(ss, 4);
        const float rstd = rsqrtf(ss * (1.0f / 128.0f) + NORM_EPS);
        unsigned w[8];
#pragma unroll
        for (int i = 0; i < 16; i += 2) { const float ga = i < 8 ? bfx(g0, i) : bfx(g1, i - 8), gb = (i + 1) < 8 ? bfx(g0, i + 1) : bfx(g1, i + 1 - 8);
            w[i >> 1] = cvt_pk_bf16(o[i] * rstd * norm_g[16 * es + i] * siluf_(ga), o[i + 1] * rstd * norm_g[16 * es + i + 1] * siluf_(gb)); }
        u32x4* dst = (u32x4*)(REC + (size_t)(c * 64 + t) * 1024 + h * 128 + 16 * es);
        dst[0] = (u32x4){w[0], w[1], w[2], w[3]}; dst[1] = (u32x4){w[4], w[5], w[6], w[7]};
    }
    __syncthreads();
}

constexpr int SC_KT = 0, SC_SB = 36864, SC_SPITCH = 132;
__device__ __forceinline__ unsigned pk_f16(float a, float b) { return __builtin_bit_cast(unsigned, __builtin_amdgcn_cvt_pkrtz(a, b)); }
__device__ __forceinline__ void score_flush(LAS unsigned char* lds, unsigned short* SCORES, int t0, int kt, int tid) {
    const LAS float* sb = (const LAS float*)(lds + SC_SB + (kt & 1) * (32 * SC_SPITCH * 4));
    const int row = tid >> 4, seg = tid & 15;
    const f32x4 a = *(const LAS f32x4*)(sb + row * SC_SPITCH + seg * 8), b = *(const LAS f32x4*)(sb + row * SC_SPITCH + seg * 8 + 4);
    unsigned short* dst = SCORES + (size_t)(t0 + row) * S + kt * 128 + seg * 8;
    *(u32x4*)dst = (u32x4){pk_f16(a[0], a[1]), pk_f16(a[2], a[3]), pk_f16(b[0], b[1]), pk_f16(b[2], b[3])};
}
__device__ __forceinline__ void score_block(LAS unsigned char* lds, const bf16_t* PROJ, const bf16_t* KI, unsigned short* SCORES, int qb, int tid, int wave, int lane) {
    const int t0 = qb * 32, nkt = (t0 >> 7) + 1;
    const int r = lane & 31, hh = lane >> 5;
    bf16x8 Af[2][4]; float wv[2][16]; f32x2 wv2[2][8];
#pragma unroll
    for (int p = 0; p < 2; ++p) {
        const int tq = t0 + 4 * wave + 2 * p + (r >> 4); const bf16_t* qrow = PROJ + (size_t)tq * DINP + CQI + (r & 15) * 64 + 8 * hh;
#pragma unroll
        for (int ks = 0; ks < 4; ++ks) Af[p][ks] = *(const bf16x8*)(qrow + 16 * ks);
#pragma unroll
        for (int reg = 0; reg < 16; ++reg) { const int row = (reg & 3) + 8 * (reg >> 2) + 4 * hh; const int tw = t0 + 4 * wave + 2 * p + (row >> 4);
            wv[p][reg] = bf2f(PROJ[(size_t)tw * DINP + CWI + (row & 15)]) * (1.0f / 32.0f); }
#pragma unroll
        for (int i = 0; i < 8; ++i) wv2[p][i] = (f32x2){wv[p][2 * i], wv[p][2 * i + 1]};
    }
    const u32x2 tagsw = __builtin_amdgcn_permlane32_swap(0u, 1u, false, false); const int qsel = (int)tagsw[0];
    u32x4 stg[2];
#pragma unroll
    for (int i = 0; i < 2; ++i) { const int q = tid + 512 * i; stg[i] = *(const u32x4*)(KI + (size_t)(q >> 3) * 64 + (q & 7) * 8); }
#pragma unroll
    for (int i = 0; i < 2; ++i) { const int q = tid + 512 * i; *(LAS u32x4*)(lds + SC_KT + (q >> 3) * 144 + (q & 7) * 16) = stg[i]; }
    __syncthreads();
    for (int kt = 0; kt < nkt; ++kt) {
        const LAS unsigned char* buf = lds + SC_KT + (kt & 1) * 18432;
        LAS float* sb = (LAS float*)(lds + SC_SB + (kt & 1) * (32 * SC_SPITCH * 4));
        if (kt > 0) score_flush(lds, SCORES, t0, kt - 1, tid);
        if (kt + 1 < nkt) {
#pragma unroll
            for (int i = 0; i < 2; ++i) { const int q = tid + 512 * i; stg[i] = *(const u32x4*)(KI + (size_t)((kt + 1) * 128 + (q >> 3)) * 64 + (q & 7) * 8); }
        }
        for (int rep2 = 0; rep2 < ((MK_REP2) & 1) + 1; ++rep2) {
        f32x16 accP[2], accC[2];
#define SC_MFMA(cb) do { bf16x8 Bf[4]; _Pragma("unroll") for (int ks = 0; ks < 4; ++ks) Bf[ks] = *(const LAS bf16x8*)(buf + (32 * (cb) + r) * 144 + (16 * ks + 8 * hh) * 2); \
            _Pragma("unroll") for (int p = 0; p < 2; ++p) { _Pragma("unroll") for (int i = 0; i < 16; ++i) accC[p][i] = 0.f; \
                _Pragma("unroll") for (int ks = 0; ks < 4; ++ks) accC[p] = __builtin_amdgcn_mfma_f32_32x32x16_bf16(Af[p][ks], Bf[ks], accC[p], 0, 0, 0); } } while (0)
#define SC_RED(acc, cb) do { _Pragma("unroll") for (int p = 0; p < 2; ++p) { f32x2 s0 = {0.f, 0.f}, s1 = {0.f, 0.f}; \
            _Pragma("unroll") for (int reg = 0; reg < 8; reg += 2) { const f32x2 r0 = {relu_i(acc[p][reg]), relu_i(acc[p][reg + 1])}; const f32x2 r1 = {relu_i(acc[p][reg + 8]), relu_i(acc[p][reg + 9])}; \
                s0 = __builtin_elementwise_fma(wv2[p][reg >> 1], r0, s0); s1 = __builtin_elementwise_fma(wv2[p][4 + (reg >> 1)], r1, s1); } \
            const float p0 = s0[0] + s0[1], p1 = s1[0] + s1[1]; \
            const u32x2 sw = __builtin_amdgcn_permlane32_swap(__float_as_uint(p0), __float_as_uint(p1), false, false); \
            sb[(4 * wave + 2 * p + qsel) * SC_SPITCH + 32 * (cb) + r] = __uint_as_float(sw[0]) + __uint_as_float(sw[1]); } } while (0)
#define SC_INTERLEAVE() do { _Pragma("unroll") for (int i = 0; i < 8; ++i) { __builtin_amdgcn_sched_group_barrier(0x008, 1, 0); __builtin_amdgcn_sched_group_barrier(0x002, 8, 0); } } while (0)
        SC_MFMA(0);
        accP[0] = accC[0]; accP[1] = accC[1]; SC_MFMA(1); SC_RED(accP, 0); SC_INTERLEAVE();
        accP[0] = accC[0]; accP[1] = accC[1]; SC_MFMA(2); SC_RED(accP, 1); SC_INTERLEAVE();
        accP[0] = accC[0]; accP[1] = accC[1]; SC_MFMA(3); SC_RED(accP, 2); SC_INTERLEAVE();
        SC_RED(accC, 3);
#undef SC_MFMA
#undef SC_RED
#undef SC_INTERLEAVE
        }
        if (kt + 1 < nkt) {
#pragma unroll
            for (int i = 0; i < 2; ++i) { const int q = tid + 512 * i; *(LAS u32x4*)(lds + SC_KT + ((kt + 1) & 1) * 18432 + (q >> 3) * 144 + (q & 7) * 16) = stg[i]; }
        }
        __syncthreads();
    }
    score_flush(lds, SCORES, t0, nkt - 1, tid);
    __syncthreads();
}

__device__ __forceinline__ float wave_kth16(const float (&v)[16], int K) {
    const float NINF = -__builtin_inff();
    float mx = NINF, mn = __builtin_inff();
#pragma unroll
    for (int j = 0; j < 16; ++j) { mx = fmaxf(mx, v[j]); mn = fminf(mn, v[j] == NINF ? __builtin_inff() : v[j]); }
    mx = wave_max(mx); mn = -wave_max(-mn);
    int c = 0;
#pragma unroll
    for (int j = 0; j < 16; ++j) c += __popcll(__ballot(v[j] >= mx));
    if (c >= K) return mx;
    float lo = mn, hi = mx, tau = mn;
    for (int it = 0; it < 64; ++it) {
        const float mid = 0.5f * (lo + hi);
        if (!(mid > lo && mid < hi)) { tau = lo; break; }
        c = 0;
#pragma unroll
        for (int j = 0; j < 16; ++j) c += __popcll(__ballot(v[j] >= mid));
        if (c == K) { tau = mid; break; }
        if (c > K) lo = mid; else hi = mid;
        tau = lo;
    }
    return tau;
}
__device__ __forceinline__ int lanes_below(unsigned long long mask) { return (int)__builtin_amdgcn_mbcnt_hi((unsigned)(mask >> 32), __builtin_amdgcn_mbcnt_lo((unsigned)mask, 0u)); }
__device__ __forceinline__ float h2f(unsigned short h) { return (float)__builtin_bit_cast(_Float16, h); }
__device__ __forceinline__ float h2f_lo(unsigned u) { return h2f((unsigned short)(u & 0xffffu)); }
__device__ __forceinline__ float h2f_hi(unsigned u) { return h2f((unsigned short)(u >> 16)); }
__device__ __forceinline__ void select_row(LAS unsigned char* wl, const unsigned short* SCORES, int t, int lane) {
    LAS int* selw = (LAS int*)wl; LAS float* cval = (LAS float*)(wl + 1024); LAS int* cidx = (LAS int*)(wl + 5120);
    const float NINF = -__builtin_inff();
    const unsigned short* row = SCORES + (size_t)t * S; const int n = t + 1;
    float c[16]; int N;
    if (n <= 1024) {
#pragma unroll
        for (int j = 0; j < 16; ++j) { const int i = lane + 64 * j; c[j] = i < n ? h2f(row[i]) : NINF; }
        N = -1;
    } else {
        const int m = n >> 4; float s[16];
#pragma unroll
        for (int j = 0; j < 16; ++j) { const int i = lane + 64 * j; s[j] = i < m ? h2f(row[16 * i + 7]) : NINF; }
        int K = 32, cnt = 0;
        for (;;) {
            const float tlo = (K >= m) ? NINF : wave_kth16(s, K);
            cnt = 0;
            const int nq = (n + 511) >> 9;
            if (tlo > 0.f) {
                const unsigned T16 = pk_f16(tlo, tlo);
                for (int q0 = 0; q0 < nq; q0 += 4) {
                    u32x4 v[4];
#pragma unroll
                    for (int u = 0; u < 4; ++u) { const int e = 8 * (lane + 64 * (q0 + u)); v[u] = (e <= t) ? *(const u32x4*)(row + e) : (u32x4){0xfc00fc00u, 0xfc00fc00u, 0xfc00fc00u, 0xfc00fc00u}; }
#pragma unroll
                    for (int u = 0; u < 4; ++u) { const int e = 8 * (lane + 64 * (q0 + u));
                        unsigned m8 = 0;
#pragma unroll
                        for (int w = 0; w < 4; ++w) { const unsigned vw_ = v[u][w];
                            const s16x2 d = __builtin_elementwise_sub_sat(__builtin_bit_cast(s16x2, vw_), __builtin_bit_cast(s16x2, T16));
                            const unsigned mm = ~__builtin_bit_cast(unsigned, d); m8 |= (((mm >> 15) & 1u) | ((mm >> 30) & 2u)) << (2 * w); }
                        const int nv = t + 1 - e; if (nv < 8) m8 &= nv > 0 ? ((1u << nv) - 1u) : 0u;
                        for (;;) { const bool has = m8 != 0u; const unsigned long long mask = __ballot(has); if (!mask) break;
                            const int pos = cnt + lanes_below(mask);
                            if (has) { const int k = __builtin_ctz(m8); m8 &= m8 - 1u; if (pos < 1024) cidx[pos] = e + k; }
                            cnt += __popcll(mask); } }
                }
            } else {
                for (int q0 = 0; q0 < nq; q0 += 4) {
                    u32x4 v[4];
#pragma unroll
                    for (int u = 0; u < 4; ++u) { const int e = 8 * (lane + 64 * (q0 + u)); v[u] = (e <= t) ? *(const u32x4*)(row + e) : (u32x4){0xfc00fc00u, 0xfc00fc00u, 0xfc00fc00u, 0xfc00fc00u}; }
#pragma unroll
                    for (int u = 0; u < 4; ++u) { const int e = 8 * (lane + 64 * (q0 + u));
#pragma unroll
                        for (int k = 0; k < 8; ++k) { const float x = (k & 1) ? h2f_hi(v[u][k >> 1]) : h2f_lo(v[u][k >> 1]);
                            const bool pred = (e + k <= t) && (x >= tlo); const unsigned long long mask = __ballot(pred);
                            if (mask) { const int pos = cnt + lanes_below(mask); if (pred && pos < 1024) cidx[pos] = e + k; cnt += __popcll(mask); } } }
                }
            }
            if (cnt >= 256 || K >= m) break;
            K *= 2;
        }
        N = cnt < 1024 ? cnt : 1024;
#pragma unroll
        for (int j = 0; j < 16; ++j) { const int i = lane + 64 * j; c[j] = i < N ? h2f(row[cidx[i]]) : NINF; }
    }
    const float tau = wave_kth16(c, 256);
    int base = 0;
#pragma unroll
    for (int j = 0; j < 16; ++j) { const bool pred = c[j] >= tau; const unsigned long long mask = __ballot(pred);
        if (mask) { const int pos = base + lanes_below(mask); if (pred && pos < 256) selw[pos] = (N < 0) ? (lane + 64 * j) : cidx[lane + 64 * j]; base += __popcll(mask); } }
}

__device__ __forceinline__ void attn_query(LAS unsigned char* wl, const bf16_t* PROJ, const bf16_t* KC, const bf16_t* VC, bf16_t* ATT, int t, int lane) {
    LAS int* selw = (LAS int*)wl; LAS float* L = (LAS float*)(wl + 1024);
    const int nsel = t < 255 ? t + 1 : 256;
    const int fr = lane & 15, fq = lane >> 4;
    bf16x8 qf[2][4];
#pragma unroll
    for (int g = 0; g < 2; ++g)
#pragma unroll
        for (int ks = 0; ks < 4; ++ks) { const bf16x8 z = {0, 0, 0, 0, 0, 0, 0, 0}; qf[g][ks] = fr < 4 ? *(const bf16x8*)(PROJ + (size_t)t * DINP + CQ + (4 * g + fr) * 128 + 64 * (ks >> 1) + 16 * fq + 8 * (ks & 1)) : z; }
    const float scale = 0.08838834764831845f;
    const int nkt = (nsel + 15) >> 4;
    {
        LAS unsigned char* KT = wl + 9216;
        const int half_ = lane >> 5, l31_ = lane & 31;
        u32x4 kw[3][8];
#define QK_LOAD(buf, kt) do { _Pragma("unroll") for (int u = 0; u < 8; ++u) { const unsigned off_ = (unsigned)selw[16 * (kt) + 2 * u + half_] * 512u + 16u * (unsigned)l31_; kw[buf][u] = *(const u32x4*)((const char*)KC + off_); } } while (0)
#define QK_COMP(buf, kt) do { _Pragma("unroll") for (int u = 0; u < 8; ++u) *(LAS u32x4*)(KT + (2 * u + half_) * 528 + 16 * l31_) = kw[buf][u]; \
        _Pragma("unroll") for (int g = 0; g < 2; ++g) { f32x4 acc = (f32x4){0.f, 0.f, 0.f, 0.f}; \
            _Pragma("unroll") for (int ks = 0; ks < 4; ++ks) { const bf16x8 kf_ = *(const LAS bf16x8*)(KT + fr * 528 + g * 256 + (64 * (ks >> 1) + 16 * fq + 8 * (ks & 1)) * 2); \
                acc = __builtin_amdgcn_mfma_f32_16x16x32_bf16(qf[g][ks], kf_, acc, 0, 0, 0); } \
            if (fq == 0) { _Pragma("unroll") for (int r = 0; r < 4; ++r) L[(4 * g + r) * 256 + 16 * (kt) + fr] = (16 * (kt) + fr < nsel) ? acc[r] * scale : -__builtin_inff(); } } } while (0)
        QK_LOAD(0, 0); if (1 < nkt) QK_LOAD(1, 1);
        for (int kt = 0; kt < nkt; kt += 3) {
            if (kt + 2 < nkt) QK_LOAD(2, kt + 2);
            __builtin_amdgcn_sched_barrier(0);
            QK_COMP(0, kt);
            if (kt + 1 < nkt) { if (kt + 3 < nkt) QK_LOAD(0, kt + 3); __builtin_amdgcn_sched_barrier(0); QK_COMP(1, kt + 1); }
            if (kt + 2 < nkt) { if (kt + 4 < nkt) QK_LOAD(1, kt + 4); __builtin_amdgcn_sched_barrier(0); QK_COMP(2, kt + 2); }
        }
#undef QK_LOAD
#undef QK_COMP
        if (fq == 0) { for (int kt = nkt; kt < 16; ++kt) {
#pragma unroll
            for (int r = 0; r < 8; ++r) L[r * 256 + 16 * kt + fr] = -__builtin_inff(); } }
    }
    float p[8][4];
#pragma unroll
    for (int hd = 0; hd < 8; ++hd) { float m = -__builtin_inff();
#pragma unroll
        for (int i = 0; i < 4; ++i) { p[hd][i] = L[hd * 256 + lane + 64 * i]; m = fmaxf(m, p[hd][i]); }
        m = wave_max(m); float s = 0.f;
#pragma unroll
        for (int i = 0; i < 4; ++i) { p[hd][i] = __expf(p[hd][i] - m); s += p[hd][i]; }
        s = 1.0f / wave_sum(s);
#pragma unroll
        for (int i = 0; i < 4; ++i) p[hd][i] *= s; }
    LAS bf16_t* Pb = (LAS bf16_t*)(wl + 1024);
#pragma unroll
    for (int hd = 0; hd < 8; ++hd)
#pragma unroll
        for (int i = 0; i < 4; ++i) Pb[hd * 256 + lane + 64 * i] = f2bf(p[hd][i]);
    LAS unsigned char* VT = wl + 9216;
    const int half = lane >> 5, l31 = lane & 31, ii = lane & 15, kq = lane >> 4;
    f32x4 acc[16];
#pragma unroll
    for (int nt = 0; nt < 16; ++nt) acc[nt] = (f32x4){0.f, 0.f, 0.f, 0.f};
    const int nch = (nsel + 15) >> 4;
    u32x4 vw[3][8];
#define PV_LOAD(buf, c) do { _Pragma("unroll") for (int u = 0; u < 8; ++u) { const unsigned off_ = (unsigned)selw[16 * (c) + 2 * u + half] * 512u + 16u * (unsigned)l31; vw[buf][u] = *(const u32x4*)((const char*)VC + off_); } } while (0)
#define PV_COMP(buf, c) do { _Pragma("unroll") for (int u = 0; u < 8; ++u) *(LAS u32x4*)(VT + (2 * u + half) * 528 + 16 * l31) = vw[buf][u]; \
        s16x4 pa[2]; _Pragma("unroll") for (int g = 0; g < 2; ++g) { const s16x4 r_ = *(const LAS s16x4*)(Pb + (g * 4 + (ii & 3)) * 256 + 16 * (c) + 4 * kq); pa[g] = ii < 4 ? r_ : (s16x4){0, 0, 0, 0}; } \
        _Pragma("unroll") for (int nt = 0; nt < 16; ++nt) { const s16x4 b_ = __builtin_amdgcn_ds_read_tr16_b64_v4i16((LAS s16x4*)(VT + (4 * kq + (ii >> 2)) * 528 + (16 * nt + 4 * (ii & 3)) * 2)); \
            acc[nt] = __builtin_amdgcn_mfma_f32_16x16x16bf16_1k(pa[nt >> 3], b_, acc[nt], 0, 0, 0); } } while (0)
    PV_LOAD(0, 0); if (1 < nch) PV_LOAD(1, 1);
    for (int c = 0; c < nch; c += 3) {
        if (c + 2 < nch) PV_LOAD(2, c + 2);
        __builtin_amdgcn_sched_barrier(0);
        PV_COMP(0, c);
        if (c + 1 < nch) { if (c + 3 < nch) PV_LOAD(0, c + 3); __builtin_amdgcn_sched_barrier(0); PV_COMP(1, c + 1); }
        if (c + 2 < nch) { if (c + 4 < nch) PV_LOAD(1, c + 4); __builtin_amdgcn_sched_barrier(0); PV_COMP(2, c + 2); }
    }
#undef PV_LOAD
#undef PV_COMP
    LAS float* OB = (LAS float*)(wl + 1024 + 4096);
    if (kq == 0) {
#pragma unroll
        for (int nt = 0; nt < 16; ++nt)
#pragma unroll
            for (int r = 0; r < 4; ++r) OB[(4 * (nt >> 3) + r) * 128 + 16 * (nt & 7) + ii] = acc[nt][r];
    }
    {
        const f32x4 a0 = *(const LAS f32x4*)(OB + 16 * lane), a1 = *(const LAS f32x4*)(OB + 16 * lane + 4), a2 = *(const LAS f32x4*)(OB + 16 * lane + 8), a3 = *(const LAS f32x4*)(OB + 16 * lane + 12);
        u32x4 w0, w1; w0.x = cvt_pk_bf16(a0[0], a0[1]); w0.y = cvt_pk_bf16(a0[2], a0[3]); w0.z = cvt_pk_bf16(a1[0], a1[1]); w0.w = cvt_pk_bf16(a1[2], a1[3]);
        w1.x = cvt_pk_bf16(a2[0], a2[1]); w1.y = cvt_pk_bf16(a2[2], a2[3]); w1.z = cvt_pk_bf16(a3[0], a3[1]); w1.w = cvt_pk_bf16(a3[2], a3[3]);
        u32x4* dst = (u32x4*)(ATT + (size_t)t * 1024 + 16 * lane); dst[0] = w0; dst[1] = w1;
    }
}


__device__ __forceinline__ void convert_item8(const float* __restrict__ W, int K, int N, int ld, unsigned char* WT, int mode, int item, int lane, LAS unsigned char* scr) {
    const int nblk = N >> 6; const int kb = item / nblk, nb = item - kb * nblk; const int k0 = kb * 256, n0 = nb * 64;
    const int c4 = lane & 15, kr = lane >> 4;
    const float* src = W + (size_t)(k0 + 4 * kr) * ld + n0 + 4 * c4;
#pragma unroll 4
    for (int i = 0; i < 16; ++i) {
        f32x4 v[4];
#pragma unroll
        for (int r = 0; r < 4; ++r) v[r] = __builtin_nontemporal_load((const f32x4*)(src + (size_t)(16 * i + r) * ld));
        const int kk = 16 * i + 4 * kr;
#pragma unroll
        for (int e = 0; e < 4; ++e) *(LAS unsigned*)(scr + (4 * c4 + e) * 272 + kk) = pack4_fp8(v[0][e] * W8_SCALE, v[1][e] * W8_SCALE, v[2][e] * W8_SCALE, v[3][e] * W8_SCALE);
    }
    LDS_WAIT(); asm volatile("" ::: "memory");
#pragma unroll 4
    for (int j = 0; j < 16; ++j) {
        const int q = j * 64 + lane, n = q >> 4, ch = q & 15;
        const u32x4 v = *(const LAS u32x4*)(scr + n * 272 + ch * 16);
        *(u32x4*)(WT + (size_t)dest_row(mode, n0 + n) * K + k0 + ch * 16) = v;
    }
    LDS_WAIT(); asm volatile("" ::: "memory");
}

__global__ void __launch_bounds__(NTHR, 2) fwd_kernel(Args args) {
    extern __shared__ __attribute__((aligned(16))) unsigned char lds_raw[];
    LAS unsigned char* lds = (LAS unsigned char*)lds_raw;
    volatile LAS unsigned* MISC = (volatile LAS unsigned*)(lds + LDS_MISC);
    const int tid = threadIdx.x, lane = tid & 63, wave = __builtin_amdgcn_readfirstlane(tid >> 6);
    const int G = gridDim.x, wg = blockIdx.x;
    unsigned char* ws = args.ws;
    unsigned* ctl = (unsigned*)(ws + WS_CTL);
    const int lo = args.ph_lo, hi = args.ph_hi, flags = args.flags;
    const float* x = (const float*)args.in[0]; const float* cvec = (const float*)args.in[1]; const int* positions = (const int*)args.in[2];
    const float* w_ada = (const float*)args.in[3]; const float* b_ada = (const float*)args.in[4]; const float* norm1_g = (const float*)args.in[5];
    const float* w_in = (const float*)args.in[6]; const float* idx_knorm_g = (const float*)args.in[7]; const float* idx_knorm_b = (const float*)args.in[8];
    const float* lb_logits = (const float*)args.in[9]; const float* hgrn_norm_g = (const float*)args.in[10];
    const float* w_proj_att = (const float*)args.in[11]; const float* w_proj_hgrn = (const float*)args.in[12]; const float* w_out = (const float*)args.in[13];
    const float* norm2_g = (const float*)args.in[14]; const float* w_router = (const float*)args.in[15]; const float* b_router = (const float*)args.in[16];
    const float* w1 = (const float*)args.in[17]; const float* b1 = (const float*)args.in[18]; const float* w2 = (const float*)args.in[19]; const float* b2 = (const float*)args.in[20];
    const float* final_g = (const float*)args.in[21];
    float* out = args.out;
    float* MOD = (float*)(ws + WS_MOD); int* TOPE = (int*)(ws + WS_TOPE); float* GATE = (float*)(ws + WS_GATE); int* SLOT = (int*)(ws + WS_SLOT);
    bf16_t* WIN_T = (bf16_t*)(ws + WS_WIN_T); bf16_t* WA_T = (bf16_t*)(ws + WS_WA_T); bf16_t* WH_T = (bf16_t*)(ws + WS_WH_T); bf16_t* WO_T = (bf16_t*)(ws + WS_WO_T);
    unsigned char* WIN_T8 = ws + WS_WIN_T + 8 * MiB;
    unsigned char* HA8 = ws + WS_SCORES;
    unsigned char* W1_T = ws + WS_W1_T; unsigned char* W2_T = ws + WS_W2_T;
    bf16_t* HB = (bf16_t*)(ws + WS_H); bf16_t* PROJ = (bf16_t*)(ws + WS_PROJ);
    float* X1 = (float*)(ws + WS_X1);
    unsigned char* XB = ws + WS_XB; unsigned char* ACT = ws + WS_ACT; bf16_t* YB = (bf16_t*)(ws + WS_YB);
    int* TOKS = (int*)(ws + WS_TOKS);
    unsigned char* H8 = ws + WS_H;
    bf16_t* KI = (bf16_t*)(ws + WS_KI); bf16_t* KC = (bf16_t*)(ws + WS_KC); bf16_t* VC = (bf16_t*)(ws + WS_VC);
    float* ST = (float*)(ws + WS_ST); float* DC = (float*)(ws + WS_DC); int* SEL = (int*)(ws + WS_SEL);
    bf16_t* ATT = (bf16_t*)(ws + WS_ATT); bf16_t* REC = (bf16_t*)(ws + WS_REC); bf16_t* MERGED = (bf16_t*)(ws + WS_MERGED); unsigned short* SCORES = (unsigned short*)(ws + WS_SCORES);

    for (int u = tid; u < 128; u += NTHR) MISC[u] = 0u;
    __syncthreads();
    const bool one_launch = (hi - lo) > 1;
    XcdBarrier bar; bar.bar = ctl + CW_BAR; bar.x = 0; bar.st = MISC + 8;
    if (one_launch) bar = xcd_barrier_post(ctl + CW_BAR, MISC + 8);
#define IN(k) (lo <= (k) && (k) < hi)
#define NREP(k) ((((MK_REP) >> (k)) & 1) + 1)
#define SEAM(k) do { if (IN(k) && IN((k) + 1)) xcd_barrier(bar); } while (0)

    const float* x1src = (flags & FLAG_MIXER) ? (const float*)X1 : x;

    if (IN(PH_PRO)) {
        for (int cb = wg; cb < 256; cb += G) {
            LAS float* red = (LAS float*)lds;
            const int c4 = tid % 12, kg = tid / 12;
            f32x4 acc = (f32x4){0.f, 0.f, 0.f, 0.f};
            if (kg < 42) {
                const float* wp = w_ada + (size_t)cb * 48 + 4 * c4;
#pragma unroll 7
                for (int j = 0; j < 49; ++j) { const int k = kg + 42 * j; if (k < D) { const f32x4 v = __builtin_nontemporal_load((const f32x4*)(wp + (size_t)k * (6 * D))); acc += siluf_(cvec[k]) * v; } }
                *(LAS f32x4*)(red + kg * 48 + 4 * c4) = acc;
            }
            __syncthreads();
            if (tid < 48) { float s = b_ada[cb * 48 + tid];
#pragma unroll 6
                for (int q = 0; q < 42; ++q) s += red[q * 48 + tid];
                MOD[cb * 48 + tid] = s; }
            __syncthreads();
        }
        LAS unsigned char* scr = lds + wave * 17408;
        const int gw = wg * NWAVES + wave, NGW = G * NWAVES;
        for (int rep = 0; rep < NREP(PH_PRO); ++rep) {
        if (flags & FLAG_MIXER) {
            constexpr int NB_IN = (1104 + 63) / 64;
            for (int it = gw; it < 16 * NB_IN; it += NGW) convert_item(w_in + 1536, 2048, 1104, DIN, WIN_T, 0, it, lane, scr);
            for (int it = gw; it < 8 * 32; it += NGW) convert_item(w_proj_att, 1024, 2048, 2048, WA_T, 0, it, lane, scr);
            for (int it = gw; it < 8 * 32; it += NGW) convert_item(w_proj_hgrn, 1024, 2048, 2048, WH_T, 0, it, lane, scr);
            for (int it = gw; it < 16 * 32; it += NGW) convert_item(w_out, 2048, 2048, 2048, WO_T, 0, it, lane, scr);
            for (int it = gw; it < 8 * 24; it += NGW) convert_item8(w_in, 2048, 1536, DIN, WIN_T8, 0, it, lane, scr);
            for (int it = gw; it < 8 * 128; it += NGW) convert_item8(w_in + 2640, 2048, 8192, DIN, WIN_T8 + (size_t)1536 * 2048, 0, it, lane, scr);
            for (size_t i = (size_t)wg * NTHR + tid; i < (size_t)176 * 2048 * 2 / 16; i += (size_t)G * NTHR) ((u32x4*)(WIN_T + (size_t)1104 * 2048))[i] = (u32x4){0u, 0u, 0u, 0u};
        }
        if (flags & FLAG_MOE) {
            constexpr int I1 = (2048 / 256) * (4096 / 64), I2 = (2048 / 256) * (2048 / 64);
            for (int it = gw; it < NEXP * I1; it += NGW) { const int e = it / I1, r = it - e * I1; convert_item8(w1 + (size_t)e * 2048 * 4096, 2048, 4096, 4096, W1_T + (size_t)e * 4096 * 2048, 2, r, lane, scr); }
            for (int it = gw; it < NEXP * I2; it += NGW) { const int e = it / I2, r = it - e * I2; convert_item8(w2 + (size_t)e * 2048 * 2048, 2048, 2048, 2048, W2_T + (size_t)e * 2048 * 2048, 0, r, lane, scr); }
        }
        }
    }
    SEAM(PH_PRO);

    if (flags & FLAG_MIXER) {
    if (IN(PH_H)) {
        const float* sh1 = MOD; const float* sc1 = MOD + D;
        const int gw = wg * NWAVES + wave, NGW = G * NWAVES;
        f32x4 gs[8], sh[8];
#pragma unroll
        for (int j = 0; j < 8; ++j) { const int c = 4 * lane + 256 * j; const f32x4 g = *(const f32x4*)(norm1_g + c), sc = *(const f32x4*)(sc1 + c); sh[j] = *(const f32x4*)(sh1 + c);
#pragma unroll
            for (int e = 0; e < 4; ++e) gs[j][e] = g[e] * (1.0f + sc[e]); }
        for (int rep = 0; rep < NREP(PH_H); ++rep)
        for (int t = gw; t < S; t += NGW) {
            const f32x4* xr = (const f32x4*)(x + (size_t)t * D) + lane;
            f32x4 v[8]; float ss = 0.f;
#pragma unroll
            for (int j = 0; j < 8; ++j) { v[j] = xr[64 * j]; ss += (v[j][0] * v[j][0] + v[j][1] * v[j][1]) + (v[j][2] * v[j][2] + v[j][3] * v[j][3]); }
            const float rstd = rsqrtf(wave_sum(ss) * (1.0f / D) + NORM_EPS);
#pragma unroll
            for (int j = 0; j < 8; ++j) { const f32x4 h = v[j] * rstd * gs[j] + sh[j]; u32x2 w; w.x = cvt_pk_bf16(h[0], h[1]); w.y = cvt_pk_bf16(h[2], h[3]);
                *(u32x2*)(HB + (size_t)t * D + 4 * lane + 256 * j) = w;
                *(unsigned*)(HA8 + (size_t)t * D + 4 * lane + 256 * j) = pack4_fp8(h[0], h[1], h[2], h[3]); }
        }
    }
    SEAM(PH_H);
    if (IN(PH_INPROJ)) for (int rep = 0; rep < NREP(PH_INPROJ); ++rep) {
        {
            pg8::Gemm g8{HA8, WIN_T8, 2048, 0, nullptr}; pg8::StaticOrder S8; S8.init(S, 9728, G, wg);
            pg8::EpiBf16 E8{PROJ, DINP, nullptr, 0, 1.0f / W8_SCALE, 6, 1280};
            pg8::gemm_phase<pg8::EpiBf16, pg8::StaticOrder, true>(lds, g8, S8, E8);
        }
        {
            pg8::Gemm g{HB, WIN_T, 2048, 0, nullptr}; pg8::StaticOrder So; So.init(S, 1280, G, (wg + 128) % G);
            pg8::EpiBf16 E{PROJ + CQI, DINP, nullptr, 0, 1.0f, 1 << 30, 0};
            pg8::gemm_phase<pg8::EpiBf16, pg8::StaticOrder>(lds, g, So, E);
        }
    }
    SEAM(PH_INPROJ);
    if (IN(PH_POST)) {
        const int gw = wg * NWAVES + wave, NGW = G * NWAVES;
        for (int t = gw; t < S; t += NGW) post_token(PROJ, KI, KC, VC, positions, idx_knorm_g, idx_knorm_b, t, lane);
        __syncthreads();
        for (int rep = 0; rep < NREP(PH_POST); ++rep)
        for (int u = wg; u < 2048; u += G) hgrn_l1(lds, PROJ, lb_logits, ST, DC, u >> 3, u & 7, tid, wave, lane);
    }
    SEAM(PH_POST);
    if (IN(PH_SCORE)) {
        for (int idx = wg * NTHR + tid; idx < 8 * 128 * 128; idx += G * NTHR) {
            const int h = idx >> 14, d = idx & 127; float s = 0.f;
            float* sp = ST + idx; const float* dp = DC + h * 128 + d;
            for (int c = 0; c < 256; c += 8) {
                float l[8], dc[8];
#pragma unroll
                for (int i = 0; i < 8; ++i) { l[i] = sp[(size_t)(c + i) * 131072]; dc[i] = dp[(size_t)(c + i) * 1024]; }
#pragma unroll
                for (int i = 0; i < 8; ++i) { sp[(size_t)(c + i) * 131072] = s; s = dc[i] * s + l[i]; }
            }
        }
        if (flags & FLAG_ATT) for (int rep = 0; rep < NREP(PH_SCORE); ++rep) {
            for (int j = wg; j < 252; j += G) { score_block(lds, PROJ, KI, SCORES, 8 + j, tid, wave, lane); score_block(lds, PROJ, KI, SCORES, 511 - j, tid, wave, lane); }
        }
    }
    SEAM(PH_SCORE);
    if (IN(PH_ATTN)) {
        const int gw = wg * NWAVES + wave, NGW = G * NWAVES;
        for (int rep = 0; rep < NREP(PH_SELECT); ++rep)
        for (int u = wg; u < 2048; u += G) hgrn_l3(lds, PROJ, lb_logits, ST, hgrn_norm_g, REC, u >> 3, u & 7, tid, wave, lane);
        if (flags & FLAG_ATT) for (int rep = 0; rep < NREP(PH_ATTN); ++rep) {
            for (int t = gw; t < S; t += NGW) {
                LAS unsigned char* wl = lds + wave * 17664;
                if (t >= 256) { for (int rep2 = 0; rep2 < (((MK_REP2) >> 1) & 1) + 1; ++rep2) select_row(wl, SCORES, t, lane); }
                else {
#pragma unroll
                    for (int i = 0; i < 4; ++i) { const int idx = lane + 64 * i; ((LAS int*)wl)[idx] = idx <= t ? idx : 0; }
                }
                for (int rep2 = 0; rep2 < (((MK_REP2) >> 2) & 1) + 1; ++rep2) attn_query(wl, PROJ, KC, VC, ATT, t, lane);
            }
        } else {
            for (size_t i = (size_t)wg * NTHR + tid; i < (size_t)S * 1024 * 2 / 16; i += (size_t)G * NTHR) ((u32x4*)ATT)[i] = (u32x4){0u, 0u, 0u, 0u};
        }
    }
    SEAM(PH_ATTN);
    if (IN(PH_OP1)) {
        pg8::Gemm g{ATT, WA_T, 1024, 0, nullptr}; pg8::StaticOrder So; So.init(S, 2048, G, wg);
        pg8::EpiGate E{MERGED, PROJ + CGA, 0};
        pg8::gemm_phase<pg8::EpiGate, pg8::StaticOrder>(lds, g, So, E);
    }
    if (IN(PH_OP1) && IN(PH_OP2)) { VM_WAIT(); __syncthreads(); }
    if (IN(PH_OP2)) {
        pg8::Gemm g{REC, WH_T, 1024, 0, nullptr}; pg8::StaticOrder So; So.init(S, 2048, G, wg);
        pg8::EpiGate E{MERGED, PROJ + CGR, 1};
        pg8::gemm_phase<pg8::EpiGate, pg8::StaticOrder>(lds, g, So, E);
    }
    SEAM(PH_OP2);
    if (IN(PH_WOUT)) {
        pg8::Gemm g{MERGED, WO_T, 2048, 0, nullptr}; pg8::StaticOrder So; So.init(S, 2048, G, wg);
        pg8::EpiResid E{x, MOD + 2 * D, X1};
        pg8::gemm_phase<pg8::EpiResid, pg8::StaticOrder>(lds, g, So, E);
    }
    SEAM(PH_WOUT);
    }

    if (IN(PH_ROUTER) && (flags & FLAG_MOE)) {
        LAS float* hs = (LAS float*)lds;
        volatile LAS unsigned* lcnt = MISC + 32;
        const float* sh2 = MOD + 3 * D; const float* sc2 = MOD + 4 * D;
        if (tid < 32) lcnt[tid] = 0u;
        __syncthreads();
        for (int grp = wg; grp < S / 16; grp += G) {
#pragma unroll 1
            for (int q = 0; q < 2; ++q) {
                const int tl = 2 * wave + q, t = grp * 16 + tl;
                const f32x4* xr = (const f32x4*)(x1src + (size_t)t * D) + lane;
                f32x4 v[8]; float ss = 0.f;
#pragma unroll
                for (int j = 0; j < 8; ++j) { v[j] = xr[64 * j]; ss += (v[j][0] * v[j][0] + v[j][1] * v[j][1]) + (v[j][2] * v[j][2] + v[j][3] * v[j][3]); }
                const float rstd = rsqrtf(wave_sum(ss) * (1.0f / D) + NORM_EPS);
#pragma unroll
                for (int j = 0; j < 8; ++j) {
                    const int c = 4 * lane + 256 * j;
                    const f32x4 g = *(const f32x4*)(norm2_g + c), sc = *(const f32x4*)(sc2 + c), sh = *(const f32x4*)(sh2 + c);
                    f32x4 h;
#pragma unroll
                    for (int e = 0; e < 4; ++e) h[e] = v[j][e] * rstd * g[e] * (1.0f + sc[e]) + sh[e];
                    *(LAS f32x4*)(hs + tl * 2048 + c) = h;
                    *(unsigned*)(H8 + (size_t)t * D + c) = pack4_fp8(h[0], h[1], h[2], h[3]);
                }
            }
            __syncthreads();
            {
                LAS float* part = (LAS float*)(lds + 131072);
                const int fr = lane & 15, fq = lane >> 4;
                f32x4 acc0 = (f32x4){0.f, 0.f, 0.f, 0.f}, acc1 = acc0;
                const LAS float* hrow = hs + fr * 2048 + wave * 256 + 4 * fq; const float* wrp = w_router + (size_t)(wave * 256 + 4 * fq) * 32 + fr;
#pragma unroll 2
                for (int i = 0; i < 16; ++i) {
                    const f32x4 a4 = *(const LAS f32x4*)(hrow + 16 * i);
                    float b0[4], b1[4];
#pragma unroll
                    for (int s = 0; s < 4; ++s) { b0[s] = wrp[(size_t)(16 * i + s) * 32]; b1[s] = wrp[(size_t)(16 * i + s) * 32 + 16]; }
#pragma unroll
                    for (int s = 0; s < 4; ++s) { acc0 = __builtin_amdgcn_mfma_f32_16x16x4f32(a4[s], b0[s], acc0, 0, 0, 0); acc1 = __builtin_amdgcn_mfma_f32_16x16x4f32(a4[s], b1[s], acc1, 0, 0, 0); }
                }
#pragma unroll
                for (int r = 0; r < 4; ++r) { part[(wave * 16 + 4 * fq + r) * 32 + fr] = acc0[r]; part[(wave * 16 + 4 * fq + r) * 32 + 16 + fr] = acc1[r]; }
                __syncthreads();
                const int tl = tid >> 5, e = tid & 31, t = grp * 16 + tl;
                float v = b_router[e];
#pragma unroll
                for (int w = 0; w < 8; ++w) v += part[(w * 16 + tl) * 32 + e];
                float tv[4]; int ti[4];
#pragma unroll
                for (int k = 0; k < 4; ++k) {
                    float bv = v; int bi = e;
#pragma unroll
                    for (int o = 16; o >= 1; o >>= 1) { const float ov = __shfl_xor(bv, o); const int oi = __shfl_xor(bi, o); if (ov > bv || (ov == bv && oi < bi)) { bv = ov; bi = oi; } }
                    tv[k] = bv; ti[k] = bi; if (e == bi) v = -__builtin_inff();
                }
                if (e == 0) {
                    const float e1 = __expf(tv[1] - tv[0]), e2 = __expf(tv[2] - tv[0]), e3 = __expf(tv[3] - tv[0]); const float inv = 1.0f / (1.0f + e1 + e2 + e3);
                    *(int4*)(TOPE + (size_t)t * 4) = make_int4(ti[0], ti[1], ti[2], ti[3]);
                    *(f32x4*)(GATE + (size_t)t * 4) = (f32x4){inv, e1 * inv, e2 * inv, e3 * inv};
#pragma unroll
                    for (int k = 0; k < 4; ++k) __hip_atomic_fetch_add((LAS unsigned*)&lcnt[ti[k]], 1u, __ATOMIC_RELAXED, __HIP_MEMORY_SCOPE_WORKGROUP);
                }
            }
            __syncthreads();
        }
        if (tid < 32) { const unsigned c = lcnt[tid]; if (c) __hip_atomic_fetch_add(ctl + CW_CNT + tid, c, __ATOMIC_RELAXED, __HIP_MEMORY_SCOPE_AGENT); }
    }
    SEAM(PH_ROUTER);

    if (IN(PH_SCATTER) && (flags & FLAG_MOE)) {
        volatile LAS unsigned* lcnt = MISC + 32; volatile LAS unsigned* lbase = MISC + 64; LAS int* pstart = (LAS int*)(lds + 1024); LAS int* pcnt = (LAS int*)(lds + 1280);
        if (tid == 0) { int p = 0; for (int e = 0; e < NEXP; ++e) { const int c = (int)__hip_atomic_load(ctl + CW_CNT + e, __ATOMIC_RELAXED, __HIP_MEMORY_SCOPE_AGENT); pstart[e] = p; pcnt[e] = c; p += (c + 255) & ~255; } }
        if (tid < 32) lcnt[tid] = 0u;
        __syncthreads();
        if (wg < NEXP) { const int e = wg; for (int s = pstart[e] + pcnt[e] + tid; s < pstart[e] + ((pcnt[e] + 255) & ~255); s += NTHR) TOKS[s] = 0; }
        for (int blk = wg; blk < S / 64; blk += G) {
            int e = 0, lrank = 0;
            if (tid < 256) { e = TOPE[(size_t)blk * 256 + tid]; lrank = (int)__hip_atomic_fetch_add((LAS unsigned*)&lcnt[e], 1u, __ATOMIC_RELAXED, __HIP_MEMORY_SCOPE_WORKGROUP); }
            __syncthreads();
            if (tid < 32) { const unsigned c = lcnt[tid]; lbase[tid] = c ? __hip_atomic_fetch_add(ctl + CW_FILL + tid, c, __ATOMIC_RELAXED, __HIP_MEMORY_SCOPE_AGENT) : 0u; }
            __syncthreads();
            if (tid < 256) { const int slot = pstart[e] + (int)lbase[e] + lrank; SLOT[(size_t)blk * 256 + tid] = slot; TOKS[slot] = blk * 64 + (tid >> 2); }
            __syncthreads();
            if (tid < 32) lcnt[tid] = 0u;
            __syncthreads();
        }
    }
    SEAM(PH_SCATTER);

    if ((IN(PH_MOE1) || IN(PH_MOE2)) && (flags & FLAG_MOE)) {
        LAS int* panel_e = (LAS int*)(lds + 131072 + 2048);
        LAS int* npan = (LAS int*)(lds + 131072 + 2048 + 2048);
        __syncthreads();
        if (tid == 0) { int p = 0; for (int e = 0; e < NEXP; ++e) { const int np = (int)((__hip_atomic_load(ctl + CW_CNT + e, __ATOMIC_RELAXED, __HIP_MEMORY_SCOPE_AGENT) + 255u) >> 8); for (int q = 0; q < np; ++q) panel_e[p + q] = e; p += np; } npan[0] = p; }
        __syncthreads();
        const int nPanels = npan[0];
        if (IN(PH_MOE1)) for (int rep = 0; rep < NREP(PH_MOE1); ++rep) {
            pg8::Gemm g{H8, W1_T, 2048, (size_t)4096 * 2048, TOKS}; pg8::MoeOrder So; So.init(nPanels, 16, G, wg, panel_e);
            pg8::EpiSwiglu E{ACT, b1};
            pg8::gemm_phase<pg8::EpiSwiglu, pg8::MoeOrder, true>(lds, g, So, E);
        }
        SEAM(PH_MOE1);
        if (IN(PH_MOE2)) for (int rep = 0; rep < NREP(PH_MOE2); ++rep) {
            pg8::Gemm g{ACT, W2_T, 2048, (size_t)2048 * 2048, nullptr}; pg8::MoeOrder So; So.init(nPanels, 8, G, wg, panel_e);
            pg8::EpiBf16 E{YB, 2048, b2, 2048, 1.0f / (W8_SCALE * ACT8_SCALE), 1 << 30, 0};
            pg8::gemm_phase<pg8::EpiBf16, pg8::MoeOrder, true>(lds, g, So, E);
        }
    }
    SEAM(PH_MOE2);

    if (IN(PH_FINAL)) {
        const float* gt2 = MOD + 5 * D;
        const int gw = wg * NWAVES + wave, NGW = G * NWAVES;
        for (int rep = 0; rep < NREP(PH_FINAL); ++rep)
        for (int t = gw; t < S; t += NGW) {
            const f32x4* xr = (const f32x4*)(x1src + (size_t)t * D) + lane;
            f32x4 v[8];
#pragma unroll
            for (int j = 0; j < 8; ++j) v[j] = xr[64 * j];
            if (flags & FLAG_MOE) {
                f32x4 m[8];
#pragma unroll
                for (int j = 0; j < 8; ++j) m[j] = (f32x4){0.f, 0.f, 0.f, 0.f};
                const int4 sl = *(const int4*)(SLOT + (size_t)t * 4); const f32x4 gt = *(const f32x4*)(GATE + (size_t)t * 4);
                const int sls[4] = {sl.x, sl.y, sl.z, sl.w};
#pragma unroll
                for (int k = 0; k < 4; ++k) {
                    const u32x2* yr = (const u32x2*)(YB + (size_t)sls[k] * D) + lane; const float gk = gt[k];
#pragma unroll
                    for (int j = 0; j < 8; ++j) { const u32x2 w = yr[64 * j]; m[j][0] += gk * bf_lo(w.x); m[j][1] += gk * bf_hi(w.x); m[j][2] += gk * bf_lo(w.y); m[j][3] += gk * bf_hi(w.y); }
                }
#pragma unroll
                for (int j = 0; j < 8; ++j) { const f32x4 g2 = *(const f32x4*)(gt2 + 4 * lane + 256 * j); v[j] = v[j] + g2 * m[j]; }
            }
            float ss = 0.f;
#pragma unroll
            for (int j = 0; j < 8; ++j) ss += (v[j][0] * v[j][0] + v[j][1] * v[j][1]) + (v[j][2] * v[j][2] + v[j][3] * v[j][3]);
            const float rstd = rsqrtf(wave_sum(ss) * (1.0f / D) + NORM_EPS);
            f32x4* orow = (f32x4*)(out + (size_t)t * D) + lane;
#pragma unroll
            for (int j = 0; j < 8; ++j) { const f32x4 fg = *(const f32x4*)(final_g + 4 * lane + 256 * j); orow[64 * j] = v[j] * rstd * fg; }
        }
    }
#undef IN
#undef SEAM
}

#ifndef MK_ONE_LAUNCH
#define MK_ONE_LAUNCH 1
#endif
#ifndef MK_FLAGS
#define MK_FLAGS (FLAG_MOE | FLAG_MIXER | FLAG_ATT)
#endif
extern "C" void kernel_launch(void* const* d_in, const int* in_sizes, int n_in, void* d_out, int out_size, void* d_ws, size_t ws_size, hipStream_t stream) {
    static int grid = 0;
    if (grid == 0) {
        if (n_in != 22 || out_size != S * D || ws_size < WS_END) { fprintf(stderr, "kernel_launch: unexpected shapes: n_in %d out %d ws %zu (need %zu)\n", n_in, out_size, ws_size, (size_t)WS_END); grid = -1; return; }
        int dev = 0, cus = 0, per_cu = 0;
        if (hipGetDevice(&dev) != hipSuccess || hipDeviceGetAttribute(&cus, hipDeviceAttributeMultiprocessorCount, dev) != hipSuccess) { grid = -1; return; }
        if (hipFuncSetAttribute((const void*)fwd_kernel, hipFuncAttributeMaxDynamicSharedMemorySize, LDS_BYTES) != hipSuccess) { fprintf(stderr, "kernel_launch: hipFuncSetAttribute failed\n"); grid = -1; return; }
        if (hipOccupancyMaxActiveBlocksPerMultiprocessor(&per_cu, (const void*)fwd_kernel, NTHR, LDS_BYTES) != hipSuccess || per_cu < 1) { fprintf(stderr, "kernel_launch: occupancy query says %d\n", per_cu); (void)hipGetLastError(); grid = -1; return; }
        grid = cus;
    }
    if (grid < 0) return;
    (void)in_sizes;
    hipMemsetAsync((char*)d_ws + WS_CTL, 0, CTL_BYTES, stream);
    Args a{};
    for (int i = 0; i < 22; ++i) a.in[i] = d_in[i];
    a.out = (float*)d_out; a.ws = (unsigned char*)d_ws; a.flags = MK_FLAGS; a.pad = 0;
#if MK_ONE_LAUNCH
    a.ph_lo = 0; a.ph_hi = NPH;
    hipLaunchKernelGGL(fwd_kernel, dim3(grid), dim3(NTHR), LDS_BYTES, stream, a);
#else
    for (int p = 0; p < NPH; ++p) { a.ph_lo = p; a.ph_hi = p + 1; hipLaunchKernelGGL(fwd_kernel, dim3(grid), dim3(NTHR), LDS_BYTES, stream, a); }
#endif
}
```

```cpp
#include <hip/hip_runtime.h>
#include <cstdio>
#include <cstdint>

#define GAS __attribute__((address_space(1)))
#define LAS __attribute__((address_space(3)))
typedef unsigned short bf16_t;
typedef short bf16x8 __attribute__((ext_vector_type(8)));
typedef float f32x4 __attribute__((ext_vector_type(4)));
typedef float f32x2 __attribute__((ext_vector_type(2)));
typedef float f32x16 __attribute__((ext_vector_type(16)));
typedef unsigned u32x4 __attribute__((ext_vector_type(4)));
typedef unsigned u32x2 __attribute__((ext_vector_type(2)));
typedef int i32x4 __attribute__((ext_vector_type(4)));
typedef int i32x8 __attribute__((ext_vector_type(8)));
typedef short s16x4 __attribute__((ext_vector_type(4)));
typedef short s16x2 __attribute__((ext_vector_type(2)));

constexpr int S = 16384, D = 2048, DIN = 10832, DINP = 11008, NEXP = 32, DFF = 2048;
constexpr int NWAVES = 8, NTHR = 512;
constexpr int CQ = 0, CK = 1024, CV = 1280, CQI = 1536, CKI = 2560, CWI = 2624, CHQ = 2816, CHF = 3840, CHI = 4864, CHG = 5888, CGA = 6912, CGR = 8960;
constexpr int PMAX = 65536 + NEXP * 256;
constexpr float NORM_EPS = 1e-5f;

constexpr size_t MiB = 1u << 20;
constexpr size_t al256(size_t x) { return (x + 255) & ~(size_t)255; }
constexpr size_t WS_CTL = 0, CTL_BYTES = 1 * MiB;
constexpr size_t WS_MOD = WS_CTL + CTL_BYTES;
constexpr size_t WS_TOPE = WS_MOD + 64 * 1024;
constexpr size_t WS_GATE = WS_TOPE + (size_t)S * 16;
constexpr size_t WS_SLOT = WS_GATE + (size_t)S * 16;
constexpr size_t WS_WIN_T = WS_SLOT + (size_t)S * 16;
constexpr size_t WS_WA_T = WS_WIN_T + (size_t)DINP * D * 2;
constexpr size_t WS_WH_T = WS_WA_T + (size_t)2048 * 1024 * 2;
constexpr size_t WS_WO_T = WS_WH_T + (size_t)2048 * 1024 * 2;
constexpr size_t WS_W1_T = WS_WO_T + (size_t)2048 * 2048 * 2;
constexpr size_t WS_W2_T = WS_W1_T + (size_t)NEXP * 4096 * 2048 * 2;
constexpr size_t WS_H = WS_W2_T + (size_t)NEXP * 2048 * 2048 * 2;
constexpr size_t WS_PROJ = WS_H + (size_t)S * D * 2;
constexpr size_t WS_KI = WS_PROJ + (size_t)S * DINP * 2;
constexpr size_t WS_KC = WS_KI + (size_t)S * 64 * 2;
constexpr size_t WS_VC = WS_KC + (size_t)S * 256 * 2;
constexpr size_t WS_ST = WS_VC + (size_t)S * 256 * 2;
constexpr size_t WS_DC = WS_ST + (size_t)256 * 8 * 128 * 128 * 4;
constexpr size_t WS_SEL = WS_DC + (size_t)256 * 8 * 128 * 4;
constexpr size_t WS_ATT = WS_SEL + (size_t)S * 256 * 4;
constexpr size_t WS_REC = WS_ATT + (size_t)S * 1024 * 2;
constexpr size_t WS_MERGED = WS_REC + (size_t)S * 1024 * 2;
constexpr size_t WS_X1 = WS_MERGED + (size_t)S * 2048 * 2;
constexpr size_t WS_SCORES = WS_X1 + (size_t)S * 2048 * 4;
constexpr size_t WS_XB = WS_SCORES;
constexpr size_t WS_ACT = WS_XB + (size_t)PMAX * 2048 * 2;
constexpr size_t WS_YB = WS_ACT + (size_t)PMAX * 2048 * 2;
constexpr size_t WS_END = WS_SCORES + (size_t)S * S * 4;
static_assert(WS_YB + (size_t)PMAX * 2048 * 2 <= WS_END, "MoE buffers overlay the score matrix");
static_assert(WS_END <= (size_t)4096 * MiB, "workspace");
constexpr int CW_BAR = 4096, CW_CNT = 8192, CW_FILL = 8448;
constexpr size_t WS_TOKS = WS_SEL;

constexpr int LDS_BYTES = 155648;
constexpr int LDS_MISC = LDS_BYTES - 512;

__device__ __forceinline__ unsigned cvt_pk_bf16(float lo, float hi) { unsigned r; asm volatile("v_cvt_pk_bf16_f32 %0, %1, %2" : "=v"(r) : "v"(lo), "v"(hi)); return r; }
__device__ __forceinline__ float bf_lo(unsigned u) { return __uint_as_float(u << 16); }
__device__ __forceinline__ float bf_hi(unsigned u) { return __uint_as_float(u & 0xffff0000u); }
__device__ __forceinline__ float bf2f(bf16_t b) { return __uint_as_float(((unsigned)b) << 16); }
__device__ __forceinline__ float wave_sum(float v) {
#pragma unroll
    for (int o = 1; o < 64; o <<= 1) v += __shfl_xor(v, o);
    return v;
}
__device__ __forceinline__ float wave_max(float v) {
#pragma unroll
    for (int o = 1; o < 64; o <<= 1) v = fmaxf(v, __shfl_xor(v, o));
    return v;
}
__device__ __forceinline__ float sigmoidf_(float x) { return __builtin_amdgcn_rcpf(1.0f + __expf(-x)); }
__device__ __forceinline__ float siluf_(float x) { return x * __builtin_amdgcn_rcpf(1.0f + __expf(-x)); }
__device__ __forceinline__ unsigned pack4_fp8(float a, float b, float c, float d) { int w = 0; w = __builtin_amdgcn_cvt_pk_fp8_f32(a, b, w, false); w = __builtin_amdgcn_cvt_pk_fp8_f32(c, d, w, true); return (unsigned)w; }
constexpr float W8_SCALE = 64.0f, ACT8_SCALE = 4.0f;
__device__ __forceinline__ float relu_i(float x) { const int i = __float_as_int(x); return __int_as_float(i > 0 ? i : 0); }
#define LDS_WAIT() asm volatile("s_waitcnt lgkmcnt(0)" ::: "memory")
#define VM_WAIT() asm volatile("s_waitcnt vmcnt(0)" ::: "memory")

#define XB_TMO      128
#define XB_XCNT(j)  (256  + 64 * (j))
#define XB_XSUB(j)  (1280 + 64 * (j))
#define XB_XGEN(j)  (2304 + 64 * (j))
#define XB_TOP      3328
#define XB_TOPGEN   3392
#define XCD_BAR_WORDS 3456
#define XB_SPIN_CAP (1u << 22)

__device__ __forceinline__ unsigned xb_ld(unsigned* p)              { return __hip_atomic_load(p, __ATOMIC_RELAXED, __HIP_MEMORY_SCOPE_AGENT); }
__device__ __forceinline__ unsigned xb_add(unsigned* p, unsigned v) { return __hip_atomic_fetch_add(p, v, __ATOMIC_RELAXED, __HIP_MEMORY_SCOPE_AGENT); }
__device__ __forceinline__ unsigned xb_xcc_id() { return (unsigned)__builtin_amdgcn_s_getreg((3 << 11) | 20) & 0xFu; }
#define XB_SPIN(cond, bar) do { unsigned _sp = 0; while (cond) { __builtin_amdgcn_s_sleep(1); \
    if ((++_sp & 255u) == 0u) { if (xb_ld(&(bar)[XB_TMO])) break; if (_sp > XB_SPIN_CAP) { atomicAdd(&(bar)[XB_TMO], 1u); break; } } } } while (0)

struct XcdBarrier { unsigned* bar; unsigned x; volatile LAS unsigned* st; };

__device__ __forceinline__ XcdBarrier xcd_barrier_post(unsigned* bar, volatile LAS unsigned* st) {
    XcdBarrier b; b.bar = bar; b.x = xb_xcc_id(); b.st = st;
    if (threadIdx.x == 0) (void)xb_add(&bar[XB_XCNT(b.x)], 1u);
    return b;
}
__device__ __forceinline__ void xcd_barrier_complete(unsigned* bar, unsigned x, unsigned& nloc, unsigned& nx) {
    const unsigned G = gridDim.x * gridDim.y * gridDim.z;
    unsigned sum, cnt, mine, sp = 0u;
    for (;;) {
        sum = 0u; cnt = 0u; mine = 0u;
#pragma unroll
        for (unsigned j = 0; j < 16; ++j) { const unsigned c = xb_ld(&bar[XB_XCNT(j)]); sum += c; cnt += (c > 0u) ? 1u : 0u; mine = (j == x) ? c : mine; }
        if (sum == G) break;
        __builtin_amdgcn_s_sleep(1);
        if ((++sp & 255u) == 0u) { if (xb_ld(&bar[XB_TMO])) break; if (sp > XB_SPIN_CAP) { atomicAdd(&bar[XB_TMO], 1u); break; } }
    }
    nloc = mine > 0u ? mine : 1u; nx = cnt > 0u ? cnt : 1u;
}
__device__ __forceinline__ void xcd_barrier(const XcdBarrier& b) {
    asm volatile("s_waitcnt vmcnt(0)" ::: "memory");
    __syncthreads();
    if (threadIdx.x == 0) {
        unsigned* bar = b.bar;
        __builtin_amdgcn_s_waitcnt(0);
        unsigned nloc = b.st[0], nx = b.st[1];
        if (nloc == 0u) { xcd_barrier_complete(bar, b.x, nloc, nx); b.st[0] = nloc; b.st[1] = nx; }
        const unsigned old = xb_add(&bar[XB_XSUB(b.x)], 1u);
        const unsigned gen = old / nloc;
        if (old + 1u == (gen + 1u) * nloc) {
            __builtin_amdgcn_fence(__ATOMIC_RELEASE, "agent");
            asm volatile("s_waitcnt vmcnt(0)" ::: "memory");
            const unsigned og = xb_add(&bar[XB_TOP], 1u);
            const unsigned tg = og / nx;
            if (og + 1u == (tg + 1u) * nx) xb_add(&bar[XB_TOPGEN], 1u);
            else XB_SPIN(xb_ld(&bar[XB_TOPGEN]) == tg, bar);
            __builtin_amdgcn_fence(__ATOMIC_ACQUIRE, "agent");
            xb_add(&bar[XB_XGEN(b.x)], 1u);
            asm volatile("s_waitcnt vmcnt(0)" ::: "memory");
        } else {
            XB_SPIN(xb_ld(&bar[XB_XGEN(b.x)]) == gen, bar);
            __builtin_amdgcn_fence(__ATOMIC_ACQUIRE, "agent");
            asm volatile("s_waitcnt vmcnt(0)" ::: "memory");
        }
    }
    __syncthreads();
}

namespace pg8 {
constexpr int BM = 256, BK = 64, HALF = 128, HTB = HALF * BK * 2, STAGE_BYTES = 8 * HTB, NXCD = 8, WGM = 8;
__host__ __device__ __forceinline__ int lds_byte(int r, int c) { const int st = (r >> 4) * 2 + (c >> 5), rr = r & 15, cc = c & 31, ob = rr * 64 + cc * 2; return st * 1024 + (ob ^ (((ob >> 9) & 1) << 5)); }
__host__ __device__ __forceinline__ void stage_rc(int b, int& R, int& C) { const int st = b / 1024, sb = b % 1024, swz = sb ^ (((sb >> 9) & 1) << 5); R = (st >> 1) * 16 + swz / 64; C = (st & 1) * 32 + (swz % 64) / 2; }
__host__ __device__ __forceinline__ int perm32(int rho) { const int n = rho >> 4, i = rho & 15; return 8 * (i >> 2) + 4 * n + (i & 3); }

struct Unit { int pm, pn, e; };
struct Gemm { const void* A; const void* Bt; int K; size_t estride; const int* arow; size_t astride; };

struct StaticOrder {
    int nM, nN, nwg, G, c, i;
    __device__ void init(int M, int N, int G_, int c_) { nM = M / BM; nN = N / BM; nwg = nM * nN; G = G_; c = c_; i = 0; }
    __device__ bool next(Unit& u) {
        const long L = (long)i * G + c; ++i; if (L >= nwg) return false;
        int wgid = (int)L; { const int q = nwg / NXCD, r = nwg % NXCD, xcd = wgid % NXCD, off = wgid / NXCD; wgid = (xcd < r ? xcd * (q + 1) : r * (q + 1) + (xcd - r) * q) + off; }
        const int nig = WGM * nN, gid = wgid / nig, fm = gid * WGM, gsz = (nM - fm) < WGM ? (nM - fm) : WGM;
        u.pm = fm + ((wgid % nig) % gsz); u.pn = (wgid % nig) / gsz; u.e = 0; return true;
    }
};
struct MoeOrder {
    int nPanels, nN, G, c, i; const LAS int* panel_e;
    __device__ void init(int nPanels_, int nN_, int G_, int c_, const LAS int* pe) { nPanels = nPanels_; nN = nN_; G = G_; c = c_; i = 0; panel_e = pe; }
    __device__ bool next(Unit& u) {
        const int PB = 256 / nN;
        const int nblk = (nPanels + PB - 1) / PB;
        for (;;) {
            const long L = (long)i * G + c; ++i;
            const int blk = (int)(L >> 8), r = (int)(L & 255), x = r & 7, j = r >> 3;
            if (blk >= nblk) return false;
            int pm, pn;
            if (nN == 16) { pm = blk * 16 + 4 * (x >> 1) + (j & 3); pn = 8 * (x & 1) + (j >> 2); }
            else          { pm = blk * 32 + 4 * x + (j & 3);        pn = j >> 2; }
            if (pm < nPanels) { u.pm = pm; u.pn = pn; u.e = panel_e[pm]; return true; }
        }
    }
};

template <class Epi, class Sched, bool FP8 = false>
__device__ __forceinline__ void gemm_phase(LAS unsigned char* lds, const Gemm g, Sched& S, const Epi& E) {
    const int tid = threadIdx.x, wid = __builtin_amdgcn_readfirstlane(tid >> 6), lane = tid & 63, wr = wid >> 2, wc = wid & 3, fr = lane & 15, fq = lane >> 4;
    const int K = g.K; const int pitch = FP8 ? K : 2 * K; const int nt = pitch / 128;
    unsigned voffA[2], voffB[2];
#pragma unroll
    for (int i = 0; i < 2; ++i) { int R, C; stage_rc(tid * 16 + i * 8192, R, C); const int Rb = Epi::PERM ? ((R & ~31) + perm32(R & 31)) : R;
        voffA[i] = (unsigned)(R * pitch + C * 2); voffB[i] = (unsigned)(Rb * pitch + C * 2); }
    const size_t kstep = (size_t)(BK * 2);
    const size_t hstep = (size_t)HALF * pitch;
    const size_t tstep = 2 * hstep;
    int RA[2], CA[2];
#pragma unroll
    for (int i = 0; i < 2; ++i) stage_rc(tid * 16 + i * 8192, RA[i], CA[i]);
    const bool gather = g.arow != nullptr;
    const size_t hsA = gather ? 0 : hstep;
    unsigned vA0[2] = {voffA[0], voffA[1]}, vA1[2] = {voffA[0], voffA[1]}, nA0[2] = {voffA[0], voffA[1]}, nA1[2] = {voffA[0], voffA[1]};
#define PG8_AOFF(dst0, dst1, u) do { if (gather) { _Pragma("unroll") for (int i = 0; i < 2; ++i) { \
        dst0[i] = (unsigned)g.arow[(u).pm * 256 + RA[i]] * (unsigned)pitch + (unsigned)(CA[i] * 2); dst1[i] = (unsigned)g.arow[(u).pm * 256 + 128 + RA[i]] * (unsigned)pitch + (unsigned)(CA[i] * 2); } } } while (0)
    const unsigned ldsw = (unsigned)wid * 1024u;
    const int aoff = lds_byte(wr * 64 + fr, fq * 8), boff = lds_byte(wc * 32 + fr, fq * 8);
#define PG8_SA(b, h) (((b) * 2 + (h)) * HTB)
#define PG8_SB(b, h) ((4 + (b) * 2 + (h)) * HTB)
#define PG8_STAGE(bufoff, gbase, voff) do { _Pragma("unroll") for (int _i = 0; _i < 2; ++_i) \
        __builtin_amdgcn_global_load_lds((const unsigned*)((const char*)(gbase) + (voff)[_i]), (LAS unsigned*)(lds + (bufoff) + ldsw + _i * 8192), 16, 0, 0); } while (0)
#define PG8_LD8(p) __builtin_shufflevector(*(const LAS i32x4*)(p), *(const LAS i32x4*)((p) + 1024), 0, 1, 2, 3, 4, 5, 6, 7)
#define PG8_LDA(dst, b, h) do { _Pragma("unroll") for (int m = 0; m < 4; ++m) { if constexpr (FP8) dst##8[m] = PG8_LD8(lds + PG8_SA(b, h) + aoff + m * 2048); \
        else { _Pragma("unroll") for (int k = 0; k < 2; ++k) dst[m][k] = *(const LAS bf16x8*)(lds + PG8_SA(b, h) + aoff + m * 2048 + k * 1024); } } } while (0)
#define PG8_LDB(dst, b, h) do { _Pragma("unroll") for (int n = 0; n < 2; ++n) { if constexpr (FP8) dst##8[n] = PG8_LD8(lds + PG8_SB(b, h) + boff + n * 2048); \
        else { _Pragma("unroll") for (int k = 0; k < 2; ++k) dst[n][k] = *(const LAS bf16x8*)(lds + PG8_SB(b, h) + boff + n * 2048 + k * 1024); } } } while (0)
#define PG8_MMA(ai, bj, At, Bt) do { __builtin_amdgcn_s_setprio(1); _Pragma("unroll") for (int m = 0; m < 4; ++m) _Pragma("unroll") for (int n = 0; n < 2; ++n) { \
        if constexpr (FP8) asm volatile("v_mfma_scale_f32_16x16x128_f8f6f4 %0, %1, %2, %0, %3, %3 op_sel_hi:[0,0,0]" : "+v"(acc[ai][bj][m][n]) : "v"(Bt##8[n]), "v"(At##8[m]), "v"(scl1)); \
        else { _Pragma("unroll") for (int k = 0; k < 2; ++k) acc[ai][bj][m][n] = __builtin_amdgcn_mfma_f32_16x16x32_bf16(Bt[n][k], At[m][k], acc[ai][bj][m][n], 0, 0, 0); } } \
        __builtin_amdgcn_s_setprio(0); } while (0)
#define PG8_WAIT_V(n) asm volatile("s_waitcnt vmcnt(" #n ")" ::: "memory")
#define PG8_WAIT_L(n) asm volatile("s_waitcnt lgkmcnt(" #n ")" ::: "memory")
#define PG8_BAR __builtin_amdgcn_s_barrier()
#define PG8_SCHED __builtin_amdgcn_sched_barrier(0)
    Unit cur, nxt;
    if (!S.next(cur)) return;
    const unsigned scl1 = 0x7f7f7f7fu;
    f32x4 acc[2][2][4][2];
#pragma unroll
    for (int a = 0; a < 2; ++a)
#pragma unroll
        for (int b = 0; b < 2; ++b)
#pragma unroll
            for (int m = 0; m < 4; ++m)
#pragma unroll
                for (int n = 0; n < 2; ++n) acc[a][b][m][n] = (f32x4){0.f, 0.f, 0.f, 0.f};
    bf16x8 At[4][2], B0[2][2], B1[2][2]; i32x8 At8[4], B08[2], B18[2];
    const char* cA = (const char*)g.A + (size_t)cur.e * g.astride + (gather ? (size_t)0 : (size_t)cur.pm * tstep); const char* cB = (const char*)g.Bt + (size_t)cur.e * g.estride + (size_t)cur.pn * tstep;
    PG8_AOFF(vA0, vA1, cur);
    PG8_STAGE(PG8_SB(0, 0), cB, voffB); PG8_STAGE(PG8_SB(0, 1), cB + hstep, voffB); PG8_STAGE(PG8_SA(0, 0), cA, vA0); PG8_STAGE(PG8_SA(0, 1), cA + hsA, vA1);
    if (wr == 1) PG8_BAR;
    PG8_WAIT_V(2); PG8_BAR;
    PG8_STAGE(PG8_SB(1, 0), cB + kstep, voffB); PG8_STAGE(PG8_SA(1, 0), cA + kstep, vA0); PG8_STAGE(PG8_SB(1, 1), cB + hstep + kstep, voffB);
    PG8_WAIT_V(6); PG8_BAR;
    for (;;) {
        const bool has_next = S.next(nxt);
        const char* nA = has_next ? (const char*)g.A + (size_t)nxt.e * g.astride + (gather ? (size_t)0 : (size_t)nxt.pm * tstep) : cA;
        if (has_next) PG8_AOFF(nA0, nA1, nxt);
        const char* nB = has_next ? (const char*)g.Bt + (size_t)nxt.e * g.estride + (size_t)nxt.pn * tstep : cB;
        for (int t = 0; t < nt; t += 2) {
            const bool last = (t == nt - 2);
            const char* a1 = cA + (size_t)(t + 1) * kstep;
            const char* a2 = last ? nA : cA + (size_t)(t + 2) * kstep; const char* b2 = last ? nB : cB + (size_t)(t + 2) * kstep;
            const char* a3 = a2 + kstep; const char* b3 = b2 + kstep;
            PG8_LDB(B0, 0, 0); PG8_LDB(B1, 0, 1); PG8_SCHED; PG8_LDA(At, 0, 0); PG8_STAGE(PG8_SA(1, 1), a1 + hsA, vA1);
            if (last && has_next) { vA0[0] = nA0[0]; vA0[1] = nA0[1]; vA1[0] = nA1[0]; vA1[1] = nA1[1]; }
            PG8_WAIT_V(8); PG8_WAIT_L(0); PG8_BAR; PG8_MMA(0, 0, At, B0); PG8_MMA(0, 1, At, B1); PG8_BAR; PG8_SCHED;
            PG8_LDA(At, 0, 1); PG8_STAGE(PG8_SB(0, 0), b2, voffB); PG8_STAGE(PG8_SB(0, 1), b2 + hstep, voffB); PG8_STAGE(PG8_SA(0, 0), a2, vA0);
            PG8_WAIT_V(8); PG8_WAIT_L(0); PG8_BAR; PG8_MMA(1, 0, At, B0); PG8_MMA(1, 1, At, B1); PG8_BAR; PG8_SCHED;
            PG8_LDB(B0, 1, 0); PG8_LDB(B1, 1, 1); PG8_SCHED; PG8_LDA(At, 1, 0); PG8_STAGE(PG8_SA(0, 1), a2 + hsA, vA1);
            PG8_WAIT_V(8); PG8_WAIT_L(0); PG8_BAR; PG8_MMA(0, 0, At, B0); PG8_MMA(0, 1, At, B1); PG8_BAR; PG8_SCHED;
            PG8_LDA(At, 1, 1); PG8_STAGE(PG8_SB(1, 0), b3, voffB); PG8_STAGE(PG8_SB(1, 1), b3 + hstep, voffB); PG8_STAGE(PG8_SA(1, 0), a3, vA0);
            PG8_WAIT_V(8); PG8_WAIT_L(0); PG8_BAR; PG8_MMA(1, 0, At, B0); PG8_MMA(1, 1, At, B1); PG8_BAR; PG8_SCHED;
        }
        if (wr == 0) PG8_BAR;
        if constexpr (FP8) {
#pragma unroll
            for (int a = 0; a < 2; ++a)
#pragma unroll
                for (int b = 0; b < 2; ++b) asm volatile("s_nop 15" : "+v"(acc[a][b][0][0]), "+v"(acc[a][b][0][1]), "+v"(acc[a][b][1][0]), "+v"(acc[a][b][1][1]), "+v"(acc[a][b][2][0]), "+v"(acc[a][b][2][1]), "+v"(acc[a][b][3][0]), "+v"(acc[a][b][3][1]));
        }
        const bool keep_acc = E(acc, cur, wr, wc, fr, fq);
        if (!has_next) break;
        if (!keep_acc)
#pragma unroll
        for (int a = 0; a < 2; ++a)
#pragma unroll
            for (int b = 0; b < 2; ++b)
#pragma unroll
                for (int m = 0; m < 4; ++m)
#pragma unroll
                    for (int n = 0; n < 2; ++n) acc[a][b][m][n] = (f32x4){0.f, 0.f, 0.f, 0.f};
        cur = nxt; cA = nA; cB = nB;
        if (wr == 1) PG8_BAR;
    }
    PG8_WAIT_V(0);
    PG8_BAR;
#undef PG8_AOFF
#undef PG8_SA
#undef PG8_SB
#undef PG8_STAGE
#undef PG8_LDA
#undef PG8_LDB
#undef PG8_MMA
#undef PG8_LD8
#undef PG8_WAIT_V
#undef PG8_WAIT_L
#undef PG8_BAR
#undef PG8_SCHED
}

struct EpiBf16 {
    static constexpr bool PERM = true;
    bf16_t* O; int ldc; const float* bias; int bias_estride; float ascale; int skip_from, skip_cols;
    __device__ __forceinline__ bool operator()(const f32x4 (&acc)[2][2][4][2], const Unit& u, int wr, int wc, int fr, int fq) const {
        const int row0 = u.pm * BM + wr * 64 + fr; const int col0 = u.pn * BM + wc * 32 + 8 * fq + (u.pn >= skip_from ? skip_cols : 0);
        f32x4 bv[2][2];
#pragma unroll
        for (int bj = 0; bj < 2; ++bj)
#pragma unroll
            for (int n = 0; n < 2; ++n) bv[bj][n] = bias ? *(const f32x4*)(bias + (size_t)u.e * bias_estride + col0 + bj * HALF + 4 * n) : (f32x4){0.f, 0.f, 0.f, 0.f};
#pragma unroll
        for (int ai = 0; ai < 2; ++ai)
#pragma unroll
            for (int m = 0; m < 4; ++m) { bf16_t* rowp = O + (size_t)(row0 + ai * HALF + m * 16) * ldc + col0;
#pragma unroll
                for (int bj = 0; bj < 2; ++bj) { const f32x4 v0 = acc[ai][bj][m][0] * ascale + bv[bj][0], v1 = acc[ai][bj][m][1] * ascale + bv[bj][1];
                    u32x4 w; w.x = cvt_pk_bf16(v0[0], v0[1]); w.y = cvt_pk_bf16(v0[2], v0[3]); w.z = cvt_pk_bf16(v1[0], v1[1]); w.w = cvt_pk_bf16(v1[2], v1[3]);
                    *(u32x4*)(rowp + bj * HALF) = w; } }
        return false;
    }
};
__device__ __forceinline__ float swiglu1(float ug, float ul) {
    ug = fminf(ug, 7.0f); ul = fminf(fmaxf(ul, -7.0f), 7.0f);
    return ug * __builtin_amdgcn_rcpf(1.0f + __expf(-1.702f * ug)) * (ul + 1.0f);
}
struct EpiSwiglu {
    static constexpr bool PERM = true;
    unsigned char* O; const float* b1;
    __device__ __forceinline__ bool operator()(const f32x4 (&acc)[2][2][4][2], const Unit& u, int wr, int wc, int fr, int fq) const {
        const int row0 = u.pm * BM + wr * 64 + fr; const int c0 = u.pn * 128 + wc * 32 + 8 * fq;
        const float* bg = b1 + (size_t)u.e * 4096 + c0; const float* bl = bg + 2048;
        f32x4 bgv[2], blv[2];
#pragma unroll
        for (int n = 0; n < 2; ++n) { bgv[n] = *(const f32x4*)(bg + 4 * n); blv[n] = *(const f32x4*)(bl + 4 * n); }
#pragma unroll
        for (int ai = 0; ai < 2; ++ai)
#pragma unroll
            for (int m = 0; m < 4; ++m) {
                float a[8];
#pragma unroll
                for (int n = 0; n < 2; ++n)
#pragma unroll
                    for (int j = 0; j < 4; ++j) a[4 * n + j] = ACT8_SCALE * swiglu1(acc[ai][0][m][n][j] * (1.0f / W8_SCALE) + bgv[n][j], acc[ai][1][m][n][j] * (1.0f / W8_SCALE) + blv[n][j]);
                u32x2 w; w.x = pack4_fp8(a[0], a[1], a[2], a[3]); w.y = pack4_fp8(a[4], a[5], a[6], a[7]);
                *(u32x2*)(O + (size_t)(row0 + ai * HALF + m * 16) * 2048 + c0) = w;
            }
        return false;
    }
};

struct TwoPartOrder {
    StaticOrder so; Unit held; int part;
    __device__ void init(int M, int N, int G_, int c_) { so.init(M, N, G_, c_); part = 0; }
    __device__ bool next(Unit& u) { if (part == 1) { u = held; u.e = 1; part = 0; return true; } if (!so.next(held)) return false; u = held; u.e = 0; part = 1; return true; }
};
struct EpiGate2 {
    static constexpr bool PERM = true;
    bf16_t* O; const bf16_t* Ga; const bf16_t* Gr;
    __device__ __forceinline__ bool operator()(f32x4 (&acc)[2][2][4][2], const Unit& u, int wr, int wc, int fr, int fq) const {
        const int row0 = u.pm * BM + wr * 64 + fr; const int col0 = u.pn * BM + wc * 32 + 8 * fq;
#pragma unroll
        for (int ai = 0; ai < 2; ++ai)
#pragma unroll
            for (int m = 0; m < 4; ++m) { const size_t row = (size_t)(row0 + ai * HALF + m * 16);
#pragma unroll
                for (int bj = 0; bj < 2; ++bj) { const int c = col0 + bj * HALF;
                    const u32x4 gr = *(const u32x4*)(Gr + row * DINP + c);
                    if (u.e == 0) {
                        const u32x4 ga = *(const u32x4*)(Ga + row * DINP + c);
#pragma unroll
                        for (int q = 0; q < 4; ++q) {
                            const float r0 = (1.0f + __expf(-bf_lo(gr[q]))) * __builtin_amdgcn_rcpf(1.0f + __expf(-bf_lo(ga[q]))), r1 = (1.0f + __expf(-bf_hi(gr[q]))) * __builtin_amdgcn_rcpf(1.0f + __expf(-bf_hi(ga[q])));
                            acc[ai][bj][m][q >> 1][(2 * q) & 3] *= r0; acc[ai][bj][m][q >> 1][(2 * q + 1) & 3] *= r1; }
                    } else {
                        float r[8];
#pragma unroll
                        for (int q = 0; q < 4; ++q) { r[2 * q] = sigmoidf_(bf_lo(gr[q])) * acc[ai][bj][m][q >> 1][(2 * q) & 3]; r[2 * q + 1] = sigmoidf_(bf_hi(gr[q])) * acc[ai][bj][m][q >> 1][(2 * q + 1) & 3]; }
                        u32x4 w; w.x = cvt_pk_bf16(r[0], r[1]); w.y = cvt_pk_bf16(r[2], r[3]); w.z = cvt_pk_bf16(r[4], r[5]); w.w = cvt_pk_bf16(r[6], r[7]);
                        *(u32x4*)(O + row * 2048 + c) = w; } } }
        return u.e == 0;
    }
};
struct EpiDelta {
    static constexpr bool PERM = true;
    const float* gt; bf16_t* DL;
    __device__ __forceinline__ bool operator()(const f32x4 (&acc)[2][2][4][2], const Unit& u, int wr, int wc, int fr, int fq) const {
        const int row0 = u.pm * BM + wr * 64 + fr; const int col0 = u.pn * BM + wc * 32 + 8 * fq;
        f32x4 g[2][2];
#pragma unroll
        for (int bj = 0; bj < 2; ++bj)
#pragma unroll
            for (int n = 0; n < 2; ++n) g[bj][n] = *(const f32x4*)(gt + col0 + bj * HALF + 4 * n);
#pragma unroll
        for (int ai = 0; ai < 2; ++ai)
#pragma unroll
            for (int m = 0; m < 4; ++m) { bf16_t* rowp = DL + (size_t)(row0 + ai * HALF + m * 16) * 2048 + col0;
#pragma unroll
                for (int bj = 0; bj < 2; ++bj) { const f32x4 v0 = acc[ai][bj][m][0] * g[bj][0], v1 = acc[ai][bj][m][1] * g[bj][1];
                    u32x4 w; w.x = cvt_pk_bf16(v0[0], v0[1]); w.y = cvt_pk_bf16(v0[2], v0[3]); w.z = cvt_pk_bf16(v1[0], v1[1]); w.w = cvt_pk_bf16(v1[2], v1[3]);
                    *(u32x4*)(rowp + bj * HALF) = w; } }
        return false;
    }
};
}

struct Args { const void* in[22]; float* out; unsigned char* ws; int ph_lo, ph_hi, flags, pad; };
enum { PH_PRO = 0, PH_H, PH_INPROJ, PH_POST, PH_SCORE, PH_SELECT, PH_ATTN, PH_OP1, PH_OP2, PH_WOUT, PH_ROUTER, PH_SCATTER, PH_MOE1, PH_MOE2, PH_FINAL, NPH };

__device__ __forceinline__ int dest_row(int mode, int n) {
    if (mode == 1) return n < 2640 ? n : n + 176;
    if (mode == 2) { const int g = n >> 11, c = n & 2047; return (c >> 7) * 256 + g * 128 + (c & 127); }
    return n;
}
__device__ __forceinline__ void convert_item(const float* __restrict__ W, int K, int N, int ld, bf16_t* WT, int mode, int item, int lane, LAS unsigned char* scr) {
    const int nblk = (N + 63) >> 6; const int kb = item / nblk, nb = item - kb * nblk; const int k0 = kb * 128, n0 = nb * 64;
    const int c4 = lane & 15, kr = lane >> 4;
    const bool ok = (n0 + 4 * c4) < N;
    const float* src = W + (size_t)(k0 + 2 * kr) * ld + n0 + 4 * c4;
#pragma unroll 4
    for (int i = 0; i < 16; ++i) {
        f32x4 v0 = (f32x4){0.f, 0.f, 0.f, 0.f}, v1 = v0;
        if (ok) { v0 = *(const f32x4*)(src + (size_t)(8 * i) * ld); v1 = *(const f32x4*)(src + (size_t)(8 * i + 1) * ld); }
        const int kk = 8 * i + 2 * kr;
#pragma unroll
        for (int e = 0; e < 4; ++e) *(LAS unsigned*)(scr + (4 * c4 + e) * 272 + kk * 2) = cvt_pk_bf16(v0[e], v1[e]);
    }
    LDS_WAIT(); asm volatile("" ::: "memory");
#pragma unroll 4
    for (int j = 0; j < 16; ++j) {
        const int q = j * 64 + lane, n = q >> 4, ch = q & 15;
        const u32x4 v = *(const LAS u32x4*)(scr + n * 272 + ch * 16);
        if (n0 + n < N) *(u32x4*)(WT + (size_t)dest_row(mode, n0 + n) * K + k0 + ch * 8) = v;
    }
    LDS_WAIT(); asm volatile("" ::: "memory");
}


__device__ __forceinline__ bf16_t f2bf(float f) { unsigned u = __float_as_uint(f); return (bf16_t)((u + 0x7fffu + ((u >> 16) & 1u)) >> 16); }
__device__ __forceinline__ float bfx(const u32x4& w, int i) { const unsigned u = w[i >> 1]; return (i & 1) ? bf_hi(u) : bf_lo(u); }
__device__ __forceinline__ void rope_sc(float pos, float inv, float& sn, float& cs) {
    const float ang = pos * inv;
    const double a = (double)ang; const double n = __builtin_rint(a * 0.15915494309189535); const float r = (float)(a - n * 6.283185307179586);
    sn = sinf(r); cs = cosf(r);
}
__device__ __forceinline__ void post_token(bf16_t* PROJ, bf16_t* KI, bf16_t* KC, bf16_t* VC, const int* positions, const float* kng, const float* knb, int t, int lane) {
    const float pos = (float)positions[t];
    bf16_t* row = PROJ + (size_t)t * DINP;
    float sn, cs;
#pragma unroll
    for (int i = 0; i < 2; ++i) {
        const int pp = lane + 64 * i, hd = pp >> 4, ii = pp & 15;
        rope_sc(pos, powf(500000.0f, -(float)ii * (1.0f / 16.0f)), sn, cs);
        bf16_t* p = row + CQ + hd * 128 + ii; const float a = bf2f(p[0]), b = bf2f(p[16]);
        p[0] = f2bf(a * cs - b * sn); p[16] = f2bf(b * cs + a * sn);
    }
#pragma unroll
    for (int i = 0; i < 2; ++i) {
        const int pp = lane + 64 * i, hd = pp >> 3, ii = pp & 7;
        rope_sc(pos, powf(500000.0f, -(float)ii * (1.0f / 8.0f)), sn, cs);
        bf16_t* p = row + CQI + hd * 64 + ii; const float a = bf2f(p[0]), b = bf2f(p[8]);
        p[0] = f2bf(a * cs - b * sn); p[8] = f2bf(b * cs + a * sn);
    }
    if (lane < 32) {
        const int g = lane >> 4, ii = lane & 15;
        rope_sc(pos, powf(500000.0f, -(float)ii * (1.0f / 16.0f)), sn, cs);
        const bf16_t* p = row + CK + g * 128 + ii; const float a = bf2f(p[0]), b = bf2f(p[16]);
        bf16_t* o = KC + (size_t)t * 256 + g * 128 + ii; o[0] = f2bf(a * cs - b * sn); o[16] = f2bf(b * cs + a * sn);
    }
#pragma unroll
    for (int i = 0; i < 3; ++i) { const int idx = lane + 64 * i, g = idx / 96, r = idx - g * 96; KC[(size_t)t * 256 + g * 128 + 32 + r] = row[CK + g * 128 + 32 + r]; }
    *(u32x2*)(VC + (size_t)t * 256 + 4 * lane) = *(const u32x2*)(row + CV + 4 * lane);
    {
        const float v = bf2f(row[CKI + lane]);
        const float mean = wave_sum(v) * (1.0f / 64.0f); const float d = v - mean; const float var = wave_sum(d * d) * (1.0f / 64.0f);
        const float y = d * rsqrtf(var + NORM_EPS) * kng[lane] + knb[lane];
        const float other = __shfl_xor(y, 8);
        rope_sc(pos, powf(500000.0f, -(float)(lane & 7) * (1.0f / 8.0f)), sn, cs);
        float o = y;
        if (lane < 8) o = y * cs - other * sn; else if (lane < 16) o = y * cs + other * sn;
        KI[(size_t)t * 64 + lane] = f2bf(o);
    }
}

constexpr int HG_GB = 0, HG_Q1 = 33792, HG_Q2 = 51200, HG_K2 = 68608, HG_VT = 86016, HG_PB = 104448, HG_LB = 113664;
__device__ __forceinline__ void hgrn_cumsum(LAS unsigned char* lds, const u32x4& w0, const u32x4& w1, float l0, float l1, int tid) {
    LAS float* GB = (LAS float*)(lds + HG_GB); LAS float* LB = (LAS float*)(lds + HG_LB); LAS float* SEG = (LAS float*)(lds + HG_LB + 512);
    if (tid < 128) LB[tid] = 1.0f / (1.0f + expf(l1 - l0));
    __syncthreads();
    const int t = tid >> 3, dseg = tid & 7;
#pragma unroll
    for (int i = 0; i < 16; ++i) { const float z = i < 8 ? bfx(w0, i) : bfx(w1, i - 8); const float lb = LB[16 * dseg + i]; GB[t * 128 + 16 * dseg + i] = logf(lb + (1.0f - lb) * sigmoidf_(z)); }
    __syncthreads();
    const int d = tid & 127, tq = tid >> 7;
    float z[16];
#pragma unroll
    for (int i = 0; i < 16; ++i) z[i] = GB[(16 * tq + i) * 128 + d];
    float a = 0.f;
#pragma unroll
    for (int i = 0; i < 16; ++i) { a += z[i]; z[i] = a; }
    SEG[tq * 128 + d] = a;
    __syncthreads();
    float pre = 0.f;
    for (int q = 0; q < tq; ++q) pre += SEG[q * 128 + d];
#pragma unroll
    for (int i = 0; i < 16; ++i) GB[(16 * tq + i) * 128 + d] = z[i] + pre;
    __syncthreads();
}
__device__ __forceinline__ void hgrn_vt(LAS unsigned char* lds, const u32x4& a, const u32x4& b, int tid) {
    const int s2 = tid & 31, eg = tid >> 5;
#pragma unroll
    for (int i = 0; i < 8; ++i) { const unsigned lo = (i & 1) ? (a[i >> 1] >> 16) : (a[i >> 1] & 0xffffu), hi = (i & 1) ? (b[i >> 1] >> 16) : (b[i >> 1] & 0xffffu);
        *(LAS unsigned*)(lds + HG_VT + (8 * eg + i) * 144 + s2 * 4) = lo | (hi << 16); }
}
__device__ __forceinline__ void hgrn_l1(LAS unsigned char* lds, const bf16_t* PROJ, const float* lb_logits, float* ST, float* DC, int c, int h, int tid, int wave, int lane) {
    const int t = tid >> 3, dseg = tid & 7, s2 = tid & 31, dg = tid >> 5;
    const bf16_t* pf = PROJ + (size_t)(c * 64 + t) * DINP + CHF + h * 128 + 16 * dseg;
    const bf16_t* pk = PROJ + (size_t)(c * 64 + 2 * s2) * DINP + CHF + h * 128 + 8 * dg;
    const u32x4 w0 = *(const u32x4*)pf, w1 = *(const u32x4*)(pf + 8);
    const u32x4 ka = *(const u32x4*)pk, kb = *(const u32x4*)(pk + DINP);
    const u32x4 va = *(const u32x4*)(pk - CHF + CHI), vb = *(const u32x4*)(pk - CHF + CHI + DINP);
    const float l0 = lb_logits[h * 128 + (tid & 127)], l1 = lb_logits[1024 + h * 128 + (tid & 127)];
    hgrn_cumsum(lds, w0, w1, l0, l1, tid);
    const LAS float* GB = (const LAS float*)(lds + HG_GB); const LAS float* LB = (const LAS float*)(lds + HG_LB);
    {
#pragma unroll
        for (int i = 0; i < 8; ++i) { const int d = 8 * dg + i; const float lb = LB[d], b63 = GB[63 * 128 + d];
            const float k0 = (1.0f - lb) * (1.0f - sigmoidf_(bfx(ka, i))), k1 = (1.0f - lb) * (1.0f - sigmoidf_(bfx(kb, i)));
            const float v0 = k0 * __expf(b63 - GB[(2 * s2) * 128 + d]), v1 = k1 * __expf(b63 - GB[(2 * s2 + 1) * 128 + d]);
            *(LAS unsigned*)(lds + HG_Q1 + d * 144 + s2 * 4) = cvt_pk_bf16(v0, v1); }
    }
    hgrn_vt(lds, va, vb, tid);
    __syncthreads();
    const int fr = lane & 15, fq = lane >> 4;
    bf16x8 af[2];
#pragma unroll
    for (int ks = 0; ks < 2; ++ks) af[ks] = *(const LAS bf16x8*)(lds + HG_VT + (16 * wave + fr) * 144 + (32 * ks + 8 * fq) * 2);
    float* dst = ST + ((size_t)(c * 8 + h) * 128) * 128;
#pragma unroll 2
    for (int dt = 0; dt < 8; ++dt) {
        f32x4 acc = (f32x4){0.f, 0.f, 0.f, 0.f};
#pragma unroll
        for (int ks = 0; ks < 2; ++ks) { const bf16x8 bfr = *(const LAS bf16x8*)(lds + HG_Q1 + (16 * dt + fr) * 144 + (32 * ks + 8 * fq) * 2); acc = __builtin_amdgcn_mfma_f32_16x16x32_bf16(af[ks], bfr, acc, 0, 0, 0); }
#pragma unroll
        for (int r = 0; r < 4; ++r) dst[(size_t)(16 * wave + 4 * fq + r) * 128 + 16 * dt + fr] = acc[r];
    }
    if (tid < 128) DC[(size_t)(c * 8 + h) * 128 + tid] = __expf(GB[63 * 128 + tid]);
    __syncthreads();
}
__device__ __forceinline__ void hgrn_l3(LAS unsigned char* lds, const bf16_t* PROJ, const float* lb_logits, const float* ST, const float* norm_g, bf16_t* REC, int c, int h, int tid, int wave, int lane) {
    const int t = tid >> 3, dseg = tid & 7, s2 = tid & 31, eg = tid >> 5, fr = lane & 15, fq = lane >> 4;
    const bf16_t* pf = PROJ + (size_t)(c * 64 + t) * DINP + CHF + h * 128 + 16 * dseg;
    const u32x4 f0 = *(const u32x4*)pf, f1 = *(const u32x4*)(pf + 8), q0 = *(const u32x4*)(pf - CHF + CHQ), q1 = *(const u32x4*)(pf - CHF + CHQ + 8);
    const u32x4 g0 = *(const u32x4*)(pf - CHF + CHG), g1 = *(const u32x4*)(pf - CHF + CHG + 8);
    const bf16_t* pv = PROJ + (size_t)(c * 64 + 2 * s2) * DINP + CHI + h * 128 + 8 * eg;
    const u32x4 va = *(const u32x4*)pv, vb = *(const u32x4*)(pv + DINP);
    const float* sp = ST + ((size_t)(c * 8 + h) * 128 + 16 * wave + fr) * 128 + 8 * fq;
    f32x4 sx[4][2];
#pragma unroll
    for (int ks = 0; ks < 4; ++ks) { sx[ks][0] = *(const f32x4*)(sp + 32 * ks); sx[ks][1] = *(const f32x4*)(sp + 32 * ks + 4); }
    const float l0 = lb_logits[h * 128 + (tid & 127)], l1 = lb_logits[1024 + h * 128 + (tid & 127)];
    hgrn_cumsum(lds, f0, f1, l0, l1, tid);
    const LAS float* GB = (const LAS float*)(lds + HG_GB); const LAS float* LB = (const LAS float*)(lds + HG_LB);
    {
        unsigned o1[8], o2[8], o3[8];
#pragma unroll
        for (int i = 0; i < 16; i += 2) {
            float a1[2], a2[2], a3[2];
#pragma unroll
            for (int j = 0; j < 2; ++j) { const int d = 16 * dseg + i + j; const float lb = LB[d], b = GB[t * 128 + d], br = GB[31 * 128 + d];
                const float z = (i + j) < 8 ? bfx(f0, i + j) : bfx(f1, i + j - 8), qv = (i + j) < 8 ? bfx(q0, i + j) : bfx(q1, i + j - 8);
                const float k = (1.0f - lb) * (1.0f - sigmoidf_(z)), q = siluf_(qv);
                a1[j] = q * __expf(b); a2[j] = q * __expf(b - br); a3[j] = k * __expf(br - b); }
            o1[i >> 1] = cvt_pk_bf16(a1[0], a1[1]); o2[i >> 1] = cvt_pk_bf16(a2[0], a2[1]); o3[i >> 1] = cvt_pk_bf16(a3[0], a3[1]);
        }
        LAS u32x4* d1 = (LAS u32x4*)(lds + HG_Q1 + t * 272 + dseg * 32); LAS u32x4* d2 = (LAS u32x4*)(lds + HG_Q2 + t * 272 + dseg * 32); LAS u32x4* d3 = (LAS u32x4*)(lds + HG_K2 + t * 272 + dseg * 32);
        d1[0] = (u32x4){o1[0], o1[1], o1[2], o1[3]}; d1[1] = (u32x4){o1[4], o1[5], o1[6], o1[7]};
        d2[0] = (u32x4){o2[0], o2[1], o2[2], o2[3]}; d2[1] = (u32x4){o2[4], o2[5], o2[6], o2[7]};
        d3[0] = (u32x4){o3[0], o3[1], o3[2], o3[3]}; d3[1] = (u32x4){o3[4], o3[5], o3[6], o3[7]};
    }
    hgrn_vt(lds, va, vb, tid);
    __syncthreads();
#pragma unroll
    for (int q = 0; q < 2; ++q) {
        const int tile = 2 * wave + q, tt = tile >> 2, stl = tile & 3;
        f32x4 acc = (f32x4){0.f, 0.f, 0.f, 0.f};
#pragma unroll
        for (int ks = 0; ks < 4; ++ks) { const bf16x8 a = *(const LAS bf16x8*)(lds + HG_Q2 + (16 * tt + fr) * 272 + (32 * ks + 8 * fq) * 2), b = *(const LAS bf16x8*)(lds + HG_K2 + (16 * stl + fr) * 272 + (32 * ks + 8 * fq) * 2);
            acc = __builtin_amdgcn_mfma_f32_16x16x32_bf16(a, b, acc, 0, 0, 0); }
#pragma unroll
        for (int r = 0; r < 4; ++r) { const int tr_ = 16 * tt + 4 * fq + r, s = 16 * stl + fr; *(LAS bf16_t*)(lds + HG_PB + tr_ * 144 + s * 2) = f2bf(s <= tr_ ? acc[r] : 0.f); }
    }
    __syncthreads();
    {
        bf16x8 b1[2], b2[4];
#pragma unroll
        for (int ks = 0; ks < 2; ++ks) b1[ks] = *(const LAS bf16x8*)(lds + HG_VT + (16 * wave + fr) * 144 + (32 * ks + 8 * fq) * 2);
#pragma unroll
        for (int ks = 0; ks < 4; ++ks) { const f32x4 x0 = sx[ks][0], x1 = sx[ks][1];
            u32x4 w; w.x = cvt_pk_bf16(x0[0], x0[1]); w.y = cvt_pk_bf16(x0[2], x0[3]); w.z = cvt_pk_bf16(x1[0], x1[1]); w.w = cvt_pk_bf16(x1[2], x1[3]); b2[ks] = __builtin_bit_cast(bf16x8, w); }
        LAS float* OB = (LAS float*)(lds + HG_GB);
#pragma unroll
        for (int tt = 0; tt < 4; ++tt) {
            f32x4 acc = (f32x4){0.f, 0.f, 0.f, 0.f};
#pragma unroll
            for (int ks = 0; ks < 2; ++ks) { const bf16x8 a = *(const LAS bf16x8*)(lds + HG_PB + (16 * tt + fr) * 144 + (32 * ks + 8 * fq) * 2); acc = __builtin_amdgcn_mfma_f32_16x16x32_bf16(a, b1[ks], acc, 0, 0, 0); }
#pragma unroll
            for (int ks = 0; ks < 4; ++ks) { const bf16x8 a = *(const LAS bf16x8*)(lds + HG_Q1 + (16 * tt + fr) * 272 + (32 * ks + 8 * fq) * 2); acc = __builtin_amdgcn_mfma_f32_16x16x32_bf16(a, b2[ks], acc, 0, 0, 0); }
#pragma unroll
            for (int r = 0; r < 4; ++r) OB[(16 * tt + 4 * fq + r) * 132 + 16 * wave + fr] = acc[r];
        }
    }
    __syncthreads();
    {
        const int es = dseg; const LAS float* OB = (const LAS float*)(lds + HG_GB);
        float o[16]; float ss = 0.f;
#pragma unroll
        for (int i = 0; i < 16; ++i) { o[i] = OB[t * 132 + 16 * es + i]; ss += o[i] * o[i]; }
        ss += __shfl_xor(ss, 1); ss += __shfl_xor(ss, 2); ss += __shfl_xor(ss, 4);
        const float rstd = rsqrtf(ss * (1.0f / 128.0f) + NORM_EPS);
        unsigned w[8];
#pragma unroll
        for (int i = 0; i < 16; i += 2) { const float ga = i < 8 ? bfx(g0, i) : bfx(g1, i - 8), gb = (i + 1) < 8 ? bfx(g0, i + 1) : bfx(g1, i + 1 - 8);
            w[i >> 1] = cvt_pk_bf16(o[i] * rstd * norm_g[16 * es + i] * siluf_(ga), o[i + 1] * rstd * norm_g[16 * es + i + 1] * siluf_(gb)); }
        u32x4* dst = (u32x4*)(REC + (size_t)(c * 64 + t) * 1024 + h * 128 + 16 * es);
        dst[0] = (u32x4){w[0], w[1], w[2], w[3]}; dst[1] = (u32x4){w[4], w[5], w[6], w[7]};
    }
    __syncthreads();
}

constexpr int SC_KT = 0, SC_SB = 36864, SC_SPITCH = 132;
__device__ __forceinline__ unsigned pk_f16(float a, float b) { return __builtin_bit_cast(unsigned, __builtin_amdgcn_cvt_pkrtz(a, b)); }
__device__ __forceinline__ void score_flush(LAS unsigned char* lds, unsigned short* SCORES, int t0, int kt, int tid) {
    const LAS float* sb = (const LAS float*)(lds + SC_SB + (kt & 1) * (32 * SC_SPITCH * 4));
    const int row = tid >> 4, seg = tid & 15;
    const f32x4 a = *(const LAS f32x4*)(sb + row * SC_SPITCH + seg * 8), b = *(const LAS f32x4*)(sb + row * SC_SPITCH + seg * 8 + 4);
    unsigned short* dst = SCORES + (size_t)(t0 + row) * S + kt * 128 + seg * 8;
    *(u32x4*)dst = (u32x4){pk_f16(a[0], a[1]), pk_f16(a[2], a[3]), pk_f16(b[0], b[1]), pk_f16(b[2], b[3])};
}
__device__ __forceinline__ void score_block(LAS unsigned char* lds, const bf16_t* PROJ, const bf16_t* KI, unsigned short* SCORES, int qb, int tid, int wave, int lane) {
    const int t0 = qb * 32, nkt = (t0 >> 7) + 1;
    const int r = lane & 31, hh = lane >> 5;
    bf16x8 Af[2][4]; float wv[2][16]; f32x2 wv2[2][8];
#pragma unroll
    for (int p = 0; p < 2; ++p) {
        const int tq = t0 + 4 * wave + 2 * p + (r >> 4); const bf16_t* qrow = PROJ + (size_t)tq * DINP + CQI + (r & 15) * 64 + 8 * hh;
#pragma unroll
        for (int ks = 0; ks < 4; ++ks) Af[p][ks] = *(const bf16x8*)(qrow + 16 * ks);
#pragma unroll
        for (int reg = 0; reg < 16; ++reg) { const int row = (reg & 3) + 8 * (reg >> 2) + 4 * hh; const int tw = t0 + 4 * wave + 2 * p + (row >> 4);
            wv[p][reg] = bf2f(PROJ[(size_t)tw * DINP + CWI + (row & 15)]) * (1.0f / 32.0f); }
#pragma unroll
        for (int i = 0; i < 8; ++i) wv2[p][i] = (f32x2){wv[p][2 * i], wv[p][2 * i + 1]};
    }
    const u32x2 tagsw = __builtin_amdgcn_permlane32_swap(0u, 1u, false, false); const int qsel = (int)tagsw[0];
    u32x4 stg[2];
#pragma unroll
    for (int i = 0; i < 2; ++i) { const int q = tid + 512 * i; stg[i] = *(const u32x4*)(KI + (size_t)(q >> 3) * 64 + (q & 7) * 8); }
#pragma unroll
    for (int i = 0; i < 2; ++i) { const int q = tid + 512 * i; *(LAS u32x4*)(lds + SC_KT + (q >> 3) * 144 + (q & 7) * 16) = stg[i]; }
    __syncthreads();
    for (int kt = 0; kt < nkt; ++kt) {
        const LAS unsigned char* buf = lds + SC_KT + (kt & 1) * 18432;
        LAS float* sb = (LAS float*)(lds + SC_SB + (kt & 1) * (32 * SC_SPITCH * 4));
        if (kt > 0) score_flush(lds, SCORES, t0, kt - 1, tid);
        if (kt + 1 < nkt) {
#pragma unroll
            for (int i = 0; i < 2; ++i) { const int q = tid + 512 * i; stg[i] = *(const u32x4*)(KI + (size_t)((kt + 1) * 128 + (q >> 3)) * 64 + (q & 7) * 8); }
        }
        {
        f32x16 accP[2], accC[2];
#define SC_MFMA(cb) do { bf16x8 Bf[4]; _Pragma("unroll") for (int ks = 0; ks < 4; ++ks) Bf[ks] = *(const LAS bf16x8*)(buf + (32 * (cb) + r) * 144 + (16 * ks + 8 * hh) * 2); \
            _Pragma("unroll") for (int p = 0; p < 2; ++p) { _Pragma("unroll") for (int i = 0; i < 16; ++i) accC[p][i] = 0.f; \
                _Pragma("unroll") for (int ks = 0; ks < 4; ++ks) accC[p] = __builtin_amdgcn_mfma_f32_32x32x16_bf16(Af[p][ks], Bf[ks], accC[p], 0, 0, 0); } } while (0)
#define SC_RED(acc, cb) do { _Pragma("unroll") for (int p = 0; p < 2; ++p) { f32x2 s0 = {0.f, 0.f}, s1 = {0.f, 0.f}; \
            _Pragma("unroll") for (int reg = 0; reg < 8; reg += 2) { const f32x2 r0 = {relu_i(acc[p][reg]), relu_i(acc[p][reg + 1])}; const f32x2 r1 = {relu_i(acc[p][reg + 8]), relu_i(acc[p][reg + 9])}; \
                s0 = __builtin_elementwise_fma(wv2[p][reg >> 1], r0, s0); s1 = __builtin_elementwise_fma(wv2[p][4 + (reg >> 1)], r1, s1); } \
            const float p0 = s0[0] + s0[1], p1 = s1[0] + s1[1]; \
            const u32x2 sw = __builtin_amdgcn_permlane32_swap(__float_as_uint(p0), __float_as_uint(p1), false, false); \
            sb[(4 * wave + 2 * p + qsel) * SC_SPITCH + 32 * (cb) + r] = __uint_as_float(sw[0]) + __uint_as_float(sw[1]); } } while (0)
#define SC_INTERLEAVE() do { _Pragma("unroll") for (int i = 0; i < 8; ++i) { __builtin_amdgcn_sched_group_barrier(0x008, 1, 0); __builtin_amdgcn_sched_group_barrier(0x002, 8, 0); } } while (0)
        SC_MFMA(0);
        accP[0] = accC[0]; accP[1] = accC[1]; SC_MFMA(1); SC_RED(accP, 0); SC_INTERLEAVE();
        accP[0] = accC[0]; accP[1] = accC[1]; SC_MFMA(2); SC_RED(accP, 1); SC_INTERLEAVE();
        accP[0] = accC[0]; accP[1] = accC[1]; SC_MFMA(3); SC_RED(accP, 2); SC_INTERLEAVE();
        SC_RED(accC, 3);
#undef SC_MFMA
#undef SC_RED
#undef SC_INTERLEAVE
        }
        if (kt + 1 < nkt) {
#pragma unroll
            for (int i = 0; i < 2; ++i) { const int q = tid + 512 * i; *(LAS u32x4*)(lds + SC_KT + ((kt + 1) & 1) * 18432 + (q >> 3) * 144 + (q & 7) * 16) = stg[i]; }
        }
        __syncthreads();
    }
    score_flush(lds, SCORES, t0, nkt - 1, tid);
    __syncthreads();
}

__device__ __forceinline__ float wave_kth16(const float (&v)[16], int K) {
    const float NINF = -__builtin_inff();
    float mx = NINF, mn = __builtin_inff();
#pragma unroll
    for (int j = 0; j < 16; ++j) { mx = fmaxf(mx, v[j]); mn = fminf(mn, v[j] == NINF ? __builtin_inff() : v[j]); }
    mx = wave_max(mx); mn = -wave_max(-mn);
    int c = 0;
#pragma unroll
    for (int j = 0; j < 16; ++j) c += __popcll(__ballot(v[j] >= mx));
    if (c >= K) return mx;
    float lo = mn, hi = mx, tau = mn;
    for (int it = 0; it < 64; ++it) {
        const float mid = 0.5f * (lo + hi);
        if (!(mid > lo && mid < hi)) { tau = lo; break; }
        c = 0;
#pragma unroll
        for (int j = 0; j < 16; ++j) c += __popcll(__ballot(v[j] >= mid));
        if (c == K) { tau = mid; break; }
        if (c > K) lo = mid; else hi = mid;
        tau = lo;
    }
    return tau;
}
__device__ __forceinline__ int lanes_below(unsigned long long mask) { return (int)__builtin_amdgcn_mbcnt_hi((unsigned)(mask >> 32), __builtin_amdgcn_mbcnt_lo((unsigned)mask, 0u)); }
__device__ __forceinline__ float h2f(unsigned short h) { return (float)__builtin_bit_cast(_Float16, h); }
__device__ __forceinline__ float h2f_lo(unsigned u) { return h2f((unsigned short)(u & 0xffffu)); }
__device__ __forceinline__ float h2f_hi(unsigned u) { return h2f((unsigned short)(u >> 16)); }
__device__ __forceinline__ void select_row(LAS unsigned char* wl, const unsigned short* SCORES, int t, int lane) {
    LAS int* selw = (LAS int*)wl; LAS int* cidx = (LAS int*)(wl + 5120);
    const float NINF = -__builtin_inff();
    const unsigned short* row = SCORES + (size_t)t * S; const int n = t + 1;
    float c[16]; int N;
    if (n <= 1024) {
#pragma unroll
        for (int j = 0; j < 16; ++j) { const int i = lane + 64 * j; c[j] = i < n ? h2f(row[i]) : NINF; }
        N = -1;
    } else {
        const int m = n >> 4; float s[16];
#pragma unroll
        for (int j = 0; j < 16; ++j) { const int i = lane + 64 * j; s[j] = i < m ? h2f(row[16 * i + 7]) : NINF; }
        int K = 32, cnt = 0;
        for (;;) {
            const float tlo = (K >= m) ? NINF : wave_kth16(s, K);
            cnt = 0;
            const int nq = (n + 511) >> 9;
            if (tlo > 0.f) {
                const unsigned T16 = pk_f16(tlo, tlo);
                for (int q0 = 0; q0 < nq; q0 += 4) {
                    u32x4 v[4];
#pragma unroll
                    for (int u = 0; u < 4; ++u) { const int e = 8 * (lane + 64 * (q0 + u)); v[u] = (e <= t) ? *(const u32x4*)(row + e) : (u32x4){0xfc00fc00u, 0xfc00fc00u, 0xfc00fc00u, 0xfc00fc00u}; }
#pragma unroll
                    for (int u = 0; u < 4; ++u) { const int e = 8 * (lane + 64 * (q0 + u));
                        unsigned m8 = 0;
#pragma unroll
                        for (int w = 0; w < 4; ++w) { const unsigned vw_ = v[u][w];
                            const s16x2 d = __builtin_elementwise_sub_sat(__builtin_bit_cast(s16x2, vw_), __builtin_bit_cast(s16x2, T16));
                            const unsigned mm = ~__builtin_bit_cast(unsigned, d); m8 |= (((mm >> 15) & 1u) | ((mm >> 30) & 2u)) << (2 * w); }
                        const int nv = t + 1 - e; if (nv < 8) m8 &= nv > 0 ? ((1u << nv) - 1u) : 0u;
                        for (;;) { const bool has = m8 != 0u; const unsigned long long mask = __ballot(has); if (!mask) break;
                            const int pos = cnt + lanes_below(mask);
                            if (has) { const int k = __builtin_ctz(m8); m8 &= m8 - 1u; if (pos < 1024) cidx[pos] = e + k; }
                            cnt += __popcll(mask); } }
                }
            } else {
                for (int q0 = 0; q0 < nq; q0 += 4) {
                    u32x4 v[4];
#pragma unroll
                    for (int u = 0; u < 4; ++u) { const int e = 8 * (lane + 64 * (q0 + u)); v[u] = (e <= t) ? *(const u32x4*)(row + e) : (u32x4){0xfc00fc00u, 0xfc00fc00u, 0xfc00fc00u, 0xfc00fc00u}; }
#pragma unroll
                    for (int u = 0; u < 4; ++u) { const int e = 8 * (lane + 64 * (q0 + u));
#pragma unroll
                        for (int k = 0; k < 8; ++k) { const float x = (k & 1) ? h2f_hi(v[u][k >> 1]) : h2f_lo(v[u][k >> 1]);
                            const bool pred = (e + k <= t) && (x >= tlo); const unsigned long long mask = __ballot(pred);
                            if (mask) { const int pos = cnt + lanes_below(mask); if (pred && pos < 1024) cidx[pos] = e + k; cnt += __popcll(mask); } } }
                }
            }
            if (cnt >= 256 || K >= m) break;
            K *= 2;
        }
        N = cnt < 1024 ? cnt : 1024;
#pragma unroll
        for (int j = 0; j < 16; ++j) { const int i = lane + 64 * j; c[j] = i < N ? h2f(row[cidx[i]]) : NINF; }
    }
    const float tau = wave_kth16(c, 256);
    int base = 0;
#pragma unroll
    for (int j = 0; j < 16; ++j) { const bool pred = c[j] >= tau; const unsigned long long mask = __ballot(pred);
        if (mask) { const int pos = base + lanes_below(mask); if (pred && pos < 256) selw[pos] = (N < 0) ? (lane + 64 * j) : cidx[lane + 64 * j]; base += __popcll(mask); } }
}

__device__ __forceinline__ void attn_query(LAS unsigned char* wl, const bf16_t* PROJ, const bf16_t* KC, const bf16_t* VC, bf16_t* ATT, int t, int lane) {
    LAS int* selw = (LAS int*)wl; LAS float* L = (LAS float*)(wl + 1024);
    const int nsel = t < 255 ? t + 1 : 256;
    const int fr = lane & 15, fq = lane >> 4;
    bf16x8 qf[2][4];
#pragma unroll
    for (int g = 0; g < 2; ++g)
#pragma unroll
        for (int ks = 0; ks < 4; ++ks) { const bf16x8 z = {0, 0, 0, 0, 0, 0, 0, 0}; qf[g][ks] = fr < 4 ? *(const bf16x8*)(PROJ + (size_t)t * DINP + CQ + (4 * g + fr) * 128 + 64 * (ks >> 1) + 16 * fq + 8 * (ks & 1)) : z; }
    const float scale = 0.08838834764831845f;
    const int nkt = (nsel + 15) >> 4;
    {
        LAS unsigned char* KT = wl + 9216;
        const int half_ = lane >> 5, l31_ = lane & 31;
        u32x4 kw[3][8];
#define QK_LOAD(buf, kt) do { _Pragma("unroll") for (int u = 0; u < 8; ++u) { const unsigned off_ = (unsigned)selw[16 * (kt) + 2 * u + half_] * 512u + 16u * (unsigned)l31_; kw[buf][u] = *(const u32x4*)((const char*)KC + off_); } } while (0)
#define QK_COMP(buf, kt) do { _Pragma("unroll") for (int u = 0; u < 8; ++u) *(LAS u32x4*)(KT + (2 * u + half_) * 528 + 16 * l31_) = kw[buf][u]; \
        _Pragma("unroll") for (int g = 0; g < 2; ++g) { f32x4 acc = (f32x4){0.f, 0.f, 0.f, 0.f}; \
            _Pragma("unroll") for (int ks = 0; ks < 4; ++ks) { const bf16x8 kf_ = *(const LAS bf16x8*)(KT + fr * 528 + g * 256 + (64 * (ks >> 1) + 16 * fq + 8 * (ks & 1)) * 2); \
                acc = __builtin_amdgcn_mfma_f32_16x16x32_bf16(qf[g][ks], kf_, acc, 0, 0, 0); } \
            if (fq == 0) { _Pragma("unroll") for (int r = 0; r < 4; ++r) L[(4 * g + r) * 256 + 16 * (kt) + fr] = (16 * (kt) + fr < nsel) ? acc[r] * scale : -__builtin_inff(); } } } while (0)
        QK_LOAD(0, 0); if (1 < nkt) QK_LOAD(1, 1);
        for (int kt = 0; kt < nkt; kt += 3) {
            if (kt + 2 < nkt) QK_LOAD(2, kt + 2);
            __builtin_amdgcn_sched_barrier(0);
            QK_COMP(0, kt);
            if (kt + 1 < nkt) { if (kt + 3 < nkt) QK_LOAD(0, kt + 3); __builtin_amdgcn_sched_barrier(0); QK_COMP(1, kt + 1); }
            if (kt + 2 < nkt) { if (kt + 4 < nkt) QK_LOAD(1, kt + 4); __builtin_amdgcn_sched_barrier(0); QK_COMP(2, kt + 2); }
        }
#undef QK_LOAD
#undef QK_COMP
        if (fq == 0) { for (int kt = nkt; kt < 16; ++kt) {
#pragma unroll
            for (int r = 0; r < 8; ++r) L[r * 256 + 16 * kt + fr] = -__builtin_inff(); } }
    }
    float p[8][4];
#pragma unroll
    for (int hd = 0; hd < 8; ++hd) { float m = -__builtin_inff();
#pragma unroll
        for (int i = 0; i < 4; ++i) { p[hd][i] = L[hd * 256 + lane + 64 * i]; m = fmaxf(m, p[hd][i]); }
        m = wave_max(m); float s = 0.f;
#pragma unroll
        for (int i = 0; i < 4; ++i) { p[hd][i] = __expf(p[hd][i] - m); s += p[hd][i]; }
        s = 1.0f / wave_sum(s);
#pragma unroll
        for (int i = 0; i < 4; ++i) p[hd][i] *= s; }
    LAS bf16_t* Pb = (LAS bf16_t*)(wl + 1024);
#pragma unroll
    for (int hd = 0; hd < 8; ++hd)
#pragma unroll
        for (int i = 0; i < 4; ++i) Pb[hd * 256 + lane + 64 * i] = f2bf(p[hd][i]);
    LAS unsigned char* VT = wl + 9216;
    const int half = lane >> 5, l31 = lane & 31, ii = lane & 15, kq = lane >> 4;
    f32x4 acc[16];
#pragma unroll
    for (int nt = 0; nt < 16; ++nt) acc[nt] = (f32x4){0.f, 0.f, 0.f, 0.f};
    const int nch = (nsel + 15) >> 4;
    u32x4 vw[3][8];
#define PV_LOAD(buf, c) do { _Pragma("unroll") for (int u = 0; u < 8; ++u) { const unsigned off_ = (unsigned)selw[16 * (c) + 2 * u + half] * 512u + 16u * (unsigned)l31; vw[buf][u] = *(const u32x4*)((const char*)VC + off_); } } while (0)
#define PV_COMP(buf, c) do { _Pragma("unroll") for (int u = 0; u < 8; ++u) *(LAS u32x4*)(VT + (2 * u + half) * 528 + 16 * l31) = vw[buf][u]; \
        s16x4 pa[2]; _Pragma("unroll") for (int g = 0; g < 2; ++g) { const s16x4 r_ = *(const LAS s16x4*)(Pb + (g * 4 + (ii & 3)) * 256 + 16 * (c) + 4 * kq); pa[g] = ii < 4 ? r_ : (s16x4){0, 0, 0, 0}; } \
        _Pragma("unroll") for (int nt = 0; nt < 16; ++nt) { const s16x4 b_ = __builtin_amdgcn_ds_read_tr16_b64_v4i16((LAS s16x4*)(VT + (4 * kq + (ii >> 2)) * 528 + (16 * nt + 4 * (ii & 3)) * 2)); \
            acc[nt] = __builtin_amdgcn_mfma_f32_16x16x16bf16_1k(pa[nt >> 3], b_, acc[nt], 0, 0, 0); } } while (0)
    PV_LOAD(0, 0); if (1 < nch) PV_LOAD(1, 1);
    for (int c = 0; c < nch; c += 3) {
        if (c + 2 < nch) PV_LOAD(2, c + 2);
        __builtin_amdgcn_sched_barrier(0);
        PV_COMP(0, c);
        if (c + 1 < nch) { if (c + 3 < nch) PV_LOAD(0, c + 3); __builtin_amdgcn_sched_barrier(0); PV_COMP(1, c + 1); }
        if (c + 2 < nch) { if (c + 4 < nch) PV_LOAD(1, c + 4); __builtin_amdgcn_sched_barrier(0); PV_COMP(2, c + 2); }
    }
#undef PV_LOAD
#undef PV_COMP
    LAS float* OB = (LAS float*)(wl + 1024 + 4096);
    if (kq == 0) {
#pragma unroll
        for (int nt = 0; nt < 16; ++nt)
#pragma unroll
            for (int r = 0; r < 4; ++r) OB[(4 * (nt >> 3) + r) * 128 + 16 * (nt & 7) + ii] = acc[nt][r];
    }
    {
        const f32x4 a0 = *(const LAS f32x4*)(OB + 16 * lane), a1 = *(const LAS f32x4*)(OB + 16 * lane + 4), a2 = *(const LAS f32x4*)(OB + 16 * lane + 8), a3 = *(const LAS f32x4*)(OB + 16 * lane + 12);
        u32x4 w0, w1; w0.x = cvt_pk_bf16(a0[0], a0[1]); w0.y = cvt_pk_bf16(a0[2], a0[3]); w0.z = cvt_pk_bf16(a1[0], a1[1]); w0.w = cvt_pk_bf16(a1[2], a1[3]);
        w1.x = cvt_pk_bf16(a2[0], a2[1]); w1.y = cvt_pk_bf16(a2[2], a2[3]); w1.z = cvt_pk_bf16(a3[0], a3[1]); w1.w = cvt_pk_bf16(a3[2], a3[3]);
        u32x4* dst = (u32x4*)(ATT + (size_t)t * 1024 + 16 * lane); dst[0] = w0; dst[1] = w1;
    }
}


__device__ __forceinline__ void convert_item8(const float* __restrict__ W, int K, int N, int ld, unsigned char* WT, int mode, int item, int lane, LAS unsigned char* scr) {
    const int nblk = N >> 6; const int kb = item / nblk, nb = item - kb * nblk; const int k0 = kb * 256, n0 = nb * 64;
    const int c4 = lane & 15, kr = lane >> 4;
    const float* src = W + (size_t)(k0 + 4 * kr) * ld + n0 + 4 * c4;
#pragma unroll 4
    for (int i = 0; i < 16; ++i) {
        f32x4 v[4];
#pragma unroll
        for (int r = 0; r < 4; ++r) v[r] = __builtin_nontemporal_load((const f32x4*)(src + (size_t)(16 * i + r) * ld));
        const int kk = 16 * i + 4 * kr;
#pragma unroll
        for (int e = 0; e < 4; ++e) *(LAS unsigned*)(scr + (4 * c4 + e) * 272 + kk) = pack4_fp8(v[0][e] * W8_SCALE, v[1][e] * W8_SCALE, v[2][e] * W8_SCALE, v[3][e] * W8_SCALE);
    }
    LDS_WAIT(); asm volatile("" ::: "memory");
#pragma unroll 4
    for (int j = 0; j < 16; ++j) {
        const int q = j * 64 + lane, n = q >> 4, ch = q & 15;
        const u32x4 v = *(const LAS u32x4*)(scr + n * 272 + ch * 16);
        *(u32x4*)(WT + (size_t)dest_row(mode, n0 + n) * K + k0 + ch * 16) = v;
    }
    LDS_WAIT(); asm volatile("" ::: "memory");
}

struct Conv8Job { const float* W; unsigned char* WT; int N; int mode; size_t w_estride, wt_estride; int items_per_e; };
__device__ __forceinline__ void conv8_load(const Conv8Job& jb, int item, int wave, int lane, f32x4 (&v)[16]) {
    const int e = item / jb.items_per_e, r = item - e * jb.items_per_e; const int nblk = jb.N >> 8; const int kb = r / nblk, nb = r - kb * nblk;
    const float* src = jb.W + (size_t)e * jb.w_estride + (size_t)(kb * 128 + 16 * wave) * jb.N + nb * 256 + 4 * lane;
#pragma unroll
    for (int i = 0; i < 16; ++i) v[i] = __builtin_nontemporal_load((const f32x4*)(src + (size_t)i * jb.N));
}
__device__ __forceinline__ void conv8_to_lds(LAS unsigned char* img, int wave, int lane, const f32x4 (&v)[16]) {
#pragma unroll
    for (int g = 0; g < 4; ++g)
#pragma unroll
        for (int e = 0; e < 4; ++e) *(LAS unsigned*)(img + (4 * lane + e) * 144 + 16 * wave + 4 * g) = pack4_fp8(v[4 * g][e] * W8_SCALE, v[4 * g + 1][e] * W8_SCALE, v[4 * g + 2][e] * W8_SCALE, v[4 * g + 3][e] * W8_SCALE);
}
__device__ __forceinline__ void conv8_store(const Conv8Job& jb, int item, const LAS unsigned char* img, int tid) {
    const int e = item / jb.items_per_e, r = item - e * jb.items_per_e; const int nblk = jb.N >> 8; const int kb = r / nblk, nb = r - kb * nblk;
    unsigned char* dst = jb.WT + (size_t)e * jb.wt_estride + kb * 128;
#pragma unroll
    for (int j = 0; j < 4; ++j) { const int q = j * 512 + tid, n = q >> 3, ch = q & 7;
        *(u32x4*)(dst + (size_t)dest_row(jb.mode, nb * 256 + n) * 2048 + ch * 16) = *(const LAS u32x4*)(img + n * 144 + ch * 16); }
}
__device__ __forceinline__ void conv8_run(LAS unsigned char* lds, const Conv8Job& jb, int n_items, int wg, int G, int tid, int wave, int lane) {
    f32x4 v[16]; int it = wg, par = 0;
    if (it < n_items) conv8_load(jb, it, wave, lane, v);
    for (; it < n_items; it += G, par ^= 1) {
        LAS unsigned char* img = lds + par * 36864;
        conv8_to_lds(img, wave, lane, v);
        __syncthreads();
        if (it + G < n_items) conv8_load(jb, it + G, wave, lane, v);
        conv8_store(jb, it, img, tid);
    }
    __syncthreads();
}

__global__ void __launch_bounds__(NTHR, 2) fwd_kernel(Args args) {
    extern __shared__ __attribute__((aligned(16))) unsigned char lds_raw[];
    LAS unsigned char* lds = (LAS unsigned char*)lds_raw;
    volatile LAS unsigned* MISC = (volatile LAS unsigned*)(lds + LDS_MISC);
    const int tid = threadIdx.x, lane = tid & 63, wave = __builtin_amdgcn_readfirstlane(tid >> 6);
    const int G = gridDim.x, wg = blockIdx.x;
    unsigned char* ws = args.ws;
    unsigned* ctl = (unsigned*)(ws + WS_CTL);
    const int lo = args.ph_lo, hi = args.ph_hi;
    const float* x = (const float*)args.in[0]; const float* cvec = (const float*)args.in[1]; const int* positions = (const int*)args.in[2];
    const float* w_ada = (const float*)args.in[3]; const float* b_ada = (const float*)args.in[4]; const float* norm1_g = (const float*)args.in[5];
    const float* w_in = (const float*)args.in[6]; const float* idx_knorm_g = (const float*)args.in[7]; const float* idx_knorm_b = (const float*)args.in[8];
    const float* lb_logits = (const float*)args.in[9]; const float* hgrn_norm_g = (const float*)args.in[10];
    const float* w_proj_att = (const float*)args.in[11]; const float* w_proj_hgrn = (const float*)args.in[12]; const float* w_out = (const float*)args.in[13];
    const float* norm2_g = (const float*)args.in[14]; const float* w_router = (const float*)args.in[15]; const float* b_router = (const float*)args.in[16];
    const float* w1 = (const float*)args.in[17]; const float* b1 = (const float*)args.in[18]; const float* w2 = (const float*)args.in[19]; const float* b2 = (const float*)args.in[20];
    const float* final_g = (const float*)args.in[21];
    float* out = args.out;
    float* MOD = (float*)(ws + WS_MOD); int* TOPE = (int*)(ws + WS_TOPE); float* GATE = (float*)(ws + WS_GATE); int* SLOT = (int*)(ws + WS_SLOT);
    bf16_t* WIN_T = (bf16_t*)(ws + WS_WIN_T); bf16_t* WA_T = (bf16_t*)(ws + WS_WA_T); bf16_t* WH_T = (bf16_t*)(ws + WS_WH_T); bf16_t* WO_T = (bf16_t*)(ws + WS_WO_T);
    unsigned char* WIN_T8 = ws + WS_WIN_T + 8 * MiB;
    unsigned char* HA8 = ws + WS_SCORES;
    unsigned char* W1_T = ws + WS_W1_T; unsigned char* W2_T = ws + WS_W2_T;
    bf16_t* HB = (bf16_t*)(ws + WS_H); bf16_t* PROJ = (bf16_t*)(ws + WS_PROJ);
    bf16_t* DELTA = (bf16_t*)(ws + WS_ATT);
    unsigned char* ACT = ws + WS_ACT; bf16_t* YB = (bf16_t*)(ws + WS_YB);
    int* TOKS = (int*)(ws + WS_TOKS);
    unsigned char* H8 = ws + WS_H;
    bf16_t* KI = (bf16_t*)(ws + WS_KI); bf16_t* KC = (bf16_t*)(ws + WS_KC); bf16_t* VC = (bf16_t*)(ws + WS_VC);
    float* ST = (float*)(ws + WS_ST); float* DC = (float*)(ws + WS_DC);
    bf16_t* ATT = (bf16_t*)(ws + WS_ATT); bf16_t* REC = (bf16_t*)(ws + WS_REC); bf16_t* MERGED = (bf16_t*)(ws + WS_MERGED); unsigned short* SCORES = (unsigned short*)(ws + WS_SCORES);

    for (int u = tid; u < 128; u += NTHR) MISC[u] = 0u;
    __syncthreads();
    const bool one_launch = (hi - lo) > 1;
    XcdBarrier bar; bar.bar = ctl + CW_BAR; bar.x = 0; bar.st = MISC + 8;
    if (one_launch) bar = xcd_barrier_post(ctl + CW_BAR, MISC + 8);
#define IN(k) (lo <= (k) && (k) < hi)
#define SEAM(k) do { if (IN(k) && IN((k) + 1)) xcd_barrier(bar); } while (0)


    if (IN(PH_PRO)) {
        for (int cb = wg; cb < 256; cb += G) {
            LAS float* red = (LAS float*)lds;
            const int c4 = tid % 12, kg = tid / 12;
            f32x4 acc = (f32x4){0.f, 0.f, 0.f, 0.f};
            if (kg < 42) {
                const float* wp = w_ada + (size_t)cb * 48 + 4 * c4;
#pragma unroll 7
                for (int j = 0; j < 49; ++j) { const int k = kg + 42 * j; if (k < D) { const f32x4 v = __builtin_nontemporal_load((const f32x4*)(wp + (size_t)k * (6 * D))); acc += siluf_(cvec[k]) * v; } }
                *(LAS f32x4*)(red + kg * 48 + 4 * c4) = acc;
            }
            __syncthreads();
            if (tid < 48) { float s = b_ada[cb * 48 + tid];
#pragma unroll 6
                for (int q = 0; q < 42; ++q) s += red[q * 48 + tid];
                MOD[cb * 48 + tid] = s; }
            __syncthreads();
        }
        LAS unsigned char* scr = lds + wave * 17408;
        const int gw = wg * NWAVES + wave, NGW = G * NWAVES;
        {
            constexpr int NB_IN = (1104 + 63) / 64;
            for (int it = gw; it < 16 * NB_IN; it += NGW) convert_item(w_in + 1536, 2048, 1104, DIN, WIN_T, 0, it, lane, scr);
            for (int it = gw; it < 8 * 32; it += NGW) convert_item(w_proj_att, 1024, 2048, 2048, WA_T, 0, it, lane, scr);
            for (int it = gw; it < 8 * 32; it += NGW) convert_item(w_proj_hgrn, 1024, 2048, 2048, WH_T, 0, it, lane, scr);
            for (int it = gw; it < 16 * 32; it += NGW) convert_item(w_out, 2048, 2048, 2048, WO_T, 0, it, lane, scr);
            for (int it = gw; it < 8 * 24; it += NGW) convert_item8(w_in, 2048, 1536, DIN, WIN_T8, 0, it, lane, scr);
            for (int it = gw; it < 8 * 128; it += NGW) convert_item8(w_in + 2640, 2048, 8192, DIN, WIN_T8 + (size_t)1536 * 2048, 0, it, lane, scr);
            for (size_t i = (size_t)wg * NTHR + tid; i < (size_t)176 * 2048 * 2 / 16; i += (size_t)G * NTHR) ((u32x4*)(WIN_T + (size_t)1104 * 2048))[i] = (u32x4){0u, 0u, 0u, 0u};
        }
        {
            __syncthreads();
            const Conv8Job j1{w1, W1_T, 4096, 2, (size_t)2048 * 4096, (size_t)4096 * 2048, 16 * 16}; conv8_run(lds, j1, NEXP * 16 * 16, wg, G, tid, wave, lane);
            const Conv8Job j2{w2, W2_T, 2048, 0, (size_t)2048 * 2048, (size_t)2048 * 2048, 16 * 8};  conv8_run(lds, j2, NEXP * 16 * 8, wg, G, tid, wave, lane);
        }
    }
    SEAM(PH_PRO);

    {
    if (IN(PH_H)) {
        const float* sh1 = MOD; const float* sc1 = MOD + D;
        const int gw = wg * NWAVES + wave, NGW = G * NWAVES;
        f32x4 gs[8], sh[8];
#pragma unroll
        for (int j = 0; j < 8; ++j) { const int c = 4 * lane + 256 * j; const f32x4 g = *(const f32x4*)(norm1_g + c), sc = *(const f32x4*)(sc1 + c); sh[j] = *(const f32x4*)(sh1 + c);
#pragma unroll
            for (int e = 0; e < 4; ++e) gs[j][e] = g[e] * (1.0f + sc[e]); }
        for (int t = gw; t < S; t += NGW) {
            const f32x4* xr = (const f32x4*)(x + (size_t)t * D) + lane;
            f32x4 v[8]; float ss = 0.f;
#pragma unroll
            for (int j = 0; j < 8; ++j) { v[j] = xr[64 * j]; ss += (v[j][0] * v[j][0] + v[j][1] * v[j][1]) + (v[j][2] * v[j][2] + v[j][3] * v[j][3]); }
            const float rstd = rsqrtf(wave_sum(ss) * (1.0f / D) + NORM_EPS);
#pragma unroll
            for (int j = 0; j < 8; ++j) { const f32x4 h = v[j] * rstd * gs[j] + sh[j]; u32x2 w; w.x = cvt_pk_bf16(h[0], h[1]); w.y = cvt_pk_bf16(h[2], h[3]);
                *(u32x2*)(HB + (size_t)t * D + 4 * lane + 256 * j) = w;
                *(unsigned*)(HA8 + (size_t)t * D + 4 * lane + 256 * j) = pack4_fp8(h[0], h[1], h[2], h[3]); }
        }
    }
    SEAM(PH_H);
    if (IN(PH_INPROJ)) {
        {
            pg8::Gemm g8{HA8, WIN_T8, 2048, 0, nullptr, 0}; pg8::StaticOrder S8; S8.init(S, 9728, G, wg);
            pg8::EpiBf16 E8{PROJ, DINP, nullptr, 0, 1.0f / W8_SCALE, 6, 1280};
            pg8::gemm_phase<pg8::EpiBf16, pg8::StaticOrder, true>(lds, g8, S8, E8);
        }
        {
            pg8::Gemm g{HB, WIN_T, 2048, 0, nullptr, 0}; pg8::StaticOrder So; So.init(S, 1280, G, (wg + 128) % G);
            pg8::EpiBf16 E{PROJ + CQI, DINP, nullptr, 0, 1.0f, 1 << 30, 0};
            pg8::gemm_phase<pg8::EpiBf16, pg8::StaticOrder>(lds, g, So, E);
        }
    }
    SEAM(PH_INPROJ);
    if (IN(PH_POST)) {
        const int gw = wg * NWAVES + wave, NGW = G * NWAVES;
        for (int t = gw; t < S; t += NGW) post_token(PROJ, KI, KC, VC, positions, idx_knorm_g, idx_knorm_b, t, lane);
        __syncthreads();
        for (int u = wg; u < 2048; u += G) hgrn_l1(lds, PROJ, lb_logits, ST, DC, u >> 3, u & 7, tid, wave, lane);
    }
    SEAM(PH_POST);
    if (IN(PH_SCORE)) {
        for (int idx = wg * NTHR + tid; idx < 8 * 128 * 128; idx += G * NTHR) {
            const int h = idx >> 14, d = idx & 127; float s = 0.f;
            float* sp = ST + idx; const float* dp = DC + h * 128 + d;
            for (int c = 0; c < 256; c += 8) {
                float l[8], dc[8];
#pragma unroll
                for (int i = 0; i < 8; ++i) { l[i] = sp[(size_t)(c + i) * 131072]; dc[i] = dp[(size_t)(c + i) * 1024]; }
#pragma unroll
                for (int i = 0; i < 8; ++i) { sp[(size_t)(c + i) * 131072] = s; s = dc[i] * s + l[i]; }
            }
        }
        {
            for (int j = wg; j < 252; j += G) { score_block(lds, PROJ, KI, SCORES, 8 + j, tid, wave, lane); score_block(lds, PROJ, KI, SCORES, 511 - j, tid, wave, lane); }
        }
    }
    SEAM(PH_SCORE);
    if (IN(PH_ATTN)) {
        const int gw = wg * NWAVES + wave, NGW = G * NWAVES;
        for (int u = wg; u < 2048; u += G) hgrn_l3(lds, PROJ, lb_logits, ST, hgrn_norm_g, REC, u >> 3, u & 7, tid, wave, lane);
        {
            for (int t = gw; t < S; t += NGW) {
                LAS unsigned char* wl = lds + wave * 17664;
                if (t >= 256) select_row(wl, SCORES, t, lane);
                else {
#pragma unroll
                    for (int i = 0; i < 4; ++i) { const int idx = lane + 64 * i; ((LAS int*)wl)[idx] = idx <= t ? idx : 0; }
                }
                attn_query(wl, PROJ, KC, VC, ATT, t, lane);
            }
        }
    }
    SEAM(PH_ATTN);
    if (IN(PH_OP1)) {
        pg8::Gemm g{ATT, WA_T, 1024, (size_t)2048 * 1024 * 2, nullptr, (size_t)S * 1024 * 2};
        pg8::TwoPartOrder So; So.init(S, 2048, G, wg);
        pg8::EpiGate2 E{MERGED, PROJ + CGA, PROJ + CGR};
        pg8::gemm_phase<pg8::EpiGate2, pg8::TwoPartOrder>(lds, g, So, E);
    }
    SEAM(PH_OP2);
    if (IN(PH_WOUT)) {
        pg8::Gemm g{MERGED, WO_T, 2048, 0, nullptr, 0}; pg8::StaticOrder So; So.init(S, 2048, G, wg);
        pg8::EpiDelta E{MOD + 2 * D, DELTA};
        pg8::gemm_phase<pg8::EpiDelta, pg8::StaticOrder>(lds, g, So, E);
    }
    SEAM(PH_WOUT);
    }

    if (IN(PH_ROUTER)) {
        LAS float* hs = (LAS float*)lds;
        volatile LAS unsigned* lcnt = MISC + 32;
        const float* sh2 = MOD + 3 * D; const float* sc2 = MOD + 4 * D;
        if (tid < 32) lcnt[tid] = 0u;
        __syncthreads();
        for (int grp = wg; grp < S / 16; grp += G) {
#pragma unroll 1
            for (int q = 0; q < 2; ++q) {
                const int tl = 2 * wave + q, t = grp * 16 + tl;
                const f32x4* xr = (const f32x4*)(x + (size_t)t * D) + lane; const u32x2* dr = (const u32x2*)(DELTA + (size_t)t * D) + lane;
                f32x4 v[8]; float ss = 0.f;
#pragma unroll
                for (int j = 0; j < 8; ++j) { const u32x2 dw = dr[64 * j]; v[j] = xr[64 * j] + (f32x4){bf_lo(dw.x), bf_hi(dw.x), bf_lo(dw.y), bf_hi(dw.y)};
                    ss += (v[j][0] * v[j][0] + v[j][1] * v[j][1]) + (v[j][2] * v[j][2] + v[j][3] * v[j][3]); }
                const float rstd = rsqrtf(wave_sum(ss) * (1.0f / D) + NORM_EPS);
#pragma unroll
                for (int j = 0; j < 8; ++j) {
                    const int c = 4 * lane + 256 * j;
                    const f32x4 g = *(const f32x4*)(norm2_g + c), sc = *(const f32x4*)(sc2 + c), sh = *(const f32x4*)(sh2 + c);
                    f32x4 h;
#pragma unroll
                    for (int e = 0; e < 4; ++e) h[e] = v[j][e] * rstd * g[e] * (1.0f + sc[e]) + sh[e];
                    *(LAS f32x4*)(hs + tl * 2048 + c) = h;
                    *(unsigned*)(H8 + (size_t)t * D + c) = pack4_fp8(h[0], h[1], h[2], h[3]);
                }
            }
            __syncthreads();
            {
                LAS float* part = (LAS float*)(lds + 131072);
                const int fr = lane & 15, fq = lane >> 4;
                f32x4 acc0 = (f32x4){0.f, 0.f, 0.f, 0.f}, acc1 = acc0;
                const LAS float* hrow = hs + fr * 2048 + wave * 256 + 4 * fq; const float* wrp = w_router + (size_t)(wave * 256 + 4 * fq) * 32 + fr;
#pragma unroll 2
                for (int i = 0; i < 16; ++i) {
                    const f32x4 a4 = *(const LAS f32x4*)(hrow + 16 * i);
                    float b0[4], b1[4];
#pragma unroll
                    for (int s = 0; s < 4; ++s) { b0[s] = wrp[(size_t)(16 * i + s) * 32]; b1[s] = wrp[(size_t)(16 * i + s) * 32 + 16]; }
#pragma unroll
                    for (int s = 0; s < 4; ++s) { acc0 = __builtin_amdgcn_mfma_f32_16x16x4f32(a4[s], b0[s], acc0, 0, 0, 0); acc1 = __builtin_amdgcn_mfma_f32_16x16x4f32(a4[s], b1[s], acc1, 0, 0, 0); }
                }
#pragma unroll
                for (int r = 0; r < 4; ++r) { part[(wave * 16 + 4 * fq + r) * 32 + fr] = acc0[r]; part[(wave * 16 + 4 * fq + r) * 32 + 16 + fr] = acc1[r]; }
                __syncthreads();
                const int tl = tid >> 5, e = tid & 31, t = grp * 16 + tl;
                float v = b_router[e];
#pragma unroll
                for (int w = 0; w < 8; ++w) v += part[(w * 16 + tl) * 32 + e];
                float tv[4]; int ti[4];
#pragma unroll
                for (int k = 0; k < 4; ++k) {
                    float bv = v; int bi = e;
#pragma unroll
                    for (int o = 16; o >= 1; o >>= 1) { const float ov = __shfl_xor(bv, o); const int oi = __shfl_xor(bi, o); if (ov > bv || (ov == bv && oi < bi)) { bv = ov; bi = oi; } }
                    tv[k] = bv; ti[k] = bi; if (e == bi) v = -__builtin_inff();
                }
                if (e == 0) {
                    const float e1 = __expf(tv[1] - tv[0]), e2 = __expf(tv[2] - tv[0]), e3 = __expf(tv[3] - tv[0]); const float inv = 1.0f / (1.0f + e1 + e2 + e3);
                    *(int4*)(TOPE + (size_t)t * 4) = make_int4(ti[0], ti[1], ti[2], ti[3]);
                    *(f32x4*)(GATE + (size_t)t * 4) = (f32x4){inv, e1 * inv, e2 * inv, e3 * inv};
#pragma unroll
                    for (int k = 0; k < 4; ++k) __hip_atomic_fetch_add((LAS unsigned*)&lcnt[ti[k]], 1u, __ATOMIC_RELAXED, __HIP_MEMORY_SCOPE_WORKGROUP);
                }
            }
            __syncthreads();
        }
        if (tid < 32) { const unsigned c = lcnt[tid]; if (c) __hip_atomic_fetch_add(ctl + CW_CNT + tid, c, __ATOMIC_RELAXED, __HIP_MEMORY_SCOPE_AGENT); }
    }
    SEAM(PH_ROUTER);

    if (IN(PH_SCATTER)) {
        volatile LAS unsigned* lcnt = MISC + 32; volatile LAS unsigned* lbase = MISC + 64; LAS int* pstart = (LAS int*)(lds + 1024); LAS int* pcnt = (LAS int*)(lds + 1280);
        if (tid == 0) { int p = 0; for (int e = 0; e < NEXP; ++e) { const int c = (int)__hip_atomic_load(ctl + CW_CNT + e, __ATOMIC_RELAXED, __HIP_MEMORY_SCOPE_AGENT); pstart[e] = p; pcnt[e] = c; p += (c + 255) & ~255; } }
        if (tid < 32) lcnt[tid] = 0u;
        __syncthreads();
        if (wg < NEXP) { const int e = wg; for (int s = pstart[e] + pcnt[e] + tid; s < pstart[e] + ((pcnt[e] + 255) & ~255); s += NTHR) TOKS[s] = 0; }
        for (int blk = wg; blk < S / 64; blk += G) {
            int e = 0, lrank = 0;
            if (tid < 256) { e = TOPE[(size_t)blk * 256 + tid]; lrank = (int)__hip_atomic_fetch_add((LAS unsigned*)&lcnt[e], 1u, __ATOMIC_RELAXED, __HIP_MEMORY_SCOPE_WORKGROUP); }
            __syncthreads();
            if (tid < 32) { const unsigned c = lcnt[tid]; lbase[tid] = c ? __hip_atomic_fetch_add(ctl + CW_FILL + tid, c, __ATOMIC_RELAXED, __HIP_MEMORY_SCOPE_AGENT) : 0u; }
            __syncthreads();
            if (tid < 256) { const int slot = pstart[e] + (int)lbase[e] + lrank; SLOT[(size_t)blk * 256 + tid] = slot; TOKS[slot] = blk * 64 + (tid >> 2); }
            __syncthreads();
            if (tid < 32) lcnt[tid] = 0u;
            __syncthreads();
        }
    }
    SEAM(PH_SCATTER);

    if (IN(PH_MOE1) || IN(PH_MOE2)) {
        LAS int* panel_e = (LAS int*)(lds + 131072 + 2048);
        LAS int* npan = (LAS int*)(lds + 131072 + 2048 + 2048);
        __syncthreads();
        if (tid == 0) { int p = 0; for (int e = 0; e < NEXP; ++e) { const int np = (int)((__hip_atomic_load(ctl + CW_CNT + e, __ATOMIC_RELAXED, __HIP_MEMORY_SCOPE_AGENT) + 255u) >> 8); for (int q = 0; q < np; ++q) panel_e[p + q] = e; p += np; } npan[0] = p; }
        __syncthreads();
        const int nPanels = npan[0];
        if (IN(PH_MOE1)) {
            pg8::Gemm g{H8, W1_T, 2048, (size_t)4096 * 2048, TOKS, 0}; pg8::MoeOrder So; So.init(nPanels, 16, G, wg, panel_e);
            pg8::EpiSwiglu E{ACT, b1};
            pg8::gemm_phase<pg8::EpiSwiglu, pg8::MoeOrder, true>(lds, g, So, E);
        }
        SEAM(PH_MOE1);
        if (IN(PH_MOE2)) {
            pg8::Gemm g{ACT, W2_T, 2048, (size_t)2048 * 2048, nullptr, 0}; pg8::MoeOrder So; So.init(nPanels, 8, G, wg, panel_e);
            pg8::EpiBf16 E{YB, 2048, b2, 2048, 1.0f / (W8_SCALE * ACT8_SCALE), 1 << 30, 0};
            pg8::gemm_phase<pg8::EpiBf16, pg8::MoeOrder, true>(lds, g, So, E);
        }
    }
    SEAM(PH_MOE2);

    if (IN(PH_FINAL)) {
        const float* gt2 = MOD + 5 * D;
        const int gw = wg * NWAVES + wave, NGW = G * NWAVES;
        for (int t = gw; t < S; t += NGW) {
            const f32x4* xr = (const f32x4*)(x + (size_t)t * D) + lane; const u32x2* dr = (const u32x2*)(DELTA + (size_t)t * D) + lane;
            f32x4 v[8];
#pragma unroll
            for (int j = 0; j < 8; ++j) { const u32x2 dw = dr[64 * j]; v[j] = xr[64 * j] + (f32x4){bf_lo(dw.x), bf_hi(dw.x), bf_lo(dw.y), bf_hi(dw.y)}; }
            {
                f32x4 m[8];
#pragma unroll
                for (int j = 0; j < 8; ++j) m[j] = (f32x4){0.f, 0.f, 0.f, 0.f};
                const int4 sl = *(const int4*)(SLOT + (size_t)t * 4); const f32x4 gt = *(const f32x4*)(GATE + (size_t)t * 4);
                const int sls[4] = {sl.x, sl.y, sl.z, sl.w};
#pragma unroll
                for (int k = 0; k < 4; ++k) {
                    const u32x2* yr = (const u32x2*)(YB + (size_t)sls[k] * D) + lane; const float gk = gt[k];
#pragma unroll
                    for (int j = 0; j < 8; ++j) { const u32x2 w = yr[64 * j]; m[j][0] += gk * bf_lo(w.x); m[j][1] += gk * bf_hi(w.x); m[j][2] += gk * bf_lo(w.y); m[j][3] += gk * bf_hi(w.y); }
                }
#pragma unroll
                for (int j = 0; j < 8; ++j) { const f32x4 g2 = *(const f32x4*)(gt2 + 4 * lane + 256 * j); v[j] = v[j] + g2 * m[j]; }
            }
            float ss = 0.f;
#pragma unroll
            for (int j = 0; j < 8; ++j) ss += (v[j][0] * v[j][0] + v[j][1] * v[j][1]) + (v[j][2] * v[j][2] + v[j][3] * v[j][3]);
            const float rstd = rsqrtf(wave_sum(ss) * (1.0f / D) + NORM_EPS);
            f32x4* orow = (f32x4*)(out + (size_t)t * D) + lane;
#pragma unroll
            for (int j = 0; j < 8; ++j) { const f32x4 fg = *(const f32x4*)(final_g + 4 * lane + 256 * j); orow[64 * j] = v[j] * rstd * fg; }
        }
    }
#undef IN
#undef SEAM
}

#ifndef MK_ONE_LAUNCH
#define MK_ONE_LAUNCH 1
#endif
extern "C" void kernel_launch(void* const* d_in, const int* in_sizes, int n_in, void* d_out, int out_size, void* d_ws, size_t ws_size, hipStream_t stream) {
    static int grid = 0;
    if (grid == 0) {
        if (n_in != 22 || out_size != S * D || ws_size < WS_END) { fprintf(stderr, "kernel_launch: unexpected shapes: n_in %d out %d ws %zu (need %zu)\n", n_in, out_size, ws_size, (size_t)WS_END); grid = -1; return; }
        int dev = 0, cus = 0, per_cu = 0;
        if (hipGetDevice(&dev) != hipSuccess || hipDeviceGetAttribute(&cus, hipDeviceAttributeMultiprocessorCount, dev) != hipSuccess) { grid = -1; return; }
        if (hipFuncSetAttribute((const void*)fwd_kernel, hipFuncAttributeMaxDynamicSharedMemorySize, LDS_BYTES) != hipSuccess) { fprintf(stderr, "kernel_launch: hipFuncSetAttribute failed\n"); grid = -1; return; }
        if (hipOccupancyMaxActiveBlocksPerMultiprocessor(&per_cu, (const void*)fwd_kernel, NTHR, LDS_BYTES) != hipSuccess || per_cu < 1) { fprintf(stderr, "kernel_launch: occupancy query says %d\n", per_cu); (void)hipGetLastError(); grid = -1; return; }
        grid = cus;
    }
    if (grid < 0) return;
    (void)in_sizes;
    hipMemsetAsync((char*)d_ws + WS_CTL, 0, CTL_BYTES, stream);
    Args a{};
    for (int i = 0; i < 22; ++i) a.in[i] = d_in[i];
    a.out = (float*)d_out; a.ws = (unsigned char*)d_ws; a.flags = 0; a.pad = 0;
#if MK_ONE_LAUNCH
    a.ph_lo = 0; a.ph_hi = NPH;
    hipLaunchKernelGGL(fwd_kernel, dim3(grid), dim3(NTHR), LDS_BYTES, stream, a);
#else
    for (int p = 0; p < NPH; ++p) { a.ph_lo = p; a.ph_hi = p + 1; hipLaunchKernelGGL(fwd_kernel, dim3(grid), dim3(NTHR), LDS_BYTES, stream, a); }
#endif
}
```

```cpp
#include <hip/hip_runtime.h>
#include <cstdio>
#include <cstdint>

#define GAS __attribute__((address_space(1)))
#define LAS __attribute__((address_space(3)))
typedef unsigned short bf16_t;
typedef short bf16x8 __attribute__((ext_vector_type(8)));
typedef float f32x4 __attribute__((ext_vector_type(4)));
typedef float f32x2 __attribute__((ext_vector_type(2)));
typedef float f32x16 __attribute__((ext_vector_type(16)));
typedef unsigned u32x4 __attribute__((ext_vector_type(4)));
typedef unsigned u32x2 __attribute__((ext_vector_type(2)));
typedef int i32x4 __attribute__((ext_vector_type(4)));
typedef int i32x8 __attribute__((ext_vector_type(8)));
typedef short s16x4 __attribute__((ext_vector_type(4)));
typedef short s16x2 __attribute__((ext_vector_type(2)));

constexpr int S = 16384, D = 2048, DIN = 10832, DINP = 11008, NEXP = 32, DFF = 2048;
constexpr int NWAVES = 8, NTHR = 512;
constexpr int CQ = 0, CK = 1024, CV = 1280, CQI = 1536, CKI = 2560, CWI = 2624, CHQ = 2816, CHF = 3840, CHI = 4864, CHG = 5888, CGA = 6912, CGR = 8960;
constexpr int PMAX = 65536 + NEXP * 256;
constexpr float NORM_EPS = 1e-5f;

constexpr size_t MiB = 1u << 20;
constexpr size_t al256(size_t x) { return (x + 255) & ~(size_t)255; }
constexpr size_t WS_CTL = 0, CTL_BYTES = 1 * MiB;
constexpr size_t WS_MOD = WS_CTL + CTL_BYTES;
constexpr size_t WS_TOPE = WS_MOD + 64 * 1024;
constexpr size_t WS_GATE = WS_TOPE + (size_t)S * 16;
constexpr size_t WS_SLOT = WS_GATE + (size_t)S * 16;
constexpr size_t WS_WIN_T = WS_SLOT + (size_t)S * 16;
constexpr size_t WS_WA_T = WS_WIN_T + (size_t)DINP * D * 2;
constexpr size_t WS_WH_T = WS_WA_T + (size_t)2048 * 1024 * 2;
constexpr size_t WS_WO_T = WS_WH_T + (size_t)2048 * 1024 * 2;
constexpr size_t WS_W1_T = WS_WO_T + (size_t)2048 * 2048 * 2;
constexpr size_t WS_W2_T = WS_W1_T + (size_t)NEXP * 4096 * 2048 * 2;
constexpr size_t WS_H = WS_W2_T + (size_t)NEXP * 2048 * 2048 * 2;
constexpr size_t WS_PROJ = WS_H + (size_t)S * D * 2;
constexpr size_t WS_KI = WS_PROJ + (size_t)S * DINP * 2;
constexpr size_t WS_KC = WS_KI + (size_t)S * 64 * 2;
constexpr size_t WS_VC = WS_KC + (size_t)S * 256 * 2;
constexpr size_t WS_ST = WS_VC + (size_t)S * 256 * 2;
constexpr size_t WS_DC = WS_ST + (size_t)256 * 8 * 128 * 128 * 4;
constexpr size_t WS_SEL = WS_DC + (size_t)256 * 8 * 128 * 4;
constexpr size_t WS_ATT = WS_SEL + (size_t)S * 256 * 4;
constexpr size_t WS_REC = WS_ATT + (size_t)S * 1024 * 2;
constexpr size_t WS_MERGED = WS_REC + (size_t)S * 1024 * 2;
constexpr size_t WS_X1 = WS_MERGED + (size_t)S * 2048 * 2;
constexpr size_t WS_SCORES = WS_X1 + (size_t)S * 2048 * 4;
constexpr size_t WS_XB = WS_SCORES;
constexpr size_t WS_ACT = WS_XB + (size_t)PMAX * 2048 * 2;
constexpr size_t WS_YB = WS_ACT + (size_t)PMAX * 2048 * 2;
constexpr size_t WS_END = WS_SCORES + (size_t)S * S * 4;
static_assert(WS_YB + (size_t)PMAX * 2048 * 2 <= WS_END, "MoE buffers overlay the score matrix");
static_assert(WS_END <= (size_t)4096 * MiB, "workspace");
constexpr int CW_BAR = 4096, CW_CNT = 8192, CW_FILL = 8448;
constexpr size_t WS_TOKS = WS_SEL;

constexpr int LDS_BYTES = 155648;
constexpr int LDS_MISC = LDS_BYTES - 512;

__device__ __forceinline__ unsigned cvt_pk_bf16(float lo, float hi) { unsigned r; asm volatile("v_cvt_pk_bf16_f32 %0, %1, %2" : "=v"(r) : "v"(lo), "v"(hi)); return r; }
__device__ __forceinline__ float bf_lo(unsigned u) { return __uint_as_float(u << 16); }
__device__ __forceinline__ float bf_hi(unsigned u) { return __uint_as_float(u & 0xffff0000u); }
__device__ __forceinline__ float bf2f(bf16_t b) { return __uint_as_float(((unsigned)b) << 16); }
__device__ __forceinline__ float wave_sum(float v) {
#pragma unroll
    for (int o = 1; o < 64; o <<= 1) v += __shfl_xor(v, o);
    return v;
}
__device__ __forceinline__ float wave_max(float v) {
#pragma unroll
    for (int o = 1; o < 64; o <<= 1) v = fmaxf(v, __shfl_xor(v, o));
    return v;
}
__device__ __forceinline__ float sigmoidf_(float x) { return __builtin_amdgcn_rcpf(1.0f + __expf(-x)); }
__device__ __forceinline__ float siluf_(float x) { return x * __builtin_amdgcn_rcpf(1.0f + __expf(-x)); }
__device__ __forceinline__ unsigned pack4_fp8(float a, float b, float c, float d) { int w = 0; w = __builtin_amdgcn_cvt_pk_fp8_f32(a, b, w, false); w = __builtin_amdgcn_cvt_pk_fp8_f32(c, d, w, true); return (unsigned)w; }
constexpr float W8_SCALE = 64.0f, ACT8_SCALE = 4.0f;
__device__ __forceinline__ float relu_i(float x) { const int i = __float_as_int(x); return __int_as_float(i > 0 ? i : 0); }
#define LDS_WAIT() asm volatile("s_waitcnt lgkmcnt(0)" ::: "memory")
#define VM_WAIT() asm volatile("s_waitcnt vmcnt(0)" ::: "memory")

#define XB_TMO      128
#define XB_XCNT(j)  (256  + 64 * (j))
#define XB_XSUB(j)  (1280 + 64 * (j))
#define XB_XGEN(j)  (2304 + 64 * (j))
#define XB_TOP      3328
#define XB_TOPGEN   3392
#define XCD_BAR_WORDS 3456
#define XB_SPIN_CAP (1u << 22)

__device__ __forceinline__ unsigned xb_ld(unsigned* p)              { return __hip_atomic_load(p, __ATOMIC_RELAXED, __HIP_MEMORY_SCOPE_AGENT); }
__device__ __forceinline__ unsigned xb_add(unsigned* p, unsigned v) { return __hip_atomic_fetch_add(p, v, __ATOMIC_RELAXED, __HIP_MEMORY_SCOPE_AGENT); }
__device__ __forceinline__ unsigned xb_xcc_id() { return (unsigned)__builtin_amdgcn_s_getreg((3 << 11) | 20) & 0xFu; }
#define XB_SPIN(cond, bar) do { unsigned _sp = 0; while (cond) { __builtin_amdgcn_s_sleep(1); \
    if ((++_sp & 255u) == 0u) { if (xb_ld(&(bar)[XB_TMO])) break; if (_sp > XB_SPIN_CAP) { atomicAdd(&(bar)[XB_TMO], 1u); break; } } } } while (0)

struct XcdBarrier { unsigned* bar; unsigned x; volatile LAS unsigned* st; };

__device__ __forceinline__ XcdBarrier xcd_barrier_post(unsigned* bar, volatile LAS unsigned* st) {
    XcdBarrier b; b.bar = bar; b.x = xb_xcc_id(); b.st = st;
    if (threadIdx.x == 0) (void)xb_add(&bar[XB_XCNT(b.x)], 1u);
    return b;
}
__device__ __forceinline__ void xcd_barrier_complete(unsigned* bar, unsigned x, unsigned& nloc, unsigned& nx) {
    const unsigned G = gridDim.x * gridDim.y * gridDim.z;
    unsigned sum, cnt, mine, sp = 0u;
    for (;;) {
        sum = 0u; cnt = 0u; mine = 0u;
#pragma unroll
        for (unsigned j = 0; j < 16; ++j) { const unsigned c = xb_ld(&bar[XB_XCNT(j)]); sum += c; cnt += (c > 0u) ? 1u : 0u; mine = (j == x) ? c : mine; }
        if (sum == G) break;
        __builtin_amdgcn_s_sleep(1);
        if ((++sp & 255u) == 0u) { if (xb_ld(&bar[XB_TMO])) break; if (sp > XB_SPIN_CAP) { atomicAdd(&bar[XB_TMO], 1u); break; } }
    }
    nloc = mine > 0u ? mine : 1u; nx = cnt > 0u ? cnt : 1u;
}
__device__ __forceinline__ void xcd_barrier(const XcdBarrier& b) {
    asm volatile("s_waitcnt vmcnt(0)" ::: "memory");
    __syncthreads();
    if (threadIdx.x == 0) {
        unsigned* bar = b.bar;
        __builtin_amdgcn_s_waitcnt(0);
        unsigned nloc = b.st[0], nx = b.st[1];
        if (nloc == 0u) { xcd_barrier_complete(bar, b.x, nloc, nx); b.st[0] = nloc; b.st[1] = nx; }
        const unsigned old = xb_add(&bar[XB_XSUB(b.x)], 1u);
        const unsigned gen = old / nloc;
        if (old + 1u == (gen + 1u) * nloc) {
            __builtin_amdgcn_fence(__ATOMIC_RELEASE, "agent");
            asm volatile("s_waitcnt vmcnt(0)" ::: "memory");
            const unsigned og = xb_add(&bar[XB_TOP], 1u);
            const unsigned tg = og / nx;
            if (og + 1u == (tg + 1u) * nx) xb_add(&bar[XB_TOPGEN], 1u);
            else XB_SPIN(xb_ld(&bar[XB_TOPGEN]) == tg, bar);
            __builtin_amdgcn_fence(__ATOMIC_ACQUIRE, "agent");
            xb_add(&bar[XB_XGEN(b.x)], 1u);
            asm volatile("s_waitcnt vmcnt(0)" ::: "memory");
        } else {
            XB_SPIN(xb_ld(&bar[XB_XGEN(b.x)]) == gen, bar);
            __builtin_amdgcn_fence(__ATOMIC_ACQUIRE, "agent");
            asm volatile("s_waitcnt vmcnt(0)" ::: "memory");
        }
    }
    __syncthreads();
}

namespace pg8 {
constexpr int BM = 256, BK = 64, HALF = 128, HTB = HALF * BK * 2, STAGE_BYTES = 8 * HTB, NXCD = 8, WGM = 8;
__host__ __device__ __forceinline__ int lds_byte(int r, int c) { const int st = (r >> 4) * 2 + (c >> 5), rr = r & 15, cc = c & 31, ob = rr * 64 + cc * 2; return st * 1024 + (ob ^ (((ob >> 9) & 1) << 5)); }
__host__ __device__ __forceinline__ void stage_rc(int b, int& R, int& C) { const int st = b / 1024, sb = b % 1024, swz = sb ^ (((sb >> 9) & 1) << 5); R = (st >> 1) * 16 + swz / 64; C = (st & 1) * 32 + (swz % 64) / 2; }
__host__ __device__ __forceinline__ int perm32(int rho) { const int n = rho >> 4, i = rho & 15; return 8 * (i >> 2) + 4 * n + (i & 3); }

struct Unit { int pm, pn, e; };
struct Gemm { const void* A; const void* Bt; int K; size_t estride; const int* arow; size_t astride; };

struct StaticOrder {
    int nM, nN, nwg, G, c, i, full, erank, en;
    __device__ void init(int M, int N, int G_, int c_) { nM = M / BM; nN = N / BM; nwg = nM * nN; G = G_; c = c_; i = 0; full = 1 << 30; erank = -1; en = 1; }
    __device__ void skew(int full_, int erank_, int en_) { full = full_; erank = erank_; en = en_; }
    __device__ bool next(Unit& u) {
        long L;
        if (i < full) L = (long)i * G + c; else { if (erank < 0) return false; L = (long)full * G + (long)(i - full) * en + erank; }
        ++i; if (L >= nwg) return false;
        int wgid = (int)L; { const int q = nwg / NXCD, r = nwg % NXCD, xcd = wgid % NXCD, off = wgid / NXCD; wgid = (xcd < r ? xcd * (q + 1) : r * (q + 1) + (xcd - r) * q) + off; }
        const int nig = WGM * nN, gid = wgid / nig, fm = gid * WGM, gsz = (nM - fm) < WGM ? (nM - fm) : WGM;
        u.pm = fm + ((wgid % nig) % gsz); u.pn = (wgid % nig) / gsz; u.e = 0; return true;
    }
};
struct MoeOrder {
    int nPanels, nN, G, c, i; const LAS int* panel_e;
    __device__ void init(int nPanels_, int nN_, int G_, int c_, const LAS int* pe) { nPanels = nPanels_; nN = nN_; G = G_; c = c_; i = 0; panel_e = pe; }
    __device__ bool next(Unit& u) {
        const int PB = 256 / nN;
        const int nblk = (nPanels + PB - 1) / PB;
        for (;;) {
            const long L = (long)i * G + c; ++i;
            const int blk = (int)(L >> 8), r = (int)(L & 255), x = r & 7, j = r >> 3;
            if (blk >= nblk) return false;
            int pm, pn;
            if (nN == 16) { pm = blk * 16 + 4 * (x >> 1) + (j & 3); pn = 8 * (x & 1) + (j >> 2); }
            else          { pm = blk * 32 + 4 * x + (j & 3);        pn = j >> 2; }
            if (pm < nPanels) { u.pm = pm; u.pn = pn; u.e = panel_e[pm]; return true; }
        }
    }
};

template <class Epi, class Sched, bool FP8 = false>
__device__ __forceinline__ void gemm_phase(LAS unsigned char* lds, const Gemm g, Sched& S, const Epi& E) {
    const int tid = threadIdx.x, wid = __builtin_amdgcn_readfirstlane(tid >> 6), lane = tid & 63, wr = wid >> 2, wc = wid & 3, fr = lane & 15, fq = lane >> 4;
    const int K = g.K; const int pitch = FP8 ? K : 2 * K; const int nt = pitch / 128;
    unsigned voffA[2], voffB[2];
#pragma unroll
    for (int i = 0; i < 2; ++i) { int R, C; stage_rc(tid * 16 + i * 8192, R, C); const int Rb = Epi::PERM ? ((R & ~31) + perm32(R & 31)) : R;
        voffA[i] = (unsigned)(R * pitch + C * 2); voffB[i] = (unsigned)(Rb * pitch + C * 2); }
    const size_t kstep = (size_t)(BK * 2);
    const size_t hstep = (size_t)HALF * pitch;
    const size_t tstep = 2 * hstep;
    int RA[2], CA[2];
#pragma unroll
    for (int i = 0; i < 2; ++i) stage_rc(tid * 16 + i * 8192, RA[i], CA[i]);
    const bool gather = g.arow != nullptr;
    const size_t hsA = gather ? 0 : hstep;
    unsigned vA0[2] = {voffA[0], voffA[1]}, vA1[2] = {voffA[0], voffA[1]}, nA0[2] = {voffA[0], voffA[1]}, nA1[2] = {voffA[0], voffA[1]};
#define PG8_AOFF(dst0, dst1, u) do { if (gather) { _Pragma("unroll") for (int i = 0; i < 2; ++i) { \
        dst0[i] = (unsigned)g.arow[(u).pm * 256 + RA[i]] * (unsigned)pitch + (unsigned)(CA[i] * 2); dst1[i] = (unsigned)g.arow[(u).pm * 256 + 128 + RA[i]] * (unsigned)pitch + (unsigned)(CA[i] * 2); } } } while (0)
    const unsigned ldsw = (unsigned)wid * 1024u;
    const int aoff = lds_byte(wr * 64 + fr, fq * 8), boff = lds_byte(wc * 32 + fr, fq * 8);
#define PG8_SA(b, h) (((b) * 2 + (h)) * HTB)
#define PG8_SB(b, h) ((4 + (b) * 2 + (h)) * HTB)
#define PG8_STAGE(bufoff, gbase, voff) do { _Pragma("unroll") for (int _i = 0; _i < 2; ++_i) \
        __builtin_amdgcn_global_load_lds((const unsigned*)((const char*)(gbase) + (voff)[_i]), (LAS unsigned*)(lds + (bufoff) + ldsw + _i * 8192), 16, 0, 0); } while (0)
#define PG8_LD8(p) __builtin_shufflevector(*(const LAS i32x4*)(p), *(const LAS i32x4*)((p) + 1024), 0, 1, 2, 3, 4, 5, 6, 7)
#define PG8_LDA(dst, b, h) do { _Pragma("unroll") for (int m = 0; m < 4; ++m) { if constexpr (FP8) dst##8[m] = PG8_LD8(lds + PG8_SA(b, h) + aoff + m * 2048); \
        else { _Pragma("unroll") for (int k = 0; k < 2; ++k) dst[m][k] = *(const LAS bf16x8*)(lds + PG8_SA(b, h) + aoff + m * 2048 + k * 1024); } } } while (0)
#define PG8_LDB(dst, b, h) do { _Pragma("unroll") for (int n = 0; n < 2; ++n) { if constexpr (FP8) dst##8[n] = PG8_LD8(lds + PG8_SB(b, h) + boff + n * 2048); \
        else { _Pragma("unroll") for (int k = 0; k < 2; ++k) dst[n][k] = *(const LAS bf16x8*)(lds + PG8_SB(b, h) + boff + n * 2048 + k * 1024); } } } while (0)
#define PG8_MMA(ai, bj, At, Bt) do { __builtin_amdgcn_s_setprio(1); _Pragma("unroll") for (int m = 0; m < 4; ++m) _Pragma("unroll") for (int n = 0; n < 2; ++n) { \
        if constexpr (FP8) asm volatile("v_mfma_scale_f32_16x16x128_f8f6f4 %0, %1, %2, %0, %3, %3 op_sel_hi:[0,0,0]" : "+v"(acc[ai][bj][m][n]) : "v"(Bt##8[n]), "v"(At##8[m]), "v"(scl1)); \
        else { _Pragma("unroll") for (int k = 0; k < 2; ++k) acc[ai][bj][m][n] = __builtin_amdgcn_mfma_f32_16x16x32_bf16(Bt[n][k], At[m][k], acc[ai][bj][m][n], 0, 0, 0); } } \
        __builtin_amdgcn_s_setprio(0); } while (0)
#define PG8_WAIT_V(n) asm volatile("s_waitcnt vmcnt(" #n ")" ::: "memory")
#define PG8_WAIT_L(n) asm volatile("s_waitcnt lgkmcnt(" #n ")" ::: "memory")
#define PG8_BAR __builtin_amdgcn_s_barrier()
#define PG8_SCHED __builtin_amdgcn_sched_barrier(0)
    Unit cur, nxt;
    if (!S.next(cur)) return;
    const unsigned scl1 = 0x7f7f7f7fu;
    f32x4 acc[2][2][4][2];
#pragma unroll
    for (int a = 0; a < 2; ++a)
#pragma unroll
        for (int b = 0; b < 2; ++b)
#pragma unroll
            for (int m = 0; m < 4; ++m)
#pragma unroll
                for (int n = 0; n < 2; ++n) acc[a][b][m][n] = (f32x4){0.f, 0.f, 0.f, 0.f};
    bf16x8 At[4][2], B0[2][2], B1[2][2]; i32x8 At8[4], B08[2], B18[2];
    const char* cA = (const char*)g.A + (size_t)cur.e * g.astride + (gather ? (size_t)0 : (size_t)cur.pm * tstep); const char* cB = (const char*)g.Bt + (size_t)cur.e * g.estride + (size_t)cur.pn * tstep;
    PG8_AOFF(vA0, vA1, cur);
    PG8_STAGE(PG8_SB(0, 0), cB, voffB); PG8_STAGE(PG8_SB(0, 1), cB + hstep, voffB); PG8_STAGE(PG8_SA(0, 0), cA, vA0); PG8_STAGE(PG8_SA(0, 1), cA + hsA, vA1);
    if (wr == 1) PG8_BAR;
    PG8_WAIT_V(2); PG8_BAR;
    PG8_STAGE(PG8_SB(1, 0), cB + kstep, voffB); PG8_STAGE(PG8_SA(1, 0), cA + kstep, vA0); PG8_STAGE(PG8_SB(1, 1), cB + hstep + kstep, voffB);
    PG8_WAIT_V(6); PG8_BAR;
    for (;;) {
        const bool has_next = S.next(nxt);
        const char* nA = has_next ? (const char*)g.A + (size_t)nxt.e * g.astride + (gather ? (size_t)0 : (size_t)nxt.pm * tstep) : cA;
        if (has_next) PG8_AOFF(nA0, nA1, nxt);
        const char* nB = has_next ? (const char*)g.Bt + (size_t)nxt.e * g.estride + (size_t)nxt.pn * tstep : cB;
        for (int t = 0; t < nt; t += 2) {
            const bool last = (t == nt - 2);
            const char* a1 = cA + (size_t)(t + 1) * kstep;
            const char* a2 = last ? nA : cA + (size_t)(t + 2) * kstep; const char* b2 = last ? nB : cB + (size_t)(t + 2) * kstep;
            const char* a3 = a2 + kstep; const char* b3 = b2 + kstep;
            PG8_LDB(B0, 0, 0); PG8_LDB(B1, 0, 1); PG8_SCHED; PG8_LDA(At, 0, 0); PG8_STAGE(PG8_SA(1, 1), a1 + hsA, vA1);
            if (last && has_next) { vA0[0] = nA0[0]; vA0[1] = nA0[1]; vA1[0] = nA1[0]; vA1[1] = nA1[1]; }
            PG8_WAIT_V(8); PG8_WAIT_L(0); PG8_BAR; PG8_MMA(0, 0, At, B0); PG8_MMA(0, 1, At, B1); PG8_BAR; PG8_SCHED;
            PG8_LDA(At, 0, 1); PG8_STAGE(PG8_SB(0, 0), b2, voffB); PG8_STAGE(PG8_SB(0, 1), b2 + hstep, voffB); PG8_STAGE(PG8_SA(0, 0), a2, vA0);
            PG8_WAIT_V(8); PG8_WAIT_L(0); PG8_BAR; PG8_MMA(1, 0, At, B0); PG8_MMA(1, 1, At, B1); PG8_BAR; PG8_SCHED;
            PG8_LDB(B0, 1, 0); PG8_LDB(B1, 1, 1); PG8_SCHED; PG8_LDA(At, 1, 0); PG8_STAGE(PG8_SA(0, 1), a2 + hsA, vA1);
            PG8_WAIT_V(8); PG8_WAIT_L(0); PG8_BAR; PG8_MMA(0, 0, At, B0); PG8_MMA(0, 1, At, B1); PG8_BAR; PG8_SCHED;
            PG8_LDA(At, 1, 1); PG8_STAGE(PG8_SB(1, 0), b3, voffB); PG8_STAGE(PG8_SB(1, 1), b3 + hstep, voffB); PG8_STAGE(PG8_SA(1, 0), a3, vA0);
            PG8_WAIT_V(8); PG8_WAIT_L(0); PG8_BAR; PG8_MMA(1, 0, At, B0); PG8_MMA(1, 1, At, B1); PG8_BAR; PG8_SCHED;
        }
        if (wr == 0) PG8_BAR;
        if constexpr (FP8) {
#pragma unroll
            for (int a = 0; a < 2; ++a)
#pragma unroll
                for (int b = 0; b < 2; ++b) asm volatile("s_nop 15" : "+v"(acc[a][b][0][0]), "+v"(acc[a][b][0][1]), "+v"(acc[a][b][1][0]), "+v"(acc[a][b][1][1]), "+v"(acc[a][b][2][0]), "+v"(acc[a][b][2][1]), "+v"(acc[a][b][3][0]), "+v"(acc[a][b][3][1]));
        }
        const bool keep_acc = E(acc, cur, wr, wc, fr, fq);
        if (!has_next) break;
        if (!keep_acc)
#pragma unroll
        for (int a = 0; a < 2; ++a)
#pragma unroll
            for (int b = 0; b < 2; ++b)
#pragma unroll
                for (int m = 0; m < 4; ++m)
#pragma unroll
                    for (int n = 0; n < 2; ++n) acc[a][b][m][n] = (f32x4){0.f, 0.f, 0.f, 0.f};
        cur = nxt; cA = nA; cB = nB;
        if (wr == 1) PG8_BAR;
    }
    PG8_WAIT_V(0);
    PG8_BAR;
#undef PG8_AOFF
#undef PG8_SA
#undef PG8_SB
#undef PG8_STAGE
#undef PG8_LDA
#undef PG8_LDB
#undef PG8_MMA
#undef PG8_LD8
#undef PG8_WAIT_V
#undef PG8_WAIT_L
#undef PG8_BAR
#undef PG8_SCHED
}

struct EpiBf16 {
    static constexpr bool PERM = true;
    bf16_t* O; int ldc; const float* bias; int bias_estride; float ascale; int skip_from, skip_cols;
    __device__ __forceinline__ bool operator()(const f32x4 (&acc)[2][2][4][2], const Unit& u, int wr, int wc, int fr, int fq) const {
        const int row0 = u.pm * BM + wr * 64 + fr; const int col0 = u.pn * BM + wc * 32 + 8 * fq + (u.pn >= skip_from ? skip_cols : 0);
        f32x4 bv[2][2];
#pragma unroll
        for (int bj = 0; bj < 2; ++bj)
#pragma unroll
            for (int n = 0; n < 2; ++n) bv[bj][n] = bias ? *(const f32x4*)(bias + (size_t)u.e * bias_estride + col0 + bj * HALF + 4 * n) : (f32x4){0.f, 0.f, 0.f, 0.f};
#pragma unroll
        for (int ai = 0; ai < 2; ++ai)
#pragma unroll
            for (int m = 0; m < 4; ++m) { bf16_t* rowp = O + (size_t)(row0 + ai * HALF + m * 16) * ldc + col0;
#pragma unroll
                for (int bj = 0; bj < 2; ++bj) { const f32x4 v0 = acc[ai][bj][m][0] * ascale + bv[bj][0], v1 = acc[ai][bj][m][1] * ascale + bv[bj][1];
                    u32x4 w; w.x = cvt_pk_bf16(v0[0], v0[1]); w.y = cvt_pk_bf16(v0[2], v0[3]); w.z = cvt_pk_bf16(v1[0], v1[1]); w.w = cvt_pk_bf16(v1[2], v1[3]);
                    *(u32x4*)(rowp + bj * HALF) = w; } }
        return false;
    }
};
__device__ __forceinline__ float swiglu1(float ug, float ul) {
    ug = fminf(ug, 7.0f); ul = fminf(fmaxf(ul, -7.0f), 7.0f);
    return ug * __builtin_amdgcn_rcpf(1.0f + __expf(-1.702f * ug)) * (ul + 1.0f);
}
struct EpiSwiglu {
    static constexpr bool PERM = true;
    unsigned char* O; const float* b1;
    __device__ __forceinline__ bool operator()(const f32x4 (&acc)[2][2][4][2], const Unit& u, int wr, int wc, int fr, int fq) const {
        const int row0 = u.pm * BM + wr * 64 + fr; const int c0 = u.pn * 128 + wc * 32 + 8 * fq;
        const float* bg = b1 + (size_t)u.e * 4096 + c0; const float* bl = bg + 2048;
        f32x4 bgv[2], blv[2];
#pragma unroll
        for (int n = 0; n < 2; ++n) { bgv[n] = *(const f32x4*)(bg + 4 * n); blv[n] = *(const f32x4*)(bl + 4 * n); }
#pragma unroll
        for (int ai = 0; ai < 2; ++ai)
#pragma unroll
            for (int m = 0; m < 4; ++m) {
                float a[8];
#pragma unroll
                for (int n = 0; n < 2; ++n)
#pragma unroll
                    for (int j = 0; j < 4; ++j) a[4 * n + j] = ACT8_SCALE * swiglu1(acc[ai][0][m][n][j] * (1.0f / W8_SCALE) + bgv[n][j], acc[ai][1][m][n][j] * (1.0f / W8_SCALE) + blv[n][j]);
                u32x2 w; w.x = pack4_fp8(a[0], a[1], a[2], a[3]); w.y = pack4_fp8(a[4], a[5], a[6], a[7]);
                *(u32x2*)(O + (size_t)(row0 + ai * HALF + m * 16) * 2048 + c0) = w;
            }
        return false;
    }
};

struct TwoPartOrder {
    StaticOrder so; Unit held; int part;
    __device__ void init(int M, int N, int G_, int c_) { so.init(M, N, G_, c_); part = 0; }
    __device__ bool next(Unit& u) { if (part == 1) { u = held; u.e = 1; part = 0; return true; } if (!so.next(held)) return false; u = held; u.e = 0; part = 1; return true; }
};
struct EpiGate2 {
    static constexpr bool PERM = true;
    bf16_t* O; const bf16_t* Ga; const bf16_t* Gr;
    __device__ __forceinline__ bool operator()(f32x4 (&acc)[2][2][4][2], const Unit& u, int wr, int wc, int fr, int fq) const {
        const int row0 = u.pm * BM + wr * 64 + fr; const int col0 = u.pn * BM + wc * 32 + 8 * fq;
#pragma unroll
        for (int ai = 0; ai < 2; ++ai)
#pragma unroll
            for (int m = 0; m < 4; ++m) { const size_t row = (size_t)(row0 + ai * HALF + m * 16);
#pragma unroll
                for (int bj = 0; bj < 2; ++bj) { const int c = col0 + bj * HALF;
                    const u32x4 gr = *(const u32x4*)(Gr + row * DINP + c);
                    if (u.e == 0) {
                        const u32x4 ga = *(const u32x4*)(Ga + row * DINP + c);
#pragma unroll
                        for (int q = 0; q < 4; ++q) {
                            const float r0 = (1.0f + __expf(-bf_lo(gr[q]))) * __builtin_amdgcn_rcpf(1.0f + __expf(-bf_lo(ga[q]))), r1 = (1.0f + __expf(-bf_hi(gr[q]))) * __builtin_amdgcn_rcpf(1.0f + __expf(-bf_hi(ga[q])));
                            acc[ai][bj][m][q >> 1][(2 * q) & 3] *= r0; acc[ai][bj][m][q >> 1][(2 * q + 1) & 3] *= r1; }
                    } else {
                        float r[8];
#pragma unroll
                        for (int q = 0; q < 4; ++q) { r[2 * q] = sigmoidf_(bf_lo(gr[q])) * acc[ai][bj][m][q >> 1][(2 * q) & 3]; r[2 * q + 1] = sigmoidf_(bf_hi(gr[q])) * acc[ai][bj][m][q >> 1][(2 * q + 1) & 3]; }
                        u32x4 w; w.x = cvt_pk_bf16(r[0], r[1]); w.y = cvt_pk_bf16(r[2], r[3]); w.z = cvt_pk_bf16(r[4], r[5]); w.w = cvt_pk_bf16(r[6], r[7]);
                        *(u32x4*)(O + row * 2048 + c) = w; } } }
        return u.e == 0;
    }
};
struct EpiDelta {
    static constexpr bool PERM = true;
    const float* gt; bf16_t* DL;
    __device__ __forceinline__ bool operator()(const f32x4 (&acc)[2][2][4][2], const Unit& u, int wr, int wc, int fr, int fq) const {
        const int row0 = u.pm * BM + wr * 64 + fr; const int col0 = u.pn * BM + wc * 32 + 8 * fq;
        f32x4 g[2][2];
#pragma unroll
        for (int bj = 0; bj < 2; ++bj)
#pragma unroll
            for (int n = 0; n < 2; ++n) g[bj][n] = *(const f32x4*)(gt + col0 + bj * HALF + 4 * n);
#pragma unroll
        for (int ai = 0; ai < 2; ++ai)
#pragma unroll
            for (int m = 0; m < 4; ++m) { bf16_t* rowp = DL + (size_t)(row0 + ai * HALF + m * 16) * 2048 + col0;
#pragma unroll
                for (int bj = 0; bj < 2; ++bj) { const f32x4 v0 = acc[ai][bj][m][0] * g[bj][0], v1 = acc[ai][bj][m][1] * g[bj][1];
                    u32x4 w; w.x = cvt_pk_bf16(v0[0], v0[1]); w.y = cvt_pk_bf16(v0[2], v0[3]); w.z = cvt_pk_bf16(v1[0], v1[1]); w.w = cvt_pk_bf16(v1[2], v1[3]);
                    *(u32x4*)(rowp + bj * HALF) = w; } }
        return false;
    }
};
}

struct Args { const void* in[22]; float* out; unsigned char* ws; int ph_lo, ph_hi, flags, pad; };
enum { PH_PRO = 0, PH_H, PH_INPROJ, PH_POST, PH_SCORE, PH_SELECT, PH_ATTN, PH_OP1, PH_OP2, PH_WOUT, PH_ROUTER, PH_SCATTER, PH_MOE1, PH_MOE2, PH_FINAL, NPH };

__device__ __forceinline__ int dest_row(int mode, int n) {
    if (mode == 1) return n < 2640 ? n : n + 176;
    if (mode == 2) { const int g = n >> 11, c = n & 2047; return (c >> 7) * 256 + g * 128 + (c & 127); }
    return n;
}
__device__ __forceinline__ void convert_item(const float* __restrict__ W, int K, int N, int ld, bf16_t* WT, int mode, int item, int lane, LAS unsigned char* scr) {
    const int nblk = (N + 63) >> 6; const int kb = item / nblk, nb = item - kb * nblk; const int k0 = kb * 128, n0 = nb * 64;
    const int c4 = lane & 15, kr = lane >> 4;
    const bool ok = (n0 + 4 * c4) < N;
    const float* src = W + (size_t)(k0 + 2 * kr) * ld + n0 + 4 * c4;
#pragma unroll 4
    for (int i = 0; i < 16; ++i) {
        f32x4 v0 = (f32x4){0.f, 0.f, 0.f, 0.f}, v1 = v0;
        if (ok) { v0 = *(const f32x4*)(src + (size_t)(8 * i) * ld); v1 = *(const f32x4*)(src + (size_t)(8 * i + 1) * ld); }
        const int kk = 8 * i + 2 * kr;
#pragma unroll
        for (int e = 0; e < 4; ++e) *(LAS unsigned*)(scr + (4 * c4 + e) * 272 + kk * 2) = cvt_pk_bf16(v0[e], v1[e]);
    }
    LDS_WAIT(); asm volatile("" ::: "memory");
#pragma unroll 4
    for (int j = 0; j < 16; ++j) {
        const int q = j * 64 + lane, n = q >> 4, ch = q & 15;
        const u32x4 v = *(const LAS u32x4*)(scr + n * 272 + ch * 16);
        if (n0 + n < N) *(u32x4*)(WT + (size_t)dest_row(mode, n0 + n) * K + k0 + ch * 8) = v;
    }
    LDS_WAIT(); asm volatile("" ::: "memory");
}


__device__ __forceinline__ bf16_t f2bf(float f) { unsigned u = __float_as_uint(f); return (bf16_t)((u + 0x7fffu + ((u >> 16) & 1u)) >> 16); }
__device__ __forceinline__ float bfx(const u32x4& w, int i) { const unsigned u = w[i >> 1]; return (i & 1) ? bf_hi(u) : bf_lo(u); }
__device__ __forceinline__ void rope_sc(float pos, float inv, float& sn, float& cs) {
    const float ang = pos * inv;
    const double a = (double)ang; const double n = __builtin_rint(a * 0.15915494309189535); const float r = (float)(a - n * 6.283185307179586);
    sn = sinf(r); cs = cosf(r);
}
__device__ __forceinline__ void post_token(bf16_t* PROJ, bf16_t* KI, bf16_t* KC, bf16_t* VC, const int* positions, const float* kng, const float* knb, int t, int lane) {
    const float pos = (float)positions[t];
    bf16_t* row = PROJ + (size_t)t * DINP;
    float sn, cs;
#pragma unroll
    for (int i = 0; i < 2; ++i) {
        const int pp = lane + 64 * i, hd = pp >> 4, ii = pp & 15;
        rope_sc(pos, powf(500000.0f, -(float)ii * (1.0f / 16.0f)), sn, cs);
        bf16_t* p = row + CQ + hd * 128 + ii; const float a = bf2f(p[0]), b = bf2f(p[16]);
        p[0] = f2bf(a * cs - b * sn); p[16] = f2bf(b * cs + a * sn);
    }
#pragma unroll
    for (int i = 0; i < 2; ++i) {
        const int pp = lane + 64 * i, hd = pp >> 3, ii = pp & 7;
        rope_sc(pos, powf(500000.0f, -(float)ii * (1.0f / 8.0f)), sn, cs);
        bf16_t* p = row + CQI + hd * 64 + ii; const float a = bf2f(p[0]), b = bf2f(p[8]);
        p[0] = f2bf(a * cs - b * sn); p[8] = f2bf(b * cs + a * sn);
    }
    if (lane < 32) {
        const int g = lane >> 4, ii = lane & 15;
        rope_sc(pos, powf(500000.0f, -(float)ii * (1.0f / 16.0f)), sn, cs);
        const bf16_t* p = row + CK + g * 128 + ii; const float a = bf2f(p[0]), b = bf2f(p[16]);
        bf16_t* o = KC + (size_t)t * 256 + g * 128 + ii; o[0] = f2bf(a * cs - b * sn); o[16] = f2bf(b * cs + a * sn);
    }
#pragma unroll
    for (int i = 0; i < 3; ++i) { const int idx = lane + 64 * i, g = idx / 96, r = idx - g * 96; KC[(size_t)t * 256 + g * 128 + 32 + r] = row[CK + g * 128 + 32 + r]; }
    *(u32x2*)(VC + (size_t)t * 256 + 4 * lane) = *(const u32x2*)(row + CV + 4 * lane);
    {
        const float v = bf2f(row[CKI + lane]);
        const float mean = wave_sum(v) * (1.0f / 64.0f); const float d = v - mean; const float var = wave_sum(d * d) * (1.0f / 64.0f);
        const float y = d * rsqrtf(var + NORM_EPS) * kng[lane] + knb[lane];
        const float other = __shfl_xor(y, 8);
        rope_sc(pos, powf(500000.0f, -(float)(lane & 7) * (1.0f / 8.0f)), sn, cs);
        float o = y;
        if (lane < 8) o = y * cs - other * sn; else if (lane < 16) o = y * cs + other * sn;
        KI[(size_t)t * 64 + lane] = f2bf(o);
    }
}

constexpr int HG_GB = 0, HG_Q1 = 33792, HG_Q2 = 51200, HG_K2 = 68608, HG_VT = 86016, HG_PB = 104448, HG_LB = 113664;
__device__ __forceinline__ void hgrn_cumsum(LAS unsigned char* lds, const u32x4& w0, const u32x4& w1, float l0, float l1, int tid) {
    LAS float* GB = (LAS float*)(lds + HG_GB); LAS float* LB = (LAS float*)(lds + HG_LB); LAS float* SEG = (LAS float*)(lds + HG_LB + 512);
    if (tid < 128) LB[tid] = 1.0f / (1.0f + expf(l1 - l0));
    __syncthreads();
    const int t = tid >> 3, dseg = tid & 7;
#pragma unroll
    for (int i = 0; i < 16; ++i) { const float z = i < 8 ? bfx(w0, i) : bfx(w1, i - 8); const float lb = LB[16 * dseg + i]; GB[t * 128 + 16 * dseg + i] = logf(lb + (1.0f - lb) * sigmoidf_(z)); }
    __syncthreads();
    const int d = tid & 127, tq = tid >> 7;
    float z[16];
#pragma unroll
    for (int i = 0; i < 16; ++i) z[i] = GB[(16 * tq + i) * 128 + d];
    float a = 0.f;
#pragma unroll
    for (int i = 0; i < 16; ++i) { a += z[i]; z[i] = a; }
    SEG[tq * 128 + d] = a;
    __syncthreads();
    float pre = 0.f;
    for (int q = 0; q < tq; ++q) pre += SEG[q * 128 + d];
#pragma unroll
    for (int i = 0; i < 16; ++i) GB[(16 * tq + i) * 128 + d] = z[i] + pre;
    __syncthreads();
}
__device__ __forceinline__ void hgrn_vt(LAS unsigned char* lds, const u32x4& a, const u32x4& b, int tid) {
    const int s2 = tid & 31, eg = tid >> 5;
#pragma unroll
    for (int i = 0; i < 8; ++i) { const unsigned lo = (i & 1) ? (a[i >> 1] >> 16) : (a[i >> 1] & 0xffffu), hi = (i & 1) ? (b[i >> 1] >> 16) : (b[i >> 1] & 0xffffu);
        *(LAS unsigned*)(lds + HG_VT + (8 * eg + i) * 144 + s2 * 4) = lo | (hi << 16); }
}
__device__ __forceinline__ void hgrn_l1(LAS unsigned char* lds, const bf16_t* PROJ, const float* lb_logits, float* ST, float* DC, int c, int h, int tid, int wave, int lane) {
    const int t = tid >> 3, dseg = tid & 7, s2 = tid & 31, dg = tid >> 5;
    const bf16_t* pf = PROJ + (size_t)(c * 64 + t) * DINP + CHF + h * 128 + 16 * dseg;
    const bf16_t* pk = PROJ + (size_t)(c * 64 + 2 * s2) * DINP + CHF + h * 128 + 8 * dg;
    const u32x4 w0 = *(const u32x4*)pf, w1 = *(const u32x4*)(pf + 8);
    const u32x4 ka = *(const u32x4*)pk, kb = *(const u32x4*)(pk + DINP);
    const u32x4 va = *(const u32x4*)(pk - CHF + CHI), vb = *(const u32x4*)(pk - CHF + CHI + DINP);
    const float l0 = lb_logits[h * 128 + (tid & 127)], l1 = lb_logits[1024 + h * 128 + (tid & 127)];
    hgrn_cumsum(lds, w0, w1, l0, l1, tid);
    const LAS float* GB = (const LAS float*)(lds + HG_GB); const LAS float* LB = (const LAS float*)(lds + HG_LB);
    {
#pragma unroll
        for (int i = 0; i < 8; ++i) { const int d = 8 * dg + i; const float lb = LB[d], b63 = GB[63 * 128 + d];
            const float k0 = (1.0f - lb) * (1.0f - sigmoidf_(bfx(ka, i))), k1 = (1.0f - lb) * (1.0f - sigmoidf_(bfx(kb, i)));
            const float v0 = k0 * __expf(b63 - GB[(2 * s2) * 128 + d]), v1 = k1 * __expf(b63 - GB[(2 * s2 + 1) * 128 + d]);
            *(LAS unsigned*)(lds + HG_Q1 + d * 144 + s2 * 4) = cvt_pk_bf16(v0, v1); }
    }
    hgrn_vt(lds, va, vb, tid);
    __syncthreads();
    const int fr = lane & 15, fq = lane >> 4;
    bf16x8 af[2];
#pragma unroll
    for (int ks = 0; ks < 2; ++ks) af[ks] = *(const LAS bf16x8*)(lds + HG_VT + (16 * wave + fr) * 144 + (32 * ks + 8 * fq) * 2);
    float* dst = ST + ((size_t)(c * 8 + h) * 128) * 128;
#pragma unroll 2
    for (int dt = 0; dt < 8; ++dt) {
        f32x4 acc = (f32x4){0.f, 0.f, 0.f, 0.f};
#pragma unroll
        for (int ks = 0; ks < 2; ++ks) { const bf16x8 bfr = *(const LAS bf16x8*)(lds + HG_Q1 + (16 * dt + fr) * 144 + (32 * ks + 8 * fq) * 2); acc = __builtin_amdgcn_mfma_f32_16x16x32_bf16(af[ks], bfr, acc, 0, 0, 0); }
#pragma unroll
        for (int r = 0; r < 4; ++r) dst[(size_t)(16 * wave + 4 * fq + r) * 128 + 16 * dt + fr] = acc[r];
    }
    if (tid < 128) DC[(size_t)(c * 8 + h) * 128 + tid] = __expf(GB[63 * 128 + tid]);
    __syncthreads();
}
__device__ __forceinline__ void hgrn_l3(LAS unsigned char* lds, const bf16_t* PROJ, const float* lb_logits, const float* ST, const float* norm_g, bf16_t* REC, int c, int h, int tid, int wave, int lane) {
    const int t = tid >> 3, dseg = tid & 7, s2 = tid & 31, eg = tid >> 5, fr = lane & 15, fq = lane >> 4;
    const bf16_t* pf = PROJ + (size_t)(c * 64 + t) * DINP + CHF + h * 128 + 16 * dseg;
    const u32x4 f0 = *(const u32x4*)pf, f1 = *(const u32x4*)(pf + 8), q0 = *(const u32x4*)(pf - CHF + CHQ), q1 = *(const u32x4*)(pf - CHF + CHQ + 8);
    const u32x4 g0 = *(const u32x4*)(pf - CHF + CHG), g1 = *(const u32x4*)(pf - CHF + CHG + 8);
    const bf16_t* pv = PROJ + (size_t)(c * 64 + 2 * s2) * DINP + CHI + h * 128 + 8 * eg;
    const u32x4 va = *(const u32x4*)pv, vb = *(const u32x4*)(pv + DINP);
    const float* sp = ST + ((size_t)(c * 8 + h) * 128 + 16 * wave + fr) * 128 + 8 * fq;
    f32x4 sx[4][2];
#pragma unroll
    for (int ks = 0; ks < 4; ++ks) { sx[ks][0] = *(const f32x4*)(sp + 32 * ks); sx[ks][1] = *(const f32x4*)(sp + 32 * ks + 4); }
    const float l0 = lb_logits[h * 128 + (tid & 127)], l1 = lb_logits[1024 + h * 128 + (tid & 127)];
    hgrn_cumsum(lds, f0, f1, l0, l1, tid);
    const LAS float* GB = (const LAS float*)(lds + HG_GB); const LAS float* LB = (const LAS float*)(lds + HG_LB);
    {
        unsigned o1[8], o2[8], o3[8];
#pragma unroll
        for (int i = 0; i < 16; i += 2) {
            float a1[2], a2[2], a3[2];
#pragma unroll
            for (int j = 0; j < 2; ++j) { const int d = 16 * dseg + i + j; const float lb = LB[d], b = GB[t * 128 + d], br = GB[31 * 128 + d];
                const float z = (i + j) < 8 ? bfx(f0, i + j) : bfx(f1, i + j - 8), qv = (i + j) < 8 ? bfx(q0, i + j) : bfx(q1, i + j - 8);
                const float k = (1.0f - lb) * (1.0f - sigmoidf_(z)), q = siluf_(qv);
                a1[j] = q * __expf(b); a2[j] = q * __expf(b - br); a3[j] = k * __expf(br - b); }
            o1[i >> 1] = cvt_pk_bf16(a1[0], a1[1]); o2[i >> 1] = cvt_pk_bf16(a2[0], a2[1]); o3[i >> 1] = cvt_pk_bf16(a3[0], a3[1]);
        }
        LAS u32x4* d1 = (LAS u32x4*)(lds + HG_Q1 + t * 272 + dseg * 32); LAS u32x4* d2 = (LAS u32x4*)(lds + HG_Q2 + t * 272 + dseg * 32); LAS u32x4* d3 = (LAS u32x4*)(lds + HG_K2 + t * 272 + dseg * 32);
        d1[0] = (u32x4){o1[0], o1[1], o1[2], o1[3]}; d1[1] = (u32x4){o1[4], o1[5], o1[6], o1[7]};
        d2[0] = (u32x4){o2[0], o2[1], o2[2], o2[3]}; d2[1] = (u32x4){o2[4], o2[5], o2[6], o2[7]};
        d3[0] = (u32x4){o3[0], o3[1], o3[2], o3[3]}; d3[1] = (u32x4){o3[4], o3[5], o3[6], o3[7]};
    }
    hgrn_vt(lds, va, vb, tid);
    __syncthreads();
#pragma unroll
    for (int q = 0; q < 2; ++q) {
        const int tile = 2 * wave + q, tt = tile >> 2, stl = tile & 3;
        f32x4 acc = (f32x4){0.f, 0.f, 0.f, 0.f};
#pragma unroll
        for (int ks = 0; ks < 4; ++ks) { const bf16x8 a = *(const LAS bf16x8*)(lds + HG_Q2 + (16 * tt + fr) * 272 + (32 * ks + 8 * fq) * 2), b = *(const LAS bf16x8*)(lds + HG_K2 + (16 * stl + fr) * 272 + (32 * ks + 8 * fq) * 2);
            acc = __builtin_amdgcn_mfma_f32_16x16x32_bf16(a, b, acc, 0, 0, 0); }
#pragma unroll
        for (int r = 0; r < 4; ++r) { const int tr_ = 16 * tt + 4 * fq + r, s = 16 * stl + fr; *(LAS bf16_t*)(lds + HG_PB + tr_ * 144 + s * 2) = f2bf(s <= tr_ ? acc[r] : 0.f); }
    }
    __syncthreads();
    {
        bf16x8 b1[2], b2[4];
#pragma unroll
        for (int ks = 0; ks < 2; ++ks) b1[ks] = *(const LAS bf16x8*)(lds + HG_VT + (16 * wave + fr) * 144 + (32 * ks + 8 * fq) * 2);
#pragma unroll
        for (int ks = 0; ks < 4; ++ks) { const f32x4 x0 = sx[ks][0], x1 = sx[ks][1];
            u32x4 w; w.x = cvt_pk_bf16(x0[0], x0[1]); w.y = cvt_pk_bf16(x0[2], x0[3]); w.z = cvt_pk_bf16(x1[0], x1[1]); w.w = cvt_pk_bf16(x1[2], x1[3]); b2[ks] = __builtin_bit_cast(bf16x8, w); }
        LAS float* OB = (LAS float*)(lds + HG_GB);
#pragma unroll
        for (int tt = 0; tt < 4; ++tt) {
            f32x4 acc = (f32x4){0.f, 0.f, 0.f, 0.f};
#pragma unroll
            for (int ks = 0; ks < 2; ++ks) { const bf16x8 a = *(const LAS bf16x8*)(lds + HG_PB + (16 * tt + fr) * 144 + (32 * ks + 8 * fq) * 2); acc = __builtin_amdgcn_mfma_f32_16x16x32_bf16(a, b1[ks], acc, 0, 0, 0); }
#pragma unroll
            for (int ks = 0; ks < 4; ++ks) { const bf16x8 a = *(const LAS bf16x8*)(lds + HG_Q1 + (16 * tt + fr) * 272 + (32 * ks + 8 * fq) * 2); acc = __builtin_amdgcn_mfma_f32_16x16x32_bf16(a, b2[ks], acc, 0, 0, 0); }
#pragma unroll
            for (int r = 0; r < 4; ++r) OB[(16 * tt + 4 * fq + r) * 132 + 16 * wave + fr] = acc[r];
        }
    }
    __syncthreads();
    {
        const int es = dseg; const LAS float* OB = (const LAS float*)(lds + HG_GB);
        float o[16]; float ss = 0.f;
#pragma unroll
        for (int i = 0; i < 16; ++i) { o[i] = OB[t * 132 + 16 * es + i]; ss += o[i] * o[i]; }
        ss += __shfl_xor(ss, 1); ss += __shfl_xor(ss, 2); ss += __shfl_xor(ss, 4);
        const float rstd = rsqrtf(ss * (1.0f / 128.0f) + NORM_EPS);
        unsigned w[8];
#pragma unroll
        for (int i = 0; i < 16; i += 2) { const float ga = i < 8 ? bfx(g0, i) : bfx(g1, i - 8), gb = (i + 1) < 8 ? bfx(g0, i + 1) : bfx(g1, i + 1 - 8);
            w[i >> 1] = cvt_pk_bf16(o[i] * rstd * norm_g[16 * es + i] * siluf_(ga), o[i + 1] * rstd * norm_g[16 * es + i + 1] * siluf_(gb)); }
        u32x4* dst = (u32x4*)(REC + (size_t)(c * 64 + t) * 1024 + h * 128 + 16 * es);
        dst[0] = (u32x4){w[0], w[1], w[2], w[3]}; dst[1] = (u32x4){w[4], w[5], w[6], w[7]};
    }
    __syncthreads();
}

constexpr int SC_KT = 0, SC_SB = 36864, SC_SPITCH = 132;
__device__ __forceinline__ unsigned pk_f16(float a, float b) { return __builtin_bit_cast(unsigned, __builtin_amdgcn_cvt_pkrtz(a, b)); }
__device__ __forceinline__ void score_flush(LAS unsigned char* lds, unsigned short* SCORES, int t0, int kt, int tid) {
    const LAS float* sb = (const LAS float*)(lds + SC_SB + (kt & 1) * (32 * SC_SPITCH * 4));
    const int row = tid >> 4, seg = tid & 15;
    const f32x4 a = *(const LAS f32x4*)(sb + row * SC_SPITCH + seg * 8), b = *(const LAS f32x4*)(sb + row * SC_SPITCH + seg * 8 + 4);
    unsigned short* dst = SCORES + (size_t)(t0 + row) * S + kt * 128 + seg * 8;
    *(u32x4*)dst = (u32x4){pk_f16(a[0], a[1]), pk_f16(a[2], a[3]), pk_f16(b[0], b[1]), pk_f16(b[2], b[3])};
}
__device__ __forceinline__ void score_block(LAS unsigned char* lds, const bf16_t* PROJ, const bf16_t* KI, unsigned short* SCORES, int qb, int tid, int wave, int lane) {
    const int t0 = qb * 32, nkt = (t0 >> 7) + 1;
    const int r = lane & 31, hh = lane >> 5;
    bf16x8 Af[2][4]; float wv[2][16]; f32x2 wv2[2][8];
#pragma unroll
    for (int p = 0; p < 2; ++p) {
        const int tq = t0 + 4 * wave + 2 * p + (r >> 4); const bf16_t* qrow = PROJ + (size_t)tq * DINP + CQI + (r & 15) * 64 + 8 * hh;
#pragma unroll
        for (int ks = 0; ks < 4; ++ks) Af[p][ks] = *(const bf16x8*)(qrow + 16 * ks);
#pragma unroll
        for (int reg = 0; reg < 16; ++reg) { const int row = (reg & 3) + 8 * (reg >> 2) + 4 * hh; const int tw = t0 + 4 * wave + 2 * p + (row >> 4);
            wv[p][reg] = bf2f(PROJ[(size_t)tw * DINP + CWI + (row & 15)]) * (1.0f / 32.0f); }
#pragma unroll
        for (int i = 0; i < 8; ++i) wv2[p][i] = (f32x2){wv[p][2 * i], wv[p][2 * i + 1]};
    }
    const u32x2 tagsw = __builtin_amdgcn_permlane32_swap(0u, 1u, false, false); const int qsel = (int)tagsw[0];
    u32x4 stg[2];
#pragma unroll
    for (int i = 0; i < 2; ++i) { const int q = tid + 512 * i; stg[i] = *(const u32x4*)(KI + (size_t)(q >> 3) * 64 + (q & 7) * 8); }
#pragma unroll
    for (int i = 0; i < 2; ++i) { const int q = tid + 512 * i; *(LAS u32x4*)(lds + SC_KT + (q >> 3) * 144 + (q & 7) * 16) = stg[i]; }
    __syncthreads();
    for (int kt = 0; kt < nkt; ++kt) {
        const LAS unsigned char* buf = lds + SC_KT + (kt & 1) * 18432;
        LAS float* sb = (LAS float*)(lds + SC_SB + (kt & 1) * (32 * SC_SPITCH * 4));
        if (kt > 0) score_flush(lds, SCORES, t0, kt - 1, tid);
        if (kt + 1 < nkt) {
#pragma unroll
            for (int i = 0; i < 2; ++i) { const int q = tid + 512 * i; stg[i] = *(const u32x4*)(KI + (size_t)((kt + 1) * 128 + (q >> 3)) * 64 + (q & 7) * 8); }
        }
        {
        f32x16 accP[2], accC[2];
#define SC_MFMA(cb) do { bf16x8 Bf[4]; _Pragma("unroll") for (int ks = 0; ks < 4; ++ks) Bf[ks] = *(const LAS bf16x8*)(buf + (32 * (cb) + r) * 144 + (16 * ks + 8 * hh) * 2); \
            _Pragma("unroll") for (int p = 0; p < 2; ++p) { _Pragma("unroll") for (int i = 0; i < 16; ++i) accC[p][i] = 0.f; \
                _Pragma("unroll") for (int ks = 0; ks < 4; ++ks) accC[p] = __builtin_amdgcn_mfma_f32_32x32x16_bf16(Af[p][ks], Bf[ks], accC[p], 0, 0, 0); } } while (0)
#define SC_RED(acc, cb) do { _Pragma("unroll") for (int p = 0; p < 2; ++p) { f32x2 s0 = {0.f, 0.f}, s1 = {0.f, 0.f}; \
            _Pragma("unroll") for (int reg = 0; reg < 8; reg += 2) { const f32x2 r0 = {relu_i(acc[p][reg]), relu_i(acc[p][reg + 1])}; const f32x2 r1 = {relu_i(acc[p][reg + 8]), relu_i(acc[p][reg + 9])}; \
                s0 = __builtin_elementwise_fma(wv2[p][reg >> 1], r0, s0); s1 = __builtin_elementwise_fma(wv2[p][4 + (reg >> 1)], r1, s1); } \
            const float p0 = s0[0] + s0[1], p1 = s1[0] + s1[1]; \
            const u32x2 sw = __builtin_amdgcn_permlane32_swap(__float_as_uint(p0), __float_as_uint(p1), false, false); \
            sb[(4 * wave + 2 * p + qsel) * SC_SPITCH + 32 * (cb) + r] = __uint_as_float(sw[0]) + __uint_as_float(sw[1]); } } while (0)
#define SC_INTERLEAVE() do { _Pragma("unroll") for (int i = 0; i < 8; ++i) { __builtin_amdgcn_sched_group_barrier(0x008, 1, 0); __builtin_amdgcn_sched_group_barrier(0x002, 8, 0); } } while (0)
        SC_MFMA(0);
        accP[0] = accC[0]; accP[1] = accC[1]; SC_MFMA(1); SC_RED(accP, 0); SC_INTERLEAVE();
        accP[0] = accC[0]; accP[1] = accC[1]; SC_MFMA(2); SC_RED(accP, 1); SC_INTERLEAVE();
        accP[0] = accC[0]; accP[1] = accC[1]; SC_MFMA(3); SC_RED(accP, 2); SC_INTERLEAVE();
        SC_RED(accC, 3);
#undef SC_MFMA
#undef SC_RED
#undef SC_INTERLEAVE
        }
        if (kt + 1 < nkt) {
#pragma unroll
            for (int i = 0; i < 2; ++i) { const int q = tid + 512 * i; *(LAS u32x4*)(lds + SC_KT + ((kt + 1) & 1) * 18432 + (q >> 3) * 144 + (q & 7) * 16) = stg[i]; }
        }
        __syncthreads();
    }
    score_flush(lds, SCORES, t0, nkt - 1, tid);
    __syncthreads();
}

__device__ __forceinline__ float wave_kth16(const float (&v)[16], int K) {
    const float NINF = -__builtin_inff();
    float mx = NINF, mn = __builtin_inff();
#pragma unroll
    for (int j = 0; j < 16; ++j) { mx = fmaxf(mx, v[j]); mn = fminf(mn, v[j] == NINF ? __builtin_inff() : v[j]); }
    mx = wave_max(mx); mn = -wave_max(-mn);
    int c = 0;
#pragma unroll
    for (int j = 0; j < 16; ++j) c += __popcll(__ballot(v[j] >= mx));
    if (c >= K) return mx;
    float lo = mn, hi = mx, tau = mn;
    for (int it = 0; it < 64; ++it) {
        const float mid = 0.5f * (lo + hi);
        if (!(mid > lo && mid < hi)) { tau = lo; break; }
        c = 0;
#pragma unroll
        for (int j = 0; j < 16; ++j) c += __popcll(__ballot(v[j] >= mid));
        if (c == K) { tau = mid; break; }
        if (c > K) lo = mid; else hi = mid;
        tau = lo;
    }
    return tau;
}
__device__ __forceinline__ int lanes_below(unsigned long long mask) { return (int)__builtin_amdgcn_mbcnt_hi((unsigned)(mask >> 32), __builtin_amdgcn_mbcnt_lo((unsigned)mask, 0u)); }
__device__ __forceinline__ float h2f(unsigned short h) { return (float)__builtin_bit_cast(_Float16, h); }
__device__ __forceinline__ float h2f_lo(unsigned u) { return h2f((unsigned short)(u & 0xffffu)); }
__device__ __forceinline__ float h2f_hi(unsigned u) { return h2f((unsigned short)(u >> 16)); }
__device__ __forceinline__ void select_row(LAS unsigned char* wl, const unsigned short* SCORES, int t, int lane) {
    LAS int* selw = (LAS int*)wl; LAS int* cidx = (LAS int*)(wl + 5120);
    const float NINF = -__builtin_inff();
    const unsigned short* row = SCORES + (size_t)t * S; const int n = t + 1;
    float c[16]; int N;
    if (n <= 1024) {
#pragma unroll
        for (int j = 0; j < 16; ++j) { const int i = lane + 64 * j; c[j] = i < n ? h2f(row[i]) : NINF; }
        N = -1;
    } else {
        const int m = n >> 4; float s[16];
#pragma unroll
        for (int j = 0; j < 16; ++j) { const int i = lane + 64 * j; s[j] = i < m ? h2f(row[16 * i + 7]) : NINF; }
        int K = 32, cnt = 0;
        for (;;) {
            const float tlo = (K >= m) ? NINF : wave_kth16(s, K);
            cnt = 0;
            const int nq = (n + 511) >> 9;
            if (tlo > 0.f) {
                const unsigned T16 = pk_f16(tlo, tlo);
                for (int q0 = 0; q0 < nq; q0 += 4) {
                    u32x4 v[4];
#pragma unroll
                    for (int u = 0; u < 4; ++u) { const int e = 8 * (lane + 64 * (q0 + u)); v[u] = (e <= t) ? *(const u32x4*)(row + e) : (u32x4){0xfc00fc00u, 0xfc00fc00u, 0xfc00fc00u, 0xfc00fc00u}; }
#pragma unroll
                    for (int u = 0; u < 4; ++u) { const int e = 8 * (lane + 64 * (q0 + u));
                        unsigned m8 = 0;
#pragma unroll
                        for (int w = 0; w < 4; ++w) { const unsigned vw_ = v[u][w];
                            const s16x2 d = __builtin_elementwise_sub_sat(__builtin_bit_cast(s16x2, vw_), __builtin_bit_cast(s16x2, T16));
                            const unsigned mm = ~__builtin_bit_cast(unsigned, d); m8 |= (((mm >> 15) & 1u) | ((mm >> 30) & 2u)) << (2 * w); }
                        const int nv = t + 1 - e; if (nv < 8) m8 &= nv > 0 ? ((1u << nv) - 1u) : 0u;
                        for (;;) { const bool has = m8 != 0u; const unsigned long long mask = __ballot(has); if (!mask) break;
                            const int pos = cnt + lanes_below(mask);
                            if (has) { const int k = __builtin_ctz(m8); m8 &= m8 - 1u; if (pos < 1024) cidx[pos] = e + k; }
                            cnt += __popcll(mask); } }
                }
            } else {
                for (int q0 = 0; q0 < nq; q0 += 4) {
                    u32x4 v[4];
#pragma unroll
                    for (int u = 0; u < 4; ++u) { const int e = 8 * (lane + 64 * (q0 + u)); v[u] = (e <= t) ? *(const u32x4*)(row + e) : (u32x4){0xfc00fc00u, 0xfc00fc00u, 0xfc00fc00u, 0xfc00fc00u}; }
#pragma unroll
                    for (int u = 0; u < 4; ++u) { const int e = 8 * (lane + 64 * (q0 + u));
#pragma unroll
                        for (int k = 0; k < 8; ++k) { const float x = (k & 1) ? h2f_hi(v[u][k >> 1]) : h2f_lo(v[u][k >> 1]);
                            const bool pred = (e + k <= t) && (x >= tlo); const unsigned long long mask = __ballot(pred);
                            if (mask) { const int pos = cnt + lanes_below(mask); if (pred && pos < 1024) cidx[pos] = e + k; cnt += __popcll(mask); } } }
                }
            }
            if (cnt >= 256 || K >= m) break;
            K *= 2;
        }
        N = cnt < 1024 ? cnt : 1024;
#pragma unroll
        for (int j = 0; j < 16; ++j) { const int i = lane + 64 * j; c[j] = i < N ? h2f(row[cidx[i]]) : NINF; }
    }
    const float tau = wave_kth16(c, 256);
    int base = 0;
#pragma unroll
    for (int j = 0; j < 16; ++j) { const bool pred = c[j] >= tau; const unsigned long long mask = __ballot(pred);
        if (mask) { const int pos = base + lanes_below(mask); if (pred && pos < 256) selw[pos] = (N < 0) ? (lane + 64 * j) : cidx[lane + 64 * j]; base += __popcll(mask); } }
}

__device__ __forceinline__ void attn_query(LAS unsigned char* wl, const bf16_t* PROJ, const bf16_t* KC, const bf16_t* VC, bf16_t* ATT, int t, int lane) {
    LAS int* selw = (LAS int*)wl; LAS float* L = (LAS float*)(wl + 1024);
    const int nsel = t < 255 ? t + 1 : 256;
    const int fr = lane & 15, fq = lane >> 4;
    bf16x8 qf[2][4];
#pragma unroll
    for (int g = 0; g < 2; ++g)
#pragma unroll
        for (int ks = 0; ks < 4; ++ks) { const bf16x8 z = {0, 0, 0, 0, 0, 0, 0, 0}; qf[g][ks] = fr < 4 ? *(const bf16x8*)(PROJ + (size_t)t * DINP + CQ + (4 * g + fr) * 128 + 64 * (ks >> 1) + 16 * fq + 8 * (ks & 1)) : z; }
    const float scale = 0.08838834764831845f;
    const int nkt = (nsel + 15) >> 4;
    {
        LAS unsigned char* KT = wl + 9216;
        const int half_ = lane >> 5, l31_ = lane & 31;
        u32x4 kw[3][8];
#define QK_LOAD(buf, kt) do { _Pragma("unroll") for (int u = 0; u < 8; ++u) { const unsigned off_ = (unsigned)selw[16 * (kt) + 2 * u + half_] * 512u + 16u * (unsigned)l31_; kw[buf][u] = *(const u32x4*)((const char*)KC + off_); } } while (0)
#define QK_COMP(buf, kt) do { _Pragma("unroll") for (int u = 0; u < 8; ++u) *(LAS u32x4*)(KT + (2 * u + half_) * 528 + 16 * l31_) = kw[buf][u]; \
        _Pragma("unroll") for (int g = 0; g < 2; ++g) { f32x4 acc = (f32x4){0.f, 0.f, 0.f, 0.f}; \
            _Pragma("unroll") for (int ks = 0; ks < 4; ++ks) { const bf16x8 kf_ = *(const LAS bf16x8*)(KT + fr * 528 + g * 256 + (64 * (ks >> 1) + 16 * fq + 8 * (ks & 1)) * 2); \
                acc = __builtin_amdgcn_mfma_f32_16x16x32_bf16(qf[g][ks], kf_, acc, 0, 0, 0); } \
            if (fq == 0) { _Pragma("unroll") for (int r = 0; r < 4; ++r) L[(4 * g + r) * 256 + 16 * (kt) + fr] = (16 * (kt) + fr < nsel) ? acc[r] * scale : -__builtin_inff(); } } } while (0)
        QK_LOAD(0, 0); if (1 < nkt) QK_LOAD(1, 1);
        for (int kt = 0; kt < nkt; kt += 3) {
            if (kt + 2 < nkt) QK_LOAD(2, kt + 2);
            __builtin_amdgcn_sched_barrier(0);
            QK_COMP(0, kt);
            if (kt + 1 < nkt) { if (kt + 3 < nkt) QK_LOAD(0, kt + 3); __builtin_amdgcn_sched_barrier(0); QK_COMP(1, kt + 1); }
            if (kt + 2 < nkt) { if (kt + 4 < nkt) QK_LOAD(1, kt + 4); __builtin_amdgcn_sched_barrier(0); QK_COMP(2, kt + 2); }
        }
#undef QK_LOAD
#undef QK_COMP
        if (fq == 0) { for (int kt = nkt; kt < 16; ++kt) {
#pragma unroll
            for (int r = 0; r < 8; ++r) L[r * 256 + 16 * kt + fr] = -__builtin_inff(); } }
    }
    float p[8][4];
#pragma unroll
    for (int hd = 0; hd < 8; ++hd) { float m = -__builtin_inff();
#pragma unroll
        for (int i = 0; i < 4; ++i) { p[hd][i] = L[hd * 256 + lane + 64 * i]; m = fmaxf(m, p[hd][i]); }
        m = wave_max(m); float s = 0.f;
#pragma unroll
        for (int i = 0; i < 4; ++i) { p[hd][i] = __expf(p[hd][i] - m); s += p[hd][i]; }
        s = 1.0f / wave_sum(s);
#pragma unroll
        for (int i = 0; i < 4; ++i) p[hd][i] *= s; }
    LAS bf16_t* Pb = (LAS bf16_t*)(wl + 1024);
#pragma unroll
    for (int hd = 0; hd < 8; ++hd)
#pragma unroll
        for (int i = 0; i < 4; ++i) Pb[hd * 256 + lane + 64 * i] = f2bf(p[hd][i]);
    LAS unsigned char* VT = wl + 9216;
    const int half = lane >> 5, l31 = lane & 31, ii = lane & 15, kq = lane >> 4;
    f32x4 acc[16];
#pragma unroll
    for (int nt = 0; nt < 16; ++nt) acc[nt] = (f32x4){0.f, 0.f, 0.f, 0.f};
    const int nch = (nsel + 15) >> 4;
    u32x4 vw[3][8];
#define PV_LOAD(buf, c) do { _Pragma("unroll") for (int u = 0; u < 8; ++u) { const unsigned off_ = (unsigned)selw[16 * (c) + 2 * u + half] * 512u + 16u * (unsigned)l31; vw[buf][u] = *(const u32x4*)((const char*)VC + off_); } } while (0)
#define PV_COMP(buf, c) do { _Pragma("unroll") for (int u = 0; u < 8; ++u) *(LAS u32x4*)(VT + (2 * u + half) * 528 + 16 * l31) = vw[buf][u]; \
        s16x4 pa[2]; _Pragma("unroll") for (int g = 0; g < 2; ++g) { const s16x4 r_ = *(const LAS s16x4*)(Pb + (g * 4 + (ii & 3)) * 256 + 16 * (c) + 4 * kq); pa[g] = ii < 4 ? r_ : (s16x4){0, 0, 0, 0}; } \
        _Pragma("unroll") for (int nt = 0; nt < 16; ++nt) { const s16x4 b_ = __builtin_amdgcn_ds_read_tr16_b64_v4i16((LAS s16x4*)(VT + (4 * kq + (ii >> 2)) * 528 + (16 * nt + 4 * (ii & 3)) * 2)); \
            acc[nt] = __builtin_amdgcn_mfma_f32_16x16x16bf16_1k(pa[nt >> 3], b_, acc[nt], 0, 0, 0); } } while (0)
    PV_LOAD(0, 0); if (1 < nch) PV_LOAD(1, 1);
    for (int c = 0; c < nch; c += 3) {
        if (c + 2 < nch) PV_LOAD(2, c + 2);
        __builtin_amdgcn_sched_barrier(0);
        PV_COMP(0, c);
        if (c + 1 < nch) { if (c + 3 < nch) PV_LOAD(0, c + 3); __builtin_amdgcn_sched_barrier(0); PV_COMP(1, c + 1); }
        if (c + 2 < nch) { if (c + 4 < nch) PV_LOAD(1, c + 4); __builtin_amdgcn_sched_barrier(0); PV_COMP(2, c + 2); }
    }
#undef PV_LOAD
#undef PV_COMP
    LAS float* OB = (LAS float*)(wl + 1024 + 4096);
    if (kq == 0) {
#pragma unroll
        for (int nt = 0; nt < 16; ++nt)
#pragma unroll
            for (int r = 0; r < 4; ++r) OB[(4 * (nt >> 3) + r) * 128 + 16 * (nt & 7) + ii] = acc[nt][r];
    }
    {
        const f32x4 a0 = *(const LAS f32x4*)(OB + 16 * lane), a1 = *(const LAS f32x4*)(OB + 16 * lane + 4), a2 = *(const LAS f32x4*)(OB + 16 * lane + 8), a3 = *(const LAS f32x4*)(OB + 16 * lane + 12);
        u32x4 w0, w1; w0.x = cvt_pk_bf16(a0[0], a0[1]); w0.y = cvt_pk_bf16(a0[2], a0[3]); w0.z = cvt_pk_bf16(a1[0], a1[1]); w0.w = cvt_pk_bf16(a1[2], a1[3]);
        w1.x = cvt_pk_bf16(a2[0], a2[1]); w1.y = cvt_pk_bf16(a2[2], a2[3]); w1.z = cvt_pk_bf16(a3[0], a3[1]); w1.w = cvt_pk_bf16(a3[2], a3[3]);
        u32x4* dst = (u32x4*)(ATT + (size_t)t * 1024 + 16 * lane); dst[0] = w0; dst[1] = w1;
    }
}


__device__ __forceinline__ void convert_item8(const float* __restrict__ W, int K, int N, int ld, unsigned char* WT, int mode, int item, int lane, LAS unsigned char* scr) {
    const int nblk = N >> 6; const int kb = item / nblk, nb = item - kb * nblk; const int k0 = kb * 256, n0 = nb * 64;
    const int c4 = lane & 15, kr = lane >> 4;
    const float* src = W + (size_t)(k0 + 4 * kr) * ld + n0 + 4 * c4;
#pragma unroll 4
    for (int i = 0; i < 16; ++i) {
        f32x4 v[4];
#pragma unroll
        for (int r = 0; r < 4; ++r) v[r] = __builtin_nontemporal_load((const f32x4*)(src + (size_t)(16 * i + r) * ld));
        const int kk = 16 * i + 4 * kr;
#pragma unroll
        for (int e = 0; e < 4; ++e) *(LAS unsigned*)(scr + (4 * c4 + e) * 272 + kk) = pack4_fp8(v[0][e] * W8_SCALE, v[1][e] * W8_SCALE, v[2][e] * W8_SCALE, v[3][e] * W8_SCALE);
    }
    LDS_WAIT(); asm volatile("" ::: "memory");
#pragma unroll 4
    for (int j = 0; j < 16; ++j) {
        const int q = j * 64 + lane, n = q >> 4, ch = q & 15;
        const u32x4 v = *(const LAS u32x4*)(scr + n * 272 + ch * 16);
        *(u32x4*)(WT + (size_t)dest_row(mode, n0 + n) * K + k0 + ch * 16) = v;
    }
    LDS_WAIT(); asm volatile("" ::: "memory");
}

struct Conv8Job { const float* W; unsigned char* WT; int N; int mode; size_t w_estride, wt_estride; int items_per_e; };
__device__ __forceinline__ void conv8_load(const Conv8Job& jb, int item, int wave, int lane, f32x4 (&v)[16]) {
    const int e = item / jb.items_per_e, r = item - e * jb.items_per_e; const int nblk = jb.N >> 8; const int kb = r / nblk, nb = r - kb * nblk;
    const float* src = jb.W + (size_t)e * jb.w_estride + (size_t)(kb * 128 + 16 * wave) * jb.N + nb * 256 + 4 * lane;
#pragma unroll
    for (int i = 0; i < 16; ++i) v[i] = __builtin_nontemporal_load((const f32x4*)(src + (size_t)i * jb.N));
}
__device__ __forceinline__ void conv8_to_lds(LAS unsigned char* img, int wave, int lane, const f32x4 (&v)[16]) {
#pragma unroll
    for (int g = 0; g < 4; ++g)
#pragma unroll
        for (int e = 0; e < 4; ++e) *(LAS unsigned*)(img + (4 * lane + e) * 144 + 16 * wave + 4 * g) = pack4_fp8(v[4 * g][e] * W8_SCALE, v[4 * g + 1][e] * W8_SCALE, v[4 * g + 2][e] * W8_SCALE, v[4 * g + 3][e] * W8_SCALE);
}
__device__ __forceinline__ void conv8_store(const Conv8Job& jb, int item, const LAS unsigned char* img, int tid) {
    const int e = item / jb.items_per_e, r = item - e * jb.items_per_e; const int nblk = jb.N >> 8; const int kb = r / nblk, nb = r - kb * nblk;
    unsigned char* dst = jb.WT + (size_t)e * jb.wt_estride + kb * 128;
#pragma unroll
    for (int j = 0; j < 4; ++j) { const int q = j * 512 + tid, n = q >> 3, ch = q & 7;
        *(u32x4*)(dst + (size_t)dest_row(jb.mode, nb * 256 + n) * 2048 + ch * 16) = *(const LAS u32x4*)(img + n * 144 + ch * 16); }
}
__device__ __forceinline__ void conv8_run(LAS unsigned char* lds, const Conv8Job& jb, int n_items, int wg, int G, int tid, int wave, int lane) {
    f32x4 v[16]; int it = wg, par = 0;
    if (it < n_items) conv8_load(jb, it, wave, lane, v);
    for (; it < n_items; it += G, par ^= 1) {
        LAS unsigned char* img = lds + par * 36864;
        conv8_to_lds(img, wave, lane, v);
        __syncthreads();
        if (it + G < n_items) conv8_load(jb, it + G, wave, lane, v);
        conv8_store(jb, it, img, tid);
    }
    __syncthreads();
}

__global__ void __launch_bounds__(NTHR, 2) fwd_kernel(Args args) {
    extern __shared__ __attribute__((aligned(16))) unsigned char lds_raw[];
    LAS unsigned char* lds = (LAS unsigned char*)lds_raw;
    volatile LAS unsigned* MISC = (volatile LAS unsigned*)(lds + LDS_MISC);
    const int tid = threadIdx.x, lane = tid & 63, wave = __builtin_amdgcn_readfirstlane(tid >> 6);
    const int G = gridDim.x, wg = blockIdx.x;
    unsigned char* ws = args.ws;
    unsigned* ctl = (unsigned*)(ws + WS_CTL);
    const int lo = args.ph_lo, hi = args.ph_hi;
    const float* x = (const float*)args.in[0]; const float* cvec = (const float*)args.in[1]; const int* positions = (const int*)args.in[2];
    const float* w_ada = (const float*)args.in[3]; const float* b_ada = (const float*)args.in[4]; const float* norm1_g = (const float*)args.in[5];
    const float* w_in = (const float*)args.in[6]; const float* idx_knorm_g = (const float*)args.in[7]; const float* idx_knorm_b = (const float*)args.in[8];
    const float* lb_logits = (const float*)args.in[9]; const float* hgrn_norm_g = (const float*)args.in[10];
    const float* w_proj_att = (const float*)args.in[11]; const float* w_proj_hgrn = (const float*)args.in[12]; const float* w_out = (const float*)args.in[13];
    const float* norm2_g = (const float*)args.in[14]; const float* w_router = (const float*)args.in[15]; const float* b_router = (const float*)args.in[16];
    const float* w1 = (const float*)args.in[17]; const float* b1 = (const float*)args.in[18]; const float* w2 = (const float*)args.in[19]; const float* b2 = (const float*)args.in[20];
    const float* final_g = (const float*)args.in[21];
    float* out = args.out;
    float* MOD = (float*)(ws + WS_MOD); int* TOPE = (int*)(ws + WS_TOPE); float* GATE = (float*)(ws + WS_GATE); int* SLOT = (int*)(ws + WS_SLOT);
    bf16_t* WIN_T = (bf16_t*)(ws + WS_WIN_T); bf16_t* WA_T = (bf16_t*)(ws + WS_WA_T); bf16_t* WH_T = (bf16_t*)(ws + WS_WH_T); bf16_t* WO_T = (bf16_t*)(ws + WS_WO_T);
    unsigned char* WIN_T8 = ws + WS_WIN_T + 8 * MiB;
    unsigned char* HA8 = ws + WS_SCORES;
    unsigned char* W1_T = ws + WS_W1_T; unsigned char* W2_T = ws + WS_W2_T;
    bf16_t* HB = (bf16_t*)(ws + WS_H); bf16_t* PROJ = (bf16_t*)(ws + WS_PROJ);
    bf16_t* DELTA = (bf16_t*)(ws + WS_ATT);
    unsigned char* ACT = ws + WS_ACT; bf16_t* YB = (bf16_t*)(ws + WS_YB);
    int* TOKS = (int*)(ws + WS_TOKS);
    unsigned char* H8 = ws + WS_H;
    bf16_t* KI = (bf16_t*)(ws + WS_KI); bf16_t* KC = (bf16_t*)(ws + WS_KC); bf16_t* VC = (bf16_t*)(ws + WS_VC);
    float* ST = (float*)(ws + WS_ST); float* DC = (float*)(ws + WS_DC);
    bf16_t* ATT = (bf16_t*)(ws + WS_ATT); bf16_t* REC = (bf16_t*)(ws + WS_REC); bf16_t* MERGED = (bf16_t*)(ws + WS_MERGED); unsigned short* SCORES = (unsigned short*)(ws + WS_SCORES);

    for (int u = tid; u < 128; u += NTHR) MISC[u] = 0u;
    __syncthreads();
    const bool one_launch = (hi - lo) > 1;
    XcdBarrier bar; bar.bar = ctl + CW_BAR; bar.x = 0; bar.st = MISC + 8;
    if (one_launch) bar = xcd_barrier_post(ctl + CW_BAR, MISC + 8);
#define IN(k) (lo <= (k) && (k) < hi)
#define SEAM(k) do { if (IN(k) && IN((k) + 1)) xcd_barrier(bar); } while (0)


    if (IN(PH_PRO)) {
        for (int cb = wg; cb < 256; cb += G) {
            LAS float* red = (LAS float*)lds;
            const int c4 = tid % 12, kg = tid / 12;
            f32x4 acc = (f32x4){0.f, 0.f, 0.f, 0.f};
            if (kg < 42) {
                const float* wp = w_ada + (size_t)cb * 48 + 4 * c4;
#pragma unroll 7
                for (int j = 0; j < 49; ++j) { const int k = kg + 42 * j; if (k < D) { const f32x4 v = __builtin_nontemporal_load((const f32x4*)(wp + (size_t)k * (6 * D))); acc += siluf_(cvec[k]) * v; } }
                *(LAS f32x4*)(red + kg * 48 + 4 * c4) = acc;
            }
            __syncthreads();
            if (tid < 48) { float s = b_ada[cb * 48 + tid];
#pragma unroll 6
                for (int q = 0; q < 42; ++q) s += red[q * 48 + tid];
                MOD[cb * 48 + tid] = s; }
            __syncthreads();
        }
        LAS unsigned char* scr = lds + wave * 17408;
        const int gw = wg * NWAVES + wave, NGW = G * NWAVES;
        {
            constexpr int NB_IN = (1104 + 63) / 64;
            for (int it = gw; it < 16 * NB_IN; it += NGW) convert_item(w_in + 1536, 2048, 1104, DIN, WIN_T, 0, it, lane, scr);
            for (int it = gw; it < 8 * 32; it += NGW) convert_item(w_proj_att, 1024, 2048, 2048, WA_T, 0, it, lane, scr);
            for (int it = gw; it < 8 * 32; it += NGW) convert_item(w_proj_hgrn, 1024, 2048, 2048, WH_T, 0, it, lane, scr);
            for (int it = gw; it < 16 * 32; it += NGW) convert_item(w_out, 2048, 2048, 2048, WO_T, 0, it, lane, scr);
            for (int it = gw; it < 8 * 24; it += NGW) convert_item8(w_in, 2048, 1536, DIN, WIN_T8, 0, it, lane, scr);
            for (int it = gw; it < 8 * 128; it += NGW) convert_item8(w_in + 2640, 2048, 8192, DIN, WIN_T8 + (size_t)1536 * 2048, 0, it, lane, scr);
            for (size_t i = (size_t)wg * NTHR + tid; i < (size_t)176 * 2048 * 2 / 16; i += (size_t)G * NTHR) ((u32x4*)(WIN_T + (size_t)1104 * 2048))[i] = (u32x4){0u, 0u, 0u, 0u};
        }
        {
            __syncthreads();
            const Conv8Job j1{w1, W1_T, 4096, 2, (size_t)2048 * 4096, (size_t)4096 * 2048, 16 * 16}; conv8_run(lds, j1, NEXP * 16 * 16, wg, G, tid, wave, lane);
            const Conv8Job j2{w2, W2_T, 2048, 0, (size_t)2048 * 2048, (size_t)2048 * 2048, 16 * 8};  conv8_run(lds, j2, NEXP * 16 * 8, wg, G, tid, wave, lane);
        }
    }
    SEAM(PH_PRO);

    {
    if (IN(PH_H)) {
        const float* sh1 = MOD; const float* sc1 = MOD + D;
        const int gw = wg * NWAVES + wave, NGW = G * NWAVES;
        f32x4 gs[8], sh[8];
#pragma unroll
        for (int j = 0; j < 8; ++j) { const int c = 4 * lane + 256 * j; const f32x4 g = *(const f32x4*)(norm1_g + c), sc = *(const f32x4*)(sc1 + c); sh[j] = *(const f32x4*)(sh1 + c);
#pragma unroll
            for (int e = 0; e < 4; ++e) gs[j][e] = g[e] * (1.0f + sc[e]); }
        for (int t = gw; t < S; t += NGW) {
            const f32x4* xr = (const f32x4*)(x + (size_t)t * D) + lane;
            f32x4 v[8]; float ss = 0.f;
#pragma unroll
            for (int j = 0; j < 8; ++j) { v[j] = xr[64 * j]; ss += (v[j][0] * v[j][0] + v[j][1] * v[j][1]) + (v[j][2] * v[j][2] + v[j][3] * v[j][3]); }
            const float rstd = rsqrtf(wave_sum(ss) * (1.0f / D) + NORM_EPS);
#pragma unroll
            for (int j = 0; j < 8; ++j) { const f32x4 h = v[j] * rstd * gs[j] + sh[j]; u32x2 w; w.x = cvt_pk_bf16(h[0], h[1]); w.y = cvt_pk_bf16(h[2], h[3]);
                *(u32x2*)(HB + (size_t)t * D + 4 * lane + 256 * j) = w;
                *(unsigned*)(HA8 + (size_t)t * D + 4 * lane + 256 * j) = pack4_fp8(h[0], h[1], h[2], h[3]); }
        }
    }
    SEAM(PH_H);
    if (IN(PH_INPROJ)) {
        {
            pg8::Gemm g8{HA8, WIN_T8, 2048, 0, nullptr, 0}; pg8::StaticOrder S8; S8.init(S, 9728, G, wg);
            if (G == 256) S8.skew(8, (wg >= 128 && wg < 192) ? -1 : (wg < 128 ? wg : wg - 64), 192);
            pg8::EpiBf16 E8{PROJ, DINP, nullptr, 0, 1.0f / W8_SCALE, 6, 1280};
            pg8::gemm_phase<pg8::EpiBf16, pg8::StaticOrder, true>(lds, g8, S8, E8);
        }
        {
            pg8::Gemm g{HB, WIN_T, 2048, 0, nullptr, 0}; pg8::StaticOrder So; So.init(S, 1280, G, (wg + 128) % G);
            pg8::EpiBf16 E{PROJ + CQI, DINP, nullptr, 0, 1.0f, 1 << 30, 0};
            pg8::gemm_phase<pg8::EpiBf16, pg8::StaticOrder>(lds, g, So, E);
        }
    }
    SEAM(PH_INPROJ);
    if (IN(PH_POST)) {
        const int gw = wg * NWAVES + wave, NGW = G * NWAVES;
        for (int t = gw; t < S; t += NGW) post_token(PROJ, KI, KC, VC, positions, idx_knorm_g, idx_knorm_b, t, lane);
        __syncthreads();
        for (int u = wg; u < 2048; u += G) hgrn_l1(lds, PROJ, lb_logits, ST, DC, u >> 3, u & 7, tid, wave, lane);
    }
    SEAM(PH_POST);
    if (IN(PH_SCORE)) {
        for (int idx = wg * NTHR + tid; idx < 8 * 128 * 128; idx += G * NTHR) {
            const int h = idx >> 14, d = idx & 127; float s = 0.f;
            float* sp = ST + idx; const float* dp = DC + h * 128 + d;
            for (int c = 0; c < 256; c += 8) {
                float l[8], dc[8];
#pragma unroll
                for (int i = 0; i < 8; ++i) { l[i] = sp[(size_t)(c + i) * 131072]; dc[i] = dp[(size_t)(c + i) * 1024]; }
#pragma unroll
                for (int i = 0; i < 8; ++i) { sp[(size_t)(c + i) * 131072] = s; s = dc[i] * s + l[i]; }
            }
        }
        {
            for (int j = wg; j < 252; j += G) { score_block(lds, PROJ, KI, SCORES, 8 + j, tid, wave, lane); score_block(lds, PROJ, KI, SCORES, 511 - j, tid, wave, lane); }
        }
    }
    SEAM(PH_SCORE);
    if (IN(PH_ATTN)) {
        const int gw = wg * NWAVES + wave, NGW = G * NWAVES;
        for (int u = wg; u < 2048; u += G) hgrn_l3(lds, PROJ, lb_logits, ST, hgrn_norm_g, REC, u >> 3, u & 7, tid, wave, lane);
        {
            for (int t = gw; t < S; t += NGW) {
                LAS unsigned char* wl = lds + wave * 17664;
                if (t >= 256) select_row(wl, SCORES, t, lane);
                else {
#pragma unroll
                    for (int i = 0; i < 4; ++i) { const int idx = lane + 64 * i; ((LAS int*)wl)[idx] = idx <= t ? idx : 0; }
                }
                attn_query(wl, PROJ, KC, VC, ATT, t, lane);
            }
        }
    }
    SEAM(PH_ATTN);
    if (IN(PH_OP1)) {
        pg8::Gemm g{ATT, WA_T, 1024, (size_t)2048 * 1024 * 2, nullptr, (size_t)S * 1024 * 2};
        pg8::TwoPartOrder So; So.init(S, 2048, G, wg);
        pg8::EpiGate2 E{MERGED, PROJ + CGA, PROJ + CGR};
        pg8::gemm_phase<pg8::EpiGate2, pg8::TwoPartOrder>(lds, g, So, E);
    }
    SEAM(PH_OP2);
    if (IN(PH_WOUT)) {
        pg8::Gemm g{MERGED, WO_T, 2048, 0, nullptr, 0}; pg8::StaticOrder So; So.init(S, 2048, G, wg);
        pg8::EpiDelta E{MOD + 2 * D, DELTA};
        pg8::gemm_phase<pg8::EpiDelta, pg8::StaticOrder>(lds, g, So, E);
    }
    SEAM(PH_WOUT);
    }

    if (IN(PH_ROUTER)) {
        LAS float* hs = (LAS float*)lds;
        volatile LAS unsigned* lcnt = MISC + 32;
        const float* sh2 = MOD + 3 * D; const float* sc2 = MOD + 4 * D;
        if (tid < 32) lcnt[tid] = 0u;
        __syncthreads();
        for (int grp = wg; grp < S / 16; grp += G) {
#pragma unroll 1
            for (int q = 0; q < 2; ++q) {
                const int tl = 2 * wave + q, t = grp * 16 + tl;
                const f32x4* xr = (const f32x4*)(x + (size_t)t * D) + lane; const u32x2* dr = (const u32x2*)(DELTA + (size_t)t * D) + lane;
                f32x4 v[8]; float ss = 0.f;
#pragma unroll
                for (int j = 0; j < 8; ++j) { const u32x2 dw = dr[64 * j]; v[j] = xr[64 * j] + (f32x4){bf_lo(dw.x), bf_hi(dw.x), bf_lo(dw.y), bf_hi(dw.y)};
                    ss += (v[j][0] * v[j][0] + v[j][1] * v[j][1]) + (v[j][2] * v[j][2] + v[j][3] * v[j][3]); }
                const float rstd = rsqrtf(wave_sum(ss) * (1.0f / D) + NORM_EPS);
#pragma unroll
                for (int j = 0; j < 8; ++j) {
                    const int c = 4 * lane + 256 * j;
                    const f32x4 g = *(const f32x4*)(norm2_g + c), sc = *(const f32x4*)(sc2 + c), sh = *(const f32x4*)(sh2 + c);
                    f32x4 h;
#pragma unroll
                    for (int e = 0; e < 4; ++e) h[e] = v[j][e] * rstd * g[e] * (1.0f + sc[e]) + sh[e];
                    *(LAS f32x4*)(hs + tl * 2048 + c) = h;
                    *(unsigned*)(H8 + (size_t)t * D + c) = pack4_fp8(h[0], h[1], h[2], h[3]);
                }
            }
            __syncthreads();
            {
                LAS float* part = (LAS float*)(lds + 131072);
                const int fr = lane & 15, fq = lane >> 4;
                f32x4 acc0 = (f32x4){0.f, 0.f, 0.f, 0.f}, acc1 = acc0;
                const LAS float* hrow = hs + fr * 2048 + wave * 256 + 4 * fq; const float* wrp = w_router + (size_t)(wave * 256 + 4 * fq) * 32 + fr;
#pragma unroll 2
                for (int i = 0; i < 16; ++i) {
                    const f32x4 a4 = *(const LAS f32x4*)(hrow + 16 * i);
                    float b0[4], b1[4];
#pragma unroll
                    for (int s = 0; s < 4; ++s) { b0[s] = wrp[(size_t)(16 * i + s) * 32]; b1[s] = wrp[(size_t)(16 * i + s) * 32 + 16]; }
#pragma unroll
                    for (int s = 0; s < 4; ++s) { acc0 = __builtin_amdgcn_mfma_f32_16x16x4f32(a4[s], b0[s], acc0, 0, 0, 0); acc1 = __builtin_amdgcn_mfma_f32_16x16x4f32(a4[s], b1[s], acc1, 0, 0, 0); }
                }
#pragma unroll
                for (int r = 0; r < 4; ++r) { part[(wave * 16 + 4 * fq + r) * 32 + fr] = acc0[r]; part[(wave * 16 + 4 * fq + r) * 32 + 16 + fr] = acc1[r]; }
                __syncthreads();
                const int tl = tid >> 5, e = tid & 31, t = grp * 16 + tl;
                float v = b_router[e];
#pragma unroll
                for (int w = 0; w < 8; ++w) v += part[(w * 16 + tl) * 32 + e];
                float tv[4]; int ti[4];
#pragma unroll
                for (int k = 0; k < 4; ++k) {
                    float bv = v; int bi = e;
#pragma unroll
                    for (int o = 16; o >= 1; o >>= 1) { const float ov = __shfl_xor(bv, o); const int oi = __shfl_xor(bi, o); if (ov > bv || (ov == bv && oi < bi)) { bv = ov; bi = oi; } }
                    tv[k] = bv; ti[k] = bi; if (e == bi) v = -__builtin_inff();
                }
                if (e == 0) {
                    const float e1 = __expf(tv[1] - tv[0]), e2 = __expf(tv[2] - tv[0]), e3 = __expf(tv[3] - tv[0]); const float inv = 1.0f / (1.0f + e1 + e2 + e3);
                    *(int4*)(TOPE + (size_t)t * 4) = make_int4(ti[0], ti[1], ti[2], ti[3]);
                    *(f32x4*)(GATE + (size_t)t * 4) = (f32x4){inv, e1 * inv, e2 * inv, e3 * inv};
#pragma unroll
                    for (int k = 0; k < 4; ++k) __hip_atomic_fetch_add((LAS unsigned*)&lcnt[ti[k]], 1u, __ATOMIC_RELAXED, __HIP_MEMORY_SCOPE_WORKGROUP);
                }
            }
            __syncthreads();
        }
        if (tid < 32) { const unsigned c = lcnt[tid]; if (c) __hip_atomic_fetch_add(ctl + CW_CNT + tid, c, __ATOMIC_RELAXED, __HIP_MEMORY_SCOPE_AGENT); }
    }
    SEAM(PH_ROUTER);

    if (IN(PH_SCATTER)) {
        volatile LAS unsigned* lcnt = MISC + 32; volatile LAS unsigned* lbase = MISC + 64; LAS int* pstart = (LAS int*)(lds + 1024); LAS int* pcnt = (LAS int*)(lds + 1280);
        if (tid == 0) { int p = 0; for (int e = 0; e < NEXP; ++e) { const int c = (int)__hip_atomic_load(ctl + CW_CNT + e, __ATOMIC_RELAXED, __HIP_MEMORY_SCOPE_AGENT); pstart[e] = p; pcnt[e] = c; p += (c + 255) & ~255; } }
        if (tid < 32) lcnt[tid] = 0u;
        __syncthreads();
        if (wg < NEXP) { const int e = wg; for (int s = pstart[e] + pcnt[e] + tid; s < pstart[e] + ((pcnt[e] + 255) & ~255); s += NTHR) TOKS[s] = 0; }
        for (int blk = wg; blk < S / 64; blk += G) {
            int e = 0, lrank = 0;
            if (tid < 256) { e = TOPE[(size_t)blk * 256 + tid]; lrank = (int)__hip_atomic_fetch_add((LAS unsigned*)&lcnt[e], 1u, __ATOMIC_RELAXED, __HIP_MEMORY_SCOPE_WORKGROUP); }
            __syncthreads();
            if (tid < 32) { const unsigned c = lcnt[tid]; lbase[tid] = c ? __hip_atomic_fetch_add(ctl + CW_FILL + tid, c, __ATOMIC_RELAXED, __HIP_MEMORY_SCOPE_AGENT) : 0u; }
            __syncthreads();
            if (tid < 256) { const int slot = pstart[e] + (int)lbase[e] + lrank; SLOT[(size_t)blk * 256 + tid] = slot; TOKS[slot] = blk * 64 + (tid >> 2); }
            __syncthreads();
            if (tid < 32) lcnt[tid] = 0u;
            __syncthreads();
        }
    }
    SEAM(PH_SCATTER);

    if (IN(PH_MOE1) || IN(PH_MOE2)) {
        LAS int* panel_e = (LAS int*)(lds + 131072 + 2048);
        LAS int* npan = (LAS int*)(lds + 131072 + 2048 + 2048);
        __syncthreads();
        if (tid == 0) { int p = 0; for (int e = 0; e < NEXP; ++e) { const int np = (int)((__hip_atomic_load(ctl + CW_CNT + e, __ATOMIC_RELAXED, __HIP_MEMORY_SCOPE_AGENT) + 255u) >> 8); for (int q = 0; q < np; ++q) panel_e[p + q] = e; p += np; } npan[0] = p; }
        __syncthreads();
        const int nPanels = npan[0];
        if (IN(PH_MOE1)) {
            pg8::Gemm g{H8, W1_T, 2048, (size_t)4096 * 2048, TOKS, 0}; pg8::MoeOrder So; So.init(nPanels, 16, G, wg, panel_e);
            pg8::EpiSwiglu E{ACT, b1};
            pg8::gemm_phase<pg8::EpiSwiglu, pg8::MoeOrder, true>(lds, g, So, E);
        }
        SEAM(PH_MOE1);
        if (IN(PH_MOE2)) {
            pg8::Gemm g{ACT, W2_T, 2048, (size_t)2048 * 2048, nullptr, 0}; pg8::MoeOrder So; So.init(nPanels, 8, G, wg, panel_e);
            pg8::EpiBf16 E{YB, 2048, b2, 2048, 1.0f / (W8_SCALE * ACT8_SCALE), 1 << 30, 0};
            pg8::gemm_phase<pg8::EpiBf16, pg8::MoeOrder, true>(lds, g, So, E);
        }
    }
    SEAM(PH_MOE2);

    if (IN(PH_FINAL)) {
        const float* gt2 = MOD + 5 * D;
        const int gw = wg * NWAVES + wave, NGW = G * NWAVES;
        for (int t = gw; t < S; t += NGW) {
            const f32x4* xr = (const f32x4*)(x + (size_t)t * D) + lane; const u32x2* dr = (const u32x2*)(DELTA + (size_t)t * D) + lane;
            f32x4 v[8];
#pragma unroll
            for (int j = 0; j < 8; ++j) { const u32x2 dw = dr[64 * j]; v[j] = xr[64 * j] + (f32x4){bf_lo(dw.x), bf_hi(dw.x), bf_lo(dw.y), bf_hi(dw.y)}; }
            {
                f32x4 m[8];
#pragma unroll
                for (int j = 0; j < 8; ++j) m[j] = (f32x4){0.f, 0.f, 0.f, 0.f};
                const int4 sl = *(const int4*)(SLOT + (size_t)t * 4); const f32x4 gt = *(const f32x4*)(GATE + (size_t)t * 4);
                const int sls[4] = {sl.x, sl.y, sl.z, sl.w};
#pragma unroll
                for (int k = 0; k < 4; ++k) {
                    const u32x2* yr = (const u32x2*)(YB + (size_t)sls[k] * D) + lane; const float gk = gt[k];
#pragma unroll
                    for (int j = 0; j < 8; ++j) { const u32x2 w = yr[64 * j]; m[j][0] += gk * bf_lo(w.x); m[j][1] += gk * bf_hi(w.x); m[j][2] += gk * bf_lo(w.y); m[j][3] += gk * bf_hi(w.y); }
                }
#pragma unroll
                for (int j = 0; j < 8; ++j) { const f32x4 g2 = *(const f32x4*)(gt2 + 4 * lane + 256 * j); v[j] = v[j] + g2 * m[j]; }
            }
            float ss = 0.f;
#pragma unroll
            for (int j = 0; j < 8; ++j) ss += (v[j][0] * v[j][0] + v[j][1] * v[j][1]) + (v[j][2] * v[j][2] + v[j][3] * v[j][3]);
            const float rstd = rsqrtf(wave_sum(ss) * (1.0f / D) + NORM_EPS);
            f32x4* orow = (f32x4*)(out + (size_t)t * D) + lane;
#pragma unroll
            for (int j = 0; j < 8; ++j) { const f32x4 fg = *(const f32x4*)(final_g + 4 * lane + 256 * j); orow[64 * j] = v[j] * rstd * fg; }
        }
    }
#undef IN
#undef SEAM
}

#ifndef MK_ONE_LAUNCH
#define MK_ONE_LAUNCH 1
#endif
extern "C" void kernel_launch(void* const* d_in, const int* in_sizes, int n_in, void* d_out, int out_size, void* d_ws, size_t ws_size, hipStream_t stream) {
    static int grid = 0;
    if (grid == 0) {
        if (n_in != 22 || out_size != S * D || ws_size < WS_END) { fprintf(stderr, "kernel_launch: unexpected shapes: n_in %d out %d ws %zu (need %zu)\n", n_in, out_size, ws_size, (size_t)WS_END); grid = -1; return; }
        int dev = 0, cus = 0, per_cu = 0;
        if (hipGetDevice(&dev) != hipSuccess || hipDeviceGetAttribute(&cus, hipDeviceAttributeMultiprocessorCount, dev) != hipSuccess) { grid = -1; return; }
        if (hipFuncSetAttribute((const void*)fwd_kernel, hipFuncAttributeMaxDynamicSharedMemorySize, LDS_BYTES) != hipSuccess) { fprintf(stderr, "kernel_launch: hipFuncSetAttribute failed\n"); grid = -1; return; }
        if (hipOccupancyMaxActiveBlocksPerMultiprocessor(&per_cu, (const void*)fwd_kernel, NTHR, LDS_BYTES) != hipSuccess || per_cu < 1) { fprintf(stderr, "kernel_launch: occupancy query says %d\n", per_cu); (void)hipGetLastError(); grid = -1; return; }
        grid = cus;
    }
    if (grid < 0) return;
    (void)in_sizes;
    hipMemsetAsync((char*)d_ws + WS_CTL, 0, CTL_BYTES, stream);
    Args a{};
    for (int i = 0; i < 22; ++i) a.in[i] = d_in[i];
    a.out = (float*)d_out; a.ws = (unsigned char*)d_ws; a.flags = 0; a.pad = 0;
#if MK_ONE_LAUNCH
    a.ph_lo = 0; a.ph_hi = NPH;
    hipLaunchKernelGGL(fwd_kernel, dim3(grid), dim3(NTHR), LDS_BYTES, stream, a);
#else
    for (int p = 0; p < NPH; ++p) { a.ph_lo = p; a.ph_hi = p + 1; hipLaunchKernelGGL(fwd_kernel, dim3(grid), dim3(NTHR), LDS_BYTES, stream, a); }
#endif
}
```

```cpp
#include <hip/hip_runtime.h>
#include <cstdio>
#include <cstdint>

#define GAS __attribute__((address_space(1)))
#define LAS __attribute__((address_space(3)))
typedef unsigned short bf16_t;
typedef short bf16x8 __attribute__((ext_vector_type(8)));
typedef float f32x4 __attribute__((ext_vector_type(4)));
typedef float f32x2 __attribute__((ext_vector_type(2)));
typedef float f32x16 __attribute__((ext_vector_type(16)));
typedef unsigned u32x4 __attribute__((ext_vector_type(4)));
typedef unsigned u32x2 __attribute__((ext_vector_type(2)));
typedef int i32x4 __attribute__((ext_vector_type(4)));
typedef int i32x8 __attribute__((ext_vector_type(8)));
typedef short s16x4 __attribute__((ext_vector_type(4)));
typedef short s16x2 __attribute__((ext_vector_type(2)));

constexpr int S = 16384, D = 2048, DIN = 10832, DINP = 11008, NEXP = 32, DFF = 2048;
constexpr int NWAVES = 8, NTHR = 512;
constexpr int CQ = 0, CK = 1024, CV = 1280, CQI = 1536, CKI = 2560, CWI = 2624, CHQ = 2816, CHF = 3840, CHI = 4864, CHG = 5888, CGA = 6912, CGR = 8960;
constexpr int PMAX = 65536 + NEXP * 256;
constexpr float NORM_EPS = 1e-5f;

constexpr size_t MiB = 1u << 20;
constexpr size_t al256(size_t x) { return (x + 255) & ~(size_t)255; }
constexpr size_t WS_CTL = 0, CTL_BYTES = 1 * MiB;
constexpr size_t WS_MOD = WS_CTL + CTL_BYTES;
constexpr size_t WS_TOPE = WS_MOD + 64 * 1024;
constexpr size_t WS_GATE = WS_TOPE + (size_t)S * 16;
constexpr size_t WS_SLOT = WS_GATE + (size_t)S * 16;
constexpr size_t WS_WIN_T = WS_SLOT + (size_t)S * 16;
constexpr size_t WS_WA_T = WS_WIN_T + (size_t)DINP * D * 2;
constexpr size_t WS_WH_T = WS_WA_T + (size_t)2048 * 1024 * 2;
constexpr size_t WS_WO_T = WS_WH_T + (size_t)2048 * 1024 * 2;
constexpr size_t WS_W1_T = WS_WO_T + (size_t)2048 * 2048 * 2;
constexpr size_t WS_W2_T = WS_W1_T + (size_t)NEXP * 4096 * 2048 * 2;
constexpr size_t WS_H = WS_W2_T + (size_t)NEXP * 2048 * 2048 * 2;
constexpr size_t WS_PROJ = WS_H + (size_t)S * D * 2;
constexpr size_t WS_KI = WS_PROJ + (size_t)S * DINP * 2;
constexpr size_t WS_KC = WS_KI + (size_t)S * 64 * 2;
constexpr size_t WS_VC = WS_KC + (size_t)S * 256 * 2;
constexpr size_t WS_ST = WS_VC + (size_t)S * 256 * 2;
constexpr size_t WS_DC = WS_ST + (size_t)256 * 8 * 128 * 128 * 4;
constexpr size_t WS_SEL = WS_DC + (size_t)256 * 8 * 128 * 4;
constexpr size_t WS_ATT = WS_SEL + (size_t)S * 256 * 4;
constexpr size_t WS_REC = WS_ATT + (size_t)S * 1024 * 2;
constexpr size_t WS_MERGED = WS_REC + (size_t)S * 1024 * 2;
constexpr size_t WS_X1 = WS_MERGED + (size_t)S * 2048 * 2;
constexpr size_t WS_SCORES = WS_X1 + (size_t)S * 2048 * 4;
constexpr size_t WS_XB = WS_SCORES;
constexpr size_t WS_ACT = WS_XB + (size_t)PMAX * 2048 * 2;
constexpr size_t WS_YB = WS_ACT + (size_t)PMAX * 2048 * 2;
constexpr size_t WS_END = WS_SCORES + (size_t)S * S * 4;
static_assert(WS_YB + (size_t)PMAX * 2048 * 2 <= WS_END, "MoE buffers overlay the score matrix");
static_assert(WS_END <= (size_t)4096 * MiB, "workspace");
constexpr int CW_BAR = 4096, CW_CNT = 8192, CW_FILL = 8448;
constexpr size_t WS_TOKS = WS_SEL;

constexpr int LDS_BYTES = 155648;
constexpr int LDS_MISC = LDS_BYTES - 512;

__device__ __forceinline__ unsigned cvt_pk_bf16(float lo, float hi) { unsigned r; asm volatile("v_cvt_pk_bf16_f32 %0, %1, %2" : "=v"(r) : "v"(lo), "v"(hi)); return r; }
__device__ __forceinline__ float bf_lo(unsigned u) { return __uint_as_float(u << 16); }
__device__ __forceinline__ float bf_hi(unsigned u) { return __uint_as_float(u & 0xffff0000u); }
__device__ __forceinline__ float bf2f(bf16_t b) { return __uint_as_float(((unsigned)b) << 16); }
__device__ __forceinline__ float wave_sum(float v) {
#define DPPS(ctrl, rmask) { const int s_ = __builtin_amdgcn_update_dpp(0, __float_as_int(v), ctrl, rmask, 0xF, false); v += __int_as_float(s_); }
    DPPS(0x111, 0xF) DPPS(0x112, 0xF) DPPS(0x114, 0xF) DPPS(0x118, 0xF) DPPS(0x142, 0xA) DPPS(0x143, 0xC)
#undef DPPS
    return __int_as_float(__builtin_amdgcn_readlane(__float_as_int(v), 63));
}
__device__ __forceinline__ float wave_max(float v) {
#define DPPM(ctrl, rmask) { const int o_ = __float_as_int(v); const int s_ = __builtin_amdgcn_update_dpp(o_, o_, ctrl, rmask, 0xF, false); v = fmaxf(v, __int_as_float(s_)); }
    DPPM(0x111, 0xF) DPPM(0x112, 0xF) DPPM(0x114, 0xF) DPPM(0x118, 0xF) DPPM(0x142, 0xA) DPPM(0x143, 0xC)
#undef DPPM
    return __int_as_float(__builtin_amdgcn_readlane(__float_as_int(v), 63));
}
__device__ __forceinline__ float sigmoidf_(float x) { return __builtin_amdgcn_rcpf(1.0f + __expf(-x)); }
__device__ __forceinline__ float siluf_(float x) { return x * __builtin_amdgcn_rcpf(1.0f + __expf(-x)); }
__device__ __forceinline__ unsigned pack4_fp8(float a, float b, float c, float d) { int w = 0; w = __builtin_amdgcn_cvt_pk_fp8_f32(a, b, w, false); w = __builtin_amdgcn_cvt_pk_fp8_f32(c, d, w, true); return (unsigned)w; }
constexpr float W8_SCALE = 64.0f, ACT8_SCALE = 4.0f;
__device__ __forceinline__ float relu_i(float x) { const int i = __float_as_int(x); return __int_as_float(i > 0 ? i : 0); }
__device__ __forceinline__ void fp8x16_to_bf16(const u32x4& w, u32x4& lo, u32x4& hi) {
    unsigned o[8];
#pragma unroll
    for (int q = 0; q < 4; ++q) { const unsigned wq = w[q]; const f32x2 a = __builtin_amdgcn_cvt_pk_f32_fp8((int)wq, false), b = __builtin_amdgcn_cvt_pk_f32_fp8((int)wq, true);
        o[2 * q] = cvt_pk_bf16(a[0], a[1]); o[2 * q + 1] = cvt_pk_bf16(b[0], b[1]); }
    lo = (u32x4){o[0], o[1], o[2], o[3]}; hi = (u32x4){o[4], o[5], o[6], o[7]};
}
__device__ __forceinline__ unsigned char fp8_1(float x) { return (unsigned char)(__builtin_amdgcn_cvt_pk_fp8_f32(x, x, 0, false) & 0xff); }
#define LDS_WAIT() asm volatile("s_waitcnt lgkmcnt(0)" ::: "memory")
#define VM_WAIT() asm volatile("s_waitcnt vmcnt(0)" ::: "memory")

#define XB_TMO      128
#define XB_XCNT(j)  (256  + 64 * (j))
#define XB_XSUB(j)  (1280 + 64 * (j))
#define XB_XGEN(j)  (2304 + 64 * (j))
#define XB_TOP      3328
#define XB_TOPGEN   3392
#define XCD_BAR_WORDS 3456
#define XB_SPIN_CAP (1u << 22)

__device__ __forceinline__ unsigned xb_ld(unsigned* p)              { return __hip_atomic_load(p, __ATOMIC_RELAXED, __HIP_MEMORY_SCOPE_AGENT); }
__device__ __forceinline__ unsigned xb_add(unsigned* p, unsigned v) { return __hip_atomic_fetch_add(p, v, __ATOMIC_RELAXED, __HIP_MEMORY_SCOPE_AGENT); }
__device__ __forceinline__ unsigned xb_xcc_id() { return (unsigned)__builtin_amdgcn_s_getreg((3 << 11) | 20) & 0xFu; }
#define XB_SPIN(cond, bar) do { unsigned _sp = 0; while (cond) { __builtin_amdgcn_s_sleep(1); \
    if ((++_sp & 255u) == 0u) { if (xb_ld(&(bar)[XB_TMO])) break; if (_sp > XB_SPIN_CAP) { atomicAdd(&(bar)[XB_TMO], 1u); break; } } } } while (0)

struct XcdBarrier { unsigned* bar; unsigned x; volatile LAS unsigned* st; };

__device__ __forceinline__ XcdBarrier xcd_barrier_post(unsigned* bar, volatile LAS unsigned* st) {
    XcdBarrier b; b.bar = bar; b.x = xb_xcc_id(); b.st = st;
    if (threadIdx.x == 0) (void)xb_add(&bar[XB_XCNT(b.x)], 1u);
    return b;
}
__device__ __forceinline__ void xcd_barrier_complete(unsigned* bar, unsigned x, unsigned& nloc, unsigned& nx) {
    const unsigned G = gridDim.x * gridDim.y * gridDim.z;
    unsigned sum, cnt, mine, sp = 0u;
    for (;;) {
        sum = 0u; cnt = 0u; mine = 0u;
#pragma unroll
        for (unsigned j = 0; j < 16; ++j) { const unsigned c = xb_ld(&bar[XB_XCNT(j)]); sum += c; cnt += (c > 0u) ? 1u : 0u; mine = (j == x) ? c : mine; }
        if (sum == G) break;
        __builtin_amdgcn_s_sleep(1);
        if ((++sp & 255u) == 0u) { if (xb_ld(&bar[XB_TMO])) break; if (sp > XB_SPIN_CAP) { atomicAdd(&bar[XB_TMO], 1u); break; } }
    }
    nloc = mine > 0u ? mine : 1u; nx = cnt > 0u ? cnt : 1u;
}
__device__ __forceinline__ void xcd_barrier(const XcdBarrier& b) {
    asm volatile("s_waitcnt vmcnt(0)" ::: "memory");
    __syncthreads();
    if (threadIdx.x == 0) {
        unsigned* bar = b.bar;
        __builtin_amdgcn_s_waitcnt(0);
        unsigned nloc = b.st[0], nx = b.st[1];
        if (nloc == 0u) { xcd_barrier_complete(bar, b.x, nloc, nx); b.st[0] = nloc; b.st[1] = nx; }
        const unsigned old = xb_add(&bar[XB_XSUB(b.x)], 1u);
        const unsigned gen = old / nloc;
        if (old + 1u == (gen + 1u) * nloc) {
            __builtin_amdgcn_fence(__ATOMIC_RELEASE, "agent");
            asm volatile("s_waitcnt vmcnt(0)" ::: "memory");
            const unsigned og = xb_add(&bar[XB_TOP], 1u);
            const unsigned tg = og / nx;
            if (og + 1u == (tg + 1u) * nx) xb_add(&bar[XB_TOPGEN], 1u);
            else XB_SPIN(xb_ld(&bar[XB_TOPGEN]) == tg, bar);
            __builtin_amdgcn_fence(__ATOMIC_ACQUIRE, "agent");
            xb_add(&bar[XB_XGEN(b.x)], 1u);
            asm volatile("s_waitcnt vmcnt(0)" ::: "memory");
        } else {
            XB_SPIN(xb_ld(&bar[XB_XGEN(b.x)]) == gen, bar);
            __builtin_amdgcn_fence(__ATOMIC_ACQUIRE, "agent");
            asm volatile("s_waitcnt vmcnt(0)" ::: "memory");
        }
    }
    __syncthreads();
}

namespace pg8 {
constexpr int BM = 256, BK = 64, HALF = 128, HTB = HALF * BK * 2, STAGE_BYTES = 8 * HTB, NXCD = 8, WGM = 8;
__host__ __device__ __forceinline__ int lds_byte(int r, int c) { const int st = (r >> 4) * 2 + (c >> 5), rr = r & 15, cc = c & 31, ob = rr * 64 + cc * 2; return st * 1024 + (ob ^ (((ob >> 9) & 1) << 5)); }
__host__ __device__ __forceinline__ void stage_rc(int b, int& R, int& C) { const int st = b / 1024, sb = b % 1024, swz = sb ^ (((sb >> 9) & 1) << 5); R = (st >> 1) * 16 + swz / 64; C = (st & 1) * 32 + (swz % 64) / 2; }
__host__ __device__ __forceinline__ int perm32(int rho) { const int n = rho >> 4, i = rho & 15; return 8 * (i >> 2) + 4 * n + (i & 3); }

struct Unit { int pm, pn, e; };
struct Gemm { const void* A; const void* Bt; int K; size_t estride; const int* arow; size_t astride; };

struct StaticOrder {
    int nM, nN, nwg, G, c, i, full, erank, en;
    __device__ void init(int M, int N, int G_, int c_) { nM = M / BM; nN = N / BM; nwg = nM * nN; G = G_; c = c_; i = 0; full = 1 << 30; erank = -1; en = 1; }
    __device__ void skew(int full_, int erank_, int en_) { full = full_; erank = erank_; en = en_; }
    __device__ bool next(Unit& u) {
        long L;
        if (i < full) L = (long)i * G + c; else { if (erank < 0) return false; L = (long)full * G + (long)(i - full) * en + erank; }
        ++i; if (L >= nwg) return false;
        int wgid = (int)L; { const int q = nwg / NXCD, r = nwg % NXCD, xcd = wgid % NXCD, off = wgid / NXCD; wgid = (xcd < r ? xcd * (q + 1) : r * (q + 1) + (xcd - r) * q) + off; }
        const int nig = WGM * nN, gid = wgid / nig, fm = gid * WGM, gsz = (nM - fm) < WGM ? (nM - fm) : WGM;
        u.pm = fm + ((wgid % nig) % gsz); u.pn = (wgid % nig) / gsz; u.e = 0; return true;
    }
};
struct MoeOrder {
    int nPanels, nN, G, c, i; const LAS int* panel_e;
    __device__ void init(int nPanels_, int nN_, int G_, int c_, const LAS int* pe) { nPanels = nPanels_; nN = nN_; G = G_; c = c_; i = 0; panel_e = pe; }
    __device__ bool next(Unit& u) {
        const int PB = 256 / nN;
        const int nblk = (nPanels + PB - 1) / PB;
        for (;;) {
            const long L = (long)i * G + c; ++i;
            const int blk = (int)(L >> 8), r = (int)(L & 255), x = r & 7, j = r >> 3;
            if (blk >= nblk) return false;
            int pm, pn;
            if (nN == 16) { pm = blk * 16 + 4 * (x >> 1) + (j & 3); pn = 8 * (x & 1) + (j >> 2); }
            else          { pm = blk * 32 + 4 * x + (j & 3);        pn = j >> 2; }
            if (pm < nPanels) { u.pm = pm; u.pn = pn; u.e = panel_e[pm]; return true; }
        }
    }
};

template <class Epi, class Sched, bool FP8 = false>
__device__ __forceinline__ void gemm_phase(LAS unsigned char* lds, const Gemm g, Sched& S, const Epi& E) {
    const int tid = threadIdx.x, wid = __builtin_amdgcn_readfirstlane(tid >> 6), lane = tid & 63, wr = wid >> 2, wc = wid & 3, fr = lane & 15, fq = lane >> 4;
    const int K = g.K; const int pitch = FP8 ? K : 2 * K; const int nt = pitch / 128;
    unsigned voffA[2], voffB[2];
#pragma unroll
    for (int i = 0; i < 2; ++i) { int R, C; stage_rc(tid * 16 + i * 8192, R, C); const int Rb = Epi::PERM ? ((R & ~31) + perm32(R & 31)) : R;
        voffA[i] = (unsigned)(R * pitch + C * 2); voffB[i] = (unsigned)(Rb * pitch + C * 2); }
    const size_t kstep = (size_t)(BK * 2);
    const size_t hstep = (size_t)HALF * pitch;
    const size_t tstep = 2 * hstep;
    int RA[2], CA[2];
#pragma unroll
    for (int i = 0; i < 2; ++i) stage_rc(tid * 16 + i * 8192, RA[i], CA[i]);
    const bool gather = g.arow != nullptr;
    const size_t hsA = gather ? 0 : hstep;
    unsigned vA0[2] = {voffA[0], voffA[1]}, vA1[2] = {voffA[0], voffA[1]}, nA0[2] = {voffA[0], voffA[1]}, nA1[2] = {voffA[0], voffA[1]};
#define PG8_AOFF(dst0, dst1, u) do { if (gather) { _Pragma("unroll") for (int i = 0; i < 2; ++i) { \
        dst0[i] = (unsigned)g.arow[(u).pm * 256 + RA[i]] * (unsigned)pitch + (unsigned)(CA[i] * 2); dst1[i] = (unsigned)g.arow[(u).pm * 256 + 128 + RA[i]] * (unsigned)pitch + (unsigned)(CA[i] * 2); } } } while (0)
    const unsigned ldsw = (unsigned)wid * 1024u;
    const int aoff = lds_byte(wr * 64 + fr, fq * 8), boff = lds_byte(wc * 32 + fr, fq * 8);
#define PG8_SA(b, h) (((b) * 2 + (h)) * HTB)
#define PG8_SB(b, h) ((4 + (b) * 2 + (h)) * HTB)
#define PG8_STAGE(bufoff, gbase, voff) do { _Pragma("unroll") for (int _i = 0; _i < 2; ++_i) \
        __builtin_amdgcn_global_load_lds((const unsigned*)((const char*)(gbase) + (voff)[_i]), (LAS unsigned*)(lds + (bufoff) + ldsw + _i * 8192), 16, 0, 0); } while (0)
#define PG8_LD8(p) __builtin_shufflevector(*(const LAS i32x4*)(p), *(const LAS i32x4*)((p) + 1024), 0, 1, 2, 3, 4, 5, 6, 7)
#define PG8_LDA(dst, b, h) do { _Pragma("unroll") for (int m = 0; m < 4; ++m) { if constexpr (FP8) dst##8[m] = PG8_LD8(lds + PG8_SA(b, h) + aoff + m * 2048); \
        else { _Pragma("unroll") for (int k = 0; k < 2; ++k) dst[m][k] = *(const LAS bf16x8*)(lds + PG8_SA(b, h) + aoff + m * 2048 + k * 1024); } } } while (0)
#define PG8_LDB(dst, b, h) do { _Pragma("unroll") for (int n = 0; n < 2; ++n) { if constexpr (FP8) dst##8[n] = PG8_LD8(lds + PG8_SB(b, h) + boff + n * 2048); \
        else { _Pragma("unroll") for (int k = 0; k < 2; ++k) dst[n][k] = *(const LAS bf16x8*)(lds + PG8_SB(b, h) + boff + n * 2048 + k * 1024); } } } while (0)
#define PG8_MMA(ai, bj, At, Bt) do { __builtin_amdgcn_s_setprio(1); _Pragma("unroll") for (int m = 0; m < 4; ++m) _Pragma("unroll") for (int n = 0; n < 2; ++n) { \
        if constexpr (FP8) asm volatile("v_mfma_scale_f32_16x16x128_f8f6f4 %0, %1, %2, %0, %3, %3 op_sel_hi:[0,0,0]" : "+v"(acc[ai][bj][m][n]) : "v"(Bt##8[n]), "v"(At##8[m]), "v"(scl1)); \
        else { _Pragma("unroll") for (int k = 0; k < 2; ++k) acc[ai][bj][m][n] = __builtin_amdgcn_mfma_f32_16x16x32_bf16(Bt[n][k], At[m][k], acc[ai][bj][m][n], 0, 0, 0); } } \
        __builtin_amdgcn_s_setprio(0); } while (0)
#define PG8_WAIT_V(n) asm volatile("s_waitcnt vmcnt(" #n ")" ::: "memory")
#define PG8_WAIT_L(n) asm volatile("s_waitcnt lgkmcnt(" #n ")" ::: "memory")
#define PG8_BAR __builtin_amdgcn_s_barrier()
#define PG8_SCHED __builtin_amdgcn_sched_barrier(0)
    Unit cur, nxt;
    if (!S.next(cur)) return;
    const unsigned scl1 = 0x7f7f7f7fu;
    f32x4 acc[2][2][4][2];
#pragma unroll
    for (int a = 0; a < 2; ++a)
#pragma unroll
        for (int b = 0; b < 2; ++b)
#pragma unroll
            for (int m = 0; m < 4; ++m)
#pragma unroll
                for (int n = 0; n < 2; ++n) acc[a][b][m][n] = (f32x4){0.f, 0.f, 0.f, 0.f};
    bf16x8 At[4][2], B0[2][2], B1[2][2]; i32x8 At8[4], B08[2], B18[2];
    const char* cA = (const char*)g.A + (size_t)cur.e * g.astride + (gather ? (size_t)0 : (size_t)cur.pm * tstep); const char* cB = (const char*)g.Bt + (size_t)cur.e * g.estride + (size_t)cur.pn * tstep;
    PG8_AOFF(vA0, vA1, cur);
    PG8_STAGE(PG8_SB(0, 0), cB, voffB); PG8_STAGE(PG8_SB(0, 1), cB + hstep, voffB); PG8_STAGE(PG8_SA(0, 0), cA, vA0); PG8_STAGE(PG8_SA(0, 1), cA + hsA, vA1);
    if (wr == 1) PG8_BAR;
    PG8_WAIT_V(2); PG8_BAR;
    PG8_STAGE(PG8_SB(1, 0), cB + kstep, voffB); PG8_STAGE(PG8_SA(1, 0), cA + kstep, vA0); PG8_STAGE(PG8_SB(1, 1), cB + hstep + kstep, voffB);
    PG8_WAIT_V(6); PG8_BAR;
    for (;;) {
        const bool has_next = S.next(nxt);
        const char* nA = has_next ? (const char*)g.A + (size_t)nxt.e * g.astride + (gather ? (size_t)0 : (size_t)nxt.pm * tstep) : cA;
        if (has_next) PG8_AOFF(nA0, nA1, nxt);
        const char* nB = has_next ? (const char*)g.Bt + (size_t)nxt.e * g.estride + (size_t)nxt.pn * tstep : cB;
        for (int t = 0; t < nt; t += 2) {
            const bool last = (t == nt - 2);
            const char* a1 = cA + (size_t)(t + 1) * kstep;
            const char* a2 = last ? nA : cA + (size_t)(t + 2) * kstep; const char* b2 = last ? nB : cB + (size_t)(t + 2) * kstep;
            const char* a3 = a2 + kstep; const char* b3 = b2 + kstep;
            PG8_LDB(B0, 0, 0); PG8_LDB(B1, 0, 1); PG8_SCHED; PG8_LDA(At, 0, 0); PG8_STAGE(PG8_SA(1, 1), a1 + hsA, vA1);
            if (last && has_next) { vA0[0] = nA0[0]; vA0[1] = nA0[1]; vA1[0] = nA1[0]; vA1[1] = nA1[1]; }
            PG8_WAIT_V(8); PG8_WAIT_L(0); PG8_BAR; PG8_MMA(0, 0, At, B0); PG8_MMA(0, 1, At, B1); PG8_BAR; PG8_SCHED;
            PG8_LDA(At, 0, 1); PG8_STAGE(PG8_SB(0, 0), b2, voffB); PG8_STAGE(PG8_SB(0, 1), b2 + hstep, voffB); PG8_STAGE(PG8_SA(0, 0), a2, vA0);
            PG8_WAIT_V(8); PG8_WAIT_L(0); PG8_BAR; PG8_MMA(1, 0, At, B0); PG8_MMA(1, 1, At, B1); PG8_BAR; PG8_SCHED;
            PG8_LDB(B0, 1, 0); PG8_LDB(B1, 1, 1); PG8_SCHED; PG8_LDA(At, 1, 0); PG8_STAGE(PG8_SA(0, 1), a2 + hsA, vA1);
            PG8_WAIT_V(8); PG8_WAIT_L(0); PG8_BAR; PG8_MMA(0, 0, At, B0); PG8_MMA(0, 1, At, B1); PG8_BAR; PG8_SCHED;
            PG8_LDA(At, 1, 1); PG8_STAGE(PG8_SB(1, 0), b3, voffB); PG8_STAGE(PG8_SB(1, 1), b3 + hstep, voffB); PG8_STAGE(PG8_SA(1, 0), a3, vA0);
            PG8_WAIT_V(8); PG8_WAIT_L(0); PG8_BAR; PG8_MMA(1, 0, At, B0); PG8_MMA(1, 1, At, B1); PG8_BAR; PG8_SCHED;
        }
        if (wr == 0) PG8_BAR;
        if constexpr (FP8) {
#pragma unroll
            for (int a = 0; a < 2; ++a)
#pragma unroll
                for (int b = 0; b < 2; ++b) asm volatile("s_nop 15" : "+v"(acc[a][b][0][0]), "+v"(acc[a][b][0][1]), "+v"(acc[a][b][1][0]), "+v"(acc[a][b][1][1]), "+v"(acc[a][b][2][0]), "+v"(acc[a][b][2][1]), "+v"(acc[a][b][3][0]), "+v"(acc[a][b][3][1]));
        }
        const bool keep_acc = E(acc, cur, wr, wc, fr, fq);
        if (!has_next) break;
        if (!keep_acc)
#pragma unroll
        for (int a = 0; a < 2; ++a)
#pragma unroll
            for (int b = 0; b < 2; ++b)
#pragma unroll
                for (int m = 0; m < 4; ++m)
#pragma unroll
                    for (int n = 0; n < 2; ++n) acc[a][b][m][n] = (f32x4){0.f, 0.f, 0.f, 0.f};
        cur = nxt; cA = nA; cB = nB;
        if (wr == 1) PG8_BAR;
    }
    PG8_WAIT_V(0);
    PG8_BAR;
#undef PG8_AOFF
#undef PG8_SA
#undef PG8_SB
#undef PG8_STAGE
#undef PG8_LDA
#undef PG8_LDB
#undef PG8_MMA
#undef PG8_LD8
#undef PG8_WAIT_V
#undef PG8_WAIT_L
#undef PG8_BAR
#undef PG8_SCHED
}

struct EpiBf16 {
    static constexpr bool PERM = true;
    bf16_t* O; int ldc; const float* bias; int bias_estride; float ascale; int skip_from, skip_cols;
    __device__ __forceinline__ bool operator()(const f32x4 (&acc)[2][2][4][2], const Unit& u, int wr, int wc, int fr, int fq) const {
        const int row0 = u.pm * BM + wr * 64 + fr; const int col0 = u.pn * BM + wc * 32 + 8 * fq + (u.pn >= skip_from ? skip_cols : 0);
        f32x4 bv[2][2];
#pragma unroll
        for (int bj = 0; bj < 2; ++bj)
#pragma unroll
            for (int n = 0; n < 2; ++n) bv[bj][n] = bias ? *(const f32x4*)(bias + (size_t)u.e * bias_estride + col0 + bj * HALF + 4 * n) : (f32x4){0.f, 0.f, 0.f, 0.f};
#pragma unroll
        for (int ai = 0; ai < 2; ++ai)
#pragma unroll
            for (int m = 0; m < 4; ++m) { bf16_t* rowp = O + (size_t)(row0 + ai * HALF + m * 16) * ldc + col0;
#pragma unroll
                for (int bj = 0; bj < 2; ++bj) { const f32x4 v0 = acc[ai][bj][m][0] * ascale + bv[bj][0], v1 = acc[ai][bj][m][1] * ascale + bv[bj][1];
                    u32x4 w; w.x = cvt_pk_bf16(v0[0], v0[1]); w.y = cvt_pk_bf16(v0[2], v0[3]); w.z = cvt_pk_bf16(v1[0], v1[1]); w.w = cvt_pk_bf16(v1[2], v1[3]);
                    *(u32x4*)(rowp + bj * HALF) = w; } }
        return false;
    }
};
__device__ __forceinline__ float swiglu1(float ug, float ul) {
    ug = fminf(ug, 7.0f); ul = fminf(fmaxf(ul, -7.0f), 7.0f);
    return ug * __builtin_amdgcn_rcpf(1.0f + __expf(-1.702f * ug)) * (ul + 1.0f);
}
struct EpiSwiglu {
    static constexpr bool PERM = true;
    unsigned char* O; const float* b1;
    __device__ __forceinline__ bool operator()(const f32x4 (&acc)[2][2][4][2], const Unit& u, int wr, int wc, int fr, int fq) const {
        const int row0 = u.pm * BM + wr * 64 + fr; const int c0 = u.pn * 128 + wc * 32 + 8 * fq;
        const float* bg = b1 + (size_t)u.e * 4096 + c0; const float* bl = bg + 2048;
        f32x4 bgv[2], blv[2];
#pragma unroll
        for (int n = 0; n < 2; ++n) { bgv[n] = *(const f32x4*)(bg + 4 * n); blv[n] = *(const f32x4*)(bl + 4 * n); }
#pragma unroll
        for (int ai = 0; ai < 2; ++ai)
#pragma unroll
            for (int m = 0; m < 4; ++m) {
                float a[8];
#pragma unroll
                for (int n = 0; n < 2; ++n)
#pragma unroll
                    for (int j = 0; j < 4; ++j) a[4 * n + j] = ACT8_SCALE * swiglu1(acc[ai][0][m][n][j] * (1.0f / W8_SCALE) + bgv[n][j], acc[ai][1][m][n][j] * (1.0f / W8_SCALE) + blv[n][j]);
                u32x2 w; w.x = pack4_fp8(a[0], a[1], a[2], a[3]); w.y = pack4_fp8(a[4], a[5], a[6], a[7]);
                *(u32x2*)(O + (size_t)(row0 + ai * HALF + m * 16) * 2048 + c0) = w;
            }
        return false;
    }
};

struct TwoPartOrder {
    StaticOrder so; Unit held; int part;
    __device__ void init(int M, int N, int G_, int c_) { so.init(M, N, G_, c_); part = 0; }
    __device__ bool next(Unit& u) { if (part == 1) { u = held; u.e = 1; part = 0; return true; } if (!so.next(held)) return false; u = held; u.e = 0; part = 1; return true; }
};
struct EpiGate2 {
    static constexpr bool PERM = true;
    bf16_t* O; const bf16_t* Ga; const bf16_t* Gr;
    __device__ __forceinline__ bool operator()(f32x4 (&acc)[2][2][4][2], const Unit& u, int wr, int wc, int fr, int fq) const {
        const int row0 = u.pm * BM + wr * 64 + fr; const int col0 = u.pn * BM + wc * 32 + 8 * fq;
#pragma unroll
        for (int ai = 0; ai < 2; ++ai)
#pragma unroll
            for (int m = 0; m < 4; ++m) { const size_t row = (size_t)(row0 + ai * HALF + m * 16);
#pragma unroll
                for (int bj = 0; bj < 2; ++bj) { const int c = col0 + bj * HALF;
                    const u32x4 gr = *(const u32x4*)(Gr + row * DINP + c);
                    if (u.e == 0) {
                        const u32x4 ga = *(const u32x4*)(Ga + row * DINP + c);
#pragma unroll
                        for (int q = 0; q < 4; ++q) {
                            const float r0 = (1.0f + __expf(-bf_lo(gr[q]))) * __builtin_amdgcn_rcpf(1.0f + __expf(-bf_lo(ga[q]))), r1 = (1.0f + __expf(-bf_hi(gr[q]))) * __builtin_amdgcn_rcpf(1.0f + __expf(-bf_hi(ga[q])));
                            acc[ai][bj][m][q >> 1][(2 * q) & 3] *= r0; acc[ai][bj][m][q >> 1][(2 * q + 1) & 3] *= r1; }
                    } else {
                        float r[8];
#pragma unroll
                        for (int q = 0; q < 4; ++q) { r[2 * q] = sigmoidf_(bf_lo(gr[q])) * acc[ai][bj][m][q >> 1][(2 * q) & 3]; r[2 * q + 1] = sigmoidf_(bf_hi(gr[q])) * acc[ai][bj][m][q >> 1][(2 * q + 1) & 3]; }
                        u32x4 w; w.x = cvt_pk_bf16(r[0], r[1]); w.y = cvt_pk_bf16(r[2], r[3]); w.z = cvt_pk_bf16(r[4], r[5]); w.w = cvt_pk_bf16(r[6], r[7]);
                        *(u32x4*)(O + row * 2048 + c) = w; } } }
        return u.e == 0;
    }
};
struct EpiDelta {
    static constexpr bool PERM = true;
    const float* gt; bf16_t* DL;
    __device__ __forceinline__ bool operator()(const f32x4 (&acc)[2][2][4][2], const Unit& u, int wr, int wc, int fr, int fq) const {
        const int row0 = u.pm * BM + wr * 64 + fr; const int col0 = u.pn * BM + wc * 32 + 8 * fq;
        f32x4 g[2][2];
#pragma unroll
        for (int bj = 0; bj < 2; ++bj)
#pragma unroll
            for (int n = 0; n < 2; ++n) g[bj][n] = *(const f32x4*)(gt + col0 + bj * HALF + 4 * n);
#pragma unroll
        for (int ai = 0; ai < 2; ++ai)
#pragma unroll
            for (int m = 0; m < 4; ++m) { bf16_t* rowp = DL + (size_t)(row0 + ai * HALF + m * 16) * 2048 + col0;
#pragma unroll
                for (int bj = 0; bj < 2; ++bj) { const f32x4 v0 = acc[ai][bj][m][0] * g[bj][0], v1 = acc[ai][bj][m][1] * g[bj][1];
                    u32x4 w; w.x = cvt_pk_bf16(v0[0], v0[1]); w.y = cvt_pk_bf16(v0[2], v0[3]); w.z = cvt_pk_bf16(v1[0], v1[1]); w.w = cvt_pk_bf16(v1[2], v1[3]);
                    *(u32x4*)(rowp + bj * HALF) = w; } }
        return false;
    }
};
}

struct Args { const void* in[22]; float* out; unsigned char* ws; int ph_lo, ph_hi, flags, pad; };
enum { PH_PRO = 0, PH_H, PH_INPROJ, PH_POST, PH_SCORE, PH_SELECT, PH_ATTN, PH_OP1, PH_OP2, PH_WOUT, PH_ROUTER, PH_SCATTER, PH_MOE1, PH_MOE2, PH_FINAL, NPH };

__device__ __forceinline__ int dest_row(int mode, int n) {
    if (mode == 1) return n < 2640 ? n : n + 176;
    if (mode == 2) { const int g = n >> 11, c = n & 2047; return (c >> 7) * 256 + g * 128 + (c & 127); }
    return n;
}
__device__ __forceinline__ void convert_item(const float* __restrict__ W, int K, int N, int ld, bf16_t* WT, int mode, int item, int lane, LAS unsigned char* scr) {
    const int nblk = (N + 63) >> 6; const int kb = item / nblk, nb = item - kb * nblk; const int k0 = kb * 128, n0 = nb * 64;
    const int c4 = lane & 15, kr = lane >> 4;
    const bool ok = (n0 + 4 * c4) < N;
    const float* src = W + (size_t)(k0 + 2 * kr) * ld + n0 + 4 * c4;
#pragma unroll 4
    for (int i = 0; i < 16; ++i) {
        f32x4 v0 = (f32x4){0.f, 0.f, 0.f, 0.f}, v1 = v0;
        if (ok) { v0 = *(const f32x4*)(src + (size_t)(8 * i) * ld); v1 = *(const f32x4*)(src + (size_t)(8 * i + 1) * ld); }
        const int kk = 8 * i + 2 * kr;
#pragma unroll
        for (int e = 0; e < 4; ++e) *(LAS unsigned*)(scr + (4 * c4 + e) * 272 + kk * 2) = cvt_pk_bf16(v0[e], v1[e]);
    }
    LDS_WAIT(); asm volatile("" ::: "memory");
#pragma unroll 4
    for (int j = 0; j < 16; ++j) {
        const int q = j * 64 + lane, n = q >> 4, ch = q & 15;
        const u32x4 v = *(const LAS u32x4*)(scr + n * 272 + ch * 16);
        if (n0 + n < N) *(u32x4*)(WT + (size_t)dest_row(mode, n0 + n) * K + k0 + ch * 8) = v;
    }
    LDS_WAIT(); asm volatile("" ::: "memory");
}


__device__ __forceinline__ bf16_t f2bf(float f) { unsigned u = __float_as_uint(f); return (bf16_t)((u + 0x7fffu + ((u >> 16) & 1u)) >> 16); }
__device__ __forceinline__ float bfx(const u32x4& w, int i) { const unsigned u = w[i >> 1]; return (i & 1) ? bf_hi(u) : bf_lo(u); }
__device__ __forceinline__ void rope_sc(float pos, float inv, float& sn, float& cs) {
    const float ang = pos * inv;
    const double a = (double)ang; const double n = __builtin_rint(a * 0.15915494309189535); const float r = (float)(a - n * 6.283185307179586);
    sn = sinf(r); cs = cosf(r);
}
__device__ __forceinline__ void post_token(bf16_t* PROJ, bf16_t* KI, unsigned char* KC, unsigned char* VC, const int* positions, const float* kng, const float* knb, int t, int lane) {
    const float pos = (float)positions[t];
    bf16_t* row = PROJ + (size_t)t * DINP;
    float sn, cs;
#pragma unroll
    for (int i = 0; i < 2; ++i) {
        const int pp = lane + 64 * i, hd = pp >> 4, ii = pp & 15;
        rope_sc(pos, powf(500000.0f, -(float)ii * (1.0f / 16.0f)), sn, cs);
        bf16_t* p = row + CQ + hd * 128 + ii; const float a = bf2f(p[0]), b = bf2f(p[16]);
        p[0] = f2bf(a * cs - b * sn); p[16] = f2bf(b * cs + a * sn);
    }
#pragma unroll
    for (int i = 0; i < 2; ++i) {
        const int pp = lane + 64 * i, hd = pp >> 3, ii = pp & 7;
        rope_sc(pos, powf(500000.0f, -(float)ii * (1.0f / 8.0f)), sn, cs);
        bf16_t* p = row + CQI + hd * 64 + ii; const float a = bf2f(p[0]), b = bf2f(p[8]);
        p[0] = f2bf(a * cs - b * sn); p[8] = f2bf(b * cs + a * sn);
    }
    if (lane < 32) {
        const int g = lane >> 4, ii = lane & 15;
        rope_sc(pos, powf(500000.0f, -(float)ii * (1.0f / 16.0f)), sn, cs);
        const bf16_t* p = row + CK + g * 128 + ii; const float a = bf2f(p[0]), b = bf2f(p[16]);
        unsigned char* o = KC + (size_t)t * 256 + g * 128 + ii; o[0] = fp8_1(a * cs - b * sn); o[16] = fp8_1(b * cs + a * sn);
    }
#pragma unroll
    for (int i = 0; i < 3; ++i) { const int idx = lane + 64 * i, g = idx / 96, r = idx - g * 96; KC[(size_t)t * 256 + g * 128 + 32 + r] = fp8_1(bf2f(row[CK + g * 128 + 32 + r])); }
    { const u32x2 w = *(const u32x2*)(row + CV + 4 * lane); *(unsigned*)(VC + (size_t)t * 256 + 4 * lane) = pack4_fp8(bf_lo(w.x), bf_hi(w.x), bf_lo(w.y), bf_hi(w.y)); }
    {
        const float v = bf2f(row[CKI + lane]);
        const float mean = wave_sum(v) * (1.0f / 64.0f); const float d = v - mean; const float var = wave_sum(d * d) * (1.0f / 64.0f);
        const float y = d * rsqrtf(var + NORM_EPS) * kng[lane] + knb[lane];
        const float other = __shfl_xor(y, 8);
        rope_sc(pos, powf(500000.0f, -(float)(lane & 7) * (1.0f / 8.0f)), sn, cs);
        float o = y;
        if (lane < 8) o = y * cs - other * sn; else if (lane < 16) o = y * cs + other * sn;
        KI[(size_t)t * 64 + lane] = f2bf(o);
    }
}

constexpr int HG_GB = 0, HG_Q1 = 33792, HG_Q2 = 51200, HG_K2 = 68608, HG_VT = 86016, HG_PB = 104448, HG_LB = 113664;
__device__ __forceinline__ void hgrn_cumsum(LAS unsigned char* lds, const u32x4& w0, const u32x4& w1, float l0, float l1, int tid) {
    LAS float* GB = (LAS float*)(lds + HG_GB); LAS float* LB = (LAS float*)(lds + HG_LB); LAS float* SEG = (LAS float*)(lds + HG_LB + 512);
    if (tid < 128) LB[tid] = 1.0f / (1.0f + expf(l1 - l0));
    __syncthreads();
    const int t = tid >> 3, dseg = tid & 7;
#pragma unroll
    for (int i = 0; i < 16; ++i) { const float z = i < 8 ? bfx(w0, i) : bfx(w1, i - 8); const float lb = LB[16 * dseg + i]; GB[t * 128 + 16 * dseg + i] = logf(lb + (1.0f - lb) * sigmoidf_(z)); }
    __syncthreads();
    const int d = tid & 127, tq = tid >> 7;
    float z[16];
#pragma unroll
    for (int i = 0; i < 16; ++i) z[i] = GB[(16 * tq + i) * 128 + d];
    float a = 0.f;
#pragma unroll
    for (int i = 0; i < 16; ++i) { a += z[i]; z[i] = a; }
    SEG[tq * 128 + d] = a;
    __syncthreads();
    float pre = 0.f;
    for (int q = 0; q < tq; ++q) pre += SEG[q * 128 + d];
#pragma unroll
    for (int i = 0; i < 16; ++i) GB[(16 * tq + i) * 128 + d] = z[i] + pre;
    __syncthreads();
}
__device__ __forceinline__ void hgrn_vt(LAS unsigned char* lds, const u32x4& a, const u32x4& b, int tid) {
    const int s2 = tid & 31, eg = tid >> 5;
#pragma unroll
    for (int i = 0; i < 8; ++i) { const unsigned lo = (i & 1) ? (a[i >> 1] >> 16) : (a[i >> 1] & 0xffffu), hi = (i & 1) ? (b[i >> 1] >> 16) : (b[i >> 1] & 0xffffu);
        *(LAS unsigned*)(lds + HG_VT + (8 * eg + i) * 144 + s2 * 4) = lo | (hi << 16); }
}
__device__ __forceinline__ void hgrn_l1(LAS unsigned char* lds, const bf16_t* PROJ, const float* lb_logits, float* ST, float* DC, int c, int h, int tid, int wave, int lane) {
    const int t = tid >> 3, dseg = tid & 7, s2 = tid & 31, dg = tid >> 5;
    const bf16_t* pf = PROJ + (size_t)(c * 64 + t) * DINP + CHF + h * 128 + 16 * dseg;
    const bf16_t* pk = PROJ + (size_t)(c * 64 + 2 * s2) * DINP + CHF + h * 128 + 8 * dg;
    const u32x4 w0 = *(const u32x4*)pf, w1 = *(const u32x4*)(pf + 8);
    const u32x4 ka = *(const u32x4*)pk, kb = *(const u32x4*)(pk + DINP);
    const u32x4 va = *(const u32x4*)(pk - CHF + CHI), vb = *(const u32x4*)(pk - CHF + CHI + DINP);
    const float l0 = lb_logits[h * 128 + (tid & 127)], l1 = lb_logits[1024 + h * 128 + (tid & 127)];
    hgrn_cumsum(lds, w0, w1, l0, l1, tid);
    const LAS float* GB = (const LAS float*)(lds + HG_GB); const LAS float* LB = (const LAS float*)(lds + HG_LB);
    {
#pragma unroll
        for (int i = 0; i < 8; ++i) { const int d = 8 * dg + i; const float lb = LB[d], b63 = GB[63 * 128 + d];
            const float k0 = (1.0f - lb) * (1.0f - sigmoidf_(bfx(ka, i))), k1 = (1.0f - lb) * (1.0f - sigmoidf_(bfx(kb, i)));
            const float v0 = k0 * __expf(b63 - GB[(2 * s2) * 128 + d]), v1 = k1 * __expf(b63 - GB[(2 * s2 + 1) * 128 + d]);
            *(LAS unsigned*)(lds + HG_Q1 + d * 144 + s2 * 4) = cvt_pk_bf16(v0, v1); }
    }
    hgrn_vt(lds, va, vb, tid);
    __syncthreads();
    const int fr = lane & 15, fq = lane >> 4;
    bf16x8 af[2];
#pragma unroll
    for (int ks = 0; ks < 2; ++ks) af[ks] = *(const LAS bf16x8*)(lds + HG_VT + (16 * wave + fr) * 144 + (32 * ks + 8 * fq) * 2);
    float* dst = ST + ((size_t)(c * 8 + h) * 128) * 128;
#pragma unroll 2
    for (int dt = 0; dt < 8; ++dt) {
        f32x4 acc = (f32x4){0.f, 0.f, 0.f, 0.f};
#pragma unroll
        for (int ks = 0; ks < 2; ++ks) { const bf16x8 bfr = *(const LAS bf16x8*)(lds + HG_Q1 + (16 * dt + fr) * 144 + (32 * ks + 8 * fq) * 2); acc = __builtin_amdgcn_mfma_f32_16x16x32_bf16(af[ks], bfr, acc, 0, 0, 0); }
#pragma unroll
        for (int r = 0; r < 4; ++r) dst[(size_t)(16 * wave + 4 * fq + r) * 128 + 16 * dt + fr] = acc[r];
    }
    if (tid < 128) DC[(size_t)(c * 8 + h) * 128 + tid] = __expf(GB[63 * 128 + tid]);
    __syncthreads();
}
__device__ __forceinline__ void hgrn_l3(LAS unsigned char* lds, const bf16_t* PROJ, const float* lb_logits, const float* ST, const float* norm_g, bf16_t* REC, int c, int h, int tid, int wave, int lane) {
    const int t = tid >> 3, dseg = tid & 7, s2 = tid & 31, eg = tid >> 5, fr = lane & 15, fq = lane >> 4;
    const bf16_t* pf = PROJ + (size_t)(c * 64 + t) * DINP + CHF + h * 128 + 16 * dseg;
    const u32x4 f0 = *(const u32x4*)pf, f1 = *(const u32x4*)(pf + 8), q0 = *(const u32x4*)(pf - CHF + CHQ), q1 = *(const u32x4*)(pf - CHF + CHQ + 8);
    const u32x4 g0 = *(const u32x4*)(pf - CHF + CHG), g1 = *(const u32x4*)(pf - CHF + CHG + 8);
    const bf16_t* pv = PROJ + (size_t)(c * 64 + 2 * s2) * DINP + CHI + h * 128 + 8 * eg;
    const u32x4 va = *(const u32x4*)pv, vb = *(const u32x4*)(pv + DINP);
    const float* sp = ST + ((size_t)(c * 8 + h) * 128 + 16 * wave + fr) * 128 + 8 * fq;
    f32x4 sx[4][2];
#pragma unroll
    for (int ks = 0; ks < 4; ++ks) { sx[ks][0] = *(const f32x4*)(sp + 32 * ks); sx[ks][1] = *(const f32x4*)(sp + 32 * ks + 4); }
    const float l0 = lb_logits[h * 128 + (tid & 127)], l1 = lb_logits[1024 + h * 128 + (tid & 127)];
    hgrn_cumsum(lds, f0, f1, l0, l1, tid);
    const LAS float* GB = (const LAS float*)(lds + HG_GB); const LAS float* LB = (const LAS float*)(lds + HG_LB);
    {
        unsigned o1[8], o2[8], o3[8];
#pragma unroll
        for (int i = 0; i < 16; i += 2) {
            float a1[2], a2[2], a3[2];
#pragma unroll
            for (int j = 0; j < 2; ++j) { const int d = 16 * dseg + i + j; const float lb = LB[d], b = GB[t * 128 + d], br = GB[31 * 128 + d];
                const float z = (i + j) < 8 ? bfx(f0, i + j) : bfx(f1, i + j - 8), qv = (i + j) < 8 ? bfx(q0, i + j) : bfx(q1, i + j - 8);
                const float k = (1.0f - lb) * (1.0f - sigmoidf_(z)), q = siluf_(qv);
                a1[j] = q * __expf(b); a2[j] = q * __expf(b - br); a3[j] = k * __expf(br - b); }
            o1[i >> 1] = cvt_pk_bf16(a1[0], a1[1]); o2[i >> 1] = cvt_pk_bf16(a2[0], a2[1]); o3[i >> 1] = cvt_pk_bf16(a3[0], a3[1]);
        }
        LAS u32x4* d1 = (LAS u32x4*)(lds + HG_Q1 + t * 272 + dseg * 32); LAS u32x4* d2 = (LAS u32x4*)(lds + HG_Q2 + t * 272 + dseg * 32); LAS u32x4* d3 = (LAS u32x4*)(lds + HG_K2 + t * 272 + dseg * 32);
        d1[0] = (u32x4){o1[0], o1[1], o1[2], o1[3]}; d1[1] = (u32x4){o1[4], o1[5], o1[6], o1[7]};
        d2[0] = (u32x4){o2[0], o2[1], o2[2], o2[3]}; d2[1] = (u32x4){o2[4], o2[5], o2[6], o2[7]};
        d3[0] = (u32x4){o3[0], o3[1], o3[2], o3[3]}; d3[1] = (u32x4){o3[4], o3[5], o3[6], o3[7]};
    }
    hgrn_vt(lds, va, vb, tid);
    __syncthreads();
#pragma unroll
    for (int q = 0; q < 2; ++q) {
        const int tile = 2 * wave + q, tt = tile >> 2, stl = tile & 3;
        f32x4 acc = (f32x4){0.f, 0.f, 0.f, 0.f};
#pragma unroll
        for (int ks = 0; ks < 4; ++ks) { const bf16x8 a = *(const LAS bf16x8*)(lds + HG_Q2 + (16 * tt + fr) * 272 + (32 * ks + 8 * fq) * 2), b = *(const LAS bf16x8*)(lds + HG_K2 + (16 * stl + fr) * 272 + (32 * ks + 8 * fq) * 2);
            acc = __builtin_amdgcn_mfma_f32_16x16x32_bf16(a, b, acc, 0, 0, 0); }
#pragma unroll
        for (int r = 0; r < 4; ++r) { const int tr_ = 16 * tt + 4 * fq + r, s = 16 * stl + fr; *(LAS bf16_t*)(lds + HG_PB + tr_ * 144 + s * 2) = f2bf(s <= tr_ ? acc[r] : 0.f); }
    }
    __syncthreads();
    {
        bf16x8 b1[2], b2[4];
#pragma unroll
        for (int ks = 0; ks < 2; ++ks) b1[ks] = *(const LAS bf16x8*)(lds + HG_VT + (16 * wave + fr) * 144 + (32 * ks + 8 * fq) * 2);
#pragma unroll
        for (int ks = 0; ks < 4; ++ks) { const f32x4 x0 = sx[ks][0], x1 = sx[ks][1];
            u32x4 w; w.x = cvt_pk_bf16(x0[0], x0[1]); w.y = cvt_pk_bf16(x0[2], x0[3]); w.z = cvt_pk_bf16(x1[0], x1[1]); w.w = cvt_pk_bf16(x1[2], x1[3]); b2[ks] = __builtin_bit_cast(bf16x8, w); }
        LAS float* OB = (LAS float*)(lds + HG_GB);
#pragma unroll
        for (int tt = 0; tt < 4; ++tt) {
            f32x4 acc = (f32x4){0.f, 0.f, 0.f, 0.f};
#pragma unroll
            for (int ks = 0; ks < 2; ++ks) { const bf16x8 a = *(const LAS bf16x8*)(lds + HG_PB + (16 * tt + fr) * 144 + (32 * ks + 8 * fq) * 2); acc = __builtin_amdgcn_mfma_f32_16x16x32_bf16(a, b1[ks], acc, 0, 0, 0); }
#pragma unroll
            for (int ks = 0; ks < 4; ++ks) { const bf16x8 a = *(const LAS bf16x8*)(lds + HG_Q1 + (16 * tt + fr) * 272 + (32 * ks + 8 * fq) * 2); acc = __builtin_amdgcn_mfma_f32_16x16x32_bf16(a, b2[ks], acc, 0, 0, 0); }
#pragma unroll
            for (int r = 0; r < 4; ++r) OB[(16 * tt + 4 * fq + r) * 132 + 16 * wave + fr] = acc[r];
        }
    }
    __syncthreads();
    {
        const int es = dseg; const LAS float* OB = (const LAS float*)(lds + HG_GB);
        float o[16]; float ss = 0.f;
#pragma unroll
        for (int i = 0; i < 16; ++i) { o[i] = OB[t * 132 + 16 * es + i]; ss += o[i] * o[i]; }
        ss += __shfl_xor(ss, 1); ss += __shfl_xor(ss, 2); ss += __shfl_xor(ss, 4);
        const float rstd = rsqrtf(ss * (1.0f / 128.0f) + NORM_EPS);
        unsigned w[8];
#pragma unroll
        for (int i = 0; i < 16; i += 2) { const float ga = i < 8 ? bfx(g0, i) : bfx(g1, i - 8), gb = (i + 1) < 8 ? bfx(g0, i + 1) : bfx(g1, i + 1 - 8);
            w[i >> 1] = cvt_pk_bf16(o[i] * rstd * norm_g[16 * es + i] * siluf_(ga), o[i + 1] * rstd * norm_g[16 * es + i + 1] * siluf_(gb)); }
        u32x4* dst = (u32x4*)(REC + (size_t)(c * 64 + t) * 1024 + h * 128 + 16 * es);
        dst[0] = (u32x4){w[0], w[1], w[2], w[3]}; dst[1] = (u32x4){w[4], w[5], w[6], w[7]};
    }
    __syncthreads();
}

constexpr int SC_KT = 0, SC_SB = 36864, SC_SPITCH = 132;
__device__ __forceinline__ unsigned pk_f16(float a, float b) { return __builtin_bit_cast(unsigned, __builtin_amdgcn_cvt_pkrtz(a, b)); }
__device__ __forceinline__ void score_flush(LAS unsigned char* lds, unsigned short* SCORES, unsigned short* SEGMAX, int t0, int kt, int tid) {
    const LAS float* sb = (const LAS float*)(lds + SC_SB + (kt & 1) * (32 * SC_SPITCH * 4));
    const int row = tid >> 4, seg = tid & 15;
    const f32x4 a = *(const LAS f32x4*)(sb + row * SC_SPITCH + seg * 8), b = *(const LAS f32x4*)(sb + row * SC_SPITCH + seg * 8 + 4);
    unsigned short* dst = SCORES + (size_t)(t0 + row) * S + kt * 128 + seg * 8;
    *(u32x4*)dst = (u32x4){pk_f16(a[0], a[1]), pk_f16(a[2], a[3]), pk_f16(b[0], b[1]), pk_f16(b[2], b[3])};
    const float mx = fmaxf(fmaxf(fmaxf(a[0], a[1]), fmaxf(a[2], a[3])), fmaxf(fmaxf(b[0], b[1]), fmaxf(b[2], b[3])));
    SEGMAX[(size_t)(t0 + row) * 2048 + kt * 16 + seg] = (unsigned short)(pk_f16(mx, mx) & 0xffffu);
}
__device__ __forceinline__ void score_block(LAS unsigned char* lds, const bf16_t* PROJ, const bf16_t* KI, unsigned short* SCORES, unsigned short* SEGMAX, int qb, int tid, int wave, int lane) {
    const int t0 = qb * 32, nkt = (t0 >> 7) + 1;
    const int r = lane & 31, hh = lane >> 5;
    bf16x8 Af[2][4]; float wv[2][16]; f32x2 wv2[2][8];
#pragma unroll
    for (int p = 0; p < 2; ++p) {
        const int tq = t0 + 4 * wave + 2 * p + (r >> 4); const bf16_t* qrow = PROJ + (size_t)tq * DINP + CQI + (r & 15) * 64 + 8 * hh;
#pragma unroll
        for (int ks = 0; ks < 4; ++ks) Af[p][ks] = *(const bf16x8*)(qrow + 16 * ks);
#pragma unroll
        for (int reg = 0; reg < 16; ++reg) { const int row = (reg & 3) + 8 * (reg >> 2) + 4 * hh; const int tw = t0 + 4 * wave + 2 * p + (row >> 4);
            wv[p][reg] = bf2f(PROJ[(size_t)tw * DINP + CWI + (row & 15)]) * (1.0f / 32.0f); }
#pragma unroll
        for (int i = 0; i < 8; ++i) wv2[p][i] = (f32x2){wv[p][2 * i], wv[p][2 * i + 1]};
    }
    const u32x2 tagsw = __builtin_amdgcn_permlane32_swap(0u, 1u, false, false); const int qsel = (int)tagsw[0];
    u32x4 stg[2];
#pragma unroll
    for (int i = 0; i < 2; ++i) { const int q = tid + 512 * i; stg[i] = *(const u32x4*)(KI + (size_t)(q >> 3) * 64 + (q & 7) * 8); }
#pragma unroll
    for (int i = 0; i < 2; ++i) { const int q = tid + 512 * i; *(LAS u32x4*)(lds + SC_KT + (q >> 3) * 144 + (q & 7) * 16) = stg[i]; }
    __syncthreads();
    for (int kt = 0; kt < nkt; ++kt) {
        const LAS unsigned char* buf = lds + SC_KT + (kt & 1) * 18432;
        LAS float* sb = (LAS float*)(lds + SC_SB + (kt & 1) * (32 * SC_SPITCH * 4));
        if (kt > 0) score_flush(lds, SCORES, SEGMAX, t0, kt - 1, tid);
        if (kt + 1 < nkt) {
#pragma unroll
            for (int i = 0; i < 2; ++i) { const int q = tid + 512 * i; stg[i] = *(const u32x4*)(KI + (size_t)((kt + 1) * 128 + (q >> 3)) * 64 + (q & 7) * 8); }
        }
        {
        f32x16 accP[2], accC[2];
#define SC_MFMA(cb) do { bf16x8 Bf[4]; _Pragma("unroll") for (int ks = 0; ks < 4; ++ks) Bf[ks] = *(const LAS bf16x8*)(buf + (32 * (cb) + r) * 144 + (16 * ks + 8 * hh) * 2); \
            _Pragma("unroll") for (int p = 0; p < 2; ++p) { _Pragma("unroll") for (int i = 0; i < 16; ++i) accC[p][i] = 0.f; \
                _Pragma("unroll") for (int ks = 0; ks < 4; ++ks) accC[p] = __builtin_amdgcn_mfma_f32_32x32x16_bf16(Af[p][ks], Bf[ks], accC[p], 0, 0, 0); } } while (0)
#define SC_RED(acc, cb) do { _Pragma("unroll") for (int p = 0; p < 2; ++p) { f32x2 s0 = {0.f, 0.f}, s1 = {0.f, 0.f}; \
            _Pragma("unroll") for (int reg = 0; reg < 8; reg += 2) { const f32x2 r0 = {relu_i(acc[p][reg]), relu_i(acc[p][reg + 1])}; const f32x2 r1 = {relu_i(acc[p][reg + 8]), relu_i(acc[p][reg + 9])}; \
                s0 = __builtin_elementwise_fma(wv2[p][reg >> 1], r0, s0); s1 = __builtin_elementwise_fma(wv2[p][4 + (reg >> 1)], r1, s1); } \
            const float p0 = s0[0] + s0[1], p1 = s1[0] + s1[1]; \
            const u32x2 sw = __builtin_amdgcn_permlane32_swap(__float_as_uint(p0), __float_as_uint(p1), false, false); \
            sb[(4 * wave + 2 * p + qsel) * SC_SPITCH + 32 * (cb) + r] = __uint_as_float(sw[0]) + __uint_as_float(sw[1]); } } while (0)
#define SC_INTERLEAVE() do { _Pragma("unroll") for (int i = 0; i < 8; ++i) { __builtin_amdgcn_sched_group_barrier(0x008, 1, 0); __builtin_amdgcn_sched_group_barrier(0x002, 8, 0); } } while (0)
        SC_MFMA(0);
        accP[0] = accC[0]; accP[1] = accC[1]; SC_MFMA(1); SC_RED(accP, 0); SC_INTERLEAVE();
        accP[0] = accC[0]; accP[1] = accC[1]; SC_MFMA(2); SC_RED(accP, 1); SC_INTERLEAVE();
        accP[0] = accC[0]; accP[1] = accC[1]; SC_MFMA(3); SC_RED(accP, 2); SC_INTERLEAVE();
        SC_RED(accC, 3);
#undef SC_MFMA
#undef SC_RED
#undef SC_INTERLEAVE
        }
        if (kt + 1 < nkt) {
#pragma unroll
            for (int i = 0; i < 2; ++i) { const int q = tid + 512 * i; *(LAS u32x4*)(lds + SC_KT + ((kt + 1) & 1) * 18432 + (q >> 3) * 144 + (q & 7) * 16) = stg[i]; }
        }
        __syncthreads();
    }
    score_flush(lds, SCORES, SEGMAX, t0, nkt - 1, tid);
    __syncthreads();
}

__device__ __forceinline__ float wave_kth16(const float (&v)[16], int K) {
    const float NINF = -__builtin_inff();
    float mx = NINF, mn = __builtin_inff();
#pragma unroll
    for (int j = 0; j < 16; ++j) { mx = fmaxf(mx, v[j]); mn = fminf(mn, v[j] == NINF ? __builtin_inff() : v[j]); }
    mx = wave_max(mx); mn = -wave_max(-mn);
    int c = 0;
#pragma unroll
    for (int j = 0; j < 16; ++j) c += __popcll(__ballot(v[j] >= mx));
    if (c >= K) return mx;
    float lo = mn, hi = mx, tau = mn;
    for (int it = 0; it < 64; ++it) {
        const float mid = 0.5f * (lo + hi);
        if (!(mid > lo && mid < hi)) { tau = lo; break; }
        c = 0;
#pragma unroll
        for (int j = 0; j < 16; ++j) c += __popcll(__ballot(v[j] >= mid));
        if (c == K) { tau = mid; break; }
        if (c > K) lo = mid; else hi = mid;
        tau = lo;
    }
    return tau;
}
__device__ __forceinline__ int lanes_below(unsigned long long mask) { return (int)__builtin_amdgcn_mbcnt_hi((unsigned)(mask >> 32), __builtin_amdgcn_mbcnt_lo((unsigned)mask, 0u)); }
__device__ __forceinline__ float h2f(unsigned short h) { return (float)__builtin_bit_cast(_Float16, h); }
__device__ __forceinline__ float h2f_lo(unsigned u) { return h2f((unsigned short)(u & 0xffffu)); }
__device__ __forceinline__ float h2f_hi(unsigned u) { return h2f((unsigned short)(u >> 16)); }
__device__ __forceinline__ unsigned ge_mask8(const u32x4& v, unsigned T16) {
    unsigned m8 = 0;
#pragma unroll
    for (int w = 0; w < 4; ++w) { const unsigned vw_ = v[w];
        const s16x2 d = __builtin_elementwise_sub_sat(__builtin_bit_cast(s16x2, vw_), __builtin_bit_cast(s16x2, T16));
        const unsigned mm = ~__builtin_bit_cast(unsigned, d); m8 |= (((mm >> 15) & 1u) | ((mm >> 30) & 2u)) << (2 * w); }
    return m8;
}
__device__ __forceinline__ int append_bits(LAS int* list, int cnt, unsigned m8, int base) {
    for (;;) { const bool has = m8 != 0u; const unsigned long long mask = __ballot(has); if (!mask) break;
        const int pos = cnt + lanes_below(mask);
        if (has) { const int k = __builtin_ctz(m8); m8 &= m8 - 1u; if (pos < 1024) list[pos] = base + k; }
        cnt += __popcll(mask); }
    return cnt;
}
__device__ __forceinline__ void select_row(LAS unsigned char* wl, const unsigned short* SCORES, const unsigned short* SEGMAX, int t, int lane) {
    LAS int* selw = (LAS int*)wl; LAS int* segl = (LAS int*)(wl + 1024); LAS int* cidx = (LAS int*)(wl + 5120);
    const float NINF = -__builtin_inff();
    const unsigned short* row = SCORES + (size_t)t * S; const int n = t + 1;
    float c[16]; int N;
    if (n <= 1024) {
#pragma unroll
        for (int j = 0; j < 16; ++j) { const int i = lane + 64 * j; c[j] = i < n ? h2f(row[i]) : NINF; }
        N = -1;
    } else {
        const int m = n >> 4; float s[16];
#pragma unroll
        for (int j = 0; j < 16; ++j) { const int i = lane + 64 * j; s[j] = i < m ? h2f(row[16 * i + 7]) : NINF; }
        int K = 32, cnt = 0;
        for (;;) {
            const float tlo = (K >= m) ? NINF : wave_kth16(s, K);
            cnt = 0;
            const int nq = (n + 511) >> 9;
            if (tlo > 0.f) {
                const unsigned T16 = pk_f16(tlo, tlo);
                const u32x4 NEG = (u32x4){0xfc00fc00u, 0xfc00fc00u, 0xfc00fc00u, 0xfc00fc00u};
                const unsigned short* smrow = SEGMAX + (size_t)t * 2048; const int nseg = (t >> 3) + 1;
                int ns = 0;
                {
                    u32x4 sv[4];
#pragma unroll
                    for (int u = 0; u < 4; ++u) { const int e8 = 8 * (lane + 64 * u); sv[u] = (e8 < nseg) ? *(const u32x4*)(smrow + e8) : NEG; }
#pragma unroll
                    for (int u = 0; u < 4; ++u) { const int e8 = 8 * (lane + 64 * u); unsigned m8 = ge_mask8(sv[u], T16);
                        const int nv = nseg - e8; if (nv < 8) m8 &= nv > 0 ? ((1u << nv) - 1u) : 0u;
                        ns = append_bits(segl, ns, m8, e8); }
                }
                if (ns > 1024) ns = 1024;
                for (int j0 = 0; j0 < ns; j0 += 256) {
                    u32x4 v[4]; int sg[4];
#pragma unroll
                    for (int u = 0; u < 4; ++u) { const int i = j0 + lane + 64 * u; sg[u] = i < ns ? segl[i] : -1; v[u] = sg[u] >= 0 ? *(const u32x4*)(row + 8 * sg[u]) : NEG; }
#pragma unroll
                    for (int u = 0; u < 4; ++u) { const int e = 8 * sg[u]; unsigned m8 = sg[u] >= 0 ? ge_mask8(v[u], T16) : 0u;
                        const int nv = t + 1 - e; if (nv < 8) m8 &= nv > 0 ? ((1u << nv) - 1u) : 0u;
                        cnt = append_bits(cidx, cnt, m8, e); }
                }
            } else {
                for (int q0 = 0; q0 < nq; q0 += 4) {
                    u32x4 v[4];
#pragma unroll
                    for (int u = 0; u < 4; ++u) { const int e = 8 * (lane + 64 * (q0 + u)); v[u] = (e <= t) ? *(const u32x4*)(row + e) : (u32x4){0xfc00fc00u, 0xfc00fc00u, 0xfc00fc00u, 0xfc00fc00u}; }
#pragma unroll
                    for (int u = 0; u < 4; ++u) { const int e = 8 * (lane + 64 * (q0 + u));
#pragma unroll
                        for (int k = 0; k < 8; ++k) { const float x = (k & 1) ? h2f_hi(v[u][k >> 1]) : h2f_lo(v[u][k >> 1]);
                            const bool pred = (e + k <= t) && (x >= tlo); const unsigned long long mask = __ballot(pred);
                            if (mask) { const int pos = cnt + lanes_below(mask); if (pred && pos < 1024) cidx[pos] = e + k; cnt += __popcll(mask); } } }
                }
            }
            if (cnt >= 256 || K >= m) break;
            K *= 2;
        }
        N = cnt < 1024 ? cnt : 1024;
#pragma unroll
        for (int j = 0; j < 16; ++j) { const int i = lane + 64 * j; c[j] = i < N ? h2f(row[cidx[i]]) : NINF; }
    }
    const float tau = wave_kth16(c, 256);
    int base = 0;
#pragma unroll
    for (int j = 0; j < 16; ++j) { const bool pred = c[j] >= tau; const unsigned long long mask = __ballot(pred);
        if (mask) { const int pos = base + lanes_below(mask); if (pred && pos < 256) selw[pos] = (N < 0) ? (lane + 64 * j) : cidx[lane + 64 * j]; base += __popcll(mask); } }
}

__device__ __forceinline__ void attn_query(LAS unsigned char* wl, const bf16_t* PROJ, const unsigned char* KC, const unsigned char* VC, bf16_t* ATT, int t, int lane) {
    LAS int* selw = (LAS int*)wl; LAS float* L = (LAS float*)(wl + 1024);
    const int nsel = t < 255 ? t + 1 : 256;
    const int fr = lane & 15, fq = lane >> 4;
    bf16x8 qf[2][4];
#pragma unroll
    for (int g = 0; g < 2; ++g)
#pragma unroll
        for (int ks = 0; ks < 4; ++ks) { const bf16x8 z = {0, 0, 0, 0, 0, 0, 0, 0}; qf[g][ks] = fr < 4 ? *(const bf16x8*)(PROJ + (size_t)t * DINP + CQ + (4 * g + fr) * 128 + 64 * (ks >> 1) + 16 * fq + 8 * (ks & 1)) : z; }
    const float scale = 0.08838834764831845f;
    const int nkt = (nsel + 15) >> 4;
    {
        LAS unsigned char* KT = wl + 9216;
        const int q4_ = lane >> 4, l15_ = lane & 15;
        u32x4 kw[3][4];
#define QK_LOAD(buf, kt) do { _Pragma("unroll") for (int u = 0; u < 4; ++u) { const unsigned off_ = (unsigned)selw[16 * (kt) + 4 * u + q4_] * 256u + 16u * (unsigned)l15_; kw[buf][u] = *(const u32x4*)((const char*)KC + off_); } } while (0)
#define QK_COMP(buf, kt) do { _Pragma("unroll") for (int u = 0; u < 4; ++u) { u32x4 lo_, hi_; fp8x16_to_bf16(kw[buf][u], lo_, hi_); LAS u32x4* d_ = (LAS u32x4*)(KT + (4 * u + q4_) * 528 + 32 * l15_); d_[0] = lo_; d_[1] = hi_; } \
        _Pragma("unroll") for (int g = 0; g < 2; ++g) { f32x4 acc = (f32x4){0.f, 0.f, 0.f, 0.f}; \
            _Pragma("unroll") for (int ks = 0; ks < 4; ++ks) { const bf16x8 kf_ = *(const LAS bf16x8*)(KT + fr * 528 + g * 256 + (64 * (ks >> 1) + 16 * fq + 8 * (ks & 1)) * 2); \
                acc = __builtin_amdgcn_mfma_f32_16x16x32_bf16(qf[g][ks], kf_, acc, 0, 0, 0); } \
            if (fq == 0) { _Pragma("unroll") for (int r = 0; r < 4; ++r) L[(4 * g + r) * 256 + 16 * (kt) + fr] = (16 * (kt) + fr < nsel) ? acc[r] * scale : -__builtin_inff(); } } } while (0)
        QK_LOAD(0, 0); if (1 < nkt) QK_LOAD(1, 1);
        for (int kt = 0; kt < nkt; kt += 3) {
            if (kt + 2 < nkt) QK_LOAD(2, kt + 2);
            __builtin_amdgcn_sched_barrier(0);
            QK_COMP(0, kt);
            if (kt + 1 < nkt) { if (kt + 3 < nkt) QK_LOAD(0, kt + 3); __builtin_amdgcn_sched_barrier(0); QK_COMP(1, kt + 1); }
            if (kt + 2 < nkt) { if (kt + 4 < nkt) QK_LOAD(1, kt + 4); __builtin_amdgcn_sched_barrier(0); QK_COMP(2, kt + 2); }
        }
#undef QK_LOAD
#undef QK_COMP
        if (fq == 0) { for (int kt = nkt; kt < 16; ++kt) {
#pragma unroll
            for (int r = 0; r < 8; ++r) L[r * 256 + 16 * kt + fr] = -__builtin_inff(); } }
    }
    float p[8][4];
#pragma unroll
    for (int hd = 0; hd < 8; ++hd) { float m = -__builtin_inff();
#pragma unroll
        for (int i = 0; i < 4; ++i) { p[hd][i] = L[hd * 256 + lane + 64 * i]; m = fmaxf(m, p[hd][i]); }
        m = wave_max(m); float s = 0.f;
#pragma unroll
        for (int i = 0; i < 4; ++i) { p[hd][i] = __expf(p[hd][i] - m); s += p[hd][i]; }
        s = 1.0f / wave_sum(s);
#pragma unroll
        for (int i = 0; i < 4; ++i) p[hd][i] *= s; }
    LAS bf16_t* Pb = (LAS bf16_t*)(wl + 1024);
#pragma unroll
    for (int hd = 0; hd < 8; ++hd)
#pragma unroll
        for (int i = 0; i < 4; ++i) Pb[hd * 256 + lane + 64 * i] = f2bf(p[hd][i]);
    LAS unsigned char* VT = wl + 9216;
    const int ii = lane & 15, kq = lane >> 4;
    f32x4 acc[16];
#pragma unroll
    for (int nt = 0; nt < 16; ++nt) acc[nt] = (f32x4){0.f, 0.f, 0.f, 0.f};
    const int nch = (nsel + 15) >> 4;
    u32x4 vw[3][4];
#define PV_LOAD(buf, c) do { _Pragma("unroll") for (int u = 0; u < 4; ++u) { const unsigned off_ = (unsigned)selw[16 * (c) + 4 * u + kq] * 256u + 16u * (unsigned)ii; vw[buf][u] = *(const u32x4*)((const char*)VC + off_); } } while (0)
#define PV_COMP(buf, c) do { _Pragma("unroll") for (int u = 0; u < 4; ++u) { u32x4 lo_, hi_; fp8x16_to_bf16(vw[buf][u], lo_, hi_); LAS u32x4* d_ = (LAS u32x4*)(VT + (4 * u + kq) * 528 + 32 * ii); d_[0] = lo_; d_[1] = hi_; } \
        s16x4 pa[2]; _Pragma("unroll") for (int g = 0; g < 2; ++g) { const s16x4 r_ = *(const LAS s16x4*)(Pb + (g * 4 + (ii & 3)) * 256 + 16 * (c) + 4 * kq); pa[g] = ii < 4 ? r_ : (s16x4){0, 0, 0, 0}; } \
        _Pragma("unroll") for (int nt = 0; nt < 16; ++nt) { const s16x4 b_ = __builtin_amdgcn_ds_read_tr16_b64_v4i16((LAS s16x4*)(VT + (4 * kq + (ii >> 2)) * 528 + (16 * nt + 4 * (ii & 3)) * 2)); \
            acc[nt] = __builtin_amdgcn_mfma_f32_16x16x16bf16_1k(pa[nt >> 3], b_, acc[nt], 0, 0, 0); } } while (0)
    PV_LOAD(0, 0); if (1 < nch) PV_LOAD(1, 1);
    for (int c = 0; c < nch; c += 3) {
        if (c + 2 < nch) PV_LOAD(2, c + 2);
        __builtin_amdgcn_sched_barrier(0);
        PV_COMP(0, c);
        if (c + 1 < nch) { if (c + 3 < nch) PV_LOAD(0, c + 3); __builtin_amdgcn_sched_barrier(0); PV_COMP(1, c + 1); }
        if (c + 2 < nch) { if (c + 4 < nch) PV_LOAD(1, c + 4); __builtin_amdgcn_sched_barrier(0); PV_COMP(2, c + 2); }
    }
#undef PV_LOAD
#undef PV_COMP
    LAS float* OB = (LAS float*)(wl + 1024 + 4096);
    if (kq == 0) {
#pragma unroll
        for (int nt = 0; nt < 16; ++nt)
#pragma unroll
            for (int r = 0; r < 4; ++r) OB[(4 * (nt >> 3) + r) * 128 + 16 * (nt & 7) + ii] = acc[nt][r];
    }
    {
        const f32x4 a0 = *(const LAS f32x4*)(OB + 16 * lane), a1 = *(const LAS f32x4*)(OB + 16 * lane + 4), a2 = *(const LAS f32x4*)(OB + 16 * lane + 8), a3 = *(const LAS f32x4*)(OB + 16 * lane + 12);
        u32x4 w0, w1; w0.x = cvt_pk_bf16(a0[0], a0[1]); w0.y = cvt_pk_bf16(a0[2], a0[3]); w0.z = cvt_pk_bf16(a1[0], a1[1]); w0.w = cvt_pk_bf16(a1[2], a1[3]);
        w1.x = cvt_pk_bf16(a2[0], a2[1]); w1.y = cvt_pk_bf16(a2[2], a2[3]); w1.z = cvt_pk_bf16(a3[0], a3[1]); w1.w = cvt_pk_bf16(a3[2], a3[3]);
        u32x4* dst = (u32x4*)(ATT + (size_t)t * 1024 + 16 * lane); dst[0] = w0; dst[1] = w1;
    }
}


__device__ __forceinline__ void convert_item8(const float* __restrict__ W, int K, int N, int ld, unsigned char* WT, int mode, int item, int lane, LAS unsigned char* scr) {
    const int nblk = N >> 6; const int kb = item / nblk, nb = item - kb * nblk; const int k0 = kb * 256, n0 = nb * 64;
    const int c4 = lane & 15, kr = lane >> 4;
    const float* src = W + (size_t)(k0 + 4 * kr) * ld + n0 + 4 * c4;
#pragma unroll 4
    for (int i = 0; i < 16; ++i) {
        f32x4 v[4];
#pragma unroll
        for (int r = 0; r < 4; ++r) v[r] = __builtin_nontemporal_load((const f32x4*)(src + (size_t)(16 * i + r) * ld));
        const int kk = 16 * i + 4 * kr;
#pragma unroll
        for (int e = 0; e < 4; ++e) *(LAS unsigned*)(scr + (4 * c4 + e) * 272 + kk) = pack4_fp8(v[0][e] * W8_SCALE, v[1][e] * W8_SCALE, v[2][e] * W8_SCALE, v[3][e] * W8_SCALE);
    }
    LDS_WAIT(); asm volatile("" ::: "memory");
#pragma unroll 4
    for (int j = 0; j < 16; ++j) {
        const int q = j * 64 + lane, n = q >> 4, ch = q & 15;
        const u32x4 v = *(const LAS u32x4*)(scr + n * 272 + ch * 16);
        *(u32x4*)(WT + (size_t)dest_row(mode, n0 + n) * K + k0 + ch * 16) = v;
    }
    LDS_WAIT(); asm volatile("" ::: "memory");
}

struct Conv8Job { const float* W; unsigned char* WT; int N; int mode; size_t w_estride, wt_estride; int items_per_e; };
__device__ __forceinline__ void conv8_load(const Conv8Job& jb, int item, int wave, int lane, f32x4 (&v)[16]) {
    const int e = item / jb.items_per_e, r = item - e * jb.items_per_e; const int nblk = jb.N >> 8; const int kb = r / nblk, nb = r - kb * nblk;
    const float* src = jb.W + (size_t)e * jb.w_estride + (size_t)(kb * 128 + 16 * wave) * jb.N + nb * 256 + 4 * lane;
#pragma unroll
    for (int i = 0; i < 16; ++i) v[i] = __builtin_nontemporal_load((const f32x4*)(src + (size_t)i * jb.N));
}
__device__ __forceinline__ void conv8_to_lds(LAS unsigned char* img, int wave, int lane, const f32x4 (&v)[16]) {
#pragma unroll
    for (int g = 0; g < 4; ++g)
#pragma unroll
        for (int e = 0; e < 4; ++e) *(LAS unsigned*)(img + (4 * lane + e) * 144 + 16 * wave + 4 * g) = pack4_fp8(v[4 * g][e] * W8_SCALE, v[4 * g + 1][e] * W8_SCALE, v[4 * g + 2][e] * W8_SCALE, v[4 * g + 3][e] * W8_SCALE);
}
__device__ __forceinline__ void conv8_store(const Conv8Job& jb, int item, const LAS unsigned char* img, int tid) {
    const int e = item / jb.items_per_e, r = item - e * jb.items_per_e; const int nblk = jb.N >> 8; const int kb = r / nblk, nb = r - kb * nblk;
    unsigned char* dst = jb.WT + (size_t)e * jb.wt_estride + kb * 128;
#pragma unroll
    for (int j = 0; j < 4; ++j) { const int q = j * 512 + tid, n = q >> 3, ch = q & 7;
        *(u32x4*)(dst + (size_t)dest_row(jb.mode, nb * 256 + n) * 2048 + ch * 16) = *(const LAS u32x4*)(img + n * 144 + ch * 16); }
}
__device__ __forceinline__ void conv8_run(LAS unsigned char* lds, const Conv8Job& jb, int n_items, int wg, int G, int tid, int wave, int lane) {
    f32x4 v[16]; int it = wg, par = 0;
    if (it < n_items) conv8_load(jb, it, wave, lane, v);
    for (; it < n_items; it += G, par ^= 1) {
        LAS unsigned char* img = lds + par * 36864;
        conv8_to_lds(img, wave, lane, v);
        __syncthreads();
        if (it + G < n_items) conv8_load(jb, it + G, wave, lane, v);
        conv8_store(jb, it, img, tid);
    }
    __syncthreads();
}

__global__ void __launch_bounds__(NTHR, 2) fwd_kernel(Args args) {
    extern __shared__ __attribute__((aligned(16))) unsigned char lds_raw[];
    LAS unsigned char* lds = (LAS unsigned char*)lds_raw;
    volatile LAS unsigned* MISC = (volatile LAS unsigned*)(lds + LDS_MISC);
    const int tid = threadIdx.x, lane = tid & 63, wave = __builtin_amdgcn_readfirstlane(tid >> 6);
    const int G = gridDim.x, wg = blockIdx.x;
    unsigned char* ws = args.ws;
    unsigned* ctl = (unsigned*)(ws + WS_CTL);
    const int lo = args.ph_lo, hi = args.ph_hi;
    const float* x = (const float*)args.in[0]; const float* cvec = (const float*)args.in[1]; const int* positions = (const int*)args.in[2];
    const float* w_ada = (const float*)args.in[3]; const float* b_ada = (const float*)args.in[4]; const float* norm1_g = (const float*)args.in[5];
    const float* w_in = (const float*)args.in[6]; const float* idx_knorm_g = (const float*)args.in[7]; const float* idx_knorm_b = (const float*)args.in[8];
    const float* lb_logits = (const float*)args.in[9]; const float* hgrn_norm_g = (const float*)args.in[10];
    const float* w_proj_att = (const float*)args.in[11]; const float* w_proj_hgrn = (const float*)args.in[12]; const float* w_out = (const float*)args.in[13];
    const float* norm2_g = (const float*)args.in[14]; const float* w_router = (const float*)args.in[15]; const float* b_router = (const float*)args.in[16];
    const float* w1 = (const float*)args.in[17]; const float* b1 = (const float*)args.in[18]; const float* w2 = (const float*)args.in[19]; const float* b2 = (const float*)args.in[20];
    const float* final_g = (const float*)args.in[21];
    float* out = args.out;
    float* MOD = (float*)(ws + WS_MOD); int* TOPE = (int*)(ws + WS_TOPE); float* GATE = (float*)(ws + WS_GATE); int* SLOT = (int*)(ws + WS_SLOT);
    bf16_t* WIN_T = (bf16_t*)(ws + WS_WIN_T); bf16_t* WA_T = (bf16_t*)(ws + WS_WA_T); bf16_t* WH_T = (bf16_t*)(ws + WS_WH_T); bf16_t* WO_T = (bf16_t*)(ws + WS_WO_T);
    unsigned char* WIN_T8 = ws + WS_WIN_T + 8 * MiB;
    unsigned char* HA8 = ws + WS_SCORES;
    unsigned char* W1_T = ws + WS_W1_T; unsigned char* W2_T = ws + WS_W2_T;
    bf16_t* HB = (bf16_t*)(ws + WS_H); bf16_t* PROJ = (bf16_t*)(ws + WS_PROJ);
    bf16_t* DELTA = (bf16_t*)(ws + WS_ATT);
    unsigned char* ACT = ws + WS_ACT; bf16_t* YB = (bf16_t*)(ws + WS_YB);
    int* TOKS = (int*)(ws + WS_TOKS);
    unsigned char* H8 = ws + WS_H;
    bf16_t* KI = (bf16_t*)(ws + WS_KI); unsigned char* KC = ws + WS_KC; unsigned char* VC = ws + WS_VC;
    float* ST = (float*)(ws + WS_ST); float* DC = (float*)(ws + WS_DC);
    bf16_t* ATT = (bf16_t*)(ws + WS_ATT); bf16_t* REC = (bf16_t*)(ws + WS_REC); bf16_t* MERGED = (bf16_t*)(ws + WS_MERGED); unsigned short* SCORES = (unsigned short*)(ws + WS_SCORES);
    unsigned short* SEGMAX = (unsigned short*)(ws + WS_X1);

    for (int u = tid; u < 128; u += NTHR) MISC[u] = 0u;
    __syncthreads();
    const bool one_launch = (hi - lo) > 1;
    XcdBarrier bar; bar.bar = ctl + CW_BAR; bar.x = 0; bar.st = MISC + 8;
    if (one_launch) bar = xcd_barrier_post(ctl + CW_BAR, MISC + 8);
#define IN(k) (lo <= (k) && (k) < hi)
#define SEAM(k) do { if (IN(k) && IN((k) + 1)) xcd_barrier(bar); } while (0)


    if (IN(PH_PRO)) {
        for (int cb = wg; cb < 256; cb += G) {
            LAS float* red = (LAS float*)lds;
            const int c4 = tid % 12, kg = tid / 12;
            f32x4 acc = (f32x4){0.f, 0.f, 0.f, 0.f};
            if (kg < 42) {
                const float* wp = w_ada + (size_t)cb * 48 + 4 * c4;
#pragma unroll 7
                for (int j = 0; j < 49; ++j) { const int k = kg + 42 * j; if (k < D) { const f32x4 v = __builtin_nontemporal_load((const f32x4*)(wp + (size_t)k * (6 * D))); acc += siluf_(cvec[k]) * v; } }
                *(LAS f32x4*)(red + kg * 48 + 4 * c4) = acc;
            }
            __syncthreads();
            if (tid < 48) { float s = b_ada[cb * 48 + tid];
#pragma unroll 6
                for (int q = 0; q < 42; ++q) s += red[q * 48 + tid];
                MOD[cb * 48 + tid] = s; }
            __syncthreads();
        }
        LAS unsigned char* scr = lds + wave * 17408;
        const int gw = wg * NWAVES + wave, NGW = G * NWAVES;
        {
            constexpr int NB_IN = (1104 + 63) / 64;
            for (int it = gw; it < 16 * NB_IN; it += NGW) convert_item(w_in + 1536, 2048, 1104, DIN, WIN_T, 0, it, lane, scr);
            for (int it = gw; it < 8 * 32; it += NGW) convert_item(w_proj_att, 1024, 2048, 2048, WA_T, 0, it, lane, scr);
            for (int it = gw; it < 8 * 32; it += NGW) convert_item(w_proj_hgrn, 1024, 2048, 2048, WH_T, 0, it, lane, scr);
            for (int it = gw; it < 16 * 32; it += NGW) convert_item(w_out, 2048, 2048, 2048, WO_T, 0, it, lane, scr);
            for (int it = gw; it < 8 * 24; it += NGW) convert_item8(w_in, 2048, 1536, DIN, WIN_T8, 0, it, lane, scr);
            for (int it = gw; it < 8 * 128; it += NGW) convert_item8(w_in + 2640, 2048, 8192, DIN, WIN_T8 + (size_t)1536 * 2048, 0, it, lane, scr);
            for (size_t i = (size_t)wg * NTHR + tid; i < (size_t)176 * 2048 * 2 / 16; i += (size_t)G * NTHR) ((u32x4*)(WIN_T + (size_t)1104 * 2048))[i] = (u32x4){0u, 0u, 0u, 0u};
        }
        {
            __syncthreads();
            const Conv8Job j1{w1, W1_T, 4096, 2, (size_t)2048 * 4096, (size_t)4096 * 2048, 16 * 16}; conv8_run(lds, j1, NEXP * 16 * 16, wg, G, tid, wave, lane);
            const Conv8Job j2{w2, W2_T, 2048, 0, (size_t)2048 * 2048, (size_t)2048 * 2048, 16 * 8};  conv8_run(lds, j2, NEXP * 16 * 8, wg, G, tid, wave, lane);
        }
    }
    SEAM(PH_PRO);

    {
    if (IN(PH_H)) {
        const float* sh1 = MOD; const float* sc1 = MOD + D;
        const int gw = wg * NWAVES + wave, NGW = G * NWAVES;
        f32x4 gs[8], sh[8];
#pragma unroll
        for (int j = 0; j < 8; ++j) { const int c = 4 * lane + 256 * j; const f32x4 g = *(const f32x4*)(norm1_g + c), sc = *(const f32x4*)(sc1 + c); sh[j] = *(const f32x4*)(sh1 + c);
#pragma unroll
            for (int e = 0; e < 4; ++e) gs[j][e] = g[e] * (1.0f + sc[e]); }
        for (int t = gw; t < S; t += NGW) {
            const f32x4* xr = (const f32x4*)(x + (size_t)t * D) + lane;
            f32x4 v[8]; float ss = 0.f;
#pragma unroll
            for (int j = 0; j < 8; ++j) { v[j] = xr[64 * j]; ss += (v[j][0] * v[j][0] + v[j][1] * v[j][1]) + (v[j][2] * v[j][2] + v[j][3] * v[j][3]); }
            const float rstd = rsqrtf(wave_sum(ss) * (1.0f / D) + NORM_EPS);
#pragma unroll
            for (int j = 0; j < 8; ++j) { const f32x4 h = v[j] * rstd * gs[j] + sh[j]; u32x2 w; w.x = cvt_pk_bf16(h[0], h[1]); w.y = cvt_pk_bf16(h[2], h[3]);
                *(u32x2*)(HB + (size_t)t * D + 4 * lane + 256 * j) = w;
                *(unsigned*)(HA8 + (size_t)t * D + 4 * lane + 256 * j) = pack4_fp8(h[0], h[1], h[2], h[3]); }
        }
    }
    SEAM(PH_H);
    if (IN(PH_INPROJ)) {
        {
            pg8::Gemm g8{HA8, WIN_T8, 2048, 0, nullptr, 0}; pg8::StaticOrder S8; S8.init(S, 9728, G, wg);
            if (G == 256) S8.skew(8, (wg >= 128 && wg < 192) ? -1 : (wg < 128 ? wg : wg - 64), 192);
            pg8::EpiBf16 E8{PROJ, DINP, nullptr, 0, 1.0f / W8_SCALE, 6, 1280};
            pg8::gemm_phase<pg8::EpiBf16, pg8::StaticOrder, true>(lds, g8, S8, E8);
        }
        {
            pg8::Gemm g{HB, WIN_T, 2048, 0, nullptr, 0}; pg8::StaticOrder So; So.init(S, 1280, G, (wg + 128) % G);
            pg8::EpiBf16 E{PROJ + CQI, DINP, nullptr, 0, 1.0f, 1 << 30, 0};
            pg8::gemm_phase<pg8::EpiBf16, pg8::StaticOrder>(lds, g, So, E);
        }
    }
    SEAM(PH_INPROJ);
    if (IN(PH_POST)) {
        const int gw = wg * NWAVES + wave, NGW = G * NWAVES;
        for (int t = gw; t < S; t += NGW) post_token(PROJ, KI, KC, VC, positions, idx_knorm_g, idx_knorm_b, t, lane);
        __syncthreads();
        for (int u = wg; u < 2048; u += G) hgrn_l1(lds, PROJ, lb_logits, ST, DC, u >> 3, u & 7, tid, wave, lane);
    }
    SEAM(PH_POST);
    if (IN(PH_SCORE)) {
        for (int idx = wg * NTHR + tid; idx < 8 * 128 * 128; idx += G * NTHR) {
            const int h = idx >> 14, d = idx & 127; float s = 0.f;
            float* sp = ST + idx; const float* dp = DC + h * 128 + d;
            for (int c = 0; c < 256; c += 8) {
                float l[8], dc[8];
#pragma unroll
                for (int i = 0; i < 8; ++i) { l[i] = sp[(size_t)(c + i) * 131072]; dc[i] = dp[(size_t)(c + i) * 1024]; }
#pragma unroll
                for (int i = 0; i < 8; ++i) { sp[(size_t)(c + i) * 131072] = s; s = dc[i] * s + l[i]; }
            }
        }
        {
            for (int j = wg; j < 252; j += G) { score_block(lds, PROJ, KI, SCORES, SEGMAX, 8 + j, tid, wave, lane); score_block(lds, PROJ, KI, SCORES, SEGMAX, 511 - j, tid, wave, lane); }
        }
    }
    SEAM(PH_SCORE);
    if (IN(PH_ATTN)) {
        const int gw = wg * NWAVES + wave, NGW = G * NWAVES;
        for (int u = wg; u < 2048; u += G) hgrn_l3(lds, PROJ, lb_logits, ST, hgrn_norm_g, REC, u >> 3, u & 7, tid, wave, lane);
        {
            for (int t = gw; t < S; t += NGW) {
                LAS unsigned char* wl = lds + wave * 17664;
                if (t >= 256) select_row(wl, SCORES, SEGMAX, t, lane);
                else {
#pragma unroll
                    for (int i = 0; i < 4; ++i) { const int idx = lane + 64 * i; ((LAS int*)wl)[idx] = idx <= t ? idx : 0; }
                }
                attn_query(wl, PROJ, KC, VC, ATT, t, lane);
            }
        }
    }
    SEAM(PH_ATTN);
    if (IN(PH_OP1)) {
        pg8::Gemm g{ATT, WA_T, 1024, (size_t)2048 * 1024 * 2, nullptr, (size_t)S * 1024 * 2};
        pg8::TwoPartOrder So; So.init(S, 2048, G, wg);
        pg8::EpiGate2 E{MERGED, PROJ + CGA, PROJ + CGR};
        pg8::gemm_phase<pg8::EpiGate2, pg8::TwoPartOrder>(lds, g, So, E);
    }
    SEAM(PH_OP2);
    if (IN(PH_WOUT)) {
        pg8::Gemm g{MERGED, WO_T, 2048, 0, nullptr, 0}; pg8::StaticOrder So; So.init(S, 2048, G, wg);
        pg8::EpiDelta E{MOD + 2 * D, DELTA};
        pg8::gemm_phase<pg8::EpiDelta, pg8::StaticOrder>(lds, g, So, E);
    }
    SEAM(PH_WOUT);
    }

    if (IN(PH_ROUTER)) {
        LAS float* hs = (LAS float*)lds;
        volatile LAS unsigned* lcnt = MISC + 32;
        const float* sh2 = MOD + 3 * D; const float* sc2 = MOD + 4 * D;
        if (tid < 32) lcnt[tid] = 0u;
        __syncthreads();
        for (int grp = wg; grp < S / 16; grp += G) {
#pragma unroll 1
            for (int q = 0; q < 2; ++q) {
                const int tl = 2 * wave + q, t = grp * 16 + tl;
                const f32x4* xr = (const f32x4*)(x + (size_t)t * D) + lane; const u32x2* dr = (const u32x2*)(DELTA + (size_t)t * D) + lane;
                f32x4 v[8]; float ss = 0.f;
#pragma unroll
                for (int j = 0; j < 8; ++j) { const u32x2 dw = dr[64 * j]; v[j] = xr[64 * j] + (f32x4){bf_lo(dw.x), bf_hi(dw.x), bf_lo(dw.y), bf_hi(dw.y)};
                    ss += (v[j][0] * v[j][0] + v[j][1] * v[j][1]) + (v[j][2] * v[j][2] + v[j][3] * v[j][3]); }
                const float rstd = rsqrtf(wave_sum(ss) * (1.0f / D) + NORM_EPS);
#pragma unroll
                for (int j = 0; j < 8; ++j) {
                    const int c = 4 * lane + 256 * j;
                    const f32x4 g = *(const f32x4*)(norm2_g + c), sc = *(const f32x4*)(sc2 + c), sh = *(const f32x4*)(sh2 + c);
                    f32x4 h;
#pragma unroll
                    for (int e = 0; e < 4; ++e) h[e] = v[j][e] * rstd * g[e] * (1.0f + sc[e]) + sh[e];
                    *(LAS f32x4*)(hs + tl * 2048 + c) = h;
                    *(unsigned*)(H8 + (size_t)t * D + c) = pack4_fp8(h[0], h[1], h[2], h[3]);
                }
            }
            __syncthreads();
            {
                LAS float* part = (LAS float*)(lds + 131072);
                const int fr = lane & 15, fq = lane >> 4;
                f32x4 acc0 = (f32x4){0.f, 0.f, 0.f, 0.f}, acc1 = acc0;
                const LAS float* hrow = hs + fr * 2048 + wave * 256 + 4 * fq; const float* wrp = w_router + (size_t)(wave * 256 + 4 * fq) * 32 + fr;
#pragma unroll 2
                for (int i = 0; i < 16; ++i) {
                    const f32x4 a4 = *(const LAS f32x4*)(hrow + 16 * i);
                    float b0[4], b1[4];
#pragma unroll
                    for (int s = 0; s < 4; ++s) { b0[s] = wrp[(size_t)(16 * i + s) * 32]; b1[s] = wrp[(size_t)(16 * i + s) * 32 + 16]; }
#pragma unroll
                    for (int s = 0; s < 4; ++s) { acc0 = __builtin_amdgcn_mfma_f32_16x16x4f32(a4[s], b0[s], acc0, 0, 0, 0); acc1 = __builtin_amdgcn_mfma_f32_16x16x4f32(a4[s], b1[s], acc1, 0, 0, 0); }
                }
#pragma unroll
                for (int r = 0; r < 4; ++r) { part[(wave * 16 + 4 * fq + r) * 32 + fr] = acc0[r]; part[(wave * 16 + 4 * fq + r) * 32 + 16 + fr] = acc1[r]; }
                __syncthreads();
                const int tl = tid >> 5, e = tid & 31, t = grp * 16 + tl;
                float v = b_router[e];
#pragma unroll
                for (int w = 0; w < 8; ++w) v += part[(w * 16 + tl) * 32 + e];
                float tv[4]; int ti[4];
#pragma unroll
                for (int k = 0; k < 4; ++k) {
                    float bv = v; int bi = e;
#pragma unroll
                    for (int o = 16; o >= 1; o >>= 1) { const float ov = __shfl_xor(bv, o); const int oi = __shfl_xor(bi, o); if (ov > bv || (ov == bv && oi < bi)) { bv = ov; bi = oi; } }
                    tv[k] = bv; ti[k] = bi; if (e == bi) v = -__builtin_inff();
                }
                if (e == 0) {
                    const float e1 = __expf(tv[1] - tv[0]), e2 = __expf(tv[2] - tv[0]), e3 = __expf(tv[3] - tv[0]); const float inv = 1.0f / (1.0f + e1 + e2 + e3);
                    *(int4*)(TOPE + (size_t)t * 4) = make_int4(ti[0], ti[1], ti[2], ti[3]);
                    *(f32x4*)(GATE + (size_t)t * 4) = (f32x4){inv, e1 * inv, e2 * inv, e3 * inv};
#pragma unroll
                    for (int k = 0; k < 4; ++k) __hip_atomic_fetch_add((LAS unsigned*)&lcnt[ti[k]], 1u, __ATOMIC_RELAXED, __HIP_MEMORY_SCOPE_WORKGROUP);
                }
            }
            __syncthreads();
        }
        if (tid < 32) { const unsigned c = lcnt[tid]; if (c) __hip_atomic_fetch_add(ctl + CW_CNT + tid, c, __ATOMIC_RELAXED, __HIP_MEMORY_SCOPE_AGENT); }
    }
    SEAM(PH_ROUTER);

    if (IN(PH_SCATTER)) {
        volatile LAS unsigned* lcnt = MISC + 32; volatile LAS unsigned* lbase = MISC + 64; LAS int* pstart = (LAS int*)(lds + 1024); LAS int* pcnt = (LAS int*)(lds + 1280);
        if (tid == 0) { int p = 0; for (int e = 0; e < NEXP; ++e) { const int c = (int)__hip_atomic_load(ctl + CW_CNT + e, __ATOMIC_RELAXED, __HIP_MEMORY_SCOPE_AGENT); pstart[e] = p; pcnt[e] = c; p += (c + 255) & ~255; } }
        if (tid < 32) lcnt[tid] = 0u;
        __syncthreads();
        if (wg < NEXP) { const int e = wg; for (int s = pstart[e] + pcnt[e] + tid; s < pstart[e] + ((pcnt[e] + 255) & ~255); s += NTHR) TOKS[s] = 0; }
        for (int blk = wg; blk < S / 64; blk += G) {
            int e = 0, lrank = 0;
            if (tid < 256) { e = TOPE[(size_t)blk * 256 + tid]; lrank = (int)__hip_atomic_fetch_add((LAS unsigned*)&lcnt[e], 1u, __ATOMIC_RELAXED, __HIP_MEMORY_SCOPE_WORKGROUP); }
            __syncthreads();
            if (tid < 32) { const unsigned c = lcnt[tid]; lbase[tid] = c ? __hip_atomic_fetch_add(ctl + CW_FILL + tid, c, __ATOMIC_RELAXED, __HIP_MEMORY_SCOPE_AGENT) : 0u; }
            __syncthreads();
            if (tid < 256) { const int slot = pstart[e] + (int)lbase[e] + lrank; SLOT[(size_t)blk * 256 + tid] = slot; TOKS[slot] = blk * 64 + (tid >> 2); }
            __syncthreads();
            if (tid < 32) lcnt[tid] = 0u;
            __syncthreads();
        }
    }
    SEAM(PH_SCATTER);

    if (IN(PH_MOE1) || IN(PH_MOE2)) {
        LAS int* panel_e = (LAS int*)(lds + 131072 + 2048);
        LAS int* npan = (LAS int*)(lds + 131072 + 2048 + 2048);
        __syncthreads();
        if (tid == 0) { int p = 0; for (int e = 0; e < NEXP; ++e) { const int np = (int)((__hip_atomic_load(ctl + CW_CNT + e, __ATOMIC_RELAXED, __HIP_MEMORY_SCOPE_AGENT) + 255u) >> 8); for (int q = 0; q < np; ++q) panel_e[p + q] = e; p += np; } npan[0] = p; }
        __syncthreads();
        const int nPanels = npan[0];
        if (IN(PH_MOE1)) {
            pg8::Gemm g{H8, W1_T, 2048, (size_t)4096 * 2048, TOKS, 0}; pg8::MoeOrder So; So.init(nPanels, 16, G, wg, panel_e);
            pg8::EpiSwiglu E{ACT, b1};
            pg8::gemm_phase<pg8::EpiSwiglu, pg8::MoeOrder, true>(lds, g, So, E);
        }
        SEAM(PH_MOE1);
        if (IN(PH_MOE2)) {
            pg8::Gemm g{ACT, W2_T, 2048, (size_t)2048 * 2048, nullptr, 0}; pg8::MoeOrder So; So.init(nPanels, 8, G, wg, panel_e);
            pg8::EpiBf16 E{YB, 2048, b2, 2048, 1.0f / (W8_SCALE * ACT8_SCALE), 1 << 30, 0};
            pg8::gemm_phase<pg8::EpiBf16, pg8::MoeOrder, true>(lds, g, So, E);
        }
    }
    SEAM(PH_MOE2);

    if (IN(PH_FINAL)) {
        const float* gt2 = MOD + 5 * D;
        const int gw = wg * NWAVES + wave, NGW = G * NWAVES;
        for (int t = gw; t < S; t += NGW) {
            const f32x4* xr = (const f32x4*)(x + (size_t)t * D) + lane; const u32x2* dr = (const u32x2*)(DELTA + (size_t)t * D) + lane;
            f32x4 v[8];
#pragma unroll
            for (int j = 0; j < 8; ++j) { const u32x2 dw = dr[64 * j]; v[j] = xr[64 * j] + (f32x4){bf_lo(dw.x), bf_hi(dw.x), bf_lo(dw.y), bf_hi(dw.y)}; }
            {
                f32x4 m[8];
#pragma unroll
                for (int j = 0; j < 8; ++j) m[j] = (f32x4){0.f, 0.f, 0.f, 0.f};
                const int4 sl = *(const int4*)(SLOT + (size_t)t * 4); const f32x4 gt = *(const f32x4*)(GATE + (size_t)t * 4);
                const int sls[4] = {sl.x, sl.y, sl.z, sl.w};
#pragma unroll
                for (int k = 0; k < 4; ++k) {
                    const u32x2* yr = (const u32x2*)(YB + (size_t)sls[k] * D) + lane; const float gk = gt[k];
#pragma unroll
                    for (int j = 0; j < 8; ++j) { const u32x2 w = yr[64 * j]; m[j][0] += gk * bf_lo(w.x); m[j][1] += gk * bf_hi(w.x); m[j][2] += gk * bf_lo(w.y); m[j][3] += gk * bf_hi(w.y); }
                }
#pragma unroll
                for (int j = 0; j < 8; ++j) { const f32x4 g2 = *(const f32x4*)(gt2 + 4 * lane + 256 * j); v[j] = v[j] + g2 * m[j]; }
            }
            float ss = 0.f;
#pragma unroll
            for (int j = 0; j < 8; ++j) ss += (v[j][0] * v[j][0] + v[j][1] * v[j][1]) + (v[j][2] * v[j][2] + v[j][3] * v[j][3]);
            const float rstd = rsqrtf(wave_sum(ss) * (1.0f / D) + NORM_EPS);
            f32x4* orow = (f32x4*)(out + (size_t)t * D) + lane;
#pragma unroll
            for (int j = 0; j < 8; ++j) { const f32x4 fg = *(const f32x4*)(final_g + 4 * lane + 256 * j); orow[64 * j] = v[j] * rstd * fg; }
        }
    }
#undef IN
#undef SEAM
}

#ifndef MK_ONE_LAUNCH
#define MK_ONE_LAUNCH 1
#endif
extern "C" void kernel_launch(void* const* d_in, const int* in_sizes, int n_in, void* d_out, int out_size, void* d_ws, size_t ws_size, hipStream_t stream) {
    static int grid = 0;
    if (grid == 0) {
        if (n_in != 22 || out_size != S * D || ws_size < WS_END) { fprintf(stderr, "kernel_launch: unexpected shapes: n_in %d out %d ws %zu (need %zu)\n", n_in, out_size, ws_size, (size_t)WS_END); grid = -1; return; }
        int dev = 0, cus = 0, per_cu = 0;
        if (hipGetDevice(&dev) != hipSuccess || hipDeviceGetAttribute(&cus, hipDeviceAttributeMultiprocessorCount, dev) != hipSuccess) { grid = -1; return; }
        if (hipFuncSetAttribute((const void*)fwd_kernel, hipFuncAttributeMaxDynamicSharedMemorySize, LDS_BYTES) != hipSuccess) { fprintf(stderr, "kernel_launch: hipFuncSetAttribute failed\n"); grid = -1; return; }
        if (hipOccupancyMaxActiveBlocksPerMultiprocessor(&per_cu, (const void*)fwd_kernel, NTHR, LDS_BYTES) != hipSuccess || per_cu < 1) { fprintf(stderr, "kernel_launch: occupancy query says %d\n", per_cu); (void)hipGetLastError(); grid = -1; return; }
        grid = cus;
    }
    if (grid < 0) return;
    (void)in_sizes;
    hipMemsetAsync((char*)d_ws + WS_CTL, 0, CTL_BYTES, stream);
    Args a{};
    for (int i = 0; i < 22; ++i) a.in[i] = d_in[i];
    a.out = (float*)d_out; a.ws = (unsigned char*)d_ws; a.flags = 0; a.pad = 0;
#if MK_ONE_LAUNCH
    a.ph_lo = 0; a.ph_hi = NPH;
    hipLaunchKernelGGL(fwd_kernel, dim3(grid), dim3(NTHR), LDS_BYTES, stream, a);
#else
    for (int p = 0; p < NPH; ++p) { a.ph_lo = p; a.ph_hi = p + 1; hipLaunchKernelGGL(fwd_kernel, dim3(grid), dim3(NTHR), LDS_BYTES, stream, a); }
#endif
}
```

```cpp
#include <hip/hip_runtime.h>
#include <cstdio>
#include <cstdint>

#define GAS __attribute__((address_space(1)))
#define LAS __attribute__((address_space(3)))
typedef unsigned short bf16_t;
typedef short bf16x8 __attribute__((ext_vector_type(8)));
typedef float f32x4 __attribute__((ext_vector_type(4)));
typedef float f32x2 __attribute__((ext_vector_type(2)));
typedef float f32x16 __attribute__((ext_vector_type(16)));
typedef unsigned u32x4 __attribute__((ext_vector_type(4)));
typedef unsigned u32x2 __attribute__((ext_vector_type(2)));
typedef int i32x4 __attribute__((ext_vector_type(4)));
typedef int i32x8 __attribute__((ext_vector_type(8)));
typedef short s16x4 __attribute__((ext_vector_type(4)));
typedef short s16x2 __attribute__((ext_vector_type(2)));

constexpr int S = 16384, D = 2048, DIN = 10832, DINP = 11008, NEXP = 32, DFF = 2048;
constexpr int NWAVES = 8, NTHR = 512;
constexpr int CQ = 0, CK = 1024, CV = 1280, CQI = 1536, CKI = 2560, CWI = 2624, CHQ = 2816, CHF = 3840, CHI = 4864, CHG = 5888, CGA = 6912, CGR = 8960;
constexpr int PMAX = 65536 + NEXP * 256;
constexpr float NORM_EPS = 1e-5f;

constexpr size_t MiB = 1u << 20;
constexpr size_t al256(size_t x) { return (x + 255) & ~(size_t)255; }
constexpr size_t WS_CTL = 0, CTL_BYTES = 1 * MiB;
constexpr size_t WS_MOD = WS_CTL + CTL_BYTES;
constexpr size_t WS_TOPE = WS_MOD + 64 * 1024;
constexpr size_t WS_GATE = WS_TOPE + (size_t)S * 16;
constexpr size_t WS_SLOT = WS_GATE + (size_t)S * 16;
constexpr size_t WS_WIN_T = WS_SLOT + (size_t)S * 16;
constexpr size_t WS_WA_T = WS_WIN_T + (size_t)DINP * D * 2;
constexpr size_t WS_WH_T = WS_WA_T + (size_t)2048 * 1024 * 2;
constexpr size_t WS_WO_T = WS_WH_T + (size_t)2048 * 1024 * 2;
constexpr size_t WS_W1_T = WS_WO_T + (size_t)2048 * 2048 * 2;
constexpr size_t WS_W2_T = WS_W1_T + (size_t)NEXP * 4096 * 2048 * 2;
constexpr size_t WS_H = WS_W2_T + (size_t)NEXP * 2048 * 2048 * 2;
constexpr size_t WS_PROJ = WS_H + (size_t)S * D * 2;
constexpr size_t WS_KI = WS_PROJ + (size_t)S * DINP * 2;
constexpr size_t WS_KC = WS_KI + (size_t)S * 64 * 2;
constexpr size_t WS_VC = WS_KC + (size_t)S * 256 * 2;
constexpr size_t WS_ST = WS_VC + (size_t)S * 256 * 2;
constexpr size_t WS_DC = WS_ST + (size_t)256 * 8 * 128 * 128 * 4;
constexpr size_t WS_SEL = WS_DC + (size_t)256 * 8 * 128 * 4;
constexpr size_t WS_ATT = WS_SEL + (size_t)S * 256 * 4;
constexpr size_t WS_REC = WS_ATT + (size_t)S * 1024 * 2;
constexpr size_t WS_MERGED = WS_REC + (size_t)S * 1024 * 2;
constexpr size_t WS_X1 = WS_MERGED + (size_t)S * 2048 * 2;
constexpr size_t WS_SCORES = WS_X1 + (size_t)S * 2048 * 4;
constexpr size_t WS_XB = WS_SCORES;
constexpr size_t WS_ACT = WS_XB + (size_t)PMAX * 2048 * 2;
constexpr size_t WS_YB = WS_ACT + (size_t)PMAX * 2048 * 2;
constexpr size_t WS_END = WS_SCORES + (size_t)S * S * 4;
static_assert(WS_YB + (size_t)PMAX * 2048 * 2 <= WS_END, "MoE buffers overlay the score matrix");
static_assert(WS_END <= (size_t)4096 * MiB, "workspace");
constexpr int CW_BAR = 4096, CW_CNT = 8192, CW_FILL = 8448;
constexpr size_t WS_TOKS = WS_SEL;

constexpr int LDS_BYTES = 155648;
constexpr int LDS_MISC = LDS_BYTES - 512;

__device__ __forceinline__ unsigned cvt_pk_bf16(float lo, float hi) { unsigned r; asm volatile("v_cvt_pk_bf16_f32 %0, %1, %2" : "=v"(r) : "v"(lo), "v"(hi)); return r; }
__device__ __forceinline__ float bf_lo(unsigned u) { return __uint_as_float(u << 16); }
__device__ __forceinline__ float bf_hi(unsigned u) { return __uint_as_float(u & 0xffff0000u); }
__device__ __forceinline__ float bf2f(bf16_t b) { return __uint_as_float(((unsigned)b) << 16); }
__device__ __forceinline__ float wave_sum(float v) {
#define DPPS(ctrl, rmask) { const int s_ = __builtin_amdgcn_update_dpp(0, __float_as_int(v), ctrl, rmask, 0xF, false); v += __int_as_float(s_); }
    DPPS(0x111, 0xF) DPPS(0x112, 0xF) DPPS(0x114, 0xF) DPPS(0x118, 0xF) DPPS(0x142, 0xA) DPPS(0x143, 0xC)
#undef DPPS
    return __int_as_float(__builtin_amdgcn_readlane(__float_as_int(v), 63));
}
__device__ __forceinline__ float wave_max(float v) {
#define DPPM(ctrl, rmask) { const int o_ = __float_as_int(v); const int s_ = __builtin_amdgcn_update_dpp(o_, o_, ctrl, rmask, 0xF, false); v = fmaxf(v, __int_as_float(s_)); }
    DPPM(0x111, 0xF) DPPM(0x112, 0xF) DPPM(0x114, 0xF) DPPM(0x118, 0xF) DPPM(0x142, 0xA) DPPM(0x143, 0xC)
#undef DPPM
    return __int_as_float(__builtin_amdgcn_readlane(__float_as_int(v), 63));
}
__device__ __forceinline__ float sigmoidf_(float x) { return __builtin_amdgcn_rcpf(1.0f + __expf(-x)); }
__device__ __forceinline__ float siluf_(float x) { return x * __builtin_amdgcn_rcpf(1.0f + __expf(-x)); }
__device__ __forceinline__ unsigned pack4_fp8(float a, float b, float c, float d) { int w = 0; w = __builtin_amdgcn_cvt_pk_fp8_f32(a, b, w, false); w = __builtin_amdgcn_cvt_pk_fp8_f32(c, d, w, true); return (unsigned)w; }
constexpr float W8_SCALE = 64.0f, ACT8_SCALE = 4.0f;
__device__ __forceinline__ float relu_i(float x) { const int i = __float_as_int(x); return __int_as_float(i > 0 ? i : 0); }
__device__ __forceinline__ void fp8x16_to_bf16(const u32x4& w, u32x4& lo, u32x4& hi) {
    unsigned o[8];
#pragma unroll
    for (int q = 0; q < 4; ++q) { const unsigned wq = w[q]; const f32x2 a = __builtin_amdgcn_cvt_pk_f32_fp8((int)wq, false), b = __builtin_amdgcn_cvt_pk_f32_fp8((int)wq, true);
        o[2 * q] = cvt_pk_bf16(a[0], a[1]); o[2 * q + 1] = cvt_pk_bf16(b[0], b[1]); }
    lo = (u32x4){o[0], o[1], o[2], o[3]}; hi = (u32x4){o[4], o[5], o[6], o[7]};
}
__device__ __forceinline__ unsigned char fp8_1(float x) { return (unsigned char)(__builtin_amdgcn_cvt_pk_fp8_f32(x, x, 0, false) & 0xff); }
#define LDS_WAIT() asm volatile("s_waitcnt lgkmcnt(0)" ::: "memory")
#define VM_WAIT() asm volatile("s_waitcnt vmcnt(0)" ::: "memory")

#define XB_TMO      128
#define XB_XCNT(j)  (256  + 64 * (j))
#define XB_XSUB(j)  (1280 + 64 * (j))
#define XB_XGEN(j)  (2304 + 64 * (j))
#define XB_TOP      3328
#define XB_TOPGEN   3392
#define XCD_BAR_WORDS 3456
#define XB_SPIN_CAP (1u << 22)

__device__ __forceinline__ unsigned xb_ld(unsigned* p)              { return __hip_atomic_load(p, __ATOMIC_RELAXED, __HIP_MEMORY_SCOPE_AGENT); }
__device__ __forceinline__ unsigned xb_add(unsigned* p, unsigned v) { return __hip_atomic_fetch_add(p, v, __ATOMIC_RELAXED, __HIP_MEMORY_SCOPE_AGENT); }
__device__ __forceinline__ unsigned xb_xcc_id() { return (unsigned)__builtin_amdgcn_s_getreg((3 << 11) | 20) & 0xFu; }
#define XB_SPIN(cond, bar) do { unsigned _sp = 0; while (cond) { __builtin_amdgcn_s_sleep(1); \
    if ((++_sp & 255u) == 0u) { if (xb_ld(&(bar)[XB_TMO])) break; if (_sp > XB_SPIN_CAP) { atomicAdd(&(bar)[XB_TMO], 1u); break; } } } } while (0)

struct XcdBarrier { unsigned* bar; unsigned x; volatile LAS unsigned* st; };

__device__ __forceinline__ XcdBarrier xcd_barrier_post(unsigned* bar, volatile LAS unsigned* st) {
    XcdBarrier b; b.bar = bar; b.x = xb_xcc_id(); b.st = st;
    if (threadIdx.x == 0) (void)xb_add(&bar[XB_XCNT(b.x)], 1u);
    return b;
}
__device__ __forceinline__ void xcd_barrier_complete(unsigned* bar, unsigned x, unsigned& nloc, unsigned& nx) {
    const unsigned G = gridDim.x * gridDim.y * gridDim.z;
    unsigned sum, cnt, mine, sp = 0u;
    for (;;) {
        sum = 0u; cnt = 0u; mine = 0u;
#pragma unroll
        for (unsigned j = 0; j < 16; ++j) { const unsigned c = xb_ld(&bar[XB_XCNT(j)]); sum += c; cnt += (c > 0u) ? 1u : 0u; mine = (j == x) ? c : mine; }
        if (sum == G) break;
        __builtin_amdgcn_s_sleep(1);
        if ((++sp & 255u) == 0u) { if (xb_ld(&bar[XB_TMO])) break; if (sp > XB_SPIN_CAP) { atomicAdd(&bar[XB_TMO], 1u); break; } }
    }
    nloc = mine > 0u ? mine : 1u; nx = cnt > 0u ? cnt : 1u;
}
__device__ __forceinline__ void xcd_barrier(const XcdBarrier& b) {
    asm volatile("s_waitcnt vmcnt(0)" ::: "memory");
    __syncthreads();
    if (threadIdx.x == 0) {
        unsigned* bar = b.bar;
        __builtin_amdgcn_s_waitcnt(0);
        unsigned nloc = b.st[0], nx = b.st[1];
        if (nloc == 0u) { xcd_barrier_complete(bar, b.x, nloc, nx); b.st[0] = nloc; b.st[1] = nx; }
        const unsigned old = xb_add(&bar[XB_XSUB(b.x)], 1u);
        const unsigned gen = old / nloc;
        if (old + 1u == (gen + 1u) * nloc) {
            __builtin_amdgcn_fence(__ATOMIC_RELEASE, "agent");
            asm volatile("s_waitcnt vmcnt(0)" ::: "memory");
            const unsigned og = xb_add(&bar[XB_TOP], 1u);
            const unsigned tg = og / nx;
            if (og + 1u == (tg + 1u) * nx) xb_add(&bar[XB_TOPGEN], 1u);
            else XB_SPIN(xb_ld(&bar[XB_TOPGEN]) == tg, bar);
            __builtin_amdgcn_fence(__ATOMIC_ACQUIRE, "agent");
            xb_add(&bar[XB_XGEN(b.x)], 1u);
            asm volatile("s_waitcnt vmcnt(0)" ::: "memory");
        } else {
            XB_SPIN(xb_ld(&bar[XB_XGEN(b.x)]) == gen, bar);
            __builtin_amdgcn_fence(__ATOMIC_ACQUIRE, "agent");
            asm volatile("s_waitcnt vmcnt(0)" ::: "memory");
        }
    }
    __syncthreads();
}

namespace pg8 {
constexpr int BM = 256, BK = 64, HALF = 128, HTB = HALF * BK * 2, STAGE_BYTES = 8 * HTB, NXCD = 8, WGM = 8;
__host__ __device__ __forceinline__ int lds_byte(int r, int c) { const int st = (r >> 4) * 2 + (c >> 5), rr = r & 15, cc = c & 31, ob = rr * 64 + cc * 2; return st * 1024 + (ob ^ (((ob >> 9) & 1) << 5)); }
__host__ __device__ __forceinline__ void stage_rc(int b, int& R, int& C) { const int st = b / 1024, sb = b % 1024, swz = sb ^ (((sb >> 9) & 1) << 5); R = (st >> 1) * 16 + swz / 64; C = (st & 1) * 32 + (swz % 64) / 2; }
__host__ __device__ __forceinline__ int perm32(int rho) { const int n = rho >> 4, i = rho & 15; return 8 * (i >> 2) + 4 * n + (i & 3); }

struct Unit { int pm, pn, e; };
struct Gemm { const void* A; const void* Bt; int K; size_t estride; const int* arow; size_t astride; };

struct StaticOrder {
    int nM, nN, nwg, G, c, i, full, erank, en;
    __device__ void init(int M, int N, int G_, int c_) { nM = M / BM; nN = N / BM; nwg = nM * nN; G = G_; c = c_; i = 0; full = 1 << 30; erank = -1; en = 1; }
    __device__ void skew(int full_, int erank_, int en_) { full = full_; erank = erank_; en = en_; }
    __device__ bool next(Unit& u) {
        long L;
        if (i < full) L = (long)i * G + c; else { if (erank < 0) return false; L = (long)full * G + (long)(i - full) * en + erank; }
        ++i; if (L >= nwg) return false;
        int wgid = (int)L; { const int q = nwg / NXCD, r = nwg % NXCD, xcd = wgid % NXCD, off = wgid / NXCD; wgid = (xcd < r ? xcd * (q + 1) : r * (q + 1) + (xcd - r) * q) + off; }
        const int nig = WGM * nN, gid = wgid / nig, fm = gid * WGM, gsz = (nM - fm) < WGM ? (nM - fm) : WGM;
        u.pm = fm + ((wgid % nig) % gsz); u.pn = (wgid % nig) / gsz; u.e = 0; return true;
    }
};
struct MoeOrder {
    int nPanels, nN, G, c, i; const LAS int* panel_e;
    __device__ void init(int nPanels_, int nN_, int G_, int c_, const LAS int* pe) { nPanels = nPanels_; nN = nN_; G = G_; c = c_; i = 0; panel_e = pe; }
    __device__ bool next(Unit& u) {
        const int PB = 256 / nN;
        const int nblk = (nPanels + PB - 1) / PB;
        for (;;) {
            const long L = (long)i * G + c; ++i;
            const int blk = (int)(L >> 8), r = (int)(L & 255), x = r & 7, j = r >> 3;
            if (blk >= nblk) return false;
            int pm, pn;
            if (nN == 16) { pm = blk * 16 + 4 * (x >> 1) + (j & 3); pn = 8 * (x & 1) + (j >> 2); }
            else          { pm = blk * 32 + 4 * x + (j & 3);        pn = j >> 2; }
            if (pm < nPanels) { u.pm = pm; u.pn = pn; u.e = panel_e[pm]; return true; }
        }
    }
};

template <class Epi, class Sched, bool FP8 = false>
__device__ __forceinline__ void gemm_phase(LAS unsigned char* lds, const Gemm g, Sched& S, const Epi& E) {
    const int tid = threadIdx.x, wid = __builtin_amdgcn_readfirstlane(tid >> 6), lane = tid & 63, wr = wid >> 2, wc = wid & 3, fr = lane & 15, fq = lane >> 4;
    const int K = g.K; const int pitch = FP8 ? K : 2 * K; const int nt = pitch / 128;
    unsigned voffA[2], voffB[2];
#pragma unroll
    for (int i = 0; i < 2; ++i) { int R, C; stage_rc(tid * 16 + i * 8192, R, C); const int Rb = Epi::PERM ? ((R & ~31) + perm32(R & 31)) : R;
        voffA[i] = (unsigned)(R * pitch + C * 2); voffB[i] = (unsigned)(Rb * pitch + C * 2); }
    const size_t kstep = (size_t)(BK * 2);
    const size_t hstep = (size_t)HALF * pitch;
    const size_t tstep = 2 * hstep;
    int RA[2], CA[2];
#pragma unroll
    for (int i = 0; i < 2; ++i) stage_rc(tid * 16 + i * 8192, RA[i], CA[i]);
    const bool gather = g.arow != nullptr;
    const size_t hsA = gather ? 0 : hstep;
    unsigned vA0[2] = {voffA[0], voffA[1]}, vA1[2] = {voffA[0], voffA[1]}, nA0[2] = {voffA[0], voffA[1]}, nA1[2] = {voffA[0], voffA[1]};
#define PG8_AOFF(dst0, dst1, u) do { if (gather) { _Pragma("unroll") for (int i = 0; i < 2; ++i) { \
        dst0[i] = (unsigned)g.arow[(u).pm * 256 + RA[i]] * (unsigned)pitch + (unsigned)(CA[i] * 2); dst1[i] = (unsigned)g.arow[(u).pm * 256 + 128 + RA[i]] * (unsigned)pitch + (unsigned)(CA[i] * 2); } } } while (0)
    const unsigned ldsw = (unsigned)wid * 1024u;
    const int aoff = lds_byte(wr * 64 + fr, fq * 8), boff = lds_byte(wc * 32 + fr, fq * 8);
#define PG8_SA(b, h) (((b) * 2 + (h)) * HTB)
#define PG8_SB(b, h) ((4 + (b) * 2 + (h)) * HTB)
#define PG8_STAGE(bufoff, gbase, voff) do { _Pragma("unroll") for (int _i = 0; _i < 2; ++_i) \
        __builtin_amdgcn_global_load_lds((const unsigned*)((const char*)(gbase) + (voff)[_i]), (LAS unsigned*)(lds + (bufoff) + ldsw + _i * 8192), 16, 0, 0); } while (0)
#define PG8_LD8(p) __builtin_shufflevector(*(const LAS i32x4*)(p), *(const LAS i32x4*)((p) + 1024), 0, 1, 2, 3, 4, 5, 6, 7)
#define PG8_LDA(dst, b, h) do { _Pragma("unroll") for (int m = 0; m < 4; ++m) { if constexpr (FP8) dst##8[m] = PG8_LD8(lds + PG8_SA(b, h) + aoff + m * 2048); \
        else { _Pragma("unroll") for (int k = 0; k < 2; ++k) dst[m][k] = *(const LAS bf16x8*)(lds + PG8_SA(b, h) + aoff + m * 2048 + k * 1024); } } } while (0)
#define PG8_LDB(dst, b, h) do { _Pragma("unroll") for (int n = 0; n < 2; ++n) { if constexpr (FP8) dst##8[n] = PG8_LD8(lds + PG8_SB(b, h) + boff + n * 2048); \
        else { _Pragma("unroll") for (int k = 0; k < 2; ++k) dst[n][k] = *(const LAS bf16x8*)(lds + PG8_SB(b, h) + boff + n * 2048 + k * 1024); } } } while (0)
#define PG8_MMA(ai, bj, At, Bt) do { __builtin_amdgcn_s_setprio(1); _Pragma("unroll") for (int m = 0; m < 4; ++m) _Pragma("unroll") for (int n = 0; n < 2; ++n) { \
        if constexpr (FP8) asm volatile("v_mfma_scale_f32_16x16x128_f8f6f4 %0, %1, %2, %0, %3, %3 op_sel_hi:[0,0,0]" : "+v"(acc[ai][bj][m][n]) : "v"(Bt##8[n]), "v"(At##8[m]), "v"(scl1)); \
        else { _Pragma("unroll") for (int k = 0; k < 2; ++k) acc[ai][bj][m][n] = __builtin_amdgcn_mfma_f32_16x16x32_bf16(Bt[n][k], At[m][k], acc[ai][bj][m][n], 0, 0, 0); } } \
        __builtin_amdgcn_s_setprio(0); } while (0)
#define PG8_WAIT_V(n) asm volatile("s_waitcnt vmcnt(" #n ")" ::: "memory")
#define PG8_WAIT_L(n) asm volatile("s_waitcnt lgkmcnt(" #n ")" ::: "memory")
#define PG8_BAR __builtin_amdgcn_s_barrier()
#define PG8_SCHED __builtin_amdgcn_sched_barrier(0)
    Unit cur, nxt;
    if (!S.next(cur)) return;
    const unsigned scl1 = 0x7f7f7f7fu;
    f32x4 acc[2][2][4][2];
#pragma unroll
    for (int a = 0; a < 2; ++a)
#pragma unroll
        for (int b = 0; b < 2; ++b)
#pragma unroll
            for (int m = 0; m < 4; ++m)
#pragma unroll
                for (int n = 0; n < 2; ++n) acc[a][b][m][n] = (f32x4){0.f, 0.f, 0.f, 0.f};
    bf16x8 At[4][2], B0[2][2], B1[2][2]; i32x8 At8[4], B08[2], B18[2];
    const char* cA = (const char*)g.A + (size_t)cur.e * g.astride + (gather ? (size_t)0 : (size_t)cur.pm * tstep); const char* cB = (const char*)g.Bt + (size_t)cur.e * g.estride + (size_t)cur.pn * tstep;
    PG8_AOFF(vA0, vA1, cur);
    PG8_STAGE(PG8_SB(0, 0), cB, voffB); PG8_STAGE(PG8_SB(0, 1), cB + hstep, voffB); PG8_STAGE(PG8_SA(0, 0), cA, vA0); PG8_STAGE(PG8_SA(0, 1), cA + hsA, vA1);
    if (wr == 1) PG8_BAR;
    PG8_WAIT_V(2); PG8_BAR;
    PG8_STAGE(PG8_SB(1, 0), cB + kstep, voffB); PG8_STAGE(PG8_SA(1, 0), cA + kstep, vA0); PG8_STAGE(PG8_SB(1, 1), cB + hstep + kstep, voffB);
    PG8_WAIT_V(6); PG8_BAR;
    for (;;) {
        const bool has_next = S.next(nxt);
        const char* nA = has_next ? (const char*)g.A + (size_t)nxt.e * g.astride + (gather ? (size_t)0 : (size_t)nxt.pm * tstep) : cA;
        if (has_next) PG8_AOFF(nA0, nA1, nxt);
        const char* nB = has_next ? (const char*)g.Bt + (size_t)nxt.e * g.estride + (size_t)nxt.pn * tstep : cB;
        for (int t = 0; t < nt; t += 2) {
            const bool last = (t == nt - 2);
            const char* a1 = cA + (size_t)(t + 1) * kstep;
            const char* a2 = last ? nA : cA + (size_t)(t + 2) * kstep; const char* b2 = last ? nB : cB + (size_t)(t + 2) * kstep;
            const char* a3 = a2 + kstep; const char* b3 = b2 + kstep;
            PG8_LDB(B0, 0, 0); PG8_LDB(B1, 0, 1); PG8_SCHED; PG8_LDA(At, 0, 0); PG8_STAGE(PG8_SA(1, 1), a1 + hsA, vA1);
            if (last && has_next) { vA0[0] = nA0[0]; vA0[1] = nA0[1]; vA1[0] = nA1[0]; vA1[1] = nA1[1]; }
            PG8_WAIT_V(8); PG8_WAIT_L(0); PG8_BAR; PG8_MMA(0, 0, At, B0); PG8_MMA(0, 1, At, B1); PG8_BAR; PG8_SCHED;
            PG8_LDA(At, 0, 1); PG8_STAGE(PG8_SB(0, 0), b2, voffB); PG8_STAGE(PG8_SB(0, 1), b2 + hstep, voffB); PG8_STAGE(PG8_SA(0, 0), a2, vA0);
            PG8_WAIT_V(8); PG8_WAIT_L(0); PG8_BAR; PG8_MMA(1, 0, At, B0); PG8_MMA(1, 1, At, B1); PG8_BAR; PG8_SCHED;
            PG8_LDB(B0, 1, 0); PG8_LDB(B1, 1, 1); PG8_SCHED; PG8_LDA(At, 1, 0); PG8_STAGE(PG8_SA(0, 1), a2 + hsA, vA1);
            PG8_WAIT_V(8); PG8_WAIT_L(0); PG8_BAR; PG8_MMA(0, 0, At, B0); PG8_MMA(0, 1, At, B1); PG8_BAR; PG8_SCHED;
            PG8_LDA(At, 1, 1); PG8_STAGE(PG8_SB(1, 0), b3, voffB); PG8_STAGE(PG8_SB(1, 1), b3 + hstep, voffB); PG8_STAGE(PG8_SA(1, 0), a3, vA0);
            PG8_WAIT_V(8); PG8_WAIT_L(0); PG8_BAR; PG8_MMA(1, 0, At, B0); PG8_MMA(1, 1, At, B1); PG8_BAR; PG8_SCHED;
        }
        if (wr == 0) PG8_BAR;
        if constexpr (FP8) {
#pragma unroll
            for (int a = 0; a < 2; ++a)
#pragma unroll
                for (int b = 0; b < 2; ++b) asm volatile("s_nop 15" : "+v"(acc[a][b][0][0]), "+v"(acc[a][b][0][1]), "+v"(acc[a][b][1][0]), "+v"(acc[a][b][1][1]), "+v"(acc[a][b][2][0]), "+v"(acc[a][b][2][1]), "+v"(acc[a][b][3][0]), "+v"(acc[a][b][3][1]));
        }
        const bool keep_acc = E(acc, cur, wr, wc, fr, fq);
        if (!has_next) break;
        if (!keep_acc)
#pragma unroll
        for (int a = 0; a < 2; ++a)
#pragma unroll
            for (int b = 0; b < 2; ++b)
#pragma unroll
                for (int m = 0; m < 4; ++m)
#pragma unroll
                    for (int n = 0; n < 2; ++n) acc[a][b][m][n] = (f32x4){0.f, 0.f, 0.f, 0.f};
        cur = nxt; cA = nA; cB = nB;
        if (wr == 1) PG8_BAR;
    }
    PG8_WAIT_V(0);
    PG8_BAR;
#undef PG8_AOFF
#undef PG8_SA
#undef PG8_SB
#undef PG8_STAGE
#undef PG8_LDA
#undef PG8_LDB
#undef PG8_MMA
#undef PG8_LD8
#undef PG8_WAIT_V
#undef PG8_WAIT_L
#undef PG8_BAR
#undef PG8_SCHED
}

struct EpiBf16 {
    static constexpr bool PERM = true;
    bf16_t* O; int ldc; const float* bias; int bias_estride; float ascale; int skip_from, skip_cols;
    __device__ __forceinline__ bool operator()(const f32x4 (&acc)[2][2][4][2], const Unit& u, int wr, int wc, int fr, int fq) const {
        const int row0 = u.pm * BM + wr * 64 + fr; const int col0 = u.pn * BM + wc * 32 + 8 * fq + (u.pn >= skip_from ? skip_cols : 0);
        f32x4 bv[2][2];
#pragma unroll
        for (int bj = 0; bj < 2; ++bj)
#pragma unroll
            for (int n = 0; n < 2; ++n) bv[bj][n] = bias ? *(const f32x4*)(bias + (size_t)u.e * bias_estride + col0 + bj * HALF + 4 * n) : (f32x4){0.f, 0.f, 0.f, 0.f};
#pragma unroll
        for (int ai = 0; ai < 2; ++ai)
#pragma unroll
            for (int m = 0; m < 4; ++m) { bf16_t* rowp = O + (size_t)(row0 + ai * HALF + m * 16) * ldc + col0;
#pragma unroll
                for (int bj = 0; bj < 2; ++bj) { const f32x4 v0 = acc[ai][bj][m][0] * ascale + bv[bj][0], v1 = acc[ai][bj][m][1] * ascale + bv[bj][1];
                    u32x4 w; w.x = cvt_pk_bf16(v0[0], v0[1]); w.y = cvt_pk_bf16(v0[2], v0[3]); w.z = cvt_pk_bf16(v1[0], v1[1]); w.w = cvt_pk_bf16(v1[2], v1[3]);
                    *(u32x4*)(rowp + bj * HALF) = w; } }
        return false;
    }
};
__device__ __forceinline__ float swiglu1(float ug, float ul) {
    ug = fminf(ug, 7.0f); ul = fminf(fmaxf(ul, -7.0f), 7.0f);
    return ug * __builtin_amdgcn_rcpf(1.0f + __expf(-1.702f * ug)) * (ul + 1.0f);
}
struct EpiSwiglu {
    static constexpr bool PERM = true;
    unsigned char* O; const float* b1;
    __device__ __forceinline__ bool operator()(const f32x4 (&acc)[2][2][4][2], const Unit& u, int wr, int wc, int fr, int fq) const {
        const int row0 = u.pm * BM + wr * 64 + fr; const int c0 = u.pn * 128 + wc * 32 + 8 * fq;
        const float* bg = b1 + (size_t)u.e * 4096 + c0; const float* bl = bg + 2048;
        f32x4 bgv[2], blv[2];
#pragma unroll
        for (int n = 0; n < 2; ++n) { bgv[n] = *(const f32x4*)(bg + 4 * n); blv[n] = *(const f32x4*)(bl + 4 * n); }
#pragma unroll
        for (int ai = 0; ai < 2; ++ai)
#pragma unroll
            for (int m = 0; m < 4; ++m) {
                float a[8];
#pragma unroll
                for (int n = 0; n < 2; ++n)
#pragma unroll
                    for (int j = 0; j < 4; ++j) a[4 * n + j] = ACT8_SCALE * swiglu1(acc[ai][0][m][n][j] * (1.0f / W8_SCALE) + bgv[n][j], acc[ai][1][m][n][j] * (1.0f / W8_SCALE) + blv[n][j]);
                u32x2 w; w.x = pack4_fp8(a[0], a[1], a[2], a[3]); w.y = pack4_fp8(a[4], a[5], a[6], a[7]);
                *(u32x2*)(O + (size_t)(row0 + ai * HALF + m * 16) * 2048 + c0) = w;
            }
        return false;
    }
};

struct TwoPartOrder {
    StaticOrder so; Unit held; int part;
    __device__ void init(int M, int N, int G_, int c_) { so.init(M, N, G_, c_); part = 0; }
    __device__ bool next(Unit& u) { if (part == 1) { u = held; u.e = 1; part = 0; return true; } if (!so.next(held)) return false; u = held; u.e = 0; part = 1; return true; }
};
struct EpiGate2 {
    static constexpr bool PERM = true;
    bf16_t* O; const bf16_t* Ga; const bf16_t* Gr;
    __device__ __forceinline__ bool operator()(f32x4 (&acc)[2][2][4][2], const Unit& u, int wr, int wc, int fr, int fq) const {
        const int row0 = u.pm * BM + wr * 64 + fr; const int col0 = u.pn * BM + wc * 32 + 8 * fq;
#pragma unroll
        for (int ai = 0; ai < 2; ++ai)
#pragma unroll
            for (int m = 0; m < 4; ++m) { const size_t row = (size_t)(row0 + ai * HALF + m * 16);
#pragma unroll
                for (int bj = 0; bj < 2; ++bj) { const int c = col0 + bj * HALF;
                    const u32x4 gr = *(const u32x4*)(Gr + row * DINP + c);
                    if (u.e == 0) {
                        const u32x4 ga = *(const u32x4*)(Ga + row * DINP + c);
#pragma unroll
                        for (int q = 0; q < 4; ++q) {
                            const float r0 = (1.0f + __expf(-bf_lo(gr[q]))) * __builtin_amdgcn_rcpf(1.0f + __expf(-bf_lo(ga[q]))), r1 = (1.0f + __expf(-bf_hi(gr[q]))) * __builtin_amdgcn_rcpf(1.0f + __expf(-bf_hi(ga[q])));
                            acc[ai][bj][m][q >> 1][(2 * q) & 3] *= r0; acc[ai][bj][m][q >> 1][(2 * q + 1) & 3] *= r1; }
                    } else {
                        float r[8];
#pragma unroll
                        for (int q = 0; q < 4; ++q) { r[2 * q] = sigmoidf_(bf_lo(gr[q])) * acc[ai][bj][m][q >> 1][(2 * q) & 3]; r[2 * q + 1] = sigmoidf_(bf_hi(gr[q])) * acc[ai][bj][m][q >> 1][(2 * q + 1) & 3]; }
                        u32x4 w; w.x = cvt_pk_bf16(r[0], r[1]); w.y = cvt_pk_bf16(r[2], r[3]); w.z = cvt_pk_bf16(r[4], r[5]); w.w = cvt_pk_bf16(r[6], r[7]);
                        *(u32x4*)(O + row * 2048 + c) = w; } } }
        return u.e == 0;
    }
};
struct EpiDelta {
    static constexpr bool PERM = true;
    const float* gt; bf16_t* DL;
    __device__ __forceinline__ bool operator()(const f32x4 (&acc)[2][2][4][2], const Unit& u, int wr, int wc, int fr, int fq) const {
        const int row0 = u.pm * BM + wr * 64 + fr; const int col0 = u.pn * BM + wc * 32 + 8 * fq;
        f32x4 g[2][2];
#pragma unroll
        for (int bj = 0; bj < 2; ++bj)
#pragma unroll
            for (int n = 0; n < 2; ++n) g[bj][n] = *(const f32x4*)(gt + col0 + bj * HALF + 4 * n);
#pragma unroll
        for (int ai = 0; ai < 2; ++ai)
#pragma unroll
            for (int m = 0; m < 4; ++m) { bf16_t* rowp = DL + (size_t)(row0 + ai * HALF + m * 16) * 2048 + col0;
#pragma unroll
                for (int bj = 0; bj < 2; ++bj) { const f32x4 v0 = acc[ai][bj][m][0] * g[bj][0], v1 = acc[ai][bj][m][1] * g[bj][1];
                    u32x4 w; w.x = cvt_pk_bf16(v0[0], v0[1]); w.y = cvt_pk_bf16(v0[2], v0[3]); w.z = cvt_pk_bf16(v1[0], v1[1]); w.w = cvt_pk_bf16(v1[2], v1[3]);
                    *(u32x4*)(rowp + bj * HALF) = w; } }
        return false;
    }
};
}

struct Args { const void* in[22]; float* out; unsigned char* ws; int ph_lo, ph_hi, flags, pad; };
constexpr int XCONV = 96;
enum { PH_PRO = 0, PH_H, PH_INPROJ, PH_POST, PH_SCORE, PH_SELECT, PH_ATTN, PH_OP1, PH_OP2, PH_WOUT, PH_ROUTER, PH_SCATTER, PH_MOE1, PH_MOE2, PH_FINAL, NPH };

__device__ __forceinline__ int dest_row(int mode, int n) {
    if (mode == 1) return n < 2640 ? n : n + 176;
    if (mode == 2) { const int g = n >> 11, c = n & 2047; return (c >> 7) * 256 + g * 128 + (c & 127); }
    return n;
}
__device__ __forceinline__ void convert_item(const float* __restrict__ W, int K, int N, int ld, bf16_t* WT, int mode, int item, int lane, LAS unsigned char* scr) {
    const int nblk = (N + 63) >> 6; const int kb = item / nblk, nb = item - kb * nblk; const int k0 = kb * 128, n0 = nb * 64;
    const int c4 = lane & 15, kr = lane >> 4;
    const bool ok = (n0 + 4 * c4) < N;
    const float* src = W + (size_t)(k0 + 2 * kr) * ld + n0 + 4 * c4;
#pragma unroll 4
    for (int i = 0; i < 16; ++i) {
        f32x4 v0 = (f32x4){0.f, 0.f, 0.f, 0.f}, v1 = v0;
        if (ok) { v0 = *(const f32x4*)(src + (size_t)(8 * i) * ld); v1 = *(const f32x4*)(src + (size_t)(8 * i + 1) * ld); }
        const int kk = 8 * i + 2 * kr;
#pragma unroll
        for (int e = 0; e < 4; ++e) *(LAS unsigned*)(scr + (4 * c4 + e) * 272 + kk * 2) = cvt_pk_bf16(v0[e], v1[e]);
    }
    LDS_WAIT(); asm volatile("" ::: "memory");
#pragma unroll 4
    for (int j = 0; j < 16; ++j) {
        const int q = j * 64 + lane, n = q >> 4, ch = q & 15;
        const u32x4 v = *(const LAS u32x4*)(scr + n * 272 + ch * 16);
        if (n0 + n < N) *(u32x4*)(WT + (size_t)dest_row(mode, n0 + n) * K + k0 + ch * 8) = v;
    }
    LDS_WAIT(); asm volatile("" ::: "memory");
}


__device__ __forceinline__ bf16_t f2bf(float f) { unsigned u = __float_as_uint(f); return (bf16_t)((u + 0x7fffu + ((u >> 16) & 1u)) >> 16); }
__device__ __forceinline__ float bfx(const u32x4& w, int i) { const unsigned u = w[i >> 1]; return (i & 1) ? bf_hi(u) : bf_lo(u); }
__device__ __forceinline__ void rope_sc(float pos, float inv, float& sn, float& cs) {
    const float ang = pos * inv;
    const double a = (double)ang; const double n = __builtin_rint(a * 0.15915494309189535); const float r = (float)(a - n * 6.283185307179586);
    sn = sinf(r); cs = cosf(r);
}
__device__ __forceinline__ void post_token(bf16_t* PROJ, bf16_t* KI, unsigned char* KC, unsigned char* VC, const int* positions, const float* kng, const float* knb, int t, int lane) {
    const float pos = (float)positions[t];
    bf16_t* row = PROJ + (size_t)t * DINP;
    float sn, cs;
#pragma unroll
    for (int i = 0; i < 2; ++i) {
        const int pp = lane + 64 * i, hd = pp >> 4, ii = pp & 15;
        rope_sc(pos, powf(500000.0f, -(float)ii * (1.0f / 16.0f)), sn, cs);
        bf16_t* p = row + CQ + hd * 128 + ii; const float a = bf2f(p[0]), b = bf2f(p[16]);
        p[0] = f2bf(a * cs - b * sn); p[16] = f2bf(b * cs + a * sn);
    }
#pragma unroll
    for (int i = 0; i < 2; ++i) {
        const int pp = lane + 64 * i, hd = pp >> 3, ii = pp & 7;
        rope_sc(pos, powf(500000.0f, -(float)ii * (1.0f / 8.0f)), sn, cs);
        bf16_t* p = row + CQI + hd * 64 + ii; const float a = bf2f(p[0]), b = bf2f(p[8]);
        p[0] = f2bf(a * cs - b * sn); p[8] = f2bf(b * cs + a * sn);
    }
    if (lane < 32) {
        const int g = lane >> 4, ii = lane & 15;
        rope_sc(pos, powf(500000.0f, -(float)ii * (1.0f / 16.0f)), sn, cs);
        const bf16_t* p = row + CK + g * 128 + ii; const float a = bf2f(p[0]), b = bf2f(p[16]);
        unsigned char* o = KC + (size_t)t * 256 + g * 128 + ii; o[0] = fp8_1(a * cs - b * sn); o[16] = fp8_1(b * cs + a * sn);
    }
#pragma unroll
    for (int i = 0; i < 3; ++i) { const int idx = lane + 64 * i, g = idx / 96, r = idx - g * 96; KC[(size_t)t * 256 + g * 128 + 32 + r] = fp8_1(bf2f(row[CK + g * 128 + 32 + r])); }
    { const u32x2 w = *(const u32x2*)(row + CV + 4 * lane); *(unsigned*)(VC + (size_t)t * 256 + 4 * lane) = pack4_fp8(bf_lo(w.x), bf_hi(w.x), bf_lo(w.y), bf_hi(w.y)); }
    {
        const float v = bf2f(row[CKI + lane]);
        const float mean = wave_sum(v) * (1.0f / 64.0f); const float d = v - mean; const float var = wave_sum(d * d) * (1.0f / 64.0f);
        const float y = d * rsqrtf(var + NORM_EPS) * kng[lane] + knb[lane];
        const float other = __shfl_xor(y, 8);
        rope_sc(pos, powf(500000.0f, -(float)(lane & 7) * (1.0f / 8.0f)), sn, cs);
        float o = y;
        if (lane < 8) o = y * cs - other * sn; else if (lane < 16) o = y * cs + other * sn;
        KI[(size_t)t * 64 + lane] = f2bf(o);
    }
}

constexpr int HG_GB = 0, HG_Q1 = 33792, HG_Q2 = 51200, HG_K2 = 68608, HG_VT = 86016, HG_PB = 104448, HG_LB = 113664;
__device__ __forceinline__ void hgrn_cumsum(LAS unsigned char* lds, const u32x4& w0, const u32x4& w1, float l0, float l1, int tid) {
    LAS float* GB = (LAS float*)(lds + HG_GB); LAS float* LB = (LAS float*)(lds + HG_LB); LAS float* SEG = (LAS float*)(lds + HG_LB + 512);
    if (tid < 128) LB[tid] = 1.0f / (1.0f + expf(l1 - l0));
    __syncthreads();
    const int t = tid >> 3, dseg = tid & 7;
#pragma unroll
    for (int i = 0; i < 16; ++i) { const float z = i < 8 ? bfx(w0, i) : bfx(w1, i - 8); const float lb = LB[16 * dseg + i]; GB[t * 128 + 16 * dseg + i] = logf(lb + (1.0f - lb) * sigmoidf_(z)); }
    __syncthreads();
    const int d = tid & 127, tq = tid >> 7;
    float z[16];
#pragma unroll
    for (int i = 0; i < 16; ++i) z[i] = GB[(16 * tq + i) * 128 + d];
    float a = 0.f;
#pragma unroll
    for (int i = 0; i < 16; ++i) { a += z[i]; z[i] = a; }
    SEG[tq * 128 + d] = a;
    __syncthreads();
    float pre = 0.f;
    for (int q = 0; q < tq; ++q) pre += SEG[q * 128 + d];
#pragma unroll
    for (int i = 0; i < 16; ++i) GB[(16 * tq + i) * 128 + d] = z[i] + pre;
    __syncthreads();
}
__device__ __forceinline__ void hgrn_vt(LAS unsigned char* lds, const u32x4& a, const u32x4& b, int tid) {
    const int s2 = tid & 31, eg = tid >> 5;
#pragma unroll
    for (int i = 0; i < 8; ++i) { const unsigned lo = (i & 1) ? (a[i >> 1] >> 16) : (a[i >> 1] & 0xffffu), hi = (i & 1) ? (b[i >> 1] >> 16) : (b[i >> 1] & 0xffffu);
        *(LAS unsigned*)(lds + HG_VT + (8 * eg + i) * 144 + s2 * 4) = lo | (hi << 16); }
}
__device__ __forceinline__ void hgrn_l1(LAS unsigned char* lds, const bf16_t* PROJ, const float* lb_logits, float* ST, float* DC, int c, int h, int tid, int wave, int lane) {
    const int t = tid >> 3, dseg = tid & 7, s2 = tid & 31, dg = tid >> 5;
    const bf16_t* pf = PROJ + (size_t)(c * 64 + t) * DINP + CHF + h * 128 + 16 * dseg;
    const bf16_t* pk = PROJ + (size_t)(c * 64 + 2 * s2) * DINP + CHF + h * 128 + 8 * dg;
    const u32x4 w0 = *(const u32x4*)pf, w1 = *(const u32x4*)(pf + 8);
    const u32x4 ka = *(const u32x4*)pk, kb = *(const u32x4*)(pk + DINP);
    const u32x4 va = *(const u32x4*)(pk - CHF + CHI), vb = *(const u32x4*)(pk - CHF + CHI + DINP);
    const float l0 = lb_logits[h * 128 + (tid & 127)], l1 = lb_logits[1024 + h * 128 + (tid & 127)];
    hgrn_cumsum(lds, w0, w1, l0, l1, tid);
    const LAS float* GB = (const LAS float*)(lds + HG_GB); const LAS float* LB = (const LAS float*)(lds + HG_LB);
    {
#pragma unroll
        for (int i = 0; i < 8; ++i) { const int d = 8 * dg + i; const float lb = LB[d], b63 = GB[63 * 128 + d];
            const float k0 = (1.0f - lb) * (1.0f - sigmoidf_(bfx(ka, i))), k1 = (1.0f - lb) * (1.0f - sigmoidf_(bfx(kb, i)));
            const float v0 = k0 * __expf(b63 - GB[(2 * s2) * 128 + d]), v1 = k1 * __expf(b63 - GB[(2 * s2 + 1) * 128 + d]);
            *(LAS unsigned*)(lds + HG_Q1 + d * 144 + s2 * 4) = cvt_pk_bf16(v0, v1); }
    }
    hgrn_vt(lds, va, vb, tid);
    __syncthreads();
    const int fr = lane & 15, fq = lane >> 4;
    bf16x8 af[2];
#pragma unroll
    for (int ks = 0; ks < 2; ++ks) af[ks] = *(const LAS bf16x8*)(lds + HG_VT + (16 * wave + fr) * 144 + (32 * ks + 8 * fq) * 2);
    float* dst = ST + ((size_t)(c * 8 + h) * 128) * 128;
#pragma unroll 2
    for (int dt = 0; dt < 8; ++dt) {
        f32x4 acc = (f32x4){0.f, 0.f, 0.f, 0.f};
#pragma unroll
        for (int ks = 0; ks < 2; ++ks) { const bf16x8 bfr = *(const LAS bf16x8*)(lds + HG_Q1 + (16 * dt + fr) * 144 + (32 * ks + 8 * fq) * 2); acc = __builtin_amdgcn_mfma_f32_16x16x32_bf16(af[ks], bfr, acc, 0, 0, 0); }
#pragma unroll
        for (int r = 0; r < 4; ++r) dst[(size_t)(16 * wave + 4 * fq + r) * 128 + 16 * dt + fr] = acc[r];
    }
    if (tid < 128) DC[(size_t)(c * 8 + h) * 128 + tid] = __expf(GB[63 * 128 + tid]);
    __syncthreads();
}
__device__ __forceinline__ void hgrn_l3(LAS unsigned char* lds, const bf16_t* PROJ, const float* lb_logits, const float* ST, const float* norm_g, bf16_t* REC, int c, int h, int tid, int wave, int lane) {
    const int t = tid >> 3, dseg = tid & 7, s2 = tid & 31, eg = tid >> 5, fr = lane & 15, fq = lane >> 4;
    const bf16_t* pf = PROJ + (size_t)(c * 64 + t) * DINP + CHF + h * 128 + 16 * dseg;
    const u32x4 f0 = *(const u32x4*)pf, f1 = *(const u32x4*)(pf + 8), q0 = *(const u32x4*)(pf - CHF + CHQ), q1 = *(const u32x4*)(pf - CHF + CHQ + 8);
    const u32x4 g0 = *(const u32x4*)(pf - CHF + CHG), g1 = *(const u32x4*)(pf - CHF + CHG + 8);
    const bf16_t* pv = PROJ + (size_t)(c * 64 + 2 * s2) * DINP + CHI + h * 128 + 8 * eg;
    const u32x4 va = *(const u32x4*)pv, vb = *(const u32x4*)(pv + DINP);
    const float* sp = ST + ((size_t)(c * 8 + h) * 128 + 16 * wave + fr) * 128 + 8 * fq;
    f32x4 sx[4][2];
#pragma unroll
    for (int ks = 0; ks < 4; ++ks) { sx[ks][0] = *(const f32x4*)(sp + 32 * ks); sx[ks][1] = *(const f32x4*)(sp + 32 * ks + 4); }
    const float l0 = lb_logits[h * 128 + (tid & 127)], l1 = lb_logits[1024 + h * 128 + (tid & 127)];
    hgrn_cumsum(lds, f0, f1, l0, l1, tid);
    const LAS float* GB = (const LAS float*)(lds + HG_GB); const LAS float* LB = (const LAS float*)(lds + HG_LB);
    {
        unsigned o1[8], o2[8], o3[8];
#pragma unroll
        for (int i = 0; i < 16; i += 2) {
            float a1[2], a2[2], a3[2];
#pragma unroll
            for (int j = 0; j < 2; ++j) { const int d = 16 * dseg + i + j; const float lb = LB[d], b = GB[t * 128 + d], br = GB[31 * 128 + d];
                const float z = (i + j) < 8 ? bfx(f0, i + j) : bfx(f1, i + j - 8), qv = (i + j) < 8 ? bfx(q0, i + j) : bfx(q1, i + j - 8);
                const float k = (1.0f - lb) * (1.0f - sigmoidf_(z)), q = siluf_(qv);
                a1[j] = q * __expf(b); a2[j] = q * __expf(b - br); a3[j] = k * __expf(br - b); }
            o1[i >> 1] = cvt_pk_bf16(a1[0], a1[1]); o2[i >> 1] = cvt_pk_bf16(a2[0], a2[1]); o3[i >> 1] = cvt_pk_bf16(a3[0], a3[1]);
        }
        LAS u32x4* d1 = (LAS u32x4*)(lds + HG_Q1 + t * 272 + dseg * 32); LAS u32x4* d2 = (LAS u32x4*)(lds + HG_Q2 + t * 272 + dseg * 32); LAS u32x4* d3 = (LAS u32x4*)(lds + HG_K2 + t * 272 + dseg * 32);
        d1[0] = (u32x4){o1[0], o1[1], o1[2], o1[3]}; d1[1] = (u32x4){o1[4], o1[5], o1[6], o1[7]};
        d2[0] = (u32x4){o2[0], o2[1], o2[2], o2[3]}; d2[1] = (u32x4){o2[4], o2[5], o2[6], o2[7]};
        d3[0] = (u32x4){o3[0], o3[1], o3[2], o3[3]}; d3[1] = (u32x4){o3[4], o3[5], o3[6], o3[7]};
    }
    hgrn_vt(lds, va, vb, tid);
    __syncthreads();
#pragma unroll
    for (int q = 0; q < 2; ++q) {
        const int tile = 2 * wave + q, tt = tile >> 2, stl = tile & 3;
        f32x4 acc = (f32x4){0.f, 0.f, 0.f, 0.f};
#pragma unroll
        for (int ks = 0; ks < 4; ++ks) { const bf16x8 a = *(const LAS bf16x8*)(lds + HG_Q2 + (16 * tt + fr) * 272 + (32 * ks + 8 * fq) * 2), b = *(const LAS bf16x8*)(lds + HG_K2 + (16 * stl + fr) * 272 + (32 * ks + 8 * fq) * 2);
            acc = __builtin_amdgcn_mfma_f32_16x16x32_bf16(a, b, acc, 0, 0, 0); }
#pragma unroll
        for (int r = 0; r < 4; ++r) { const int tr_ = 16 * tt + 4 * fq + r, s = 16 * stl + fr; *(LAS bf16_t*)(lds + HG_PB + tr_ * 144 + s * 2) = f2bf(s <= tr_ ? acc[r] : 0.f); }
    }
    __syncthreads();
    {
        bf16x8 b1[2], b2[4];
#pragma unroll
        for (int ks = 0; ks < 2; ++ks) b1[ks] = *(const LAS bf16x8*)(lds + HG_VT + (16 * wave + fr) * 144 + (32 * ks + 8 * fq) * 2);
#pragma unroll
        for (int ks = 0; ks < 4; ++ks) { const f32x4 x0 = sx[ks][0], x1 = sx[ks][1];
            u32x4 w; w.x = cvt_pk_bf16(x0[0], x0[1]); w.y = cvt_pk_bf16(x0[2], x0[3]); w.z = cvt_pk_bf16(x1[0], x1[1]); w.w = cvt_pk_bf16(x1[2], x1[3]); b2[ks] = __builtin_bit_cast(bf16x8, w); }
        LAS float* OB = (LAS float*)(lds + HG_GB);
#pragma unroll
        for (int tt = 0; tt < 4; ++tt) {
            f32x4 acc = (f32x4){0.f, 0.f, 0.f, 0.f};
#pragma unroll
            for (int ks = 0; ks < 2; ++ks) { const bf16x8 a = *(const LAS bf16x8*)(lds + HG_PB + (16 * tt + fr) * 144 + (32 * ks + 8 * fq) * 2); acc = __builtin_amdgcn_mfma_f32_16x16x32_bf16(a, b1[ks], acc, 0, 0, 0); }
#pragma unroll
            for (int ks = 0; ks < 4; ++ks) { const bf16x8 a = *(const LAS bf16x8*)(lds + HG_Q1 + (16 * tt + fr) * 272 + (32 * ks + 8 * fq) * 2); acc = __builtin_amdgcn_mfma_f32_16x16x32_bf16(a, b2[ks], acc, 0, 0, 0); }
#pragma unroll
            for (int r = 0; r < 4; ++r) OB[(16 * tt + 4 * fq + r) * 132 + 16 * wave + fr] = acc[r];
        }
    }
    __syncthreads();
    {
        const int es = dseg; const LAS float* OB = (const LAS float*)(lds + HG_GB);
        float o[16]; float ss = 0.f;
#pragma unroll
        for (int i = 0; i < 16; ++i) { o[i] = OB[t * 132 + 16 * es + i]; ss += o[i] * o[i]; }
        ss += __shfl_xor(ss, 1); ss += __shfl_xor(ss, 2); ss += __shfl_xor(ss, 4);
        const float rstd = rsqrtf(ss * (1.0f / 128.0f) + NORM_EPS);
        unsigned w[8];
#pragma unroll
        for (int i = 0; i < 16; i += 2) { const float ga = i < 8 ? bfx(g0, i) : bfx(g1, i - 8), gb = (i + 1) < 8 ? bfx(g0, i + 1) : bfx(g1, i + 1 - 8);
            w[i >> 1] = cvt_pk_bf16(o[i] * rstd * norm_g[16 * es + i] * siluf_(ga), o[i + 1] * rstd * norm_g[16 * es + i + 1] * siluf_(gb)); }
        u32x4* dst = (u32x4*)(REC + (size_t)(c * 64 + t) * 1024 + h * 128 + 16 * es);
        dst[0] = (u32x4){w[0], w[1], w[2], w[3]}; dst[1] = (u32x4){w[4], w[5], w[6], w[7]};
    }
    __syncthreads();
}

constexpr int SC_KT = 0, SC_SB = 36864, SC_SPITCH = 132;
__device__ __forceinline__ unsigned pk_f16(float a, float b) { return __builtin_bit_cast(unsigned, __builtin_amdgcn_cvt_pkrtz(a, b)); }
__device__ __forceinline__ void score_flush(LAS unsigned char* lds, unsigned short* SCORES, unsigned short* SEGMAX, int t0, int kt, int tid) {
    const LAS float* sb = (const LAS float*)(lds + SC_SB + (kt & 1) * (32 * SC_SPITCH * 4));
    const int row = tid >> 4, seg = tid & 15;
    const f32x4 a = *(const LAS f32x4*)(sb + row * SC_SPITCH + seg * 8), b = *(const LAS f32x4*)(sb + row * SC_SPITCH + seg * 8 + 4);
    unsigned short* dst = SCORES + (size_t)(t0 + row) * S + kt * 128 + seg * 8;
    *(u32x4*)dst = (u32x4){pk_f16(a[0], a[1]), pk_f16(a[2], a[3]), pk_f16(b[0], b[1]), pk_f16(b[2], b[3])};
    const float mx = fmaxf(fmaxf(fmaxf(a[0], a[1]), fmaxf(a[2], a[3])), fmaxf(fmaxf(b[0], b[1]), fmaxf(b[2], b[3])));
    SEGMAX[(size_t)(t0 + row) * 2048 + kt * 16 + seg] = (unsigned short)(pk_f16(mx, mx) & 0xffffu);
}
__device__ __forceinline__ void score_block(LAS unsigned char* lds, const bf16_t* PROJ, const bf16_t* KI, unsigned short* SCORES, unsigned short* SEGMAX, int qb, int tid, int wave, int lane) {
    const int t0 = qb * 32, nkt = (t0 >> 7) + 1;
    const int r = lane & 31, hh = lane >> 5;
    bf16x8 Af[2][4]; float wv[2][16]; f32x2 wv2[2][8];
#pragma unroll
    for (int p = 0; p < 2; ++p) {
        const int tq = t0 + 4 * wave + 2 * p + (r >> 4); const bf16_t* qrow = PROJ + (size_t)tq * DINP + CQI + (r & 15) * 64 + 8 * hh;
#pragma unroll
        for (int ks = 0; ks < 4; ++ks) Af[p][ks] = *(const bf16x8*)(qrow + 16 * ks);
#pragma unroll
        for (int reg = 0; reg < 16; ++reg) { const int row = (reg & 3) + 8 * (reg >> 2) + 4 * hh; const int tw = t0 + 4 * wave + 2 * p + (row >> 4);
            wv[p][reg] = bf2f(PROJ[(size_t)tw * DINP + CWI + (row & 15)]) * (1.0f / 32.0f); }
#pragma unroll
        for (int i = 0; i < 8; ++i) wv2[p][i] = (f32x2){wv[p][2 * i], wv[p][2 * i + 1]};
    }
    const u32x2 tagsw = __builtin_amdgcn_permlane32_swap(0u, 1u, false, false); const int qsel = (int)tagsw[0];
    u32x4 stg[2];
#pragma unroll
    for (int i = 0; i < 2; ++i) { const int q = tid + 512 * i; stg[i] = *(const u32x4*)(KI + (size_t)(q >> 3) * 64 + (q & 7) * 8); }
#pragma unroll
    for (int i = 0; i < 2; ++i) { const int q = tid + 512 * i; *(LAS u32x4*)(lds + SC_KT + (q >> 3) * 144 + (q & 7) * 16) = stg[i]; }
    __syncthreads();
    for (int kt = 0; kt < nkt; ++kt) {
        const LAS unsigned char* buf = lds + SC_KT + (kt & 1) * 18432;
        LAS float* sb = (LAS float*)(lds + SC_SB + (kt & 1) * (32 * SC_SPITCH * 4));
        if (kt > 0) score_flush(lds, SCORES, SEGMAX, t0, kt - 1, tid);
        if (kt + 1 < nkt) {
#pragma unroll
            for (int i = 0; i < 2; ++i) { const int q = tid + 512 * i; stg[i] = *(const u32x4*)(KI + (size_t)((kt + 1) * 128 + (q >> 3)) * 64 + (q & 7) * 8); }
        }
        {
        f32x16 accP[2], accC[2];
#define SC_MFMA(cb) do { bf16x8 Bf[4]; _Pragma("unroll") for (int ks = 0; ks < 4; ++ks) Bf[ks] = *(const LAS bf16x8*)(buf + (32 * (cb) + r) * 144 + (16 * ks + 8 * hh) * 2); \
            _Pragma("unroll") for (int p = 0; p < 2; ++p) { _Pragma("unroll") for (int i = 0; i < 16; ++i) accC[p][i] = 0.f; \
                _Pragma("unroll") for (int ks = 0; ks < 4; ++ks) accC[p] = __builtin_amdgcn_mfma_f32_32x32x16_bf16(Af[p][ks], Bf[ks], accC[p], 0, 0, 0); } } while (0)
#define SC_RED(acc, cb) do { _Pragma("unroll") for (int p = 0; p < 2; ++p) { f32x2 s0 = {0.f, 0.f}, s1 = {0.f, 0.f}; \
            _Pragma("unroll") for (int reg = 0; reg < 8; reg += 2) { const f32x2 r0 = {relu_i(acc[p][reg]), relu_i(acc[p][reg + 1])}; const f32x2 r1 = {relu_i(acc[p][reg + 8]), relu_i(acc[p][reg + 9])}; \
                s0 = __builtin_elementwise_fma(wv2[p][reg >> 1], r0, s0); s1 = __builtin_elementwise_fma(wv2[p][4 + (reg >> 1)], r1, s1); } \
            const float p0 = s0[0] + s0[1], p1 = s1[0] + s1[1]; \
            const u32x2 sw = __builtin_amdgcn_permlane32_swap(__float_as_uint(p0), __float_as_uint(p1), false, false); \
            sb[(4 * wave + 2 * p + qsel) * SC_SPITCH + 32 * (cb) + r] = __uint_as_float(sw[0]) + __uint_as_float(sw[1]); } } while (0)
#define SC_INTERLEAVE() do { _Pragma("unroll") for (int i = 0; i < 8; ++i) { __builtin_amdgcn_sched_group_barrier(0x008, 1, 0); __builtin_amdgcn_sched_group_barrier(0x002, 8, 0); } } while (0)
        SC_MFMA(0);
        accP[0] = accC[0]; accP[1] = accC[1]; SC_MFMA(1); SC_RED(accP, 0); SC_INTERLEAVE();
        accP[0] = accC[0]; accP[1] = accC[1]; SC_MFMA(2); SC_RED(accP, 1); SC_INTERLEAVE();
        accP[0] = accC[0]; accP[1] = accC[1]; SC_MFMA(3); SC_RED(accP, 2); SC_INTERLEAVE();
        SC_RED(accC, 3);
#undef SC_MFMA
#undef SC_RED
#undef SC_INTERLEAVE
        }
        if (kt + 1 < nkt) {
#pragma unroll
            for (int i = 0; i < 2; ++i) { const int q = tid + 512 * i; *(LAS u32x4*)(lds + SC_KT + ((kt + 1) & 1) * 18432 + (q >> 3) * 144 + (q & 7) * 16) = stg[i]; }
        }
        __syncthreads();
    }
    score_flush(lds, SCORES, SEGMAX, t0, nkt - 1, tid);
    __syncthreads();
}

__device__ __forceinline__ float wave_kth16(const float (&v)[16], int K) {
    const float NINF = -__builtin_inff();
    float mx = NINF, mn = __builtin_inff();
#pragma unroll
    for (int j = 0; j < 16; ++j) { mx = fmaxf(mx, v[j]); mn = fminf(mn, v[j] == NINF ? __builtin_inff() : v[j]); }
    mx = wave_max(mx); mn = -wave_max(-mn);
    int c = 0;
#pragma unroll
    for (int j = 0; j < 16; ++j) c += __popcll(__ballot(v[j] >= mx));
    if (c >= K) return mx;
    float lo = mn, hi = mx, tau = mn;
    for (int it = 0; it < 64; ++it) {
        const float mid = 0.5f * (lo + hi);
        if (!(mid > lo && mid < hi)) { tau = lo; break; }
        c = 0;
#pragma unroll
        for (int j = 0; j < 16; ++j) c += __popcll(__ballot(v[j] >= mid));
        if (c == K) { tau = mid; break; }
        if (c > K) lo = mid; else hi = mid;
        tau = lo;
    }
    return tau;
}
__device__ __forceinline__ int lanes_below(unsigned long long mask) { return (int)__builtin_amdgcn_mbcnt_hi((unsigned)(mask >> 32), __builtin_amdgcn_mbcnt_lo((unsigned)mask, 0u)); }
__device__ __forceinline__ float h2f(unsigned short h) { return (float)__builtin_bit_cast(_Float16, h); }
__device__ __forceinline__ float h2f_lo(unsigned u) { return h2f((unsigned short)(u & 0xffffu)); }
__device__ __forceinline__ float h2f_hi(unsigned u) { return h2f((unsigned short)(u >> 16)); }
__device__ __forceinline__ unsigned ge_mask8(const u32x4& v, unsigned T16) {
    unsigned m8 = 0;
#pragma unroll
    for (int w = 0; w < 4; ++w) { const unsigned vw_ = v[w];
        const s16x2 d = __builtin_elementwise_sub_sat(__builtin_bit_cast(s16x2, vw_), __builtin_bit_cast(s16x2, T16));
        const unsigned mm = ~__builtin_bit_cast(unsigned, d); m8 |= (((mm >> 15) & 1u) | ((mm >> 30) & 2u)) << (2 * w); }
    return m8;
}
__device__ __forceinline__ int append_bits(LAS int* list, int cnt, unsigned m8, int base) {
    for (;;) { const bool has = m8 != 0u; const unsigned long long mask = __ballot(has); if (!mask) break;
        const int pos = cnt + lanes_below(mask);
        if (has) { const int k = __builtin_ctz(m8); m8 &= m8 - 1u; if (pos < 1024) list[pos] = base + k; }
        cnt += __popcll(mask); }
    return cnt;
}
__device__ __forceinline__ void select_row(LAS unsigned char* wl, const unsigned short* SCORES, const unsigned short* SEGMAX, int t, int lane) {
    LAS int* selw = (LAS int*)wl; LAS int* segl = (LAS int*)(wl + 1024); LAS int* cidx = (LAS int*)(wl + 5120);
    const float NINF = -__builtin_inff();
    const unsigned short* row = SCORES + (size_t)t * S; const int n = t + 1;
    float c[16]; int N;
    if (n <= 1024) {
#pragma unroll
        for (int j = 0; j < 16; ++j) { const int i = lane + 64 * j; c[j] = i < n ? h2f(row[i]) : NINF; }
        N = -1;
    } else {
        const int m = n >> 4; float s[16];
#pragma unroll
        for (int j = 0; j < 16; ++j) { const int i = lane + 64 * j; s[j] = i < m ? h2f(row[16 * i + 7]) : NINF; }
        int K = 32, cnt = 0;
        for (;;) {
            const float tlo = (K >= m) ? NINF : wave_kth16(s, K);
            cnt = 0;
            const int nq = (n + 511) >> 9;
            if (tlo > 0.f) {
                const unsigned T16 = pk_f16(tlo, tlo);
                const u32x4 NEG = (u32x4){0xfc00fc00u, 0xfc00fc00u, 0xfc00fc00u, 0xfc00fc00u};
                const unsigned short* smrow = SEGMAX + (size_t)t * 2048; const int nseg = (t >> 3) + 1;
                int ns = 0;
                {
                    u32x4 sv[4];
#pragma unroll
                    for (int u = 0; u < 4; ++u) { const int e8 = 8 * (lane + 64 * u); sv[u] = (e8 < nseg) ? *(const u32x4*)(smrow + e8) : NEG; }
#pragma unroll
                    for (int u = 0; u < 4; ++u) { const int e8 = 8 * (lane + 64 * u); unsigned m8 = ge_mask8(sv[u], T16);
                        const int nv = nseg - e8; if (nv < 8) m8 &= nv > 0 ? ((1u << nv) - 1u) : 0u;
                        ns = append_bits(segl, ns, m8, e8); }
                }
                if (ns > 1024) ns = 1024;
                for (int j0 = 0; j0 < ns; j0 += 256) {
                    u32x4 v[4]; int sg[4];
#pragma unroll
                    for (int u = 0; u < 4; ++u) { const int i = j0 + lane + 64 * u; sg[u] = i < ns ? segl[i] : -1; v[u] = sg[u] >= 0 ? *(const u32x4*)(row + 8 * sg[u]) : NEG; }
#pragma unroll
                    for (int u = 0; u < 4; ++u) { const int e = 8 * sg[u]; unsigned m8 = sg[u] >= 0 ? ge_mask8(v[u], T16) : 0u;
                        const int nv = t + 1 - e; if (nv < 8) m8 &= nv > 0 ? ((1u << nv) - 1u) : 0u;
                        cnt = append_bits(cidx, cnt, m8, e); }
                }
            } else {
                for (int q0 = 0; q0 < nq; q0 += 4) {
                    u32x4 v[4];
#pragma unroll
                    for (int u = 0; u < 4; ++u) { const int e = 8 * (lane + 64 * (q0 + u)); v[u] = (e <= t) ? *(const u32x4*)(row + e) : (u32x4){0xfc00fc00u, 0xfc00fc00u, 0xfc00fc00u, 0xfc00fc00u}; }
#pragma unroll
                    for (int u = 0; u < 4; ++u) { const int e = 8 * (lane + 64 * (q0 + u));
#pragma unroll
                        for (int k = 0; k < 8; ++k) { const float x = (k & 1) ? h2f_hi(v[u][k >> 1]) : h2f_lo(v[u][k >> 1]);
                            const bool pred = (e + k <= t) && (x >= tlo); const unsigned long long mask = __ballot(pred);
                            if (mask) { const int pos = cnt + lanes_below(mask); if (pred && pos < 1024) cidx[pos] = e + k; cnt += __popcll(mask); } } }
                }
            }
            if (cnt >= 256 || K >= m) break;
            K *= 2;
        }
        N = cnt < 1024 ? cnt : 1024;
#pragma unroll
        for (int j = 0; j < 16; ++j) { const int i = lane + 64 * j; c[j] = i < N ? h2f(row[cidx[i]]) : NINF; }
    }
    const float tau = wave_kth16(c, 256);
    int base = 0;
#pragma unroll
    for (int j = 0; j < 16; ++j) { const bool pred = c[j] >= tau; const unsigned long long mask = __ballot(pred);
        if (mask) { const int pos = base + lanes_below(mask); if (pred && pos < 256) selw[pos] = (N < 0) ? (lane + 64 * j) : cidx[lane + 64 * j]; base += __popcll(mask); } }
}

__device__ __forceinline__ void attn_query(LAS unsigned char* wl, const bf16_t* PROJ, const unsigned char* KC, const unsigned char* VC, bf16_t* ATT, int t, int lane) {
    LAS int* selw = (LAS int*)wl; LAS float* L = (LAS float*)(wl + 1024);
    const int nsel = t < 255 ? t + 1 : 256;
    const int fr = lane & 15, fq = lane >> 4;
    bf16x8 qf[2][4];
#pragma unroll
    for (int g = 0; g < 2; ++g)
#pragma unroll
        for (int ks = 0; ks < 4; ++ks) { const bf16x8 z = {0, 0, 0, 0, 0, 0, 0, 0}; qf[g][ks] = fr < 4 ? *(const bf16x8*)(PROJ + (size_t)t * DINP + CQ + (4 * g + fr) * 128 + 64 * (ks >> 1) + 16 * fq + 8 * (ks & 1)) : z; }
    const float scale = 0.08838834764831845f;
    const int nkt = (nsel + 15) >> 4;
    {
        LAS unsigned char* KT = wl + 9216;
        const int q4_ = lane >> 4, l15_ = lane & 15;
        u32x4 kw[3][4];
#define QK_LOAD(buf, kt) do { _Pragma("unroll") for (int u = 0; u < 4; ++u) { const unsigned off_ = (unsigned)selw[16 * (kt) + 4 * u + q4_] * 256u + 16u * (unsigned)l15_; kw[buf][u] = *(const u32x4*)((const char*)KC + off_); } } while (0)
#define QK_COMP(buf, kt) do { _Pragma("unroll") for (int u = 0; u < 4; ++u) { u32x4 lo_, hi_; fp8x16_to_bf16(kw[buf][u], lo_, hi_); LAS u32x4* d_ = (LAS u32x4*)(KT + (4 * u + q4_) * 528 + 32 * l15_); d_[0] = lo_; d_[1] = hi_; } \
        _Pragma("unroll") for (int g = 0; g < 2; ++g) { f32x4 acc = (f32x4){0.f, 0.f, 0.f, 0.f}; \
            _Pragma("unroll") for (int ks = 0; ks < 4; ++ks) { const bf16x8 kf_ = *(const LAS bf16x8*)(KT + fr * 528 + g * 256 + (64 * (ks >> 1) + 16 * fq + 8 * (ks & 1)) * 2); \
                acc = __builtin_amdgcn_mfma_f32_16x16x32_bf16(qf[g][ks], kf_, acc, 0, 0, 0); } \
            if (fq == 0) { _Pragma("unroll") for (int r = 0; r < 4; ++r) L[(4 * g + r) * 256 + 16 * (kt) + fr] = (16 * (kt) + fr < nsel) ? acc[r] * scale : -__builtin_inff(); } } } while (0)
        QK_LOAD(0, 0); if (1 < nkt) QK_LOAD(1, 1);
        for (int kt = 0; kt < nkt; kt += 3) {
            if (kt + 2 < nkt) QK_LOAD(2, kt + 2);
            __builtin_amdgcn_sched_barrier(0);
            QK_COMP(0, kt);
            if (kt + 1 < nkt) { if (kt + 3 < nkt) QK_LOAD(0, kt + 3); __builtin_amdgcn_sched_barrier(0); QK_COMP(1, kt + 1); }
            if (kt + 2 < nkt) { if (kt + 4 < nkt) QK_LOAD(1, kt + 4); __builtin_amdgcn_sched_barrier(0); QK_COMP(2, kt + 2); }
        }
#undef QK_LOAD
#undef QK_COMP
        if (fq == 0) { for (int kt = nkt; kt < 16; ++kt) {
#pragma unroll
            for (int r = 0; r < 8; ++r) L[r * 256 + 16 * kt + fr] = -__builtin_inff(); } }
    }
    float p[8][4];
#pragma unroll
    for (int hd = 0; hd < 8; ++hd) { float m = -__builtin_inff();
#pragma unroll
        for (int i = 0; i < 4; ++i) { p[hd][i] = L[hd * 256 + lane + 64 * i]; m = fmaxf(m, p[hd][i]); }
        m = wave_max(m); float s = 0.f;
#pragma unroll
        for (int i = 0; i < 4; ++i) { p[hd][i] = __expf(p[hd][i] - m); s += p[hd][i]; }
        s = 1.0f / wave_sum(s);
#pragma unroll
        for (int i = 0; i < 4; ++i) p[hd][i] *= s; }
    LAS bf16_t* Pb = (LAS bf16_t*)(wl + 1024);
#pragma unroll
    for (int hd = 0; hd < 8; ++hd)
#pragma unroll
        for (int i = 0; i < 4; ++i) Pb[hd * 256 + lane + 64 * i] = f2bf(p[hd][i]);
    LAS unsigned char* VT = wl + 9216;
    const int ii = lane & 15, kq = lane >> 4;
    f32x4 acc[16];
#pragma unroll
    for (int nt = 0; nt < 16; ++nt) acc[nt] = (f32x4){0.f, 0.f, 0.f, 0.f};
    const int nch = (nsel + 15) >> 4;
    u32x4 vw[3][4];
#define PV_LOAD(buf, c) do { _Pragma("unroll") for (int u = 0; u < 4; ++u) { const unsigned off_ = (unsigned)selw[16 * (c) + 4 * u + kq] * 256u + 16u * (unsigned)ii; vw[buf][u] = *(const u32x4*)((const char*)VC + off_); } } while (0)
#define PV_COMP(buf, c) do { _Pragma("unroll") for (int u = 0; u < 4; ++u) { u32x4 lo_, hi_; fp8x16_to_bf16(vw[buf][u], lo_, hi_); LAS u32x4* d_ = (LAS u32x4*)(VT + (4 * u + kq) * 528 + 32 * ii); d_[0] = lo_; d_[1] = hi_; } \
        s16x4 pa[2]; _Pragma("unroll") for (int g = 0; g < 2; ++g) { const s16x4 r_ = *(const LAS s16x4*)(Pb + (g * 4 + (ii & 3)) * 256 + 16 * (c) + 4 * kq); pa[g] = ii < 4 ? r_ : (s16x4){0, 0, 0, 0}; } \
        _Pragma("unroll") for (int nt = 0; nt < 16; ++nt) { const s16x4 b_ = __builtin_amdgcn_ds_read_tr16_b64_v4i16((LAS s16x4*)(VT + (4 * kq + (ii >> 2)) * 528 + (16 * nt + 4 * (ii & 3)) * 2)); \
            acc[nt] = __builtin_amdgcn_mfma_f32_16x16x16bf16_1k(pa[nt >> 3], b_, acc[nt], 0, 0, 0); } } while (0)
    PV_LOAD(0, 0); if (1 < nch) PV_LOAD(1, 1);
    for (int c = 0; c < nch; c += 3) {
        if (c + 2 < nch) PV_LOAD(2, c + 2);
        __builtin_amdgcn_sched_barrier(0);
        PV_COMP(0, c);
        if (c + 1 < nch) { if (c + 3 < nch) PV_LOAD(0, c + 3); __builtin_amdgcn_sched_barrier(0); PV_COMP(1, c + 1); }
        if (c + 2 < nch) { if (c + 4 < nch) PV_LOAD(1, c + 4); __builtin_amdgcn_sched_barrier(0); PV_COMP(2, c + 2); }
    }
#undef PV_LOAD
#undef PV_COMP
    LAS float* OB = (LAS float*)(wl + 1024 + 4096);
    if (kq == 0) {
#pragma unroll
        for (int nt = 0; nt < 16; ++nt)
#pragma unroll
            for (int r = 0; r < 4; ++r) OB[(4 * (nt >> 3) + r) * 128 + 16 * (nt & 7) + ii] = acc[nt][r];
    }
    {
        const f32x4 a0 = *(const LAS f32x4*)(OB + 16 * lane), a1 = *(const LAS f32x4*)(OB + 16 * lane + 4), a2 = *(const LAS f32x4*)(OB + 16 * lane + 8), a3 = *(const LAS f32x4*)(OB + 16 * lane + 12);
        u32x4 w0, w1; w0.x = cvt_pk_bf16(a0[0], a0[1]); w0.y = cvt_pk_bf16(a0[2], a0[3]); w0.z = cvt_pk_bf16(a1[0], a1[1]); w0.w = cvt_pk_bf16(a1[2], a1[3]);
        w1.x = cvt_pk_bf16(a2[0], a2[1]); w1.y = cvt_pk_bf16(a2[2], a2[3]); w1.z = cvt_pk_bf16(a3[0], a3[1]); w1.w = cvt_pk_bf16(a3[2], a3[3]);
        u32x4* dst = (u32x4*)(ATT + (size_t)t * 1024 + 16 * lane); dst[0] = w0; dst[1] = w1;
    }
}


__device__ __forceinline__ void convert_item8(const float* __restrict__ W, int K, int N, int ld, unsigned char* WT, int mode, int item, int lane, LAS unsigned char* scr) {
    const int nblk = N >> 6; const int kb = item / nblk, nb = item - kb * nblk; const int k0 = kb * 256, n0 = nb * 64;
    const int c4 = lane & 15, kr = lane >> 4;
    const float* src = W + (size_t)(k0 + 4 * kr) * ld + n0 + 4 * c4;
#pragma unroll 4
    for (int i = 0; i < 16; ++i) {
        f32x4 v[4];
#pragma unroll
        for (int r = 0; r < 4; ++r) v[r] = __builtin_nontemporal_load((const f32x4*)(src + (size_t)(16 * i + r) * ld));
        const int kk = 16 * i + 4 * kr;
#pragma unroll
        for (int e = 0; e < 4; ++e) *(LAS unsigned*)(scr + (4 * c4 + e) * 272 + kk) = pack4_fp8(v[0][e] * W8_SCALE, v[1][e] * W8_SCALE, v[2][e] * W8_SCALE, v[3][e] * W8_SCALE);
    }
    LDS_WAIT(); asm volatile("" ::: "memory");
#pragma unroll 4
    for (int j = 0; j < 16; ++j) {
        const int q = j * 64 + lane, n = q >> 4, ch = q & 15;
        const u32x4 v = *(const LAS u32x4*)(scr + n * 272 + ch * 16);
        *(u32x4*)(WT + (size_t)dest_row(mode, n0 + n) * K + k0 + ch * 16) = v;
    }
    LDS_WAIT(); asm volatile("" ::: "memory");
}

struct Conv8Job { const float* W; unsigned char* WT; int N; int mode; size_t w_estride, wt_estride; int items_per_e; };
constexpr int C8_PITCH = 272, C8_IMG = 256 * C8_PITCH;
__device__ __forceinline__ void conv8_load(const Conv8Job& jb, int item, int h, int wave, int lane, f32x4 (&v)[16]) {
    const int e = item / jb.items_per_e, r = item - e * jb.items_per_e; const int nblk = jb.N >> 8; const int kb = r / nblk, nb = r - kb * nblk;
    const float* src = jb.W + (size_t)e * jb.w_estride + (size_t)(kb * 256 + 32 * wave + 16 * h) * jb.N + nb * 256 + 4 * lane;
#pragma unroll
    for (int i = 0; i < 16; ++i) v[i] = __builtin_nontemporal_load((const f32x4*)(src + (size_t)i * jb.N));
}
__device__ __forceinline__ void conv8_to_lds(LAS unsigned char* img, int h, int wave, int lane, const f32x4 (&v)[16]) {
#pragma unroll
    for (int e = 0; e < 4; ++e) { u32x4 w;
#pragma unroll
        for (int g = 0; g < 4; ++g) w[g] = pack4_fp8(v[4 * g][e] * W8_SCALE, v[4 * g + 1][e] * W8_SCALE, v[4 * g + 2][e] * W8_SCALE, v[4 * g + 3][e] * W8_SCALE);
        *(LAS u32x4*)(img + (4 * lane + e) * C8_PITCH + 32 * wave + 16 * h) = w; }
}
__device__ __forceinline__ void conv8_store(const Conv8Job& jb, int item, const LAS unsigned char* img, int tid) {
    const int e = item / jb.items_per_e, r = item - e * jb.items_per_e; const int nblk = jb.N >> 8; const int kb = r / nblk, nb = r - kb * nblk;
    unsigned char* dst = jb.WT + (size_t)e * jb.wt_estride + kb * 256;
#pragma unroll
    for (int j = 0; j < 8; ++j) { const int q = j * 512 + tid, n = q >> 4, ch = q & 15;
        __builtin_nontemporal_store(*(const LAS u32x4*)(img + n * C8_PITCH + ch * 16), (u32x4*)(dst + (size_t)dest_row(jb.mode, nb * 256 + n) * 2048 + ch * 16)); }
}
__device__ __forceinline__ void conv8_run(LAS unsigned char* lds, const Conv8Job& jb, int n_items, int wg, int G, int tid, int wave, int lane) {
    if (wg >= n_items) return;
    f32x4 a[16], b[16]; int par = 0;
    conv8_load(jb, wg, 0, wave, lane, a); conv8_load(jb, wg, 1, wave, lane, b);
    for (int it = wg; it < n_items; it += G, par ^= 1) {
        LAS unsigned char* img = lds + par * C8_IMG;
        const int nx = (it + G < n_items) ? it + G : it;
        conv8_to_lds(img, 0, wave, lane, a); __builtin_amdgcn_sched_barrier(0);
        conv8_load(jb, nx, 0, wave, lane, a); __builtin_amdgcn_sched_barrier(0);
        conv8_to_lds(img, 1, wave, lane, b); __builtin_amdgcn_sched_barrier(0);
        conv8_load(jb, nx, 1, wave, lane, b); __builtin_amdgcn_sched_barrier(0);
        __syncthreads();
        conv8_store(jb, it, img, tid);
    }
    __syncthreads();
}

__global__ void __launch_bounds__(NTHR, 2) fwd_kernel(Args args) {
    extern __shared__ __attribute__((aligned(16))) unsigned char lds_raw[];
    LAS unsigned char* lds = (LAS unsigned char*)lds_raw;
    volatile LAS unsigned* MISC = (volatile LAS unsigned*)(lds + LDS_MISC);
    const int tid = threadIdx.x, lane = tid & 63, wave = __builtin_amdgcn_readfirstlane(tid >> 6);
    const int G = gridDim.x, wg = blockIdx.x;
    unsigned char* ws = args.ws;
    unsigned* ctl = (unsigned*)(ws + WS_CTL);
    const int lo = args.ph_lo, hi = args.ph_hi;
    const float* x = (const float*)args.in[0]; const float* cvec = (const float*)args.in[1]; const int* positions = (const int*)args.in[2];
    const float* w_ada = (const float*)args.in[3]; const float* b_ada = (const float*)args.in[4]; const float* norm1_g = (const float*)args.in[5];
    const float* w_in = (const float*)args.in[6]; const float* idx_knorm_g = (const float*)args.in[7]; const float* idx_knorm_b = (const float*)args.in[8];
    const float* lb_logits = (const float*)args.in[9]; const float* hgrn_norm_g = (const float*)args.in[10];
    const float* w_proj_att = (const float*)args.in[11]; const float* w_proj_hgrn = (const float*)args.in[12]; const float* w_out = (const float*)args.in[13];
    const float* norm2_g = (const float*)args.in[14]; const float* w_router = (const float*)args.in[15]; const float* b_router = (const float*)args.in[16];
    const float* w1 = (const float*)args.in[17]; const float* b1 = (const float*)args.in[18]; const float* w2 = (const float*)args.in[19]; const float* b2 = (const float*)args.in[20];
    const float* final_g = (const float*)args.in[21];
    float* out = args.out;
    float* MOD = (float*)(ws + WS_MOD); int* TOPE = (int*)(ws + WS_TOPE); float* GATE = (float*)(ws + WS_GATE); int* SLOT = (int*)(ws + WS_SLOT);
    bf16_t* WIN_T = (bf16_t*)(ws + WS_WIN_T); bf16_t* WA_T = (bf16_t*)(ws + WS_WA_T); bf16_t* WH_T = (bf16_t*)(ws + WS_WH_T); bf16_t* WO_T = (bf16_t*)(ws + WS_WO_T);
    unsigned char* WIN_T8 = ws + WS_WIN_T + 8 * MiB;
    unsigned char* HA8 = ws + WS_SCORES;
    unsigned char* W1_T = ws + WS_W1_T; unsigned char* W2_T = ws + WS_W2_T;
    bf16_t* HB = (bf16_t*)(ws + WS_H); bf16_t* PROJ = (bf16_t*)(ws + WS_PROJ);
    bf16_t* DELTA = (bf16_t*)(ws + WS_ATT);
    unsigned char* ACT = ws + WS_ACT; bf16_t* YB = (bf16_t*)(ws + WS_YB);
    int* TOKS = (int*)(ws + WS_TOKS);
    unsigned char* H8 = ws + WS_H;
    bf16_t* KI = (bf16_t*)(ws + WS_KI); unsigned char* KC = ws + WS_KC; unsigned char* VC = ws + WS_VC;
    float* ST = (float*)(ws + WS_ST); float* DC = (float*)(ws + WS_DC);
    bf16_t* ATT = (bf16_t*)(ws + WS_ATT); bf16_t* REC = (bf16_t*)(ws + WS_REC); bf16_t* MERGED = (bf16_t*)(ws + WS_MERGED); unsigned short* SCORES = (unsigned short*)(ws + WS_SCORES);
    unsigned short* SEGMAX = (unsigned short*)(ws + WS_X1);

    for (int u = tid; u < 128; u += NTHR) MISC[u] = 0u;
    __syncthreads();
    const bool one_launch = (hi - lo) > 1;
    XcdBarrier bar; bar.bar = ctl + CW_BAR; bar.x = 0; bar.st = MISC + 8;
    if (one_launch) bar = xcd_barrier_post(ctl + CW_BAR, MISC + 8);
#define IN(k) (lo <= (k) && (k) < hi)
#define SEAM(k) do { if (IN(k) && IN((k) + 1)) xcd_barrier(bar); } while (0)


    if (IN(PH_PRO)) {
        for (int cb = wg; cb < 256; cb += G) {
            LAS float* red = (LAS float*)lds;
            const int c4 = tid % 12, kg = tid / 12;
            f32x4 acc = (f32x4){0.f, 0.f, 0.f, 0.f};
            if (kg < 42) {
                const float* wp = w_ada + (size_t)cb * 48 + 4 * c4;
#pragma unroll 7
                for (int j = 0; j < 49; ++j) { const int k = kg + 42 * j; if (k < D) { const f32x4 v = __builtin_nontemporal_load((const f32x4*)(wp + (size_t)k * (6 * D))); acc += siluf_(cvec[k]) * v; } }
                *(LAS f32x4*)(red + kg * 48 + 4 * c4) = acc;
            }
            __syncthreads();
            if (tid < 48) { float s = b_ada[cb * 48 + tid];
#pragma unroll 6
                for (int q = 0; q < 42; ++q) s += red[q * 48 + tid];
                MOD[cb * 48 + tid] = s; }
            __syncthreads();
        }
        LAS unsigned char* scr = lds + wave * 17408;
        const int gw = wg * NWAVES + wave, NGW = G * NWAVES;
        {
            constexpr int NB_IN = (1104 + 63) / 64;
            for (int it = gw; it < 16 * NB_IN; it += NGW) convert_item(w_in + 1536, 2048, 1104, DIN, WIN_T, 0, it, lane, scr);
            for (int it = gw; it < 8 * 32; it += NGW) convert_item(w_proj_att, 1024, 2048, 2048, WA_T, 0, it, lane, scr);
            for (int it = gw; it < 8 * 32; it += NGW) convert_item(w_proj_hgrn, 1024, 2048, 2048, WH_T, 0, it, lane, scr);
            for (int it = gw; it < 16 * 32; it += NGW) convert_item(w_out, 2048, 2048, 2048, WO_T, 0, it, lane, scr);
            for (int it = gw; it < 8 * 24; it += NGW) convert_item8(w_in, 2048, 1536, DIN, WIN_T8, 0, it, lane, scr);
            for (int it = gw; it < 8 * 128; it += NGW) convert_item8(w_in + 2640, 2048, 8192, DIN, WIN_T8 + (size_t)1536 * 2048, 0, it, lane, scr);
            for (size_t i = (size_t)wg * NTHR + tid; i < (size_t)176 * 2048 * 2 / 16; i += (size_t)G * NTHR) ((u32x4*)(WIN_T + (size_t)1104 * 2048))[i] = (u32x4){0u, 0u, 0u, 0u};
        }
    }
    SEAM(PH_PRO);

    {
    if (IN(PH_H)) {
        const float* sh1 = MOD; const float* sc1 = MOD + D;
        const int gw = wg * NWAVES + wave, NGW = G * NWAVES;
        f32x4 gs[8], sh[8];
#pragma unroll
        for (int j = 0; j < 8; ++j) { const int c = 4 * lane + 256 * j; const f32x4 g = *(const f32x4*)(norm1_g + c), sc = *(const f32x4*)(sc1 + c); sh[j] = *(const f32x4*)(sh1 + c);
#pragma unroll
            for (int e = 0; e < 4; ++e) gs[j][e] = g[e] * (1.0f + sc[e]); }
        for (int t = gw; t < S; t += NGW) {
            const f32x4* xr = (const f32x4*)(x + (size_t)t * D) + lane;
            f32x4 v[8]; float ss = 0.f;
#pragma unroll
            for (int j = 0; j < 8; ++j) { v[j] = xr[64 * j]; ss += (v[j][0] * v[j][0] + v[j][1] * v[j][1]) + (v[j][2] * v[j][2] + v[j][3] * v[j][3]); }
            const float rstd = rsqrtf(wave_sum(ss) * (1.0f / D) + NORM_EPS);
#pragma unroll
            for (int j = 0; j < 8; ++j) { const f32x4 h = v[j] * rstd * gs[j] + sh[j]; u32x2 w; w.x = cvt_pk_bf16(h[0], h[1]); w.y = cvt_pk_bf16(h[2], h[3]);
                *(u32x2*)(HB + (size_t)t * D + 4 * lane + 256 * j) = w;
                *(unsigned*)(HA8 + (size_t)t * D + 4 * lane + 256 * j) = pack4_fp8(h[0], h[1], h[2], h[3]); }
        }
    }
    SEAM(PH_H);
    if (IN(PH_INPROJ)) {
        const int XC = (G == 256) ? XCONV : 0;
        const Conv8Job j1{w1, W1_T, 4096, 2, (size_t)2048 * 4096, (size_t)4096 * 2048, 8 * 16};
        const Conv8Job j2{w2, W2_T, 2048, 0, (size_t)2048 * 2048, (size_t)2048 * 2048, 8 * 8};
        if (XC == 0) { conv8_run(lds, j1, NEXP * 8 * 16, wg, G, tid, wave, lane); conv8_run(lds, j2, NEXP * 8 * 8, wg, G, tid, wave, lane); }
        if (wg < XC) { conv8_run(lds, j1, NEXP * 8 * 16, wg, XC, tid, wave, lane); conv8_run(lds, j2, NEXP * 8 * 8, wg, XC, tid, wave, lane); }
        else {
            const int Gg = G - XC, cg = wg - XC;
            {
                pg8::Gemm g8{HA8, WIN_T8, 2048, 0, nullptr, 0}; pg8::StaticOrder S8; S8.init(S, 9728, Gg, cg);
                const int full8 = 2432 / Gg, rem8 = 2432 - full8 * Gg;
                if (rem8 > 0) S8.skew(full8, cg < rem8 ? cg : -1, rem8);
                pg8::EpiBf16 E8{PROJ, DINP, nullptr, 0, 1.0f / W8_SCALE, 6, 1280};
                pg8::gemm_phase<pg8::EpiBf16, pg8::StaticOrder, true>(lds, g8, S8, E8);
            }
            {
                pg8::Gemm g{HB, WIN_T, 2048, 0, nullptr, 0}; pg8::StaticOrder So; So.init(S, 1280, Gg, (cg + Gg - (2432 % Gg)) % Gg);
                pg8::EpiBf16 E{PROJ + CQI, DINP, nullptr, 0, 1.0f, 1 << 30, 0};
                pg8::gemm_phase<pg8::EpiBf16, pg8::StaticOrder>(lds, g, So, E);
            }
        }
    }
    SEAM(PH_INPROJ);
    if (IN(PH_POST)) {
        const int gw = wg * NWAVES + wave, NGW = G * NWAVES;
        for (int t = gw; t < S; t += NGW) post_token(PROJ, KI, KC, VC, positions, idx_knorm_g, idx_knorm_b, t, lane);
        __syncthreads();
        for (int u = wg; u < 2048; u += G) hgrn_l1(lds, PROJ, lb_logits, ST, DC, u >> 3, u & 7, tid, wave, lane);
    }
    SEAM(PH_POST);
    if (IN(PH_SCORE)) {
        for (int idx = wg * NTHR + tid; idx < 8 * 128 * 128; idx += G * NTHR) {
            const int h = idx >> 14, d = idx & 127; float s = 0.f;
            float* sp = ST + idx; const float* dp = DC + h * 128 + d;
            for (int c = 0; c < 256; c += 8) {
                float l[8], dc[8];
#pragma unroll
                for (int i = 0; i < 8; ++i) { l[i] = sp[(size_t)(c + i) * 131072]; dc[i] = dp[(size_t)(c + i) * 1024]; }
#pragma unroll
                for (int i = 0; i < 8; ++i) { sp[(size_t)(c + i) * 131072] = s; s = dc[i] * s + l[i]; }
            }
        }
        {
            for (int j = wg; j < 252; j += G) { score_block(lds, PROJ, KI, SCORES, SEGMAX, 8 + j, tid, wave, lane); score_block(lds, PROJ, KI, SCORES, SEGMAX, 511 - j, tid, wave, lane); }
        }
    }
    SEAM(PH_SCORE);
    if (IN(PH_ATTN)) {
        const int gw = wg * NWAVES + wave, NGW = G * NWAVES;
        for (int u = wg; u < 2048; u += G) hgrn_l3(lds, PROJ, lb_logits, ST, hgrn_norm_g, REC, u >> 3, u & 7, tid, wave, lane);
        {
            for (int t = gw; t < S; t += NGW) {
                LAS unsigned char* wl = lds + wave * 17664;
                if (t >= 256) select_row(wl, SCORES, SEGMAX, t, lane);
                else {
#pragma unroll
                    for (int i = 0; i < 4; ++i) { const int idx = lane + 64 * i; ((LAS int*)wl)[idx] = idx <= t ? idx : 0; }
                }
                attn_query(wl, PROJ, KC, VC, ATT, t, lane);
            }
        }
    }
    SEAM(PH_ATTN);
    if (IN(PH_OP1)) {
        pg8::Gemm g{ATT, WA_T, 1024, (size_t)2048 * 1024 * 2, nullptr, (size_t)S * 1024 * 2};
        pg8::TwoPartOrder So; So.init(S, 2048, G, wg);
        pg8::EpiGate2 E{MERGED, PROJ + CGA, PROJ + CGR};
        pg8::gemm_phase<pg8::EpiGate2, pg8::TwoPartOrder>(lds, g, So, E);
    }
    SEAM(PH_OP2);
    if (IN(PH_WOUT)) {
        pg8::Gemm g{MERGED, WO_T, 2048, 0, nullptr, 0}; pg8::StaticOrder So; So.init(S, 2048, G, wg);
        pg8::EpiDelta E{MOD + 2 * D, DELTA};
        pg8::gemm_phase<pg8::EpiDelta, pg8::StaticOrder>(lds, g, So, E);
    }
    SEAM(PH_WOUT);
    }

    if (IN(PH_ROUTER)) {
        LAS float* hs = (LAS float*)lds;
        volatile LAS unsigned* lcnt = MISC + 32;
        const float* sh2 = MOD + 3 * D; const float* sc2 = MOD + 4 * D;
        if (tid < 32) lcnt[tid] = 0u;
        __syncthreads();
        for (int grp = wg; grp < S / 16; grp += G) {
#pragma unroll 1
            for (int q = 0; q < 2; ++q) {
                const int tl = 2 * wave + q, t = grp * 16 + tl;
                const f32x4* xr = (const f32x4*)(x + (size_t)t * D) + lane; const u32x2* dr = (const u32x2*)(DELTA + (size_t)t * D) + lane;
                f32x4 v[8]; float ss = 0.f;
#pragma unroll
                for (int j = 0; j < 8; ++j) { const u32x2 dw = dr[64 * j]; v[j] = xr[64 * j] + (f32x4){bf_lo(dw.x), bf_hi(dw.x), bf_lo(dw.y), bf_hi(dw.y)};
                    ss += (v[j][0] * v[j][0] + v[j][1] * v[j][1]) + (v[j][2] * v[j][2] + v[j][3] * v[j][3]); }
                const float rstd = rsqrtf(wave_sum(ss) * (1.0f / D) + NORM_EPS);
#pragma unroll
                for (int j = 0; j < 8; ++j) {
                    const int c = 4 * lane + 256 * j;
                    const f32x4 g = *(const f32x4*)(norm2_g + c), sc = *(const f32x4*)(sc2 + c), sh = *(const f32x4*)(sh2 + c);
                    f32x4 h;
#pragma unroll
                    for (int e = 0; e < 4; ++e) h[e] = v[j][e] * rstd * g[e] * (1.0f + sc[e]) + sh[e];
                    *(LAS f32x4*)(hs + tl * 2048 + c) = h;
                    *(unsigned*)(H8 + (size_t)t * D + c) = pack4_fp8(h[0], h[1], h[2], h[3]);
                }
            }
            __syncthreads();
            {
                LAS float* part = (LAS float*)(lds + 131072);
                const int fr = lane & 15, fq = lane >> 4;
                f32x4 acc0 = (f32x4){0.f, 0.f, 0.f, 0.f}, acc1 = acc0;
                const LAS float* hrow = hs + fr * 2048 + wave * 256 + 4 * fq; const float* wrp = w_router + (size_t)(wave * 256 + 4 * fq) * 32 + fr;
#pragma unroll 2
                for (int i = 0; i < 16; ++i) {
                    const f32x4 a4 = *(const LAS f32x4*)(hrow + 16 * i);
                    float b0[4], b1[4];
#pragma unroll
                    for (int s = 0; s < 4; ++s) { b0[s] = wrp[(size_t)(16 * i + s) * 32]; b1[s] = wrp[(size_t)(16 * i + s) * 32 + 16]; }
#pragma unroll
                    for (int s = 0; s < 4; ++s) { acc0 = __builtin_amdgcn_mfma_f32_16x16x4f32(a4[s], b0[s], acc0, 0, 0, 0); acc1 = __builtin_amdgcn_mfma_f32_16x16x4f32(a4[s], b1[s], acc1, 0, 0, 0); }
                }
#pragma unroll
                for (int r = 0; r < 4; ++r) { part[(wave * 16 + 4 * fq + r) * 32 + fr] = acc0[r]; part[(wave * 16 + 4 * fq + r) * 32 + 16 + fr] = acc1[r]; }
                __syncthreads();
                const int tl = tid >> 5, e = tid & 31, t = grp * 16 + tl;
                float v = b_router[e];
#pragma unroll
                for (int w = 0; w < 8; ++w) v += part[(w * 16 + tl) * 32 + e];
                float tv[4]; int ti[4];
#pragma unroll
                for (int k = 0; k < 4; ++k) {
                    float bv = v; int bi = e;
#pragma unroll
                    for (int o = 16; o >= 1; o >>= 1) { const float ov = __shfl_xor(bv, o); const int oi = __shfl_xor(bi, o); if (ov > bv || (ov == bv && oi < bi)) { bv = ov; bi = oi; } }
                    tv[k] = bv; ti[k] = bi; if (e == bi) v = -__builtin_inff();
                }
                if (e == 0) {
                    const float e1 = __expf(tv[1] - tv[0]), e2 = __expf(tv[2] - tv[0]), e3 = __expf(tv[3] - tv[0]); const float inv = 1.0f / (1.0f + e1 + e2 + e3);
                    *(int4*)(TOPE + (size_t)t * 4) = make_int4(ti[0], ti[1], ti[2], ti[3]);
                    *(f32x4*)(GATE + (size_t)t * 4) = (f32x4){inv, e1 * inv, e2 * inv, e3 * inv};
#pragma unroll
                    for (int k = 0; k < 4; ++k) __hip_atomic_fetch_add((LAS unsigned*)&lcnt[ti[k]], 1u, __ATOMIC_RELAXED, __HIP_MEMORY_SCOPE_WORKGROUP);
                }
            }
            __syncthreads();
        }
        if (tid < 32) { const unsigned c = lcnt[tid]; if (c) __hip_atomic_fetch_add(ctl + CW_CNT + tid, c, __ATOMIC_RELAXED, __HIP_MEMORY_SCOPE_AGENT); }
    }
    SEAM(PH_ROUTER);

    if (IN(PH_SCATTER)) {
        volatile LAS unsigned* lcnt = MISC + 32; volatile LAS unsigned* lbase = MISC + 64; LAS int* pstart = (LAS int*)(lds + 1024); LAS int* pcnt = (LAS int*)(lds + 1280);
        if (tid == 0) { int p = 0; for (int e = 0; e < NEXP; ++e) { const int c = (int)__hip_atomic_load(ctl + CW_CNT + e, __ATOMIC_RELAXED, __HIP_MEMORY_SCOPE_AGENT); pstart[e] = p; pcnt[e] = c; p += (c + 255) & ~255; } }
        if (tid < 32) lcnt[tid] = 0u;
        __syncthreads();
        if (wg < NEXP) { const int e = wg; for (int s = pstart[e] + pcnt[e] + tid; s < pstart[e] + ((pcnt[e] + 255) & ~255); s += NTHR) TOKS[s] = 0; }
        for (int blk = wg; blk < S / 64; blk += G) {
            int e = 0, lrank = 0;
            if (tid < 256) { e = TOPE[(size_t)blk * 256 + tid]; lrank = (int)__hip_atomic_fetch_add((LAS unsigned*)&lcnt[e], 1u, __ATOMIC_RELAXED, __HIP_MEMORY_SCOPE_WORKGROUP); }
            __syncthreads();
            if (tid < 32) { const unsigned c = lcnt[tid]; lbase[tid] = c ? __hip_atomic_fetch_add(ctl + CW_FILL + tid, c, __ATOMIC_RELAXED, __HIP_MEMORY_SCOPE_AGENT) : 0u; }
            __syncthreads();
            if (tid < 256) { const int slot = pstart[e] + (int)lbase[e] + lrank; SLOT[(size_t)blk * 256 + tid] = slot; TOKS[slot] = blk * 64 + (tid >> 2); }
            __syncthreads();
            if (tid < 32) lcnt[tid] = 0u;
            __syncthreads();
        }
    }
    SEAM(PH_SCATTER);

    if (IN(PH_MOE1) || IN(PH_MOE2)) {
        LAS int* panel_e = (LAS int*)(lds + 131072 + 2048);
        LAS int* npan = (LAS int*)(lds + 131072 + 2048 + 2048);
        __syncthreads();
        if (tid == 0) { int p = 0; for (int e = 0; e < NEXP; ++e) { const int np = (int)((__hip_atomic_load(ctl + CW_CNT + e, __ATOMIC_RELAXED, __HIP_MEMORY_SCOPE_AGENT) + 255u) >> 8); for (int q = 0; q < np; ++q) panel_e[p + q] = e; p += np; } npan[0] = p; }
        __syncthreads();
        const int nPanels = npan[0];
        if (IN(PH_MOE1)) {
            pg8::Gemm g{H8, W1_T, 2048, (size_t)4096 * 2048, TOKS, 0}; pg8::MoeOrder So; So.init(nPanels, 16, G, wg, panel_e);
            pg8::EpiSwiglu E{ACT, b1};
            pg8::gemm_phase<pg8::EpiSwiglu, pg8::MoeOrder, true>(lds, g, So, E);
        }
        SEAM(PH_MOE1);
        if (IN(PH_MOE2)) {
            pg8::Gemm g{ACT, W2_T, 2048, (size_t)2048 * 2048, nullptr, 0}; pg8::MoeOrder So; So.init(nPanels, 8, G, wg, panel_e);
            pg8::EpiBf16 E{YB, 2048, b2, 2048, 1.0f / (W8_SCALE * ACT8_SCALE), 1 << 30, 0};
            pg8::gemm_phase<pg8::EpiBf16, pg8::MoeOrder, true>(lds, g, So, E);
        }
    }
    SEAM(PH_MOE2);

    if (IN(PH_FINAL)) {
        const float* gt2 = MOD + 5 * D;
        const int gw = wg * NWAVES + wave, NGW = G * NWAVES;
        for (int t = gw; t < S; t += NGW) {
            const f32x4* xr = (const f32x4*)(x + (size_t)t * D) + lane; const u32x2* dr = (const u32x2*)(DELTA + (size_t)t * D) + lane;
            f32x4 v[8];
#pragma unroll
            for (int j = 0; j < 8; ++j) { const u32x2 dw = dr[64 * j]; v[j] = xr[64 * j] + (f32x4){bf_lo(dw.x), bf_hi(dw.x), bf_lo(dw.y), bf_hi(dw.y)}; }
            {
                f32x4 m[8];
#pragma unroll
                for (int j = 0; j < 8; ++j) m[j] = (f32x4){0.f, 0.f, 0.f, 0.f};
                const int4 sl = *(const int4*)(SLOT + (size_t)t * 4); const f32x4 gt = *(const f32x4*)(GATE + (size_t)t * 4);
                const int sls[4] = {sl.x, sl.y, sl.z, sl.w};
#pragma unroll
                for (int k = 0; k < 4; ++k) {
                    const u32x2* yr = (const u32x2*)(YB + (size_t)sls[k] * D) + lane; const float gk = gt[k];
#pragma unroll
                    for (int j = 0; j < 8; ++j) { const u32x2 w = yr[64 * j]; m[j][0] += gk * bf_lo(w.x); m[j][1] += gk * bf_hi(w.x); m[j][2] += gk * bf_lo(w.y); m[j][3] += gk * bf_hi(w.y); }
                }
#pragma unroll
                for (int j = 0; j < 8; ++j) { const f32x4 g2 = *(const f32x4*)(gt2 + 4 * lane + 256 * j); v[j] = v[j] + g2 * m[j]; }
            }
            float ss = 0.f;
#pragma unroll
            for (int j = 0; j < 8; ++j) ss += (v[j][0] * v[j][0] + v[j][1] * v[j][1]) + (v[j][2] * v[j][2] + v[j][3] * v[j][3]);
            const float rstd = rsqrtf(wave_sum(ss) * (1.0f / D) + NORM_EPS);
            f32x4* orow = (f32x4*)(out + (size_t)t * D) + lane;
#pragma unroll
            for (int j = 0; j < 8; ++j) { const f32x4 fg = *(const f32x4*)(final_g + 4 * lane + 256 * j); orow[64 * j] = v[j] * rstd * fg; }
        }
    }
#undef IN
#undef SEAM
}

#ifndef MK_ONE_LAUNCH
#define MK_ONE_LAUNCH 1
#endif
extern "C" void kernel_launch(void* const* d_in, const int* in_sizes, int n_in, void* d_out, int out_size, void* d_ws, size_t ws_size, hipStream_t stream) {
    static int grid = 0;
    if (grid == 0) {
        if (n_in != 22 || out_size != S * D || ws_size < WS_END) { fprintf(stderr, "kernel_launch: unexpected shapes: n_in %d out %d ws %zu (need %zu)\n", n_in, out_size, ws_size, (size_t)WS_END); grid = -1; return; }
        int dev = 0, cus = 0, per_cu = 0;
        if (hipGetDevice(&dev) != hipSuccess || hipDeviceGetAttribute(&cus, hipDeviceAttributeMultiprocessorCount, dev) != hipSuccess) { grid = -1; return; }
        if (hipFuncSetAttribute((const void*)fwd_kernel, hipFuncAttributeMaxDynamicSharedMemorySize, LDS_BYTES) != hipSuccess) { fprintf(stderr, "kernel_launch: hipFuncSetAttribute failed\n"); grid = -1; return; }
        if (hipOccupancyMaxActiveBlocksPerMultiprocessor(&per_cu, (const void*)fwd_kernel, NTHR, LDS_BYTES) != hipSuccess || per_cu < 1) { fprintf(stderr, "kernel_launch: occupancy query says %d\n", per_cu); (void)hipGetLastError(); grid = -1; return; }
        grid = cus;
    }
    if (grid < 0) return;
    (void)in_sizes;
    hipMemsetAsync((char*)d_ws + WS_CTL, 0, CTL_BYTES, stream);
    Args a{};
    for (int i = 0; i < 22; ++i) a.in[i] = d_in[i];
    a.out = (float*)d_out; a.ws = (unsigned char*)d_ws; a.flags = 0; a.pad = 0;
#if MK_ONE_LAUNCH
    a.ph_lo = 0; a.ph_hi = NPH;
    hipLaunchKernelGGL(fwd_kernel, dim3(grid), dim3(NTHR), LDS_BYTES, stream, a);
#else
    for (int p = 0; p < NPH; ++p) { a.ph_lo = p; a.ph_hi = p + 1; hipLaunchKernelGGL(fwd_kernel, dim3(grid), dim3(NTHR), LDS_BYTES, stream, a); }
#endif
}
```

```cpp
#include <hip/hip_runtime.h>
#include <cstdio>
#include <cstdint>

#define GAS __attribute__((address_space(1)))
#define LAS __attribute__((address_space(3)))
typedef unsigned short bf16_t;
typedef short bf16x8 __attribute__((ext_vector_type(8)));
typedef float f32x4 __attribute__((ext_vector_type(4)));
typedef float f32x2 __attribute__((ext_vector_type(2)));
typedef float f32x16 __attribute__((ext_vector_type(16)));
typedef unsigned u32x4 __attribute__((ext_vector_type(4)));
typedef unsigned u32x2 __attribute__((ext_vector_type(2)));
typedef int i32x4 __attribute__((ext_vector_type(4)));
typedef int i32x8 __attribute__((ext_vector_type(8)));
typedef short s16x4 __attribute__((ext_vector_type(4)));
typedef short s16x2 __attribute__((ext_vector_type(2)));

constexpr int S = 16384, D = 2048, DIN = 10832, DINP = 11008, NEXP = 32, DFF = 2048;
constexpr int NWAVES = 8, NTHR = 512;
constexpr int CQ = 0, CK = 1024, CV = 1280, CQI = 1536, CKI = 2560, CWI = 2624, CHQ = 2816, CHF = 3840, CHI = 4864, CHG = 5888, CGA = 6912, CGR = 8960;
constexpr int PMAX = 65536 + NEXP * 256;
constexpr float NORM_EPS = 1e-5f;

constexpr size_t MiB = 1u << 20;
constexpr size_t al256(size_t x) { return (x + 255) & ~(size_t)255; }
constexpr size_t WS_CTL = 0, CTL_BYTES = 1 * MiB;
constexpr size_t WS_MOD = WS_CTL + CTL_BYTES;
constexpr size_t WS_TOPE = WS_MOD + 64 * 1024;
constexpr size_t WS_GATE = WS_TOPE + (size_t)S * 16;
constexpr size_t WS_SLOT = WS_GATE + (size_t)S * 16;
constexpr size_t WS_WIN_T = WS_SLOT + (size_t)S * 16;
constexpr size_t WS_WA_T = WS_WIN_T + (size_t)DINP * D * 2;
constexpr size_t WS_WH_T = WS_WA_T + (size_t)2048 * 1024 * 2;
constexpr size_t WS_WO_T = WS_WH_T + (size_t)2048 * 1024 * 2;
constexpr size_t WS_W1_T = WS_WO_T + (size_t)2048 * 2048 * 2;
constexpr size_t WS_W2_T = WS_W1_T + (size_t)NEXP * 4096 * 2048 * 2;
constexpr size_t WS_H = WS_W2_T + (size_t)NEXP * 2048 * 2048 * 2;
constexpr size_t WS_PROJ = WS_H + (size_t)S * D * 2;
constexpr size_t WS_KI = WS_PROJ + (size_t)S * DINP * 2;
constexpr size_t WS_KC = WS_KI + (size_t)S * 64 * 2;
constexpr size_t WS_VC = WS_KC + (size_t)S * 256 * 2;
constexpr size_t WS_ST = WS_VC + (size_t)S * 256 * 2;
constexpr size_t WS_DC = WS_ST + (size_t)256 * 8 * 128 * 128 * 4;
constexpr size_t WS_SEL = WS_DC + (size_t)256 * 8 * 128 * 4;
constexpr size_t WS_ATT = WS_SEL + (size_t)S * 256 * 4;
constexpr size_t WS_REC = WS_ATT + (size_t)S * 1024 * 2;
constexpr size_t WS_MERGED = WS_REC + (size_t)S * 1024 * 2;
constexpr size_t WS_X1 = WS_MERGED + (size_t)S * 2048 * 2;
constexpr size_t WS_SCORES = WS_X1 + (size_t)S * 2048 * 4;
constexpr size_t WS_XB = WS_SCORES;
constexpr size_t WS_ACT = WS_XB + (size_t)PMAX * 2048 * 2;
constexpr size_t WS_YB = WS_ACT + (size_t)PMAX * 2048 * 2;
constexpr size_t WS_END = WS_SCORES + (size_t)S * S * 4;
static_assert(WS_YB + (size_t)PMAX * 2048 * 2 <= WS_END, "MoE buffers overlay the score matrix");
static_assert(WS_END <= (size_t)4096 * MiB, "workspace");
constexpr int CW_BAR = 4096, CW_CNT = 8192, CW_FILL = 8448;
constexpr size_t WS_TOKS = WS_SEL;

constexpr int LDS_BYTES = 155648;
constexpr int LDS_MISC = LDS_BYTES - 512;

__device__ __forceinline__ unsigned cvt_pk_bf16(float lo, float hi) { unsigned r; asm volatile("v_cvt_pk_bf16_f32 %0, %1, %2" : "=v"(r) : "v"(lo), "v"(hi)); return r; }
__device__ __forceinline__ float bf_lo(unsigned u) { return __uint_as_float(u << 16); }
__device__ __forceinline__ float bf_hi(unsigned u) { return __uint_as_float(u & 0xffff0000u); }
__device__ __forceinline__ float bf2f(bf16_t b) { return __uint_as_float(((unsigned)b) << 16); }
__device__ __forceinline__ float wave_sum(float v) {
#define DPPS(ctrl, rmask) { const int s_ = __builtin_amdgcn_update_dpp(0, __float_as_int(v), ctrl, rmask, 0xF, false); v += __int_as_float(s_); }
    DPPS(0x111, 0xF) DPPS(0x112, 0xF) DPPS(0x114, 0xF) DPPS(0x118, 0xF) DPPS(0x142, 0xA) DPPS(0x143, 0xC)
#undef DPPS
    return __int_as_float(__builtin_amdgcn_readlane(__float_as_int(v), 63));
}
__device__ __forceinline__ float wave_max(float v) {
#define DPPM(ctrl, rmask) { const int o_ = __float_as_int(v); const int s_ = __builtin_amdgcn_update_dpp(o_, o_, ctrl, rmask, 0xF, false); v = fmaxf(v, __int_as_float(s_)); }
    DPPM(0x111, 0xF) DPPM(0x112, 0xF) DPPM(0x114, 0xF) DPPM(0x118, 0xF) DPPM(0x142, 0xA) DPPM(0x143, 0xC)
#undef DPPM
    return __int_as_float(__builtin_amdgcn_readlane(__float_as_int(v), 63));
}
__device__ __forceinline__ float sigmoidf_(float x) { return __builtin_amdgcn_rcpf(1.0f + __expf(-x)); }
__device__ __forceinline__ float siluf_(float x) { return x * __builtin_amdgcn_rcpf(1.0f + __expf(-x)); }
__device__ __forceinline__ unsigned pack4_fp8(float a, float b, float c, float d) { int w = 0; w = __builtin_amdgcn_cvt_pk_fp8_f32(a, b, w, false); w = __builtin_amdgcn_cvt_pk_fp8_f32(c, d, w, true); return (unsigned)w; }
constexpr float W8_SCALE = 64.0f, ACT8_SCALE = 4.0f;
__device__ __forceinline__ float relu_i(float x) { const int i = __float_as_int(x); return __int_as_float(i > 0 ? i : 0); }
__device__ __forceinline__ void fp8x16_to_bf16(const u32x4& w, u32x4& lo, u32x4& hi) {
    unsigned o[8];
#pragma unroll
    for (int q = 0; q < 4; ++q) { const unsigned wq = w[q]; const f32x2 a = __builtin_amdgcn_cvt_pk_f32_fp8((int)wq, false), b = __builtin_amdgcn_cvt_pk_f32_fp8((int)wq, true);
        o[2 * q] = cvt_pk_bf16(a[0], a[1]); o[2 * q + 1] = cvt_pk_bf16(b[0], b[1]); }
    lo = (u32x4){o[0], o[1], o[2], o[3]}; hi = (u32x4){o[4], o[5], o[6], o[7]};
}
__device__ __forceinline__ unsigned char fp8_1(float x) { return (unsigned char)(__builtin_amdgcn_cvt_pk_fp8_f32(x, x, 0, false) & 0xff); }
#define LDS_WAIT() asm volatile("s_waitcnt lgkmcnt(0)" ::: "memory")
#define VM_WAIT() asm volatile("s_waitcnt vmcnt(0)" ::: "memory")

#define XB_TMO      128
#define XB_XCNT(j)  (256  + 64 * (j))
#define XB_XSUB(j)  (1280 + 64 * (j))
#define XB_XGEN(j)  (2304 + 64 * (j))
#define XB_TOP      3328
#define XB_TOPGEN   3392
#define XCD_BAR_WORDS 3456
#define XB_SPIN_CAP (1u << 22)

__device__ __forceinline__ unsigned xb_ld(unsigned* p)              { return __hip_atomic_load(p, __ATOMIC_RELAXED, __HIP_MEMORY_SCOPE_AGENT); }
__device__ __forceinline__ unsigned xb_add(unsigned* p, unsigned v) { return __hip_atomic_fetch_add(p, v, __ATOMIC_RELAXED, __HIP_MEMORY_SCOPE_AGENT); }
__device__ __forceinline__ unsigned xb_xcc_id() { return (unsigned)__builtin_amdgcn_s_getreg((3 << 11) | 20) & 0xFu; }
#define XB_SPIN(cond, bar) do { unsigned _sp = 0; while (cond) { __builtin_amdgcn_s_sleep(1); \
    if ((++_sp & 255u) == 0u) { if (xb_ld(&(bar)[XB_TMO])) break; if (_sp > XB_SPIN_CAP) { atomicAdd(&(bar)[XB_TMO], 1u); break; } } } } while (0)

struct XcdBarrier { unsigned* bar; unsigned x; volatile LAS unsigned* st; };

__device__ __forceinline__ XcdBarrier xcd_barrier_post(unsigned* bar, volatile LAS unsigned* st) {
    XcdBarrier b; b.bar = bar; b.x = xb_xcc_id(); b.st = st;
    if (threadIdx.x == 0) (void)xb_add(&bar[XB_XCNT(b.x)], 1u);
    return b;
}
__device__ __forceinline__ void xcd_barrier_complete(unsigned* bar, unsigned x, unsigned& nloc, unsigned& nx) {
    const unsigned G = gridDim.x * gridDim.y * gridDim.z;
    unsigned sum, cnt, mine, sp = 0u;
    for (;;) {
        sum = 0u; cnt = 0u; mine = 0u;
#pragma unroll
        for (unsigned j = 0; j < 16; ++j) { const unsigned c = xb_ld(&bar[XB_XCNT(j)]); sum += c; cnt += (c > 0u) ? 1u : 0u; mine = (j == x) ? c : mine; }
        if (sum == G) break;
        __builtin_amdgcn_s_sleep(1);
        if ((++sp & 255u) == 0u) { if (xb_ld(&bar[XB_TMO])) break; if (sp > XB_SPIN_CAP) { atomicAdd(&bar[XB_TMO], 1u); break; } }
    }
    nloc = mine > 0u ? mine : 1u; nx = cnt > 0u ? cnt : 1u;
}
__device__ __forceinline__ void xcd_barrier(const XcdBarrier& b) {
    asm volatile("s_waitcnt vmcnt(0)" ::: "memory");
    __syncthreads();
    if (threadIdx.x == 0) {
        unsigned* bar = b.bar;
        __builtin_amdgcn_s_waitcnt(0);
        unsigned nloc = b.st[0], nx = b.st[1];
        if (nloc == 0u) { xcd_barrier_complete(bar, b.x, nloc, nx); b.st[0] = nloc; b.st[1] = nx; }
        const unsigned old = xb_add(&bar[XB_XSUB(b.x)], 1u);
        const unsigned gen = old / nloc;
        if (old + 1u == (gen + 1u) * nloc) {
            __builtin_amdgcn_fence(__ATOMIC_RELEASE, "agent");
            asm volatile("s_waitcnt vmcnt(0)" ::: "memory");
            const unsigned og = xb_add(&bar[XB_TOP], 1u);
            const unsigned tg = og / nx;
            if (og + 1u == (tg + 1u) * nx) xb_add(&bar[XB_TOPGEN], 1u);
            else XB_SPIN(xb_ld(&bar[XB_TOPGEN]) == tg, bar);
            __builtin_amdgcn_fence(__ATOMIC_ACQUIRE, "agent");
            xb_add(&bar[XB_XGEN(b.x)], 1u);
            asm volatile("s_waitcnt vmcnt(0)" ::: "memory");
        } else {
            XB_SPIN(xb_ld(&bar[XB_XGEN(b.x)]) == gen, bar);
            __builtin_amdgcn_fence(__ATOMIC_ACQUIRE, "agent");
            asm volatile("s_waitcnt vmcnt(0)" ::: "memory");
        }
    }
    __syncthreads();
}

namespace pg8 {
constexpr int BM = 256, BK = 64, HALF = 128, HTB = HALF * BK * 2, STAGE_BYTES = 8 * HTB, NXCD = 8, WGM = 8;
__host__ __device__ __forceinline__ int lds_byte(int r, int c) { const int st = (r >> 4) * 2 + (c >> 5), rr = r & 15, cc = c & 31, ob = rr * 64 + cc * 2; return st * 1024 + (ob ^ (((ob >> 9) & 1) << 5)); }
__host__ __device__ __forceinline__ void stage_rc(int b, int& R, int& C) { const int st = b / 1024, sb = b % 1024, swz = sb ^ (((sb >> 9) & 1) << 5); R = (st >> 1) * 16 + swz / 64; C = (st & 1) * 32 + (swz % 64) / 2; }
__host__ __device__ __forceinline__ int perm32(int rho) { const int n = rho >> 4, i = rho & 15; return 8 * (i >> 2) + 4 * n + (i & 3); }

struct Unit { int pm, pn, e; };
struct Gemm { const void* A; const void* Bt; int K; size_t estride; const int* arow; size_t astride; };

struct StaticOrder {
    int nM, nN, nwg, G, c, i, full, erank, en;
    __device__ void init(int M, int N, int G_, int c_) { nM = M / BM; nN = N / BM; nwg = nM * nN; G = G_; c = c_; i = 0; full = 1 << 30; erank = -1; en = 1; }
    __device__ void skew(int full_, int erank_, int en_) { full = full_; erank = erank_; en = en_; }
    __device__ bool next(Unit& u) {
        long L;
        if (i < full) L = (long)i * G + c; else { if (erank < 0) return false; L = (long)full * G + (long)(i - full) * en + erank; }
        ++i; if (L >= nwg) return false;
        int wgid = (int)L; { const int q = nwg / NXCD, r = nwg % NXCD, xcd = wgid % NXCD, off = wgid / NXCD; wgid = (xcd < r ? xcd * (q + 1) : r * (q + 1) + (xcd - r) * q) + off; }
        const int nig = WGM * nN, gid = wgid / nig, fm = gid * WGM, gsz = (nM - fm) < WGM ? (nM - fm) : WGM;
        u.pm = fm + ((wgid % nig) % gsz); u.pn = (wgid % nig) / gsz; u.e = 0; return true;
    }
};
struct MoeOrder {
    int nPanels, nN, G, c, i; const LAS int* panel_e;
    __device__ void init(int nPanels_, int nN_, int G_, int c_, const LAS int* pe) { nPanels = nPanels_; nN = nN_; G = G_; c = c_; i = 0; panel_e = pe; }
    __device__ bool next(Unit& u) {
        const int PB = 256 / nN;
        const int nblk = (nPanels + PB - 1) / PB;
        for (;;) {
            const long L = (long)i * G + c; ++i;
            const int blk = (int)(L >> 8), r = (int)(L & 255), x = r & 7, j = r >> 3;
            if (blk >= nblk) return false;
            int pm, pn;
            if (nN == 16) { pm = blk * 16 + 4 * (x >> 1) + (j & 3); pn = 8 * (x & 1) + (j >> 2); }
            else          { pm = blk * 32 + 4 * x + (j & 3);        pn = j >> 2; }
            if (pm < nPanels) { u.pm = pm; u.pn = pn; u.e = panel_e[pm]; return true; }
        }
    }
};

template <class Epi, class Sched, bool FP8 = false>
__device__ __forceinline__ void gemm_phase(LAS unsigned char* lds, const Gemm g, Sched& S, const Epi& E) {
    const int tid = threadIdx.x, wid = __builtin_amdgcn_readfirstlane(tid >> 6), lane = tid & 63, wr = wid >> 2, wc = wid & 3, fr = lane & 15, fq = lane >> 4;
    const int K = g.K; const int pitch = FP8 ? K : 2 * K; const int nt = pitch / 128;
    unsigned voffA[2], voffB[2];
#pragma unroll
    for (int i = 0; i < 2; ++i) { int R, C; stage_rc(tid * 16 + i * 8192, R, C); const int Rb = Epi::PERM ? ((R & ~31) + perm32(R & 31)) : R;
        voffA[i] = (unsigned)(R * pitch + C * 2); voffB[i] = (unsigned)(Rb * pitch + C * 2); }
    const size_t kstep = (size_t)(BK * 2);
    const size_t hstep = (size_t)HALF * pitch;
    const size_t tstep = 2 * hstep;
    int RA[2], CA[2];
#pragma unroll
    for (int i = 0; i < 2; ++i) stage_rc(tid * 16 + i * 8192, RA[i], CA[i]);
    const bool gather = g.arow != nullptr;
    const size_t hsA = gather ? 0 : hstep;
    unsigned vA0[2] = {voffA[0], voffA[1]}, vA1[2] = {voffA[0], voffA[1]}, nA0[2] = {voffA[0], voffA[1]}, nA1[2] = {voffA[0], voffA[1]};
#define PG8_AOFF(dst0, dst1, u) do { if (gather) { _Pragma("unroll") for (int i = 0; i < 2; ++i) { \
        dst0[i] = (unsigned)g.arow[(u).pm * 256 + RA[i]] * (unsigned)pitch + (unsigned)(CA[i] * 2); dst1[i] = (unsigned)g.arow[(u).pm * 256 + 128 + RA[i]] * (unsigned)pitch + (unsigned)(CA[i] * 2); } } } while (0)
    const unsigned ldsw = (unsigned)wid * 1024u;
    const int aoff = lds_byte(wr * 64 + fr, fq * 8), boff = lds_byte(wc * 32 + fr, fq * 8);
#define PG8_SA(b, h) (((b) * 2 + (h)) * HTB)
#define PG8_SB(b, h) ((4 + (b) * 2 + (h)) * HTB)
#define PG8_STAGE(bufoff, gbase, voff) do { _Pragma("unroll") for (int _i = 0; _i < 2; ++_i) \
        __builtin_amdgcn_global_load_lds((const unsigned*)((const char*)(gbase) + (voff)[_i]), (LAS unsigned*)(lds + (bufoff) + ldsw + _i * 8192), 16, 0, 0); } while (0)
#define PG8_LD8(p) __builtin_shufflevector(*(const LAS i32x4*)(p), *(const LAS i32x4*)((p) + 1024), 0, 1, 2, 3, 4, 5, 6, 7)
#define PG8_LDA(dst, b, h) do { _Pragma("unroll") for (int m = 0; m < 4; ++m) { if constexpr (FP8) dst##8[m] = PG8_LD8(lds + PG8_SA(b, h) + aoff + m * 2048); \
        else { _Pragma("unroll") for (int k = 0; k < 2; ++k) dst[m][k] = *(const LAS bf16x8*)(lds + PG8_SA(b, h) + aoff + m * 2048 + k * 1024); } } } while (0)
#define PG8_LDB(dst, b, h) do { _Pragma("unroll") for (int n = 0; n < 2; ++n) { if constexpr (FP8) dst##8[n] = PG8_LD8(lds + PG8_SB(b, h) + boff + n * 2048); \
        else { _Pragma("unroll") for (int k = 0; k < 2; ++k) dst[n][k] = *(const LAS bf16x8*)(lds + PG8_SB(b, h) + boff + n * 2048 + k * 1024); } } } while (0)
#define PG8_MMA(ai, bj, At, Bt) do { __builtin_amdgcn_s_setprio(1); _Pragma("unroll") for (int m = 0; m < 4; ++m) _Pragma("unroll") for (int n = 0; n < 2; ++n) { \
        if constexpr (FP8) asm volatile("v_mfma_scale_f32_16x16x128_f8f6f4 %0, %1, %2, %0, %3, %3 op_sel_hi:[0,0,0]" : "+v"(acc[ai][bj][m][n]) : "v"(Bt##8[n]), "v"(At##8[m]), "v"(scl1)); \
        else { _Pragma("unroll") for (int k = 0; k < 2; ++k) acc[ai][bj][m][n] = __builtin_amdgcn_mfma_f32_16x16x32_bf16(Bt[n][k], At[m][k], acc[ai][bj][m][n], 0, 0, 0); } } \
        __builtin_amdgcn_s_setprio(0); } while (0)
#define PG8_WAIT_V(n) asm volatile("s_waitcnt vmcnt(" #n ")" ::: "memory")
#define PG8_WAIT_L(n) asm volatile("s_waitcnt lgkmcnt(" #n ")" ::: "memory")
#define PG8_BAR __builtin_amdgcn_s_barrier()
#define PG8_SCHED __builtin_amdgcn_sched_barrier(0)
    Unit cur, nxt;
    if (!S.next(cur)) return;
    const unsigned scl1 = 0x7f7f7f7fu;
    f32x4 acc[2][2][4][2];
#pragma unroll
    for (int a = 0; a < 2; ++a)
#pragma unroll
        for (int b = 0; b < 2; ++b)
#pragma unroll
            for (int m = 0; m < 4; ++m)
#pragma unroll
                for (int n = 0; n < 2; ++n) acc[a][b][m][n] = (f32x4){0.f, 0.f, 0.f, 0.f};
    bf16x8 At[4][2], B0[2][2], B1[2][2]; i32x8 At8[4], B08[2], B18[2];
    const char* cA = (const char*)g.A + (size_t)cur.e * g.astride + (gather ? (size_t)0 : (size_t)cur.pm * tstep); const char* cB = (const char*)g.Bt + (size_t)cur.e * g.estride + (size_t)cur.pn * tstep;
    PG8_AOFF(vA0, vA1, cur);
    PG8_STAGE(PG8_SB(0, 0), cB, voffB); PG8_STAGE(PG8_SB(0, 1), cB + hstep, voffB); PG8_STAGE(PG8_SA(0, 0), cA, vA0); PG8_STAGE(PG8_SA(0, 1), cA + hsA, vA1);
    if (wr == 1) PG8_BAR;
    PG8_WAIT_V(2); PG8_BAR;
    PG8_STAGE(PG8_SB(1, 0), cB + kstep, voffB); PG8_STAGE(PG8_SA(1, 0), cA + kstep, vA0); PG8_STAGE(PG8_SB(1, 1), cB + hstep + kstep, voffB);
    PG8_WAIT_V(6); PG8_BAR;
    for (;;) {
        const bool has_next = S.next(nxt);
        const char* nA = has_next ? (const char*)g.A + (size_t)nxt.e * g.astride + (gather ? (size_t)0 : (size_t)nxt.pm * tstep) : cA;
        if (has_next) PG8_AOFF(nA0, nA1, nxt);
        const char* nB = has_next ? (const char*)g.Bt + (size_t)nxt.e * g.estride + (size_t)nxt.pn * tstep : cB;
        for (int t = 0; t < nt; t += 2) {
            const bool last = (t == nt - 2);
            const char* a1 = cA + (size_t)(t + 1) * kstep;
            const char* a2 = last ? nA : cA + (size_t)(t + 2) * kstep; const char* b2 = last ? nB : cB + (size_t)(t + 2) * kstep;
            const char* a3 = a2 + kstep; const char* b3 = b2 + kstep;
            PG8_LDB(B0, 0, 0); PG8_LDB(B1, 0, 1); PG8_SCHED; PG8_LDA(At, 0, 0); PG8_STAGE(PG8_SA(1, 1), a1 + hsA, vA1);
            if (last && has_next) { vA0[0] = nA0[0]; vA0[1] = nA0[1]; vA1[0] = nA1[0]; vA1[1] = nA1[1]; }
            PG8_WAIT_V(8); PG8_WAIT_L(0); PG8_BAR; PG8_MMA(0, 0, At, B0); PG8_MMA(0, 1, At, B1); PG8_BAR; PG8_SCHED;
            PG8_LDA(At, 0, 1); PG8_STAGE(PG8_SB(0, 0), b2, voffB); PG8_STAGE(PG8_SB(0, 1), b2 + hstep, voffB); PG8_STAGE(PG8_SA(0, 0), a2, vA0);
            PG8_WAIT_V(8); PG8_WAIT_L(0); PG8_BAR; PG8_MMA(1, 0, At, B0); PG8_MMA(1, 1, At, B1); PG8_BAR; PG8_SCHED;
            PG8_LDB(B0, 1, 0); PG8_LDB(B1, 1, 1); PG8_SCHED; PG8_LDA(At, 1, 0); PG8_STAGE(PG8_SA(0, 1), a2 + hsA, vA1);
            PG8_WAIT_V(8); PG8_WAIT_L(0); PG8_BAR; PG8_MMA(0, 0, At, B0); PG8_MMA(0, 1, At, B1); PG8_BAR; PG8_SCHED;
            PG8_LDA(At, 1, 1); PG8_STAGE(PG8_SB(1, 0), b3, voffB); PG8_STAGE(PG8_SB(1, 1), b3 + hstep, voffB); PG8_STAGE(PG8_SA(1, 0), a3, vA0);
            PG8_WAIT_V(8); PG8_WAIT_L(0); PG8_BAR; PG8_MMA(1, 0, At, B0); PG8_MMA(1, 1, At, B1); PG8_BAR; PG8_SCHED;
        }
        if (wr == 0) PG8_BAR;
        if constexpr (FP8) {
#pragma unroll
            for (int a = 0; a < 2; ++a)
#pragma unroll
                for (int b = 0; b < 2; ++b) asm volatile("s_nop 15" : "+v"(acc[a][b][0][0]), "+v"(acc[a][b][0][1]), "+v"(acc[a][b][1][0]), "+v"(acc[a][b][1][1]), "+v"(acc[a][b][2][0]), "+v"(acc[a][b][2][1]), "+v"(acc[a][b][3][0]), "+v"(acc[a][b][3][1]));
        }
        const bool keep_acc = E(acc, cur, wr, wc, fr, fq);
        if (!has_next) break;
        if (!keep_acc)
#pragma unroll
        for (int a = 0; a < 2; ++a)
#pragma unroll
            for (int b = 0; b < 2; ++b)
#pragma unroll
                for (int m = 0; m < 4; ++m)
#pragma unroll
                    for (int n = 0; n < 2; ++n) acc[a][b][m][n] = (f32x4){0.f, 0.f, 0.f, 0.f};
        cur = nxt; cA = nA; cB = nB;
        if (wr == 1) PG8_BAR;
    }
    PG8_WAIT_V(0);
    PG8_BAR;
#undef PG8_AOFF
#undef PG8_SA
#undef PG8_SB
#undef PG8_STAGE
#undef PG8_LDA
#undef PG8_LDB
#undef PG8_MMA
#undef PG8_LD8
#undef PG8_WAIT_V
#undef PG8_WAIT_L
#undef PG8_BAR
#undef PG8_SCHED
}

struct EpiBf16 {
    static constexpr bool PERM = true;
    bf16_t* O; int ldc; const float* bias; int bias_estride; float ascale; int skip_from, skip_cols;
    __device__ __forceinline__ bool operator()(const f32x4 (&acc)[2][2][4][2], const Unit& u, int wr, int wc, int fr, int fq) const {
        const int row0 = u.pm * BM + wr * 64 + fr; const int col0 = u.pn * BM + wc * 32 + 8 * fq + (u.pn >= skip_from ? skip_cols : 0);
        f32x4 bv[2][2];
#pragma unroll
        for (int bj = 0; bj < 2; ++bj)
#pragma unroll
            for (int n = 0; n < 2; ++n) bv[bj][n] = bias ? *(const f32x4*)(bias + (size_t)u.e * bias_estride + col0 + bj * HALF + 4 * n) : (f32x4){0.f, 0.f, 0.f, 0.f};
#pragma unroll
        for (int ai = 0; ai < 2; ++ai)
#pragma unroll
            for (int m = 0; m < 4; ++m) { bf16_t* rowp = O + (size_t)(row0 + ai * HALF + m * 16) * ldc + col0;
#pragma unroll
                for (int bj = 0; bj < 2; ++bj) { const f32x4 v0 = acc[ai][bj][m][0] * ascale + bv[bj][0], v1 = acc[ai][bj][m][1] * ascale + bv[bj][1];
                    u32x4 w; w.x = cvt_pk_bf16(v0[0], v0[1]); w.y = cvt_pk_bf16(v0[2], v0[3]); w.z = cvt_pk_bf16(v1[0], v1[1]); w.w = cvt_pk_bf16(v1[2], v1[3]);
                    *(u32x4*)(rowp + bj * HALF) = w; } }
        return false;
    }
};
__device__ __forceinline__ float swiglu1(float ug, float ul) {
    ug = fminf(ug, 7.0f); ul = fminf(fmaxf(ul, -7.0f), 7.0f);
    return ug * __builtin_amdgcn_rcpf(1.0f + __expf(-1.702f * ug)) * (ul + 1.0f);
}
struct EpiSwiglu {
    static constexpr bool PERM = true;
    unsigned char* O; const float* b1;
    __device__ __forceinline__ bool operator()(const f32x4 (&acc)[2][2][4][2], const Unit& u, int wr, int wc, int fr, int fq) const {
        const int row0 = u.pm * BM + wr * 64 + fr; const int c0 = u.pn * 128 + wc * 32 + 8 * fq;
        const float* bg = b1 + (size_t)u.e * 4096 + c0; const float* bl = bg + 2048;
        f32x4 bgv[2], blv[2];
#pragma unroll
        for (int n = 0; n < 2; ++n) { bgv[n] = *(const f32x4*)(bg + 4 * n); blv[n] = *(const f32x4*)(bl + 4 * n); }
#pragma unroll
        for (int ai = 0; ai < 2; ++ai)
#pragma unroll
            for (int m = 0; m < 4; ++m) {
                float a[8];
#pragma unroll
                for (int n = 0; n < 2; ++n)
#pragma unroll
                    for (int j = 0; j < 4; ++j) a[4 * n + j] = ACT8_SCALE * swiglu1(acc[ai][0][m][n][j] * (1.0f / W8_SCALE) + bgv[n][j], acc[ai][1][m][n][j] * (1.0f / W8_SCALE) + blv[n][j]);
                u32x2 w; w.x = pack4_fp8(a[0], a[1], a[2], a[3]); w.y = pack4_fp8(a[4], a[5], a[6], a[7]);
                *(u32x2*)(O + (size_t)(row0 + ai * HALF + m * 16) * 2048 + c0) = w;
            }
        return false;
    }
};

struct TwoPartOrder {
    StaticOrder so; Unit held; int part;
    __device__ void init(int M, int N, int G_, int c_) { so.init(M, N, G_, c_); part = 0; }
    __device__ bool next(Unit& u) { if (part == 1) { u = held; u.e = 1; part = 0; return true; } if (!so.next(held)) return false; u = held; u.e = 0; part = 1; return true; }
};
struct EpiGate2 {
    static constexpr bool PERM = true;
    bf16_t* O; const bf16_t* Ga; const bf16_t* Gr;
    __device__ __forceinline__ bool operator()(f32x4 (&acc)[2][2][4][2], const Unit& u, int wr, int wc, int fr, int fq) const {
        const int row0 = u.pm * BM + wr * 64 + fr; const int col0 = u.pn * BM + wc * 32 + 8 * fq;
#pragma unroll
        for (int ai = 0; ai < 2; ++ai)
#pragma unroll
            for (int m = 0; m < 4; ++m) { const size_t row = (size_t)(row0 + ai * HALF + m * 16);
#pragma unroll
                for (int bj = 0; bj < 2; ++bj) { const int c = col0 + bj * HALF;
                    const u32x4 gr = *(const u32x4*)(Gr + row * DINP + c);
                    if (u.e == 0) {
                        const u32x4 ga = *(const u32x4*)(Ga + row * DINP + c);
#pragma unroll
                        for (int q = 0; q < 4; ++q) {
                            const float r0 = (1.0f + __expf(-bf_lo(gr[q]))) * __builtin_amdgcn_rcpf(1.0f + __expf(-bf_lo(ga[q]))), r1 = (1.0f + __expf(-bf_hi(gr[q]))) * __builtin_amdgcn_rcpf(1.0f + __expf(-bf_hi(ga[q])));
                            acc[ai][bj][m][q >> 1][(2 * q) & 3] *= r0; acc[ai][bj][m][q >> 1][(2 * q + 1) & 3] *= r1; }
                    } else {
                        float r[8];
#pragma unroll
                        for (int q = 0; q < 4; ++q) { r[2 * q] = sigmoidf_(bf_lo(gr[q])) * acc[ai][bj][m][q >> 1][(2 * q) & 3]; r[2 * q + 1] = sigmoidf_(bf_hi(gr[q])) * acc[ai][bj][m][q >> 1][(2 * q + 1) & 3]; }
                        u32x4 w; w.x = cvt_pk_bf16(r[0], r[1]); w.y = cvt_pk_bf16(r[2], r[3]); w.z = cvt_pk_bf16(r[4], r[5]); w.w = cvt_pk_bf16(r[6], r[7]);
                        *(u32x4*)(O + row * 2048 + c) = w; } } }
        return u.e == 0;
    }
};
struct EpiDelta {
    static constexpr bool PERM = true;
    const float* gt; bf16_t* DL;
    __device__ __forceinline__ bool operator()(const f32x4 (&acc)[2][2][4][2], const Unit& u, int wr, int wc, int fr, int fq) const {
        const int row0 = u.pm * BM + wr * 64 + fr; const int col0 = u.pn * BM + wc * 32 + 8 * fq;
        f32x4 g[2][2];
#pragma unroll
        for (int bj = 0; bj < 2; ++bj)
#pragma unroll
            for (int n = 0; n < 2; ++n) g[bj][n] = *(const f32x4*)(gt + col0 + bj * HALF + 4 * n);
#pragma unroll
        for (int ai = 0; ai < 2; ++ai)
#pragma unroll
            for (int m = 0; m < 4; ++m) { bf16_t* rowp = DL + (size_t)(row0 + ai * HALF + m * 16) * 2048 + col0;
#pragma unroll
                for (int bj = 0; bj < 2; ++bj) { const f32x4 v0 = acc[ai][bj][m][0] * g[bj][0], v1 = acc[ai][bj][m][1] * g[bj][1];
                    u32x4 w; w.x = cvt_pk_bf16(v0[0], v0[1]); w.y = cvt_pk_bf16(v0[2], v0[3]); w.z = cvt_pk_bf16(v1[0], v1[1]); w.w = cvt_pk_bf16(v1[2], v1[3]);
                    *(u32x4*)(rowp + bj * HALF) = w; } }
        return false;
    }
};
}

struct Args { const void* in[22]; float* out; unsigned char* ws; int ph_lo, ph_hi, flags, pad; };
constexpr int XCONV = 0, XSCORE = 96;
constexpr int CW_SCQ = 12288, SCP = 5;
enum { PH_PRO = 0, PH_H, PH_INPROJ, PH_POST, PH_SCORE, PH_SELECT, PH_ATTN, PH_OP1, PH_OP2, PH_WOUT, PH_ROUTER, PH_SCATTER, PH_MOE1, PH_MOE2, PH_FINAL, NPH };

__device__ __forceinline__ int dest_row(int mode, int n) {
    if (mode == 1) return n < 2640 ? n : n + 176;
    if (mode == 2) { const int g = n >> 11, c = n & 2047; return (c >> 7) * 256 + g * 128 + (c & 127); }
    return n;
}
__device__ __forceinline__ void convert_item(const float* __restrict__ W, int K, int N, int ld, bf16_t* WT, int mode, int item, int lane, LAS unsigned char* scr) {
    const int nblk = (N + 63) >> 6; const int kb = item / nblk, nb = item - kb * nblk; const int k0 = kb * 128, n0 = nb * 64;
    const int c4 = lane & 15, kr = lane >> 4;
    const bool ok = (n0 + 4 * c4) < N;
    const float* src = W + (size_t)(k0 + 2 * kr) * ld + n0 + 4 * c4;
#pragma unroll 4
    for (int i = 0; i < 16; ++i) {
        f32x4 v0 = (f32x4){0.f, 0.f, 0.f, 0.f}, v1 = v0;
        if (ok) { v0 = *(const f32x4*)(src + (size_t)(8 * i) * ld); v1 = *(const f32x4*)(src + (size_t)(8 * i + 1) * ld); }
        const int kk = 8 * i + 2 * kr;
#pragma unroll
        for (int e = 0; e < 4; ++e) *(LAS unsigned*)(scr + (4 * c4 + e) * 272 + kk * 2) = cvt_pk_bf16(v0[e], v1[e]);
    }
    LDS_WAIT(); asm volatile("" ::: "memory");
#pragma unroll 4
    for (int j = 0; j < 16; ++j) {
        const int q = j * 64 + lane, n = q >> 4, ch = q & 15;
        const u32x4 v = *(const LAS u32x4*)(scr + n * 272 + ch * 16);
        if (n0 + n < N) *(u32x4*)(WT + (size_t)dest_row(mode, n0 + n) * K + k0 + ch * 8) = v;
    }
    LDS_WAIT(); asm volatile("" ::: "memory");
}


__device__ __forceinline__ bf16_t f2bf(float f) { unsigned u = __float_as_uint(f); return (bf16_t)((u + 0x7fffu + ((u >> 16) & 1u)) >> 16); }
__device__ __forceinline__ float bfx(const u32x4& w, int i) { const unsigned u = w[i >> 1]; return (i & 1) ? bf_hi(u) : bf_lo(u); }
__device__ __forceinline__ void rope_sc(float pos, float inv, float& sn, float& cs) {
    const float ang = pos * inv;
    const double a = (double)ang; const double n = __builtin_rint(a * 0.15915494309189535); const float r = (float)(a - n * 6.283185307179586);
    sn = sinf(r); cs = cosf(r);
}
__device__ __forceinline__ void post_token(bf16_t* PROJ, bf16_t* KI, unsigned char* KC, unsigned char* VC, const int* positions, const float* kng, const float* knb, int t, int lane) {
    const float pos = (float)positions[t];
    bf16_t* row = PROJ + (size_t)t * DINP;
    float sn, cs;
#pragma unroll
    for (int i = 0; i < 2; ++i) {
        const int pp = lane + 64 * i, hd = pp >> 4, ii = pp & 15;
        rope_sc(pos, powf(500000.0f, -(float)ii * (1.0f / 16.0f)), sn, cs);
        bf16_t* p = row + CQ + hd * 128 + ii; const float a = bf2f(p[0]), b = bf2f(p[16]);
        p[0] = f2bf(a * cs - b * sn); p[16] = f2bf(b * cs + a * sn);
    }
#pragma unroll
    for (int i = 0; i < 2; ++i) {
        const int pp = lane + 64 * i, hd = pp >> 3, ii = pp & 7;
        rope_sc(pos, powf(500000.0f, -(float)ii * (1.0f / 8.0f)), sn, cs);
        bf16_t* p = row + CQI + hd * 64 + ii; const float a = bf2f(p[0]), b = bf2f(p[8]);
        p[0] = f2bf(a * cs - b * sn); p[8] = f2bf(b * cs + a * sn);
    }
    if (lane < 32) {
        const int g = lane >> 4, ii = lane & 15;
        rope_sc(pos, powf(500000.0f, -(float)ii * (1.0f / 16.0f)), sn, cs);
        const bf16_t* p = row + CK + g * 128 + ii; const float a = bf2f(p[0]), b = bf2f(p[16]);
        unsigned char* o = KC + (size_t)t * 256 + g * 128 + ii; o[0] = fp8_1(a * cs - b * sn); o[16] = fp8_1(b * cs + a * sn);
    }
#pragma unroll
    for (int i = 0; i < 3; ++i) { const int idx = lane + 64 * i, g = idx / 96, r = idx - g * 96; KC[(size_t)t * 256 + g * 128 + 32 + r] = fp8_1(bf2f(row[CK + g * 128 + 32 + r])); }
    { const u32x2 w = *(const u32x2*)(row + CV + 4 * lane); *(unsigned*)(VC + (size_t)t * 256 + 4 * lane) = pack4_fp8(bf_lo(w.x), bf_hi(w.x), bf_lo(w.y), bf_hi(w.y)); }
    {
        const float v = bf2f(row[CKI + lane]);
        const float mean = wave_sum(v) * (1.0f / 64.0f); const float d = v - mean; const float var = wave_sum(d * d) * (1.0f / 64.0f);
        const float y = d * rsqrtf(var + NORM_EPS) * kng[lane] + knb[lane];
        const float other = __shfl_xor(y, 8);
        rope_sc(pos, powf(500000.0f, -(float)(lane & 7) * (1.0f / 8.0f)), sn, cs);
        float o = y;
        if (lane < 8) o = y * cs - other * sn; else if (lane < 16) o = y * cs + other * sn;
        KI[(size_t)t * 64 + lane] = f2bf(o);
    }
}

constexpr int HG_GB = 0, HG_Q1 = 33792, HG_Q2 = 51200, HG_K2 = 68608, HG_VT = 86016, HG_PB = 104448, HG_LB = 113664;
__device__ __forceinline__ void hgrn_cumsum(LAS unsigned char* lds, const u32x4& w0, const u32x4& w1, float l0, float l1, int tid) {
    LAS float* GB = (LAS float*)(lds + HG_GB); LAS float* LB = (LAS float*)(lds + HG_LB); LAS float* SEG = (LAS float*)(lds + HG_LB + 512);
    if (tid < 128) LB[tid] = 1.0f / (1.0f + expf(l1 - l0));
    __syncthreads();
    const int t = tid >> 3, dseg = tid & 7;
#pragma unroll
    for (int i = 0; i < 16; ++i) { const float z = i < 8 ? bfx(w0, i) : bfx(w1, i - 8); const float lb = LB[16 * dseg + i]; GB[t * 128 + 16 * dseg + i] = logf(lb + (1.0f - lb) * sigmoidf_(z)); }
    __syncthreads();
    const int d = tid & 127, tq = tid >> 7;
    float z[16];
#pragma unroll
    for (int i = 0; i < 16; ++i) z[i] = GB[(16 * tq + i) * 128 + d];
    float a = 0.f;
#pragma unroll
    for (int i = 0; i < 16; ++i) { a += z[i]; z[i] = a; }
    SEG[tq * 128 + d] = a;
    __syncthreads();
    float pre = 0.f;
    for (int q = 0; q < tq; ++q) pre += SEG[q * 128 + d];
#pragma unroll
    for (int i = 0; i < 16; ++i) GB[(16 * tq + i) * 128 + d] = z[i] + pre;
    __syncthreads();
}
__device__ __forceinline__ void hgrn_vt(LAS unsigned char* lds, const u32x4& a, const u32x4& b, int tid) {
    const int s2 = tid & 31, eg = tid >> 5;
#pragma unroll
    for (int i = 0; i < 8; ++i) { const unsigned lo = (i & 1) ? (a[i >> 1] >> 16) : (a[i >> 1] & 0xffffu), hi = (i & 1) ? (b[i >> 1] >> 16) : (b[i >> 1] & 0xffffu);
        *(LAS unsigned*)(lds + HG_VT + (8 * eg + i) * 144 + s2 * 4) = lo | (hi << 16); }
}
__device__ __forceinline__ void hgrn_l1(LAS unsigned char* lds, const bf16_t* PROJ, const float* lb_logits, float* ST, float* DC, int c, int h, int tid, int wave, int lane) {
    const int t = tid >> 3, dseg = tid & 7, s2 = tid & 31, dg = tid >> 5;
    const bf16_t* pf = PROJ + (size_t)(c * 64 + t) * DINP + CHF + h * 128 + 16 * dseg;
    const bf16_t* pk = PROJ + (size_t)(c * 64 + 2 * s2) * DINP + CHF + h * 128 + 8 * dg;
    const u32x4 w0 = *(const u32x4*)pf, w1 = *(const u32x4*)(pf + 8);
    const u32x4 ka = *(const u32x4*)pk, kb = *(const u32x4*)(pk + DINP);
    const u32x4 va = *(const u32x4*)(pk - CHF + CHI), vb = *(const u32x4*)(pk - CHF + CHI + DINP);
    const float l0 = lb_logits[h * 128 + (tid & 127)], l1 = lb_logits[1024 + h * 128 + (tid & 127)];
    hgrn_cumsum(lds, w0, w1, l0, l1, tid);
    const LAS float* GB = (const LAS float*)(lds + HG_GB); const LAS float* LB = (const LAS float*)(lds + HG_LB);
    {
#pragma unroll
        for (int i = 0; i < 8; ++i) { const int d = 8 * dg + i; const float lb = LB[d], b63 = GB[63 * 128 + d];
            const float k0 = (1.0f - lb) * (1.0f - sigmoidf_(bfx(ka, i))), k1 = (1.0f - lb) * (1.0f - sigmoidf_(bfx(kb, i)));
            const float v0 = k0 * __expf(b63 - GB[(2 * s2) * 128 + d]), v1 = k1 * __expf(b63 - GB[(2 * s2 + 1) * 128 + d]);
            *(LAS unsigned*)(lds + HG_Q1 + d * 144 + s2 * 4) = cvt_pk_bf16(v0, v1); }
    }
    hgrn_vt(lds, va, vb, tid);
    __syncthreads();
    const int fr = lane & 15, fq = lane >> 4;
    bf16x8 af[2];
#pragma unroll
    for (int ks = 0; ks < 2; ++ks) af[ks] = *(const LAS bf16x8*)(lds + HG_VT + (16 * wave + fr) * 144 + (32 * ks + 8 * fq) * 2);
    float* dst = ST + ((size_t)(c * 8 + h) * 128) * 128;
#pragma unroll 2
    for (int dt = 0; dt < 8; ++dt) {
        f32x4 acc = (f32x4){0.f, 0.f, 0.f, 0.f};
#pragma unroll
        for (int ks = 0; ks < 2; ++ks) { const bf16x8 bfr = *(const LAS bf16x8*)(lds + HG_Q1 + (16 * dt + fr) * 144 + (32 * ks + 8 * fq) * 2); acc = __builtin_amdgcn_mfma_f32_16x16x32_bf16(af[ks], bfr, acc, 0, 0, 0); }
#pragma unroll
        for (int r = 0; r < 4; ++r) dst[(size_t)(16 * wave + 4 * fq + r) * 128 + 16 * dt + fr] = acc[r];
    }
    if (tid < 128) DC[(size_t)(c * 8 + h) * 128 + tid] = __expf(GB[63 * 128 + tid]);
    __syncthreads();
}
__device__ __forceinline__ void hgrn_l3(LAS unsigned char* lds, const bf16_t* PROJ, const float* lb_logits, const float* ST, const float* norm_g, bf16_t* REC, int c, int h, int tid, int wave, int lane) {
    const int t = tid >> 3, dseg = tid & 7, s2 = tid & 31, eg = tid >> 5, fr = lane & 15, fq = lane >> 4;
    const bf16_t* pf = PROJ + (size_t)(c * 64 + t) * DINP + CHF + h * 128 + 16 * dseg;
    const u32x4 f0 = *(const u32x4*)pf, f1 = *(const u32x4*)(pf + 8), q0 = *(const u32x4*)(pf - CHF + CHQ), q1 = *(const u32x4*)(pf - CHF + CHQ + 8);
    const u32x4 g0 = *(const u32x4*)(pf - CHF + CHG), g1 = *(const u32x4*)(pf - CHF + CHG + 8);
    const bf16_t* pv = PROJ + (size_t)(c * 64 + 2 * s2) * DINP + CHI + h * 128 + 8 * eg;
    const u32x4 va = *(const u32x4*)pv, vb = *(const u32x4*)(pv + DINP);
    const float* sp = ST + ((size_t)(c * 8 + h) * 128 + 16 * wave + fr) * 128 + 8 * fq;
    f32x4 sx[4][2];
#pragma unroll
    for (int ks = 0; ks < 4; ++ks) { sx[ks][0] = *(const f32x4*)(sp + 32 * ks); sx[ks][1] = *(const f32x4*)(sp + 32 * ks + 4); }
    const float l0 = lb_logits[h * 128 + (tid & 127)], l1 = lb_logits[1024 + h * 128 + (tid & 127)];
    hgrn_cumsum(lds, f0, f1, l0, l1, tid);
    const LAS float* GB = (const LAS float*)(lds + HG_GB); const LAS float* LB = (const LAS float*)(lds + HG_LB);
    {
        unsigned o1[8], o2[8], o3[8];
#pragma unroll
        for (int i = 0; i < 16; i += 2) {
            float a1[2], a2[2], a3[2];
#pragma unroll
            for (int j = 0; j < 2; ++j) { const int d = 16 * dseg + i + j; const float lb = LB[d], b = GB[t * 128 + d], br = GB[31 * 128 + d];
                const float z = (i + j) < 8 ? bfx(f0, i + j) : bfx(f1, i + j - 8), qv = (i + j) < 8 ? bfx(q0, i + j) : bfx(q1, i + j - 8);
                const float k = (1.0f - lb) * (1.0f - sigmoidf_(z)), q = siluf_(qv);
                a1[j] = q * __expf(b); a2[j] = q * __expf(b - br); a3[j] = k * __expf(br - b); }
            o1[i >> 1] = cvt_pk_bf16(a1[0], a1[1]); o2[i >> 1] = cvt_pk_bf16(a2[0], a2[1]); o3[i >> 1] = cvt_pk_bf16(a3[0], a3[1]);
        }
        LAS u32x4* d1 = (LAS u32x4*)(lds + HG_Q1 + t * 272 + dseg * 32); LAS u32x4* d2 = (LAS u32x4*)(lds + HG_Q2 + t * 272 + dseg * 32); LAS u32x4* d3 = (LAS u32x4*)(lds + HG_K2 + t * 272 + dseg * 32);
        d1[0] = (u32x4){o1[0], o1[1], o1[2], o1[3]}; d1[1] = (u32x4){o1[4], o1[5], o1[6], o1[7]};
        d2[0] = (u32x4){o2[0], o2[1], o2[2], o2[3]}; d2[1] = (u32x4){o2[4], o2[5], o2[6], o2[7]};
        d3[0] = (u32x4){o3[0], o3[1], o3[2], o3[3]}; d3[1] = (u32x4){o3[4], o3[5], o3[6], o3[7]};
    }
    hgrn_vt(lds, va, vb, tid);
    __syncthreads();
#pragma unroll
    for (int q = 0; q < 2; ++q) {
        const int tile = 2 * wave + q, tt = tile >> 2, stl = tile & 3;
        f32x4 acc = (f32x4){0.f, 0.f, 0.f, 0.f};
#pragma unroll
        for (int ks = 0; ks < 4; ++ks) { const bf16x8 a = *(const LAS bf16x8*)(lds + HG_Q2 + (16 * tt + fr) * 272 + (32 * ks + 8 * fq) * 2), b = *(const LAS bf16x8*)(lds + HG_K2 + (16 * stl + fr) * 272 + (32 * ks + 8 * fq) * 2);
            acc = __builtin_amdgcn_mfma_f32_16x16x32_bf16(a, b, acc, 0, 0, 0); }
#pragma unroll
        for (int r = 0; r < 4; ++r) { const int tr_ = 16 * tt + 4 * fq + r, s = 16 * stl + fr; *(LAS bf16_t*)(lds + HG_PB + tr_ * 144 + s * 2) = f2bf(s <= tr_ ? acc[r] : 0.f); }
    }
    __syncthreads();
    {
        bf16x8 b1[2], b2[4];
#pragma unroll
        for (int ks = 0; ks < 2; ++ks) b1[ks] = *(const LAS bf16x8*)(lds + HG_VT + (16 * wave + fr) * 144 + (32 * ks + 8 * fq) * 2);
#pragma unroll
        for (int ks = 0; ks < 4; ++ks) { const f32x4 x0 = sx[ks][0], x1 = sx[ks][1];
            u32x4 w; w.x = cvt_pk_bf16(x0[0], x0[1]); w.y = cvt_pk_bf16(x0[2], x0[3]); w.z = cvt_pk_bf16(x1[0], x1[1]); w.w = cvt_pk_bf16(x1[2], x1[3]); b2[ks] = __builtin_bit_cast(bf16x8, w); }
        LAS float* OB = (LAS float*)(lds + HG_GB);
#pragma unroll
        for (int tt = 0; tt < 4; ++tt) {
            f32x4 acc = (f32x4){0.f, 0.f, 0.f, 0.f};
#pragma unroll
            for (int ks = 0; ks < 2; ++ks) { const bf16x8 a = *(const LAS bf16x8*)(lds + HG_PB + (16 * tt + fr) * 144 + (32 * ks + 8 * fq) * 2); acc = __builtin_amdgcn_mfma_f32_16x16x32_bf16(a, b1[ks], acc, 0, 0, 0); }
#pragma unroll
            for (int ks = 0; ks < 4; ++ks) { const bf16x8 a = *(const LAS bf16x8*)(lds + HG_Q1 + (16 * tt + fr) * 272 + (32 * ks + 8 * fq) * 2); acc = __builtin_amdgcn_mfma_f32_16x16x32_bf16(a, b2[ks], acc, 0, 0, 0); }
#pragma unroll
            for (int r = 0; r < 4; ++r) OB[(16 * tt + 4 * fq + r) * 132 + 16 * wave + fr] = acc[r];
        }
    }
    __syncthreads();
    {
        const int es = dseg; const LAS float* OB = (const LAS float*)(lds + HG_GB);
        float o[16]; float ss = 0.f;
#pragma unroll
        for (int i = 0; i < 16; ++i) { o[i] = OB[t * 132 + 16 * es + i]; ss += o[i] * o[i]; }
        ss += __shfl_xor(ss, 1); ss += __shfl_xor(ss, 2); ss += __shfl_xor(ss, 4);
        const float rstd = rsqrtf(ss * (1.0f / 128.0f) + NORM_EPS);
        unsigned w[8];
#pragma unroll
        for (int i = 0; i < 16; i += 2) { const float ga = i < 8 ? bfx(g0, i) : bfx(g1, i - 8), gb = (i + 1) < 8 ? bfx(g0, i + 1) : bfx(g1, i + 1 - 8);
            w[i >> 1] = cvt_pk_bf16(o[i] * rstd * norm_g[16 * es + i] * siluf_(ga), o[i + 1] * rstd * norm_g[16 * es + i + 1] * siluf_(gb)); }
        u32x4* dst = (u32x4*)(REC + (size_t)(c * 64 + t) * 1024 + h * 128 + 16 * es);
        dst[0] = (u32x4){w[0], w[1], w[2], w[3]}; dst[1] = (u32x4){w[4], w[5], w[6], w[7]};
    }
    __syncthreads();
}

constexpr int SC_KT = 0, SC_SB = 36864, SC_SPITCH = 132;
__device__ __forceinline__ unsigned pk_f16(float a, float b) { return __builtin_bit_cast(unsigned, __builtin_amdgcn_cvt_pkrtz(a, b)); }
__device__ __forceinline__ void score_flush(LAS unsigned char* lds, unsigned short* SCORES, unsigned short* SEGMAX, int t0, int kt, int tid) {
    const LAS float* sb = (const LAS float*)(lds + SC_SB + (kt & 1) * (32 * SC_SPITCH * 4));
    const int row = tid >> 4, seg = tid & 15;
    const f32x4 a = *(const LAS f32x4*)(sb + row * SC_SPITCH + seg * 8), b = *(const LAS f32x4*)(sb + row * SC_SPITCH + seg * 8 + 4);
    unsigned short* dst = SCORES + (size_t)(t0 + row) * S + kt * 128 + seg * 8;
    *(u32x4*)dst = (u32x4){pk_f16(a[0], a[1]), pk_f16(a[2], a[3]), pk_f16(b[0], b[1]), pk_f16(b[2], b[3])};
    const float mx = fmaxf(fmaxf(fmaxf(a[0], a[1]), fmaxf(a[2], a[3])), fmaxf(fmaxf(b[0], b[1]), fmaxf(b[2], b[3])));
    SEGMAX[(size_t)(t0 + row) * 2048 + kt * 16 + seg] = (unsigned short)(pk_f16(mx, mx) & 0xffffu);
}
__device__ __forceinline__ void score_block(LAS unsigned char* lds, const bf16_t* PROJ, const bf16_t* KI, unsigned short* SCORES, unsigned short* SEGMAX, int qb, int kt0, int kt1, int tid, int wave, int lane) {
    const int t0 = qb * 32;
    const int r = lane & 31, hh = lane >> 5;
    bf16x8 Af[2][4]; float wv[2][16]; f32x2 wv2[2][8];
#pragma unroll
    for (int p = 0; p < 2; ++p) {
        const int tq = t0 + 4 * wave + 2 * p + (r >> 4); const bf16_t* qrow = PROJ + (size_t)tq * DINP + CQI + (r & 15) * 64 + 8 * hh;
#pragma unroll
        for (int ks = 0; ks < 4; ++ks) Af[p][ks] = *(const bf16x8*)(qrow + 16 * ks);
#pragma unroll
        for (int reg = 0; reg < 16; ++reg) { const int row = (reg & 3) + 8 * (reg >> 2) + 4 * hh; const int tw = t0 + 4 * wave + 2 * p + (row >> 4);
            wv[p][reg] = bf2f(PROJ[(size_t)tw * DINP + CWI + (row & 15)]) * (1.0f / 32.0f); }
#pragma unroll
        for (int i = 0; i < 8; ++i) wv2[p][i] = (f32x2){wv[p][2 * i], wv[p][2 * i + 1]};
    }
    const u32x2 tagsw = __builtin_amdgcn_permlane32_swap(0u, 1u, false, false); const int qsel = (int)tagsw[0];
    u32x4 stg[2];
#pragma unroll
    for (int i = 0; i < 2; ++i) { const int q = tid + 512 * i; stg[i] = *(const u32x4*)(KI + (size_t)(kt0 * 128 + (q >> 3)) * 64 + (q & 7) * 8); }
#pragma unroll
    for (int i = 0; i < 2; ++i) { const int q = tid + 512 * i; *(LAS u32x4*)(lds + SC_KT + (kt0 & 1) * 18432 + (q >> 3) * 144 + (q & 7) * 16) = stg[i]; }
    __syncthreads();
    for (int kt = kt0; kt < kt1; ++kt) {
        const LAS unsigned char* buf = lds + SC_KT + (kt & 1) * 18432;
        LAS float* sb = (LAS float*)(lds + SC_SB + (kt & 1) * (32 * SC_SPITCH * 4));
        if (kt + 1 < kt1) {
#pragma unroll
            for (int i = 0; i < 2; ++i) { const int q = tid + 512 * i; stg[i] = *(const u32x4*)(KI + (size_t)((kt + 1) * 128 + (q >> 3)) * 64 + (q & 7) * 8); }
        }
        __builtin_amdgcn_sched_barrier(0);
        if (kt > kt0) score_flush(lds, SCORES, SEGMAX, t0, kt - 1, tid);
        {
        f32x16 accP[2], accC[2];
#define SC_MFMA(cb) do { bf16x8 Bf[4]; _Pragma("unroll") for (int ks = 0; ks < 4; ++ks) Bf[ks] = *(const LAS bf16x8*)(buf + (32 * (cb) + r) * 144 + (16 * ks + 8 * hh) * 2); \
            _Pragma("unroll") for (int p = 0; p < 2; ++p) { _Pragma("unroll") for (int i = 0; i < 16; ++i) accC[p][i] = 0.f; \
                _Pragma("unroll") for (int ks = 0; ks < 4; ++ks) accC[p] = __builtin_amdgcn_mfma_f32_32x32x16_bf16(Af[p][ks], Bf[ks], accC[p], 0, 0, 0); } } while (0)
#define SC_RED(acc, cb) do { _Pragma("unroll") for (int p = 0; p < 2; ++p) { f32x2 s0 = {0.f, 0.f}, s1 = {0.f, 0.f}; \
            _Pragma("unroll") for (int reg = 0; reg < 8; reg += 2) { const f32x2 r0 = {relu_i(acc[p][reg]), relu_i(acc[p][reg + 1])}; const f32x2 r1 = {relu_i(acc[p][reg + 8]), relu_i(acc[p][reg + 9])}; \
                s0 = __builtin_elementwise_fma(wv2[p][reg >> 1], r0, s0); s1 = __builtin_elementwise_fma(wv2[p][4 + (reg >> 1)], r1, s1); } \
            const float p0 = s0[0] + s0[1], p1 = s1[0] + s1[1]; \
            const u32x2 sw = __builtin_amdgcn_permlane32_swap(__float_as_uint(p0), __float_as_uint(p1), false, false); \
            sb[(4 * wave + 2 * p + qsel) * SC_SPITCH + 32 * (cb) + r] = __uint_as_float(sw[0]) + __uint_as_float(sw[1]); } } while (0)
#define SC_INTERLEAVE() do { _Pragma("unroll") for (int i = 0; i < 8; ++i) { __builtin_amdgcn_sched_group_barrier(0x008, 1, 0); __builtin_amdgcn_sched_group_barrier(0x002, 8, 0); } } while (0)
        SC_MFMA(0);
        accP[0] = accC[0]; accP[1] = accC[1]; SC_MFMA(1); SC_RED(accP, 0); SC_INTERLEAVE();
        accP[0] = accC[0]; accP[1] = accC[1]; SC_MFMA(2); SC_RED(accP, 1); SC_INTERLEAVE();
        accP[0] = accC[0]; accP[1] = accC[1]; SC_MFMA(3); SC_RED(accP, 2); SC_INTERLEAVE();
        SC_RED(accC, 3);
#undef SC_MFMA
#undef SC_RED
#undef SC_INTERLEAVE
        }
        if (kt + 1 < kt1) {
#pragma unroll
            for (int i = 0; i < 2; ++i) { const int q = tid + 512 * i; *(LAS u32x4*)(lds + SC_KT + ((kt + 1) & 1) * 18432 + (q >> 3) * 144 + (q & 7) * 16) = stg[i]; }
        }
        __syncthreads();
    }
    score_flush(lds, SCORES, SEGMAX, t0, kt1 - 1, tid);
    __syncthreads();
}

__device__ __forceinline__ float wave_kth16(const float (&v)[16], int K) {
    const float NINF = -__builtin_inff();
    float mx = NINF, mn = __builtin_inff();
#pragma unroll
    for (int j = 0; j < 16; ++j) { mx = fmaxf(mx, v[j]); mn = fminf(mn, v[j] == NINF ? __builtin_inff() : v[j]); }
    mx = wave_max(mx); mn = -wave_max(-mn);
    int c = 0;
#pragma unroll
    for (int j = 0; j < 16; ++j) c += __popcll(__ballot(v[j] >= mx));
    if (c >= K) return mx;
    float lo = mn, hi = mx, tau = mn;
    for (int it = 0; it < 64; ++it) {
        const float mid = 0.5f * (lo + hi);
        if (!(mid > lo && mid < hi)) { tau = lo; break; }
        c = 0;
#pragma unroll
        for (int j = 0; j < 16; ++j) c += __popcll(__ballot(v[j] >= mid));
        if (c == K) { tau = mid; break; }
        if (c > K) lo = mid; else hi = mid;
        tau = lo;
    }
    return tau;
}
__device__ __forceinline__ int lanes_below(unsigned long long mask) { return (int)__builtin_amdgcn_mbcnt_hi((unsigned)(mask >> 32), __builtin_amdgcn_mbcnt_lo((unsigned)mask, 0u)); }
__device__ __forceinline__ float h2f(unsigned short h) { return (float)__builtin_bit_cast(_Float16, h); }
__device__ __forceinline__ float h2f_lo(unsigned u) { return h2f((unsigned short)(u & 0xffffu)); }
__device__ __forceinline__ float h2f_hi(unsigned u) { return h2f((unsigned short)(u >> 16)); }
__device__ __forceinline__ unsigned ge_mask8(const u32x4& v, unsigned T16) {
    unsigned m8 = 0;
#pragma unroll
    for (int w = 0; w < 4; ++w) { const unsigned vw_ = v[w];
        const s16x2 d = __builtin_elementwise_sub_sat(__builtin_bit_cast(s16x2, vw_), __builtin_bit_cast(s16x2, T16));
        const unsigned mm = ~__builtin_bit_cast(unsigned, d); m8 |= (((mm >> 15) & 1u) | ((mm >> 30) & 2u)) << (2 * w); }
    return m8;
}
__device__ __forceinline__ int append_bits(LAS int* list, int cnt, unsigned m8, int base) {
    for (;;) { const bool has = m8 != 0u; const unsigned long long mask = __ballot(has); if (!mask) break;
        const int pos = cnt + lanes_below(mask);
        if (has) { const int k = __builtin_ctz(m8); m8 &= m8 - 1u; if (pos < 1024) list[pos] = base + k; }
        cnt += __popcll(mask); }
    return cnt;
}
__device__ __forceinline__ void select_row(LAS unsigned char* wl, const unsigned short* SCORES, const unsigned short* SEGMAX, int t, int lane) {
    LAS int* selw = (LAS int*)wl; LAS int* segl = (LAS int*)(wl + 1024); LAS int* cidx = (LAS int*)(wl + 5120);
    const float NINF = -__builtin_inff();
    const unsigned short* row = SCORES + (size_t)t * S; const int n = t + 1;
    float c[16]; int N;
    if (n <= 1024) {
#pragma unroll
        for (int j = 0; j < 16; ++j) { const int i = lane + 64 * j; c[j] = i < n ? h2f(row[i]) : NINF; }
        N = -1;
    } else {
        const int m = n >> 4; float s[16];
#pragma unroll
        for (int j = 0; j < 16; ++j) { const int i = lane + 64 * j; s[j] = i < m ? h2f(row[16 * i + 7]) : NINF; }
        int K = 32, cnt = 0;
        for (;;) {
            const float tlo = (K >= m) ? NINF : wave_kth16(s, K);
            cnt = 0;
            const int nq = (n + 511) >> 9;
            if (tlo > 0.f) {
                const unsigned T16 = pk_f16(tlo, tlo);
                const u32x4 NEG = (u32x4){0xfc00fc00u, 0xfc00fc00u, 0xfc00fc00u, 0xfc00fc00u};
                const unsigned short* smrow = SEGMAX + (size_t)t * 2048; const int nseg = (t >> 3) + 1;
                int ns = 0;
                {
                    u32x4 sv[4];
#pragma unroll
                    for (int u = 0; u < 4; ++u) { const int e8 = 8 * (lane + 64 * u); sv[u] = (e8 < nseg) ? *(const u32x4*)(smrow + e8) : NEG; }
#pragma unroll
                    for (int u = 0; u < 4; ++u) { const int e8 = 8 * (lane + 64 * u); unsigned m8 = ge_mask8(sv[u], T16);
                        const int nv = nseg - e8; if (nv < 8) m8 &= nv > 0 ? ((1u << nv) - 1u) : 0u;
                        ns = append_bits(segl, ns, m8, e8); }
                }
                if (ns > 1024) ns = 1024;
                for (int j0 = 0; j0 < ns; j0 += 256) {
                    u32x4 v[4]; int sg[4];
#pragma unroll
                    for (int u = 0; u < 4; ++u) { const int i = j0 + lane + 64 * u; sg[u] = i < ns ? segl[i] : -1; v[u] = sg[u] >= 0 ? *(const u32x4*)(row + 8 * sg[u]) : NEG; }
#pragma unroll
                    for (int u = 0; u < 4; ++u) { const int e = 8 * sg[u]; unsigned m8 = sg[u] >= 0 ? ge_mask8(v[u], T16) : 0u;
                        const int nv = t + 1 - e; if (nv < 8) m8 &= nv > 0 ? ((1u << nv) - 1u) : 0u;
                        cnt = append_bits(cidx, cnt, m8, e); }
                }
            } else {
                for (int q0 = 0; q0 < nq; q0 += 4) {
                    u32x4 v[4];
#pragma unroll
                    for (int u = 0; u < 4; ++u) { const int e = 8 * (lane + 64 * (q0 + u)); v[u] = (e <= t) ? *(const u32x4*)(row + e) : (u32x4){0xfc00fc00u, 0xfc00fc00u, 0xfc00fc00u, 0xfc00fc00u}; }
#pragma unroll
                    for (int u = 0; u < 4; ++u) { const int e = 8 * (lane + 64 * (q0 + u));
#pragma unroll
                        for (int k = 0; k < 8; ++k) { const float x = (k & 1) ? h2f_hi(v[u][k >> 1]) : h2f_lo(v[u][k >> 1]);
                            const bool pred = (e + k <= t) && (x >= tlo); const unsigned long long mask = __ballot(pred);
                            if (mask) { const int pos = cnt + lanes_below(mask); if (pred && pos < 1024) cidx[pos] = e + k; cnt += __popcll(mask); } } }
                }
            }
            if (cnt >= 256 || K >= m) break;
            K *= 2;
        }
        N = cnt < 1024 ? cnt : 1024;
#pragma unroll
        for (int j = 0; j < 16; ++j) { const int i = lane + 64 * j; c[j] = i < N ? h2f(row[cidx[i]]) : NINF; }
    }
    const float tau = wave_kth16(c, 256);
    int base = 0;
#pragma unroll
    for (int j = 0; j < 16; ++j) { const bool pred = c[j] >= tau; const unsigned long long mask = __ballot(pred);
        if (mask) { const int pos = base + lanes_below(mask); if (pred && pos < 256) selw[pos] = (N < 0) ? (lane + 64 * j) : cidx[lane + 64 * j]; base += __popcll(mask); } }
}

__device__ __forceinline__ void attn_query(LAS unsigned char* wl, const bf16_t* PROJ, const unsigned char* KC, const unsigned char* VC, bf16_t* ATT, int t, int lane) {
    LAS int* selw = (LAS int*)wl; LAS float* L = (LAS float*)(wl + 1024);
    const int nsel = t < 255 ? t + 1 : 256;
    const int fr = lane & 15, fq = lane >> 4;
    bf16x8 qf[2][4];
#pragma unroll
    for (int g = 0; g < 2; ++g)
#pragma unroll
        for (int ks = 0; ks < 4; ++ks) { const bf16x8 z = {0, 0, 0, 0, 0, 0, 0, 0}; qf[g][ks] = fr < 4 ? *(const bf16x8*)(PROJ + (size_t)t * DINP + CQ + (4 * g + fr) * 128 + 64 * (ks >> 1) + 16 * fq + 8 * (ks & 1)) : z; }
    const float scale = 0.08838834764831845f;
    const int nkt = (nsel + 15) >> 4;
    {
        LAS unsigned char* KT = wl + 9216;
        const int q4_ = lane >> 4, l15_ = lane & 15;
        u32x4 kw[3][4];
#define QK_LOAD(buf, kt) do { _Pragma("unroll") for (int u = 0; u < 4; ++u) { const unsigned off_ = (unsigned)selw[16 * (kt) + 4 * u + q4_] * 256u + 16u * (unsigned)l15_; kw[buf][u] = *(const u32x4*)((const char*)KC + off_); } } while (0)
#define QK_COMP(buf, kt) do { _Pragma("unroll") for (int u = 0; u < 4; ++u) { u32x4 lo_, hi_; fp8x16_to_bf16(kw[buf][u], lo_, hi_); LAS u32x4* d_ = (LAS u32x4*)(KT + (4 * u + q4_) * 528 + 32 * l15_); d_[0] = lo_; d_[1] = hi_; } \
        _Pragma("unroll") for (int g = 0; g < 2; ++g) { f32x4 acc = (f32x4){0.f, 0.f, 0.f, 0.f}; \
            _Pragma("unroll") for (int ks = 0; ks < 4; ++ks) { const bf16x8 kf_ = *(const LAS bf16x8*)(KT + fr * 528 + g * 256 + (64 * (ks >> 1) + 16 * fq + 8 * (ks & 1)) * 2); \
                acc = __builtin_amdgcn_mfma_f32_16x16x32_bf16(qf[g][ks], kf_, acc, 0, 0, 0); } \
            if (fq == 0) { _Pragma("unroll") for (int r = 0; r < 4; ++r) L[(4 * g + r) * 256 + 16 * (kt) + fr] = (16 * (kt) + fr < nsel) ? acc[r] * scale : -__builtin_inff(); } } } while (0)
        QK_LOAD(0, 0); if (1 < nkt) QK_LOAD(1, 1);
        for (int kt = 0; kt < nkt; kt += 3) {
            if (kt + 2 < nkt) QK_LOAD(2, kt + 2);
            __builtin_amdgcn_sched_barrier(0);
            QK_COMP(0, kt);
            if (kt + 1 < nkt) { if (kt + 3 < nkt) QK_LOAD(0, kt + 3); __builtin_amdgcn_sched_barrier(0); QK_COMP(1, kt + 1); }
            if (kt + 2 < nkt) { if (kt + 4 < nkt) QK_LOAD(1, kt + 4); __builtin_amdgcn_sched_barrier(0); QK_COMP(2, kt + 2); }
        }
#undef QK_LOAD
#undef QK_COMP
        if (fq == 0) { for (int kt = nkt; kt < 16; ++kt) {
#pragma unroll
            for (int r = 0; r < 8; ++r) L[r * 256 + 16 * kt + fr] = -__builtin_inff(); } }
    }
    float p[8][4];
#pragma unroll
    for (int hd = 0; hd < 8; ++hd) { float m = -__builtin_inff();
#pragma unroll
        for (int i = 0; i < 4; ++i) { p[hd][i] = L[hd * 256 + lane + 64 * i]; m = fmaxf(m, p[hd][i]); }
        m = wave_max(m); float s = 0.f;
#pragma unroll
        for (int i = 0; i < 4; ++i) { p[hd][i] = __expf(p[hd][i] - m); s += p[hd][i]; }
        s = 1.0f / wave_sum(s);
#pragma unroll
        for (int i = 0; i < 4; ++i) p[hd][i] *= s; }
    LAS bf16_t* Pb = (LAS bf16_t*)(wl + 1024);
#pragma unroll
    for (int hd = 0; hd < 8; ++hd)
#pragma unroll
        for (int i = 0; i < 4; ++i) Pb[hd * 256 + lane + 64 * i] = f2bf(p[hd][i]);
    LAS unsigned char* VT = wl + 9216;
    const int ii = lane & 15, kq = lane >> 4;
    f32x4 acc[16];
#pragma unroll
    for (int nt = 0; nt < 16; ++nt) acc[nt] = (f32x4){0.f, 0.f, 0.f, 0.f};
    const int nch = (nsel + 15) >> 4;
    u32x4 vw[3][4];
#define PV_LOAD(buf, c) do { _Pragma("unroll") for (int u = 0; u < 4; ++u) { const unsigned off_ = (unsigned)selw[16 * (c) + 4 * u + kq] * 256u + 16u * (unsigned)ii; vw[buf][u] = *(const u32x4*)((const char*)VC + off_); } } while (0)
#define PV_COMP(buf, c) do { _Pragma("unroll") for (int u = 0; u < 4; ++u) { u32x4 lo_, hi_; fp8x16_to_bf16(vw[buf][u], lo_, hi_); LAS u32x4* d_ = (LAS u32x4*)(VT + (4 * u + kq) * 528 + 32 * ii); d_[0] = lo_; d_[1] = hi_; } \
        s16x4 pa[2]; _Pragma("unroll") for (int g = 0; g < 2; ++g) { const s16x4 r_ = *(const LAS s16x4*)(Pb + (g * 4 + (ii & 3)) * 256 + 16 * (c) + 4 * kq); pa[g] = ii < 4 ? r_ : (s16x4){0, 0, 0, 0}; } \
        _Pragma("unroll") for (int nt = 0; nt < 16; ++nt) { const s16x4 b_ = __builtin_amdgcn_ds_read_tr16_b64_v4i16((LAS s16x4*)(VT + (4 * kq + (ii >> 2)) * 528 + (16 * nt + 4 * (ii & 3)) * 2)); \
            acc[nt] = __builtin_amdgcn_mfma_f32_16x16x16bf16_1k(pa[nt >> 3], b_, acc[nt], 0, 0, 0); } } while (0)
    PV_LOAD(0, 0); if (1 < nch) PV_LOAD(1, 1);
    for (int c = 0; c < nch; c += 3) {
        if (c + 2 < nch) PV_LOAD(2, c + 2);
        __builtin_amdgcn_sched_barrier(0);
        PV_COMP(0, c);
        if (c + 1 < nch) { if (c + 3 < nch) PV_LOAD(0, c + 3); __builtin_amdgcn_sched_barrier(0); PV_COMP(1, c + 1); }
        if (c + 2 < nch) { if (c + 4 < nch) PV_LOAD(1, c + 4); __builtin_amdgcn_sched_barrier(0); PV_COMP(2, c + 2); }
    }
#undef PV_LOAD
#undef PV_COMP
    LAS float* OB = (LAS float*)(wl + 1024 + 4096);
    if (kq == 0) {
#pragma unroll
        for (int nt = 0; nt < 16; ++nt)
#pragma unroll
            for (int r = 0; r < 4; ++r) OB[(4 * (nt >> 3) + r) * 128 + 16 * (nt & 7) + ii] = acc[nt][r];
    }
    {
        const f32x4 a0 = *(const LAS f32x4*)(OB + 16 * lane), a1 = *(const LAS f32x4*)(OB + 16 * lane + 4), a2 = *(const LAS f32x4*)(OB + 16 * lane + 8), a3 = *(const LAS f32x4*)(OB + 16 * lane + 12);
        u32x4 w0, w1; w0.x = cvt_pk_bf16(a0[0], a0[1]); w0.y = cvt_pk_bf16(a0[2], a0[3]); w0.z = cvt_pk_bf16(a1[0], a1[1]); w0.w = cvt_pk_bf16(a1[2], a1[3]);
        w1.x = cvt_pk_bf16(a2[0], a2[1]); w1.y = cvt_pk_bf16(a2[2], a2[3]); w1.z = cvt_pk_bf16(a3[0], a3[1]); w1.w = cvt_pk_bf16(a3[2], a3[3]);
        u32x4* dst = (u32x4*)(ATT + (size_t)t * 1024 + 16 * lane); dst[0] = w0; dst[1] = w1;
    }
}


__device__ __forceinline__ void convert_item8(const float* __restrict__ W, int K, int N, int ld, unsigned char* WT, int mode, int item, int lane, LAS unsigned char* scr) {
    const int nblk = N >> 6; const int kb = item / nblk, nb = item - kb * nblk; const int k0 = kb * 256, n0 = nb * 64;
    const int c4 = lane & 15, kr = lane >> 4;
    const float* src = W + (size_t)(k0 + 4 * kr) * ld + n0 + 4 * c4;
#pragma unroll 4
    for (int i = 0; i < 16; ++i) {
        f32x4 v[4];
#pragma unroll
        for (int r = 0; r < 4; ++r) v[r] = __builtin_nontemporal_load((const f32x4*)(src + (size_t)(16 * i + r) * ld));
        const int kk = 16 * i + 4 * kr;
#pragma unroll
        for (int e = 0; e < 4; ++e) *(LAS unsigned*)(scr + (4 * c4 + e) * 272 + kk) = pack4_fp8(v[0][e] * W8_SCALE, v[1][e] * W8_SCALE, v[2][e] * W8_SCALE, v[3][e] * W8_SCALE);
    }
    LDS_WAIT(); asm volatile("" ::: "memory");
#pragma unroll 4
    for (int j = 0; j < 16; ++j) {
        const int q = j * 64 + lane, n = q >> 4, ch = q & 15;
        const u32x4 v = *(const LAS u32x4*)(scr + n * 272 + ch * 16);
        *(u32x4*)(WT + (size_t)dest_row(mode, n0 + n) * K + k0 + ch * 16) = v;
    }
    LDS_WAIT(); asm volatile("" ::: "memory");
}

struct Conv8Job { const float* W; unsigned char* WT; int N; int mode; size_t w_estride, wt_estride; int items_per_e; };
constexpr int C8_PITCH = 272, C8_IMG = 256 * C8_PITCH;
__device__ __forceinline__ void conv8_load(const Conv8Job& jb, int item, int h, int wave, int lane, f32x4 (&v)[16]) {
    const int e = item / jb.items_per_e, r = item - e * jb.items_per_e; const int nblk = jb.N >> 8; const int kb = r / nblk, nb = r - kb * nblk;
    const float* src = jb.W + (size_t)e * jb.w_estride + (size_t)(kb * 256 + 32 * wave + 16 * h) * jb.N + nb * 256 + 4 * lane;
#pragma unroll
    for (int i = 0; i < 16; ++i) v[i] = __builtin_nontemporal_load((const f32x4*)(src + (size_t)i * jb.N));
}
__device__ __forceinline__ void conv8_to_lds(LAS unsigned char* img, int h, int wave, int lane, const f32x4 (&v)[16]) {
#pragma unroll
    for (int e = 0; e < 4; ++e) { u32x4 w;
#pragma unroll
        for (int g = 0; g < 4; ++g) w[g] = pack4_fp8(v[4 * g][e] * W8_SCALE, v[4 * g + 1][e] * W8_SCALE, v[4 * g + 2][e] * W8_SCALE, v[4 * g + 3][e] * W8_SCALE);
        *(LAS u32x4*)(img + (4 * lane + e) * C8_PITCH + 32 * wave + 16 * h) = w; }
}
__device__ __forceinline__ void conv8_store(const Conv8Job& jb, int item, const LAS unsigned char* img, int tid) {
    const int e = item / jb.items_per_e, r = item - e * jb.items_per_e; const int nblk = jb.N >> 8; const int kb = r / nblk, nb = r - kb * nblk;
    unsigned char* dst = jb.WT + (size_t)e * jb.wt_estride + kb * 256;
#pragma unroll
    for (int j = 0; j < 8; ++j) { const int q = j * 512 + tid, n = q >> 4, ch = q & 15;
        __builtin_nontemporal_store(*(const LAS u32x4*)(img + n * C8_PITCH + ch * 16), (u32x4*)(dst + (size_t)dest_row(jb.mode, nb * 256 + n) * 2048 + ch * 16)); }
}
__device__ __forceinline__ void conv8_run(LAS unsigned char* lds, const Conv8Job& jb, int n_items, int wg, int G, int tid, int wave, int lane) {
    if (wg >= n_items) return;
    f32x4 a[16], b[16]; int par = 0;
    conv8_load(jb, wg, 0, wave, lane, a); conv8_load(jb, wg, 1, wave, lane, b);
    for (int it = wg; it < n_items; it += G, par ^= 1) {
        LAS unsigned char* img = lds + par * C8_IMG;
        const int nx = (it + G < n_items) ? it + G : it;
        conv8_to_lds(img, 0, wave, lane, a); __builtin_amdgcn_sched_barrier(0);
        conv8_load(jb, nx, 0, wave, lane, a); __builtin_amdgcn_sched_barrier(0);
        conv8_to_lds(img, 1, wave, lane, b); __builtin_amdgcn_sched_barrier(0);
        conv8_load(jb, nx, 1, wave, lane, b); __builtin_amdgcn_sched_barrier(0);
        __syncthreads();
        conv8_store(jb, it, img, tid);
    }
    __syncthreads();
}

__global__ void __launch_bounds__(NTHR, 2) fwd_kernel(Args args) {
    extern __shared__ __attribute__((aligned(16))) unsigned char lds_raw[];
    LAS unsigned char* lds = (LAS unsigned char*)lds_raw;
    volatile LAS unsigned* MISC = (volatile LAS unsigned*)(lds + LDS_MISC);
    const int tid = threadIdx.x, lane = tid & 63, wave = __builtin_amdgcn_readfirstlane(tid >> 6);
    const int G = gridDim.x, wg = blockIdx.x;
    unsigned char* ws = args.ws;
    unsigned* ctl = (unsigned*)(ws + WS_CTL);
    const int lo = args.ph_lo, hi = args.ph_hi;
    const float* x = (const float*)args.in[0]; const float* cvec = (const float*)args.in[1]; const int* positions = (const int*)args.in[2];
    const float* w_ada = (const float*)args.in[3]; const float* b_ada = (const float*)args.in[4]; const float* norm1_g = (const float*)args.in[5];
    const float* w_in = (const float*)args.in[6]; const float* idx_knorm_g = (const float*)args.in[7]; const float* idx_knorm_b = (const float*)args.in[8];
    const float* lb_logits = (const float*)args.in[9]; const float* hgrn_norm_g = (const float*)args.in[10];
    const float* w_proj_att = (const float*)args.in[11]; const float* w_proj_hgrn = (const float*)args.in[12]; const float* w_out = (const float*)args.in[13];
    const float* norm2_g = (const float*)args.in[14]; const float* w_router = (const float*)args.in[15]; const float* b_router = (const float*)args.in[16];
    const float* w1 = (const float*)args.in[17]; const float* b1 = (const float*)args.in[18]; const float* w2 = (const float*)args.in[19]; const float* b2 = (const float*)args.in[20];
    const float* final_g = (const float*)args.in[21];
    float* out = args.out;
    float* MOD = (float*)(ws + WS_MOD); int* TOPE = (int*)(ws + WS_TOPE); float* GATE = (float*)(ws + WS_GATE); int* SLOT = (int*)(ws + WS_SLOT);
    bf16_t* WIN_T = (bf16_t*)(ws + WS_WIN_T); bf16_t* WA_T = (bf16_t*)(ws + WS_WA_T); bf16_t* WH_T = (bf16_t*)(ws + WS_WH_T); bf16_t* WO_T = (bf16_t*)(ws + WS_WO_T);
    unsigned char* WIN_T8 = ws + WS_WIN_T + 8 * MiB;
    unsigned char* HA8 = ws + WS_SCORES;
    unsigned char* W1_T = ws + WS_W1_T; unsigned char* W2_T = ws + WS_W2_T;
    bf16_t* HB = (bf16_t*)(ws + WS_H); bf16_t* PROJ = (bf16_t*)(ws + WS_PROJ);
    bf16_t* DELTA = (bf16_t*)(ws + WS_ATT);
    unsigned char* ACT = ws + WS_ACT; bf16_t* YB = (bf16_t*)(ws + WS_YB);
    int* TOKS = (int*)(ws + WS_TOKS);
    unsigned char* H8 = ws + WS_H;
    bf16_t* KI = (bf16_t*)(ws + WS_KI); unsigned char* KC = ws + WS_KC; unsigned char* VC = ws + WS_VC;
    float* ST = (float*)(ws + WS_ST); float* DC = (float*)(ws + WS_DC);
    bf16_t* ATT = (bf16_t*)(ws + WS_ATT); bf16_t* REC = (bf16_t*)(ws + WS_REC); bf16_t* MERGED = (bf16_t*)(ws + WS_MERGED); unsigned short* SCORES = (unsigned short*)(ws + WS_SCORES);
    unsigned short* SEGMAX = (unsigned short*)(ws + WS_X1);

    for (int u = tid; u < 128; u += NTHR) MISC[u] = 0u;
    __syncthreads();
    const bool one_launch = (hi - lo) > 1;
    XcdBarrier bar; bar.bar = ctl + CW_BAR; bar.x = 0; bar.st = MISC + 8;
    if (one_launch) bar = xcd_barrier_post(ctl + CW_BAR, MISC + 8);
#define IN(k) (lo <= (k) && (k) < hi)
#define SEAM(k) do { if (IN(k) && IN((k) + 1)) xcd_barrier(bar); } while (0)


    if (IN(PH_PRO)) {
        for (int cb = wg; cb < 256; cb += G) {
            LAS float* red = (LAS float*)lds;
            const int c4 = tid % 12, kg = tid / 12;
            f32x4 acc = (f32x4){0.f, 0.f, 0.f, 0.f};
            if (kg < 42) {
                const float* wp = w_ada + (size_t)cb * 48 + 4 * c4;
#pragma unroll 7
                for (int j = 0; j < 49; ++j) { const int k = kg + 42 * j; if (k < D) { const f32x4 v = __builtin_nontemporal_load((const f32x4*)(wp + (size_t)k * (6 * D))); acc += siluf_(cvec[k]) * v; } }
                *(LAS f32x4*)(red + kg * 48 + 4 * c4) = acc;
            }
            __syncthreads();
            if (tid < 48) { float s = b_ada[cb * 48 + tid];
#pragma unroll 6
                for (int q = 0; q < 42; ++q) s += red[q * 48 + tid];
                MOD[cb * 48 + tid] = s; }
            __syncthreads();
        }
        LAS unsigned char* scr = lds + wave * 17408;
        const int gw = wg * NWAVES + wave, NGW = G * NWAVES;
        {
            constexpr int NB_IN = (1104 + 63) / 64;
            for (int it = gw; it < 16 * NB_IN; it += NGW) convert_item(w_in + 1536, 2048, 1104, DIN, WIN_T, 0, it, lane, scr);
            for (int it = gw; it < 8 * 32; it += NGW) convert_item(w_proj_att, 1024, 2048, 2048, WA_T, 0, it, lane, scr);
            for (int it = gw; it < 8 * 32; it += NGW) convert_item(w_proj_hgrn, 1024, 2048, 2048, WH_T, 0, it, lane, scr);
            for (int it = gw; it < 16 * 32; it += NGW) convert_item(w_out, 2048, 2048, 2048, WO_T, 0, it, lane, scr);
            for (int it = gw; it < 8 * 24; it += NGW) convert_item8(w_in, 2048, 1536, DIN, WIN_T8, 0, it, lane, scr);
            for (int it = gw; it < 8 * 128; it += NGW) convert_item8(w_in + 2640, 2048, 8192, DIN, WIN_T8 + (size_t)1536 * 2048, 0, it, lane, scr);
            for (size_t i = (size_t)wg * NTHR + tid; i < (size_t)176 * 2048 * 2 / 16; i += (size_t)G * NTHR) ((u32x4*)(WIN_T + (size_t)1104 * 2048))[i] = (u32x4){0u, 0u, 0u, 0u};
        }
    }
    SEAM(PH_PRO);

    {
    if (IN(PH_H)) {
        const float* sh1 = MOD; const float* sc1 = MOD + D;
        const int gw = wg * NWAVES + wave, NGW = G * NWAVES;
        f32x4 gs[8], sh[8];
#pragma unroll
        for (int j = 0; j < 8; ++j) { const int c = 4 * lane + 256 * j; const f32x4 g = *(const f32x4*)(norm1_g + c), sc = *(const f32x4*)(sc1 + c); sh[j] = *(const f32x4*)(sh1 + c);
#pragma unroll
            for (int e = 0; e < 4; ++e) gs[j][e] = g[e] * (1.0f + sc[e]); }
        for (int t = gw; t < S; t += NGW) {
            const f32x4* xr = (const f32x4*)(x + (size_t)t * D) + lane;
            f32x4 v[8]; float ss = 0.f;
#pragma unroll
            for (int j = 0; j < 8; ++j) { v[j] = xr[64 * j]; ss += (v[j][0] * v[j][0] + v[j][1] * v[j][1]) + (v[j][2] * v[j][2] + v[j][3] * v[j][3]); }
            const float rstd = rsqrtf(wave_sum(ss) * (1.0f / D) + NORM_EPS);
#pragma unroll
            for (int j = 0; j < 8; ++j) { const f32x4 h = v[j] * rstd * gs[j] + sh[j]; u32x2 w; w.x = cvt_pk_bf16(h[0], h[1]); w.y = cvt_pk_bf16(h[2], h[3]);
                *(u32x2*)(HB + (size_t)t * D + 4 * lane + 256 * j) = w;
                *(unsigned*)(HA8 + (size_t)t * D + 4 * lane + 256 * j) = pack4_fp8(h[0], h[1], h[2], h[3]); }
        }
    }
    SEAM(PH_H);
    if (IN(PH_INPROJ)) {
        const int XC = (G == 256) ? XCONV : 0;
        const Conv8Job j1{w1, W1_T, 4096, 2, (size_t)2048 * 4096, (size_t)4096 * 2048, 8 * 16};
        const Conv8Job j2{w2, W2_T, 2048, 0, (size_t)2048 * 2048, (size_t)2048 * 2048, 8 * 8};
        if (G != 256) { conv8_run(lds, j1, NEXP * 8 * 16, wg, G, tid, wave, lane); conv8_run(lds, j2, NEXP * 8 * 8, wg, G, tid, wave, lane); }
        if (wg < XC) { conv8_run(lds, j1, NEXP * 8 * 16, wg, XC, tid, wave, lane); conv8_run(lds, j2, NEXP * 8 * 8, wg, XC, tid, wave, lane); }
        else {
            const int Gg = G - XC, cg = wg - XC;
            {
                pg8::Gemm g8{HA8, WIN_T8, 2048, 0, nullptr, 0}; pg8::StaticOrder S8; S8.init(S, 9728, Gg, cg);
                const int full8 = 2432 / Gg, rem8 = 2432 - full8 * Gg;
                if (Gg == 256) S8.skew(8, (wg >= 128 && wg < 192) ? -1 : (wg < 128 ? wg : wg - 64), 192);
                else if (rem8 > 0) S8.skew(full8, cg < rem8 ? cg : -1, rem8);
                pg8::EpiBf16 E8{PROJ, DINP, nullptr, 0, 1.0f / W8_SCALE, 6, 1280};
                pg8::gemm_phase<pg8::EpiBf16, pg8::StaticOrder, true>(lds, g8, S8, E8);
            }
            {
                pg8::Gemm g{HB, WIN_T, 2048, 0, nullptr, 0}; pg8::StaticOrder So; So.init(S, 1280, Gg, Gg == 256 ? (wg + 128) % G : (cg + Gg - (2432 % Gg)) % Gg);
                pg8::EpiBf16 E{PROJ + CQI, DINP, nullptr, 0, 1.0f, 1 << 30, 0};
                pg8::gemm_phase<pg8::EpiBf16, pg8::StaticOrder>(lds, g, So, E);
            }
        }
    }
    SEAM(PH_INPROJ);
    if (IN(PH_POST)) {
        const int gw = wg * NWAVES + wave, NGW = G * NWAVES;
        for (int t = gw; t < S; t += NGW) post_token(PROJ, KI, KC, VC, positions, idx_knorm_g, idx_knorm_b, t, lane);
        __syncthreads();
        for (int u = wg; u < 2048; u += G) hgrn_l1(lds, PROJ, lb_logits, ST, DC, u >> 3, u & 7, tid, wave, lane);
    }
    SEAM(PH_POST);
    if (IN(PH_SCORE)) {
        for (int idx = wg * NTHR + tid; idx < 8 * 128 * 128; idx += G * NTHR) {
            const int h = idx >> 14, d = idx & 127; float s = 0.f;
            float* sp = ST + idx; const float* dp = DC + h * 128 + d;
            for (int c = 0; c < 256; c += 8) {
                float l[8], dc[8];
#pragma unroll
                for (int i = 0; i < 8; ++i) { l[i] = sp[(size_t)(c + i) * 131072]; dc[i] = dp[(size_t)(c + i) * 1024]; }
#pragma unroll
                for (int i = 0; i < 8; ++i) { sp[(size_t)(c + i) * 131072] = s; s = dc[i] * s + l[i]; }
            }
        }
        {
            const int XS = (G == 256) ? XSCORE : 0;
            if (wg < XS) {
                const Conv8Job j1{w1, W1_T, 4096, 2, (size_t)2048 * 4096, (size_t)4096 * 2048, 8 * 16};
                const Conv8Job j2{w2, W2_T, 2048, 0, (size_t)2048 * 2048, (size_t)2048 * 2048, 8 * 8};
                __syncthreads();
                conv8_run(lds, j1, NEXP * 8 * 16, wg, XS, tid, wave, lane); conv8_run(lds, j2, NEXP * 8 * 8, wg, XS, tid, wave, lane);
            }
            for (;;) {
                if (tid == 0) MISC[100] = __hip_atomic_fetch_add(ctl + CW_SCQ, 1u, __ATOMIC_RELAXED, __HIP_MEMORY_SCOPE_AGENT);
                __syncthreads();
                const int item = (int)MISC[100];
                __syncthreads();
                if (item >= 252 * SCP) break;
                const int j = item / SCP, p = item - j * SCP, qa = 8 + j, qb2 = 511 - j, na = (qa >> 2) + 1, nb = (qb2 >> 2) + 1, T = na + nb;
                const int lo = p * T / SCP, hi = (p + 1) * T / SCP;
                const int a0 = lo < na ? lo : na, a1 = hi < na ? hi : na, b0 = (lo > na ? lo : na) - na, b1 = (hi > na ? hi : na) - na;
                if (a1 > a0) score_block(lds, PROJ, KI, SCORES, SEGMAX, qa, a0, a1, tid, wave, lane);
                if (b1 > b0) score_block(lds, PROJ, KI, SCORES, SEGMAX, qb2, b0, b1, tid, wave, lane);
            }
        }
    }
    SEAM(PH_SCORE);
    if (IN(PH_ATTN)) {
        const int gw = wg * NWAVES + wave, NGW = G * NWAVES;
        for (int u = wg; u < 2048; u += G) hgrn_l3(lds, PROJ, lb_logits, ST, hgrn_norm_g, REC, u >> 3, u & 7, tid, wave, lane);
        {
            for (int t = gw; t < S; t += NGW) {
                LAS unsigned char* wl = lds + wave * 17664;
                if (t >= 256) select_row(wl, SCORES, SEGMAX, t, lane);
                else {
#pragma unroll
                    for (int i = 0; i < 4; ++i) { const int idx = lane + 64 * i; ((LAS int*)wl)[idx] = idx <= t ? idx : 0; }
                }
                attn_query(wl, PROJ, KC, VC, ATT, t, lane);
            }
        }
    }
    SEAM(PH_ATTN);
    if (IN(PH_OP1)) {
        pg8::Gemm g{ATT, WA_T, 1024, (size_t)2048 * 1024 * 2, nullptr, (size_t)S * 1024 * 2};
        pg8::TwoPartOrder So; So.init(S, 2048, G, wg);
        pg8::EpiGate2 E{MERGED, PROJ + CGA, PROJ + CGR};
        pg8::gemm_phase<pg8::EpiGate2, pg8::TwoPartOrder>(lds, g, So, E);
    }
    SEAM(PH_OP2);
    if (IN(PH_WOUT)) {
        pg8::Gemm g{MERGED, WO_T, 2048, 0, nullptr, 0}; pg8::StaticOrder So; So.init(S, 2048, G, wg);
        pg8::EpiDelta E{MOD + 2 * D, DELTA};
        pg8::gemm_phase<pg8::EpiDelta, pg8::StaticOrder>(lds, g, So, E);
    }
    SEAM(PH_WOUT);
    }

    if (IN(PH_ROUTER)) {
        LAS float* hs = (LAS float*)lds;
        volatile LAS unsigned* lcnt = MISC + 32;
        const float* sh2 = MOD + 3 * D; const float* sc2 = MOD + 4 * D;
        if (tid < 32) lcnt[tid] = 0u;
        __syncthreads();
        for (int grp = wg; grp < S / 16; grp += G) {
#pragma unroll 1
            for (int q = 0; q < 2; ++q) {
                const int tl = 2 * wave + q, t = grp * 16 + tl;
                const f32x4* xr = (const f32x4*)(x + (size_t)t * D) + lane; const u32x2* dr = (const u32x2*)(DELTA + (size_t)t * D) + lane;
                f32x4 v[8]; float ss = 0.f;
#pragma unroll
                for (int j = 0; j < 8; ++j) { const u32x2 dw = dr[64 * j]; v[j] = xr[64 * j] + (f32x4){bf_lo(dw.x), bf_hi(dw.x), bf_lo(dw.y), bf_hi(dw.y)};
                    ss += (v[j][0] * v[j][0] + v[j][1] * v[j][1]) + (v[j][2] * v[j][2] + v[j][3] * v[j][3]); }
                const float rstd = rsqrtf(wave_sum(ss) * (1.0f / D) + NORM_EPS);
#pragma unroll
                for (int j = 0; j < 8; ++j) {
                    const int c = 4 * lane + 256 * j;
                    const f32x4 g = *(const f32x4*)(norm2_g + c), sc = *(const f32x4*)(sc2 + c), sh = *(const f32x4*)(sh2 + c);
                    f32x4 h;
#pragma unroll
                    for (int e = 0; e < 4; ++e) h[e] = v[j][e] * rstd * g[e] * (1.0f + sc[e]) + sh[e];
                    *(LAS f32x4*)(hs + tl * 2048 + c) = h;
                    *(unsigned*)(H8 + (size_t)t * D + c) = pack4_fp8(h[0], h[1], h[2], h[3]);
                }
            }
            __syncthreads();
            {
                LAS float* part = (LAS float*)(lds + 131072);
                const int fr = lane & 15, fq = lane >> 4;
                f32x4 acc0 = (f32x4){0.f, 0.f, 0.f, 0.f}, acc1 = acc0;
                const LAS float* hrow = hs + fr * 2048 + wave * 256 + 4 * fq; const float* wrp = w_router + (size_t)(wave * 256 + 4 * fq) * 32 + fr;
#pragma unroll 2
                for (int i = 0; i < 16; ++i) {
                    const f32x4 a4 = *(const LAS f32x4*)(hrow + 16 * i);
                    float b0[4], b1[4];
#pragma unroll
                    for (int s = 0; s < 4; ++s) { b0[s] = wrp[(size_t)(16 * i + s) * 32]; b1[s] = wrp[(size_t)(16 * i + s) * 32 + 16]; }
#pragma unroll
                    for (int s = 0; s < 4; ++s) { acc0 = __builtin_amdgcn_mfma_f32_16x16x4f32(a4[s], b0[s], acc0, 0, 0, 0); acc1 = __builtin_amdgcn_mfma_f32_16x16x4f32(a4[s], b1[s], acc1, 0, 0, 0); }
                }
#pragma unroll
                for (int r = 0; r < 4; ++r) { part[(wave * 16 + 4 * fq + r) * 32 + fr] = acc0[r]; part[(wave * 16 + 4 * fq + r) * 32 + 16 + fr] = acc1[r]; }
                __syncthreads();
                const int tl = tid >> 5, e = tid & 31, t = grp * 16 + tl;
                float v = b_router[e];
#pragma unroll
                for (int w = 0; w < 8; ++w) v += part[(w * 16 + tl) * 32 + e];
                float tv[4]; int ti[4];
#pragma unroll
                for (int k = 0; k < 4; ++k) {
                    float bv = v; int bi = e;
#pragma unroll
                    for (int o = 16; o >= 1; o >>= 1) { const float ov = __shfl_xor(bv, o); const int oi = __shfl_xor(bi, o); if (ov > bv || (ov == bv && oi < bi)) { bv = ov; bi = oi; } }
                    tv[k] = bv; ti[k] = bi; if (e == bi) v = -__builtin_inff();
                }
                if (e == 0) {
                    const float e1 = __expf(tv[1] - tv[0]), e2 = __expf(tv[2] - tv[0]), e3 = __expf(tv[3] - tv[0]); const float inv = 1.0f / (1.0f + e1 + e2 + e3);
                    *(int4*)(TOPE + (size_t)t * 4) = make_int4(ti[0], ti[1], ti[2], ti[3]);
                    *(f32x4*)(GATE + (size_t)t * 4) = (f32x4){inv, e1 * inv, e2 * inv, e3 * inv};
#pragma unroll
                    for (int k = 0; k < 4; ++k) __hip_atomic_fetch_add((LAS unsigned*)&lcnt[ti[k]], 1u, __ATOMIC_RELAXED, __HIP_MEMORY_SCOPE_WORKGROUP);
                }
            }
            __syncthreads();
        }
        if (tid < 32) { const unsigned c = lcnt[tid]; if (c) __hip_atomic_fetch_add(ctl + CW_CNT + tid, c, __ATOMIC_RELAXED, __HIP_MEMORY_SCOPE_AGENT); }
    }
    SEAM(PH_ROUTER);

    if (IN(PH_SCATTER)) {
        volatile LAS unsigned* lcnt = MISC + 32; volatile LAS unsigned* lbase = MISC + 64; LAS int* pstart = (LAS int*)(lds + 1024); LAS int* pcnt = (LAS int*)(lds + 1280);
        if (tid == 0) { int p = 0; for (int e = 0; e < NEXP; ++e) { const int c = (int)__hip_atomic_load(ctl + CW_CNT + e, __ATOMIC_RELAXED, __HIP_MEMORY_SCOPE_AGENT); pstart[e] = p; pcnt[e] = c; p += (c + 255) & ~255; } }
        if (tid < 32) lcnt[tid] = 0u;
        __syncthreads();
        if (wg < NEXP) { const int e = wg; for (int s = pstart[e] + pcnt[e] + tid; s < pstart[e] + ((pcnt[e] + 255) & ~255); s += NTHR) TOKS[s] = 0; }
        for (int blk = wg; blk < S / 64; blk += G) {
            int e = 0, lrank = 0;
            if (tid < 256) { e = TOPE[(size_t)blk * 256 + tid]; lrank = (int)__hip_atomic_fetch_add((LAS unsigned*)&lcnt[e], 1u, __ATOMIC_RELAXED, __HIP_MEMORY_SCOPE_WORKGROUP); }
            __syncthreads();
            if (tid < 32) { const unsigned c = lcnt[tid]; lbase[tid] = c ? __hip_atomic_fetch_add(ctl + CW_FILL + tid, c, __ATOMIC_RELAXED, __HIP_MEMORY_SCOPE_AGENT) : 0u; }
            __syncthreads();
            if (tid < 256) { const int slot = pstart[e] + (int)lbase[e] + lrank; SLOT[(size_t)blk * 256 + tid] = slot; TOKS[slot] = blk * 64 + (tid >> 2); }
            __syncthreads();
            if (tid < 32) lcnt[tid] = 0u;
            __syncthreads();
        }
    }
    SEAM(PH_SCATTER);

    if (IN(PH_MOE1) || IN(PH_MOE2)) {
        LAS int* panel_e = (LAS int*)(lds + 131072 + 2048);
        LAS int* npan = (LAS int*)(lds + 131072 + 2048 + 2048);
        __syncthreads();
        if (tid == 0) { int p = 0; for (int e = 0; e < NEXP; ++e) { const int np = (int)((__hip_atomic_load(ctl + CW_CNT + e, __ATOMIC_RELAXED, __HIP_MEMORY_SCOPE_AGENT) + 255u) >> 8); for (int q = 0; q < np; ++q) panel_e[p + q] = e; p += np; } npan[0] = p; }
        __syncthreads();
        const int nPanels = npan[0];
        if (IN(PH_MOE1)) {
            pg8::Gemm g{H8, W1_T, 2048, (size_t)4096 * 2048, TOKS, 0}; pg8::MoeOrder So; So.init(nPanels, 16, G, wg, panel_e);
            pg8::EpiSwiglu E{ACT, b1};
            pg8::gemm_phase<pg8::EpiSwiglu, pg8::MoeOrder, true>(lds, g, So, E);
        }
        SEAM(PH_MOE1);
        if (IN(PH_MOE2)) {
            pg8::Gemm g{ACT, W2_T, 2048, (size_t)2048 * 2048, nullptr, 0}; pg8::MoeOrder So; So.init(nPanels, 8, G, wg, panel_e);
            pg8::EpiBf16 E{YB, 2048, b2, 2048, 1.0f / (W8_SCALE * ACT8_SCALE), 1 << 30, 0};
            pg8::gemm_phase<pg8::EpiBf16, pg8::MoeOrder, true>(lds, g, So, E);
        }
    }
    SEAM(PH_MOE2);

    if (IN(PH_FINAL)) {
        const float* gt2 = MOD + 5 * D;
        const int gw = wg * NWAVES + wave, NGW = G * NWAVES;
        for (int t = gw; t < S; t += NGW) {
            const f32x4* xr = (const f32x4*)(x + (size_t)t * D) + lane; const u32x2* dr = (const u32x2*)(DELTA + (size_t)t * D) + lane;
            f32x4 v[8];
#pragma unroll
            for (int j = 0; j < 8; ++j) { const u32x2 dw = dr[64 * j]; v[j] = xr[64 * j] + (f32x4){bf_lo(dw.x), bf_hi(dw.x), bf_lo(dw.y), bf_hi(dw.y)}; }
            {
                f32x4 m[8];
#pragma unroll
                for (int j = 0; j < 8; ++j) m[j] = (f32x4){0.f, 0.f, 0.f, 0.f};
                const int4 sl = *(const int4*)(SLOT + (size_t)t * 4); const f32x4 gt = *(const f32x4*)(GATE + (size_t)t * 4);
                const int sls[4] = {sl.x, sl.y, sl.z, sl.w};
#pragma unroll
                for (int k = 0; k < 4; ++k) {
                    const u32x2* yr = (const u32x2*)(YB + (size_t)sls[k] * D) + lane; const float gk = gt[k];
#pragma unroll
                    for (int j = 0; j < 8; ++j) { const u32x2 w = yr[64 * j]; m[j][0] += gk * bf_lo(w.x); m[j][1] += gk * bf_hi(w.x); m[j][2] += gk * bf_lo(w.y); m[j][3] += gk * bf_hi(w.y); }
                }
#pragma unroll
                for (int j = 0; j < 8; ++j) { const f32x4 g2 = *(const f32x4*)(gt2 + 4 * lane + 256 * j); v[j] = v[j] + g2 * m[j]; }
            }
            float ss = 0.f;
#pragma unroll
            for (int j = 0; j < 8; ++j) ss += (v[j][0] * v[j][0] + v[j][1] * v[j][1]) + (v[j][2] * v[j][2] + v[j][3] * v[j][3]);
            const float rstd = rsqrtf(wave_sum(ss) * (1.0f / D) + NORM_EPS);
            f32x4* orow = (f32x4*)(out + (size_t)t * D) + lane;
#pragma unroll
            for (int j = 0; j < 8; ++j) { const f32x4 fg = *(const f32x4*)(final_g + 4 * lane + 256 * j); orow[64 * j] = v[j] * rstd * fg; }
        }
    }
#undef IN
#undef SEAM
}

#ifndef MK_ONE_LAUNCH
#define MK_ONE_LAUNCH 1
#endif
extern "C" void kernel_launch(void* const* d_in, const int* in_sizes, int n_in, void* d_out, int out_size, void* d_ws, size_t ws_size, hipStream_t stream) {
    static int grid = 0;
    if (grid == 0) {
        if (n_in != 22 || out_size != S * D || ws_size < WS_END) { fprintf(stderr, "kernel_launch: unexpected shapes: n_in %d out %d ws %zu (need %zu)\n", n_in, out_size, ws_size, (size_t)WS_END); grid = -1; return; }
        int dev = 0, cus = 0, per_cu = 0;
        if (hipGetDevice(&dev) != hipSuccess || hipDeviceGetAttribute(&cus, hipDeviceAttributeMultiprocessorCount, dev) != hipSuccess) { grid = -1; return; }
        if (hipFuncSetAttribute((const void*)fwd_kernel, hipFuncAttributeMaxDynamicSharedMemorySize, LDS_BYTES) != hipSuccess) { fprintf(stderr, "kernel_launch: hipFuncSetAttribute failed\n"); grid = -1; return; }
        if (hipOccupancyMaxActiveBlocksPerMultiprocessor(&per_cu, (const void*)fwd_kernel, NTHR, LDS_BYTES) != hipSuccess || per_cu < 1) { fprintf(stderr, "kernel_launch: occupancy query says %d\n", per_cu); (void)hipGetLastError(); grid = -1; return; }
        grid = cus;
    }
    if (grid < 0) return;
    (void)in_sizes;
    hipMemsetAsync((char*)d_ws + WS_CTL, 0, CTL_BYTES, stream);
    Args a{};
    for (int i = 0; i < 22; ++i) a.in[i] = d_in[i];
    a.out = (float*)d_out; a.ws = (unsigned char*)d_ws; a.flags = 0; a.pad = 0;
#if MK_ONE_LAUNCH
    a.ph_lo = 0; a.ph_hi = NPH;
    hipLaunchKernelGGL(fwd_kernel, dim3(grid), dim3(NTHR), LDS_BYTES, stream, a);
#else
    for (int p = 0; p < NPH; ++p) { a.ph_lo = p; a.ph_hi = p + 1; hipLaunchKernelGGL(fwd_kernel, dim3(grid), dim3(NTHR), LDS_BYTES, stream, a); }
#endif
}
```

```cpp
#include <hip/hip_runtime.h>
#include <cstdio>
#include <cstdint>

#define GAS __attribute__((address_space(1)))
#define LAS __attribute__((address_space(3)))
typedef unsigned short bf16_t;
typedef short bf16x8 __attribute__((ext_vector_type(8)));
typedef float f32x4 __attribute__((ext_vector_type(4)));
typedef float f32x2 __attribute__((ext_vector_type(2)));
typedef float f32x16 __attribute__((ext_vector_type(16)));
typedef unsigned u32x4 __attribute__((ext_vector_type(4)));
typedef unsigned u32x2 __attribute__((ext_vector_type(2)));
typedef int i32x4 __attribute__((ext_vector_type(4)));
typedef int i32x8 __attribute__((ext_vector_type(8)));
typedef short s16x4 __attribute__((ext_vector_type(4)));
typedef short s16x2 __attribute__((ext_vector_type(2)));

constexpr int S = 16384, D = 2048, DIN = 10832, DINP = 11008, NEXP = 32, DFF = 2048;
constexpr int NWAVES = 8, NTHR = 512;
constexpr int CQ = 0, CK = 1024, CV = 1280, CQI = 1536, CKI = 2560, CWI = 2624, CHQ = 2816, CHF = 3840, CHI = 4864, CHG = 5888, CGA = 6912, CGR = 8960;
constexpr int PMAX = 65536 + NEXP * 256;
constexpr float NORM_EPS = 1e-5f;

constexpr size_t MiB = 1u << 20;
constexpr size_t al256(size_t x) { return (x + 255) & ~(size_t)255; }
constexpr size_t WS_CTL = 0, CTL_BYTES = 1 * MiB;
constexpr size_t WS_MOD = WS_CTL + CTL_BYTES;
constexpr size_t WS_TOPE = WS_MOD + 64 * 1024;
constexpr size_t WS_GATE = WS_TOPE + (size_t)S * 16;
constexpr size_t WS_SLOT = WS_GATE + (size_t)S * 16;
constexpr size_t WS_WIN_T = WS_SLOT + (size_t)S * 16;
constexpr size_t WS_WA_T = WS_WIN_T + (size_t)DINP * D * 2;
constexpr size_t WS_WH_T = WS_WA_T + (size_t)2048 * 1024 * 2;
constexpr size_t WS_WO_T = WS_WH_T + (size_t)2048 * 1024 * 2;
constexpr size_t WS_W1_T = WS_WO_T + (size_t)2048 * 2048 * 2;
constexpr size_t WS_W2_T = WS_W1_T + (size_t)NEXP * 4096 * 2048 * 2;
constexpr size_t WS_H = WS_W2_T + (size_t)NEXP * 2048 * 2048 * 2;
constexpr size_t WS_PROJ = WS_H + (size_t)S * D * 2;
constexpr size_t WS_KI = WS_PROJ + (size_t)S * DINP * 2;
constexpr size_t WS_KC = WS_KI + (size_t)S * 64 * 2;
constexpr size_t WS_VC = WS_KC + (size_t)S * 256 * 2;
constexpr size_t WS_ST = WS_VC + (size_t)S * 256 * 2;
constexpr size_t WS_DC = WS_ST + (size_t)256 * 8 * 128 * 128 * 4;
constexpr size_t WS_SEL = WS_DC + (size_t)256 * 8 * 128 * 4;
constexpr size_t WS_ATT = WS_SEL + (size_t)S * 256 * 4;
constexpr size_t WS_REC = WS_ATT + (size_t)S * 1024 * 2;
constexpr size_t WS_MERGED = WS_REC + (size_t)S * 1024 * 2;
constexpr size_t WS_X1 = WS_MERGED + (size_t)S * 2048 * 2;
constexpr size_t WS_SCORES = WS_X1 + (size_t)S * 2048 * 4;
constexpr size_t WS_XB = WS_SCORES;
constexpr size_t WS_ACT = WS_XB + (size_t)PMAX * 2048 * 2;
constexpr size_t WS_YB = WS_ACT + (size_t)PMAX * 2048 * 2;
constexpr size_t WS_END = WS_SCORES + (size_t)S * S * 4;
static_assert(WS_YB + (size_t)PMAX * 2048 * 2 <= WS_END, "MoE buffers overlay the score matrix");
static_assert(WS_END <= (size_t)4096 * MiB, "workspace");
constexpr int CW_BAR = 4096, CW_CNT = 8192, CW_FILL = 8448;
constexpr size_t WS_TOKS = WS_SEL;

constexpr int LDS_BYTES = 155648;
constexpr int LDS_MISC = LDS_BYTES - 512;

__device__ __forceinline__ unsigned cvt_pk_bf16(float lo, float hi) { unsigned r; asm volatile("v_cvt_pk_bf16_f32 %0, %1, %2" : "=v"(r) : "v"(lo), "v"(hi)); return r; }
__device__ __forceinline__ float bf_lo(unsigned u) { return __uint_as_float(u << 16); }
__device__ __forceinline__ float bf_hi(unsigned u) { return __uint_as_float(u & 0xffff0000u); }
__device__ __forceinline__ float bf2f(bf16_t b) { return __uint_as_float(((unsigned)b) << 16); }
__device__ __forceinline__ float wave_sum(float v) {
#define DPPS(ctrl, rmask) { const int s_ = __builtin_amdgcn_update_dpp(0, __float_as_int(v), ctrl, rmask, 0xF, false); v += __int_as_float(s_); }
    DPPS(0x111, 0xF) DPPS(0x112, 0xF) DPPS(0x114, 0xF) DPPS(0x118, 0xF) DPPS(0x142, 0xA) DPPS(0x143, 0xC)
#undef DPPS
    return __int_as_float(__builtin_amdgcn_readlane(__float_as_int(v), 63));
}
__device__ __forceinline__ float wave_max(float v) {
#define DPPM(ctrl, rmask) { const int o_ = __float_as_int(v); const int s_ = __builtin_amdgcn_update_dpp(o_, o_, ctrl, rmask, 0xF, false); v = fmaxf(v, __int_as_float(s_)); }
    DPPM(0x111, 0xF) DPPM(0x112, 0xF) DPPM(0x114, 0xF) DPPM(0x118, 0xF) DPPM(0x142, 0xA) DPPM(0x143, 0xC)
#undef DPPM
    return __int_as_float(__builtin_amdgcn_readlane(__float_as_int(v), 63));
}
__device__ __forceinline__ float sigmoidf_(float x) { return __builtin_amdgcn_rcpf(1.0f + __expf(-x)); }
__device__ __forceinline__ float siluf_(float x) { return x * __builtin_amdgcn_rcpf(1.0f + __expf(-x)); }
__device__ __forceinline__ unsigned pack4_fp8(float a, float b, float c, float d) { int w = 0; w = __builtin_amdgcn_cvt_pk_fp8_f32(a, b, w, false); w = __builtin_amdgcn_cvt_pk_fp8_f32(c, d, w, true); return (unsigned)w; }
constexpr float W8_SCALE = 64.0f, ACT8_SCALE = 4.0f, MRG8_SCALE = 8.0f;
__device__ __forceinline__ float relu_i(float x) { const int i = __float_as_int(x); return __int_as_float(i > 0 ? i : 0); }
__device__ __forceinline__ void fp8x16_to_bf16(const u32x4& w, u32x4& lo, u32x4& hi) {
    unsigned o[8];
#pragma unroll
    for (int q = 0; q < 4; ++q) { const unsigned wq = w[q]; const f32x2 a = __builtin_amdgcn_cvt_pk_f32_fp8((int)wq, false), b = __builtin_amdgcn_cvt_pk_f32_fp8((int)wq, true);
        o[2 * q] = cvt_pk_bf16(a[0], a[1]); o[2 * q + 1] = cvt_pk_bf16(b[0], b[1]); }
    lo = (u32x4){o[0], o[1], o[2], o[3]}; hi = (u32x4){o[4], o[5], o[6], o[7]};
}
__device__ __forceinline__ unsigned char fp8_1(float x) { return (unsigned char)(__builtin_amdgcn_cvt_pk_fp8_f32(x, x, 0, false) & 0xff); }
#define LDS_WAIT() asm volatile("s_waitcnt lgkmcnt(0)" ::: "memory")
#define VM_WAIT() asm volatile("s_waitcnt vmcnt(0)" ::: "memory")

#define XB_TMO      128
#define XB_XCNT(j)  (256  + 64 * (j))
#define XB_XSUB(j)  (1280 + 64 * (j))
#define XB_XGEN(j)  (2304 + 64 * (j))
#define XB_TOP      3328
#define XB_TOPGEN   3392
#define XCD_BAR_WORDS 3456
#define XB_SPIN_CAP (1u << 22)

__device__ __forceinline__ unsigned xb_ld(unsigned* p)              { return __hip_atomic_load(p, __ATOMIC_RELAXED, __HIP_MEMORY_SCOPE_AGENT); }
__device__ __forceinline__ unsigned xb_add(unsigned* p, unsigned v) { return __hip_atomic_fetch_add(p, v, __ATOMIC_RELAXED, __HIP_MEMORY_SCOPE_AGENT); }
__device__ __forceinline__ unsigned xb_xcc_id() { return (unsigned)__builtin_amdgcn_s_getreg((3 << 11) | 20) & 0xFu; }
#define XB_SPIN(cond, bar) do { unsigned _sp = 0; while (cond) { __builtin_amdgcn_s_sleep(1); \
    if ((++_sp & 255u) == 0u) { if (xb_ld(&(bar)[XB_TMO])) break; if (_sp > XB_SPIN_CAP) { atomicAdd(&(bar)[XB_TMO], 1u); break; } } } } while (0)

struct XcdBarrier { unsigned* bar; unsigned x; volatile LAS unsigned* st; };

__device__ __forceinline__ XcdBarrier xcd_barrier_post(unsigned* bar, volatile LAS unsigned* st) {
    XcdBarrier b; b.bar = bar; b.x = xb_xcc_id(); b.st = st;
    if (threadIdx.x == 0) (void)xb_add(&bar[XB_XCNT(b.x)], 1u);
    return b;
}
__device__ __forceinline__ void xcd_barrier_complete(unsigned* bar, unsigned x, unsigned& nloc, unsigned& nx) {
    const unsigned G = gridDim.x * gridDim.y * gridDim.z;
    unsigned sum, cnt, mine, sp = 0u;
    for (;;) {
        sum = 0u; cnt = 0u; mine = 0u;
#pragma unroll
        for (unsigned j = 0; j < 16; ++j) { const unsigned c = xb_ld(&bar[XB_XCNT(j)]); sum += c; cnt += (c > 0u) ? 1u : 0u; mine = (j == x) ? c : mine; }
        if (sum == G) break;
        __builtin_amdgcn_s_sleep(1);
        if ((++sp & 255u) == 0u) { if (xb_ld(&bar[XB_TMO])) break; if (sp > XB_SPIN_CAP) { atomicAdd(&bar[XB_TMO], 1u); break; } }
    }
    nloc = mine > 0u ? mine : 1u; nx = cnt > 0u ? cnt : 1u;
}
__device__ __forceinline__ void xcd_barrier(const XcdBarrier& b) {
    asm volatile("s_waitcnt vmcnt(0)" ::: "memory");
    __syncthreads();
    if (threadIdx.x == 0) {
        unsigned* bar = b.bar;
        __builtin_amdgcn_s_waitcnt(0);
        unsigned nloc = b.st[0], nx = b.st[1];
        if (nloc == 0u) { xcd_barrier_complete(bar, b.x, nloc, nx); b.st[0] = nloc; b.st[1] = nx; }
        const unsigned old = xb_add(&bar[XB_XSUB(b.x)], 1u);
        const unsigned gen = old / nloc;
        if (old + 1u == (gen + 1u) * nloc) {
            __builtin_amdgcn_fence(__ATOMIC_RELEASE, "agent");
            asm volatile("s_waitcnt vmcnt(0)" ::: "memory");
            const unsigned og = xb_add(&bar[XB_TOP], 1u);
            const unsigned tg = og / nx;
            if (og + 1u == (tg + 1u) * nx) xb_add(&bar[XB_TOPGEN], 1u);
            else XB_SPIN(xb_ld(&bar[XB_TOPGEN]) == tg, bar);
            __builtin_amdgcn_fence(__ATOMIC_ACQUIRE, "agent");
            xb_add(&bar[XB_XGEN(b.x)], 1u);
            asm volatile("s_waitcnt vmcnt(0)" ::: "memory");
        } else {
            XB_SPIN(xb_ld(&bar[XB_XGEN(b.x)]) == gen, bar);
            __builtin_amdgcn_fence(__ATOMIC_ACQUIRE, "agent");
            asm volatile("s_waitcnt vmcnt(0)" ::: "memory");
        }
    }
    __syncthreads();
}

namespace pg8 {
constexpr int BM = 256, BK = 64, HALF = 128, HTB = HALF * BK * 2, STAGE_BYTES = 8 * HTB, NXCD = 8, WGM = 8;
__host__ __device__ __forceinline__ int lds_byte(int r, int c) { const int st = (r >> 4) * 2 + (c >> 5), rr = r & 15, cc = c & 31, ob = rr * 64 + cc * 2; return st * 1024 + (ob ^ (((ob >> 9) & 1) << 5)); }
__host__ __device__ __forceinline__ void stage_rc(int b, int& R, int& C) { const int st = b / 1024, sb = b % 1024, swz = sb ^ (((sb >> 9) & 1) << 5); R = (st >> 1) * 16 + swz / 64; C = (st & 1) * 32 + (swz % 64) / 2; }
__host__ __device__ __forceinline__ int perm32(int rho) { const int n = rho >> 4, i = rho & 15; return 8 * (i >> 2) + 4 * n + (i & 3); }

struct Unit { int pm, pn, e; };
struct Gemm { const void* A; const void* Bt; int K; size_t estride; const int* arow; size_t astride; };

struct StaticOrder {
    int nM, nN, nwg, G, c, i, full, erank, en;
    __device__ void init(int M, int N, int G_, int c_) { nM = M / BM; nN = N / BM; nwg = nM * nN; G = G_; c = c_; i = 0; full = 1 << 30; erank = -1; en = 1; }
    __device__ void skew(int full_, int erank_, int en_) { full = full_; erank = erank_; en = en_; }
    __device__ bool next(Unit& u) {
        long L;
        if (i < full) L = (long)i * G + c; else { if (erank < 0) return false; L = (long)full * G + (long)(i - full) * en + erank; }
        ++i; if (L >= nwg) return false;
        int wgid = (int)L; { const int q = nwg / NXCD, r = nwg % NXCD, xcd = wgid % NXCD, off = wgid / NXCD; wgid = (xcd < r ? xcd * (q + 1) : r * (q + 1) + (xcd - r) * q) + off; }
        const int nig = WGM * nN, gid = wgid / nig, fm = gid * WGM, gsz = (nM - fm) < WGM ? (nM - fm) : WGM;
        u.pm = fm + ((wgid % nig) % gsz); u.pn = (wgid % nig) / gsz; u.e = 0; return true;
    }
};
struct MoeOrder {
    int nPanels, nN, G, c, i; const LAS int* panel_e;
    __device__ void init(int nPanels_, int nN_, int G_, int c_, const LAS int* pe) { nPanels = nPanels_; nN = nN_; G = G_; c = c_; i = 0; panel_e = pe; }
    __device__ bool next(Unit& u) {
        const int PB = 256 / nN;
        const int nblk = (nPanels + PB - 1) / PB;
        for (;;) {
            const long L = (long)i * G + c; ++i;
            const int blk = (int)(L >> 8), r = (int)(L & 255), x = r & 7, j = r >> 3;
            if (blk >= nblk) return false;
            int pm, pn;
            if (nN == 16) { pm = blk * 16 + 4 * (x >> 1) + (j & 3); pn = 8 * (x & 1) + (j >> 2); }
            else          { pm = blk * 32 + 4 * x + (j & 3);        pn = j >> 2; }
            if (pm < nPanels) { u.pm = pm; u.pn = pn; u.e = panel_e[pm]; return true; }
        }
    }
};

template <class Epi, class Sched, bool FP8 = false>
__device__ __forceinline__ void gemm_phase(LAS unsigned char* lds, const Gemm g, Sched& S, const Epi& E) {
    const int tid = threadIdx.x, wid = __builtin_amdgcn_readfirstlane(tid >> 6), lane = tid & 63, wr = wid >> 2, wc = wid & 3, fr = lane & 15, fq = lane >> 4;
    const int K = g.K; const int pitch = FP8 ? K : 2 * K; const int nt = pitch / 128;
    unsigned voffA[2], voffB[2];
#pragma unroll
    for (int i = 0; i < 2; ++i) { int R, C; stage_rc(tid * 16 + i * 8192, R, C); const int Rb = Epi::PERM ? ((R & ~31) + perm32(R & 31)) : R;
        voffA[i] = (unsigned)(R * pitch + C * 2); voffB[i] = (unsigned)(Rb * pitch + C * 2); }
    const size_t kstep = (size_t)(BK * 2);
    const size_t hstep = (size_t)HALF * pitch;
    const size_t tstep = 2 * hstep;
    int RA[2], CA[2];
#pragma unroll
    for (int i = 0; i < 2; ++i) stage_rc(tid * 16 + i * 8192, RA[i], CA[i]);
    const bool gather = g.arow != nullptr;
    const size_t hsA = gather ? 0 : hstep;
    unsigned vA0[2] = {voffA[0], voffA[1]}, vA1[2] = {voffA[0], voffA[1]}, nA0[2] = {voffA[0], voffA[1]}, nA1[2] = {voffA[0], voffA[1]};
#define PG8_AOFF(dst0, dst1, u) do { if (gather) { _Pragma("unroll") for (int i = 0; i < 2; ++i) { \
        dst0[i] = (unsigned)g.arow[(u).pm * 256 + RA[i]] * (unsigned)pitch + (unsigned)(CA[i] * 2); dst1[i] = (unsigned)g.arow[(u).pm * 256 + 128 + RA[i]] * (unsigned)pitch + (unsigned)(CA[i] * 2); } } } while (0)
    const unsigned ldsw = (unsigned)wid * 1024u;
    const int aoff = lds_byte(wr * 64 + fr, fq * 8), boff = lds_byte(wc * 32 + fr, fq * 8);
#define PG8_SA(b, h) (((b) * 2 + (h)) * HTB)
#define PG8_SB(b, h) ((4 + (b) * 2 + (h)) * HTB)
#define PG8_STAGE(bufoff, gbase, voff) do { _Pragma("unroll") for (int _i = 0; _i < 2; ++_i) \
        __builtin_amdgcn_global_load_lds((const unsigned*)((const char*)(gbase) + (voff)[_i]), (LAS unsigned*)(lds + (bufoff) + ldsw + _i * 8192), 16, 0, 0); } while (0)
#define PG8_LD8(p) __builtin_shufflevector(*(const LAS i32x4*)(p), *(const LAS i32x4*)((p) + 1024), 0, 1, 2, 3, 4, 5, 6, 7)
#define PG8_LDA(dst, b, h) do { _Pragma("unroll") for (int m = 0; m < 4; ++m) { if constexpr (FP8) dst##8[m] = PG8_LD8(lds + PG8_SA(b, h) + aoff + m * 2048); \
        else { _Pragma("unroll") for (int k = 0; k < 2; ++k) dst[m][k] = *(const LAS bf16x8*)(lds + PG8_SA(b, h) + aoff + m * 2048 + k * 1024); } } } while (0)
#define PG8_LDB(dst, b, h) do { _Pragma("unroll") for (int n = 0; n < 2; ++n) { if constexpr (FP8) dst##8[n] = PG8_LD8(lds + PG8_SB(b, h) + boff + n * 2048); \
        else { _Pragma("unroll") for (int k = 0; k < 2; ++k) dst[n][k] = *(const LAS bf16x8*)(lds + PG8_SB(b, h) + boff + n * 2048 + k * 1024); } } } while (0)
#define PG8_MMA(ai, bj, At, Bt) do { __builtin_amdgcn_s_setprio(1); _Pragma("unroll") for (int m = 0; m < 4; ++m) _Pragma("unroll") for (int n = 0; n < 2; ++n) { \
        if constexpr (FP8) asm volatile("v_mfma_scale_f32_16x16x128_f8f6f4 %0, %1, %2, %0, %3, %3 op_sel_hi:[0,0,0]" : "+v"(acc[ai][bj][m][n]) : "v"(Bt##8[n]), "v"(At##8[m]), "v"(scl1)); \
        else { _Pragma("unroll") for (int k = 0; k < 2; ++k) acc[ai][bj][m][n] = __builtin_amdgcn_mfma_f32_16x16x32_bf16(Bt[n][k], At[m][k], acc[ai][bj][m][n], 0, 0, 0); } } \
        __builtin_amdgcn_s_setprio(0); } while (0)
#define PG8_WAIT_V(n) asm volatile("s_waitcnt vmcnt(" #n ")" ::: "memory")
#define PG8_WAIT_L(n) asm volatile("s_waitcnt lgkmcnt(" #n ")" ::: "memory")
#define PG8_BAR __builtin_amdgcn_s_barrier()
#define PG8_SCHED __builtin_amdgcn_sched_barrier(0)
    Unit cur, nxt;
    if (!S.next(cur)) return;
    const unsigned scl1 = 0x7f7f7f7fu;
    f32x4 acc[2][2][4][2];
#pragma unroll
    for (int a = 0; a < 2; ++a)
#pragma unroll
        for (int b = 0; b < 2; ++b)
#pragma unroll
            for (int m = 0; m < 4; ++m)
#pragma unroll
                for (int n = 0; n < 2; ++n) acc[a][b][m][n] = (f32x4){0.f, 0.f, 0.f, 0.f};
    bf16x8 At[4][2], B0[2][2], B1[2][2]; i32x8 At8[4], B08[2], B18[2];
    const char* cA = (const char*)g.A + (size_t)cur.e * g.astride + (gather ? (size_t)0 : (size_t)cur.pm * tstep); const char* cB = (const char*)g.Bt + (size_t)cur.e * g.estride + (size_t)cur.pn * tstep;
    PG8_AOFF(vA0, vA1, cur);
    PG8_STAGE(PG8_SB(0, 0), cB, voffB); PG8_STAGE(PG8_SB(0, 1), cB + hstep, voffB); PG8_STAGE(PG8_SA(0, 0), cA, vA0); PG8_STAGE(PG8_SA(0, 1), cA + hsA, vA1);
    if (wr == 1) PG8_BAR;
    PG8_WAIT_V(2); PG8_BAR;
    PG8_STAGE(PG8_SB(1, 0), cB + kstep, voffB); PG8_STAGE(PG8_SA(1, 0), cA + kstep, vA0); PG8_STAGE(PG8_SB(1, 1), cB + hstep + kstep, voffB);
    PG8_WAIT_V(6); PG8_BAR;
    for (;;) {
        const bool has_next = S.next(nxt);
        const char* nA = has_next ? (const char*)g.A + (size_t)nxt.e * g.astride + (gather ? (size_t)0 : (size_t)nxt.pm * tstep) : cA;
        if (has_next) PG8_AOFF(nA0, nA1, nxt);
        const char* nB = has_next ? (const char*)g.Bt + (size_t)nxt.e * g.estride + (size_t)nxt.pn * tstep : cB;
        for (int t = 0; t < nt; t += 2) {
            const bool last = (t == nt - 2);
            const char* a1 = cA + (size_t)(t + 1) * kstep;
            const char* a2 = last ? nA : cA + (size_t)(t + 2) * kstep; const char* b2 = last ? nB : cB + (size_t)(t + 2) * kstep;
            const char* a3 = a2 + kstep; const char* b3 = b2 + kstep;
            PG8_LDB(B0, 0, 0); PG8_LDB(B1, 0, 1); PG8_SCHED; PG8_LDA(At, 0, 0); PG8_STAGE(PG8_SA(1, 1), a1 + hsA, vA1);
            if (last && has_next) { vA0[0] = nA0[0]; vA0[1] = nA0[1]; vA1[0] = nA1[0]; vA1[1] = nA1[1]; }
            PG8_WAIT_V(8); PG8_WAIT_L(0); PG8_BAR; PG8_MMA(0, 0, At, B0); PG8_MMA(0, 1, At, B1); PG8_BAR; PG8_SCHED;
            PG8_LDA(At, 0, 1); PG8_STAGE(PG8_SB(0, 0), b2, voffB); PG8_STAGE(PG8_SB(0, 1), b2 + hstep, voffB); PG8_STAGE(PG8_SA(0, 0), a2, vA0);
            PG8_WAIT_V(8); PG8_WAIT_L(0); PG8_BAR; PG8_MMA(1, 0, At, B0); PG8_MMA(1, 1, At, B1); PG8_BAR; PG8_SCHED;
            PG8_LDB(B0, 1, 0); PG8_LDB(B1, 1, 1); PG8_SCHED; PG8_LDA(At, 1, 0); PG8_STAGE(PG8_SA(0, 1), a2 + hsA, vA1);
            PG8_WAIT_V(8); PG8_WAIT_L(0); PG8_BAR; PG8_MMA(0, 0, At, B0); PG8_MMA(0, 1, At, B1); PG8_BAR; PG8_SCHED;
            PG8_LDA(At, 1, 1); PG8_STAGE(PG8_SB(1, 0), b3, voffB); PG8_STAGE(PG8_SB(1, 1), b3 + hstep, voffB); PG8_STAGE(PG8_SA(1, 0), a3, vA0);
            PG8_WAIT_V(8); PG8_WAIT_L(0); PG8_BAR; PG8_MMA(1, 0, At, B0); PG8_MMA(1, 1, At, B1); PG8_BAR; PG8_SCHED;
        }
        if (wr == 0) PG8_BAR;
        if constexpr (FP8) {
#pragma unroll
            for (int a = 0; a < 2; ++a)
#pragma unroll
                for (int b = 0; b < 2; ++b) asm volatile("s_nop 15" : "+v"(acc[a][b][0][0]), "+v"(acc[a][b][0][1]), "+v"(acc[a][b][1][0]), "+v"(acc[a][b][1][1]), "+v"(acc[a][b][2][0]), "+v"(acc[a][b][2][1]), "+v"(acc[a][b][3][0]), "+v"(acc[a][b][3][1]));
        }
        const bool keep_acc = E(acc, cur, wr, wc, fr, fq);
        if (!has_next) break;
        if (!keep_acc)
#pragma unroll
        for (int a = 0; a < 2; ++a)
#pragma unroll
            for (int b = 0; b < 2; ++b)
#pragma unroll
                for (int m = 0; m < 4; ++m)
#pragma unroll
                    for (int n = 0; n < 2; ++n) acc[a][b][m][n] = (f32x4){0.f, 0.f, 0.f, 0.f};
        cur = nxt; cA = nA; cB = nB;
        if (wr == 1) PG8_BAR;
    }
    PG8_WAIT_V(0);
    PG8_BAR;
#undef PG8_AOFF
#undef PG8_SA
#undef PG8_SB
#undef PG8_STAGE
#undef PG8_LDA
#undef PG8_LDB
#undef PG8_MMA
#undef PG8_LD8
#undef PG8_WAIT_V
#undef PG8_WAIT_L
#undef PG8_BAR
#undef PG8_SCHED
}

struct EpiBf16 {
    static constexpr bool PERM = true;
    bf16_t* O; int ldc; const float* bias; int bias_estride; float ascale; int skip_from, skip_cols;
    __device__ __forceinline__ bool operator()(const f32x4 (&acc)[2][2][4][2], const Unit& u, int wr, int wc, int fr, int fq) const {
        const int row0 = u.pm * BM + wr * 64 + fr; const int col0 = u.pn * BM + wc * 32 + 8 * fq + (u.pn >= skip_from ? skip_cols : 0);
        f32x4 bv[2][2];
#pragma unroll
        for (int bj = 0; bj < 2; ++bj)
#pragma unroll
            for (int n = 0; n < 2; ++n) bv[bj][n] = bias ? *(const f32x4*)(bias + (size_t)u.e * bias_estride + col0 + bj * HALF + 4 * n) : (f32x4){0.f, 0.f, 0.f, 0.f};
#pragma unroll
        for (int ai = 0; ai < 2; ++ai)
#pragma unroll
            for (int m = 0; m < 4; ++m) { bf16_t* rowp = O + (size_t)(row0 + ai * HALF + m * 16) * ldc + col0;
#pragma unroll
                for (int bj = 0; bj < 2; ++bj) { const f32x4 v0 = acc[ai][bj][m][0] * ascale + bv[bj][0], v1 = acc[ai][bj][m][1] * ascale + bv[bj][1];
                    u32x4 w; w.x = cvt_pk_bf16(v0[0], v0[1]); w.y = cvt_pk_bf16(v0[2], v0[3]); w.z = cvt_pk_bf16(v1[0], v1[1]); w.w = cvt_pk_bf16(v1[2], v1[3]);
                    *(u32x4*)(rowp + bj * HALF) = w; } }
        return false;
    }
};
__device__ __forceinline__ float swiglu1(float ug, float ul) {
    ug = fminf(ug, 7.0f); ul = fminf(fmaxf(ul, -7.0f), 7.0f);
    return ug * __builtin_amdgcn_rcpf(1.0f + __expf(-1.702f * ug)) * (ul + 1.0f);
}
struct EpiSwiglu {
    static constexpr bool PERM = true;
    unsigned char* O; const float* b1;
    __device__ __forceinline__ bool operator()(const f32x4 (&acc)[2][2][4][2], const Unit& u, int wr, int wc, int fr, int fq) const {
        const int row0 = u.pm * BM + wr * 64 + fr; const int c0 = u.pn * 128 + wc * 32 + 8 * fq;
        const float* bg = b1 + (size_t)u.e * 4096 + c0; const float* bl = bg + 2048;
        f32x4 bgv[2], blv[2];
#pragma unroll
        for (int n = 0; n < 2; ++n) { bgv[n] = *(const f32x4*)(bg + 4 * n); blv[n] = *(const f32x4*)(bl + 4 * n); }
#pragma unroll
        for (int ai = 0; ai < 2; ++ai)
#pragma unroll
            for (int m = 0; m < 4; ++m) {
                float a[8];
#pragma unroll
                for (int n = 0; n < 2; ++n)
#pragma unroll
                    for (int j = 0; j < 4; ++j) a[4 * n + j] = ACT8_SCALE * swiglu1(acc[ai][0][m][n][j] * (1.0f / W8_SCALE) + bgv[n][j], acc[ai][1][m][n][j] * (1.0f / W8_SCALE) + blv[n][j]);
                u32x2 w; w.x = pack4_fp8(a[0], a[1], a[2], a[3]); w.y = pack4_fp8(a[4], a[5], a[6], a[7]);
                *(u32x2*)(O + (size_t)(row0 + ai * HALF + m * 16) * 2048 + c0) = w;
            }
        return false;
    }
};

struct TwoPartOrder {
    StaticOrder so; Unit held; int part;
    __device__ void init(int M, int N, int G_, int c_) { so.init(M, N, G_, c_); part = 0; }
    __device__ bool next(Unit& u) { if (part == 1) { u = held; u.e = 1; part = 0; return true; } if (!so.next(held)) return false; u = held; u.e = 0; part = 1; return true; }
};
struct EpiGate2 {
    static constexpr bool PERM = true;
    unsigned char* O; const bf16_t* Ga; const bf16_t* Gr;
    __device__ __forceinline__ bool operator()(f32x4 (&acc)[2][2][4][2], const Unit& u, int wr, int wc, int fr, int fq) const {
        const int row0 = u.pm * BM + wr * 64 + fr; const int col0 = u.pn * BM + wc * 32 + 8 * fq;
#pragma unroll
        for (int ai = 0; ai < 2; ++ai)
#pragma unroll
            for (int m = 0; m < 4; ++m) { const size_t row = (size_t)(row0 + ai * HALF + m * 16);
#pragma unroll
                for (int bj = 0; bj < 2; ++bj) { const int c = col0 + bj * HALF;
                    const u32x4 gr = *(const u32x4*)(Gr + row * DINP + c);
                    if (u.e == 0) {
                        const u32x4 ga = *(const u32x4*)(Ga + row * DINP + c);
#pragma unroll
                        for (int q = 0; q < 4; ++q) {
                            const float r0 = (1.0f + __expf(-bf_lo(gr[q]))) * __builtin_amdgcn_rcpf(1.0f + __expf(-bf_lo(ga[q]))), r1 = (1.0f + __expf(-bf_hi(gr[q]))) * __builtin_amdgcn_rcpf(1.0f + __expf(-bf_hi(ga[q])));
                            acc[ai][bj][m][q >> 1][(2 * q) & 3] *= r0; acc[ai][bj][m][q >> 1][(2 * q + 1) & 3] *= r1; }
                    } else {
                        float r[8];
#pragma unroll
                        for (int q = 0; q < 4; ++q) { r[2 * q] = sigmoidf_(bf_lo(gr[q])) * acc[ai][bj][m][q >> 1][(2 * q) & 3]; r[2 * q + 1] = sigmoidf_(bf_hi(gr[q])) * acc[ai][bj][m][q >> 1][(2 * q + 1) & 3]; }
                        u32x2 w; w.x = pack4_fp8(r[0] * MRG8_SCALE, r[1] * MRG8_SCALE, r[2] * MRG8_SCALE, r[3] * MRG8_SCALE); w.y = pack4_fp8(r[4] * MRG8_SCALE, r[5] * MRG8_SCALE, r[6] * MRG8_SCALE, r[7] * MRG8_SCALE);
                        *(u32x2*)(O + row * 2048 + c) = w; } } }
        return u.e == 0;
    }
};
struct EpiDelta {
    static constexpr bool PERM = true;
    const float* gt; bf16_t* DL; float ascale;
    __device__ __forceinline__ bool operator()(const f32x4 (&acc)[2][2][4][2], const Unit& u, int wr, int wc, int fr, int fq) const {
        const int row0 = u.pm * BM + wr * 64 + fr; const int col0 = u.pn * BM + wc * 32 + 8 * fq;
        f32x4 g[2][2];
#pragma unroll
        for (int bj = 0; bj < 2; ++bj)
#pragma unroll
            for (int n = 0; n < 2; ++n) g[bj][n] = *(const f32x4*)(gt + col0 + bj * HALF + 4 * n);
#pragma unroll
        for (int ai = 0; ai < 2; ++ai)
#pragma unroll
            for (int m = 0; m < 4; ++m) { bf16_t* rowp = DL + (size_t)(row0 + ai * HALF + m * 16) * 2048 + col0;
#pragma unroll
                for (int bj = 0; bj < 2; ++bj) { const f32x4 v0 = acc[ai][bj][m][0] * ascale * g[bj][0], v1 = acc[ai][bj][m][1] * ascale * g[bj][1];
                    u32x4 w; w.x = cvt_pk_bf16(v0[0], v0[1]); w.y = cvt_pk_bf16(v0[2], v0[3]); w.z = cvt_pk_bf16(v1[0], v1[1]); w.w = cvt_pk_bf16(v1[2], v1[3]);
                    *(u32x4*)(rowp + bj * HALF) = w; } }
        return false;
    }
};
}

struct Args { const void* in[22]; float* out; unsigned char* ws; int ph_lo, ph_hi, flags, pad; };
constexpr int XCONV = 0, XSCORE = 96;
constexpr int CW_SCQ = 12288, SCP = 5, CW_ATQ = 12352;
enum { PH_PRO = 0, PH_H, PH_INPROJ, PH_POST, PH_SCORE, PH_SELECT, PH_ATTN, PH_OP1, PH_OP2, PH_WOUT, PH_ROUTER, PH_SCATTER, PH_MOE1, PH_MOE2, PH_FINAL, NPH };

__device__ __forceinline__ int dest_row(int mode, int n) {
    if (mode == 1) return n < 2640 ? n : n + 176;
    if (mode == 2) { const int g = n >> 11, c = n & 2047; return (c >> 7) * 256 + g * 128 + (c & 127); }
    return n;
}
__device__ __forceinline__ void convert_item(const float* __restrict__ W, int K, int N, int ld, bf16_t* WT, int mode, int item, int lane, LAS unsigned char* scr) {
    const int nblk = (N + 63) >> 6; const int kb = item / nblk, nb = item - kb * nblk; const int k0 = kb * 128, n0 = nb * 64;
    const int c4 = lane & 15, kr = lane >> 4;
    const bool ok = (n0 + 4 * c4) < N;
    const float* src = W + (size_t)(k0 + 2 * kr) * ld + n0 + 4 * c4;
#pragma unroll 4
    for (int i = 0; i < 16; ++i) {
        f32x4 v0 = (f32x4){0.f, 0.f, 0.f, 0.f}, v1 = v0;
        if (ok) { v0 = *(const f32x4*)(src + (size_t)(8 * i) * ld); v1 = *(const f32x4*)(src + (size_t)(8 * i + 1) * ld); }
        const int kk = 8 * i + 2 * kr;
#pragma unroll
        for (int e = 0; e < 4; ++e) *(LAS unsigned*)(scr + (4 * c4 + e) * 272 + kk * 2) = cvt_pk_bf16(v0[e], v1[e]);
    }
    LDS_WAIT(); asm volatile("" ::: "memory");
#pragma unroll 4
    for (int j = 0; j < 16; ++j) {
        const int q = j * 64 + lane, n = q >> 4, ch = q & 15;
        const u32x4 v = *(const LAS u32x4*)(scr + n * 272 + ch * 16);
        if (n0 + n < N) *(u32x4*)(WT + (size_t)dest_row(mode, n0 + n) * K + k0 + ch * 8) = v;
    }
    LDS_WAIT(); asm volatile("" ::: "memory");
}


__device__ __forceinline__ bf16_t f2bf(float f) { unsigned u = __float_as_uint(f); return (bf16_t)((u + 0x7fffu + ((u >> 16) & 1u)) >> 16); }
__device__ __forceinline__ float bfx(const u32x4& w, int i) { const unsigned u = w[i >> 1]; return (i & 1) ? bf_hi(u) : bf_lo(u); }
__device__ __forceinline__ void rope_sc(float pos, float inv, float& sn, float& cs) {
    const float ang = pos * inv;
    const double a = (double)ang; const double n = __builtin_rint(a * 0.15915494309189535); const float r = (float)(a - n * 6.283185307179586);
    sn = sinf(r); cs = cosf(r);
}
__device__ __forceinline__ void post_token(bf16_t* PROJ, bf16_t* KI, unsigned char* KC, unsigned char* VC, const int* positions, const float* kng, const float* knb, int t, int lane) {
    const float pos = (float)positions[t];
    bf16_t* row = PROJ + (size_t)t * DINP;
    float sn, cs;
#pragma unroll
    for (int i = 0; i < 2; ++i) {
        const int pp = lane + 64 * i, hd = pp >> 4, ii = pp & 15;
        rope_sc(pos, powf(500000.0f, -(float)ii * (1.0f / 16.0f)), sn, cs);
        bf16_t* p = row + CQ + hd * 128 + ii; const float a = bf2f(p[0]), b = bf2f(p[16]);
        p[0] = f2bf(a * cs - b * sn); p[16] = f2bf(b * cs + a * sn);
    }
#pragma unroll
    for (int i = 0; i < 2; ++i) {
        const int pp = lane + 64 * i, hd = pp >> 3, ii = pp & 7;
        rope_sc(pos, powf(500000.0f, -(float)ii * (1.0f / 8.0f)), sn, cs);
        bf16_t* p = row + CQI + hd * 64 + ii; const float a = bf2f(p[0]), b = bf2f(p[8]);
        p[0] = f2bf(a * cs - b * sn); p[8] = f2bf(b * cs + a * sn);
    }
    if (lane < 32) {
        const int g = lane >> 4, ii = lane & 15;
        rope_sc(pos, powf(500000.0f, -(float)ii * (1.0f / 16.0f)), sn, cs);
        const bf16_t* p = row + CK + g * 128 + ii; const float a = bf2f(p[0]), b = bf2f(p[16]);
        unsigned char* o = KC + (size_t)t * 256 + g * 128 + ii; o[0] = fp8_1(a * cs - b * sn); o[16] = fp8_1(b * cs + a * sn);
    }
#pragma unroll
    for (int i = 0; i < 3; ++i) { const int idx = lane + 64 * i, g = idx / 96, r = idx - g * 96; KC[(size_t)t * 256 + g * 128 + 32 + r] = fp8_1(bf2f(row[CK + g * 128 + 32 + r])); }
    { const u32x2 w = *(const u32x2*)(row + CV + 4 * lane); *(unsigned*)(VC + (size_t)t * 256 + 4 * lane) = pack4_fp8(bf_lo(w.x), bf_hi(w.x), bf_lo(w.y), bf_hi(w.y)); }
    {
        const float v = bf2f(row[CKI + lane]);
        const float mean = wave_sum(v) * (1.0f / 64.0f); const float d = v - mean; const float var = wave_sum(d * d) * (1.0f / 64.0f);
        const float y = d * rsqrtf(var + NORM_EPS) * kng[lane] + knb[lane];
        const float other = __shfl_xor(y, 8);
        rope_sc(pos, powf(500000.0f, -(float)(lane & 7) * (1.0f / 8.0f)), sn, cs);
        float o = y;
        if (lane < 8) o = y * cs - other * sn; else if (lane < 16) o = y * cs + other * sn;
        KI[(size_t)t * 64 + lane] = f2bf(o);
    }
}

constexpr int HG_GB = 0, HG_Q1 = 33792, HG_Q2 = 51200, HG_K2 = 68608, HG_VT = 86016, HG_PB = 104448, HG_LB = 113664;
__device__ __forceinline__ void hgrn_cumsum(LAS unsigned char* lds, const u32x4& w0, const u32x4& w1, float l0, float l1, int tid) {
    LAS float* GB = (LAS float*)(lds + HG_GB); LAS float* LB = (LAS float*)(lds + HG_LB); LAS float* SEG = (LAS float*)(lds + HG_LB + 512);
    if (tid < 128) LB[tid] = 1.0f / (1.0f + expf(l1 - l0));
    __syncthreads();
    const int t = tid >> 3, dseg = tid & 7;
#pragma unroll
    for (int i = 0; i < 16; ++i) { const float z = i < 8 ? bfx(w0, i) : bfx(w1, i - 8); const float lb = LB[16 * dseg + i]; GB[t * 128 + 16 * dseg + i] = logf(lb + (1.0f - lb) * sigmoidf_(z)); }
    __syncthreads();
    const int d = tid & 127, tq = tid >> 7;
    float z[16];
#pragma unroll
    for (int i = 0; i < 16; ++i) z[i] = GB[(16 * tq + i) * 128 + d];
    float a = 0.f;
#pragma unroll
    for (int i = 0; i < 16; ++i) { a += z[i]; z[i] = a; }
    SEG[tq * 128 + d] = a;
    __syncthreads();
    float pre = 0.f;
    for (int q = 0; q < tq; ++q) pre += SEG[q * 128 + d];
#pragma unroll
    for (int i = 0; i < 16; ++i) GB[(16 * tq + i) * 128 + d] = z[i] + pre;
    __syncthreads();
}
__device__ __forceinline__ void hgrn_vt(LAS unsigned char* lds, const u32x4& a, const u32x4& b, int tid) {
    const int s2 = tid & 31, eg = tid >> 5;
#pragma unroll
    for (int i = 0; i < 8; ++i) { const unsigned lo = (i & 1) ? (a[i >> 1] >> 16) : (a[i >> 1] & 0xffffu), hi = (i & 1) ? (b[i >> 1] >> 16) : (b[i >> 1] & 0xffffu);
        *(LAS unsigned*)(lds + HG_VT + (8 * eg + i) * 144 + s2 * 4) = lo | (hi << 16); }
}
__device__ __forceinline__ void hgrn_l1(LAS unsigned char* lds, const bf16_t* PROJ, const float* lb_logits, float* ST, float* DC, int c, int h, int tid, int wave, int lane) {
    const int t = tid >> 3, dseg = tid & 7, s2 = tid & 31, dg = tid >> 5;
    const bf16_t* pf = PROJ + (size_t)(c * 64 + t) * DINP + CHF + h * 128 + 16 * dseg;
    const bf16_t* pk = PROJ + (size_t)(c * 64 + 2 * s2) * DINP + CHF + h * 128 + 8 * dg;
    const u32x4 w0 = *(const u32x4*)pf, w1 = *(const u32x4*)(pf + 8);
    const u32x4 ka = *(const u32x4*)pk, kb = *(const u32x4*)(pk + DINP);
    const u32x4 va = *(const u32x4*)(pk - CHF + CHI), vb = *(const u32x4*)(pk - CHF + CHI + DINP);
    const float l0 = lb_logits[h * 128 + (tid & 127)], l1 = lb_logits[1024 + h * 128 + (tid & 127)];
    hgrn_cumsum(lds, w0, w1, l0, l1, tid);
    const LAS float* GB = (const LAS float*)(lds + HG_GB); const LAS float* LB = (const LAS float*)(lds + HG_LB);
    {
#pragma unroll
        for (int i = 0; i < 8; ++i) { const int d = 8 * dg + i; const float lb = LB[d], b63 = GB[63 * 128 + d];
            const float k0 = (1.0f - lb) * (1.0f - sigmoidf_(bfx(ka, i))), k1 = (1.0f - lb) * (1.0f - sigmoidf_(bfx(kb, i)));
            const float v0 = k0 * __expf(b63 - GB[(2 * s2) * 128 + d]), v1 = k1 * __expf(b63 - GB[(2 * s2 + 1) * 128 + d]);
            *(LAS unsigned*)(lds + HG_Q1 + d * 144 + s2 * 4) = cvt_pk_bf16(v0, v1); }
    }
    hgrn_vt(lds, va, vb, tid);
    __syncthreads();
    const int fr = lane & 15, fq = lane >> 4;
    bf16x8 af[2];
#pragma unroll
    for (int ks = 0; ks < 2; ++ks) af[ks] = *(const LAS bf16x8*)(lds + HG_VT + (16 * wave + fr) * 144 + (32 * ks + 8 * fq) * 2);
    float* dst = ST + ((size_t)(c * 8 + h) * 128) * 128;
#pragma unroll 2
    for (int dt = 0; dt < 8; ++dt) {
        f32x4 acc = (f32x4){0.f, 0.f, 0.f, 0.f};
#pragma unroll
        for (int ks = 0; ks < 2; ++ks) { const bf16x8 bfr = *(const LAS bf16x8*)(lds + HG_Q1 + (16 * dt + fr) * 144 + (32 * ks + 8 * fq) * 2); acc = __builtin_amdgcn_mfma_f32_16x16x32_bf16(af[ks], bfr, acc, 0, 0, 0); }
#pragma unroll
        for (int r = 0; r < 4; ++r) dst[(size_t)(16 * wave + 4 * fq + r) * 128 + 16 * dt + fr] = acc[r];
    }
    if (tid < 128) DC[(size_t)(c * 8 + h) * 128 + tid] = __expf(GB[63 * 128 + tid]);
    __syncthreads();
}
__device__ __forceinline__ void hgrn_l3(LAS unsigned char* lds, const bf16_t* PROJ, const float* lb_logits, const float* ST, const float* norm_g, bf16_t* REC, int c, int h, int tid, int wave, int lane) {
    const int t = tid >> 3, dseg = tid & 7, s2 = tid & 31, eg = tid >> 5, fr = lane & 15, fq = lane >> 4;
    const bf16_t* pf = PROJ + (size_t)(c * 64 + t) * DINP + CHF + h * 128 + 16 * dseg;
    const u32x4 f0 = *(const u32x4*)pf, f1 = *(const u32x4*)(pf + 8), q0 = *(const u32x4*)(pf - CHF + CHQ), q1 = *(const u32x4*)(pf - CHF + CHQ + 8);
    const u32x4 g0 = *(const u32x4*)(pf - CHF + CHG), g1 = *(const u32x4*)(pf - CHF + CHG + 8);
    const bf16_t* pv = PROJ + (size_t)(c * 64 + 2 * s2) * DINP + CHI + h * 128 + 8 * eg;
    const u32x4 va = *(const u32x4*)pv, vb = *(const u32x4*)(pv + DINP);
    const float* sp = ST + ((size_t)(c * 8 + h) * 128 + 16 * wave + fr) * 128 + 8 * fq;
    f32x4 sx[4][2];
#pragma unroll
    for (int ks = 0; ks < 4; ++ks) { sx[ks][0] = *(const f32x4*)(sp + 32 * ks); sx[ks][1] = *(const f32x4*)(sp + 32 * ks + 4); }
    const float l0 = lb_logits[h * 128 + (tid & 127)], l1 = lb_logits[1024 + h * 128 + (tid & 127)];
    hgrn_cumsum(lds, f0, f1, l0, l1, tid);
    const LAS float* GB = (const LAS float*)(lds + HG_GB); const LAS float* LB = (const LAS float*)(lds + HG_LB);
    {
        unsigned o1[8], o2[8], o3[8];
#pragma unroll
        for (int i = 0; i < 16; i += 2) {
            float a1[2], a2[2], a3[2];
#pragma unroll
            for (int j = 0; j < 2; ++j) { const int d = 16 * dseg + i + j; const float lb = LB[d], b = GB[t * 128 + d], br = GB[31 * 128 + d];
                const float z = (i + j) < 8 ? bfx(f0, i + j) : bfx(f1, i + j - 8), qv = (i + j) < 8 ? bfx(q0, i + j) : bfx(q1, i + j - 8);
                const float k = (1.0f - lb) * (1.0f - sigmoidf_(z)), q = siluf_(qv);
                a1[j] = q * __expf(b); a2[j] = q * __expf(b - br); a3[j] = k * __expf(br - b); }
            o1[i >> 1] = cvt_pk_bf16(a1[0], a1[1]); o2[i >> 1] = cvt_pk_bf16(a2[0], a2[1]); o3[i >> 1] = cvt_pk_bf16(a3[0], a3[1]);
        }
        LAS u32x4* d1 = (LAS u32x4*)(lds + HG_Q1 + t * 272 + dseg * 32); LAS u32x4* d2 = (LAS u32x4*)(lds + HG_Q2 + t * 272 + dseg * 32); LAS u32x4* d3 = (LAS u32x4*)(lds + HG_K2 + t * 272 + dseg * 32);
        d1[0] = (u32x4){o1[0], o1[1], o1[2], o1[3]}; d1[1] = (u32x4){o1[4], o1[5], o1[6], o1[7]};
        d2[0] = (u32x4){o2[0], o2[1], o2[2], o2[3]}; d2[1] = (u32x4){o2[4], o2[5], o2[6], o2[7]};
        d3[0] = (u32x4){o3[0], o3[1], o3[2], o3[3]}; d3[1] = (u32x4){o3[4], o3[5], o3[6], o3[7]};
    }
    hgrn_vt(lds, va, vb, tid);
    __syncthreads();
#pragma unroll
    for (int q = 0; q < 2; ++q) {
        const int tile = 2 * wave + q, tt = tile >> 2, stl = tile & 3;
        f32x4 acc = (f32x4){0.f, 0.f, 0.f, 0.f};
#pragma unroll
        for (int ks = 0; ks < 4; ++ks) { const bf16x8 a = *(const LAS bf16x8*)(lds + HG_Q2 + (16 * tt + fr) * 272 + (32 * ks + 8 * fq) * 2), b = *(const LAS bf16x8*)(lds + HG_K2 + (16 * stl + fr) * 272 + (32 * ks + 8 * fq) * 2);
            acc = __builtin_amdgcn_mfma_f32_16x16x32_bf16(a, b, acc, 0, 0, 0); }
#pragma unroll
        for (int r = 0; r < 4; ++r) { const int tr_ = 16 * tt + 4 * fq + r, s = 16 * stl + fr; *(LAS bf16_t*)(lds + HG_PB + tr_ * 144 + s * 2) = f2bf(s <= tr_ ? acc[r] : 0.f); }
    }
    __syncthreads();
    {
        bf16x8 b1[2], b2[4];
#pragma unroll
        for (int ks = 0; ks < 2; ++ks) b1[ks] = *(const LAS bf16x8*)(lds + HG_VT + (16 * wave + fr) * 144 + (32 * ks + 8 * fq) * 2);
#pragma unroll
        for (int ks = 0; ks < 4; ++ks) { const f32x4 x0 = sx[ks][0], x1 = sx[ks][1];
            u32x4 w; w.x = cvt_pk_bf16(x0[0], x0[1]); w.y = cvt_pk_bf16(x0[2], x0[3]); w.z = cvt_pk_bf16(x1[0], x1[1]); w.w = cvt_pk_bf16(x1[2], x1[3]); b2[ks] = __builtin_bit_cast(bf16x8, w); }
        LAS float* OB = (LAS float*)(lds + HG_GB);
#pragma unroll
        for (int tt = 0; tt < 4; ++tt) {
            f32x4 acc = (f32x4){0.f, 0.f, 0.f, 0.f};
#pragma unroll
            for (int ks = 0; ks < 2; ++ks) { const bf16x8 a = *(const LAS bf16x8*)(lds + HG_PB + (16 * tt + fr) * 144 + (32 * ks + 8 * fq) * 2); acc = __builtin_amdgcn_mfma_f32_16x16x32_bf16(a, b1[ks], acc, 0, 0, 0); }
#pragma unroll
            for (int ks = 0; ks < 4; ++ks) { const bf16x8 a = *(const LAS bf16x8*)(lds + HG_Q1 + (16 * tt + fr) * 272 + (32 * ks + 8 * fq) * 2); acc = __builtin_amdgcn_mfma_f32_16x16x32_bf16(a, b2[ks], acc, 0, 0, 0); }
#pragma unroll
            for (int r = 0; r < 4; ++r) OB[(16 * tt + 4 * fq + r) * 132 + 16 * wave + fr] = acc[r];
        }
    }
    __syncthreads();
    {
        const int es = dseg; const LAS float* OB = (const LAS float*)(lds + HG_GB);
        float o[16]; float ss = 0.f;
#pragma unroll
        for (int i = 0; i < 16; ++i) { o[i] = OB[t * 132 + 16 * es + i]; ss += o[i] * o[i]; }
        ss += __shfl_xor(ss, 1); ss += __shfl_xor(ss, 2); ss += __shfl_xor(ss, 4);
        const float rstd = rsqrtf(ss * (1.0f / 128.0f) + NORM_EPS);
        unsigned w[8];
#pragma unroll
        for (int i = 0; i < 16; i += 2) { const float ga = i < 8 ? bfx(g0, i) : bfx(g1, i - 8), gb = (i + 1) < 8 ? bfx(g0, i + 1) : bfx(g1, i + 1 - 8);
            w[i >> 1] = cvt_pk_bf16(o[i] * rstd * norm_g[16 * es + i] * siluf_(ga), o[i + 1] * rstd * norm_g[16 * es + i + 1] * siluf_(gb)); }
        u32x4* dst = (u32x4*)(REC + (size_t)(c * 64 + t) * 1024 + h * 128 + 16 * es);
        dst[0] = (u32x4){w[0], w[1], w[2], w[3]}; dst[1] = (u32x4){w[4], w[5], w[6], w[7]};
    }
    __syncthreads();
}

constexpr int SC_KT = 0, SC_SB = 36864, SC_SPITCH = 132;
__device__ __forceinline__ unsigned pk_f16(float a, float b) { return __builtin_bit_cast(unsigned, __builtin_amdgcn_cvt_pkrtz(a, b)); }
__device__ __forceinline__ void score_flush(LAS unsigned char* lds, unsigned short* SCORES, unsigned short* SEGMAX, int t0, int kt, int tid) {
    const LAS float* sb = (const LAS float*)(lds + SC_SB + (kt & 1) * (32 * SC_SPITCH * 4));
    const int row = tid >> 4, seg = tid & 15;
    const f32x4 a = *(const LAS f32x4*)(sb + row * SC_SPITCH + seg * 8), b = *(const LAS f32x4*)(sb + row * SC_SPITCH + seg * 8 + 4);
    unsigned short* dst = SCORES + (size_t)(t0 + row) * S + kt * 128 + seg * 8;
    *(u32x4*)dst = (u32x4){pk_f16(a[0], a[1]), pk_f16(a[2], a[3]), pk_f16(b[0], b[1]), pk_f16(b[2], b[3])};
    const float mx = fmaxf(fmaxf(fmaxf(a[0], a[1]), fmaxf(a[2], a[3])), fmaxf(fmaxf(b[0], b[1]), fmaxf(b[2], b[3])));
    SEGMAX[(size_t)(t0 + row) * 2048 + kt * 16 + seg] = (unsigned short)(pk_f16(mx, mx) & 0xffffu);
}
__device__ __forceinline__ void score_block(LAS unsigned char* lds, const bf16_t* PROJ, const bf16_t* KI, unsigned short* SCORES, unsigned short* SEGMAX, int qb, int kt0, int kt1, int tid, int wave, int lane) {
    const int t0 = qb * 32;
    const int r = lane & 31, hh = lane >> 5;
    bf16x8 Af[2][4]; float wv[2][16]; f32x2 wv2[2][8];
#pragma unroll
    for (int p = 0; p < 2; ++p) {
        const int tq = t0 + 4 * wave + 2 * p + (r >> 4); const bf16_t* qrow = PROJ + (size_t)tq * DINP + CQI + (r & 15) * 64 + 8 * hh;
#pragma unroll
        for (int ks = 0; ks < 4; ++ks) Af[p][ks] = *(const bf16x8*)(qrow + 16 * ks);
#pragma unroll
        for (int reg = 0; reg < 16; ++reg) { const int row = (reg & 3) + 8 * (reg >> 2) + 4 * hh; const int tw = t0 + 4 * wave + 2 * p + (row >> 4);
            wv[p][reg] = bf2f(PROJ[(size_t)tw * DINP + CWI + (row & 15)]) * (1.0f / 32.0f); }
#pragma unroll
        for (int i = 0; i < 8; ++i) wv2[p][i] = (f32x2){wv[p][2 * i], wv[p][2 * i + 1]};
    }
    const u32x2 tagsw = __builtin_amdgcn_permlane32_swap(0u, 1u, false, false); const int qsel = (int)tagsw[0];
    u32x4 stg[2];
#pragma unroll
    for (int i = 0; i < 2; ++i) { const int q = tid + 512 * i; stg[i] = *(const u32x4*)(KI + (size_t)(kt0 * 128 + (q >> 3)) * 64 + (q & 7) * 8); }
#pragma unroll
    for (int i = 0; i < 2; ++i) { const int q = tid + 512 * i; *(LAS u32x4*)(lds + SC_KT + (kt0 & 1) * 18432 + (q >> 3) * 144 + (q & 7) * 16) = stg[i]; }
    __syncthreads();
    for (int kt = kt0; kt < kt1; ++kt) {
        const LAS unsigned char* buf = lds + SC_KT + (kt & 1) * 18432;
        LAS float* sb = (LAS float*)(lds + SC_SB + (kt & 1) * (32 * SC_SPITCH * 4));
        if (kt + 1 < kt1) {
#pragma unroll
            for (int i = 0; i < 2; ++i) { const int q = tid + 512 * i; stg[i] = *(const u32x4*)(KI + (size_t)((kt + 1) * 128 + (q >> 3)) * 64 + (q & 7) * 8); }
        }
        __builtin_amdgcn_sched_barrier(0);
        if (kt > kt0) score_flush(lds, SCORES, SEGMAX, t0, kt - 1, tid);
        {
        f32x16 accP[2], accC[2];
#define SC_MFMA(cb) do { bf16x8 Bf[4]; _Pragma("unroll") for (int ks = 0; ks < 4; ++ks) Bf[ks] = *(const LAS bf16x8*)(buf + (32 * (cb) + r) * 144 + (16 * ks + 8 * hh) * 2); \
            _Pragma("unroll") for (int p = 0; p < 2; ++p) { _Pragma("unroll") for (int i = 0; i < 16; ++i) accC[p][i] = 0.f; \
                _Pragma("unroll") for (int ks = 0; ks < 4; ++ks) accC[p] = __builtin_amdgcn_mfma_f32_32x32x16_bf16(Af[p][ks], Bf[ks], accC[p], 0, 0, 0); } } while (0)
#define SC_RED(acc, cb) do { _Pragma("unroll") for (int p = 0; p < 2; ++p) { f32x2 s0 = {0.f, 0.f}, s1 = {0.f, 0.f}; \
            _Pragma("unroll") for (int reg = 0; reg < 8; reg += 2) { const f32x2 r0 = {relu_i(acc[p][reg]), relu_i(acc[p][reg + 1])}; const f32x2 r1 = {relu_i(acc[p][reg + 8]), relu_i(acc[p][reg + 9])}; \
                s0 = __builtin_elementwise_fma(wv2[p][reg >> 1], r0, s0); s1 = __builtin_elementwise_fma(wv2[p][4 + (reg >> 1)], r1, s1); } \
            const float p0 = s0[0] + s0[1], p1 = s1[0] + s1[1]; \
            const u32x2 sw = __builtin_amdgcn_permlane32_swap(__float_as_uint(p0), __float_as_uint(p1), false, false); \
            sb[(4 * wave + 2 * p + qsel) * SC_SPITCH + 32 * (cb) + r] = __uint_as_float(sw[0]) + __uint_as_float(sw[1]); } } while (0)
#define SC_INTERLEAVE() do { _Pragma("unroll") for (int i = 0; i < 8; ++i) { __builtin_amdgcn_sched_group_barrier(0x008, 1, 0); __builtin_amdgcn_sched_group_barrier(0x002, 8, 0); } } while (0)
        SC_MFMA(0);
        accP[0] = accC[0]; accP[1] = accC[1]; SC_MFMA(1); SC_RED(accP, 0); SC_INTERLEAVE();
        accP[0] = accC[0]; accP[1] = accC[1]; SC_MFMA(2); SC_RED(accP, 1); SC_INTERLEAVE();
        accP[0] = accC[0]; accP[1] = accC[1]; SC_MFMA(3); SC_RED(accP, 2); SC_INTERLEAVE();
        SC_RED(accC, 3);
#undef SC_MFMA
#undef SC_RED
#undef SC_INTERLEAVE
        }
        if (kt + 1 < kt1) {
#pragma unroll
            for (int i = 0; i < 2; ++i) { const int q = tid + 512 * i; *(LAS u32x4*)(lds + SC_KT + ((kt + 1) & 1) * 18432 + (q >> 3) * 144 + (q & 7) * 16) = stg[i]; }
        }
        __syncthreads();
    }
    score_flush(lds, SCORES, SEGMAX, t0, kt1 - 1, tid);
    __syncthreads();
}

__device__ __forceinline__ float wave_kth16(const float (&v)[16], int K) {
    const float NINF = -__builtin_inff();
    float mx = NINF, mn = __builtin_inff();
#pragma unroll
    for (int j = 0; j < 16; ++j) { mx = fmaxf(mx, v[j]); mn = fminf(mn, v[j] == NINF ? __builtin_inff() : v[j]); }
    mx = wave_max(mx); mn = -wave_max(-mn);
    int c = 0;
#pragma unroll
    for (int j = 0; j < 16; ++j) c += __popcll(__ballot(v[j] >= mx));
    if (c >= K) return mx;
    float lo = mn, hi = mx, tau = mn;
    for (int it = 0; it < 64; ++it) {
        const float mid = 0.5f * (lo + hi);
        if (!(mid > lo && mid < hi)) { tau = lo; break; }
        c = 0;
#pragma unroll
        for (int j = 0; j < 16; ++j) c += __popcll(__ballot(v[j] >= mid));
        if (c == K) { tau = mid; break; }
        if (c > K) lo = mid; else hi = mid;
        tau = lo;
    }
    return tau;
}
__device__ __forceinline__ int lanes_below(unsigned long long mask) { return (int)__builtin_amdgcn_mbcnt_hi((unsigned)(mask >> 32), __builtin_amdgcn_mbcnt_lo((unsigned)mask, 0u)); }
__device__ __forceinline__ float h2f(unsigned short h) { return (float)__builtin_bit_cast(_Float16, h); }
__device__ __forceinline__ float h2f_lo(unsigned u) { return h2f((unsigned short)(u & 0xffffu)); }
__device__ __forceinline__ float h2f_hi(unsigned u) { return h2f((unsigned short)(u >> 16)); }
__device__ __forceinline__ unsigned ge_mask8(const u32x4& v, unsigned T16) {
    unsigned m8 = 0;
#pragma unroll
    for (int w = 0; w < 4; ++w) { const unsigned vw_ = v[w];
        const s16x2 d = __builtin_elementwise_sub_sat(__builtin_bit_cast(s16x2, vw_), __builtin_bit_cast(s16x2, T16));
        const unsigned mm = ~__builtin_bit_cast(unsigned, d); m8 |= (((mm >> 15) & 1u) | ((mm >> 30) & 2u)) << (2 * w); }
    return m8;
}
__device__ __forceinline__ int append_bits(LAS int* list, int cnt, unsigned m8, int base) {
    for (;;) { const bool has = m8 != 0u; const unsigned long long mask = __ballot(has); if (!mask) break;
        const int pos = cnt + lanes_below(mask);
        if (has) { const int k = __builtin_ctz(m8); m8 &= m8 - 1u; if (pos < 1024) list[pos] = base + k; }
        cnt += __popcll(mask); }
    return cnt;
}
__device__ __forceinline__ void select_row(LAS unsigned char* wl, const unsigned short* SCORES, const unsigned short* SEGMAX, int t, int lane) {
    LAS int* selw = (LAS int*)wl; LAS int* segl = (LAS int*)(wl + 1024); LAS int* cidx = (LAS int*)(wl + 5120);
    const float NINF = -__builtin_inff();
    const unsigned short* row = SCORES + (size_t)t * S; const int n = t + 1;
    float c[16]; int N;
    if (n <= 1024) {
#pragma unroll
        for (int j = 0; j < 16; ++j) { const int i = lane + 64 * j; c[j] = i < n ? h2f(row[i]) : NINF; }
        N = -1;
    } else {
        const int m = n >> 4; float s[16];
#pragma unroll
        for (int j = 0; j < 16; ++j) { const int i = lane + 64 * j; s[j] = i < m ? h2f(row[16 * i + 7]) : NINF; }
        int K = 32, cnt = 0;
        for (;;) {
            const float tlo = (K >= m) ? NINF : wave_kth16(s, K);
            cnt = 0;
            const int nq = (n + 511) >> 9;
            if (tlo > 0.f) {
                const unsigned T16 = pk_f16(tlo, tlo);
                const u32x4 NEG = (u32x4){0xfc00fc00u, 0xfc00fc00u, 0xfc00fc00u, 0xfc00fc00u};
                const unsigned short* smrow = SEGMAX + (size_t)t * 2048; const int nseg = (t >> 3) + 1;
                int ns = 0;
                {
                    u32x4 sv[4];
#pragma unroll
                    for (int u = 0; u < 4; ++u) { const int e8 = 8 * (lane + 64 * u); sv[u] = (e8 < nseg) ? *(const u32x4*)(smrow + e8) : NEG; }
#pragma unroll
                    for (int u = 0; u < 4; ++u) { const int e8 = 8 * (lane + 64 * u); unsigned m8 = ge_mask8(sv[u], T16);
                        const int nv = nseg - e8; if (nv < 8) m8 &= nv > 0 ? ((1u << nv) - 1u) : 0u;
                        ns = append_bits(segl, ns, m8, e8); }
                }
                if (ns > 1024) ns = 1024;
                for (int j0 = 0; j0 < ns; j0 += 256) {
                    u32x4 v[4]; int sg[4];
#pragma unroll
                    for (int u = 0; u < 4; ++u) { const int i = j0 + lane + 64 * u; sg[u] = i < ns ? segl[i] : -1; v[u] = sg[u] >= 0 ? *(const u32x4*)(row + 8 * sg[u]) : NEG; }
#pragma unroll
                    for (int u = 0; u < 4; ++u) { const int e = 8 * sg[u]; unsigned m8 = sg[u] >= 0 ? ge_mask8(v[u], T16) : 0u;
                        const int nv = t + 1 - e; if (nv < 8) m8 &= nv > 0 ? ((1u << nv) - 1u) : 0u;
                        cnt = append_bits(cidx, cnt, m8, e); }
                }
            } else {
                for (int q0 = 0; q0 < nq; q0 += 4) {
                    u32x4 v[4];
#pragma unroll
                    for (int u = 0; u < 4; ++u) { const int e = 8 * (lane + 64 * (q0 + u)); v[u] = (e <= t) ? *(const u32x4*)(row + e) : (u32x4){0xfc00fc00u, 0xfc00fc00u, 0xfc00fc00u, 0xfc00fc00u}; }
#pragma unroll
                    for (int u = 0; u < 4; ++u) { const int e = 8 * (lane + 64 * (q0 + u));
#pragma unroll
                        for (int k = 0; k < 8; ++k) { const float x = (k & 1) ? h2f_hi(v[u][k >> 1]) : h2f_lo(v[u][k >> 1]);
                            const bool pred = (e + k <= t) && (x >= tlo); const unsigned long long mask = __ballot(pred);
                            if (mask) { const int pos = cnt + lanes_below(mask); if (pred && pos < 1024) cidx[pos] = e + k; cnt += __popcll(mask); } } }
                }
            }
            if (cnt >= 256 || K >= m) break;
            K *= 2;
        }
        N = cnt < 1024 ? cnt : 1024;
#pragma unroll
        for (int j = 0; j < 16; ++j) { const int i = lane + 64 * j; c[j] = i < N ? h2f(row[cidx[i]]) : NINF; }
    }
    const float tau = wave_kth16(c, 256);
    int base = 0;
#pragma unroll
    for (int j = 0; j < 16; ++j) { const bool pred = c[j] >= tau; const unsigned long long mask = __ballot(pred);
        if (mask) { const int pos = base + lanes_below(mask); if (pred && pos < 256) selw[pos] = (N < 0) ? (lane + 64 * j) : cidx[lane + 64 * j]; base += __popcll(mask); } }
}

__device__ __forceinline__ void attn_query(LAS unsigned char* wl, const bf16_t* PROJ, const unsigned char* KC, const unsigned char* VC, bf16_t* ATT, int t, int lane) {
    LAS int* selw = (LAS int*)wl; LAS float* L = (LAS float*)(wl + 1024);
    const int nsel = t < 255 ? t + 1 : 256;
    const int fr = lane & 15, fq = lane >> 4;
    bf16x8 qf[2][4];
#pragma unroll
    for (int g = 0; g < 2; ++g)
#pragma unroll
        for (int ks = 0; ks < 4; ++ks) { const bf16x8 z = {0, 0, 0, 0, 0, 0, 0, 0}; qf[g][ks] = fr < 4 ? *(const bf16x8*)(PROJ + (size_t)t * DINP + CQ + (4 * g + fr) * 128 + 64 * (ks >> 1) + 16 * fq + 8 * (ks & 1)) : z; }
    const float scale = 0.08838834764831845f;
    const int nkt = (nsel + 15) >> 4;
    {
        LAS unsigned char* KT = wl + 9216;
        const int q4_ = lane >> 4, l15_ = lane & 15;
        u32x4 kw[3][4];
#define QK_LOAD(buf, kt) do { _Pragma("unroll") for (int u = 0; u < 4; ++u) { const unsigned off_ = (unsigned)selw[16 * (kt) + 4 * u + q4_] * 256u + 16u * (unsigned)l15_; kw[buf][u] = *(const u32x4*)((const char*)KC + off_); } } while (0)
#define QK_COMP(buf, kt) do { _Pragma("unroll") for (int u = 0; u < 4; ++u) { u32x4 lo_, hi_; fp8x16_to_bf16(kw[buf][u], lo_, hi_); LAS u32x4* d_ = (LAS u32x4*)(KT + (4 * u + q4_) * 528 + 32 * l15_); d_[0] = lo_; d_[1] = hi_; } \
        _Pragma("unroll") for (int g = 0; g < 2; ++g) { f32x4 acc = (f32x4){0.f, 0.f, 0.f, 0.f}; \
            _Pragma("unroll") for (int ks = 0; ks < 4; ++ks) { const bf16x8 kf_ = *(const LAS bf16x8*)(KT + fr * 528 + g * 256 + (64 * (ks >> 1) + 16 * fq + 8 * (ks & 1)) * 2); \
                acc = __builtin_amdgcn_mfma_f32_16x16x32_bf16(qf[g][ks], kf_, acc, 0, 0, 0); } \
            if (fq == 0) { _Pragma("unroll") for (int r = 0; r < 4; ++r) L[(4 * g + r) * 256 + 16 * (kt) + fr] = (16 * (kt) + fr < nsel) ? acc[r] * scale : -__builtin_inff(); } } } while (0)
        QK_LOAD(0, 0); if (1 < nkt) QK_LOAD(1, 1);
        for (int kt = 0; kt < nkt; kt += 3) {
            if (kt + 2 < nkt) QK_LOAD(2, kt + 2);
            __builtin_amdgcn_sched_barrier(0);
            QK_COMP(0, kt);
            if (kt + 1 < nkt) { if (kt + 3 < nkt) QK_LOAD(0, kt + 3); __builtin_amdgcn_sched_barrier(0); QK_COMP(1, kt + 1); }
            if (kt + 2 < nkt) { if (kt + 4 < nkt) QK_LOAD(1, kt + 4); __builtin_amdgcn_sched_barrier(0); QK_COMP(2, kt + 2); }
        }
#undef QK_LOAD
#undef QK_COMP
        if (fq == 0) { for (int kt = nkt; kt < 16; ++kt) {
#pragma unroll
            for (int r = 0; r < 8; ++r) L[r * 256 + 16 * kt + fr] = -__builtin_inff(); } }
    }
    float p[8][4];
#pragma unroll
    for (int hd = 0; hd < 8; ++hd) { float m = -__builtin_inff();
#pragma unroll
        for (int i = 0; i < 4; ++i) { p[hd][i] = L[hd * 256 + lane + 64 * i]; m = fmaxf(m, p[hd][i]); }
        m = wave_max(m); float s = 0.f;
#pragma unroll
        for (int i = 0; i < 4; ++i) { p[hd][i] = __expf(p[hd][i] - m); s += p[hd][i]; }
        s = 1.0f / wave_sum(s);
#pragma unroll
        for (int i = 0; i < 4; ++i) p[hd][i] *= s; }
    LAS bf16_t* Pb = (LAS bf16_t*)(wl + 1024);
#pragma unroll
    for (int hd = 0; hd < 8; ++hd)
#pragma unroll
        for (int i = 0; i < 4; ++i) Pb[hd * 256 + lane + 64 * i] = f2bf(p[hd][i]);
    LAS unsigned char* VT = wl + 9216;
    const int ii = lane & 15, kq = lane >> 4;
    f32x4 acc[16];
#pragma unroll
    for (int nt = 0; nt < 16; ++nt) acc[nt] = (f32x4){0.f, 0.f, 0.f, 0.f};
    const int nch = (nsel + 15) >> 4;
    u32x4 vw[3][4];
#define PV_LOAD(buf, c) do { _Pragma("unroll") for (int u = 0; u < 4; ++u) { const unsigned off_ = (unsigned)selw[16 * (c) + 4 * u + kq] * 256u + 16u * (unsigned)ii; vw[buf][u] = *(const u32x4*)((const char*)VC + off_); } } while (0)
#define PV_COMP(buf, c) do { _Pragma("unroll") for (int u = 0; u < 4; ++u) { u32x4 lo_, hi_; fp8x16_to_bf16(vw[buf][u], lo_, hi_); LAS u32x4* d_ = (LAS u32x4*)(VT + (4 * u + kq) * 528 + 32 * ii); d_[0] = lo_; d_[1] = hi_; } \
        s16x4 pa[2]; _Pragma("unroll") for (int g = 0; g < 2; ++g) { const s16x4 r_ = *(const LAS s16x4*)(Pb + (g * 4 + (ii & 3)) * 256 + 16 * (c) + 4 * kq); pa[g] = ii < 4 ? r_ : (s16x4){0, 0, 0, 0}; } \
        _Pragma("unroll") for (int nt = 0; nt < 16; ++nt) { const s16x4 b_ = __builtin_amdgcn_ds_read_tr16_b64_v4i16((LAS s16x4*)(VT + (4 * kq + (ii >> 2)) * 528 + (16 * nt + 4 * (ii & 3)) * 2)); \
            acc[nt] = __builtin_amdgcn_mfma_f32_16x16x16bf16_1k(pa[nt >> 3], b_, acc[nt], 0, 0, 0); } } while (0)
    PV_LOAD(0, 0); if (1 < nch) PV_LOAD(1, 1);
    for (int c = 0; c < nch; c += 3) {
        if (c + 2 < nch) PV_LOAD(2, c + 2);
        __builtin_amdgcn_sched_barrier(0);
        PV_COMP(0, c);
        if (c + 1 < nch) { if (c + 3 < nch) PV_LOAD(0, c + 3); __builtin_amdgcn_sched_barrier(0); PV_COMP(1, c + 1); }
        if (c + 2 < nch) { if (c + 4 < nch) PV_LOAD(1, c + 4); __builtin_amdgcn_sched_barrier(0); PV_COMP(2, c + 2); }
    }
#undef PV_LOAD
#undef PV_COMP
    LAS float* OB = (LAS float*)(wl + 1024 + 4096);
    if (kq == 0) {
#pragma unroll
        for (int nt = 0; nt < 16; ++nt)
#pragma unroll
            for (int r = 0; r < 4; ++r) OB[(4 * (nt >> 3) + r) * 128 + 16 * (nt & 7) + ii] = acc[nt][r];
    }
    {
        const f32x4 a0 = *(const LAS f32x4*)(OB + 16 * lane), a1 = *(const LAS f32x4*)(OB + 16 * lane + 4), a2 = *(const LAS f32x4*)(OB + 16 * lane + 8), a3 = *(const LAS f32x4*)(OB + 16 * lane + 12);
        u32x4 w0, w1; w0.x = cvt_pk_bf16(a0[0], a0[1]); w0.y = cvt_pk_bf16(a0[2], a0[3]); w0.z = cvt_pk_bf16(a1[0], a1[1]); w0.w = cvt_pk_bf16(a1[2], a1[3]);
        w1.x = cvt_pk_bf16(a2[0], a2[1]); w1.y = cvt_pk_bf16(a2[2], a2[3]); w1.z = cvt_pk_bf16(a3[0], a3[1]); w1.w = cvt_pk_bf16(a3[2], a3[3]);
        u32x4* dst = (u32x4*)(ATT + (size_t)t * 1024 + 16 * lane); dst[0] = w0; dst[1] = w1;
    }
}


__device__ __forceinline__ void convert_item8(const float* __restrict__ W, int K, int N, int ld, unsigned char* WT, int mode, int item, int lane, LAS unsigned char* scr) {
    const int nblk = N >> 6; const int kb = item / nblk, nb = item - kb * nblk; const int k0 = kb * 256, n0 = nb * 64;
    const int c4 = lane & 15, kr = lane >> 4;
    const float* src = W + (size_t)(k0 + 4 * kr) * ld + n0 + 4 * c4;
#pragma unroll 4
    for (int i = 0; i < 16; ++i) {
        f32x4 v[4];
#pragma unroll
        for (int r = 0; r < 4; ++r) v[r] = __builtin_nontemporal_load((const f32x4*)(src + (size_t)(16 * i + r) * ld));
        const int kk = 16 * i + 4 * kr;
#pragma unroll
        for (int e = 0; e < 4; ++e) *(LAS unsigned*)(scr + (4 * c4 + e) * 272 + kk) = pack4_fp8(v[0][e] * W8_SCALE, v[1][e] * W8_SCALE, v[2][e] * W8_SCALE, v[3][e] * W8_SCALE);
    }
    LDS_WAIT(); asm volatile("" ::: "memory");
#pragma unroll 4
    for (int j = 0; j < 16; ++j) {
        const int q = j * 64 + lane, n = q >> 4, ch = q & 15;
        const u32x4 v = *(const LAS u32x4*)(scr + n * 272 + ch * 16);
        *(u32x4*)(WT + (size_t)dest_row(mode, n0 + n) * K + k0 + ch * 16) = v;
    }
    LDS_WAIT(); asm volatile("" ::: "memory");
}

struct Conv8Job { const float* W; unsigned char* WT; int N; int mode; size_t w_estride, wt_estride; int items_per_e; };
constexpr int C8_PITCH = 272, C8_IMG = 256 * C8_PITCH;
__device__ __forceinline__ void conv8_load(const Conv8Job& jb, int item, int h, int wave, int lane, f32x4 (&v)[16]) {
    const int e = item / jb.items_per_e, r = item - e * jb.items_per_e; const int nblk = jb.N >> 8; const int kb = r / nblk, nb = r - kb * nblk;
    const float* src = jb.W + (size_t)e * jb.w_estride + (size_t)(kb * 256 + 32 * wave + 16 * h) * jb.N + nb * 256 + 4 * lane;
#pragma unroll
    for (int i = 0; i < 16; ++i) v[i] = __builtin_nontemporal_load((const f32x4*)(src + (size_t)i * jb.N));
}
__device__ __forceinline__ void conv8_to_lds(LAS unsigned char* img, int h, int wave, int lane, const f32x4 (&v)[16]) {
#pragma unroll
    for (int e = 0; e < 4; ++e) { u32x4 w;
#pragma unroll
        for (int g = 0; g < 4; ++g) w[g] = pack4_fp8(v[4 * g][e] * W8_SCALE, v[4 * g + 1][e] * W8_SCALE, v[4 * g + 2][e] * W8_SCALE, v[4 * g + 3][e] * W8_SCALE);
        *(LAS u32x4*)(img + (4 * lane + e) * C8_PITCH + 32 * wave + 16 * h) = w; }
}
__device__ __forceinline__ void conv8_store(const Conv8Job& jb, int item, const LAS unsigned char* img, int tid) {
    const int e = item / jb.items_per_e, r = item - e * jb.items_per_e; const int nblk = jb.N >> 8; const int kb = r / nblk, nb = r - kb * nblk;
    unsigned char* dst = jb.WT + (size_t)e * jb.wt_estride + kb * 256;
#pragma unroll
    for (int j = 0; j < 8; ++j) { const int q = j * 512 + tid, n = q >> 4, ch = q & 15;
        __builtin_nontemporal_store(*(const LAS u32x4*)(img + n * C8_PITCH + ch * 16), (u32x4*)(dst + (size_t)dest_row(jb.mode, nb * 256 + n) * 2048 + ch * 16)); }
}
__device__ __forceinline__ void conv8_run(LAS unsigned char* lds, const Conv8Job& jb, int n_items, int wg, int G, int tid, int wave, int lane) {
    if (wg >= n_items) return;
    f32x4 a[16], b[16]; int par = 0;
    conv8_load(jb, wg, 0, wave, lane, a); conv8_load(jb, wg, 1, wave, lane, b);
    for (int it = wg; it < n_items; it += G, par ^= 1) {
        LAS unsigned char* img = lds + par * C8_IMG;
        const int nx = (it + G < n_items) ? it + G : it;
        conv8_to_lds(img, 0, wave, lane, a); __builtin_amdgcn_sched_barrier(0);
        conv8_load(jb, nx, 0, wave, lane, a); __builtin_amdgcn_sched_barrier(0);
        conv8_to_lds(img, 1, wave, lane, b); __builtin_amdgcn_sched_barrier(0);
        conv8_load(jb, nx, 1, wave, lane, b); __builtin_amdgcn_sched_barrier(0);
        __syncthreads();
        conv8_store(jb, it, img, tid);
    }
    __syncthreads();
}

__global__ void __launch_bounds__(NTHR, 2) fwd_kernel(Args args) {
    extern __shared__ __attribute__((aligned(16))) unsigned char lds_raw[];
    LAS unsigned char* lds = (LAS unsigned char*)lds_raw;
    volatile LAS unsigned* MISC = (volatile LAS unsigned*)(lds + LDS_MISC);
    const int tid = threadIdx.x, lane = tid & 63, wave = __builtin_amdgcn_readfirstlane(tid >> 6);
    const int G = gridDim.x, wg = blockIdx.x;
    unsigned char* ws = args.ws;
    unsigned* ctl = (unsigned*)(ws + WS_CTL);
    const int lo = args.ph_lo, hi = args.ph_hi;
    const float* x = (const float*)args.in[0]; const float* cvec = (const float*)args.in[1]; const int* positions = (const int*)args.in[2];
    const float* w_ada = (const float*)args.in[3]; const float* b_ada = (const float*)args.in[4]; const float* norm1_g = (const float*)args.in[5];
    const float* w_in = (const float*)args.in[6]; const float* idx_knorm_g = (const float*)args.in[7]; const float* idx_knorm_b = (const float*)args.in[8];
    const float* lb_logits = (const float*)args.in[9]; const float* hgrn_norm_g = (const float*)args.in[10];
    const float* w_proj_att = (const float*)args.in[11]; const float* w_proj_hgrn = (const float*)args.in[12]; const float* w_out = (const float*)args.in[13];
    const float* norm2_g = (const float*)args.in[14]; const float* w_router = (const float*)args.in[15]; const float* b_router = (const float*)args.in[16];
    const float* w1 = (const float*)args.in[17]; const float* b1 = (const float*)args.in[18]; const float* w2 = (const float*)args.in[19]; const float* b2 = (const float*)args.in[20];
    const float* final_g = (const float*)args.in[21];
    float* out = args.out;
    float* MOD = (float*)(ws + WS_MOD); int* TOPE = (int*)(ws + WS_TOPE); float* GATE = (float*)(ws + WS_GATE); int* SLOT = (int*)(ws + WS_SLOT);
    bf16_t* WIN_T = (bf16_t*)(ws + WS_WIN_T); bf16_t* WA_T = (bf16_t*)(ws + WS_WA_T); bf16_t* WH_T = (bf16_t*)(ws + WS_WH_T); bf16_t* WO_T = (bf16_t*)(ws + WS_WO_T);
    unsigned char* WIN_T8 = ws + WS_WIN_T + 8 * MiB;
    unsigned char* HA8 = ws + WS_SCORES;
    unsigned char* W1_T = ws + WS_W1_T; unsigned char* W2_T = ws + WS_W2_T;
    bf16_t* HB = (bf16_t*)(ws + WS_H); bf16_t* PROJ = (bf16_t*)(ws + WS_PROJ);
    bf16_t* DELTA = (bf16_t*)(ws + WS_ATT);
    unsigned char* ACT = ws + WS_ACT; bf16_t* YB = (bf16_t*)(ws + WS_YB);
    int* TOKS = (int*)(ws + WS_TOKS);
    unsigned char* H8 = ws + WS_H;
    bf16_t* KI = (bf16_t*)(ws + WS_KI); unsigned char* KC = ws + WS_KC; unsigned char* VC = ws + WS_VC;
    float* ST = (float*)(ws + WS_ST); float* DC = (float*)(ws + WS_DC);
    bf16_t* ATT = (bf16_t*)(ws + WS_ATT); bf16_t* REC = (bf16_t*)(ws + WS_REC); bf16_t* MERGED = (bf16_t*)(ws + WS_MERGED); unsigned short* SCORES = (unsigned short*)(ws + WS_SCORES);
    unsigned short* SEGMAX = (unsigned short*)(ws + WS_X1);

    for (int u = tid; u < 128; u += NTHR) MISC[u] = 0u;
    __syncthreads();
    const bool one_launch = (hi - lo) > 1;
    XcdBarrier bar; bar.bar = ctl + CW_BAR; bar.x = 0; bar.st = MISC + 8;
    if (one_launch) bar = xcd_barrier_post(ctl + CW_BAR, MISC + 8);
#define IN(k) (lo <= (k) && (k) < hi)
#define SEAM(k) do { if (IN(k) && IN((k) + 1)) xcd_barrier(bar); } while (0)


    if (IN(PH_PRO)) {
        for (int cb = wg; cb < 256; cb += G) {
            LAS float* red = (LAS float*)lds;
            const int c4 = tid % 12, kg = tid / 12;
            f32x4 acc = (f32x4){0.f, 0.f, 0.f, 0.f};
            if (kg < 42) {
                const float* wp = w_ada + (size_t)cb * 48 + 4 * c4;
#pragma unroll 7
                for (int j = 0; j < 49; ++j) { const int k = kg + 42 * j; if (k < D) { const f32x4 v = __builtin_nontemporal_load((const f32x4*)(wp + (size_t)k * (6 * D))); acc += siluf_(cvec[k]) * v; } }
                *(LAS f32x4*)(red + kg * 48 + 4 * c4) = acc;
            }
            __syncthreads();
            if (tid < 48) { float s = b_ada[cb * 48 + tid];
#pragma unroll 6
                for (int q = 0; q < 42; ++q) s += red[q * 48 + tid];
                MOD[cb * 48 + tid] = s; }
            __syncthreads();
        }
        LAS unsigned char* scr = lds + wave * 17408;
        const int gw = wg * NWAVES + wave, NGW = G * NWAVES;
        {
            constexpr int NB_IN = (1104 + 63) / 64;
            for (int it = gw; it < 16 * NB_IN; it += NGW) convert_item(w_in + 1536, 2048, 1104, DIN, WIN_T, 0, it, lane, scr);
            for (int it = gw; it < 8 * 32; it += NGW) convert_item(w_proj_att, 1024, 2048, 2048, WA_T, 0, it, lane, scr);
            for (int it = gw; it < 8 * 32; it += NGW) convert_item(w_proj_hgrn, 1024, 2048, 2048, WH_T, 0, it, lane, scr);
            for (int it = gw; it < 8 * 32; it += NGW) convert_item8(w_out, 2048, 2048, 2048, (unsigned char*)WO_T, 0, it, lane, scr);
            for (int it = gw; it < 8 * 24; it += NGW) convert_item8(w_in, 2048, 1536, DIN, WIN_T8, 0, it, lane, scr);
            for (int it = gw; it < 8 * 128; it += NGW) convert_item8(w_in + 2640, 2048, 8192, DIN, WIN_T8 + (size_t)1536 * 2048, 0, it, lane, scr);
            for (size_t i = (size_t)wg * NTHR + tid; i < (size_t)176 * 2048 * 2 / 16; i += (size_t)G * NTHR) ((u32x4*)(WIN_T + (size_t)1104 * 2048))[i] = (u32x4){0u, 0u, 0u, 0u};
        }
    }
    SEAM(PH_PRO);

    {
    if (IN(PH_H)) {
        const float* sh1 = MOD; const float* sc1 = MOD + D;
        const int gw = wg * NWAVES + wave, NGW = G * NWAVES;
        f32x4 gs[8], sh[8];
#pragma unroll
        for (int j = 0; j < 8; ++j) { const int c = 4 * lane + 256 * j; const f32x4 g = *(const f32x4*)(norm1_g + c), sc = *(const f32x4*)(sc1 + c); sh[j] = *(const f32x4*)(sh1 + c);
#pragma unroll
            for (int e = 0; e < 4; ++e) gs[j][e] = g[e] * (1.0f + sc[e]); }
        for (int t = gw; t < S; t += NGW) {
            const f32x4* xr = (const f32x4*)(x + (size_t)t * D) + lane;
            f32x4 v[8]; float ss = 0.f;
#pragma unroll
            for (int j = 0; j < 8; ++j) { v[j] = xr[64 * j]; ss += (v[j][0] * v[j][0] + v[j][1] * v[j][1]) + (v[j][2] * v[j][2] + v[j][3] * v[j][3]); }
            const float rstd = rsqrtf(wave_sum(ss) * (1.0f / D) + NORM_EPS);
#pragma unroll
            for (int j = 0; j < 8; ++j) { const f32x4 h = v[j] * rstd * gs[j] + sh[j]; u32x2 w; w.x = cvt_pk_bf16(h[0], h[1]); w.y = cvt_pk_bf16(h[2], h[3]);
                *(u32x2*)(HB + (size_t)t * D + 4 * lane + 256 * j) = w;
                *(unsigned*)(HA8 + (size_t)t * D + 4 * lane + 256 * j) = pack4_fp8(h[0], h[1], h[2], h[3]); }
        }
    }
    SEAM(PH_H);
    if (IN(PH_INPROJ)) {
        const int XC = (G == 256) ? XCONV : 0;
        const Conv8Job j1{w1, W1_T, 4096, 2, (size_t)2048 * 4096, (size_t)4096 * 2048, 8 * 16};
        const Conv8Job j2{w2, W2_T, 2048, 0, (size_t)2048 * 2048, (size_t)2048 * 2048, 8 * 8};
        if (G != 256) { conv8_run(lds, j1, NEXP * 8 * 16, wg, G, tid, wave, lane); conv8_run(lds, j2, NEXP * 8 * 8, wg, G, tid, wave, lane); }
        if (wg < XC) { conv8_run(lds, j1, NEXP * 8 * 16, wg, XC, tid, wave, lane); conv8_run(lds, j2, NEXP * 8 * 8, wg, XC, tid, wave, lane); }
        else {
            const int Gg = G - XC, cg = wg - XC;
            {
                pg8::Gemm g8{HA8, WIN_T8, 2048, 0, nullptr, 0}; pg8::StaticOrder S8; S8.init(S, 9728, Gg, cg);
                const int full8 = 2432 / Gg, rem8 = 2432 - full8 * Gg;
                if (Gg == 256) S8.skew(8, (wg >= 128 && wg < 192) ? -1 : (wg < 128 ? wg : wg - 64), 192);
                else if (rem8 > 0) S8.skew(full8, cg < rem8 ? cg : -1, rem8);
                pg8::EpiBf16 E8{PROJ, DINP, nullptr, 0, 1.0f / W8_SCALE, 6, 1280};
                pg8::gemm_phase<pg8::EpiBf16, pg8::StaticOrder, true>(lds, g8, S8, E8);
            }
            {
                pg8::Gemm g{HB, WIN_T, 2048, 0, nullptr, 0}; pg8::StaticOrder So; So.init(S, 1280, Gg, Gg == 256 ? (wg + 128) % G : (cg + Gg - (2432 % Gg)) % Gg);
                pg8::EpiBf16 E{PROJ + CQI, DINP, nullptr, 0, 1.0f, 1 << 30, 0};
                pg8::gemm_phase<pg8::EpiBf16, pg8::StaticOrder>(lds, g, So, E);
            }
        }
    }
    SEAM(PH_INPROJ);
    if (IN(PH_POST)) {
        const int gw = wg * NWAVES + wave, NGW = G * NWAVES;
        for (int t = gw; t < S; t += NGW) post_token(PROJ, KI, KC, VC, positions, idx_knorm_g, idx_knorm_b, t, lane);
        __syncthreads();
        for (int u = wg; u < 2048; u += G) hgrn_l1(lds, PROJ, lb_logits, ST, DC, u >> 3, u & 7, tid, wave, lane);
    }
    SEAM(PH_POST);
    if (IN(PH_SCORE)) {
        for (int idx = wg * NTHR + tid; idx < 8 * 128 * 128; idx += G * NTHR) {
            const int h = idx >> 14, d = idx & 127; float s = 0.f;
            float* sp = ST + idx; const float* dp = DC + h * 128 + d;
            for (int c = 0; c < 256; c += 8) {
                float l[8], dc[8];
#pragma unroll
                for (int i = 0; i < 8; ++i) { l[i] = sp[(size_t)(c + i) * 131072]; dc[i] = dp[(size_t)(c + i) * 1024]; }
#pragma unroll
                for (int i = 0; i < 8; ++i) { sp[(size_t)(c + i) * 131072] = s; s = dc[i] * s + l[i]; }
            }
        }
        {
            const int XS = (G == 256) ? XSCORE : 0;
            if (wg < XS) {
                const Conv8Job j1{w1, W1_T, 4096, 2, (size_t)2048 * 4096, (size_t)4096 * 2048, 8 * 16};
                const Conv8Job j2{w2, W2_T, 2048, 0, (size_t)2048 * 2048, (size_t)2048 * 2048, 8 * 8};
                __syncthreads();
                conv8_run(lds, j1, NEXP * 8 * 16, wg, XS, tid, wave, lane); conv8_run(lds, j2, NEXP * 8 * 8, wg, XS, tid, wave, lane);
            }
            for (;;) {
                if (tid == 0) MISC[100] = __hip_atomic_fetch_add(ctl + CW_SCQ, 1u, __ATOMIC_RELAXED, __HIP_MEMORY_SCOPE_AGENT);
                __syncthreads();
                const int item = (int)MISC[100];
                __syncthreads();
                if (item >= 252 * SCP) break;
                const int j = item / SCP, p = item - j * SCP, qa = 8 + j, qb2 = 511 - j, na = (qa >> 2) + 1, nb = (qb2 >> 2) + 1, T = na + nb;
                const int lo = p * T / SCP, hi = (p + 1) * T / SCP;
                const int a0 = lo < na ? lo : na, a1 = hi < na ? hi : na, b0 = (lo > na ? lo : na) - na, b1 = (hi > na ? hi : na) - na;
                if (a1 > a0) score_block(lds, PROJ, KI, SCORES, SEGMAX, qa, a0, a1, tid, wave, lane);
                if (b1 > b0) score_block(lds, PROJ, KI, SCORES, SEGMAX, qb2, b0, b1, tid, wave, lane);
            }
        }
    }
    SEAM(PH_SCORE);
    if (IN(PH_ATTN)) {
        const int gw = wg * NWAVES + wave, NGW = G * NWAVES;
        for (int u = wg; u < 2048; u += G) hgrn_l3(lds, PROJ, lb_logits, ST, hgrn_norm_g, REC, u >> 3, u & 7, tid, wave, lane);
        {
            for (;;) {
                unsigned tq = 0; if (lane == 0) tq = __hip_atomic_fetch_add(ctl + CW_ATQ, 1u, __ATOMIC_RELAXED, __HIP_MEMORY_SCOPE_AGENT);
                tq = (unsigned)__builtin_amdgcn_readfirstlane((int)tq);
                if (tq >= (unsigned)S) break;
                const int t = S - 1 - (int)tq;
                LAS unsigned char* wl = lds + wave * 17664;
                if (t >= 256) select_row(wl, SCORES, SEGMAX, t, lane);
                else {
#pragma unroll
                    for (int i = 0; i < 4; ++i) { const int idx = lane + 64 * i; ((LAS int*)wl)[idx] = idx <= t ? idx : 0; }
                }
                attn_query(wl, PROJ, KC, VC, ATT, t, lane);
            }
        }
    }
    SEAM(PH_ATTN);
    if (IN(PH_OP1)) {
        pg8::Gemm g{ATT, WA_T, 1024, (size_t)2048 * 1024 * 2, nullptr, (size_t)S * 1024 * 2};
        pg8::TwoPartOrder So; So.init(S, 2048, G, wg);
        pg8::EpiGate2 E{(unsigned char*)MERGED, PROJ + CGA, PROJ + CGR};
        pg8::gemm_phase<pg8::EpiGate2, pg8::TwoPartOrder>(lds, g, So, E);
    }
    SEAM(PH_OP2);
    if (IN(PH_WOUT)) {
        pg8::Gemm g{MERGED, WO_T, 2048, 0, nullptr, 0}; pg8::StaticOrder So; So.init(S, 2048, G, wg);
        pg8::EpiDelta E{MOD + 2 * D, DELTA, 1.0f / (W8_SCALE * MRG8_SCALE)};
        pg8::gemm_phase<pg8::EpiDelta, pg8::StaticOrder, true>(lds, g, So, E);
    }
    SEAM(PH_WOUT);
    }

    if (IN(PH_ROUTER)) {
        LAS float* hs = (LAS float*)lds;
        volatile LAS unsigned* lcnt = MISC + 32;
        const float* sh2 = MOD + 3 * D; const float* sc2 = MOD + 4 * D;
        if (tid < 32) lcnt[tid] = 0u;
        __syncthreads();
        for (int grp = wg; grp < S / 16; grp += G) {
#pragma unroll 1
            for (int q = 0; q < 2; ++q) {
                const int tl = 2 * wave + q, t = grp * 16 + tl;
                const f32x4* xr = (const f32x4*)(x + (size_t)t * D) + lane; const u32x2* dr = (const u32x2*)(DELTA + (size_t)t * D) + lane;
                f32x4 v[8]; float ss = 0.f;
#pragma unroll
                for (int j = 0; j < 8; ++j) { const u32x2 dw = dr[64 * j]; v[j] = xr[64 * j] + (f32x4){bf_lo(dw.x), bf_hi(dw.x), bf_lo(dw.y), bf_hi(dw.y)};
                    ss += (v[j][0] * v[j][0] + v[j][1] * v[j][1]) + (v[j][2] * v[j][2] + v[j][3] * v[j][3]); }
                const float rstd = rsqrtf(wave_sum(ss) * (1.0f / D) + NORM_EPS);
#pragma unroll
                for (int j = 0; j < 8; ++j) {
                    const int c = 4 * lane + 256 * j;
                    const f32x4 g = *(const f32x4*)(norm2_g + c), sc = *(const f32x4*)(sc2 + c), sh = *(const f32x4*)(sh2 + c);
                    f32x4 h;
#pragma unroll
                    for (int e = 0; e < 4; ++e) h[e] = v[j][e] * rstd * g[e] * (1.0f + sc[e]) + sh[e];
                    *(LAS f32x4*)(hs + tl * 2048 + c) = h;
                    *(unsigned*)(H8 + (size_t)t * D + c) = pack4_fp8(h[0], h[1], h[2], h[3]);
                }
            }
            __syncthreads();
            {
                LAS float* part = (LAS float*)(lds + 131072);
                const int fr = lane & 15, fq = lane >> 4;
                f32x4 acc0 = (f32x4){0.f, 0.f, 0.f, 0.f}, acc1 = acc0;
                const LAS float* hrow = hs + fr * 2048 + wave * 256 + 4 * fq; const float* wrp = w_router + (size_t)(wave * 256 + 4 * fq) * 32 + fr;
#pragma unroll 2
                for (int i = 0; i < 16; ++i) {
                    const f32x4 a4 = *(const LAS f32x4*)(hrow + 16 * i);
                    float b0[4], b1[4];
#pragma unroll
                    for (int s = 0; s < 4; ++s) { b0[s] = wrp[(size_t)(16 * i + s) * 32]; b1[s] = wrp[(size_t)(16 * i + s) * 32 + 16]; }
#pragma unroll
                    for (int s = 0; s < 4; ++s) { acc0 = __builtin_amdgcn_mfma_f32_16x16x4f32(a4[s], b0[s], acc0, 0, 0, 0); acc1 = __builtin_amdgcn_mfma_f32_16x16x4f32(a4[s], b1[s], acc1, 0, 0, 0); }
                }
#pragma unroll
                for (int r = 0; r < 4; ++r) { part[(wave * 16 + 4 * fq + r) * 32 + fr] = acc0[r]; part[(wave * 16 + 4 * fq + r) * 32 + 16 + fr] = acc1[r]; }
                __syncthreads();
                const int tl = tid >> 5, e = tid & 31, t = grp * 16 + tl;
                float v = b_router[e];
#pragma unroll
                for (int w = 0; w < 8; ++w) v += part[(w * 16 + tl) * 32 + e];
                float tv[4]; int ti[4];
#pragma unroll
                for (int k = 0; k < 4; ++k) {
                    float bv = v; int bi = e;
#pragma unroll
                    for (int o = 16; o >= 1; o >>= 1) { const float ov = __shfl_xor(bv, o); const int oi = __shfl_xor(bi, o); if (ov > bv || (ov == bv && oi < bi)) { bv = ov; bi = oi; } }
                    tv[k] = bv; ti[k] = bi; if (e == bi) v = -__builtin_inff();
                }
                if (e == 0) {
                    const float e1 = __expf(tv[1] - tv[0]), e2 = __expf(tv[2] - tv[0]), e3 = __expf(tv[3] - tv[0]); const float inv = 1.0f / (1.0f + e1 + e2 + e3);
                    *(int4*)(TOPE + (size_t)t * 4) = make_int4(ti[0], ti[1], ti[2], ti[3]);
                    *(f32x4*)(GATE + (size_t)t * 4) = (f32x4){inv, e1 * inv, e2 * inv, e3 * inv};
#pragma unroll
                    for (int k = 0; k < 4; ++k) __hip_atomic_fetch_add((LAS unsigned*)&lcnt[ti[k]], 1u, __ATOMIC_RELAXED, __HIP_MEMORY_SCOPE_WORKGROUP);
                }
            }
            __syncthreads();
        }
        if (tid < 32) { const unsigned c = lcnt[tid]; if (c) __hip_atomic_fetch_add(ctl + CW_CNT + tid, c, __ATOMIC_RELAXED, __HIP_MEMORY_SCOPE_AGENT); }
    }
    SEAM(PH_ROUTER);

    if (IN(PH_SCATTER)) {
        volatile LAS unsigned* lcnt = MISC + 32; volatile LAS unsigned* lbase = MISC + 64; LAS int* pstart = (LAS int*)(lds + 1024); LAS int* pcnt = (LAS int*)(lds + 1280);
        if (tid == 0) { int p = 0; for (int e = 0; e < NEXP; ++e) { const int c = (int)__hip_atomic_load(ctl + CW_CNT + e, __ATOMIC_RELAXED, __HIP_MEMORY_SCOPE_AGENT); pstart[e] = p; pcnt[e] = c; p += (c + 255) & ~255; } }
        if (tid < 32) lcnt[tid] = 0u;
        __syncthreads();
        if (wg < NEXP) { const int e = wg; for (int s = pstart[e] + pcnt[e] + tid; s < pstart[e] + ((pcnt[e] + 255) & ~255); s += NTHR) TOKS[s] = 0; }
        for (int blk = wg; blk < S / 64; blk += G) {
            int e = 0, lrank = 0;
            if (tid < 256) { e = TOPE[(size_t)blk * 256 + tid]; lrank = (int)__hip_atomic_fetch_add((LAS unsigned*)&lcnt[e], 1u, __ATOMIC_RELAXED, __HIP_MEMORY_SCOPE_WORKGROUP); }
            __syncthreads();
            if (tid < 32) { const unsigned c = lcnt[tid]; lbase[tid] = c ? __hip_atomic_fetch_add(ctl + CW_FILL + tid, c, __ATOMIC_RELAXED, __HIP_MEMORY_SCOPE_AGENT) : 0u; }
            __syncthreads();
            if (tid < 256) { const int slot = pstart[e] + (int)lbase[e] + lrank; SLOT[(size_t)blk * 256 + tid] = slot; TOKS[slot] = blk * 64 + (tid >> 2); }
            __syncthreads();
            if (tid < 32) lcnt[tid] = 0u;
            __syncthreads();
        }
    }
    SEAM(PH_SCATTER);

    if (IN(PH_MOE1) || IN(PH_MOE2)) {
        LAS int* panel_e = (LAS int*)(lds + 131072 + 2048);
        LAS int* npan = (LAS int*)(lds + 131072 + 2048 + 2048);
        __syncthreads();
        if (tid == 0) { int p = 0; for (int e = 0; e < NEXP; ++e) { const int np = (int)((__hip_atomic_load(ctl + CW_CNT + e, __ATOMIC_RELAXED, __HIP_MEMORY_SCOPE_AGENT) + 255u) >> 8); for (int q = 0; q < np; ++q) panel_e[p + q] = e; p += np; } npan[0] = p; }
        __syncthreads();
        const int nPanels = npan[0];
        if (IN(PH_MOE1)) {
            pg8::Gemm g{H8, W1_T, 2048, (size_t)4096 * 2048, TOKS, 0}; pg8::MoeOrder So; So.init(nPanels, 16, G, wg, panel_e);
            pg8::EpiSwiglu E{ACT, b1};
            pg8::gemm_phase<pg8::EpiSwiglu, pg8::MoeOrder, true>(lds, g, So, E);
        }
        SEAM(PH_MOE1);
        if (IN(PH_MOE2)) {
            pg8::Gemm g{ACT, W2_T, 2048, (size_t)2048 * 2048, nullptr, 0}; pg8::MoeOrder So; So.init(nPanels, 8, G, wg, panel_e);
            pg8::EpiBf16 E{YB, 2048, b2, 2048, 1.0f / (W8_SCALE * ACT8_SCALE), 1 << 30, 0};
            pg8::gemm_phase<pg8::EpiBf16, pg8::MoeOrder, true>(lds, g, So, E);
        }
    }
    SEAM(PH_MOE2);

    if (IN(PH_FINAL)) {
        const float* gt2 = MOD + 5 * D;
        const int gw = wg * NWAVES + wave, NGW = G * NWAVES;
        for (int t = gw; t < S; t += NGW) {
            const f32x4* xr = (const f32x4*)(x + (size_t)t * D) + lane; const u32x2* dr = (const u32x2*)(DELTA + (size_t)t * D) + lane;
            f32x4 v[8];
#pragma unroll
            for (int j = 0; j < 8; ++j) { const u32x2 dw = dr[64 * j]; v[j] = xr[64 * j] + (f32x4){bf_lo(dw.x), bf_hi(dw.x), bf_lo(dw.y), bf_hi(dw.y)}; }
            {
                f32x4 m[8];
#pragma unroll
                for (int j = 0; j < 8; ++j) m[j] = (f32x4){0.f, 0.f, 0.f, 0.f};
                const int4 sl = *(const int4*)(SLOT + (size_t)t * 4); const f32x4 gt = *(const f32x4*)(GATE + (size_t)t * 4);
                const int sls[4] = {sl.x, sl.y, sl.z, sl.w};
#pragma unroll
                for (int k = 0; k < 4; ++k) {
                    const u32x2* yr = (const u32x2*)(YB + (size_t)sls[k] * D) + lane; const float gk = gt[k];
#pragma unroll
                    for (int j = 0; j < 8; ++j) { const u32x2 w = yr[64 * j]; m[j][0] += gk * bf_lo(w.x); m[j][1] += gk * bf_hi(w.x); m[j][2] += gk * bf_lo(w.y); m[j][3] += gk * bf_hi(w.y); }
                }
#pragma unroll
                for (int j = 0; j < 8; ++j) { const f32x4 g2 = *(const f32x4*)(gt2 + 4 * lane + 256 * j); v[j] = v[j] + g2 * m[j]; }
            }
            float ss = 0.f;
#pragma unroll
            for (int j = 0; j < 8; ++j) ss += (v[j][0] * v[j][0] + v[j][1] * v[j][1]) + (v[j][2] * v[j][2] + v[j][3] * v[j][3]);
            const float rstd = rsqrtf(wave_sum(ss) * (1.0f / D) + NORM_EPS);
            f32x4* orow = (f32x4*)(out + (size_t)t * D) + lane;
#pragma unroll
            for (int j = 0; j < 8; ++j) { const f32x4 fg = *(const f32x4*)(final_g + 4 * lane + 256 * j); orow[64 * j] = v[j] * rstd * fg; }
        }
    }
#undef IN
#undef SEAM
}

#ifndef MK_ONE_LAUNCH
#define MK_ONE_LAUNCH 1
#endif
extern "C" void kernel_launch(void* const* d_in, const int* in_sizes, int n_in, void* d_out, int out_size, void* d_ws, size_t ws_size, hipStream_t stream) {
    static int grid = 0;
    if (grid == 0) {
        if (n_in != 22 || out_size != S * D || ws_size < WS_END) { fprintf(stderr, "kernel_launch: unexpected shapes: n_in %d out %d ws %zu (need %zu)\n", n_in, out_size, ws_size, (size_t)WS_END); grid = -1; return; }
        int dev = 0, cus = 0, per_cu = 0;
        if (hipGetDevice(&dev) != hipSuccess || hipDeviceGetAttribute(&cus, hipDeviceAttributeMultiprocessorCount, dev) != hipSuccess) { grid = -1; return; }
        if (hipFuncSetAttribute((const void*)fwd_kernel, hipFuncAttributeMaxDynamicSharedMemorySize, LDS_BYTES) != hipSuccess) { fprintf(stderr, "kernel_launch: hipFuncSetAttribute failed\n"); grid = -1; return; }
        if (hipOccupancyMaxActiveBlocksPerMultiprocessor(&per_cu, (const void*)fwd_kernel, NTHR, LDS_BYTES) != hipSuccess || per_cu < 1) { fprintf(stderr, "kernel_launch: occupancy query says %d\n", per_cu); (void)hipGetLastError(); grid = -1; return; }
        grid = cus;
    }
    if (grid < 0) return;
    (void)in_sizes;
    hipMemsetAsync((char*)d_ws + WS_CTL, 0, CTL_BYTES, stream);
    Args a{};
    for (int i = 0; i < 22; ++i) a.in[i] = d_in[i];
    a.out = (float*)d_out; a.ws = (unsigned char*)d_ws; a.flags = 0; a.pad = 0;
#if MK_ONE_LAUNCH
    a.ph_lo = 0; a.ph_hi = NPH;
    hipLaunchKernelGGL(fwd_kernel, dim3(grid), dim3(NTHR), LDS_BYTES, stream, a);
#else
    for (int p = 0; p < NPH; ++p) { a.ph_lo = p; a.ph_hi = p + 1; hipLaunchKernelGGL(fwd_kernel, dim3(grid), dim3(NTHR), LDS_BYTES, stream, a); }
#endif
}
```

```cpp
#include <hip/hip_runtime.h>
#include <cstdio>
#include <cstdint>

#define GAS __attribute__((address_space(1)))
#define LAS __attribute__((address_space(3)))
typedef unsigned short bf16_t;
typedef short bf16x8 __attribute__((ext_vector_type(8)));
typedef float f32x4 __attribute__((ext_vector_type(4)));
typedef float f32x2 __attribute__((ext_vector_type(2)));
typedef float f32x16 __attribute__((ext_vector_type(16)));
typedef unsigned u32x4 __attribute__((ext_vector_type(4)));
typedef unsigned u32x2 __attribute__((ext_vector_type(2)));
typedef int i32x4 __attribute__((ext_vector_type(4)));
typedef int i32x8 __attribute__((ext_vector_type(8)));
typedef short s16x4 __attribute__((ext_vector_type(4)));
typedef short s16x2 __attribute__((ext_vector_type(2)));

constexpr int S = 16384, D = 2048, DIN = 10832, DINP = 11008, NEXP = 32, DFF = 2048;
constexpr int NWAVES = 8, NTHR = 512;
constexpr int CQ = 0, CK = 1024, CV = 1280, CQI = 1536, CKI = 2560, CWI = 2624, CHQ = 2816, CHF = 3840, CHI = 4864, CHG = 5888, CGA = 6912, CGR = 8960;
constexpr int PMAX = 65536 + NEXP * 256;
constexpr float NORM_EPS = 1e-5f;

constexpr size_t MiB = 1u << 20;
constexpr size_t al256(size_t x) { return (x + 255) & ~(size_t)255; }
constexpr size_t WS_CTL = 0, CTL_BYTES = 1 * MiB;
constexpr size_t WS_MOD = WS_CTL + CTL_BYTES;
constexpr size_t WS_TOPE = WS_MOD + 64 * 1024;
constexpr size_t WS_GATE = WS_TOPE + (size_t)S * 16;
constexpr size_t WS_SLOT = WS_GATE + (size_t)S * 16;
constexpr size_t WS_WIN_T = WS_SLOT + (size_t)S * 16;
constexpr size_t WS_WA_T = WS_WIN_T + (size_t)DINP * D * 2;
constexpr size_t WS_WH_T = WS_WA_T + (size_t)2048 * 1024 * 2;
constexpr size_t WS_WO_T = WS_WH_T + (size_t)2048 * 1024 * 2;
constexpr size_t WS_W1_T = WS_WO_T + (size_t)2048 * 2048 * 2;
constexpr size_t WS_W2_T = WS_W1_T + (size_t)NEXP * 4096 * 2048 * 2;
constexpr size_t WS_H = WS_W2_T + (size_t)NEXP * 2048 * 2048 * 2;
constexpr size_t WS_PROJ = WS_H + (size_t)S * D * 2;
constexpr size_t WS_KI = WS_PROJ + (size_t)S * DINP * 2;
constexpr size_t WS_KC = WS_KI + (size_t)S * 64 * 2;
constexpr size_t WS_VC = WS_KC + (size_t)S * 256 * 2;
constexpr size_t WS_ST = WS_VC + (size_t)S * 256 * 2;
constexpr size_t WS_DC = WS_ST + (size_t)256 * 8 * 128 * 128 * 4;
constexpr size_t WS_SEL = WS_DC + (size_t)256 * 8 * 128 * 4;
constexpr size_t WS_ATT = WS_SEL + (size_t)S * 256 * 4;
constexpr size_t WS_REC = WS_ATT + (size_t)S * 1024 * 2;
constexpr size_t WS_MERGED = WS_REC + (size_t)S * 1024 * 2;
constexpr size_t WS_X1 = WS_MERGED + (size_t)S * 2048 * 2;
constexpr size_t WS_SCORES = WS_X1 + (size_t)S * 2048 * 4;
constexpr size_t WS_XB = WS_SCORES;
constexpr size_t WS_ACT = WS_XB + (size_t)PMAX * 2048 * 2;
constexpr size_t WS_YB = WS_ACT + (size_t)PMAX * 2048 * 2;
constexpr size_t WS_END = WS_SCORES + (size_t)S * S * 4;
static_assert(WS_YB + (size_t)PMAX * 2048 * 2 <= WS_END, "MoE buffers overlay the score matrix");
static_assert(WS_END <= (size_t)4096 * MiB, "workspace");
constexpr int CW_BAR = 4096, CW_CNT = 8192, CW_FILL = 8448;
constexpr size_t WS_TOKS = WS_SEL;

constexpr int LDS_BYTES = 155648;
constexpr int LDS_MISC = LDS_BYTES - 512;

__device__ __forceinline__ unsigned cvt_pk_bf16(float lo, float hi) { unsigned r; asm volatile("v_cvt_pk_bf16_f32 %0, %1, %2" : "=v"(r) : "v"(lo), "v"(hi)); return r; }
__device__ __forceinline__ float bf_lo(unsigned u) { return __uint_as_float(u << 16); }
__device__ __forceinline__ float bf_hi(unsigned u) { return __uint_as_float(u & 0xffff0000u); }
__device__ __forceinline__ float bf2f(bf16_t b) { return __uint_as_float(((unsigned)b) << 16); }
__device__ __forceinline__ float wave_sum(float v) {
#define DPPS(ctrl, rmask) { const int s_ = __builtin_amdgcn_update_dpp(0, __float_as_int(v), ctrl, rmask, 0xF, false); v += __int_as_float(s_); }
    DPPS(0x111, 0xF) DPPS(0x112, 0xF) DPPS(0x114, 0xF) DPPS(0x118, 0xF) DPPS(0x142, 0xA) DPPS(0x143, 0xC)
#undef DPPS
    return __int_as_float(__builtin_amdgcn_readlane(__float_as_int(v), 63));
}
__device__ __forceinline__ float wave_max(float v) {
#define DPPM(ctrl, rmask) { const int o_ = __float_as_int(v); const int s_ = __builtin_amdgcn_update_dpp(o_, o_, ctrl, rmask, 0xF, false); v = fmaxf(v, __int_as_float(s_)); }
    DPPM(0x111, 0xF) DPPM(0x112, 0xF) DPPM(0x114, 0xF) DPPM(0x118, 0xF) DPPM(0x142, 0xA) DPPM(0x143, 0xC)
#undef DPPM
    return __int_as_float(__builtin_amdgcn_readlane(__float_as_int(v), 63));
}
__device__ __forceinline__ float sigmoidf_(float x) { return __builtin_amdgcn_rcpf(1.0f + __expf(-x)); }
__device__ __forceinline__ float siluf_(float x) { return x * __builtin_amdgcn_rcpf(1.0f + __expf(-x)); }
__device__ __forceinline__ unsigned pack4_fp8(float a, float b, float c, float d) { int w = 0; w = __builtin_amdgcn_cvt_pk_fp8_f32(a, b, w, false); w = __builtin_amdgcn_cvt_pk_fp8_f32(c, d, w, true); return (unsigned)w; }
constexpr float W8_SCALE = 64.0f, ACT8_SCALE = 4.0f, MRG8_SCALE = 8.0f, OP8_SCALE = 16.0f;
__device__ __forceinline__ float relu_i(float x) { const int i = __float_as_int(x); return __int_as_float(i > 0 ? i : 0); }
__device__ __forceinline__ void fp8x16_to_bf16(const u32x4& w, u32x4& lo, u32x4& hi) {
    unsigned o[8];
#pragma unroll
    for (int q = 0; q < 4; ++q) { const unsigned wq = w[q]; const f32x2 a = __builtin_amdgcn_cvt_pk_f32_fp8((int)wq, false), b = __builtin_amdgcn_cvt_pk_f32_fp8((int)wq, true);
        o[2 * q] = cvt_pk_bf16(a[0], a[1]); o[2 * q + 1] = cvt_pk_bf16(b[0], b[1]); }
    lo = (u32x4){o[0], o[1], o[2], o[3]}; hi = (u32x4){o[4], o[5], o[6], o[7]};
}
__device__ __forceinline__ unsigned char fp8_1(float x) { return (unsigned char)(__builtin_amdgcn_cvt_pk_fp8_f32(x, x, 0, false) & 0xff); }
#define LDS_WAIT() asm volatile("s_waitcnt lgkmcnt(0)" ::: "memory")
#define VM_WAIT() asm volatile("s_waitcnt vmcnt(0)" ::: "memory")

#define XB_TMO      128
#define XB_XCNT(j)  (256  + 64 * (j))
#define XB_XSUB(j)  (1280 + 64 * (j))
#define XB_XGEN(j)  (2304 + 64 * (j))
#define XB_TOP      3328
#define XB_TOPGEN   3392
#define XCD_BAR_WORDS 3456
#define XB_SPIN_CAP (1u << 22)

__device__ __forceinline__ unsigned xb_ld(unsigned* p)              { return __hip_atomic_load(p, __ATOMIC_RELAXED, __HIP_MEMORY_SCOPE_AGENT); }
__device__ __forceinline__ unsigned xb_add(unsigned* p, unsigned v) { return __hip_atomic_fetch_add(p, v, __ATOMIC_RELAXED, __HIP_MEMORY_SCOPE_AGENT); }
__device__ __forceinline__ unsigned xb_xcc_id() { return (unsigned)__builtin_amdgcn_s_getreg((3 << 11) | 20) & 0xFu; }
#define XB_SPIN(cond, bar) do { unsigned _sp = 0; while (cond) { __builtin_amdgcn_s_sleep(1); \
    if ((++_sp & 255u) == 0u) { if (xb_ld(&(bar)[XB_TMO])) break; if (_sp > XB_SPIN_CAP) { atomicAdd(&(bar)[XB_TMO], 1u); break; } } } } while (0)

struct XcdBarrier { unsigned* bar; unsigned x; volatile LAS unsigned* st; };

__device__ __forceinline__ XcdBarrier xcd_barrier_post(unsigned* bar, volatile LAS unsigned* st) {
    XcdBarrier b; b.bar = bar; b.x = xb_xcc_id(); b.st = st;
    if (threadIdx.x == 0) (void)xb_add(&bar[XB_XCNT(b.x)], 1u);
    return b;
}
__device__ __forceinline__ void xcd_barrier_complete(unsigned* bar, unsigned x, unsigned& nloc, unsigned& nx) {
    const unsigned G = gridDim.x * gridDim.y * gridDim.z;
    unsigned sum, cnt, mine, sp = 0u;
    for (;;) {
        sum = 0u; cnt = 0u; mine = 0u;
#pragma unroll
        for (unsigned j = 0; j < 16; ++j) { const unsigned c = xb_ld(&bar[XB_XCNT(j)]); sum += c; cnt += (c > 0u) ? 1u : 0u; mine = (j == x) ? c : mine; }
        if (sum == G) break;
        __builtin_amdgcn_s_sleep(1);
        if ((++sp & 255u) == 0u) { if (xb_ld(&bar[XB_TMO])) break; if (sp > XB_SPIN_CAP) { atomicAdd(&bar[XB_TMO], 1u); break; } }
    }
    nloc = mine > 0u ? mine : 1u; nx = cnt > 0u ? cnt : 1u;
}
__device__ __forceinline__ void xcd_barrier(const XcdBarrier& b) {
    asm volatile("s_waitcnt vmcnt(0)" ::: "memory");
    __syncthreads();
    if (threadIdx.x == 0) {
        unsigned* bar = b.bar;
        __builtin_amdgcn_s_waitcnt(0);
        unsigned nloc = b.st[0], nx = b.st[1];
        if (nloc == 0u) { xcd_barrier_complete(bar, b.x, nloc, nx); b.st[0] = nloc; b.st[1] = nx; }
        const unsigned old = xb_add(&bar[XB_XSUB(b.x)], 1u);
        const unsigned gen = old / nloc;
        if (old + 1u == (gen + 1u) * nloc) {
            __builtin_amdgcn_fence(__ATOMIC_RELEASE, "agent");
            asm volatile("s_waitcnt vmcnt(0)" ::: "memory");
            const unsigned og = xb_add(&bar[XB_TOP], 1u);
            const unsigned tg = og / nx;
            if (og + 1u == (tg + 1u) * nx) xb_add(&bar[XB_TOPGEN], 1u);
            else XB_SPIN(xb_ld(&bar[XB_TOPGEN]) == tg, bar);
            __builtin_amdgcn_fence(__ATOMIC_ACQUIRE, "agent");
            xb_add(&bar[XB_XGEN(b.x)], 1u);
            asm volatile("s_waitcnt vmcnt(0)" ::: "memory");
        } else {
            XB_SPIN(xb_ld(&bar[XB_XGEN(b.x)]) == gen, bar);
            __builtin_amdgcn_fence(__ATOMIC_ACQUIRE, "agent");
            asm volatile("s_waitcnt vmcnt(0)" ::: "memory");
        }
    }
    __syncthreads();
}

namespace pg8 {
constexpr int BM = 256, BK = 64, HALF = 128, HTB = HALF * BK * 2, STAGE_BYTES = 8 * HTB, NXCD = 8, WGM = 8;
__host__ __device__ __forceinline__ int lds_byte(int r, int c) { const int st = (r >> 4) * 2 + (c >> 5), rr = r & 15, cc = c & 31, ob = rr * 64 + cc * 2; return st * 1024 + (ob ^ (((ob >> 9) & 1) << 5)); }
__host__ __device__ __forceinline__ void stage_rc(int b, int& R, int& C) { const int st = b / 1024, sb = b % 1024, swz = sb ^ (((sb >> 9) & 1) << 5); R = (st >> 1) * 16 + swz / 64; C = (st & 1) * 32 + (swz % 64) / 2; }
__host__ __device__ __forceinline__ int perm32(int rho) { const int n = rho >> 4, i = rho & 15; return 8 * (i >> 2) + 4 * n + (i & 3); }

struct Unit { int pm, pn, e; };
struct Gemm { const void* A; const void* Bt; int K; size_t estride; const int* arow; size_t astride; };

struct StaticOrder {
    int nM, nN, nwg, G, c, i, full, erank, en;
    __device__ void init(int M, int N, int G_, int c_) { nM = M / BM; nN = N / BM; nwg = nM * nN; G = G_; c = c_; i = 0; full = 1 << 30; erank = -1; en = 1; }
    __device__ void skew(int full_, int erank_, int en_) { full = full_; erank = erank_; en = en_; }
    __device__ bool next(Unit& u) {
        long L;
        if (i < full) L = (long)i * G + c; else { if (erank < 0) return false; L = (long)full * G + (long)(i - full) * en + erank; }
        ++i; if (L >= nwg) return false;
        int wgid = (int)L; { const int q = nwg / NXCD, r = nwg % NXCD, xcd = wgid % NXCD, off = wgid / NXCD; wgid = (xcd < r ? xcd * (q + 1) : r * (q + 1) + (xcd - r) * q) + off; }
        const int nig = WGM * nN, gid = wgid / nig, fm = gid * WGM, gsz = (nM - fm) < WGM ? (nM - fm) : WGM;
        u.pm = fm + ((wgid % nig) % gsz); u.pn = (wgid % nig) / gsz; u.e = 0; return true;
    }
};
struct MoeOrder {
    int nPanels, nN, G, c, i; const LAS int* panel_e;
    __device__ void init(int nPanels_, int nN_, int G_, int c_, const LAS int* pe) { nPanels = nPanels_; nN = nN_; G = G_; c = c_; i = 0; panel_e = pe; }
    __device__ bool next(Unit& u) {
        const int PB = 256 / nN;
        const int nblk = (nPanels + PB - 1) / PB;
        for (;;) {
            const long L = (long)i * G + c; ++i;
            const int blk = (int)(L >> 8), r = (int)(L & 255), x = r & 7, j = r >> 3;
            if (blk >= nblk) return false;
            int pm, pn;
            if (nN == 16) { pm = blk * 16 + 4 * (x >> 1) + (j & 3); pn = 8 * (x & 1) + (j >> 2); }
            else          { pm = blk * 32 + 4 * x + (j & 3);        pn = j >> 2; }
            if (pm < nPanels) { u.pm = pm; u.pn = pn; u.e = panel_e[pm]; return true; }
        }
    }
};

template <class Epi, class Sched, bool FP8 = false>
__device__ __forceinline__ void gemm_phase(LAS unsigned char* lds, const Gemm g, Sched& S, const Epi& E) {
    const int tid = threadIdx.x, wid = __builtin_amdgcn_readfirstlane(tid >> 6), lane = tid & 63, wr = wid >> 2, wc = wid & 3, fr = lane & 15, fq = lane >> 4;
    const int K = g.K; const int pitch = FP8 ? K : 2 * K; const int nt = pitch / 128;
    unsigned voffA[2], voffB[2];
#pragma unroll
    for (int i = 0; i < 2; ++i) { int R, C; stage_rc(tid * 16 + i * 8192, R, C); const int Rb = Epi::PERM ? ((R & ~31) + perm32(R & 31)) : R;
        voffA[i] = (unsigned)(R * pitch + C * 2); voffB[i] = (unsigned)(Rb * pitch + C * 2); }
    const size_t kstep = (size_t)(BK * 2);
    const size_t hstep = (size_t)HALF * pitch;
    const size_t tstep = 2 * hstep;
    int RA[2], CA[2];
#pragma unroll
    for (int i = 0; i < 2; ++i) stage_rc(tid * 16 + i * 8192, RA[i], CA[i]);
    const bool gather = g.arow != nullptr;
    const size_t hsA = gather ? 0 : hstep;
    unsigned vA0[2] = {voffA[0], voffA[1]}, vA1[2] = {voffA[0], voffA[1]}, nA0[2] = {voffA[0], voffA[1]}, nA1[2] = {voffA[0], voffA[1]};
#define PG8_AOFF(dst0, dst1, u) do { if (gather) { _Pragma("unroll") for (int i = 0; i < 2; ++i) { \
        dst0[i] = (unsigned)g.arow[(u).pm * 256 + RA[i]] * (unsigned)pitch + (unsigned)(CA[i] * 2); dst1[i] = (unsigned)g.arow[(u).pm * 256 + 128 + RA[i]] * (unsigned)pitch + (unsigned)(CA[i] * 2); } } } while (0)
    const unsigned ldsw = (unsigned)wid * 1024u;
    const int aoff = lds_byte(wr * 64 + fr, fq * 8), boff = lds_byte(wc * 32 + fr, fq * 8);
#define PG8_SA(b, h) (((b) * 2 + (h)) * HTB)
#define PG8_SB(b, h) ((4 + (b) * 2 + (h)) * HTB)
#define PG8_STAGE(bufoff, gbase, voff) do { _Pragma("unroll") for (int _i = 0; _i < 2; ++_i) \
        __builtin_amdgcn_global_load_lds((const unsigned*)((const char*)(gbase) + (voff)[_i]), (LAS unsigned*)(lds + (bufoff) + ldsw + _i * 8192), 16, 0, 0); } while (0)
#define PG8_LD8(p) __builtin_shufflevector(*(const LAS i32x4*)(p), *(const LAS i32x4*)((p) + 1024), 0, 1, 2, 3, 4, 5, 6, 7)
#define PG8_LDA(dst, b, h) do { _Pragma("unroll") for (int m = 0; m < 4; ++m) { if constexpr (FP8) dst##8[m] = PG8_LD8(lds + PG8_SA(b, h) + aoff + m * 2048); \
        else { _Pragma("unroll") for (int k = 0; k < 2; ++k) dst[m][k] = *(const LAS bf16x8*)(lds + PG8_SA(b, h) + aoff + m * 2048 + k * 1024); } } } while (0)
#define PG8_LDB(dst, b, h) do { _Pragma("unroll") for (int n = 0; n < 2; ++n) { if constexpr (FP8) dst##8[n] = PG8_LD8(lds + PG8_SB(b, h) + boff + n * 2048); \
        else { _Pragma("unroll") for (int k = 0; k < 2; ++k) dst[n][k] = *(const LAS bf16x8*)(lds + PG8_SB(b, h) + boff + n * 2048 + k * 1024); } } } while (0)
#define PG8_MMA(ai, bj, At, Bt) do { __builtin_amdgcn_s_setprio(1); _Pragma("unroll") for (int m = 0; m < 4; ++m) _Pragma("unroll") for (int n = 0; n < 2; ++n) { \
        if constexpr (FP8) asm volatile("v_mfma_scale_f32_16x16x128_f8f6f4 %0, %1, %2, %0, %3, %3 op_sel_hi:[0,0,0]" : "+v"(acc[ai][bj][m][n]) : "v"(Bt##8[n]), "v"(At##8[m]), "v"(scl1)); \
        else { _Pragma("unroll") for (int k = 0; k < 2; ++k) acc[ai][bj][m][n] = __builtin_amdgcn_mfma_f32_16x16x32_bf16(Bt[n][k], At[m][k], acc[ai][bj][m][n], 0, 0, 0); } } \
        __builtin_amdgcn_s_setprio(0); } while (0)
#define PG8_WAIT_V(n) asm volatile("s_waitcnt vmcnt(" #n ")" ::: "memory")
#define PG8_WAIT_L(n) asm volatile("s_waitcnt lgkmcnt(" #n ")" ::: "memory")
#define PG8_BAR __builtin_amdgcn_s_barrier()
#define PG8_SCHED __builtin_amdgcn_sched_barrier(0)
    Unit cur, nxt;
    if (!S.next(cur)) return;
    const unsigned scl1 = 0x7f7f7f7fu;
    f32x4 acc[2][2][4][2];
#pragma unroll
    for (int a = 0; a < 2; ++a)
#pragma unroll
        for (int b = 0; b < 2; ++b)
#pragma unroll
            for (int m = 0; m < 4; ++m)
#pragma unroll
                for (int n = 0; n < 2; ++n) acc[a][b][m][n] = (f32x4){0.f, 0.f, 0.f, 0.f};
    bf16x8 At[4][2], B0[2][2], B1[2][2]; i32x8 At8[4], B08[2], B18[2];
    const char* cA = (const char*)g.A + (size_t)cur.e * g.astride + (gather ? (size_t)0 : (size_t)cur.pm * tstep); const char* cB = (const char*)g.Bt + (size_t)cur.e * g.estride + (size_t)cur.pn * tstep;
    PG8_AOFF(vA0, vA1, cur);
    PG8_STAGE(PG8_SB(0, 0), cB, voffB); PG8_STAGE(PG8_SB(0, 1), cB + hstep, voffB); PG8_STAGE(PG8_SA(0, 0), cA, vA0); PG8_STAGE(PG8_SA(0, 1), cA + hsA, vA1);
    if (wr == 1) PG8_BAR;
    PG8_WAIT_V(2); PG8_BAR;
    PG8_STAGE(PG8_SB(1, 0), cB + kstep, voffB); PG8_STAGE(PG8_SA(1, 0), cA + kstep, vA0); PG8_STAGE(PG8_SB(1, 1), cB + hstep + kstep, voffB);
    PG8_WAIT_V(6); PG8_BAR;
    for (;;) {
        const bool has_next = S.next(nxt);
        const char* nA = has_next ? (const char*)g.A + (size_t)nxt.e * g.astride + (gather ? (size_t)0 : (size_t)nxt.pm * tstep) : cA;
        if (has_next) PG8_AOFF(nA0, nA1, nxt);
        const char* nB = has_next ? (const char*)g.Bt + (size_t)nxt.e * g.estride + (size_t)nxt.pn * tstep : cB;
        for (int t = 0; t < nt; t += 2) {
            const bool last = (t == nt - 2);
            const char* a1 = cA + (size_t)(t + 1) * kstep;
            const char* a2 = last ? nA : cA + (size_t)(t + 2) * kstep; const char* b2 = last ? nB : cB + (size_t)(t + 2) * kstep;
            const char* a3 = a2 + kstep; const char* b3 = b2 + kstep;
            PG8_LDB(B0, 0, 0); PG8_LDB(B1, 0, 1); PG8_SCHED; PG8_LDA(At, 0, 0); PG8_STAGE(PG8_SA(1, 1), a1 + hsA, vA1);
            if (last && has_next) { vA0[0] = nA0[0]; vA0[1] = nA0[1]; vA1[0] = nA1[0]; vA1[1] = nA1[1]; }
            PG8_WAIT_V(8); PG8_WAIT_L(0); PG8_BAR; PG8_MMA(0, 0, At, B0); PG8_MMA(0, 1, At, B1); PG8_BAR; PG8_SCHED;
            PG8_LDA(At, 0, 1); PG8_STAGE(PG8_SB(0, 0), b2, voffB); PG8_STAGE(PG8_SB(0, 1), b2 + hstep, voffB); PG8_STAGE(PG8_SA(0, 0), a2, vA0);
            PG8_WAIT_V(8); PG8_WAIT_L(0); PG8_BAR; PG8_MMA(1, 0, At, B0); PG8_MMA(1, 1, At, B1); PG8_BAR; PG8_SCHED;
            PG8_LDB(B0, 1, 0); PG8_LDB(B1, 1, 1); PG8_SCHED; PG8_LDA(At, 1, 0); PG8_STAGE(PG8_SA(0, 1), a2 + hsA, vA1);
            PG8_WAIT_V(8); PG8_WAIT_L(0); PG8_BAR; PG8_MMA(0, 0, At, B0); PG8_MMA(0, 1, At, B1); PG8_BAR; PG8_SCHED;
            PG8_LDA(At, 1, 1); PG8_STAGE(PG8_SB(1, 0), b3, voffB); PG8_STAGE(PG8_SB(1, 1), b3 + hstep, voffB); PG8_STAGE(PG8_SA(1, 0), a3, vA0);
            PG8_WAIT_V(8); PG8_WAIT_L(0); PG8_BAR; PG8_MMA(1, 0, At, B0); PG8_MMA(1, 1, At, B1); PG8_BAR; PG8_SCHED;
        }
        if (wr == 0) PG8_BAR;
        if constexpr (FP8) {
#pragma unroll
            for (int a = 0; a < 2; ++a)
#pragma unroll
                for (int b = 0; b < 2; ++b) asm volatile("s_nop 15" : "+v"(acc[a][b][0][0]), "+v"(acc[a][b][0][1]), "+v"(acc[a][b][1][0]), "+v"(acc[a][b][1][1]), "+v"(acc[a][b][2][0]), "+v"(acc[a][b][2][1]), "+v"(acc[a][b][3][0]), "+v"(acc[a][b][3][1]));
        }
        const bool keep_acc = E(acc, cur, wr, wc, fr, fq);
        if (!has_next) break;
        if (!keep_acc)
#pragma unroll
        for (int a = 0; a < 2; ++a)
#pragma unroll
            for (int b = 0; b < 2; ++b)
#pragma unroll
                for (int m = 0; m < 4; ++m)
#pragma unroll
                    for (int n = 0; n < 2; ++n) acc[a][b][m][n] = (f32x4){0.f, 0.f, 0.f, 0.f};
        cur = nxt; cA = nA; cB = nB;
        if (wr == 1) PG8_BAR;
    }
    PG8_WAIT_V(0);
    PG8_BAR;
#undef PG8_AOFF
#undef PG8_SA
#undef PG8_SB
#undef PG8_STAGE
#undef PG8_LDA
#undef PG8_LDB
#undef PG8_MMA
#undef PG8_LD8
#undef PG8_WAIT_V
#undef PG8_WAIT_L
#undef PG8_BAR
#undef PG8_SCHED
}

struct EpiBf16 {
    static constexpr bool PERM = true;
    bf16_t* O; int ldc; const float* bias; int bias_estride; float ascale; int skip_from, skip_cols;
    __device__ __forceinline__ bool operator()(const f32x4 (&acc)[2][2][4][2], const Unit& u, int wr, int wc, int fr, int fq) const {
        const int row0 = u.pm * BM + wr * 64 + fr; const int col0 = u.pn * BM + wc * 32 + 8 * fq + (u.pn >= skip_from ? skip_cols : 0);
        f32x4 bv[2][2];
#pragma unroll
        for (int bj = 0; bj < 2; ++bj)
#pragma unroll
            for (int n = 0; n < 2; ++n) bv[bj][n] = bias ? *(const f32x4*)(bias + (size_t)u.e * bias_estride + col0 + bj * HALF + 4 * n) : (f32x4){0.f, 0.f, 0.f, 0.f};
#pragma unroll
        for (int ai = 0; ai < 2; ++ai)
#pragma unroll
            for (int m = 0; m < 4; ++m) { bf16_t* rowp = O + (size_t)(row0 + ai * HALF + m * 16) * ldc + col0;
#pragma unroll
                for (int bj = 0; bj < 2; ++bj) { const f32x4 v0 = acc[ai][bj][m][0] * ascale + bv[bj][0], v1 = acc[ai][bj][m][1] * ascale + bv[bj][1];
                    u32x4 w; w.x = cvt_pk_bf16(v0[0], v0[1]); w.y = cvt_pk_bf16(v0[2], v0[3]); w.z = cvt_pk_bf16(v1[0], v1[1]); w.w = cvt_pk_bf16(v1[2], v1[3]);
                    *(u32x4*)(rowp + bj * HALF) = w; } }
        return false;
    }
};
__device__ __forceinline__ float swiglu1(float ug, float ul) {
    ug = fminf(ug, 7.0f); ul = fminf(fmaxf(ul, -7.0f), 7.0f);
    return ug * __builtin_amdgcn_rcpf(1.0f + __expf(-1.702f * ug)) * (ul + 1.0f);
}
struct EpiSwiglu {
    static constexpr bool PERM = true;
    unsigned char* O; const float* b1;
    __device__ __forceinline__ bool operator()(const f32x4 (&acc)[2][2][4][2], const Unit& u, int wr, int wc, int fr, int fq) const {
        const int row0 = u.pm * BM + wr * 64 + fr; const int c0 = u.pn * 128 + wc * 32 + 8 * fq;
        const float* bg = b1 + (size_t)u.e * 4096 + c0; const float* bl = bg + 2048;
        f32x4 bgv[2], blv[2];
#pragma unroll
        for (int n = 0; n < 2; ++n) { bgv[n] = *(const f32x4*)(bg + 4 * n); blv[n] = *(const f32x4*)(bl + 4 * n); }
#pragma unroll
        for (int ai = 0; ai < 2; ++ai)
#pragma unroll
            for (int m = 0; m < 4; ++m) {
                float a[8];
#pragma unroll
                for (int n = 0; n < 2; ++n)
#pragma unroll
                    for (int j = 0; j < 4; ++j) a[4 * n + j] = ACT8_SCALE * swiglu1(acc[ai][0][m][n][j] * (1.0f / W8_SCALE) + bgv[n][j], acc[ai][1][m][n][j] * (1.0f / W8_SCALE) + blv[n][j]);
                u32x2 w; w.x = pack4_fp8(a[0], a[1], a[2], a[3]); w.y = pack4_fp8(a[4], a[5], a[6], a[7]);
                *(u32x2*)(O + (size_t)(row0 + ai * HALF + m * 16) * 2048 + c0) = w;
            }
        return false;
    }
};

struct TwoPartOrder {
    StaticOrder so; Unit held; int part;
    __device__ void init(int M, int N, int G_, int c_) { so.init(M, N, G_, c_); part = 0; }
    __device__ bool next(Unit& u) { if (part == 1) { u = held; u.e = 1; part = 0; return true; } if (!so.next(held)) return false; u = held; u.e = 0; part = 1; return true; }
};
struct EpiGate2 {
    static constexpr bool PERM = true;
    unsigned char* O; const bf16_t* Ga; const bf16_t* Gr;
    __device__ __forceinline__ bool operator()(f32x4 (&acc)[2][2][4][2], const Unit& u, int wr, int wc, int fr, int fq) const {
        const int row0 = u.pm * BM + wr * 64 + fr; const int col0 = u.pn * BM + wc * 32 + 8 * fq;
#pragma unroll
        for (int ai = 0; ai < 2; ++ai)
#pragma unroll
            for (int m = 0; m < 4; ++m) { const size_t row = (size_t)(row0 + ai * HALF + m * 16);
#pragma unroll
                for (int bj = 0; bj < 2; ++bj) { const int c = col0 + bj * HALF;
                    const u32x4 gr = *(const u32x4*)(Gr + row * DINP + c);
                    if (u.e == 0) {
                        const u32x4 ga = *(const u32x4*)(Ga + row * DINP + c);
#pragma unroll
                        for (int q = 0; q < 4; ++q) {
                            const float r0 = (1.0f + __expf(-bf_lo(gr[q]))) * __builtin_amdgcn_rcpf(1.0f + __expf(-bf_lo(ga[q]))), r1 = (1.0f + __expf(-bf_hi(gr[q]))) * __builtin_amdgcn_rcpf(1.0f + __expf(-bf_hi(ga[q])));
                            acc[ai][bj][m][q >> 1][(2 * q) & 3] *= r0; acc[ai][bj][m][q >> 1][(2 * q + 1) & 3] *= r1; }
                    } else {
                        float r[8];
#pragma unroll
                        for (int q = 0; q < 4; ++q) { r[2 * q] = sigmoidf_(bf_lo(gr[q])) * acc[ai][bj][m][q >> 1][(2 * q) & 3]; r[2 * q + 1] = sigmoidf_(bf_hi(gr[q])) * acc[ai][bj][m][q >> 1][(2 * q + 1) & 3]; }
                        u32x2 w; constexpr float osc = MRG8_SCALE / (W8_SCALE * OP8_SCALE); w.x = pack4_fp8(r[0] * osc, r[1] * osc, r[2] * osc, r[3] * osc); w.y = pack4_fp8(r[4] * osc, r[5] * osc, r[6] * osc, r[7] * osc);
                        *(u32x2*)(O + row * 2048 + c) = w; } } }
        return u.e == 0;
    }
};
struct EpiDelta {
    static constexpr bool PERM = true;
    const float* gt; bf16_t* DL; float ascale;
    __device__ __forceinline__ bool operator()(const f32x4 (&acc)[2][2][4][2], const Unit& u, int wr, int wc, int fr, int fq) const {
        const int row0 = u.pm * BM + wr * 64 + fr; const int col0 = u.pn * BM + wc * 32 + 8 * fq;
        f32x4 g[2][2];
#pragma unroll
        for (int bj = 0; bj < 2; ++bj)
#pragma unroll
            for (int n = 0; n < 2; ++n) g[bj][n] = *(const f32x4*)(gt + col0 + bj * HALF + 4 * n);
#pragma unroll
        for (int ai = 0; ai < 2; ++ai)
#pragma unroll
            for (int m = 0; m < 4; ++m) { bf16_t* rowp = DL + (size_t)(row0 + ai * HALF + m * 16) * 2048 + col0;
#pragma unroll
                for (int bj = 0; bj < 2; ++bj) { const f32x4 v0 = acc[ai][bj][m][0] * ascale * g[bj][0], v1 = acc[ai][bj][m][1] * ascale * g[bj][1];
                    u32x4 w; w.x = cvt_pk_bf16(v0[0], v0[1]); w.y = cvt_pk_bf16(v0[2], v0[3]); w.z = cvt_pk_bf16(v1[0], v1[1]); w.w = cvt_pk_bf16(v1[2], v1[3]);
                    *(u32x4*)(rowp + bj * HALF) = w; } }
        return false;
    }
};
}

struct Args { const void* in[22]; float* out; unsigned char* ws; int ph_lo, ph_hi, flags, pad; };
constexpr int XCONV = 0, XSCORE = 96;
constexpr int CW_SCQ = 12288, SCP = 5, CW_ATQ = 12352;
enum { PH_PRO = 0, PH_H, PH_INPROJ, PH_POST, PH_SCORE, PH_SELECT, PH_ATTN, PH_OP1, PH_OP2, PH_WOUT, PH_ROUTER, PH_SCATTER, PH_MOE1, PH_MOE2, PH_FINAL, NPH };

__device__ __forceinline__ int dest_row(int mode, int n) {
    if (mode == 1) return n < 2640 ? n : n + 176;
    if (mode == 2) { const int g = n >> 11, c = n & 2047; return (c >> 7) * 256 + g * 128 + (c & 127); }
    return n;
}
__device__ __forceinline__ void convert_item(const float* __restrict__ W, int K, int N, int ld, bf16_t* WT, int mode, int item, int lane, LAS unsigned char* scr) {
    const int nblk = (N + 63) >> 6; const int kb = item / nblk, nb = item - kb * nblk; const int k0 = kb * 128, n0 = nb * 64;
    const int c4 = lane & 15, kr = lane >> 4;
    const bool ok = (n0 + 4 * c4) < N;
    const float* src = W + (size_t)(k0 + 2 * kr) * ld + n0 + 4 * c4;
#pragma unroll 4
    for (int i = 0; i < 16; ++i) {
        f32x4 v0 = (f32x4){0.f, 0.f, 0.f, 0.f}, v1 = v0;
        if (ok) { v0 = *(const f32x4*)(src + (size_t)(8 * i) * ld); v1 = *(const f32x4*)(src + (size_t)(8 * i + 1) * ld); }
        const int kk = 8 * i + 2 * kr;
#pragma unroll
        for (int e = 0; e < 4; ++e) *(LAS unsigned*)(scr + (4 * c4 + e) * 272 + kk * 2) = cvt_pk_bf16(v0[e], v1[e]);
    }
    LDS_WAIT(); asm volatile("" ::: "memory");
#pragma unroll 4
    for (int j = 0; j < 16; ++j) {
        const int q = j * 64 + lane, n = q >> 4, ch = q & 15;
        const u32x4 v = *(const LAS u32x4*)(scr + n * 272 + ch * 16);
        if (n0 + n < N) *(u32x4*)(WT + (size_t)dest_row(mode, n0 + n) * K + k0 + ch * 8) = v;
    }
    LDS_WAIT(); asm volatile("" ::: "memory");
}


__device__ __forceinline__ bf16_t f2bf(float f) { unsigned u = __float_as_uint(f); return (bf16_t)((u + 0x7fffu + ((u >> 16) & 1u)) >> 16); }
__device__ __forceinline__ float bfx(const u32x4& w, int i) { const unsigned u = w[i >> 1]; return (i & 1) ? bf_hi(u) : bf_lo(u); }
__device__ __forceinline__ void rope_sc(float pos, float inv, float& sn, float& cs) {
    const float ang = pos * inv;
    const double a = (double)ang; const double n = __builtin_rint(a * 0.15915494309189535); const float r = (float)(a - n * 6.283185307179586);
    sn = sinf(r); cs = cosf(r);
}
__device__ __forceinline__ void post_token(bf16_t* PROJ, bf16_t* KI, unsigned char* KC, unsigned char* VC, const int* positions, const float* kng, const float* knb, int t, int lane) {
    const float pos = (float)positions[t];
    bf16_t* row = PROJ + (size_t)t * DINP;
    float sn, cs;
#pragma unroll
    for (int i = 0; i < 2; ++i) {
        const int pp = lane + 64 * i, hd = pp >> 4, ii = pp & 15;
        rope_sc(pos, powf(500000.0f, -(float)ii * (1.0f / 16.0f)), sn, cs);
        bf16_t* p = row + CQ + hd * 128 + ii; const float a = bf2f(p[0]), b = bf2f(p[16]);
        p[0] = f2bf(a * cs - b * sn); p[16] = f2bf(b * cs + a * sn);
    }
#pragma unroll
    for (int i = 0; i < 2; ++i) {
        const int pp = lane + 64 * i, hd = pp >> 3, ii = pp & 7;
        rope_sc(pos, powf(500000.0f, -(float)ii * (1.0f / 8.0f)), sn, cs);
        bf16_t* p = row + CQI + hd * 64 + ii; const float a = bf2f(p[0]), b = bf2f(p[8]);
        p[0] = f2bf(a * cs - b * sn); p[8] = f2bf(b * cs + a * sn);
    }
    if (lane < 32) {
        const int g = lane >> 4, ii = lane & 15;
        rope_sc(pos, powf(500000.0f, -(float)ii * (1.0f / 16.0f)), sn, cs);
        const bf16_t* p = row + CK + g * 128 + ii; const float a = bf2f(p[0]), b = bf2f(p[16]);
        unsigned char* o = KC + (size_t)t * 256 + g * 128 + ii; o[0] = fp8_1(a * cs - b * sn); o[16] = fp8_1(b * cs + a * sn);
    }
#pragma unroll
    for (int i = 0; i < 3; ++i) { const int idx = lane + 64 * i, g = idx / 96, r = idx - g * 96; KC[(size_t)t * 256 + g * 128 + 32 + r] = fp8_1(bf2f(row[CK + g * 128 + 32 + r])); }
    { const u32x2 w = *(const u32x2*)(row + CV + 4 * lane); *(unsigned*)(VC + (size_t)t * 256 + 4 * lane) = pack4_fp8(bf_lo(w.x), bf_hi(w.x), bf_lo(w.y), bf_hi(w.y)); }
    {
        const float v = bf2f(row[CKI + lane]);
        const float mean = wave_sum(v) * (1.0f / 64.0f); const float d = v - mean; const float var = wave_sum(d * d) * (1.0f / 64.0f);
        const float y = d * rsqrtf(var + NORM_EPS) * kng[lane] + knb[lane];
        const float other = __shfl_xor(y, 8);
        rope_sc(pos, powf(500000.0f, -(float)(lane & 7) * (1.0f / 8.0f)), sn, cs);
        float o = y;
        if (lane < 8) o = y * cs - other * sn; else if (lane < 16) o = y * cs + other * sn;
        KI[(size_t)t * 64 + lane] = f2bf(o);
    }
}

constexpr int HG_GB = 0, HG_Q1 = 33792, HG_Q2 = 51200, HG_K2 = 68608, HG_VT = 86016, HG_PB = 104448, HG_LB = 113664;
__device__ __forceinline__ void hgrn_cumsum(LAS unsigned char* lds, const u32x4& w0, const u32x4& w1, float l0, float l1, int tid) {
    LAS float* GB = (LAS float*)(lds + HG_GB); LAS float* LB = (LAS float*)(lds + HG_LB); LAS float* SEG = (LAS float*)(lds + HG_LB + 512);
    if (tid < 128) LB[tid] = 1.0f / (1.0f + expf(l1 - l0));
    __syncthreads();
    const int t = tid >> 3, dseg = tid & 7;
#pragma unroll
    for (int i = 0; i < 16; ++i) { const float z = i < 8 ? bfx(w0, i) : bfx(w1, i - 8); const float lb = LB[16 * dseg + i]; GB[t * 128 + 16 * dseg + i] = logf(lb + (1.0f - lb) * sigmoidf_(z)); }
    __syncthreads();
    const int d = tid & 127, tq = tid >> 7;
    float z[16];
#pragma unroll
    for (int i = 0; i < 16; ++i) z[i] = GB[(16 * tq + i) * 128 + d];
    float a = 0.f;
#pragma unroll
    for (int i = 0; i < 16; ++i) { a += z[i]; z[i] = a; }
    SEG[tq * 128 + d] = a;
    __syncthreads();
    float pre = 0.f;
    for (int q = 0; q < tq; ++q) pre += SEG[q * 128 + d];
#pragma unroll
    for (int i = 0; i < 16; ++i) GB[(16 * tq + i) * 128 + d] = z[i] + pre;
    __syncthreads();
}
__device__ __forceinline__ void hgrn_vt(LAS unsigned char* lds, const u32x4& a, const u32x4& b, int tid) {
    const int s2 = tid & 31, eg = tid >> 5;
#pragma unroll
    for (int i = 0; i < 8; ++i) { const unsigned lo = (i & 1) ? (a[i >> 1] >> 16) : (a[i >> 1] & 0xffffu), hi = (i & 1) ? (b[i >> 1] >> 16) : (b[i >> 1] & 0xffffu);
        *(LAS unsigned*)(lds + HG_VT + (8 * eg + i) * 144 + s2 * 4) = lo | (hi << 16); }
}
__device__ __forceinline__ void hgrn_l1(LAS unsigned char* lds, const bf16_t* PROJ, const float* lb_logits, float* ST, float* DC, int c, int h, int tid, int wave, int lane) {
    const int t = tid >> 3, dseg = tid & 7, s2 = tid & 31, dg = tid >> 5;
    const bf16_t* pf = PROJ + (size_t)(c * 64 + t) * DINP + CHF + h * 128 + 16 * dseg;
    const bf16_t* pk = PROJ + (size_t)(c * 64 + 2 * s2) * DINP + CHF + h * 128 + 8 * dg;
    const u32x4 w0 = *(const u32x4*)pf, w1 = *(const u32x4*)(pf + 8);
    const u32x4 ka = *(const u32x4*)pk, kb = *(const u32x4*)(pk + DINP);
    const u32x4 va = *(const u32x4*)(pk - CHF + CHI), vb = *(const u32x4*)(pk - CHF + CHI + DINP);
    const float l0 = lb_logits[h * 128 + (tid & 127)], l1 = lb_logits[1024 + h * 128 + (tid & 127)];
    hgrn_cumsum(lds, w0, w1, l0, l1, tid);
    const LAS float* GB = (const LAS float*)(lds + HG_GB); const LAS float* LB = (const LAS float*)(lds + HG_LB);
    {
#pragma unroll
        for (int i = 0; i < 8; ++i) { const int d = 8 * dg + i; const float lb = LB[d], b63 = GB[63 * 128 + d];
            const float k0 = (1.0f - lb) * (1.0f - sigmoidf_(bfx(ka, i))), k1 = (1.0f - lb) * (1.0f - sigmoidf_(bfx(kb, i)));
            const float v0 = k0 * __expf(b63 - GB[(2 * s2) * 128 + d]), v1 = k1 * __expf(b63 - GB[(2 * s2 + 1) * 128 + d]);
            *(LAS unsigned*)(lds + HG_Q1 + d * 144 + s2 * 4) = cvt_pk_bf16(v0, v1); }
    }
    hgrn_vt(lds, va, vb, tid);
    __syncthreads();
    const int fr = lane & 15, fq = lane >> 4;
    bf16x8 af[2];
#pragma unroll
    for (int ks = 0; ks < 2; ++ks) af[ks] = *(const LAS bf16x8*)(lds + HG_VT + (16 * wave + fr) * 144 + (32 * ks + 8 * fq) * 2);
    float* dst = ST + ((size_t)(c * 8 + h) * 128) * 128;
#pragma unroll 2
    for (int dt = 0; dt < 8; ++dt) {
        f32x4 acc = (f32x4){0.f, 0.f, 0.f, 0.f};
#pragma unroll
        for (int ks = 0; ks < 2; ++ks) { const bf16x8 bfr = *(const LAS bf16x8*)(lds + HG_Q1 + (16 * dt + fr) * 144 + (32 * ks + 8 * fq) * 2); acc = __builtin_amdgcn_mfma_f32_16x16x32_bf16(af[ks], bfr, acc, 0, 0, 0); }
#pragma unroll
        for (int r = 0; r < 4; ++r) dst[(size_t)(16 * wave + 4 * fq + r) * 128 + 16 * dt + fr] = acc[r];
    }
    if (tid < 128) DC[(size_t)(c * 8 + h) * 128 + tid] = __expf(GB[63 * 128 + tid]);
    __syncthreads();
}
__device__ __forceinline__ void hgrn_l3(LAS unsigned char* lds, const bf16_t* PROJ, const float* lb_logits, const float* ST, const float* norm_g, unsigned char* REC, int c, int h, int tid, int wave, int lane) {
    const int t = tid >> 3, dseg = tid & 7, s2 = tid & 31, eg = tid >> 5, fr = lane & 15, fq = lane >> 4;
    const bf16_t* pf = PROJ + (size_t)(c * 64 + t) * DINP + CHF + h * 128 + 16 * dseg;
    const u32x4 f0 = *(const u32x4*)pf, f1 = *(const u32x4*)(pf + 8), q0 = *(const u32x4*)(pf - CHF + CHQ), q1 = *(const u32x4*)(pf - CHF + CHQ + 8);
    const u32x4 g0 = *(const u32x4*)(pf - CHF + CHG), g1 = *(const u32x4*)(pf - CHF + CHG + 8);
    const bf16_t* pv = PROJ + (size_t)(c * 64 + 2 * s2) * DINP + CHI + h * 128 + 8 * eg;
    const u32x4 va = *(const u32x4*)pv, vb = *(const u32x4*)(pv + DINP);
    const float* sp = ST + ((size_t)(c * 8 + h) * 128 + 16 * wave + fr) * 128 + 8 * fq;
    f32x4 sx[4][2];
#pragma unroll
    for (int ks = 0; ks < 4; ++ks) { sx[ks][0] = *(const f32x4*)(sp + 32 * ks); sx[ks][1] = *(const f32x4*)(sp + 32 * ks + 4); }
    const float l0 = lb_logits[h * 128 + (tid & 127)], l1 = lb_logits[1024 + h * 128 + (tid & 127)];
    hgrn_cumsum(lds, f0, f1, l0, l1, tid);
    const LAS float* GB = (const LAS float*)(lds + HG_GB); const LAS float* LB = (const LAS float*)(lds + HG_LB);
    {
        unsigned o1[8], o2[8], o3[8];
#pragma unroll
        for (int i = 0; i < 16; i += 2) {
            float a1[2], a2[2], a3[2];
#pragma unroll
            for (int j = 0; j < 2; ++j) { const int d = 16 * dseg + i + j; const float lb = LB[d], b = GB[t * 128 + d], br = GB[31 * 128 + d];
                const float z = (i + j) < 8 ? bfx(f0, i + j) : bfx(f1, i + j - 8), qv = (i + j) < 8 ? bfx(q0, i + j) : bfx(q1, i + j - 8);
                const float k = (1.0f - lb) * (1.0f - sigmoidf_(z)), q = siluf_(qv);
                a1[j] = q * __expf(b); a2[j] = q * __expf(b - br); a3[j] = k * __expf(br - b); }
            o1[i >> 1] = cvt_pk_bf16(a1[0], a1[1]); o2[i >> 1] = cvt_pk_bf16(a2[0], a2[1]); o3[i >> 1] = cvt_pk_bf16(a3[0], a3[1]);
        }
        LAS u32x4* d1 = (LAS u32x4*)(lds + HG_Q1 + t * 272 + dseg * 32); LAS u32x4* d2 = (LAS u32x4*)(lds + HG_Q2 + t * 272 + dseg * 32); LAS u32x4* d3 = (LAS u32x4*)(lds + HG_K2 + t * 272 + dseg * 32);
        d1[0] = (u32x4){o1[0], o1[1], o1[2], o1[3]}; d1[1] = (u32x4){o1[4], o1[5], o1[6], o1[7]};
        d2[0] = (u32x4){o2[0], o2[1], o2[2], o2[3]}; d2[1] = (u32x4){o2[4], o2[5], o2[6], o2[7]};
        d3[0] = (u32x4){o3[0], o3[1], o3[2], o3[3]}; d3[1] = (u32x4){o3[4], o3[5], o3[6], o3[7]};
    }
    hgrn_vt(lds, va, vb, tid);
    __syncthreads();
#pragma unroll
    for (int q = 0; q < 2; ++q) {
        const int tile = 2 * wave + q, tt = tile >> 2, stl = tile & 3;
        f32x4 acc = (f32x4){0.f, 0.f, 0.f, 0.f};
#pragma unroll
        for (int ks = 0; ks < 4; ++ks) { const bf16x8 a = *(const LAS bf16x8*)(lds + HG_Q2 + (16 * tt + fr) * 272 + (32 * ks + 8 * fq) * 2), b = *(const LAS bf16x8*)(lds + HG_K2 + (16 * stl + fr) * 272 + (32 * ks + 8 * fq) * 2);
            acc = __builtin_amdgcn_mfma_f32_16x16x32_bf16(a, b, acc, 0, 0, 0); }
#pragma unroll
        for (int r = 0; r < 4; ++r) { const int tr_ = 16 * tt + 4 * fq + r, s = 16 * stl + fr; *(LAS bf16_t*)(lds + HG_PB + tr_ * 144 + s * 2) = f2bf(s <= tr_ ? acc[r] : 0.f); }
    }
    __syncthreads();
    {
        bf16x8 b1[2], b2[4];
#pragma unroll
        for (int ks = 0; ks < 2; ++ks) b1[ks] = *(const LAS bf16x8*)(lds + HG_VT + (16 * wave + fr) * 144 + (32 * ks + 8 * fq) * 2);
#pragma unroll
        for (int ks = 0; ks < 4; ++ks) { const f32x4 x0 = sx[ks][0], x1 = sx[ks][1];
            u32x4 w; w.x = cvt_pk_bf16(x0[0], x0[1]); w.y = cvt_pk_bf16(x0[2], x0[3]); w.z = cvt_pk_bf16(x1[0], x1[1]); w.w = cvt_pk_bf16(x1[2], x1[3]); b2[ks] = __builtin_bit_cast(bf16x8, w); }
        LAS float* OB = (LAS float*)(lds + HG_GB);
#pragma unroll
        for (int tt = 0; tt < 4; ++tt) {
            f32x4 acc = (f32x4){0.f, 0.f, 0.f, 0.f};
#pragma unroll
            for (int ks = 0; ks < 2; ++ks) { const bf16x8 a = *(const LAS bf16x8*)(lds + HG_PB + (16 * tt + fr) * 144 + (32 * ks + 8 * fq) * 2); acc = __builtin_amdgcn_mfma_f32_16x16x32_bf16(a, b1[ks], acc, 0, 0, 0); }
#pragma unroll
            for (int ks = 0; ks < 4; ++ks) { const bf16x8 a = *(const LAS bf16x8*)(lds + HG_Q1 + (16 * tt + fr) * 272 + (32 * ks + 8 * fq) * 2); acc = __builtin_amdgcn_mfma_f32_16x16x32_bf16(a, b2[ks], acc, 0, 0, 0); }
#pragma unroll
            for (int r = 0; r < 4; ++r) OB[(16 * tt + 4 * fq + r) * 132 + 16 * wave + fr] = acc[r];
        }
    }
    __syncthreads();
    {
        const int es = dseg; const LAS float* OB = (const LAS float*)(lds + HG_GB);
        float o[16]; float ss = 0.f;
#pragma unroll
        for (int i = 0; i < 16; ++i) { o[i] = OB[t * 132 + 16 * es + i]; ss += o[i] * o[i]; }
        ss += __shfl_xor(ss, 1); ss += __shfl_xor(ss, 2); ss += __shfl_xor(ss, 4);
        const float rstd = rsqrtf(ss * (1.0f / 128.0f) + NORM_EPS);
        float rv[16];
#pragma unroll
        for (int i = 0; i < 16; ++i) { const float ga = i < 8 ? bfx(g0, i) : bfx(g1, i - 8); rv[i] = o[i] * (rstd * OP8_SCALE) * norm_g[16 * es + i] * siluf_(ga); }
        *(u32x4*)(REC + (size_t)(c * 64 + t) * 1024 + h * 128 + 16 * es) = (u32x4){pack4_fp8(rv[0], rv[1], rv[2], rv[3]), pack4_fp8(rv[4], rv[5], rv[6], rv[7]), pack4_fp8(rv[8], rv[9], rv[10], rv[11]), pack4_fp8(rv[12], rv[13], rv[14], rv[15])};
    }
    __syncthreads();
}

constexpr int SC_KT = 0, SC_SB = 36864, SC_SPITCH = 132;
__device__ __forceinline__ unsigned pk_f16(float a, float b) { return __builtin_bit_cast(unsigned, __builtin_amdgcn_cvt_pkrtz(a, b)); }
__device__ __forceinline__ void score_flush(LAS unsigned char* lds, unsigned short* SCORES, unsigned short* SEGMAX, int t0, int kt, int tid) {
    const LAS float* sb = (const LAS float*)(lds + SC_SB + (kt & 1) * (32 * SC_SPITCH * 4));
    const int row = tid >> 4, seg = tid & 15;
    const f32x4 a = *(const LAS f32x4*)(sb + row * SC_SPITCH + seg * 8), b = *(const LAS f32x4*)(sb + row * SC_SPITCH + seg * 8 + 4);
    unsigned short* dst = SCORES + (size_t)(t0 + row) * S + kt * 128 + seg * 8;
    *(u32x4*)dst = (u32x4){pk_f16(a[0], a[1]), pk_f16(a[2], a[3]), pk_f16(b[0], b[1]), pk_f16(b[2], b[3])};
    const float mx = fmaxf(fmaxf(fmaxf(a[0], a[1]), fmaxf(a[2], a[3])), fmaxf(fmaxf(b[0], b[1]), fmaxf(b[2], b[3])));
    SEGMAX[(size_t)(t0 + row) * 2048 + kt * 16 + seg] = (unsigned short)(pk_f16(mx, mx) & 0xffffu);
}
__device__ __forceinline__ void score_block(LAS unsigned char* lds, const bf16_t* PROJ, const bf16_t* KI, unsigned short* SCORES, unsigned short* SEGMAX, int qb, int kt0, int kt1, int tid, int wave, int lane) {
    const int t0 = qb * 32;
    const int r = lane & 31, hh = lane >> 5;
    bf16x8 Af[2][4]; float wv[2][16]; f32x2 wv2[2][8];
#pragma unroll
    for (int p = 0; p < 2; ++p) {
        const int tq = t0 + 4 * wave + 2 * p + (r >> 4); const bf16_t* qrow = PROJ + (size_t)tq * DINP + CQI + (r & 15) * 64 + 8 * hh;
#pragma unroll
        for (int ks = 0; ks < 4; ++ks) Af[p][ks] = *(const bf16x8*)(qrow + 16 * ks);
#pragma unroll
        for (int reg = 0; reg < 16; ++reg) { const int row = (reg & 3) + 8 * (reg >> 2) + 4 * hh; const int tw = t0 + 4 * wave + 2 * p + (row >> 4);
            wv[p][reg] = bf2f(PROJ[(size_t)tw * DINP + CWI + (row & 15)]) * (1.0f / 32.0f); }
#pragma unroll
        for (int i = 0; i < 8; ++i) wv2[p][i] = (f32x2){wv[p][2 * i], wv[p][2 * i + 1]};
    }
    const u32x2 tagsw = __builtin_amdgcn_permlane32_swap(0u, 1u, false, false); const int qsel = (int)tagsw[0];
    u32x4 stg[2];
#pragma unroll
    for (int i = 0; i < 2; ++i) { const int q = tid + 512 * i; stg[i] = *(const u32x4*)(KI + (size_t)(kt0 * 128 + (q >> 3)) * 64 + (q & 7) * 8); }
#pragma unroll
    for (int i = 0; i < 2; ++i) { const int q = tid + 512 * i; *(LAS u32x4*)(lds + SC_KT + (kt0 & 1) * 18432 + (q >> 3) * 144 + (q & 7) * 16) = stg[i]; }
    __syncthreads();
    for (int kt = kt0; kt < kt1; ++kt) {
        const LAS unsigned char* buf = lds + SC_KT + (kt & 1) * 18432;
        LAS float* sb = (LAS float*)(lds + SC_SB + (kt & 1) * (32 * SC_SPITCH * 4));
        if (kt + 1 < kt1) {
#pragma unroll
            for (int i = 0; i < 2; ++i) { const int q = tid + 512 * i; stg[i] = *(const u32x4*)(KI + (size_t)((kt + 1) * 128 + (q >> 3)) * 64 + (q & 7) * 8); }
        }
        __builtin_amdgcn_sched_barrier(0);
        if (kt > kt0) score_flush(lds, SCORES, SEGMAX, t0, kt - 1, tid);
        {
        f32x16 accP[2], accC[2];
#define SC_MFMA(cb) do { bf16x8 Bf[4]; _Pragma("unroll") for (int ks = 0; ks < 4; ++ks) Bf[ks] = *(const LAS bf16x8*)(buf + (32 * (cb) + r) * 144 + (16 * ks + 8 * hh) * 2); \
            _Pragma("unroll") for (int p = 0; p < 2; ++p) { _Pragma("unroll") for (int i = 0; i < 16; ++i) accC[p][i] = 0.f; \
                _Pragma("unroll") for (int ks = 0; ks < 4; ++ks) accC[p] = __builtin_amdgcn_mfma_f32_32x32x16_bf16(Af[p][ks], Bf[ks], accC[p], 0, 0, 0); } } while (0)
#define SC_RED(acc, cb) do { _Pragma("unroll") for (int p = 0; p < 2; ++p) { f32x2 s0 = {0.f, 0.f}, s1 = {0.f, 0.f}; \
            _Pragma("unroll") for (int reg = 0; reg < 8; reg += 2) { const f32x2 r0 = {relu_i(acc[p][reg]), relu_i(acc[p][reg + 1])}; const f32x2 r1 = {relu_i(acc[p][reg + 8]), relu_i(acc[p][reg + 9])}; \
                s0 = __builtin_elementwise_fma(wv2[p][reg >> 1], r0, s0); s1 = __builtin_elementwise_fma(wv2[p][4 + (reg >> 1)], r1, s1); } \
            const float p0 = s0[0] + s0[1], p1 = s1[0] + s1[1]; \
            const u32x2 sw = __builtin_amdgcn_permlane32_swap(__float_as_uint(p0), __float_as_uint(p1), false, false); \
            sb[(4 * wave + 2 * p + qsel) * SC_SPITCH + 32 * (cb) + r] = __uint_as_float(sw[0]) + __uint_as_float(sw[1]); } } while (0)
#define SC_INTERLEAVE() do { _Pragma("unroll") for (int i = 0; i < 8; ++i) { __builtin_amdgcn_sched_group_barrier(0x008, 1, 0); __builtin_amdgcn_sched_group_barrier(0x002, 8, 0); } } while (0)
        SC_MFMA(0);
        accP[0] = accC[0]; accP[1] = accC[1]; SC_MFMA(1); SC_RED(accP, 0); SC_INTERLEAVE();
        accP[0] = accC[0]; accP[1] = accC[1]; SC_MFMA(2); SC_RED(accP, 1); SC_INTERLEAVE();
        accP[0] = accC[0]; accP[1] = accC[1]; SC_MFMA(3); SC_RED(accP, 2); SC_INTERLEAVE();
        SC_RED(accC, 3);
#undef SC_MFMA
#undef SC_RED
#undef SC_INTERLEAVE
        }
        if (kt + 1 < kt1) {
#pragma unroll
            for (int i = 0; i < 2; ++i) { const int q = tid + 512 * i; *(LAS u32x4*)(lds + SC_KT + ((kt + 1) & 1) * 18432 + (q >> 3) * 144 + (q & 7) * 16) = stg[i]; }
        }
        __syncthreads();
    }
    score_flush(lds, SCORES, SEGMAX, t0, kt1 - 1, tid);
    __syncthreads();
}

__device__ __forceinline__ float wave_kth16(const float (&v)[16], int K) {
    const float NINF = -__builtin_inff();
    float mx = NINF, mn = __builtin_inff();
#pragma unroll
    for (int j = 0; j < 16; ++j) { mx = fmaxf(mx, v[j]); mn = fminf(mn, v[j] == NINF ? __builtin_inff() : v[j]); }
    mx = wave_max(mx); mn = -wave_max(-mn);
    int c = 0;
#pragma unroll
    for (int j = 0; j < 16; ++j) c += __popcll(__ballot(v[j] >= mx));
    if (c >= K) return mx;
    float lo = mn, hi = mx, tau = mn;
    for (int it = 0; it < 64; ++it) {
        const float mid = 0.5f * (lo + hi);
        if (!(mid > lo && mid < hi)) { tau = lo; break; }
        c = 0;
#pragma unroll
        for (int j = 0; j < 16; ++j) c += __popcll(__ballot(v[j] >= mid));
        if (c == K) { tau = mid; break; }
        if (c > K) lo = mid; else hi = mid;
        tau = lo;
    }
    return tau;
}
__device__ __forceinline__ int lanes_below(unsigned long long mask) { return (int)__builtin_amdgcn_mbcnt_hi((unsigned)(mask >> 32), __builtin_amdgcn_mbcnt_lo((unsigned)mask, 0u)); }
__device__ __forceinline__ float h2f(unsigned short h) { return (float)__builtin_bit_cast(_Float16, h); }
__device__ __forceinline__ float h2f_lo(unsigned u) { return h2f((unsigned short)(u & 0xffffu)); }
__device__ __forceinline__ float h2f_hi(unsigned u) { return h2f((unsigned short)(u >> 16)); }
__device__ __forceinline__ unsigned ge_mask8(const u32x4& v, unsigned T16) {
    unsigned m8 = 0;
#pragma unroll
    for (int w = 0; w < 4; ++w) { const unsigned vw_ = v[w];
        const s16x2 d = __builtin_elementwise_sub_sat(__builtin_bit_cast(s16x2, vw_), __builtin_bit_cast(s16x2, T16));
        const unsigned mm = ~__builtin_bit_cast(unsigned, d); m8 |= (((mm >> 15) & 1u) | ((mm >> 30) & 2u)) << (2 * w); }
    return m8;
}
__device__ __forceinline__ int append_bits(LAS int* list, int cnt, unsigned m8, int base) {
    for (;;) { const bool has = m8 != 0u; const unsigned long long mask = __ballot(has); if (!mask) break;
        const int pos = cnt + lanes_below(mask);
        if (has) { const int k = __builtin_ctz(m8); m8 &= m8 - 1u; if (pos < 1024) list[pos] = base + k; }
        cnt += __popcll(mask); }
    return cnt;
}
__device__ __forceinline__ void select_row(LAS unsigned char* wl, const unsigned short* SCORES, const unsigned short* SEGMAX, int t, int lane) {
    LAS int* selw = (LAS int*)wl; LAS int* segl = (LAS int*)(wl + 1024); LAS int* cidx = (LAS int*)(wl + 5120);
    const float NINF = -__builtin_inff();
    const unsigned short* row = SCORES + (size_t)t * S; const int n = t + 1;
    float c[16]; int N;
    if (n <= 1024) {
#pragma unroll
        for (int j = 0; j < 16; ++j) { const int i = lane + 64 * j; c[j] = i < n ? h2f(row[i]) : NINF; }
        N = -1;
    } else {
        const int m = n >> 4; float s[16];
#pragma unroll
        for (int j = 0; j < 16; ++j) { const int i = lane + 64 * j; s[j] = i < m ? h2f(row[16 * i + 7]) : NINF; }
        int K = 32, cnt = 0;
        for (;;) {
            const float tlo = (K >= m) ? NINF : wave_kth16(s, K);
            cnt = 0;
            const int nq = (n + 511) >> 9;
            if (tlo > 0.f) {
                const unsigned T16 = pk_f16(tlo, tlo);
                const u32x4 NEG = (u32x4){0xfc00fc00u, 0xfc00fc00u, 0xfc00fc00u, 0xfc00fc00u};
                const unsigned short* smrow = SEGMAX + (size_t)t * 2048; const int nseg = (t >> 3) + 1;
                int ns = 0;
                {
                    u32x4 sv[4];
#pragma unroll
                    for (int u = 0; u < 4; ++u) { const int e8 = 8 * (lane + 64 * u); sv[u] = (e8 < nseg) ? *(const u32x4*)(smrow + e8) : NEG; }
#pragma unroll
                    for (int u = 0; u < 4; ++u) { const int e8 = 8 * (lane + 64 * u); unsigned m8 = ge_mask8(sv[u], T16);
                        const int nv = nseg - e8; if (nv < 8) m8 &= nv > 0 ? ((1u << nv) - 1u) : 0u;
                        ns = append_bits(segl, ns, m8, e8); }
                }
                if (ns > 1024) ns = 1024;
                for (int j0 = 0; j0 < ns; j0 += 256) {
                    u32x4 v[4]; int sg[4];
#pragma unroll
                    for (int u = 0; u < 4; ++u) { const int i = j0 + lane + 64 * u; sg[u] = i < ns ? segl[i] : -1; v[u] = sg[u] >= 0 ? *(const u32x4*)(row + 8 * sg[u]) : NEG; }
#pragma unroll
                    for (int u = 0; u < 4; ++u) { const int e = 8 * sg[u]; unsigned m8 = sg[u] >= 0 ? ge_mask8(v[u], T16) : 0u;
                        const int nv = t + 1 - e; if (nv < 8) m8 &= nv > 0 ? ((1u << nv) - 1u) : 0u;
                        cnt = append_bits(cidx, cnt, m8, e); }
                }
            } else {
                for (int q0 = 0; q0 < nq; q0 += 4) {
                    u32x4 v[4];
#pragma unroll
                    for (int u = 0; u < 4; ++u) { const int e = 8 * (lane + 64 * (q0 + u)); v[u] = (e <= t) ? *(const u32x4*)(row + e) : (u32x4){0xfc00fc00u, 0xfc00fc00u, 0xfc00fc00u, 0xfc00fc00u}; }
#pragma unroll
                    for (int u = 0; u < 4; ++u) { const int e = 8 * (lane + 64 * (q0 + u));
#pragma unroll
                        for (int k = 0; k < 8; ++k) { const float x = (k & 1) ? h2f_hi(v[u][k >> 1]) : h2f_lo(v[u][k >> 1]);
                            const bool pred = (e + k <= t) && (x >= tlo); const unsigned long long mask = __ballot(pred);
                            if (mask) { const int pos = cnt + lanes_below(mask); if (pred && pos < 1024) cidx[pos] = e + k; cnt += __popcll(mask); } } }
                }
            }
            if (cnt >= 256 || K >= m) break;
            K *= 2;
        }
        N = cnt < 1024 ? cnt : 1024;
#pragma unroll
        for (int j = 0; j < 16; ++j) { const int i = lane + 64 * j; c[j] = i < N ? h2f(row[cidx[i]]) : NINF; }
    }
    const float tau = wave_kth16(c, 256);
    int base = 0;
#pragma unroll
    for (int j = 0; j < 16; ++j) { const bool pred = c[j] >= tau; const unsigned long long mask = __ballot(pred);
        if (mask) { const int pos = base + lanes_below(mask); if (pred && pos < 256) selw[pos] = (N < 0) ? (lane + 64 * j) : cidx[lane + 64 * j]; base += __popcll(mask); } }
}

__device__ __forceinline__ void attn_query(LAS unsigned char* wl, const bf16_t* PROJ, const unsigned char* KC, const unsigned char* VC, unsigned char* ATT, int t, int lane) {
    LAS int* selw = (LAS int*)wl; LAS float* L = (LAS float*)(wl + 1024);
    const int nsel = t < 255 ? t + 1 : 256;
    const int fr = lane & 15, fq = lane >> 4;
    bf16x8 qf[2][4];
#pragma unroll
    for (int g = 0; g < 2; ++g)
#pragma unroll
        for (int ks = 0; ks < 4; ++ks) { const bf16x8 z = {0, 0, 0, 0, 0, 0, 0, 0}; qf[g][ks] = fr < 4 ? *(const bf16x8*)(PROJ + (size_t)t * DINP + CQ + (4 * g + fr) * 128 + 64 * (ks >> 1) + 16 * fq + 8 * (ks & 1)) : z; }
    const float scale = 0.08838834764831845f;
    const int nkt = (nsel + 15) >> 4;
    {
        LAS unsigned char* KT = wl + 9216;
        const int q4_ = lane >> 4, l15_ = lane & 15;
        u32x4 kw[3][4];
#define QK_LOAD(buf, kt) do { _Pragma("unroll") for (int u = 0; u < 4; ++u) { const unsigned off_ = (unsigned)selw[16 * (kt) + 4 * u + q4_] * 256u + 16u * (unsigned)l15_; kw[buf][u] = *(const u32x4*)((const char*)KC + off_); } } while (0)
#define QK_COMP(buf, kt) do { _Pragma("unroll") for (int u = 0; u < 4; ++u) { u32x4 lo_, hi_; fp8x16_to_bf16(kw[buf][u], lo_, hi_); LAS u32x4* d_ = (LAS u32x4*)(KT + (4 * u + q4_) * 528 + 32 * l15_); d_[0] = lo_; d_[1] = hi_; } \
        _Pragma("unroll") for (int g = 0; g < 2; ++g) { f32x4 acc = (f32x4){0.f, 0.f, 0.f, 0.f}; \
            _Pragma("unroll") for (int ks = 0; ks < 4; ++ks) { const bf16x8 kf_ = *(const LAS bf16x8*)(KT + fr * 528 + g * 256 + (64 * (ks >> 1) + 16 * fq + 8 * (ks & 1)) * 2); \
                acc = __builtin_amdgcn_mfma_f32_16x16x32_bf16(qf[g][ks], kf_, acc, 0, 0, 0); } \
            if (fq == 0) { _Pragma("unroll") for (int r = 0; r < 4; ++r) L[(4 * g + r) * 256 + 16 * (kt) + fr] = (16 * (kt) + fr < nsel) ? acc[r] * scale : -__builtin_inff(); } } } while (0)
        QK_LOAD(0, 0); if (1 < nkt) QK_LOAD(1, 1);
        for (int kt = 0; kt < nkt; kt += 3) {
            if (kt + 2 < nkt) QK_LOAD(2, kt + 2);
            __builtin_amdgcn_sched_barrier(0);
            QK_COMP(0, kt);
            if (kt + 1 < nkt) { if (kt + 3 < nkt) QK_LOAD(0, kt + 3); __builtin_amdgcn_sched_barrier(0); QK_COMP(1, kt + 1); }
            if (kt + 2 < nkt) { if (kt + 4 < nkt) QK_LOAD(1, kt + 4); __builtin_amdgcn_sched_barrier(0); QK_COMP(2, kt + 2); }
        }
#undef QK_LOAD
#undef QK_COMP
        if (fq == 0) { for (int kt = nkt; kt < 16; ++kt) {
#pragma unroll
            for (int r = 0; r < 8; ++r) L[r * 256 + 16 * kt + fr] = -__builtin_inff(); } }
    }
    float p[8][4];
#pragma unroll
    for (int hd = 0; hd < 8; ++hd) { float m = -__builtin_inff();
#pragma unroll
        for (int i = 0; i < 4; ++i) { p[hd][i] = L[hd * 256 + lane + 64 * i]; m = fmaxf(m, p[hd][i]); }
        m = wave_max(m); float s = 0.f;
#pragma unroll
        for (int i = 0; i < 4; ++i) { p[hd][i] = __expf(p[hd][i] - m); s += p[hd][i]; }
        s = 1.0f / wave_sum(s);
#pragma unroll
        for (int i = 0; i < 4; ++i) p[hd][i] *= s; }
    LAS bf16_t* Pb = (LAS bf16_t*)(wl + 1024);
#pragma unroll
    for (int hd = 0; hd < 8; ++hd)
#pragma unroll
        for (int i = 0; i < 4; ++i) Pb[hd * 256 + lane + 64 * i] = f2bf(p[hd][i]);
    LAS unsigned char* VT = wl + 9216;
    const int ii = lane & 15, kq = lane >> 4;
    f32x4 acc[16];
#pragma unroll
    for (int nt = 0; nt < 16; ++nt) acc[nt] = (f32x4){0.f, 0.f, 0.f, 0.f};
    const int nch = (nsel + 15) >> 4;
    u32x4 vw[3][4];
#define PV_LOAD(buf, c) do { _Pragma("unroll") for (int u = 0; u < 4; ++u) { const unsigned off_ = (unsigned)selw[16 * (c) + 4 * u + kq] * 256u + 16u * (unsigned)ii; vw[buf][u] = *(const u32x4*)((const char*)VC + off_); } } while (0)
#define PV_COMP(buf, c) do { _Pragma("unroll") for (int u = 0; u < 4; ++u) { u32x4 lo_, hi_; fp8x16_to_bf16(vw[buf][u], lo_, hi_); LAS u32x4* d_ = (LAS u32x4*)(VT + (4 * u + kq) * 528 + 32 * ii); d_[0] = lo_; d_[1] = hi_; } \
        s16x4 pa[2]; _Pragma("unroll") for (int g = 0; g < 2; ++g) { const s16x4 r_ = *(const LAS s16x4*)(Pb + (g * 4 + (ii & 3)) * 256 + 16 * (c) + 4 * kq); pa[g] = ii < 4 ? r_ : (s16x4){0, 0, 0, 0}; } \
        _Pragma("unroll") for (int nt = 0; nt < 16; ++nt) { const s16x4 b_ = __builtin_amdgcn_ds_read_tr16_b64_v4i16((LAS s16x4*)(VT + (4 * kq + (ii >> 2)) * 528 + (16 * nt + 4 * (ii & 3)) * 2)); \
            acc[nt] = __builtin_amdgcn_mfma_f32_16x16x16bf16_1k(pa[nt >> 3], b_, acc[nt], 0, 0, 0); } } while (0)
    PV_LOAD(0, 0); if (1 < nch) PV_LOAD(1, 1);
    for (int c = 0; c < nch; c += 3) {
        if (c + 2 < nch) PV_LOAD(2, c + 2);
        __builtin_amdgcn_sched_barrier(0);
        PV_COMP(0, c);
        if (c + 1 < nch) { if (c + 3 < nch) PV_LOAD(0, c + 3); __builtin_amdgcn_sched_barrier(0); PV_COMP(1, c + 1); }
        if (c + 2 < nch) { if (c + 4 < nch) PV_LOAD(1, c + 4); __builtin_amdgcn_sched_barrier(0); PV_COMP(2, c + 2); }
    }
#undef PV_LOAD
#undef PV_COMP
    LAS float* OB = (LAS float*)(wl + 1024 + 4096);
    if (kq == 0) {
#pragma unroll
        for (int nt = 0; nt < 16; ++nt)
#pragma unroll
            for (int r = 0; r < 4; ++r) OB[(4 * (nt >> 3) + r) * 128 + 16 * (nt & 7) + ii] = acc[nt][r];
    }
    {
        const f32x4 a0 = *(const LAS f32x4*)(OB + 16 * lane), a1 = *(const LAS f32x4*)(OB + 16 * lane + 4), a2 = *(const LAS f32x4*)(OB + 16 * lane + 8), a3 = *(const LAS f32x4*)(OB + 16 * lane + 12);
        const f32x4 b0 = a0 * OP8_SCALE, b1 = a1 * OP8_SCALE, b2 = a2 * OP8_SCALE, b3 = a3 * OP8_SCALE;
        *(u32x4*)(ATT + (size_t)t * 1024 + 16 * lane) = (u32x4){pack4_fp8(b0[0], b0[1], b0[2], b0[3]), pack4_fp8(b1[0], b1[1], b1[2], b1[3]), pack4_fp8(b2[0], b2[1], b2[2], b2[3]), pack4_fp8(b3[0], b3[1], b3[2], b3[3])};
    }
}


__device__ __forceinline__ void convert_item8(const float* __restrict__ W, int K, int N, int ld, unsigned char* WT, int mode, int item, int lane, LAS unsigned char* scr) {
    const int nblk = N >> 6; const int kb = item / nblk, nb = item - kb * nblk; const int k0 = kb * 256, n0 = nb * 64;
    const int c4 = lane & 15, kr = lane >> 4;
    const float* src = W + (size_t)(k0 + 4 * kr) * ld + n0 + 4 * c4;
#pragma unroll 4
    for (int i = 0; i < 16; ++i) {
        f32x4 v[4];
#pragma unroll
        for (int r = 0; r < 4; ++r) v[r] = __builtin_nontemporal_load((const f32x4*)(src + (size_t)(16 * i + r) * ld));
        const int kk = 16 * i + 4 * kr;
#pragma unroll
        for (int e = 0; e < 4; ++e) *(LAS unsigned*)(scr + (4 * c4 + e) * 272 + kk) = pack4_fp8(v[0][e] * W8_SCALE, v[1][e] * W8_SCALE, v[2][e] * W8_SCALE, v[3][e] * W8_SCALE);
    }
    LDS_WAIT(); asm volatile("" ::: "memory");
#pragma unroll 4
    for (int j = 0; j < 16; ++j) {
        const int q = j * 64 + lane, n = q >> 4, ch = q & 15;
        const u32x4 v = *(const LAS u32x4*)(scr + n * 272 + ch * 16);
        *(u32x4*)(WT + (size_t)dest_row(mode, n0 + n) * K + k0 + ch * 16) = v;
    }
    LDS_WAIT(); asm volatile("" ::: "memory");
}

struct Conv8Job { const float* W; unsigned char* WT; int N; int mode; size_t w_estride, wt_estride; int items_per_e; };
constexpr int C8_PITCH = 272, C8_IMG = 256 * C8_PITCH;
__device__ __forceinline__ void conv8_load(const Conv8Job& jb, int item, int h, int wave, int lane, f32x4 (&v)[16]) {
    const int e = item / jb.items_per_e, r = item - e * jb.items_per_e; const int nblk = jb.N >> 8; const int kb = r / nblk, nb = r - kb * nblk;
    const float* src = jb.W + (size_t)e * jb.w_estride + (size_t)(kb * 256 + 32 * wave + 16 * h) * jb.N + nb * 256 + 4 * lane;
#pragma unroll
    for (int i = 0; i < 16; ++i) v[i] = __builtin_nontemporal_load((const f32x4*)(src + (size_t)i * jb.N));
}
__device__ __forceinline__ void conv8_to_lds(LAS unsigned char* img, int h, int wave, int lane, const f32x4 (&v)[16]) {
#pragma unroll
    for (int e = 0; e < 4; ++e) { u32x4 w;
#pragma unroll
        for (int g = 0; g < 4; ++g) w[g] = pack4_fp8(v[4 * g][e] * W8_SCALE, v[4 * g + 1][e] * W8_SCALE, v[4 * g + 2][e] * W8_SCALE, v[4 * g + 3][e] * W8_SCALE);
        *(LAS u32x4*)(img + (4 * lane + e) * C8_PITCH + 32 * wave + 16 * h) = w; }
}
__device__ __forceinline__ void conv8_store(const Conv8Job& jb, int item, const LAS unsigned char* img, int tid) {
    const int e = item / jb.items_per_e, r = item - e * jb.items_per_e; const int nblk = jb.N >> 8; const int kb = r / nblk, nb = r - kb * nblk;
    unsigned char* dst = jb.WT + (size_t)e * jb.wt_estride + kb * 256;
#pragma unroll
    for (int j = 0; j < 8; ++j) { const int q = j * 512 + tid, n = q >> 4, ch = q & 15;
        __builtin_nontemporal_store(*(const LAS u32x4*)(img + n * C8_PITCH + ch * 16), (u32x4*)(dst + (size_t)dest_row(jb.mode, nb * 256 + n) * 2048 + ch * 16)); }
}
__device__ __forceinline__ void conv8_run(LAS unsigned char* lds, const Conv8Job& jb, int n_items, int wg, int G, int tid, int wave, int lane) {
    if (wg >= n_items) return;
    f32x4 a[16], b[16]; int par = 0;
    conv8_load(jb, wg, 0, wave, lane, a); conv8_load(jb, wg, 1, wave, lane, b);
    for (int it = wg; it < n_items; it += G, par ^= 1) {
        LAS unsigned char* img = lds + par * C8_IMG;
        const int nx = (it + G < n_items) ? it + G : it;
        conv8_to_lds(img, 0, wave, lane, a); __builtin_amdgcn_sched_barrier(0);
        conv8_load(jb, nx, 0, wave, lane, a); __builtin_amdgcn_sched_barrier(0);
        conv8_to_lds(img, 1, wave, lane, b); __builtin_amdgcn_sched_barrier(0);
        conv8_load(jb, nx, 1, wave, lane, b); __builtin_amdgcn_sched_barrier(0);
        __syncthreads();
        conv8_store(jb, it, img, tid);
    }
    __syncthreads();
}

__global__ void __launch_bounds__(NTHR, 2) fwd_kernel(Args args) {
    extern __shared__ __attribute__((aligned(16))) unsigned char lds_raw[];
    LAS unsigned char* lds = (LAS unsigned char*)lds_raw;
    volatile LAS unsigned* MISC = (volatile LAS unsigned*)(lds + LDS_MISC);
    const int tid = threadIdx.x, lane = tid & 63, wave = __builtin_amdgcn_readfirstlane(tid >> 6);
    const int G = gridDim.x, wg = blockIdx.x;
    unsigned char* ws = args.ws;
    unsigned* ctl = (unsigned*)(ws + WS_CTL);
    const int lo = args.ph_lo, hi = args.ph_hi;
    const float* x = (const float*)args.in[0]; const float* cvec = (const float*)args.in[1]; const int* positions = (const int*)args.in[2];
    const float* w_ada = (const float*)args.in[3]; const float* b_ada = (const float*)args.in[4]; const float* norm1_g = (const float*)args.in[5];
    const float* w_in = (const float*)args.in[6]; const float* idx_knorm_g = (const float*)args.in[7]; const float* idx_knorm_b = (const float*)args.in[8];
    const float* lb_logits = (const float*)args.in[9]; const float* hgrn_norm_g = (const float*)args.in[10];
    const float* w_proj_att = (const float*)args.in[11]; const float* w_proj_hgrn = (const float*)args.in[12]; const float* w_out = (const float*)args.in[13];
    const float* norm2_g = (const float*)args.in[14]; const float* w_router = (const float*)args.in[15]; const float* b_router = (const float*)args.in[16];
    const float* w1 = (const float*)args.in[17]; const float* b1 = (const float*)args.in[18]; const float* w2 = (const float*)args.in[19]; const float* b2 = (const float*)args.in[20];
    const float* final_g = (const float*)args.in[21];
    float* out = args.out;
    float* MOD = (float*)(ws + WS_MOD); int* TOPE = (int*)(ws + WS_TOPE); float* GATE = (float*)(ws + WS_GATE); int* SLOT = (int*)(ws + WS_SLOT);
    bf16_t* WIN_T = (bf16_t*)(ws + WS_WIN_T); bf16_t* WA_T = (bf16_t*)(ws + WS_WA_T); bf16_t* WH_T = (bf16_t*)(ws + WS_WH_T); bf16_t* WO_T = (bf16_t*)(ws + WS_WO_T);
    unsigned char* WIN_T8 = ws + WS_WIN_T + 8 * MiB;
    unsigned char* HA8 = ws + WS_SCORES;
    unsigned char* W1_T = ws + WS_W1_T; unsigned char* W2_T = ws + WS_W2_T;
    bf16_t* HB = (bf16_t*)(ws + WS_H); bf16_t* PROJ = (bf16_t*)(ws + WS_PROJ);
    bf16_t* DELTA = (bf16_t*)(ws + WS_ATT);
    unsigned char* ACT = ws + WS_ACT; bf16_t* YB = (bf16_t*)(ws + WS_YB);
    int* TOKS = (int*)(ws + WS_TOKS);
    unsigned char* H8 = ws + WS_H;
    bf16_t* KI = (bf16_t*)(ws + WS_KI); unsigned char* KC = ws + WS_KC; unsigned char* VC = ws + WS_VC;
    float* ST = (float*)(ws + WS_ST); float* DC = (float*)(ws + WS_DC);
    unsigned char* ATT = ws + WS_ATT; unsigned char* REC = ATT + (size_t)S * 1024;        bf16_t* MERGED = (bf16_t*)(ws + WS_MERGED); unsigned short* SCORES = (unsigned short*)(ws + WS_SCORES);
    unsigned short* SEGMAX = (unsigned short*)(ws + WS_X1);

    for (int u = tid; u < 128; u += NTHR) MISC[u] = 0u;
    __syncthreads();
    const bool one_launch = (hi - lo) > 1;
    XcdBarrier bar; bar.bar = ctl + CW_BAR; bar.x = 0; bar.st = MISC + 8;
    if (one_launch) bar = xcd_barrier_post(ctl + CW_BAR, MISC + 8);
#define IN(k) (lo <= (k) && (k) < hi)
#define SEAM(k) do { if (IN(k) && IN((k) + 1)) xcd_barrier(bar); } while (0)


    if (IN(PH_PRO)) {
        for (int cb = wg; cb < 256; cb += G) {
            LAS float* red = (LAS float*)lds;
            const int c4 = tid % 12, kg = tid / 12;
            f32x4 acc = (f32x4){0.f, 0.f, 0.f, 0.f};
            if (kg < 42) {
                const float* wp = w_ada + (size_t)cb * 48 + 4 * c4;
#pragma unroll 7
                for (int j = 0; j < 49; ++j) { const int k = kg + 42 * j; if (k < D) { const f32x4 v = __builtin_nontemporal_load((const f32x4*)(wp + (size_t)k * (6 * D))); acc += siluf_(cvec[k]) * v; } }
                *(LAS f32x4*)(red + kg * 48 + 4 * c4) = acc;
            }
            __syncthreads();
            if (tid < 48) { float s = b_ada[cb * 48 + tid];
#pragma unroll 6
                for (int q = 0; q < 42; ++q) s += red[q * 48 + tid];
                MOD[cb * 48 + tid] = s; }
            __syncthreads();
        }
        LAS unsigned char* scr = lds + wave * 17408;
        const int gw = wg * NWAVES + wave, NGW = G * NWAVES;
        {
            constexpr int NB_IN = (1104 + 63) / 64;
            for (int it = gw; it < 16 * NB_IN; it += NGW) convert_item(w_in + 1536, 2048, 1104, DIN, WIN_T, 0, it, lane, scr);
            for (int it = gw; it < 4 * 32; it += NGW) convert_item8(w_proj_att, 1024, 2048, 2048, (unsigned char*)WA_T, 0, it, lane, scr);
            for (int it = gw; it < 4 * 32; it += NGW) convert_item8(w_proj_hgrn, 1024, 2048, 2048, (unsigned char*)WA_T + (size_t)2048 * 1024, 0, it, lane, scr);
            for (int it = gw; it < 8 * 32; it += NGW) convert_item8(w_out, 2048, 2048, 2048, (unsigned char*)WO_T, 0, it, lane, scr);
            for (int it = gw; it < 8 * 24; it += NGW) convert_item8(w_in, 2048, 1536, DIN, WIN_T8, 0, it, lane, scr);
            for (int it = gw; it < 8 * 128; it += NGW) convert_item8(w_in + 2640, 2048, 8192, DIN, WIN_T8 + (size_t)1536 * 2048, 0, it, lane, scr);
            for (size_t i = (size_t)wg * NTHR + tid; i < (size_t)176 * 2048 * 2 / 16; i += (size_t)G * NTHR) ((u32x4*)(WIN_T + (size_t)1104 * 2048))[i] = (u32x4){0u, 0u, 0u, 0u};
        }
    }
    SEAM(PH_PRO);

    {
    if (IN(PH_H)) {
        const float* sh1 = MOD; const float* sc1 = MOD + D;
        const int gw = wg * NWAVES + wave, NGW = G * NWAVES;
        f32x4 gs[8], sh[8];
#pragma unroll
        for (int j = 0; j < 8; ++j) { const int c = 4 * lane + 256 * j; const f32x4 g = *(const f32x4*)(norm1_g + c), sc = *(const f32x4*)(sc1 + c); sh[j] = *(const f32x4*)(sh1 + c);
#pragma unroll
            for (int e = 0; e < 4; ++e) gs[j][e] = g[e] * (1.0f + sc[e]); }
        for (int t = gw; t < S; t += NGW) {
            const f32x4* xr = (const f32x4*)(x + (size_t)t * D) + lane;
            f32x4 v[8]; float ss = 0.f;
#pragma unroll
            for (int j = 0; j < 8; ++j) { v[j] = xr[64 * j]; ss += (v[j][0] * v[j][0] + v[j][1] * v[j][1]) + (v[j][2] * v[j][2] + v[j][3] * v[j][3]); }
            const float rstd = rsqrtf(wave_sum(ss) * (1.0f / D) + NORM_EPS);
#pragma unroll
            for (int j = 0; j < 8; ++j) { const f32x4 h = v[j] * rstd * gs[j] + sh[j]; u32x2 w; w.x = cvt_pk_bf16(h[0], h[1]); w.y = cvt_pk_bf16(h[2], h[3]);
                *(u32x2*)(HB + (size_t)t * D + 4 * lane + 256 * j) = w;
                *(unsigned*)(HA8 + (size_t)t * D + 4 * lane + 256 * j) = pack4_fp8(h[0], h[1], h[2], h[3]); }
        }
    }
    SEAM(PH_H);
    if (IN(PH_INPROJ)) {
        const int XC = (G == 256) ? XCONV : 0;
        const Conv8Job j1{w1, W1_T, 4096, 2, (size_t)2048 * 4096, (size_t)4096 * 2048, 8 * 16};
        const Conv8Job j2{w2, W2_T, 2048, 0, (size_t)2048 * 2048, (size_t)2048 * 2048, 8 * 8};
        if (G != 256) { conv8_run(lds, j1, NEXP * 8 * 16, wg, G, tid, wave, lane); conv8_run(lds, j2, NEXP * 8 * 8, wg, G, tid, wave, lane); }
        if (wg < XC) { conv8_run(lds, j1, NEXP * 8 * 16, wg, XC, tid, wave, lane); conv8_run(lds, j2, NEXP * 8 * 8, wg, XC, tid, wave, lane); }
        else {
            const int Gg = G - XC, cg = wg - XC;
            {
                pg8::Gemm g8{HA8, WIN_T8, 2048, 0, nullptr, 0}; pg8::StaticOrder S8; S8.init(S, 9728, Gg, cg);
                const int full8 = 2432 / Gg, rem8 = 2432 - full8 * Gg;
                if (Gg == 256) S8.skew(8, (wg >= 128 && wg < 192) ? -1 : (wg < 128 ? wg : wg - 64), 192);
                else if (rem8 > 0) S8.skew(full8, cg < rem8 ? cg : -1, rem8);
                pg8::EpiBf16 E8{PROJ, DINP, nullptr, 0, 1.0f / W8_SCALE, 6, 1280};
                pg8::gemm_phase<pg8::EpiBf16, pg8::StaticOrder, true>(lds, g8, S8, E8);
            }
            {
                pg8::Gemm g{HB, WIN_T, 2048, 0, nullptr, 0}; pg8::StaticOrder So; So.init(S, 1280, Gg, Gg == 256 ? (wg + 128) % G : (cg + Gg - (2432 % Gg)) % Gg);
                pg8::EpiBf16 E{PROJ + CQI, DINP, nullptr, 0, 1.0f, 1 << 30, 0};
                pg8::gemm_phase<pg8::EpiBf16, pg8::StaticOrder>(lds, g, So, E);
            }
        }
    }
    SEAM(PH_INPROJ);
    if (IN(PH_POST)) {
        const int gw = wg * NWAVES + wave, NGW = G * NWAVES;
        for (int t = gw; t < S; t += NGW) post_token(PROJ, KI, KC, VC, positions, idx_knorm_g, idx_knorm_b, t, lane);
        __syncthreads();
        for (int u = wg; u < 2048; u += G) hgrn_l1(lds, PROJ, lb_logits, ST, DC, u >> 3, u & 7, tid, wave, lane);
    }
    SEAM(PH_POST);
    if (IN(PH_SCORE)) {
        for (int idx = wg * NTHR + tid; idx < 8 * 128 * 128; idx += G * NTHR) {
            const int h = idx >> 14, d = idx & 127; float s = 0.f;
            float* sp = ST + idx; const float* dp = DC + h * 128 + d;
            for (int c = 0; c < 256; c += 8) {
                float l[8], dc[8];
#pragma unroll
                for (int i = 0; i < 8; ++i) { l[i] = sp[(size_t)(c + i) * 131072]; dc[i] = dp[(size_t)(c + i) * 1024]; }
#pragma unroll
                for (int i = 0; i < 8; ++i) { sp[(size_t)(c + i) * 131072] = s; s = dc[i] * s + l[i]; }
            }
        }
        {
            const int XS = (G == 256) ? XSCORE : 0;
            if (wg < XS) {
                const Conv8Job j1{w1, W1_T, 4096, 2, (size_t)2048 * 4096, (size_t)4096 * 2048, 8 * 16};
                const Conv8Job j2{w2, W2_T, 2048, 0, (size_t)2048 * 2048, (size_t)2048 * 2048, 8 * 8};
                __syncthreads();
                conv8_run(lds, j1, NEXP * 8 * 16, wg, XS, tid, wave, lane); conv8_run(lds, j2, NEXP * 8 * 8, wg, XS, tid, wave, lane);
            }
            for (;;) {
                if (tid == 0) MISC[100] = __hip_atomic_fetch_add(ctl + CW_SCQ, 1u, __ATOMIC_RELAXED, __HIP_MEMORY_SCOPE_AGENT);
                __syncthreads();
                const int item = (int)MISC[100];
                __syncthreads();
                if (item >= 252 * SCP) break;
                const int j = item / SCP, p = item - j * SCP, qa = 8 + j, qb2 = 511 - j, na = (qa >> 2) + 1, nb = (qb2 >> 2) + 1, T = na + nb;
                const int lo = p * T / SCP, hi = (p + 1) * T / SCP;
                const int a0 = lo < na ? lo : na, a1 = hi < na ? hi : na, b0 = (lo > na ? lo : na) - na, b1 = (hi > na ? hi : na) - na;
                if (a1 > a0) score_block(lds, PROJ, KI, SCORES, SEGMAX, qa, a0, a1, tid, wave, lane);
                if (b1 > b0) score_block(lds, PROJ, KI, SCORES, SEGMAX, qb2, b0, b1, tid, wave, lane);
            }
        }
    }
    SEAM(PH_SCORE);
    if (IN(PH_ATTN)) {
        const int gw = wg * NWAVES + wave, NGW = G * NWAVES;
        for (int u = wg; u < 2048; u += G) hgrn_l3(lds, PROJ, lb_logits, ST, hgrn_norm_g, REC, u >> 3, u & 7, tid, wave, lane);
        {
            for (;;) {
                unsigned tq = 0; if (lane == 0) tq = __hip_atomic_fetch_add(ctl + CW_ATQ, 1u, __ATOMIC_RELAXED, __HIP_MEMORY_SCOPE_AGENT);
                tq = (unsigned)__builtin_amdgcn_readfirstlane((int)tq);
                if (tq >= (unsigned)S) break;
                const int t = S - 1 - (int)tq;
                LAS unsigned char* wl = lds + wave * 17664;
                if (t >= 256) select_row(wl, SCORES, SEGMAX, t, lane);
                else {
#pragma unroll
                    for (int i = 0; i < 4; ++i) { const int idx = lane + 64 * i; ((LAS int*)wl)[idx] = idx <= t ? idx : 0; }
                }
                attn_query(wl, PROJ, KC, VC, ATT, t, lane);
            }
        }
    }
    SEAM(PH_ATTN);
    if (IN(PH_OP1)) {
        pg8::Gemm g{ATT, WA_T, 1024, (size_t)2048 * 1024, nullptr, (size_t)S * 1024};
        pg8::TwoPartOrder So; So.init(S, 2048, G, wg);
        pg8::EpiGate2 E{(unsigned char*)MERGED, PROJ + CGA, PROJ + CGR};
        pg8::gemm_phase<pg8::EpiGate2, pg8::TwoPartOrder, true>(lds, g, So, E);
    }
    SEAM(PH_OP2);
    if (IN(PH_WOUT)) {
        pg8::Gemm g{MERGED, WO_T, 2048, 0, nullptr, 0}; pg8::StaticOrder So; So.init(S, 2048, G, wg);
        pg8::EpiDelta E{MOD + 2 * D, DELTA, 1.0f / (W8_SCALE * MRG8_SCALE)};
        pg8::gemm_phase<pg8::EpiDelta, pg8::StaticOrder, true>(lds, g, So, E);
    }
    SEAM(PH_WOUT);
    }

    if (IN(PH_ROUTER)) {
        LAS float* hs = (LAS float*)lds;
        volatile LAS unsigned* lcnt = MISC + 32;
        const float* sh2 = MOD + 3 * D; const float* sc2 = MOD + 4 * D;
        if (tid < 32) lcnt[tid] = 0u;
        __syncthreads();
        for (int grp = wg; grp < S / 16; grp += G) {
#pragma unroll 1
            for (int q = 0; q < 2; ++q) {
                const int tl = 2 * wave + q, t = grp * 16 + tl;
                const f32x4* xr = (const f32x4*)(x + (size_t)t * D) + lane; const u32x2* dr = (const u32x2*)(DELTA + (size_t)t * D) + lane;
                f32x4 v[8]; float ss = 0.f;
#pragma unroll
                for (int j = 0; j < 8; ++j) { const u32x2 dw = dr[64 * j]; v[j] = xr[64 * j] + (f32x4){bf_lo(dw.x), bf_hi(dw.x), bf_lo(dw.y), bf_hi(dw.y)};
                    ss += (v[j][0] * v[j][0] + v[j][1] * v[j][1]) + (v[j][2] * v[j][2] + v[j][3] * v[j][3]); }
                const float rstd = rsqrtf(wave_sum(ss) * (1.0f / D) + NORM_EPS);
#pragma unroll
                for (int j = 0; j < 8; ++j) {
                    const int c = 4 * lane + 256 * j;
                    const f32x4 g = *(const f32x4*)(norm2_g + c), sc = *(const f32x4*)(sc2 + c), sh = *(const f32x4*)(sh2 + c);
                    f32x4 h;
#pragma unroll
                    for (int e = 0; e < 4; ++e) h[e] = v[j][e] * rstd * g[e] * (1.0f + sc[e]) + sh[e];
                    *(LAS f32x4*)(hs + tl * 2048 + c) = h;
                    *(unsigned*)(H8 + (size_t)t * D + c) = pack4_fp8(h[0], h[1], h[2], h[3]);
                }
            }
            __syncthreads();
            {
                LAS float* part = (LAS float*)(lds + 131072);
                const int fr = lane & 15, fq = lane >> 4;
                f32x4 acc0 = (f32x4){0.f, 0.f, 0.f, 0.f}, acc1 = acc0;
                const LAS float* hrow = hs + fr * 2048 + wave * 256 + 4 * fq; const float* wrp = w_router + (size_t)(wave * 256 + 4 * fq) * 32 + fr;
#pragma unroll 2
                for (int i = 0; i < 16; ++i) {
                    const f32x4 a4 = *(const LAS f32x4*)(hrow + 16 * i);
                    float b0[4], b1[4];
#pragma unroll
                    for (int s = 0; s < 4; ++s) { b0[s] = wrp[(size_t)(16 * i + s) * 32]; b1[s] = wrp[(size_t)(16 * i + s) * 32 + 16]; }
#pragma unroll
                    for (int s = 0; s < 4; ++s) { acc0 = __builtin_amdgcn_mfma_f32_16x16x4f32(a4[s], b0[s], acc0, 0, 0, 0); acc1 = __builtin_amdgcn_mfma_f32_16x16x4f32(a4[s], b1[s], acc1, 0, 0, 0); }
                }
#pragma unroll
                for (int r = 0; r < 4; ++r) { part[(wave * 16 + 4 * fq + r) * 32 + fr] = acc0[r]; part[(wave * 16 + 4 * fq + r) * 32 + 16 + fr] = acc1[r]; }
                __syncthreads();
                const int tl = tid >> 5, e = tid & 31, t = grp * 16 + tl;
                float v = b_router[e];
#pragma unroll
                for (int w = 0; w < 8; ++w) v += part[(w * 16 + tl) * 32 + e];
                float tv[4]; int ti[4];
#pragma unroll
                for (int k = 0; k < 4; ++k) {
                    float bv = v; int bi = e;
#pragma unroll
                    for (int o = 16; o >= 1; o >>= 1) { const float ov = __shfl_xor(bv, o); const int oi = __shfl_xor(bi, o); if (ov > bv || (ov == bv && oi < bi)) { bv = ov; bi = oi; } }
                    tv[k] = bv; ti[k] = bi; if (e == bi) v = -__builtin_inff();
                }
                if (e == 0) {
                    const float e1 = __expf(tv[1] - tv[0]), e2 = __expf(tv[2] - tv[0]), e3 = __expf(tv[3] - tv[0]); const float inv = 1.0f / (1.0f + e1 + e2 + e3);
                    *(int4*)(TOPE + (size_t)t * 4) = make_int4(ti[0], ti[1], ti[2], ti[3]);
                    *(f32x4*)(GATE + (size_t)t * 4) = (f32x4){inv, e1 * inv, e2 * inv, e3 * inv};
#pragma unroll
                    for (int k = 0; k < 4; ++k) __hip_atomic_fetch_add((LAS unsigned*)&lcnt[ti[k]], 1u, __ATOMIC_RELAXED, __HIP_MEMORY_SCOPE_WORKGROUP);
                }
            }
            __syncthreads();
        }
        if (tid < 32) { const unsigned c = lcnt[tid]; if (c) __hip_atomic_fetch_add(ctl + CW_CNT + tid, c, __ATOMIC_RELAXED, __HIP_MEMORY_SCOPE_AGENT); }
    }
    SEAM(PH_ROUTER);

    if (IN(PH_SCATTER)) {
        volatile LAS unsigned* lcnt = MISC + 32; volatile LAS unsigned* lbase = MISC + 64; LAS int* pstart = (LAS int*)(lds + 1024); LAS int* pcnt = (LAS int*)(lds + 1280);
        if (tid == 0) { int p = 0; for (int e = 0; e < NEXP; ++e) { const int c = (int)__hip_atomic_load(ctl + CW_CNT + e, __ATOMIC_RELAXED, __HIP_MEMORY_SCOPE_AGENT); pstart[e] = p; pcnt[e] = c; p += (c + 255) & ~255; } }
        if (tid < 32) lcnt[tid] = 0u;
        __syncthreads();
        if (wg < NEXP) { const int e = wg; for (int s = pstart[e] + pcnt[e] + tid; s < pstart[e] + ((pcnt[e] + 255) & ~255); s += NTHR) TOKS[s] = 0; }
        for (int blk = wg; blk < S / 64; blk += G) {
            int e = 0, lrank = 0;
            if (tid < 256) { e = TOPE[(size_t)blk * 256 + tid]; lrank = (int)__hip_atomic_fetch_add((LAS unsigned*)&lcnt[e], 1u, __ATOMIC_RELAXED, __HIP_MEMORY_SCOPE_WORKGROUP); }
            __syncthreads();
            if (tid < 32) { const unsigned c = lcnt[tid]; lbase[tid] = c ? __hip_atomic_fetch_add(ctl + CW_FILL + tid, c, __ATOMIC_RELAXED, __HIP_MEMORY_SCOPE_AGENT) : 0u; }
            __syncthreads();
            if (tid < 256) { const int slot = pstart[e] + (int)lbase[e] + lrank; SLOT[(size_t)blk * 256 + tid] = slot; TOKS[slot] = blk * 64 + (tid >> 2); }
            __syncthreads();
            if (tid < 32) lcnt[tid] = 0u;
            __syncthreads();
        }
    }
    SEAM(PH_SCATTER);

    if (IN(PH_MOE1) || IN(PH_MOE2)) {
        LAS int* panel_e = (LAS int*)(lds + 131072 + 2048);
        LAS int* npan = (LAS int*)(lds + 131072 + 2048 + 2048);
        __syncthreads();
        if (tid == 0) { int p = 0; for (int e = 0; e < NEXP; ++e) { const int np = (int)((__hip_atomic_load(ctl + CW_CNT + e, __ATOMIC_RELAXED, __HIP_MEMORY_SCOPE_AGENT) + 255u) >> 8); for (int q = 0; q < np; ++q) panel_e[p + q] = e; p += np; } npan[0] = p; }
        __syncthreads();
        const int nPanels = npan[0];
        if (IN(PH_MOE1)) {
            pg8::Gemm g{H8, W1_T, 2048, (size_t)4096 * 2048, TOKS, 0}; pg8::MoeOrder So; So.init(nPanels, 16, G, wg, panel_e);
            pg8::EpiSwiglu E{ACT, b1};
            pg8::gemm_phase<pg8::EpiSwiglu, pg8::MoeOrder, true>(lds, g, So, E);
        }
        SEAM(PH_MOE1);
        if (IN(PH_MOE2)) {
            pg8::Gemm g{ACT, W2_T, 2048, (size_t)2048 * 2048, nullptr, 0}; pg8::MoeOrder So; So.init(nPanels, 8, G, wg, panel_e);
            pg8::EpiBf16 E{YB, 2048, b2, 2048, 1.0f / (W8_SCALE * ACT8_SCALE), 1 << 30, 0};
            pg8::gemm_phase<pg8::EpiBf16, pg8::MoeOrder, true>(lds, g, So, E);
        }
    }
    SEAM(PH_MOE2);

    if (IN(PH_FINAL)) {
        const float* gt2 = MOD + 5 * D;
        const int gw = wg * NWAVES + wave, NGW = G * NWAVES;
        for (int t = gw; t < S; t += NGW) {
            const f32x4* xr = (const f32x4*)(x + (size_t)t * D) + lane; const u32x2* dr = (const u32x2*)(DELTA + (size_t)t * D) + lane;
            f32x4 v[8];
#pragma unroll
            for (int j = 0; j < 8; ++j) { const u32x2 dw = dr[64 * j]; v[j] = xr[64 * j] + (f32x4){bf_lo(dw.x), bf_hi(dw.x), bf_lo(dw.y), bf_hi(dw.y)}; }
            {
                f32x4 m[8];
#pragma unroll
                for (int j = 0; j < 8; ++j) m[j] = (f32x4){0.f, 0.f, 0.f, 0.f};
                const int4 sl = *(const int4*)(SLOT + (size_t)t * 4); const f32x4 gt = *(const f32x4*)(GATE + (size_t)t * 4);
                const int sls[4] = {sl.x, sl.y, sl.z, sl.w};
#pragma unroll
                for (int k = 0; k < 4; ++k) {
                    const u32x2* yr = (const u32x2*)(YB + (size_t)sls[k] * D) + lane; const float gk = gt[k];
#pragma unroll
                    for (int j = 0; j < 8; ++j) { const u32x2 w = yr[64 * j]; m[j][0] += gk * bf_lo(w.x); m[j][1] += gk * bf_hi(w.x); m[j][2] += gk * bf_lo(w.y); m[j][3] += gk * bf_hi(w.y); }
                }
#pragma unroll
                for (int j = 0; j < 8; ++j) { const f32x4 g2 = *(const f32x4*)(gt2 + 4 * lane + 256 * j); v[j] = v[j] + g2 * m[j]; }
            }
            float ss = 0.f;
#pragma unroll
            for (int j = 0; j < 8; ++j) ss += (v[j][0] * v[j][0] + v[j][1] * v[j][1]) + (v[j][2] * v[j][2] + v[j][3] * v[j][3]);
            const float rstd = rsqrtf(wave_sum(ss) * (1.0f / D) + NORM_EPS);
            f32x4* orow = (f32x4*)(out + (size_t)t * D) + lane;
#pragma unroll
            for (int j = 0; j < 8; ++j) { const f32x4 fg = *(const f32x4*)(final_g + 4 * lane + 256 * j); orow[64 * j] = v[j] * rstd * fg; }
        }
    }
#undef IN
#undef SEAM
}

#ifndef MK_ONE_LAUNCH
#define MK_ONE_LAUNCH 1
#endif
extern "C" void kernel_launch(void* const* d_in, const int* in_sizes, int n_in, void* d_out, int out_size, void* d_ws, size_t ws_size, hipStream_t stream) {
    static int grid = 0;
    if (grid == 0) {
        if (n_in != 22 || out_size != S * D || ws_size < WS_END) { fprintf(stderr, "kernel_launch: unexpected shapes: n_in %d out %d ws %zu (need %zu)\n", n_in, out_size, ws_size, (size_t)WS_END); grid = -1; return; }
        int dev = 0, cus = 0, per_cu = 0;
        if (hipGetDevice(&dev) != hipSuccess || hipDeviceGetAttribute(&cus, hipDeviceAttributeMultiprocessorCount, dev) != hipSuccess) { grid = -1; return; }
        if (hipFuncSetAttribute((const void*)fwd_kernel, hipFuncAttributeMaxDynamicSharedMemorySize, LDS_BYTES) != hipSuccess) { fprintf(stderr, "kernel_launch: hipFuncSetAttribute failed\n"); grid = -1; return; }
        if (hipOccupancyMaxActiveBlocksPerMultiprocessor(&per_cu, (const void*)fwd_kernel, NTHR, LDS_BYTES) != hipSuccess || per_cu < 1) { fprintf(stderr, "kernel_launch: occupancy query says %d\n", per_cu); (void)hipGetLastError(); grid = -1; return; }
        grid = cus;
    }
    if (grid < 0) return;
    (void)in_sizes;
    hipMemsetAsync((char*)d_ws + WS_CTL, 0, CTL_BYTES, stream);
    Args a{};
    for (int i = 0; i < 22; ++i) a.in[i] = d_in[i];
    a.out = (float*)d_out; a.ws = (unsigned char*)d_ws; a.flags = 0; a.pad = 0;
#if MK_ONE_LAUNCH
    a.ph_lo = 0; a.ph_hi = NPH;
    hipLaunchKernelGGL(fwd_kernel, dim3(grid), dim3(NTHR), LDS_BYTES, stream, a);
#else
    for (int p = 0; p < NPH; ++p) { a.ph_lo = p; a.ph_hi = p + 1; hipLaunchKernelGGL(fwd_kernel, dim3(grid), dim3(NTHR), LDS_BYTES, stream, a); }
#endif
}
```

```cpp
#include <hip/hip_runtime.h>
#include <cstdio>
#include <cstdint>

#define GAS __attribute__((address_space(1)))
#define LAS __attribute__((address_space(3)))
typedef unsigned short bf16_t;
typedef short bf16x8 __attribute__((ext_vector_type(8)));
typedef float f32x4 __attribute__((ext_vector_type(4)));
typedef float f32x2 __attribute__((ext_vector_type(2)));
typedef float f32x16 __attribute__((ext_vector_type(16)));
typedef unsigned u32x4 __attribute__((ext_vector_type(4)));
typedef unsigned u32x2 __attribute__((ext_vector_type(2)));
typedef int i32x4 __attribute__((ext_vector_type(4)));
typedef int i32x8 __attribute__((ext_vector_type(8)));
typedef short s16x4 __attribute__((ext_vector_type(4)));
typedef short s16x2 __attribute__((ext_vector_type(2)));

constexpr int S = 16384, D = 2048, DIN = 10832, DINP = 11008, NEXP = 32, DFF = 2048;
constexpr int NWAVES = 8, NTHR = 512;
constexpr int CQ = 0, CK = 1024, CV = 1280, CQI = 1536, CKI = 2560, CWI = 2624, CHQ = 2816, CHF = 3840, CHI = 4864, CHG = 5888, CGA = 6912, CGR = 8960;
constexpr int PMAX = 65536 + NEXP * 256;
constexpr float NORM_EPS = 1e-5f;

constexpr size_t MiB = 1u << 20;
constexpr size_t al256(size_t x) { return (x + 255) & ~(size_t)255; }
constexpr size_t WS_CTL = 0, CTL_BYTES = 1 * MiB;
constexpr size_t WS_MOD = WS_CTL + CTL_BYTES;
constexpr size_t WS_TOPE = WS_MOD + 64 * 1024;
constexpr size_t WS_GATE = WS_TOPE + (size_t)S * 16;
constexpr size_t WS_SLOT = WS_GATE + (size_t)S * 16;
constexpr size_t WS_WIN_T = WS_SLOT + (size_t)S * 16;
constexpr size_t WS_WA_T = WS_WIN_T + (size_t)DINP * D * 2;
constexpr size_t WS_WH_T = WS_WA_T + (size_t)2048 * 1024 * 2;
constexpr size_t WS_WO_T = WS_WH_T + (size_t)2048 * 1024 * 2;
constexpr size_t WS_W1_T = WS_WO_T + (size_t)2048 * 2048 * 2;
constexpr size_t WS_W2_T = WS_W1_T + (size_t)NEXP * 4096 * 2048 * 2;
constexpr size_t WS_H = WS_W2_T + (size_t)NEXP * 2048 * 2048 * 2;
constexpr size_t WS_PROJ = WS_H + (size_t)S * D * 2;
constexpr size_t WS_KI = WS_PROJ + (size_t)S * DINP * 2;
constexpr size_t WS_KC = WS_KI + (size_t)S * 64 * 2;
constexpr size_t WS_VC = WS_KC + (size_t)S * 256 * 2;
constexpr size_t WS_ST = WS_VC + (size_t)S * 256 * 2;
constexpr size_t WS_DC = WS_ST + (size_t)256 * 8 * 128 * 128 * 4;
constexpr size_t WS_SEL = WS_DC + (size_t)256 * 8 * 128 * 4;
constexpr size_t WS_ATT = WS_SEL + (size_t)S * 256 * 4;
constexpr size_t WS_REC = WS_ATT + (size_t)S * 1024 * 2;
constexpr size_t WS_MERGED = WS_REC + (size_t)S * 1024 * 2;
constexpr size_t WS_X1 = WS_MERGED + (size_t)S * 2048 * 2;
constexpr size_t WS_SCORES = WS_X1 + (size_t)S * 2048 * 4;
constexpr size_t WS_XB = WS_SCORES;
constexpr size_t WS_ACT = WS_XB + (size_t)PMAX * 2048 * 2;
constexpr size_t WS_YB = WS_ACT + (size_t)PMAX * 2048 * 2;
constexpr size_t WS_END = WS_SCORES + (size_t)S * S * 4;
static_assert(WS_YB + (size_t)PMAX * 2048 * 2 <= WS_END, "MoE buffers overlay the score matrix");
static_assert(WS_END <= (size_t)4096 * MiB, "workspace");
constexpr int CW_BAR = 4096, CW_CNT = 8192, CW_FILL = 8448;
constexpr size_t WS_TOKS = WS_SEL;

constexpr int LDS_BYTES = 155648;
constexpr int LDS_MISC = LDS_BYTES - 512;

__device__ __forceinline__ unsigned cvt_pk_bf16(float lo, float hi) { unsigned r; asm volatile("v_cvt_pk_bf16_f32 %0, %1, %2" : "=v"(r) : "v"(lo), "v"(hi)); return r; }
__device__ __forceinline__ float bf_lo(unsigned u) { return __uint_as_float(u << 16); }
__device__ __forceinline__ float bf_hi(unsigned u) { return __uint_as_float(u & 0xffff0000u); }
__device__ __forceinline__ float bf2f(bf16_t b) { return __uint_as_float(((unsigned)b) << 16); }
__device__ __forceinline__ float wave_sum(float v) {
#define DPPS(ctrl, rmask) { const int s_ = __builtin_amdgcn_update_dpp(0, __float_as_int(v), ctrl, rmask, 0xF, false); v += __int_as_float(s_); }
    DPPS(0x111, 0xF) DPPS(0x112, 0xF) DPPS(0x114, 0xF) DPPS(0x118, 0xF) DPPS(0x142, 0xA) DPPS(0x143, 0xC)
#undef DPPS
    return __int_as_float(__builtin_amdgcn_readlane(__float_as_int(v), 63));
}
__device__ __forceinline__ float wave_max(float v) {
#define DPPM(ctrl, rmask) { const int o_ = __float_as_int(v); const int s_ = __builtin_amdgcn_update_dpp(o_, o_, ctrl, rmask, 0xF, false); v = fmaxf(v, __int_as_float(s_)); }
    DPPM(0x111, 0xF) DPPM(0x112, 0xF) DPPM(0x114, 0xF) DPPM(0x118, 0xF) DPPM(0x142, 0xA) DPPM(0x143, 0xC)
#undef DPPM
    return __int_as_float(__builtin_amdgcn_readlane(__float_as_int(v), 63));
}
__device__ __forceinline__ float sigmoidf_(float x) { return __builtin_amdgcn_rcpf(1.0f + __expf(-x)); }
__device__ __forceinline__ float siluf_(float x) { return x * __builtin_amdgcn_rcpf(1.0f + __expf(-x)); }
__device__ __forceinline__ unsigned pack4_fp8(float a, float b, float c, float d) { int w = 0; w = __builtin_amdgcn_cvt_pk_fp8_f32(a, b, w, false); w = __builtin_amdgcn_cvt_pk_fp8_f32(c, d, w, true); return (unsigned)w; }
constexpr float W8_SCALE = 64.0f, ACT8_SCALE = 4.0f, MRG8_SCALE = 8.0f, OP8_SCALE = 16.0f;
__device__ __forceinline__ float relu_i(float x) { const int i = __float_as_int(x); return __int_as_float(i > 0 ? i : 0); }
__device__ __forceinline__ void fp8x16_to_bf16(const u32x4& w, u32x4& lo, u32x4& hi) {
    unsigned o[8];
#pragma unroll
    for (int q = 0; q < 4; ++q) { const unsigned wq = w[q]; const f32x2 a = __builtin_amdgcn_cvt_pk_f32_fp8((int)wq, false), b = __builtin_amdgcn_cvt_pk_f32_fp8((int)wq, true);
        o[2 * q] = cvt_pk_bf16(a[0], a[1]); o[2 * q + 1] = cvt_pk_bf16(b[0], b[1]); }
    lo = (u32x4){o[0], o[1], o[2], o[3]}; hi = (u32x4){o[4], o[5], o[6], o[7]};
}
__device__ __forceinline__ unsigned char fp8_1(float x) { return (unsigned char)(__builtin_amdgcn_cvt_pk_fp8_f32(x, x, 0, false) & 0xff); }
#define LDS_WAIT() asm volatile("s_waitcnt lgkmcnt(0)" ::: "memory")
#define VM_WAIT() asm volatile("s_waitcnt vmcnt(0)" ::: "memory")

#define XB_TMO      128
#define XB_XCNT(j)  (256  + 64 * (j))
#define XB_XSUB(j)  (1280 + 64 * (j))
#define XB_XGEN(j)  (2304 + 64 * (j))
#define XB_TOP      3328
#define XB_TOPGEN   3392
#define XCD_BAR_WORDS 3456
#define XB_SPIN_CAP (1u << 22)

__device__ __forceinline__ unsigned xb_ld(unsigned* p)              { return __hip_atomic_load(p, __ATOMIC_RELAXED, __HIP_MEMORY_SCOPE_AGENT); }
__device__ __forceinline__ unsigned xb_add(unsigned* p, unsigned v) { return __hip_atomic_fetch_add(p, v, __ATOMIC_RELAXED, __HIP_MEMORY_SCOPE_AGENT); }
__device__ __forceinline__ unsigned xb_xcc_id() { return (unsigned)__builtin_amdgcn_s_getreg((3 << 11) | 20) & 0xFu; }
#define XB_SPIN(cond, bar) do { unsigned _sp = 0; while (cond) { __builtin_amdgcn_s_sleep(1); \
    if ((++_sp & 255u) == 0u) { if (xb_ld(&(bar)[XB_TMO])) break; if (_sp > XB_SPIN_CAP) { atomicAdd(&(bar)[XB_TMO], 1u); break; } } } } while (0)

struct XcdBarrier { unsigned* bar; unsigned x; volatile LAS unsigned* st; };

__device__ __forceinline__ XcdBarrier xcd_barrier_post(unsigned* bar, volatile LAS unsigned* st) {
    XcdBarrier b; b.bar = bar; b.x = xb_xcc_id(); b.st = st;
    if (threadIdx.x == 0) (void)xb_add(&bar[XB_XCNT(b.x)], 1u);
    return b;
}
__device__ __forceinline__ void xcd_barrier_complete(unsigned* bar, unsigned x, unsigned& nloc, unsigned& nx) {
    const unsigned G = gridDim.x * gridDim.y * gridDim.z;
    unsigned sum, cnt, mine, sp = 0u;
    for (;;) {
        sum = 0u; cnt = 0u; mine = 0u;
#pragma unroll
        for (unsigned j = 0; j < 16; ++j) { const unsigned c = xb_ld(&bar[XB_XCNT(j)]); sum += c; cnt += (c > 0u) ? 1u : 0u; mine = (j == x) ? c : mine; }
        if (sum == G) break;
        __builtin_amdgcn_s_sleep(1);
        if ((++sp & 255u) == 0u) { if (xb_ld(&bar[XB_TMO])) break; if (sp > XB_SPIN_CAP) { atomicAdd(&bar[XB_TMO], 1u); break; } }
    }
    nloc = mine > 0u ? mine : 1u; nx = cnt > 0u ? cnt : 1u;
}
__device__ __forceinline__ void xcd_barrier(const XcdBarrier& b) {
    asm volatile("s_waitcnt vmcnt(0)" ::: "memory");
    __syncthreads();
    if (threadIdx.x == 0) {
        unsigned* bar = b.bar;
        __builtin_amdgcn_s_waitcnt(0);
        unsigned nloc = b.st[0], nx = b.st[1];
        if (nloc == 0u) { xcd_barrier_complete(bar, b.x, nloc, nx); b.st[0] = nloc; b.st[1] = nx; }
        const unsigned old = xb_add(&bar[XB_XSUB(b.x)], 1u);
        const unsigned gen = old / nloc;
        if (old + 1u == (gen + 1u) * nloc) {
            __builtin_amdgcn_fence(__ATOMIC_RELEASE, "agent");
            asm volatile("s_waitcnt vmcnt(0)" ::: "memory");
            const unsigned og = xb_add(&bar[XB_TOP], 1u);
            const unsigned tg = og / nx;
            if (og + 1u == (tg + 1u) * nx) xb_add(&bar[XB_TOPGEN], 1u);
            else XB_SPIN(xb_ld(&bar[XB_TOPGEN]) == tg, bar);
            __builtin_amdgcn_fence(__ATOMIC_ACQUIRE, "agent");
            xb_add(&bar[XB_XGEN(b.x)], 1u);
            asm volatile("s_waitcnt vmcnt(0)" ::: "memory");
        } else {
            XB_SPIN(xb_ld(&bar[XB_XGEN(b.x)]) == gen, bar);
            __builtin_amdgcn_fence(__ATOMIC_ACQUIRE, "agent");
            asm volatile("s_waitcnt vmcnt(0)" ::: "memory");
        }
    }
    __syncthreads();
}

namespace pg8 {
constexpr int BM = 256, BK = 64, HALF = 128, HTB = HALF * BK * 2, STAGE_BYTES = 8 * HTB, NXCD = 8, WGM = 8;
__host__ __device__ __forceinline__ int lds_byte(int r, int c) { const int st = (r >> 4) * 2 + (c >> 5), rr = r & 15, cc = c & 31, ob = rr * 64 + cc * 2; return st * 1024 + (ob ^ (((ob >> 9) & 1) << 5)); }
__host__ __device__ __forceinline__ void stage_rc(int b, int& R, int& C) { const int st = b / 1024, sb = b % 1024, swz = sb ^ (((sb >> 9) & 1) << 5); R = (st >> 1) * 16 + swz / 64; C = (st & 1) * 32 + (swz % 64) / 2; }
__host__ __device__ __forceinline__ int perm32(int rho) { const int n = rho >> 4, i = rho & 15; return 8 * (i >> 2) + 4 * n + (i & 3); }

struct Unit { int pm, pn, e; };
struct Gemm { const void* A; const void* Bt; int K; size_t estride; const int* arow; size_t astride; };

struct StaticOrder {
    int nM, nN, nwg, G, c, i, full, erank, en;
    __device__ void init(int M, int N, int G_, int c_) { nM = M / BM; nN = N / BM; nwg = nM * nN; G = G_; c = c_; i = 0; full = 1 << 30; erank = -1; en = 1; }
    __device__ void skew(int full_, int erank_, int en_) { full = full_; erank = erank_; en = en_; }
    __device__ bool next(Unit& u) {
        long L;
        if (i < full) L = (long)i * G + c; else { if (erank < 0) return false; L = (long)full * G + (long)(i - full) * en + erank; }
        ++i; if (L >= nwg) return false;
        int wgid = (int)L; { const int q = nwg / NXCD, r = nwg % NXCD, xcd = wgid % NXCD, off = wgid / NXCD; wgid = (xcd < r ? xcd * (q + 1) : r * (q + 1) + (xcd - r) * q) + off; }
        const int nig = WGM * nN, gid = wgid / nig, fm = gid * WGM, gsz = (nM - fm) < WGM ? (nM - fm) : WGM;
        u.pm = fm + ((wgid % nig) % gsz); u.pn = (wgid % nig) / gsz; u.e = 0; return true;
    }
};
struct MoeOrder {
    int nPanels, nN, G, c, i; const LAS int* panel_e;
    __device__ void init(int nPanels_, int nN_, int G_, int c_, const LAS int* pe) { nPanels = nPanels_; nN = nN_; G = G_; c = c_; i = 0; panel_e = pe; }
    __device__ bool next(Unit& u) {
        const int PB = 256 / nN;
        const int nblk = (nPanels + PB - 1) / PB;
        for (;;) {
            const long L = (long)i * G + c; ++i;
            const int blk = (int)(L >> 8), r = (int)(L & 255), x = r & 7, j = r >> 3;
            if (blk >= nblk) return false;
            int pm, pn;
            if (nN == 16) { pm = blk * 16 + 4 * (x >> 1) + (j & 3); pn = 8 * (x & 1) + (j >> 2); }
            else          { pm = blk * 32 + 4 * x + (j & 3);        pn = j >> 2; }
            if (pm < nPanels) { u.pm = pm; u.pn = pn; u.e = panel_e[pm]; return true; }
        }
    }
};

template <class Epi, class Sched, bool FP8 = false>
__device__ __forceinline__ void gemm_phase(LAS unsigned char* lds, const Gemm g, Sched& S, const Epi& E) {
    const int tid = threadIdx.x, wid = __builtin_amdgcn_readfirstlane(tid >> 6), lane = tid & 63, wr = wid >> 2, wc = wid & 3, fr = lane & 15, fq = lane >> 4;
    const int K = g.K; const int pitch = FP8 ? K : 2 * K; const int nt = pitch / 128;
    unsigned voffA[2], voffB[2];
#pragma unroll
    for (int i = 0; i < 2; ++i) { int R, C; stage_rc(tid * 16 + i * 8192, R, C); const int Rb = Epi::PERM ? ((R & ~31) + perm32(R & 31)) : R;
        voffA[i] = (unsigned)(R * pitch + C * 2); voffB[i] = (unsigned)(Rb * pitch + C * 2); }
    const size_t kstep = (size_t)(BK * 2);
    const size_t hstep = (size_t)HALF * pitch;
    const size_t tstep = 2 * hstep;
    int RA[2], CA[2];
#pragma unroll
    for (int i = 0; i < 2; ++i) stage_rc(tid * 16 + i * 8192, RA[i], CA[i]);
    const bool gather = g.arow != nullptr;
    const size_t hsA = gather ? 0 : hstep;
    unsigned vA0[2] = {voffA[0], voffA[1]}, vA1[2] = {voffA[0], voffA[1]}, nA0[2] = {voffA[0], voffA[1]}, nA1[2] = {voffA[0], voffA[1]};
#define PG8_AOFF(dst0, dst1, u) do { if (gather) { _Pragma("unroll") for (int i = 0; i < 2; ++i) { \
        dst0[i] = (unsigned)g.arow[(u).pm * 256 + RA[i]] * (unsigned)pitch + (unsigned)(CA[i] * 2); dst1[i] = (unsigned)g.arow[(u).pm * 256 + 128 + RA[i]] * (unsigned)pitch + (unsigned)(CA[i] * 2); } } } while (0)
    const unsigned ldsw = (unsigned)wid * 1024u;
    const int aoff = lds_byte(wr * 64 + fr, fq * 8), boff = lds_byte(wc * 32 + fr, fq * 8);
#define PG8_SA(b, h) (((b) * 2 + (h)) * HTB)
#define PG8_SB(b, h) ((4 + (b) * 2 + (h)) * HTB)
#define PG8_STAGE(bufoff, gbase, voff) do { _Pragma("unroll") for (int _i = 0; _i < 2; ++_i) \
        __builtin_amdgcn_global_load_lds((const unsigned*)((const char*)(gbase) + (voff)[_i]), (LAS unsigned*)(lds + (bufoff) + ldsw + _i * 8192), 16, 0, 0); } while (0)
#define PG8_LD8(p) __builtin_shufflevector(*(const LAS i32x4*)(p), *(const LAS i32x4*)((p) + 1024), 0, 1, 2, 3, 4, 5, 6, 7)
#define PG8_LDA(dst, b, h) do { _Pragma("unroll") for (int m = 0; m < 4; ++m) { if constexpr (FP8) dst##8[m] = PG8_LD8(lds + PG8_SA(b, h) + aoff + m * 2048); \
        else { _Pragma("unroll") for (int k = 0; k < 2; ++k) dst[m][k] = *(const LAS bf16x8*)(lds + PG8_SA(b, h) + aoff + m * 2048 + k * 1024); } } } while (0)
#define PG8_LDB(dst, b, h) do { _Pragma("unroll") for (int n = 0; n < 2; ++n) { if constexpr (FP8) dst##8[n] = PG8_LD8(lds + PG8_SB(b, h) + boff + n * 2048); \
        else { _Pragma("unroll") for (int k = 0; k < 2; ++k) dst[n][k] = *(const LAS bf16x8*)(lds + PG8_SB(b, h) + boff + n * 2048 + k * 1024); } } } while (0)
#define PG8_MMA(ai, bj, At, Bt) do { __builtin_amdgcn_s_setprio(1); _Pragma("unroll") for (int m = 0; m < 4; ++m) _Pragma("unroll") for (int n = 0; n < 2; ++n) { \
        if constexpr (FP8) asm volatile("v_mfma_scale_f32_16x16x128_f8f6f4 %0, %1, %2, %0, %3, %3 op_sel_hi:[0,0,0]" : "+v"(acc[ai][bj][m][n]) : "v"(Bt##8[n]), "v"(At##8[m]), "v"(scl1)); \
        else { _Pragma("unroll") for (int k = 0; k < 2; ++k) acc[ai][bj][m][n] = __builtin_amdgcn_mfma_f32_16x16x32_bf16(Bt[n][k], At[m][k], acc[ai][bj][m][n], 0, 0, 0); } } \
        __builtin_amdgcn_s_setprio(0); } while (0)
#define PG8_WAIT_V(n) asm volatile("s_waitcnt vmcnt(" #n ")" ::: "memory")
#define PG8_WAIT_L(n) asm volatile("s_waitcnt lgkmcnt(" #n ")" ::: "memory")
#define PG8_BAR __builtin_amdgcn_s_barrier()
#define PG8_SCHED __builtin_amdgcn_sched_barrier(0)
    Unit cur, nxt;
    if (!S.next(cur)) return;
    const unsigned scl1 = 0x7f7f7f7fu;
    f32x4 acc[2][2][4][2];
#pragma unroll
    for (int a = 0; a < 2; ++a)
#pragma unroll
        for (int b = 0; b < 2; ++b)
#pragma unroll
            for (int m = 0; m < 4; ++m)
#pragma unroll
                for (int n = 0; n < 2; ++n) acc[a][b][m][n] = (f32x4){0.f, 0.f, 0.f, 0.f};
    bf16x8 At[4][2], B0[2][2], B1[2][2]; i32x8 At8[4], B08[2], B18[2];
    const char* cA = (const char*)g.A + (size_t)cur.e * g.astride + (gather ? (size_t)0 : (size_t)cur.pm * tstep); const char* cB = (const char*)g.Bt + (size_t)cur.e * g.estride + (size_t)cur.pn * tstep;
    PG8_AOFF(vA0, vA1, cur);
    PG8_STAGE(PG8_SB(0, 0), cB, voffB); PG8_STAGE(PG8_SB(0, 1), cB + hstep, voffB); PG8_STAGE(PG8_SA(0, 0), cA, vA0); PG8_STAGE(PG8_SA(0, 1), cA + hsA, vA1);
    if (wr == 1) PG8_BAR;
    PG8_WAIT_V(2); PG8_BAR;
    PG8_STAGE(PG8_SB(1, 0), cB + kstep, voffB); PG8_STAGE(PG8_SA(1, 0), cA + kstep, vA0); PG8_STAGE(PG8_SB(1, 1), cB + hstep + kstep, voffB);
    PG8_WAIT_V(6); PG8_BAR;
    for (;;) {
        const bool has_next = S.next(nxt);
        const char* nA = has_next ? (const char*)g.A + (size_t)nxt.e * g.astride + (gather ? (size_t)0 : (size_t)nxt.pm * tstep) : cA;
        if (has_next) PG8_AOFF(nA0, nA1, nxt);
        const char* nB = has_next ? (const char*)g.Bt + (size_t)nxt.e * g.estride + (size_t)nxt.pn * tstep : cB;
        for (int t = 0; t < nt; t += 2) {
            const bool last = (t == nt - 2);
            const char* a1 = cA + (size_t)(t + 1) * kstep;
            const char* a2 = last ? nA : cA + (size_t)(t + 2) * kstep; const char* b2 = last ? nB : cB + (size_t)(t + 2) * kstep;
            const char* a3 = a2 + kstep; const char* b3 = b2 + kstep;
            PG8_LDB(B0, 0, 0); PG8_LDB(B1, 0, 1); PG8_SCHED; PG8_LDA(At, 0, 0); PG8_STAGE(PG8_SA(1, 1), a1 + hsA, vA1);
            if (last && has_next) { vA0[0] = nA0[0]; vA0[1] = nA0[1]; vA1[0] = nA1[0]; vA1[1] = nA1[1]; }
            PG8_WAIT_V(8); PG8_WAIT_L(0); PG8_BAR; PG8_MMA(0, 0, At, B0); PG8_MMA(0, 1, At, B1); PG8_BAR; PG8_SCHED;
            PG8_LDA(At, 0, 1); PG8_STAGE(PG8_SB(0, 0), b2, voffB); PG8_STAGE(PG8_SB(0, 1), b2 + hstep, voffB); PG8_STAGE(PG8_SA(0, 0), a2, vA0);
            PG8_WAIT_V(8); PG8_WAIT_L(0); PG8_BAR; PG8_MMA(1, 0, At, B0); PG8_MMA(1, 1, At, B1); PG8_BAR; PG8_SCHED;
            PG8_LDB(B0, 1, 0); PG8_LDB(B1, 1, 1); PG8_SCHED; PG8_LDA(At, 1, 0); PG8_STAGE(PG8_SA(0, 1), a2 + hsA, vA1);
            PG8_WAIT_V(8); PG8_WAIT_L(0); PG8_BAR; PG8_MMA(0, 0, At, B0); PG8_MMA(0, 1, At, B1); PG8_BAR; PG8_SCHED;
            PG8_LDA(At, 1, 1); PG8_STAGE(PG8_SB(1, 0), b3, voffB); PG8_STAGE(PG8_SB(1, 1), b3 + hstep, voffB); PG8_STAGE(PG8_SA(1, 0), a3, vA0);
            PG8_WAIT_V(8); PG8_WAIT_L(0); PG8_BAR; PG8_MMA(1, 0, At, B0); PG8_MMA(1, 1, At, B1); PG8_BAR; PG8_SCHED;
        }
        if (wr == 0) PG8_BAR;
        if constexpr (FP8) {
#pragma unroll
            for (int a = 0; a < 2; ++a)
#pragma unroll
                for (int b = 0; b < 2; ++b) asm volatile("s_nop 15" : "+v"(acc[a][b][0][0]), "+v"(acc[a][b][0][1]), "+v"(acc[a][b][1][0]), "+v"(acc[a][b][1][1]), "+v"(acc[a][b][2][0]), "+v"(acc[a][b][2][1]), "+v"(acc[a][b][3][0]), "+v"(acc[a][b][3][1]));
        }
        const bool keep_acc = E(acc, cur, wr, wc, fr, fq);
        if (!has_next) break;
        if (!keep_acc)
#pragma unroll
        for (int a = 0; a < 2; ++a)
#pragma unroll
            for (int b = 0; b < 2; ++b)
#pragma unroll
                for (int m = 0; m < 4; ++m)
#pragma unroll
                    for (int n = 0; n < 2; ++n) acc[a][b][m][n] = (f32x4){0.f, 0.f, 0.f, 0.f};
        cur = nxt; cA = nA; cB = nB;
        if (wr == 1) PG8_BAR;
    }
    PG8_WAIT_V(0);
    PG8_BAR;
#undef PG8_AOFF
#undef PG8_SA
#undef PG8_SB
#undef PG8_STAGE
#undef PG8_LDA
#undef PG8_LDB
#undef PG8_MMA
#undef PG8_LD8
#undef PG8_WAIT_V
#undef PG8_WAIT_L
#undef PG8_BAR
#undef PG8_SCHED
}

struct EpiBf16 {
    static constexpr bool PERM = true;
    bf16_t* O; int ldc; const float* bias; int bias_estride; float ascale; int skip_from, skip_cols;
    __device__ __forceinline__ bool operator()(const f32x4 (&acc)[2][2][4][2], const Unit& u, int wr, int wc, int fr, int fq) const {
        const int row0 = u.pm * BM + wr * 64 + fr; const int col0 = u.pn * BM + wc * 32 + 8 * fq + (u.pn >= skip_from ? skip_cols : 0);
        f32x4 bv[2][2];
#pragma unroll
        for (int bj = 0; bj < 2; ++bj)
#pragma unroll
            for (int n = 0; n < 2; ++n) bv[bj][n] = bias ? *(const f32x4*)(bias + (size_t)u.e * bias_estride + col0 + bj * HALF + 4 * n) : (f32x4){0.f, 0.f, 0.f, 0.f};
#pragma unroll
        for (int ai = 0; ai < 2; ++ai)
#pragma unroll
            for (int m = 0; m < 4; ++m) { bf16_t* rowp = O + (size_t)(row0 + ai * HALF + m * 16) * ldc + col0;
#pragma unroll
                for (int bj = 0; bj < 2; ++bj) { const f32x4 v0 = acc[ai][bj][m][0] * ascale + bv[bj][0], v1 = acc[ai][bj][m][1] * ascale + bv[bj][1];
                    u32x4 w; w.x = cvt_pk_bf16(v0[0], v0[1]); w.y = cvt_pk_bf16(v0[2], v0[3]); w.z = cvt_pk_bf16(v1[0], v1[1]); w.w = cvt_pk_bf16(v1[2], v1[3]);
                    *(u32x4*)(rowp + bj * HALF) = w; } }
        return false;
    }
};
__device__ __forceinline__ float swiglu1(float ug, float ul) {
    ug = fminf(ug, 7.0f); ul = fminf(fmaxf(ul, -7.0f), 7.0f);
    return ug * __builtin_amdgcn_rcpf(1.0f + __expf(-1.702f * ug)) * (ul + 1.0f);
}
struct EpiSwiglu {
    static constexpr bool PERM = true;
    unsigned char* O; const float* b1;
    __device__ __forceinline__ bool operator()(const f32x4 (&acc)[2][2][4][2], const Unit& u, int wr, int wc, int fr, int fq) const {
        const int row0 = u.pm * BM + wr * 64 + fr; const int c0 = u.pn * 128 + wc * 32 + 8 * fq;
        const float* bg = b1 + (size_t)u.e * 4096 + c0; const float* bl = bg + 2048;
        f32x4 bgv[2], blv[2];
#pragma unroll
        for (int n = 0; n < 2; ++n) { bgv[n] = *(const f32x4*)(bg + 4 * n); blv[n] = *(const f32x4*)(bl + 4 * n); }
#pragma unroll
        for (int ai = 0; ai < 2; ++ai)
#pragma unroll
            for (int m = 0; m < 4; ++m) {
                float a[8];
#pragma unroll
                for (int n = 0; n < 2; ++n)
#pragma unroll
                    for (int j = 0; j < 4; ++j) a[4 * n + j] = ACT8_SCALE * swiglu1(acc[ai][0][m][n][j] * (1.0f / W8_SCALE) + bgv[n][j], acc[ai][1][m][n][j] * (1.0f / W8_SCALE) + blv[n][j]);
                u32x2 w; w.x = pack4_fp8(a[0], a[1], a[2], a[3]); w.y = pack4_fp8(a[4], a[5], a[6], a[7]);
                *(u32x2*)(O + (size_t)(row0 + ai * HALF + m * 16) * 2048 + c0) = w;
            }
        return false;
    }
};

struct TwoPartOrder {
    StaticOrder so; Unit held; int part;
    __device__ void init(int M, int N, int G_, int c_) { so.init(M, N, G_, c_); part = 0; }
    __device__ bool next(Unit& u) { if (part == 1) { u = held; u.e = 1; part = 0; return true; } if (!so.next(held)) return false; u = held; u.e = 0; part = 1; return true; }
};
struct EpiGate2 {
    static constexpr bool PERM = true;
    unsigned char* O; const bf16_t* Ga; const bf16_t* Gr;
    __device__ __forceinline__ bool operator()(f32x4 (&acc)[2][2][4][2], const Unit& u, int wr, int wc, int fr, int fq) const {
        const int row0 = u.pm * BM + wr * 64 + fr; const int col0 = u.pn * BM + wc * 32 + 8 * fq;
#pragma unroll
        for (int ai = 0; ai < 2; ++ai)
#pragma unroll
            for (int m = 0; m < 4; ++m) { const size_t row = (size_t)(row0 + ai * HALF + m * 16);
#pragma unroll
                for (int bj = 0; bj < 2; ++bj) { const int c = col0 + bj * HALF;
                    const u32x4 gr = *(const u32x4*)(Gr + row * DINP + c);
                    if (u.e == 0) {
                        const u32x4 ga = *(const u32x4*)(Ga + row * DINP + c);
#pragma unroll
                        for (int q = 0; q < 4; ++q) {
                            const float r0 = (1.0f + __expf(-bf_lo(gr[q]))) * __builtin_amdgcn_rcpf(1.0f + __expf(-bf_lo(ga[q]))), r1 = (1.0f + __expf(-bf_hi(gr[q]))) * __builtin_amdgcn_rcpf(1.0f + __expf(-bf_hi(ga[q])));
                            acc[ai][bj][m][q >> 1][(2 * q) & 3] *= r0; acc[ai][bj][m][q >> 1][(2 * q + 1) & 3] *= r1; }
                    } else {
                        float r[8];
#pragma unroll
                        for (int q = 0; q < 4; ++q) { r[2 * q] = sigmoidf_(bf_lo(gr[q])) * acc[ai][bj][m][q >> 1][(2 * q) & 3]; r[2 * q + 1] = sigmoidf_(bf_hi(gr[q])) * acc[ai][bj][m][q >> 1][(2 * q + 1) & 3]; }
                        u32x2 w; constexpr float osc = MRG8_SCALE / (W8_SCALE * OP8_SCALE); w.x = pack4_fp8(r[0] * osc, r[1] * osc, r[2] * osc, r[3] * osc); w.y = pack4_fp8(r[4] * osc, r[5] * osc, r[6] * osc, r[7] * osc);
                        *(u32x2*)(O + row * 2048 + c) = w; } } }
        return u.e == 0;
    }
};
struct EpiDelta {
    static constexpr bool PERM = true;
    const float* gt; bf16_t* DL; float ascale;
    __device__ __forceinline__ bool operator()(const f32x4 (&acc)[2][2][4][2], const Unit& u, int wr, int wc, int fr, int fq) const {
        const int row0 = u.pm * BM + wr * 64 + fr; const int col0 = u.pn * BM + wc * 32 + 8 * fq;
        f32x4 g[2][2];
#pragma unroll
        for (int bj = 0; bj < 2; ++bj)
#pragma unroll
            for (int n = 0; n < 2; ++n) g[bj][n] = *(const f32x4*)(gt + col0 + bj * HALF + 4 * n);
#pragma unroll
        for (int ai = 0; ai < 2; ++ai)
#pragma unroll
            for (int m = 0; m < 4; ++m) { bf16_t* rowp = DL + (size_t)(row0 + ai * HALF + m * 16) * 2048 + col0;
#pragma unroll
                for (int bj = 0; bj < 2; ++bj) { const f32x4 v0 = acc[ai][bj][m][0] * ascale * g[bj][0], v1 = acc[ai][bj][m][1] * ascale * g[bj][1];
                    u32x4 w; w.x = cvt_pk_bf16(v0[0], v0[1]); w.y = cvt_pk_bf16(v0[2], v0[3]); w.z = cvt_pk_bf16(v1[0], v1[1]); w.w = cvt_pk_bf16(v1[2], v1[3]);
                    *(u32x4*)(rowp + bj * HALF) = w; } }
        return false;
    }
};
}

struct Args { const void* in[22]; float* out; unsigned char* ws; int ph_lo, ph_hi, flags, pad; };
constexpr int XCONV = 0, XSCORE = 96;
constexpr int CW_SCQ = 12288, SCP = 5, CW_ATQ = 12352;
enum { PH_PRO = 0, PH_H, PH_INPROJ, PH_POST, PH_SCORE, PH_SELECT, PH_ATTN, PH_OP1, PH_OP2, PH_WOUT, PH_ROUTER, PH_SCATTER, PH_MOE1, PH_MOE2, PH_FINAL, NPH };

__device__ __forceinline__ int dest_row(int mode, int n) {
    if (mode == 1) return n < 2640 ? n : n + 176;
    if (mode == 2) { const int g = n >> 11, c = n & 2047; return (c >> 7) * 256 + g * 128 + (c & 127); }
    return n;
}
__device__ __forceinline__ void convert_item(const float* __restrict__ W, int K, int N, int ld, bf16_t* WT, int mode, int item, int lane, LAS unsigned char* scr) {
    const int nblk = (N + 63) >> 6; const int kb = item / nblk, nb = item - kb * nblk; const int k0 = kb * 128, n0 = nb * 64;
    const int c4 = lane & 15, kr = lane >> 4;
    const bool ok = (n0 + 4 * c4) < N;
    const float* src = W + (size_t)(k0 + 2 * kr) * ld + n0 + 4 * c4;
#pragma unroll 4
    for (int i = 0; i < 16; ++i) {
        f32x4 v0 = (f32x4){0.f, 0.f, 0.f, 0.f}, v1 = v0;
        if (ok) { v0 = *(const f32x4*)(src + (size_t)(8 * i) * ld); v1 = *(const f32x4*)(src + (size_t)(8 * i + 1) * ld); }
        const int kk = 8 * i + 2 * kr;
#pragma unroll
        for (int e = 0; e < 4; ++e) *(LAS unsigned*)(scr + (4 * c4 + e) * 272 + kk * 2) = cvt_pk_bf16(v0[e], v1[e]);
    }
    LDS_WAIT(); asm volatile("" ::: "memory");
#pragma unroll 4
    for (int j = 0; j < 16; ++j) {
        const int q = j * 64 + lane, n = q >> 4, ch = q & 15;
        const u32x4 v = *(const LAS u32x4*)(scr + n * 272 + ch * 16);
        if (n0 + n < N) *(u32x4*)(WT + (size_t)dest_row(mode, n0 + n) * K + k0 + ch * 8) = v;
    }
    LDS_WAIT(); asm volatile("" ::: "memory");
}


__device__ __forceinline__ bf16_t f2bf(float f) { unsigned u = __float_as_uint(f); return (bf16_t)((u + 0x7fffu + ((u >> 16) & 1u)) >> 16); }
__device__ __forceinline__ float bfx(const u32x4& w, int i) { const unsigned u = w[i >> 1]; return (i & 1) ? bf_hi(u) : bf_lo(u); }
__device__ __forceinline__ void rope_sc(float pos, float inv, float& sn, float& cs) {
    const float ang = pos * inv;
    const double a = (double)ang; const double n = __builtin_rint(a * 0.15915494309189535); const float r = (float)(a - n * 6.283185307179586);
    sn = sinf(r); cs = cosf(r);
}
__device__ __forceinline__ void post_token(bf16_t* PROJ, bf16_t* KI, unsigned char* KC, unsigned char* VC, const int* positions, const float* kng, const float* knb, int t, int lane) {
    const float pos = (float)positions[t];
    bf16_t* row = PROJ + (size_t)t * DINP;
    float sn, cs;
#pragma unroll
    for (int i = 0; i < 2; ++i) {
        const int pp = lane + 64 * i, hd = pp >> 4, ii = pp & 15;
        rope_sc(pos, powf(500000.0f, -(float)ii * (1.0f / 16.0f)), sn, cs);
        bf16_t* p = row + CQ + hd * 128 + ii; const float a = bf2f(p[0]), b = bf2f(p[16]);
        p[0] = f2bf(a * cs - b * sn); p[16] = f2bf(b * cs + a * sn);
    }
#pragma unroll
    for (int i = 0; i < 2; ++i) {
        const int pp = lane + 64 * i, hd = pp >> 3, ii = pp & 7;
        rope_sc(pos, powf(500000.0f, -(float)ii * (1.0f / 8.0f)), sn, cs);
        bf16_t* p = row + CQI + hd * 64 + ii; const float a = bf2f(p[0]), b = bf2f(p[8]);
        p[0] = f2bf(a * cs - b * sn); p[8] = f2bf(b * cs + a * sn);
    }
    if (lane < 32) {
        const int g = lane >> 4, ii = lane & 15;
        rope_sc(pos, powf(500000.0f, -(float)ii * (1.0f / 16.0f)), sn, cs);
        const bf16_t* p = row + CK + g * 128 + ii; const float a = bf2f(p[0]), b = bf2f(p[16]);
        unsigned char* o = KC + (size_t)t * 256 + g * 128 + ii; o[0] = fp8_1(a * cs - b * sn); o[16] = fp8_1(b * cs + a * sn);
    }
#pragma unroll
    for (int i = 0; i < 3; ++i) { const int idx = lane + 64 * i, g = idx / 96, r = idx - g * 96; KC[(size_t)t * 256 + g * 128 + 32 + r] = fp8_1(bf2f(row[CK + g * 128 + 32 + r])); }
    { const u32x2 w = *(const u32x2*)(row + CV + 4 * lane); *(unsigned*)(VC + (size_t)t * 256 + 4 * lane) = pack4_fp8(bf_lo(w.x), bf_hi(w.x), bf_lo(w.y), bf_hi(w.y)); }
    {
        const float v = bf2f(row[CKI + lane]);
        const float mean = wave_sum(v) * (1.0f / 64.0f); const float d = v - mean; const float var = wave_sum(d * d) * (1.0f / 64.0f);
        const float y = d * rsqrtf(var + NORM_EPS) * kng[lane] + knb[lane];
        const float other = __shfl_xor(y, 8);
        rope_sc(pos, powf(500000.0f, -(float)(lane & 7) * (1.0f / 8.0f)), sn, cs);
        float o = y;
        if (lane < 8) o = y * cs - other * sn; else if (lane < 16) o = y * cs + other * sn;
        KI[(size_t)t * 64 + lane] = f2bf(o);
    }
}

constexpr int HG_GB = 0, HG_Q1 = 33792, HG_Q2 = 51200, HG_K2 = 68608, HG_VT = 86016, HG_PB = 104448, HG_LB = 113664;
__device__ __forceinline__ void hgrn_cumsum(LAS unsigned char* lds, const u32x4& w0, const u32x4& w1, float l0, float l1, int tid) {
    LAS float* GB = (LAS float*)(lds + HG_GB); LAS float* LB = (LAS float*)(lds + HG_LB); LAS float* SEG = (LAS float*)(lds + HG_LB + 512);
    if (tid < 128) LB[tid] = 1.0f / (1.0f + expf(l1 - l0));
    __syncthreads();
    const int t = tid >> 3, dseg = tid & 7;
#pragma unroll
    for (int i = 0; i < 16; ++i) { const float z = i < 8 ? bfx(w0, i) : bfx(w1, i - 8); const float lb = LB[16 * dseg + i]; GB[t * 128 + 16 * dseg + i] = logf(lb + (1.0f - lb) * sigmoidf_(z)); }
    __syncthreads();
    const int d = tid & 127, tq = tid >> 7;
    float z[16];
#pragma unroll
    for (int i = 0; i < 16; ++i) z[i] = GB[(16 * tq + i) * 128 + d];
    float a = 0.f;
#pragma unroll
    for (int i = 0; i < 16; ++i) { a += z[i]; z[i] = a; }
    SEG[tq * 128 + d] = a;
    __syncthreads();
    float pre = 0.f;
    for (int q = 0; q < tq; ++q) pre += SEG[q * 128 + d];
#pragma unroll
    for (int i = 0; i < 16; ++i) GB[(16 * tq + i) * 128 + d] = z[i] + pre;
    __syncthreads();
}
__device__ __forceinline__ void hgrn_vt(LAS unsigned char* lds, const u32x4& a, const u32x4& b, int tid) {
    const int s2 = tid & 31, eg = tid >> 5;
#pragma unroll
    for (int i = 0; i < 8; ++i) { const unsigned lo = (i & 1) ? (a[i >> 1] >> 16) : (a[i >> 1] & 0xffffu), hi = (i & 1) ? (b[i >> 1] >> 16) : (b[i >> 1] & 0xffffu);
        *(LAS unsigned*)(lds + HG_VT + (8 * eg + i) * 144 + s2 * 4) = lo | (hi << 16); }
}
__device__ __forceinline__ void hgrn_l1(LAS unsigned char* lds, const bf16_t* PROJ, const float* lb_logits, float* ST, float* DC, int c, int h, int tid, int wave, int lane) {
    const int t = tid >> 3, dseg = tid & 7, s2 = tid & 31, dg = tid >> 5;
    const bf16_t* pf = PROJ + (size_t)(c * 64 + t) * DINP + CHF + h * 128 + 16 * dseg;
    const bf16_t* pk = PROJ + (size_t)(c * 64 + 2 * s2) * DINP + CHF + h * 128 + 8 * dg;
    const u32x4 w0 = *(const u32x4*)pf, w1 = *(const u32x4*)(pf + 8);
    const u32x4 ka = *(const u32x4*)pk, kb = *(const u32x4*)(pk + DINP);
    const u32x4 va = *(const u32x4*)(pk - CHF + CHI), vb = *(const u32x4*)(pk - CHF + CHI + DINP);
    const float l0 = lb_logits[h * 128 + (tid & 127)], l1 = lb_logits[1024 + h * 128 + (tid & 127)];
    hgrn_cumsum(lds, w0, w1, l0, l1, tid);
    const LAS float* GB = (const LAS float*)(lds + HG_GB); const LAS float* LB = (const LAS float*)(lds + HG_LB);
    {
#pragma unroll
        for (int i = 0; i < 8; ++i) { const int d = 8 * dg + i; const float lb = LB[d], b63 = GB[63 * 128 + d];
            const float k0 = (1.0f - lb) * (1.0f - sigmoidf_(bfx(ka, i))), k1 = (1.0f - lb) * (1.0f - sigmoidf_(bfx(kb, i)));
            const float v0 = k0 * __expf(b63 - GB[(2 * s2) * 128 + d]), v1 = k1 * __expf(b63 - GB[(2 * s2 + 1) * 128 + d]);
            *(LAS unsigned*)(lds + HG_Q1 + d * 144 + s2 * 4) = cvt_pk_bf16(v0, v1); }
    }
    hgrn_vt(lds, va, vb, tid);
    __syncthreads();
    const int fr = lane & 15, fq = lane >> 4;
    bf16x8 af[2];
#pragma unroll
    for (int ks = 0; ks < 2; ++ks) af[ks] = *(const LAS bf16x8*)(lds + HG_VT + (16 * wave + fr) * 144 + (32 * ks + 8 * fq) * 2);
    float* dst = ST + ((size_t)(c * 8 + h) * 128) * 128;
#pragma unroll 2
    for (int dt = 0; dt < 8; ++dt) {
        f32x4 acc = (f32x4){0.f, 0.f, 0.f, 0.f};
#pragma unroll
        for (int ks = 0; ks < 2; ++ks) { const bf16x8 bfr = *(const LAS bf16x8*)(lds + HG_Q1 + (16 * dt + fr) * 144 + (32 * ks + 8 * fq) * 2); acc = __builtin_amdgcn_mfma_f32_16x16x32_bf16(af[ks], bfr, acc, 0, 0, 0); }
#pragma unroll
        for (int r = 0; r < 4; ++r) dst[(size_t)(16 * wave + 4 * fq + r) * 128 + 16 * dt + fr] = acc[r];
    }
    if (tid < 128) DC[(size_t)(c * 8 + h) * 128 + tid] = __expf(GB[63 * 128 + tid]);
    __syncthreads();
}
__device__ __forceinline__ void hgrn_l3(LAS unsigned char* lds, const bf16_t* PROJ, const float* lb_logits, const float* ST, const float* norm_g, unsigned char* REC, int c, int h, int tid, int wave, int lane) {
    const int t = tid >> 3, dseg = tid & 7, s2 = tid & 31, eg = tid >> 5, fr = lane & 15, fq = lane >> 4;
    const bf16_t* pf = PROJ + (size_t)(c * 64 + t) * DINP + CHF + h * 128 + 16 * dseg;
    const u32x4 f0 = *(const u32x4*)pf, f1 = *(const u32x4*)(pf + 8), q0 = *(const u32x4*)(pf - CHF + CHQ), q1 = *(const u32x4*)(pf - CHF + CHQ + 8);
    const u32x4 g0 = *(const u32x4*)(pf - CHF + CHG), g1 = *(const u32x4*)(pf - CHF + CHG + 8);
    const bf16_t* pv = PROJ + (size_t)(c * 64 + 2 * s2) * DINP + CHI + h * 128 + 8 * eg;
    const u32x4 va = *(const u32x4*)pv, vb = *(const u32x4*)(pv + DINP);
    const float* sp = ST + ((size_t)(c * 8 + h) * 128 + 16 * wave + fr) * 128 + 8 * fq;
    f32x4 sx[4][2];
#pragma unroll
    for (int ks = 0; ks < 4; ++ks) { sx[ks][0] = *(const f32x4*)(sp + 32 * ks); sx[ks][1] = *(const f32x4*)(sp + 32 * ks + 4); }
    const float l0 = lb_logits[h * 128 + (tid & 127)], l1 = lb_logits[1024 + h * 128 + (tid & 127)];
    hgrn_cumsum(lds, f0, f1, l0, l1, tid);
    const LAS float* GB = (const LAS float*)(lds + HG_GB); const LAS float* LB = (const LAS float*)(lds + HG_LB);
    {
        unsigned o1[8], o2[8], o3[8];
#pragma unroll
        for (int i = 0; i < 16; i += 2) {
            float a1[2], a2[2], a3[2];
#pragma unroll
            for (int j = 0; j < 2; ++j) { const int d = 16 * dseg + i + j; const float lb = LB[d], b = GB[t * 128 + d], br = GB[31 * 128 + d];
                const float z = (i + j) < 8 ? bfx(f0, i + j) : bfx(f1, i + j - 8), qv = (i + j) < 8 ? bfx(q0, i + j) : bfx(q1, i + j - 8);
                const float k = (1.0f - lb) * (1.0f - sigmoidf_(z)), q = siluf_(qv);
                a1[j] = q * __expf(b); a2[j] = q * __expf(b - br); a3[j] = k * __expf(br - b); }
            o1[i >> 1] = cvt_pk_bf16(a1[0], a1[1]); o2[i >> 1] = cvt_pk_bf16(a2[0], a2[1]); o3[i >> 1] = cvt_pk_bf16(a3[0], a3[1]);
        }
        LAS u32x4* d1 = (LAS u32x4*)(lds + HG_Q1 + t * 272 + dseg * 32); LAS u32x4* d2 = (LAS u32x4*)(lds + HG_Q2 + t * 272 + dseg * 32); LAS u32x4* d3 = (LAS u32x4*)(lds + HG_K2 + t * 272 + dseg * 32);
        d1[0] = (u32x4){o1[0], o1[1], o1[2], o1[3]}; d1[1] = (u32x4){o1[4], o1[5], o1[6], o1[7]};
        d2[0] = (u32x4){o2[0], o2[1], o2[2], o2[3]}; d2[1] = (u32x4){o2[4], o2[5], o2[6], o2[7]};
        d3[0] = (u32x4){o3[0], o3[1], o3[2], o3[3]}; d3[1] = (u32x4){o3[4], o3[5], o3[6], o3[7]};
    }
    hgrn_vt(lds, va, vb, tid);
    __syncthreads();
#pragma unroll
    for (int q = 0; q < 2; ++q) {
        const int tile = 2 * wave + q, tt = tile >> 2, stl = tile & 3;
        f32x4 acc = (f32x4){0.f, 0.f, 0.f, 0.f};
#pragma unroll
        for (int ks = 0; ks < 4; ++ks) { const bf16x8 a = *(const LAS bf16x8*)(lds + HG_Q2 + (16 * tt + fr) * 272 + (32 * ks + 8 * fq) * 2), b = *(const LAS bf16x8*)(lds + HG_K2 + (16 * stl + fr) * 272 + (32 * ks + 8 * fq) * 2);
            acc = __builtin_amdgcn_mfma_f32_16x16x32_bf16(a, b, acc, 0, 0, 0); }
#pragma unroll
        for (int r = 0; r < 4; ++r) { const int tr_ = 16 * tt + 4 * fq + r, s = 16 * stl + fr; *(LAS bf16_t*)(lds + HG_PB + tr_ * 144 + s * 2) = f2bf(s <= tr_ ? acc[r] : 0.f); }
    }
    __syncthreads();
    {
        bf16x8 b1[2], b2[4];
#pragma unroll
        for (int ks = 0; ks < 2; ++ks) b1[ks] = *(const LAS bf16x8*)(lds + HG_VT + (16 * wave + fr) * 144 + (32 * ks + 8 * fq) * 2);
#pragma unroll
        for (int ks = 0; ks < 4; ++ks) { const f32x4 x0 = sx[ks][0], x1 = sx[ks][1];
            u32x4 w; w.x = cvt_pk_bf16(x0[0], x0[1]); w.y = cvt_pk_bf16(x0[2], x0[3]); w.z = cvt_pk_bf16(x1[0], x1[1]); w.w = cvt_pk_bf16(x1[2], x1[3]); b2[ks] = __builtin_bit_cast(bf16x8, w); }
        LAS float* OB = (LAS float*)(lds + HG_GB);
#pragma unroll
        for (int tt = 0; tt < 4; ++tt) {
            f32x4 acc = (f32x4){0.f, 0.f, 0.f, 0.f};
#pragma unroll
            for (int ks = 0; ks < 2; ++ks) { const bf16x8 a = *(const LAS bf16x8*)(lds + HG_PB + (16 * tt + fr) * 144 + (32 * ks + 8 * fq) * 2); acc = __builtin_amdgcn_mfma_f32_16x16x32_bf16(a, b1[ks], acc, 0, 0, 0); }
#pragma unroll
            for (int ks = 0; ks < 4; ++ks) { const bf16x8 a = *(const LAS bf16x8*)(lds + HG_Q1 + (16 * tt + fr) * 272 + (32 * ks + 8 * fq) * 2); acc = __builtin_amdgcn_mfma_f32_16x16x32_bf16(a, b2[ks], acc, 0, 0, 0); }
#pragma unroll
            for (int r = 0; r < 4; ++r) OB[(16 * tt + 4 * fq + r) * 132 + 16 * wave + fr] = acc[r];
        }
    }
    __syncthreads();
    {
        const int es = dseg; const LAS float* OB = (const LAS float*)(lds + HG_GB);
        float o[16]; float ss = 0.f;
#pragma unroll
        for (int i = 0; i < 16; ++i) { o[i] = OB[t * 132 + 16 * es + i]; ss += o[i] * o[i]; }
        ss += __shfl_xor(ss, 1); ss += __shfl_xor(ss, 2); ss += __shfl_xor(ss, 4);
        const float rstd = rsqrtf(ss * (1.0f / 128.0f) + NORM_EPS);
        float rv[16];
#pragma unroll
        for (int i = 0; i < 16; ++i) { const float ga = i < 8 ? bfx(g0, i) : bfx(g1, i - 8); rv[i] = o[i] * (rstd * OP8_SCALE) * norm_g[16 * es + i] * siluf_(ga); }
        *(u32x4*)(REC + (size_t)(c * 64 + t) * 1024 + h * 128 + 16 * es) = (u32x4){pack4_fp8(rv[0], rv[1], rv[2], rv[3]), pack4_fp8(rv[4], rv[5], rv[6], rv[7]), pack4_fp8(rv[8], rv[9], rv[10], rv[11]), pack4_fp8(rv[12], rv[13], rv[14], rv[15])};
    }
    __syncthreads();
}

constexpr int SC_KT = 0, SC_SB = 36864, SC_SPITCH = 132;
__device__ __forceinline__ unsigned pk_f16(float a, float b) { return __builtin_bit_cast(unsigned, __builtin_amdgcn_cvt_pkrtz(a, b)); }
__device__ __forceinline__ void score_flush(LAS unsigned char* lds, unsigned short* SCORES, unsigned short* SEGMAX, int t0, int kt, int tid) {
    const LAS float* sb = (const LAS float*)(lds + SC_SB + (kt & 1) * (32 * SC_SPITCH * 4));
    const int row = tid >> 4, seg = tid & 15;
    const f32x4 a = *(const LAS f32x4*)(sb + row * SC_SPITCH + seg * 8), b = *(const LAS f32x4*)(sb + row * SC_SPITCH + seg * 8 + 4);
    unsigned short* dst = SCORES + (size_t)(t0 + row) * S + kt * 128 + seg * 8;
    *(u32x4*)dst = (u32x4){pk_f16(a[0], a[1]), pk_f16(a[2], a[3]), pk_f16(b[0], b[1]), pk_f16(b[2], b[3])};
    const float mx = fmaxf(fmaxf(fmaxf(a[0], a[1]), fmaxf(a[2], a[3])), fmaxf(fmaxf(b[0], b[1]), fmaxf(b[2], b[3])));
    SEGMAX[(size_t)(t0 + row) * 2048 + kt * 16 + seg] = (unsigned short)(pk_f16(mx, mx) & 0xffffu);
}
__device__ __forceinline__ void score_block(LAS unsigned char* lds, const bf16_t* PROJ, const bf16_t* KI, unsigned short* SCORES, unsigned short* SEGMAX, int qb, int kt0, int kt1, int tid, int wave, int lane) {
    const int t0 = qb * 32;
    const int r = lane & 31, hh = lane >> 5;
    bf16x8 Af[2][4]; float wv[2][16]; f32x2 wv2[2][8];
#pragma unroll
    for (int p = 0; p < 2; ++p) {
        const int tq = t0 + 4 * wave + 2 * p + (r >> 4); const bf16_t* qrow = PROJ + (size_t)tq * DINP + CQI + (r & 15) * 64 + 8 * hh;
#pragma unroll
        for (int ks = 0; ks < 4; ++ks) Af[p][ks] = *(const bf16x8*)(qrow + 16 * ks);
#pragma unroll
        for (int qq = 0; qq < 2; ++qq) {
            const bf16_t* wp = PROJ + (size_t)(t0 + 4 * wave + 2 * p + qq) * DINP + CWI + 4 * hh;
            const u32x2 wa = *(const u32x2*)wp, wb = *(const u32x2*)(wp + 8);
            wv[p][8 * qq + 0] = bf_lo(wa.x) * (1.0f / 32.0f); wv[p][8 * qq + 1] = bf_hi(wa.x) * (1.0f / 32.0f); wv[p][8 * qq + 2] = bf_lo(wa.y) * (1.0f / 32.0f); wv[p][8 * qq + 3] = bf_hi(wa.y) * (1.0f / 32.0f);
            wv[p][8 * qq + 4] = bf_lo(wb.x) * (1.0f / 32.0f); wv[p][8 * qq + 5] = bf_hi(wb.x) * (1.0f / 32.0f); wv[p][8 * qq + 6] = bf_lo(wb.y) * (1.0f / 32.0f); wv[p][8 * qq + 7] = bf_hi(wb.y) * (1.0f / 32.0f);
        }
#pragma unroll
        for (int i = 0; i < 8; ++i) wv2[p][i] = (f32x2){wv[p][2 * i], wv[p][2 * i + 1]};
    }
    const u32x2 tagsw = __builtin_amdgcn_permlane32_swap(0u, 1u, false, false); const int qsel = (int)tagsw[0];
    u32x4 stg[2];
#pragma unroll
    for (int i = 0; i < 2; ++i) { const int q = tid + 512 * i; stg[i] = *(const u32x4*)(KI + (size_t)(kt0 * 128 + (q >> 3)) * 64 + (q & 7) * 8); }
#pragma unroll
    for (int i = 0; i < 2; ++i) { const int q = tid + 512 * i; *(LAS u32x4*)(lds + SC_KT + (kt0 & 1) * 18432 + (q >> 3) * 144 + (q & 7) * 16) = stg[i]; }
    __syncthreads();
    for (int kt = kt0; kt < kt1; ++kt) {
        const LAS unsigned char* buf = lds + SC_KT + (kt & 1) * 18432;
        LAS float* sb = (LAS float*)(lds + SC_SB + (kt & 1) * (32 * SC_SPITCH * 4));
        if (kt + 1 < kt1) {
#pragma unroll
            for (int i = 0; i < 2; ++i) { const int q = tid + 512 * i; stg[i] = *(const u32x4*)(KI + (size_t)((kt + 1) * 128 + (q >> 3)) * 64 + (q & 7) * 8); }
        }
        __builtin_amdgcn_sched_barrier(0);
        if (kt > kt0) score_flush(lds, SCORES, SEGMAX, t0, kt - 1, tid);
        {
        f32x16 accP[2], accC[2];
#define SC_MFMA(cb) do { bf16x8 Bf[4]; _Pragma("unroll") for (int ks = 0; ks < 4; ++ks) Bf[ks] = *(const LAS bf16x8*)(buf + (32 * (cb) + r) * 144 + (16 * ks + 8 * hh) * 2); \
            _Pragma("unroll") for (int p = 0; p < 2; ++p) { _Pragma("unroll") for (int i = 0; i < 16; ++i) accC[p][i] = 0.f; \
                _Pragma("unroll") for (int ks = 0; ks < 4; ++ks) accC[p] = __builtin_amdgcn_mfma_f32_32x32x16_bf16(Af[p][ks], Bf[ks], accC[p], 0, 0, 0); } } while (0)
#define SC_RED(acc, cb) do { _Pragma("unroll") for (int p = 0; p < 2; ++p) { f32x2 s0 = {0.f, 0.f}, s1 = {0.f, 0.f}; \
            _Pragma("unroll") for (int reg = 0; reg < 8; reg += 2) { const f32x2 r0 = {relu_i(acc[p][reg]), relu_i(acc[p][reg + 1])}; const f32x2 r1 = {relu_i(acc[p][reg + 8]), relu_i(acc[p][reg + 9])}; \
                s0 = __builtin_elementwise_fma(wv2[p][reg >> 1], r0, s0); s1 = __builtin_elementwise_fma(wv2[p][4 + (reg >> 1)], r1, s1); } \
            const float p0 = s0[0] + s0[1], p1 = s1[0] + s1[1]; \
            const u32x2 sw = __builtin_amdgcn_permlane32_swap(__float_as_uint(p0), __float_as_uint(p1), false, false); \
            sb[(4 * wave + 2 * p + qsel) * SC_SPITCH + 32 * (cb) + r] = __uint_as_float(sw[0]) + __uint_as_float(sw[1]); } } while (0)
#define SC_INTERLEAVE() do { _Pragma("unroll") for (int i = 0; i < 8; ++i) { __builtin_amdgcn_sched_group_barrier(0x008, 1, 0); __builtin_amdgcn_sched_group_barrier(0x002, 8, 0); } } while (0)
        SC_MFMA(0);
        accP[0] = accC[0]; accP[1] = accC[1]; SC_MFMA(1); SC_RED(accP, 0); SC_INTERLEAVE();
        accP[0] = accC[0]; accP[1] = accC[1]; SC_MFMA(2); SC_RED(accP, 1); SC_INTERLEAVE();
        accP[0] = accC[0]; accP[1] = accC[1]; SC_MFMA(3); SC_RED(accP, 2); SC_INTERLEAVE();
        SC_RED(accC, 3);
#undef SC_MFMA
#undef SC_RED
#undef SC_INTERLEAVE
        }
        if (kt + 1 < kt1) {
#pragma unroll
            for (int i = 0; i < 2; ++i) { const int q = tid + 512 * i; *(LAS u32x4*)(lds + SC_KT + ((kt + 1) & 1) * 18432 + (q >> 3) * 144 + (q & 7) * 16) = stg[i]; }
        }
        __syncthreads();
    }
    score_flush(lds, SCORES, SEGMAX, t0, kt1 - 1, tid);
    __syncthreads();
}

__device__ __forceinline__ float wave_kth16(const float (&v)[16], int K) {
    const float NINF = -__builtin_inff();
    float mx = NINF, mn = __builtin_inff();
#pragma unroll
    for (int j = 0; j < 16; ++j) { mx = fmaxf(mx, v[j]); mn = fminf(mn, v[j] == NINF ? __builtin_inff() : v[j]); }
    mx = wave_max(mx); mn = -wave_max(-mn);
    int c = 0;
#pragma unroll
    for (int j = 0; j < 16; ++j) c += __popcll(__ballot(v[j] >= mx));
    if (c >= K) return mx;
    float lo = mn, hi = mx, tau = mn;
    for (int it = 0; it < 64; ++it) {
        const float mid = 0.5f * (lo + hi);
        if (!(mid > lo && mid < hi)) { tau = lo; break; }
        c = 0;
#pragma unroll
        for (int j = 0; j < 16; ++j) c += __popcll(__ballot(v[j] >= mid));
        if (c == K) { tau = mid; break; }
        if (c > K) lo = mid; else hi = mid;
        tau = lo;
    }
    return tau;
}
__device__ __forceinline__ int lanes_below(unsigned long long mask) { return (int)__builtin_amdgcn_mbcnt_hi((unsigned)(mask >> 32), __builtin_amdgcn_mbcnt_lo((unsigned)mask, 0u)); }
__device__ __forceinline__ float h2f(unsigned short h) { return (float)__builtin_bit_cast(_Float16, h); }
__device__ __forceinline__ float h2f_lo(unsigned u) { return h2f((unsigned short)(u & 0xffffu)); }
__device__ __forceinline__ float h2f_hi(unsigned u) { return h2f((unsigned short)(u >> 16)); }
__device__ __forceinline__ unsigned ge_mask8(const u32x4& v, unsigned T16) {
    unsigned m8 = 0;
#pragma unroll
    for (int w = 0; w < 4; ++w) { const unsigned vw_ = v[w];
        const s16x2 d = __builtin_elementwise_sub_sat(__builtin_bit_cast(s16x2, vw_), __builtin_bit_cast(s16x2, T16));
        const unsigned mm = ~__builtin_bit_cast(unsigned, d); m8 |= (((mm >> 15) & 1u) | ((mm >> 30) & 2u)) << (2 * w); }
    return m8;
}
__device__ __forceinline__ int append_bits(LAS int* list, int cnt, unsigned m8, int base) {
    for (;;) { const bool has = m8 != 0u; const unsigned long long mask = __ballot(has); if (!mask) break;
        const int pos = cnt + lanes_below(mask);
        if (has) { const int k = __builtin_ctz(m8); m8 &= m8 - 1u; if (pos < 1024) list[pos] = base + k; }
        cnt += __popcll(mask); }
    return cnt;
}
__device__ __forceinline__ void select_row(LAS unsigned char* wl, const unsigned short* SCORES, const unsigned short* SEGMAX, int t, int lane) {
    LAS int* selw = (LAS int*)wl; LAS int* segl = (LAS int*)(wl + 1024); LAS int* cidx = (LAS int*)(wl + 5120);
    const float NINF = -__builtin_inff();
    const unsigned short* row = SCORES + (size_t)t * S; const int n = t + 1;
    float c[16]; int N;
    if (n <= 1024) {
#pragma unroll
        for (int j = 0; j < 16; ++j) { const int i = lane + 64 * j; c[j] = i < n ? h2f(row[i]) : NINF; }
        N = -1;
    } else {
        const int m = n >> 4; float s[16];
#pragma unroll
        for (int j = 0; j < 16; ++j) { const int i = lane + 64 * j; s[j] = i < m ? h2f(row[16 * i + 7]) : NINF; }
        int K = 32, cnt = 0;
        for (;;) {
            const float tlo = (K >= m) ? NINF : wave_kth16(s, K);
            cnt = 0;
            const int nq = (n + 511) >> 9;
            if (tlo > 0.f) {
                const unsigned T16 = pk_f16(tlo, tlo);
                const u32x4 NEG = (u32x4){0xfc00fc00u, 0xfc00fc00u, 0xfc00fc00u, 0xfc00fc00u};
                const unsigned short* smrow = SEGMAX + (size_t)t * 2048; const int nseg = (t >> 3) + 1;
                int ns = 0;
                {
                    u32x4 sv[4];
#pragma unroll
                    for (int u = 0; u < 4; ++u) { const int e8 = 8 * (lane + 64 * u); sv[u] = (e8 < nseg) ? *(const u32x4*)(smrow + e8) : NEG; }
#pragma unroll
                    for (int u = 0; u < 4; ++u) { const int e8 = 8 * (lane + 64 * u); unsigned m8 = ge_mask8(sv[u], T16);
                        const int nv = nseg - e8; if (nv < 8) m8 &= nv > 0 ? ((1u << nv) - 1u) : 0u;
                        ns = append_bits(segl, ns, m8, e8); }
                }
                if (ns > 1024) ns = 1024;
                for (int j0 = 0; j0 < ns; j0 += 256) {
                    u32x4 v[4]; int sg[4];
#pragma unroll
                    for (int u = 0; u < 4; ++u) { const int i = j0 + lane + 64 * u; sg[u] = i < ns ? segl[i] : -1; v[u] = sg[u] >= 0 ? *(const u32x4*)(row + 8 * sg[u]) : NEG; }
#pragma unroll
                    for (int u = 0; u < 4; ++u) { const int e = 8 * sg[u]; unsigned m8 = sg[u] >= 0 ? ge_mask8(v[u], T16) : 0u;
                        const int nv = t + 1 - e; if (nv < 8) m8 &= nv > 0 ? ((1u << nv) - 1u) : 0u;
                        cnt = append_bits(cidx, cnt, m8, e); }
                }
            } else {
                for (int q0 = 0; q0 < nq; q0 += 4) {
                    u32x4 v[4];
#pragma unroll
                    for (int u = 0; u < 4; ++u) { const int e = 8 * (lane + 64 * (q0 + u)); v[u] = (e <= t) ? *(const u32x4*)(row + e) : (u32x4){0xfc00fc00u, 0xfc00fc00u, 0xfc00fc00u, 0xfc00fc00u}; }
#pragma unroll
                    for (int u = 0; u < 4; ++u) { const int e = 8 * (lane + 64 * (q0 + u));
#pragma unroll
                        for (int k = 0; k < 8; ++k) { const float x = (k & 1) ? h2f_hi(v[u][k >> 1]) : h2f_lo(v[u][k >> 1]);
                            const bool pred = (e + k <= t) && (x >= tlo); const unsigned long long mask = __ballot(pred);
                            if (mask) { const int pos = cnt + lanes_below(mask); if (pred && pos < 1024) cidx[pos] = e + k; cnt += __popcll(mask); } } }
                }
            }
            if (cnt >= 256 || K >= m) break;
            K *= 2;
        }
        N = cnt < 1024 ? cnt : 1024;
#pragma unroll
        for (int j = 0; j < 16; ++j) { const int i = lane + 64 * j; c[j] = i < N ? h2f(row[cidx[i]]) : NINF; }
    }
    const float tau = wave_kth16(c, 256);
    int base = 0;
#pragma unroll
    for (int j = 0; j < 16; ++j) { const bool pred = c[j] >= tau; const unsigned long long mask = __ballot(pred);
        if (mask) { const int pos = base + lanes_below(mask); if (pred && pos < 256) selw[pos] = (N < 0) ? (lane + 64 * j) : cidx[lane + 64 * j]; base += __popcll(mask); } }
}

__device__ __forceinline__ void attn_query(LAS unsigned char* wl, const bf16_t* PROJ, const unsigned char* KC, const unsigned char* VC, unsigned char* ATT, int t, int lane) {
    LAS int* selw = (LAS int*)wl; LAS float* L = (LAS float*)(wl + 1024);
    const int nsel = t < 255 ? t + 1 : 256;
    const int fr = lane & 15, fq = lane >> 4;
    bf16x8 qf[2][4];
#pragma unroll
    for (int g = 0; g < 2; ++g)
#pragma unroll
        for (int ks = 0; ks < 4; ++ks) { const bf16x8 z = {0, 0, 0, 0, 0, 0, 0, 0}; qf[g][ks] = fr < 4 ? *(const bf16x8*)(PROJ + (size_t)t * DINP + CQ + (4 * g + fr) * 128 + 64 * (ks >> 1) + 16 * fq + 8 * (ks & 1)) : z; }
    const float scale = 0.08838834764831845f;
    const int nkt = (nsel + 15) >> 4;
    {
        LAS unsigned char* KT = wl + 9216;
        const int q4_ = lane >> 4, l15_ = lane & 15;
        u32x4 kw[3][4];
#define QK_LOAD(buf, kt) do { _Pragma("unroll") for (int u = 0; u < 4; ++u) { const unsigned off_ = (unsigned)selw[16 * (kt) + 4 * u + q4_] * 256u + 16u * (unsigned)l15_; kw[buf][u] = *(const u32x4*)((const char*)KC + off_); } } while (0)
#define QK_COMP(buf, kt) do { _Pragma("unroll") for (int u = 0; u < 4; ++u) { u32x4 lo_, hi_; fp8x16_to_bf16(kw[buf][u], lo_, hi_); LAS u32x4* d_ = (LAS u32x4*)(KT + (4 * u + q4_) * 528 + 32 * l15_); d_[0] = lo_; d_[1] = hi_; } \
        _Pragma("unroll") for (int g = 0; g < 2; ++g) { f32x4 acc = (f32x4){0.f, 0.f, 0.f, 0.f}; \
            _Pragma("unroll") for (int ks = 0; ks < 4; ++ks) { const bf16x8 kf_ = *(const LAS bf16x8*)(KT + fr * 528 + g * 256 + (64 * (ks >> 1) + 16 * fq + 8 * (ks & 1)) * 2); \
                acc = __builtin_amdgcn_mfma_f32_16x16x32_bf16(qf[g][ks], kf_, acc, 0, 0, 0); } \
            if (fq == 0) { _Pragma("unroll") for (int r = 0; r < 4; ++r) L[(4 * g + r) * 256 + 16 * (kt) + fr] = (16 * (kt) + fr < nsel) ? acc[r] * scale : -__builtin_inff(); } } } while (0)
        QK_LOAD(0, 0); if (1 < nkt) QK_LOAD(1, 1);
        for (int kt = 0; kt < nkt; kt += 3) {
            if (kt + 2 < nkt) QK_LOAD(2, kt + 2);
            __builtin_amdgcn_sched_barrier(0);
            QK_COMP(0, kt);
            if (kt + 1 < nkt) { if (kt + 3 < nkt) QK_LOAD(0, kt + 3); __builtin_amdgcn_sched_barrier(0); QK_COMP(1, kt + 1); }
            if (kt + 2 < nkt) { if (kt + 4 < nkt) QK_LOAD(1, kt + 4); __builtin_amdgcn_sched_barrier(0); QK_COMP(2, kt + 2); }
        }
#undef QK_LOAD
#undef QK_COMP
        if (fq == 0) { for (int kt = nkt; kt < 16; ++kt) {
#pragma unroll
            for (int r = 0; r < 8; ++r) L[r * 256 + 16 * kt + fr] = -__builtin_inff(); } }
    }
    float p[8][4];
#pragma unroll
    for (int hd = 0; hd < 8; ++hd) { float m = -__builtin_inff();
#pragma unroll
        for (int i = 0; i < 4; ++i) { p[hd][i] = L[hd * 256 + lane + 64 * i]; m = fmaxf(m, p[hd][i]); }
        m = wave_max(m); float s = 0.f;
#pragma unroll
        for (int i = 0; i < 4; ++i) { p[hd][i] = __expf(p[hd][i] - m); s += p[hd][i]; }
        s = 1.0f / wave_sum(s);
#pragma unroll
        for (int i = 0; i < 4; ++i) p[hd][i] *= s; }
    LAS bf16_t* Pb = (LAS bf16_t*)(wl + 1024);
#pragma unroll
    for (int hd = 0; hd < 8; ++hd)
#pragma unroll
        for (int i = 0; i < 4; ++i) Pb[hd * 256 + lane + 64 * i] = f2bf(p[hd][i]);
    LAS unsigned char* VT = wl + 9216;
    const int ii = lane & 15, kq = lane >> 4;
    f32x4 acc[16];
#pragma unroll
    for (int nt = 0; nt < 16; ++nt) acc[nt] = (f32x4){0.f, 0.f, 0.f, 0.f};
    const int nch = (nsel + 15) >> 4;
    u32x4 vw[3][4];
#define PV_LOAD(buf, c) do { _Pragma("unroll") for (int u = 0; u < 4; ++u) { const unsigned off_ = (unsigned)selw[16 * (c) + 4 * u + kq] * 256u + 16u * (unsigned)ii; vw[buf][u] = *(const u32x4*)((const char*)VC + off_); } } while (0)
#define PV_COMP(buf, c) do { _Pragma("unroll") for (int u = 0; u < 4; ++u) { u32x4 lo_, hi_; fp8x16_to_bf16(vw[buf][u], lo_, hi_); LAS u32x4* d_ = (LAS u32x4*)(VT + (4 * u + kq) * 528 + 32 * ii); d_[0] = lo_; d_[1] = hi_; } \
        s16x4 pa[2]; _Pragma("unroll") for (int g = 0; g < 2; ++g) { const s16x4 r_ = *(const LAS s16x4*)(Pb + (g * 4 + (ii & 3)) * 256 + 16 * (c) + 4 * kq); pa[g] = ii < 4 ? r_ : (s16x4){0, 0, 0, 0}; } \
        _Pragma("unroll") for (int nt = 0; nt < 16; ++nt) { const s16x4 b_ = __builtin_amdgcn_ds_read_tr16_b64_v4i16((LAS s16x4*)(VT + (4 * kq + (ii >> 2)) * 528 + (16 * nt + 4 * (ii & 3)) * 2)); \
            acc[nt] = __builtin_amdgcn_mfma_f32_16x16x16bf16_1k(pa[nt >> 3], b_, acc[nt], 0, 0, 0); } } while (0)
    PV_LOAD(0, 0); if (1 < nch) PV_LOAD(1, 1);
    for (int c = 0; c < nch; c += 3) {
        if (c + 2 < nch) PV_LOAD(2, c + 2);
        __builtin_amdgcn_sched_barrier(0);
        PV_COMP(0, c);
        if (c + 1 < nch) { if (c + 3 < nch) PV_LOAD(0, c + 3); __builtin_amdgcn_sched_barrier(0); PV_COMP(1, c + 1); }
        if (c + 2 < nch) { if (c + 4 < nch) PV_LOAD(1, c + 4); __builtin_amdgcn_sched_barrier(0); PV_COMP(2, c + 2); }
    }
#undef PV_LOAD
#undef PV_COMP
    LAS float* OB = (LAS float*)(wl + 1024 + 4096);
    if (kq == 0) {
#pragma unroll
        for (int nt = 0; nt < 16; ++nt)
#pragma unroll
            for (int r = 0; r < 4; ++r) OB[(4 * (nt >> 3) + r) * 128 + 16 * (nt & 7) + ii] = acc[nt][r];
    }
    {
        const f32x4 a0 = *(const LAS f32x4*)(OB + 16 * lane), a1 = *(const LAS f32x4*)(OB + 16 * lane + 4), a2 = *(const LAS f32x4*)(OB + 16 * lane + 8), a3 = *(const LAS f32x4*)(OB + 16 * lane + 12);
        const f32x4 b0 = a0 * OP8_SCALE, b1 = a1 * OP8_SCALE, b2 = a2 * OP8_SCALE, b3 = a3 * OP8_SCALE;
        *(u32x4*)(ATT + (size_t)t * 1024 + 16 * lane) = (u32x4){pack4_fp8(b0[0], b0[1], b0[2], b0[3]), pack4_fp8(b1[0], b1[1], b1[2], b1[3]), pack4_fp8(b2[0], b2[1], b2[2], b2[3]), pack4_fp8(b3[0], b3[1], b3[2], b3[3])};
    }
}


__device__ __forceinline__ void convert_item8(const float* __restrict__ W, int K, int N, int ld, unsigned char* WT, int mode, int item, int lane, LAS unsigned char* scr) {
    const int nblk = N >> 6; const int kb = item / nblk, nb = item - kb * nblk; const int k0 = kb * 256, n0 = nb * 64;
    const int c4 = lane & 15, kr = lane >> 4;
    const float* src = W + (size_t)(k0 + 4 * kr) * ld + n0 + 4 * c4;
#pragma unroll 4
    for (int i = 0; i < 16; ++i) {
        f32x4 v[4];
#pragma unroll
        for (int r = 0; r < 4; ++r) v[r] = __builtin_nontemporal_load((const f32x4*)(src + (size_t)(16 * i + r) * ld));
        const int kk = 16 * i + 4 * kr;
#pragma unroll
        for (int e = 0; e < 4; ++e) *(LAS unsigned*)(scr + (4 * c4 + e) * 272 + kk) = pack4_fp8(v[0][e] * W8_SCALE, v[1][e] * W8_SCALE, v[2][e] * W8_SCALE, v[3][e] * W8_SCALE);
    }
    LDS_WAIT(); asm volatile("" ::: "memory");
#pragma unroll 4
    for (int j = 0; j < 16; ++j) {
        const int q = j * 64 + lane, n = q >> 4, ch = q & 15;
        const u32x4 v = *(const LAS u32x4*)(scr + n * 272 + ch * 16);
        *(u32x4*)(WT + (size_t)dest_row(mode, n0 + n) * K + k0 + ch * 16) = v;
    }
    LDS_WAIT(); asm volatile("" ::: "memory");
}

struct Conv8Job { const float* W; unsigned char* WT; int N; int mode; size_t w_estride, wt_estride; int items_per_e; };
constexpr int C8_PITCH = 272, C8_IMG = 256 * C8_PITCH;
__device__ __forceinline__ void conv8_load(const Conv8Job& jb, int item, int h, int wave, int lane, f32x4 (&v)[16]) {
    const int e = item / jb.items_per_e, r = item - e * jb.items_per_e; const int nblk = jb.N >> 8; const int kb = r / nblk, nb = r - kb * nblk;
    const float* src = jb.W + (size_t)e * jb.w_estride + (size_t)(kb * 256 + 32 * wave + 16 * h) * jb.N + nb * 256 + 4 * lane;
#pragma unroll
    for (int i = 0; i < 16; ++i) v[i] = __builtin_nontemporal_load((const f32x4*)(src + (size_t)i * jb.N));
}
__device__ __forceinline__ void conv8_to_lds(LAS unsigned char* img, int h, int wave, int lane, const f32x4 (&v)[16]) {
#pragma unroll
    for (int e = 0; e < 4; ++e) { u32x4 w;
#pragma unroll
        for (int g = 0; g < 4; ++g) w[g] = pack4_fp8(v[4 * g][e] * W8_SCALE, v[4 * g + 1][e] * W8_SCALE, v[4 * g + 2][e] * W8_SCALE, v[4 * g + 3][e] * W8_SCALE);
        *(LAS u32x4*)(img + (4 * lane + e) * C8_PITCH + 32 * wave + 16 * h) = w; }
}
__device__ __forceinline__ void conv8_store(const Conv8Job& jb, int item, const LAS unsigned char* img, int tid) {
    const int e = item / jb.items_per_e, r = item - e * jb.items_per_e; const int nblk = jb.N >> 8; const int kb = r / nblk, nb = r - kb * nblk;
    unsigned char* dst = jb.WT + (size_t)e * jb.wt_estride + kb * 256;
#pragma unroll
    for (int j = 0; j < 8; ++j) { const int q = j * 512 + tid, n = q >> 4, ch = q & 15;
        __builtin_nontemporal_store(*(const LAS u32x4*)(img + n * C8_PITCH + ch * 16), (u32x4*)(dst + (size_t)dest_row(jb.mode, nb * 256 + n) * 2048 + ch * 16)); }
}
__device__ __forceinline__ void conv8_run(LAS unsigned char* lds, const Conv8Job& jb, int n_items, int wg, int G, int tid, int wave, int lane) {
    if (wg >= n_items) return;
    f32x4 a[16], b[16]; int par = 0;
    conv8_load(jb, wg, 0, wave, lane, a); conv8_load(jb, wg, 1, wave, lane, b);
    for (int it = wg; it < n_items; it += G, par ^= 1) {
        LAS unsigned char* img = lds + par * C8_IMG;
        const int nx = (it + G < n_items) ? it + G : it;
        conv8_to_lds(img, 0, wave, lane, a); __builtin_amdgcn_sched_barrier(0);
        conv8_load(jb, nx, 0, wave, lane, a); __builtin_amdgcn_sched_barrier(0);
        conv8_to_lds(img, 1, wave, lane, b); __builtin_amdgcn_sched_barrier(0);
        conv8_load(jb, nx, 1, wave, lane, b); __builtin_amdgcn_sched_barrier(0);
        __syncthreads();
        conv8_store(jb, it, img, tid);
    }
    __syncthreads();
}

__global__ void __launch_bounds__(NTHR, 2) fwd_kernel(Args args) {
    extern __shared__ __attribute__((aligned(16))) unsigned char lds_raw[];
    LAS unsigned char* lds = (LAS unsigned char*)lds_raw;
    volatile LAS unsigned* MISC = (volatile LAS unsigned*)(lds + LDS_MISC);
    const int tid = threadIdx.x, lane = tid & 63, wave = __builtin_amdgcn_readfirstlane(tid >> 6);
    const int G = gridDim.x, wg = blockIdx.x;
    unsigned char* ws = args.ws;
    unsigned* ctl = (unsigned*)(ws + WS_CTL);
    const int lo = args.ph_lo, hi = args.ph_hi;
    const float* x = (const float*)args.in[0]; const float* cvec = (const float*)args.in[1]; const int* positions = (const int*)args.in[2];
    const float* w_ada = (const float*)args.in[3]; const float* b_ada = (const float*)args.in[4]; const float* norm1_g = (const float*)args.in[5];
    const float* w_in = (const float*)args.in[6]; const float* idx_knorm_g = (const float*)args.in[7]; const float* idx_knorm_b = (const float*)args.in[8];
    const float* lb_logits = (const float*)args.in[9]; const float* hgrn_norm_g = (const float*)args.in[10];
    const float* w_proj_att = (const float*)args.in[11]; const float* w_proj_hgrn = (const float*)args.in[12]; const float* w_out = (const float*)args.in[13];
    const float* norm2_g = (const float*)args.in[14]; const float* w_router = (const float*)args.in[15]; const float* b_router = (const float*)args.in[16];
    const float* w1 = (const float*)args.in[17]; const float* b1 = (const float*)args.in[18]; const float* w2 = (const float*)args.in[19]; const float* b2 = (const float*)args.in[20];
    const float* final_g = (const float*)args.in[21];
    float* out = args.out;
    float* MOD = (float*)(ws + WS_MOD); int* TOPE = (int*)(ws + WS_TOPE); float* GATE = (float*)(ws + WS_GATE); int* SLOT = (int*)(ws + WS_SLOT);
    bf16_t* WIN_T = (bf16_t*)(ws + WS_WIN_T); bf16_t* WA_T = (bf16_t*)(ws + WS_WA_T); bf16_t* WH_T = (bf16_t*)(ws + WS_WH_T); bf16_t* WO_T = (bf16_t*)(ws + WS_WO_T);
    unsigned char* WIN_T8 = ws + WS_WIN_T + 8 * MiB;
    unsigned char* HA8 = ws + WS_SCORES;
    unsigned char* W1_T = ws + WS_W1_T; unsigned char* W2_T = ws + WS_W2_T;
    bf16_t* HB = (bf16_t*)(ws + WS_H); bf16_t* PROJ = (bf16_t*)(ws + WS_PROJ);
    bf16_t* DELTA = (bf16_t*)(ws + WS_ATT);
    unsigned char* ACT = ws + WS_ACT; bf16_t* YB = (bf16_t*)(ws + WS_YB);
    int* TOKS = (int*)(ws + WS_TOKS);
    unsigned char* H8 = ws + WS_H;
    bf16_t* KI = (bf16_t*)(ws + WS_KI); unsigned char* KC = ws + WS_KC; unsigned char* VC = ws + WS_VC;
    float* ST = (float*)(ws + WS_ST); float* DC = (float*)(ws + WS_DC);
    unsigned char* ATT = ws + WS_ATT; unsigned char* REC = ATT + (size_t)S * 1024;        bf16_t* MERGED = (bf16_t*)(ws + WS_MERGED); unsigned short* SCORES = (unsigned short*)(ws + WS_SCORES);
    unsigned short* SEGMAX = (unsigned short*)(ws + WS_X1);

    for (int u = tid; u < 128; u += NTHR) MISC[u] = 0u;
    __syncthreads();
    const bool one_launch = (hi - lo) > 1;
    XcdBarrier bar; bar.bar = ctl + CW_BAR; bar.x = 0; bar.st = MISC + 8;
    if (one_launch) bar = xcd_barrier_post(ctl + CW_BAR, MISC + 8);
#define IN(k) (lo <= (k) && (k) < hi)
#define SEAM(k) do { if (IN(k) && IN((k) + 1)) xcd_barrier(bar); } while (0)


    if (IN(PH_PRO)) {
        for (int cb = wg; cb < 256; cb += G) {
            LAS float* red = (LAS float*)lds;
            const int c4 = tid % 12, kg = tid / 12;
            f32x4 acc = (f32x4){0.f, 0.f, 0.f, 0.f};
            if (kg < 42) {
                const float* wp = w_ada + (size_t)cb * 48 + 4 * c4;
#pragma unroll 7
                for (int j = 0; j < 49; ++j) { const int k = kg + 42 * j; if (k < D) { const f32x4 v = __builtin_nontemporal_load((const f32x4*)(wp + (size_t)k * (6 * D))); acc += siluf_(cvec[k]) * v; } }
                *(LAS f32x4*)(red + kg * 48 + 4 * c4) = acc;
            }
            __syncthreads();
            if (tid < 48) { float s = b_ada[cb * 48 + tid];
#pragma unroll 6
                for (int q = 0; q < 42; ++q) s += red[q * 48 + tid];
                MOD[cb * 48 + tid] = s; }
            __syncthreads();
        }
        LAS unsigned char* scr = lds + wave * 17408;
        const int gw = wg * NWAVES + wave, NGW = G * NWAVES;
        {
            constexpr int NB_IN = (1104 + 63) / 64;
            for (int it = gw; it < 16 * NB_IN; it += NGW) convert_item(w_in + 1536, 2048, 1104, DIN, WIN_T, 0, it, lane, scr);
            for (int it = gw; it < 4 * 32; it += NGW) convert_item8(w_proj_att, 1024, 2048, 2048, (unsigned char*)WA_T, 0, it, lane, scr);
            for (int it = gw; it < 4 * 32; it += NGW) convert_item8(w_proj_hgrn, 1024, 2048, 2048, (unsigned char*)WA_T + (size_t)2048 * 1024, 0, it, lane, scr);
            for (int it = gw; it < 8 * 32; it += NGW) convert_item8(w_out, 2048, 2048, 2048, (unsigned char*)WO_T, 0, it, lane, scr);
            for (int it = gw; it < 8 * 24; it += NGW) convert_item8(w_in, 2048, 1536, DIN, WIN_T8, 0, it, lane, scr);
            for (int it = gw; it < 8 * 128; it += NGW) convert_item8(w_in + 2640, 2048, 8192, DIN, WIN_T8 + (size_t)1536 * 2048, 0, it, lane, scr);
            for (size_t i = (size_t)wg * NTHR + tid; i < (size_t)176 * 2048 * 2 / 16; i += (size_t)G * NTHR) ((u32x4*)(WIN_T + (size_t)1104 * 2048))[i] = (u32x4){0u, 0u, 0u, 0u};
        }
    }
    SEAM(PH_PRO);

    {
    if (IN(PH_H)) {
        const float* sh1 = MOD; const float* sc1 = MOD + D;
        const int gw = wg * NWAVES + wave, NGW = G * NWAVES;
        f32x4 gs[8], sh[8];
#pragma unroll
        for (int j = 0; j < 8; ++j) { const int c = 4 * lane + 256 * j; const f32x4 g = *(const f32x4*)(norm1_g + c), sc = *(const f32x4*)(sc1 + c); sh[j] = *(const f32x4*)(sh1 + c);
#pragma unroll
            for (int e = 0; e < 4; ++e) gs[j][e] = g[e] * (1.0f + sc[e]); }
        for (int t = gw; t < S; t += NGW) {
            const f32x4* xr = (const f32x4*)(x + (size_t)t * D) + lane;
            f32x4 v[8]; float ss = 0.f;
#pragma unroll
            for (int j = 0; j < 8; ++j) { v[j] = xr[64 * j]; ss += (v[j][0] * v[j][0] + v[j][1] * v[j][1]) + (v[j][2] * v[j][2] + v[j][3] * v[j][3]); }
            const float rstd = rsqrtf(wave_sum(ss) * (1.0f / D) + NORM_EPS);
#pragma unroll
            for (int j = 0; j < 8; ++j) { const f32x4 h = v[j] * rstd * gs[j] + sh[j]; u32x2 w; w.x = cvt_pk_bf16(h[0], h[1]); w.y = cvt_pk_bf16(h[2], h[3]);
                *(u32x2*)(HB + (size_t)t * D + 4 * lane + 256 * j) = w;
                *(unsigned*)(HA8 + (size_t)t * D + 4 * lane + 256 * j) = pack4_fp8(h[0], h[1], h[2], h[3]); }
        }
    }
    SEAM(PH_H);
    if (IN(PH_INPROJ)) {
        const int XC = (G == 256) ? XCONV : 0;
        const Conv8Job j1{w1, W1_T, 4096, 2, (size_t)2048 * 4096, (size_t)4096 * 2048, 8 * 16};
        const Conv8Job j2{w2, W2_T, 2048, 0, (size_t)2048 * 2048, (size_t)2048 * 2048, 8 * 8};
        if (G != 256) { conv8_run(lds, j1, NEXP * 8 * 16, wg, G, tid, wave, lane); conv8_run(lds, j2, NEXP * 8 * 8, wg, G, tid, wave, lane); }
        if (wg < XC) { conv8_run(lds, j1, NEXP * 8 * 16, wg, XC, tid, wave, lane); conv8_run(lds, j2, NEXP * 8 * 8, wg, XC, tid, wave, lane); }
        else {
            const int Gg = G - XC, cg = wg - XC;
            {
                pg8::Gemm g8{HA8, WIN_T8, 2048, 0, nullptr, 0}; pg8::StaticOrder S8; S8.init(S, 9728, Gg, cg);
                const int full8 = 2432 / Gg, rem8 = 2432 - full8 * Gg;
                if (Gg == 256) S8.skew(8, (wg >= 128 && wg < 192) ? -1 : (wg < 128 ? wg : wg - 64), 192);
                else if (rem8 > 0) S8.skew(full8, cg < rem8 ? cg : -1, rem8);
                pg8::EpiBf16 E8{PROJ, DINP, nullptr, 0, 1.0f / W8_SCALE, 6, 1280};
                pg8::gemm_phase<pg8::EpiBf16, pg8::StaticOrder, true>(lds, g8, S8, E8);
            }
            {
                pg8::Gemm g{HB, WIN_T, 2048, 0, nullptr, 0}; pg8::StaticOrder So; So.init(S, 1280, Gg, Gg == 256 ? (wg + 128) % G : (cg + Gg - (2432 % Gg)) % Gg);
                pg8::EpiBf16 E{PROJ + CQI, DINP, nullptr, 0, 1.0f, 1 << 30, 0};
                pg8::gemm_phase<pg8::EpiBf16, pg8::StaticOrder>(lds, g, So, E);
            }
        }
    }
    SEAM(PH_INPROJ);
    if (IN(PH_POST)) {
        const int gw = wg * NWAVES + wave, NGW = G * NWAVES;
        for (int t = gw; t < S; t += NGW) post_token(PROJ, KI, KC, VC, positions, idx_knorm_g, idx_knorm_b, t, lane);
        __syncthreads();
        for (int u = wg; u < 2048; u += G) hgrn_l1(lds, PROJ, lb_logits, ST, DC, u >> 3, u & 7, tid, wave, lane);
    }
    SEAM(PH_POST);
    if (IN(PH_SCORE)) {
        for (int idx = wg * NTHR + tid; idx < 8 * 128 * 128; idx += G * NTHR) {
            const int h = idx >> 14, d = idx & 127; float s = 0.f;
            float* sp = ST + idx; const float* dp = DC + h * 128 + d;
            for (int c = 0; c < 256; c += 8) {
                float l[8], dc[8];
#pragma unroll
                for (int i = 0; i < 8; ++i) { l[i] = sp[(size_t)(c + i) * 131072]; dc[i] = dp[(size_t)(c + i) * 1024]; }
#pragma unroll
                for (int i = 0; i < 8; ++i) { sp[(size_t)(c + i) * 131072] = s; s = dc[i] * s + l[i]; }
            }
        }
        {
            const int XS = (G == 256) ? XSCORE : 0;
            if (wg < XS) {
                const Conv8Job j1{w1, W1_T, 4096, 2, (size_t)2048 * 4096, (size_t)4096 * 2048, 8 * 16};
                const Conv8Job j2{w2, W2_T, 2048, 0, (size_t)2048 * 2048, (size_t)2048 * 2048, 8 * 8};
                __syncthreads();
                conv8_run(lds, j1, NEXP * 8 * 16, wg, XS, tid, wave, lane); conv8_run(lds, j2, NEXP * 8 * 8, wg, XS, tid, wave, lane);
            }
            for (;;) {
                if (tid == 0) MISC[100] = __hip_atomic_fetch_add(ctl + CW_SCQ, 1u, __ATOMIC_RELAXED, __HIP_MEMORY_SCOPE_AGENT);
                __syncthreads();
                const int item = (int)MISC[100];
                __syncthreads();
                if (item >= 252 * 6) break;
                int j, lo, hi;
                if (item < 504) { j = item >> 1; const int T = ((8 + j) >> 2) + ((511 - j) >> 2) + 2; const int p = item & 1; lo = p * T / 3; hi = (p + 1) * T / 3; }
                else { const int i2 = item - 504; j = i2 >> 2; const int T = ((8 + j) >> 2) + ((511 - j) >> 2) + 2; const int p = i2 & 3, b = 2 * T / 3; lo = b + p * (T - b) / 4; hi = b + (p + 1) * (T - b) / 4; }
                const int qa = 8 + j, qb2 = 511 - j, na = (qa >> 2) + 1;
                const int a0 = lo < na ? lo : na, a1 = hi < na ? hi : na, b0 = (lo > na ? lo : na) - na, b1 = (hi > na ? hi : na) - na;
                if (a1 > a0) score_block(lds, PROJ, KI, SCORES, SEGMAX, qa, a0, a1, tid, wave, lane);
                if (b1 > b0) score_block(lds, PROJ, KI, SCORES, SEGMAX, qb2, b0, b1, tid, wave, lane);
            }
        }
    }
    SEAM(PH_SCORE);
    if (IN(PH_ATTN)) {
        const int gw = wg * NWAVES + wave, NGW = G * NWAVES;
        for (int u = wg; u < 2048; u += G) hgrn_l3(lds, PROJ, lb_logits, ST, hgrn_norm_g, REC, u >> 3, u & 7, tid, wave, lane);
        {
            for (;;) {
                unsigned tq = 0; if (lane == 0) tq = __hip_atomic_fetch_add(ctl + CW_ATQ, 1u, __ATOMIC_RELAXED, __HIP_MEMORY_SCOPE_AGENT);
                tq = (unsigned)__builtin_amdgcn_readfirstlane((int)tq);
                if (tq >= (unsigned)S) break;
                const int t = S - 1 - (int)tq;
                LAS unsigned char* wl = lds + wave * 17664;
                if (t >= 256) select_row(wl, SCORES, SEGMAX, t, lane);
                else {
#pragma unroll
                    for (int i = 0; i < 4; ++i) { const int idx = lane + 64 * i; ((LAS int*)wl)[idx] = idx <= t ? idx : 0; }
                }
                attn_query(wl, PROJ, KC, VC, ATT, t, lane);
            }
        }
    }
    SEAM(PH_ATTN);
    if (IN(PH_OP1)) {
        pg8::Gemm g{ATT, WA_T, 1024, (size_t)2048 * 1024, nullptr, (size_t)S * 1024};
        pg8::TwoPartOrder So; So.init(S, 2048, G, wg);
        pg8::EpiGate2 E{(unsigned char*)MERGED, PROJ + CGA, PROJ + CGR};
        pg8::gemm_phase<pg8::EpiGate2, pg8::TwoPartOrder, true>(lds, g, So, E);
    }
    SEAM(PH_OP2);
    if (IN(PH_WOUT)) {
        pg8::Gemm g{MERGED, WO_T, 2048, 0, nullptr, 0}; pg8::StaticOrder So; So.init(S, 2048, G, wg);
        pg8::EpiDelta E{MOD + 2 * D, DELTA, 1.0f / (W8_SCALE * MRG8_SCALE)};
        pg8::gemm_phase<pg8::EpiDelta, pg8::StaticOrder, true>(lds, g, So, E);
    }
    SEAM(PH_WOUT);
    }

    if (IN(PH_ROUTER)) {
        LAS float* hs = (LAS float*)lds;
        volatile LAS unsigned* lcnt = MISC + 32;
        const float* sh2 = MOD + 3 * D; const float* sc2 = MOD + 4 * D;
        if (tid < 32) lcnt[tid] = 0u;
        __syncthreads();
        for (int grp = wg; grp < S / 16; grp += G) {
#pragma unroll 1
            for (int q = 0; q < 2; ++q) {
                const int tl = 2 * wave + q, t = grp * 16 + tl;
                const f32x4* xr = (const f32x4*)(x + (size_t)t * D) + lane; const u32x2* dr = (const u32x2*)(DELTA + (size_t)t * D) + lane;
                f32x4 v[8]; float ss = 0.f;
#pragma unroll
                for (int j = 0; j < 8; ++j) { const u32x2 dw = dr[64 * j]; v[j] = xr[64 * j] + (f32x4){bf_lo(dw.x), bf_hi(dw.x), bf_lo(dw.y), bf_hi(dw.y)};
                    ss += (v[j][0] * v[j][0] + v[j][1] * v[j][1]) + (v[j][2] * v[j][2] + v[j][3] * v[j][3]); }
                const float rstd = rsqrtf(wave_sum(ss) * (1.0f / D) + NORM_EPS);
#pragma unroll
                for (int j = 0; j < 8; ++j) {
                    const int c = 4 * lane + 256 * j;
                    const f32x4 g = *(const f32x4*)(norm2_g + c), sc = *(const f32x4*)(sc2 + c), sh = *(const f32x4*)(sh2 + c);
                    f32x4 h;
#pragma unroll
                    for (int e = 0; e < 4; ++e) h[e] = v[j][e] * rstd * g[e] * (1.0f + sc[e]) + sh[e];
                    *(LAS f32x4*)(hs + tl * 2048 + c) = h;
                    *(unsigned*)(H8 + (size_t)t * D + c) = pack4_fp8(h[0], h[1], h[2], h[3]);
                }
            }
            __syncthreads();
            {
                LAS float* part = (LAS float*)(lds + 131072);
                const int fr = lane & 15, fq = lane >> 4;
                f32x4 acc0 = (f32x4){0.f, 0.f, 0.f, 0.f}, acc1 = acc0;
                const LAS float* hrow = hs + fr * 2048 + wave * 256 + 4 * fq; const float* wrp = w_router + (size_t)(wave * 256 + 4 * fq) * 32 + fr;
#pragma unroll 2
                for (int i = 0; i < 16; ++i) {
                    const f32x4 a4 = *(const LAS f32x4*)(hrow + 16 * i);
                    float b0[4], b1[4];
#pragma unroll
                    for (int s = 0; s < 4; ++s) { b0[s] = wrp[(size_t)(16 * i + s) * 32]; b1[s] = wrp[(size_t)(16 * i + s) * 32 + 16]; }
#pragma unroll
                    for (int s = 0; s < 4; ++s) { acc0 = __builtin_amdgcn_mfma_f32_16x16x4f32(a4[s], b0[s], acc0, 0, 0, 0); acc1 = __builtin_amdgcn_mfma_f32_16x16x4f32(a4[s], b1[s], acc1, 0, 0, 0); }
                }
#pragma unroll
                for (int r = 0; r < 4; ++r) { part[(wave * 16 + 4 * fq + r) * 32 + fr] = acc0[r]; part[(wave * 16 + 4 * fq + r) * 32 + 16 + fr] = acc1[r]; }
                __syncthreads();
                const int tl = tid >> 5, e = tid & 31, t = grp * 16 + tl;
                float v = b_router[e];
#pragma unroll
                for (int w = 0; w < 8; ++w) v += part[(w * 16 + tl) * 32 + e];
                float tv[4]; int ti[4];
#pragma unroll
                for (int k = 0; k < 4; ++k) {
                    float bv = v; int bi = e;
#pragma unroll
                    for (int o = 16; o >= 1; o >>= 1) { const float ov = __shfl_xor(bv, o); const int oi = __shfl_xor(bi, o); if (ov > bv || (ov == bv && oi < bi)) { bv = ov; bi = oi; } }
                    tv[k] = bv; ti[k] = bi; if (e == bi) v = -__builtin_inff();
                }
                if (e == 0) {
                    const float e1 = __expf(tv[1] - tv[0]), e2 = __expf(tv[2] - tv[0]), e3 = __expf(tv[3] - tv[0]); const float inv = 1.0f / (1.0f + e1 + e2 + e3);
                    *(int4*)(TOPE + (size_t)t * 4) = make_int4(ti[0], ti[1], ti[2], ti[3]);
                    *(f32x4*)(GATE + (size_t)t * 4) = (f32x4){inv, e1 * inv, e2 * inv, e3 * inv};
#pragma unroll
                    for (int k = 0; k < 4; ++k) __hip_atomic_fetch_add((LAS unsigned*)&lcnt[ti[k]], 1u, __ATOMIC_RELAXED, __HIP_MEMORY_SCOPE_WORKGROUP);
                }
            }
            __syncthreads();
        }
        if (tid < 32) { const unsigned c = lcnt[tid]; if (c) __hip_atomic_fetch_add(ctl + CW_CNT + tid, c, __ATOMIC_RELAXED, __HIP_MEMORY_SCOPE_AGENT); }
    }
    SEAM(PH_ROUTER);

    if (IN(PH_SCATTER)) {
        volatile LAS unsigned* lcnt = MISC + 32; volatile LAS unsigned* lbase = MISC + 64; LAS int* pstart = (LAS int*)(lds + 1024); LAS int* pcnt = (LAS int*)(lds + 1280);
        if (tid == 0) { int p = 0; for (int e = 0; e < NEXP; ++e) { const int c = (int)__hip_atomic_load(ctl + CW_CNT + e, __ATOMIC_RELAXED, __HIP_MEMORY_SCOPE_AGENT); pstart[e] = p; pcnt[e] = c; p += (c + 255) & ~255; } }
        if (tid < 32) lcnt[tid] = 0u;
        __syncthreads();
        if (wg < NEXP) { const int e = wg; for (int s = pstart[e] + pcnt[e] + tid; s < pstart[e] + ((pcnt[e] + 255) & ~255); s += NTHR) TOKS[s] = 0; }
        for (int blk = wg; blk < S / 64; blk += G) {
            int e = 0, lrank = 0;
            if (tid < 256) { e = TOPE[(size_t)blk * 256 + tid]; lrank = (int)__hip_atomic_fetch_add((LAS unsigned*)&lcnt[e], 1u, __ATOMIC_RELAXED, __HIP_MEMORY_SCOPE_WORKGROUP); }
            __syncthreads();
            if (tid < 32) { const unsigned c = lcnt[tid]; lbase[tid] = c ? __hip_atomic_fetch_add(ctl + CW_FILL + tid, c, __ATOMIC_RELAXED, __HIP_MEMORY_SCOPE_AGENT) : 0u; }
            __syncthreads();
            if (tid < 256) { const int slot = pstart[e] + (int)lbase[e] + lrank; SLOT[(size_t)blk * 256 + tid] = slot; TOKS[slot] = blk * 64 + (tid >> 2); }
            __syncthreads();
            if (tid < 32) lcnt[tid] = 0u;
            __syncthreads();
        }
    }
    SEAM(PH_SCATTER);

    if (IN(PH_MOE1) || IN(PH_MOE2)) {
        LAS int* panel_e = (LAS int*)(lds + 131072 + 2048);
        LAS int* npan = (LAS int*)(lds + 131072 + 2048 + 2048);
        __syncthreads();
        if (tid == 0) { int p = 0; for (int e = 0; e < NEXP; ++e) { const int np = (int)((__hip_atomic_load(ctl + CW_CNT + e, __ATOMIC_RELAXED, __HIP_MEMORY_SCOPE_AGENT) + 255u) >> 8); for (int q = 0; q < np; ++q) panel_e[p + q] = e; p += np; } npan[0] = p; }
        __syncthreads();
        const int nPanels = npan[0];
        if (IN(PH_MOE1)) {
            pg8::Gemm g{H8, W1_T, 2048, (size_t)4096 * 2048, TOKS, 0}; pg8::MoeOrder So; So.init(nPanels, 16, G, wg, panel_e);
            pg8::EpiSwiglu E{ACT, b1};
            pg8::gemm_phase<pg8::EpiSwiglu, pg8::MoeOrder, true>(lds, g, So, E);
        }
        SEAM(PH_MOE1);
        if (IN(PH_MOE2)) {
            pg8::Gemm g{ACT, W2_T, 2048, (size_t)2048 * 2048, nullptr, 0}; pg8::MoeOrder So; So.init(nPanels, 8, G, wg, panel_e);
            pg8::EpiBf16 E{YB, 2048, b2, 2048, 1.0f / (W8_SCALE * ACT8_SCALE), 1 << 30, 0};
            pg8::gemm_phase<pg8::EpiBf16, pg8::MoeOrder, true>(lds, g, So, E);
        }
    }
    SEAM(PH_MOE2);

    if (IN(PH_FINAL)) {
        const float* gt2 = MOD + 5 * D;
        const int gw = wg * NWAVES + wave, NGW = G * NWAVES;
        for (int t = gw; t < S; t += NGW) {
            const f32x4* xr = (const f32x4*)(x + (size_t)t * D) + lane; const u32x2* dr = (const u32x2*)(DELTA + (size_t)t * D) + lane;
            f32x4 v[8];
#pragma unroll
            for (int j = 0; j < 8; ++j) { const u32x2 dw = dr[64 * j]; v[j] = xr[64 * j] + (f32x4){bf_lo(dw.x), bf_hi(dw.x), bf_lo(dw.y), bf_hi(dw.y)}; }
            {
                f32x4 m[8];
#pragma unroll
                for (int j = 0; j < 8; ++j) m[j] = (f32x4){0.f, 0.f, 0.f, 0.f};
                const int4 sl = *(const int4*)(SLOT + (size_t)t * 4); const f32x4 gt = *(const f32x4*)(GATE + (size_t)t * 4);
                const int sls[4] = {sl.x, sl.y, sl.z, sl.w};
#pragma unroll
                for (int k = 0; k < 4; ++k) {
                    const u32x2* yr = (const u32x2*)(YB + (size_t)sls[k] * D) + lane; const float gk = gt[k];
#pragma unroll
                    for (int j = 0; j < 8; ++j) { const u32x2 w = yr[64 * j]; m[j][0] += gk * bf_lo(w.x); m[j][1] += gk * bf_hi(w.x); m[j][2] += gk * bf_lo(w.y); m[j][3] += gk * bf_hi(w.y); }
                }
#pragma unroll
                for (int j = 0; j < 8; ++j) { const f32x4 g2 = *(const f32x4*)(gt2 + 4 * lane + 256 * j); v[j] = v[j] + g2 * m[j]; }
            }
            float ss = 0.f;
#pragma unroll
            for (int j = 0; j < 8; ++j) ss += (v[j][0] * v[j][0] + v[j][1] * v[j][1]) + (v[j][2] * v[j][2] + v[j][3] * v[j][3]);
            const float rstd = rsqrtf(wave_sum(ss) * (1.0f / D) + NORM_EPS);
            f32x4* orow = (f32x4*)(out + (size_t)t * D) + lane;
#pragma unroll
            for (int j = 0; j < 8; ++j) { const f32x4 fg = *(const f32x4*)(final_g + 4 * lane + 256 * j); orow[64 * j] = v[j] * rstd * fg; }
        }
    }
#undef IN
#undef SEAM
}

#ifndef MK_ONE_LAUNCH
#define MK_ONE_LAUNCH 1
#endif
extern "C" void kernel_launch(void* const* d_in, const int* in_sizes, int n_in, void* d_out, int out_size, void* d_ws, size_t ws_size, hipStream_t stream) {
    static int grid = 0;
    if (grid == 0) {
        if (n_in != 22 || out_size != S * D || ws_size < WS_END) { fprintf(stderr, "kernel_launch: unexpected shapes: n_in %d out %d ws %zu (need %zu)\n", n_in, out_size, ws_size, (size_t)WS_END); grid = -1; return; }
        int dev = 0, cus = 0, per_cu = 0;
        if (hipGetDevice(&dev) != hipSuccess || hipDeviceGetAttribute(&cus, hipDeviceAttributeMultiprocessorCount, dev) != hipSuccess) { grid = -1; return; }
        if (hipFuncSetAttribute((const void*)fwd_kernel, hipFuncAttributeMaxDynamicSharedMemorySize, LDS_BYTES) != hipSuccess) { fprintf(stderr, "kernel_launch: hipFuncSetAttribute failed\n"); grid = -1; return; }
        if (hipOccupancyMaxActiveBlocksPerMultiprocessor(&per_cu, (const void*)fwd_kernel, NTHR, LDS_BYTES) != hipSuccess || per_cu < 1) { fprintf(stderr, "kernel_launch: occupancy query says %d\n", per_cu); (void)hipGetLastError(); grid = -1; return; }
        grid = cus;
    }
    if (grid < 0) return;
    (void)in_sizes;
    hipMemsetAsync((char*)d_ws + WS_CTL, 0, CTL_BYTES, stream);
    Args a{};
    for (int i = 0; i < 22; ++i) a.in[i] = d_in[i];
    a.out = (float*)d_out; a.ws = (unsigned char*)d_ws; a.flags = 0; a.pad = 0;
#if MK_ONE_LAUNCH
    a.ph_lo = 0; a.ph_hi = NPH;
    hipLaunchKernelGGL(fwd_kernel, dim3(grid), dim3(NTHR), LDS_BYTES, stream, a);
#else
    for (int p = 0; p < NPH; ++p) { a.ph_lo = p; a.ph_hi = p + 1; hipLaunchKernelGGL(fwd_kernel, dim3(grid), dim3(NTHR), LDS_BYTES, stream, a); }
#endif
}
```

```cpp
#include <hip/hip_runtime.h>
#include <cstdio>
#include <cstdint>

#define GAS __attribute__((address_space(1)))
#define LAS __attribute__((address_space(3)))
typedef unsigned short bf16_t;
typedef short bf16x8 __attribute__((ext_vector_type(8)));
typedef float f32x4 __attribute__((ext_vector_type(4)));
typedef float f32x2 __attribute__((ext_vector_type(2)));
typedef float f32x16 __attribute__((ext_vector_type(16)));
typedef unsigned u32x4 __attribute__((ext_vector_type(4)));
typedef unsigned u32x2 __attribute__((ext_vector_type(2)));
typedef int i32x4 __attribute__((ext_vector_type(4)));
typedef int i32x8 __attribute__((ext_vector_type(8)));
typedef short s16x4 __attribute__((ext_vector_type(4)));
typedef short s16x2 __attribute__((ext_vector_type(2)));

constexpr int S = 16384, D = 2048, DIN = 10832, DINP = 11008, NEXP = 32, DFF = 2048;
constexpr int NWAVES = 8, NTHR = 512;
constexpr int CQ = 0, CK = 1024, CV = 1280, CQI = 1536, CKI = 2560, CWI = 2624, CHQ = 2816, CHF = 3840, CHI = 4864, CHG = 5888, CGA = 6912, CGR = 8960;
constexpr int PMAX = 65536 + NEXP * 256;
constexpr float NORM_EPS = 1e-5f;

constexpr size_t MiB = 1u << 20;
constexpr size_t al256(size_t x) { return (x + 255) & ~(size_t)255; }
constexpr size_t WS_CTL = 0, CTL_BYTES = 1 * MiB;
constexpr size_t WS_MOD = WS_CTL + CTL_BYTES;
constexpr size_t WS_TOPE = WS_MOD + 64 * 1024;
constexpr size_t WS_GATE = WS_TOPE + (size_t)S * 16;
constexpr size_t WS_SLOT = WS_GATE + (size_t)S * 16;
constexpr size_t WS_WIN_T = WS_SLOT + (size_t)S * 16;
constexpr size_t WS_WA_T = WS_WIN_T + (size_t)DINP * D * 2;
constexpr size_t WS_WH_T = WS_WA_T + (size_t)2048 * 1024 * 2;
constexpr size_t WS_WO_T = WS_WH_T + (size_t)2048 * 1024 * 2;
constexpr size_t WS_W1_T = WS_WO_T + (size_t)2048 * 2048 * 2;
constexpr size_t WS_W2_T = WS_W1_T + (size_t)NEXP * 4096 * 2048 * 2;
constexpr size_t WS_H = WS_W2_T + (size_t)NEXP * 2048 * 2048 * 2;
constexpr size_t WS_PROJ = WS_H + (size_t)S * D * 2;
constexpr size_t WS_KI = WS_PROJ + (size_t)S * DINP * 2;
constexpr size_t WS_KC = WS_KI + (size_t)S * 64 * 2;
constexpr size_t WS_VC = WS_KC + (size_t)S * 256 * 2;
constexpr size_t WS_ST = WS_VC + (size_t)S * 256 * 2;
constexpr size_t WS_DC = WS_ST + (size_t)256 * 8 * 128 * 128 * 4;
constexpr size_t WS_SEL = WS_DC + (size_t)256 * 8 * 128 * 4;
constexpr size_t WS_ATT = WS_SEL + (size_t)S * 256 * 4;
constexpr size_t WS_REC = WS_ATT + (size_t)S * 1024 * 2;
constexpr size_t WS_MERGED = WS_REC + (size_t)S * 1024 * 2;
constexpr size_t WS_X1 = WS_MERGED + (size_t)S * 2048 * 2;
constexpr size_t WS_SCORES = WS_X1 + (size_t)S * 2048 * 4;
constexpr size_t WS_XB = WS_SCORES;
constexpr size_t WS_ACT = WS_XB + (size_t)PMAX * 2048 * 2;
constexpr size_t WS_YB = WS_ACT + (size_t)PMAX * 2048 * 2;
constexpr size_t WS_END = WS_SCORES + (size_t)S * S * 4;
static_assert(WS_YB + (size_t)PMAX * 2048 * 2 <= WS_END, "MoE buffers overlay the score matrix");
static_assert(WS_END <= (size_t)4096 * MiB, "workspace");
constexpr int CW_BAR = 4096, CW_CNT = 8192, CW_FILL = 8448;
constexpr size_t WS_TOKS = WS_SEL;

constexpr int LDS_BYTES = 155648;
constexpr int LDS_MISC = LDS_BYTES - 512;

__device__ __forceinline__ unsigned cvt_pk_bf16(float lo, float hi) { unsigned r; asm volatile("v_cvt_pk_bf16_f32 %0, %1, %2" : "=v"(r) : "v"(lo), "v"(hi)); return r; }
__device__ __forceinline__ float bf_lo(unsigned u) { return __uint_as_float(u << 16); }
__device__ __forceinline__ float bf_hi(unsigned u) { return __uint_as_float(u & 0xffff0000u); }
__device__ __forceinline__ float bf2f(bf16_t b) { return __uint_as_float(((unsigned)b) << 16); }
__device__ __forceinline__ float wave_sum(float v) {
#define DPPS(ctrl, rmask) { const int s_ = __builtin_amdgcn_update_dpp(0, __float_as_int(v), ctrl, rmask, 0xF, false); v += __int_as_float(s_); }
    DPPS(0x111, 0xF) DPPS(0x112, 0xF) DPPS(0x114, 0xF) DPPS(0x118, 0xF) DPPS(0x142, 0xA) DPPS(0x143, 0xC)
#undef DPPS
    return __int_as_float(__builtin_amdgcn_readlane(__float_as_int(v), 63));
}
__device__ __forceinline__ float wave_max(float v) {
#define DPPM(ctrl, rmask) { const int o_ = __float_as_int(v); const int s_ = __builtin_amdgcn_update_dpp(o_, o_, ctrl, rmask, 0xF, false); v = fmaxf(v, __int_as_float(s_)); }
    DPPM(0x111, 0xF) DPPM(0x112, 0xF) DPPM(0x114, 0xF) DPPM(0x118, 0xF) DPPM(0x142, 0xA) DPPM(0x143, 0xC)
#undef DPPM
    return __int_as_float(__builtin_amdgcn_readlane(__float_as_int(v), 63));
}
__device__ __forceinline__ float sigmoidf_(float x) { return __builtin_amdgcn_rcpf(1.0f + __expf(-x)); }
__device__ __forceinline__ float siluf_(float x) { return x * __builtin_amdgcn_rcpf(1.0f + __expf(-x)); }
__device__ __forceinline__ unsigned pack4_fp8(float a, float b, float c, float d) { int w = 0; w = __builtin_amdgcn_cvt_pk_fp8_f32(a, b, w, false); w = __builtin_amdgcn_cvt_pk_fp8_f32(c, d, w, true); return (unsigned)w; }
constexpr float W8_SCALE = 64.0f, ACT8_SCALE = 4.0f, MRG8_SCALE = 8.0f, OP8_SCALE = 16.0f;
__device__ __forceinline__ float relu_i(float x) { const int i = __float_as_int(x); return __int_as_float(i > 0 ? i : 0); }
__device__ __forceinline__ void fp8x16_to_bf16(const u32x4& w, u32x4& lo, u32x4& hi) {
    unsigned o[8];
#pragma unroll
    for (int q = 0; q < 4; ++q) { const unsigned wq = w[q]; const f32x2 a = __builtin_amdgcn_cvt_pk_f32_fp8((int)wq, false), b = __builtin_amdgcn_cvt_pk_f32_fp8((int)wq, true);
        o[2 * q] = cvt_pk_bf16(a[0], a[1]); o[2 * q + 1] = cvt_pk_bf16(b[0], b[1]); }
    lo = (u32x4){o[0], o[1], o[2], o[3]}; hi = (u32x4){o[4], o[5], o[6], o[7]};
}
__device__ __forceinline__ unsigned char fp8_1(float x) { return (unsigned char)(__builtin_amdgcn_cvt_pk_fp8_f32(x, x, 0, false) & 0xff); }
#define LDS_WAIT() asm volatile("s_waitcnt lgkmcnt(0)" ::: "memory")
#define VM_WAIT() asm volatile("s_waitcnt vmcnt(0)" ::: "memory")

#define XB_TMO      128
#define XB_XCNT(j)  (256  + 64 * (j))
#define XB_XSUB(j)  (1280 + 64 * (j))
#define XB_XGEN(j)  (2304 + 64 * (j))
#define XB_TOP      3328
#define XB_TOPGEN   3392
#define XCD_BAR_WORDS 3456
#define XB_SPIN_CAP (1u << 22)

__device__ __forceinline__ unsigned xb_ld(unsigned* p)              { return __hip_atomic_load(p, __ATOMIC_RELAXED, __HIP_MEMORY_SCOPE_AGENT); }
__device__ __forceinline__ unsigned xb_add(unsigned* p, unsigned v) { return __hip_atomic_fetch_add(p, v, __ATOMIC_RELAXED, __HIP_MEMORY_SCOPE_AGENT); }
__device__ __forceinline__ unsigned xb_xcc_id() { return (unsigned)__builtin_amdgcn_s_getreg((3 << 11) | 20) & 0xFu; }
#define XB_SPIN(cond, bar) do { unsigned _sp = 0; while (cond) { __builtin_amdgcn_s_sleep(1); \
    if ((++_sp & 255u) == 0u) { if (xb_ld(&(bar)[XB_TMO])) break; if (_sp > XB_SPIN_CAP) { atomicAdd(&(bar)[XB_TMO], 1u); break; } } } } while (0)

struct XcdBarrier { unsigned* bar; unsigned x; volatile LAS unsigned* st; };

__device__ __forceinline__ XcdBarrier xcd_barrier_post(unsigned* bar, volatile LAS unsigned* st) {
    XcdBarrier b; b.bar = bar; b.x = xb_xcc_id(); b.st = st;
    if (threadIdx.x == 0) (void)xb_add(&bar[XB_XCNT(b.x)], 1u);
    return b;
}
__device__ __forceinline__ void xcd_barrier_complete(unsigned* bar, unsigned x, unsigned& nloc, unsigned& nx) {
    const unsigned G = gridDim.x * gridDim.y * gridDim.z;
    unsigned sum, cnt, mine, sp = 0u;
    for (;;) {
        sum = 0u; cnt = 0u; mine = 0u;
#pragma unroll
        for (unsigned j = 0; j < 16; ++j) { const unsigned c = xb_ld(&bar[XB_XCNT(j)]); sum += c; cnt += (c > 0u) ? 1u : 0u; mine = (j == x) ? c : mine; }
        if (sum == G) break;
        __builtin_amdgcn_s_sleep(1);
        if ((++sp & 255u) == 0u) { if (xb_ld(&bar[XB_TMO])) break; if (sp > XB_SPIN_CAP) { atomicAdd(&bar[XB_TMO], 1u); break; } }
    }
    nloc = mine > 0u ? mine : 1u; nx = cnt > 0u ? cnt : 1u;
}
__device__ __forceinline__ void xcd_barrier(const XcdBarrier& b) {
    asm volatile("s_waitcnt vmcnt(0)" ::: "memory");
    __syncthreads();
    if (threadIdx.x == 0) {
        unsigned* bar = b.bar;
        __builtin_amdgcn_s_waitcnt(0);
        unsigned nloc = b.st[0], nx = b.st[1];
        if (nloc == 0u) { xcd_barrier_complete(bar, b.x, nloc, nx); b.st[0] = nloc; b.st[1] = nx; }
        const unsigned old = xb_add(&bar[XB_XSUB(b.x)], 1u);
        const unsigned gen = old / nloc;
        if (old + 1u == (gen + 1u) * nloc) {
            __builtin_amdgcn_fence(__ATOMIC_RELEASE, "agent");
            asm volatile("s_waitcnt vmcnt(0)" ::: "memory");
            const unsigned og = xb_add(&bar[XB_TOP], 1u);
            const unsigned tg = og / nx;
            if (og + 1u == (tg + 1u) * nx) xb_add(&bar[XB_TOPGEN], 1u);
            else XB_SPIN(xb_ld(&bar[XB_TOPGEN]) == tg, bar);
            __builtin_amdgcn_fence(__ATOMIC_ACQUIRE, "agent");
            xb_add(&bar[XB_XGEN(b.x)], 1u);
            asm volatile("s_waitcnt vmcnt(0)" ::: "memory");
        } else {
            XB_SPIN(xb_ld(&bar[XB_XGEN(b.x)]) == gen, bar);
            __builtin_amdgcn_fence(__ATOMIC_ACQUIRE, "agent");
            asm volatile("s_waitcnt vmcnt(0)" ::: "memory");
        }
    }
    __syncthreads();
}

namespace pg8 {
constexpr int BM = 256, BK = 64, HALF = 128, HTB = HALF * BK * 2, STAGE_BYTES = 8 * HTB, NXCD = 8, WGM = 8;
__host__ __device__ __forceinline__ int lds_byte(int r, int c) { const int st = (r >> 4) * 2 + (c >> 5), rr = r & 15, cc = c & 31, ob = rr * 64 + cc * 2; return st * 1024 + (ob ^ (((ob >> 9) & 1) << 5)); }
__host__ __device__ __forceinline__ void stage_rc(int b, int& R, int& C) { const int st = b / 1024, sb = b % 1024, swz = sb ^ (((sb >> 9) & 1) << 5); R = (st >> 1) * 16 + swz / 64; C = (st & 1) * 32 + (swz % 64) / 2; }
__host__ __device__ __forceinline__ int perm32(int rho) { const int n = rho >> 4, i = rho & 15; return 8 * (i >> 2) + 4 * n + (i & 3); }

struct Unit { int pm, pn, e; };
struct Gemm { const void* A; const void* Bt; int K; size_t estride; const int* arow; size_t astride; };

struct StaticOrder {
    int nM, nN, nwg, G, c, i, full, erank, en;
    __device__ void init(int M, int N, int G_, int c_) { nM = M / BM; nN = N / BM; nwg = nM * nN; G = G_; c = c_; i = 0; full = 1 << 30; erank = -1; en = 1; }
    __device__ void skew(int full_, int erank_, int en_) { full = full_; erank = erank_; en = en_; }
    __device__ bool next(Unit& u) {
        long L;
        if (i < full) L = (long)i * G + c; else { if (erank < 0) return false; L = (long)full * G + (long)(i - full) * en + erank; }
        ++i; if (L >= nwg) return false;
        int wgid = (int)L; { const int q = nwg / NXCD, r = nwg % NXCD, xcd = wgid % NXCD, off = wgid / NXCD; wgid = (xcd < r ? xcd * (q + 1) : r * (q + 1) + (xcd - r) * q) + off; }
        const int nig = WGM * nN, gid = wgid / nig, fm = gid * WGM, gsz = (nM - fm) < WGM ? (nM - fm) : WGM;
        u.pm = fm + ((wgid % nig) % gsz); u.pn = (wgid % nig) / gsz; u.e = 0; return true;
    }
};
struct MoeOrder {
    int nPanels, nN, G, c, i; const LAS int* panel_e;
    __device__ void init(int nPanels_, int nN_, int G_, int c_, const LAS int* pe) { nPanels = nPanels_; nN = nN_; G = G_; c = c_; i = 0; panel_e = pe; }
    __device__ bool next(Unit& u) {
        const int PB = 256 / nN;
        const int nblk = (nPanels + PB - 1) / PB;
        for (;;) {
            const long L = (long)i * G + c; ++i;
            const int blk = (int)(L >> 8), r = (int)(L & 255), x = r & 7, j = r >> 3;
            if (blk >= nblk) return false;
            int pm, pn;
            if (nN == 16) { pm = blk * 16 + 4 * (x >> 1) + (j & 3); pn = 8 * (x & 1) + (j >> 2); }
            else          { pm = blk * 32 + 4 * x + (j & 3);        pn = j >> 2; }
            if (pm < nPanels) { u.pm = pm; u.pn = pn; u.e = panel_e[pm]; return true; }
        }
    }
};

template <class Epi, class Sched, bool FP8 = false>
__device__ __forceinline__ void gemm_phase(LAS unsigned char* lds, const Gemm g, Sched& S, const Epi& E) {
    const int tid = threadIdx.x, wid = __builtin_amdgcn_readfirstlane(tid >> 6), lane = tid & 63, wr = wid >> 2, wc = wid & 3, fr = lane & 15, fq = lane >> 4;
    const int K = g.K; const int pitch = FP8 ? K : 2 * K; const int nt = pitch / 128;
    unsigned voffA[2], voffB[2];
#pragma unroll
    for (int i = 0; i < 2; ++i) { int R, C; stage_rc(tid * 16 + i * 8192, R, C); const int Rb = Epi::PERM ? ((R & ~31) + perm32(R & 31)) : R;
        voffA[i] = (unsigned)(R * pitch + C * 2); voffB[i] = (unsigned)(Rb * pitch + C * 2); }
    const size_t kstep = (size_t)(BK * 2);
    const size_t hstep = (size_t)HALF * pitch;
    const size_t tstep = 2 * hstep;
    int RA[2], CA[2];
#pragma unroll
    for (int i = 0; i < 2; ++i) stage_rc(tid * 16 + i * 8192, RA[i], CA[i]);
    const bool gather = g.arow != nullptr;
    const size_t hsA = gather ? 0 : hstep;
    unsigned vA0[2] = {voffA[0], voffA[1]}, vA1[2] = {voffA[0], voffA[1]}, nA0[2] = {voffA[0], voffA[1]}, nA1[2] = {voffA[0], voffA[1]};
#define PG8_AOFF(dst0, dst1, u) do { if (gather) { _Pragma("unroll") for (int i = 0; i < 2; ++i) { \
        dst0[i] = (unsigned)g.arow[(u).pm * 256 + RA[i]] * (unsigned)pitch + (unsigned)(CA[i] * 2); dst1[i] = (unsigned)g.arow[(u).pm * 256 + 128 + RA[i]] * (unsigned)pitch + (unsigned)(CA[i] * 2); } } } while (0)
    const unsigned ldsw = (unsigned)wid * 1024u;
    const int aoff = lds_byte(wr * 64 + fr, fq * 8), boff = lds_byte(wc * 32 + fr, fq * 8);
#define PG8_SA(b, h) (((b) * 2 + (h)) * HTB)
#define PG8_SB(b, h) ((4 + (b) * 2 + (h)) * HTB)
#define PG8_STAGE(bufoff, gbase, voff) do { _Pragma("unroll") for (int _i = 0; _i < 2; ++_i) \
        __builtin_amdgcn_global_load_lds((const unsigned*)((const char*)(gbase) + (voff)[_i]), (LAS unsigned*)(lds + (bufoff) + ldsw + _i * 8192), 16, 0, 0); } while (0)
#define PG8_LD8(p) __builtin_shufflevector(*(const LAS i32x4*)(p), *(const LAS i32x4*)((p) + 1024), 0, 1, 2, 3, 4, 5, 6, 7)
#define PG8_LDA(dst, b, h) do { _Pragma("unroll") for (int m = 0; m < 4; ++m) { if constexpr (FP8) dst##8[m] = PG8_LD8(lds + PG8_SA(b, h) + aoff + m * 2048); \
        else { _Pragma("unroll") for (int k = 0; k < 2; ++k) dst[m][k] = *(const LAS bf16x8*)(lds + PG8_SA(b, h) + aoff + m * 2048 + k * 1024); } } } while (0)
#define PG8_LDB(dst, b, h) do { _Pragma("unroll") for (int n = 0; n < 2; ++n) { if constexpr (FP8) dst##8[n] = PG8_LD8(lds + PG8_SB(b, h) + boff + n * 2048); \
        else { _Pragma("unroll") for (int k = 0; k < 2; ++k) dst[n][k] = *(const LAS bf16x8*)(lds + PG8_SB(b, h) + boff + n * 2048 + k * 1024); } } } while (0)
#define PG8_MMA(ai, bj, At, Bt) do { __builtin_amdgcn_s_setprio(1); _Pragma("unroll") for (int m = 0; m < 4; ++m) _Pragma("unroll") for (int n = 0; n < 2; ++n) { \
        if constexpr (FP8) asm volatile("v_mfma_scale_f32_16x16x128_f8f6f4 %0, %1, %2, %0, %3, %3 op_sel_hi:[0,0,0]" : "+v"(acc[ai][bj][m][n]) : "v"(Bt##8[n]), "v"(At##8[m]), "v"(scl1)); \
        else { _Pragma("unroll") for (int k = 0; k < 2; ++k) acc[ai][bj][m][n] = __builtin_amdgcn_mfma_f32_16x16x32_bf16(Bt[n][k], At[m][k], acc[ai][bj][m][n], 0, 0, 0); } } \
        __builtin_amdgcn_s_setprio(0); } while (0)
#define PG8_WAIT_V(n) asm volatile("s_waitcnt vmcnt(" #n ")" ::: "memory")
#define PG8_WAIT_L(n) asm volatile("s_waitcnt lgkmcnt(" #n ")" ::: "memory")
#define PG8_BAR __builtin_amdgcn_s_barrier()
#define PG8_SCHED __builtin_amdgcn_sched_barrier(0)
    Unit cur, nxt;
    if (!S.next(cur)) return;
    const unsigned scl1 = 0x7f7f7f7fu;
    f32x4 acc[2][2][4][2];
#pragma unroll
    for (int a = 0; a < 2; ++a)
#pragma unroll
        for (int b = 0; b < 2; ++b)
#pragma unroll
            for (int m = 0; m < 4; ++m)
#pragma unroll
                for (int n = 0; n < 2; ++n) acc[a][b][m][n] = (f32x4){0.f, 0.f, 0.f, 0.f};
    bf16x8 At[4][2], B0[2][2], B1[2][2]; i32x8 At8[4], B08[2], B18[2];
    const char* cA = (const char*)g.A + (size_t)cur.e * g.astride + (gather ? (size_t)0 : (size_t)cur.pm * tstep); const char* cB = (const char*)g.Bt + (size_t)cur.e * g.estride + (size_t)cur.pn * tstep;
    PG8_AOFF(vA0, vA1, cur);
    PG8_STAGE(PG8_SB(0, 0), cB, voffB); PG8_STAGE(PG8_SB(0, 1), cB + hstep, voffB); PG8_STAGE(PG8_SA(0, 0), cA, vA0); PG8_STAGE(PG8_SA(0, 1), cA + hsA, vA1);
    if (wr == 1) PG8_BAR;
    PG8_WAIT_V(2); PG8_BAR;
    PG8_STAGE(PG8_SB(1, 0), cB + kstep, voffB); PG8_STAGE(PG8_SA(1, 0), cA + kstep, vA0); PG8_STAGE(PG8_SB(1, 1), cB + hstep + kstep, voffB);
    PG8_WAIT_V(6); PG8_BAR;
    for (;;) {
        const bool has_next = S.next(nxt);
        const char* nA = has_next ? (const char*)g.A + (size_t)nxt.e * g.astride + (gather ? (size_t)0 : (size_t)nxt.pm * tstep) : cA;
        if (has_next) PG8_AOFF(nA0, nA1, nxt);
        const char* nB = has_next ? (const char*)g.Bt + (size_t)nxt.e * g.estride + (size_t)nxt.pn * tstep : cB;
        for (int t = 0; t < nt; t += 2) {
            const bool last = (t == nt - 2);
            const char* a1 = cA + (size_t)(t + 1) * kstep;
            const char* a2 = last ? nA : cA + (size_t)(t + 2) * kstep; const char* b2 = last ? nB : cB + (size_t)(t + 2) * kstep;
            const char* a3 = a2 + kstep; const char* b3 = b2 + kstep;
            PG8_LDB(B0, 0, 0); PG8_LDB(B1, 0, 1); PG8_SCHED; PG8_LDA(At, 0, 0); PG8_STAGE(PG8_SA(1, 1), a1 + hsA, vA1);
            if (last && has_next) { vA0[0] = nA0[0]; vA0[1] = nA0[1]; vA1[0] = nA1[0]; vA1[1] = nA1[1]; }
            PG8_WAIT_V(8); PG8_WAIT_L(0); PG8_BAR; PG8_MMA(0, 0, At, B0); PG8_MMA(0, 1, At, B1); PG8_BAR; PG8_SCHED;
            PG8_LDA(At, 0, 1); PG8_STAGE(PG8_SB(0, 0), b2, voffB); PG8_STAGE(PG8_SB(0, 1), b2 + hstep, voffB); PG8_STAGE(PG8_SA(0, 0), a2, vA0);
            PG8_WAIT_V(8); PG8_WAIT_L(0); PG8_BAR; PG8_MMA(1, 0, At, B0); PG8_MMA(1, 1, At, B1); PG8_BAR; PG8_SCHED;
            PG8_LDB(B0, 1, 0); PG8_LDB(B1, 1, 1); PG8_SCHED; PG8_LDA(At, 1, 0); PG8_STAGE(PG8_SA(0, 1), a2 + hsA, vA1);
            PG8_WAIT_V(8); PG8_WAIT_L(0); PG8_BAR; PG8_MMA(0, 0, At, B0); PG8_MMA(0, 1, At, B1); PG8_BAR; PG8_SCHED;
            PG8_LDA(At, 1, 1); PG8_STAGE(PG8_SB(1, 0), b3, voffB); PG8_STAGE(PG8_SB(1, 1), b3 + hstep, voffB); PG8_STAGE(PG8_SA(1, 0), a3, vA0);
            PG8_WAIT_V(8); PG8_WAIT_L(0); PG8_BAR; PG8_MMA(1, 0, At, B0); PG8_MMA(1, 1, At, B1); PG8_BAR; PG8_SCHED;
        }
        if (wr == 0) PG8_BAR;
        if constexpr (FP8) {
#pragma unroll
            for (int a = 0; a < 2; ++a)
#pragma unroll
                for (int b = 0; b < 2; ++b) asm volatile("s_nop 15" : "+v"(acc[a][b][0][0]), "+v"(acc[a][b][0][1]), "+v"(acc[a][b][1][0]), "+v"(acc[a][b][1][1]), "+v"(acc[a][b][2][0]), "+v"(acc[a][b][2][1]), "+v"(acc[a][b][3][0]), "+v"(acc[a][b][3][1]));
        }
        const bool keep_acc = E(acc, cur, wr, wc, fr, fq);
        if (!has_next) break;
        if (!keep_acc)
#pragma unroll
        for (int a = 0; a < 2; ++a)
#pragma unroll
            for (int b = 0; b < 2; ++b)
#pragma unroll
                for (int m = 0; m < 4; ++m)
#pragma unroll
                    for (int n = 0; n < 2; ++n) acc[a][b][m][n] = (f32x4){0.f, 0.f, 0.f, 0.f};
        cur = nxt; cA = nA; cB = nB;
        if (wr == 1) PG8_BAR;
    }
    PG8_WAIT_V(0);
    PG8_BAR;
#undef PG8_AOFF
#undef PG8_SA
#undef PG8_SB
#undef PG8_STAGE
#undef PG8_LDA
#undef PG8_LDB
#undef PG8_MMA
#undef PG8_LD8
#undef PG8_WAIT_V
#undef PG8_WAIT_L
#undef PG8_BAR
#undef PG8_SCHED
}

struct EpiBf16 {
    static constexpr bool PERM = true;
    bf16_t* O; int ldc; const float* bias; int bias_estride; float ascale; int skip_from, skip_cols;
    __device__ __forceinline__ bool operator()(const f32x4 (&acc)[2][2][4][2], const Unit& u, int wr, int wc, int fr, int fq) const {
        const int row0 = u.pm * BM + wr * 64 + fr; const int col0 = u.pn * BM + wc * 32 + 8 * fq + (u.pn >= skip_from ? skip_cols : 0);
        f32x4 bv[2][2];
#pragma unroll
        for (int bj = 0; bj < 2; ++bj)
#pragma unroll
            for (int n = 0; n < 2; ++n) bv[bj][n] = bias ? *(const f32x4*)(bias + (size_t)u.e * bias_estride + col0 + bj * HALF + 4 * n) : (f32x4){0.f, 0.f, 0.f, 0.f};
#pragma unroll
        for (int ai = 0; ai < 2; ++ai)
#pragma unroll
            for (int m = 0; m < 4; ++m) { bf16_t* rowp = O + (size_t)(row0 + ai * HALF + m * 16) * ldc + col0;
#pragma unroll
                for (int bj = 0; bj < 2; ++bj) { const f32x4 v0 = acc[ai][bj][m][0] * ascale + bv[bj][0], v1 = acc[ai][bj][m][1] * ascale + bv[bj][1];
                    u32x4 w; w.x = cvt_pk_bf16(v0[0], v0[1]); w.y = cvt_pk_bf16(v0[2], v0[3]); w.z = cvt_pk_bf16(v1[0], v1[1]); w.w = cvt_pk_bf16(v1[2], v1[3]);
                    *(u32x4*)(rowp + bj * HALF) = w; } }
        return false;
    }
};
__device__ __forceinline__ float swiglu1(float ug, float ul) {
    ug = fminf(ug, 7.0f); ul = fminf(fmaxf(ul, -7.0f), 7.0f);
    return ug * __builtin_amdgcn_rcpf(1.0f + __expf(-1.702f * ug)) * (ul + 1.0f);
}
struct EpiSwiglu {
    static constexpr bool PERM = true;
    unsigned char* O; const float* b1;
    __device__ __forceinline__ bool operator()(const f32x4 (&acc)[2][2][4][2], const Unit& u, int wr, int wc, int fr, int fq) const {
        const int row0 = u.pm * BM + wr * 64 + fr; const int c0 = u.pn * 128 + wc * 32 + 8 * fq;
        const float* bg = b1 + (size_t)u.e * 4096 + c0; const float* bl = bg + 2048;
        f32x4 bgv[2], blv[2];
#pragma unroll
        for (int n = 0; n < 2; ++n) { bgv[n] = *(const f32x4*)(bg + 4 * n); blv[n] = *(const f32x4*)(bl + 4 * n); }
#pragma unroll
        for (int ai = 0; ai < 2; ++ai)
#pragma unroll
            for (int m = 0; m < 4; ++m) {
                float a[8];
#pragma unroll
                for (int n = 0; n < 2; ++n)
#pragma unroll
                    for (int j = 0; j < 4; ++j) a[4 * n + j] = ACT8_SCALE * swiglu1(acc[ai][0][m][n][j] * (1.0f / W8_SCALE) + bgv[n][j], acc[ai][1][m][n][j] * (1.0f / W8_SCALE) + blv[n][j]);
                u32x2 w; w.x = pack4_fp8(a[0], a[1], a[2], a[3]); w.y = pack4_fp8(a[4], a[5], a[6], a[7]);
                *(u32x2*)(O + (size_t)(row0 + ai * HALF + m * 16) * 2048 + c0) = w;
            }
        return false;
    }
};

struct TwoPartOrder {
    StaticOrder so; Unit held; int part;
    __device__ void init(int M, int N, int G_, int c_) { so.init(M, N, G_, c_); part = 0; }
    __device__ bool next(Unit& u) { if (part == 1) { u = held; u.e = 1; part = 0; return true; } if (!so.next(held)) return false; u = held; u.e = 0; part = 1; return true; }
};
struct EpiGate2 {
    static constexpr bool PERM = true;
    unsigned char* O; const bf16_t* Ga; const bf16_t* Gr;
    __device__ __forceinline__ bool operator()(f32x4 (&acc)[2][2][4][2], const Unit& u, int wr, int wc, int fr, int fq) const {
        const int row0 = u.pm * BM + wr * 64 + fr; const int col0 = u.pn * BM + wc * 32 + 8 * fq;
#pragma unroll
        for (int ai = 0; ai < 2; ++ai)
#pragma unroll
            for (int m = 0; m < 4; ++m) { const size_t row = (size_t)(row0 + ai * HALF + m * 16);
#pragma unroll
                for (int bj = 0; bj < 2; ++bj) { const int c = col0 + bj * HALF;
                    const u32x4 gr = *(const u32x4*)(Gr + row * DINP + c);
                    if (u.e == 0) {
                        const u32x4 ga = *(const u32x4*)(Ga + row * DINP + c);
#pragma unroll
                        for (int q = 0; q < 4; ++q) {
                            const float r0 = (1.0f + __expf(-bf_lo(gr[q]))) * __builtin_amdgcn_rcpf(1.0f + __expf(-bf_lo(ga[q]))), r1 = (1.0f + __expf(-bf_hi(gr[q]))) * __builtin_amdgcn_rcpf(1.0f + __expf(-bf_hi(ga[q])));
                            acc[ai][bj][m][q >> 1][(2 * q) & 3] *= r0; acc[ai][bj][m][q >> 1][(2 * q + 1) & 3] *= r1; }
                    } else {
                        float r[8];
#pragma unroll
                        for (int q = 0; q < 4; ++q) { r[2 * q] = sigmoidf_(bf_lo(gr[q])) * acc[ai][bj][m][q >> 1][(2 * q) & 3]; r[2 * q + 1] = sigmoidf_(bf_hi(gr[q])) * acc[ai][bj][m][q >> 1][(2 * q + 1) & 3]; }
                        u32x2 w; constexpr float osc = MRG8_SCALE / (W8_SCALE * OP8_SCALE); w.x = pack4_fp8(r[0] * osc, r[1] * osc, r[2] * osc, r[3] * osc); w.y = pack4_fp8(r[4] * osc, r[5] * osc, r[6] * osc, r[7] * osc);
                        *(u32x2*)(O + row * 2048 + c) = w; } } }
        return u.e == 0;
    }
};
struct EpiDelta {
    static constexpr bool PERM = true;
    const float* gt; bf16_t* DL; float ascale;
    __device__ __forceinline__ bool operator()(const f32x4 (&acc)[2][2][4][2], const Unit& u, int wr, int wc, int fr, int fq) const {
        const int row0 = u.pm * BM + wr * 64 + fr; const int col0 = u.pn * BM + wc * 32 + 8 * fq;
        f32x4 g[2][2];
#pragma unroll
        for (int bj = 0; bj < 2; ++bj)
#pragma unroll
            for (int n = 0; n < 2; ++n) g[bj][n] = *(const f32x4*)(gt + col0 + bj * HALF + 4 * n);
#pragma unroll
        for (int ai = 0; ai < 2; ++ai)
#pragma unroll
            for (int m = 0; m < 4; ++m) { bf16_t* rowp = DL + (size_t)(row0 + ai * HALF + m * 16) * 2048 + col0;
#pragma unroll
                for (int bj = 0; bj < 2; ++bj) { const f32x4 v0 = acc[ai][bj][m][0] * ascale * g[bj][0], v1 = acc[ai][bj][m][1] * ascale * g[bj][1];
                    u32x4 w; w.x = cvt_pk_bf16(v0[0], v0[1]); w.y = cvt_pk_bf16(v0[2], v0[3]); w.z = cvt_pk_bf16(v1[0], v1[1]); w.w = cvt_pk_bf16(v1[2], v1[3]);
                    *(u32x4*)(rowp + bj * HALF) = w; } }
        return false;
    }
};
}

struct Args { const void* in[22]; float* out; unsigned char* ws; int ph_lo, ph_hi, flags, pad; };
constexpr int XCONV = 0, XSCORE = 96;
constexpr int CW_SCQ = 12288, SCP = 5, CW_ATQ = 12352;
enum { PH_PRO = 0, PH_H, PH_INPROJ, PH_POST, PH_SCORE, PH_SELECT, PH_ATTN, PH_OP1, PH_OP2, PH_WOUT, PH_ROUTER, PH_SCATTER, PH_MOE1, PH_MOE2, PH_FINAL, NPH };

__device__ __forceinline__ int dest_row(int mode, int n) {
    if (mode == 1) return n < 2640 ? n : n + 176;
    if (mode == 2) { const int g = n >> 11, c = n & 2047; return (c >> 7) * 256 + g * 128 + (c & 127); }
    return n;
}
__device__ __forceinline__ void convert_item(const float* __restrict__ W, int K, int N, int ld, bf16_t* WT, int mode, int item, int lane, LAS unsigned char* scr) {
    const int nblk = (N + 63) >> 6; const int kb = item / nblk, nb = item - kb * nblk; const int k0 = kb * 128, n0 = nb * 64;
    const int c4 = lane & 15, kr = lane >> 4;
    const bool ok = (n0 + 4 * c4) < N;
    const float* src = W + (size_t)(k0 + 2 * kr) * ld + n0 + 4 * c4;
#pragma unroll 4
    for (int i = 0; i < 16; ++i) {
        f32x4 v0 = (f32x4){0.f, 0.f, 0.f, 0.f}, v1 = v0;
        if (ok) { v0 = *(const f32x4*)(src + (size_t)(8 * i) * ld); v1 = *(const f32x4*)(src + (size_t)(8 * i + 1) * ld); }
        const int kk = 8 * i + 2 * kr;
#pragma unroll
        for (int e = 0; e < 4; ++e) *(LAS unsigned*)(scr + (4 * c4 + e) * 272 + kk * 2) = cvt_pk_bf16(v0[e], v1[e]);
    }
    LDS_WAIT(); asm volatile("" ::: "memory");
#pragma unroll 4
    for (int j = 0; j < 16; ++j) {
        const int q = j * 64 + lane, n = q >> 4, ch = q & 15;
        const u32x4 v = *(const LAS u32x4*)(scr + n * 272 + ch * 16);
        if (n0 + n < N) *(u32x4*)(WT + (size_t)dest_row(mode, n0 + n) * K + k0 + ch * 8) = v;
    }
    LDS_WAIT(); asm volatile("" ::: "memory");
}


__device__ __forceinline__ bf16_t f2bf(float f) { unsigned u = __float_as_uint(f); return (bf16_t)((u + 0x7fffu + ((u >> 16) & 1u)) >> 16); }
__device__ __forceinline__ float bfx(const u32x4& w, int i) { const unsigned u = w[i >> 1]; return (i & 1) ? bf_hi(u) : bf_lo(u); }
__device__ __forceinline__ void rope_sc(float pos, float inv, float& sn, float& cs) {
    const float ang = pos * inv;
    const double a = (double)ang; const double n = __builtin_rint(a * 0.15915494309189535); const float r = (float)(a - n * 6.283185307179586);
    sn = sinf(r); cs = cosf(r);
}
__device__ __forceinline__ void post_token(bf16_t* PROJ, bf16_t* KI, unsigned char* KC, unsigned char* VC, const int* positions, const float* kng, const float* knb, int t, int lane) {
    const float pos = (float)positions[t];
    bf16_t* row = PROJ + (size_t)t * DINP;
    float sn, cs;
#pragma unroll
    for (int i = 0; i < 2; ++i) {
        const int pp = lane + 64 * i, hd = pp >> 4, ii = pp & 15;
        rope_sc(pos, powf(500000.0f, -(float)ii * (1.0f / 16.0f)), sn, cs);
        bf16_t* p = row + CQ + hd * 128 + ii; const float a = bf2f(p[0]), b = bf2f(p[16]);
        p[0] = f2bf(a * cs - b * sn); p[16] = f2bf(b * cs + a * sn);
    }
#pragma unroll
    for (int i = 0; i < 2; ++i) {
        const int pp = lane + 64 * i, hd = pp >> 3, ii = pp & 7;
        rope_sc(pos, powf(500000.0f, -(float)ii * (1.0f / 8.0f)), sn, cs);
        bf16_t* p = row + CQI + hd * 64 + ii; const float a = bf2f(p[0]), b = bf2f(p[8]);
        p[0] = f2bf(a * cs - b * sn); p[8] = f2bf(b * cs + a * sn);
    }
    if (lane < 32) {
        const int g = lane >> 4, ii = lane & 15;
        rope_sc(pos, powf(500000.0f, -(float)ii * (1.0f / 16.0f)), sn, cs);
        const bf16_t* p = row + CK + g * 128 + ii; const float a = bf2f(p[0]), b = bf2f(p[16]);
        unsigned char* o = KC + (size_t)t * 256 + g * 128 + ii; o[0] = fp8_1(a * cs - b * sn); o[16] = fp8_1(b * cs + a * sn);
    }
#pragma unroll
    for (int i = 0; i < 3; ++i) { const int idx = lane + 64 * i, g = idx / 96, r = idx - g * 96; KC[(size_t)t * 256 + g * 128 + 32 + r] = fp8_1(bf2f(row[CK + g * 128 + 32 + r])); }
    { const u32x2 w = *(const u32x2*)(row + CV + 4 * lane); *(unsigned*)(VC + (size_t)t * 256 + 4 * lane) = pack4_fp8(bf_lo(w.x), bf_hi(w.x), bf_lo(w.y), bf_hi(w.y)); }
    {
        const float v = bf2f(row[CKI + lane]);
        const float mean = wave_sum(v) * (1.0f / 64.0f); const float d = v - mean; const float var = wave_sum(d * d) * (1.0f / 64.0f);
        const float y = d * rsqrtf(var + NORM_EPS) * kng[lane] + knb[lane];
        const float other = __shfl_xor(y, 8);
        rope_sc(pos, powf(500000.0f, -(float)(lane & 7) * (1.0f / 8.0f)), sn, cs);
        float o = y;
        if (lane < 8) o = y * cs - other * sn; else if (lane < 16) o = y * cs + other * sn;
        KI[(size_t)t * 64 + lane] = f2bf(o);
    }
}

constexpr int HG_GB = 0, HG_Q1 = 33792, HG_Q2 = 51200, HG_K2 = 68608, HG_VT = 86016, HG_PB = 104448, HG_LB = 113664;
__device__ __forceinline__ void hgrn_cumsum(LAS unsigned char* lds, const u32x4& w0, const u32x4& w1, float l0, float l1, int tid) {
    LAS float* GB = (LAS float*)(lds + HG_GB); LAS float* LB = (LAS float*)(lds + HG_LB); LAS float* SEG = (LAS float*)(lds + HG_LB + 512);
    if (tid < 128) LB[tid] = 1.0f / (1.0f + expf(l1 - l0));
    __syncthreads();
    const int t = tid >> 3, dseg = tid & 7;
#pragma unroll
    for (int i = 0; i < 16; ++i) { const float z = i < 8 ? bfx(w0, i) : bfx(w1, i - 8); const float lb = LB[16 * dseg + i]; GB[t * 128 + 16 * dseg + i] = logf(lb + (1.0f - lb) * sigmoidf_(z)); }
    __syncthreads();
    const int d = tid & 127, tq = tid >> 7;
    float z[16];
#pragma unroll
    for (int i = 0; i < 16; ++i) z[i] = GB[(16 * tq + i) * 128 + d];
    float a = 0.f;
#pragma unroll
    for (int i = 0; i < 16; ++i) { a += z[i]; z[i] = a; }
    SEG[tq * 128 + d] = a;
    __syncthreads();
    float pre = 0.f;
    for (int q = 0; q < tq; ++q) pre += SEG[q * 128 + d];
#pragma unroll
    for (int i = 0; i < 16; ++i) GB[(16 * tq + i) * 128 + d] = z[i] + pre;
    __syncthreads();
}
__device__ __forceinline__ void hgrn_vt(LAS unsigned char* lds, const u32x4& a, const u32x4& b, int tid) {
    const int s2 = tid & 31, eg = tid >> 5;
#pragma unroll
    for (int i = 0; i < 8; ++i) { const unsigned lo = (i & 1) ? (a[i >> 1] >> 16) : (a[i >> 1] & 0xffffu), hi = (i & 1) ? (b[i >> 1] >> 16) : (b[i >> 1] & 0xffffu);
        *(LAS unsigned*)(lds + HG_VT + (8 * eg + i) * 144 + s2 * 4) = lo | (hi << 16); }
}
__device__ __forceinline__ void hgrn_l1(LAS unsigned char* lds, const bf16_t* PROJ, const float* lb_logits, bf16_t* ST, float* DC, int c, int h, int tid, int wave, int lane) {
    const int t = tid >> 3, dseg = tid & 7, s2 = tid & 31, dg = tid >> 5;
    const bf16_t* pf = PROJ + (size_t)(c * 64 + t) * DINP + CHF + h * 128 + 16 * dseg;
    const bf16_t* pk = PROJ + (size_t)(c * 64 + 2 * s2) * DINP + CHF + h * 128 + 8 * dg;
    const u32x4 w0 = *(const u32x4*)pf, w1 = *(const u32x4*)(pf + 8);
    const u32x4 ka = *(const u32x4*)pk, kb = *(const u32x4*)(pk + DINP);
    const u32x4 va = *(const u32x4*)(pk - CHF + CHI), vb = *(const u32x4*)(pk - CHF + CHI + DINP);
    const float l0 = lb_logits[h * 128 + (tid & 127)], l1 = lb_logits[1024 + h * 128 + (tid & 127)];
    hgrn_cumsum(lds, w0, w1, l0, l1, tid);
    const LAS float* GB = (const LAS float*)(lds + HG_GB); const LAS float* LB = (const LAS float*)(lds + HG_LB);
    {
#pragma unroll
        for (int i = 0; i < 8; ++i) { const int d = 8 * dg + i; const float lb = LB[d], b63 = GB[63 * 128 + d];
            const float k0 = (1.0f - lb) * (1.0f - sigmoidf_(bfx(ka, i))), k1 = (1.0f - lb) * (1.0f - sigmoidf_(bfx(kb, i)));
            const float v0 = k0 * __expf(b63 - GB[(2 * s2) * 128 + d]), v1 = k1 * __expf(b63 - GB[(2 * s2 + 1) * 128 + d]);
            *(LAS unsigned*)(lds + HG_Q1 + d * 144 + s2 * 4) = cvt_pk_bf16(v0, v1); }
    }
    hgrn_vt(lds, va, vb, tid);
    __syncthreads();
    const int fr = lane & 15, fq = lane >> 4;
    bf16x8 af[2];
#pragma unroll
    for (int ks = 0; ks < 2; ++ks) af[ks] = *(const LAS bf16x8*)(lds + HG_VT + (16 * wave + fr) * 144 + (32 * ks + 8 * fq) * 2);
    bf16_t* dst = ST + ((size_t)(c * 8 + h) * 128) * 128;
#pragma unroll 2
    for (int dt = 0; dt < 8; ++dt) {
        f32x4 acc = (f32x4){0.f, 0.f, 0.f, 0.f};
#pragma unroll
        for (int ks = 0; ks < 2; ++ks) { const bf16x8 bfr = *(const LAS bf16x8*)(lds + HG_Q1 + (16 * dt + fr) * 144 + (32 * ks + 8 * fq) * 2); acc = __builtin_amdgcn_mfma_f32_16x16x32_bf16(af[ks], bfr, acc, 0, 0, 0); }
#pragma unroll
        for (int r = 0; r < 4; ++r) dst[(size_t)(16 * wave + 4 * fq + r) * 128 + 16 * dt + fr] = f2bf(acc[r]);
    }
    if (tid < 128) DC[(size_t)(c * 8 + h) * 128 + tid] = __expf(GB[63 * 128 + tid]);
    __syncthreads();
}
__device__ __forceinline__ void hgrn_l3(LAS unsigned char* lds, const bf16_t* PROJ, const float* lb_logits, const bf16_t* ST, const float* norm_g, unsigned char* REC, int c, int h, int tid, int wave, int lane) {
    const int t = tid >> 3, dseg = tid & 7, s2 = tid & 31, eg = tid >> 5, fr = lane & 15, fq = lane >> 4;
    const bf16_t* pf = PROJ + (size_t)(c * 64 + t) * DINP + CHF + h * 128 + 16 * dseg;
    const u32x4 f0 = *(const u32x4*)pf, f1 = *(const u32x4*)(pf + 8), q0 = *(const u32x4*)(pf - CHF + CHQ), q1 = *(const u32x4*)(pf - CHF + CHQ + 8);
    const u32x4 g0 = *(const u32x4*)(pf - CHF + CHG), g1 = *(const u32x4*)(pf - CHF + CHG + 8);
    const bf16_t* pv = PROJ + (size_t)(c * 64 + 2 * s2) * DINP + CHI + h * 128 + 8 * eg;
    const u32x4 va = *(const u32x4*)pv, vb = *(const u32x4*)(pv + DINP);
    const bf16_t* sp = ST + ((size_t)(c * 8 + h) * 128 + 16 * wave + fr) * 128 + 8 * fq;
    u32x4 sx[4];
#pragma unroll
    for (int ks = 0; ks < 4; ++ks) sx[ks] = *(const u32x4*)(sp + 32 * ks);
    const float l0 = lb_logits[h * 128 + (tid & 127)], l1 = lb_logits[1024 + h * 128 + (tid & 127)];
    hgrn_cumsum(lds, f0, f1, l0, l1, tid);
    const LAS float* GB = (const LAS float*)(lds + HG_GB); const LAS float* LB = (const LAS float*)(lds + HG_LB);
    {
        unsigned o1[8], o2[8], o3[8];
#pragma unroll
        for (int i = 0; i < 16; i += 2) {
            float a1[2], a2[2], a3[2];
#pragma unroll
            for (int j = 0; j < 2; ++j) { const int d = 16 * dseg + i + j; const float lb = LB[d], b = GB[t * 128 + d], br = GB[31 * 128 + d];
                const float z = (i + j) < 8 ? bfx(f0, i + j) : bfx(f1, i + j - 8), qv = (i + j) < 8 ? bfx(q0, i + j) : bfx(q1, i + j - 8);
                const float k = (1.0f - lb) * (1.0f - sigmoidf_(z)), q = siluf_(qv);
                a1[j] = q * __expf(b); a2[j] = q * __expf(b - br); a3[j] = k * __expf(br - b); }
            o1[i >> 1] = cvt_pk_bf16(a1[0], a1[1]); o2[i >> 1] = cvt_pk_bf16(a2[0], a2[1]); o3[i >> 1] = cvt_pk_bf16(a3[0], a3[1]);
        }
        LAS u32x4* d1 = (LAS u32x4*)(lds + HG_Q1 + t * 272 + dseg * 32); LAS u32x4* d2 = (LAS u32x4*)(lds + HG_Q2 + t * 272 + dseg * 32); LAS u32x4* d3 = (LAS u32x4*)(lds + HG_K2 + t * 272 + dseg * 32);
        d1[0] = (u32x4){o1[0], o1[1], o1[2], o1[3]}; d1[1] = (u32x4){o1[4], o1[5], o1[6], o1[7]};
        d2[0] = (u32x4){o2[0], o2[1], o2[2], o2[3]}; d2[1] = (u32x4){o2[4], o2[5], o2[6], o2[7]};
        d3[0] = (u32x4){o3[0], o3[1], o3[2], o3[3]}; d3[1] = (u32x4){o3[4], o3[5], o3[6], o3[7]};
    }
    hgrn_vt(lds, va, vb, tid);
    __syncthreads();
#pragma unroll
    for (int q = 0; q < 2; ++q) {
        const int tile = 2 * wave + q, tt = tile >> 2, stl = tile & 3;
        f32x4 acc = (f32x4){0.f, 0.f, 0.f, 0.f};
#pragma unroll
        for (int ks = 0; ks < 4; ++ks) { const bf16x8 a = *(const LAS bf16x8*)(lds + HG_Q2 + (16 * tt + fr) * 272 + (32 * ks + 8 * fq) * 2), b = *(const LAS bf16x8*)(lds + HG_K2 + (16 * stl + fr) * 272 + (32 * ks + 8 * fq) * 2);
            acc = __builtin_amdgcn_mfma_f32_16x16x32_bf16(a, b, acc, 0, 0, 0); }
#pragma unroll
        for (int r = 0; r < 4; ++r) { const int tr_ = 16 * tt + 4 * fq + r, s = 16 * stl + fr; *(LAS bf16_t*)(lds + HG_PB + tr_ * 144 + s * 2) = f2bf(s <= tr_ ? acc[r] : 0.f); }
    }
    __syncthreads();
    {
        bf16x8 b1[2], b2[4];
#pragma unroll
        for (int ks = 0; ks < 2; ++ks) b1[ks] = *(const LAS bf16x8*)(lds + HG_VT + (16 * wave + fr) * 144 + (32 * ks + 8 * fq) * 2);
#pragma unroll
        for (int ks = 0; ks < 4; ++ks) b2[ks] = __builtin_bit_cast(bf16x8, sx[ks]);
        LAS float* OB = (LAS float*)(lds + HG_GB);
#pragma unroll
        for (int tt = 0; tt < 4; ++tt) {
            f32x4 acc = (f32x4){0.f, 0.f, 0.f, 0.f};
#pragma unroll
            for (int ks = 0; ks < 2; ++ks) { const bf16x8 a = *(const LAS bf16x8*)(lds + HG_PB + (16 * tt + fr) * 144 + (32 * ks + 8 * fq) * 2); acc = __builtin_amdgcn_mfma_f32_16x16x32_bf16(a, b1[ks], acc, 0, 0, 0); }
#pragma unroll
            for (int ks = 0; ks < 4; ++ks) { const bf16x8 a = *(const LAS bf16x8*)(lds + HG_Q1 + (16 * tt + fr) * 272 + (32 * ks + 8 * fq) * 2); acc = __builtin_amdgcn_mfma_f32_16x16x32_bf16(a, b2[ks], acc, 0, 0, 0); }
#pragma unroll
            for (int r = 0; r < 4; ++r) OB[(16 * tt + 4 * fq + r) * 132 + 16 * wave + fr] = acc[r];
        }
    }
    __syncthreads();
    {
        const int es = dseg; const LAS float* OB = (const LAS float*)(lds + HG_GB);
        float o[16]; float ss = 0.f;
#pragma unroll
        for (int i = 0; i < 16; ++i) { o[i] = OB[t * 132 + 16 * es + i]; ss += o[i] * o[i]; }
        ss += __shfl_xor(ss, 1); ss += __shfl_xor(ss, 2); ss += __shfl_xor(ss, 4);
        const float rstd = rsqrtf(ss * (1.0f / 128.0f) + NORM_EPS);
        float rv[16];
#pragma unroll
        for (int i = 0; i < 16; ++i) { const float ga = i < 8 ? bfx(g0, i) : bfx(g1, i - 8); rv[i] = o[i] * (rstd * OP8_SCALE) * norm_g[16 * es + i] * siluf_(ga); }
        *(u32x4*)(REC + (size_t)(c * 64 + t) * 1024 + h * 128 + 16 * es) = (u32x4){pack4_fp8(rv[0], rv[1], rv[2], rv[3]), pack4_fp8(rv[4], rv[5], rv[6], rv[7]), pack4_fp8(rv[8], rv[9], rv[10], rv[11]), pack4_fp8(rv[12], rv[13], rv[14], rv[15])};
    }
    __syncthreads();
}

constexpr int SC_KT = 0, SC_SB = 36864, SC_SPITCH = 132;
__device__ __forceinline__ unsigned pk_f16(float a, float b) { return __builtin_bit_cast(unsigned, __builtin_amdgcn_cvt_pkrtz(a, b)); }
__device__ __forceinline__ void score_flush(LAS unsigned char* lds, unsigned short* SCORES, unsigned short* SEGMAX, int t0, int kt, int tid) {
    const LAS float* sb = (const LAS float*)(lds + SC_SB + (kt & 1) * (32 * SC_SPITCH * 4));
    const int row = tid >> 4, seg = tid & 15;
    const f32x4 a = *(const LAS f32x4*)(sb + row * SC_SPITCH + seg * 8), b = *(const LAS f32x4*)(sb + row * SC_SPITCH + seg * 8 + 4);
    unsigned short* dst = SCORES + (size_t)(t0 + row) * S + kt * 128 + seg * 8;
    *(u32x4*)dst = (u32x4){pk_f16(a[0], a[1]), pk_f16(a[2], a[3]), pk_f16(b[0], b[1]), pk_f16(b[2], b[3])};
    const float mx = fmaxf(fmaxf(fmaxf(a[0], a[1]), fmaxf(a[2], a[3])), fmaxf(fmaxf(b[0], b[1]), fmaxf(b[2], b[3])));
    SEGMAX[(size_t)(t0 + row) * 2048 + kt * 16 + seg] = (unsigned short)(pk_f16(mx, mx) & 0xffffu);
}
__device__ __forceinline__ void score_block(LAS unsigned char* lds, const bf16_t* PROJ, const bf16_t* KI, unsigned short* SCORES, unsigned short* SEGMAX, int qb, int kt0, int kt1, int tid, int wave, int lane) {
    const int t0 = qb * 32;
    const int r = lane & 31, hh = lane >> 5;
    bf16x8 Af[2][4]; float wv[2][16]; f32x2 wv2[2][8];
#pragma unroll
    for (int p = 0; p < 2; ++p) {
        const int tq = t0 + 4 * wave + 2 * p + (r >> 4); const bf16_t* qrow = PROJ + (size_t)tq * DINP + CQI + (r & 15) * 64 + 8 * hh;
#pragma unroll
        for (int ks = 0; ks < 4; ++ks) Af[p][ks] = *(const bf16x8*)(qrow + 16 * ks);
#pragma unroll
        for (int qq = 0; qq < 2; ++qq) {
            const bf16_t* wp = PROJ + (size_t)(t0 + 4 * wave + 2 * p + qq) * DINP + CWI + 4 * hh;
            const u32x2 wa = *(const u32x2*)wp, wb = *(const u32x2*)(wp + 8);
            wv[p][8 * qq + 0] = bf_lo(wa.x) * (1.0f / 32.0f); wv[p][8 * qq + 1] = bf_hi(wa.x) * (1.0f / 32.0f); wv[p][8 * qq + 2] = bf_lo(wa.y) * (1.0f / 32.0f); wv[p][8 * qq + 3] = bf_hi(wa.y) * (1.0f / 32.0f);
            wv[p][8 * qq + 4] = bf_lo(wb.x) * (1.0f / 32.0f); wv[p][8 * qq + 5] = bf_hi(wb.x) * (1.0f / 32.0f); wv[p][8 * qq + 6] = bf_lo(wb.y) * (1.0f / 32.0f); wv[p][8 * qq + 7] = bf_hi(wb.y) * (1.0f / 32.0f);
        }
#pragma unroll
        for (int i = 0; i < 8; ++i) wv2[p][i] = (f32x2){wv[p][2 * i], wv[p][2 * i + 1]};
    }
    const u32x2 tagsw = __builtin_amdgcn_permlane32_swap(0u, 1u, false, false); const int qsel = (int)tagsw[0];
    u32x4 stg[2];
#pragma unroll
    for (int i = 0; i < 2; ++i) { const int q = tid + 512 * i; stg[i] = *(const u32x4*)(KI + (size_t)(kt0 * 128 + (q >> 3)) * 64 + (q & 7) * 8); }
#pragma unroll
    for (int i = 0; i < 2; ++i) { const int q = tid + 512 * i; *(LAS u32x4*)(lds + SC_KT + (kt0 & 1) * 18432 + (q >> 3) * 144 + (q & 7) * 16) = stg[i]; }
    __syncthreads();
    for (int kt = kt0; kt < kt1; ++kt) {
        const LAS unsigned char* buf = lds + SC_KT + (kt & 1) * 18432;
        LAS float* sb = (LAS float*)(lds + SC_SB + (kt & 1) * (32 * SC_SPITCH * 4));
        if (kt + 1 < kt1) {
#pragma unroll
            for (int i = 0; i < 2; ++i) { const int q = tid + 512 * i; stg[i] = *(const u32x4*)(KI + (size_t)((kt + 1) * 128 + (q >> 3)) * 64 + (q & 7) * 8); }
        }
        __builtin_amdgcn_sched_barrier(0);
        if (kt > kt0) score_flush(lds, SCORES, SEGMAX, t0, kt - 1, tid);
        {
        f32x16 accP[2], accC[2];
#define SC_MFMA(cb) do { bf16x8 Bf[4]; _Pragma("unroll") for (int ks = 0; ks < 4; ++ks) Bf[ks] = *(const LAS bf16x8*)(buf + (32 * (cb) + r) * 144 + (16 * ks + 8 * hh) * 2); \
            _Pragma("unroll") for (int p = 0; p < 2; ++p) { _Pragma("unroll") for (int i = 0; i < 16; ++i) accC[p][i] = 0.f; \
                _Pragma("unroll") for (int ks = 0; ks < 4; ++ks) accC[p] = __builtin_amdgcn_mfma_f32_32x32x16_bf16(Af[p][ks], Bf[ks], accC[p], 0, 0, 0); } } while (0)
#define SC_RED(acc, cb) do { _Pragma("unroll") for (int p = 0; p < 2; ++p) { f32x2 s0 = {0.f, 0.f}, s1 = {0.f, 0.f}; \
            _Pragma("unroll") for (int reg = 0; reg < 8; reg += 2) { const f32x2 r0 = {relu_i(acc[p][reg]), relu_i(acc[p][reg + 1])}; const f32x2 r1 = {relu_i(acc[p][reg + 8]), relu_i(acc[p][reg + 9])}; \
                s0 = __builtin_elementwise_fma(wv2[p][reg >> 1], r0, s0); s1 = __builtin_elementwise_fma(wv2[p][4 + (reg >> 1)], r1, s1); } \
            const float p0 = s0[0] + s0[1], p1 = s1[0] + s1[1]; \
            const u32x2 sw = __builtin_amdgcn_permlane32_swap(__float_as_uint(p0), __float_as_uint(p1), false, false); \
            sb[(4 * wave + 2 * p + qsel) * SC_SPITCH + 32 * (cb) + r] = __uint_as_float(sw[0]) + __uint_as_float(sw[1]); } } while (0)
#define SC_INTERLEAVE() do { _Pragma("unroll") for (int i = 0; i < 8; ++i) { __builtin_amdgcn_sched_group_barrier(0x008, 1, 0); __builtin_amdgcn_sched_group_barrier(0x002, 8, 0); } } while (0)
        SC_MFMA(0);
        accP[0] = accC[0]; accP[1] = accC[1]; SC_MFMA(1); SC_RED(accP, 0); SC_INTERLEAVE();
        accP[0] = accC[0]; accP[1] = accC[1]; SC_MFMA(2); SC_RED(accP, 1); SC_INTERLEAVE();
        accP[0] = accC[0]; accP[1] = accC[1]; SC_MFMA(3); SC_RED(accP, 2); SC_INTERLEAVE();
        SC_RED(accC, 3);
#undef SC_MFMA
#undef SC_RED
#undef SC_INTERLEAVE
        }
        if (kt + 1 < kt1) {
#pragma unroll
            for (int i = 0; i < 2; ++i) { const int q = tid + 512 * i; *(LAS u32x4*)(lds + SC_KT + ((kt + 1) & 1) * 18432 + (q >> 3) * 144 + (q & 7) * 16) = stg[i]; }
        }
        __syncthreads();
    }
    score_flush(lds, SCORES, SEGMAX, t0, kt1 - 1, tid);
    __syncthreads();
}

__device__ __forceinline__ float wave_kth16(const float (&v)[16], int K) {
    const float NINF = -__builtin_inff();
    float mx = NINF, mn = __builtin_inff();
#pragma unroll
    for (int j = 0; j < 16; ++j) { mx = fmaxf(mx, v[j]); mn = fminf(mn, v[j] == NINF ? __builtin_inff() : v[j]); }
    mx = wave_max(mx); mn = -wave_max(-mn);
    int c = 0;
#pragma unroll
    for (int j = 0; j < 16; ++j) c += __popcll(__ballot(v[j] >= mx));
    if (c >= K) return mx;
    float lo = mn, hi = mx, tau = mn;
    for (int it = 0; it < 64; ++it) {
        const float mid = 0.5f * (lo + hi);
        if (!(mid > lo && mid < hi)) { tau = lo; break; }
        c = 0;
#pragma unroll
        for (int j = 0; j < 16; ++j) c += __popcll(__ballot(v[j] >= mid));
        if (c == K) { tau = mid; break; }
        if (c > K) lo = mid; else hi = mid;
        tau = lo;
    }
    return tau;
}
__device__ __forceinline__ int lanes_below(unsigned long long mask) { return (int)__builtin_amdgcn_mbcnt_hi((unsigned)(mask >> 32), __builtin_amdgcn_mbcnt_lo((unsigned)mask, 0u)); }
__device__ __forceinline__ float h2f(unsigned short h) { return (float)__builtin_bit_cast(_Float16, h); }
__device__ __forceinline__ float h2f_lo(unsigned u) { return h2f((unsigned short)(u & 0xffffu)); }
__device__ __forceinline__ float h2f_hi(unsigned u) { return h2f((unsigned short)(u >> 16)); }
__device__ __forceinline__ unsigned ge_mask8(const u32x4& v, unsigned T16) {
    unsigned m8 = 0;
#pragma unroll
    for (int w = 0; w < 4; ++w) { const unsigned vw_ = v[w];
        const s16x2 d = __builtin_elementwise_sub_sat(__builtin_bit_cast(s16x2, vw_), __builtin_bit_cast(s16x2, T16));
        const unsigned mm = ~__builtin_bit_cast(unsigned, d); m8 |= (((mm >> 15) & 1u) | ((mm >> 30) & 2u)) << (2 * w); }
    return m8;
}
__device__ __forceinline__ int append_bits(LAS int* list, int cnt, unsigned m8, int base) {
    for (;;) { const bool has = m8 != 0u; const unsigned long long mask = __ballot(has); if (!mask) break;
        const int pos = cnt + lanes_below(mask);
        if (has) { const int k = __builtin_ctz(m8); m8 &= m8 - 1u; if (pos < 1024) list[pos] = base + k; }
        cnt += __popcll(mask); }
    return cnt;
}
__device__ __forceinline__ void select_row(LAS unsigned char* wl, const unsigned short* SCORES, const unsigned short* SEGMAX, int t, int lane) {
    LAS int* selw = (LAS int*)wl; LAS int* segl = (LAS int*)(wl + 1024); LAS int* cidx = (LAS int*)(wl + 5120);
    const float NINF = -__builtin_inff();
    const unsigned short* row = SCORES + (size_t)t * S; const int n = t + 1;
    float c[16]; int N;
    if (n <= 1024) {
#pragma unroll
        for (int j = 0; j < 16; ++j) { const int i = lane + 64 * j; c[j] = i < n ? h2f(row[i]) : NINF; }
        N = -1;
    } else {
        const int m = n >> 4; float s[16];
#pragma unroll
        for (int j = 0; j < 16; ++j) { const int i = lane + 64 * j; s[j] = i < m ? h2f(row[16 * i + 7]) : NINF; }
        int K = 32, cnt = 0;
        for (;;) {
            const float tlo = (K >= m) ? NINF : wave_kth16(s, K);
            cnt = 0;
            const int nq = (n + 511) >> 9;
            if (tlo > 0.f) {
                const unsigned T16 = pk_f16(tlo, tlo);
                const u32x4 NEG = (u32x4){0xfc00fc00u, 0xfc00fc00u, 0xfc00fc00u, 0xfc00fc00u};
                const unsigned short* smrow = SEGMAX + (size_t)t * 2048; const int nseg = (t >> 3) + 1;
                int ns = 0;
                {
                    u32x4 sv[4];
#pragma unroll
                    for (int u = 0; u < 4; ++u) { const int e8 = 8 * (lane + 64 * u); sv[u] = (e8 < nseg) ? *(const u32x4*)(smrow + e8) : NEG; }
#pragma unroll
                    for (int u = 0; u < 4; ++u) { const int e8 = 8 * (lane + 64 * u); unsigned m8 = ge_mask8(sv[u], T16);
                        const int nv = nseg - e8; if (nv < 8) m8 &= nv > 0 ? ((1u << nv) - 1u) : 0u;
                        ns = append_bits(segl, ns, m8, e8); }
                }
                if (ns > 1024) ns = 1024;
                for (int j0 = 0; j0 < ns; j0 += 256) {
                    u32x4 v[4]; int sg[4];
#pragma unroll
                    for (int u = 0; u < 4; ++u) { const int i = j0 + lane + 64 * u; sg[u] = i < ns ? segl[i] : -1; v[u] = sg[u] >= 0 ? *(const u32x4*)(row + 8 * sg[u]) : NEG; }
#pragma unroll
                    for (int u = 0; u < 4; ++u) { const int e = 8 * sg[u]; unsigned m8 = sg[u] >= 0 ? ge_mask8(v[u], T16) : 0u;
                        const int nv = t + 1 - e; if (nv < 8) m8 &= nv > 0 ? ((1u << nv) - 1u) : 0u;
                        cnt = append_bits(cidx, cnt, m8, e); }
                }
            } else {
                for (int q0 = 0; q0 < nq; q0 += 4) {
                    u32x4 v[4];
#pragma unroll
                    for (int u = 0; u < 4; ++u) { const int e = 8 * (lane + 64 * (q0 + u)); v[u] = (e <= t) ? *(const u32x4*)(row + e) : (u32x4){0xfc00fc00u, 0xfc00fc00u, 0xfc00fc00u, 0xfc00fc00u}; }
#pragma unroll
                    for (int u = 0; u < 4; ++u) { const int e = 8 * (lane + 64 * (q0 + u));
#pragma unroll
                        for (int k = 0; k < 8; ++k) { const float x = (k & 1) ? h2f_hi(v[u][k >> 1]) : h2f_lo(v[u][k >> 1]);
                            const bool pred = (e + k <= t) && (x >= tlo); const unsigned long long mask = __ballot(pred);
                            if (mask) { const int pos = cnt + lanes_below(mask); if (pred && pos < 1024) cidx[pos] = e + k; cnt += __popcll(mask); } } }
                }
            }
            if (cnt >= 256 || K >= m) break;
            K *= 2;
        }
        N = cnt < 1024 ? cnt : 1024;
#pragma unroll
        for (int j = 0; j < 16; ++j) { const int i = lane + 64 * j; c[j] = i < N ? h2f(row[cidx[i]]) : NINF; }
    }
    const float tau = wave_kth16(c, 256);
    int base = 0;
#pragma unroll
    for (int j = 0; j < 16; ++j) { const bool pred = c[j] >= tau; const unsigned long long mask = __ballot(pred);
        if (mask) { const int pos = base + lanes_below(mask); if (pred && pos < 256) selw[pos] = (N < 0) ? (lane + 64 * j) : cidx[lane + 64 * j]; base += __popcll(mask); } }
}

__device__ __forceinline__ void attn_query(LAS unsigned char* wl, const bf16_t* PROJ, const unsigned char* KC, const unsigned char* VC, unsigned char* ATT, int t, int lane) {
    LAS int* selw = (LAS int*)wl; LAS float* L = (LAS float*)(wl + 1024);
    const int nsel = t < 255 ? t + 1 : 256;
    const int fr = lane & 15, fq = lane >> 4;
    bf16x8 qf[2][4];
#pragma unroll
    for (int g = 0; g < 2; ++g)
#pragma unroll
        for (int ks = 0; ks < 4; ++ks) { const bf16x8 z = {0, 0, 0, 0, 0, 0, 0, 0}; qf[g][ks] = fr < 4 ? *(const bf16x8*)(PROJ + (size_t)t * DINP + CQ + (4 * g + fr) * 128 + 64 * (ks >> 1) + 16 * fq + 8 * (ks & 1)) : z; }
    const float scale = 0.08838834764831845f;
    const int nkt = (nsel + 15) >> 4;
    {
        LAS unsigned char* KT = wl + 9216;
        const int q4_ = lane >> 4, l15_ = lane & 15;
        u32x4 kw[3][4];
#define QK_LOAD(buf, kt) do { _Pragma("unroll") for (int u = 0; u < 4; ++u) { const unsigned off_ = (unsigned)selw[16 * (kt) + 4 * u + q4_] * 256u + 16u * (unsigned)l15_; kw[buf][u] = *(const u32x4*)((const char*)KC + off_); } } while (0)
#define QK_COMP(buf, kt) do { _Pragma("unroll") for (int u = 0; u < 4; ++u) { u32x4 lo_, hi_; fp8x16_to_bf16(kw[buf][u], lo_, hi_); LAS u32x4* d_ = (LAS u32x4*)(KT + (4 * u + q4_) * 528 + 32 * l15_); d_[0] = lo_; d_[1] = hi_; } \
        _Pragma("unroll") for (int g = 0; g < 2; ++g) { f32x4 acc = (f32x4){0.f, 0.f, 0.f, 0.f}; \
            _Pragma("unroll") for (int ks = 0; ks < 4; ++ks) { const bf16x8 kf_ = *(const LAS bf16x8*)(KT + fr * 528 + g * 256 + (64 * (ks >> 1) + 16 * fq + 8 * (ks & 1)) * 2); \
                acc = __builtin_amdgcn_mfma_f32_16x16x32_bf16(qf[g][ks], kf_, acc, 0, 0, 0); } \
            if (fq == 0) { _Pragma("unroll") for (int r = 0; r < 4; ++r) L[(4 * g + r) * 256 + 16 * (kt) + fr] = (16 * (kt) + fr < nsel) ? acc[r] * scale : -__builtin_inff(); } } } while (0)
        QK_LOAD(0, 0); if (1 < nkt) QK_LOAD(1, 1);
        for (int kt = 0; kt < nkt; kt += 3) {
            if (kt + 2 < nkt) QK_LOAD(2, kt + 2);
            __builtin_amdgcn_sched_barrier(0);
            QK_COMP(0, kt);
            if (kt + 1 < nkt) { if (kt + 3 < nkt) QK_LOAD(0, kt + 3); __builtin_amdgcn_sched_barrier(0); QK_COMP(1, kt + 1); }
            if (kt + 2 < nkt) { if (kt + 4 < nkt) QK_LOAD(1, kt + 4); __builtin_amdgcn_sched_barrier(0); QK_COMP(2, kt + 2); }
        }
#undef QK_LOAD
#undef QK_COMP
        if (fq == 0) { for (int kt = nkt; kt < 16; ++kt) {
#pragma unroll
            for (int r = 0; r < 8; ++r) L[r * 256 + 16 * kt + fr] = -__builtin_inff(); } }
    }
    float p[8][4];
#pragma unroll
    for (int hd = 0; hd < 8; ++hd) { float m = -__builtin_inff();
#pragma unroll
        for (int i = 0; i < 4; ++i) { p[hd][i] = L[hd * 256 + lane + 64 * i]; m = fmaxf(m, p[hd][i]); }
        m = wave_max(m); float s = 0.f;
#pragma unroll
        for (int i = 0; i < 4; ++i) { p[hd][i] = __expf(p[hd][i] - m); s += p[hd][i]; }
        s = 1.0f / wave_sum(s);
#pragma unroll
        for (int i = 0; i < 4; ++i) p[hd][i] *= s; }
    LAS bf16_t* Pb = (LAS bf16_t*)(wl + 1024);
#pragma unroll
    for (int hd = 0; hd < 8; ++hd)
#pragma unroll
        for (int i = 0; i < 4; ++i) Pb[hd * 256 + lane + 64 * i] = f2bf(p[hd][i]);
    LAS unsigned char* VT = wl + 9216;
    const int ii = lane & 15, kq = lane >> 4;
    f32x4 acc[16];
#pragma unroll
    for (int nt = 0; nt < 16; ++nt) acc[nt] = (f32x4){0.f, 0.f, 0.f, 0.f};
    const int nch = (nsel + 15) >> 4;
    u32x4 vw[3][4];
#define PV_LOAD(buf, c) do { _Pragma("unroll") for (int u = 0; u < 4; ++u) { const unsigned off_ = (unsigned)selw[16 * (c) + 4 * u + kq] * 256u + 16u * (unsigned)ii; vw[buf][u] = *(const u32x4*)((const char*)VC + off_); } } while (0)
#define PV_COMP(buf, c) do { _Pragma("unroll") for (int u = 0; u < 4; ++u) { u32x4 lo_, hi_; fp8x16_to_bf16(vw[buf][u], lo_, hi_); LAS u32x4* d_ = (LAS u32x4*)(VT + (4 * u + kq) * 528 + 32 * ii); d_[0] = lo_; d_[1] = hi_; } \
        s16x4 pa[2]; _Pragma("unroll") for (int g = 0; g < 2; ++g) { const s16x4 r_ = *(const LAS s16x4*)(Pb + (g * 4 + (ii & 3)) * 256 + 16 * (c) + 4 * kq); pa[g] = ii < 4 ? r_ : (s16x4){0, 0, 0, 0}; } \
        _Pragma("unroll") for (int nt = 0; nt < 16; ++nt) { const s16x4 b_ = __builtin_amdgcn_ds_read_tr16_b64_v4i16((LAS s16x4*)(VT + (4 * kq + (ii >> 2)) * 528 + (16 * nt + 4 * (ii & 3)) * 2)); \
            acc[nt] = __builtin_amdgcn_mfma_f32_16x16x16bf16_1k(pa[nt >> 3], b_, acc[nt], 0, 0, 0); } } while (0)
    PV_LOAD(0, 0); if (1 < nch) PV_LOAD(1, 1);
    for (int c = 0; c < nch; c += 3) {
        if (c + 2 < nch) PV_LOAD(2, c + 2);
        __builtin_amdgcn_sched_barrier(0);
        PV_COMP(0, c);
        if (c + 1 < nch) { if (c + 3 < nch) PV_LOAD(0, c + 3); __builtin_amdgcn_sched_barrier(0); PV_COMP(1, c + 1); }
        if (c + 2 < nch) { if (c + 4 < nch) PV_LOAD(1, c + 4); __builtin_amdgcn_sched_barrier(0); PV_COMP(2, c + 2); }
    }
#undef PV_LOAD
#undef PV_COMP
    LAS float* OB = (LAS float*)(wl + 1024 + 4096);
    if (kq == 0) {
#pragma unroll
        for (int nt = 0; nt < 16; ++nt)
#pragma unroll
            for (int r = 0; r < 4; ++r) OB[(4 * (nt >> 3) + r) * 128 + 16 * (nt & 7) + ii] = acc[nt][r];
    }
    {
        const f32x4 a0 = *(const LAS f32x4*)(OB + 16 * lane), a1 = *(const LAS f32x4*)(OB + 16 * lane + 4), a2 = *(const LAS f32x4*)(OB + 16 * lane + 8), a3 = *(const LAS f32x4*)(OB + 16 * lane + 12);
        const f32x4 b0 = a0 * OP8_SCALE, b1 = a1 * OP8_SCALE, b2 = a2 * OP8_SCALE, b3 = a3 * OP8_SCALE;
        *(u32x4*)(ATT + (size_t)t * 1024 + 16 * lane) = (u32x4){pack4_fp8(b0[0], b0[1], b0[2], b0[3]), pack4_fp8(b1[0], b1[1], b1[2], b1[3]), pack4_fp8(b2[0], b2[1], b2[2], b2[3]), pack4_fp8(b3[0], b3[1], b3[2], b3[3])};
    }
}


__device__ __forceinline__ void convert_item8(const float* __restrict__ W, int K, int N, int ld, unsigned char* WT, int mode, int item, int lane, LAS unsigned char* scr) {
    const int nblk = N >> 6; const int kb = item / nblk, nb = item - kb * nblk; const int k0 = kb * 256, n0 = nb * 64;
    const int c4 = lane & 15, kr = lane >> 4;
    const float* src = W + (size_t)(k0 + 4 * kr) * ld + n0 + 4 * c4;
#pragma unroll 4
    for (int i = 0; i < 16; ++i) {
        f32x4 v[4];
#pragma unroll
        for (int r = 0; r < 4; ++r) v[r] = __builtin_nontemporal_load((const f32x4*)(src + (size_t)(16 * i + r) * ld));
        const int kk = 16 * i + 4 * kr;
#pragma unroll
        for (int e = 0; e < 4; ++e) *(LAS unsigned*)(scr + (4 * c4 + e) * 272 + kk) = pack4_fp8(v[0][e] * W8_SCALE, v[1][e] * W8_SCALE, v[2][e] * W8_SCALE, v[3][e] * W8_SCALE);
    }
    LDS_WAIT(); asm volatile("" ::: "memory");
#pragma unroll 4
    for (int j = 0; j < 16; ++j) {
        const int q = j * 64 + lane, n = q >> 4, ch = q & 15;
        const u32x4 v = *(const LAS u32x4*)(scr + n * 272 + ch * 16);
        *(u32x4*)(WT + (size_t)dest_row(mode, n0 + n) * K + k0 + ch * 16) = v;
    }
    LDS_WAIT(); asm volatile("" ::: "memory");
}

struct Conv8Job { const float* W; unsigned char* WT; int N; int mode; size_t w_estride, wt_estride; int items_per_e; };
constexpr int C8_PITCH = 272, C8_IMG = 256 * C8_PITCH;
__device__ __forceinline__ void conv8_load(const Conv8Job& jb, int item, int h, int wave, int lane, f32x4 (&v)[16]) {
    const int e = item / jb.items_per_e, r = item - e * jb.items_per_e; const int nblk = jb.N >> 8; const int kb = r / nblk, nb = r - kb * nblk;
    const float* src = jb.W + (size_t)e * jb.w_estride + (size_t)(kb * 256 + 32 * wave + 16 * h) * jb.N + nb * 256 + 4 * lane;
#pragma unroll
    for (int i = 0; i < 16; ++i) v[i] = __builtin_nontemporal_load((const f32x4*)(src + (size_t)i * jb.N));
}
__device__ __forceinline__ void conv8_to_lds(LAS unsigned char* img, int h, int wave, int lane, const f32x4 (&v)[16]) {
#pragma unroll
    for (int e = 0; e < 4; ++e) { u32x4 w;
#pragma unroll
        for (int g = 0; g < 4; ++g) w[g] = pack4_fp8(v[4 * g][e] * W8_SCALE, v[4 * g + 1][e] * W8_SCALE, v[4 * g + 2][e] * W8_SCALE, v[4 * g + 3][e] * W8_SCALE);
        *(LAS u32x4*)(img + (4 * lane + e) * C8_PITCH + 32 * wave + 16 * h) = w; }
}
__device__ __forceinline__ void conv8_store(const Conv8Job& jb, int item, const LAS unsigned char* img, int tid) {
    const int e = item / jb.items_per_e, r = item - e * jb.items_per_e; const int nblk = jb.N >> 8; const int kb = r / nblk, nb = r - kb * nblk;
    unsigned char* dst = jb.WT + (size_t)e * jb.wt_estride + kb * 256;
#pragma unroll
    for (int j = 0; j < 8; ++j) { const int q = j * 512 + tid, n = q >> 4, ch = q & 15;
        __builtin_nontemporal_store(*(const LAS u32x4*)(img + n * C8_PITCH + ch * 16), (u32x4*)(dst + (size_t)dest_row(jb.mode, nb * 256 + n) * 2048 + ch * 16)); }
}
__device__ __forceinline__ void conv8_run(LAS unsigned char* lds, const Conv8Job& jb, int n_items, int wg, int G, int tid, int wave, int lane) {
    if (wg >= n_items) return;
    f32x4 a[16], b[16]; int par = 0;
    conv8_load(jb, wg, 0, wave, lane, a); conv8_load(jb, wg, 1, wave, lane, b);
    for (int it = wg; it < n_items; it += G, par ^= 1) {
        LAS unsigned char* img = lds + par * C8_IMG;
        const int nx = (it + G < n_items) ? it + G : it;
        conv8_to_lds(img, 0, wave, lane, a); __builtin_amdgcn_sched_barrier(0);
        conv8_load(jb, nx, 0, wave, lane, a); __builtin_amdgcn_sched_barrier(0);
        conv8_to_lds(img, 1, wave, lane, b); __builtin_amdgcn_sched_barrier(0);
        conv8_load(jb, nx, 1, wave, lane, b); __builtin_amdgcn_sched_barrier(0);
        __syncthreads();
        conv8_store(jb, it, img, tid);
    }
    __syncthreads();
}

__global__ void __launch_bounds__(NTHR, 2) fwd_kernel(Args args) {
    extern __shared__ __attribute__((aligned(16))) unsigned char lds_raw[];
    LAS unsigned char* lds = (LAS unsigned char*)lds_raw;
    volatile LAS unsigned* MISC = (volatile LAS unsigned*)(lds + LDS_MISC);
    const int tid = threadIdx.x, lane = tid & 63, wave = __builtin_amdgcn_readfirstlane(tid >> 6);
    const int G = gridDim.x, wg = blockIdx.x;
    unsigned char* ws = args.ws;
    unsigned* ctl = (unsigned*)(ws + WS_CTL);
    const int lo = args.ph_lo, hi = args.ph_hi;
    const float* x = (const float*)args.in[0]; const float* cvec = (const float*)args.in[1]; const int* positions = (const int*)args.in[2];
    const float* w_ada = (const float*)args.in[3]; const float* b_ada = (const float*)args.in[4]; const float* norm1_g = (const float*)args.in[5];
    const float* w_in = (const float*)args.in[6]; const float* idx_knorm_g = (const float*)args.in[7]; const float* idx_knorm_b = (const float*)args.in[8];
    const float* lb_logits = (const float*)args.in[9]; const float* hgrn_norm_g = (const float*)args.in[10];
    const float* w_proj_att = (const float*)args.in[11]; const float* w_proj_hgrn = (const float*)args.in[12]; const float* w_out = (const float*)args.in[13];
    const float* norm2_g = (const float*)args.in[14]; const float* w_router = (const float*)args.in[15]; const float* b_router = (const float*)args.in[16];
    const float* w1 = (const float*)args.in[17]; const float* b1 = (const float*)args.in[18]; const float* w2 = (const float*)args.in[19]; const float* b2 = (const float*)args.in[20];
    const float* final_g = (const float*)args.in[21];
    float* out = args.out;
    float* MOD = (float*)(ws + WS_MOD); int* TOPE = (int*)(ws + WS_TOPE); float* GATE = (float*)(ws + WS_GATE); int* SLOT = (int*)(ws + WS_SLOT);
    bf16_t* WIN_T = (bf16_t*)(ws + WS_WIN_T); bf16_t* WA_T = (bf16_t*)(ws + WS_WA_T); bf16_t* WH_T = (bf16_t*)(ws + WS_WH_T); bf16_t* WO_T = (bf16_t*)(ws + WS_WO_T);
    unsigned char* WIN_T8 = ws + WS_WIN_T + 8 * MiB;
    unsigned char* HA8 = ws + WS_SCORES;
    unsigned char* W1_T = ws + WS_W1_T; unsigned char* W2_T = ws + WS_W2_T;
    bf16_t* HB = (bf16_t*)(ws + WS_H); bf16_t* PROJ = (bf16_t*)(ws + WS_PROJ);
    bf16_t* DELTA = (bf16_t*)(ws + WS_ATT);
    unsigned char* ACT = ws + WS_ACT; bf16_t* YB = (bf16_t*)(ws + WS_YB);
    int* TOKS = (int*)(ws + WS_TOKS);
    unsigned char* H8 = ws + WS_H;
    bf16_t* KI = (bf16_t*)(ws + WS_KI); unsigned char* KC = ws + WS_KC; unsigned char* VC = ws + WS_VC;
    bf16_t* ST = (bf16_t*)(ws + WS_ST); float* DC = (float*)(ws + WS_DC);
    unsigned char* ATT = ws + WS_ATT; unsigned char* REC = ATT + (size_t)S * 1024;        bf16_t* MERGED = (bf16_t*)(ws + WS_MERGED); unsigned short* SCORES = (unsigned short*)(ws + WS_SCORES);
    unsigned short* SEGMAX = (unsigned short*)(ws + WS_X1);

    for (int u = tid; u < 128; u += NTHR) MISC[u] = 0u;
    __syncthreads();
    const bool one_launch = (hi - lo) > 1;
    XcdBarrier bar; bar.bar = ctl + CW_BAR; bar.x = 0; bar.st = MISC + 8;
    if (one_launch) bar = xcd_barrier_post(ctl + CW_BAR, MISC + 8);
#define IN(k) (lo <= (k) && (k) < hi)
#define SEAM(k) do { if (IN(k) && IN((k) + 1)) xcd_barrier(bar); } while (0)


    if (IN(PH_PRO)) {
        for (int cb = wg; cb < 256; cb += G) {
            LAS float* red = (LAS float*)lds;
            const int c4 = tid % 12, kg = tid / 12;
            f32x4 acc = (f32x4){0.f, 0.f, 0.f, 0.f};
            if (kg < 42) {
                const float* wp = w_ada + (size_t)cb * 48 + 4 * c4;
#pragma unroll 7
                for (int j = 0; j < 49; ++j) { const int k = kg + 42 * j; if (k < D) { const f32x4 v = __builtin_nontemporal_load((const f32x4*)(wp + (size_t)k * (6 * D))); acc += siluf_(cvec[k]) * v; } }
                *(LAS f32x4*)(red + kg * 48 + 4 * c4) = acc;
            }
            __syncthreads();
            if (tid < 48) { float s = b_ada[cb * 48 + tid];
#pragma unroll 6
                for (int q = 0; q < 42; ++q) s += red[q * 48 + tid];
                MOD[cb * 48 + tid] = s; }
            __syncthreads();
        }
        LAS unsigned char* scr = lds + wave * 17408;
        const int gw = wg * NWAVES + wave, NGW = G * NWAVES;
        {
            constexpr int NB_IN = (1104 + 63) / 64;
            for (int it = gw; it < 16 * NB_IN; it += NGW) convert_item(w_in + 1536, 2048, 1104, DIN, WIN_T, 0, it, lane, scr);
            for (int it = gw; it < 4 * 32; it += NGW) convert_item8(w_proj_att, 1024, 2048, 2048, (unsigned char*)WA_T, 0, it, lane, scr);
            for (int it = gw; it < 4 * 32; it += NGW) convert_item8(w_proj_hgrn, 1024, 2048, 2048, (unsigned char*)WA_T + (size_t)2048 * 1024, 0, it, lane, scr);
            for (int it = gw; it < 8 * 32; it += NGW) convert_item8(w_out, 2048, 2048, 2048, (unsigned char*)WO_T, 0, it, lane, scr);
            for (int it = gw; it < 8 * 24; it += NGW) convert_item8(w_in, 2048, 1536, DIN, WIN_T8, 0, it, lane, scr);
            for (int it = gw; it < 8 * 128; it += NGW) convert_item8(w_in + 2640, 2048, 8192, DIN, WIN_T8 + (size_t)1536 * 2048, 0, it, lane, scr);
            for (size_t i = (size_t)wg * NTHR + tid; i < (size_t)176 * 2048 * 2 / 16; i += (size_t)G * NTHR) ((u32x4*)(WIN_T + (size_t)1104 * 2048))[i] = (u32x4){0u, 0u, 0u, 0u};
        }
    }
    SEAM(PH_PRO);

    {
    if (IN(PH_H)) {
        const float* sh1 = MOD; const float* sc1 = MOD + D;
        const int gw = wg * NWAVES + wave, NGW = G * NWAVES;
        f32x4 gs[8], sh[8];
#pragma unroll
        for (int j = 0; j < 8; ++j) { const int c = 4 * lane + 256 * j; const f32x4 g = *(const f32x4*)(norm1_g + c), sc = *(const f32x4*)(sc1 + c); sh[j] = *(const f32x4*)(sh1 + c);
#pragma unroll
            for (int e = 0; e < 4; ++e) gs[j][e] = g[e] * (1.0f + sc[e]); }
        for (int t = gw; t < S; t += NGW) {
            const f32x4* xr = (const f32x4*)(x + (size_t)t * D) + lane;
            f32x4 v[8]; float ss = 0.f;
#pragma unroll
            for (int j = 0; j < 8; ++j) { v[j] = xr[64 * j]; ss += (v[j][0] * v[j][0] + v[j][1] * v[j][1]) + (v[j][2] * v[j][2] + v[j][3] * v[j][3]); }
            const float rstd = rsqrtf(wave_sum(ss) * (1.0f / D) + NORM_EPS);
#pragma unroll
            for (int j = 0; j < 8; ++j) { const f32x4 h = v[j] * rstd * gs[j] + sh[j]; u32x2 w; w.x = cvt_pk_bf16(h[0], h[1]); w.y = cvt_pk_bf16(h[2], h[3]);
                *(u32x2*)(HB + (size_t)t * D + 4 * lane + 256 * j) = w;
                *(unsigned*)(HA8 + (size_t)t * D + 4 * lane + 256 * j) = pack4_fp8(h[0], h[1], h[2], h[3]); }
        }
    }
    SEAM(PH_H);
    if (IN(PH_INPROJ)) {
        const int XC = (G == 256) ? XCONV : 0;
        const Conv8Job j1{w1, W1_T, 4096, 2, (size_t)2048 * 4096, (size_t)4096 * 2048, 8 * 16};
        const Conv8Job j2{w2, W2_T, 2048, 0, (size_t)2048 * 2048, (size_t)2048 * 2048, 8 * 8};
        if (G != 256) { conv8_run(lds, j1, NEXP * 8 * 16, wg, G, tid, wave, lane); conv8_run(lds, j2, NEXP * 8 * 8, wg, G, tid, wave, lane); }
        if (wg < XC) { conv8_run(lds, j1, NEXP * 8 * 16, wg, XC, tid, wave, lane); conv8_run(lds, j2, NEXP * 8 * 8, wg, XC, tid, wave, lane); }
        else {
            const int Gg = G - XC, cg = wg - XC;
            {
                pg8::Gemm g8{HA8, WIN_T8, 2048, 0, nullptr, 0}; pg8::StaticOrder S8; S8.init(S, 9728, Gg, cg);
                const int full8 = 2432 / Gg, rem8 = 2432 - full8 * Gg;
                if (Gg == 256) S8.skew(8, (wg >= 128 && wg < 192) ? -1 : (wg < 128 ? wg : wg - 64), 192);
                else if (rem8 > 0) S8.skew(full8, cg < rem8 ? cg : -1, rem8);
                pg8::EpiBf16 E8{PROJ, DINP, nullptr, 0, 1.0f / W8_SCALE, 6, 1280};
                pg8::gemm_phase<pg8::EpiBf16, pg8::StaticOrder, true>(lds, g8, S8, E8);
            }
            {
                pg8::Gemm g{HB, WIN_T, 2048, 0, nullptr, 0}; pg8::StaticOrder So; So.init(S, 1280, Gg, Gg == 256 ? (wg + 128) % G : (cg + Gg - (2432 % Gg)) % Gg);
                pg8::EpiBf16 E{PROJ + CQI, DINP, nullptr, 0, 1.0f, 1 << 30, 0};
                pg8::gemm_phase<pg8::EpiBf16, pg8::StaticOrder>(lds, g, So, E);
            }
        }
    }
    SEAM(PH_INPROJ);
    if (IN(PH_POST)) {
        const int gw = wg * NWAVES + wave, NGW = G * NWAVES;
        for (int t = gw; t < S; t += NGW) post_token(PROJ, KI, KC, VC, positions, idx_knorm_g, idx_knorm_b, t, lane);
        __syncthreads();
        for (int u = wg; u < 2048; u += G) hgrn_l1(lds, PROJ, lb_logits, ST, DC, u >> 3, u & 7, tid, wave, lane);
    }
    SEAM(PH_POST);
    if (IN(PH_SCORE)) {
        for (int idx = wg * NTHR + tid; idx < 8 * 128 * 128; idx += G * NTHR) {
            const int h = idx >> 14, d = idx & 127; float s = 0.f;
            bf16_t* sp = ST + idx; const float* dp = DC + h * 128 + d;
            for (int c = 0; c < 256; c += 16) {
                float l[16], dc[16];
#pragma unroll
                for (int i = 0; i < 16; ++i) { l[i] = bf2f(sp[(size_t)(c + i) * 131072]); dc[i] = dp[(size_t)(c + i) * 1024]; }
#pragma unroll
                for (int i = 0; i < 16; ++i) { sp[(size_t)(c + i) * 131072] = f2bf(s); s = dc[i] * s + l[i]; }
            }
        }
        {
            const int XS = (G == 256) ? XSCORE : 0;
            if (wg < XS) {
                const Conv8Job j1{w1, W1_T, 4096, 2, (size_t)2048 * 4096, (size_t)4096 * 2048, 8 * 16};
                const Conv8Job j2{w2, W2_T, 2048, 0, (size_t)2048 * 2048, (size_t)2048 * 2048, 8 * 8};
                __syncthreads();
                conv8_run(lds, j1, NEXP * 8 * 16, wg, XS, tid, wave, lane); conv8_run(lds, j2, NEXP * 8 * 8, wg, XS, tid, wave, lane);
            }
            for (;;) {
                if (tid == 0) MISC[100] = __hip_atomic_fetch_add(ctl + CW_SCQ, 1u, __ATOMIC_RELAXED, __HIP_MEMORY_SCOPE_AGENT);
                __syncthreads();
                const int item = (int)MISC[100];
                __syncthreads();
                if (item >= 252 * 6) break;
                int j, lo, hi;
                if (item < 504) { j = item >> 1; const int T = ((8 + j) >> 2) + ((511 - j) >> 2) + 2; const int p = item & 1; lo = p * T / 3; hi = (p + 1) * T / 3; }
                else { const int i2 = item - 504; j = i2 >> 2; const int T = ((8 + j) >> 2) + ((511 - j) >> 2) + 2; const int p = i2 & 3, b = 2 * T / 3; lo = b + p * (T - b) / 4; hi = b + (p + 1) * (T - b) / 4; }
                const int qa = 8 + j, qb2 = 511 - j, na = (qa >> 2) + 1;
                const int a0 = lo < na ? lo : na, a1 = hi < na ? hi : na, b0 = (lo > na ? lo : na) - na, b1 = (hi > na ? hi : na) - na;
                if (a1 > a0) score_block(lds, PROJ, KI, SCORES, SEGMAX, qa, a0, a1, tid, wave, lane);
                if (b1 > b0) score_block(lds, PROJ, KI, SCORES, SEGMAX, qb2, b0, b1, tid, wave, lane);
            }
        }
    }
    SEAM(PH_SCORE);
    if (IN(PH_ATTN)) {
        const int gw = wg * NWAVES + wave, NGW = G * NWAVES;
        for (int u = wg; u < 2048; u += G) hgrn_l3(lds, PROJ, lb_logits, ST, hgrn_norm_g, REC, u >> 3, u & 7, tid, wave, lane);
        {
            for (;;) {
                unsigned tq = 0; if (lane == 0) tq = __hip_atomic_fetch_add(ctl + CW_ATQ, 1u, __ATOMIC_RELAXED, __HIP_MEMORY_SCOPE_AGENT);
                tq = (unsigned)__builtin_amdgcn_readfirstlane((int)tq);
                if (tq >= (unsigned)S) break;
                const int t = S - 1 - (int)tq;
                LAS unsigned char* wl = lds + wave * 17664;
                if (t >= 256) select_row(wl, SCORES, SEGMAX, t, lane);
                else {
#pragma unroll
                    for (int i = 0; i < 4; ++i) { const int idx = lane + 64 * i; ((LAS int*)wl)[idx] = idx <= t ? idx : 0; }
                }
                attn_query(wl, PROJ, KC, VC, ATT, t, lane);
            }
        }
    }
    SEAM(PH_ATTN);
    if (IN(PH_OP1)) {
        pg8::Gemm g{ATT, WA_T, 1024, (size_t)2048 * 1024, nullptr, (size_t)S * 1024};
        pg8::TwoPartOrder So; So.init(S, 2048, G, wg);
        pg8::EpiGate2 E{(unsigned char*)MERGED, PROJ + CGA, PROJ + CGR};
        pg8::gemm_phase<pg8::EpiGate2, pg8::TwoPartOrder, true>(lds, g, So, E);
    }
    SEAM(PH_OP2);
    if (IN(PH_WOUT)) {
        pg8::Gemm g{MERGED, WO_T, 2048, 0, nullptr, 0}; pg8::StaticOrder So; So.init(S, 2048, G, wg);
        pg8::EpiDelta E{MOD + 2 * D, DELTA, 1.0f / (W8_SCALE * MRG8_SCALE)};
        pg8::gemm_phase<pg8::EpiDelta, pg8::StaticOrder, true>(lds, g, So, E);
    }
    SEAM(PH_WOUT);
    }

    if (IN(PH_ROUTER)) {
        LAS float* hs = (LAS float*)lds;
        volatile LAS unsigned* lcnt = MISC + 32;
        const float* sh2 = MOD + 3 * D; const float* sc2 = MOD + 4 * D;
        if (tid < 32) lcnt[tid] = 0u;
        __syncthreads();
        for (int grp = wg; grp < S / 16; grp += G) {
#pragma unroll 1
            for (int q = 0; q < 2; ++q) {
                const int tl = 2 * wave + q, t = grp * 16 + tl;
                const f32x4* xr = (const f32x4*)(x + (size_t)t * D) + lane; const u32x2* dr = (const u32x2*)(DELTA + (size_t)t * D) + lane;
                f32x4 v[8]; float ss = 0.f;
#pragma unroll
                for (int j = 0; j < 8; ++j) { const u32x2 dw = dr[64 * j]; v[j] = xr[64 * j] + (f32x4){bf_lo(dw.x), bf_hi(dw.x), bf_lo(dw.y), bf_hi(dw.y)};
                    ss += (v[j][0] * v[j][0] + v[j][1] * v[j][1]) + (v[j][2] * v[j][2] + v[j][3] * v[j][3]); }
                const float rstd = rsqrtf(wave_sum(ss) * (1.0f / D) + NORM_EPS);
#pragma unroll
                for (int j = 0; j < 8; ++j) {
                    const int c = 4 * lane + 256 * j;
                    const f32x4 g = *(const f32x4*)(norm2_g + c), sc = *(const f32x4*)(sc2 + c), sh = *(const f32x4*)(sh2 + c);
                    f32x4 h;
#pragma unroll
                    for (int e = 0; e < 4; ++e) h[e] = v[j][e] * rstd * g[e] * (1.0f + sc[e]) + sh[e];
                    *(LAS f32x4*)(hs + tl * 2048 + c) = h;
                    *(unsigned*)(H8 + (size_t)t * D + c) = pack4_fp8(h[0], h[1], h[2], h[3]);
                }
            }
            __syncthreads();
            {
                LAS float* part = (LAS float*)(lds + 131072);
                const int fr = lane & 15, fq = lane >> 4;
                f32x4 acc0 = (f32x4){0.f, 0.f, 0.f, 0.f}, acc1 = acc0;
                const LAS float* hrow = hs + fr * 2048 + wave * 256 + 4 * fq; const float* wrp = w_router + (size_t)(wave * 256 + 4 * fq) * 32 + fr;
#pragma unroll 2
                for (int i = 0; i < 16; ++i) {
                    const f32x4 a4 = *(const LAS f32x4*)(hrow + 16 * i);
                    float b0[4], b1[4];
#pragma unroll
                    for (int s = 0; s < 4; ++s) { b0[s] = wrp[(size_t)(16 * i + s) * 32]; b1[s] = wrp[(size_t)(16 * i + s) * 32 + 16]; }
#pragma unroll
                    for (int s = 0; s < 4; ++s) { acc0 = __builtin_amdgcn_mfma_f32_16x16x4f32(a4[s], b0[s], acc0, 0, 0, 0); acc1 = __builtin_amdgcn_mfma_f32_16x16x4f32(a4[s], b1[s], acc1, 0, 0, 0); }
                }
#pragma unroll
                for (int r = 0; r < 4; ++r) { part[(wave * 16 + 4 * fq + r) * 32 + fr] = acc0[r]; part[(wave * 16 + 4 * fq + r) * 32 + 16 + fr] = acc1[r]; }
                __syncthreads();
                const int tl = tid >> 5, e = tid & 31, t = grp * 16 + tl;
                float v = b_router[e];
#pragma unroll
                for (int w = 0; w < 8; ++w) v += part[(w * 16 + tl) * 32 + e];
                float tv[4]; int ti[4];
#pragma unroll
                for (int k = 0; k < 4; ++k) {
                    float bv = v; int bi = e;
#pragma unroll
                    for (int o = 16; o >= 1; o >>= 1) { const float ov = __shfl_xor(bv, o); const int oi = __shfl_xor(bi, o); if (ov > bv || (ov == bv && oi < bi)) { bv = ov; bi = oi; } }
                    tv[k] = bv; ti[k] = bi; if (e == bi) v = -__builtin_inff();
                }
                if (e == 0) {
                    const float e1 = __expf(tv[1] - tv[0]), e2 = __expf(tv[2] - tv[0]), e3 = __expf(tv[3] - tv[0]); const float inv = 1.0f / (1.0f + e1 + e2 + e3);
                    *(int4*)(TOPE + (size_t)t * 4) = make_int4(ti[0], ti[1], ti[2], ti[3]);
                    *(f32x4*)(GATE + (size_t)t * 4) = (f32x4){inv, e1 * inv, e2 * inv, e3 * inv};
#pragma unroll
                    for (int k = 0; k < 4; ++k) __hip_atomic_fetch_add((LAS unsigned*)&lcnt[ti[k]], 1u, __ATOMIC_RELAXED, __HIP_MEMORY_SCOPE_WORKGROUP);
                }
            }
            __syncthreads();
        }
        if (tid < 32) { const unsigned c = lcnt[tid]; if (c) __hip_atomic_fetch_add(ctl + CW_CNT + tid, c, __ATOMIC_RELAXED, __HIP_MEMORY_SCOPE_AGENT); }
    }
    SEAM(PH_ROUTER);

    if (IN(PH_SCATTER)) {
        volatile LAS unsigned* lcnt = MISC + 32; volatile LAS unsigned* lbase = MISC + 64; LAS int* pstart = (LAS int*)(lds + 1024); LAS int* pcnt = (LAS int*)(lds + 1280);
        if (tid == 0) { int p = 0; for (int e = 0; e < NEXP; ++e) { const int c = (int)__hip_atomic_load(ctl + CW_CNT + e, __ATOMIC_RELAXED, __HIP_MEMORY_SCOPE_AGENT); pstart[e] = p; pcnt[e] = c; p += (c + 255) & ~255; } }
        if (tid < 32) lcnt[tid] = 0u;
        __syncthreads();
        if (wg < NEXP) { const int e = wg; for (int s = pstart[e] + pcnt[e] + tid; s < pstart[e] + ((pcnt[e] + 255) & ~255); s += NTHR) TOKS[s] = 0; }
        for (int blk = wg; blk < S / 64; blk += G) {
            int e = 0, lrank = 0;
            if (tid < 256) { e = TOPE[(size_t)blk * 256 + tid]; lrank = (int)__hip_atomic_fetch_add((LAS unsigned*)&lcnt[e], 1u, __ATOMIC_RELAXED, __HIP_MEMORY_SCOPE_WORKGROUP); }
            __syncthreads();
            if (tid < 32) { const unsigned c = lcnt[tid]; lbase[tid] = c ? __hip_atomic_fetch_add(ctl + CW_FILL + tid, c, __ATOMIC_RELAXED, __HIP_MEMORY_SCOPE_AGENT) : 0u; }
            __syncthreads();
            if (tid < 256) { const int slot = pstart[e] + (int)lbase[e] + lrank; SLOT[(size_t)blk * 256 + tid] = slot; TOKS[slot] = blk * 64 + (tid >> 2); }
            __syncthreads();
            if (tid < 32) lcnt[tid] = 0u;
            __syncthreads();
        }
    }
    SEAM(PH_SCATTER);

    if (IN(PH_MOE1) || IN(PH_MOE2)) {
        LAS int* panel_e = (LAS int*)(lds + 131072 + 2048);
        LAS int* npan = (LAS int*)(lds + 131072 + 2048 + 2048);
        __syncthreads();
        if (tid == 0) { int p = 0; for (int e = 0; e < NEXP; ++e) { const int np = (int)((__hip_atomic_load(ctl + CW_CNT + e, __ATOMIC_RELAXED, __HIP_MEMORY_SCOPE_AGENT) + 255u) >> 8); for (int q = 0; q < np; ++q) panel_e[p + q] = e; p += np; } npan[0] = p; }
        __syncthreads();
        const int nPanels = npan[0];
        if (IN(PH_MOE1)) {
            pg8::Gemm g{H8, W1_T, 2048, (size_t)4096 * 2048, TOKS, 0}; pg8::MoeOrder So; So.init(nPanels, 16, G, wg, panel_e);
            pg8::EpiSwiglu E{ACT, b1};
            pg8::gemm_phase<pg8::EpiSwiglu, pg8::MoeOrder, true>(lds, g, So, E);
        }
        SEAM(PH_MOE1);
        if (IN(PH_MOE2)) {
            pg8::Gemm g{ACT, W2_T, 2048, (size_t)2048 * 2048, nullptr, 0}; pg8::MoeOrder So; So.init(nPanels, 8, G, wg, panel_e);
            pg8::EpiBf16 E{YB, 2048, b2, 2048, 1.0f / (W8_SCALE * ACT8_SCALE), 1 << 30, 0};
            pg8::gemm_phase<pg8::EpiBf16, pg8::MoeOrder, true>(lds, g, So, E);
        }
    }
    SEAM(PH_MOE2);

    if (IN(PH_FINAL)) {
        const float* gt2 = MOD + 5 * D;
        const int gw = wg * NWAVES + wave, NGW = G * NWAVES;
        for (int t = gw; t < S; t += NGW) {
            const f32x4* xr = (const f32x4*)(x + (size_t)t * D) + lane; const u32x2* dr = (const u32x2*)(DELTA + (size_t)t * D) + lane;
            f32x4 v[8];
#pragma unroll
            for (int j = 0; j < 8; ++j) { const u32x2 dw = dr[64 * j]; v[j] = xr[64 * j] + (f32x4){bf_lo(dw.x), bf_hi(dw.x), bf_lo(dw.y), bf_hi(dw.y)}; }
            {
                f32x4 m[8];
#pragma unroll
                for (int j = 0; j < 8; ++j) m[j] = (f32x4){0.f, 0.f, 0.f, 0.f};
                const int4 sl = *(const int4*)(SLOT + (size_t)t * 4); const f32x4 gt = *(const f32x4*)(GATE + (size_t)t * 4);
                const int sls[4] = {sl.x, sl.y, sl.z, sl.w};
#pragma unroll
                for (int k = 0; k < 4; ++k) {
                    const u32x2* yr = (const u32x2*)(YB + (size_t)sls[k] * D) + lane; const float gk = gt[k];
#pragma unroll
                    for (int j = 0; j < 8; ++j) { const u32x2 w = yr[64 * j]; m[j][0] += gk * bf_lo(w.x); m[j][1] += gk * bf_hi(w.x); m[j][2] += gk * bf_lo(w.y); m[j][3] += gk * bf_hi(w.y); }
                }
#pragma unroll
                for (int j = 0; j < 8; ++j) { const f32x4 g2 = *(const f32x4*)(gt2 + 4 * lane + 256 * j); v[j] = v[j] + g2 * m[j]; }
            }
            float ss = 0.f;
#pragma unroll
            for (int j = 0; j < 8; ++j) ss += (v[j][0] * v[j][0] + v[j][1] * v[j][1]) + (v[j][2] * v[j][2] + v[j][3] * v[j][3]);
            const float rstd = rsqrtf(wave_sum(ss) * (1.0f / D) + NORM_EPS);
            f32x4* orow = (f32x4*)(out + (size_t)t * D) + lane;
#pragma unroll
            for (int j = 0; j < 8; ++j) { const f32x4 fg = *(const f32x4*)(final_g + 4 * lane + 256 * j); orow[64 * j] = v[j] * rstd * fg; }
        }
    }
#undef IN
#undef SEAM
}

#ifndef MK_ONE_LAUNCH
#define MK_ONE_LAUNCH 1
#endif
extern "C" void kernel_launch(void* const* d_in, const int* in_sizes, int n_in, void* d_out, int out_size, void* d_ws, size_t ws_size, hipStream_t stream) {
    static int grid = 0;
    if (grid == 0) {
        if (n_in != 22 || out_size != S * D || ws_size < WS_END) { fprintf(stderr, "kernel_launch: unexpected shapes: n_in %d out %d ws %zu (need %zu)\n", n_in, out_size, ws_size, (size_t)WS_END); grid = -1; return; }
        int dev = 0, cus = 0, per_cu = 0;
        if (hipGetDevice(&dev) != hipSuccess || hipDeviceGetAttribute(&cus, hipDeviceAttributeMultiprocessorCount, dev) != hipSuccess) { grid = -1; return; }
        if (hipFuncSetAttribute((const void*)fwd_kernel, hipFuncAttributeMaxDynamicSharedMemorySize, LDS_BYTES) != hipSuccess) { fprintf(stderr, "kernel_launch: hipFuncSetAttribute failed\n"); grid = -1; return; }
        if (hipOccupancyMaxActiveBlocksPerMultiprocessor(&per_cu, (const void*)fwd_kernel, NTHR, LDS_BYTES) != hipSuccess || per_cu < 1) { fprintf(stderr, "kernel_launch: occupancy query says %d\n", per_cu); (void)hipGetLastError(); grid = -1; return; }
        grid = cus;
    }
    if (grid < 0) return;
    (void)in_sizes;
    hipMemsetAsync((char*)d_ws + WS_CTL, 0, CTL_BYTES, stream);
    Args a{};
    for (int i = 0; i < 22; ++i) a.in[i] = d_in[i];
    a.out = (float*)d_out; a.ws = (unsigned char*)d_ws; a.flags = 0; a.pad = 0;
#if MK_ONE_LAUNCH
    a.ph_lo = 0; a.ph_hi = NPH;
    hipLaunchKernelGGL(fwd_kernel, dim3(grid), dim3(NTHR), LDS_BYTES, stream, a);
#else
    for (int p = 0; p < NPH; ++p) { a.ph_lo = p; a.ph_hi = p + 1; hipLaunchKernelGGL(fwd_kernel, dim3(grid), dim3(NTHR), LDS_BYTES, stream, a); }
#endif
}
```

```cpp
#include <hip/hip_runtime.h>
#include <cstdio>
#include <cstdint>

#define GAS __attribute__((address_space(1)))
#define LAS __attribute__((address_space(3)))
typedef unsigned short bf16_t;
typedef short bf16x8 __attribute__((ext_vector_type(8)));
typedef float f32x4 __attribute__((ext_vector_type(4)));
typedef float f32x2 __attribute__((ext_vector_type(2)));
typedef float f32x16 __attribute__((ext_vector_type(16)));
typedef unsigned u32x4 __attribute__((ext_vector_type(4)));
typedef unsigned u32x2 __attribute__((ext_vector_type(2)));
typedef int i32x4 __attribute__((ext_vector_type(4)));
typedef int i32x8 __attribute__((ext_vector_type(8)));
typedef short s16x4 __attribute__((ext_vector_type(4)));
typedef short s16x2 __attribute__((ext_vector_type(2)));
typedef int v2i32 __attribute__((ext_vector_type(2)));

constexpr int S = 16384, D = 2048, DIN = 10832, DINP = 11008, NEXP = 32, DFF = 2048;
constexpr int NWAVES = 8, NTHR = 512;
constexpr int CQ = 0, CK = 1024, CV = 1280, CQI = 1536, CKI = 2560, CWI = 2624, CHQ = 2816, CHF = 3840, CHI = 4864, CHG = 5888, CGA = 6912, CGR = 8960;
constexpr int PMAX = 65536 + NEXP * 256;
constexpr float NORM_EPS = 1e-5f;

constexpr size_t MiB = 1u << 20;
constexpr size_t al256(size_t x) { return (x + 255) & ~(size_t)255; }
constexpr size_t WS_CTL = 0, CTL_BYTES = 1 * MiB;
constexpr size_t WS_MOD = WS_CTL + CTL_BYTES;
constexpr size_t WS_TOPE = WS_MOD + 64 * 1024;
constexpr size_t WS_GATE = WS_TOPE + (size_t)S * 16;
constexpr size_t WS_SLOT = WS_GATE + (size_t)S * 16;
constexpr size_t WS_WIN_T = WS_SLOT + (size_t)S * 16;
constexpr size_t WS_WA_T = WS_WIN_T + (size_t)DINP * D * 2;
constexpr size_t WS_WH_T = WS_WA_T + (size_t)2048 * 1024 * 2;
constexpr size_t WS_WO_T = WS_WH_T + (size_t)2048 * 1024 * 2;
constexpr size_t WS_W1_T = WS_WO_T + (size_t)2048 * 2048 * 2;
constexpr size_t WS_W2_T = WS_W1_T + (size_t)NEXP * 4096 * 2048 * 2;
constexpr size_t WS_H = WS_W2_T + (size_t)NEXP * 2048 * 2048 * 2;
constexpr size_t WS_PROJ = WS_H + (size_t)S * D * 2;
constexpr size_t WS_KI = WS_PROJ + (size_t)S * DINP * 2;
constexpr size_t WS_KC = WS_KI + (size_t)S * 64 * 2;
constexpr size_t WS_VC = WS_KC + (size_t)S * 256 * 2;
constexpr size_t WS_ST = WS_VC + (size_t)S * 256 * 2;
constexpr size_t WS_DC = WS_ST + (size_t)256 * 8 * 128 * 128 * 4;
constexpr size_t WS_SEL = WS_DC + (size_t)256 * 8 * 128 * 4;
constexpr size_t WS_ATT = WS_SEL + (size_t)S * 256 * 4;
constexpr size_t WS_REC = WS_ATT + (size_t)S * 1024 * 2;
constexpr size_t WS_MERGED = WS_REC + (size_t)S * 1024 * 2;
constexpr size_t WS_X1 = WS_MERGED + (size_t)S * 2048 * 2;
constexpr size_t WS_SCORES = WS_X1 + (size_t)S * 2048 * 4;
constexpr size_t WS_XB = WS_SCORES;
constexpr size_t WS_ACT = WS_XB + (size_t)PMAX * 2048 * 2;
constexpr size_t WS_YB = WS_ACT + (size_t)PMAX * 2048 * 2;
constexpr size_t WS_END = WS_SCORES + (size_t)S * S * 4;
static_assert(WS_YB + (size_t)PMAX * 2048 * 2 <= WS_END, "MoE buffers overlay the score matrix");
static_assert(WS_END <= (size_t)4096 * MiB, "workspace");
constexpr int CW_BAR = 4096, CW_CNT = 8192, CW_FILL = 8448;
constexpr size_t WS_TOKS = WS_SEL;

constexpr int LDS_BYTES = 155648;
constexpr int LDS_MISC = LDS_BYTES - 512;

__device__ __forceinline__ unsigned cvt_pk_bf16(float lo, float hi) { unsigned r; asm volatile("v_cvt_pk_bf16_f32 %0, %1, %2" : "=v"(r) : "v"(lo), "v"(hi)); return r; }
__device__ __forceinline__ float bf_lo(unsigned u) { return __uint_as_float(u << 16); }
__device__ __forceinline__ float bf_hi(unsigned u) { return __uint_as_float(u & 0xffff0000u); }
__device__ __forceinline__ float bf2f(bf16_t b) { return __uint_as_float(((unsigned)b) << 16); }
__device__ __forceinline__ float wave_sum(float v) {
#define DPPS(ctrl, rmask) { const int s_ = __builtin_amdgcn_update_dpp(0, __float_as_int(v), ctrl, rmask, 0xF, false); v += __int_as_float(s_); }
    DPPS(0x111, 0xF) DPPS(0x112, 0xF) DPPS(0x114, 0xF) DPPS(0x118, 0xF) DPPS(0x142, 0xA) DPPS(0x143, 0xC)
#undef DPPS
    return __int_as_float(__builtin_amdgcn_readlane(__float_as_int(v), 63));
}
__device__ __forceinline__ float wave_max(float v) {
#define DPPM(ctrl, rmask) { const int o_ = __float_as_int(v); const int s_ = __builtin_amdgcn_update_dpp(o_, o_, ctrl, rmask, 0xF, false); v = fmaxf(v, __int_as_float(s_)); }
    DPPM(0x111, 0xF) DPPM(0x112, 0xF) DPPM(0x114, 0xF) DPPM(0x118, 0xF) DPPM(0x142, 0xA) DPPM(0x143, 0xC)
#undef DPPM
    return __int_as_float(__builtin_amdgcn_readlane(__float_as_int(v), 63));
}
__device__ __forceinline__ float sigmoidf_(float x) { return __builtin_amdgcn_rcpf(1.0f + __expf(-x)); }
__device__ __forceinline__ float siluf_(float x) { return x * __builtin_amdgcn_rcpf(1.0f + __expf(-x)); }
__device__ __forceinline__ unsigned pack4_fp8(float a, float b, float c, float d) { int w = 0; w = __builtin_amdgcn_cvt_pk_fp8_f32(a, b, w, false); w = __builtin_amdgcn_cvt_pk_fp8_f32(c, d, w, true); return (unsigned)w; }
constexpr float W8_SCALE = 64.0f, ACT8_SCALE = 4.0f, MRG8_SCALE = 8.0f, OP8_SCALE = 16.0f;
__device__ __forceinline__ float relu_i(float x) { const int i = __float_as_int(x); return __int_as_float(i > 0 ? i : 0); }
__device__ __forceinline__ void fp8x16_to_bf16(const u32x4& w, u32x4& lo, u32x4& hi) {
    unsigned o[8];
#pragma unroll
    for (int q = 0; q < 4; ++q) { const unsigned wq = w[q]; const f32x2 a = __builtin_amdgcn_cvt_pk_f32_fp8((int)wq, false), b = __builtin_amdgcn_cvt_pk_f32_fp8((int)wq, true);
        o[2 * q] = cvt_pk_bf16(a[0], a[1]); o[2 * q + 1] = cvt_pk_bf16(b[0], b[1]); }
    lo = (u32x4){o[0], o[1], o[2], o[3]}; hi = (u32x4){o[4], o[5], o[6], o[7]};
}
__device__ __forceinline__ unsigned char fp8_1(float x) { return (unsigned char)(__builtin_amdgcn_cvt_pk_fp8_f32(x, x, 0, false) & 0xff); }
#define LDS_WAIT() asm volatile("s_waitcnt lgkmcnt(0)" ::: "memory")
#define VM_WAIT() asm volatile("s_waitcnt vmcnt(0)" ::: "memory")

#define XB_TMO      128
#define XB_XCNT(j)  (256  + 64 * (j))
#define XB_XSUB(j)  (1280 + 64 * (j))
#define XB_XGEN(j)  (2304 + 64 * (j))
#define XB_TOP      3328
#define XB_TOPGEN   3392
#define XCD_BAR_WORDS 3456
#define XB_SPIN_CAP (1u << 22)

__device__ __forceinline__ unsigned xb_ld(unsigned* p)              { return __hip_atomic_load(p, __ATOMIC_RELAXED, __HIP_MEMORY_SCOPE_AGENT); }
__device__ __forceinline__ unsigned xb_add(unsigned* p, unsigned v) { return __hip_atomic_fetch_add(p, v, __ATOMIC_RELAXED, __HIP_MEMORY_SCOPE_AGENT); }
__device__ __forceinline__ unsigned xb_xcc_id() { return (unsigned)__builtin_amdgcn_s_getreg((3 << 11) | 20) & 0xFu; }
#define XB_SPIN(cond, bar) do { unsigned _sp = 0; while (cond) { __builtin_amdgcn_s_sleep(1); \
    if ((++_sp & 255u) == 0u) { if (xb_ld(&(bar)[XB_TMO])) break; if (_sp > XB_SPIN_CAP) { atomicAdd(&(bar)[XB_TMO], 1u); break; } } } } while (0)

struct XcdBarrier { unsigned* bar; unsigned x; volatile LAS unsigned* st; };

__device__ __forceinline__ XcdBarrier xcd_barrier_post(unsigned* bar, volatile LAS unsigned* st) {
    XcdBarrier b; b.bar = bar; b.x = xb_xcc_id(); b.st = st;
    if (threadIdx.x == 0) (void)xb_add(&bar[XB_XCNT(b.x)], 1u);
    return b;
}
__device__ __forceinline__ void xcd_barrier_complete(unsigned* bar, unsigned x, unsigned& nloc, unsigned& nx) {
    const unsigned G = gridDim.x * gridDim.y * gridDim.z;
    unsigned sum, cnt, mine, sp = 0u;
    for (;;) {
        sum = 0u; cnt = 0u; mine = 0u;
#pragma unroll
        for (unsigned j = 0; j < 16; ++j) { const unsigned c = xb_ld(&bar[XB_XCNT(j)]); sum += c; cnt += (c > 0u) ? 1u : 0u; mine = (j == x) ? c : mine; }
        if (sum == G) break;
        __builtin_amdgcn_s_sleep(1);
        if ((++sp & 255u) == 0u) { if (xb_ld(&bar[XB_TMO])) break; if (sp > XB_SPIN_CAP) { atomicAdd(&bar[XB_TMO], 1u); break; } }
    }
    nloc = mine > 0u ? mine : 1u; nx = cnt > 0u ? cnt : 1u;
}
__device__ __forceinline__ void xcd_barrier(const XcdBarrier& b) {
    asm volatile("s_waitcnt vmcnt(0)" ::: "memory");
    __syncthreads();
    if (threadIdx.x == 0) {
        unsigned* bar = b.bar;
        __builtin_amdgcn_s_waitcnt(0);
        unsigned nloc = b.st[0], nx = b.st[1];
        if (nloc == 0u) { xcd_barrier_complete(bar, b.x, nloc, nx); b.st[0] = nloc; b.st[1] = nx; }
        const unsigned old = xb_add(&bar[XB_XSUB(b.x)], 1u);
        const unsigned gen = old / nloc;
        if (old + 1u == (gen + 1u) * nloc) {
            __builtin_amdgcn_fence(__ATOMIC_RELEASE, "agent");
            asm volatile("s_waitcnt vmcnt(0)" ::: "memory");
            const unsigned og = xb_add(&bar[XB_TOP], 1u);
            const unsigned tg = og / nx;
            if (og + 1u == (tg + 1u) * nx) xb_add(&bar[XB_TOPGEN], 1u);
            else XB_SPIN(xb_ld(&bar[XB_TOPGEN]) == tg, bar);
            __builtin_amdgcn_fence(__ATOMIC_ACQUIRE, "agent");
            xb_add(&bar[XB_XGEN(b.x)], 1u);
            asm volatile("s_waitcnt vmcnt(0)" ::: "memory");
        } else {
            XB_SPIN(xb_ld(&bar[XB_XGEN(b.x)]) == gen, bar);
            __builtin_amdgcn_fence(__ATOMIC_ACQUIRE, "agent");
            asm volatile("s_waitcnt vmcnt(0)" ::: "memory");
        }
    }
    __syncthreads();
}

namespace pg8 {
constexpr int BM = 256, BK = 64, HALF = 128, HTB = HALF * BK * 2, STAGE_BYTES = 8 * HTB, NXCD = 8, WGM = 8;
__host__ __device__ __forceinline__ int lds_byte(int r, int c) { const int st = (r >> 4) * 2 + (c >> 5), rr = r & 15, cc = c & 31, ob = rr * 64 + cc * 2; return st * 1024 + (ob ^ (((ob >> 9) & 1) << 5)); }
__host__ __device__ __forceinline__ void stage_rc(int b, int& R, int& C) { const int st = b / 1024, sb = b % 1024, swz = sb ^ (((sb >> 9) & 1) << 5); R = (st >> 1) * 16 + swz / 64; C = (st & 1) * 32 + (swz % 64) / 2; }
__host__ __device__ __forceinline__ int perm32(int rho) { const int n = rho >> 4, i = rho & 15; return 8 * (i >> 2) + 4 * n + (i & 3); }

struct Unit { int pm, pn, e; };
struct Gemm { const void* A; const void* Bt; int K; size_t estride; const int* arow; size_t astride; };

struct StaticOrder {
    int nM, nN, nwg, G, c, i, full, erank, en;
    __device__ void init(int M, int N, int G_, int c_) { nM = M / BM; nN = N / BM; nwg = nM * nN; G = G_; c = c_; i = 0; full = 1 << 30; erank = -1; en = 1; }
    __device__ void skew(int full_, int erank_, int en_) { full = full_; erank = erank_; en = en_; }
    __device__ bool next(Unit& u) {
        long L;
        if (i < full) L = (long)i * G + c; else { if (erank < 0) return false; L = (long)full * G + (long)(i - full) * en + erank; }
        ++i; if (L >= nwg) return false;
        int wgid = (int)L; { const int q = nwg / NXCD, r = nwg % NXCD, xcd = wgid % NXCD, off = wgid / NXCD; wgid = (xcd < r ? xcd * (q + 1) : r * (q + 1) + (xcd - r) * q) + off; }
        const int nig = WGM * nN, gid = wgid / nig, fm = gid * WGM, gsz = (nM - fm) < WGM ? (nM - fm) : WGM;
        u.pm = fm + ((wgid % nig) % gsz); u.pn = (wgid % nig) / gsz; u.e = 0; return true;
    }
};
struct MoeOrder {
    int nPanels, nN, G, c, i; const LAS int* panel_e;
    __device__ void init(int nPanels_, int nN_, int G_, int c_, const LAS int* pe) { nPanels = nPanels_; nN = nN_; G = G_; c = c_; i = 0; panel_e = pe; }
    __device__ bool next(Unit& u) {
        const int PB = 256 / nN;
        const int nblk = (nPanels + PB - 1) / PB;
        for (;;) {
            const long L = (long)i * G + c; ++i;
            const int blk = (int)(L >> 8), r = (int)(L & 255), x = r & 7, j = r >> 3;
            if (blk >= nblk) return false;
            int pm, pn;
            if (nN == 16) { pm = blk * 16 + 4 * (x >> 1) + (j & 3); pn = 8 * (x & 1) + (j >> 2); }
            else          { pm = blk * 32 + 4 * x + (j & 3);        pn = j >> 2; }
            if (pm < nPanels) { u.pm = pm; u.pn = pn; u.e = panel_e[pm]; return true; }
        }
    }
};

template <class Epi, class Sched, bool FP8 = false>
__device__ __forceinline__ void gemm_phase(LAS unsigned char* lds, const Gemm g, Sched& S, const Epi& E) {
    const int tid = threadIdx.x, wid = __builtin_amdgcn_readfirstlane(tid >> 6), lane = tid & 63, wr = wid >> 2, wc = wid & 3, fr = lane & 15, fq = lane >> 4;
    const int K = g.K; const int pitch = FP8 ? K : 2 * K; const int nt = pitch / 128;
    unsigned voffA[2], voffB[2];
#pragma unroll
    for (int i = 0; i < 2; ++i) { int R, C; stage_rc(tid * 16 + i * 8192, R, C); const int Rb = Epi::PERM ? ((R & ~31) + perm32(R & 31)) : R;
        voffA[i] = (unsigned)(R * pitch + C * 2); voffB[i] = (unsigned)(Rb * pitch + C * 2); }
    const size_t kstep = (size_t)(BK * 2);
    const size_t hstep = (size_t)HALF * pitch;
    const size_t tstep = 2 * hstep;
    int RA[2], CA[2];
#pragma unroll
    for (int i = 0; i < 2; ++i) stage_rc(tid * 16 + i * 8192, RA[i], CA[i]);
    const bool gather = g.arow != nullptr;
    const size_t hsA = gather ? 0 : hstep;
    unsigned vA0[2] = {voffA[0], voffA[1]}, vA1[2] = {voffA[0], voffA[1]}, nA0[2] = {voffA[0], voffA[1]}, nA1[2] = {voffA[0], voffA[1]};
#define PG8_AOFF(dst0, dst1, u) do { if (gather) { _Pragma("unroll") for (int i = 0; i < 2; ++i) { \
        dst0[i] = (unsigned)g.arow[(u).pm * 256 + RA[i]] * (unsigned)pitch + (unsigned)(CA[i] * 2); dst1[i] = (unsigned)g.arow[(u).pm * 256 + 128 + RA[i]] * (unsigned)pitch + (unsigned)(CA[i] * 2); } } } while (0)
    const unsigned ldsw = (unsigned)wid * 1024u;
    const int aoff = lds_byte(wr * 64 + fr, fq * 8), boff = lds_byte(wc * 32 + fr, fq * 8);
#define PG8_SA(b, h) (((b) * 2 + (h)) * HTB)
#define PG8_SB(b, h) ((4 + (b) * 2 + (h)) * HTB)
#define PG8_STAGE(bufoff, gbase, voff) do { _Pragma("unroll") for (int _i = 0; _i < 2; ++_i) \
        __builtin_amdgcn_global_load_lds((const unsigned*)((const char*)(gbase) + (voff)[_i]), (LAS unsigned*)(lds + (bufoff) + ldsw + _i * 8192), 16, 0, 0); } while (0)
#define PG8_LD8(p) __builtin_shufflevector(*(const LAS i32x4*)(p), *(const LAS i32x4*)((p) + 1024), 0, 1, 2, 3, 4, 5, 6, 7)
#define PG8_LDA(dst, b, h) do { _Pragma("unroll") for (int m = 0; m < 4; ++m) { if constexpr (FP8) dst##8[m] = PG8_LD8(lds + PG8_SA(b, h) + aoff + m * 2048); \
        else { _Pragma("unroll") for (int k = 0; k < 2; ++k) dst[m][k] = *(const LAS bf16x8*)(lds + PG8_SA(b, h) + aoff + m * 2048 + k * 1024); } } } while (0)
#define PG8_LDB(dst, b, h) do { _Pragma("unroll") for (int n = 0; n < 2; ++n) { if constexpr (FP8) dst##8[n] = PG8_LD8(lds + PG8_SB(b, h) + boff + n * 2048); \
        else { _Pragma("unroll") for (int k = 0; k < 2; ++k) dst[n][k] = *(const LAS bf16x8*)(lds + PG8_SB(b, h) + boff + n * 2048 + k * 1024); } } } while (0)
#define PG8_MMA(ai, bj, At, Bt) do { __builtin_amdgcn_s_setprio(1); _Pragma("unroll") for (int m = 0; m < 4; ++m) _Pragma("unroll") for (int n = 0; n < 2; ++n) { \
        if constexpr (FP8) asm volatile("v_mfma_scale_f32_16x16x128_f8f6f4 %0, %1, %2, %0, %3, %3 op_sel_hi:[0,0,0]" : "+v"(acc[ai][bj][m][n]) : "v"(Bt##8[n]), "v"(At##8[m]), "v"(scl1)); \
        else { _Pragma("unroll") for (int k = 0; k < 2; ++k) acc[ai][bj][m][n] = __builtin_amdgcn_mfma_f32_16x16x32_bf16(Bt[n][k], At[m][k], acc[ai][bj][m][n], 0, 0, 0); } } \
        __builtin_amdgcn_s_setprio(0); } while (0)
#define PG8_WAIT_V(n) asm volatile("s_waitcnt vmcnt(" #n ")" ::: "memory")
#define PG8_WAIT_L(n) asm volatile("s_waitcnt lgkmcnt(" #n ")" ::: "memory")
#define PG8_BAR __builtin_amdgcn_s_barrier()
#define PG8_SCHED __builtin_amdgcn_sched_barrier(0)
    Unit cur, nxt;
    if (!S.next(cur)) return;
    const unsigned scl1 = 0x7f7f7f7fu;
    f32x4 acc[2][2][4][2];
#pragma unroll
    for (int a = 0; a < 2; ++a)
#pragma unroll
        for (int b = 0; b < 2; ++b)
#pragma unroll
            for (int m = 0; m < 4; ++m)
#pragma unroll
                for (int n = 0; n < 2; ++n) acc[a][b][m][n] = (f32x4){0.f, 0.f, 0.f, 0.f};
    bf16x8 At[4][2], B0[2][2], B1[2][2]; i32x8 At8[4], B08[2], B18[2];
    const char* cA = (const char*)g.A + (size_t)cur.e * g.astride + (gather ? (size_t)0 : (size_t)cur.pm * tstep); const char* cB = (const char*)g.Bt + (size_t)cur.e * g.estride + (size_t)cur.pn * tstep;
    PG8_AOFF(vA0, vA1, cur);
    PG8_STAGE(PG8_SB(0, 0), cB, voffB); PG8_STAGE(PG8_SB(0, 1), cB + hstep, voffB); PG8_STAGE(PG8_SA(0, 0), cA, vA0); PG8_STAGE(PG8_SA(0, 1), cA + hsA, vA1);
    if (wr == 1) PG8_BAR;
    PG8_WAIT_V(2); PG8_BAR;
    PG8_STAGE(PG8_SB(1, 0), cB + kstep, voffB); PG8_STAGE(PG8_SA(1, 0), cA + kstep, vA0); PG8_STAGE(PG8_SB(1, 1), cB + hstep + kstep, voffB);
    PG8_WAIT_V(6); PG8_BAR;
    for (;;) {
        const bool has_next = S.next(nxt);
        const char* nA = has_next ? (const char*)g.A + (size_t)nxt.e * g.astride + (gather ? (size_t)0 : (size_t)nxt.pm * tstep) : cA;
        if (has_next) PG8_AOFF(nA0, nA1, nxt);
        const char* nB = has_next ? (const char*)g.Bt + (size_t)nxt.e * g.estride + (size_t)nxt.pn * tstep : cB;
        for (int t = 0; t < nt; t += 2) {
            const bool last = (t == nt - 2);
            const char* a1 = cA + (size_t)(t + 1) * kstep;
            const char* a2 = last ? nA : cA + (size_t)(t + 2) * kstep; const char* b2 = last ? nB : cB + (size_t)(t + 2) * kstep;
            const char* a3 = a2 + kstep; const char* b3 = b2 + kstep;
            PG8_LDB(B0, 0, 0); PG8_LDB(B1, 0, 1); PG8_SCHED; PG8_LDA(At, 0, 0); PG8_STAGE(PG8_SA(1, 1), a1 + hsA, vA1);
            if (last && has_next) { vA0[0] = nA0[0]; vA0[1] = nA0[1]; vA1[0] = nA1[0]; vA1[1] = nA1[1]; }
            PG8_WAIT_V(8); PG8_WAIT_L(0); PG8_BAR; PG8_MMA(0, 0, At, B0); PG8_MMA(0, 1, At, B1); PG8_BAR; PG8_SCHED;
            PG8_LDA(At, 0, 1); PG8_STAGE(PG8_SB(0, 0), b2, voffB); PG8_STAGE(PG8_SB(0, 1), b2 + hstep, voffB); PG8_STAGE(PG8_SA(0, 0), a2, vA0);
            PG8_WAIT_V(8); PG8_WAIT_L(0); PG8_BAR; PG8_MMA(1, 0, At, B0); PG8_MMA(1, 1, At, B1); PG8_BAR; PG8_SCHED;
            PG8_LDB(B0, 1, 0); PG8_LDB(B1, 1, 1); PG8_SCHED; PG8_LDA(At, 1, 0); PG8_STAGE(PG8_SA(0, 1), a2 + hsA, vA1);
            PG8_WAIT_V(8); PG8_WAIT_L(0); PG8_BAR; PG8_MMA(0, 0, At, B0); PG8_MMA(0, 1, At, B1); PG8_BAR; PG8_SCHED;
            PG8_LDA(At, 1, 1); PG8_STAGE(PG8_SB(1, 0), b3, voffB); PG8_STAGE(PG8_SB(1, 1), b3 + hstep, voffB); PG8_STAGE(PG8_SA(1, 0), a3, vA0);
            PG8_WAIT_V(8); PG8_WAIT_L(0); PG8_BAR; PG8_MMA(1, 0, At, B0); PG8_MMA(1, 1, At, B1); PG8_BAR; PG8_SCHED;
        }
        if (wr == 0) PG8_BAR;
        if constexpr (FP8) {
#pragma unroll
            for (int a = 0; a < 2; ++a)
#pragma unroll
                for (int b = 0; b < 2; ++b) asm volatile("s_nop 15" : "+v"(acc[a][b][0][0]), "+v"(acc[a][b][0][1]), "+v"(acc[a][b][1][0]), "+v"(acc[a][b][1][1]), "+v"(acc[a][b][2][0]), "+v"(acc[a][b][2][1]), "+v"(acc[a][b][3][0]), "+v"(acc[a][b][3][1]));
        }
        const bool keep_acc = E(acc, cur, wr, wc, fr, fq);
        if (!has_next) break;
        if (!keep_acc)
#pragma unroll
        for (int a = 0; a < 2; ++a)
#pragma unroll
            for (int b = 0; b < 2; ++b)
#pragma unroll
                for (int m = 0; m < 4; ++m)
#pragma unroll
                    for (int n = 0; n < 2; ++n) acc[a][b][m][n] = (f32x4){0.f, 0.f, 0.f, 0.f};
        cur = nxt; cA = nA; cB = nB;
        if (wr == 1) PG8_BAR;
    }
    PG8_WAIT_V(0);
    PG8_BAR;
#undef PG8_AOFF
#undef PG8_SA
#undef PG8_SB
#undef PG8_STAGE
#undef PG8_LDA
#undef PG8_LDB
#undef PG8_MMA
#undef PG8_LD8
#undef PG8_WAIT_V
#undef PG8_WAIT_L
#undef PG8_BAR
#undef PG8_SCHED
}

struct EpiBf16 {
    static constexpr bool PERM = true;
    bf16_t* O; int ldc; const float* bias; int bias_estride; float ascale; int skip_from, skip_cols;
    __device__ __forceinline__ bool operator()(const f32x4 (&acc)[2][2][4][2], const Unit& u, int wr, int wc, int fr, int fq) const {
        const int row0 = u.pm * BM + wr * 64 + fr; const int col0 = u.pn * BM + wc * 32 + 8 * fq + (u.pn >= skip_from ? skip_cols : 0);
        f32x4 bv[2][2];
#pragma unroll
        for (int bj = 0; bj < 2; ++bj)
#pragma unroll
            for (int n = 0; n < 2; ++n) bv[bj][n] = bias ? *(const f32x4*)(bias + (size_t)u.e * bias_estride + col0 + bj * HALF + 4 * n) : (f32x4){0.f, 0.f, 0.f, 0.f};
#pragma unroll
        for (int ai = 0; ai < 2; ++ai)
#pragma unroll
            for (int m = 0; m < 4; ++m) { bf16_t* rowp = O + (size_t)(row0 + ai * HALF + m * 16) * ldc + col0;
#pragma unroll
                for (int bj = 0; bj < 2; ++bj) { const f32x4 v0 = acc[ai][bj][m][0] * ascale + bv[bj][0], v1 = acc[ai][bj][m][1] * ascale + bv[bj][1];
                    u32x4 w; w.x = cvt_pk_bf16(v0[0], v0[1]); w.y = cvt_pk_bf16(v0[2], v0[3]); w.z = cvt_pk_bf16(v1[0], v1[1]); w.w = cvt_pk_bf16(v1[2], v1[3]);
                    *(u32x4*)(rowp + bj * HALF) = w; } }
        return false;
    }
};
__device__ __forceinline__ float swiglu1(float ug, float ul) {
    ug = fminf(ug, 7.0f); ul = fminf(fmaxf(ul, -7.0f), 7.0f);
    return ug * __builtin_amdgcn_rcpf(1.0f + __expf(-1.702f * ug)) * (ul + 1.0f);
}
struct EpiSwiglu {
    static constexpr bool PERM = true;
    unsigned char* O; const float* b1;
    __device__ __forceinline__ bool operator()(const f32x4 (&acc)[2][2][4][2], const Unit& u, int wr, int wc, int fr, int fq) const {
        const int row0 = u.pm * BM + wr * 64 + fr; const int c0 = u.pn * 128 + wc * 32 + 8 * fq;
        const float* bg = b1 + (size_t)u.e * 4096 + c0; const float* bl = bg + 2048;
        f32x4 bgv[2], blv[2];
#pragma unroll
        for (int n = 0; n < 2; ++n) { bgv[n] = *(const f32x4*)(bg + 4 * n); blv[n] = *(const f32x4*)(bl + 4 * n); }
#pragma unroll
        for (int ai = 0; ai < 2; ++ai)
#pragma unroll
            for (int m = 0; m < 4; ++m) {
                float a[8];
#pragma unroll
                for (int n = 0; n < 2; ++n)
#pragma unroll
                    for (int j = 0; j < 4; ++j) a[4 * n + j] = ACT8_SCALE * swiglu1(acc[ai][0][m][n][j] * (1.0f / W8_SCALE) + bgv[n][j], acc[ai][1][m][n][j] * (1.0f / W8_SCALE) + blv[n][j]);
                u32x2 w; w.x = pack4_fp8(a[0], a[1], a[2], a[3]); w.y = pack4_fp8(a[4], a[5], a[6], a[7]);
                *(u32x2*)(O + (size_t)(row0 + ai * HALF + m * 16) * 2048 + c0) = w;
            }
        return false;
    }
};

struct TwoPartOrder {
    StaticOrder so; Unit held; int part;
    __device__ void init(int M, int N, int G_, int c_) { so.init(M, N, G_, c_); part = 0; }
    __device__ bool next(Unit& u) { if (part == 1) { u = held; u.e = 1; part = 0; return true; } if (!so.next(held)) return false; u = held; u.e = 0; part = 1; return true; }
};
struct EpiGate2 {
    static constexpr bool PERM = true;
    unsigned char* O; const bf16_t* Ga; const bf16_t* Gr;
    __device__ __forceinline__ bool operator()(f32x4 (&acc)[2][2][4][2], const Unit& u, int wr, int wc, int fr, int fq) const {
        const int row0 = u.pm * BM + wr * 64 + fr; const int col0 = u.pn * BM + wc * 32 + 8 * fq;
#pragma unroll
        for (int ai = 0; ai < 2; ++ai)
#pragma unroll
            for (int m = 0; m < 4; ++m) { const size_t row = (size_t)(row0 + ai * HALF + m * 16);
#pragma unroll
                for (int bj = 0; bj < 2; ++bj) { const int c = col0 + bj * HALF;
                    const u32x4 gr = *(const u32x4*)(Gr + row * DINP + c);
                    if (u.e == 0) {
                        const u32x4 ga = *(const u32x4*)(Ga + row * DINP + c);
#pragma unroll
                        for (int q = 0; q < 4; ++q) {
                            const float r0 = (1.0f + __expf(-bf_lo(gr[q]))) * __builtin_amdgcn_rcpf(1.0f + __expf(-bf_lo(ga[q]))), r1 = (1.0f + __expf(-bf_hi(gr[q]))) * __builtin_amdgcn_rcpf(1.0f + __expf(-bf_hi(ga[q])));
                            acc[ai][bj][m][q >> 1][(2 * q) & 3] *= r0; acc[ai][bj][m][q >> 1][(2 * q + 1) & 3] *= r1; }
                    } else {
                        float r[8];
#pragma unroll
                        for (int q = 0; q < 4; ++q) { r[2 * q] = sigmoidf_(bf_lo(gr[q])) * acc[ai][bj][m][q >> 1][(2 * q) & 3]; r[2 * q + 1] = sigmoidf_(bf_hi(gr[q])) * acc[ai][bj][m][q >> 1][(2 * q + 1) & 3]; }
                        u32x2 w; constexpr float osc = MRG8_SCALE / (W8_SCALE * OP8_SCALE); w.x = pack4_fp8(r[0] * osc, r[1] * osc, r[2] * osc, r[3] * osc); w.y = pack4_fp8(r[4] * osc, r[5] * osc, r[6] * osc, r[7] * osc);
                        *(u32x2*)(O + row * 2048 + c) = w; } } }
        return u.e == 0;
    }
};
struct EpiDelta {
    static constexpr bool PERM = true;
    const float* gt; bf16_t* DL; float ascale;
    __device__ __forceinline__ bool operator()(const f32x4 (&acc)[2][2][4][2], const Unit& u, int wr, int wc, int fr, int fq) const {
        const int row0 = u.pm * BM + wr * 64 + fr; const int col0 = u.pn * BM + wc * 32 + 8 * fq;
        f32x4 g[2][2];
#pragma unroll
        for (int bj = 0; bj < 2; ++bj)
#pragma unroll
            for (int n = 0; n < 2; ++n) g[bj][n] = *(const f32x4*)(gt + col0 + bj * HALF + 4 * n);
#pragma unroll
        for (int ai = 0; ai < 2; ++ai)
#pragma unroll
            for (int m = 0; m < 4; ++m) { bf16_t* rowp = DL + (size_t)(row0 + ai * HALF + m * 16) * 2048 + col0;
#pragma unroll
                for (int bj = 0; bj < 2; ++bj) { const f32x4 v0 = acc[ai][bj][m][0] * ascale * g[bj][0], v1 = acc[ai][bj][m][1] * ascale * g[bj][1];
                    u32x4 w; w.x = cvt_pk_bf16(v0[0], v0[1]); w.y = cvt_pk_bf16(v0[2], v0[3]); w.z = cvt_pk_bf16(v1[0], v1[1]); w.w = cvt_pk_bf16(v1[2], v1[3]);
                    *(u32x4*)(rowp + bj * HALF) = w; } }
        return false;
    }
};
}

struct Args { const void* in[22]; float* out; unsigned char* ws; int ph_lo, ph_hi, flags, pad; };
constexpr int XCONV = 0, XSCORE = 96;
constexpr int CW_SCQ = 12288, SCP = 5, CW_ATQ = 12352;
enum { PH_PRO = 0, PH_H, PH_INPROJ, PH_POST, PH_SCORE, PH_SELECT, PH_ATTN, PH_OP1, PH_OP2, PH_WOUT, PH_ROUTER, PH_SCATTER, PH_MOE1, PH_MOE2, PH_FINAL, NPH };

__device__ __forceinline__ int dest_row(int mode, int n) {
    if (mode == 1) return n < 2640 ? n : n + 176;
    if (mode == 2) { const int g = n >> 11, c = n & 2047; return (c >> 7) * 256 + g * 128 + (c & 127); }
    return n;
}
__device__ __forceinline__ void convert_item(const float* __restrict__ W, int K, int N, int ld, bf16_t* WT, int mode, int item, int lane, LAS unsigned char* scr) {
    const int nblk = (N + 63) >> 6; const int kb = item / nblk, nb = item - kb * nblk; const int k0 = kb * 128, n0 = nb * 64;
    const int c4 = lane & 15, kr = lane >> 4;
    const bool ok = (n0 + 4 * c4) < N;
    const float* src = W + (size_t)(k0 + 2 * kr) * ld + n0 + 4 * c4;
#pragma unroll 4
    for (int i = 0; i < 16; ++i) {
        f32x4 v0 = (f32x4){0.f, 0.f, 0.f, 0.f}, v1 = v0;
        if (ok) { v0 = *(const f32x4*)(src + (size_t)(8 * i) * ld); v1 = *(const f32x4*)(src + (size_t)(8 * i + 1) * ld); }
        const int kk = 8 * i + 2 * kr;
#pragma unroll
        for (int e = 0; e < 4; ++e) *(LAS unsigned*)(scr + (4 * c4 + e) * 272 + kk * 2) = cvt_pk_bf16(v0[e], v1[e]);
    }
    LDS_WAIT(); asm volatile("" ::: "memory");
#pragma unroll 4
    for (int j = 0; j < 16; ++j) {
        const int q = j * 64 + lane, n = q >> 4, ch = q & 15;
        const u32x4 v = *(const LAS u32x4*)(scr + n * 272 + ch * 16);
        if (n0 + n < N) *(u32x4*)(WT + (size_t)dest_row(mode, n0 + n) * K + k0 + ch * 8) = v;
    }
    LDS_WAIT(); asm volatile("" ::: "memory");
}


__device__ __forceinline__ bf16_t f2bf(float f) { unsigned u = __float_as_uint(f); return (bf16_t)((u + 0x7fffu + ((u >> 16) & 1u)) >> 16); }
__device__ __forceinline__ float bfx(const u32x4& w, int i) { const unsigned u = w[i >> 1]; return (i & 1) ? bf_hi(u) : bf_lo(u); }
__device__ __forceinline__ void rope_sc(float pos, float inv, float& sn, float& cs) {
    const float ang = pos * inv;
    const double a = (double)ang; const double n = __builtin_rint(a * 0.15915494309189535); const float r = (float)(a - n * 6.283185307179586);
    sn = sinf(r); cs = cosf(r);
}
__device__ __forceinline__ void post_token(bf16_t* PROJ, bf16_t* KI, unsigned char* KC, unsigned char* VC, const int* positions, const float* kng, const float* knb, int t, int lane) {
    const float pos = (float)positions[t];
    bf16_t* row = PROJ + (size_t)t * DINP;
    float sn, cs;
#pragma unroll
    for (int i = 0; i < 2; ++i) {
        const int pp = lane + 64 * i, hd = pp >> 4, ii = pp & 15;
        rope_sc(pos, powf(500000.0f, -(float)ii * (1.0f / 16.0f)), sn, cs);
        bf16_t* p = row + CQ + hd * 128 + ii; const float a = bf2f(p[0]), b = bf2f(p[16]);
        p[0] = f2bf(a * cs - b * sn); p[16] = f2bf(b * cs + a * sn);
    }
#pragma unroll
    for (int i = 0; i < 2; ++i) {
        const int pp = lane + 64 * i, hd = pp >> 3, ii = pp & 7;
        rope_sc(pos, powf(500000.0f, -(float)ii * (1.0f / 8.0f)), sn, cs);
        bf16_t* p = row + CQI + hd * 64 + ii; const float a = bf2f(p[0]), b = bf2f(p[8]);
        p[0] = f2bf(a * cs - b * sn); p[8] = f2bf(b * cs + a * sn);
    }
    if (lane < 32) {
        const int g = lane >> 4, ii = lane & 15;
        rope_sc(pos, powf(500000.0f, -(float)ii * (1.0f / 16.0f)), sn, cs);
        const bf16_t* p = row + CK + g * 128 + ii; const float a = bf2f(p[0]), b = bf2f(p[16]);
        unsigned char* o = KC + (size_t)t * 256 + g * 128 + ii; o[0] = fp8_1(a * cs - b * sn); o[16] = fp8_1(b * cs + a * sn);
    }
#pragma unroll
    for (int i = 0; i < 3; ++i) { const int idx = lane + 64 * i, g = idx / 96, r = idx - g * 96; KC[(size_t)t * 256 + g * 128 + 32 + r] = fp8_1(bf2f(row[CK + g * 128 + 32 + r])); }
    { const u32x2 w = *(const u32x2*)(row + CV + 4 * lane); *(unsigned*)(VC + (size_t)t * 256 + 4 * lane) = pack4_fp8(bf_lo(w.x), bf_hi(w.x), bf_lo(w.y), bf_hi(w.y)); }
    {
        const float v = bf2f(row[CKI + lane]);
        const float mean = wave_sum(v) * (1.0f / 64.0f); const float d = v - mean; const float var = wave_sum(d * d) * (1.0f / 64.0f);
        const float y = d * rsqrtf(var + NORM_EPS) * kng[lane] + knb[lane];
        const float other = __shfl_xor(y, 8);
        rope_sc(pos, powf(500000.0f, -(float)(lane & 7) * (1.0f / 8.0f)), sn, cs);
        float o = y;
        if (lane < 8) o = y * cs - other * sn; else if (lane < 16) o = y * cs + other * sn;
        KI[(size_t)t * 64 + lane] = f2bf(o);
    }
}

constexpr int HG_GB = 0, HG_Q1 = 33792, HG_Q2 = 51200, HG_K2 = 68608, HG_VT = 86016, HG_PB = 104448, HG_LB = 113664;
__device__ __forceinline__ void hgrn_cumsum(LAS unsigned char* lds, const u32x4& w0, const u32x4& w1, float l0, float l1, int tid) {
    LAS float* GB = (LAS float*)(lds + HG_GB); LAS float* LB = (LAS float*)(lds + HG_LB); LAS float* SEG = (LAS float*)(lds + HG_LB + 512);
    if (tid < 128) LB[tid] = 1.0f / (1.0f + expf(l1 - l0));
    __syncthreads();
    const int t = tid >> 3, dseg = tid & 7;
#pragma unroll
    for (int i = 0; i < 16; ++i) { const float z = i < 8 ? bfx(w0, i) : bfx(w1, i - 8); const float lb = LB[16 * dseg + i]; GB[t * 128 + 16 * dseg + i] = logf(lb + (1.0f - lb) * sigmoidf_(z)); }
    __syncthreads();
    const int d = tid & 127, tq = tid >> 7;
    float z[16];
#pragma unroll
    for (int i = 0; i < 16; ++i) z[i] = GB[(16 * tq + i) * 128 + d];
    float a = 0.f;
#pragma unroll
    for (int i = 0; i < 16; ++i) { a += z[i]; z[i] = a; }
    SEG[tq * 128 + d] = a;
    __syncthreads();
    float pre = 0.f;
    for (int q = 0; q < tq; ++q) pre += SEG[q * 128 + d];
#pragma unroll
    for (int i = 0; i < 16; ++i) GB[(16 * tq + i) * 128 + d] = z[i] + pre;
    __syncthreads();
}
__device__ __forceinline__ void hgrn_vt(LAS unsigned char* lds, const u32x4& a, const u32x4& b, int tid) {
    const int s2 = tid & 31, eg = tid >> 5;
#pragma unroll
    for (int i = 0; i < 8; ++i) { const unsigned lo = (i & 1) ? (a[i >> 1] >> 16) : (a[i >> 1] & 0xffffu), hi = (i & 1) ? (b[i >> 1] >> 16) : (b[i >> 1] & 0xffffu);
        *(LAS unsigned*)(lds + HG_VT + (8 * eg + i) * 144 + s2 * 4) = lo | (hi << 16); }
}
__device__ __forceinline__ void hgrn_l1(LAS unsigned char* lds, const bf16_t* PROJ, const float* lb_logits, bf16_t* ST, float* DC, int c, int h, int tid, int wave, int lane) {
    const int t = tid >> 3, dseg = tid & 7, s2 = tid & 31, dg = tid >> 5;
    const bf16_t* pf = PROJ + (size_t)(c * 64 + t) * DINP + CHF + h * 128 + 16 * dseg;
    const bf16_t* pk = PROJ + (size_t)(c * 64 + 2 * s2) * DINP + CHF + h * 128 + 8 * dg;
    const u32x4 w0 = *(const u32x4*)pf, w1 = *(const u32x4*)(pf + 8);
    const u32x4 ka = *(const u32x4*)pk, kb = *(const u32x4*)(pk + DINP);
    const u32x4 va = *(const u32x4*)(pk - CHF + CHI), vb = *(const u32x4*)(pk - CHF + CHI + DINP);
    const float l0 = lb_logits[h * 128 + (tid & 127)], l1 = lb_logits[1024 + h * 128 + (tid & 127)];
    hgrn_cumsum(lds, w0, w1, l0, l1, tid);
    const LAS float* GB = (const LAS float*)(lds + HG_GB); const LAS float* LB = (const LAS float*)(lds + HG_LB);
    {
#pragma unroll
        for (int i = 0; i < 8; ++i) { const int d = 8 * dg + i; const float lb = LB[d], b63 = GB[63 * 128 + d];
            const float k0 = (1.0f - lb) * (1.0f - sigmoidf_(bfx(ka, i))), k1 = (1.0f - lb) * (1.0f - sigmoidf_(bfx(kb, i)));
            const float v0 = k0 * __expf(b63 - GB[(2 * s2) * 128 + d]), v1 = k1 * __expf(b63 - GB[(2 * s2 + 1) * 128 + d]);
            *(LAS unsigned*)(lds + HG_Q1 + d * 144 + s2 * 4) = cvt_pk_bf16(v0, v1); }
    }
    hgrn_vt(lds, va, vb, tid);
    __syncthreads();
    const int fr = lane & 15, fq = lane >> 4;
    bf16x8 af[2];
#pragma unroll
    for (int ks = 0; ks < 2; ++ks) af[ks] = *(const LAS bf16x8*)(lds + HG_VT + (16 * wave + fr) * 144 + (32 * ks + 8 * fq) * 2);
    bf16_t* dst = ST + ((size_t)(c * 8 + h) * 128) * 128;
#pragma unroll 2
    for (int dt = 0; dt < 8; ++dt) {
        f32x4 acc = (f32x4){0.f, 0.f, 0.f, 0.f};
#pragma unroll
        for (int ks = 0; ks < 2; ++ks) { const bf16x8 bfr = *(const LAS bf16x8*)(lds + HG_Q1 + (16 * dt + fr) * 144 + (32 * ks + 8 * fq) * 2); acc = __builtin_amdgcn_mfma_f32_16x16x32_bf16(af[ks], bfr, acc, 0, 0, 0); }
#pragma unroll
        for (int r = 0; r < 4; ++r) dst[(size_t)(16 * wave + 4 * fq + r) * 128 + 16 * dt + fr] = f2bf(acc[r]);
    }
    if (tid < 128) DC[(size_t)(c * 8 + h) * 128 + tid] = __expf(GB[63 * 128 + tid]);
    __syncthreads();
}
__device__ __forceinline__ void hgrn_l3(LAS unsigned char* lds, const bf16_t* PROJ, const float* lb_logits, const bf16_t* ST, const float* norm_g, unsigned char* REC, int c, int h, int tid, int wave, int lane) {
    const int t = tid >> 3, dseg = tid & 7, s2 = tid & 31, eg = tid >> 5, fr = lane & 15, fq = lane >> 4;
    const bf16_t* pf = PROJ + (size_t)(c * 64 + t) * DINP + CHF + h * 128 + 16 * dseg;
    const u32x4 f0 = *(const u32x4*)pf, f1 = *(const u32x4*)(pf + 8), q0 = *(const u32x4*)(pf - CHF + CHQ), q1 = *(const u32x4*)(pf - CHF + CHQ + 8);
    const u32x4 g0 = *(const u32x4*)(pf - CHF + CHG), g1 = *(const u32x4*)(pf - CHF + CHG + 8);
    const bf16_t* pv = PROJ + (size_t)(c * 64 + 2 * s2) * DINP + CHI + h * 128 + 8 * eg;
    const u32x4 va = *(const u32x4*)pv, vb = *(const u32x4*)(pv + DINP);
    const bf16_t* sp = ST + ((size_t)(c * 8 + h) * 128 + 16 * wave + fr) * 128 + 8 * fq;
    u32x4 sx[4];
#pragma unroll
    for (int ks = 0; ks < 4; ++ks) sx[ks] = *(const u32x4*)(sp + 32 * ks);
    const float l0 = lb_logits[h * 128 + (tid & 127)], l1 = lb_logits[1024 + h * 128 + (tid & 127)];
    hgrn_cumsum(lds, f0, f1, l0, l1, tid);
    const LAS float* GB = (const LAS float*)(lds + HG_GB); const LAS float* LB = (const LAS float*)(lds + HG_LB);
    {
        unsigned o1[8], o2[8], o3[8];
#pragma unroll
        for (int i = 0; i < 16; i += 2) {
            float a1[2], a2[2], a3[2];
#pragma unroll
            for (int j = 0; j < 2; ++j) { const int d = 16 * dseg + i + j; const float lb = LB[d], b = GB[t * 128 + d], br = GB[31 * 128 + d];
                const float z = (i + j) < 8 ? bfx(f0, i + j) : bfx(f1, i + j - 8), qv = (i + j) < 8 ? bfx(q0, i + j) : bfx(q1, i + j - 8);
                const float k = (1.0f - lb) * (1.0f - sigmoidf_(z)), q = siluf_(qv);
                a1[j] = q * __expf(b); a2[j] = q * __expf(b - br); a3[j] = k * __expf(br - b); }
            o1[i >> 1] = cvt_pk_bf16(a1[0], a1[1]); o2[i >> 1] = cvt_pk_bf16(a2[0], a2[1]); o3[i >> 1] = cvt_pk_bf16(a3[0], a3[1]);
        }
        LAS u32x4* d1 = (LAS u32x4*)(lds + HG_Q1 + t * 272 + dseg * 32); LAS u32x4* d2 = (LAS u32x4*)(lds + HG_Q2 + t * 272 + dseg * 32); LAS u32x4* d3 = (LAS u32x4*)(lds + HG_K2 + t * 272 + dseg * 32);
        d1[0] = (u32x4){o1[0], o1[1], o1[2], o1[3]}; d1[1] = (u32x4){o1[4], o1[5], o1[6], o1[7]};
        d2[0] = (u32x4){o2[0], o2[1], o2[2], o2[3]}; d2[1] = (u32x4){o2[4], o2[5], o2[6], o2[7]};
        d3[0] = (u32x4){o3[0], o3[1], o3[2], o3[3]}; d3[1] = (u32x4){o3[4], o3[5], o3[6], o3[7]};
    }
    hgrn_vt(lds, va, vb, tid);
    __syncthreads();
#pragma unroll
    for (int q = 0; q < 2; ++q) {
        const int tile = 2 * wave + q, tt = tile >> 2, stl = tile & 3;
        f32x4 acc = (f32x4){0.f, 0.f, 0.f, 0.f};
#pragma unroll
        for (int ks = 0; ks < 4; ++ks) { const bf16x8 a = *(const LAS bf16x8*)(lds + HG_Q2 + (16 * tt + fr) * 272 + (32 * ks + 8 * fq) * 2), b = *(const LAS bf16x8*)(lds + HG_K2 + (16 * stl + fr) * 272 + (32 * ks + 8 * fq) * 2);
            acc = __builtin_amdgcn_mfma_f32_16x16x32_bf16(a, b, acc, 0, 0, 0); }
#pragma unroll
        for (int r = 0; r < 4; ++r) { const int tr_ = 16 * tt + 4 * fq + r, s = 16 * stl + fr; *(LAS bf16_t*)(lds + HG_PB + tr_ * 144 + s * 2) = f2bf(s <= tr_ ? acc[r] : 0.f); }
    }
    __syncthreads();
    {
        bf16x8 b1[2], b2[4];
#pragma unroll
        for (int ks = 0; ks < 2; ++ks) b1[ks] = *(const LAS bf16x8*)(lds + HG_VT + (16 * wave + fr) * 144 + (32 * ks + 8 * fq) * 2);
#pragma unroll
        for (int ks = 0; ks < 4; ++ks) b2[ks] = __builtin_bit_cast(bf16x8, sx[ks]);
        LAS float* OB = (LAS float*)(lds + HG_GB);
#pragma unroll
        for (int tt = 0; tt < 4; ++tt) {
            f32x4 acc = (f32x4){0.f, 0.f, 0.f, 0.f};
#pragma unroll
            for (int ks = 0; ks < 2; ++ks) { const bf16x8 a = *(const LAS bf16x8*)(lds + HG_PB + (16 * tt + fr) * 144 + (32 * ks + 8 * fq) * 2); acc = __builtin_amdgcn_mfma_f32_16x16x32_bf16(a, b1[ks], acc, 0, 0, 0); }
#pragma unroll
            for (int ks = 0; ks < 4; ++ks) { const bf16x8 a = *(const LAS bf16x8*)(lds + HG_Q1 + (16 * tt + fr) * 272 + (32 * ks + 8 * fq) * 2); acc = __builtin_amdgcn_mfma_f32_16x16x32_bf16(a, b2[ks], acc, 0, 0, 0); }
#pragma unroll
            for (int r = 0; r < 4; ++r) OB[(16 * tt + 4 * fq + r) * 132 + 16 * wave + fr] = acc[r];
        }
    }
    __syncthreads();
    {
        const int es = dseg; const LAS float* OB = (const LAS float*)(lds + HG_GB);
        float o[16]; float ss = 0.f;
#pragma unroll
        for (int i = 0; i < 16; ++i) { o[i] = OB[t * 132 + 16 * es + i]; ss += o[i] * o[i]; }
        ss += __shfl_xor(ss, 1); ss += __shfl_xor(ss, 2); ss += __shfl_xor(ss, 4);
        const float rstd = rsqrtf(ss * (1.0f / 128.0f) + NORM_EPS);
        float rv[16];
#pragma unroll
        for (int i = 0; i < 16; ++i) { const float ga = i < 8 ? bfx(g0, i) : bfx(g1, i - 8); rv[i] = o[i] * (rstd * OP8_SCALE) * norm_g[16 * es + i] * siluf_(ga); }
        *(u32x4*)(REC + (size_t)(c * 64 + t) * 1024 + h * 128 + 16 * es) = (u32x4){pack4_fp8(rv[0], rv[1], rv[2], rv[3]), pack4_fp8(rv[4], rv[5], rv[6], rv[7]), pack4_fp8(rv[8], rv[9], rv[10], rv[11]), pack4_fp8(rv[12], rv[13], rv[14], rv[15])};
    }
    __syncthreads();
}

constexpr int SC_KT = 0, SC_SB = 36864, SC_SPITCH = 132;
__device__ __forceinline__ unsigned pk_f16(float a, float b) { return __builtin_bit_cast(unsigned, __builtin_amdgcn_cvt_pkrtz(a, b)); }
__device__ __forceinline__ void score_flush(LAS unsigned char* lds, unsigned short* SCORES, unsigned short* SEGMAX, int t0, int kt, int tid) {
    const LAS float* sb = (const LAS float*)(lds + SC_SB + (kt & 1) * (32 * SC_SPITCH * 4));
    const int row = tid >> 4, seg = tid & 15;
    const f32x4 a = *(const LAS f32x4*)(sb + row * SC_SPITCH + seg * 8), b = *(const LAS f32x4*)(sb + row * SC_SPITCH + seg * 8 + 4);
    unsigned short* dst = SCORES + (size_t)(t0 + row) * S + kt * 128 + seg * 8;
    *(u32x4*)dst = (u32x4){pk_f16(a[0], a[1]), pk_f16(a[2], a[3]), pk_f16(b[0], b[1]), pk_f16(b[2], b[3])};
    const float mx = fmaxf(fmaxf(fmaxf(a[0], a[1]), fmaxf(a[2], a[3])), fmaxf(fmaxf(b[0], b[1]), fmaxf(b[2], b[3])));
    SEGMAX[(size_t)(t0 + row) * 2048 + kt * 16 + seg] = (unsigned short)(pk_f16(mx, mx) & 0xffffu);
}
__device__ __forceinline__ void score_block(LAS unsigned char* lds, const bf16_t* PROJ, const bf16_t* KI, unsigned short* SCORES, unsigned short* SEGMAX, int qb, int kt0, int kt1, int tid, int wave, int lane) {
    const int t0 = qb * 32;
    const int r = lane & 31, hh = lane >> 5;
    bf16x8 Af[2][4]; float wv[2][16]; f32x2 wv2[2][8];
#pragma unroll
    for (int p = 0; p < 2; ++p) {
        const int tq = t0 + 4 * wave + 2 * p + (r >> 4); const bf16_t* qrow = PROJ + (size_t)tq * DINP + CQI + (r & 15) * 64 + 8 * hh;
#pragma unroll
        for (int ks = 0; ks < 4; ++ks) Af[p][ks] = *(const bf16x8*)(qrow + 16 * ks);
#pragma unroll
        for (int qq = 0; qq < 2; ++qq) {
            const bf16_t* wp = PROJ + (size_t)(t0 + 4 * wave + 2 * p + qq) * DINP + CWI + 4 * hh;
            const u32x2 wa = *(const u32x2*)wp, wb = *(const u32x2*)(wp + 8);
            wv[p][8 * qq + 0] = bf_lo(wa.x) * (1.0f / 32.0f); wv[p][8 * qq + 1] = bf_hi(wa.x) * (1.0f / 32.0f); wv[p][8 * qq + 2] = bf_lo(wa.y) * (1.0f / 32.0f); wv[p][8 * qq + 3] = bf_hi(wa.y) * (1.0f / 32.0f);
            wv[p][8 * qq + 4] = bf_lo(wb.x) * (1.0f / 32.0f); wv[p][8 * qq + 5] = bf_hi(wb.x) * (1.0f / 32.0f); wv[p][8 * qq + 6] = bf_lo(wb.y) * (1.0f / 32.0f); wv[p][8 * qq + 7] = bf_hi(wb.y) * (1.0f / 32.0f);
        }
#pragma unroll
        for (int i = 0; i < 8; ++i) wv2[p][i] = (f32x2){wv[p][2 * i], wv[p][2 * i + 1]};
    }
    const u32x2 tagsw = __builtin_amdgcn_permlane32_swap(0u, 1u, false, false); const int qsel = (int)tagsw[0];
    u32x4 stg[2];
#pragma unroll
    for (int i = 0; i < 2; ++i) { const int q = tid + 512 * i; stg[i] = *(const u32x4*)(KI + (size_t)(kt0 * 128 + (q >> 3)) * 64 + (q & 7) * 8); }
#pragma unroll
    for (int i = 0; i < 2; ++i) { const int q = tid + 512 * i; *(LAS u32x4*)(lds + SC_KT + (kt0 & 1) * 18432 + (q >> 3) * 144 + (q & 7) * 16) = stg[i]; }
    __syncthreads();
    for (int kt = kt0; kt < kt1; ++kt) {
        const LAS unsigned char* buf = lds + SC_KT + (kt & 1) * 18432;
        LAS float* sb = (LAS float*)(lds + SC_SB + (kt & 1) * (32 * SC_SPITCH * 4));
        if (kt + 1 < kt1) {
#pragma unroll
            for (int i = 0; i < 2; ++i) { const int q = tid + 512 * i; stg[i] = *(const u32x4*)(KI + (size_t)((kt + 1) * 128 + (q >> 3)) * 64 + (q & 7) * 8); }
        }
        __builtin_amdgcn_sched_barrier(0);
        if (kt > kt0) score_flush(lds, SCORES, SEGMAX, t0, kt - 1, tid);
        {
        f32x16 accP[2], accC[2];
#define SC_MFMA(cb) do { bf16x8 Bf[4]; _Pragma("unroll") for (int ks = 0; ks < 4; ++ks) Bf[ks] = *(const LAS bf16x8*)(buf + (32 * (cb) + r) * 144 + (16 * ks + 8 * hh) * 2); \
            _Pragma("unroll") for (int p = 0; p < 2; ++p) { _Pragma("unroll") for (int i = 0; i < 16; ++i) accC[p][i] = 0.f; \
                _Pragma("unroll") for (int ks = 0; ks < 4; ++ks) accC[p] = __builtin_amdgcn_mfma_f32_32x32x16_bf16(Af[p][ks], Bf[ks], accC[p], 0, 0, 0); } } while (0)
#define SC_RED(acc, cb) do { _Pragma("unroll") for (int p = 0; p < 2; ++p) { f32x2 s0 = {0.f, 0.f}, s1 = {0.f, 0.f}; \
            _Pragma("unroll") for (int reg = 0; reg < 8; reg += 2) { const f32x2 r0 = {relu_i(acc[p][reg]), relu_i(acc[p][reg + 1])}; const f32x2 r1 = {relu_i(acc[p][reg + 8]), relu_i(acc[p][reg + 9])}; \
                s0 = __builtin_elementwise_fma(wv2[p][reg >> 1], r0, s0); s1 = __builtin_elementwise_fma(wv2[p][4 + (reg >> 1)], r1, s1); } \
            const float p0 = s0[0] + s0[1], p1 = s1[0] + s1[1]; \
            const u32x2 sw = __builtin_amdgcn_permlane32_swap(__float_as_uint(p0), __float_as_uint(p1), false, false); \
            sb[(4 * wave + 2 * p + qsel) * SC_SPITCH + 32 * (cb) + r] = __uint_as_float(sw[0]) + __uint_as_float(sw[1]); } } while (0)
#define SC_INTERLEAVE() do { _Pragma("unroll") for (int i = 0; i < 8; ++i) { __builtin_amdgcn_sched_group_barrier(0x008, 1, 0); __builtin_amdgcn_sched_group_barrier(0x002, 8, 0); } } while (0)
        SC_MFMA(0);
        accP[0] = accC[0]; accP[1] = accC[1]; SC_MFMA(1); SC_RED(accP, 0); SC_INTERLEAVE();
        accP[0] = accC[0]; accP[1] = accC[1]; SC_MFMA(2); SC_RED(accP, 1); SC_INTERLEAVE();
        accP[0] = accC[0]; accP[1] = accC[1]; SC_MFMA(3); SC_RED(accP, 2); SC_INTERLEAVE();
        SC_RED(accC, 3);
#undef SC_MFMA
#undef SC_RED
#undef SC_INTERLEAVE
        }
        if (kt + 1 < kt1) {
#pragma unroll
            for (int i = 0; i < 2; ++i) { const int q = tid + 512 * i; *(LAS u32x4*)(lds + SC_KT + ((kt + 1) & 1) * 18432 + (q >> 3) * 144 + (q & 7) * 16) = stg[i]; }
        }
        __syncthreads();
    }
    score_flush(lds, SCORES, SEGMAX, t0, kt1 - 1, tid);
    __syncthreads();
}

__device__ __forceinline__ float wave_kth16(const float (&v)[16], int K) {
    const float NINF = -__builtin_inff();
    float mx = NINF, mn = __builtin_inff();
#pragma unroll
    for (int j = 0; j < 16; ++j) { mx = fmaxf(mx, v[j]); mn = fminf(mn, v[j] == NINF ? __builtin_inff() : v[j]); }
    mx = wave_max(mx); mn = -wave_max(-mn);
    int c = 0;
#pragma unroll
    for (int j = 0; j < 16; ++j) c += __popcll(__ballot(v[j] >= mx));
    if (c >= K) return mx;
    float lo = mn, hi = mx, tau = mn;
    for (int it = 0; it < 64; ++it) {
        const float mid = 0.5f * (lo + hi);
        if (!(mid > lo && mid < hi)) { tau = lo; break; }
        c = 0;
#pragma unroll
        for (int j = 0; j < 16; ++j) c += __popcll(__ballot(v[j] >= mid));
        if (c == K) { tau = mid; break; }
        if (c > K) lo = mid; else hi = mid;
        tau = lo;
    }
    return tau;
}
__device__ __forceinline__ int lanes_below(unsigned long long mask) { return (int)__builtin_amdgcn_mbcnt_hi((unsigned)(mask >> 32), __builtin_amdgcn_mbcnt_lo((unsigned)mask, 0u)); }
__device__ __forceinline__ float h2f(unsigned short h) { return (float)__builtin_bit_cast(_Float16, h); }
__device__ __forceinline__ float h2f_lo(unsigned u) { return h2f((unsigned short)(u & 0xffffu)); }
__device__ __forceinline__ float h2f_hi(unsigned u) { return h2f((unsigned short)(u >> 16)); }
__device__ __forceinline__ unsigned ge_mask8(const u32x4& v, unsigned T16) {
    unsigned m8 = 0;
#pragma unroll
    for (int w = 0; w < 4; ++w) { const unsigned vw_ = v[w];
        const s16x2 d = __builtin_elementwise_sub_sat(__builtin_bit_cast(s16x2, vw_), __builtin_bit_cast(s16x2, T16));
        const unsigned mm = ~__builtin_bit_cast(unsigned, d); m8 |= (((mm >> 15) & 1u) | ((mm >> 30) & 2u)) << (2 * w); }
    return m8;
}
__device__ __forceinline__ int append_bits(LAS int* list, int cnt, unsigned m8, int base) {
    for (;;) { const bool has = m8 != 0u; const unsigned long long mask = __ballot(has); if (!mask) break;
        const int pos = cnt + lanes_below(mask);
        if (has) { const int k = __builtin_ctz(m8); m8 &= m8 - 1u; if (pos < 1024) list[pos] = base + k; }
        cnt += __popcll(mask); }
    return cnt;
}
__device__ __forceinline__ void select_row(LAS unsigned char* wl, const unsigned short* SCORES, const unsigned short* SEGMAX, int t, int lane) {
    LAS int* selw = (LAS int*)wl; LAS int* segl = (LAS int*)(wl + 1024); LAS int* cidx = (LAS int*)(wl + 5120);
    const float NINF = -__builtin_inff();
    const unsigned short* row = SCORES + (size_t)t * S; const int n = t + 1;
    float c[16]; int N;
    if (n <= 1024) {
#pragma unroll
        for (int j = 0; j < 16; ++j) { const int i = lane + 64 * j; c[j] = i < n ? h2f(row[i]) : NINF; }
        N = -1;
    } else {
        const int m = n >> 4; float s[16];
#pragma unroll
        for (int j = 0; j < 16; ++j) { const int i = lane + 64 * j; s[j] = i < m ? h2f(row[16 * i + 7]) : NINF; }
        int K = 32, cnt = 0;
        for (;;) {
            const float tlo = (K >= m) ? NINF : wave_kth16(s, K);
            cnt = 0;
            const int nq = (n + 511) >> 9;
            if (tlo > 0.f) {
                const unsigned T16 = pk_f16(tlo, tlo);
                const u32x4 NEG = (u32x4){0xfc00fc00u, 0xfc00fc00u, 0xfc00fc00u, 0xfc00fc00u};
                const unsigned short* smrow = SEGMAX + (size_t)t * 2048; const int nseg = (t >> 3) + 1;
                int ns = 0;
                {
                    u32x4 sv[4];
#pragma unroll
                    for (int u = 0; u < 4; ++u) { const int e8 = 8 * (lane + 64 * u); sv[u] = (e8 < nseg) ? *(const u32x4*)(smrow + e8) : NEG; }
#pragma unroll
                    for (int u = 0; u < 4; ++u) { const int e8 = 8 * (lane + 64 * u); unsigned m8 = ge_mask8(sv[u], T16);
                        const int nv = nseg - e8; if (nv < 8) m8 &= nv > 0 ? ((1u << nv) - 1u) : 0u;
                        ns = append_bits(segl, ns, m8, e8); }
                }
                if (ns > 1024) ns = 1024;
                for (int j0 = 0; j0 < ns; j0 += 256) {
                    u32x4 v[4]; int sg[4];
#pragma unroll
                    for (int u = 0; u < 4; ++u) { const int i = j0 + lane + 64 * u; sg[u] = i < ns ? segl[i] : -1; v[u] = sg[u] >= 0 ? *(const u32x4*)(row + 8 * sg[u]) : NEG; }
#pragma unroll
                    for (int u = 0; u < 4; ++u) { const int e = 8 * sg[u]; unsigned m8 = sg[u] >= 0 ? ge_mask8(v[u], T16) : 0u;
                        const int nv = t + 1 - e; if (nv < 8) m8 &= nv > 0 ? ((1u << nv) - 1u) : 0u;
                        cnt = append_bits(cidx, cnt, m8, e); }
                }
            } else {
                for (int q0 = 0; q0 < nq; q0 += 4) {
                    u32x4 v[4];
#pragma unroll
                    for (int u = 0; u < 4; ++u) { const int e = 8 * (lane + 64 * (q0 + u)); v[u] = (e <= t) ? *(const u32x4*)(row + e) : (u32x4){0xfc00fc00u, 0xfc00fc00u, 0xfc00fc00u, 0xfc00fc00u}; }
#pragma unroll
                    for (int u = 0; u < 4; ++u) { const int e = 8 * (lane + 64 * (q0 + u));
#pragma unroll
                        for (int k = 0; k < 8; ++k) { const float x = (k & 1) ? h2f_hi(v[u][k >> 1]) : h2f_lo(v[u][k >> 1]);
                            const bool pred = (e + k <= t) && (x >= tlo); const unsigned long long mask = __ballot(pred);
                            if (mask) { const int pos = cnt + lanes_below(mask); if (pred && pos < 1024) cidx[pos] = e + k; cnt += __popcll(mask); } } }
                }
            }
            if (cnt >= 256 || K >= m) break;
            K *= 2;
        }
        N = cnt < 1024 ? cnt : 1024;
#pragma unroll
        for (int j = 0; j < 16; ++j) { const int i = lane + 64 * j; c[j] = i < N ? h2f(row[cidx[i]]) : NINF; }
    }
    const float tau = wave_kth16(c, 256);
    int base = 0;
#pragma unroll
    for (int j = 0; j < 16; ++j) { const bool pred = c[j] >= tau; const unsigned long long mask = __ballot(pred);
        if (mask) { const int pos = base + lanes_below(mask); if (pred && pos < 256) selw[pos] = (N < 0) ? (lane + 64 * j) : cidx[lane + 64 * j]; base += __popcll(mask); } }
}

__device__ __forceinline__ void attn_query(LAS unsigned char* wl, const bf16_t* PROJ, const unsigned char* KC, const unsigned char* VC, unsigned char* ATT, int t, int lane) {
    LAS int* selw = (LAS int*)wl; LAS float* L = (LAS float*)(wl + 1024);
    const int nsel = t < 255 ? t + 1 : 256;
    const int fr = lane & 15, fq = lane >> 4;
    constexpr float QS = 8.0f;
    long qh[2][4], ql[2][4];
#pragma unroll
    for (int g = 0; g < 2; ++g)
#pragma unroll
        for (int ks = 0; ks < 4; ++ks) {
            u32x4 z = (u32x4){0u, 0u, 0u, 0u};
            if (fr < 4) z = *(const u32x4*)(PROJ + (size_t)t * DINP + CQ + (4 * g + fr) * 128 + 32 * ks + 8 * fq);
            float qv[8], rv[8];
#pragma unroll
            for (int e = 0; e < 4; ++e) { qv[2 * e] = bf_lo(z[e]) * QS; qv[2 * e + 1] = bf_hi(z[e]) * QS; }
            const unsigned h0 = pack4_fp8(qv[0], qv[1], qv[2], qv[3]), h1 = pack4_fp8(qv[4], qv[5], qv[6], qv[7]);
            rv[0] = qv[0] - __builtin_amdgcn_cvt_f32_fp8((int)h0, 0); rv[1] = qv[1] - __builtin_amdgcn_cvt_f32_fp8((int)h0, 1); rv[2] = qv[2] - __builtin_amdgcn_cvt_f32_fp8((int)h0, 2); rv[3] = qv[3] - __builtin_amdgcn_cvt_f32_fp8((int)h0, 3);
            rv[4] = qv[4] - __builtin_amdgcn_cvt_f32_fp8((int)h1, 0); rv[5] = qv[5] - __builtin_amdgcn_cvt_f32_fp8((int)h1, 1); rv[6] = qv[6] - __builtin_amdgcn_cvt_f32_fp8((int)h1, 2); rv[7] = qv[7] - __builtin_amdgcn_cvt_f32_fp8((int)h1, 3);
            const unsigned l0 = pack4_fp8(rv[0] * 16.0f, rv[1] * 16.0f, rv[2] * 16.0f, rv[3] * 16.0f), l1 = pack4_fp8(rv[4] * 16.0f, rv[5] * 16.0f, rv[6] * 16.0f, rv[7] * 16.0f);
            qh[g][ks] = (long)(((unsigned long long)h1 << 32) | h0); ql[g][ks] = (long)(((unsigned long long)l1 << 32) | l0);
        }
    const float scale = 0.08838834764831845f / QS;
    const int nkt = (nsel + 15) >> 4;
    {
        LAS unsigned char* KT = wl + 9216;
        const int q4_ = lane >> 4, l15_ = lane & 15;
        u32x4 kw[3][4];
#define QK_LOAD(buf, kt) do { _Pragma("unroll") for (int u = 0; u < 4; ++u) { const unsigned off_ = (unsigned)selw[16 * (kt) + 4 * u + q4_] * 256u + 16u * (unsigned)l15_; kw[buf][u] = *(const u32x4*)((const char*)KC + off_); } } while (0)
#define QK_COMP(buf, kt) do { _Pragma("unroll") for (int u = 0; u < 4; ++u) *(LAS u32x4*)(KT + (4 * u + q4_) * 272 + 16 * l15_) = kw[buf][u];     \
        _Pragma("unroll") for (int g = 0; g < 2; ++g) { f32x4 acch = (f32x4){0.f, 0.f, 0.f, 0.f}, accl = (f32x4){0.f, 0.f, 0.f, 0.f}; \
            _Pragma("unroll") for (int ks = 0; ks < 4; ++ks) { const long kf_ = *(const LAS long*)(KT + fr * 272 + g * 128 + 32 * ks + 8 * fq); \
                acch = __builtin_amdgcn_mfma_f32_16x16x32_fp8_fp8(qh[g][ks], kf_, acch, 0, 0, 0); accl = __builtin_amdgcn_mfma_f32_16x16x32_fp8_fp8(ql[g][ks], kf_, accl, 0, 0, 0); } \
            if (fq == 0) { _Pragma("unroll") for (int r = 0; r < 4; ++r) L[(4 * g + r) * 256 + 16 * (kt) + fr] = (16 * (kt) + fr < nsel) ? (acch[r] + accl[r] * 0.0625f) * scale : -__builtin_inff(); } } } while (0)
        QK_LOAD(0, 0); if (1 < nkt) QK_LOAD(1, 1);
        for (int kt = 0; kt < nkt; kt += 3) {
            if (kt + 2 < nkt) QK_LOAD(2, kt + 2);
            __builtin_amdgcn_sched_barrier(0);
            QK_COMP(0, kt);
            if (kt + 1 < nkt) { if (kt + 3 < nkt) QK_LOAD(0, kt + 3); __builtin_amdgcn_sched_barrier(0); QK_COMP(1, kt + 1); }
            if (kt + 2 < nkt) { if (kt + 4 < nkt) QK_LOAD(1, kt + 4); __builtin_amdgcn_sched_barrier(0); QK_COMP(2, kt + 2); }
        }
#undef QK_LOAD
#undef QK_COMP
        if (fq == 0) { for (int kt = nkt; kt < 16; ++kt) {
#pragma unroll
            for (int r = 0; r < 8; ++r) L[r * 256 + 16 * kt + fr] = -__builtin_inff(); } }
    }
    float p[8][4];
#pragma unroll
    for (int hd = 0; hd < 8; ++hd) { float m = -__builtin_inff();
#pragma unroll
        for (int i = 0; i < 4; ++i) { p[hd][i] = L[hd * 256 + 4 * lane + i]; m = fmaxf(m, p[hd][i]); }
        m = wave_max(m); float s = 0.f;
#pragma unroll
        for (int i = 0; i < 4; ++i) { p[hd][i] = __expf(p[hd][i] - m); s += p[hd][i]; }
        s = 1.0f / wave_sum(s);
#pragma unroll
        for (int i = 0; i < 4; ++i) p[hd][i] *= s; }
    constexpr float PS = 256.0f;
    LAS unsigned* Ph = (LAS unsigned*)(wl + 1024); LAS unsigned* Pl = (LAS unsigned*)(wl + 1024 + 2048);
#pragma unroll
    for (int hd = 0; hd < 8; ++hd) {
        const float a0 = p[hd][0] * PS, a1 = p[hd][1] * PS, a2 = p[hd][2] * PS, a3 = p[hd][3] * PS;
        const unsigned h = pack4_fp8(a0, a1, a2, a3);
        const unsigned l = pack4_fp8(a0 - __builtin_amdgcn_cvt_f32_fp8((int)h, 0), a1 - __builtin_amdgcn_cvt_f32_fp8((int)h, 1), a2 - __builtin_amdgcn_cvt_f32_fp8((int)h, 2), a3 - __builtin_amdgcn_cvt_f32_fp8((int)h, 3));
        Ph[hd * 64 + lane] = h; Pl[hd * 64 + lane] = l;
    }
    LAS unsigned char* VT = wl + 9216;
    const int ii = lane & 15, kq = lane >> 4;
    f32x4 acc[16];
#pragma unroll
    for (int nt = 0; nt < 16; ++nt) acc[nt] = (f32x4){0.f, 0.f, 0.f, 0.f};
    const int nch = (nsel + 15) >> 4;
    u32x4 vw[3][4];
#define PV_LOAD(buf, c) do { _Pragma("unroll") for (int u = 0; u < 4; ++u) { const unsigned off_ = (unsigned)selw[16 * (c) + 4 * u + kq] * 256u + 16u * (unsigned)ii; vw[buf][u] = *(const u32x4*)((const char*)VC + off_); } } while (0)
#define PV_COMP(buf, c) do { _Pragma("unroll") for (int u = 0; u < 4; ++u) { LAS u32x2* d_ = (LAS u32x2*)(VT + (16 * ((c) & 1) + 4 * u + kq) * 264 + 16 * ii); d_[0] = (u32x2){vw[buf][u].x, vw[buf][u].y}; d_[1] = (u32x2){vw[buf][u].z, vw[buf][u].w}; } \
        if (((c) & 1) || (c) == nch - 1) { \
            if (!((c) & 1)) { _Pragma("unroll") for (int u = 0; u < 4; ++u) { LAS u32x2* d_ = (LAS u32x2*)(VT + (16 + 4 * u + kq) * 264 + 16 * ii); d_[0] = (u32x2){0u, 0u}; d_[1] = (u32x2){0u, 0u}; } } \
            long pah[2], pal[2]; _Pragma("unroll") for (int g = 0; g < 2; ++g) { const int po_ = (g * 4 + (ii & 3)) * 256 + 32 * ((c) >> 1) + 8 * kq; \
                const long h_ = *(const LAS long*)((const LAS unsigned char*)Ph + po_), l_ = *(const LAS long*)((const LAS unsigned char*)Pl + po_); pah[g] = ii < 4 ? h_ : 0l; pal[g] = ii < 4 ? l_ : 0l; } \
            _Pragma("unroll") for (int nt = 0; nt < 16; ++nt) { const v2i32 t_ = __builtin_amdgcn_ds_read_tr8_b64_v2i32((LAS v2i32*)(VT + (8 * kq + (ii >> 1)) * 264 + 16 * nt + 8 * (ii & 1))); \
                const long b_ = __builtin_bit_cast(long, t_); \
                acc[nt] = __builtin_amdgcn_mfma_f32_16x16x32_fp8_fp8(pah[nt >> 3], b_, acc[nt], 0, 0, 0); acc[nt] = __builtin_amdgcn_mfma_f32_16x16x32_fp8_fp8(pal[nt >> 3], b_, acc[nt], 0, 0, 0); } } } while (0)
    PV_LOAD(0, 0); if (1 < nch) PV_LOAD(1, 1);
    for (int c = 0; c < nch; c += 3) {
        if (c + 2 < nch) PV_LOAD(2, c + 2);
        __builtin_amdgcn_sched_barrier(0);
        PV_COMP(0, c);
        if (c + 1 < nch) { if (c + 3 < nch) PV_LOAD(0, c + 3); __builtin_amdgcn_sched_barrier(0); PV_COMP(1, c + 1); }
        if (c + 2 < nch) { if (c + 4 < nch) PV_LOAD(1, c + 4); __builtin_amdgcn_sched_barrier(0); PV_COMP(2, c + 2); }
    }
#undef PV_LOAD
#undef PV_COMP
    LAS float* OB = (LAS float*)(wl + 1024 + 4096);
    if (kq == 0) {
#pragma unroll
        for (int nt = 0; nt < 16; ++nt)
#pragma unroll
            for (int r = 0; r < 4; ++r) OB[(4 * (nt >> 3) + r) * 128 + 16 * (nt & 7) + ii] = acc[nt][r];
    }
    {
        const f32x4 a0 = *(const LAS f32x4*)(OB + 16 * lane), a1 = *(const LAS f32x4*)(OB + 16 * lane + 4), a2 = *(const LAS f32x4*)(OB + 16 * lane + 8), a3 = *(const LAS f32x4*)(OB + 16 * lane + 12);
        const f32x4 b0 = a0 * (OP8_SCALE / PS), b1 = a1 * (OP8_SCALE / PS), b2 = a2 * (OP8_SCALE / PS), b3 = a3 * (OP8_SCALE / PS);
        *(u32x4*)(ATT + (size_t)t * 1024 + 16 * lane) = (u32x4){pack4_fp8(b0[0], b0[1], b0[2], b0[3]), pack4_fp8(b1[0], b1[1], b1[2], b1[3]), pack4_fp8(b2[0], b2[1], b2[2], b2[3]), pack4_fp8(b3[0], b3[1], b3[2], b3[3])};
    }
}


__device__ __forceinline__ void convert_item8(const float* __restrict__ W, int K, int N, int ld, unsigned char* WT, int mode, int item, int lane, LAS unsigned char* scr) {
    const int nblk = N >> 6; const int kb = item / nblk, nb = item - kb * nblk; const int k0 = kb * 256, n0 = nb * 64;
    const int c4 = lane & 15, kr = lane >> 4;
    const float* src = W + (size_t)(k0 + 4 * kr) * ld + n0 + 4 * c4;
#pragma unroll 4
    for (int i = 0; i < 16; ++i) {
        f32x4 v[4];
#pragma unroll
        for (int r = 0; r < 4; ++r) v[r] = __builtin_nontemporal_load((const f32x4*)(src + (size_t)(16 * i + r) * ld));
        const int kk = 16 * i + 4 * kr;
#pragma unroll
        for (int e = 0; e < 4; ++e) *(LAS unsigned*)(scr + (4 * c4 + e) * 272 + kk) = pack4_fp8(v[0][e] * W8_SCALE, v[1][e] * W8_SCALE, v[2][e] * W8_SCALE, v[3][e] * W8_SCALE);
    }
    LDS_WAIT(); asm volatile("" ::: "memory");
#pragma unroll 4
    for (int j = 0; j < 16; ++j) {
        const int q = j * 64 + lane, n = q >> 4, ch = q & 15;
        const u32x4 v = *(const LAS u32x4*)(scr + n * 272 + ch * 16);
        *(u32x4*)(WT + (size_t)dest_row(mode, n0 + n) * K + k0 + ch * 16) = v;
    }
    LDS_WAIT(); asm volatile("" ::: "memory");
}

struct Conv8Job { const float* W; unsigned char* WT; int N; int mode; size_t w_estride, wt_estride; int items_per_e; };
constexpr int C8_PITCH = 272, C8_IMG = 256 * C8_PITCH;
__device__ __forceinline__ void conv8_load(const Conv8Job& jb, int item, int h, int wave, int lane, f32x4 (&v)[16]) {
    const int e = item / jb.items_per_e, r = item - e * jb.items_per_e; const int nblk = jb.N >> 8; const int kb = r / nblk, nb = r - kb * nblk;
    const float* src = jb.W + (size_t)e * jb.w_estride + (size_t)(kb * 256 + 32 * wave + 16 * h) * jb.N + nb * 256 + 4 * lane;
#pragma unroll
    for (int i = 0; i < 16; ++i) v[i] = __builtin_nontemporal_load((const f32x4*)(src + (size_t)i * jb.N));
}
__device__ __forceinline__ void conv8_to_lds(LAS unsigned char* img, int h, int wave, int lane, const f32x4 (&v)[16]) {
#pragma unroll
    for (int e = 0; e < 4; ++e) { u32x4 w;
#pragma unroll
        for (int g = 0; g < 4; ++g) w[g] = pack4_fp8(v[4 * g][e] * W8_SCALE, v[4 * g + 1][e] * W8_SCALE, v[4 * g + 2][e] * W8_SCALE, v[4 * g + 3][e] * W8_SCALE);
        *(LAS u32x4*)(img + (4 * lane + e) * C8_PITCH + 32 * wave + 16 * h) = w; }
}
__device__ __forceinline__ void conv8_store(const Conv8Job& jb, int item, const LAS unsigned char* img, int tid) {
    const int e = item / jb.items_per_e, r = item - e * jb.items_per_e; const int nblk = jb.N >> 8; const int kb = r / nblk, nb = r - kb * nblk;
    unsigned char* dst = jb.WT + (size_t)e * jb.wt_estride + kb * 256;
#pragma unroll
    for (int j = 0; j < 8; ++j) { const int q = j * 512 + tid, n = q >> 4, ch = q & 15;
        __builtin_nontemporal_store(*(const LAS u32x4*)(img + n * C8_PITCH + ch * 16), (u32x4*)(dst + (size_t)dest_row(jb.mode, nb * 256 + n) * 2048 + ch * 16)); }
}
__device__ __forceinline__ void conv8_run(LAS unsigned char* lds, const Conv8Job& jb, int n_items, int wg, int G, int tid, int wave, int lane) {
    if (wg >= n_items) return;
    f32x4 a[16], b[16]; int par = 0;
    conv8_load(jb, wg, 0, wave, lane, a); conv8_load(jb, wg, 1, wave, lane, b);
    for (int it = wg; it < n_items; it += G, par ^= 1) {
        LAS unsigned char* img = lds + par * C8_IMG;
        const int nx = (it + G < n_items) ? it + G : it;
        conv8_to_lds(img, 0, wave, lane, a); __builtin_amdgcn_sched_barrier(0);
        conv8_load(jb, nx, 0, wave, lane, a); __builtin_amdgcn_sched_barrier(0);
        conv8_to_lds(img, 1, wave, lane, b); __builtin_amdgcn_sched_barrier(0);
        conv8_load(jb, nx, 1, wave, lane, b); __builtin_amdgcn_sched_barrier(0);
        __syncthreads();
        conv8_store(jb, it, img, tid);
    }
    __syncthreads();
}

__global__ void __launch_bounds__(NTHR, 2) fwd_kernel(Args args) {
    extern __shared__ __attribute__((aligned(16))) unsigned char lds_raw[];
    LAS unsigned char* lds = (LAS unsigned char*)lds_raw;
    volatile LAS unsigned* MISC = (volatile LAS unsigned*)(lds + LDS_MISC);
    const int tid = threadIdx.x, lane = tid & 63, wave = __builtin_amdgcn_readfirstlane(tid >> 6);
    const int G = gridDim.x, wg = blockIdx.x;
    unsigned char* ws = args.ws;
    unsigned* ctl = (unsigned*)(ws + WS_CTL);
    const int lo = args.ph_lo, hi = args.ph_hi;
    const float* x = (const float*)args.in[0]; const float* cvec = (const float*)args.in[1]; const int* positions = (const int*)args.in[2];
    const float* w_ada = (const float*)args.in[3]; const float* b_ada = (const float*)args.in[4]; const float* norm1_g = (const float*)args.in[5];
    const float* w_in = (const float*)args.in[6]; const float* idx_knorm_g = (const float*)args.in[7]; const float* idx_knorm_b = (const float*)args.in[8];
    const float* lb_logits = (const float*)args.in[9]; const float* hgrn_norm_g = (const float*)args.in[10];
    const float* w_proj_att = (const float*)args.in[11]; const float* w_proj_hgrn = (const float*)args.in[12]; const float* w_out = (const float*)args.in[13];
    const float* norm2_g = (const float*)args.in[14]; const float* w_router = (const float*)args.in[15]; const float* b_router = (const float*)args.in[16];
    const float* w1 = (const float*)args.in[17]; const float* b1 = (const float*)args.in[18]; const float* w2 = (const float*)args.in[19]; const float* b2 = (const float*)args.in[20];
    const float* final_g = (const float*)args.in[21];
    float* out = args.out;
    float* MOD = (float*)(ws + WS_MOD); int* TOPE = (int*)(ws + WS_TOPE); float* GATE = (float*)(ws + WS_GATE); int* SLOT = (int*)(ws + WS_SLOT);
    bf16_t* WIN_T = (bf16_t*)(ws + WS_WIN_T); bf16_t* WA_T = (bf16_t*)(ws + WS_WA_T); bf16_t* WH_T = (bf16_t*)(ws + WS_WH_T); bf16_t* WO_T = (bf16_t*)(ws + WS_WO_T);
    unsigned char* WIN_T8 = ws + WS_WIN_T + 8 * MiB;
    unsigned char* HA8 = ws + WS_SCORES;
    unsigned char* W1_T = ws + WS_W1_T; unsigned char* W2_T = ws + WS_W2_T;
    bf16_t* HB = (bf16_t*)(ws + WS_H); bf16_t* PROJ = (bf16_t*)(ws + WS_PROJ);
    bf16_t* DELTA = (bf16_t*)(ws + WS_ATT);
    unsigned char* ACT = ws + WS_ACT; bf16_t* YB = (bf16_t*)(ws + WS_YB);
    int* TOKS = (int*)(ws + WS_TOKS);
    unsigned char* H8 = ws + WS_H;
    bf16_t* KI = (bf16_t*)(ws + WS_KI); unsigned char* KC = ws + WS_KC; unsigned char* VC = ws + WS_VC;
    bf16_t* ST = (bf16_t*)(ws + WS_ST); float* DC = (float*)(ws + WS_DC);
    unsigned char* ATT = ws + WS_ATT; unsigned char* REC = ATT + (size_t)S * 1024;        bf16_t* MERGED = (bf16_t*)(ws + WS_MERGED); unsigned short* SCORES = (unsigned short*)(ws + WS_SCORES);
    unsigned short* SEGMAX = (unsigned short*)(ws + WS_X1);

    for (int u = tid; u < 128; u += NTHR) MISC[u] = 0u;
    __syncthreads();
    const bool one_launch = (hi - lo) > 1;
    XcdBarrier bar; bar.bar = ctl + CW_BAR; bar.x = 0; bar.st = MISC + 8;
    if (one_launch) bar = xcd_barrier_post(ctl + CW_BAR, MISC + 8);
#define IN(k) (lo <= (k) && (k) < hi)
#define SEAM(k) do { if (IN(k) && IN((k) + 1)) xcd_barrier(bar); } while (0)


    if (IN(PH_PRO)) {
        for (int cb = wg; cb < 256; cb += G) {
            LAS float* red = (LAS float*)lds;
            const int c4 = tid % 12, kg = tid / 12;
            f32x4 acc = (f32x4){0.f, 0.f, 0.f, 0.f};
            if (kg < 42) {
                const float* wp = w_ada + (size_t)cb * 48 + 4 * c4;
#pragma unroll 7
                for (int j = 0; j < 49; ++j) { const int k = kg + 42 * j; if (k < D) { const f32x4 v = __builtin_nontemporal_load((const f32x4*)(wp + (size_t)k * (6 * D))); acc += siluf_(cvec[k]) * v; } }
                *(LAS f32x4*)(red + kg * 48 + 4 * c4) = acc;
            }
            __syncthreads();
            if (tid < 48) { float s = b_ada[cb * 48 + tid];
#pragma unroll 6
                for (int q = 0; q < 42; ++q) s += red[q * 48 + tid];
                MOD[cb * 48 + tid] = s; }
            __syncthreads();
        }
        LAS unsigned char* scr = lds + wave * 17408;
        const int gw = wg * NWAVES + wave, NGW = G * NWAVES;
        {
            constexpr int NB_IN = (1104 + 63) / 64;
            for (int it = gw; it < 16 * NB_IN; it += NGW) convert_item(w_in + 1536, 2048, 1104, DIN, WIN_T, 0, it, lane, scr);
            for (int it = gw; it < 4 * 32; it += NGW) convert_item8(w_proj_att, 1024, 2048, 2048, (unsigned char*)WA_T, 0, it, lane, scr);
            for (int it = gw; it < 4 * 32; it += NGW) convert_item8(w_proj_hgrn, 1024, 2048, 2048, (unsigned char*)WA_T + (size_t)2048 * 1024, 0, it, lane, scr);
            for (int it = gw; it < 8 * 32; it += NGW) convert_item8(w_out, 2048, 2048, 2048, (unsigned char*)WO_T, 0, it, lane, scr);
            for (int it = gw; it < 8 * 24; it += NGW) convert_item8(w_in, 2048, 1536, DIN, WIN_T8, 0, it, lane, scr);
            for (int it = gw; it < 8 * 128; it += NGW) convert_item8(w_in + 2640, 2048, 8192, DIN, WIN_T8 + (size_t)1536 * 2048, 0, it, lane, scr);
            for (size_t i = (size_t)wg * NTHR + tid; i < (size_t)176 * 2048 * 2 / 16; i += (size_t)G * NTHR) ((u32x4*)(WIN_T + (size_t)1104 * 2048))[i] = (u32x4){0u, 0u, 0u, 0u};
        }
    }
    SEAM(PH_PRO);

    {
    if (IN(PH_H)) {
        const float* sh1 = MOD; const float* sc1 = MOD + D;
        const int gw = wg * NWAVES + wave, NGW = G * NWAVES;
        f32x4 gs[8], sh[8];
#pragma unroll
        for (int j = 0; j < 8; ++j) { const int c = 4 * lane + 256 * j; const f32x4 g = *(const f32x4*)(norm1_g + c), sc = *(const f32x4*)(sc1 + c); sh[j] = *(const f32x4*)(sh1 + c);
#pragma unroll
            for (int e = 0; e < 4; ++e) gs[j][e] = g[e] * (1.0f + sc[e]); }
        for (int t = gw; t < S; t += NGW) {
            const f32x4* xr = (const f32x4*)(x + (size_t)t * D) + lane;
            f32x4 v[8]; float ss = 0.f;
#pragma unroll
            for (int j = 0; j < 8; ++j) { v[j] = xr[64 * j]; ss += (v[j][0] * v[j][0] + v[j][1] * v[j][1]) + (v[j][2] * v[j][2] + v[j][3] * v[j][3]); }
            const float rstd = rsqrtf(wave_sum(ss) * (1.0f / D) + NORM_EPS);
#pragma unroll
            for (int j = 0; j < 8; ++j) { const f32x4 h = v[j] * rstd * gs[j] + sh[j]; u32x2 w; w.x = cvt_pk_bf16(h[0], h[1]); w.y = cvt_pk_bf16(h[2], h[3]);
                *(u32x2*)(HB + (size_t)t * D + 4 * lane + 256 * j) = w;
                *(unsigned*)(HA8 + (size_t)t * D + 4 * lane + 256 * j) = pack4_fp8(h[0], h[1], h[2], h[3]); }
        }
    }
    SEAM(PH_H);
    if (IN(PH_INPROJ)) {
        const int XC = (G == 256) ? XCONV : 0;
        const Conv8Job j1{w1, W1_T, 4096, 2, (size_t)2048 * 4096, (size_t)4096 * 2048, 8 * 16};
        const Conv8Job j2{w2, W2_T, 2048, 0, (size_t)2048 * 2048, (size_t)2048 * 2048, 8 * 8};
        if (G != 256) { conv8_run(lds, j1, NEXP * 8 * 16, wg, G, tid, wave, lane); conv8_run(lds, j2, NEXP * 8 * 8, wg, G, tid, wave, lane); }
        if (wg < XC) { conv8_run(lds, j1, NEXP * 8 * 16, wg, XC, tid, wave, lane); conv8_run(lds, j2, NEXP * 8 * 8, wg, XC, tid, wave, lane); }
        else {
            const int Gg = G - XC, cg = wg - XC;
            {
                pg8::Gemm g8{HA8, WIN_T8, 2048, 0, nullptr, 0}; pg8::StaticOrder S8; S8.init(S, 9728, Gg, cg);
                const int full8 = 2432 / Gg, rem8 = 2432 - full8 * Gg;
                if (Gg == 256) S8.skew(8, (wg >= 128 && wg < 192) ? -1 : (wg < 128 ? wg : wg - 64), 192);
                else if (rem8 > 0) S8.skew(full8, cg < rem8 ? cg : -1, rem8);
                pg8::EpiBf16 E8{PROJ, DINP, nullptr, 0, 1.0f / W8_SCALE, 6, 1280};
                pg8::gemm_phase<pg8::EpiBf16, pg8::StaticOrder, true>(lds, g8, S8, E8);
            }
            {
                pg8::Gemm g{HB, WIN_T, 2048, 0, nullptr, 0}; pg8::StaticOrder So; So.init(S, 1280, Gg, Gg == 256 ? (wg + 128) % G : (cg + Gg - (2432 % Gg)) % Gg);
                pg8::EpiBf16 E{PROJ + CQI, DINP, nullptr, 0, 1.0f, 1 << 30, 0};
                pg8::gemm_phase<pg8::EpiBf16, pg8::StaticOrder>(lds, g, So, E);
            }
        }
    }
    SEAM(PH_INPROJ);
    if (IN(PH_POST)) {
        const int gw = wg * NWAVES + wave, NGW = G * NWAVES;
        for (int t = gw; t < S; t += NGW) post_token(PROJ, KI, KC, VC, positions, idx_knorm_g, idx_knorm_b, t, lane);
        __syncthreads();
        for (int u = wg; u < 2048; u += G) hgrn_l1(lds, PROJ, lb_logits, ST, DC, u >> 3, u & 7, tid, wave, lane);
    }
    SEAM(PH_POST);
    if (IN(PH_SCORE)) {
        for (int idx = wg * NTHR + tid; idx < 8 * 128 * 128; idx += G * NTHR) {
            const int h = idx >> 14, d = idx & 127; float s = 0.f;
            bf16_t* sp = ST + idx; const float* dp = DC + h * 128 + d;
            for (int c = 0; c < 256; c += 16) {
                float l[16], dc[16];
#pragma unroll
                for (int i = 0; i < 16; ++i) { l[i] = bf2f(sp[(size_t)(c + i) * 131072]); dc[i] = dp[(size_t)(c + i) * 1024]; }
#pragma unroll
                for (int i = 0; i < 16; ++i) { sp[(size_t)(c + i) * 131072] = f2bf(s); s = dc[i] * s + l[i]; }
            }
        }
        {
            const int XS = (G == 256) ? XSCORE : 0;
            if (wg < XS) {
                const Conv8Job j1{w1, W1_T, 4096, 2, (size_t)2048 * 4096, (size_t)4096 * 2048, 8 * 16};
                const Conv8Job j2{w2, W2_T, 2048, 0, (size_t)2048 * 2048, (size_t)2048 * 2048, 8 * 8};
                __syncthreads();
                conv8_run(lds, j1, NEXP * 8 * 16, wg, XS, tid, wave, lane); conv8_run(lds, j2, NEXP * 8 * 8, wg, XS, tid, wave, lane);
            }
            for (;;) {
                if (tid == 0) MISC[100] = __hip_atomic_fetch_add(ctl + CW_SCQ, 1u, __ATOMIC_RELAXED, __HIP_MEMORY_SCOPE_AGENT);
                __syncthreads();
                const int item = (int)MISC[100];
                __syncthreads();
                if (item >= 252 * 6) break;
                int j, lo, hi;
                if (item < 504) { j = item >> 1; const int T = ((8 + j) >> 2) + ((511 - j) >> 2) + 2; const int p = item & 1; lo = p * T / 3; hi = (p + 1) * T / 3; }
                else { const int i2 = item - 504; j = i2 >> 2; const int T = ((8 + j) >> 2) + ((511 - j) >> 2) + 2; const int p = i2 & 3, b = 2 * T / 3; lo = b + p * (T - b) / 4; hi = b + (p + 1) * (T - b) / 4; }
                const int qa = 8 + j, qb2 = 511 - j, na = (qa >> 2) + 1;
                const int a0 = lo < na ? lo : na, a1 = hi < na ? hi : na, b0 = (lo > na ? lo : na) - na, b1 = (hi > na ? hi : na) - na;
                if (a1 > a0) score_block(lds, PROJ, KI, SCORES, SEGMAX, qa, a0, a1, tid, wave, lane);
                if (b1 > b0) score_block(lds, PROJ, KI, SCORES, SEGMAX, qb2, b0, b1, tid, wave, lane);
            }
        }
    }
    SEAM(PH_SCORE);
    if (IN(PH_ATTN)) {
        const int gw = wg * NWAVES + wave, NGW = G * NWAVES;
        for (int u = wg; u < 2048; u += G) hgrn_l3(lds, PROJ, lb_logits, ST, hgrn_norm_g, REC, u >> 3, u & 7, tid, wave, lane);
        {
            for (;;) {
                unsigned tq = 0; if (lane == 0) tq = __hip_atomic_fetch_add(ctl + CW_ATQ, 1u, __ATOMIC_RELAXED, __HIP_MEMORY_SCOPE_AGENT);
                tq = (unsigned)__builtin_amdgcn_readfirstlane((int)tq);
                if (tq >= (unsigned)S) break;
                const int t = S - 1 - (int)tq;
                LAS unsigned char* wl = lds + wave * 17664;
                if (t >= 256) select_row(wl, SCORES, SEGMAX, t, lane);
                else {
#pragma unroll
                    for (int i = 0; i < 4; ++i) { const int idx = lane + 64 * i; ((LAS int*)wl)[idx] = idx <= t ? idx : 0; }
                }
                attn_query(wl, PROJ, KC, VC, ATT, t, lane);
            }
        }
    }
    SEAM(PH_ATTN);
    if (IN(PH_OP1)) {
        pg8::Gemm g{ATT, WA_T, 1024, (size_t)2048 * 1024, nullptr, (size_t)S * 1024};
        pg8::TwoPartOrder So; So.init(S, 2048, G, wg);
        pg8::EpiGate2 E{(unsigned char*)MERGED, PROJ + CGA, PROJ + CGR};
        pg8::gemm_phase<pg8::EpiGate2, pg8::TwoPartOrder, true>(lds, g, So, E);
    }
    SEAM(PH_OP2);
    if (IN(PH_WOUT)) {
        pg8::Gemm g{MERGED, WO_T, 2048, 0, nullptr, 0}; pg8::StaticOrder So; So.init(S, 2048, G, wg);
        pg8::EpiDelta E{MOD + 2 * D, DELTA, 1.0f / (W8_SCALE * MRG8_SCALE)};
        pg8::gemm_phase<pg8::EpiDelta, pg8::StaticOrder, true>(lds, g, So, E);
    }
    SEAM(PH_WOUT);
    }

    if (IN(PH_ROUTER)) {
        LAS float* hs = (LAS float*)lds;
        volatile LAS unsigned* lcnt = MISC + 32;
        const float* sh2 = MOD + 3 * D; const float* sc2 = MOD + 4 * D;
        if (tid < 32) lcnt[tid] = 0u;
        __syncthreads();
        for (int grp = wg; grp < S / 16; grp += G) {
#pragma unroll 1
            for (int q = 0; q < 2; ++q) {
                const int tl = 2 * wave + q, t = grp * 16 + tl;
                const f32x4* xr = (const f32x4*)(x + (size_t)t * D) + lane; const u32x2* dr = (const u32x2*)(DELTA + (size_t)t * D) + lane;
                f32x4 v[8]; float ss = 0.f;
#pragma unroll
                for (int j = 0; j < 8; ++j) { const u32x2 dw = dr[64 * j]; v[j] = xr[64 * j] + (f32x4){bf_lo(dw.x), bf_hi(dw.x), bf_lo(dw.y), bf_hi(dw.y)};
                    ss += (v[j][0] * v[j][0] + v[j][1] * v[j][1]) + (v[j][2] * v[j][2] + v[j][3] * v[j][3]); }
#pragma unroll
                for (int j = 0; j < 8; ++j) { u32x2 w; w.x = cvt_pk_bf16(v[j][0], v[j][1]); w.y = cvt_pk_bf16(v[j][2], v[j][3]); ((u32x2*)(DELTA + (size_t)t * D) + lane)[64 * j] = w; }
                const float rstd = rsqrtf(wave_sum(ss) * (1.0f / D) + NORM_EPS);
#pragma unroll
                for (int j = 0; j < 8; ++j) {
                    const int c = 4 * lane + 256 * j;
                    const f32x4 g = *(const f32x4*)(norm2_g + c), sc = *(const f32x4*)(sc2 + c), sh = *(const f32x4*)(sh2 + c);
                    f32x4 h;
#pragma unroll
                    for (int e = 0; e < 4; ++e) h[e] = v[j][e] * rstd * g[e] * (1.0f + sc[e]) + sh[e];
                    *(LAS f32x4*)(hs + tl * 2048 + c) = h;
                    *(unsigned*)(H8 + (size_t)t * D + c) = pack4_fp8(h[0], h[1], h[2], h[3]);
                }
            }
            __syncthreads();
            {
                LAS float* part = (LAS float*)(lds + 131072);
                const int fr = lane & 15, fq = lane >> 4;
                f32x4 acc0 = (f32x4){0.f, 0.f, 0.f, 0.f}, acc1 = acc0;
                const LAS float* hrow = hs + fr * 2048 + wave * 256 + 4 * fq; const float* wrp = w_router + (size_t)(wave * 256 + 4 * fq) * 32 + fr;
#pragma unroll 2
                for (int i = 0; i < 16; ++i) {
                    const f32x4 a4 = *(const LAS f32x4*)(hrow + 16 * i);
                    float b0[4], b1[4];
#pragma unroll
                    for (int s = 0; s < 4; ++s) { b0[s] = wrp[(size_t)(16 * i + s) * 32]; b1[s] = wrp[(size_t)(16 * i + s) * 32 + 16]; }
#pragma unroll
                    for (int s = 0; s < 4; ++s) { acc0 = __builtin_amdgcn_mfma_f32_16x16x4f32(a4[s], b0[s], acc0, 0, 0, 0); acc1 = __builtin_amdgcn_mfma_f32_16x16x4f32(a4[s], b1[s], acc1, 0, 0, 0); }
                }
#pragma unroll
                for (int r = 0; r < 4; ++r) { part[(wave * 16 + 4 * fq + r) * 32 + fr] = acc0[r]; part[(wave * 16 + 4 * fq + r) * 32 + 16 + fr] = acc1[r]; }
                __syncthreads();
                const int tl = tid >> 5, e = tid & 31, t = grp * 16 + tl;
                float v = b_router[e];
#pragma unroll
                for (int w = 0; w < 8; ++w) v += part[(w * 16 + tl) * 32 + e];
                float tv[4]; int ti[4];
#pragma unroll
                for (int k = 0; k < 4; ++k) {
                    float bv = v; int bi = e;
#pragma unroll
                    for (int o = 16; o >= 1; o >>= 1) { const float ov = __shfl_xor(bv, o); const int oi = __shfl_xor(bi, o); if (ov > bv || (ov == bv && oi < bi)) { bv = ov; bi = oi; } }
                    tv[k] = bv; ti[k] = bi; if (e == bi) v = -__builtin_inff();
                }
                if (e == 0) {
                    const float e1 = __expf(tv[1] - tv[0]), e2 = __expf(tv[2] - tv[0]), e3 = __expf(tv[3] - tv[0]); const float inv = 1.0f / (1.0f + e1 + e2 + e3);
                    *(int4*)(TOPE + (size_t)t * 4) = make_int4(ti[0], ti[1], ti[2], ti[3]);
                    *(f32x4*)(GATE + (size_t)t * 4) = (f32x4){inv, e1 * inv, e2 * inv, e3 * inv};
#pragma unroll
                    for (int k = 0; k < 4; ++k) __hip_atomic_fetch_add((LAS unsigned*)&lcnt[ti[k]], 1u, __ATOMIC_RELAXED, __HIP_MEMORY_SCOPE_WORKGROUP);
                }
            }
            __syncthreads();
        }
        if (tid < 32) { const unsigned c = lcnt[tid]; if (c) __hip_atomic_fetch_add(ctl + CW_CNT + tid, c, __ATOMIC_RELAXED, __HIP_MEMORY_SCOPE_AGENT); }
    }
    SEAM(PH_ROUTER);

    if (IN(PH_SCATTER)) {
        volatile LAS unsigned* lcnt = MISC + 32; volatile LAS unsigned* lbase = MISC + 64; LAS int* pstart = (LAS int*)(lds + 1024); LAS int* pcnt = (LAS int*)(lds + 1280);
        if (tid == 0) { int p = 0; for (int e = 0; e < NEXP; ++e) { const int c = (int)__hip_atomic_load(ctl + CW_CNT + e, __ATOMIC_RELAXED, __HIP_MEMORY_SCOPE_AGENT); pstart[e] = p; pcnt[e] = c; p += (c + 255) & ~255; } }
        if (tid < 32) lcnt[tid] = 0u;
        __syncthreads();
        if (wg < NEXP) { const int e = wg; for (int s = pstart[e] + pcnt[e] + tid; s < pstart[e] + ((pcnt[e] + 255) & ~255); s += NTHR) TOKS[s] = 0; }
        for (int blk = wg; blk < S / 64; blk += G) {
            int e = 0, lrank = 0;
            if (tid < 256) { e = TOPE[(size_t)blk * 256 + tid]; lrank = (int)__hip_atomic_fetch_add((LAS unsigned*)&lcnt[e], 1u, __ATOMIC_RELAXED, __HIP_MEMORY_SCOPE_WORKGROUP); }
            __syncthreads();
            if (tid < 32) { const unsigned c = lcnt[tid]; lbase[tid] = c ? __hip_atomic_fetch_add(ctl + CW_FILL + tid, c, __ATOMIC_RELAXED, __HIP_MEMORY_SCOPE_AGENT) : 0u; }
            __syncthreads();
            if (tid < 256) { const int slot = pstart[e] + (int)lbase[e] + lrank; SLOT[(size_t)blk * 256 + tid] = slot; TOKS[slot] = blk * 64 + (tid >> 2); }
            __syncthreads();
            if (tid < 32) lcnt[tid] = 0u;
            __syncthreads();
        }
    }
    SEAM(PH_SCATTER);

    if (IN(PH_MOE1) || IN(PH_MOE2)) {
        LAS int* panel_e = (LAS int*)(lds + 131072 + 2048);
        LAS int* npan = (LAS int*)(lds + 131072 + 2048 + 2048);
        __syncthreads();
        if (tid == 0) { int p = 0; for (int e = 0; e < NEXP; ++e) { const int np = (int)((__hip_atomic_load(ctl + CW_CNT + e, __ATOMIC_RELAXED, __HIP_MEMORY_SCOPE_AGENT) + 255u) >> 8); for (int q = 0; q < np; ++q) panel_e[p + q] = e; p += np; } npan[0] = p; }
        __syncthreads();
        const int nPanels = npan[0];
        if (IN(PH_MOE1)) {
            pg8::Gemm g{H8, W1_T, 2048, (size_t)4096 * 2048, TOKS, 0}; pg8::MoeOrder So; So.init(nPanels, 16, G, wg, panel_e);
            pg8::EpiSwiglu E{ACT, b1};
            pg8::gemm_phase<pg8::EpiSwiglu, pg8::MoeOrder, true>(lds, g, So, E);
        }
        SEAM(PH_MOE1);
        if (IN(PH_MOE2)) {
            pg8::Gemm g{ACT, W2_T, 2048, (size_t)2048 * 2048, nullptr, 0}; pg8::MoeOrder So; So.init(nPanels, 8, G, wg, panel_e);
            pg8::EpiBf16 E{YB, 2048, b2, 2048, 1.0f / (W8_SCALE * ACT8_SCALE), 1 << 30, 0};
            pg8::gemm_phase<pg8::EpiBf16, pg8::MoeOrder, true>(lds, g, So, E);
        }
    }
    SEAM(PH_MOE2);

    if (IN(PH_FINAL)) {
        const float* gt2 = MOD + 5 * D;
        const int gw = wg * NWAVES + wave, NGW = G * NWAVES;
        for (int t = gw; t < S; t += NGW) {
            const u32x2* dr = (const u32x2*)(DELTA + (size_t)t * D) + lane;
            f32x4 v[8];
#pragma unroll
            for (int j = 0; j < 8; ++j) { const u32x2 dw = dr[64 * j]; v[j] = (f32x4){bf_lo(dw.x), bf_hi(dw.x), bf_lo(dw.y), bf_hi(dw.y)}; }
            {
                f32x4 m[8];
#pragma unroll
                for (int j = 0; j < 8; ++j) m[j] = (f32x4){0.f, 0.f, 0.f, 0.f};
                const int4 sl = *(const int4*)(SLOT + (size_t)t * 4); const f32x4 gt = *(const f32x4*)(GATE + (size_t)t * 4);
                const int sls[4] = {sl.x, sl.y, sl.z, sl.w};
#pragma unroll
                for (int k = 0; k < 4; ++k) {
                    const u32x2* yr = (const u32x2*)(YB + (size_t)sls[k] * D) + lane; const float gk = gt[k];
#pragma unroll
                    for (int j = 0; j < 8; ++j) { const u32x2 w = yr[64 * j]; m[j][0] += gk * bf_lo(w.x); m[j][1] += gk * bf_hi(w.x); m[j][2] += gk * bf_lo(w.y); m[j][3] += gk * bf_hi(w.y); }
                }
#pragma unroll
                for (int j = 0; j < 8; ++j) { const f32x4 g2 = *(const f32x4*)(gt2 + 4 * lane + 256 * j); v[j] = v[j] + g2 * m[j]; }
            }
            float ss = 0.f;
#pragma unroll
            for (int j = 0; j < 8; ++j) ss += (v[j][0] * v[j][0] + v[j][1] * v[j][1]) + (v[j][2] * v[j][2] + v[j][3] * v[j][3]);
            const float rstd = rsqrtf(wave_sum(ss) * (1.0f / D) + NORM_EPS);
            f32x4* orow = (f32x4*)(out + (size_t)t * D) + lane;
#pragma unroll
            for (int j = 0; j < 8; ++j) { const f32x4 fg = *(const f32x4*)(final_g + 4 * lane + 256 * j); orow[64 * j] = v[j] * rstd * fg; }
        }
    }
#undef IN
#undef SEAM
}

#ifndef MK_ONE_LAUNCH
#define MK_ONE_LAUNCH 1
#endif
extern "C" void kernel_launch(void* const* d_in, const int* in_sizes, int n_in, void* d_out, int out_size, void* d_ws, size_t ws_size, hipStream_t stream) {
    static int grid = 0;
    if (grid == 0) {
        if (n_in != 22 || out_size != S * D || ws_size < WS_END) { fprintf(stderr, "kernel_launch: unexpected shapes: n_in %d out %d ws %zu (need %zu)\n", n_in, out_size, ws_size, (size_t)WS_END); grid = -1; return; }
        int dev = 0, cus = 0, per_cu = 0;
        if (hipGetDevice(&dev) != hipSuccess || hipDeviceGetAttribute(&cus, hipDeviceAttributeMultiprocessorCount, dev) != hipSuccess) { grid = -1; return; }
        if (hipFuncSetAttribute((const void*)fwd_kernel, hipFuncAttributeMaxDynamicSharedMemorySize, LDS_BYTES) != hipSuccess) { fprintf(stderr, "kernel_launch: hipFuncSetAttribute failed\n"); grid = -1; return; }
        if (hipOccupancyMaxActiveBlocksPerMultiprocessor(&per_cu, (const void*)fwd_kernel, NTHR, LDS_BYTES) != hipSuccess || per_cu < 1) { fprintf(stderr, "kernel_launch: occupancy query says %d\n", per_cu); (void)hipGetLastError(); grid = -1; return; }
        grid = cus;
    }
    if (grid < 0) return;
    (void)in_sizes;
    hipMemsetAsync((char*)d_ws + WS_CTL, 0, CTL_BYTES, stream);
    Args a{};
    for (int i = 0; i < 22; ++i) a.in[i] = d_in[i];
    a.out = (float*)d_out; a.ws = (unsigned char*)d_ws; a.flags = 0; a.pad = 0;
#if MK_ONE_LAUNCH
    a.ph_lo = 0; a.ph_hi = NPH;
    hipLaunchKernelGGL(fwd_kernel, dim3(grid), dim3(NTHR), LDS_BYTES, stream, a);
#else
    for (int p = 0; p < NPH; ++p) { a.ph_lo = p; a.ph_hi = p + 1; hipLaunchKernelGGL(fwd_kernel, dim3(grid), dim3(NTHR), LDS_BYTES, stream, a); }
#endif
}
```

```cpp
#include <hip/hip_runtime.h>
#include <cstdio>
#include <cstdint>

#define GAS __attribute__((address_space(1)))
#define LAS __attribute__((address_space(3)))
typedef unsigned short bf16_t;
typedef short bf16x8 __attribute__((ext_vector_type(8)));
typedef float f32x4 __attribute__((ext_vector_type(4)));
typedef float f32x2 __attribute__((ext_vector_type(2)));
typedef float f32x16 __attribute__((ext_vector_type(16)));
typedef unsigned u32x4 __attribute__((ext_vector_type(4)));
typedef unsigned u32x2 __attribute__((ext_vector_type(2)));
typedef int i32x4 __attribute__((ext_vector_type(4)));
typedef int i32x8 __attribute__((ext_vector_type(8)));
typedef short s16x4 __attribute__((ext_vector_type(4)));
typedef short s16x2 __attribute__((ext_vector_type(2)));
typedef int v2i32 __attribute__((ext_vector_type(2)));

constexpr int S = 16384, D = 2048, DIN = 10832, DINP = 11008, NEXP = 32, DFF = 2048;
constexpr int NWAVES = 8, NTHR = 512;
constexpr int CQ = 0, CK = 1024, CV = 1280, CQI = 1536, CKI = 2560, CWI = 2624, CHQ = 2816, CHF = 3840, CHI = 4864, CHG = 5888, CGA = 6912, CGR = 8960;
constexpr int PMAX = 65536 + NEXP * 256;
constexpr float NORM_EPS = 1e-5f;

constexpr size_t MiB = 1u << 20;
constexpr size_t al256(size_t x) { return (x + 255) & ~(size_t)255; }
constexpr size_t WS_CTL = 0, CTL_BYTES = 1 * MiB;
constexpr size_t WS_MOD = WS_CTL + CTL_BYTES;
constexpr size_t WS_TOPE = WS_MOD + 64 * 1024;
constexpr size_t WS_GATE = WS_TOPE + (size_t)S * 16;
constexpr size_t WS_SLOT = WS_GATE + (size_t)S * 16;
constexpr size_t WS_WIN_T = WS_SLOT + (size_t)S * 16;
constexpr size_t WS_WA_T = WS_WIN_T + (size_t)DINP * D * 2;
constexpr size_t WS_WH_T = WS_WA_T + (size_t)2048 * 1024 * 2;
constexpr size_t WS_WO_T = WS_WH_T + (size_t)2048 * 1024 * 2;
constexpr size_t WS_W1_T = WS_WO_T + (size_t)2048 * 2048 * 2;
constexpr size_t WS_W2_T = WS_W1_T + (size_t)NEXP * 4096 * 2048 * 2;
constexpr size_t WS_H = WS_W2_T + (size_t)NEXP * 2048 * 2048 * 2;
constexpr size_t WS_PROJ = WS_H + (size_t)S * D * 2;
constexpr size_t WS_KI = WS_PROJ + (size_t)S * DINP * 2;
constexpr size_t WS_KC = WS_KI + (size_t)S * 64 * 2;
constexpr size_t WS_VC = WS_KC + (size_t)S * 256 * 2;
constexpr size_t WS_ST = WS_VC + (size_t)S * 256 * 2;
constexpr size_t WS_DC = WS_ST + (size_t)256 * 8 * 128 * 128 * 4;
constexpr size_t WS_SEL = WS_DC + (size_t)256 * 8 * 128 * 4;
constexpr size_t WS_ATT = WS_SEL + (size_t)S * 256 * 4;
constexpr size_t WS_REC = WS_ATT + (size_t)S * 1024 * 2;
constexpr size_t WS_MERGED = WS_REC + (size_t)S * 1024 * 2;
constexpr size_t WS_X1 = WS_MERGED + (size_t)S * 2048 * 2;
constexpr size_t WS_SCORES = WS_X1 + (size_t)S * 2048 * 4;
constexpr size_t WS_XB = WS_SCORES;
constexpr size_t WS_ACT = WS_XB + (size_t)PMAX * 2048 * 2;
constexpr size_t WS_YB = WS_ACT + (size_t)PMAX * 2048 * 2;
constexpr size_t WS_END = WS_SCORES + (size_t)S * S * 4;
static_assert(WS_YB + (size_t)PMAX * 2048 * 2 <= WS_END, "MoE buffers overlay the score matrix");
static_assert(WS_END <= (size_t)4096 * MiB, "workspace");
constexpr int CW_BAR = 4096, CW_CNT = 8192, CW_FILL = 8448;
constexpr size_t WS_TOKS = WS_SEL;

constexpr int LDS_BYTES = 155648;
constexpr int LDS_MISC = LDS_BYTES - 512;

__device__ __forceinline__ unsigned cvt_pk_bf16(float lo, float hi) { unsigned r; asm volatile("v_cvt_pk_bf16_f32 %0, %1, %2" : "=v"(r) : "v"(lo), "v"(hi)); return r; }
__device__ __forceinline__ float bf_lo(unsigned u) { return __uint_as_float(u << 16); }
__device__ __forceinline__ float bf_hi(unsigned u) { return __uint_as_float(u & 0xffff0000u); }
__device__ __forceinline__ float bf2f(bf16_t b) { return __uint_as_float(((unsigned)b) << 16); }
__device__ __forceinline__ float wave_sum(float v) {
#define DPPS(ctrl, rmask) { const int s_ = __builtin_amdgcn_update_dpp(0, __float_as_int(v), ctrl, rmask, 0xF, false); v += __int_as_float(s_); }
    DPPS(0x111, 0xF) DPPS(0x112, 0xF) DPPS(0x114, 0xF) DPPS(0x118, 0xF) DPPS(0x142, 0xA) DPPS(0x143, 0xC)
#undef DPPS
    return __int_as_float(__builtin_amdgcn_readlane(__float_as_int(v), 63));
}
__device__ __forceinline__ float wave_max(float v) {
#define DPPM(ctrl, rmask) { const int o_ = __float_as_int(v); const int s_ = __builtin_amdgcn_update_dpp(o_, o_, ctrl, rmask, 0xF, false); v = fmaxf(v, __int_as_float(s_)); }
    DPPM(0x111, 0xF) DPPM(0x112, 0xF) DPPM(0x114, 0xF) DPPM(0x118, 0xF) DPPM(0x142, 0xA) DPPM(0x143, 0xC)
#undef DPPM
    return __int_as_float(__builtin_amdgcn_readlane(__float_as_int(v), 63));
}
__device__ __forceinline__ float sigmoidf_(float x) { return __builtin_amdgcn_rcpf(1.0f + __expf(-x)); }
__device__ __forceinline__ float siluf_(float x) { return x * __builtin_amdgcn_rcpf(1.0f + __expf(-x)); }
__device__ __forceinline__ unsigned pack4_fp8(float a, float b, float c, float d) { int w = 0; w = __builtin_amdgcn_cvt_pk_fp8_f32(a, b, w, false); w = __builtin_amdgcn_cvt_pk_fp8_f32(c, d, w, true); return (unsigned)w; }
constexpr float W8_SCALE = 64.0f, ACT8_SCALE = 4.0f, MRG8_SCALE = 8.0f, OP8_SCALE = 16.0f;
__device__ __forceinline__ float relu_i(float x) { const int i = __float_as_int(x); return __int_as_float(i > 0 ? i : 0); }
__device__ __forceinline__ void fp8x16_to_bf16(const u32x4& w, u32x4& lo, u32x4& hi) {
    unsigned o[8];
#pragma unroll
    for (int q = 0; q < 4; ++q) { const unsigned wq = w[q]; const f32x2 a = __builtin_amdgcn_cvt_pk_f32_fp8((int)wq, false), b = __builtin_amdgcn_cvt_pk_f32_fp8((int)wq, true);
        o[2 * q] = cvt_pk_bf16(a[0], a[1]); o[2 * q + 1] = cvt_pk_bf16(b[0], b[1]); }
    lo = (u32x4){o[0], o[1], o[2], o[3]}; hi = (u32x4){o[4], o[5], o[6], o[7]};
}
__device__ __forceinline__ unsigned char fp8_1(float x) { return (unsigned char)(__builtin_amdgcn_cvt_pk_fp8_f32(x, x, 0, false) & 0xff); }
#define LDS_WAIT() asm volatile("s_waitcnt lgkmcnt(0)" ::: "memory")
#define VM_WAIT() asm volatile("s_waitcnt vmcnt(0)" ::: "memory")

#define XB_TMO      128
#define XB_XCNT(j)  (256  + 64 * (j))
#define XB_XSUB(j)  (1280 + 64 * (j))
#define XB_XGEN(j)  (2304 + 64 * (j))
#define XB_TOP      3328
#define XB_TOPGEN   3392
#define XCD_BAR_WORDS 3456
#define XB_SPIN_CAP (1u << 22)

__device__ __forceinline__ unsigned xb_ld(unsigned* p)              { return __hip_atomic_load(p, __ATOMIC_RELAXED, __HIP_MEMORY_SCOPE_AGENT); }
__device__ __forceinline__ unsigned xb_add(unsigned* p, unsigned v) { return __hip_atomic_fetch_add(p, v, __ATOMIC_RELAXED, __HIP_MEMORY_SCOPE_AGENT); }
__device__ __forceinline__ unsigned xb_xcc_id() { return (unsigned)__builtin_amdgcn_s_getreg((3 << 11) | 20) & 0xFu; }
#define XB_SPIN(cond, bar) do { unsigned _sp = 0; while (cond) { __builtin_amdgcn_s_sleep(1); \
    if ((++_sp & 255u) == 0u) { if (xb_ld(&(bar)[XB_TMO])) break; if (_sp > XB_SPIN_CAP) { atomicAdd(&(bar)[XB_TMO], 1u); break; } } } } while (0)

struct XcdBarrier { unsigned* bar; unsigned x; volatile LAS unsigned* st; };

__device__ __forceinline__ XcdBarrier xcd_barrier_post(unsigned* bar, volatile LAS unsigned* st) {
    XcdBarrier b; b.bar = bar; b.x = xb_xcc_id(); b.st = st;
    if (threadIdx.x == 0) (void)xb_add(&bar[XB_XCNT(b.x)], 1u);
    return b;
}
__device__ __forceinline__ void xcd_barrier_complete(unsigned* bar, unsigned x, unsigned& nloc, unsigned& nx) {
    const unsigned G = gridDim.x * gridDim.y * gridDim.z;
    unsigned sum, cnt, mine, sp = 0u;
    for (;;) {
        sum = 0u; cnt = 0u; mine = 0u;
#pragma unroll
        for (unsigned j = 0; j < 16; ++j) { const unsigned c = xb_ld(&bar[XB_XCNT(j)]); sum += c; cnt += (c > 0u) ? 1u : 0u; mine = (j == x) ? c : mine; }
        if (sum == G) break;
        __builtin_amdgcn_s_sleep(1);
        if ((++sp & 255u) == 0u) { if (xb_ld(&bar[XB_TMO])) break; if (sp > XB_SPIN_CAP) { atomicAdd(&bar[XB_TMO], 1u); break; } }
    }
    nloc = mine > 0u ? mine : 1u; nx = cnt > 0u ? cnt : 1u;
}
__device__ __forceinline__ void xcd_barrier(const XcdBarrier& b) {
    asm volatile("s_waitcnt vmcnt(0)" ::: "memory");
    __syncthreads();
    if (threadIdx.x == 0) {
        unsigned* bar = b.bar;
        __builtin_amdgcn_s_waitcnt(0);
        unsigned nloc = b.st[0], nx = b.st[1];
        if (nloc == 0u) { xcd_barrier_complete(bar, b.x, nloc, nx); b.st[0] = nloc; b.st[1] = nx; }
        const unsigned old = xb_add(&bar[XB_XSUB(b.x)], 1u);
        const unsigned gen = old / nloc;
        if (old + 1u == (gen + 1u) * nloc) {
            __builtin_amdgcn_fence(__ATOMIC_RELEASE, "agent");
            asm volatile("s_waitcnt vmcnt(0)" ::: "memory");
            const unsigned og = xb_add(&bar[XB_TOP], 1u);
            const unsigned tg = og / nx;
            if (og + 1u == (tg + 1u) * nx) xb_add(&bar[XB_TOPGEN], 1u);
            else XB_SPIN(xb_ld(&bar[XB_TOPGEN]) == tg, bar);
            __builtin_amdgcn_fence(__ATOMIC_ACQUIRE, "agent");
            xb_add(&bar[XB_XGEN(b.x)], 1u);
            asm volatile("s_waitcnt vmcnt(0)" ::: "memory");
        } else {
            XB_SPIN(xb_ld(&bar[XB_XGEN(b.x)]) == gen, bar);
            __builtin_amdgcn_fence(__ATOMIC_ACQUIRE, "agent");
            asm volatile("s_waitcnt vmcnt(0)" ::: "memory");
        }
    }
    __syncthreads();
}

namespace pg8 {
constexpr int BM = 256, BK = 64, HALF = 128, HTB = HALF * BK * 2, STAGE_BYTES = 8 * HTB, NXCD = 8, WGM = 8;
__host__ __device__ __forceinline__ int lds_byte(int r, int c) { const int st = (r >> 4) * 2 + (c >> 5), rr = r & 15, cc = c & 31, ob = rr * 64 + cc * 2; return st * 1024 + (ob ^ (((ob >> 9) & 1) << 5)); }
__host__ __device__ __forceinline__ void stage_rc(int b, int& R, int& C) { const int st = b / 1024, sb = b % 1024, swz = sb ^ (((sb >> 9) & 1) << 5); R = (st >> 1) * 16 + swz / 64; C = (st & 1) * 32 + (swz % 64) / 2; }
__host__ __device__ __forceinline__ int perm32(int rho) { const int n = rho >> 4, i = rho & 15; return 8 * (i >> 2) + 4 * n + (i & 3); }

struct Unit { int pm, pn, e; };
struct Gemm { const void* A; const void* Bt; int K; size_t estride; const int* arow; size_t astride; };

struct StaticOrder {
    int nM, nN, nwg, G, c, i, full, erank, en;
    __device__ void init(int M, int N, int G_, int c_) { nM = M / BM; nN = N / BM; nwg = nM * nN; G = G_; c = c_; i = 0; full = 1 << 30; erank = -1; en = 1; }
    __device__ void skew(int full_, int erank_, int en_) { full = full_; erank = erank_; en = en_; }
    __device__ bool next(Unit& u) {
        long L;
        if (i < full) L = (long)i * G + c; else { if (erank < 0) return false; L = (long)full * G + (long)(i - full) * en + erank; }
        ++i; if (L >= nwg) return false;
        int wgid = (int)L; { const int q = nwg / NXCD, r = nwg % NXCD, xcd = wgid % NXCD, off = wgid / NXCD; wgid = (xcd < r ? xcd * (q + 1) : r * (q + 1) + (xcd - r) * q) + off; }
        const int nig = WGM * nN, gid = wgid / nig, fm = gid * WGM, gsz = (nM - fm) < WGM ? (nM - fm) : WGM;
        u.pm = fm + ((wgid % nig) % gsz); u.pn = (wgid % nig) / gsz; u.e = 0; return true;
    }
};
struct MoeOrder {
    int nPanels, nN, G, c, i; const LAS int* panel_e;
    __device__ void init(int nPanels_, int nN_, int G_, int c_, const LAS int* pe) { nPanels = nPanels_; nN = nN_; G = G_; c = c_; i = 0; panel_e = pe; }
    __device__ bool next(Unit& u) {
        const int PB = 256 / nN;
        const int nblk = (nPanels + PB - 1) / PB;
        for (;;) {
            const long L = (long)i * G + c; ++i;
            const int blk = (int)(L >> 8), r = (int)(L & 255), x = r & 7, j = r >> 3;
            if (blk >= nblk) return false;
            int pm, pn;
            if (nN == 16) { pm = blk * 16 + 4 * (x >> 1) + (j & 3); pn = 8 * (x & 1) + (j >> 2); }
            else          { pm = blk * 32 + 4 * x + (j & 3);        pn = j >> 2; }
            if (pm < nPanels) { u.pm = pm; u.pn = pn; u.e = panel_e[pm]; return true; }
        }
    }
};

template <class Epi, class Sched, bool FP8 = false>
__device__ __forceinline__ void gemm_phase(LAS unsigned char* lds, const Gemm g, Sched& S, const Epi& E) {
    const int tid = threadIdx.x, wid = __builtin_amdgcn_readfirstlane(tid >> 6), lane = tid & 63, wr = wid >> 2, wc = wid & 3, fr = lane & 15, fq = lane >> 4;
    const int K = g.K; const int pitch = FP8 ? K : 2 * K; const int nt = pitch / 128;
    unsigned voffA[2], voffB[2];
#pragma unroll
    for (int i = 0; i < 2; ++i) { int R, C; stage_rc(tid * 16 + i * 8192, R, C); const int Rb = Epi::PERM ? ((R & ~31) + perm32(R & 31)) : R;
        voffA[i] = (unsigned)(R * pitch + C * 2); voffB[i] = (unsigned)(Rb * pitch + C * 2); }
    const size_t kstep = (size_t)(BK * 2);
    const size_t hstep = (size_t)HALF * pitch;
    const size_t tstep = 2 * hstep;
    int RA[2], CA[2];
#pragma unroll
    for (int i = 0; i < 2; ++i) stage_rc(tid * 16 + i * 8192, RA[i], CA[i]);
    const bool gather = g.arow != nullptr;
    const size_t hsA = gather ? 0 : hstep;
    unsigned vA0[2] = {voffA[0], voffA[1]}, vA1[2] = {voffA[0], voffA[1]}, nA0[2] = {voffA[0], voffA[1]}, nA1[2] = {voffA[0], voffA[1]};
#define PG8_AOFF(dst0, dst1, u) do { if (gather) { _Pragma("unroll") for (int i = 0; i < 2; ++i) { \
        dst0[i] = (unsigned)g.arow[(u).pm * 256 + RA[i]] * (unsigned)pitch + (unsigned)(CA[i] * 2); dst1[i] = (unsigned)g.arow[(u).pm * 256 + 128 + RA[i]] * (unsigned)pitch + (unsigned)(CA[i] * 2); } } } while (0)
    const unsigned ldsw = (unsigned)wid * 1024u;
    const int aoff = lds_byte(wr * 64 + fr, fq * 8), boff = lds_byte(wc * 32 + fr, fq * 8);
#define PG8_SA(b, h) (((b) * 2 + (h)) * HTB)
#define PG8_SB(b, h) ((4 + (b) * 2 + (h)) * HTB)
#define PG8_STAGE(bufoff, gbase, voff) do { _Pragma("unroll") for (int _i = 0; _i < 2; ++_i) \
        __builtin_amdgcn_global_load_lds((const unsigned*)((const char*)(gbase) + (voff)[_i]), (LAS unsigned*)(lds + (bufoff) + ldsw + _i * 8192), 16, 0, 0); } while (0)
#define PG8_LD8(p) __builtin_shufflevector(*(const LAS i32x4*)(p), *(const LAS i32x4*)((p) + 1024), 0, 1, 2, 3, 4, 5, 6, 7)
#define PG8_LDA(dst, b, h) do { _Pragma("unroll") for (int m = 0; m < 4; ++m) { if constexpr (FP8) dst##8[m] = PG8_LD8(lds + PG8_SA(b, h) + aoff + m * 2048); \
        else { _Pragma("unroll") for (int k = 0; k < 2; ++k) dst[m][k] = *(const LAS bf16x8*)(lds + PG8_SA(b, h) + aoff + m * 2048 + k * 1024); } } } while (0)
#define PG8_LDB(dst, b, h) do { _Pragma("unroll") for (int n = 0; n < 2; ++n) { if constexpr (FP8) dst##8[n] = PG8_LD8(lds + PG8_SB(b, h) + boff + n * 2048); \
        else { _Pragma("unroll") for (int k = 0; k < 2; ++k) dst[n][k] = *(const LAS bf16x8*)(lds + PG8_SB(b, h) + boff + n * 2048 + k * 1024); } } } while (0)
#define PG8_MMA(ai, bj, At, Bt) do { __builtin_amdgcn_s_setprio(1); _Pragma("unroll") for (int m = 0; m < 4; ++m) _Pragma("unroll") for (int n = 0; n < 2; ++n) { \
        if constexpr (FP8) asm volatile("v_mfma_scale_f32_16x16x128_f8f6f4 %0, %1, %2, %0, %3, %3 op_sel_hi:[0,0,0]" : "+v"(acc[ai][bj][m][n]) : "v"(Bt##8[n]), "v"(At##8[m]), "v"(scl1)); \
        else { _Pragma("unroll") for (int k = 0; k < 2; ++k) acc[ai][bj][m][n] = __builtin_amdgcn_mfma_f32_16x16x32_bf16(Bt[n][k], At[m][k], acc[ai][bj][m][n], 0, 0, 0); } } \
        __builtin_amdgcn_s_setprio(0); } while (0)
#define PG8_WAIT_V(n) asm volatile("s_waitcnt vmcnt(" #n ")" ::: "memory")
#define PG8_WAIT_L(n) asm volatile("s_waitcnt lgkmcnt(" #n ")" ::: "memory")
#define PG8_BAR __builtin_amdgcn_s_barrier()
#define PG8_SCHED __builtin_amdgcn_sched_barrier(0)
    Unit cur, nxt;
    if (!S.next(cur)) return;
    const unsigned scl1 = 0x7f7f7f7fu;
    f32x4 acc[2][2][4][2];
#pragma unroll
    for (int a = 0; a < 2; ++a)
#pragma unroll
        for (int b = 0; b < 2; ++b)
#pragma unroll
            for (int m = 0; m < 4; ++m)
#pragma unroll
                for (int n = 0; n < 2; ++n) acc[a][b][m][n] = (f32x4){0.f, 0.f, 0.f, 0.f};
    bf16x8 At[4][2], B0[2][2], B1[2][2]; i32x8 At8[4], B08[2], B18[2];
    const char* cA = (const char*)g.A + (size_t)cur.e * g.astride + (gather ? (size_t)0 : (size_t)cur.pm * tstep); const char* cB = (const char*)g.Bt + (size_t)cur.e * g.estride + (size_t)cur.pn * tstep;
    PG8_AOFF(vA0, vA1, cur);
    PG8_STAGE(PG8_SB(0, 0), cB, voffB); PG8_STAGE(PG8_SB(0, 1), cB + hstep, voffB); PG8_STAGE(PG8_SA(0, 0), cA, vA0); PG8_STAGE(PG8_SA(0, 1), cA + hsA, vA1);
    if (wr == 1) PG8_BAR;
    PG8_WAIT_V(2); PG8_BAR;
    PG8_STAGE(PG8_SB(1, 0), cB + kstep, voffB); PG8_STAGE(PG8_SA(1, 0), cA + kstep, vA0); PG8_STAGE(PG8_SB(1, 1), cB + hstep + kstep, voffB);
    PG8_WAIT_V(6); PG8_BAR;
    for (;;) {
        const bool has_next = S.next(nxt);
        const char* nA = has_next ? (const char*)g.A + (size_t)nxt.e * g.astride + (gather ? (size_t)0 : (size_t)nxt.pm * tstep) : cA;
        if (has_next) PG8_AOFF(nA0, nA1, nxt);
        const char* nB = has_next ? (const char*)g.Bt + (size_t)nxt.e * g.estride + (size_t)nxt.pn * tstep : cB;
        for (int t = 0; t < nt; t += 2) {
            const bool last = (t == nt - 2);
            const char* a1 = cA + (size_t)(t + 1) * kstep;
            const char* a2 = last ? nA : cA + (size_t)(t + 2) * kstep; const char* b2 = last ? nB : cB + (size_t)(t + 2) * kstep;
            const char* a3 = a2 + kstep; const char* b3 = b2 + kstep;
            PG8_LDB(B0, 0, 0); PG8_LDB(B1, 0, 1); PG8_SCHED; PG8_LDA(At, 0, 0); PG8_STAGE(PG8_SA(1, 1), a1 + hsA, vA1);
            if (last && has_next) { vA0[0] = nA0[0]; vA0[1] = nA0[1]; vA1[0] = nA1[0]; vA1[1] = nA1[1]; }
            PG8_WAIT_V(8); PG8_WAIT_L(0); PG8_BAR; PG8_MMA(0, 0, At, B0); PG8_MMA(0, 1, At, B1); PG8_BAR; PG8_SCHED;
            PG8_LDA(At, 0, 1); PG8_STAGE(PG8_SB(0, 0), b2, voffB); PG8_STAGE(PG8_SB(0, 1), b2 + hstep, voffB); PG8_STAGE(PG8_SA(0, 0), a2, vA0);
            PG8_WAIT_V(8); PG8_WAIT_L(0); PG8_BAR; PG8_MMA(1, 0, At, B0); PG8_MMA(1, 1, At, B1); PG8_BAR; PG8_SCHED;
            PG8_LDB(B0, 1, 0); PG8_LDB(B1, 1, 1); PG8_SCHED; PG8_LDA(At, 1, 0); PG8_STAGE(PG8_SA(0, 1), a2 + hsA, vA1);
            PG8_WAIT_V(8); PG8_WAIT_L(0); PG8_BAR; PG8_MMA(0, 0, At, B0); PG8_MMA(0, 1, At, B1); PG8_BAR; PG8_SCHED;
            PG8_LDA(At, 1, 1); PG8_STAGE(PG8_SB(1, 0), b3, voffB); PG8_STAGE(PG8_SB(1, 1), b3 + hstep, voffB); PG8_STAGE(PG8_SA(1, 0), a3, vA0);
            PG8_WAIT_V(8); PG8_WAIT_L(0); PG8_BAR; PG8_MMA(1, 0, At, B0); PG8_MMA(1, 1, At, B1); PG8_BAR; PG8_SCHED;
        }
        if (wr == 0) PG8_BAR;
        if constexpr (FP8) {
#pragma unroll
            for (int a = 0; a < 2; ++a)
#pragma unroll
                for (int b = 0; b < 2; ++b) asm volatile("s_nop 15" : "+v"(acc[a][b][0][0]), "+v"(acc[a][b][0][1]), "+v"(acc[a][b][1][0]), "+v"(acc[a][b][1][1]), "+v"(acc[a][b][2][0]), "+v"(acc[a][b][2][1]), "+v"(acc[a][b][3][0]), "+v"(acc[a][b][3][1]));
        }
        const bool keep_acc = E(acc, cur, wr, wc, fr, fq);
        if (!has_next) break;
        if (!keep_acc)
#pragma unroll
        for (int a = 0; a < 2; ++a)
#pragma unroll
            for (int b = 0; b < 2; ++b)
#pragma unroll
                for (int m = 0; m < 4; ++m)
#pragma unroll
                    for (int n = 0; n < 2; ++n) acc[a][b][m][n] = (f32x4){0.f, 0.f, 0.f, 0.f};
        cur = nxt; cA = nA; cB = nB;
        if (wr == 1) PG8_BAR;
    }
    PG8_WAIT_V(0);
    PG8_BAR;
#undef PG8_AOFF
#undef PG8_SA
#undef PG8_SB
#undef PG8_STAGE
#undef PG8_LDA
#undef PG8_LDB
#undef PG8_MMA
#undef PG8_LD8
#undef PG8_WAIT_V
#undef PG8_WAIT_L
#undef PG8_BAR
#undef PG8_SCHED
}

struct EpiBf16 {
    static constexpr bool PERM = true;
    bf16_t* O; int ldc; const float* bias; int bias_estride; float ascale; int skip_from, skip_cols;
    __device__ __forceinline__ bool operator()(const f32x4 (&acc)[2][2][4][2], const Unit& u, int wr, int wc, int fr, int fq) const {
        const int row0 = u.pm * BM + wr * 64 + fr; const int col0 = u.pn * BM + wc * 32 + 8 * fq + (u.pn >= skip_from ? skip_cols : 0);
        f32x4 bv[2][2];
#pragma unroll
        for (int bj = 0; bj < 2; ++bj)
#pragma unroll
            for (int n = 0; n < 2; ++n) bv[bj][n] = bias ? *(const f32x4*)(bias + (size_t)u.e * bias_estride + col0 + bj * HALF + 4 * n) : (f32x4){0.f, 0.f, 0.f, 0.f};
#pragma unroll
        for (int ai = 0; ai < 2; ++ai)
#pragma unroll
            for (int m = 0; m < 4; ++m) { bf16_t* rowp = O + (size_t)(row0 + ai * HALF + m * 16) * ldc + col0;
#pragma unroll
                for (int bj = 0; bj < 2; ++bj) { const f32x4 v0 = acc[ai][bj][m][0] * ascale + bv[bj][0], v1 = acc[ai][bj][m][1] * ascale + bv[bj][1];
                    u32x4 w; w.x = cvt_pk_bf16(v0[0], v0[1]); w.y = cvt_pk_bf16(v0[2], v0[3]); w.z = cvt_pk_bf16(v1[0], v1[1]); w.w = cvt_pk_bf16(v1[2], v1[3]);
                    *(u32x4*)(rowp + bj * HALF) = w; } }
        return false;
    }
};
__device__ __forceinline__ float swiglu1(float ug, float ul) {
    ug = fminf(ug, 7.0f); ul = fminf(fmaxf(ul, -7.0f), 7.0f);
    return ug * __builtin_amdgcn_rcpf(1.0f + __expf(-1.702f * ug)) * (ul + 1.0f);
}
struct EpiSwiglu {
    static constexpr bool PERM = true;
    unsigned char* O; const float* b1;
    __device__ __forceinline__ bool operator()(const f32x4 (&acc)[2][2][4][2], const Unit& u, int wr, int wc, int fr, int fq) const {
        const int row0 = u.pm * BM + wr * 64 + fr; const int c0 = u.pn * 128 + wc * 32 + 8 * fq;
        const float* bg = b1 + (size_t)u.e * 4096 + c0; const float* bl = bg + 2048;
        f32x4 bgv[2], blv[2];
#pragma unroll
        for (int n = 0; n < 2; ++n) { bgv[n] = *(const f32x4*)(bg + 4 * n); blv[n] = *(const f32x4*)(bl + 4 * n); }
#pragma unroll
        for (int ai = 0; ai < 2; ++ai)
#pragma unroll
            for (int m = 0; m < 4; ++m) {
                float a[8];
#pragma unroll
                for (int n = 0; n < 2; ++n)
#pragma unroll
                    for (int j = 0; j < 4; ++j) a[4 * n + j] = ACT8_SCALE * swiglu1(acc[ai][0][m][n][j] * (1.0f / W8_SCALE) + bgv[n][j], acc[ai][1][m][n][j] * (1.0f / W8_SCALE) + blv[n][j]);
                u32x2 w; w.x = pack4_fp8(a[0], a[1], a[2], a[3]); w.y = pack4_fp8(a[4], a[5], a[6], a[7]);
                *(u32x2*)(O + (size_t)(row0 + ai * HALF + m * 16) * 2048 + c0) = w;
            }
        return false;
    }
};

struct TwoPartOrder {
    StaticOrder so; Unit held; int part;
    __device__ void init(int M, int N, int G_, int c_) { so.init(M, N, G_, c_); part = 0; }
    __device__ bool next(Unit& u) { if (part == 1) { u = held; u.e = 1; part = 0; return true; } if (!so.next(held)) return false; u = held; u.e = 0; part = 1; return true; }
};
struct EpiGate2 {
    static constexpr bool PERM = true;
    unsigned char* O; const bf16_t* Ga; const bf16_t* Gr;
    __device__ __forceinline__ bool operator()(f32x4 (&acc)[2][2][4][2], const Unit& u, int wr, int wc, int fr, int fq) const {
        const int row0 = u.pm * BM + wr * 64 + fr; const int col0 = u.pn * BM + wc * 32 + 8 * fq;
#pragma unroll
        for (int ai = 0; ai < 2; ++ai)
#pragma unroll
            for (int m = 0; m < 4; ++m) { const size_t row = (size_t)(row0 + ai * HALF + m * 16);
#pragma unroll
                for (int bj = 0; bj < 2; ++bj) { const int c = col0 + bj * HALF;
                    const u32x4 gr = *(const u32x4*)(Gr + row * DINP + c);
                    if (u.e == 0) {
                        const u32x4 ga = *(const u32x4*)(Ga + row * DINP + c);
#pragma unroll
                        for (int q = 0; q < 4; ++q) {
                            const float r0 = (1.0f + __expf(-bf_lo(gr[q]))) * __builtin_amdgcn_rcpf(1.0f + __expf(-bf_lo(ga[q]))), r1 = (1.0f + __expf(-bf_hi(gr[q]))) * __builtin_amdgcn_rcpf(1.0f + __expf(-bf_hi(ga[q])));
                            acc[ai][bj][m][q >> 1][(2 * q) & 3] *= r0; acc[ai][bj][m][q >> 1][(2 * q + 1) & 3] *= r1; }
                    } else {
                        float r[8];
#pragma unroll
                        for (int q = 0; q < 4; ++q) { r[2 * q] = sigmoidf_(bf_lo(gr[q])) * acc[ai][bj][m][q >> 1][(2 * q) & 3]; r[2 * q + 1] = sigmoidf_(bf_hi(gr[q])) * acc[ai][bj][m][q >> 1][(2 * q + 1) & 3]; }
                        u32x2 w; constexpr float osc = MRG8_SCALE / (W8_SCALE * OP8_SCALE); w.x = pack4_fp8(r[0] * osc, r[1] * osc, r[2] * osc, r[3] * osc); w.y = pack4_fp8(r[4] * osc, r[5] * osc, r[6] * osc, r[7] * osc);
                        *(u32x2*)(O + row * 2048 + c) = w; } } }
        return u.e == 0;
    }
};
struct EpiDelta {
    static constexpr bool PERM = true;
    const float* gt; bf16_t* DL; float ascale;
    __device__ __forceinline__ bool operator()(const f32x4 (&acc)[2][2][4][2], const Unit& u, int wr, int wc, int fr, int fq) const {
        const int row0 = u.pm * BM + wr * 64 + fr; const int col0 = u.pn * BM + wc * 32 + 8 * fq;
        f32x4 g[2][2];
#pragma unroll
        for (int bj = 0; bj < 2; ++bj)
#pragma unroll
            for (int n = 0; n < 2; ++n) g[bj][n] = *(const f32x4*)(gt + col0 + bj * HALF + 4 * n);
#pragma unroll
        for (int ai = 0; ai < 2; ++ai)
#pragma unroll
            for (int m = 0; m < 4; ++m) { bf16_t* rowp = DL + (size_t)(row0 + ai * HALF + m * 16) * 2048 + col0;
#pragma unroll
                for (int bj = 0; bj < 2; ++bj) { const f32x4 v0 = acc[ai][bj][m][0] * ascale * g[bj][0], v1 = acc[ai][bj][m][1] * ascale * g[bj][1];
                    u32x4 w; w.x = cvt_pk_bf16(v0[0], v0[1]); w.y = cvt_pk_bf16(v0[2], v0[3]); w.z = cvt_pk_bf16(v1[0], v1[1]); w.w = cvt_pk_bf16(v1[2], v1[3]);
                    *(u32x4*)(rowp + bj * HALF) = w; } }
        return false;
    }
};
}

struct Args { const void* in[22]; float* out; unsigned char* ws; int ph_lo, ph_hi, flags, pad; };
constexpr int XCONV = 0, XSCORE = 96;
constexpr int CW_SCQ = 12288, SCP = 5, CW_ATQ = 12352;
enum { PH_PRO = 0, PH_H, PH_INPROJ, PH_POST, PH_SCORE, PH_SELECT, PH_ATTN, PH_OP1, PH_OP2, PH_WOUT, PH_ROUTER, PH_SCATTER, PH_MOE1, PH_MOE2, PH_FINAL, NPH };

__device__ __forceinline__ int dest_row(int mode, int n) {
    if (mode == 1) return n < 2640 ? n : n + 176;
    if (mode == 2) { const int g = n >> 11, c = n & 2047; return (c >> 7) * 256 + g * 128 + (c & 127); }
    return n;
}
__device__ __forceinline__ void convert_item(const float* __restrict__ W, int K, int N, int ld, bf16_t* WT, int mode, int item, int lane, LAS unsigned char* scr) {
    const int nblk = (N + 63) >> 6; const int kb = item / nblk, nb = item - kb * nblk; const int k0 = kb * 128, n0 = nb * 64;
    const int c4 = lane & 15, kr = lane >> 4;
    const bool ok = (n0 + 4 * c4) < N;
    const float* src = W + (size_t)(k0 + 2 * kr) * ld + n0 + 4 * c4;
#pragma unroll 4
    for (int i = 0; i < 16; ++i) {
        f32x4 v0 = (f32x4){0.f, 0.f, 0.f, 0.f}, v1 = v0;
        if (ok) { v0 = *(const f32x4*)(src + (size_t)(8 * i) * ld); v1 = *(const f32x4*)(src + (size_t)(8 * i + 1) * ld); }
        const int kk = 8 * i + 2 * kr;
#pragma unroll
        for (int e = 0; e < 4; ++e) *(LAS unsigned*)(scr + (4 * c4 + e) * 272 + kk * 2) = cvt_pk_bf16(v0[e], v1[e]);
    }
    LDS_WAIT(); asm volatile("" ::: "memory");
#pragma unroll 4
    for (int j = 0; j < 16; ++j) {
        const int q = j * 64 + lane, n = q >> 4, ch = q & 15;
        const u32x4 v = *(const LAS u32x4*)(scr + n * 272 + ch * 16);
        if (n0 + n < N) *(u32x4*)(WT + (size_t)dest_row(mode, n0 + n) * K + k0 + ch * 8) = v;
    }
    LDS_WAIT(); asm volatile("" ::: "memory");
}


__device__ __forceinline__ bf16_t f2bf(float f) { unsigned u = __float_as_uint(f); return (bf16_t)((u + 0x7fffu + ((u >> 16) & 1u)) >> 16); }
__device__ __forceinline__ float bfx(const u32x4& w, int i) { const unsigned u = w[i >> 1]; return (i & 1) ? bf_hi(u) : bf_lo(u); }
__device__ __forceinline__ void rope_sc(float pos, float inv, float& sn, float& cs) {
    const float ang = pos * inv;
    const double a = (double)ang; const double n = __builtin_rint(a * 0.15915494309189535); const float r = (float)(a - n * 6.283185307179586);
    sn = sinf(r); cs = cosf(r);
}
__device__ __forceinline__ void post_token(bf16_t* PROJ, bf16_t* KI, unsigned char* KC, unsigned char* VC, const int* positions, const float* kng, const float* knb, int t, int lane) {
    const float pos = (float)positions[t];
    bf16_t* row = PROJ + (size_t)t * DINP;
    float sn, cs;
#pragma unroll
    for (int i = 0; i < 2; ++i) {
        const int pp = lane + 64 * i, hd = pp >> 4, ii = pp & 15;
        rope_sc(pos, powf(500000.0f, -(float)ii * (1.0f / 16.0f)), sn, cs);
        bf16_t* p = row + CQ + hd * 128 + ii; const float a = bf2f(p[0]), b = bf2f(p[16]);
        p[0] = f2bf(a * cs - b * sn); p[16] = f2bf(b * cs + a * sn);
    }
#pragma unroll
    for (int i = 0; i < 2; ++i) {
        const int pp = lane + 64 * i, hd = pp >> 3, ii = pp & 7;
        rope_sc(pos, powf(500000.0f, -(float)ii * (1.0f / 8.0f)), sn, cs);
        bf16_t* p = row + CQI + hd * 64 + ii; const float a = bf2f(p[0]), b = bf2f(p[8]);
        p[0] = f2bf(a * cs - b * sn); p[8] = f2bf(b * cs + a * sn);
    }
    if (lane < 32) {
        const int g = lane >> 4, ii = lane & 15;
        rope_sc(pos, powf(500000.0f, -(float)ii * (1.0f / 16.0f)), sn, cs);
        const bf16_t* p = row + CK + g * 128 + ii; const float a = bf2f(p[0]), b = bf2f(p[16]);
        unsigned char* o = KC + (size_t)t * 256 + g * 128 + ii; o[0] = fp8_1(a * cs - b * sn); o[16] = fp8_1(b * cs + a * sn);
    }
#pragma unroll
    for (int i = 0; i < 3; ++i) { const int idx = lane + 64 * i, g = idx / 96, r = idx - g * 96; KC[(size_t)t * 256 + g * 128 + 32 + r] = fp8_1(bf2f(row[CK + g * 128 + 32 + r])); }
    { const u32x2 w = *(const u32x2*)(row + CV + 4 * lane); *(unsigned*)(VC + (size_t)t * 256 + 4 * lane) = pack4_fp8(bf_lo(w.x), bf_hi(w.x), bf_lo(w.y), bf_hi(w.y)); }
    {
        const float v = bf2f(row[CKI + lane]);
        const float mean = wave_sum(v) * (1.0f / 64.0f); const float d = v - mean; const float var = wave_sum(d * d) * (1.0f / 64.0f);
        const float y = d * rsqrtf(var + NORM_EPS) * kng[lane] + knb[lane];
        const float other = __shfl_xor(y, 8);
        rope_sc(pos, powf(500000.0f, -(float)(lane & 7) * (1.0f / 8.0f)), sn, cs);
        float o = y;
        if (lane < 8) o = y * cs - other * sn; else if (lane < 16) o = y * cs + other * sn;
        KI[(size_t)t * 64 + lane] = f2bf(o);
    }
}

constexpr int HG_GB = 0, HG_Q1 = 33792, HG_Q2 = 51200, HG_K2 = 68608, HG_VT = 86016, HG_PB = 104448, HG_LB = 113664;
__device__ __forceinline__ void hgrn_cumsum(LAS unsigned char* lds, const u32x4& w0, const u32x4& w1, float l0, float l1, int tid) {
    LAS float* GB = (LAS float*)(lds + HG_GB); LAS float* LB = (LAS float*)(lds + HG_LB); LAS float* SEG = (LAS float*)(lds + HG_LB + 512);
    if (tid < 128) LB[tid] = 1.0f / (1.0f + expf(l1 - l0));
    __syncthreads();
    const int t = tid >> 3, dseg = tid & 7;
#pragma unroll
    for (int i = 0; i < 16; ++i) { const float z = i < 8 ? bfx(w0, i) : bfx(w1, i - 8); const float lb = LB[16 * dseg + i]; GB[t * 128 + 16 * dseg + i] = logf(lb + (1.0f - lb) * sigmoidf_(z)); }
    __syncthreads();
    const int d = tid & 127, tq = tid >> 7;
    float z[16];
#pragma unroll
    for (int i = 0; i < 16; ++i) z[i] = GB[(16 * tq + i) * 128 + d];
    float a = 0.f;
#pragma unroll
    for (int i = 0; i < 16; ++i) { a += z[i]; z[i] = a; }
    SEG[tq * 128 + d] = a;
    __syncthreads();
    float pre = 0.f;
    for (int q = 0; q < tq; ++q) pre += SEG[q * 128 + d];
#pragma unroll
    for (int i = 0; i < 16; ++i) GB[(16 * tq + i) * 128 + d] = z[i] + pre;
    __syncthreads();
}
__device__ __forceinline__ void hgrn_vt(LAS unsigned char* lds, const u32x4& a, const u32x4& b, int tid) {
    const int s2 = tid & 31, eg = tid >> 5;
#pragma unroll
    for (int i = 0; i < 8; ++i) { const unsigned lo = (i & 1) ? (a[i >> 1] >> 16) : (a[i >> 1] & 0xffffu), hi = (i & 1) ? (b[i >> 1] >> 16) : (b[i >> 1] & 0xffffu);
        *(LAS unsigned*)(lds + HG_VT + (8 * eg + i) * 144 + s2 * 4) = lo | (hi << 16); }
}
__device__ __forceinline__ void hgrn_l1(LAS unsigned char* lds, const bf16_t* PROJ, const float* lb_logits, bf16_t* ST, float* DC, int c, int h, int tid, int wave, int lane) {
    const int t = tid >> 3, dseg = tid & 7, s2 = tid & 31, dg = tid >> 5;
    const bf16_t* pf = PROJ + (size_t)(c * 64 + t) * DINP + CHF + h * 128 + 16 * dseg;
    const bf16_t* pk = PROJ + (size_t)(c * 64 + 2 * s2) * DINP + CHF + h * 128 + 8 * dg;
    const u32x4 w0 = *(const u32x4*)pf, w1 = *(const u32x4*)(pf + 8);
    const u32x4 ka = *(const u32x4*)pk, kb = *(const u32x4*)(pk + DINP);
    const u32x4 va = *(const u32x4*)(pk - CHF + CHI), vb = *(const u32x4*)(pk - CHF + CHI + DINP);
    const float l0 = lb_logits[h * 128 + (tid & 127)], l1 = lb_logits[1024 + h * 128 + (tid & 127)];
    hgrn_cumsum(lds, w0, w1, l0, l1, tid);
    const LAS float* GB = (const LAS float*)(lds + HG_GB); const LAS float* LB = (const LAS float*)(lds + HG_LB);
    {
#pragma unroll
        for (int i = 0; i < 8; ++i) { const int d = 8 * dg + i; const float lb = LB[d], b63 = GB[63 * 128 + d];
            const float k0 = (1.0f - lb) * (1.0f - sigmoidf_(bfx(ka, i))), k1 = (1.0f - lb) * (1.0f - sigmoidf_(bfx(kb, i)));
            const float v0 = k0 * __expf(b63 - GB[(2 * s2) * 128 + d]), v1 = k1 * __expf(b63 - GB[(2 * s2 + 1) * 128 + d]);
            *(LAS unsigned*)(lds + HG_Q1 + d * 144 + s2 * 4) = cvt_pk_bf16(v0, v1); }
    }
    hgrn_vt(lds, va, vb, tid);
    __syncthreads();
    const int fr = lane & 15, fq = lane >> 4;
    bf16x8 af[2];
#pragma unroll
    for (int ks = 0; ks < 2; ++ks) af[ks] = *(const LAS bf16x8*)(lds + HG_VT + (16 * wave + fr) * 144 + (32 * ks + 8 * fq) * 2);
    bf16_t* dst = ST + ((size_t)(c * 8 + h) * 128) * 128;
#pragma unroll 2
    for (int dt = 0; dt < 8; ++dt) {
        f32x4 acc = (f32x4){0.f, 0.f, 0.f, 0.f};
#pragma unroll
        for (int ks = 0; ks < 2; ++ks) { const bf16x8 bfr = *(const LAS bf16x8*)(lds + HG_Q1 + (16 * dt + fr) * 144 + (32 * ks + 8 * fq) * 2); acc = __builtin_amdgcn_mfma_f32_16x16x32_bf16(af[ks], bfr, acc, 0, 0, 0); }
#pragma unroll
        for (int r = 0; r < 4; ++r) dst[(size_t)(16 * wave + 4 * fq + r) * 128 + 16 * dt + fr] = f2bf(acc[r]);
    }
    if (tid < 128) DC[(size_t)(c * 8 + h) * 128 + tid] = __expf(GB[63 * 128 + tid]);
    __syncthreads();
}
__device__ __forceinline__ void hgrn_l3(LAS unsigned char* lds, const bf16_t* PROJ, const float* lb_logits, const bf16_t* ST, const float* norm_g, unsigned char* REC, int c, int h, int tid, int wave, int lane) {
    const int t = tid >> 3, dseg = tid & 7, s2 = tid & 31, eg = tid >> 5, fr = lane & 15, fq = lane >> 4;
    const bf16_t* pf = PROJ + (size_t)(c * 64 + t) * DINP + CHF + h * 128 + 16 * dseg;
    const u32x4 f0 = *(const u32x4*)pf, f1 = *(const u32x4*)(pf + 8), q0 = *(const u32x4*)(pf - CHF + CHQ), q1 = *(const u32x4*)(pf - CHF + CHQ + 8);
    const u32x4 g0 = *(const u32x4*)(pf - CHF + CHG), g1 = *(const u32x4*)(pf - CHF + CHG + 8);
    const bf16_t* pv = PROJ + (size_t)(c * 64 + 2 * s2) * DINP + CHI + h * 128 + 8 * eg;
    const u32x4 va = *(const u32x4*)pv, vb = *(const u32x4*)(pv + DINP);
    const bf16_t* sp = ST + ((size_t)(c * 8 + h) * 128 + 16 * wave + fr) * 128 + 8 * fq;
    u32x4 sx[4];
#pragma unroll
    for (int ks = 0; ks < 4; ++ks) sx[ks] = *(const u32x4*)(sp + 32 * ks);
    const float l0 = lb_logits[h * 128 + (tid & 127)], l1 = lb_logits[1024 + h * 128 + (tid & 127)];
    hgrn_cumsum(lds, f0, f1, l0, l1, tid);
    const LAS float* GB = (const LAS float*)(lds + HG_GB); const LAS float* LB = (const LAS float*)(lds + HG_LB);
    {
        unsigned o1[8], o2[8], o3[8];
#pragma unroll
        for (int i = 0; i < 16; i += 2) {
            float a1[2], a2[2], a3[2];
#pragma unroll
            for (int j = 0; j < 2; ++j) { const int d = 16 * dseg + i + j; const float lb = LB[d], b = GB[t * 128 + d], br = GB[31 * 128 + d];
                const float z = (i + j) < 8 ? bfx(f0, i + j) : bfx(f1, i + j - 8), qv = (i + j) < 8 ? bfx(q0, i + j) : bfx(q1, i + j - 8);
                const float k = (1.0f - lb) * (1.0f - sigmoidf_(z)), q = siluf_(qv);
                a1[j] = q * __expf(b); a2[j] = q * __expf(b - br); a3[j] = k * __expf(br - b); }
            o1[i >> 1] = cvt_pk_bf16(a1[0], a1[1]); o2[i >> 1] = cvt_pk_bf16(a2[0], a2[1]); o3[i >> 1] = cvt_pk_bf16(a3[0], a3[1]);
        }
        LAS u32x4* d1 = (LAS u32x4*)(lds + HG_Q1 + t * 272 + dseg * 32); LAS u32x4* d2 = (LAS u32x4*)(lds + HG_Q2 + t * 272 + dseg * 32); LAS u32x4* d3 = (LAS u32x4*)(lds + HG_K2 + t * 272 + dseg * 32);
        d1[0] = (u32x4){o1[0], o1[1], o1[2], o1[3]}; d1[1] = (u32x4){o1[4], o1[5], o1[6], o1[7]};
        d2[0] = (u32x4){o2[0], o2[1], o2[2], o2[3]}; d2[1] = (u32x4){o2[4], o2[5], o2[6], o2[7]};
        d3[0] = (u32x4){o3[0], o3[1], o3[2], o3[3]}; d3[1] = (u32x4){o3[4], o3[5], o3[6], o3[7]};
    }
    hgrn_vt(lds, va, vb, tid);
    __syncthreads();
#pragma unroll
    for (int q = 0; q < 2; ++q) {
        const int tile = 2 * wave + q, tt = tile >> 2, stl = tile & 3;
        f32x4 acc = (f32x4){0.f, 0.f, 0.f, 0.f};
#pragma unroll
        for (int ks = 0; ks < 4; ++ks) { const bf16x8 a = *(const LAS bf16x8*)(lds + HG_Q2 + (16 * tt + fr) * 272 + (32 * ks + 8 * fq) * 2), b = *(const LAS bf16x8*)(lds + HG_K2 + (16 * stl + fr) * 272 + (32 * ks + 8 * fq) * 2);
            acc = __builtin_amdgcn_mfma_f32_16x16x32_bf16(a, b, acc, 0, 0, 0); }
#pragma unroll
        for (int r = 0; r < 4; ++r) { const int tr_ = 16 * tt + 4 * fq + r, s = 16 * stl + fr; *(LAS bf16_t*)(lds + HG_PB + tr_ * 144 + s * 2) = f2bf(s <= tr_ ? acc[r] : 0.f); }
    }
    __syncthreads();
    {
        bf16x8 b1[2], b2[4];
#pragma unroll
        for (int ks = 0; ks < 2; ++ks) b1[ks] = *(const LAS bf16x8*)(lds + HG_VT + (16 * wave + fr) * 144 + (32 * ks + 8 * fq) * 2);
#pragma unroll
        for (int ks = 0; ks < 4; ++ks) b2[ks] = __builtin_bit_cast(bf16x8, sx[ks]);
        LAS float* OB = (LAS float*)(lds + HG_GB);
#pragma unroll
        for (int tt = 0; tt < 4; ++tt) {
            f32x4 acc = (f32x4){0.f, 0.f, 0.f, 0.f};
#pragma unroll
            for (int ks = 0; ks < 2; ++ks) { const bf16x8 a = *(const LAS bf16x8*)(lds + HG_PB + (16 * tt + fr) * 144 + (32 * ks + 8 * fq) * 2); acc = __builtin_amdgcn_mfma_f32_16x16x32_bf16(a, b1[ks], acc, 0, 0, 0); }
#pragma unroll
            for (int ks = 0; ks < 4; ++ks) { const bf16x8 a = *(const LAS bf16x8*)(lds + HG_Q1 + (16 * tt + fr) * 272 + (32 * ks + 8 * fq) * 2); acc = __builtin_amdgcn_mfma_f32_16x16x32_bf16(a, b2[ks], acc, 0, 0, 0); }
#pragma unroll
            for (int r = 0; r < 4; ++r) OB[(16 * tt + 4 * fq + r) * 132 + 16 * wave + fr] = acc[r];
        }
    }
    __syncthreads();
    {
        const int es = dseg; const LAS float* OB = (const LAS float*)(lds + HG_GB);
        float o[16]; float ss = 0.f;
#pragma unroll
        for (int i = 0; i < 16; ++i) { o[i] = OB[t * 132 + 16 * es + i]; ss += o[i] * o[i]; }
        ss += __shfl_xor(ss, 1); ss += __shfl_xor(ss, 2); ss += __shfl_xor(ss, 4);
        const float rstd = rsqrtf(ss * (1.0f / 128.0f) + NORM_EPS);
        float rv[16];
#pragma unroll
        for (int i = 0; i < 16; ++i) { const float ga = i < 8 ? bfx(g0, i) : bfx(g1, i - 8); rv[i] = o[i] * (rstd * OP8_SCALE) * norm_g[16 * es + i] * siluf_(ga); }
        *(u32x4*)(REC + (size_t)(c * 64 + t) * 1024 + h * 128 + 16 * es) = (u32x4){pack4_fp8(rv[0], rv[1], rv[2], rv[3]), pack4_fp8(rv[4], rv[5], rv[6], rv[7]), pack4_fp8(rv[8], rv[9], rv[10], rv[11]), pack4_fp8(rv[12], rv[13], rv[14], rv[15])};
    }
    __syncthreads();
}

constexpr int SC_KT = 0, SC_SB = 36864, SC_SPITCH = 132;
__device__ __forceinline__ unsigned pk_f16(float a, float b) { return __builtin_bit_cast(unsigned, __builtin_amdgcn_cvt_pkrtz(a, b)); }
__device__ __forceinline__ void score_flush(LAS unsigned char* lds, unsigned short* SCORES, unsigned short* SEGMAX, int t0, int kt, int tid) {
    const LAS float* sb = (const LAS float*)(lds + SC_SB + (kt & 1) * (32 * SC_SPITCH * 4));
    const int row = tid >> 4, seg = tid & 15;
    const f32x4 a = *(const LAS f32x4*)(sb + row * SC_SPITCH + seg * 8), b = *(const LAS f32x4*)(sb + row * SC_SPITCH + seg * 8 + 4);
    unsigned short* dst = SCORES + (size_t)(t0 + row) * S + kt * 128 + seg * 8;
    *(u32x4*)dst = (u32x4){pk_f16(a[0], a[1]), pk_f16(a[2], a[3]), pk_f16(b[0], b[1]), pk_f16(b[2], b[3])};
    const float mx = fmaxf(fmaxf(fmaxf(a[0], a[1]), fmaxf(a[2], a[3])), fmaxf(fmaxf(b[0], b[1]), fmaxf(b[2], b[3])));
    SEGMAX[(size_t)(t0 + row) * 2048 + kt * 16 + seg] = (unsigned short)(pk_f16(mx, mx) & 0xffffu);
}
__device__ __forceinline__ void score_block(LAS unsigned char* lds, const bf16_t* PROJ, const bf16_t* KI, unsigned short* SCORES, unsigned short* SEGMAX, int qb, int kt0, int kt1, int tid, int wave, int lane) {
    const int t0 = qb * 32;
    const int r = lane & 31, hh = lane >> 5;
    bf16x8 Af[2][4]; float wv[2][16]; f32x2 wv2[2][8];
#pragma unroll
    for (int p = 0; p < 2; ++p) {
        const int tq = t0 + 4 * wave + 2 * p + (r >> 4); const bf16_t* qrow = PROJ + (size_t)tq * DINP + CQI + (r & 15) * 64 + 8 * hh;
#pragma unroll
        for (int ks = 0; ks < 4; ++ks) Af[p][ks] = *(const bf16x8*)(qrow + 16 * ks);
#pragma unroll
        for (int qq = 0; qq < 2; ++qq) {
            const bf16_t* wp = PROJ + (size_t)(t0 + 4 * wave + 2 * p + qq) * DINP + CWI + 4 * hh;
            const u32x2 wa = *(const u32x2*)wp, wb = *(const u32x2*)(wp + 8);
            wv[p][8 * qq + 0] = bf_lo(wa.x) * (1.0f / 32.0f); wv[p][8 * qq + 1] = bf_hi(wa.x) * (1.0f / 32.0f); wv[p][8 * qq + 2] = bf_lo(wa.y) * (1.0f / 32.0f); wv[p][8 * qq + 3] = bf_hi(wa.y) * (1.0f / 32.0f);
            wv[p][8 * qq + 4] = bf_lo(wb.x) * (1.0f / 32.0f); wv[p][8 * qq + 5] = bf_hi(wb.x) * (1.0f / 32.0f); wv[p][8 * qq + 6] = bf_lo(wb.y) * (1.0f / 32.0f); wv[p][8 * qq + 7] = bf_hi(wb.y) * (1.0f / 32.0f);
        }
#pragma unroll
        for (int i = 0; i < 8; ++i) wv2[p][i] = (f32x2){wv[p][2 * i], wv[p][2 * i + 1]};
    }
    const u32x2 tagsw = __builtin_amdgcn_permlane32_swap(0u, 1u, false, false); const int qsel = (int)tagsw[0];
    u32x4 stg[2];
#pragma unroll
    for (int i = 0; i < 2; ++i) { const int q = tid + 512 * i; stg[i] = *(const u32x4*)(KI + (size_t)(kt0 * 128 + (q >> 3)) * 64 + (q & 7) * 8); }
#pragma unroll
    for (int i = 0; i < 2; ++i) { const int q = tid + 512 * i; *(LAS u32x4*)(lds + SC_KT + (kt0 & 1) * 18432 + (q >> 3) * 144 + (q & 7) * 16) = stg[i]; }
    __syncthreads();
    for (int kt = kt0; kt < kt1; ++kt) {
        const LAS unsigned char* buf = lds + SC_KT + (kt & 1) * 18432;
        LAS float* sb = (LAS float*)(lds + SC_SB + (kt & 1) * (32 * SC_SPITCH * 4));
        if (kt + 1 < kt1) {
#pragma unroll
            for (int i = 0; i < 2; ++i) { const int q = tid + 512 * i; stg[i] = *(const u32x4*)(KI + (size_t)((kt + 1) * 128 + (q >> 3)) * 64 + (q & 7) * 8); }
        }
        __builtin_amdgcn_sched_barrier(0);
        if (kt > kt0) score_flush(lds, SCORES, SEGMAX, t0, kt - 1, tid);
        {
        f32x16 accP[2], accC[2];
#define SC_MFMA(cb) do { bf16x8 Bf[4]; _Pragma("unroll") for (int ks = 0; ks < 4; ++ks) Bf[ks] = *(const LAS bf16x8*)(buf + (32 * (cb) + r) * 144 + (16 * ks + 8 * hh) * 2); \
            _Pragma("unroll") for (int p = 0; p < 2; ++p) { _Pragma("unroll") for (int i = 0; i < 16; ++i) accC[p][i] = 0.f; \
                _Pragma("unroll") for (int ks = 0; ks < 4; ++ks) accC[p] = __builtin_amdgcn_mfma_f32_32x32x16_bf16(Af[p][ks], Bf[ks], accC[p], 0, 0, 0); } } while (0)
#define SC_RED(acc, cb) do { _Pragma("unroll") for (int p = 0; p < 2; ++p) { f32x2 s0 = {0.f, 0.f}, s1 = {0.f, 0.f}; \
            _Pragma("unroll") for (int reg = 0; reg < 8; reg += 2) { const f32x2 r0 = {relu_i(acc[p][reg]), relu_i(acc[p][reg + 1])}; const f32x2 r1 = {relu_i(acc[p][reg + 8]), relu_i(acc[p][reg + 9])}; \
                s0 = __builtin_elementwise_fma(wv2[p][reg >> 1], r0, s0); s1 = __builtin_elementwise_fma(wv2[p][4 + (reg >> 1)], r1, s1); } \
            const float p0 = s0[0] + s0[1], p1 = s1[0] + s1[1]; \
            const u32x2 sw = __builtin_amdgcn_permlane32_swap(__float_as_uint(p0), __float_as_uint(p1), false, false); \
            sb[(4 * wave + 2 * p + qsel) * SC_SPITCH + 32 * (cb) + r] = __uint_as_float(sw[0]) + __uint_as_float(sw[1]); } } while (0)
#define SC_INTERLEAVE() do { _Pragma("unroll") for (int i = 0; i < 8; ++i) { __builtin_amdgcn_sched_group_barrier(0x008, 1, 0); __builtin_amdgcn_sched_group_barrier(0x002, 8, 0); } } while (0)
        SC_MFMA(0);
        accP[0] = accC[0]; accP[1] = accC[1]; SC_MFMA(1); SC_RED(accP, 0); SC_INTERLEAVE();
        accP[0] = accC[0]; accP[1] = accC[1]; SC_MFMA(2); SC_RED(accP, 1); SC_INTERLEAVE();
        accP[0] = accC[0]; accP[1] = accC[1]; SC_MFMA(3); SC_RED(accP, 2); SC_INTERLEAVE();
        SC_RED(accC, 3);
#undef SC_MFMA
#undef SC_RED
#undef SC_INTERLEAVE
        }
        if (kt + 1 < kt1) {
#pragma unroll
            for (int i = 0; i < 2; ++i) { const int q = tid + 512 * i; *(LAS u32x4*)(lds + SC_KT + ((kt + 1) & 1) * 18432 + (q >> 3) * 144 + (q & 7) * 16) = stg[i]; }
        }
        __syncthreads();
    }
    score_flush(lds, SCORES, SEGMAX, t0, kt1 - 1, tid);
    __syncthreads();
}

template <int NV, bool EXACT>
__device__ __forceinline__ float wave_kth(const float (&v)[NV], int K) {
    const float NINF = -__builtin_inff();
    float mx = NINF, mn = __builtin_inff();
#pragma unroll
    for (int j = 0; j < NV; ++j) { mx = fmaxf(mx, v[j]); mn = fminf(mn, v[j] == NINF ? __builtin_inff() : v[j]); }
    mx = wave_max(mx); mn = -wave_max(-mn);
    int c = 0;
#pragma unroll
    for (int j = 0; j < NV; ++j) c += __popcll(__ballot(v[j] >= mx));
    if (c >= K) return mx;
    float lo = mn, hi = mx, tau = mn;
    for (int it = 0; it < 64; ++it) {
        const float mid = 0.5f * (lo + hi);
        if (!(mid > lo && mid < hi)) { tau = lo; break; }
        c = 0;
#pragma unroll
        for (int j = 0; j < NV; ++j) c += __popcll(__ballot(v[j] >= mid));
        if (c == K || (!EXACT && c > K && c <= K + (K >> 2))) { tau = mid; break; }
        if (c > K) lo = mid; else hi = mid;
        tau = lo;
    }
    return tau;
}
__device__ __forceinline__ float wave_kth16(const float (&v)[16], int K) { return wave_kth<16, true>(v, K); }
__device__ __forceinline__ int lanes_below(unsigned long long mask) { return (int)__builtin_amdgcn_mbcnt_hi((unsigned)(mask >> 32), __builtin_amdgcn_mbcnt_lo((unsigned)mask, 0u)); }
__device__ __forceinline__ float h2f(unsigned short h) { return (float)__builtin_bit_cast(_Float16, h); }
__device__ __forceinline__ float h2f_lo(unsigned u) { return h2f((unsigned short)(u & 0xffffu)); }
__device__ __forceinline__ float h2f_hi(unsigned u) { return h2f((unsigned short)(u >> 16)); }
__device__ __forceinline__ unsigned ge_mask8(const u32x4& v, unsigned T16) {
    unsigned m8 = 0;
#pragma unroll
    for (int w = 0; w < 4; ++w) { const unsigned vw_ = v[w];
        const s16x2 d = __builtin_elementwise_sub_sat(__builtin_bit_cast(s16x2, vw_), __builtin_bit_cast(s16x2, T16));
        const unsigned mm = ~__builtin_bit_cast(unsigned, d); m8 |= (((mm >> 15) & 1u) | ((mm >> 30) & 2u)) << (2 * w); }
    return m8;
}
__device__ __forceinline__ int append_bits(LAS int* list, int cnt, unsigned m8, int base) {
    for (;;) { const bool has = m8 != 0u; const unsigned long long mask = __ballot(has); if (!mask) break;
        const int pos = cnt + lanes_below(mask);
        if (has) { const int k = __builtin_ctz(m8); m8 &= m8 - 1u; if (pos < 1024) list[pos] = base + k; }
        cnt += __popcll(mask); }
    return cnt;
}
__device__ __forceinline__ int append_keys(LAS int* list, int cnt, unsigned m8, int base, const u32x4& v) {
    for (;;) { const bool has = m8 != 0u; const unsigned long long mask = __ballot(has); if (!mask) break;
        const int pos = cnt + lanes_below(mask);
        if (has) { const int k = __builtin_ctz(m8); m8 &= m8 - 1u;
            const unsigned dw = (k & 4) ? ((k & 2) ? v.w : v.z) : ((k & 2) ? v.y : v.x); const unsigned h = (k & 1) ? (dw >> 16) : (dw & 0xffffu);
            if (pos < 1024) list[pos] = (int)((h << 16) | (unsigned)(base + k)); }
        cnt += __popcll(mask); }
    return cnt;
}
__device__ __forceinline__ void select_row(LAS unsigned char* wl, const unsigned short* SCORES, const unsigned short* SEGMAX, int t, int lane) {
    LAS int* selw = (LAS int*)wl; LAS int* segl = (LAS int*)(wl + 1024); LAS int* cidx = (LAS int*)(wl + 5120);
    const float NINF = -__builtin_inff();
    const unsigned short* row = SCORES + (size_t)t * S; const int n = t + 1;
    float c[16]; int N;
    if (n <= 1024) {
#pragma unroll
        for (int j = 0; j < 16; ++j) { const int i = lane + 64 * j; c[j] = i < n ? h2f(row[i]) : NINF; }
        N = -1;
    } else {
        const int m = n >> 4; float s[16];
#pragma unroll
        for (int j = 0; j < 16; ++j) { const int i = lane + 64 * j; s[j] = i < m ? h2f(row[16 * i + 7]) : NINF; }
        const u32x4 NEG = (u32x4){0xfc00fc00u, 0xfc00fc00u, 0xfc00fc00u, 0xfc00fc00u};
        const unsigned short* smrow = SEGMAX + (size_t)t * 2048; const int nseg = (t >> 3) + 1;
        u32x4 sv[4];
#pragma unroll
        for (int u = 0; u < 4; ++u) { const int e8 = 8 * (lane + 64 * u); sv[u] = (e8 < nseg) ? *(const u32x4*)(smrow + e8) : NEG; }
        int K = 26, cnt = 0;
        for (;;) {
            const float tlo = (K >= m) ? NINF : wave_kth<16, false>(s, K);
            cnt = 0;
            const int nq = (n + 511) >> 9;
            if (tlo > 0.f) {
                const unsigned T16 = pk_f16(tlo, tlo);
                int ns = 0;
                {
#pragma unroll
                    for (int u = 0; u < 4; ++u) { const int e8 = 8 * (lane + 64 * u); unsigned m8 = ge_mask8(sv[u], T16);
                        const int nv = nseg - e8; if (nv < 8) m8 &= nv > 0 ? ((1u << nv) - 1u) : 0u;
                        ns = append_bits(segl, ns, m8, e8); }
                }
                if (ns > 1024) ns = 1024;
                for (int j0 = 0; j0 < ns; j0 += 512) {
                    u32x4 v[8]; int sg[8];
#pragma unroll
                    for (int u = 0; u < 8; ++u) { const int i = j0 + lane + 64 * u; sg[u] = i < ns ? segl[i] : -1; v[u] = sg[u] >= 0 ? *(const u32x4*)(row + 8 * sg[u]) : NEG; }
#pragma unroll
                    for (int u = 0; u < 8; ++u) { const int e = 8 * sg[u]; unsigned m8 = sg[u] >= 0 ? ge_mask8(v[u], T16) : 0u;
                        const int nv = t + 1 - e; if (nv < 8) m8 &= nv > 0 ? ((1u << nv) - 1u) : 0u;
                        cnt = append_keys(cidx, cnt, m8, e, v[u]); }
                }
            } else {
                for (int q0 = 0; q0 < nq; q0 += 4) {
                    u32x4 v[4];
#pragma unroll
                    for (int u = 0; u < 4; ++u) { const int e = 8 * (lane + 64 * (q0 + u)); v[u] = (e <= t) ? *(const u32x4*)(row + e) : (u32x4){0xfc00fc00u, 0xfc00fc00u, 0xfc00fc00u, 0xfc00fc00u}; }
#pragma unroll
                    for (int u = 0; u < 4; ++u) { const int e = 8 * (lane + 64 * (q0 + u));
#pragma unroll
                        for (int k = 0; k < 8; ++k) { const float x = (k & 1) ? h2f_hi(v[u][k >> 1]) : h2f_lo(v[u][k >> 1]);
                            const bool pred = (e + k <= t) && (x >= tlo); const unsigned long long mask = __ballot(pred);
                            if (mask) { const int pos = cnt + lanes_below(mask); const unsigned hb = (k & 1) ? (v[u][k >> 1] >> 16) : (v[u][k >> 1] & 0xffffu);
                                if (pred && pos < 1024) cidx[pos] = (int)((hb << 16) | (unsigned)(e + k)); cnt += __popcll(mask); } } }
                }
            }
            if (cnt >= 256 || K >= m) break;
            K *= 2;
        }
        N = cnt < 1024 ? cnt : 1024;
#pragma unroll
        for (int j = 0; j < 16; ++j) { const int i = lane + 64 * j; c[j] = i < N ? h2f((unsigned short)((unsigned)cidx[i] >> 16)) : NINF; }
    }
    float tau;
    if (N >= 0 && N <= 512) { const float c8[8] = {c[0], c[1], c[2], c[3], c[4], c[5], c[6], c[7]}; tau = wave_kth<8, true>(c8, 256); }
    else tau = wave_kth16(c, 256);
    int base = 0;
#pragma unroll
    for (int j = 0; j < 16; ++j) { const bool pred = c[j] >= tau; const unsigned long long mask = __ballot(pred);
        if (mask) { const int pos = base + lanes_below(mask); if (pred && pos < 256) selw[pos] = (N < 0) ? (lane + 64 * j) : (cidx[lane + 64 * j] & 0xffff); base += __popcll(mask); } }
}

__device__ __forceinline__ void attn_query(LAS unsigned char* wl, const bf16_t* PROJ, const unsigned char* KC, const unsigned char* VC, unsigned char* ATT, int t, int lane) {
    LAS int* selw = (LAS int*)wl; LAS float* L = (LAS float*)(wl + 1024);
    const int nsel = t < 255 ? t + 1 : 256;
    const int fr = lane & 15, fq = lane >> 4;
    constexpr float QS = 8.0f;
    long qh[2][4], ql[2][4];
#pragma unroll
    for (int g = 0; g < 2; ++g)
#pragma unroll
        for (int ks = 0; ks < 4; ++ks) {
            u32x4 z = (u32x4){0u, 0u, 0u, 0u};
            if (fr < 4) z = *(const u32x4*)(PROJ + (size_t)t * DINP + CQ + (4 * g + fr) * 128 + 32 * ks + 8 * fq);
            float qv[8], rv[8];
#pragma unroll
            for (int e = 0; e < 4; ++e) { qv[2 * e] = bf_lo(z[e]) * QS; qv[2 * e + 1] = bf_hi(z[e]) * QS; }
            const unsigned h0 = pack4_fp8(qv[0], qv[1], qv[2], qv[3]), h1 = pack4_fp8(qv[4], qv[5], qv[6], qv[7]);
            rv[0] = qv[0] - __builtin_amdgcn_cvt_f32_fp8((int)h0, 0); rv[1] = qv[1] - __builtin_amdgcn_cvt_f32_fp8((int)h0, 1); rv[2] = qv[2] - __builtin_amdgcn_cvt_f32_fp8((int)h0, 2); rv[3] = qv[3] - __builtin_amdgcn_cvt_f32_fp8((int)h0, 3);
            rv[4] = qv[4] - __builtin_amdgcn_cvt_f32_fp8((int)h1, 0); rv[5] = qv[5] - __builtin_amdgcn_cvt_f32_fp8((int)h1, 1); rv[6] = qv[6] - __builtin_amdgcn_cvt_f32_fp8((int)h1, 2); rv[7] = qv[7] - __builtin_amdgcn_cvt_f32_fp8((int)h1, 3);
            const unsigned l0 = pack4_fp8(rv[0] * 16.0f, rv[1] * 16.0f, rv[2] * 16.0f, rv[3] * 16.0f), l1 = pack4_fp8(rv[4] * 16.0f, rv[5] * 16.0f, rv[6] * 16.0f, rv[7] * 16.0f);
            qh[g][ks] = (long)(((unsigned long long)h1 << 32) | h0); ql[g][ks] = (long)(((unsigned long long)l1 << 32) | l0);
        }
    const float scale = 0.08838834764831845f / QS;
    const int nkt = (nsel + 15) >> 4;
    {
        LAS unsigned char* KT = wl + 9216;
        const int q4_ = lane >> 4, l15_ = lane & 15;
        u32x4 kw[3][4];
#define QK_LOAD(buf, kt) do { _Pragma("unroll") for (int u = 0; u < 4; ++u) { const unsigned off_ = (unsigned)selw[16 * (kt) + 4 * u + q4_] * 256u + 16u * (unsigned)l15_; kw[buf][u] = *(const u32x4*)((const char*)KC + off_); } } while (0)
#define QK_COMP(buf, kt) do { _Pragma("unroll") for (int u = 0; u < 4; ++u) *(LAS u32x4*)(KT + (4 * u + q4_) * 272 + 16 * l15_) = kw[buf][u];     \
        _Pragma("unroll") for (int g = 0; g < 2; ++g) { f32x4 acch = (f32x4){0.f, 0.f, 0.f, 0.f}, accl = (f32x4){0.f, 0.f, 0.f, 0.f}; \
            _Pragma("unroll") for (int ks = 0; ks < 4; ++ks) { const long kf_ = *(const LAS long*)(KT + fr * 272 + g * 128 + 32 * ks + 8 * fq); \
                acch = __builtin_amdgcn_mfma_f32_16x16x32_fp8_fp8(qh[g][ks], kf_, acch, 0, 0, 0); accl = __builtin_amdgcn_mfma_f32_16x16x32_fp8_fp8(ql[g][ks], kf_, accl, 0, 0, 0); } \
            if (fq == 0) { _Pragma("unroll") for (int r = 0; r < 4; ++r) L[(4 * g + r) * 256 + 16 * (kt) + fr] = (16 * (kt) + fr < nsel) ? (acch[r] + accl[r] * 0.0625f) * scale : -__builtin_inff(); } } } while (0)
        QK_LOAD(0, 0); if (1 < nkt) QK_LOAD(1, 1);
        for (int kt = 0; kt < nkt; kt += 3) {
            if (kt + 2 < nkt) QK_LOAD(2, kt + 2);
            __builtin_amdgcn_sched_barrier(0);
            QK_COMP(0, kt);
            if (kt + 1 < nkt) { if (kt + 3 < nkt) QK_LOAD(0, kt + 3); __builtin_amdgcn_sched_barrier(0); QK_COMP(1, kt + 1); }
            if (kt + 2 < nkt) { if (kt + 4 < nkt) QK_LOAD(1, kt + 4); __builtin_amdgcn_sched_barrier(0); QK_COMP(2, kt + 2); }
        }
#undef QK_LOAD
#undef QK_COMP
        if (fq == 0) { for (int kt = nkt; kt < 16; ++kt) {
#pragma unroll
            for (int r = 0; r < 8; ++r) L[r * 256 + 16 * kt + fr] = -__builtin_inff(); } }
    }
    float p[8][4];
#pragma unroll
    for (int hd = 0; hd < 8; ++hd) { float m = -__builtin_inff();
#pragma unroll
        for (int i = 0; i < 4; ++i) { p[hd][i] = L[hd * 256 + 4 * lane + i]; m = fmaxf(m, p[hd][i]); }
        m = wave_max(m); float s = 0.f;
#pragma unroll
        for (int i = 0; i < 4; ++i) { p[hd][i] = __expf(p[hd][i] - m); s += p[hd][i]; }
        s = 1.0f / wave_sum(s);
#pragma unroll
        for (int i = 0; i < 4; ++i) p[hd][i] *= s; }
    constexpr float PS = 256.0f;
    LAS unsigned* Ph = (LAS unsigned*)(wl + 1024); LAS unsigned* Pl = (LAS unsigned*)(wl + 1024 + 2048);
#pragma unroll
    for (int hd = 0; hd < 8; ++hd) {
        const float a0 = p[hd][0] * PS, a1 = p[hd][1] * PS, a2 = p[hd][2] * PS, a3 = p[hd][3] * PS;
        const unsigned h = pack4_fp8(a0, a1, a2, a3);
        const unsigned l = pack4_fp8(a0 - __builtin_amdgcn_cvt_f32_fp8((int)h, 0), a1 - __builtin_amdgcn_cvt_f32_fp8((int)h, 1), a2 - __builtin_amdgcn_cvt_f32_fp8((int)h, 2), a3 - __builtin_amdgcn_cvt_f32_fp8((int)h, 3));
        Ph[hd * 64 + lane] = h; Pl[hd * 64 + lane] = l;
    }
    LAS unsigned char* VT = wl + 9216;
    const int ii = lane & 15, kq = lane >> 4;
    f32x4 acc[16];
#pragma unroll
    for (int nt = 0; nt < 16; ++nt) acc[nt] = (f32x4){0.f, 0.f, 0.f, 0.f};
    const int nch = (nsel + 15) >> 4;
    u32x4 vw[3][4];
#define PV_LOAD(buf, c) do { _Pragma("unroll") for (int u = 0; u < 4; ++u) { const unsigned off_ = (unsigned)selw[16 * (c) + 4 * u + kq] * 256u + 16u * (unsigned)ii; vw[buf][u] = *(const u32x4*)((const char*)VC + off_); } } while (0)
#define PV_COMP(buf, c) do { _Pragma("unroll") for (int u = 0; u < 4; ++u) { LAS u32x2* d_ = (LAS u32x2*)(VT + (16 * ((c) & 1) + 4 * u + kq) * 264 + 16 * ii); d_[0] = (u32x2){vw[buf][u].x, vw[buf][u].y}; d_[1] = (u32x2){vw[buf][u].z, vw[buf][u].w}; } \
        if (((c) & 1) || (c) == nch - 1) { \
            if (!((c) & 1)) { _Pragma("unroll") for (int u = 0; u < 4; ++u) { LAS u32x2* d_ = (LAS u32x2*)(VT + (16 + 4 * u + kq) * 264 + 16 * ii); d_[0] = (u32x2){0u, 0u}; d_[1] = (u32x2){0u, 0u}; } } \
            long pah[2], pal[2]; _Pragma("unroll") for (int g = 0; g < 2; ++g) { const int po_ = (g * 4 + (ii & 3)) * 256 + 32 * ((c) >> 1) + 8 * kq; \
                const long h_ = *(const LAS long*)((const LAS unsigned char*)Ph + po_), l_ = *(const LAS long*)((const LAS unsigned char*)Pl + po_); pah[g] = ii < 4 ? h_ : 0l; pal[g] = ii < 4 ? l_ : 0l; } \
            _Pragma("unroll") for (int nt = 0; nt < 16; ++nt) { const v2i32 t_ = __builtin_amdgcn_ds_read_tr8_b64_v2i32((LAS v2i32*)(VT + (8 * kq + (ii >> 1)) * 264 + 16 * nt + 8 * (ii & 1))); \
                const long b_ = __builtin_bit_cast(long, t_); \
                acc[nt] = __builtin_amdgcn_mfma_f32_16x16x32_fp8_fp8(pah[nt >> 3], b_, acc[nt], 0, 0, 0); acc[nt] = __builtin_amdgcn_mfma_f32_16x16x32_fp8_fp8(pal[nt >> 3], b_, acc[nt], 0, 0, 0); } } } while (0)
    PV_LOAD(0, 0); if (1 < nch) PV_LOAD(1, 1);
    for (int c = 0; c < nch; c += 3) {
        if (c + 2 < nch) PV_LOAD(2, c + 2);
        __builtin_amdgcn_sched_barrier(0);
        PV_COMP(0, c);
        if (c + 1 < nch) { if (c + 3 < nch) PV_LOAD(0, c + 3); __builtin_amdgcn_sched_barrier(0); PV_COMP(1, c + 1); }
        if (c + 2 < nch) { if (c + 4 < nch) PV_LOAD(1, c + 4); __builtin_amdgcn_sched_barrier(0); PV_COMP(2, c + 2); }
    }
#undef PV_LOAD
#undef PV_COMP
    LAS float* OB = (LAS float*)(wl + 1024 + 4096);
    if (kq == 0) {
#pragma unroll
        for (int nt = 0; nt < 16; ++nt)
#pragma unroll
            for (int r = 0; r < 4; ++r) OB[(4 * (nt >> 3) + r) * 128 + 16 * (nt & 7) + ii] = acc[nt][r];
    }
    {
        const f32x4 a0 = *(const LAS f32x4*)(OB + 16 * lane), a1 = *(const LAS f32x4*)(OB + 16 * lane + 4), a2 = *(const LAS f32x4*)(OB + 16 * lane + 8), a3 = *(const LAS f32x4*)(OB + 16 * lane + 12);
        const f32x4 b0 = a0 * (OP8_SCALE / PS), b1 = a1 * (OP8_SCALE / PS), b2 = a2 * (OP8_SCALE / PS), b3 = a3 * (OP8_SCALE / PS);
        *(u32x4*)(ATT + (size_t)t * 1024 + 16 * lane) = (u32x4){pack4_fp8(b0[0], b0[1], b0[2], b0[3]), pack4_fp8(b1[0], b1[1], b1[2], b1[3]), pack4_fp8(b2[0], b2[1], b2[2], b2[3]), pack4_fp8(b3[0], b3[1], b3[2], b3[3])};
    }
}


__device__ __forceinline__ void convert_item8(const float* __restrict__ W, int K, int N, int ld, unsigned char* WT, int mode, int item, int lane, LAS unsigned char* scr) {
    const int nblk = N >> 6; const int kb = item / nblk, nb = item - kb * nblk; const int k0 = kb * 256, n0 = nb * 64;
    const int c4 = lane & 15, kr = lane >> 4;
    const float* src = W + (size_t)(k0 + 4 * kr) * ld + n0 + 4 * c4;
#pragma unroll 4
    for (int i = 0; i < 16; ++i) {
        f32x4 v[4];
#pragma unroll
        for (int r = 0; r < 4; ++r) v[r] = __builtin_nontemporal_load((const f32x4*)(src + (size_t)(16 * i + r) * ld));
        const int kk = 16 * i + 4 * kr;
#pragma unroll
        for (int e = 0; e < 4; ++e) *(LAS unsigned*)(scr + (4 * c4 + e) * 272 + kk) = pack4_fp8(v[0][e] * W8_SCALE, v[1][e] * W8_SCALE, v[2][e] * W8_SCALE, v[3][e] * W8_SCALE);
    }
    LDS_WAIT(); asm volatile("" ::: "memory");
#pragma unroll 4
    for (int j = 0; j < 16; ++j) {
        const int q = j * 64 + lane, n = q >> 4, ch = q & 15;
        const u32x4 v = *(const LAS u32x4*)(scr + n * 272 + ch * 16);
        *(u32x4*)(WT + (size_t)dest_row(mode, n0 + n) * K + k0 + ch * 16) = v;
    }
    LDS_WAIT(); asm volatile("" ::: "memory");
}

struct Conv8Job { const float* W; unsigned char* WT; int N; int mode; size_t w_estride, wt_estride; int items_per_e; };
constexpr int C8_PITCH = 272, C8_IMG = 256 * C8_PITCH;
__device__ __forceinline__ void conv8_load(const Conv8Job& jb, int item, int h, int wave, int lane, f32x4 (&v)[16]) {
    const int e = item / jb.items_per_e, r = item - e * jb.items_per_e; const int nblk = jb.N >> 8; const int kb = r / nblk, nb = r - kb * nblk;
    const float* src = jb.W + (size_t)e * jb.w_estride + (size_t)(kb * 256 + 32 * wave + 16 * h) * jb.N + nb * 256 + 4 * lane;
#pragma unroll
    for (int i = 0; i < 16; ++i) v[i] = __builtin_nontemporal_load((const f32x4*)(src + (size_t)i * jb.N));
}
__device__ __forceinline__ void conv8_to_lds(LAS unsigned char* img, int h, int wave, int lane, const f32x4 (&v)[16]) {
#pragma unroll
    for (int e = 0; e < 4; ++e) { u32x4 w;
#pragma unroll
        for (int g = 0; g < 4; ++g) w[g] = pack4_fp8(v[4 * g][e] * W8_SCALE, v[4 * g + 1][e] * W8_SCALE, v[4 * g + 2][e] * W8_SCALE, v[4 * g + 3][e] * W8_SCALE);
        *(LAS u32x4*)(img + (4 * lane + e) * C8_PITCH + 32 * wave + 16 * h) = w; }
}
__device__ __forceinline__ void conv8_store(const Conv8Job& jb, int item, const LAS unsigned char* img, int tid) {
    const int e = item / jb.items_per_e, r = item - e * jb.items_per_e; const int nblk = jb.N >> 8; const int kb = r / nblk, nb = r - kb * nblk;
    unsigned char* dst = jb.WT + (size_t)e * jb.wt_estride + kb * 256;
#pragma unroll
    for (int j = 0; j < 8; ++j) { const int q = j * 512 + tid, n = q >> 4, ch = q & 15;
        __builtin_nontemporal_store(*(const LAS u32x4*)(img + n * C8_PITCH + ch * 16), (u32x4*)(dst + (size_t)dest_row(jb.mode, nb * 256 + n) * 2048 + ch * 16)); }
}
__device__ __forceinline__ void conv8_run(LAS unsigned char* lds, const Conv8Job& jb, int n_items, int wg, int G, int tid, int wave, int lane) {
    if (wg >= n_items) return;
    f32x4 a[16], b[16]; int par = 0;
    conv8_load(jb, wg, 0, wave, lane, a); conv8_load(jb, wg, 1, wave, lane, b);
    for (int it = wg; it < n_items; it += G, par ^= 1) {
        LAS unsigned char* img = lds + par * C8_IMG;
        const int nx = (it + G < n_items) ? it + G : it;
        conv8_to_lds(img, 0, wave, lane, a); __builtin_amdgcn_sched_barrier(0);
        conv8_load(jb, nx, 0, wave, lane, a); __builtin_amdgcn_sched_barrier(0);
        conv8_to_lds(img, 1, wave, lane, b); __builtin_amdgcn_sched_barrier(0);
        conv8_load(jb, nx, 1, wave, lane, b); __builtin_amdgcn_sched_barrier(0);
        __syncthreads();
        conv8_store(jb, it, img, tid);
    }
    __syncthreads();
}

__global__ void __launch_bounds__(NTHR, 2) fwd_kernel(Args args) {
    extern __shared__ __attribute__((aligned(16))) unsigned char lds_raw[];
    LAS unsigned char* lds = (LAS unsigned char*)lds_raw;
    volatile LAS unsigned* MISC = (volatile LAS unsigned*)(lds + LDS_MISC);
    const int tid = threadIdx.x, lane = tid & 63, wave = __builtin_amdgcn_readfirstlane(tid >> 6);
    const int G = gridDim.x, wg = blockIdx.x;
    unsigned char* ws = args.ws;
    unsigned* ctl = (unsigned*)(ws + WS_CTL);
    const int lo = args.ph_lo, hi = args.ph_hi;
    const float* x = (const float*)args.in[0]; const float* cvec = (const float*)args.in[1]; const int* positions = (const int*)args.in[2];
    const float* w_ada = (const float*)args.in[3]; const float* b_ada = (const float*)args.in[4]; const float* norm1_g = (const float*)args.in[5];
    const float* w_in = (const float*)args.in[6]; const float* idx_knorm_g = (const float*)args.in[7]; const float* idx_knorm_b = (const float*)args.in[8];
    const float* lb_logits = (const float*)args.in[9]; const float* hgrn_norm_g = (const float*)args.in[10];
    const float* w_proj_att = (const float*)args.in[11]; const float* w_proj_hgrn = (const float*)args.in[12]; const float* w_out = (const float*)args.in[13];
    const float* norm2_g = (const float*)args.in[14]; const float* w_router = (const float*)args.in[15]; const float* b_router = (const float*)args.in[16];
    const float* w1 = (const float*)args.in[17]; const float* b1 = (const float*)args.in[18]; const float* w2 = (const float*)args.in[19]; const float* b2 = (const float*)args.in[20];
    const float* final_g = (const float*)args.in[21];
    float* out = args.out;
    float* MOD = (float*)(ws + WS_MOD); int* TOPE = (int*)(ws + WS_TOPE); float* GATE = (float*)(ws + WS_GATE); int* SLOT = (int*)(ws + WS_SLOT);
    bf16_t* WIN_T = (bf16_t*)(ws + WS_WIN_T); bf16_t* WA_T = (bf16_t*)(ws + WS_WA_T); bf16_t* WH_T = (bf16_t*)(ws + WS_WH_T); bf16_t* WO_T = (bf16_t*)(ws + WS_WO_T);
    unsigned char* WIN_T8 = ws + WS_WIN_T + 8 * MiB;
    unsigned char* HA8 = ws + WS_SCORES;
    unsigned char* W1_T = ws + WS_W1_T; unsigned char* W2_T = ws + WS_W2_T;
    bf16_t* HB = (bf16_t*)(ws + WS_H); bf16_t* PROJ = (bf16_t*)(ws + WS_PROJ);
    bf16_t* DELTA = (bf16_t*)(ws + WS_ATT);
    unsigned char* ACT = ws + WS_ACT; bf16_t* YB = (bf16_t*)(ws + WS_YB);
    int* TOKS = (int*)(ws + WS_TOKS);
    unsigned char* H8 = ws + WS_H;
    bf16_t* KI = (bf16_t*)(ws + WS_KI); unsigned char* KC = ws + WS_KC; unsigned char* VC = ws + WS_VC;
    bf16_t* ST = (bf16_t*)(ws + WS_ST); float* DC = (float*)(ws + WS_DC);
    unsigned char* ATT = ws + WS_ATT; unsigned char* REC = ATT + (size_t)S * 1024;        bf16_t* MERGED = (bf16_t*)(ws + WS_MERGED); unsigned short* SCORES = (unsigned short*)(ws + WS_SCORES);
    unsigned short* SEGMAX = (unsigned short*)(ws + WS_X1);

    for (int u = tid; u < 128; u += NTHR) MISC[u] = 0u;
    __syncthreads();
    const bool one_launch = (hi - lo) > 1;
    XcdBarrier bar; bar.bar = ctl + CW_BAR; bar.x = 0; bar.st = MISC + 8;
    if (one_launch) bar = xcd_barrier_post(ctl + CW_BAR, MISC + 8);
#define IN(k) (lo <= (k) && (k) < hi)
#define SEAM(k) do { if (IN(k) && IN((k) + 1)) xcd_barrier(bar); } while (0)


    if (IN(PH_PRO)) {
        for (int cb = wg; cb < 256; cb += G) {
            LAS float* red = (LAS float*)lds;
            const int c4 = tid % 12, kg = tid / 12;
            f32x4 acc = (f32x4){0.f, 0.f, 0.f, 0.f};
            if (kg < 42) {
                const float* wp = w_ada + (size_t)cb * 48 + 4 * c4;
#pragma unroll 7
                for (int j = 0; j < 49; ++j) { const int k = kg + 42 * j; if (k < D) { const f32x4 v = __builtin_nontemporal_load((const f32x4*)(wp + (size_t)k * (6 * D))); acc += siluf_(cvec[k]) * v; } }
                *(LAS f32x4*)(red + kg * 48 + 4 * c4) = acc;
            }
            __syncthreads();
            if (tid < 48) { float s = b_ada[cb * 48 + tid];
#pragma unroll 6
                for (int q = 0; q < 42; ++q) s += red[q * 48 + tid];
                MOD[cb * 48 + tid] = s; }
            __syncthreads();
        }
        LAS unsigned char* scr = lds + wave * 17408;
        const int gw = wg * NWAVES + wave, NGW = G * NWAVES;
        {
            constexpr int NB_IN = (1104 + 63) / 64;
            for (int it = gw; it < 16 * NB_IN; it += NGW) convert_item(w_in + 1536, 2048, 1104, DIN, WIN_T, 0, it, lane, scr);
            for (int it = gw; it < 4 * 32; it += NGW) convert_item8(w_proj_att, 1024, 2048, 2048, (unsigned char*)WA_T, 0, it, lane, scr);
            for (int it = gw; it < 4 * 32; it += NGW) convert_item8(w_proj_hgrn, 1024, 2048, 2048, (unsigned char*)WA_T + (size_t)2048 * 1024, 0, it, lane, scr);
            for (int it = gw; it < 8 * 32; it += NGW) convert_item8(w_out, 2048, 2048, 2048, (unsigned char*)WO_T, 0, it, lane, scr);
            for (int it = gw; it < 8 * 24; it += NGW) convert_item8(w_in, 2048, 1536, DIN, WIN_T8, 0, it, lane, scr);
            for (int it = gw; it < 8 * 128; it += NGW) convert_item8(w_in + 2640, 2048, 8192, DIN, WIN_T8 + (size_t)1536 * 2048, 0, it, lane, scr);
            for (size_t i = (size_t)wg * NTHR + tid; i < (size_t)176 * 2048 * 2 / 16; i += (size_t)G * NTHR) ((u32x4*)(WIN_T + (size_t)1104 * 2048))[i] = (u32x4){0u, 0u, 0u, 0u};
        }
    }
    SEAM(PH_PRO);

    {
    if (IN(PH_H)) {
        const float* sh1 = MOD; const float* sc1 = MOD + D;
        const int gw = wg * NWAVES + wave, NGW = G * NWAVES;
        f32x4 gs[8], sh[8];
#pragma unroll
        for (int j = 0; j < 8; ++j) { const int c = 4 * lane + 256 * j; const f32x4 g = *(const f32x4*)(norm1_g + c), sc = *(const f32x4*)(sc1 + c); sh[j] = *(const f32x4*)(sh1 + c);
#pragma unroll
            for (int e = 0; e < 4; ++e) gs[j][e] = g[e] * (1.0f + sc[e]); }
        for (int t = gw; t < S; t += NGW) {
            const f32x4* xr = (const f32x4*)(x + (size_t)t * D) + lane;
            f32x4 v[8]; float ss = 0.f;
#pragma unroll
            for (int j = 0; j < 8; ++j) { v[j] = xr[64 * j]; ss += (v[j][0] * v[j][0] + v[j][1] * v[j][1]) + (v[j][2] * v[j][2] + v[j][3] * v[j][3]); }
            const float rstd = rsqrtf(wave_sum(ss) * (1.0f / D) + NORM_EPS);
#pragma unroll
            for (int j = 0; j < 8; ++j) { const f32x4 h = v[j] * rstd * gs[j] + sh[j]; u32x2 w; w.x = cvt_pk_bf16(h[0], h[1]); w.y = cvt_pk_bf16(h[2], h[3]);
                *(u32x2*)(HB + (size_t)t * D + 4 * lane + 256 * j) = w;
                *(unsigned*)(HA8 + (size_t)t * D + 4 * lane + 256 * j) = pack4_fp8(h[0], h[1], h[2], h[3]); }
        }
    }
    SEAM(PH_H);
    if (IN(PH_INPROJ)) {
        const int XC = (G == 256) ? XCONV : 0;
        const Conv8Job j1{w1, W1_T, 4096, 2, (size_t)2048 * 4096, (size_t)4096 * 2048, 8 * 16};
        const Conv8Job j2{w2, W2_T, 2048, 0, (size_t)2048 * 2048, (size_t)2048 * 2048, 8 * 8};
        if (G != 256) { conv8_run(lds, j1, NEXP * 8 * 16, wg, G, tid, wave, lane); conv8_run(lds, j2, NEXP * 8 * 8, wg, G, tid, wave, lane); }
        if (wg < XC) { conv8_run(lds, j1, NEXP * 8 * 16, wg, XC, tid, wave, lane); conv8_run(lds, j2, NEXP * 8 * 8, wg, XC, tid, wave, lane); }
        else {
            const int Gg = G - XC, cg = wg - XC;
            {
                pg8::Gemm g8{HA8, WIN_T8, 2048, 0, nullptr, 0}; pg8::StaticOrder S8; S8.init(S, 9728, Gg, cg);
                const int full8 = 2432 / Gg, rem8 = 2432 - full8 * Gg;
                if (Gg == 256) S8.skew(8, (wg >= 128 && wg < 192) ? -1 : (wg < 128 ? wg : wg - 64), 192);
                else if (rem8 > 0) S8.skew(full8, cg < rem8 ? cg : -1, rem8);
                pg8::EpiBf16 E8{PROJ, DINP, nullptr, 0, 1.0f / W8_SCALE, 6, 1280};
                pg8::gemm_phase<pg8::EpiBf16, pg8::StaticOrder, true>(lds, g8, S8, E8);
            }
            {
                pg8::Gemm g{HB, WIN_T, 2048, 0, nullptr, 0}; pg8::StaticOrder So; So.init(S, 1280, Gg, Gg == 256 ? (wg + 128) % G : (cg + Gg - (2432 % Gg)) % Gg);
                pg8::EpiBf16 E{PROJ + CQI, DINP, nullptr, 0, 1.0f, 1 << 30, 0};
                pg8::gemm_phase<pg8::EpiBf16, pg8::StaticOrder>(lds, g, So, E);
            }
        }
    }
    SEAM(PH_INPROJ);
    if (IN(PH_POST)) {
        const int gw = wg * NWAVES + wave, NGW = G * NWAVES;
        for (int t = gw; t < S; t += NGW) post_token(PROJ, KI, KC, VC, positions, idx_knorm_g, idx_knorm_b, t, lane);
        __syncthreads();
        for (int u = wg; u < 2048; u += G) hgrn_l1(lds, PROJ, lb_logits, ST, DC, u >> 3, u & 7, tid, wave, lane);
    }
    SEAM(PH_POST);
    if (IN(PH_SCORE)) {
        for (int idx = wg * NTHR + tid; idx < 8 * 128 * 128; idx += G * NTHR) {
            const int h = idx >> 14, d = idx & 127; float s = 0.f;
            bf16_t* sp = ST + idx; const float* dp = DC + h * 128 + d;
            for (int c = 0; c < 256; c += 16) {
                float l[16], dc[16];
#pragma unroll
                for (int i = 0; i < 16; ++i) { l[i] = bf2f(sp[(size_t)(c + i) * 131072]); dc[i] = dp[(size_t)(c + i) * 1024]; }
#pragma unroll
                for (int i = 0; i < 16; ++i) { sp[(size_t)(c + i) * 131072] = f2bf(s); s = dc[i] * s + l[i]; }
            }
        }
        {
            const int XS = (G == 256) ? XSCORE : 0;
            if (wg < XS) {
                const Conv8Job j1{w1, W1_T, 4096, 2, (size_t)2048 * 4096, (size_t)4096 * 2048, 8 * 16};
                const Conv8Job j2{w2, W2_T, 2048, 0, (size_t)2048 * 2048, (size_t)2048 * 2048, 8 * 8};
                __syncthreads();
                conv8_run(lds, j1, NEXP * 8 * 16, wg, XS, tid, wave, lane); conv8_run(lds, j2, NEXP * 8 * 8, wg, XS, tid, wave, lane);
            }
            for (;;) {
                if (tid == 0) MISC[100] = __hip_atomic_fetch_add(ctl + CW_SCQ, 1u, __ATOMIC_RELAXED, __HIP_MEMORY_SCOPE_AGENT);
                __syncthreads();
                const int item = (int)MISC[100];
                __syncthreads();
                if (item >= 252 * 6) break;
                int j, lo, hi;
                if (item < 504) { j = item >> 1; const int T = ((8 + j) >> 2) + ((511 - j) >> 2) + 2; const int p = item & 1; lo = p * T / 3; hi = (p + 1) * T / 3; }
                else { const int i2 = item - 504; j = i2 >> 2; const int T = ((8 + j) >> 2) + ((511 - j) >> 2) + 2; const int p = i2 & 3, b = 2 * T / 3; lo = b + p * (T - b) / 4; hi = b + (p + 1) * (T - b) / 4; }
                const int qa = 8 + j, qb2 = 511 - j, na = (qa >> 2) + 1;
                const int a0 = lo < na ? lo : na, a1 = hi < na ? hi : na, b0 = (lo > na ? lo : na) - na, b1 = (hi > na ? hi : na) - na;
                if (a1 > a0) score_block(lds, PROJ, KI, SCORES, SEGMAX, qa, a0, a1, tid, wave, lane);
                if (b1 > b0) score_block(lds, PROJ, KI, SCORES, SEGMAX, qb2, b0, b1, tid, wave, lane);
            }
        }
    }
    SEAM(PH_SCORE);
    if (IN(PH_ATTN)) {
        const int gw = wg * NWAVES + wave, NGW = G * NWAVES;
        for (int u = wg; u < 2048; u += G) hgrn_l3(lds, PROJ, lb_logits, ST, hgrn_norm_g, REC, u >> 3, u & 7, tid, wave, lane);
        {
            for (;;) {
                unsigned tq = 0; if (lane == 0) tq = __hip_atomic_fetch_add(ctl + CW_ATQ, 1u, __ATOMIC_RELAXED, __HIP_MEMORY_SCOPE_AGENT);
                tq = (unsigned)__builtin_amdgcn_readfirstlane((int)tq);
                if (tq >= (unsigned)S) break;
                const int t = S - 1 - (int)tq;
                LAS unsigned char* wl = lds + wave * 17664;
                if (t >= 256) select_row(wl, SCORES, SEGMAX, t, lane);
                else {
#pragma unroll
                    for (int i = 0; i < 4; ++i) { const int idx = lane + 64 * i; ((LAS int*)wl)[idx] = idx <= t ? idx : 0; }
                }
                attn_query(wl, PROJ, KC, VC, ATT, t, lane);
            }
        }
    }
    SEAM(PH_ATTN);
    if (IN(PH_OP1)) {
        pg8::Gemm g{ATT, WA_T, 1024, (size_t)2048 * 1024, nullptr, (size_t)S * 1024};
        pg8::TwoPartOrder So; So.init(S, 2048, G, wg);
        pg8::EpiGate2 E{(unsigned char*)MERGED, PROJ + CGA, PROJ + CGR};
        pg8::gemm_phase<pg8::EpiGate2, pg8::TwoPartOrder, true>(lds, g, So, E);
    }
    SEAM(PH_OP2);
    if (IN(PH_WOUT)) {
        pg8::Gemm g{MERGED, WO_T, 2048, 0, nullptr, 0}; pg8::StaticOrder So; So.init(S, 2048, G, wg);
        pg8::EpiDelta E{MOD + 2 * D, DELTA, 1.0f / (W8_SCALE * MRG8_SCALE)};
        pg8::gemm_phase<pg8::EpiDelta, pg8::StaticOrder, true>(lds, g, So, E);
    }
    SEAM(PH_WOUT);
    }

    if (IN(PH_ROUTER)) {
        LAS float* hs = (LAS float*)lds;
        volatile LAS unsigned* lcnt = MISC + 32;
        const float* sh2 = MOD + 3 * D; const float* sc2 = MOD + 4 * D;
        if (tid < 32) lcnt[tid] = 0u;
        __syncthreads();
        for (int grp = wg; grp < S / 16; grp += G) {
#pragma unroll 1
            for (int q = 0; q < 2; ++q) {
                const int tl = 2 * wave + q, t = grp * 16 + tl;
                const f32x4* xr = (const f32x4*)(x + (size_t)t * D) + lane; const u32x2* dr = (const u32x2*)(DELTA + (size_t)t * D) + lane;
                f32x4 v[8]; float ss = 0.f;
#pragma unroll
                for (int j = 0; j < 8; ++j) { const u32x2 dw = dr[64 * j]; v[j] = xr[64 * j] + (f32x4){bf_lo(dw.x), bf_hi(dw.x), bf_lo(dw.y), bf_hi(dw.y)};
                    ss += (v[j][0] * v[j][0] + v[j][1] * v[j][1]) + (v[j][2] * v[j][2] + v[j][3] * v[j][3]); }
#pragma unroll
                for (int j = 0; j < 8; ++j) { u32x2 w; w.x = cvt_pk_bf16(v[j][0], v[j][1]); w.y = cvt_pk_bf16(v[j][2], v[j][3]); ((u32x2*)(DELTA + (size_t)t * D) + lane)[64 * j] = w; }
                const float rstd = rsqrtf(wave_sum(ss) * (1.0f / D) + NORM_EPS);
#pragma unroll
                for (int j = 0; j < 8; ++j) {
                    const int c = 4 * lane + 256 * j;
                    const f32x4 g = *(const f32x4*)(norm2_g + c), sc = *(const f32x4*)(sc2 + c), sh = *(const f32x4*)(sh2 + c);
                    f32x4 h;
#pragma unroll
                    for (int e = 0; e < 4; ++e) h[e] = v[j][e] * rstd * g[e] * (1.0f + sc[e]) + sh[e];
                    *(LAS f32x4*)(hs + tl * 2048 + c) = h;
                    *(unsigned*)(H8 + (size_t)t * D + c) = pack4_fp8(h[0], h[1], h[2], h[3]);
                }
            }
            __syncthreads();
            {
                LAS float* part = (LAS float*)(lds + 131072);
                const int fr = lane & 15, fq = lane >> 4;
                f32x4 acc0 = (f32x4){0.f, 0.f, 0.f, 0.f}, acc1 = acc0;
                const LAS float* hrow = hs + fr * 2048 + wave * 256 + 4 * fq; const float* wrp = w_router + (size_t)(wave * 256 + 4 * fq) * 32 + fr;
#pragma unroll 2
                for (int i = 0; i < 16; ++i) {
                    const f32x4 a4 = *(const LAS f32x4*)(hrow + 16 * i);
                    float b0[4], b1[4];
#pragma unroll
                    for (int s = 0; s < 4; ++s) { b0[s] = wrp[(size_t)(16 * i + s) * 32]; b1[s] = wrp[(size_t)(16 * i + s) * 32 + 16]; }
#pragma unroll
                    for (int s = 0; s < 4; ++s) { acc0 = __builtin_amdgcn_mfma_f32_16x16x4f32(a4[s], b0[s], acc0, 0, 0, 0); acc1 = __builtin_amdgcn_mfma_f32_16x16x4f32(a4[s], b1[s], acc1, 0, 0, 0); }
                }
#pragma unroll
                for (int r = 0; r < 4; ++r) { part[(wave * 16 + 4 * fq + r) * 32 + fr] = acc0[r]; part[(wave * 16 + 4 * fq + r) * 32 + 16 + fr] = acc1[r]; }
                __syncthreads();
                const int tl = tid >> 5, e = tid & 31, t = grp * 16 + tl;
                float v = b_router[e];
#pragma unroll
                for (int w = 0; w < 8; ++w) v += part[(w * 16 + tl) * 32 + e];
                float tv[4]; int ti[4];
#pragma unroll
                for (int k = 0; k < 4; ++k) {
                    float bv = v; int bi = e;
#pragma unroll
                    for (int o = 16; o >= 1; o >>= 1) { const float ov = __shfl_xor(bv, o); const int oi = __shfl_xor(bi, o); if (ov > bv || (ov == bv && oi < bi)) { bv = ov; bi = oi; } }
                    tv[k] = bv; ti[k] = bi; if (e == bi) v = -__builtin_inff();
                }
                if (e == 0) {
                    const float e1 = __expf(tv[1] - tv[0]), e2 = __expf(tv[2] - tv[0]), e3 = __expf(tv[3] - tv[0]); const float inv = 1.0f / (1.0f + e1 + e2 + e3);
                    *(int4*)(TOPE + (size_t)t * 4) = make_int4(ti[0], ti[1], ti[2], ti[3]);
                    *(f32x4*)(GATE + (size_t)t * 4) = (f32x4){inv, e1 * inv, e2 * inv, e3 * inv};
#pragma unroll
                    for (int k = 0; k < 4; ++k) __hip_atomic_fetch_add((LAS unsigned*)&lcnt[ti[k]], 1u, __ATOMIC_RELAXED, __HIP_MEMORY_SCOPE_WORKGROUP);
                }
            }
            __syncthreads();
        }
        if (tid < 32) { const unsigned c = lcnt[tid]; if (c) __hip_atomic_fetch_add(ctl + CW_CNT + tid, c, __ATOMIC_RELAXED, __HIP_MEMORY_SCOPE_AGENT); }
    }
    SEAM(PH_ROUTER);

    if (IN(PH_SCATTER)) {
        volatile LAS unsigned* lcnt = MISC + 32; volatile LAS unsigned* lbase = MISC + 64; LAS int* pstart = (LAS int*)(lds + 1024); LAS int* pcnt = (LAS int*)(lds + 1280);
        if (tid == 0) { int p = 0; for (int e = 0; e < NEXP; ++e) { const int c = (int)__hip_atomic_load(ctl + CW_CNT + e, __ATOMIC_RELAXED, __HIP_MEMORY_SCOPE_AGENT); pstart[e] = p; pcnt[e] = c; p += (c + 255) & ~255; } }
        if (tid < 32) lcnt[tid] = 0u;
        __syncthreads();
        if (wg < NEXP) { const int e = wg; for (int s = pstart[e] + pcnt[e] + tid; s < pstart[e] + ((pcnt[e] + 255) & ~255); s += NTHR) TOKS[s] = 0; }
        for (int blk = wg; blk < S / 64; blk += G) {
            int e = 0, lrank = 0;
            if (tid < 256) { e = TOPE[(size_t)blk * 256 + tid]; lrank = (int)__hip_atomic_fetch_add((LAS unsigned*)&lcnt[e], 1u, __ATOMIC_RELAXED, __HIP_MEMORY_SCOPE_WORKGROUP); }
            __syncthreads();
            if (tid < 32) { const unsigned c = lcnt[tid]; lbase[tid] = c ? __hip_atomic_fetch_add(ctl + CW_FILL + tid, c, __ATOMIC_RELAXED, __HIP_MEMORY_SCOPE_AGENT) : 0u; }
            __syncthreads();
            if (tid < 256) { const int slot = pstart[e] + (int)lbase[e] + lrank; SLOT[(size_t)blk * 256 + tid] = slot; TOKS[slot] = blk * 64 + (tid >> 2); }
            __syncthreads();
            if (tid < 32) lcnt[tid] = 0u;
            __syncthreads();
        }
    }
    SEAM(PH_SCATTER);

    if (IN(PH_MOE1) || IN(PH_MOE2)) {
        LAS int* panel_e = (LAS int*)(lds + 131072 + 2048);
        LAS int* npan = (LAS int*)(lds + 131072 + 2048 + 2048);
        __syncthreads();
        if (tid == 0) { int p = 0; for (int e = 0; e < NEXP; ++e) { const int np = (int)((__hip_atomic_load(ctl + CW_CNT + e, __ATOMIC_RELAXED, __HIP_MEMORY_SCOPE_AGENT) + 255u) >> 8); for (int q = 0; q < np; ++q) panel_e[p + q] = e; p += np; } npan[0] = p; }
        __syncthreads();
        const int nPanels = npan[0];
        if (IN(PH_MOE1)) {
            pg8::Gemm g{H8, W1_T, 2048, (size_t)4096 * 2048, TOKS, 0}; pg8::MoeOrder So; So.init(nPanels, 16, G, wg, panel_e);
            pg8::EpiSwiglu E{ACT, b1};
            pg8::gemm_phase<pg8::EpiSwiglu, pg8::MoeOrder, true>(lds, g, So, E);
        }
        SEAM(PH_MOE1);
        if (IN(PH_MOE2)) {
            pg8::Gemm g{ACT, W2_T, 2048, (size_t)2048 * 2048, nullptr, 0}; pg8::MoeOrder So; So.init(nPanels, 8, G, wg, panel_e);
            pg8::EpiBf16 E{YB, 2048, b2, 2048, 1.0f / (W8_SCALE * ACT8_SCALE), 1 << 30, 0};
            pg8::gemm_phase<pg8::EpiBf16, pg8::MoeOrder, true>(lds, g, So, E);
        }
    }
    SEAM(PH_MOE2);

    if (IN(PH_FINAL)) {
        const float* gt2 = MOD + 5 * D;
        const int gw = wg * NWAVES + wave, NGW = G * NWAVES;
        for (int t = gw; t < S; t += NGW) {
            const u32x2* dr = (const u32x2*)(DELTA + (size_t)t * D) + lane;
            f32x4 v[8];
#pragma unroll
            for (int j = 0; j < 8; ++j) { const u32x2 dw = dr[64 * j]; v[j] = (f32x4){bf_lo(dw.x), bf_hi(dw.x), bf_lo(dw.y), bf_hi(dw.y)}; }
            {
                f32x4 m[8];
#pragma unroll
                for (int j = 0; j < 8; ++j) m[j] = (f32x4){0.f, 0.f, 0.f, 0.f};
                const int4 sl = *(const int4*)(SLOT + (size_t)t * 4); const f32x4 gt = *(const f32x4*)(GATE + (size_t)t * 4);
                const int sls[4] = {sl.x, sl.y, sl.z, sl.w};
#pragma unroll
                for (int k = 0; k < 4; ++k) {
                    const u32x2* yr = (const u32x2*)(YB + (size_t)sls[k] * D) + lane; const float gk = gt[k];
#pragma unroll
                    for (int j = 0; j < 8; ++j) { const u32x2 w = yr[64 * j]; m[j][0] += gk * bf_lo(w.x); m[j][1] += gk * bf_hi(w.x); m[j][2] += gk * bf_lo(w.y); m[j][3] += gk * bf_hi(w.y); }
                }
#pragma unroll
                for (int j = 0; j < 8; ++j) { const f32x4 g2 = *(const f32x4*)(gt2 + 4 * lane + 256 * j); v[j] = v[j] + g2 * m[j]; }
            }
            float ss = 0.f;
#pragma unroll
            for (int j = 0; j < 8; ++j) ss += (v[j][0] * v[j][0] + v[j][1] * v[j][1]) + (v[j][2] * v[j][2] + v[j][3] * v[j][3]);
            const float rstd = rsqrtf(wave_sum(ss) * (1.0f / D) + NORM_EPS);
            f32x4* orow = (f32x4*)(out + (size_t)t * D) + lane;
#pragma unroll
            for (int j = 0; j < 8; ++j) { const f32x4 fg = *(const f32x4*)(final_g + 4 * lane + 256 * j); orow[64 * j] = v[j] * rstd * fg; }
        }
    }
#undef IN
#undef SEAM
}

#ifndef MK_ONE_LAUNCH
#define MK_ONE_LAUNCH 1
#endif
extern "C" void kernel_launch(void* const* d_in, const int* in_sizes, int n_in, void* d_out, int out_size, void* d_ws, size_t ws_size, hipStream_t stream) {
    static int grid = 0;
    if (grid == 0) {
        if (n_in != 22 || out_size != S * D || ws_size < WS_END) { fprintf(stderr, "kernel_launch: unexpected shapes: n_in %d out %d ws %zu (need %zu)\n", n_in, out_size, ws_size, (size_t)WS_END); grid = -1; return; }
        int dev = 0, cus = 0, per_cu = 0;
        if (hipGetDevice(&dev) != hipSuccess || hipDeviceGetAttribute(&cus, hipDeviceAttributeMultiprocessorCount, dev) != hipSuccess) { grid = -1; return; }
        if (hipFuncSetAttribute((const void*)fwd_kernel, hipFuncAttributeMaxDynamicSharedMemorySize, LDS_BYTES) != hipSuccess) { fprintf(stderr, "kernel_launch: hipFuncSetAttribute failed\n"); grid = -1; return; }
        if (hipOccupancyMaxActiveBlocksPerMultiprocessor(&per_cu, (const void*)fwd_kernel, NTHR, LDS_BYTES) != hipSuccess || per_cu < 1) { fprintf(stderr, "kernel_launch: occupancy query says %d\n", per_cu); (void)hipGetLastError(); grid = -1; return; }
        grid = cus;
    }
    if (grid < 0) return;
    (void)in_sizes;
    hipMemsetAsync((char*)d_ws + WS_CTL, 0, CTL_BYTES, stream);
    Args a{};
    for (int i = 0; i < 22; ++i) a.in[i] = d_in[i];
    a.out = (float*)d_out; a.ws = (unsigned char*)d_ws; a.flags = 0; a.pad = 0;
#if MK_ONE_LAUNCH
    a.ph_lo = 0; a.ph_hi = NPH;
    hipLaunchKernelGGL(fwd_kernel, dim3(grid), dim3(NTHR), LDS_BYTES, stream, a);
#else
    for (int p = 0; p < NPH; ++p) { a.ph_lo = p; a.ph_hi = p + 1; hipLaunchKernelGGL(fwd_kernel, dim3(grid), dim3(NTHR), LDS_BYTES, stream, a); }
#endif
}
```

```cpp
#include <hip/hip_runtime.h>
#include <cstdio>
#include <cstdint>

#define GAS __attribute__((address_space(1)))
#define LAS __attribute__((address_space(3)))
typedef unsigned short bf16_t;
typedef short bf16x8 __attribute__((ext_vector_type(8)));
typedef float f32x4 __attribute__((ext_vector_type(4)));
typedef float f32x2 __attribute__((ext_vector_type(2)));
typedef float f32x16 __attribute__((ext_vector_type(16)));
typedef unsigned u32x4 __attribute__((ext_vector_type(4)));
typedef unsigned u32x2 __attribute__((ext_vector_type(2)));
typedef int i32x4 __attribute__((ext_vector_type(4)));
typedef int i32x8 __attribute__((ext_vector_type(8)));
typedef short s16x4 __attribute__((ext_vector_type(4)));
typedef short s16x2 __attribute__((ext_vector_type(2)));
typedef int v2i32 __attribute__((ext_vector_type(2)));

constexpr int S = 16384, D = 2048, DIN = 10832, DINP = 11008, NEXP = 32, DFF = 2048;
constexpr int NWAVES = 8, NTHR = 512;
constexpr int CQ = 0, CK = 1024, CV = 1280, CQI = 1536, CKI = 2560, CWI = 2624, CHQ = 2816, CHF = 3840, CHI = 4864, CHG = 5888, CGA = 6912, CGR = 8960;
constexpr int PMAX = 65536 + NEXP * 256;
constexpr float NORM_EPS = 1e-5f;

constexpr size_t MiB = 1u << 20;
constexpr size_t al256(size_t x) { return (x + 255) & ~(size_t)255; }
constexpr size_t WS_CTL = 0, CTL_BYTES = 1 * MiB;
constexpr size_t WS_MOD = WS_CTL + CTL_BYTES;
constexpr size_t WS_TOPE = WS_MOD + 64 * 1024;
constexpr size_t WS_GATE = WS_TOPE + (size_t)S * 16;
constexpr size_t WS_SLOT = WS_GATE + (size_t)S * 16;
constexpr size_t WS_WIN_T = WS_SLOT + (size_t)S * 16;
constexpr size_t WS_WA_T = WS_WIN_T + (size_t)DINP * D * 2;
constexpr size_t WS_WH_T = WS_WA_T + (size_t)2048 * 1024 * 2;
constexpr size_t WS_WO_T = WS_WH_T + (size_t)2048 * 1024 * 2;
constexpr size_t WS_W1_T = WS_WO_T + (size_t)2048 * 2048 * 2;
constexpr size_t WS_W2_T = WS_W1_T + (size_t)NEXP * 4096 * 2048 * 2;
constexpr size_t WS_H = WS_W2_T + (size_t)NEXP * 2048 * 2048 * 2;
constexpr size_t WS_PROJ = WS_H + (size_t)S * D * 2;
constexpr size_t WS_KI = WS_PROJ + (size_t)S * DINP * 2;
constexpr size_t WS_KC = WS_KI + (size_t)S * 64 * 2;
constexpr size_t WS_VC = WS_KC + (size_t)S * 256 * 2;
constexpr size_t WS_ST = WS_VC + (size_t)S * 256 * 2;
constexpr size_t WS_DC = WS_ST + (size_t)256 * 8 * 128 * 128 * 4;
constexpr size_t WS_SEL = WS_DC + (size_t)256 * 8 * 128 * 4;
constexpr size_t WS_ATT = WS_SEL + (size_t)S * 256 * 4;
constexpr size_t WS_REC = WS_ATT + (size_t)S * 1024 * 2;
constexpr size_t WS_MERGED = WS_REC + (size_t)S * 1024 * 2;
constexpr size_t WS_X1 = WS_MERGED + (size_t)S * 2048 * 2;
constexpr size_t WS_SCORES = WS_X1 + (size_t)S * 2048 * 4;
constexpr size_t WS_XB = WS_SCORES;
constexpr size_t WS_ACT = WS_XB + (size_t)PMAX * 2048 * 2;
constexpr size_t WS_YB = WS_ACT + (size_t)PMAX * 2048 * 2;
constexpr size_t WS_END = WS_SCORES + (size_t)S * S * 4;
static_assert(WS_YB + (size_t)PMAX * 2048 * 2 <= WS_END, "MoE buffers overlay the score matrix");
static_assert(WS_END <= (size_t)4096 * MiB, "workspace");
constexpr int CW_BAR = 4096, CW_CNT = 8192, CW_FILL = 8448;
constexpr size_t WS_TOKS = WS_SEL;

constexpr int LDS_BYTES = 155648;
constexpr int LDS_MISC = LDS_BYTES - 512;

__device__ __forceinline__ unsigned cvt_pk_bf16(float lo, float hi) { unsigned r; asm volatile("v_cvt_pk_bf16_f32 %0, %1, %2" : "=v"(r) : "v"(lo), "v"(hi)); return r; }
__device__ __forceinline__ float bf_lo(unsigned u) { return __uint_as_float(u << 16); }
__device__ __forceinline__ float bf_hi(unsigned u) { return __uint_as_float(u & 0xffff0000u); }
__device__ __forceinline__ float bf2f(bf16_t b) { return __uint_as_float(((unsigned)b) << 16); }
__device__ __forceinline__ float wave_sum(float v) {
#define DPPS(ctrl, rmask) { const int s_ = __builtin_amdgcn_update_dpp(0, __float_as_int(v), ctrl, rmask, 0xF, false); v += __int_as_float(s_); }
    DPPS(0x111, 0xF) DPPS(0x112, 0xF) DPPS(0x114, 0xF) DPPS(0x118, 0xF) DPPS(0x142, 0xA) DPPS(0x143, 0xC)
#undef DPPS
    return __int_as_float(__builtin_amdgcn_readlane(__float_as_int(v), 63));
}
__device__ __forceinline__ float wave_max(float v) {
#define DPPM(ctrl, rmask) { const int o_ = __float_as_int(v); const int s_ = __builtin_amdgcn_update_dpp(o_, o_, ctrl, rmask, 0xF, false); v = fmaxf(v, __int_as_float(s_)); }
    DPPM(0x111, 0xF) DPPM(0x112, 0xF) DPPM(0x114, 0xF) DPPM(0x118, 0xF) DPPM(0x142, 0xA) DPPM(0x143, 0xC)
#undef DPPM
    return __int_as_float(__builtin_amdgcn_readlane(__float_as_int(v), 63));
}
__device__ __forceinline__ float sigmoidf_(float x) { return __builtin_amdgcn_rcpf(1.0f + __expf(-x)); }
__device__ __forceinline__ float siluf_(float x) { return x * __builtin_amdgcn_rcpf(1.0f + __expf(-x)); }
__device__ __forceinline__ unsigned pack4_fp8(float a, float b, float c, float d) { int w = 0; w = __builtin_amdgcn_cvt_pk_fp8_f32(a, b, w, false); w = __builtin_amdgcn_cvt_pk_fp8_f32(c, d, w, true); return (unsigned)w; }
constexpr float W8_SCALE = 64.0f, ACT8_SCALE = 4.0f, MRG8_SCALE = 8.0f, OP8_SCALE = 16.0f;
__device__ __forceinline__ float relu_i(float x) { const int i = __float_as_int(x); return __int_as_float(i > 0 ? i : 0); }
__device__ __forceinline__ void fp8x16_to_bf16(const u32x4& w, u32x4& lo, u32x4& hi) {
    unsigned o[8];
#pragma unroll
    for (int q = 0; q < 4; ++q) { const unsigned wq = w[q]; const f32x2 a = __builtin_amdgcn_cvt_pk_f32_fp8((int)wq, false), b = __builtin_amdgcn_cvt_pk_f32_fp8((int)wq, true);
        o[2 * q] = cvt_pk_bf16(a[0], a[1]); o[2 * q + 1] = cvt_pk_bf16(b[0], b[1]); }
    lo = (u32x4){o[0], o[1], o[2], o[3]}; hi = (u32x4){o[4], o[5], o[6], o[7]};
}
__device__ __forceinline__ unsigned char fp8_1(float x) { return (unsigned char)(__builtin_amdgcn_cvt_pk_fp8_f32(x, x, 0, false) & 0xff); }
#define LDS_WAIT() asm volatile("s_waitcnt lgkmcnt(0)" ::: "memory")
#define VM_WAIT() asm volatile("s_waitcnt vmcnt(0)" ::: "memory")

#define XB_TMO      128
#define XB_XCNT(j)  (256  + 64 * (j))
#define XB_XSUB(j)  (1280 + 64 * (j))
#define XB_XGEN(j)  (2304 + 64 * (j))
#define XB_TOP      3328
#define XB_TOPGEN   3392
#define XCD_BAR_WORDS 3456
#define XB_SPIN_CAP (1u << 22)

__device__ __forceinline__ unsigned xb_ld(unsigned* p)              { return __hip_atomic_load(p, __ATOMIC_RELAXED, __HIP_MEMORY_SCOPE_AGENT); }
__device__ __forceinline__ unsigned xb_add(unsigned* p, unsigned v) { return __hip_atomic_fetch_add(p, v, __ATOMIC_RELAXED, __HIP_MEMORY_SCOPE_AGENT); }
__device__ __forceinline__ unsigned xb_xcc_id() { return (unsigned)__builtin_amdgcn_s_getreg((3 << 11) | 20) & 0xFu; }
#define XB_SPIN(cond, bar) do { unsigned _sp = 0; while (cond) { __builtin_amdgcn_s_sleep(1); \
    if ((++_sp & 255u) == 0u) { if (xb_ld(&(bar)[XB_TMO])) break; if (_sp > XB_SPIN_CAP) { atomicAdd(&(bar)[XB_TMO], 1u); break; } } } } while (0)

struct XcdBarrier { unsigned* bar; unsigned x; volatile LAS unsigned* st; };

__device__ __forceinline__ XcdBarrier xcd_barrier_post(unsigned* bar, volatile LAS unsigned* st) {
    XcdBarrier b; b.bar = bar; b.x = xb_xcc_id(); b.st = st;
    if (threadIdx.x == 0) (void)xb_add(&bar[XB_XCNT(b.x)], 1u);
    return b;
}
__device__ __forceinline__ void xcd_barrier_complete(unsigned* bar, unsigned x, unsigned& nloc, unsigned& nx) {
    const unsigned G = gridDim.x * gridDim.y * gridDim.z;
    unsigned sum, cnt, mine, sp = 0u;
    for (;;) {
        sum = 0u; cnt = 0u; mine = 0u;
#pragma unroll
        for (unsigned j = 0; j < 16; ++j) { const unsigned c = xb_ld(&bar[XB_XCNT(j)]); sum += c; cnt += (c > 0u) ? 1u : 0u; mine = (j == x) ? c : mine; }
        if (sum == G) break;
        __builtin_amdgcn_s_sleep(1);
        if ((++sp & 255u) == 0u) { if (xb_ld(&bar[XB_TMO])) break; if (sp > XB_SPIN_CAP) { atomicAdd(&bar[XB_TMO], 1u); break; } }
    }
    nloc = mine > 0u ? mine : 1u; nx = cnt > 0u ? cnt : 1u;
}
__device__ __forceinline__ void xcd_barrier(const XcdBarrier& b) {
    asm volatile("s_waitcnt vmcnt(0)" ::: "memory");
    __syncthreads();
    if (threadIdx.x == 0) {
        unsigned* bar = b.bar;
        __builtin_amdgcn_s_waitcnt(0);
        unsigned nloc = b.st[0], nx = b.st[1];
        if (nloc == 0u) { xcd_barrier_complete(bar, b.x, nloc, nx); b.st[0] = nloc; b.st[1] = nx; }
        const unsigned old = xb_add(&bar[XB_XSUB(b.x)], 1u);
        const unsigned gen = old / nloc;
        if (old + 1u == (gen + 1u) * nloc) {
            __builtin_amdgcn_fence(__ATOMIC_RELEASE, "agent");
            asm volatile("s_waitcnt vmcnt(0)" ::: "memory");
            const unsigned og = xb_add(&bar[XB_TOP], 1u);
            const unsigned tg = og / nx;
            if (og + 1u == (tg + 1u) * nx) xb_add(&bar[XB_TOPGEN], 1u);
            else XB_SPIN(xb_ld(&bar[XB_TOPGEN]) == tg, bar);
            __builtin_amdgcn_fence(__ATOMIC_ACQUIRE, "agent");
            xb_add(&bar[XB_XGEN(b.x)], 1u);
            asm volatile("s_waitcnt vmcnt(0)" ::: "memory");
        } else {
            XB_SPIN(xb_ld(&bar[XB_XGEN(b.x)]) == gen, bar);
            __builtin_amdgcn_fence(__ATOMIC_ACQUIRE, "agent");
            asm volatile("s_waitcnt vmcnt(0)" ::: "memory");
        }
    }
    __syncthreads();
}

namespace pg8 {
constexpr int BM = 256, BK = 64, HALF = 128, HTB = HALF * BK * 2, STAGE_BYTES = 8 * HTB, NXCD = 8, WGM = 8;
__host__ __device__ __forceinline__ int lds_byte(int r, int c) { const int st = (r >> 4) * 2 + (c >> 5), rr = r & 15, cc = c & 31, ob = rr * 64 + cc * 2; return st * 1024 + (ob ^ (((ob >> 9) & 1) << 5)); }
__host__ __device__ __forceinline__ void stage_rc(int b, int& R, int& C) { const int st = b / 1024, sb = b % 1024, swz = sb ^ (((sb >> 9) & 1) << 5); R = (st >> 1) * 16 + swz / 64; C = (st & 1) * 32 + (swz % 64) / 2; }
__host__ __device__ __forceinline__ int perm32(int rho) { const int n = rho >> 4, i = rho & 15; return 8 * (i >> 2) + 4 * n + (i & 3); }

struct Unit { int pm, pn, e; };
struct Gemm { const void* A; const void* Bt; int K; size_t estride; const int* arow; size_t astride; };

struct StaticOrder {
    int nM, nN, nwg, G, c, i, full, erank, en;
    __device__ void init(int M, int N, int G_, int c_) { nM = M / BM; nN = N / BM; nwg = nM * nN; G = G_; c = c_; i = 0; full = 1 << 30; erank = -1; en = 1; }
    __device__ void skew(int full_, int erank_, int en_) { full = full_; erank = erank_; en = en_; }
    __device__ bool next(Unit& u) {
        long L;
        if (i < full) L = (long)i * G + c; else { if (erank < 0) return false; L = (long)full * G + (long)(i - full) * en + erank; }
        ++i; if (L >= nwg) return false;
        int wgid = (int)L; { const int q = nwg / NXCD, r = nwg % NXCD, xcd = wgid % NXCD, off = wgid / NXCD; wgid = (xcd < r ? xcd * (q + 1) : r * (q + 1) + (xcd - r) * q) + off; }
        const int nig = WGM * nN, gid = wgid / nig, fm = gid * WGM, gsz = (nM - fm) < WGM ? (nM - fm) : WGM;
        u.pm = fm + ((wgid % nig) % gsz); u.pn = (wgid % nig) / gsz; u.e = 0; return true;
    }
};
struct MoeOrder {
    int nPanels, nN, G, c, i; const LAS int* panel_e;
    __device__ void init(int nPanels_, int nN_, int G_, int c_, const LAS int* pe) { nPanels = nPanels_; nN = nN_; G = G_; c = c_; i = 0; panel_e = pe; }
    __device__ bool next(Unit& u) {
        const int PB = 256 / nN;
        const int nblk = (nPanels + PB - 1) / PB;
        for (;;) {
            const long L = (long)i * G + c; ++i;
            const int blk = (int)(L >> 8), r = (int)(L & 255), x = r & 7, j = r >> 3;
            if (blk >= nblk) return false;
            int pm, pn;
            if (nN == 16) { pm = blk * 16 + 4 * (x >> 1) + (j & 3); pn = 8 * (x & 1) + (j >> 2); }
            else          { pm = blk * 32 + 4 * x + (j & 3);        pn = j >> 2; }
            if (pm < nPanels) { u.pm = pm; u.pn = pn; u.e = panel_e[pm]; return true; }
        }
    }
};

template <class Epi, class Sched, bool FP8 = false>
__device__ __forceinline__ void gemm_phase(LAS unsigned char* lds, const Gemm g, Sched& S, const Epi& E) {
    const int tid = threadIdx.x, wid = __builtin_amdgcn_readfirstlane(tid >> 6), lane = tid & 63, wr = wid >> 2, wc = wid & 3, fr = lane & 15, fq = lane >> 4;
    const int K = g.K; const int pitch = FP8 ? K : 2 * K; const int nt = pitch / 128;
    unsigned voffA[2], voffB[2];
#pragma unroll
    for (int i = 0; i < 2; ++i) { int R, C; stage_rc(tid * 16 + i * 8192, R, C); const int Rb = Epi::PERM ? ((R & ~31) + perm32(R & 31)) : R;
        voffA[i] = (unsigned)(R * pitch + C * 2); voffB[i] = (unsigned)(Rb * pitch + C * 2); }
    const size_t kstep = (size_t)(BK * 2);
    const size_t hstep = (size_t)HALF * pitch;
    const size_t tstep = 2 * hstep;
    int RA[2], CA[2];
#pragma unroll
    for (int i = 0; i < 2; ++i) stage_rc(tid * 16 + i * 8192, RA[i], CA[i]);
    const bool gather = g.arow != nullptr;
    const size_t hsA = gather ? 0 : hstep;
    unsigned vA0[2] = {voffA[0], voffA[1]}, vA1[2] = {voffA[0], voffA[1]}, nA0[2] = {voffA[0], voffA[1]}, nA1[2] = {voffA[0], voffA[1]};
#define PG8_AOFF(dst0, dst1, u) do { if (gather) { _Pragma("unroll") for (int i = 0; i < 2; ++i) { \
        dst0[i] = (unsigned)g.arow[(u).pm * 256 + RA[i]] * (unsigned)pitch + (unsigned)(CA[i] * 2); dst1[i] = (unsigned)g.arow[(u).pm * 256 + 128 + RA[i]] * (unsigned)pitch + (unsigned)(CA[i] * 2); } } } while (0)
    const unsigned ldsw = (unsigned)wid * 1024u;
    const int aoff = lds_byte(wr * 64 + fr, fq * 8), boff = lds_byte(wc * 32 + fr, fq * 8);
#define PG8_SA(b, h) (((b) * 2 + (h)) * HTB)
#define PG8_SB(b, h) ((4 + (b) * 2 + (h)) * HTB)
#define PG8_STAGE(bufoff, gbase, voff) do { _Pragma("unroll") for (int _i = 0; _i < 2; ++_i) \
        __builtin_amdgcn_global_load_lds((const unsigned*)((const char*)(gbase) + (voff)[_i]), (LAS unsigned*)(lds + (bufoff) + ldsw + _i * 8192), 16, 0, 0); } while (0)
#define PG8_LD8(p) __builtin_shufflevector(*(const LAS i32x4*)(p), *(const LAS i32x4*)((p) + 1024), 0, 1, 2, 3, 4, 5, 6, 7)
#define PG8_LDA(dst, b, h) do { _Pragma("unroll") for (int m = 0; m < 4; ++m) { if constexpr (FP8) dst##8[m] = PG8_LD8(lds + PG8_SA(b, h) + aoff + m * 2048); \
        else { _Pragma("unroll") for (int k = 0; k < 2; ++k) dst[m][k] = *(const LAS bf16x8*)(lds + PG8_SA(b, h) + aoff + m * 2048 + k * 1024); } } } while (0)
#define PG8_LDB(dst, b, h) do { _Pragma("unroll") for (int n = 0; n < 2; ++n) { if constexpr (FP8) dst##8[n] = PG8_LD8(lds + PG8_SB(b, h) + boff + n * 2048); \
        else { _Pragma("unroll") for (int k = 0; k < 2; ++k) dst[n][k] = *(const LAS bf16x8*)(lds + PG8_SB(b, h) + boff + n * 2048 + k * 1024); } } } while (0)
#define PG8_MMA(ai, bj, At, Bt) do { __builtin_amdgcn_s_setprio(1); _Pragma("unroll") for (int m = 0; m < 4; ++m) _Pragma("unroll") for (int n = 0; n < 2; ++n) { \
        if constexpr (FP8) asm volatile("v_mfma_scale_f32_16x16x128_f8f6f4 %0, %1, %2, %0, %3, %3 op_sel_hi:[0,0,0]" : "+v"(acc[ai][bj][m][n]) : "v"(Bt##8[n]), "v"(At##8[m]), "v"(scl1)); \
        else { _Pragma("unroll") for (int k = 0; k < 2; ++k) acc[ai][bj][m][n] = __builtin_amdgcn_mfma_f32_16x16x32_bf16(Bt[n][k], At[m][k], acc[ai][bj][m][n], 0, 0, 0); } } \
        __builtin_amdgcn_s_setprio(0); } while (0)
#define PG8_WAIT_V(n) asm volatile("s_waitcnt vmcnt(" #n ")" ::: "memory")
#define PG8_WAIT_L(n) asm volatile("s_waitcnt lgkmcnt(" #n ")" ::: "memory")
#define PG8_BAR __builtin_amdgcn_s_barrier()
#define PG8_SCHED __builtin_amdgcn_sched_barrier(0)
    Unit cur, nxt;
    if (!S.next(cur)) return;
    const unsigned scl1 = 0x7f7f7f7fu;
    f32x4 acc[2][2][4][2];
#pragma unroll
    for (int a = 0; a < 2; ++a)
#pragma unroll
        for (int b = 0; b < 2; ++b)
#pragma unroll
            for (int m = 0; m < 4; ++m)
#pragma unroll
                for (int n = 0; n < 2; ++n) acc[a][b][m][n] = (f32x4){0.f, 0.f, 0.f, 0.f};
    bf16x8 At[4][2], B0[2][2], B1[2][2]; i32x8 At8[4], B08[2], B18[2];
    const char* cA = (const char*)g.A + (size_t)cur.e * g.astride + (gather ? (size_t)0 : (size_t)cur.pm * tstep); const char* cB = (const char*)g.Bt + (size_t)cur.e * g.estride + (size_t)cur.pn * tstep;
    PG8_AOFF(vA0, vA1, cur);
    PG8_STAGE(PG8_SB(0, 0), cB, voffB); PG8_STAGE(PG8_SB(0, 1), cB + hstep, voffB); PG8_STAGE(PG8_SA(0, 0), cA, vA0); PG8_STAGE(PG8_SA(0, 1), cA + hsA, vA1);
    if (wr == 1) PG8_BAR;
    PG8_WAIT_V(2); PG8_BAR;
    PG8_STAGE(PG8_SB(1, 0), cB + kstep, voffB); PG8_STAGE(PG8_SA(1, 0), cA + kstep, vA0); PG8_STAGE(PG8_SB(1, 1), cB + hstep + kstep, voffB);
    PG8_WAIT_V(6); PG8_BAR;
    for (;;) {
        const bool has_next = S.next(nxt);
        const char* nA = has_next ? (const char*)g.A + (size_t)nxt.e * g.astride + (gather ? (size_t)0 : (size_t)nxt.pm * tstep) : cA;
        if (has_next) PG8_AOFF(nA0, nA1, nxt);
        const char* nB = has_next ? (const char*)g.Bt + (size_t)nxt.e * g.estride + (size_t)nxt.pn * tstep : cB;
        for (int t = 0; t < nt; t += 2) {
            const bool last = (t == nt - 2);
            const char* a1 = cA + (size_t)(t + 1) * kstep;
            const char* a2 = last ? nA : cA + (size_t)(t + 2) * kstep; const char* b2 = last ? nB : cB + (size_t)(t + 2) * kstep;
            const char* a3 = a2 + kstep; const char* b3 = b2 + kstep;
            PG8_LDB(B0, 0, 0); PG8_LDB(B1, 0, 1); PG8_SCHED; PG8_LDA(At, 0, 0); PG8_STAGE(PG8_SA(1, 1), a1 + hsA, vA1);
            if (last && has_next) { vA0[0] = nA0[0]; vA0[1] = nA0[1]; vA1[0] = nA1[0]; vA1[1] = nA1[1]; }
            PG8_WAIT_V(8); PG8_WAIT_L(0); PG8_BAR; PG8_MMA(0, 0, At, B0); PG8_MMA(0, 1, At, B1); PG8_BAR; PG8_SCHED;
            PG8_LDA(At, 0, 1); PG8_STAGE(PG8_SB(0, 0), b2, voffB); PG8_STAGE(PG8_SB(0, 1), b2 + hstep, voffB); PG8_STAGE(PG8_SA(0, 0), a2, vA0);
            PG8_WAIT_V(8); PG8_WAIT_L(0); PG8_BAR; PG8_MMA(1, 0, At, B0); PG8_MMA(1, 1, At, B1); PG8_BAR; PG8_SCHED;
            PG8_LDB(B0, 1, 0); PG8_LDB(B1, 1, 1); PG8_SCHED; PG8_LDA(At, 1, 0); PG8_STAGE(PG8_SA(0, 1), a2 + hsA, vA1);
            PG8_WAIT_V(8); PG8_WAIT_L(0); PG8_BAR; PG8_MMA(0, 0, At, B0); PG8_MMA(0, 1, At, B1); PG8_BAR; PG8_SCHED;
            PG8_LDA(At, 1, 1); PG8_STAGE(PG8_SB(1, 0), b3, voffB); PG8_STAGE(PG8_SB(1, 1), b3 + hstep, voffB); PG8_STAGE(PG8_SA(1, 0), a3, vA0);
            PG8_WAIT_V(8); PG8_WAIT_L(0); PG8_BAR; PG8_MMA(1, 0, At, B0); PG8_MMA(1, 1, At, B1); PG8_BAR; PG8_SCHED;
        }
        if (wr == 0) PG8_BAR;
        if constexpr (FP8) {
#pragma unroll
            for (int a = 0; a < 2; ++a)
#pragma unroll
                for (int b = 0; b < 2; ++b) asm volatile("s_nop 15" : "+v"(acc[a][b][0][0]), "+v"(acc[a][b][0][1]), "+v"(acc[a][b][1][0]), "+v"(acc[a][b][1][1]), "+v"(acc[a][b][2][0]), "+v"(acc[a][b][2][1]), "+v"(acc[a][b][3][0]), "+v"(acc[a][b][3][1]));
        }
        const bool keep_acc = E(acc, cur, wr, wc, fr, fq);
        if (!has_next) break;
        if (!keep_acc)
#pragma unroll
        for (int a = 0; a < 2; ++a)
#pragma unroll
            for (int b = 0; b < 2; ++b)
#pragma unroll
                for (int m = 0; m < 4; ++m)
#pragma unroll
                    for (int n = 0; n < 2; ++n) acc[a][b][m][n] = (f32x4){0.f, 0.f, 0.f, 0.f};
        cur = nxt; cA = nA; cB = nB;
        if (wr == 1) PG8_BAR;
    }
    PG8_WAIT_V(0);
    PG8_BAR;
#undef PG8_AOFF
#undef PG8_SA
#undef PG8_SB
#undef PG8_STAGE
#undef PG8_LDA
#undef PG8_LDB
#undef PG8_MMA
#undef PG8_LD8
#undef PG8_WAIT_V
#undef PG8_WAIT_L
#undef PG8_BAR
#undef PG8_SCHED
}

struct EpiBf16 {
    static constexpr bool PERM = true;
    bf16_t* O; int ldc; const float* bias; int bias_estride; float ascale; int skip_from, skip_cols;
    __device__ __forceinline__ bool operator()(const f32x4 (&acc)[2][2][4][2], const Unit& u, int wr, int wc, int fr, int fq) const {
        const int row0 = u.pm * BM + wr * 64 + fr; const int col0 = u.pn * BM + wc * 32 + 8 * fq + (u.pn >= skip_from ? skip_cols : 0);
        f32x4 bv[2][2];
#pragma unroll
        for (int bj = 0; bj < 2; ++bj)
#pragma unroll
            for (int n = 0; n < 2; ++n) bv[bj][n] = bias ? *(const f32x4*)(bias + (size_t)u.e * bias_estride + col0 + bj * HALF + 4 * n) : (f32x4){0.f, 0.f, 0.f, 0.f};
#pragma unroll
        for (int ai = 0; ai < 2; ++ai)
#pragma unroll
            for (int m = 0; m < 4; ++m) { bf16_t* rowp = O + (size_t)(row0 + ai * HALF + m * 16) * ldc + col0;
#pragma unroll
                for (int bj = 0; bj < 2; ++bj) { const f32x4 v0 = acc[ai][bj][m][0] * ascale + bv[bj][0], v1 = acc[ai][bj][m][1] * ascale + bv[bj][1];
                    u32x4 w; w.x = cvt_pk_bf16(v0[0], v0[1]); w.y = cvt_pk_bf16(v0[2], v0[3]); w.z = cvt_pk_bf16(v1[0], v1[1]); w.w = cvt_pk_bf16(v1[2], v1[3]);
                    *(u32x4*)(rowp + bj * HALF) = w; } }
        return false;
    }
};
__device__ __forceinline__ float swiglu1(float ug, float ul) {
    ug = fminf(ug, 7.0f); ul = fminf(fmaxf(ul, -7.0f), 7.0f);
    return ug * __builtin_amdgcn_rcpf(1.0f + __expf(-1.702f * ug)) * (ul + 1.0f);
}
struct EpiSwiglu {
    static constexpr bool PERM = true;
    unsigned char* O; const float* b1;
    __device__ __forceinline__ bool operator()(const f32x4 (&acc)[2][2][4][2], const Unit& u, int wr, int wc, int fr, int fq) const {
        const int row0 = u.pm * BM + wr * 64 + fr; const int c0 = u.pn * 128 + wc * 32 + 8 * fq;
        const float* bg = b1 + (size_t)u.e * 4096 + c0; const float* bl = bg + 2048;
        f32x4 bgv[2], blv[2];
#pragma unroll
        for (int n = 0; n < 2; ++n) { bgv[n] = *(const f32x4*)(bg + 4 * n); blv[n] = *(const f32x4*)(bl + 4 * n); }
#pragma unroll
        for (int ai = 0; ai < 2; ++ai)
#pragma unroll
            for (int m = 0; m < 4; ++m) {
                float a[8];
#pragma unroll
                for (int n = 0; n < 2; ++n)
#pragma unroll
                    for (int j = 0; j < 4; ++j) a[4 * n + j] = ACT8_SCALE * swiglu1(acc[ai][0][m][n][j] * (1.0f / W8_SCALE) + bgv[n][j], acc[ai][1][m][n][j] * (1.0f / W8_SCALE) + blv[n][j]);
                u32x2 w; w.x = pack4_fp8(a[0], a[1], a[2], a[3]); w.y = pack4_fp8(a[4], a[5], a[6], a[7]);
                *(u32x2*)(O + (size_t)(row0 + ai * HALF + m * 16) * 2048 + c0) = w;
            }
        return false;
    }
};

struct TwoPartOrder {
    StaticOrder so; Unit held; int part;
    __device__ void init(int M, int N, int G_, int c_) { so.init(M, N, G_, c_); part = 0; }
    __device__ bool next(Unit& u) { if (part == 1) { u = held; u.e = 1; part = 0; return true; } if (!so.next(held)) return false; u = held; u.e = 0; part = 1; return true; }
};
struct EpiGate2 {
    static constexpr bool PERM = true;
    unsigned char* O; const bf16_t* Ga; const bf16_t* Gr;
    __device__ __forceinline__ bool operator()(f32x4 (&acc)[2][2][4][2], const Unit& u, int wr, int wc, int fr, int fq) const {
        const int row0 = u.pm * BM + wr * 64 + fr; const int col0 = u.pn * BM + wc * 32 + 8 * fq;
#pragma unroll
        for (int ai = 0; ai < 2; ++ai)
#pragma unroll
            for (int m = 0; m < 4; ++m) { const size_t row = (size_t)(row0 + ai * HALF + m * 16);
#pragma unroll
                for (int bj = 0; bj < 2; ++bj) { const int c = col0 + bj * HALF;
                    const u32x4 gr = *(const u32x4*)(Gr + row * DINP + c);
                    if (u.e == 0) {
                        const u32x4 ga = *(const u32x4*)(Ga + row * DINP + c);
#pragma unroll
                        for (int q = 0; q < 4; ++q) {
                            const float r0 = (1.0f + __expf(-bf_lo(gr[q]))) * __builtin_amdgcn_rcpf(1.0f + __expf(-bf_lo(ga[q]))), r1 = (1.0f + __expf(-bf_hi(gr[q]))) * __builtin_amdgcn_rcpf(1.0f + __expf(-bf_hi(ga[q])));
                            acc[ai][bj][m][q >> 1][(2 * q) & 3] *= r0; acc[ai][bj][m][q >> 1][(2 * q + 1) & 3] *= r1; }
                    } else {
                        float r[8];
#pragma unroll
                        for (int q = 0; q < 4; ++q) { r[2 * q] = sigmoidf_(bf_lo(gr[q])) * acc[ai][bj][m][q >> 1][(2 * q) & 3]; r[2 * q + 1] = sigmoidf_(bf_hi(gr[q])) * acc[ai][bj][m][q >> 1][(2 * q + 1) & 3]; }
                        u32x2 w; constexpr float osc = MRG8_SCALE / (W8_SCALE * OP8_SCALE); w.x = pack4_fp8(r[0] * osc, r[1] * osc, r[2] * osc, r[3] * osc); w.y = pack4_fp8(r[4] * osc, r[5] * osc, r[6] * osc, r[7] * osc);
                        *(u32x2*)(O + row * 2048 + c) = w; } } }
        return u.e == 0;
    }
};
struct EpiDelta {
    static constexpr bool PERM = true;
    const float* gt; bf16_t* DL; float ascale;
    __device__ __forceinline__ bool operator()(const f32x4 (&acc)[2][2][4][2], const Unit& u, int wr, int wc, int fr, int fq) const {
        const int row0 = u.pm * BM + wr * 64 + fr; const int col0 = u.pn * BM + wc * 32 + 8 * fq;
        f32x4 g[2][2];
#pragma unroll
        for (int bj = 0; bj < 2; ++bj)
#pragma unroll
            for (int n = 0; n < 2; ++n) g[bj][n] = *(const f32x4*)(gt + col0 + bj * HALF + 4 * n);
#pragma unroll
        for (int ai = 0; ai < 2; ++ai)
#pragma unroll
            for (int m = 0; m < 4; ++m) { bf16_t* rowp = DL + (size_t)(row0 + ai * HALF + m * 16) * 2048 + col0;
#pragma unroll
                for (int bj = 0; bj < 2; ++bj) { const f32x4 v0 = acc[ai][bj][m][0] * ascale * g[bj][0], v1 = acc[ai][bj][m][1] * ascale * g[bj][1];
                    u32x4 w; w.x = cvt_pk_bf16(v0[0], v0[1]); w.y = cvt_pk_bf16(v0[2], v0[3]); w.z = cvt_pk_bf16(v1[0], v1[1]); w.w = cvt_pk_bf16(v1[2], v1[3]);
                    *(u32x4*)(rowp + bj * HALF) = w; } }
        return false;
    }
};
}

struct Args { const void* in[22]; float* out; unsigned char* ws; int ph_lo, ph_hi, flags, pad; };
constexpr int XCONV = 0, XSCORE = 96;
constexpr int CW_SCQ = 12288, SCP = 5, CW_ATQ = 12352;
enum { PH_PRO = 0, PH_H, PH_INPROJ, PH_POST, PH_SCORE, PH_SELECT, PH_ATTN, PH_OP1, PH_OP2, PH_WOUT, PH_ROUTER, PH_SCATTER, PH_MOE1, PH_MOE2, PH_FINAL, NPH };

__device__ __forceinline__ int dest_row(int mode, int n) {
    if (mode == 1) return n < 2640 ? n : n + 176;
    if (mode == 2) { const int g = n >> 11, c = n & 2047; return (c >> 7) * 256 + g * 128 + (c & 127); }
    return n;
}
__device__ __forceinline__ void convert_item(const float* __restrict__ W, int K, int N, int ld, bf16_t* WT, int mode, int item, int lane, LAS unsigned char* scr) {
    const int nblk = (N + 63) >> 6; const int kb = item / nblk, nb = item - kb * nblk; const int k0 = kb * 128, n0 = nb * 64;
    const int c4 = lane & 15, kr = lane >> 4;
    const bool ok = (n0 + 4 * c4) < N;
    const float* src = W + (size_t)(k0 + 2 * kr) * ld + n0 + 4 * c4;
#pragma unroll 4
    for (int i = 0; i < 16; ++i) {
        f32x4 v0 = (f32x4){0.f, 0.f, 0.f, 0.f}, v1 = v0;
        if (ok) { v0 = *(const f32x4*)(src + (size_t)(8 * i) * ld); v1 = *(const f32x4*)(src + (size_t)(8 * i + 1) * ld); }
        const int kk = 8 * i + 2 * kr;
#pragma unroll
        for (int e = 0; e < 4; ++e) *(LAS unsigned*)(scr + (4 * c4 + e) * 272 + kk * 2) = cvt_pk_bf16(v0[e], v1[e]);
    }
    LDS_WAIT(); asm volatile("" ::: "memory");
#pragma unroll 4
    for (int j = 0; j < 16; ++j) {
        const int q = j * 64 + lane, n = q >> 4, ch = q & 15;
        const u32x4 v = *(const LAS u32x4*)(scr + n * 272 + ch * 16);
        if (n0 + n < N) *(u32x4*)(WT + (size_t)dest_row(mode, n0 + n) * K + k0 + ch * 8) = v;
    }
    LDS_WAIT(); asm volatile("" ::: "memory");
}


__device__ __forceinline__ bf16_t f2bf(float f) { unsigned u = __float_as_uint(f); return (bf16_t)((u + 0x7fffu + ((u >> 16) & 1u)) >> 16); }
__device__ __forceinline__ float bfx(const u32x4& w, int i) { const unsigned u = w[i >> 1]; return (i & 1) ? bf_hi(u) : bf_lo(u); }
__device__ __forceinline__ void rope_sc(float pos, float inv, float& sn, float& cs) {
    const float ang = pos * inv;
    const double a = (double)ang; const double n = __builtin_rint(a * 0.15915494309189535); const float r = (float)(a - n * 6.283185307179586);
    sn = sinf(r); cs = cosf(r);
}
__device__ __forceinline__ void post_token(bf16_t* PROJ, bf16_t* KI, unsigned char* KC, unsigned char* VC, const int* positions, const float* kng, const float* knb, int t, int lane) {
    const float pos = (float)positions[t];
    bf16_t* row = PROJ + (size_t)t * DINP;
    float sn, cs;
#pragma unroll
    for (int i = 0; i < 2; ++i) {
        const int pp = lane + 64 * i, hd = pp >> 4, ii = pp & 15;
        rope_sc(pos, powf(500000.0f, -(float)ii * (1.0f / 16.0f)), sn, cs);
        bf16_t* p = row + CQ + hd * 128 + ii; const float a = bf2f(p[0]), b = bf2f(p[16]);
        p[0] = f2bf(a * cs - b * sn); p[16] = f2bf(b * cs + a * sn);
    }
#pragma unroll
    for (int i = 0; i < 2; ++i) {
        const int pp = lane + 64 * i, hd = pp >> 3, ii = pp & 7;
        rope_sc(pos, powf(500000.0f, -(float)ii * (1.0f / 8.0f)), sn, cs);
        bf16_t* p = row + CQI + hd * 64 + ii; const float a = bf2f(p[0]), b = bf2f(p[8]);
        p[0] = f2bf(a * cs - b * sn); p[8] = f2bf(b * cs + a * sn);
    }
    if (lane < 32) {
        const int g = lane >> 4, ii = lane & 15;
        rope_sc(pos, powf(500000.0f, -(float)ii * (1.0f / 16.0f)), sn, cs);
        const bf16_t* p = row + CK + g * 128 + ii; const float a = bf2f(p[0]), b = bf2f(p[16]);
        unsigned char* o = KC + (size_t)t * 256 + g * 128 + ii; o[0] = fp8_1(a * cs - b * sn); o[16] = fp8_1(b * cs + a * sn);
    }
#pragma unroll
    for (int i = 0; i < 3; ++i) { const int idx = lane + 64 * i, g = idx / 96, r = idx - g * 96; KC[(size_t)t * 256 + g * 128 + 32 + r] = fp8_1(bf2f(row[CK + g * 128 + 32 + r])); }
    { const u32x2 w = *(const u32x2*)(row + CV + 4 * lane); *(unsigned*)(VC + (size_t)t * 256 + 4 * lane) = pack4_fp8(bf_lo(w.x), bf_hi(w.x), bf_lo(w.y), bf_hi(w.y)); }
    {
        const float v = bf2f(row[CKI + lane]);
        const float mean = wave_sum(v) * (1.0f / 64.0f); const float d = v - mean; const float var = wave_sum(d * d) * (1.0f / 64.0f);
        const float y = d * rsqrtf(var + NORM_EPS) * kng[lane] + knb[lane];
        const float other = __shfl_xor(y, 8);
        rope_sc(pos, powf(500000.0f, -(float)(lane & 7) * (1.0f / 8.0f)), sn, cs);
        float o = y;
        if (lane < 8) o = y * cs - other * sn; else if (lane < 16) o = y * cs + other * sn;
        KI[(size_t)t * 64 + lane] = f2bf(o);
    }
}

constexpr int HG_GB = 0, HG_Q1 = 33792, HG_Q2 = 51200, HG_K2 = 68608, HG_VT = 86016, HG_PB = 104448, HG_LB = 113664;
__device__ __forceinline__ void hgrn_cumsum(LAS unsigned char* lds, const u32x4& w0, const u32x4& w1, float l0, float l1, int tid) {
    LAS float* GB = (LAS float*)(lds + HG_GB); LAS float* LB = (LAS float*)(lds + HG_LB); LAS float* SEG = (LAS float*)(lds + HG_LB + 512);
    if (tid < 128) LB[tid] = 1.0f / (1.0f + expf(l1 - l0));
    __syncthreads();
    const int t = tid >> 3, dseg = tid & 7;
#pragma unroll
    for (int i = 0; i < 16; ++i) { const float z = i < 8 ? bfx(w0, i) : bfx(w1, i - 8); const float lb = LB[16 * dseg + i]; GB[t * 128 + 16 * dseg + i] = logf(lb + (1.0f - lb) * sigmoidf_(z)); }
    __syncthreads();
    const int d = tid & 127, tq = tid >> 7;
    float z[16];
#pragma unroll
    for (int i = 0; i < 16; ++i) z[i] = GB[(16 * tq + i) * 128 + d];
    float a = 0.f;
#pragma unroll
    for (int i = 0; i < 16; ++i) { a += z[i]; z[i] = a; }
    SEG[tq * 128 + d] = a;
    __syncthreads();
    float pre = 0.f;
    for (int q = 0; q < tq; ++q) pre += SEG[q * 128 + d];
#pragma unroll
    for (int i = 0; i < 16; ++i) GB[(16 * tq + i) * 128 + d] = z[i] + pre;
    __syncthreads();
}
__device__ __forceinline__ void hgrn_vt(LAS unsigned char* lds, const u32x4& a, const u32x4& b, int tid) {
    const int s2 = tid & 31, eg = tid >> 5;
#pragma unroll
    for (int i = 0; i < 8; ++i) { const unsigned lo = (i & 1) ? (a[i >> 1] >> 16) : (a[i >> 1] & 0xffffu), hi = (i & 1) ? (b[i >> 1] >> 16) : (b[i >> 1] & 0xffffu);
        *(LAS unsigned*)(lds + HG_VT + (8 * eg + i) * 144 + s2 * 4) = lo | (hi << 16); }
}
__device__ __forceinline__ void hgrn_l1(LAS unsigned char* lds, const bf16_t* PROJ, const float* lb_logits, bf16_t* ST, float* DC, int c, int h, int tid, int wave, int lane) {
    const int t = tid >> 3, dseg = tid & 7, s2 = tid & 31, dg = tid >> 5;
    const bf16_t* pf = PROJ + (size_t)(c * 64 + t) * DINP + CHF + h * 128 + 16 * dseg;
    const bf16_t* pk = PROJ + (size_t)(c * 64 + 2 * s2) * DINP + CHF + h * 128 + 8 * dg;
    const u32x4 w0 = *(const u32x4*)pf, w1 = *(const u32x4*)(pf + 8);
    const u32x4 ka = *(const u32x4*)pk, kb = *(const u32x4*)(pk + DINP);
    const u32x4 va = *(const u32x4*)(pk - CHF + CHI), vb = *(const u32x4*)(pk - CHF + CHI + DINP);
    const float l0 = lb_logits[h * 128 + (tid & 127)], l1 = lb_logits[1024 + h * 128 + (tid & 127)];
    hgrn_cumsum(lds, w0, w1, l0, l1, tid);
    const LAS float* GB = (const LAS float*)(lds + HG_GB); const LAS float* LB = (const LAS float*)(lds + HG_LB);
    {
#pragma unroll
        for (int i = 0; i < 8; ++i) { const int d = 8 * dg + i; const float lb = LB[d], b63 = GB[63 * 128 + d];
            const float k0 = (1.0f - lb) * (1.0f - sigmoidf_(bfx(ka, i))), k1 = (1.0f - lb) * (1.0f - sigmoidf_(bfx(kb, i)));
            const float v0 = k0 * __expf(b63 - GB[(2 * s2) * 128 + d]), v1 = k1 * __expf(b63 - GB[(2 * s2 + 1) * 128 + d]);
            *(LAS unsigned*)(lds + HG_Q1 + d * 144 + s2 * 4) = cvt_pk_bf16(v0, v1); }
    }
    hgrn_vt(lds, va, vb, tid);
    __syncthreads();
    const int fr = lane & 15, fq = lane >> 4;
    bf16x8 af[2];
#pragma unroll
    for (int ks = 0; ks < 2; ++ks) af[ks] = *(const LAS bf16x8*)(lds + HG_VT + (16 * wave + fr) * 144 + (32 * ks + 8 * fq) * 2);
    bf16_t* dst = ST + ((size_t)(c * 8 + h) * 128) * 128;
#pragma unroll 2
    for (int dt = 0; dt < 8; ++dt) {
        f32x4 acc = (f32x4){0.f, 0.f, 0.f, 0.f};
#pragma unroll
        for (int ks = 0; ks < 2; ++ks) { const bf16x8 bfr = *(const LAS bf16x8*)(lds + HG_Q1 + (16 * dt + fr) * 144 + (32 * ks + 8 * fq) * 2); acc = __builtin_amdgcn_mfma_f32_16x16x32_bf16(af[ks], bfr, acc, 0, 0, 0); }
#pragma unroll
        for (int r = 0; r < 4; ++r) dst[(size_t)(16 * wave + 4 * fq + r) * 128 + 16 * dt + fr] = f2bf(acc[r]);
    }
    if (tid < 128) DC[(size_t)(c * 8 + h) * 128 + tid] = __expf(GB[63 * 128 + tid]);
    __syncthreads();
}
__device__ __forceinline__ void hgrn_l3(LAS unsigned char* lds, const bf16_t* PROJ, const float* lb_logits, const bf16_t* ST, const float* norm_g, unsigned char* REC, int c, int h, int tid, int wave, int lane) {
    const int t = tid >> 3, dseg = tid & 7, s2 = tid & 31, eg = tid >> 5, fr = lane & 15, fq = lane >> 4;
    const bf16_t* pf = PROJ + (size_t)(c * 64 + t) * DINP + CHF + h * 128 + 16 * dseg;
    const u32x4 f0 = *(const u32x4*)pf, f1 = *(const u32x4*)(pf + 8), q0 = *(const u32x4*)(pf - CHF + CHQ), q1 = *(const u32x4*)(pf - CHF + CHQ + 8);
    const u32x4 g0 = *(const u32x4*)(pf - CHF + CHG), g1 = *(const u32x4*)(pf - CHF + CHG + 8);
    const bf16_t* pv = PROJ + (size_t)(c * 64 + 2 * s2) * DINP + CHI + h * 128 + 8 * eg;
    const u32x4 va = *(const u32x4*)pv, vb = *(const u32x4*)(pv + DINP);
    const bf16_t* sp = ST + ((size_t)(c * 8 + h) * 128 + 16 * wave + fr) * 128 + 8 * fq;
    u32x4 sx[4];
#pragma unroll
    for (int ks = 0; ks < 4; ++ks) sx[ks] = *(const u32x4*)(sp + 32 * ks);
    const float l0 = lb_logits[h * 128 + (tid & 127)], l1 = lb_logits[1024 + h * 128 + (tid & 127)];
    hgrn_cumsum(lds, f0, f1, l0, l1, tid);
    const LAS float* GB = (const LAS float*)(lds + HG_GB); const LAS float* LB = (const LAS float*)(lds + HG_LB);
    {
        unsigned o1[8], o2[8], o3[8];
#pragma unroll
        for (int i = 0; i < 16; i += 2) {
            float a1[2], a2[2], a3[2];
#pragma unroll
            for (int j = 0; j < 2; ++j) { const int d = 16 * dseg + i + j; const float lb = LB[d], b = GB[t * 128 + d], br = GB[31 * 128 + d];
                const float z = (i + j) < 8 ? bfx(f0, i + j) : bfx(f1, i + j - 8), qv = (i + j) < 8 ? bfx(q0, i + j) : bfx(q1, i + j - 8);
                const float k = (1.0f - lb) * (1.0f - sigmoidf_(z)), q = siluf_(qv);
                a1[j] = q * __expf(b); a2[j] = q * __expf(b - br); a3[j] = k * __expf(br - b); }
            o1[i >> 1] = cvt_pk_bf16(a1[0], a1[1]); o2[i >> 1] = cvt_pk_bf16(a2[0], a2[1]); o3[i >> 1] = cvt_pk_bf16(a3[0], a3[1]);
        }
        LAS u32x4* d1 = (LAS u32x4*)(lds + HG_Q1 + t * 272 + dseg * 32); LAS u32x4* d2 = (LAS u32x4*)(lds + HG_Q2 + t * 272 + dseg * 32); LAS u32x4* d3 = (LAS u32x4*)(lds + HG_K2 + t * 272 + dseg * 32);
        d1[0] = (u32x4){o1[0], o1[1], o1[2], o1[3]}; d1[1] = (u32x4){o1[4], o1[5], o1[6], o1[7]};
        d2[0] = (u32x4){o2[0], o2[1], o2[2], o2[3]}; d2[1] = (u32x4){o2[4], o2[5], o2[6], o2[7]};
        d3[0] = (u32x4){o3[0], o3[1], o3[2], o3[3]}; d3[1] = (u32x4){o3[4], o3[5], o3[6], o3[7]};
    }
    hgrn_vt(lds, va, vb, tid);
    __syncthreads();
#pragma unroll
    for (int q = 0; q < 2; ++q) {
        const int tile = 2 * wave + q, tt = tile >> 2, stl = tile & 3;
        f32x4 acc = (f32x4){0.f, 0.f, 0.f, 0.f};
#pragma unroll
        for (int ks = 0; ks < 4; ++ks) { const bf16x8 a = *(const LAS bf16x8*)(lds + HG_Q2 + (16 * tt + fr) * 272 + (32 * ks + 8 * fq) * 2), b = *(const LAS bf16x8*)(lds + HG_K2 + (16 * stl + fr) * 272 + (32 * ks + 8 * fq) * 2);
            acc = __builtin_amdgcn_mfma_f32_16x16x32_bf16(a, b, acc, 0, 0, 0); }
#pragma unroll
        for (int r = 0; r < 4; ++r) { const int tr_ = 16 * tt + 4 * fq + r, s = 16 * stl + fr; *(LAS bf16_t*)(lds + HG_PB + tr_ * 144 + s * 2) = f2bf(s <= tr_ ? acc[r] : 0.f); }
    }
    __syncthreads();
    {
        bf16x8 b1[2], b2[4];
#pragma unroll
        for (int ks = 0; ks < 2; ++ks) b1[ks] = *(const LAS bf16x8*)(lds + HG_VT + (16 * wave + fr) * 144 + (32 * ks + 8 * fq) * 2);
#pragma unroll
        for (int ks = 0; ks < 4; ++ks) b2[ks] = __builtin_bit_cast(bf16x8, sx[ks]);
        LAS float* OB = (LAS float*)(lds + HG_GB);
#pragma unroll
        for (int tt = 0; tt < 4; ++tt) {
            f32x4 acc = (f32x4){0.f, 0.f, 0.f, 0.f};
#pragma unroll
            for (int ks = 0; ks < 2; ++ks) { const bf16x8 a = *(const LAS bf16x8*)(lds + HG_PB + (16 * tt + fr) * 144 + (32 * ks + 8 * fq) * 2); acc = __builtin_amdgcn_mfma_f32_16x16x32_bf16(a, b1[ks], acc, 0, 0, 0); }
#pragma unroll
            for (int ks = 0; ks < 4; ++ks) { const bf16x8 a = *(const LAS bf16x8*)(lds + HG_Q1 + (16 * tt + fr) * 272 + (32 * ks + 8 * fq) * 2); acc = __builtin_amdgcn_mfma_f32_16x16x32_bf16(a, b2[ks], acc, 0, 0, 0); }
#pragma unroll
            for (int r = 0; r < 4; ++r) OB[(16 * tt + 4 * fq + r) * 132 + 16 * wave + fr] = acc[r];
        }
    }
    __syncthreads();
    {
        const int es = dseg; const LAS float* OB = (const LAS float*)(lds + HG_GB);
        float o[16]; float ss = 0.f;
#pragma unroll
        for (int i = 0; i < 16; ++i) { o[i] = OB[t * 132 + 16 * es + i]; ss += o[i] * o[i]; }
        ss += __shfl_xor(ss, 1); ss += __shfl_xor(ss, 2); ss += __shfl_xor(ss, 4);
        const float rstd = rsqrtf(ss * (1.0f / 128.0f) + NORM_EPS);
        float rv[16];
#pragma unroll
        for (int i = 0; i < 16; ++i) { const float ga = i < 8 ? bfx(g0, i) : bfx(g1, i - 8); rv[i] = o[i] * (rstd * OP8_SCALE) * norm_g[16 * es + i] * siluf_(ga); }
        *(u32x4*)(REC + (size_t)(c * 64 + t) * 1024 + h * 128 + 16 * es) = (u32x4){pack4_fp8(rv[0], rv[1], rv[2], rv[3]), pack4_fp8(rv[4], rv[5], rv[6], rv[7]), pack4_fp8(rv[8], rv[9], rv[10], rv[11]), pack4_fp8(rv[12], rv[13], rv[14], rv[15])};
    }
    __syncthreads();
}

constexpr int SC_KT = 0, SC_SB = 36864, SC_SPITCH = 132;
__device__ __forceinline__ unsigned pk_f16(float a, float b) { return __builtin_bit_cast(unsigned, __builtin_amdgcn_cvt_pkrtz(a, b)); }
__device__ __forceinline__ void score_flush(LAS unsigned char* lds, unsigned short* SCORES, unsigned short* SEGMAX, int t0, int kt, int tid) {
    const LAS float* sb = (const LAS float*)(lds + SC_SB + (kt & 1) * (32 * SC_SPITCH * 4));
    const int row = tid >> 4, seg = tid & 15;
    const f32x4 a = *(const LAS f32x4*)(sb + row * SC_SPITCH + seg * 8), b = *(const LAS f32x4*)(sb + row * SC_SPITCH + seg * 8 + 4);
    unsigned short* dst = SCORES + (size_t)(t0 + row) * S + kt * 128 + seg * 8;
    *(u32x4*)dst = (u32x4){pk_f16(a[0], a[1]), pk_f16(a[2], a[3]), pk_f16(b[0], b[1]), pk_f16(b[2], b[3])};
    const float mx = fmaxf(fmaxf(fmaxf(a[0], a[1]), fmaxf(a[2], a[3])), fmaxf(fmaxf(b[0], b[1]), fmaxf(b[2], b[3])));
    SEGMAX[(size_t)(t0 + row) * 2048 + kt * 16 + seg] = (unsigned short)(pk_f16(mx, mx) & 0xffffu);
}
__device__ __forceinline__ void score_block(LAS unsigned char* lds, const bf16_t* PROJ, const bf16_t* KI, unsigned short* SCORES, unsigned short* SEGMAX, int qb, int kt0, int kt1, int tid, int wave, int lane) {
    const int t0 = qb * 32;
    const int r = lane & 31, hh = lane >> 5;
    bf16x8 Af[2][4]; float wv[2][16]; f32x2 wv2[2][8];
#pragma unroll
    for (int p = 0; p < 2; ++p) {
        const int tq = t0 + 4 * wave + 2 * p + (r >> 4); const bf16_t* qrow = PROJ + (size_t)tq * DINP + CQI + (r & 15) * 64 + 8 * hh;
#pragma unroll
        for (int ks = 0; ks < 4; ++ks) Af[p][ks] = *(const bf16x8*)(qrow + 16 * ks);
#pragma unroll
        for (int qq = 0; qq < 2; ++qq) {
            const bf16_t* wp = PROJ + (size_t)(t0 + 4 * wave + 2 * p + qq) * DINP + CWI + 4 * hh;
            const u32x2 wa = *(const u32x2*)wp, wb = *(const u32x2*)(wp + 8);
            wv[p][8 * qq + 0] = bf_lo(wa.x) * (1.0f / 32.0f); wv[p][8 * qq + 1] = bf_hi(wa.x) * (1.0f / 32.0f); wv[p][8 * qq + 2] = bf_lo(wa.y) * (1.0f / 32.0f); wv[p][8 * qq + 3] = bf_hi(wa.y) * (1.0f / 32.0f);
            wv[p][8 * qq + 4] = bf_lo(wb.x) * (1.0f / 32.0f); wv[p][8 * qq + 5] = bf_hi(wb.x) * (1.0f / 32.0f); wv[p][8 * qq + 6] = bf_lo(wb.y) * (1.0f / 32.0f); wv[p][8 * qq + 7] = bf_hi(wb.y) * (1.0f / 32.0f);
        }
#pragma unroll
        for (int i = 0; i < 8; ++i) wv2[p][i] = (f32x2){wv[p][2 * i], wv[p][2 * i + 1]};
    }
    const u32x2 tagsw = __builtin_amdgcn_permlane32_swap(0u, 1u, false, false); const int qsel = (int)tagsw[0];
    u32x4 stg[2];
#pragma unroll
    for (int i = 0; i < 2; ++i) { const int q = tid + 512 * i; stg[i] = *(const u32x4*)(KI + (size_t)(kt0 * 128 + (q >> 3)) * 64 + (q & 7) * 8); }
#pragma unroll
    for (int i = 0; i < 2; ++i) { const int q = tid + 512 * i; *(LAS u32x4*)(lds + SC_KT + (kt0 & 1) * 18432 + (q >> 3) * 144 + (q & 7) * 16) = stg[i]; }
    __syncthreads();
    for (int kt = kt0; kt < kt1; ++kt) {
        const LAS unsigned char* buf = lds + SC_KT + (kt & 1) * 18432;
        LAS float* sb = (LAS float*)(lds + SC_SB + (kt & 1) * (32 * SC_SPITCH * 4));
        if (kt + 1 < kt1) {
#pragma unroll
            for (int i = 0; i < 2; ++i) { const int q = tid + 512 * i; stg[i] = *(const u32x4*)(KI + (size_t)((kt + 1) * 128 + (q >> 3)) * 64 + (q & 7) * 8); }
        }
        __builtin_amdgcn_sched_barrier(0);
        if (kt > kt0) score_flush(lds, SCORES, SEGMAX, t0, kt - 1, tid);
        {
        f32x16 accP[2], accC[2];
#define SC_MFMA(cb) do { bf16x8 Bf[4]; _Pragma("unroll") for (int ks = 0; ks < 4; ++ks) Bf[ks] = *(const LAS bf16x8*)(buf + (32 * (cb) + r) * 144 + (16 * ks + 8 * hh) * 2); \
            _Pragma("unroll") for (int p = 0; p < 2; ++p) { _Pragma("unroll") for (int i = 0; i < 16; ++i) accC[p][i] = 0.f; \
                _Pragma("unroll") for (int ks = 0; ks < 4; ++ks) accC[p] = __builtin_amdgcn_mfma_f32_32x32x16_bf16(Af[p][ks], Bf[ks], accC[p], 0, 0, 0); } } while (0)
#define SC_RED(acc, cb) do { _Pragma("unroll") for (int p = 0; p < 2; ++p) { f32x2 s0 = {0.f, 0.f}, s1 = {0.f, 0.f}; \
            _Pragma("unroll") for (int reg = 0; reg < 8; reg += 2) { const f32x2 r0 = {relu_i(acc[p][reg]), relu_i(acc[p][reg + 1])}; const f32x2 r1 = {relu_i(acc[p][reg + 8]), relu_i(acc[p][reg + 9])}; \
                s0 = __builtin_elementwise_fma(wv2[p][reg >> 1], r0, s0); s1 = __builtin_elementwise_fma(wv2[p][4 + (reg >> 1)], r1, s1); } \
            const float p0 = s0[0] + s0[1], p1 = s1[0] + s1[1]; \
            const u32x2 sw = __builtin_amdgcn_permlane32_swap(__float_as_uint(p0), __float_as_uint(p1), false, false); \
            sb[(4 * wave + 2 * p + qsel) * SC_SPITCH + 32 * (cb) + r] = __uint_as_float(sw[0]) + __uint_as_float(sw[1]); } } while (0)
#define SC_INTERLEAVE() do { _Pragma("unroll") for (int i = 0; i < 8; ++i) { __builtin_amdgcn_sched_group_barrier(0x008, 1, 0); __builtin_amdgcn_sched_group_barrier(0x002, 8, 0); } } while (0)
        SC_MFMA(0);
        accP[0] = accC[0]; accP[1] = accC[1]; SC_MFMA(1); SC_RED(accP, 0); SC_INTERLEAVE();
        accP[0] = accC[0]; accP[1] = accC[1]; SC_MFMA(2); SC_RED(accP, 1); SC_INTERLEAVE();
        accP[0] = accC[0]; accP[1] = accC[1]; SC_MFMA(3); SC_RED(accP, 2); SC_INTERLEAVE();
        SC_RED(accC, 3);
#undef SC_MFMA
#undef SC_RED
#undef SC_INTERLEAVE
        }
        if (kt + 1 < kt1) {
#pragma unroll
            for (int i = 0; i < 2; ++i) { const int q = tid + 512 * i; *(LAS u32x4*)(lds + SC_KT + ((kt + 1) & 1) * 18432 + (q >> 3) * 144 + (q & 7) * 16) = stg[i]; }
        }
        __syncthreads();
    }
    score_flush(lds, SCORES, SEGMAX, t0, kt1 - 1, tid);
    __syncthreads();
}

template <int NV, bool EXACT>
__device__ __forceinline__ float wave_kth(const float (&v)[NV], int K) {
    const float NINF = -__builtin_inff();
    float mx = NINF, mn = __builtin_inff();
#pragma unroll
    for (int j = 0; j < NV; ++j) { mx = fmaxf(mx, v[j]); mn = fminf(mn, v[j] == NINF ? __builtin_inff() : v[j]); }
    mx = wave_max(mx); mn = -wave_max(-mn);
    int c = 0;
#pragma unroll
    for (int j = 0; j < NV; ++j) c += __popcll(__ballot(v[j] >= mx));
    if (c >= K) return mx;
    float lo = mn, hi = mx, tau = mn;
    for (int it = 0; it < 64; ++it) {
        const float mid = 0.5f * (lo + hi);
        if (!(mid > lo && mid < hi)) { tau = lo; break; }
        c = 0;
#pragma unroll
        for (int j = 0; j < NV; ++j) c += __popcll(__ballot(v[j] >= mid));
        if (c == K || (!EXACT && c > K && c <= K + (K >> 2))) { tau = mid; break; }
        if (c > K) lo = mid; else hi = mid;
        tau = lo;
    }
    return tau;
}
__device__ __forceinline__ float wave_kth16(const float (&v)[16], int K) { return wave_kth<16, true>(v, K); }
__device__ __forceinline__ int lanes_below(unsigned long long mask) { return (int)__builtin_amdgcn_mbcnt_hi((unsigned)(mask >> 32), __builtin_amdgcn_mbcnt_lo((unsigned)mask, 0u)); }
__device__ __forceinline__ float h2f(unsigned short h) { return (float)__builtin_bit_cast(_Float16, h); }
__device__ __forceinline__ float h2f_lo(unsigned u) { return h2f((unsigned short)(u & 0xffffu)); }
__device__ __forceinline__ float h2f_hi(unsigned u) { return h2f((unsigned short)(u >> 16)); }
__device__ __forceinline__ unsigned ge_mask8(const u32x4& v, unsigned T16) {
    unsigned m8 = 0;
#pragma unroll
    for (int w = 0; w < 4; ++w) { const unsigned vw_ = v[w];
        const s16x2 d = __builtin_elementwise_sub_sat(__builtin_bit_cast(s16x2, vw_), __builtin_bit_cast(s16x2, T16));
        const unsigned mm = ~__builtin_bit_cast(unsigned, d); m8 |= (((mm >> 15) & 1u) | ((mm >> 30) & 2u)) << (2 * w); }
    return m8;
}
__device__ __forceinline__ int append_bits(LAS int* list, int cnt, unsigned m8, int base) {
    for (;;) { const bool has = m8 != 0u; const unsigned long long mask = __ballot(has); if (!mask) break;
        const int pos = cnt + lanes_below(mask);
        if (has) { const int k = __builtin_ctz(m8); m8 &= m8 - 1u; if (pos < 1024) list[pos] = base + k; }
        cnt += __popcll(mask); }
    return cnt;
}
__device__ __forceinline__ int append_keys(LAS int* list, int cnt, unsigned m8, int base, const u32x4& v) {
    for (;;) { const bool has = m8 != 0u; const unsigned long long mask = __ballot(has); if (!mask) break;
        const int pos = cnt + lanes_below(mask);
        if (has) { const int k = __builtin_ctz(m8); m8 &= m8 - 1u;
            const unsigned dw = (k & 4) ? ((k & 2) ? v.w : v.z) : ((k & 2) ? v.y : v.x); const unsigned h = (k & 1) ? (dw >> 16) : (dw & 0xffffu);
            if (pos < 1024) list[pos] = (int)((h << 16) | (unsigned)(base + k)); }
        cnt += __popcll(mask); }
    return cnt;
}
__device__ __forceinline__ void select_row(LAS unsigned char* wl, const unsigned short* SCORES, const unsigned short* SEGMAX, int t, int lane) {
    LAS int* selw = (LAS int*)wl; LAS int* segl = (LAS int*)(wl + 1024); LAS int* cidx = (LAS int*)(wl + 5120);
    const float NINF = -__builtin_inff();
    const unsigned short* row = SCORES + (size_t)t * S; const int n = t + 1;
    float c[16]; int N;
    if (n <= 1024) {
#pragma unroll
        for (int j = 0; j < 16; ++j) { const int i = lane + 64 * j; c[j] = i < n ? h2f(row[i]) : NINF; }
        N = -1;
    } else {
        const int m = n >> 4; float s[16];
#pragma unroll
        for (int j = 0; j < 16; ++j) { const int i = lane + 64 * j; s[j] = i < m ? h2f(row[16 * i + 7]) : NINF; }
        const u32x4 NEG = (u32x4){0xfc00fc00u, 0xfc00fc00u, 0xfc00fc00u, 0xfc00fc00u};
        const unsigned short* smrow = SEGMAX + (size_t)t * 2048; const int nseg = (t >> 3) + 1;
        u32x4 sv[4];
#pragma unroll
        for (int u = 0; u < 4; ++u) { const int e8 = 8 * (lane + 64 * u); sv[u] = (e8 < nseg) ? *(const u32x4*)(smrow + e8) : NEG; }
        int K = 26, cnt = 0;
        for (;;) {
            const float tlo = (K >= m) ? NINF : wave_kth<16, false>(s, K);
            cnt = 0;
            const int nq = (n + 511) >> 9;
            if (tlo > 0.f) {
                const unsigned T16 = pk_f16(tlo, tlo);
                int ns = 0;
                {
#pragma unroll
                    for (int u = 0; u < 4; ++u) { const int e8 = 8 * (lane + 64 * u); unsigned m8 = ge_mask8(sv[u], T16);
                        const int nv = nseg - e8; if (nv < 8) m8 &= nv > 0 ? ((1u << nv) - 1u) : 0u;
                        ns = append_bits(segl, ns, m8, e8); }
                }
                if (ns > 1024) ns = 1024;
                for (int j0 = 0; j0 < ns; j0 += 512) {
                    u32x4 v[8]; int sg[8];
#pragma unroll
                    for (int u = 0; u < 8; ++u) { const int i = j0 + lane + 64 * u; sg[u] = i < ns ? segl[i] : -1; v[u] = sg[u] >= 0 ? *(const u32x4*)(row + 8 * sg[u]) : NEG; }
#pragma unroll
                    for (int u = 0; u < 8; ++u) { const int e = 8 * sg[u]; unsigned m8 = sg[u] >= 0 ? ge_mask8(v[u], T16) : 0u;
                        const int nv = t + 1 - e; if (nv < 8) m8 &= nv > 0 ? ((1u << nv) - 1u) : 0u;
                        cnt = append_keys(cidx, cnt, m8, e, v[u]); }
                }
            } else {
                for (int q0 = 0; q0 < nq; q0 += 4) {
                    u32x4 v[4];
#pragma unroll
                    for (int u = 0; u < 4; ++u) { const int e = 8 * (lane + 64 * (q0 + u)); v[u] = (e <= t) ? *(const u32x4*)(row + e) : (u32x4){0xfc00fc00u, 0xfc00fc00u, 0xfc00fc00u, 0xfc00fc00u}; }
#pragma unroll
                    for (int u = 0; u < 4; ++u) { const int e = 8 * (lane + 64 * (q0 + u));
#pragma unroll
                        for (int k = 0; k < 8; ++k) { const float x = (k & 1) ? h2f_hi(v[u][k >> 1]) : h2f_lo(v[u][k >> 1]);
                            const bool pred = (e + k <= t) && (x >= tlo); const unsigned long long mask = __ballot(pred);
                            if (mask) { const int pos = cnt + lanes_below(mask); const unsigned hb = (k & 1) ? (v[u][k >> 1] >> 16) : (v[u][k >> 1] & 0xffffu);
                                if (pred && pos < 1024) cidx[pos] = (int)((hb << 16) | (unsigned)(e + k)); cnt += __popcll(mask); } } }
                }
            }
            if (cnt >= 256 || K >= m) break;
            K *= 2;
        }
        N = cnt < 1024 ? cnt : 1024;
#pragma unroll
        for (int j = 0; j < 16; ++j) { const int i = lane + 64 * j; c[j] = i < N ? h2f((unsigned short)((unsigned)cidx[i] >> 16)) : NINF; }
    }
    float tau;
    if (N >= 0 && N <= 512) { const float c8[8] = {c[0], c[1], c[2], c[3], c[4], c[5], c[6], c[7]}; tau = wave_kth<8, true>(c8, 256); }
    else tau = wave_kth16(c, 256);
    int base = 0;
#pragma unroll
    for (int j = 0; j < 16; ++j) { const bool pred = c[j] >= tau; const unsigned long long mask = __ballot(pred);
        if (mask) { const int pos = base + lanes_below(mask); if (pred && pos < 256) selw[pos] = (N < 0) ? (lane + 64 * j) : (cidx[lane + 64 * j] & 0xffff); base += __popcll(mask); } }
}

__device__ __forceinline__ void attn_query(LAS unsigned char* wl, const bf16_t* PROJ, const unsigned char* KC, const unsigned char* VC, unsigned char* ATT, int t, int lane) {
    LAS int* selw = (LAS int*)wl; LAS float* L = (LAS float*)(wl + 1024);
    const int nsel = t < 255 ? t + 1 : 256;
    const int fr = lane & 15, fq = lane >> 4;
    constexpr float QS = 8.0f;
    long qh[2][4], ql[2][4];
#pragma unroll
    for (int g = 0; g < 2; ++g)
#pragma unroll
        for (int ks = 0; ks < 4; ++ks) {
            u32x4 z = (u32x4){0u, 0u, 0u, 0u};
            if (fr < 4) z = *(const u32x4*)(PROJ + (size_t)t * DINP + CQ + (4 * g + fr) * 128 + 32 * ks + 8 * fq);
            float qv[8], rv[8];
#pragma unroll
            for (int e = 0; e < 4; ++e) { qv[2 * e] = bf_lo(z[e]) * QS; qv[2 * e + 1] = bf_hi(z[e]) * QS; }
            const unsigned h0 = pack4_fp8(qv[0], qv[1], qv[2], qv[3]), h1 = pack4_fp8(qv[4], qv[5], qv[6], qv[7]);
            rv[0] = qv[0] - __builtin_amdgcn_cvt_f32_fp8((int)h0, 0); rv[1] = qv[1] - __builtin_amdgcn_cvt_f32_fp8((int)h0, 1); rv[2] = qv[2] - __builtin_amdgcn_cvt_f32_fp8((int)h0, 2); rv[3] = qv[3] - __builtin_amdgcn_cvt_f32_fp8((int)h0, 3);
            rv[4] = qv[4] - __builtin_amdgcn_cvt_f32_fp8((int)h1, 0); rv[5] = qv[5] - __builtin_amdgcn_cvt_f32_fp8((int)h1, 1); rv[6] = qv[6] - __builtin_amdgcn_cvt_f32_fp8((int)h1, 2); rv[7] = qv[7] - __builtin_amdgcn_cvt_f32_fp8((int)h1, 3);
            const unsigned l0 = pack4_fp8(rv[0] * 16.0f, rv[1] * 16.0f, rv[2] * 16.0f, rv[3] * 16.0f), l1 = pack4_fp8(rv[4] * 16.0f, rv[5] * 16.0f, rv[6] * 16.0f, rv[7] * 16.0f);
            qh[g][ks] = (long)(((unsigned long long)h1 << 32) | h0); ql[g][ks] = (long)(((unsigned long long)l1 << 32) | l0);
        }
    const float scale = 0.08838834764831845f / QS;
    const int nkt = (nsel + 15) >> 4;
    {
        LAS unsigned char* KT = wl + 9216;
        const int q4_ = lane >> 4, l15_ = lane & 15;
        u32x4 kw[3][4];
#define QK_LOAD(buf, kt) do { _Pragma("unroll") for (int u = 0; u < 4; ++u) { const unsigned off_ = (unsigned)selw[16 * (kt) + 4 * u + q4_] * 256u + 16u * (unsigned)l15_; kw[buf][u] = *(const u32x4*)((const char*)KC + off_); } } while (0)
#define QK_COMP(buf, kt) do { _Pragma("unroll") for (int u = 0; u < 4; ++u) *(LAS u32x4*)(KT + (4 * u + q4_) * 272 + 16 * l15_) = kw[buf][u];     \
        _Pragma("unroll") for (int g = 0; g < 2; ++g) { f32x4 acch = (f32x4){0.f, 0.f, 0.f, 0.f}, accl = (f32x4){0.f, 0.f, 0.f, 0.f}; \
            _Pragma("unroll") for (int ks = 0; ks < 4; ++ks) { const long kf_ = *(const LAS long*)(KT + fr * 272 + g * 128 + 32 * ks + 8 * fq); \
                acch = __builtin_amdgcn_mfma_f32_16x16x32_fp8_fp8(qh[g][ks], kf_, acch, 0, 0, 0); accl = __builtin_amdgcn_mfma_f32_16x16x32_fp8_fp8(ql[g][ks], kf_, accl, 0, 0, 0); } \
            if (fq == 0) { _Pragma("unroll") for (int r = 0; r < 4; ++r) L[(4 * g + r) * 256 + 16 * (kt) + fr] = (16 * (kt) + fr < nsel) ? (acch[r] + accl[r] * 0.0625f) * scale : -__builtin_inff(); } } } while (0)
        QK_LOAD(0, 0); if (1 < nkt) QK_LOAD(1, 1);
        for (int kt = 0; kt < nkt; kt += 3) {
            if (kt + 2 < nkt) QK_LOAD(2, kt + 2);
            __builtin_amdgcn_sched_barrier(0);
            QK_COMP(0, kt);
            if (kt + 1 < nkt) { if (kt + 3 < nkt) QK_LOAD(0, kt + 3); __builtin_amdgcn_sched_barrier(0); QK_COMP(1, kt + 1); }
            if (kt + 2 < nkt) { if (kt + 4 < nkt) QK_LOAD(1, kt + 4); __builtin_amdgcn_sched_barrier(0); QK_COMP(2, kt + 2); }
        }
#undef QK_LOAD
#undef QK_COMP
        if (fq == 0) { for (int kt = nkt; kt < 16; ++kt) {
#pragma unroll
            for (int r = 0; r < 8; ++r) L[r * 256 + 16 * kt + fr] = -__builtin_inff(); } }
    }
    float p[8][4];
#pragma unroll
    for (int hd = 0; hd < 8; ++hd) { float m = -__builtin_inff();
#pragma unroll
        for (int i = 0; i < 4; ++i) { p[hd][i] = L[hd * 256 + 4 * lane + i]; m = fmaxf(m, p[hd][i]); }
        m = wave_max(m); float s = 0.f;
#pragma unroll
        for (int i = 0; i < 4; ++i) { p[hd][i] = __expf(p[hd][i] - m); s += p[hd][i]; }
        s = 1.0f / wave_sum(s);
#pragma unroll
        for (int i = 0; i < 4; ++i) p[hd][i] *= s; }
    constexpr float PS = 256.0f;
    LAS unsigned* Ph = (LAS unsigned*)(wl + 1024); LAS unsigned* Pl = (LAS unsigned*)(wl + 1024 + 2048);
#pragma unroll
    for (int hd = 0; hd < 8; ++hd) {
        const float a0 = p[hd][0] * PS, a1 = p[hd][1] * PS, a2 = p[hd][2] * PS, a3 = p[hd][3] * PS;
        const unsigned h = pack4_fp8(a0, a1, a2, a3);
        const unsigned l = pack4_fp8(a0 - __builtin_amdgcn_cvt_f32_fp8((int)h, 0), a1 - __builtin_amdgcn_cvt_f32_fp8((int)h, 1), a2 - __builtin_amdgcn_cvt_f32_fp8((int)h, 2), a3 - __builtin_amdgcn_cvt_f32_fp8((int)h, 3));
        Ph[hd * 64 + lane] = h; Pl[hd * 64 + lane] = l;
    }
    LAS unsigned char* VT = wl + 9216;
    const int ii = lane & 15, kq = lane >> 4;
    f32x4 acc[16];
#pragma unroll
    for (int nt = 0; nt < 16; ++nt) acc[nt] = (f32x4){0.f, 0.f, 0.f, 0.f};
    const int nch = (nsel + 15) >> 4;
    u32x4 vw[3][4];
#define PV_LOAD(buf, c) do { _Pragma("unroll") for (int u = 0; u < 4; ++u) { const unsigned off_ = (unsigned)selw[16 * (c) + 4 * u + kq] * 256u + 16u * (unsigned)ii; vw[buf][u] = *(const u32x4*)((const char*)VC + off_); } } while (0)
#define PV_COMP(buf, c) do { _Pragma("unroll") for (int u = 0; u < 4; ++u) { LAS u32x2* d_ = (LAS u32x2*)(VT + (16 * ((c) & 1) + 4 * u + kq) * 264 + 16 * ii); d_[0] = (u32x2){vw[buf][u].x, vw[buf][u].y}; d_[1] = (u32x2){vw[buf][u].z, vw[buf][u].w}; } \
        if (((c) & 1) || (c) == nch - 1) { \
            if (!((c) & 1)) { _Pragma("unroll") for (int u = 0; u < 4; ++u) { LAS u32x2* d_ = (LAS u32x2*)(VT + (16 + 4 * u + kq) * 264 + 16 * ii); d_[0] = (u32x2){0u, 0u}; d_[1] = (u32x2){0u, 0u}; } } \
            long pa[2]; _Pragma("unroll") for (int g = 0; g < 2; ++g) { const int po_ = (g * 4 + (ii & 3)) * 256 + 32 * ((c) >> 1) + 8 * kq;     \
                const long h_ = *(const LAS long*)((const LAS unsigned char*)Ph + po_ + ((ii & 4) ? 2048 : 0)); pa[g] = ii < 8 ? h_ : 0l; } \
            _Pragma("unroll") for (int nt = 0; nt < 16; ++nt) { const v2i32 t_ = __builtin_amdgcn_ds_read_tr8_b64_v2i32((LAS v2i32*)(VT + (8 * kq + (ii >> 1)) * 264 + 16 * nt + 8 * (ii & 1))); \
                const long b_ = __builtin_bit_cast(long, t_); \
                acc[nt] = __builtin_amdgcn_mfma_f32_16x16x32_fp8_fp8(pa[nt >> 3], b_, acc[nt], 0, 0, 0); } } } while (0)
    PV_LOAD(0, 0); if (1 < nch) PV_LOAD(1, 1);
    for (int c = 0; c < nch; c += 3) {
        if (c + 2 < nch) PV_LOAD(2, c + 2);
        __builtin_amdgcn_sched_barrier(0);
        PV_COMP(0, c);
        if (c + 1 < nch) { if (c + 3 < nch) PV_LOAD(0, c + 3); __builtin_amdgcn_sched_barrier(0); PV_COMP(1, c + 1); }
        if (c + 2 < nch) { if (c + 4 < nch) PV_LOAD(1, c + 4); __builtin_amdgcn_sched_barrier(0); PV_COMP(2, c + 2); }
    }
#undef PV_LOAD
#undef PV_COMP
    LAS float* OB = (LAS float*)(wl + 1024 + 4096);
    LAS float* OB2 = (LAS float*)(wl + 1024);
    if (kq < 2) {
        LAS float* ob = kq == 0 ? OB : OB2;
#pragma unroll
        for (int nt = 0; nt < 16; ++nt)
#pragma unroll
            for (int r = 0; r < 4; ++r) ob[(4 * (nt >> 3) + r) * 128 + 16 * (nt & 7) + ii] = acc[nt][r];
    }
    {
        const f32x4 a0 = *(const LAS f32x4*)(OB + 16 * lane) + *(const LAS f32x4*)(OB2 + 16 * lane), a1 = *(const LAS f32x4*)(OB + 16 * lane + 4) + *(const LAS f32x4*)(OB2 + 16 * lane + 4),
                    a2 = *(const LAS f32x4*)(OB + 16 * lane + 8) + *(const LAS f32x4*)(OB2 + 16 * lane + 8), a3 = *(const LAS f32x4*)(OB + 16 * lane + 12) + *(const LAS f32x4*)(OB2 + 16 * lane + 12);
        const f32x4 b0 = a0 * (OP8_SCALE / PS), b1 = a1 * (OP8_SCALE / PS), b2 = a2 * (OP8_SCALE / PS), b3 = a3 * (OP8_SCALE / PS);
        *(u32x4*)(ATT + (size_t)t * 1024 + 16 * lane) = (u32x4){pack4_fp8(b0[0], b0[1], b0[2], b0[3]), pack4_fp8(b1[0], b1[1], b1[2], b1[3]), pack4_fp8(b2[0], b2[1], b2[2], b2[3]), pack4_fp8(b3[0], b3[1], b3[2], b3[3])};
    }
}


__device__ __forceinline__ void convert_item8(const float* __restrict__ W, int K, int N, int ld, unsigned char* WT, int mode, int item, int lane, LAS unsigned char* scr) {
    const int nblk = N >> 6; const int kb = item / nblk, nb = item - kb * nblk; const int k0 = kb * 256, n0 = nb * 64;
    const int c4 = lane & 15, kr = lane >> 4;
    const float* src = W + (size_t)(k0 + 4 * kr) * ld + n0 + 4 * c4;
#pragma unroll 4
    for (int i = 0; i < 16; ++i) {
        f32x4 v[4];
#pragma unroll
        for (int r = 0; r < 4; ++r) v[r] = __builtin_nontemporal_load((const f32x4*)(src + (size_t)(16 * i + r) * ld));
        const int kk = 16 * i + 4 * kr;
#pragma unroll
        for (int e = 0; e < 4; ++e) *(LAS unsigned*)(scr + (4 * c4 + e) * 272 + kk) = pack4_fp8(v[0][e] * W8_SCALE, v[1][e] * W8_SCALE, v[2][e] * W8_SCALE, v[3][e] * W8_SCALE);
    }
    LDS_WAIT(); asm volatile("" ::: "memory");
#pragma unroll 4
    for (int j = 0; j < 16; ++j) {
        const int q = j * 64 + lane, n = q >> 4, ch = q & 15;
        const u32x4 v = *(const LAS u32x4*)(scr + n * 272 + ch * 16);
        *(u32x4*)(WT + (size_t)dest_row(mode, n0 + n) * K + k0 + ch * 16) = v;
    }
    LDS_WAIT(); asm volatile("" ::: "memory");
}

struct Conv8Job { const float* W; unsigned char* WT; int N; int mode; size_t w_estride, wt_estride; int items_per_e; };
constexpr int C8_PITCH = 272, C8_IMG = 256 * C8_PITCH;
__device__ __forceinline__ void conv8_load(const Conv8Job& jb, int item, int h, int wave, int lane, f32x4 (&v)[16]) {
    const int e = item / jb.items_per_e, r = item - e * jb.items_per_e; const int nblk = jb.N >> 8; const int kb = r / nblk, nb = r - kb * nblk;
    const float* src = jb.W + (size_t)e * jb.w_estride + (size_t)(kb * 256 + 32 * wave + 16 * h) * jb.N + nb * 256 + 4 * lane;
#pragma unroll
    for (int i = 0; i < 16; ++i) v[i] = __builtin_nontemporal_load((const f32x4*)(src + (size_t)i * jb.N));
}
__device__ __forceinline__ void conv8_to_lds(LAS unsigned char* img, int h, int wave, int lane, const f32x4 (&v)[16]) {
#pragma unroll
    for (int e = 0; e < 4; ++e) { u32x4 w;
#pragma unroll
        for (int g = 0; g < 4; ++g) w[g] = pack4_fp8(v[4 * g][e] * W8_SCALE, v[4 * g + 1][e] * W8_SCALE, v[4 * g + 2][e] * W8_SCALE, v[4 * g + 3][e] * W8_SCALE);
        *(LAS u32x4*)(img + (4 * lane + e) * C8_PITCH + 32 * wave + 16 * h) = w; }
}
__device__ __forceinline__ void conv8_store(const Conv8Job& jb, int item, const LAS unsigned char* img, int tid) {
    const int e = item / jb.items_per_e, r = item - e * jb.items_per_e; const int nblk = jb.N >> 8; const int kb = r / nblk, nb = r - kb * nblk;
    unsigned char* dst = jb.WT + (size_t)e * jb.wt_estride + kb * 256;
#pragma unroll
    for (int j = 0; j < 8; ++j) { const int q = j * 512 + tid, n = q >> 4, ch = q & 15;
        __builtin_nontemporal_store(*(const LAS u32x4*)(img + n * C8_PITCH + ch * 16), (u32x4*)(dst + (size_t)dest_row(jb.mode, nb * 256 + n) * 2048 + ch * 16)); }
}
__device__ __forceinline__ void conv8_run(LAS unsigned char* lds, const Conv8Job& jb, int n_items, int wg, int G, int tid, int wave, int lane) {
    if (wg >= n_items) return;
    f32x4 a[16], b[16]; int par = 0;
    conv8_load(jb, wg, 0, wave, lane, a); conv8_load(jb, wg, 1, wave, lane, b);
    for (int it = wg; it < n_items; it += G, par ^= 1) {
        LAS unsigned char* img = lds + par * C8_IMG;
        const int nx = (it + G < n_items) ? it + G : it;
        conv8_to_lds(img, 0, wave, lane, a); __builtin_amdgcn_sched_barrier(0);
        conv8_load(jb, nx, 0, wave, lane, a); __builtin_amdgcn_sched_barrier(0);
        conv8_to_lds(img, 1, wave, lane, b); __builtin_amdgcn_sched_barrier(0);
        conv8_load(jb, nx, 1, wave, lane, b); __builtin_amdgcn_sched_barrier(0);
        __syncthreads();
        conv8_store(jb, it, img, tid);
    }
    __syncthreads();
}

__global__ void __launch_bounds__(NTHR, 2) fwd_kernel(Args args) {
    extern __shared__ __attribute__((aligned(16))) unsigned char lds_raw[];
    LAS unsigned char* lds = (LAS unsigned char*)lds_raw;
    volatile LAS unsigned* MISC = (volatile LAS unsigned*)(lds + LDS_MISC);
    const int tid = threadIdx.x, lane = tid & 63, wave = __builtin_amdgcn_readfirstlane(tid >> 6);
    const int G = gridDim.x, wg = blockIdx.x;
    unsigned char* ws = args.ws;
    unsigned* ctl = (unsigned*)(ws + WS_CTL);
    const int lo = args.ph_lo, hi = args.ph_hi;
    const float* x = (const float*)args.in[0]; const float* cvec = (const float*)args.in[1]; const int* positions = (const int*)args.in[2];
    const float* w_ada = (const float*)args.in[3]; const float* b_ada = (const float*)args.in[4]; const float* norm1_g = (const float*)args.in[5];
    const float* w_in = (const float*)args.in[6]; const float* idx_knorm_g = (const float*)args.in[7]; const float* idx_knorm_b = (const float*)args.in[8];
    const float* lb_logits = (const float*)args.in[9]; const float* hgrn_norm_g = (const float*)args.in[10];
    const float* w_proj_att = (const float*)args.in[11]; const float* w_proj_hgrn = (const float*)args.in[12]; const float* w_out = (const float*)args.in[13];
    const float* norm2_g = (const float*)args.in[14]; const float* w_router = (const float*)args.in[15]; const float* b_router = (const float*)args.in[16];
    const float* w1 = (const float*)args.in[17]; const float* b1 = (const float*)args.in[18]; const float* w2 = (const float*)args.in[19]; const float* b2 = (const float*)args.in[20];
    const float* final_g = (const float*)args.in[21];
    float* out = args.out;
    float* MOD = (float*)(ws + WS_MOD); int* TOPE = (int*)(ws + WS_TOPE); float* GATE = (float*)(ws + WS_GATE); int* SLOT = (int*)(ws + WS_SLOT);
    bf16_t* WIN_T = (bf16_t*)(ws + WS_WIN_T); bf16_t* WA_T = (bf16_t*)(ws + WS_WA_T); bf16_t* WH_T = (bf16_t*)(ws + WS_WH_T); bf16_t* WO_T = (bf16_t*)(ws + WS_WO_T);
    unsigned char* WIN_T8 = ws + WS_WIN_T + 8 * MiB;
    unsigned char* HA8 = ws + WS_SCORES;
    unsigned char* W1_T = ws + WS_W1_T; unsigned char* W2_T = ws + WS_W2_T;
    bf16_t* HB = (bf16_t*)(ws + WS_H); bf16_t* PROJ = (bf16_t*)(ws + WS_PROJ);
    bf16_t* DELTA = (bf16_t*)(ws + WS_ATT);
    unsigned char* ACT = ws + WS_ACT; bf16_t* YB = (bf16_t*)(ws + WS_YB);
    int* TOKS = (int*)(ws + WS_TOKS);
    unsigned char* H8 = ws + WS_H;
    bf16_t* KI = (bf16_t*)(ws + WS_KI); unsigned char* KC = ws + WS_KC; unsigned char* VC = ws + WS_VC;
    bf16_t* ST = (bf16_t*)(ws + WS_ST); float* DC = (float*)(ws + WS_DC);
    unsigned char* ATT = ws + WS_ATT; unsigned char* REC = ATT + (size_t)S * 1024;        bf16_t* MERGED = (bf16_t*)(ws + WS_MERGED); unsigned short* SCORES = (unsigned short*)(ws + WS_SCORES);
    unsigned short* SEGMAX = (unsigned short*)(ws + WS_X1);

    for (int u = tid; u < 128; u += NTHR) MISC[u] = 0u;
    __syncthreads();
    const bool one_launch = (hi - lo) > 1;
    XcdBarrier bar; bar.bar = ctl + CW_BAR; bar.x = 0; bar.st = MISC + 8;
    if (one_launch) bar = xcd_barrier_post(ctl + CW_BAR, MISC + 8);
#define IN(k) (lo <= (k) && (k) < hi)
#define SEAM(k) do { if (IN(k) && IN((k) + 1)) xcd_barrier(bar); } while (0)


    if (IN(PH_PRO)) {
        for (int cb = wg; cb < 256; cb += G) {
            LAS float* red = (LAS float*)lds;
            const int c4 = tid % 12, kg = tid / 12;
            f32x4 acc = (f32x4){0.f, 0.f, 0.f, 0.f};
            if (kg < 42) {
                const float* wp = w_ada + (size_t)cb * 48 + 4 * c4;
#pragma unroll 7
                for (int j = 0; j < 49; ++j) { const int k = kg + 42 * j; if (k < D) { const f32x4 v = __builtin_nontemporal_load((const f32x4*)(wp + (size_t)k * (6 * D))); acc += siluf_(cvec[k]) * v; } }
                *(LAS f32x4*)(red + kg * 48 + 4 * c4) = acc;
            }
            __syncthreads();
            if (tid < 48) { float s = b_ada[cb * 48 + tid];
#pragma unroll 6
                for (int q = 0; q < 42; ++q) s += red[q * 48 + tid];
                MOD[cb * 48 + tid] = s; }
            __syncthreads();
        }
        LAS unsigned char* scr = lds + wave * 17408;
        const int gw = wg * NWAVES + wave, NGW = G * NWAVES;
        {
            constexpr int NB_IN = (1104 + 63) / 64;
            for (int it = gw; it < 16 * NB_IN; it += NGW) convert_item(w_in + 1536, 2048, 1104, DIN, WIN_T, 0, it, lane, scr);
            for (int it = gw; it < 4 * 32; it += NGW) convert_item8(w_proj_att, 1024, 2048, 2048, (unsigned char*)WA_T, 0, it, lane, scr);
            for (int it = gw; it < 4 * 32; it += NGW) convert_item8(w_proj_hgrn, 1024, 2048, 2048, (unsigned char*)WA_T + (size_t)2048 * 1024, 0, it, lane, scr);
            for (int it = gw; it < 8 * 32; it += NGW) convert_item8(w_out, 2048, 2048, 2048, (unsigned char*)WO_T, 0, it, lane, scr);
            for (int it = gw; it < 8 * 24; it += NGW) convert_item8(w_in, 2048, 1536, DIN, WIN_T8, 0, it, lane, scr);
            for (int it = gw; it < 8 * 128; it += NGW) convert_item8(w_in + 2640, 2048, 8192, DIN, WIN_T8 + (size_t)1536 * 2048, 0, it, lane, scr);
            for (size_t i = (size_t)wg * NTHR + tid; i < (size_t)176 * 2048 * 2 / 16; i += (size_t)G * NTHR) ((u32x4*)(WIN_T + (size_t)1104 * 2048))[i] = (u32x4){0u, 0u, 0u, 0u};
        }
    }
    SEAM(PH_PRO);

    {
    if (IN(PH_H)) {
        const float* sh1 = MOD; const float* sc1 = MOD + D;
        const int gw = wg * NWAVES + wave, NGW = G * NWAVES;
        f32x4 gs[8], sh[8];
#pragma unroll
        for (int j = 0; j < 8; ++j) { const int c = 4 * lane + 256 * j; const f32x4 g = *(const f32x4*)(norm1_g + c), sc = *(const f32x4*)(sc1 + c); sh[j] = *(const f32x4*)(sh1 + c);
#pragma unroll
            for (int e = 0; e < 4; ++e) gs[j][e] = g[e] * (1.0f + sc[e]); }
        for (int t = gw; t < S; t += NGW) {
            const f32x4* xr = (const f32x4*)(x + (size_t)t * D) + lane;
            f32x4 v[8]; float ss = 0.f;
#pragma unroll
            for (int j = 0; j < 8; ++j) { v[j] = xr[64 * j]; ss += (v[j][0] * v[j][0] + v[j][1] * v[j][1]) + (v[j][2] * v[j][2] + v[j][3] * v[j][3]); }
            const float rstd = rsqrtf(wave_sum(ss) * (1.0f / D) + NORM_EPS);
#pragma unroll
            for (int j = 0; j < 8; ++j) { const f32x4 h = v[j] * rstd * gs[j] + sh[j]; u32x2 w; w.x = cvt_pk_bf16(h[0], h[1]); w.y = cvt_pk_bf16(h[2], h[3]);
                *(u32x2*)(HB + (size_t)t * D + 4 * lane + 256 * j) = w;
                *(unsigned*)(HA8 + (size_t)t * D + 4 * lane + 256 * j) = pack4_fp8(h[0], h[1], h[2], h[3]); }
        }
    }
    SEAM(PH_H);
    if (IN(PH_INPROJ)) {
        const int XC = (G == 256) ? XCONV : 0;
        const Conv8Job j1{w1, W1_T, 4096, 2, (size_t)2048 * 4096, (size_t)4096 * 2048, 8 * 16};
        const Conv8Job j2{w2, W2_T, 2048, 0, (size_t)2048 * 2048, (size_t)2048 * 2048, 8 * 8};
        if (G != 256) { conv8_run(lds, j1, NEXP * 8 * 16, wg, G, tid, wave, lane); conv8_run(lds, j2, NEXP * 8 * 8, wg, G, tid, wave, lane); }
        if (wg < XC) { conv8_run(lds, j1, NEXP * 8 * 16, wg, XC, tid, wave, lane); conv8_run(lds, j2, NEXP * 8 * 8, wg, XC, tid, wave, lane); }
        else {
            const int Gg = G - XC, cg = wg - XC;
            {
                pg8::Gemm g8{HA8, WIN_T8, 2048, 0, nullptr, 0}; pg8::StaticOrder S8; S8.init(S, 9728, Gg, cg);
                const int full8 = 2432 / Gg, rem8 = 2432 - full8 * Gg;
                if (Gg == 256) S8.skew(8, (wg >= 128 && wg < 192) ? -1 : (wg < 128 ? wg : wg - 64), 192);
                else if (rem8 > 0) S8.skew(full8, cg < rem8 ? cg : -1, rem8);
                pg8::EpiBf16 E8{PROJ, DINP, nullptr, 0, 1.0f / W8_SCALE, 6, 1280};
                pg8::gemm_phase<pg8::EpiBf16, pg8::StaticOrder, true>(lds, g8, S8, E8);
            }
            {
                pg8::Gemm g{HB, WIN_T, 2048, 0, nullptr, 0}; pg8::StaticOrder So; So.init(S, 1280, Gg, Gg == 256 ? (wg + 128) % G : (cg + Gg - (2432 % Gg)) % Gg);
                pg8::EpiBf16 E{PROJ + CQI, DINP, nullptr, 0, 1.0f, 1 << 30, 0};
                pg8::gemm_phase<pg8::EpiBf16, pg8::StaticOrder>(lds, g, So, E);
            }
        }
    }
    SEAM(PH_INPROJ);
    if (IN(PH_POST)) {
        const int gw = wg * NWAVES + wave, NGW = G * NWAVES;
        for (int t = gw; t < S; t += NGW) post_token(PROJ, KI, KC, VC, positions, idx_knorm_g, idx_knorm_b, t, lane);
        __syncthreads();
        for (int u = wg; u < 2048; u += G) hgrn_l1(lds, PROJ, lb_logits, ST, DC, u >> 3, u & 7, tid, wave, lane);
    }
    SEAM(PH_POST);
    if (IN(PH_SCORE)) {
        for (int idx = wg * NTHR + tid; idx < 8 * 128 * 128; idx += G * NTHR) {
            const int h = idx >> 14, d = idx & 127; float s = 0.f;
            bf16_t* sp = ST + idx; const float* dp = DC + h * 128 + d;
            for (int c = 0; c < 256; c += 16) {
                float l[16], dc[16];
#pragma unroll
                for (int i = 0; i < 16; ++i) { l[i] = bf2f(sp[(size_t)(c + i) * 131072]); dc[i] = dp[(size_t)(c + i) * 1024]; }
#pragma unroll
                for (int i = 0; i < 16; ++i) { sp[(size_t)(c + i) * 131072] = f2bf(s); s = dc[i] * s + l[i]; }
            }
        }
        {
            const int XS = (G == 256) ? XSCORE : 0;
            if (wg < XS) {
                const Conv8Job j1{w1, W1_T, 4096, 2, (size_t)2048 * 4096, (size_t)4096 * 2048, 8 * 16};
                const Conv8Job j2{w2, W2_T, 2048, 0, (size_t)2048 * 2048, (size_t)2048 * 2048, 8 * 8};
                __syncthreads();
                conv8_run(lds, j1, NEXP * 8 * 16, wg, XS, tid, wave, lane); conv8_run(lds, j2, NEXP * 8 * 8, wg, XS, tid, wave, lane);
            }
            for (;;) {
                if (tid == 0) MISC[100] = __hip_atomic_fetch_add(ctl + CW_SCQ, 1u, __ATOMIC_RELAXED, __HIP_MEMORY_SCOPE_AGENT);
                __syncthreads();
                const int item = (int)MISC[100];
                __syncthreads();
                if (item >= 252 * 6) break;
                int j, lo, hi;
                if (item < 504) { j = item >> 1; const int T = ((8 + j) >> 2) + ((511 - j) >> 2) + 2; const int p = item & 1; lo = p * T / 3; hi = (p + 1) * T / 3; }
                else { const int i2 = item - 504; j = i2 >> 2; const int T = ((8 + j) >> 2) + ((511 - j) >> 2) + 2; const int p = i2 & 3, b = 2 * T / 3; lo = b + p * (T - b) / 4; hi = b + (p + 1) * (T - b) / 4; }
                const int qa = 8 + j, qb2 = 511 - j, na = (qa >> 2) + 1;
                const int a0 = lo < na ? lo : na, a1 = hi < na ? hi : na, b0 = (lo > na ? lo : na) - na, b1 = (hi > na ? hi : na) - na;
                if (a1 > a0) score_block(lds, PROJ, KI, SCORES, SEGMAX, qa, a0, a1, tid, wave, lane);
                if (b1 > b0) score_block(lds, PROJ, KI, SCORES, SEGMAX, qb2, b0, b1, tid, wave, lane);
            }
        }
    }
    SEAM(PH_SCORE);
    if (IN(PH_ATTN)) {
        const int gw = wg * NWAVES + wave, NGW = G * NWAVES;
        for (int u = wg; u < 2048; u += G) hgrn_l3(lds, PROJ, lb_logits, ST, hgrn_norm_g, REC, u >> 3, u & 7, tid, wave, lane);
        {
            for (;;) {
                unsigned tq = 0; if (lane == 0) tq = __hip_atomic_fetch_add(ctl + CW_ATQ, 1u, __ATOMIC_RELAXED, __HIP_MEMORY_SCOPE_AGENT);
                tq = (unsigned)__builtin_amdgcn_readfirstlane((int)tq);
                if (tq >= (unsigned)S) break;
                const int t = S - 1 - (int)tq;
                LAS unsigned char* wl = lds + wave * 17664;
                if (t >= 256) select_row(wl, SCORES, SEGMAX, t, lane);
                else {
#pragma unroll
                    for (int i = 0; i < 4; ++i) { const int idx = lane + 64 * i; ((LAS int*)wl)[idx] = idx <= t ? idx : 0; }
                }
                attn_query(wl, PROJ, KC, VC, ATT, t, lane);
            }
        }
    }
    SEAM(PH_ATTN);
    if (IN(PH_OP1)) {
        pg8::Gemm g{ATT, WA_T, 1024, (size_t)2048 * 1024, nullptr, (size_t)S * 1024};
        pg8::TwoPartOrder So; So.init(S, 2048, G, wg);
        pg8::EpiGate2 E{(unsigned char*)MERGED, PROJ + CGA, PROJ + CGR};
        pg8::gemm_phase<pg8::EpiGate2, pg8::TwoPartOrder, true>(lds, g, So, E);
    }
    SEAM(PH_OP2);
    if (IN(PH_WOUT)) {
        pg8::Gemm g{MERGED, WO_T, 2048, 0, nullptr, 0}; pg8::StaticOrder So; So.init(S, 2048, G, wg);
        pg8::EpiDelta E{MOD + 2 * D, DELTA, 1.0f / (W8_SCALE * MRG8_SCALE)};
        pg8::gemm_phase<pg8::EpiDelta, pg8::StaticOrder, true>(lds, g, So, E);
    }
    SEAM(PH_WOUT);
    }

    if (IN(PH_ROUTER)) {
        LAS float* hs = (LAS float*)lds;
        volatile LAS unsigned* lcnt = MISC + 32;
        const float* sh2 = MOD + 3 * D; const float* sc2 = MOD + 4 * D;
        if (tid < 32) lcnt[tid] = 0u;
        __syncthreads();
        for (int grp = wg; grp < S / 16; grp += G) {
#pragma unroll 1
            for (int q = 0; q < 2; ++q) {
                const int tl = 2 * wave + q, t = grp * 16 + tl;
                const f32x4* xr = (const f32x4*)(x + (size_t)t * D) + lane; const u32x2* dr = (const u32x2*)(DELTA + (size_t)t * D) + lane;
                f32x4 v[8]; float ss = 0.f;
#pragma unroll
                for (int j = 0; j < 8; ++j) { const u32x2 dw = dr[64 * j]; v[j] = xr[64 * j] + (f32x4){bf_lo(dw.x), bf_hi(dw.x), bf_lo(dw.y), bf_hi(dw.y)};
                    ss += (v[j][0] * v[j][0] + v[j][1] * v[j][1]) + (v[j][2] * v[j][2] + v[j][3] * v[j][3]); }
#pragma unroll
                for (int j = 0; j < 8; ++j) { u32x2 w; w.x = cvt_pk_bf16(v[j][0], v[j][1]); w.y = cvt_pk_bf16(v[j][2], v[j][3]); ((u32x2*)(DELTA + (size_t)t * D) + lane)[64 * j] = w; }
                const float rstd = rsqrtf(wave_sum(ss) * (1.0f / D) + NORM_EPS);
#pragma unroll
                for (int j = 0; j < 8; ++j) {
                    const int c = 4 * lane + 256 * j;
                    const f32x4 g = *(const f32x4*)(norm2_g + c), sc = *(const f32x4*)(sc2 + c), sh = *(const f32x4*)(sh2 + c);
                    f32x4 h;
#pragma unroll
                    for (int e = 0; e < 4; ++e) h[e] = v[j][e] * rstd * g[e] * (1.0f + sc[e]) + sh[e];
                    *(LAS f32x4*)(hs + tl * 2048 + c) = h;
                    *(unsigned*)(H8 + (size_t)t * D + c) = pack4_fp8(h[0], h[1], h[2], h[3]);
                }
            }
            __syncthreads();
            {
                LAS float* part = (LAS float*)(lds + 131072);
                const int fr = lane & 15, fq = lane >> 4;
                f32x4 acc0 = (f32x4){0.f, 0.f, 0.f, 0.f}, acc1 = acc0;
                const LAS float* hrow = hs + fr * 2048 + wave * 256 + 4 * fq; const float* wrp = w_router + (size_t)(wave * 256 + 4 * fq) * 32 + fr;
#pragma unroll 2
                for (int i = 0; i < 16; ++i) {
                    const f32x4 a4 = *(const LAS f32x4*)(hrow + 16 * i);
                    float b0[4], b1[4];
#pragma unroll
                    for (int s = 0; s < 4; ++s) { b0[s] = wrp[(size_t)(16 * i + s) * 32]; b1[s] = wrp[(size_t)(16 * i + s) * 32 + 16]; }
#pragma unroll
                    for (int s = 0; s < 4; ++s) { acc0 = __builtin_amdgcn_mfma_f32_16x16x4f32(a4[s], b0[s], acc0, 0, 0, 0); acc1 = __builtin_amdgcn_mfma_f32_16x16x4f32(a4[s], b1[s], acc1, 0, 0, 0); }
                }
#pragma unroll
                for (int r = 0; r < 4; ++r) { part[(wave * 16 + 4 * fq + r) * 32 + fr] = acc0[r]; part[(wave * 16 + 4 * fq + r) * 32 + 16 + fr] = acc1[r]; }
                __syncthreads();
                const int tl = tid >> 5, e = tid & 31, t = grp * 16 + tl;
                float v = b_router[e];
#pragma unroll
                for (int w = 0; w < 8; ++w) v += part[(w * 16 + tl) * 32 + e];
                float tv[4]; int ti[4];
#pragma unroll
                for (int k = 0; k < 4; ++k) {
                    float bv = v; int bi = e;
#pragma unroll
                    for (int o = 16; o >= 1; o >>= 1) { const float ov = __shfl_xor(bv, o); const int oi = __shfl_xor(bi, o); if (ov > bv || (ov == bv && oi < bi)) { bv = ov; bi = oi; } }
                    tv[k] = bv; ti[k] = bi; if (e == bi) v = -__builtin_inff();
                }
                if (e == 0) {
                    const float e1 = __expf(tv[1] - tv[0]), e2 = __expf(tv[2] - tv[0]), e3 = __expf(tv[3] - tv[0]); const float inv = 1.0f / (1.0f + e1 + e2 + e3);
                    *(int4*)(TOPE + (size_t)t * 4) = make_int4(ti[0], ti[1], ti[2], ti[3]);
                    *(f32x4*)(GATE + (size_t)t * 4) = (f32x4){inv, e1 * inv, e2 * inv, e3 * inv};
#pragma unroll
                    for (int k = 0; k < 4; ++k) __hip_atomic_fetch_add((LAS unsigned*)&lcnt[ti[k]], 1u, __ATOMIC_RELAXED, __HIP_MEMORY_SCOPE_WORKGROUP);
                }
            }
            __syncthreads();
        }
        if (tid < 32) { const unsigned c = lcnt[tid]; if (c) __hip_atomic_fetch_add(ctl + CW_CNT + tid, c, __ATOMIC_RELAXED, __HIP_MEMORY_SCOPE_AGENT); }
    }
    SEAM(PH_ROUTER);

    if (IN(PH_SCATTER)) {
        volatile LAS unsigned* lcnt = MISC + 32; volatile LAS unsigned* lbase = MISC + 64; LAS int* pstart = (LAS int*)(lds + 1024); LAS int* pcnt = (LAS int*)(lds + 1280);
        if (tid == 0) { int p = 0; for (int e = 0; e < NEXP; ++e) { const int c = (int)__hip_atomic_load(ctl + CW_CNT + e, __ATOMIC_RELAXED, __HIP_MEMORY_SCOPE_AGENT); pstart[e] = p; pcnt[e] = c; p += (c + 255) & ~255; } }
        if (tid < 32) lcnt[tid] = 0u;
        __syncthreads();
        if (wg < NEXP) { const int e = wg; for (int s = pstart[e] + pcnt[e] + tid; s < pstart[e] + ((pcnt[e] + 255) & ~255); s += NTHR) TOKS[s] = 0; }
        for (int blk = wg; blk < S / 64; blk += G) {
            int e = 0, lrank = 0;
            if (tid < 256) { e = TOPE[(size_t)blk * 256 + tid]; lrank = (int)__hip_atomic_fetch_add((LAS unsigned*)&lcnt[e], 1u, __ATOMIC_RELAXED, __HIP_MEMORY_SCOPE_WORKGROUP); }
            __syncthreads();
            if (tid < 32) { const unsigned c = lcnt[tid]; lbase[tid] = c ? __hip_atomic_fetch_add(ctl + CW_FILL + tid, c, __ATOMIC_RELAXED, __HIP_MEMORY_SCOPE_AGENT) : 0u; }
            __syncthreads();
            if (tid < 256) { const int slot = pstart[e] + (int)lbase[e] + lrank; SLOT[(size_t)blk * 256 + tid] = slot; TOKS[slot] = blk * 64 + (tid >> 2); }
            __syncthreads();
            if (tid < 32) lcnt[tid] = 0u;
            __syncthreads();
        }
    }
    SEAM(PH_SCATTER);

    if (IN(PH_MOE1) || IN(PH_MOE2)) {
        LAS int* panel_e = (LAS int*)(lds + 131072 + 2048);
        LAS int* npan = (LAS int*)(lds + 131072 + 2048 + 2048);
        __syncthreads();
        if (tid == 0) { int p = 0; for (int e = 0; e < NEXP; ++e) { const int np = (int)((__hip_atomic_load(ctl + CW_CNT + e, __ATOMIC_RELAXED, __HIP_MEMORY_SCOPE_AGENT) + 255u) >> 8); for (int q = 0; q < np; ++q) panel_e[p + q] = e; p += np; } npan[0] = p; }
        __syncthreads();
        const int nPanels = npan[0];
        if (IN(PH_MOE1)) {
            pg8::Gemm g{H8, W1_T, 2048, (size_t)4096 * 2048, TOKS, 0}; pg8::MoeOrder So; So.init(nPanels, 16, G, wg, panel_e);
            pg8::EpiSwiglu E{ACT, b1};
            pg8::gemm_phase<pg8::EpiSwiglu, pg8::MoeOrder, true>(lds, g, So, E);
        }
        SEAM(PH_MOE1);
        if (IN(PH_MOE2)) {
            pg8::Gemm g{ACT, W2_T, 2048, (size_t)2048 * 2048, nullptr, 0}; pg8::MoeOrder So; So.init(nPanels, 8, G, wg, panel_e);
            pg8::EpiBf16 E{YB, 2048, b2, 2048, 1.0f / (W8_SCALE * ACT8_SCALE), 1 << 30, 0};
            pg8::gemm_phase<pg8::EpiBf16, pg8::MoeOrder, true>(lds, g, So, E);
        }
    }
    SEAM(PH_MOE2);

    if (IN(PH_FINAL)) {
        const float* gt2 = MOD + 5 * D;
        const int gw = wg * NWAVES + wave, NGW = G * NWAVES;
        for (int t = gw; t < S; t += NGW) {
            const u32x2* dr = (const u32x2*)(DELTA + (size_t)t * D) + lane;
            f32x4 v[8];
#pragma unroll
            for (int j = 0; j < 8; ++j) { const u32x2 dw = dr[64 * j]; v[j] = (f32x4){bf_lo(dw.x), bf_hi(dw.x), bf_lo(dw.y), bf_hi(dw.y)}; }
            {
                f32x4 m[8];
#pragma unroll
                for (int j = 0; j < 8; ++j) m[j] = (f32x4){0.f, 0.f, 0.f, 0.f};
                const int4 sl = *(const int4*)(SLOT + (size_t)t * 4); const f32x4 gt = *(const f32x4*)(GATE + (size_t)t * 4);
                const int sls[4] = {sl.x, sl.y, sl.z, sl.w};
#pragma unroll
                for (int k = 0; k < 4; ++k) {
                    const u32x2* yr = (const u32x2*)(YB + (size_t)sls[k] * D) + lane; const float gk = gt[k];
#pragma unroll
                    for (int j = 0; j < 8; ++j) { const u32x2 w = yr[64 * j]; m[j][0] += gk * bf_lo(w.x); m[j][1] += gk * bf_hi(w.x); m[j][2] += gk * bf_lo(w.y); m[j][3] += gk * bf_hi(w.y); }
                }
#pragma unroll
                for (int j = 0; j < 8; ++j) { const f32x4 g2 = *(const f32x4*)(gt2 + 4 * lane + 256 * j); v[j] = v[j] + g2 * m[j]; }
            }
            float ss = 0.f;
#pragma unroll
            for (int j = 0; j < 8; ++j) ss += (v[j][0] * v[j][0] + v[j][1] * v[j][1]) + (v[j][2] * v[j][2] + v[j][3] * v[j][3]);
            const float rstd = rsqrtf(wave_sum(ss) * (1.0f / D) + NORM_EPS);
            f32x4* orow = (f32x4*)(out + (size_t)t * D) + lane;
#pragma unroll
            for (int j = 0; j < 8; ++j) { const f32x4 fg = *(const f32x4*)(final_g + 4 * lane + 256 * j); orow[64 * j] = v[j] * rstd * fg; }
        }
    }
#undef IN
#undef SEAM
}

#ifndef MK_ONE_LAUNCH
#define MK_ONE_LAUNCH 1
#endif
extern "C" void kernel_launch(void* const* d_in, const int* in_sizes, int n_in, void* d_out, int out_size, void* d_ws, size_t ws_size, hipStream_t stream) {
    static int grid = 0;
    if (grid == 0) {
        if (n_in != 22 || out_size != S * D || ws_size < WS_END) { fprintf(stderr, "kernel_launch: unexpected shapes: n_in %d out %d ws %zu (need %zu)\n", n_in, out_size, ws_size, (size_t)WS_END); grid = -1; return; }
        int dev = 0, cus = 0, per_cu = 0;
        if (hipGetDevice(&dev) != hipSuccess || hipDeviceGetAttribute(&cus, hipDeviceAttributeMultiprocessorCount, dev) != hipSuccess) { grid = -1; return; }
        if (hipFuncSetAttribute((const void*)fwd_kernel, hipFuncAttributeMaxDynamicSharedMemorySize, LDS_BYTES) != hipSuccess) { fprintf(stderr, "kernel_launch: hipFuncSetAttribute failed\n"); grid = -1; return; }
        if (hipOccupancyMaxActiveBlocksPerMultiprocessor(&per_cu, (const void*)fwd_kernel, NTHR, LDS_BYTES) != hipSuccess || per_cu < 1) { fprintf(stderr, "kernel_launch: occupancy query says %d\n", per_cu); (void)hipGetLastError(); grid = -1; return; }
        grid = cus;
    }
    if (grid < 0) return;
    (void)in_sizes;
    hipMemsetAsync((char*)d_ws + WS_CTL, 0, CTL_BYTES, stream);
    Args a{};
    for (int i = 0; i < 22; ++i) a.in[i] = d_in[i];
    a.out = (float*)d_out; a.ws = (unsigned char*)d_ws; a.flags = 0; a.pad = 0;
#if MK_ONE_LAUNCH
    a.ph_lo = 0; a.ph_hi = NPH;
    hipLaunchKernelGGL(fwd_kernel, dim3(grid), dim3(NTHR), LDS_BYTES, stream, a);
#else
    for (int p = 0; p < NPH; ++p) { a.ph_lo = p; a.ph_hi = p + 1; hipLaunchKernelGGL(fwd_kernel, dim3(grid), dim3(NTHR), LDS_BYTES, stream, a); }
#endif
}
```

```cpp
#include <hip/hip_runtime.h>
#include <cstdio>
#include <cstdint>

#define GAS __attribute__((address_space(1)))
#define LAS __attribute__((address_space(3)))
typedef unsigned short bf16_t;
typedef short bf16x8 __attribute__((ext_vector_type(8)));
typedef float f32x4 __attribute__((ext_vector_type(4)));
typedef float f32x2 __attribute__((ext_vector_type(2)));
typedef float f32x16 __attribute__((ext_vector_type(16)));
typedef unsigned u32x4 __attribute__((ext_vector_type(4)));
typedef unsigned u32x2 __attribute__((ext_vector_type(2)));
typedef int i32x4 __attribute__((ext_vector_type(4)));
typedef int i32x8 __attribute__((ext_vector_type(8)));
typedef short s16x4 __attribute__((ext_vector_type(4)));
typedef short s16x2 __attribute__((ext_vector_type(2)));
typedef int v2i32 __attribute__((ext_vector_type(2)));

constexpr int S = 16384, D = 2048, DIN = 10832, DINP = 11008, NEXP = 32, DFF = 2048;
constexpr int NWAVES = 8, NTHR = 512;
constexpr int CQ = 0, CK = 1024, CV = 1280, CQI = 1536, CKI = 2560, CWI = 2624, CHQ = 2816, CHF = 3840, CHI = 4864, CHG = 5888, CGA = 6912, CGR = 8960;
constexpr int PMAX = 65536 + NEXP * 256;
constexpr float NORM_EPS = 1e-5f;

constexpr size_t MiB = 1u << 20;
constexpr size_t al256(size_t x) { return (x + 255) & ~(size_t)255; }
constexpr size_t WS_CTL = 0, CTL_BYTES = 1 * MiB;
constexpr size_t WS_MOD = WS_CTL + CTL_BYTES;
constexpr size_t WS_TOPE = WS_MOD + 64 * 1024;
constexpr size_t WS_GATE = WS_TOPE + (size_t)S * 16;
constexpr size_t WS_SLOT = WS_GATE + (size_t)S * 16;
constexpr size_t WS_WIN_T = WS_SLOT + (size_t)S * 16;
constexpr size_t WS_WA_T = WS_WIN_T + (size_t)DINP * D * 2;
constexpr size_t WS_WH_T = WS_WA_T + (size_t)2048 * 1024 * 2;
constexpr size_t WS_WO_T = WS_WH_T + (size_t)2048 * 1024 * 2;
constexpr size_t WS_W1_T = WS_WO_T + (size_t)2048 * 2048 * 2;
constexpr size_t WS_W2_T = WS_W1_T + (size_t)NEXP * 4096 * 2048 * 2;
constexpr size_t WS_H = WS_W2_T + (size_t)NEXP * 2048 * 2048 * 2;
constexpr size_t WS_PROJ = WS_H + (size_t)S * D * 2;
constexpr size_t WS_KI = WS_PROJ + (size_t)S * DINP * 2;
constexpr size_t WS_KC = WS_KI + (size_t)S * 64 * 2;
constexpr size_t WS_VC = WS_KC + (size_t)S * 256 * 2;
constexpr size_t WS_ST = WS_VC + (size_t)S * 256 * 2;
constexpr size_t WS_DC = WS_ST + (size_t)256 * 8 * 128 * 128 * 4;
constexpr size_t WS_SEL = WS_DC + (size_t)256 * 8 * 128 * 4;
constexpr size_t WS_ATT = WS_SEL + (size_t)S * 256 * 4;
constexpr size_t WS_REC = WS_ATT + (size_t)S * 1024 * 2;
constexpr size_t WS_MERGED = WS_REC + (size_t)S * 1024 * 2;
constexpr size_t WS_X1 = WS_MERGED + (size_t)S * 2048 * 2;
constexpr size_t WS_SCORES = WS_X1 + (size_t)S * 2048 * 4;
constexpr size_t WS_XB = WS_SCORES;
constexpr size_t WS_ACT = WS_XB + (size_t)PMAX * 2048 * 2;
constexpr size_t WS_YB = WS_ACT + (size_t)PMAX * 2048 * 2;
constexpr size_t WS_END = WS_SCORES + (size_t)S * S * 4;
static_assert(WS_YB + (size_t)PMAX * 2048 * 2 <= WS_END, "MoE buffers overlay the score matrix");
static_assert(WS_END <= (size_t)4096 * MiB, "workspace");
constexpr int CW_BAR = 4096, CW_CNT = 8192, CW_FILL = 8448;
constexpr size_t WS_TOKS = WS_SEL;

constexpr int LDS_BYTES = 155648;
constexpr int LDS_MISC = LDS_BYTES - 512;

__device__ __forceinline__ unsigned cvt_pk_bf16(float lo, float hi) { unsigned r; asm volatile("v_cvt_pk_bf16_f32 %0, %1, %2" : "=v"(r) : "v"(lo), "v"(hi)); return r; }
__device__ __forceinline__ float bf_lo(unsigned u) { return __uint_as_float(u << 16); }
__device__ __forceinline__ float bf_hi(unsigned u) { return __uint_as_float(u & 0xffff0000u); }
__device__ __forceinline__ float bf2f(bf16_t b) { return __uint_as_float(((unsigned)b) << 16); }
__device__ __forceinline__ float wave_sum(float v) {
#define DPPS(ctrl, rmask) { const int s_ = __builtin_amdgcn_update_dpp(0, __float_as_int(v), ctrl, rmask, 0xF, false); v += __int_as_float(s_); }
    DPPS(0x111, 0xF) DPPS(0x112, 0xF) DPPS(0x114, 0xF) DPPS(0x118, 0xF) DPPS(0x142, 0xA) DPPS(0x143, 0xC)
#undef DPPS
    return __int_as_float(__builtin_amdgcn_readlane(__float_as_int(v), 63));
}
__device__ __forceinline__ float wave_max(float v) {
#define DPPM(ctrl, rmask) { const int o_ = __float_as_int(v); const int s_ = __builtin_amdgcn_update_dpp(o_, o_, ctrl, rmask, 0xF, false); v = fmaxf(v, __int_as_float(s_)); }
    DPPM(0x111, 0xF) DPPM(0x112, 0xF) DPPM(0x114, 0xF) DPPM(0x118, 0xF) DPPM(0x142, 0xA) DPPM(0x143, 0xC)
#undef DPPM
    return __int_as_float(__builtin_amdgcn_readlane(__float_as_int(v), 63));
}
__device__ __forceinline__ float sigmoidf_(float x) { return __builtin_amdgcn_rcpf(1.0f + __expf(-x)); }
__device__ __forceinline__ float siluf_(float x) { return x * __builtin_amdgcn_rcpf(1.0f + __expf(-x)); }
__device__ __forceinline__ unsigned pack4_fp8(float a, float b, float c, float d) { int w = 0; w = __builtin_amdgcn_cvt_pk_fp8_f32(a, b, w, false); w = __builtin_amdgcn_cvt_pk_fp8_f32(c, d, w, true); return (unsigned)w; }
constexpr float W8_SCALE = 64.0f, ACT8_SCALE = 4.0f, MRG8_SCALE = 8.0f, OP8_SCALE = 16.0f;
__device__ __forceinline__ float relu_i(float x) { const int i = __float_as_int(x); return __int_as_float(i > 0 ? i : 0); }
__device__ __forceinline__ void fp8x16_to_bf16(const u32x4& w, u32x4& lo, u32x4& hi) {
    unsigned o[8];
#pragma unroll
    for (int q = 0; q < 4; ++q) { const unsigned wq = w[q]; const f32x2 a = __builtin_amdgcn_cvt_pk_f32_fp8((int)wq, false), b = __builtin_amdgcn_cvt_pk_f32_fp8((int)wq, true);
        o[2 * q] = cvt_pk_bf16(a[0], a[1]); o[2 * q + 1] = cvt_pk_bf16(b[0], b[1]); }
    lo = (u32x4){o[0], o[1], o[2], o[3]}; hi = (u32x4){o[4], o[5], o[6], o[7]};
}
__device__ __forceinline__ unsigned char fp8_1(float x) { return (unsigned char)(__builtin_amdgcn_cvt_pk_fp8_f32(x, x, 0, false) & 0xff); }
#define LDS_WAIT() asm volatile("s_waitcnt lgkmcnt(0)" ::: "memory")
#define VM_WAIT() asm volatile("s_waitcnt vmcnt(0)" ::: "memory")

#define XB_TMO      128
#define XB_XCNT(j)  (256  + 64 * (j))
#define XB_XSUB(j)  (1280 + 64 * (j))
#define XB_XGEN(j)  (2304 + 64 * (j))
#define XB_TOP      3328
#define XB_TOPGEN   3392
#define XCD_BAR_WORDS 3456
#define XB_SPIN_CAP (1u << 22)

__device__ __forceinline__ unsigned xb_ld(unsigned* p)              { return __hip_atomic_load(p, __ATOMIC_RELAXED, __HIP_MEMORY_SCOPE_AGENT); }
__device__ __forceinline__ unsigned xb_add(unsigned* p, unsigned v) { return __hip_atomic_fetch_add(p, v, __ATOMIC_RELAXED, __HIP_MEMORY_SCOPE_AGENT); }
__device__ __forceinline__ unsigned xb_xcc_id() { return (unsigned)__builtin_amdgcn_s_getreg((3 << 11) | 20) & 0xFu; }
#define XB_SPIN(cond, bar) do { unsigned _sp = 0; while (cond) { __builtin_amdgcn_s_sleep(1); \
    if ((++_sp & 255u) == 0u) { if (xb_ld(&(bar)[XB_TMO])) break; if (_sp > XB_SPIN_CAP) { atomicAdd(&(bar)[XB_TMO], 1u); break; } } } } while (0)

struct XcdBarrier { unsigned* bar; unsigned x; volatile LAS unsigned* st; };

__device__ __forceinline__ XcdBarrier xcd_barrier_post(unsigned* bar, volatile LAS unsigned* st) {
    XcdBarrier b; b.bar = bar; b.x = xb_xcc_id(); b.st = st;
    if (threadIdx.x == 0) (void)xb_add(&bar[XB_XCNT(b.x)], 1u);
    return b;
}
__device__ __forceinline__ void xcd_barrier_complete(unsigned* bar, unsigned x, unsigned& nloc, unsigned& nx) {
    const unsigned G = gridDim.x * gridDim.y * gridDim.z;
    unsigned sum, cnt, mine, sp = 0u;
    for (;;) {
        sum = 0u; cnt = 0u; mine = 0u;
#pragma unroll
        for (unsigned j = 0; j < 16; ++j) { const unsigned c = xb_ld(&bar[XB_XCNT(j)]); sum += c; cnt += (c > 0u) ? 1u : 0u; mine = (j == x) ? c : mine; }
        if (sum == G) break;
        __builtin_amdgcn_s_sleep(1);
        if ((++sp & 255u) == 0u) { if (xb_ld(&bar[XB_TMO])) break; if (sp > XB_SPIN_CAP) { atomicAdd(&bar[XB_TMO], 1u); break; } }
    }
    nloc = mine > 0u ? mine : 1u; nx = cnt > 0u ? cnt : 1u;
}
__device__ __forceinline__ void xcd_barrier(const XcdBarrier& b) {
    asm volatile("s_waitcnt vmcnt(0)" ::: "memory");
    __syncthreads();
    if (threadIdx.x == 0) {
        unsigned* bar = b.bar;
        __builtin_amdgcn_s_waitcnt(0);
        unsigned nloc = b.st[0], nx = b.st[1];
        if (nloc == 0u) { xcd_barrier_complete(bar, b.x, nloc, nx); b.st[0] = nloc; b.st[1] = nx; }
        const unsigned old = xb_add(&bar[XB_XSUB(b.x)], 1u);
        const unsigned gen = old / nloc;
        if (old + 1u == (gen + 1u) * nloc) {
            __builtin_amdgcn_fence(__ATOMIC_RELEASE, "agent");
            asm volatile("s_waitcnt vmcnt(0)" ::: "memory");
            const unsigned og = xb_add(&bar[XB_TOP], 1u);
            const unsigned tg = og / nx;
            if (og + 1u == (tg + 1u) * nx) xb_add(&bar[XB_TOPGEN], 1u);
            else XB_SPIN(xb_ld(&bar[XB_TOPGEN]) == tg, bar);
            __builtin_amdgcn_fence(__ATOMIC_ACQUIRE, "agent");
            xb_add(&bar[XB_XGEN(b.x)], 1u);
            asm volatile("s_waitcnt vmcnt(0)" ::: "memory");
        } else {
            XB_SPIN(xb_ld(&bar[XB_XGEN(b.x)]) == gen, bar);
            __builtin_amdgcn_fence(__ATOMIC_ACQUIRE, "agent");
            asm volatile("s_waitcnt vmcnt(0)" ::: "memory");
        }
    }
    __syncthreads();
}

namespace pg8 {
constexpr int BM = 256, BK = 64, HALF = 128, HTB = HALF * BK * 2, STAGE_BYTES = 8 * HTB, NXCD = 8, WGM = 8;
__host__ __device__ __forceinline__ int lds_byte(int r, int c) { const int st = (r >> 4) * 2 + (c >> 5), rr = r & 15, cc = c & 31, ob = rr * 64 + cc * 2; return st * 1024 + (ob ^ (((ob >> 9) & 1) << 5)); }
__host__ __device__ __forceinline__ void stage_rc(int b, int& R, int& C) { const int st = b / 1024, sb = b % 1024, swz = sb ^ (((sb >> 9) & 1) << 5); R = (st >> 1) * 16 + swz / 64; C = (st & 1) * 32 + (swz % 64) / 2; }
__host__ __device__ __forceinline__ int perm32(int rho) { const int n = rho >> 4, i = rho & 15; return 8 * (i >> 2) + 4 * n + (i & 3); }

struct Unit { int pm, pn, e; };
struct Gemm { const void* A; const void* Bt; int K; size_t estride; const int* arow; size_t astride; };

struct StaticOrder {
    int nM, nN, nwg, G, c, i, full, erank, en;
    __device__ void init(int M, int N, int G_, int c_) { nM = M / BM; nN = N / BM; nwg = nM * nN; G = G_; c = c_; i = 0; full = 1 << 30; erank = -1; en = 1; }
    __device__ void skew(int full_, int erank_, int en_) { full = full_; erank = erank_; en = en_; }
    __device__ bool next(Unit& u) {
        long L;
        if (i < full) L = (long)i * G + c; else { if (erank < 0) return false; L = (long)full * G + (long)(i - full) * en + erank; }
        ++i; if (L >= nwg) return false;
        int wgid = (int)L; { const int q = nwg / NXCD, r = nwg % NXCD, xcd = wgid % NXCD, off = wgid / NXCD; wgid = (xcd < r ? xcd * (q + 1) : r * (q + 1) + (xcd - r) * q) + off; }
        const int nig = WGM * nN, gid = wgid / nig, fm = gid * WGM, gsz = (nM - fm) < WGM ? (nM - fm) : WGM;
        u.pm = fm + ((wgid % nig) % gsz); u.pn = (wgid % nig) / gsz; u.e = 0; return true;
    }
};
struct MoeOrder {
    int nPanels, nN, G, c, i; const LAS int* panel_e;
    __device__ void init(int nPanels_, int nN_, int G_, int c_, const LAS int* pe) { nPanels = nPanels_; nN = nN_; G = G_; c = c_; i = 0; panel_e = pe; }
    __device__ bool next(Unit& u) {
        const int PB = 256 / nN;
        const int nblk = (nPanels + PB - 1) / PB;
        for (;;) {
            const long L = (long)i * G + c; ++i;
            const int blk = (int)(L >> 8), r = (int)(L & 255), x = r & 7, j = r >> 3;
            if (blk >= nblk) return false;
            int pm, pn;
            if (nN == 16) { pm = blk * 16 + 4 * (x >> 1) + (j & 3); pn = 8 * (x & 1) + (j >> 2); }
            else          { pm = blk * 32 + 4 * x + (j & 3);        pn = j >> 2; }
            if (pm < nPanels) { u.pm = pm; u.pn = pn; u.e = panel_e[pm]; return true; }
        }
    }
};

template <class Epi, class Sched, bool FP8 = false>
__device__ __forceinline__ void gemm_phase(LAS unsigned char* lds, const Gemm g, Sched& S, const Epi& E) {
    const int tid = threadIdx.x, wid = __builtin_amdgcn_readfirstlane(tid >> 6), lane = tid & 63, wr = wid >> 2, wc = wid & 3, fr = lane & 15, fq = lane >> 4;
    const int K = g.K; const int pitch = FP8 ? K : 2 * K; const int nt = pitch / 128;
    unsigned voffA[2], voffB[2];
#pragma unroll
    for (int i = 0; i < 2; ++i) { int R, C; stage_rc(tid * 16 + i * 8192, R, C); const int Rb = Epi::PERM ? ((R & ~31) + perm32(R & 31)) : R;
        voffA[i] = (unsigned)(R * pitch + C * 2); voffB[i] = (unsigned)(Rb * pitch + C * 2); }
    const size_t kstep = (size_t)(BK * 2);
    const size_t hstep = (size_t)HALF * pitch;
    const size_t tstep = 2 * hstep;
    int RA[2], CA[2];
#pragma unroll
    for (int i = 0; i < 2; ++i) stage_rc(tid * 16 + i * 8192, RA[i], CA[i]);
    const bool gather = g.arow != nullptr;
    const size_t hsA = gather ? 0 : hstep;
    unsigned vA0[2] = {voffA[0], voffA[1]}, vA1[2] = {voffA[0], voffA[1]}, nA0[2] = {voffA[0], voffA[1]}, nA1[2] = {voffA[0], voffA[1]};
#define PG8_AOFF(dst0, dst1, u) do { if (gather) { _Pragma("unroll") for (int i = 0; i < 2; ++i) { \
        dst0[i] = (unsigned)g.arow[(u).pm * 256 + RA[i]] * (unsigned)pitch + (unsigned)(CA[i] * 2); dst1[i] = (unsigned)g.arow[(u).pm * 256 + 128 + RA[i]] * (unsigned)pitch + (unsigned)(CA[i] * 2); } } } while (0)
    const unsigned ldsw = (unsigned)wid * 1024u;
    const int aoff = lds_byte(wr * 64 + fr, fq * 8), boff = lds_byte(wc * 32 + fr, fq * 8);
#define PG8_SA(b, h) (((b) * 2 + (h)) * HTB)
#define PG8_SB(b, h) ((4 + (b) * 2 + (h)) * HTB)
#define PG8_STAGE(bufoff, gbase, voff) do { _Pragma("unroll") for (int _i = 0; _i < 2; ++_i) \
        __builtin_amdgcn_global_load_lds((const unsigned*)((const char*)(gbase) + (voff)[_i]), (LAS unsigned*)(lds + (bufoff) + ldsw + _i * 8192), 16, 0, 0); } while (0)
#define PG8_LD8(p) __builtin_shufflevector(*(const LAS i32x4*)(p), *(const LAS i32x4*)((p) + 1024), 0, 1, 2, 3, 4, 5, 6, 7)
#define PG8_LDA(dst, b, h) do { _Pragma("unroll") for (int m = 0; m < 4; ++m) { if constexpr (FP8) dst##8[m] = PG8_LD8(lds + PG8_SA(b, h) + aoff + m * 2048); \
        else { _Pragma("unroll") for (int k = 0; k < 2; ++k) dst[m][k] = *(const LAS bf16x8*)(lds + PG8_SA(b, h) + aoff + m * 2048 + k * 1024); } } } while (0)
#define PG8_LDB(dst, b, h) do { _Pragma("unroll") for (int n = 0; n < 2; ++n) { if constexpr (FP8) dst##8[n] = PG8_LD8(lds + PG8_SB(b, h) + boff + n * 2048); \
        else { _Pragma("unroll") for (int k = 0; k < 2; ++k) dst[n][k] = *(const LAS bf16x8*)(lds + PG8_SB(b, h) + boff + n * 2048 + k * 1024); } } } while (0)
#define PG8_MMA(ai, bj, At, Bt) do { __builtin_amdgcn_s_setprio(1); _Pragma("unroll") for (int m = 0; m < 4; ++m) _Pragma("unroll") for (int n = 0; n < 2; ++n) { \
        if constexpr (FP8) asm volatile("v_mfma_scale_f32_16x16x128_f8f6f4 %0, %1, %2, %0, %3, %3 op_sel_hi:[0,0,0]" : "+v"(acc[ai][bj][m][n]) : "v"(Bt##8[n]), "v"(At##8[m]), "v"(scl1)); \
        else { _Pragma("unroll") for (int k = 0; k < 2; ++k) acc[ai][bj][m][n] = __builtin_amdgcn_mfma_f32_16x16x32_bf16(Bt[n][k], At[m][k], acc[ai][bj][m][n], 0, 0, 0); } } \
        __builtin_amdgcn_s_setprio(0); } while (0)
#define PG8_WAIT_V(n) asm volatile("s_waitcnt vmcnt(" #n ")" ::: "memory")
#define PG8_WAIT_L(n) asm volatile("s_waitcnt lgkmcnt(" #n ")" ::: "memory")
#define PG8_BAR __builtin_amdgcn_s_barrier()
#define PG8_SCHED __builtin_amdgcn_sched_barrier(0)
    Unit cur, nxt;
    if (!S.next(cur)) return;
    const unsigned scl1 = 0x7f7f7f7fu;
    f32x4 acc[2][2][4][2];
#pragma unroll
    for (int a = 0; a < 2; ++a)
#pragma unroll
        for (int b = 0; b < 2; ++b)
#pragma unroll
            for (int m = 0; m < 4; ++m)
#pragma unroll
                for (int n = 0; n < 2; ++n) acc[a][b][m][n] = (f32x4){0.f, 0.f, 0.f, 0.f};
    bf16x8 At[4][2], B0[2][2], B1[2][2]; i32x8 At8[4], B08[2], B18[2];
    const char* cA = (const char*)g.A + (size_t)cur.e * g.astride + (gather ? (size_t)0 : (size_t)cur.pm * tstep); const char* cB = (const char*)g.Bt + (size_t)cur.e * g.estride + (size_t)cur.pn * tstep;
    PG8_AOFF(vA0, vA1, cur);
    PG8_STAGE(PG8_SB(0, 0), cB, voffB); PG8_STAGE(PG8_SB(0, 1), cB + hstep, voffB); PG8_STAGE(PG8_SA(0, 0), cA, vA0); PG8_STAGE(PG8_SA(0, 1), cA + hsA, vA1);
    if (wr == 1) PG8_BAR;
    PG8_WAIT_V(2); PG8_BAR;
    PG8_STAGE(PG8_SB(1, 0), cB + kstep, voffB); PG8_STAGE(PG8_SA(1, 0), cA + kstep, vA0); PG8_STAGE(PG8_SB(1, 1), cB + hstep + kstep, voffB);
    PG8_WAIT_V(6); PG8_BAR;
    for (;;) {
        const bool has_next = S.next(nxt);
        const char* nA = has_next ? (const char*)g.A + (size_t)nxt.e * g.astride + (gather ? (size_t)0 : (size_t)nxt.pm * tstep) : cA;
        if (has_next) PG8_AOFF(nA0, nA1, nxt);
        const char* nB = has_next ? (const char*)g.Bt + (size_t)nxt.e * g.estride + (size_t)nxt.pn * tstep : cB;
        for (int t = 0; t < nt; t += 2) {
            const bool last = (t == nt - 2);
            const char* a1 = cA + (size_t)(t + 1) * kstep;
            const char* a2 = last ? nA : cA + (size_t)(t + 2) * kstep; const char* b2 = last ? nB : cB + (size_t)(t + 2) * kstep;
            const char* a3 = a2 + kstep; const char* b3 = b2 + kstep;
            PG8_LDB(B0, 0, 0); PG8_LDB(B1, 0, 1); PG8_SCHED; PG8_LDA(At, 0, 0); PG8_STAGE(PG8_SA(1, 1), a1 + hsA, vA1);
            if (last && has_next) { vA0[0] = nA0[0]; vA0[1] = nA0[1]; vA1[0] = nA1[0]; vA1[1] = nA1[1]; }
            PG8_WAIT_V(8); PG8_WAIT_L(0); PG8_BAR; PG8_MMA(0, 0, At, B0); PG8_MMA(0, 1, At, B1); PG8_BAR; PG8_SCHED;
            PG8_LDA(At, 0, 1); PG8_STAGE(PG8_SB(0, 0), b2, voffB); PG8_STAGE(PG8_SB(0, 1), b2 + hstep, voffB); PG8_STAGE(PG8_SA(0, 0), a2, vA0);
            PG8_WAIT_V(8); PG8_WAIT_L(0); PG8_BAR; PG8_MMA(1, 0, At, B0); PG8_MMA(1, 1, At, B1); PG8_BAR; PG8_SCHED;
            PG8_LDB(B0, 1, 0); PG8_LDB(B1, 1, 1); PG8_SCHED; PG8_LDA(At, 1, 0); PG8_STAGE(PG8_SA(0, 1), a2 + hsA, vA1);
            PG8_WAIT_V(8); PG8_WAIT_L(0); PG8_BAR; PG8_MMA(0, 0, At, B0); PG8_MMA(0, 1, At, B1); PG8_BAR; PG8_SCHED;
            PG8_LDA(At, 1, 1); PG8_STAGE(PG8_SB(1, 0), b3, voffB); PG8_STAGE(PG8_SB(1, 1), b3 + hstep, voffB); PG8_STAGE(PG8_SA(1, 0), a3, vA0);
            PG8_WAIT_V(8); PG8_WAIT_L(0); PG8_BAR; PG8_MMA(1, 0, At, B0); PG8_MMA(1, 1, At, B1); PG8_BAR; PG8_SCHED;
        }
        if (wr == 0) PG8_BAR;
        if constexpr (FP8) {
#pragma unroll
            for (int a = 0; a < 2; ++a)
#pragma unroll
                for (int b = 0; b < 2; ++b) asm volatile("s_nop 15" : "+v"(acc[a][b][0][0]), "+v"(acc[a][b][0][1]), "+v"(acc[a][b][1][0]), "+v"(acc[a][b][1][1]), "+v"(acc[a][b][2][0]), "+v"(acc[a][b][2][1]), "+v"(acc[a][b][3][0]), "+v"(acc[a][b][3][1]));
        }
        const bool keep_acc = E(acc, cur, wr, wc, fr, fq);
        if (!has_next) break;
        if (!keep_acc)
#pragma unroll
        for (int a = 0; a < 2; ++a)
#pragma unroll
            for (int b = 0; b < 2; ++b)
#pragma unroll
                for (int m = 0; m < 4; ++m)
#pragma unroll
                    for (int n = 0; n < 2; ++n) acc[a][b][m][n] = (f32x4){0.f, 0.f, 0.f, 0.f};
        cur = nxt; cA = nA; cB = nB;
        if (wr == 1) PG8_BAR;
    }
    PG8_WAIT_V(0);
    PG8_BAR;
#undef PG8_AOFF
#undef PG8_SA
#undef PG8_SB
#undef PG8_STAGE
#undef PG8_LDA
#undef PG8_LDB
#undef PG8_MMA
#undef PG8_LD8
#undef PG8_WAIT_V
#undef PG8_WAIT_L
#undef PG8_BAR
#undef PG8_SCHED
}

struct EpiBf16 {
    static constexpr bool PERM = true;
    bf16_t* O; int ldc; const float* bias; int bias_estride; float ascale; int skip_from, skip_cols;
    __device__ __forceinline__ bool operator()(const f32x4 (&acc)[2][2][4][2], const Unit& u, int wr, int wc, int fr, int fq) const {
        const int row0 = u.pm * BM + wr * 64 + fr; const int col0 = u.pn * BM + wc * 32 + 8 * fq + (u.pn >= skip_from ? skip_cols : 0);
        f32x4 bv[2][2];
#pragma unroll
        for (int bj = 0; bj < 2; ++bj)
#pragma unroll
            for (int n = 0; n < 2; ++n) bv[bj][n] = bias ? *(const f32x4*)(bias + (size_t)u.e * bias_estride + col0 + bj * HALF + 4 * n) : (f32x4){0.f, 0.f, 0.f, 0.f};
#pragma unroll
        for (int ai = 0; ai < 2; ++ai)
#pragma unroll
            for (int m = 0; m < 4; ++m) { bf16_t* rowp = O + (size_t)(row0 + ai * HALF + m * 16) * ldc + col0;
#pragma unroll
                for (int bj = 0; bj < 2; ++bj) { const f32x4 v0 = acc[ai][bj][m][0] * ascale + bv[bj][0], v1 = acc[ai][bj][m][1] * ascale + bv[bj][1];
                    u32x4 w; w.x = cvt_pk_bf16(v0[0], v0[1]); w.y = cvt_pk_bf16(v0[2], v0[3]); w.z = cvt_pk_bf16(v1[0], v1[1]); w.w = cvt_pk_bf16(v1[2], v1[3]);
                    *(u32x4*)(rowp + bj * HALF) = w; } }
        return false;
    }
};
__device__ __forceinline__ float swiglu1(float ug, float ul) {
    ug = fminf(ug, 7.0f); ul = fminf(fmaxf(ul, -7.0f), 7.0f);
    return ug * __builtin_amdgcn_rcpf(1.0f + __expf(-1.702f * ug)) * (ul + 1.0f);
}
struct EpiSwiglu {
    static constexpr bool PERM = true;
    unsigned char* O; const float* b1;
    __device__ __forceinline__ bool operator()(const f32x4 (&acc)[2][2][4][2], const Unit& u, int wr, int wc, int fr, int fq) const {
        const int row0 = u.pm * BM + wr * 64 + fr; const int c0 = u.pn * 128 + wc * 32 + 8 * fq;
        const float* bg = b1 + (size_t)u.e * 4096 + c0; const float* bl = bg + 2048;
        f32x4 bgv[2], blv[2];
#pragma unroll
        for (int n = 0; n < 2; ++n) { bgv[n] = *(const f32x4*)(bg + 4 * n); blv[n] = *(const f32x4*)(bl + 4 * n); }
#pragma unroll
        for (int ai = 0; ai < 2; ++ai)
#pragma unroll
            for (int m = 0; m < 4; ++m) {
                float a[8];
#pragma unroll
                for (int n = 0; n < 2; ++n)
#pragma unroll
                    for (int j = 0; j < 4; ++j) a[4 * n + j] = ACT8_SCALE * swiglu1(acc[ai][0][m][n][j] * (1.0f / W8_SCALE) + bgv[n][j], acc[ai][1][m][n][j] * (1.0f / W8_SCALE) + blv[n][j]);
                u32x2 w; w.x = pack4_fp8(a[0], a[1], a[2], a[3]); w.y = pack4_fp8(a[4], a[5], a[6], a[7]);
                *(u32x2*)(O + (size_t)(row0 + ai * HALF + m * 16) * 2048 + c0) = w;
            }
        return false;
    }
};

struct TwoPartOrder {
    StaticOrder so; Unit held; int part;
    __device__ void init(int M, int N, int G_, int c_) { so.init(M, N, G_, c_); part = 0; }
    __device__ bool next(Unit& u) { if (part == 1) { u = held; u.e = 1; part = 0; return true; } if (!so.next(held)) return false; u = held; u.e = 0; part = 1; return true; }
};
struct EpiGate2 {
    static constexpr bool PERM = true;
    unsigned char* O; const bf16_t* Ga; const bf16_t* Gr;
    __device__ __forceinline__ bool operator()(f32x4 (&acc)[2][2][4][2], const Unit& u, int wr, int wc, int fr, int fq) const {
        const int row0 = u.pm * BM + wr * 64 + fr; const int col0 = u.pn * BM + wc * 32 + 8 * fq;
#pragma unroll
        for (int ai = 0; ai < 2; ++ai)
#pragma unroll
            for (int m = 0; m < 4; ++m) { const size_t row = (size_t)(row0 + ai * HALF + m * 16);
#pragma unroll
                for (int bj = 0; bj < 2; ++bj) { const int c = col0 + bj * HALF;
                    const u32x4 gr = *(const u32x4*)(Gr + row * DINP + c);
                    if (u.e == 0) {
                        const u32x4 ga = *(const u32x4*)(Ga + row * DINP + c);
#pragma unroll
                        for (int q = 0; q < 4; ++q) {
                            const float r0 = (1.0f + __expf(-bf_lo(gr[q]))) * __builtin_amdgcn_rcpf(1.0f + __expf(-bf_lo(ga[q]))), r1 = (1.0f + __expf(-bf_hi(gr[q]))) * __builtin_amdgcn_rcpf(1.0f + __expf(-bf_hi(ga[q])));
                            acc[ai][bj][m][q >> 1][(2 * q) & 3] *= r0; acc[ai][bj][m][q >> 1][(2 * q + 1) & 3] *= r1; }
                    } else {
                        float r[8];
#pragma unroll
                        for (int q = 0; q < 4; ++q) { r[2 * q] = sigmoidf_(bf_lo(gr[q])) * acc[ai][bj][m][q >> 1][(2 * q) & 3]; r[2 * q + 1] = sigmoidf_(bf_hi(gr[q])) * acc[ai][bj][m][q >> 1][(2 * q + 1) & 3]; }
                        u32x2 w; constexpr float osc = MRG8_SCALE / (W8_SCALE * OP8_SCALE); w.x = pack4_fp8(r[0] * osc, r[1] * osc, r[2] * osc, r[3] * osc); w.y = pack4_fp8(r[4] * osc, r[5] * osc, r[6] * osc, r[7] * osc);
                        *(u32x2*)(O + row * 2048 + c) = w; } } }
        return u.e == 0;
    }
};
struct EpiDelta {
    static constexpr bool PERM = true;
    const float* gt; bf16_t* DL; float ascale;
    __device__ __forceinline__ bool operator()(const f32x4 (&acc)[2][2][4][2], const Unit& u, int wr, int wc, int fr, int fq) const {
        const int row0 = u.pm * BM + wr * 64 + fr; const int col0 = u.pn * BM + wc * 32 + 8 * fq;
        f32x4 g[2][2];
#pragma unroll
        for (int bj = 0; bj < 2; ++bj)
#pragma unroll
            for (int n = 0; n < 2; ++n) g[bj][n] = *(const f32x4*)(gt + col0 + bj * HALF + 4 * n);
#pragma unroll
        for (int ai = 0; ai < 2; ++ai)
#pragma unroll
            for (int m = 0; m < 4; ++m) { bf16_t* rowp = DL + (size_t)(row0 + ai * HALF + m * 16) * 2048 + col0;
#pragma unroll
                for (int bj = 0; bj < 2; ++bj) { const f32x4 v0 = acc[ai][bj][m][0] * ascale * g[bj][0], v1 = acc[ai][bj][m][1] * ascale * g[bj][1];
                    u32x4 w; w.x = cvt_pk_bf16(v0[0], v0[1]); w.y = cvt_pk_bf16(v0[2], v0[3]); w.z = cvt_pk_bf16(v1[0], v1[1]); w.w = cvt_pk_bf16(v1[2], v1[3]);
                    *(u32x4*)(rowp + bj * HALF) = w; } }
        return false;
    }
};
}

struct Args { const void* in[22]; float* out; unsigned char* ws; int ph_lo, ph_hi, flags, pad; };
constexpr int XCONV = 0, XSCORE = 96;
constexpr int CW_SCQ = 12288, SCP = 5, CW_ATQ = 12352;
enum { PH_PRO = 0, PH_H, PH_INPROJ, PH_POST, PH_SCORE, PH_SELECT, PH_ATTN, PH_OP1, PH_OP2, PH_WOUT, PH_ROUTER, PH_SCATTER, PH_MOE1, PH_MOE2, PH_FINAL, NPH };

__device__ __forceinline__ int dest_row(int mode, int n) {
    if (mode == 1) return n < 2640 ? n : n + 176;
    if (mode == 2) { const int g = n >> 11, c = n & 2047; return (c >> 7) * 256 + g * 128 + (c & 127); }
    return n;
}
__device__ __forceinline__ void convert_item(const float* __restrict__ W, int K, int N, int ld, bf16_t* WT, int mode, int item, int lane, LAS unsigned char* scr) {
    const int nblk = (N + 63) >> 6; const int kb = item / nblk, nb = item - kb * nblk; const int k0 = kb * 128, n0 = nb * 64;
    const int c4 = lane & 15, kr = lane >> 4;
    const bool ok = (n0 + 4 * c4) < N;
    const float* src = W + (size_t)(k0 + 2 * kr) * ld + n0 + 4 * c4;
#pragma unroll 4
    for (int i = 0; i < 16; ++i) {
        f32x4 v0 = (f32x4){0.f, 0.f, 0.f, 0.f}, v1 = v0;
        if (ok) { v0 = *(const f32x4*)(src + (size_t)(8 * i) * ld); v1 = *(const f32x4*)(src + (size_t)(8 * i + 1) * ld); }
        const int kk = 8 * i + 2 * kr;
#pragma unroll
        for (int e = 0; e < 4; ++e) *(LAS unsigned*)(scr + (4 * c4 + e) * 272 + kk * 2) = cvt_pk_bf16(v0[e], v1[e]);
    }
    LDS_WAIT(); asm volatile("" ::: "memory");
#pragma unroll 4
    for (int j = 0; j < 16; ++j) {
        const int q = j * 64 + lane, n = q >> 4, ch = q & 15;
        const u32x4 v = *(const LAS u32x4*)(scr + n * 272 + ch * 16);
        if (n0 + n < N) *(u32x4*)(WT + (size_t)dest_row(mode, n0 + n) * K + k0 + ch * 8) = v;
    }
    LDS_WAIT(); asm volatile("" ::: "memory");
}


__device__ __forceinline__ bf16_t f2bf(float f) { unsigned u = __float_as_uint(f); return (bf16_t)((u + 0x7fffu + ((u >> 16) & 1u)) >> 16); }
__device__ __forceinline__ float bfx(const u32x4& w, int i) { const unsigned u = w[i >> 1]; return (i & 1) ? bf_hi(u) : bf_lo(u); }
__device__ __forceinline__ void rope_sc(float pos, float inv, float& sn, float& cs) {
    const float ang = pos * inv;
    const double a = (double)ang; const double n = __builtin_rint(a * 0.15915494309189535); const float r = (float)(a - n * 6.283185307179586);
    sn = sinf(r); cs = cosf(r);
}
__device__ __forceinline__ void post_token(bf16_t* PROJ, bf16_t* KI, unsigned char* KC, unsigned char* VC, const int* positions, const float* kng, const float* knb, float inv16, float inv8, int t, int lane) {
    const float pos = (float)positions[t];
    bf16_t* row = PROJ + (size_t)t * DINP;
    float sn, cs, sn8, cs8;
    rope_sc(pos, inv16, sn, cs); rope_sc(pos, inv8, sn8, cs8);
#pragma unroll
    for (int i = 0; i < 2; ++i) {
        const int pp = lane + 64 * i, hd = pp >> 4, ii = pp & 15;
        bf16_t* p = row + CQ + hd * 128 + ii; const float a = bf2f(p[0]), b = bf2f(p[16]);
        p[0] = f2bf(a * cs - b * sn); p[16] = f2bf(b * cs + a * sn);
    }
#pragma unroll
    for (int i = 0; i < 2; ++i) {
        const int pp = lane + 64 * i, hd = pp >> 3, ii = pp & 7;
        bf16_t* p = row + CQI + hd * 64 + ii; const float a = bf2f(p[0]), b = bf2f(p[8]);
        p[0] = f2bf(a * cs8 - b * sn8); p[8] = f2bf(b * cs8 + a * sn8);
    }
    if (lane < 32) {
        const int g = lane >> 4, ii = lane & 15;
        const bf16_t* p = row + CK + g * 128 + ii; const float a = bf2f(p[0]), b = bf2f(p[16]);
        unsigned char* o = KC + (size_t)t * 256 + g * 128 + ii; o[0] = fp8_1(a * cs - b * sn); o[16] = fp8_1(b * cs + a * sn);
    }
#pragma unroll
    for (int i = 0; i < 3; ++i) { const int idx = lane + 64 * i, g = idx / 96, r = idx - g * 96; KC[(size_t)t * 256 + g * 128 + 32 + r] = fp8_1(bf2f(row[CK + g * 128 + 32 + r])); }
    { const u32x2 w = *(const u32x2*)(row + CV + 4 * lane); *(unsigned*)(VC + (size_t)t * 256 + 4 * lane) = pack4_fp8(bf_lo(w.x), bf_hi(w.x), bf_lo(w.y), bf_hi(w.y)); }
    {
        const float v = bf2f(row[CKI + lane]);
        const float mean = wave_sum(v) * (1.0f / 64.0f); const float d = v - mean; const float var = wave_sum(d * d) * (1.0f / 64.0f);
        const float y = d * rsqrtf(var + NORM_EPS) * kng[lane] + knb[lane];
        const float other = __shfl_xor(y, 8);
        float o = y;
        if (lane < 8) o = y * cs8 - other * sn8; else if (lane < 16) o = y * cs8 + other * sn8;
        KI[(size_t)t * 64 + lane] = f2bf(o);
    }
}

constexpr int HG_GB = 0, HG_Q1 = 33792, HG_Q2 = 51200, HG_K2 = 68608, HG_VT = 86016, HG_PB = 104448, HG_LB = 113664;
__device__ __forceinline__ void hgrn_cumsum(LAS unsigned char* lds, const u32x4& w0, const u32x4& w1, float l0, float l1, int tid) {
    LAS float* GB = (LAS float*)(lds + HG_GB); LAS float* LB = (LAS float*)(lds + HG_LB); LAS float* SEG = (LAS float*)(lds + HG_LB + 512);
    if (tid < 128) LB[tid] = 1.0f / (1.0f + expf(l1 - l0));
    __syncthreads();
    const int t = tid >> 3, dseg = tid & 7;
#pragma unroll
    for (int i = 0; i < 16; ++i) { const float z = i < 8 ? bfx(w0, i) : bfx(w1, i - 8); const float lb = LB[16 * dseg + i]; GB[t * 128 + 16 * dseg + i] = __logf(lb + (1.0f - lb) * sigmoidf_(z)); }
    __syncthreads();
    const int d = tid & 127, tq = tid >> 7;
    float z[16];
#pragma unroll
    for (int i = 0; i < 16; ++i) z[i] = GB[(16 * tq + i) * 128 + d];
    float a = 0.f;
#pragma unroll
    for (int i = 0; i < 16; ++i) { a += z[i]; z[i] = a; }
    SEG[tq * 128 + d] = a;
    __syncthreads();
    float pre = 0.f;
    for (int q = 0; q < tq; ++q) pre += SEG[q * 128 + d];
#pragma unroll
    for (int i = 0; i < 16; ++i) GB[(16 * tq + i) * 128 + d] = z[i] + pre;
    __syncthreads();
}
__device__ __forceinline__ void hgrn_vt(LAS unsigned char* lds, const u32x4& a, const u32x4& b, int tid) {
    const int s2 = tid & 31, eg = tid >> 5;
#pragma unroll
    for (int i = 0; i < 8; ++i) { const unsigned lo = (i & 1) ? (a[i >> 1] >> 16) : (a[i >> 1] & 0xffffu), hi = (i & 1) ? (b[i >> 1] >> 16) : (b[i >> 1] & 0xffffu);
        *(LAS unsigned*)(lds + HG_VT + (8 * eg + i) * 144 + s2 * 4) = lo | (hi << 16); }
}
__device__ __forceinline__ void hgrn_l1(LAS unsigned char* lds, const bf16_t* PROJ, const float* lb_logits, bf16_t* ST, float* DC, int c, int h, int tid, int wave, int lane) {
    const int t = tid >> 3, dseg = tid & 7, s2 = tid & 31, dg = tid >> 5;
    const bf16_t* pf = PROJ + (size_t)(c * 64 + t) * DINP + CHF + h * 128 + 16 * dseg;
    const bf16_t* pk = PROJ + (size_t)(c * 64 + 2 * s2) * DINP + CHF + h * 128 + 8 * dg;
    const u32x4 w0 = *(const u32x4*)pf, w1 = *(const u32x4*)(pf + 8);
    const u32x4 ka = *(const u32x4*)pk, kb = *(const u32x4*)(pk + DINP);
    const u32x4 va = *(const u32x4*)(pk - CHF + CHI), vb = *(const u32x4*)(pk - CHF + CHI + DINP);
    const float l0 = lb_logits[h * 128 + (tid & 127)], l1 = lb_logits[1024 + h * 128 + (tid & 127)];
    hgrn_cumsum(lds, w0, w1, l0, l1, tid);
    const LAS float* GB = (const LAS float*)(lds + HG_GB); const LAS float* LB = (const LAS float*)(lds + HG_LB);
    {
#pragma unroll
        for (int i = 0; i < 8; ++i) { const int d = 8 * dg + i; const float lb = LB[d], b63 = GB[63 * 128 + d];
            const float k0 = (1.0f - lb) * (1.0f - sigmoidf_(bfx(ka, i))), k1 = (1.0f - lb) * (1.0f - sigmoidf_(bfx(kb, i)));
            const float v0 = k0 * __expf(b63 - GB[(2 * s2) * 128 + d]), v1 = k1 * __expf(b63 - GB[(2 * s2 + 1) * 128 + d]);
            *(LAS unsigned*)(lds + HG_Q1 + d * 144 + s2 * 4) = cvt_pk_bf16(v0, v1); }
    }
    hgrn_vt(lds, va, vb, tid);
    __syncthreads();
    const int fr = lane & 15, fq = lane >> 4;
    bf16x8 af[2];
#pragma unroll
    for (int ks = 0; ks < 2; ++ks) af[ks] = *(const LAS bf16x8*)(lds + HG_VT + (16 * wave + fr) * 144 + (32 * ks + 8 * fq) * 2);
    bf16_t* dst = ST + ((size_t)(c * 8 + h) * 128) * 128;
#pragma unroll 2
    for (int dt = 0; dt < 8; ++dt) {
        f32x4 acc = (f32x4){0.f, 0.f, 0.f, 0.f};
#pragma unroll
        for (int ks = 0; ks < 2; ++ks) { const bf16x8 bfr = *(const LAS bf16x8*)(lds + HG_Q1 + (16 * dt + fr) * 144 + (32 * ks + 8 * fq) * 2); acc = __builtin_amdgcn_mfma_f32_16x16x32_bf16(af[ks], bfr, acc, 0, 0, 0); }
#pragma unroll
        for (int r = 0; r < 4; ++r) dst[(size_t)(16 * wave + 4 * fq + r) * 128 + 16 * dt + fr] = f2bf(acc[r]);
    }
    if (tid < 128) DC[(size_t)(c * 8 + h) * 128 + tid] = __expf(GB[63 * 128 + tid]);
    __syncthreads();
}
__device__ __forceinline__ void hgrn_l3(LAS unsigned char* lds, const bf16_t* PROJ, const float* lb_logits, const bf16_t* ST, const float* norm_g, unsigned char* REC, int c, int h, int tid, int wave, int lane) {
    const int t = tid >> 3, dseg = tid & 7, s2 = tid & 31, eg = tid >> 5, fr = lane & 15, fq = lane >> 4;
    const bf16_t* pf = PROJ + (size_t)(c * 64 + t) * DINP + CHF + h * 128 + 16 * dseg;
    const u32x4 f0 = *(const u32x4*)pf, f1 = *(const u32x4*)(pf + 8), q0 = *(const u32x4*)(pf - CHF + CHQ), q1 = *(const u32x4*)(pf - CHF + CHQ + 8);
    const u32x4 g0 = *(const u32x4*)(pf - CHF + CHG), g1 = *(const u32x4*)(pf - CHF + CHG + 8);
    const bf16_t* pv = PROJ + (size_t)(c * 64 + 2 * s2) * DINP + CHI + h * 128 + 8 * eg;
    const u32x4 va = *(const u32x4*)pv, vb = *(const u32x4*)(pv + DINP);
    const bf16_t* sp = ST + ((size_t)(c * 8 + h) * 128 + 16 * wave + fr) * 128 + 8 * fq;
    u32x4 sx[4];
#pragma unroll
    for (int ks = 0; ks < 4; ++ks) sx[ks] = *(const u32x4*)(sp + 32 * ks);
    const float l0 = lb_logits[h * 128 + (tid & 127)], l1 = lb_logits[1024 + h * 128 + (tid & 127)];
    hgrn_cumsum(lds, f0, f1, l0, l1, tid);
    const LAS float* GB = (const LAS float*)(lds + HG_GB); const LAS float* LB = (const LAS float*)(lds + HG_LB);
    {
        unsigned o1[8], o2[8], o3[8];
#pragma unroll
        for (int i = 0; i < 16; i += 2) {
            float a1[2], a2[2], a3[2];
#pragma unroll
            for (int j = 0; j < 2; ++j) { const int d = 16 * dseg + i + j; const float lb = LB[d], b = GB[t * 128 + d], br = GB[31 * 128 + d];
                const float z = (i + j) < 8 ? bfx(f0, i + j) : bfx(f1, i + j - 8), qv = (i + j) < 8 ? bfx(q0, i + j) : bfx(q1, i + j - 8);
                const float k = (1.0f - lb) * (1.0f - sigmoidf_(z)), q = siluf_(qv);
                a1[j] = q * __expf(b); a2[j] = q * __expf(b - br); a3[j] = k * __expf(br - b); }
            o1[i >> 1] = cvt_pk_bf16(a1[0], a1[1]); o2[i >> 1] = cvt_pk_bf16(a2[0], a2[1]); o3[i >> 1] = cvt_pk_bf16(a3[0], a3[1]);
        }
        LAS u32x4* d1 = (LAS u32x4*)(lds + HG_Q1 + t * 272 + dseg * 32); LAS u32x4* d2 = (LAS u32x4*)(lds + HG_Q2 + t * 272 + dseg * 32); LAS u32x4* d3 = (LAS u32x4*)(lds + HG_K2 + t * 272 + dseg * 32);
        d1[0] = (u32x4){o1[0], o1[1], o1[2], o1[3]}; d1[1] = (u32x4){o1[4], o1[5], o1[6], o1[7]};
        d2[0] = (u32x4){o2[0], o2[1], o2[2], o2[3]}; d2[1] = (u32x4){o2[4], o2[5], o2[6], o2[7]};
        d3[0] = (u32x4){o3[0], o3[1], o3[2], o3[3]}; d3[1] = (u32x4){o3[4], o3[5], o3[6], o3[7]};
    }
    hgrn_vt(lds, va, vb, tid);
    __syncthreads();
#pragma unroll
    for (int q = 0; q < 2; ++q) {
        const int tile = 2 * wave + q, tt = tile >> 2, stl = tile & 3;
        f32x4 acc = (f32x4){0.f, 0.f, 0.f, 0.f};
#pragma unroll
        for (int ks = 0; ks < 4; ++ks) { const bf16x8 a = *(const LAS bf16x8*)(lds + HG_Q2 + (16 * tt + fr) * 272 + (32 * ks + 8 * fq) * 2), b = *(const LAS bf16x8*)(lds + HG_K2 + (16 * stl + fr) * 272 + (32 * ks + 8 * fq) * 2);
            acc = __builtin_amdgcn_mfma_f32_16x16x32_bf16(a, b, acc, 0, 0, 0); }
#pragma unroll
        for (int r = 0; r < 4; ++r) { const int tr_ = 16 * tt + 4 * fq + r, s = 16 * stl + fr; *(LAS bf16_t*)(lds + HG_PB + tr_ * 144 + s * 2) = f2bf(s <= tr_ ? acc[r] : 0.f); }
    }
    __syncthreads();
    {
        bf16x8 b1[2], b2[4];
#pragma unroll
        for (int ks = 0; ks < 2; ++ks) b1[ks] = *(const LAS bf16x8*)(lds + HG_VT + (16 * wave + fr) * 144 + (32 * ks + 8 * fq) * 2);
#pragma unroll
        for (int ks = 0; ks < 4; ++ks) b2[ks] = __builtin_bit_cast(bf16x8, sx[ks]);
        LAS float* OB = (LAS float*)(lds + HG_GB);
#pragma unroll
        for (int tt = 0; tt < 4; ++tt) {
            f32x4 acc = (f32x4){0.f, 0.f, 0.f, 0.f};
#pragma unroll
            for (int ks = 0; ks < 2; ++ks) { const bf16x8 a = *(const LAS bf16x8*)(lds + HG_PB + (16 * tt + fr) * 144 + (32 * ks + 8 * fq) * 2); acc = __builtin_amdgcn_mfma_f32_16x16x32_bf16(a, b1[ks], acc, 0, 0, 0); }
#pragma unroll
            for (int ks = 0; ks < 4; ++ks) { const bf16x8 a = *(const LAS bf16x8*)(lds + HG_Q1 + (16 * tt + fr) * 272 + (32 * ks + 8 * fq) * 2); acc = __builtin_amdgcn_mfma_f32_16x16x32_bf16(a, b2[ks], acc, 0, 0, 0); }
#pragma unroll
            for (int r = 0; r < 4; ++r) OB[(16 * tt + 4 * fq + r) * 132 + 16 * wave + fr] = acc[r];
        }
    }
    __syncthreads();
    {
        const int es = dseg; const LAS float* OB = (const LAS float*)(lds + HG_GB);
        float o[16]; float ss = 0.f;
#pragma unroll
        for (int i = 0; i < 16; ++i) { o[i] = OB[t * 132 + 16 * es + i]; ss += o[i] * o[i]; }
        ss += __shfl_xor(ss, 1); ss += __shfl_xor(ss, 2); ss += __shfl_xor(ss, 4);
        const float rstd = rsqrtf(ss * (1.0f / 128.0f) + NORM_EPS);
        float rv[16];
#pragma unroll
        for (int i = 0; i < 16; ++i) { const float ga = i < 8 ? bfx(g0, i) : bfx(g1, i - 8); rv[i] = o[i] * (rstd * OP8_SCALE) * norm_g[16 * es + i] * siluf_(ga); }
        *(u32x4*)(REC + (size_t)(c * 64 + t) * 1024 + h * 128 + 16 * es) = (u32x4){pack4_fp8(rv[0], rv[1], rv[2], rv[3]), pack4_fp8(rv[4], rv[5], rv[6], rv[7]), pack4_fp8(rv[8], rv[9], rv[10], rv[11]), pack4_fp8(rv[12], rv[13], rv[14], rv[15])};
    }
    __syncthreads();
}

constexpr int SC_KT = 0, SC_SB = 36864, SC_SPITCH = 132;
__device__ __forceinline__ unsigned pk_f16(float a, float b) { return __builtin_bit_cast(unsigned, __builtin_amdgcn_cvt_pkrtz(a, b)); }
__device__ __forceinline__ void score_flush(LAS unsigned char* lds, unsigned short* SCORES, unsigned short* SEGMAX, int t0, int kt, int tid) {
    const LAS float* sb = (const LAS float*)(lds + SC_SB + (kt & 1) * (32 * SC_SPITCH * 4));
    const int row = tid >> 4, seg = tid & 15;
    const f32x4 a = *(const LAS f32x4*)(sb + row * SC_SPITCH + seg * 8), b = *(const LAS f32x4*)(sb + row * SC_SPITCH + seg * 8 + 4);
    unsigned short* dst = SCORES + (size_t)(t0 + row) * S + kt * 128 + seg * 8;
    *(u32x4*)dst = (u32x4){pk_f16(a[0], a[1]), pk_f16(a[2], a[3]), pk_f16(b[0], b[1]), pk_f16(b[2], b[3])};
    const float mx = fmaxf(fmaxf(fmaxf(a[0], a[1]), fmaxf(a[2], a[3])), fmaxf(fmaxf(b[0], b[1]), fmaxf(b[2], b[3])));
    SEGMAX[(size_t)(t0 + row) * 2048 + kt * 16 + seg] = (unsigned short)(pk_f16(mx, mx) & 0xffffu);
}
__device__ __forceinline__ void score_block(LAS unsigned char* lds, const bf16_t* PROJ, const bf16_t* KI, unsigned short* SCORES, unsigned short* SEGMAX, int qb, int kt0, int kt1, int tid, int wave, int lane) {
    const int t0 = qb * 32;
    const int r = lane & 31, hh = lane >> 5;
    bf16x8 Af[2][4]; float wv[2][16]; f32x2 wv2[2][8];
#pragma unroll
    for (int p = 0; p < 2; ++p) {
        const int tq = t0 + 4 * wave + 2 * p + (r >> 4); const bf16_t* qrow = PROJ + (size_t)tq * DINP + CQI + (r & 15) * 64 + 8 * hh;
#pragma unroll
        for (int ks = 0; ks < 4; ++ks) Af[p][ks] = *(const bf16x8*)(qrow + 16 * ks);
#pragma unroll
        for (int qq = 0; qq < 2; ++qq) {
            const bf16_t* wp = PROJ + (size_t)(t0 + 4 * wave + 2 * p + qq) * DINP + CWI + 4 * hh;
            const u32x2 wa = *(const u32x2*)wp, wb = *(const u32x2*)(wp + 8);
            wv[p][8 * qq + 0] = bf_lo(wa.x) * (1.0f / 32.0f); wv[p][8 * qq + 1] = bf_hi(wa.x) * (1.0f / 32.0f); wv[p][8 * qq + 2] = bf_lo(wa.y) * (1.0f / 32.0f); wv[p][8 * qq + 3] = bf_hi(wa.y) * (1.0f / 32.0f);
            wv[p][8 * qq + 4] = bf_lo(wb.x) * (1.0f / 32.0f); wv[p][8 * qq + 5] = bf_hi(wb.x) * (1.0f / 32.0f); wv[p][8 * qq + 6] = bf_lo(wb.y) * (1.0f / 32.0f); wv[p][8 * qq + 7] = bf_hi(wb.y) * (1.0f / 32.0f);
        }
#pragma unroll
        for (int i = 0; i < 8; ++i) wv2[p][i] = (f32x2){wv[p][2 * i], wv[p][2 * i + 1]};
    }
    const u32x2 tagsw = __builtin_amdgcn_permlane32_swap(0u, 1u, false, false); const int qsel = (int)tagsw[0];
    u32x4 stg[2];
#pragma unroll
    for (int i = 0; i < 2; ++i) { const int q = tid + 512 * i; stg[i] = *(const u32x4*)(KI + (size_t)(kt0 * 128 + (q >> 3)) * 64 + (q & 7) * 8); }
#pragma unroll
    for (int i = 0; i < 2; ++i) { const int q = tid + 512 * i; *(LAS u32x4*)(lds + SC_KT + (kt0 & 1) * 18432 + (q >> 3) * 144 + (q & 7) * 16) = stg[i]; }
    __syncthreads();
    for (int kt = kt0; kt < kt1; ++kt) {
        const LAS unsigned char* buf = lds + SC_KT + (kt & 1) * 18432;
        LAS float* sb = (LAS float*)(lds + SC_SB + (kt & 1) * (32 * SC_SPITCH * 4));
        if (kt + 1 < kt1) {
#pragma unroll
            for (int i = 0; i < 2; ++i) { const int q = tid + 512 * i; stg[i] = *(const u32x4*)(KI + (size_t)((kt + 1) * 128 + (q >> 3)) * 64 + (q & 7) * 8); }
        }
        __builtin_amdgcn_sched_barrier(0);
        if (kt > kt0) score_flush(lds, SCORES, SEGMAX, t0, kt - 1, tid);
        {
        f32x16 accP[2], accC[2];
#define SC_MFMA(cb) do { bf16x8 Bf[4]; _Pragma("unroll") for (int ks = 0; ks < 4; ++ks) Bf[ks] = *(const LAS bf16x8*)(buf + (32 * (cb) + r) * 144 + (16 * ks + 8 * hh) * 2); \
            _Pragma("unroll") for (int p = 0; p < 2; ++p) { _Pragma("unroll") for (int i = 0; i < 16; ++i) accC[p][i] = 0.f; \
                _Pragma("unroll") for (int ks = 0; ks < 4; ++ks) accC[p] = __builtin_amdgcn_mfma_f32_32x32x16_bf16(Af[p][ks], Bf[ks], accC[p], 0, 0, 0); } } while (0)
#define SC_RED(acc, cb) do { _Pragma("unroll") for (int p = 0; p < 2; ++p) { f32x2 s0 = {0.f, 0.f}, s1 = {0.f, 0.f}; \
            _Pragma("unroll") for (int reg = 0; reg < 8; reg += 2) { const f32x2 r0 = {relu_i(acc[p][reg]), relu_i(acc[p][reg + 1])}; const f32x2 r1 = {relu_i(acc[p][reg + 8]), relu_i(acc[p][reg + 9])}; \
                s0 = __builtin_elementwise_fma(wv2[p][reg >> 1], r0, s0); s1 = __builtin_elementwise_fma(wv2[p][4 + (reg >> 1)], r1, s1); } \
            const float p0 = s0[0] + s0[1], p1 = s1[0] + s1[1]; \
            const u32x2 sw = __builtin_amdgcn_permlane32_swap(__float_as_uint(p0), __float_as_uint(p1), false, false); \
            sb[(4 * wave + 2 * p + qsel) * SC_SPITCH + 32 * (cb) + r] = __uint_as_float(sw[0]) + __uint_as_float(sw[1]); } } while (0)
#define SC_INTERLEAVE() do { _Pragma("unroll") for (int i = 0; i < 8; ++i) { __builtin_amdgcn_sched_group_barrier(0x008, 1, 0); __builtin_amdgcn_sched_group_barrier(0x002, 8, 0); } } while (0)
        SC_MFMA(0);
        accP[0] = accC[0]; accP[1] = accC[1]; SC_MFMA(1); SC_RED(accP, 0); SC_INTERLEAVE();
        accP[0] = accC[0]; accP[1] = accC[1]; SC_MFMA(2); SC_RED(accP, 1); SC_INTERLEAVE();
        accP[0] = accC[0]; accP[1] = accC[1]; SC_MFMA(3); SC_RED(accP, 2); SC_INTERLEAVE();
        SC_RED(accC, 3);
#undef SC_MFMA
#undef SC_RED
#undef SC_INTERLEAVE
        }
        if (kt + 1 < kt1) {
#pragma unroll
            for (int i = 0; i < 2; ++i) { const int q = tid + 512 * i; *(LAS u32x4*)(lds + SC_KT + ((kt + 1) & 1) * 18432 + (q >> 3) * 144 + (q & 7) * 16) = stg[i]; }
        }
        __syncthreads();
    }
    score_flush(lds, SCORES, SEGMAX, t0, kt1 - 1, tid);
    __syncthreads();
}

template <int NV, bool EXACT>
__device__ __forceinline__ float wave_kth(const float (&v)[NV], int K) {
    const float NINF = -__builtin_inff();
    float mx = NINF, mn = __builtin_inff();
#pragma unroll
    for (int j = 0; j < NV; ++j) { mx = fmaxf(mx, v[j]); mn = fminf(mn, v[j] == NINF ? __builtin_inff() : v[j]); }
    mx = wave_max(mx); mn = -wave_max(-mn);
    int c = 0;
#pragma unroll
    for (int j = 0; j < NV; ++j) c += __popcll(__ballot(v[j] >= mx));
    if (c >= K) return mx;
    float lo = mn, hi = mx, tau = mn;
    for (int it = 0; it < 64; ++it) {
        const float mid = 0.5f * (lo + hi);
        if (!(mid > lo && mid < hi)) { tau = lo; break; }
        c = 0;
#pragma unroll
        for (int j = 0; j < NV; ++j) c += __popcll(__ballot(v[j] >= mid));
        if (c == K || (!EXACT && c > K && c <= K + (K >> 2))) { tau = mid; break; }
        if (c > K) lo = mid; else hi = mid;
        tau = lo;
    }
    return tau;
}
__device__ __forceinline__ float wave_kth16(const float (&v)[16], int K) { return wave_kth<16, true>(v, K); }
__device__ __forceinline__ int lanes_below(unsigned long long mask) { return (int)__builtin_amdgcn_mbcnt_hi((unsigned)(mask >> 32), __builtin_amdgcn_mbcnt_lo((unsigned)mask, 0u)); }
__device__ __forceinline__ float h2f(unsigned short h) { return (float)__builtin_bit_cast(_Float16, h); }
__device__ __forceinline__ float h2f_lo(unsigned u) { return h2f((unsigned short)(u & 0xffffu)); }
__device__ __forceinline__ float h2f_hi(unsigned u) { return h2f((unsigned short)(u >> 16)); }
__device__ __forceinline__ unsigned ge_mask8(const u32x4& v, unsigned T16) {
    unsigned m8 = 0;
#pragma unroll
    for (int w = 0; w < 4; ++w) { const unsigned vw_ = v[w];
        const s16x2 d = __builtin_elementwise_sub_sat(__builtin_bit_cast(s16x2, vw_), __builtin_bit_cast(s16x2, T16));
        const unsigned mm = ~__builtin_bit_cast(unsigned, d); m8 |= (((mm >> 15) & 1u) | ((mm >> 30) & 2u)) << (2 * w); }
    return m8;
}
__device__ __forceinline__ int append_bits(LAS int* list, int cnt, unsigned m8, int base) {
    for (;;) { const bool has = m8 != 0u; const unsigned long long mask = __ballot(has); if (!mask) break;
        const int pos = cnt + lanes_below(mask);
        if (has) { const int k = __builtin_ctz(m8); m8 &= m8 - 1u; if (pos < 1024) list[pos] = base + k; }
        cnt += __popcll(mask); }
    return cnt;
}
__device__ __forceinline__ int append_keys(LAS int* list, int cnt, unsigned m8, int base, const u32x4& v) {
    for (;;) { const bool has = m8 != 0u; const unsigned long long mask = __ballot(has); if (!mask) break;
        const int pos = cnt + lanes_below(mask);
        if (has) { const int k = __builtin_ctz(m8); m8 &= m8 - 1u;
            const unsigned dw = (k & 4) ? ((k & 2) ? v.w : v.z) : ((k & 2) ? v.y : v.x); const unsigned h = (k & 1) ? (dw >> 16) : (dw & 0xffffu);
            if (pos < 1024) list[pos] = (int)((h << 16) | (unsigned)(base + k)); }
        cnt += __popcll(mask); }
    return cnt;
}
__device__ __forceinline__ void select_row(LAS unsigned char* wl, const unsigned short* SCORES, const unsigned short* SEGMAX, int t, int lane) {
    LAS int* selw = (LAS int*)wl; LAS int* segl = (LAS int*)(wl + 1024); LAS int* cidx = (LAS int*)(wl + 5120);
    const float NINF = -__builtin_inff();
    const unsigned short* row = SCORES + (size_t)t * S; const int n = t + 1;
    float c[16]; int N;
    if (n <= 1024) {
#pragma unroll
        for (int j = 0; j < 16; ++j) { const int i = lane + 64 * j; c[j] = i < n ? h2f(row[i]) : NINF; }
        N = -1;
    } else {
        const int m = n >> 4; float s[16];
#pragma unroll
        for (int j = 0; j < 16; ++j) { const int i = lane + 64 * j; s[j] = i < m ? h2f(row[16 * i + 7]) : NINF; }
        const u32x4 NEG = (u32x4){0xfc00fc00u, 0xfc00fc00u, 0xfc00fc00u, 0xfc00fc00u};
        const unsigned short* smrow = SEGMAX + (size_t)t * 2048; const int nseg = (t >> 3) + 1;
        u32x4 sv[4];
#pragma unroll
        for (int u = 0; u < 4; ++u) { const int e8 = 8 * (lane + 64 * u); sv[u] = (e8 < nseg) ? *(const u32x4*)(smrow + e8) : NEG; }
        int K = 26, cnt = 0;
        for (;;) {
            const float tlo = (K >= m) ? NINF : wave_kth<16, false>(s, K);
            cnt = 0;
            const int nq = (n + 511) >> 9;
            if (tlo > 0.f) {
                const unsigned T16 = pk_f16(tlo, tlo);
                int ns = 0;
                {
#pragma unroll
                    for (int u = 0; u < 4; ++u) { const int e8 = 8 * (lane + 64 * u); unsigned m8 = ge_mask8(sv[u], T16);
                        const int nv = nseg - e8; if (nv < 8) m8 &= nv > 0 ? ((1u << nv) - 1u) : 0u;
                        ns = append_bits(segl, ns, m8, e8); }
                }
                if (ns > 1024) ns = 1024;
                for (int j0 = 0; j0 < ns; j0 += 512) {
                    u32x4 v[8]; int sg[8];
#pragma unroll
                    for (int u = 0; u < 8; ++u) { const int i = j0 + lane + 64 * u; sg[u] = i < ns ? segl[i] : -1; v[u] = sg[u] >= 0 ? *(const u32x4*)(row + 8 * sg[u]) : NEG; }
#pragma unroll
                    for (int u = 0; u < 8; ++u) { const int e = 8 * sg[u]; unsigned m8 = sg[u] >= 0 ? ge_mask8(v[u], T16) : 0u;
                        const int nv = t + 1 - e; if (nv < 8) m8 &= nv > 0 ? ((1u << nv) - 1u) : 0u;
                        cnt = append_keys(cidx, cnt, m8, e, v[u]); }
                }
            } else {
                for (int q0 = 0; q0 < nq; q0 += 4) {
                    u32x4 v[4];
#pragma unroll
                    for (int u = 0; u < 4; ++u) { const int e = 8 * (lane + 64 * (q0 + u)); v[u] = (e <= t) ? *(const u32x4*)(row + e) : (u32x4){0xfc00fc00u, 0xfc00fc00u, 0xfc00fc00u, 0xfc00fc00u}; }
#pragma unroll
                    for (int u = 0; u < 4; ++u) { const int e = 8 * (lane + 64 * (q0 + u));
#pragma unroll
                        for (int k = 0; k < 8; ++k) { const float x = (k & 1) ? h2f_hi(v[u][k >> 1]) : h2f_lo(v[u][k >> 1]);
                            const bool pred = (e + k <= t) && (x >= tlo); const unsigned long long mask = __ballot(pred);
                            if (mask) { const int pos = cnt + lanes_below(mask); const unsigned hb = (k & 1) ? (v[u][k >> 1] >> 16) : (v[u][k >> 1] & 0xffffu);
                                if (pred && pos < 1024) cidx[pos] = (int)((hb << 16) | (unsigned)(e + k)); cnt += __popcll(mask); } } }
                }
            }
            if (cnt >= 256 || K >= m) break;
            K *= 2;
        }
        N = cnt < 1024 ? cnt : 1024;
#pragma unroll
        for (int j = 0; j < 16; ++j) { const int i = lane + 64 * j; c[j] = i < N ? h2f((unsigned short)((unsigned)cidx[i] >> 16)) : NINF; }
    }
    float tau;
    if (N >= 0 && N <= 512) { const float c8[8] = {c[0], c[1], c[2], c[3], c[4], c[5], c[6], c[7]}; tau = wave_kth<8, true>(c8, 256); }
    else tau = wave_kth16(c, 256);
    int base = 0;
#pragma unroll
    for (int j = 0; j < 16; ++j) { const bool pred = c[j] >= tau; const unsigned long long mask = __ballot(pred);
        if (mask) { const int pos = base + lanes_below(mask); if (pred && pos < 256) selw[pos] = (N < 0) ? (lane + 64 * j) : (cidx[lane + 64 * j] & 0xffff); base += __popcll(mask); } }
}

__device__ __forceinline__ void attn_query(LAS unsigned char* wl, const bf16_t* PROJ, const unsigned char* KC, const unsigned char* VC, unsigned char* ATT, int t, int lane) {
    LAS int* selw = (LAS int*)wl; LAS float* L = (LAS float*)(wl + 1024);
    const int nsel = t < 255 ? t + 1 : 256;
    const int fr = lane & 15, fq = lane >> 4;
    constexpr float QS = 8.0f;
    long qh[2][4], ql[2][4];
#pragma unroll
    for (int g = 0; g < 2; ++g)
#pragma unroll
        for (int ks = 0; ks < 4; ++ks) {
            u32x4 z = (u32x4){0u, 0u, 0u, 0u};
            if (fr < 4) z = *(const u32x4*)(PROJ + (size_t)t * DINP + CQ + (4 * g + fr) * 128 + 32 * ks + 8 * fq);
            float qv[8], rv[8];
#pragma unroll
            for (int e = 0; e < 4; ++e) { qv[2 * e] = bf_lo(z[e]) * QS; qv[2 * e + 1] = bf_hi(z[e]) * QS; }
            const unsigned h0 = pack4_fp8(qv[0], qv[1], qv[2], qv[3]), h1 = pack4_fp8(qv[4], qv[5], qv[6], qv[7]);
            rv[0] = qv[0] - __builtin_amdgcn_cvt_f32_fp8((int)h0, 0); rv[1] = qv[1] - __builtin_amdgcn_cvt_f32_fp8((int)h0, 1); rv[2] = qv[2] - __builtin_amdgcn_cvt_f32_fp8((int)h0, 2); rv[3] = qv[3] - __builtin_amdgcn_cvt_f32_fp8((int)h0, 3);
            rv[4] = qv[4] - __builtin_amdgcn_cvt_f32_fp8((int)h1, 0); rv[5] = qv[5] - __builtin_amdgcn_cvt_f32_fp8((int)h1, 1); rv[6] = qv[6] - __builtin_amdgcn_cvt_f32_fp8((int)h1, 2); rv[7] = qv[7] - __builtin_amdgcn_cvt_f32_fp8((int)h1, 3);
            const unsigned l0 = pack4_fp8(rv[0] * 16.0f, rv[1] * 16.0f, rv[2] * 16.0f, rv[3] * 16.0f), l1 = pack4_fp8(rv[4] * 16.0f, rv[5] * 16.0f, rv[6] * 16.0f, rv[7] * 16.0f);
            qh[g][ks] = (long)(((unsigned long long)h1 << 32) | h0); ql[g][ks] = (long)(((unsigned long long)l1 << 32) | l0);
        }
    const float scale = 0.08838834764831845f / QS;
    const int nkt = (nsel + 15) >> 4;
    {
        LAS unsigned char* KT = wl + 9216;
        const int q4_ = lane >> 4, l15_ = lane & 15;
        u32x4 kw[3][4];
#define QK_LOAD(buf, kt) do { _Pragma("unroll") for (int u = 0; u < 4; ++u) { const unsigned off_ = (unsigned)selw[16 * (kt) + 4 * u + q4_] * 256u + 16u * (unsigned)l15_; kw[buf][u] = *(const u32x4*)((const char*)KC + off_); } } while (0)
#define QK_COMP(buf, kt) do { _Pragma("unroll") for (int u = 0; u < 4; ++u) *(LAS u32x4*)(KT + (4 * u + q4_) * 272 + 16 * l15_) = kw[buf][u];     \
        _Pragma("unroll") for (int g = 0; g < 2; ++g) { f32x4 acch = (f32x4){0.f, 0.f, 0.f, 0.f}, accl = (f32x4){0.f, 0.f, 0.f, 0.f}; \
            _Pragma("unroll") for (int ks = 0; ks < 4; ++ks) { const long kf_ = *(const LAS long*)(KT + fr * 272 + g * 128 + 32 * ks + 8 * fq); \
                acch = __builtin_amdgcn_mfma_f32_16x16x32_fp8_fp8(qh[g][ks], kf_, acch, 0, 0, 0); accl = __builtin_amdgcn_mfma_f32_16x16x32_fp8_fp8(ql[g][ks], kf_, accl, 0, 0, 0); } \
            if (fq == 0) { _Pragma("unroll") for (int r = 0; r < 4; ++r) L[(4 * g + r) * 256 + 16 * (kt) + fr] = (16 * (kt) + fr < nsel) ? (acch[r] + accl[r] * 0.0625f) * scale : -__builtin_inff(); } } } while (0)
        QK_LOAD(0, 0); if (1 < nkt) QK_LOAD(1, 1);
        for (int kt = 0; kt < nkt; kt += 3) {
            if (kt + 2 < nkt) QK_LOAD(2, kt + 2);
            __builtin_amdgcn_sched_barrier(0);
            QK_COMP(0, kt);
            if (kt + 1 < nkt) { if (kt + 3 < nkt) QK_LOAD(0, kt + 3); __builtin_amdgcn_sched_barrier(0); QK_COMP(1, kt + 1); }
            if (kt + 2 < nkt) { if (kt + 4 < nkt) QK_LOAD(1, kt + 4); __builtin_amdgcn_sched_barrier(0); QK_COMP(2, kt + 2); }
        }
#undef QK_LOAD
#undef QK_COMP
        if (fq == 0) { for (int kt = nkt; kt < 16; ++kt) {
#pragma unroll
            for (int r = 0; r < 8; ++r) L[r * 256 + 16 * kt + fr] = -__builtin_inff(); } }
    }
    float p[8][4];
#pragma unroll
    for (int hd = 0; hd < 8; ++hd) { float m = -__builtin_inff();
#pragma unroll
        for (int i = 0; i < 4; ++i) { p[hd][i] = L[hd * 256 + 4 * lane + i]; m = fmaxf(m, p[hd][i]); }
        m = wave_max(m); float s = 0.f;
#pragma unroll
        for (int i = 0; i < 4; ++i) { p[hd][i] = __expf(p[hd][i] - m); s += p[hd][i]; }
        s = 1.0f / wave_sum(s);
#pragma unroll
        for (int i = 0; i < 4; ++i) p[hd][i] *= s; }
    constexpr float PS = 256.0f;
    LAS unsigned* Ph = (LAS unsigned*)(wl + 1024); LAS unsigned* Pl = (LAS unsigned*)(wl + 1024 + 2048);
#pragma unroll
    for (int hd = 0; hd < 8; ++hd) {
        const float a0 = p[hd][0] * PS, a1 = p[hd][1] * PS, a2 = p[hd][2] * PS, a3 = p[hd][3] * PS;
        const unsigned h = pack4_fp8(a0, a1, a2, a3);
        const unsigned l = pack4_fp8(a0 - __builtin_amdgcn_cvt_f32_fp8((int)h, 0), a1 - __builtin_amdgcn_cvt_f32_fp8((int)h, 1), a2 - __builtin_amdgcn_cvt_f32_fp8((int)h, 2), a3 - __builtin_amdgcn_cvt_f32_fp8((int)h, 3));
        Ph[hd * 64 + lane] = h; Pl[hd * 64 + lane] = l;
    }
    LAS unsigned char* VT = wl + 9216;
    const int ii = lane & 15, kq = lane >> 4;
    f32x4 acc[16];
#pragma unroll
    for (int nt = 0; nt < 16; ++nt) acc[nt] = (f32x4){0.f, 0.f, 0.f, 0.f};
    const int nch = (nsel + 15) >> 4;
    u32x4 vw[3][4];
#define PV_LOAD(buf, c) do { _Pragma("unroll") for (int u = 0; u < 4; ++u) { const unsigned off_ = (unsigned)selw[16 * (c) + 4 * u + kq] * 256u + 16u * (unsigned)ii; vw[buf][u] = *(const u32x4*)((const char*)VC + off_); } } while (0)
#define PV_COMP(buf, c) do { _Pragma("unroll") for (int u = 0; u < 4; ++u) { LAS u32x2* d_ = (LAS u32x2*)(VT + (16 * ((c) & 1) + 4 * u + kq) * 264 + 16 * ii); d_[0] = (u32x2){vw[buf][u].x, vw[buf][u].y}; d_[1] = (u32x2){vw[buf][u].z, vw[buf][u].w}; } \
        if (((c) & 1) || (c) == nch - 1) { \
            if (!((c) & 1)) { _Pragma("unroll") for (int u = 0; u < 4; ++u) { LAS u32x2* d_ = (LAS u32x2*)(VT + (16 + 4 * u + kq) * 264 + 16 * ii); d_[0] = (u32x2){0u, 0u}; d_[1] = (u32x2){0u, 0u}; } } \
            long pa[2]; _Pragma("unroll") for (int g = 0; g < 2; ++g) { const int po_ = (g * 4 + (ii & 3)) * 256 + 32 * ((c) >> 1) + 8 * kq;     \
                const long h_ = *(const LAS long*)((const LAS unsigned char*)Ph + po_ + ((ii & 4) ? 2048 : 0)); pa[g] = ii < 8 ? h_ : 0l; } \
            _Pragma("unroll") for (int nt = 0; nt < 16; ++nt) { const v2i32 t_ = __builtin_amdgcn_ds_read_tr8_b64_v2i32((LAS v2i32*)(VT + (8 * kq + (ii >> 1)) * 264 + 16 * nt + 8 * (ii & 1))); \
                const long b_ = __builtin_bit_cast(long, t_); \
                acc[nt] = __builtin_amdgcn_mfma_f32_16x16x32_fp8_fp8(pa[nt >> 3], b_, acc[nt], 0, 0, 0); } } } while (0)
    PV_LOAD(0, 0); if (1 < nch) PV_LOAD(1, 1);
    for (int c = 0; c < nch; c += 3) {
        if (c + 2 < nch) PV_LOAD(2, c + 2);
        __builtin_amdgcn_sched_barrier(0);
        PV_COMP(0, c);
        if (c + 1 < nch) { if (c + 3 < nch) PV_LOAD(0, c + 3); __builtin_amdgcn_sched_barrier(0); PV_COMP(1, c + 1); }
        if (c + 2 < nch) { if (c + 4 < nch) PV_LOAD(1, c + 4); __builtin_amdgcn_sched_barrier(0); PV_COMP(2, c + 2); }
    }
#undef PV_LOAD
#undef PV_COMP
    LAS float* OB = (LAS float*)(wl + 1024 + 4096);
    LAS float* OB2 = (LAS float*)(wl + 1024);
    if (kq < 2) {
        LAS float* ob = kq == 0 ? OB : OB2;
#pragma unroll
        for (int nt = 0; nt < 16; ++nt)
#pragma unroll
            for (int r = 0; r < 4; ++r) ob[(4 * (nt >> 3) + r) * 128 + 16 * (nt & 7) + ii] = acc[nt][r];
    }
    {
        const f32x4 a0 = *(const LAS f32x4*)(OB + 16 * lane) + *(const LAS f32x4*)(OB2 + 16 * lane), a1 = *(const LAS f32x4*)(OB + 16 * lane + 4) + *(const LAS f32x4*)(OB2 + 16 * lane + 4),
                    a2 = *(const LAS f32x4*)(OB + 16 * lane + 8) + *(const LAS f32x4*)(OB2 + 16 * lane + 8), a3 = *(const LAS f32x4*)(OB + 16 * lane + 12) + *(const LAS f32x4*)(OB2 + 16 * lane + 12);
        const f32x4 b0 = a0 * (OP8_SCALE / PS), b1 = a1 * (OP8_SCALE / PS), b2 = a2 * (OP8_SCALE / PS), b3 = a3 * (OP8_SCALE / PS);
        *(u32x4*)(ATT + (size_t)t * 1024 + 16 * lane) = (u32x4){pack4_fp8(b0[0], b0[1], b0[2], b0[3]), pack4_fp8(b1[0], b1[1], b1[2], b1[3]), pack4_fp8(b2[0], b2[1], b2[2], b2[3]), pack4_fp8(b3[0], b3[1], b3[2], b3[3])};
    }
}


__device__ __forceinline__ void convert_item8(const float* __restrict__ W, int K, int N, int ld, unsigned char* WT, int mode, int item, int lane, LAS unsigned char* scr) {
    const int nblk = N >> 6; const int kb = item / nblk, nb = item - kb * nblk; const int k0 = kb * 256, n0 = nb * 64;
    const int c4 = lane & 15, kr = lane >> 4;
    const float* src = W + (size_t)(k0 + 4 * kr) * ld + n0 + 4 * c4;
#pragma unroll 4
    for (int i = 0; i < 16; ++i) {
        f32x4 v[4];
#pragma unroll
        for (int r = 0; r < 4; ++r) v[r] = __builtin_nontemporal_load((const f32x4*)(src + (size_t)(16 * i + r) * ld));
        const int kk = 16 * i + 4 * kr;
#pragma unroll
        for (int e = 0; e < 4; ++e) *(LAS unsigned*)(scr + (4 * c4 + e) * 272 + kk) = pack4_fp8(v[0][e] * W8_SCALE, v[1][e] * W8_SCALE, v[2][e] * W8_SCALE, v[3][e] * W8_SCALE);
    }
    LDS_WAIT(); asm volatile("" ::: "memory");
#pragma unroll 4
    for (int j = 0; j < 16; ++j) {
        const int q = j * 64 + lane, n = q >> 4, ch = q & 15;
        const u32x4 v = *(const LAS u32x4*)(scr + n * 272 + ch * 16);
        *(u32x4*)(WT + (size_t)dest_row(mode, n0 + n) * K + k0 + ch * 16) = v;
    }
    LDS_WAIT(); asm volatile("" ::: "memory");
}

struct Conv8Job { const float* W; unsigned char* WT; int N; int mode; size_t w_estride, wt_estride; int items_per_e; };
constexpr int C8_PITCH = 272, C8_IMG = 256 * C8_PITCH;
__device__ __forceinline__ void conv8_load(const Conv8Job& jb, int item, int h, int wave, int lane, f32x4 (&v)[16]) {
    const int e = item / jb.items_per_e, r = item - e * jb.items_per_e; const int nblk = jb.N >> 8; const int kb = r / nblk, nb = r - kb * nblk;
    const float* src = jb.W + (size_t)e * jb.w_estride + (size_t)(kb * 256 + 32 * wave + 16 * h) * jb.N + nb * 256 + 4 * lane;
#pragma unroll
    for (int i = 0; i < 16; ++i) v[i] = __builtin_nontemporal_load((const f32x4*)(src + (size_t)i * jb.N));
}
__device__ __forceinline__ void conv8_to_lds(LAS unsigned char* img, int h, int wave, int lane, const f32x4 (&v)[16]) {
#pragma unroll
    for (int e = 0; e < 4; ++e) { u32x4 w;
#pragma unroll
        for (int g = 0; g < 4; ++g) w[g] = pack4_fp8(v[4 * g][e] * W8_SCALE, v[4 * g + 1][e] * W8_SCALE, v[4 * g + 2][e] * W8_SCALE, v[4 * g + 3][e] * W8_SCALE);
        *(LAS u32x4*)(img + (4 * lane + e) * C8_PITCH + 32 * wave + 16 * h) = w; }
}
__device__ __forceinline__ void conv8_store(const Conv8Job& jb, int item, const LAS unsigned char* img, int tid) {
    const int e = item / jb.items_per_e, r = item - e * jb.items_per_e; const int nblk = jb.N >> 8; const int kb = r / nblk, nb = r - kb * nblk;
    unsigned char* dst = jb.WT + (size_t)e * jb.wt_estride + kb * 256;
#pragma unroll
    for (int j = 0; j < 8; ++j) { const int q = j * 512 + tid, n = q >> 4, ch = q & 15;
        __builtin_nontemporal_store(*(const LAS u32x4*)(img + n * C8_PITCH + ch * 16), (u32x4*)(dst + (size_t)dest_row(jb.mode, nb * 256 + n) * 2048 + ch * 16)); }
}
__device__ __forceinline__ void conv8_run(LAS unsigned char* lds, const Conv8Job& jb, int n_items, int wg, int G, int tid, int wave, int lane) {
    if (wg >= n_items) return;
    f32x4 a[16], b[16]; int par = 0;
    conv8_load(jb, wg, 0, wave, lane, a); conv8_load(jb, wg, 1, wave, lane, b);
    for (int it = wg; it < n_items; it += G, par ^= 1) {
        LAS unsigned char* img = lds + par * C8_IMG;
        const int nx = (it + G < n_items) ? it + G : it;
        conv8_to_lds(img, 0, wave, lane, a); __builtin_amdgcn_sched_barrier(0);
        conv8_load(jb, nx, 0, wave, lane, a); __builtin_amdgcn_sched_barrier(0);
        conv8_to_lds(img, 1, wave, lane, b); __builtin_amdgcn_sched_barrier(0);
        conv8_load(jb, nx, 1, wave, lane, b); __builtin_amdgcn_sched_barrier(0);
        __syncthreads();
        conv8_store(jb, it, img, tid);
    }
    __syncthreads();
}

__global__ void __launch_bounds__(NTHR, 2) fwd_kernel(Args args) {
    extern __shared__ __attribute__((aligned(16))) unsigned char lds_raw[];
    LAS unsigned char* lds = (LAS unsigned char*)lds_raw;
    volatile LAS unsigned* MISC = (volatile LAS unsigned*)(lds + LDS_MISC);
    const int tid = threadIdx.x, lane = tid & 63, wave = __builtin_amdgcn_readfirstlane(tid >> 6);
    const int G = gridDim.x, wg = blockIdx.x;
    unsigned char* ws = args.ws;
    unsigned* ctl = (unsigned*)(ws + WS_CTL);
    const int lo = args.ph_lo, hi = args.ph_hi;
    const float* x = (const float*)args.in[0]; const float* cvec = (const float*)args.in[1]; const int* positions = (const int*)args.in[2];
    const float* w_ada = (const float*)args.in[3]; const float* b_ada = (const float*)args.in[4]; const float* norm1_g = (const float*)args.in[5];
    const float* w_in = (const float*)args.in[6]; const float* idx_knorm_g = (const float*)args.in[7]; const float* idx_knorm_b = (const float*)args.in[8];
    const float* lb_logits = (const float*)args.in[9]; const float* hgrn_norm_g = (const float*)args.in[10];
    const float* w_proj_att = (const float*)args.in[11]; const float* w_proj_hgrn = (const float*)args.in[12]; const float* w_out = (const float*)args.in[13];
    const float* norm2_g = (const float*)args.in[14]; const float* w_router = (const float*)args.in[15]; const float* b_router = (const float*)args.in[16];
    const float* w1 = (const float*)args.in[17]; const float* b1 = (const float*)args.in[18]; const float* w2 = (const float*)args.in[19]; const float* b2 = (const float*)args.in[20];
    const float* final_g = (const float*)args.in[21];
    float* out = args.out;
    float* MOD = (float*)(ws + WS_MOD); int* TOPE = (int*)(ws + WS_TOPE); float* GATE = (float*)(ws + WS_GATE); int* SLOT = (int*)(ws + WS_SLOT);
    bf16_t* WIN_T = (bf16_t*)(ws + WS_WIN_T); bf16_t* WA_T = (bf16_t*)(ws + WS_WA_T); bf16_t* WH_T = (bf16_t*)(ws + WS_WH_T); bf16_t* WO_T = (bf16_t*)(ws + WS_WO_T);
    unsigned char* WIN_T8 = ws + WS_WIN_T + 8 * MiB;
    unsigned char* HA8 = ws + WS_SCORES;
    unsigned char* W1_T = ws + WS_W1_T; unsigned char* W2_T = ws + WS_W2_T;
    bf16_t* HB = (bf16_t*)(ws + WS_H); bf16_t* PROJ = (bf16_t*)(ws + WS_PROJ);
    bf16_t* DELTA = (bf16_t*)(ws + WS_ATT);
    unsigned char* ACT = ws + WS_ACT; bf16_t* YB = (bf16_t*)(ws + WS_YB);
    int* TOKS = (int*)(ws + WS_TOKS);
    unsigned char* H8 = ws + WS_H;
    bf16_t* KI = (bf16_t*)(ws + WS_KI); unsigned char* KC = ws + WS_KC; unsigned char* VC = ws + WS_VC;
    bf16_t* ST = (bf16_t*)(ws + WS_ST); float* DC = (float*)(ws + WS_DC);
    unsigned char* ATT = ws + WS_ATT; unsigned char* REC = ATT + (size_t)S * 1024;        bf16_t* MERGED = (bf16_t*)(ws + WS_MERGED); unsigned short* SCORES = (unsigned short*)(ws + WS_SCORES);
    unsigned short* SEGMAX = (unsigned short*)(ws + WS_X1);

    for (int u = tid; u < 128; u += NTHR) MISC[u] = 0u;
    __syncthreads();
    const bool one_launch = (hi - lo) > 1;
    XcdBarrier bar; bar.bar = ctl + CW_BAR; bar.x = 0; bar.st = MISC + 8;
    if (one_launch) bar = xcd_barrier_post(ctl + CW_BAR, MISC + 8);
#define IN(k) (lo <= (k) && (k) < hi)
#define SEAM(k) do { if (IN(k) && IN((k) + 1)) xcd_barrier(bar); } while (0)


    if (IN(PH_PRO)) {
        for (int cb = wg; cb < 256; cb += G) {
            LAS float* red = (LAS float*)lds;
            const int c4 = tid % 12, kg = tid / 12;
            f32x4 acc = (f32x4){0.f, 0.f, 0.f, 0.f};
            if (kg < 42) {
                const float* wp = w_ada + (size_t)cb * 48 + 4 * c4;
#pragma unroll 7
                for (int j = 0; j < 49; ++j) { const int k = kg + 42 * j; if (k < D) { const f32x4 v = __builtin_nontemporal_load((const f32x4*)(wp + (size_t)k * (6 * D))); acc += siluf_(cvec[k]) * v; } }
                *(LAS f32x4*)(red + kg * 48 + 4 * c4) = acc;
            }
            __syncthreads();
            if (tid < 48) { float s = b_ada[cb * 48 + tid];
#pragma unroll 6
                for (int q = 0; q < 42; ++q) s += red[q * 48 + tid];
                MOD[cb * 48 + tid] = s; }
            __syncthreads();
        }
        LAS unsigned char* scr = lds + wave * 17408;
        const int gw = wg * NWAVES + wave, NGW = G * NWAVES;
        {
            constexpr int NB_IN = (1104 + 63) / 64;
            for (int it = gw; it < 16 * NB_IN; it += NGW) convert_item(w_in + 1536, 2048, 1104, DIN, WIN_T, 0, it, lane, scr);
            for (int it = gw; it < 4 * 32; it += NGW) convert_item8(w_proj_att, 1024, 2048, 2048, (unsigned char*)WA_T, 0, it, lane, scr);
            for (int it = gw; it < 4 * 32; it += NGW) convert_item8(w_proj_hgrn, 1024, 2048, 2048, (unsigned char*)WA_T + (size_t)2048 * 1024, 0, it, lane, scr);
            for (int it = gw; it < 8 * 32; it += NGW) convert_item8(w_out, 2048, 2048, 2048, (unsigned char*)WO_T, 0, it, lane, scr);
            for (int it = gw; it < 8 * 24; it += NGW) convert_item8(w_in, 2048, 1536, DIN, WIN_T8, 0, it, lane, scr);
            for (int it = gw; it < 8 * 128; it += NGW) convert_item8(w_in + 2640, 2048, 8192, DIN, WIN_T8 + (size_t)1536 * 2048, 0, it, lane, scr);
            for (size_t i = (size_t)wg * NTHR + tid; i < (size_t)176 * 2048 * 2 / 16; i += (size_t)G * NTHR) ((u32x4*)(WIN_T + (size_t)1104 * 2048))[i] = (u32x4){0u, 0u, 0u, 0u};
        }
    }
    SEAM(PH_PRO);

    {
    if (IN(PH_H)) {
        const float* sh1 = MOD; const float* sc1 = MOD + D;
        const int gw = wg * NWAVES + wave, NGW = G * NWAVES;
        f32x4 gs[8], sh[8];
#pragma unroll
        for (int j = 0; j < 8; ++j) { const int c = 4 * lane + 256 * j; const f32x4 g = *(const f32x4*)(norm1_g + c), sc = *(const f32x4*)(sc1 + c); sh[j] = *(const f32x4*)(sh1 + c);
#pragma unroll
            for (int e = 0; e < 4; ++e) gs[j][e] = g[e] * (1.0f + sc[e]); }
        for (int t = gw; t < S; t += NGW) {
            const f32x4* xr = (const f32x4*)(x + (size_t)t * D) + lane;
            f32x4 v[8]; float ss = 0.f;
#pragma unroll
            for (int j = 0; j < 8; ++j) { v[j] = xr[64 * j]; ss += (v[j][0] * v[j][0] + v[j][1] * v[j][1]) + (v[j][2] * v[j][2] + v[j][3] * v[j][3]); }
            const float rstd = rsqrtf(wave_sum(ss) * (1.0f / D) + NORM_EPS);
#pragma unroll
            for (int j = 0; j < 8; ++j) { const f32x4 h = v[j] * rstd * gs[j] + sh[j]; u32x2 w; w.x = cvt_pk_bf16(h[0], h[1]); w.y = cvt_pk_bf16(h[2], h[3]);
                *(u32x2*)(HB + (size_t)t * D + 4 * lane + 256 * j) = w;
                *(unsigned*)(HA8 + (size_t)t * D + 4 * lane + 256 * j) = pack4_fp8(h[0], h[1], h[2], h[3]); }
        }
    }
    SEAM(PH_H);
    if (IN(PH_INPROJ)) {
        const int XC = (G == 256) ? XCONV : 0;
        const Conv8Job j1{w1, W1_T, 4096, 2, (size_t)2048 * 4096, (size_t)4096 * 2048, 8 * 16};
        const Conv8Job j2{w2, W2_T, 2048, 0, (size_t)2048 * 2048, (size_t)2048 * 2048, 8 * 8};
        if (G != 256) { conv8_run(lds, j1, NEXP * 8 * 16, wg, G, tid, wave, lane); conv8_run(lds, j2, NEXP * 8 * 8, wg, G, tid, wave, lane); }
        if (wg < XC) { conv8_run(lds, j1, NEXP * 8 * 16, wg, XC, tid, wave, lane); conv8_run(lds, j2, NEXP * 8 * 8, wg, XC, tid, wave, lane); }
        else {
            const int Gg = G - XC, cg = wg - XC;
            {
                pg8::Gemm g8{HA8, WIN_T8, 2048, 0, nullptr, 0}; pg8::StaticOrder S8; S8.init(S, 9728, Gg, cg);
                const int full8 = 2432 / Gg, rem8 = 2432 - full8 * Gg;
                if (Gg == 256) S8.skew(8, (wg >= 128 && wg < 192) ? -1 : (wg < 128 ? wg : wg - 64), 192);
                else if (rem8 > 0) S8.skew(full8, cg < rem8 ? cg : -1, rem8);
                pg8::EpiBf16 E8{PROJ, DINP, nullptr, 0, 1.0f / W8_SCALE, 6, 1280};
                pg8::gemm_phase<pg8::EpiBf16, pg8::StaticOrder, true>(lds, g8, S8, E8);
            }
            {
                pg8::Gemm g{HB, WIN_T, 2048, 0, nullptr, 0}; pg8::StaticOrder So; So.init(S, 1280, Gg, Gg == 256 ? (wg + 128) % G : (cg + Gg - (2432 % Gg)) % Gg);
                pg8::EpiBf16 E{PROJ + CQI, DINP, nullptr, 0, 1.0f, 1 << 30, 0};
                pg8::gemm_phase<pg8::EpiBf16, pg8::StaticOrder>(lds, g, So, E);
            }
        }
    }
    SEAM(PH_INPROJ);
    if (IN(PH_POST)) {
        const int gw = wg * NWAVES + wave, NGW = G * NWAVES;
        const float inv16 = powf(500000.0f, -(float)(lane & 15) * (1.0f / 16.0f)), inv8 = powf(500000.0f, -(float)(lane & 7) * (1.0f / 8.0f));
        for (int t = gw; t < S; t += NGW) post_token(PROJ, KI, KC, VC, positions, idx_knorm_g, idx_knorm_b, inv16, inv8, t, lane);
        __syncthreads();
        for (int u = wg; u < 2048; u += G) hgrn_l1(lds, PROJ, lb_logits, ST, DC, u >> 3, u & 7, tid, wave, lane);
    }
    SEAM(PH_POST);
    if (IN(PH_SCORE)) {
        for (int idx = wg * NTHR + tid; idx < 8 * 128 * 128; idx += G * NTHR) {
            const int h = idx >> 14, d = idx & 127; float s = 0.f;
            bf16_t* sp = ST + idx; const float* dp = DC + h * 128 + d;
            for (int c = 0; c < 256; c += 16) {
                float l[16], dc[16];
#pragma unroll
                for (int i = 0; i < 16; ++i) { l[i] = bf2f(sp[(size_t)(c + i) * 131072]); dc[i] = dp[(size_t)(c + i) * 1024]; }
#pragma unroll
                for (int i = 0; i < 16; ++i) { sp[(size_t)(c + i) * 131072] = f2bf(s); s = dc[i] * s + l[i]; }
            }
        }
        {
            const int XS = (G == 256) ? XSCORE : 0;
            if (wg < XS) {
                const Conv8Job j1{w1, W1_T, 4096, 2, (size_t)2048 * 4096, (size_t)4096 * 2048, 8 * 16};
                const Conv8Job j2{w2, W2_T, 2048, 0, (size_t)2048 * 2048, (size_t)2048 * 2048, 8 * 8};
                __syncthreads();
                conv8_run(lds, j1, NEXP * 8 * 16, wg, XS, tid, wave, lane); conv8_run(lds, j2, NEXP * 8 * 8, wg, XS, tid, wave, lane);
            }
            for (;;) {
                if (tid == 0) MISC[100] = __hip_atomic_fetch_add(ctl + CW_SCQ, 1u, __ATOMIC_RELAXED, __HIP_MEMORY_SCOPE_AGENT);
                __syncthreads();
                const int item = (int)MISC[100];
                __syncthreads();
                if (item >= 252 * 6) break;
                int j, lo, hi;
                if (item < 504) { j = item >> 1; const int T = ((8 + j) >> 2) + ((511 - j) >> 2) + 2; const int p = item & 1; lo = p * T / 3; hi = (p + 1) * T / 3; }
                else { const int i2 = item - 504; j = i2 >> 2; const int T = ((8 + j) >> 2) + ((511 - j) >> 2) + 2; const int p = i2 & 3, b = 2 * T / 3; lo = b + p * (T - b) / 4; hi = b + (p + 1) * (T - b) / 4; }
                const int qa = 8 + j, qb2 = 511 - j, na = (qa >> 2) + 1;
                const int a0 = lo < na ? lo : na, a1 = hi < na ? hi : na, b0 = (lo > na ? lo : na) - na, b1 = (hi > na ? hi : na) - na;
                if (a1 > a0) score_block(lds, PROJ, KI, SCORES, SEGMAX, qa, a0, a1, tid, wave, lane);
                if (b1 > b0) score_block(lds, PROJ, KI, SCORES, SEGMAX, qb2, b0, b1, tid, wave, lane);
            }
        }
    }
    SEAM(PH_SCORE);
    if (IN(PH_ATTN)) {
        const int gw = wg * NWAVES + wave, NGW = G * NWAVES;
        for (int u = wg; u < 2048; u += G) hgrn_l3(lds, PROJ, lb_logits, ST, hgrn_norm_g, REC, u >> 3, u & 7, tid, wave, lane);
        {
            for (;;) {
                unsigned tq = 0; if (lane == 0) tq = __hip_atomic_fetch_add(ctl + CW_ATQ, 1u, __ATOMIC_RELAXED, __HIP_MEMORY_SCOPE_AGENT);
                tq = (unsigned)__builtin_amdgcn_readfirstlane((int)tq);
                if (tq >= (unsigned)S) break;
                const int t = S - 1 - (int)tq;
                LAS unsigned char* wl = lds + wave * 17664;
                if (t >= 256) select_row(wl, SCORES, SEGMAX, t, lane);
                else {
#pragma unroll
                    for (int i = 0; i < 4; ++i) { const int idx = lane + 64 * i; ((LAS int*)wl)[idx] = idx <= t ? idx : 0; }
                }
                attn_query(wl, PROJ, KC, VC, ATT, t, lane);
            }
        }
    }
    SEAM(PH_ATTN);
    if (IN(PH_OP1)) {
        pg8::Gemm g{ATT, WA_T, 1024, (size_t)2048 * 1024, nullptr, (size_t)S * 1024};
        pg8::TwoPartOrder So; So.init(S, 2048, G, wg);
        pg8::EpiGate2 E{(unsigned char*)MERGED, PROJ + CGA, PROJ + CGR};
        pg8::gemm_phase<pg8::EpiGate2, pg8::TwoPartOrder, true>(lds, g, So, E);
    }
    SEAM(PH_OP2);
    if (IN(PH_WOUT)) {
        pg8::Gemm g{MERGED, WO_T, 2048, 0, nullptr, 0}; pg8::StaticOrder So; So.init(S, 2048, G, wg);
        pg8::EpiDelta E{MOD + 2 * D, DELTA, 1.0f / (W8_SCALE * MRG8_SCALE)};
        pg8::gemm_phase<pg8::EpiDelta, pg8::StaticOrder, true>(lds, g, So, E);
    }
    SEAM(PH_WOUT);
    }

    if (IN(PH_ROUTER)) {
        LAS float* hs = (LAS float*)lds;
        volatile LAS unsigned* lcnt = MISC + 32;
        const float* sh2 = MOD + 3 * D; const float* sc2 = MOD + 4 * D;
        if (tid < 32) lcnt[tid] = 0u;
        __syncthreads();
        for (int grp = wg; grp < S / 16; grp += G) {
#pragma unroll 1
            for (int q = 0; q < 2; ++q) {
                const int tl = 2 * wave + q, t = grp * 16 + tl;
                const f32x4* xr = (const f32x4*)(x + (size_t)t * D) + lane; const u32x2* dr = (const u32x2*)(DELTA + (size_t)t * D) + lane;
                f32x4 v[8]; float ss = 0.f;
#pragma unroll
                for (int j = 0; j < 8; ++j) { const u32x2 dw = dr[64 * j]; v[j] = xr[64 * j] + (f32x4){bf_lo(dw.x), bf_hi(dw.x), bf_lo(dw.y), bf_hi(dw.y)};
                    ss += (v[j][0] * v[j][0] + v[j][1] * v[j][1]) + (v[j][2] * v[j][2] + v[j][3] * v[j][3]); }
#pragma unroll
                for (int j = 0; j < 8; ++j) { u32x2 w; w.x = cvt_pk_bf16(v[j][0], v[j][1]); w.y = cvt_pk_bf16(v[j][2], v[j][3]); ((u32x2*)(DELTA + (size_t)t * D) + lane)[64 * j] = w; }
                const float rstd = rsqrtf(wave_sum(ss) * (1.0f / D) + NORM_EPS);
#pragma unroll
                for (int j = 0; j < 8; ++j) {
                    const int c = 4 * lane + 256 * j;
                    const f32x4 g = *(const f32x4*)(norm2_g + c), sc = *(const f32x4*)(sc2 + c), sh = *(const f32x4*)(sh2 + c);
                    f32x4 h;
#pragma unroll
                    for (int e = 0; e < 4; ++e) h[e] = v[j][e] * rstd * g[e] * (1.0f + sc[e]) + sh[e];
                    *(LAS f32x4*)(hs + tl * 2048 + c) = h;
                    *(unsigned*)(H8 + (size_t)t * D + c) = pack4_fp8(h[0], h[1], h[2], h[3]);
                }
            }
            __syncthreads();
            {
                LAS float* part = (LAS float*)(lds + 131072);
                const int fr = lane & 15, fq = lane >> 4;
                f32x4 acc0 = (f32x4){0.f, 0.f, 0.f, 0.f}, acc1 = acc0;
                const LAS float* hrow = hs + fr * 2048 + wave * 256 + 4 * fq; const float* wrp = w_router + (size_t)(wave * 256 + 4 * fq) * 32 + fr;
#pragma unroll 2
                for (int i = 0; i < 16; ++i) {
                    const f32x4 a4 = *(const LAS f32x4*)(hrow + 16 * i);
                    float b0[4], b1[4];
#pragma unroll
                    for (int s = 0; s < 4; ++s) { b0[s] = wrp[(size_t)(16 * i + s) * 32]; b1[s] = wrp[(size_t)(16 * i + s) * 32 + 16]; }
#pragma unroll
                    for (int s = 0; s < 4; ++s) { acc0 = __builtin_amdgcn_mfma_f32_16x16x4f32(a4[s], b0[s], acc0, 0, 0, 0); acc1 = __builtin_amdgcn_mfma_f32_16x16x4f32(a4[s], b1[s], acc1, 0, 0, 0); }
                }
#pragma unroll
                for (int r = 0; r < 4; ++r) { part[(wave * 16 + 4 * fq + r) * 32 + fr] = acc0[r]; part[(wave * 16 + 4 * fq + r) * 32 + 16 + fr] = acc1[r]; }
                __syncthreads();
                const int tl = tid >> 5, e = tid & 31, t = grp * 16 + tl;
                float v = b_router[e];
#pragma unroll
                for (int w = 0; w < 8; ++w) v += part[(w * 16 + tl) * 32 + e];
                float tv[4]; int ti[4];
#pragma unroll
                for (int k = 0; k < 4; ++k) {
                    float bv = v; int bi = e;
#pragma unroll
                    for (int o = 16; o >= 1; o >>= 1) { const float ov = __shfl_xor(bv, o); const int oi = __shfl_xor(bi, o); if (ov > bv || (ov == bv && oi < bi)) { bv = ov; bi = oi; } }
                    tv[k] = bv; ti[k] = bi; if (e == bi) v = -__builtin_inff();
                }
                if (e == 0) {
                    const float e1 = __expf(tv[1] - tv[0]), e2 = __expf(tv[2] - tv[0]), e3 = __expf(tv[3] - tv[0]); const float inv = 1.0f / (1.0f + e1 + e2 + e3);
                    *(int4*)(TOPE + (size_t)t * 4) = make_int4(ti[0], ti[1], ti[2], ti[3]);
                    *(f32x4*)(GATE + (size_t)t * 4) = (f32x4){inv, e1 * inv, e2 * inv, e3 * inv};
#pragma unroll
                    for (int k = 0; k < 4; ++k) __hip_atomic_fetch_add((LAS unsigned*)&lcnt[ti[k]], 1u, __ATOMIC_RELAXED, __HIP_MEMORY_SCOPE_WORKGROUP);
                }
            }
            __syncthreads();
        }
        if (tid < 32) { const unsigned c = lcnt[tid]; if (c) __hip_atomic_fetch_add(ctl + CW_CNT + tid, c, __ATOMIC_RELAXED, __HIP_MEMORY_SCOPE_AGENT); }
    }
    SEAM(PH_ROUTER);

    if (IN(PH_SCATTER)) {
        volatile LAS unsigned* lcnt = MISC + 32; volatile LAS unsigned* lbase = MISC + 64; LAS int* pstart = (LAS int*)(lds + 1024); LAS int* pcnt = (LAS int*)(lds + 1280);
        if (tid == 0) { int p = 0; for (int e = 0; e < NEXP; ++e) { const int c = (int)__hip_atomic_load(ctl + CW_CNT + e, __ATOMIC_RELAXED, __HIP_MEMORY_SCOPE_AGENT); pstart[e] = p; pcnt[e] = c; p += (c + 255) & ~255; } }
        if (tid < 32) lcnt[tid] = 0u;
        __syncthreads();
        if (wg < NEXP) { const int e = wg; for (int s = pstart[e] + pcnt[e] + tid; s < pstart[e] + ((pcnt[e] + 255) & ~255); s += NTHR) TOKS[s] = 0; }
        for (int blk = wg; blk < S / 64; blk += G) {
            int e = 0, lrank = 0;
            if (tid < 256) { e = TOPE[(size_t)blk * 256 + tid]; lrank = (int)__hip_atomic_fetch_add((LAS unsigned*)&lcnt[e], 1u, __ATOMIC_RELAXED, __HIP_MEMORY_SCOPE_WORKGROUP); }
            __syncthreads();
            if (tid < 32) { const unsigned c = lcnt[tid]; lbase[tid] = c ? __hip_atomic_fetch_add(ctl + CW_FILL + tid, c, __ATOMIC_RELAXED, __HIP_MEMORY_SCOPE_AGENT) : 0u; }
            __syncthreads();
            if (tid < 256) { const int slot = pstart[e] + (int)lbase[e] + lrank; SLOT[(size_t)blk * 256 + tid] = slot; TOKS[slot] = blk * 64 + (tid >> 2); }
            __syncthreads();
            if (tid < 32) lcnt[tid] = 0u;
            __syncthreads();
        }
    }
    SEAM(PH_SCATTER);

    if (IN(PH_MOE1) || IN(PH_MOE2)) {
        LAS int* panel_e = (LAS int*)(lds + 131072 + 2048);
        LAS int* npan = (LAS int*)(lds + 131072 + 2048 + 2048);
        __syncthreads();
        if (tid == 0) { int p = 0; for (int e = 0; e < NEXP; ++e) { const int np = (int)((__hip_atomic_load(ctl + CW_CNT + e, __ATOMIC_RELAXED, __HIP_MEMORY_SCOPE_AGENT) + 255u) >> 8); for (int q = 0; q < np; ++q) panel_e[p + q] = e; p += np; } npan[0] = p; }
        __syncthreads();
        const int nPanels = npan[0];
        if (IN(PH_MOE1)) {
            pg8::Gemm g{H8, W1_T, 2048, (size_t)4096 * 2048, TOKS, 0}; pg8::MoeOrder So; So.init(nPanels, 16, G, wg, panel_e);
            pg8::EpiSwiglu E{ACT, b1};
            pg8::gemm_phase<pg8::EpiSwiglu, pg8::MoeOrder, true>(lds, g, So, E);
        }
        SEAM(PH_MOE1);
        if (IN(PH_MOE2)) {
            pg8::Gemm g{ACT, W2_T, 2048, (size_t)2048 * 2048, nullptr, 0}; pg8::MoeOrder So; So.init(nPanels, 8, G, wg, panel_e);
            pg8::EpiBf16 E{YB, 2048, b2, 2048, 1.0f / (W8_SCALE * ACT8_SCALE), 1 << 30, 0};
            pg8::gemm_phase<pg8::EpiBf16, pg8::MoeOrder, true>(lds, g, So, E);
        }
    }
    SEAM(PH_MOE2);

    if (IN(PH_FINAL)) {
        const float* gt2 = MOD + 5 * D;
        const int gw = wg * NWAVES + wave, NGW = G * NWAVES;
        for (int t = gw; t < S; t += NGW) {
            const u32x2* dr = (const u32x2*)(DELTA + (size_t)t * D) + lane;
            f32x4 v[8];
#pragma unroll
            for (int j = 0; j < 8; ++j) { const u32x2 dw = dr[64 * j]; v[j] = (f32x4){bf_lo(dw.x), bf_hi(dw.x), bf_lo(dw.y), bf_hi(dw.y)}; }
            {
                f32x4 m[8];
#pragma unroll
                for (int j = 0; j < 8; ++j) m[j] = (f32x4){0.f, 0.f, 0.f, 0.f};
                const int4 sl = *(const int4*)(SLOT + (size_t)t * 4); const f32x4 gt = *(const f32x4*)(GATE + (size_t)t * 4);
                const int sls[4] = {sl.x, sl.y, sl.z, sl.w};
#pragma unroll
                for (int k = 0; k < 4; ++k) {
                    const u32x2* yr = (const u32x2*)(YB + (size_t)sls[k] * D) + lane; const float gk = gt[k];
#pragma unroll
                    for (int j = 0; j < 8; ++j) { const u32x2 w = yr[64 * j]; m[j][0] += gk * bf_lo(w.x); m[j][1] += gk * bf_hi(w.x); m[j][2] += gk * bf_lo(w.y); m[j][3] += gk * bf_hi(w.y); }
                }
#pragma unroll
                for (int j = 0; j < 8; ++j) { const f32x4 g2 = *(const f32x4*)(gt2 + 4 * lane + 256 * j); v[j] = v[j] + g2 * m[j]; }
            }
            float ss = 0.f;
#pragma unroll
            for (int j = 0; j < 8; ++j) ss += (v[j][0] * v[j][0] + v[j][1] * v[j][1]) + (v[j][2] * v[j][2] + v[j][3] * v[j][3]);
            const float rstd = rsqrtf(wave_sum(ss) * (1.0f / D) + NORM_EPS);
            f32x4* orow = (f32x4*)(out + (size_t)t * D) + lane;
#pragma unroll
            for (int j = 0; j < 8; ++j) { const f32x4 fg = *(const f32x4*)(final_g + 4 * lane + 256 * j); orow[64 * j] = v[j] * rstd * fg; }
        }
    }
#undef IN
#undef SEAM
}

#ifndef MK_ONE_LAUNCH
#define MK_ONE_LAUNCH 1
#endif
extern "C" void kernel_launch(void* const* d_in, const int* in_sizes, int n_in, void* d_out, int out_size, void* d_ws, size_t ws_size, hipStream_t stream) {
    static int grid = 0;
    if (grid == 0) {
        if (n_in != 22 || out_size != S * D || ws_size < WS_END) { fprintf(stderr, "kernel_launch: unexpected shapes: n_in %d out %d ws %zu (need %zu)\n", n_in, out_size, ws_size, (size_t)WS_END); grid = -1; return; }
        int dev = 0, cus = 0, per_cu = 0;
        if (hipGetDevice(&dev) != hipSuccess || hipDeviceGetAttribute(&cus, hipDeviceAttributeMultiprocessorCount, dev) != hipSuccess) { grid = -1; return; }
        if (hipFuncSetAttribute((const void*)fwd_kernel, hipFuncAttributeMaxDynamicSharedMemorySize, LDS_BYTES) != hipSuccess) { fprintf(stderr, "kernel_launch: hipFuncSetAttribute failed\n"); grid = -1; return; }
        if (hipOccupancyMaxActiveBlocksPerMultiprocessor(&per_cu, (const void*)fwd_kernel, NTHR, LDS_BYTES) != hipSuccess || per_cu < 1) { fprintf(stderr, "kernel_launch: occupancy query says %d\n", per_cu); (void)hipGetLastError(); grid = -1; return; }
        grid = cus;
    }
    if (grid < 0) return;
    (void)in_sizes;
    hipMemsetAsync((char*)d_ws + WS_CTL, 0, CTL_BYTES, stream);
    Args a{};
    for (int i = 0; i < 22; ++i) a.in[i] = d_in[i];
    a.out = (float*)d_out; a.ws = (unsigned char*)d_ws; a.flags = 0; a.pad = 0;
#if MK_ONE_LAUNCH
    a.ph_lo = 0; a.ph_hi = NPH;
    hipLaunchKernelGGL(fwd_kernel, dim3(grid), dim3(NTHR), LDS_BYTES, stream, a);
#else
    for (int p = 0; p < NPH; ++p) { a.ph_lo = p; a.ph_hi = p + 1; hipLaunchKernelGGL(fwd_kernel, dim3(grid), dim3(NTHR), LDS_BYTES, stream, a); }
#endif
}
```

```cpp
#include <hip/hip_runtime.h>
#include <cstdio>
#include <cstdint>

#define GAS __attribute__((address_space(1)))
#define LAS __attribute__((address_space(3)))
typedef unsigned short bf16_t;
typedef short bf16x8 __attribute__((ext_vector_type(8)));
typedef float f32x4 __attribute__((ext_vector_type(4)));
typedef float f32x2 __attribute__((ext_vector_type(2)));
typedef float f32x16 __attribute__((ext_vector_type(16)));
typedef unsigned u32x4 __attribute__((ext_vector_type(4)));
typedef unsigned u32x2 __attribute__((ext_vector_type(2)));
typedef int i32x4 __attribute__((ext_vector_type(4)));
typedef int i32x8 __attribute__((ext_vector_type(8)));
typedef short s16x4 __attribute__((ext_vector_type(4)));
typedef short s16x2 __attribute__((ext_vector_type(2)));
typedef int v2i32 __attribute__((ext_vector_type(2)));

constexpr int S = 16384, D = 2048, DIN = 10832, DINP = 11008, NEXP = 32, DFF = 2048;
constexpr int NWAVES = 8, NTHR = 512;
constexpr int CQ = 0, CK = 1024, CV = 1280, CQI = 1536, CKI = 2560, CWI = 2624, CHQ = 2816, CHF = 3840, CHI = 4864, CHG = 5888, CGA = 6912, CGR = 8960;
constexpr int PMAX = 65536 + NEXP * 256;
constexpr float NORM_EPS = 1e-5f;

constexpr size_t MiB = 1u << 20;
constexpr size_t al256(size_t x) { return (x + 255) & ~(size_t)255; }
constexpr size_t WS_CTL = 0, CTL_BYTES = 1 * MiB;
constexpr size_t WS_MOD = WS_CTL + CTL_BYTES;
constexpr size_t WS_TOPE = WS_MOD + 64 * 1024;
constexpr size_t WS_GATE = WS_TOPE + (size_t)S * 16;
constexpr size_t WS_SLOT = WS_GATE + (size_t)S * 16;
constexpr size_t WS_WIN_T = WS_SLOT + (size_t)S * 16;
constexpr size_t WS_WA_T = WS_WIN_T + (size_t)DINP * D * 2;
constexpr size_t WS_WH_T = WS_WA_T + (size_t)2048 * 1024 * 2;
constexpr size_t WS_WO_T = WS_WH_T + (size_t)2048 * 1024 * 2;
constexpr size_t WS_W1_T = WS_WO_T + (size_t)2048 * 2048 * 2;
constexpr size_t WS_W2_T = WS_W1_T + (size_t)NEXP * 4096 * 2048 * 2;
constexpr size_t WS_H = WS_W2_T + (size_t)NEXP * 2048 * 2048 * 2;
constexpr size_t WS_PROJ = WS_H + (size_t)S * D * 2;
constexpr size_t WS_KI = WS_PROJ + (size_t)S * DINP * 2;
constexpr size_t WS_KC = WS_KI + (size_t)S * 64 * 2;
constexpr size_t WS_VC = WS_KC + (size_t)S * 256 * 2;
constexpr size_t WS_ST = WS_VC + (size_t)S * 256 * 2;
constexpr size_t WS_DC = WS_ST + (size_t)256 * 8 * 128 * 128 * 4;
constexpr size_t WS_SEL = WS_DC + (size_t)256 * 8 * 128 * 4;
constexpr size_t WS_ATT = WS_SEL + (size_t)S * 256 * 4;
constexpr size_t WS_REC = WS_ATT + (size_t)S * 1024 * 2;
constexpr size_t WS_MERGED = WS_REC + (size_t)S * 1024 * 2;
constexpr size_t WS_X1 = WS_MERGED + (size_t)S * 2048 * 2;
constexpr size_t WS_SCORES = WS_X1 + (size_t)S * 2048 * 4;
constexpr size_t WS_XB = WS_SCORES;
constexpr size_t WS_ACT = WS_XB + (size_t)PMAX * 2048 * 2;
constexpr size_t WS_YB = WS_ACT + (size_t)PMAX * 2048 * 2;
constexpr size_t WS_END = WS_SCORES + (size_t)S * S * 4;
static_assert(WS_YB + (size_t)PMAX * 2048 * 2 <= WS_END, "MoE buffers overlay the score matrix");
static_assert(WS_END <= (size_t)4096 * MiB, "workspace");
constexpr int CW_BAR = 4096, CW_CNT = 8192, CW_FILL = 8448;
constexpr size_t WS_TOKS = WS_SEL;

constexpr int LDS_BYTES = 155648;
constexpr int LDS_MISC = LDS_BYTES - 512;

__device__ __forceinline__ unsigned cvt_pk_bf16(float lo, float hi) { unsigned r; asm volatile("v_cvt_pk_bf16_f32 %0, %1, %2" : "=v"(r) : "v"(lo), "v"(hi)); return r; }
__device__ __forceinline__ float bf_lo(unsigned u) { return __uint_as_float(u << 16); }
__device__ __forceinline__ float bf_hi(unsigned u) { return __uint_as_float(u & 0xffff0000u); }
__device__ __forceinline__ float bf2f(bf16_t b) { return __uint_as_float(((unsigned)b) << 16); }
__device__ __forceinline__ float wave_sum(float v) {
#define DPPS(ctrl, rmask) { const int s_ = __builtin_amdgcn_update_dpp(0, __float_as_int(v), ctrl, rmask, 0xF, false); v += __int_as_float(s_); }
    DPPS(0x111, 0xF) DPPS(0x112, 0xF) DPPS(0x114, 0xF) DPPS(0x118, 0xF) DPPS(0x142, 0xA) DPPS(0x143, 0xC)
#undef DPPS
    return __int_as_float(__builtin_amdgcn_readlane(__float_as_int(v), 63));
}
__device__ __forceinline__ float wave_max(float v) {
#define DPPM(ctrl, rmask) { const int o_ = __float_as_int(v); const int s_ = __builtin_amdgcn_update_dpp(o_, o_, ctrl, rmask, 0xF, false); v = fmaxf(v, __int_as_float(s_)); }
    DPPM(0x111, 0xF) DPPM(0x112, 0xF) DPPM(0x114, 0xF) DPPM(0x118, 0xF) DPPM(0x142, 0xA) DPPM(0x143, 0xC)
#undef DPPM
    return __int_as_float(__builtin_amdgcn_readlane(__float_as_int(v), 63));
}
__device__ __forceinline__ float sigmoidf_(float x) { return __builtin_amdgcn_rcpf(1.0f + __expf(-x)); }
__device__ __forceinline__ float siluf_(float x) { return x * __builtin_amdgcn_rcpf(1.0f + __expf(-x)); }
__device__ __forceinline__ unsigned pack4_fp8(float a, float b, float c, float d) { int w = 0; w = __builtin_amdgcn_cvt_pk_fp8_f32(a, b, w, false); w = __builtin_amdgcn_cvt_pk_fp8_f32(c, d, w, true); return (unsigned)w; }
constexpr float W8_SCALE = 64.0f, ACT8_SCALE = 4.0f, MRG8_SCALE = 8.0f, OP8_SCALE = 16.0f;
__device__ __forceinline__ float relu_i(float x) { const int i = __float_as_int(x); return __int_as_float(i > 0 ? i : 0); }
__device__ __forceinline__ void fp8x16_to_bf16(const u32x4& w, u32x4& lo, u32x4& hi) {
    unsigned o[8];
#pragma unroll
    for (int q = 0; q < 4; ++q) { const unsigned wq = w[q]; const f32x2 a = __builtin_amdgcn_cvt_pk_f32_fp8((int)wq, false), b = __builtin_amdgcn_cvt_pk_f32_fp8((int)wq, true);
        o[2 * q] = cvt_pk_bf16(a[0], a[1]); o[2 * q + 1] = cvt_pk_bf16(b[0], b[1]); }
    lo = (u32x4){o[0], o[1], o[2], o[3]}; hi = (u32x4){o[4], o[5], o[6], o[7]};
}
__device__ __forceinline__ unsigned char fp8_1(float x) { return (unsigned char)(__builtin_amdgcn_cvt_pk_fp8_f32(x, x, 0, false) & 0xff); }
#define LDS_WAIT() asm volatile("s_waitcnt lgkmcnt(0)" ::: "memory")
#define VM_WAIT() asm volatile("s_waitcnt vmcnt(0)" ::: "memory")

#define XB_TMO      128
#define XB_XCNT(j)  (256  + 64 * (j))
#define XB_XSUB(j)  (1280 + 64 * (j))
#define XB_XGEN(j)  (2304 + 64 * (j))
#define XB_TOP      3328
#define XB_TOPGEN   3392
#define XCD_BAR_WORDS 3456
#define XB_SPIN_CAP (1u << 22)

__device__ __forceinline__ unsigned xb_ld(unsigned* p)              { return __hip_atomic_load(p, __ATOMIC_RELAXED, __HIP_MEMORY_SCOPE_AGENT); }
__device__ __forceinline__ unsigned xb_add(unsigned* p, unsigned v) { return __hip_atomic_fetch_add(p, v, __ATOMIC_RELAXED, __HIP_MEMORY_SCOPE_AGENT); }
__device__ __forceinline__ unsigned xb_xcc_id() { return (unsigned)__builtin_amdgcn_s_getreg((3 << 11) | 20) & 0xFu; }
#define XB_SPIN(cond, bar) do { unsigned _sp = 0; while (cond) { __builtin_amdgcn_s_sleep(1); \
    if ((++_sp & 255u) == 0u) { if (xb_ld(&(bar)[XB_TMO])) break; if (_sp > XB_SPIN_CAP) { atomicAdd(&(bar)[XB_TMO], 1u); break; } } } } while (0)

struct XcdBarrier { unsigned* bar; unsigned x; volatile LAS unsigned* st; };

__device__ __forceinline__ XcdBarrier xcd_barrier_post(unsigned* bar, volatile LAS unsigned* st) {
    XcdBarrier b; b.bar = bar; b.x = xb_xcc_id(); b.st = st;
    if (threadIdx.x == 0) (void)xb_add(&bar[XB_XCNT(b.x)], 1u);
    return b;
}
__device__ __forceinline__ void xcd_barrier_complete(unsigned* bar, unsigned x, unsigned& nloc, unsigned& nx) {
    const unsigned G = gridDim.x * gridDim.y * gridDim.z;
    unsigned sum, cnt, mine, sp = 0u;
    for (;;) {
        sum = 0u; cnt = 0u; mine = 0u;
#pragma unroll
        for (unsigned j = 0; j < 16; ++j) { const unsigned c = xb_ld(&bar[XB_XCNT(j)]); sum += c; cnt += (c > 0u) ? 1u : 0u; mine = (j == x) ? c : mine; }
        if (sum == G) break;
        __builtin_amdgcn_s_sleep(1);
        if ((++sp & 255u) == 0u) { if (xb_ld(&bar[XB_TMO])) break; if (sp > XB_SPIN_CAP) { atomicAdd(&bar[XB_TMO], 1u); break; } }
    }
    nloc = mine > 0u ? mine : 1u; nx = cnt > 0u ? cnt : 1u;
}
__device__ __forceinline__ void xcd_barrier(const XcdBarrier& b) {
    asm volatile("s_waitcnt vmcnt(0)" ::: "memory");
    __syncthreads();
    if (threadIdx.x == 0) {
        unsigned* bar = b.bar;
        __builtin_amdgcn_s_waitcnt(0);
        unsigned nloc = b.st[0], nx = b.st[1];
        if (nloc == 0u) { xcd_barrier_complete(bar, b.x, nloc, nx); b.st[0] = nloc; b.st[1] = nx; }
        const unsigned old = xb_add(&bar[XB_XSUB(b.x)], 1u);
        const unsigned gen = old / nloc;
        if (old + 1u == (gen + 1u) * nloc) {
            __builtin_amdgcn_fence(__ATOMIC_RELEASE, "agent");
            asm volatile("s_waitcnt vmcnt(0)" ::: "memory");
            const unsigned og = xb_add(&bar[XB_TOP], 1u);
            const unsigned tg = og / nx;
            if (og + 1u == (tg + 1u) * nx) xb_add(&bar[XB_TOPGEN], 1u);
            else XB_SPIN(xb_ld(&bar[XB_TOPGEN]) == tg, bar);
            __builtin_amdgcn_fence(__ATOMIC_ACQUIRE, "agent");
            xb_add(&bar[XB_XGEN(b.x)], 1u);
            asm volatile("s_waitcnt vmcnt(0)" ::: "memory");
        } else {
            XB_SPIN(xb_ld(&bar[XB_XGEN(b.x)]) == gen, bar);
            __builtin_amdgcn_fence(__ATOMIC_ACQUIRE, "agent");
            asm volatile("s_waitcnt vmcnt(0)" ::: "memory");
        }
    }
    __syncthreads();
}

namespace pg8 {
constexpr int BM = 256, BK = 64, HALF = 128, HTB = HALF * BK * 2, STAGE_BYTES = 8 * HTB, NXCD = 8, WGM = 8;
__host__ __device__ __forceinline__ int lds_byte(int r, int c) { const int st = (r >> 4) * 2 + (c >> 5), rr = r & 15, cc = c & 31, ob = rr * 64 + cc * 2; return st * 1024 + (ob ^ (((ob >> 9) & 1) << 5)); }
__host__ __device__ __forceinline__ void stage_rc(int b, int& R, int& C) { const int st = b / 1024, sb = b % 1024, swz = sb ^ (((sb >> 9) & 1) << 5); R = (st >> 1) * 16 + swz / 64; C = (st & 1) * 32 + (swz % 64) / 2; }
__host__ __device__ __forceinline__ int perm32(int rho) { const int n = rho >> 4, i = rho & 15; return 8 * (i >> 2) + 4 * n + (i & 3); }

struct Unit { int pm, pn, e; };
struct Gemm { const void* A; const void* Bt; int K; size_t estride; const int* arow; size_t astride; };

struct StaticOrder {
    int nM, nN, nwg, G, c, i, full, erank, en;
    __device__ void init(int M, int N, int G_, int c_) { nM = M / BM; nN = N / BM; nwg = nM * nN; G = G_; c = c_; i = 0; full = 1 << 30; erank = -1; en = 1; }
    __device__ void skew(int full_, int erank_, int en_) { full = full_; erank = erank_; en = en_; }
    __device__ bool next(Unit& u) {
        long L;
        if (i < full) L = (long)i * G + c; else { if (erank < 0) return false; L = (long)full * G + (long)(i - full) * en + erank; }
        ++i; if (L >= nwg) return false;
        int wgid = (int)L; { const int q = nwg / NXCD, r = nwg % NXCD, xcd = wgid % NXCD, off = wgid / NXCD; wgid = (xcd < r ? xcd * (q + 1) : r * (q + 1) + (xcd - r) * q) + off; }
        const int nig = WGM * nN, gid = wgid / nig, fm = gid * WGM, gsz = (nM - fm) < WGM ? (nM - fm) : WGM;
        u.pm = fm + ((wgid % nig) % gsz); u.pn = (wgid % nig) / gsz; u.e = 0; return true;
    }
};
struct MoeOrder {
    int nPanels, nN, G, c, i; const LAS int* panel_e;
    __device__ void init(int nPanels_, int nN_, int G_, int c_, const LAS int* pe) { nPanels = nPanels_; nN = nN_; G = G_; c = c_; i = 0; panel_e = pe; }
    __device__ bool next(Unit& u) {
        const int PB = 256 / nN;
        const int nblk = (nPanels + PB - 1) / PB;
        for (;;) {
            const long L = (long)i * G + c; ++i;
            const int blk = (int)(L >> 8), r = (int)(L & 255), x = r & 7, j = r >> 3;
            if (blk >= nblk) return false;
            int pm, pn;
            if (nN == 16) { pm = blk * 16 + 4 * (x >> 1) + (j & 3); pn = 8 * (x & 1) + (j >> 2); }
            else          { pm = blk * 32 + 4 * x + (j & 3);        pn = j >> 2; }
            if (pm < nPanels) { u.pm = pm; u.pn = pn; u.e = panel_e[pm]; return true; }
        }
    }
};

template <class Epi, class Sched, bool FP8 = false>
__device__ __forceinline__ void gemm_phase(LAS unsigned char* lds, const Gemm g, Sched& S, const Epi& E) {
    const int tid = threadIdx.x, wid = __builtin_amdgcn_readfirstlane(tid >> 6), lane = tid & 63, wr = wid >> 2, wc = wid & 3, fr = lane & 15, fq = lane >> 4;
    const int K = g.K; const int pitch = FP8 ? K : 2 * K; const int nt = pitch / 128;
    unsigned voffA[2], voffB[2];
#pragma unroll
    for (int i = 0; i < 2; ++i) { int R, C; stage_rc(tid * 16 + i * 8192, R, C); const int Rb = Epi::PERM ? ((R & ~31) + perm32(R & 31)) : R;
        voffA[i] = (unsigned)(R * pitch + C * 2); voffB[i] = (unsigned)(Rb * pitch + C * 2); }
    const size_t kstep = (size_t)(BK * 2);
    const size_t hstep = (size_t)HALF * pitch;
    const size_t tstep = 2 * hstep;
    int RA[2], CA[2];
#pragma unroll
    for (int i = 0; i < 2; ++i) stage_rc(tid * 16 + i * 8192, RA[i], CA[i]);
    const bool gather = g.arow != nullptr;
    const size_t hsA = gather ? 0 : hstep;
    unsigned vA0[2] = {voffA[0], voffA[1]}, vA1[2] = {voffA[0], voffA[1]}, nA0[2] = {voffA[0], voffA[1]}, nA1[2] = {voffA[0], voffA[1]};
#define PG8_AOFF(dst0, dst1, u) do { if (gather) { _Pragma("unroll") for (int i = 0; i < 2; ++i) { \
        dst0[i] = (unsigned)g.arow[(u).pm * 256 + RA[i]] * (unsigned)pitch + (unsigned)(CA[i] * 2); dst1[i] = (unsigned)g.arow[(u).pm * 256 + 128 + RA[i]] * (unsigned)pitch + (unsigned)(CA[i] * 2); } } } while (0)
    const unsigned ldsw = (unsigned)wid * 1024u;
    const int aoff = lds_byte(wr * 64 + fr, fq * 8), boff = lds_byte(wc * 32 + fr, fq * 8);
#define PG8_SA(b, h) (((b) * 2 + (h)) * HTB)
#define PG8_SB(b, h) ((4 + (b) * 2 + (h)) * HTB)
#define PG8_STAGE(bufoff, gbase, voff) do { _Pragma("unroll") for (int _i = 0; _i < 2; ++_i) \
        __builtin_amdgcn_global_load_lds((const unsigned*)((const char*)(gbase) + (voff)[_i]), (LAS unsigned*)(lds + (bufoff) + ldsw + _i * 8192), 16, 0, 0); } while (0)
#define PG8_LD8(p) __builtin_shufflevector(*(const LAS i32x4*)(p), *(const LAS i32x4*)((p) + 1024), 0, 1, 2, 3, 4, 5, 6, 7)
#define PG8_LDA(dst, b, h) do { _Pragma("unroll") for (int m = 0; m < 4; ++m) { if constexpr (FP8) dst##8[m] = PG8_LD8(lds + PG8_SA(b, h) + aoff + m * 2048); \
        else { _Pragma("unroll") for (int k = 0; k < 2; ++k) dst[m][k] = *(const LAS bf16x8*)(lds + PG8_SA(b, h) + aoff + m * 2048 + k * 1024); } } } while (0)
#define PG8_LDB(dst, b, h) do { _Pragma("unroll") for (int n = 0; n < 2; ++n) { if constexpr (FP8) dst##8[n] = PG8_LD8(lds + PG8_SB(b, h) + boff + n * 2048); \
        else { _Pragma("unroll") for (int k = 0; k < 2; ++k) dst[n][k] = *(const LAS bf16x8*)(lds + PG8_SB(b, h) + boff + n * 2048 + k * 1024); } } } while (0)
#define PG8_MMA(ai, bj, At, Bt) do { __builtin_amdgcn_s_setprio(1); _Pragma("unroll") for (int m = 0; m < 4; ++m) _Pragma("unroll") for (int n = 0; n < 2; ++n) { \
        if constexpr (FP8) asm volatile("v_mfma_scale_f32_16x16x128_f8f6f4 %0, %1, %2, %0, %3, %3 op_sel_hi:[0,0,0]" : "+v"(acc[ai][bj][m][n]) : "v"(Bt##8[n]), "v"(At##8[m]), "v"(scl1)); \
        else { _Pragma("unroll") for (int k = 0; k < 2; ++k) acc[ai][bj][m][n] = __builtin_amdgcn_mfma_f32_16x16x32_bf16(Bt[n][k], At[m][k], acc[ai][bj][m][n], 0, 0, 0); } } \
        __builtin_amdgcn_s_setprio(0); } while (0)
#define PG8_WAIT_V(n) asm volatile("s_waitcnt vmcnt(" #n ")" ::: "memory")
#define PG8_WAIT_L(n) asm volatile("s_waitcnt lgkmcnt(" #n ")" ::: "memory")
#define PG8_BAR __builtin_amdgcn_s_barrier()
#define PG8_SCHED __builtin_amdgcn_sched_barrier(0)
    Unit cur, nxt;
    if (!S.next(cur)) return;
    const unsigned scl1 = 0x7f7f7f7fu;
    f32x4 acc[2][2][4][2];
#pragma unroll
    for (int a = 0; a < 2; ++a)
#pragma unroll
        for (int b = 0; b < 2; ++b)
#pragma unroll
            for (int m = 0; m < 4; ++m)
#pragma unroll
                for (int n = 0; n < 2; ++n) acc[a][b][m][n] = (f32x4){0.f, 0.f, 0.f, 0.f};
    bf16x8 At[4][2], B0[2][2], B1[2][2]; i32x8 At8[4], B08[2], B18[2];
    const char* cA = (const char*)g.A + (size_t)cur.e * g.astride + (gather ? (size_t)0 : (size_t)cur.pm * tstep); const char* cB = (const char*)g.Bt + (size_t)cur.e * g.estride + (size_t)cur.pn * tstep;
    PG8_AOFF(vA0, vA1, cur);
    PG8_STAGE(PG8_SB(0, 0), cB, voffB); PG8_STAGE(PG8_SB(0, 1), cB + hstep, voffB); PG8_STAGE(PG8_SA(0, 0), cA, vA0); PG8_STAGE(PG8_SA(0, 1), cA + hsA, vA1);
    if (wr == 1) PG8_BAR;
    PG8_WAIT_V(2); PG8_BAR;
    PG8_STAGE(PG8_SB(1, 0), cB + kstep, voffB); PG8_STAGE(PG8_SA(1, 0), cA + kstep, vA0); PG8_STAGE(PG8_SB(1, 1), cB + hstep + kstep, voffB);
    PG8_WAIT_V(6); PG8_BAR;
    for (;;) {
        const bool has_next = S.next(nxt);
        const char* nA = has_next ? (const char*)g.A + (size_t)nxt.e * g.astride + (gather ? (size_t)0 : (size_t)nxt.pm * tstep) : cA;
        if (has_next) PG8_AOFF(nA0, nA1, nxt);
        const char* nB = has_next ? (const char*)g.Bt + (size_t)nxt.e * g.estride + (size_t)nxt.pn * tstep : cB;
        for (int t = 0; t < nt; t += 2) {
            const bool last = (t == nt - 2);
            const char* a1 = cA + (size_t)(t + 1) * kstep;
            const char* a2 = last ? nA : cA + (size_t)(t + 2) * kstep; const char* b2 = last ? nB : cB + (size_t)(t + 2) * kstep;
            const char* a3 = a2 + kstep; const char* b3 = b2 + kstep;
            PG8_LDB(B0, 0, 0); PG8_LDB(B1, 0, 1); PG8_SCHED; PG8_LDA(At, 0, 0); PG8_STAGE(PG8_SA(1, 1), a1 + hsA, vA1);
            if (last && has_next) { vA0[0] = nA0[0]; vA0[1] = nA0[1]; vA1[0] = nA1[0]; vA1[1] = nA1[1]; }
            PG8_WAIT_V(8); PG8_WAIT_L(0); PG8_BAR; PG8_MMA(0, 0, At, B0); PG8_MMA(0, 1, At, B1); PG8_BAR; PG8_SCHED;
            PG8_LDA(At, 0, 1); PG8_STAGE(PG8_SB(0, 0), b2, voffB); PG8_STAGE(PG8_SB(0, 1), b2 + hstep, voffB); PG8_STAGE(PG8_SA(0, 0), a2, vA0);
            PG8_WAIT_V(8); PG8_WAIT_L(0); PG8_BAR; PG8_MMA(1, 0, At, B0); PG8_MMA(1, 1, At, B1); PG8_BAR; PG8_SCHED;
            PG8_LDB(B0, 1, 0); PG8_LDB(B1, 1, 1); PG8_SCHED; PG8_LDA(At, 1, 0); PG8_STAGE(PG8_SA(0, 1), a2 + hsA, vA1);
            PG8_WAIT_V(8); PG8_WAIT_L(0); PG8_BAR; PG8_MMA(0, 0, At, B0); PG8_MMA(0, 1, At, B1); PG8_BAR; PG8_SCHED;
            PG8_LDA(At, 1, 1); PG8_STAGE(PG8_SB(1, 0), b3, voffB); PG8_STAGE(PG8_SB(1, 1), b3 + hstep, voffB); PG8_STAGE(PG8_SA(1, 0), a3, vA0);
            PG8_WAIT_V(8); PG8_WAIT_L(0); PG8_BAR; PG8_MMA(1, 0, At, B0); PG8_MMA(1, 1, At, B1); PG8_BAR; PG8_SCHED;
        }
        if (wr == 0) PG8_BAR;
        if constexpr (FP8) {
#pragma unroll
            for (int a = 0; a < 2; ++a)
#pragma unroll
                for (int b = 0; b < 2; ++b) asm volatile("s_nop 15" : "+v"(acc[a][b][0][0]), "+v"(acc[a][b][0][1]), "+v"(acc[a][b][1][0]), "+v"(acc[a][b][1][1]), "+v"(acc[a][b][2][0]), "+v"(acc[a][b][2][1]), "+v"(acc[a][b][3][0]), "+v"(acc[a][b][3][1]));
        }
        const bool keep_acc = E(acc, cur, wr, wc, fr, fq);
        if (!has_next) break;
        if (!keep_acc)
#pragma unroll
        for (int a = 0; a < 2; ++a)
#pragma unroll
            for (int b = 0; b < 2; ++b)
#pragma unroll
                for (int m = 0; m < 4; ++m)
#pragma unroll
                    for (int n = 0; n < 2; ++n) acc[a][b][m][n] = (f32x4){0.f, 0.f, 0.f, 0.f};
        cur = nxt; cA = nA; cB = nB;
        if (wr == 1) PG8_BAR;
    }
    PG8_WAIT_V(0);
    PG8_BAR;
#undef PG8_AOFF
#undef PG8_SA
#undef PG8_SB
#undef PG8_STAGE
#undef PG8_LDA
#undef PG8_LDB
#undef PG8_MMA
#undef PG8_LD8
#undef PG8_WAIT_V
#undef PG8_WAIT_L
#undef PG8_BAR
#undef PG8_SCHED
}

struct EpiBf16 {
    static constexpr bool PERM = true;
    bf16_t* O; int ldc; const float* bias; int bias_estride; float ascale; int skip_from, skip_cols;
    __device__ __forceinline__ bool operator()(const f32x4 (&acc)[2][2][4][2], const Unit& u, int wr, int wc, int fr, int fq) const {
        const int row0 = u.pm * BM + wr * 64 + fr; const int col0 = u.pn * BM + wc * 32 + 8 * fq + (u.pn >= skip_from ? skip_cols : 0);
        f32x4 bv[2][2];
#pragma unroll
        for (int bj = 0; bj < 2; ++bj)
#pragma unroll
            for (int n = 0; n < 2; ++n) bv[bj][n] = bias ? *(const f32x4*)(bias + (size_t)u.e * bias_estride + col0 + bj * HALF + 4 * n) : (f32x4){0.f, 0.f, 0.f, 0.f};
#pragma unroll
        for (int ai = 0; ai < 2; ++ai)
#pragma unroll
            for (int m = 0; m < 4; ++m) { bf16_t* rowp = O + (size_t)(row0 + ai * HALF + m * 16) * ldc + col0;
#pragma unroll
                for (int bj = 0; bj < 2; ++bj) { const f32x4 v0 = acc[ai][bj][m][0] * ascale + bv[bj][0], v1 = acc[ai][bj][m][1] * ascale + bv[bj][1];
                    u32x4 w; w.x = cvt_pk_bf16(v0[0], v0[1]); w.y = cvt_pk_bf16(v0[2], v0[3]); w.z = cvt_pk_bf16(v1[0], v1[1]); w.w = cvt_pk_bf16(v1[2], v1[3]);
                    *(u32x4*)(rowp + bj * HALF) = w; } }
        return false;
    }
};
__device__ __forceinline__ float swiglu1(float ug, float ul) {
    ug = fminf(ug, 7.0f); ul = fminf(fmaxf(ul, -7.0f), 7.0f);
    return ug * __builtin_amdgcn_rcpf(1.0f + __expf(-1.702f * ug)) * (ul + 1.0f);
}
struct EpiSwiglu {
    static constexpr bool PERM = true;
    unsigned char* O; const float* b1;
    __device__ __forceinline__ bool operator()(const f32x4 (&acc)[2][2][4][2], const Unit& u, int wr, int wc, int fr, int fq) const {
        const int row0 = u.pm * BM + wr * 64 + fr; const int c0 = u.pn * 128 + wc * 32 + 8 * fq;
        const float* bg = b1 + (size_t)u.e * 4096 + c0; const float* bl = bg + 2048;
        f32x4 bgv[2], blv[2];
#pragma unroll
        for (int n = 0; n < 2; ++n) { bgv[n] = *(const f32x4*)(bg + 4 * n); blv[n] = *(const f32x4*)(bl + 4 * n); }
#pragma unroll
        for (int ai = 0; ai < 2; ++ai)
#pragma unroll
            for (int m = 0; m < 4; ++m) {
                float a[8];
#pragma unroll
                for (int n = 0; n < 2; ++n)
#pragma unroll
                    for (int j = 0; j < 4; ++j) a[4 * n + j] = ACT8_SCALE * swiglu1(acc[ai][0][m][n][j] * (1.0f / W8_SCALE) + bgv[n][j], acc[ai][1][m][n][j] * (1.0f / W8_SCALE) + blv[n][j]);
                u32x2 w; w.x = pack4_fp8(a[0], a[1], a[2], a[3]); w.y = pack4_fp8(a[4], a[5], a[6], a[7]);
                *(u32x2*)(O + (size_t)(row0 + ai * HALF + m * 16) * 2048 + c0) = w;
            }
        return false;
    }
};

struct TwoPartOrder {
    StaticOrder so; Unit held; int part;
    __device__ void init(int M, int N, int G_, int c_) { so.init(M, N, G_, c_); part = 0; }
    __device__ bool next(Unit& u) { if (part == 1) { u = held; u.e = 1; part = 0; return true; } if (!so.next(held)) return false; u = held; u.e = 0; part = 1; return true; }
};
struct EpiGate2 {
    static constexpr bool PERM = true;
    unsigned char* O; const bf16_t* Ga; const bf16_t* Gr;
    __device__ __forceinline__ bool operator()(f32x4 (&acc)[2][2][4][2], const Unit& u, int wr, int wc, int fr, int fq) const {
        const int row0 = u.pm * BM + wr * 64 + fr; const int col0 = u.pn * BM + wc * 32 + 8 * fq;
#pragma unroll
        for (int ai = 0; ai < 2; ++ai)
#pragma unroll
            for (int m = 0; m < 4; ++m) { const size_t row = (size_t)(row0 + ai * HALF + m * 16);
#pragma unroll
                for (int bj = 0; bj < 2; ++bj) { const int c = col0 + bj * HALF;
                    const u32x4 gr = *(const u32x4*)(Gr + row * DINP + c);
                    if (u.e == 0) {
                        const u32x4 ga = *(const u32x4*)(Ga + row * DINP + c);
#pragma unroll
                        for (int q = 0; q < 4; ++q) {
                            const float r0 = (1.0f + __expf(-bf_lo(gr[q]))) * __builtin_amdgcn_rcpf(1.0f + __expf(-bf_lo(ga[q]))), r1 = (1.0f + __expf(-bf_hi(gr[q]))) * __builtin_amdgcn_rcpf(1.0f + __expf(-bf_hi(ga[q])));
                            acc[ai][bj][m][q >> 1][(2 * q) & 3] *= r0; acc[ai][bj][m][q >> 1][(2 * q + 1) & 3] *= r1; }
                    } else {
                        float r[8];
#pragma unroll
                        for (int q = 0; q < 4; ++q) { r[2 * q] = sigmoidf_(bf_lo(gr[q])) * acc[ai][bj][m][q >> 1][(2 * q) & 3]; r[2 * q + 1] = sigmoidf_(bf_hi(gr[q])) * acc[ai][bj][m][q >> 1][(2 * q + 1) & 3]; }
                        u32x2 w; constexpr float osc = MRG8_SCALE / (W8_SCALE * OP8_SCALE); w.x = pack4_fp8(r[0] * osc, r[1] * osc, r[2] * osc, r[3] * osc); w.y = pack4_fp8(r[4] * osc, r[5] * osc, r[6] * osc, r[7] * osc);
                        *(u32x2*)(O + row * 2048 + c) = w; } } }
        return u.e == 0;
    }
};
struct EpiDelta {
    static constexpr bool PERM = true;
    const float* gt; bf16_t* DL; float ascale;
    __device__ __forceinline__ bool operator()(const f32x4 (&acc)[2][2][4][2], const Unit& u, int wr, int wc, int fr, int fq) const {
        const int row0 = u.pm * BM + wr * 64 + fr; const int col0 = u.pn * BM + wc * 32 + 8 * fq;
        f32x4 g[2][2];
#pragma unroll
        for (int bj = 0; bj < 2; ++bj)
#pragma unroll
            for (int n = 0; n < 2; ++n) g[bj][n] = *(const f32x4*)(gt + col0 + bj * HALF + 4 * n);
#pragma unroll
        for (int ai = 0; ai < 2; ++ai)
#pragma unroll
            for (int m = 0; m < 4; ++m) { bf16_t* rowp = DL + (size_t)(row0 + ai * HALF + m * 16) * 2048 + col0;
#pragma unroll
                for (int bj = 0; bj < 2; ++bj) { const f32x4 v0 = acc[ai][bj][m][0] * ascale * g[bj][0], v1 = acc[ai][bj][m][1] * ascale * g[bj][1];
                    u32x4 w; w.x = cvt_pk_bf16(v0[0], v0[1]); w.y = cvt_pk_bf16(v0[2], v0[3]); w.z = cvt_pk_bf16(v1[0], v1[1]); w.w = cvt_pk_bf16(v1[2], v1[3]);
                    *(u32x4*)(rowp + bj * HALF) = w; } }
        return false;
    }
};
}

struct Args { const void* in[22]; float* out; unsigned char* ws; int ph_lo, ph_hi, flags, pad; };
constexpr int XCONV = 0, XSCORE = 96;
constexpr int CW_SCQ = 12288, SCP = 5, CW_ATQ = 12352;
enum { PH_PRO = 0, PH_H, PH_INPROJ, PH_POST, PH_SCORE, PH_SELECT, PH_ATTN, PH_OP1, PH_OP2, PH_WOUT, PH_ROUTER, PH_SCATTER, PH_MOE1, PH_MOE2, PH_FINAL, NPH };

__device__ __forceinline__ int dest_row(int mode, int n) {
    if (mode == 1) return n < 2640 ? n : n + 176;
    if (mode == 2) { const int g = n >> 11, c = n & 2047; return (c >> 7) * 256 + g * 128 + (c & 127); }
    return n;
}
__device__ __forceinline__ void convert_item(const float* __restrict__ W, int K, int N, int ld, bf16_t* WT, int mode, int item, int lane, LAS unsigned char* scr) {
    const int nblk = (N + 63) >> 6; const int kb = item / nblk, nb = item - kb * nblk; const int k0 = kb * 128, n0 = nb * 64;
    const int c4 = lane & 15, kr = lane >> 4;
    const bool ok = (n0 + 4 * c4) < N;
    const float* src = W + (size_t)(k0 + 2 * kr) * ld + n0 + 4 * c4;
#pragma unroll 4
    for (int i = 0; i < 16; ++i) {
        f32x4 v0 = (f32x4){0.f, 0.f, 0.f, 0.f}, v1 = v0;
        if (ok) { v0 = *(const f32x4*)(src + (size_t)(8 * i) * ld); v1 = *(const f32x4*)(src + (size_t)(8 * i + 1) * ld); }
        const int kk = 8 * i + 2 * kr;
#pragma unroll
        for (int e = 0; e < 4; ++e) *(LAS unsigned*)(scr + (4 * c4 + e) * 272 + kk * 2) = cvt_pk_bf16(v0[e], v1[e]);
    }
    LDS_WAIT(); asm volatile("" ::: "memory");
#pragma unroll 4
    for (int j = 0; j < 16; ++j) {
        const int q = j * 64 + lane, n = q >> 4, ch = q & 15;
        const u32x4 v = *(const LAS u32x4*)(scr + n * 272 + ch * 16);
        if (n0 + n < N) *(u32x4*)(WT + (size_t)dest_row(mode, n0 + n) * K + k0 + ch * 8) = v;
    }
    LDS_WAIT(); asm volatile("" ::: "memory");
}


__device__ __forceinline__ bf16_t f2bf(float f) { unsigned u = __float_as_uint(f); return (bf16_t)((u + 0x7fffu + ((u >> 16) & 1u)) >> 16); }
__device__ __forceinline__ float bfx(const u32x4& w, int i) { const unsigned u = w[i >> 1]; return (i & 1) ? bf_hi(u) : bf_lo(u); }
__device__ __forceinline__ void rope_sc(float pos, float inv, float& sn, float& cs) {
    const float ang = pos * inv;
    const double a = (double)ang; const double n = __builtin_rint(a * 0.15915494309189535); const float r = (float)(a - n * 6.283185307179586);
    sn = __sinf(r); cs = __cosf(r);
}
__device__ __forceinline__ void post_token(bf16_t* PROJ, bf16_t* KI, unsigned char* KC, unsigned char* VC, const int* positions, const float* kng, const float* knb, float inv16, float inv8, int t, int lane) {
    const float pos = (float)positions[t];
    bf16_t* row = PROJ + (size_t)t * DINP;
    float sn, cs, sn8, cs8;
    rope_sc(pos, inv16, sn, cs); rope_sc(pos, inv8, sn8, cs8);
#pragma unroll
    for (int i = 0; i < 2; ++i) {
        const int pp = lane + 64 * i, hd = pp >> 4, ii = pp & 15;
        bf16_t* p = row + CQ + hd * 128 + ii; const float a = bf2f(p[0]), b = bf2f(p[16]);
        p[0] = f2bf(a * cs - b * sn); p[16] = f2bf(b * cs + a * sn);
    }
#pragma unroll
    for (int i = 0; i < 2; ++i) {
        const int pp = lane + 64 * i, hd = pp >> 3, ii = pp & 7;
        bf16_t* p = row + CQI + hd * 64 + ii; const float a = bf2f(p[0]), b = bf2f(p[8]);
        p[0] = f2bf(a * cs8 - b * sn8); p[8] = f2bf(b * cs8 + a * sn8);
    }
    if (lane < 32) {
        const int g = lane >> 4, ii = lane & 15;
        const bf16_t* p = row + CK + g * 128 + ii; const float a = bf2f(p[0]), b = bf2f(p[16]);
        unsigned char* o = KC + (size_t)t * 256 + g * 128 + ii; o[0] = fp8_1(a * cs - b * sn); o[16] = fp8_1(b * cs + a * sn);
    }
#pragma unroll
    for (int i = 0; i < 3; ++i) { const int idx = lane + 64 * i, g = idx / 96, r = idx - g * 96; KC[(size_t)t * 256 + g * 128 + 32 + r] = fp8_1(bf2f(row[CK + g * 128 + 32 + r])); }
    { const u32x2 w = *(const u32x2*)(row + CV + 4 * lane); *(unsigned*)(VC + (size_t)t * 256 + 4 * lane) = pack4_fp8(bf_lo(w.x), bf_hi(w.x), bf_lo(w.y), bf_hi(w.y)); }
    {
        const float v = bf2f(row[CKI + lane]);
        const float mean = wave_sum(v) * (1.0f / 64.0f); const float d = v - mean; const float var = wave_sum(d * d) * (1.0f / 64.0f);
        const float y = d * rsqrtf(var + NORM_EPS) * kng[lane] + knb[lane];
        const float other = __shfl_xor(y, 8);
        float o = y;
        if (lane < 8) o = y * cs8 - other * sn8; else if (lane < 16) o = y * cs8 + other * sn8;
        KI[(size_t)t * 64 + lane] = f2bf(o);
    }
}

constexpr int HG_GB = 0, HG_Q1 = 33792, HG_Q2 = 51200, HG_K2 = 68608, HG_VT = 86016, HG_PB = 104448, HG_LB = 113664;
__device__ __forceinline__ void hgrn_cumsum(LAS unsigned char* lds, const u32x4& w0, const u32x4& w1, float l0, float l1, int tid) {
    LAS float* GB = (LAS float*)(lds + HG_GB); LAS float* LB = (LAS float*)(lds + HG_LB); LAS float* SEG = (LAS float*)(lds + HG_LB + 512);
    if (tid < 128) LB[tid] = 1.0f / (1.0f + expf(l1 - l0));
    __syncthreads();
    const int t = tid >> 3, dseg = tid & 7;
#pragma unroll
    for (int i = 0; i < 16; ++i) { const float z = i < 8 ? bfx(w0, i) : bfx(w1, i - 8); const float lb = LB[16 * dseg + i]; GB[t * 128 + 16 * dseg + i] = __logf(lb + (1.0f - lb) * sigmoidf_(z)); }
    __syncthreads();
    const int d = tid & 127, tq = tid >> 7;
    float z[16];
#pragma unroll
    for (int i = 0; i < 16; ++i) z[i] = GB[(16 * tq + i) * 128 + d];
    float a = 0.f;
#pragma unroll
    for (int i = 0; i < 16; ++i) { a += z[i]; z[i] = a; }
    SEG[tq * 128 + d] = a;
    __syncthreads();
    float pre = 0.f;
    for (int q = 0; q < tq; ++q) pre += SEG[q * 128 + d];
#pragma unroll
    for (int i = 0; i < 16; ++i) GB[(16 * tq + i) * 128 + d] = z[i] + pre;
    __syncthreads();
}
__device__ __forceinline__ void hgrn_vt(LAS unsigned char* lds, const u32x4& a, const u32x4& b, int tid) {
    const int s2 = tid & 31, eg = tid >> 5;
#pragma unroll
    for (int i = 0; i < 8; ++i) { const unsigned lo = (i & 1) ? (a[i >> 1] >> 16) : (a[i >> 1] & 0xffffu), hi = (i & 1) ? (b[i >> 1] >> 16) : (b[i >> 1] & 0xffffu);
        *(LAS unsigned*)(lds + HG_VT + (8 * eg + i) * 144 + s2 * 4) = lo | (hi << 16); }
}
__device__ __forceinline__ void hgrn_l1(LAS unsigned char* lds, const bf16_t* PROJ, const float* lb_logits, bf16_t* ST, float* DC, int c, int h, int tid, int wave, int lane) {
    const int t = tid >> 3, dseg = tid & 7, s2 = tid & 31, dg = tid >> 5;
    const bf16_t* pf = PROJ + (size_t)(c * 64 + t) * DINP + CHF + h * 128 + 16 * dseg;
    const bf16_t* pk = PROJ + (size_t)(c * 64 + 2 * s2) * DINP + CHF + h * 128 + 8 * dg;
    const u32x4 w0 = *(const u32x4*)pf, w1 = *(const u32x4*)(pf + 8);
    const u32x4 ka = *(const u32x4*)pk, kb = *(const u32x4*)(pk + DINP);
    const u32x4 va = *(const u32x4*)(pk - CHF + CHI), vb = *(const u32x4*)(pk - CHF + CHI + DINP);
    const float l0 = lb_logits[h * 128 + (tid & 127)], l1 = lb_logits[1024 + h * 128 + (tid & 127)];
    hgrn_cumsum(lds, w0, w1, l0, l1, tid);
    const LAS float* GB = (const LAS float*)(lds + HG_GB); const LAS float* LB = (const LAS float*)(lds + HG_LB);
    {
#pragma unroll
        for (int i = 0; i < 8; ++i) { const int d = 8 * dg + i; const float lb = LB[d], b63 = GB[63 * 128 + d];
            const float k0 = (1.0f - lb) * (1.0f - sigmoidf_(bfx(ka, i))), k1 = (1.0f - lb) * (1.0f - sigmoidf_(bfx(kb, i)));
            const float v0 = k0 * __expf(b63 - GB[(2 * s2) * 128 + d]), v1 = k1 * __expf(b63 - GB[(2 * s2 + 1) * 128 + d]);
            *(LAS unsigned*)(lds + HG_Q1 + d * 144 + s2 * 4) = cvt_pk_bf16(v0, v1); }
    }
    hgrn_vt(lds, va, vb, tid);
    __syncthreads();
    const int fr = lane & 15, fq = lane >> 4;
    bf16x8 af[2];
#pragma unroll
    for (int ks = 0; ks < 2; ++ks) af[ks] = *(const LAS bf16x8*)(lds + HG_VT + (16 * wave + fr) * 144 + (32 * ks + 8 * fq) * 2);
    bf16_t* dst = ST + ((size_t)(c * 8 + h) * 128) * 128;
#pragma unroll 2
    for (int dt = 0; dt < 8; ++dt) {
        f32x4 acc = (f32x4){0.f, 0.f, 0.f, 0.f};
#pragma unroll
        for (int ks = 0; ks < 2; ++ks) { const bf16x8 bfr = *(const LAS bf16x8*)(lds + HG_Q1 + (16 * dt + fr) * 144 + (32 * ks + 8 * fq) * 2); acc = __builtin_amdgcn_mfma_f32_16x16x32_bf16(af[ks], bfr, acc, 0, 0, 0); }
#pragma unroll
        for (int r = 0; r < 4; ++r) dst[(size_t)(16 * wave + 4 * fq + r) * 128 + 16 * dt + fr] = f2bf(acc[r]);
    }
    if (tid < 128) DC[(size_t)(c * 8 + h) * 128 + tid] = __expf(GB[63 * 128 + tid]);
    __syncthreads();
}
__device__ __forceinline__ void hgrn_l3(LAS unsigned char* lds, const bf16_t* PROJ, const float* lb_logits, const bf16_t* ST, const float* norm_g, unsigned char* REC, int c, int h, int tid, int wave, int lane) {
    const int t = tid >> 3, dseg = tid & 7, s2 = tid & 31, eg = tid >> 5, fr = lane & 15, fq = lane >> 4;
    const bf16_t* pf = PROJ + (size_t)(c * 64 + t) * DINP + CHF + h * 128 + 16 * dseg;
    const u32x4 f0 = *(const u32x4*)pf, f1 = *(const u32x4*)(pf + 8), q0 = *(const u32x4*)(pf - CHF + CHQ), q1 = *(const u32x4*)(pf - CHF + CHQ + 8);
    const u32x4 g0 = *(const u32x4*)(pf - CHF + CHG), g1 = *(const u32x4*)(pf - CHF + CHG + 8);
    const bf16_t* pv = PROJ + (size_t)(c * 64 + 2 * s2) * DINP + CHI + h * 128 + 8 * eg;
    const u32x4 va = *(const u32x4*)pv, vb = *(const u32x4*)(pv + DINP);
    const bf16_t* sp = ST + ((size_t)(c * 8 + h) * 128 + 16 * wave + fr) * 128 + 8 * fq;
    u32x4 sx[4];
#pragma unroll
    for (int ks = 0; ks < 4; ++ks) sx[ks] = *(const u32x4*)(sp + 32 * ks);
    const float l0 = lb_logits[h * 128 + (tid & 127)], l1 = lb_logits[1024 + h * 128 + (tid & 127)];
    hgrn_cumsum(lds, f0, f1, l0, l1, tid);
    const LAS float* GB = (const LAS float*)(lds + HG_GB); const LAS float* LB = (const LAS float*)(lds + HG_LB);
    {
        unsigned o1[8], o2[8], o3[8];
#pragma unroll
        for (int i = 0; i < 16; i += 2) {
            float a1[2], a2[2], a3[2];
#pragma unroll
            for (int j = 0; j < 2; ++j) { const int d = 16 * dseg + i + j; const float lb = LB[d], b = GB[t * 128 + d], br = GB[31 * 128 + d];
                const float z = (i + j) < 8 ? bfx(f0, i + j) : bfx(f1, i + j - 8), qv = (i + j) < 8 ? bfx(q0, i + j) : bfx(q1, i + j - 8);
                const float k = (1.0f - lb) * (1.0f - sigmoidf_(z)), q = siluf_(qv);
                a1[j] = q * __expf(b); a2[j] = q * __expf(b - br); a3[j] = k * __expf(br - b); }
            o1[i >> 1] = cvt_pk_bf16(a1[0], a1[1]); o2[i >> 1] = cvt_pk_bf16(a2[0], a2[1]); o3[i >> 1] = cvt_pk_bf16(a3[0], a3[1]);
        }
        LAS u32x4* d1 = (LAS u32x4*)(lds + HG_Q1 + t * 272 + dseg * 32); LAS u32x4* d2 = (LAS u32x4*)(lds + HG_Q2 + t * 272 + dseg * 32); LAS u32x4* d3 = (LAS u32x4*)(lds + HG_K2 + t * 272 + dseg * 32);
        d1[0] = (u32x4){o1[0], o1[1], o1[2], o1[3]}; d1[1] = (u32x4){o1[4], o1[5], o1[6], o1[7]};
        d2[0] = (u32x4){o2[0], o2[1], o2[2], o2[3]}; d2[1] = (u32x4){o2[4], o2[5], o2[6], o2[7]};
        d3[0] = (u32x4){o3[0], o3[1], o3[2], o3[3]}; d3[1] = (u32x4){o3[4], o3[5], o3[6], o3[7]};
    }
    hgrn_vt(lds, va, vb, tid);
    __syncthreads();
#pragma unroll
    for (int q = 0; q < 2; ++q) {
        const int tile = 2 * wave + q, tt = tile >> 2, stl = tile & 3;
        f32x4 acc = (f32x4){0.f, 0.f, 0.f, 0.f};
#pragma unroll
        for (int ks = 0; ks < 4; ++ks) { const bf16x8 a = *(const LAS bf16x8*)(lds + HG_Q2 + (16 * tt + fr) * 272 + (32 * ks + 8 * fq) * 2), b = *(const LAS bf16x8*)(lds + HG_K2 + (16 * stl + fr) * 272 + (32 * ks + 8 * fq) * 2);
            acc = __builtin_amdgcn_mfma_f32_16x16x32_bf16(a, b, acc, 0, 0, 0); }
#pragma unroll
        for (int r = 0; r < 4; ++r) { const int tr_ = 16 * tt + 4 * fq + r, s = 16 * stl + fr; *(LAS bf16_t*)(lds + HG_PB + tr_ * 144 + s * 2) = f2bf(s <= tr_ ? acc[r] : 0.f); }
    }
    __syncthreads();
    {
        bf16x8 b1[2], b2[4];
#pragma unroll
        for (int ks = 0; ks < 2; ++ks) b1[ks] = *(const LAS bf16x8*)(lds + HG_VT + (16 * wave + fr) * 144 + (32 * ks + 8 * fq) * 2);
#pragma unroll
        for (int ks = 0; ks < 4; ++ks) b2[ks] = __builtin_bit_cast(bf16x8, sx[ks]);
        LAS float* OB = (LAS float*)(lds + HG_GB);
#pragma unroll
        for (int tt = 0; tt < 4; ++tt) {
            f32x4 acc = (f32x4){0.f, 0.f, 0.f, 0.f};
#pragma unroll
            for (int ks = 0; ks < 2; ++ks) { const bf16x8 a = *(const LAS bf16x8*)(lds + HG_PB + (16 * tt + fr) * 144 + (32 * ks + 8 * fq) * 2); acc = __builtin_amdgcn_mfma_f32_16x16x32_bf16(a, b1[ks], acc, 0, 0, 0); }
#pragma unroll
            for (int ks = 0; ks < 4; ++ks) { const bf16x8 a = *(const LAS bf16x8*)(lds + HG_Q1 + (16 * tt + fr) * 272 + (32 * ks + 8 * fq) * 2); acc = __builtin_amdgcn_mfma_f32_16x16x32_bf16(a, b2[ks], acc, 0, 0, 0); }
#pragma unroll
            for (int r = 0; r < 4; ++r) OB[(16 * tt + 4 * fq + r) * 132 + 16 * wave + fr] = acc[r];
        }
    }
    __syncthreads();
    {
        const int es = dseg; const LAS float* OB = (const LAS float*)(lds + HG_GB);
        float o[16]; float ss = 0.f;
#pragma unroll
        for (int i = 0; i < 16; ++i) { o[i] = OB[t * 132 + 16 * es + i]; ss += o[i] * o[i]; }
        ss += __shfl_xor(ss, 1); ss += __shfl_xor(ss, 2); ss += __shfl_xor(ss, 4);
        const float rstd = rsqrtf(ss * (1.0f / 128.0f) + NORM_EPS);
        float rv[16];
#pragma unroll
        for (int i = 0; i < 16; ++i) { const float ga = i < 8 ? bfx(g0, i) : bfx(g1, i - 8); rv[i] = o[i] * (rstd * OP8_SCALE) * norm_g[16 * es + i] * siluf_(ga); }
        *(u32x4*)(REC + (size_t)(c * 64 + t) * 1024 + h * 128 + 16 * es) = (u32x4){pack4_fp8(rv[0], rv[1], rv[2], rv[3]), pack4_fp8(rv[4], rv[5], rv[6], rv[7]), pack4_fp8(rv[8], rv[9], rv[10], rv[11]), pack4_fp8(rv[12], rv[13], rv[14], rv[15])};
    }
    __syncthreads();
}

constexpr int SC_KT = 0, SC_SB = 36864, SC_SPITCH = 132;
__device__ __forceinline__ unsigned pk_f16(float a, float b) { return __builtin_bit_cast(unsigned, __builtin_amdgcn_cvt_pkrtz(a, b)); }
__device__ __forceinline__ void score_flush(LAS unsigned char* lds, unsigned short* SCORES, unsigned short* SEGMAX, int t0, int kt, int tid) {
    const LAS float* sb = (const LAS float*)(lds + SC_SB + (kt & 1) * (32 * SC_SPITCH * 4));
    const int row = tid >> 4, seg = tid & 15;
    const f32x4 a = *(const LAS f32x4*)(sb + row * SC_SPITCH + seg * 8), b = *(const LAS f32x4*)(sb + row * SC_SPITCH + seg * 8 + 4);
    unsigned short* dst = SCORES + (size_t)(t0 + row) * S + kt * 128 + seg * 8;
    *(u32x4*)dst = (u32x4){pk_f16(a[0], a[1]), pk_f16(a[2], a[3]), pk_f16(b[0], b[1]), pk_f16(b[2], b[3])};
    const float mx = fmaxf(fmaxf(fmaxf(a[0], a[1]), fmaxf(a[2], a[3])), fmaxf(fmaxf(b[0], b[1]), fmaxf(b[2], b[3])));
    SEGMAX[(size_t)(t0 + row) * 2048 + kt * 16 + seg] = (unsigned short)(pk_f16(mx, mx) & 0xffffu);
}
__device__ __forceinline__ void score_block(LAS unsigned char* lds, const bf16_t* PROJ, const bf16_t* KI, unsigned short* SCORES, unsigned short* SEGMAX, int qb, int kt0, int kt1, int tid, int wave, int lane) {
    const int t0 = qb * 32;
    const int r = lane & 31, hh = lane >> 5;
    bf16x8 Af[2][4]; float wv[2][16]; f32x2 wv2[2][8];
#pragma unroll
    for (int p = 0; p < 2; ++p) {
        const int tq = t0 + 4 * wave + 2 * p + (r >> 4); const bf16_t* qrow = PROJ + (size_t)tq * DINP + CQI + (r & 15) * 64 + 8 * hh;
#pragma unroll
        for (int ks = 0; ks < 4; ++ks) Af[p][ks] = *(const bf16x8*)(qrow + 16 * ks);
#pragma unroll
        for (int qq = 0; qq < 2; ++qq) {
            const bf16_t* wp = PROJ + (size_t)(t0 + 4 * wave + 2 * p + qq) * DINP + CWI + 4 * hh;
            const u32x2 wa = *(const u32x2*)wp, wb = *(const u32x2*)(wp + 8);
            wv[p][8 * qq + 0] = bf_lo(wa.x) * (1.0f / 32.0f); wv[p][8 * qq + 1] = bf_hi(wa.x) * (1.0f / 32.0f); wv[p][8 * qq + 2] = bf_lo(wa.y) * (1.0f / 32.0f); wv[p][8 * qq + 3] = bf_hi(wa.y) * (1.0f / 32.0f);
            wv[p][8 * qq + 4] = bf_lo(wb.x) * (1.0f / 32.0f); wv[p][8 * qq + 5] = bf_hi(wb.x) * (1.0f / 32.0f); wv[p][8 * qq + 6] = bf_lo(wb.y) * (1.0f / 32.0f); wv[p][8 * qq + 7] = bf_hi(wb.y) * (1.0f / 32.0f);
        }
#pragma unroll
        for (int i = 0; i < 8; ++i) wv2[p][i] = (f32x2){wv[p][2 * i], wv[p][2 * i + 1]};
    }
    const u32x2 tagsw = __builtin_amdgcn_permlane32_swap(0u, 1u, false, false); const int qsel = (int)tagsw[0];
    u32x4 stg[2];
#pragma unroll
    for (int i = 0; i < 2; ++i) { const int q = tid + 512 * i; stg[i] = *(const u32x4*)(KI + (size_t)(kt0 * 128 + (q >> 3)) * 64 + (q & 7) * 8); }
#pragma unroll
    for (int i = 0; i < 2; ++i) { const int q = tid + 512 * i; *(LAS u32x4*)(lds + SC_KT + (kt0 & 1) * 18432 + (q >> 3) * 144 + (q & 7) * 16) = stg[i]; }
    __syncthreads();
    for (int kt = kt0; kt < kt1; ++kt) {
        const LAS unsigned char* buf = lds + SC_KT + (kt & 1) * 18432;
        LAS float* sb = (LAS float*)(lds + SC_SB + (kt & 1) * (32 * SC_SPITCH * 4));
        if (kt + 1 < kt1) {
#pragma unroll
            for (int i = 0; i < 2; ++i) { const int q = tid + 512 * i; stg[i] = *(const u32x4*)(KI + (size_t)((kt + 1) * 128 + (q >> 3)) * 64 + (q & 7) * 8); }
        }
        __builtin_amdgcn_sched_barrier(0);
        if (kt > kt0) score_flush(lds, SCORES, SEGMAX, t0, kt - 1, tid);
        {
        f32x16 accP[2], accC[2];
#define SC_MFMA(cb) do { bf16x8 Bf[4]; _Pragma("unroll") for (int ks = 0; ks < 4; ++ks) Bf[ks] = *(const LAS bf16x8*)(buf + (32 * (cb) + r) * 144 + (16 * ks + 8 * hh) * 2); \
            _Pragma("unroll") for (int p = 0; p < 2; ++p) { _Pragma("unroll") for (int i = 0; i < 16; ++i) accC[p][i] = 0.f; \
                _Pragma("unroll") for (int ks = 0; ks < 4; ++ks) accC[p] = __builtin_amdgcn_mfma_f32_32x32x16_bf16(Af[p][ks], Bf[ks], accC[p], 0, 0, 0); } } while (0)
#define SC_RED(acc, cb) do { _Pragma("unroll") for (int p = 0; p < 2; ++p) { f32x2 s0 = {0.f, 0.f}, s1 = {0.f, 0.f}; \
            _Pragma("unroll") for (int reg = 0; reg < 8; reg += 2) { const f32x2 r0 = {relu_i(acc[p][reg]), relu_i(acc[p][reg + 1])}; const f32x2 r1 = {relu_i(acc[p][reg + 8]), relu_i(acc[p][reg + 9])}; \
                s0 = __builtin_elementwise_fma(wv2[p][reg >> 1], r0, s0); s1 = __builtin_elementwise_fma(wv2[p][4 + (reg >> 1)], r1, s1); } \
            const float p0 = s0[0] + s0[1], p1 = s1[0] + s1[1]; \
            const u32x2 sw = __builtin_amdgcn_permlane32_swap(__float_as_uint(p0), __float_as_uint(p1), false, false); \
            sb[(4 * wave + 2 * p + qsel) * SC_SPITCH + 32 * (cb) + r] = __uint_as_float(sw[0]) + __uint_as_float(sw[1]); } } while (0)
#define SC_INTERLEAVE() do { _Pragma("unroll") for (int i = 0; i < 8; ++i) { __builtin_amdgcn_sched_group_barrier(0x008, 1, 0); __builtin_amdgcn_sched_group_barrier(0x002, 8, 0); } } while (0)
        SC_MFMA(0);
        accP[0] = accC[0]; accP[1] = accC[1]; SC_MFMA(1); SC_RED(accP, 0); SC_INTERLEAVE();
        accP[0] = accC[0]; accP[1] = accC[1]; SC_MFMA(2); SC_RED(accP, 1); SC_INTERLEAVE();
        accP[0] = accC[0]; accP[1] = accC[1]; SC_MFMA(3); SC_RED(accP, 2); SC_INTERLEAVE();
        SC_RED(accC, 3);
#undef SC_MFMA
#undef SC_RED
#undef SC_INTERLEAVE
        }
        if (kt + 1 < kt1) {
#pragma unroll
            for (int i = 0; i < 2; ++i) { const int q = tid + 512 * i; *(LAS u32x4*)(lds + SC_KT + ((kt + 1) & 1) * 18432 + (q >> 3) * 144 + (q & 7) * 16) = stg[i]; }
        }
        __syncthreads();
    }
    score_flush(lds, SCORES, SEGMAX, t0, kt1 - 1, tid);
    __syncthreads();
}

template <int NV, bool EXACT>
__device__ __forceinline__ float wave_kth(const float (&v)[NV], int K) {
    const float NINF = -__builtin_inff();
    float mx = NINF, mn = __builtin_inff();
#pragma unroll
    for (int j = 0; j < NV; ++j) { mx = fmaxf(mx, v[j]); mn = fminf(mn, v[j] == NINF ? __builtin_inff() : v[j]); }
    mx = wave_max(mx); mn = -wave_max(-mn);
    int c = 0;
#pragma unroll
    for (int j = 0; j < NV; ++j) c += __popcll(__ballot(v[j] >= mx));
    if (c >= K) return mx;
    float lo = mn, hi = mx, tau = mn;
    for (int it = 0; it < 64; ++it) {
        const float mid = 0.5f * (lo + hi);
        if (!(mid > lo && mid < hi)) { tau = lo; break; }
        c = 0;
#pragma unroll
        for (int j = 0; j < NV; ++j) c += __popcll(__ballot(v[j] >= mid));
        if (c == K || (!EXACT && c > K && c <= K + (K >> 2))) { tau = mid; break; }
        if (c > K) lo = mid; else hi = mid;
        tau = lo;
    }
    return tau;
}
__device__ __forceinline__ float wave_kth16(const float (&v)[16], int K) { return wave_kth<16, true>(v, K); }
__device__ __forceinline__ int lanes_below(unsigned long long mask) { return (int)__builtin_amdgcn_mbcnt_hi((unsigned)(mask >> 32), __builtin_amdgcn_mbcnt_lo((unsigned)mask, 0u)); }
__device__ __forceinline__ float h2f(unsigned short h) { return (float)__builtin_bit_cast(_Float16, h); }
__device__ __forceinline__ float h2f_lo(unsigned u) { return h2f((unsigned short)(u & 0xffffu)); }
__device__ __forceinline__ float h2f_hi(unsigned u) { return h2f((unsigned short)(u >> 16)); }
__device__ __forceinline__ unsigned ge_mask8(const u32x4& v, unsigned T16) {
    unsigned m8 = 0;
#pragma unroll
    for (int w = 0; w < 4; ++w) { const unsigned vw_ = v[w];
        const s16x2 d = __builtin_elementwise_sub_sat(__builtin_bit_cast(s16x2, vw_), __builtin_bit_cast(s16x2, T16));
        const unsigned mm = ~__builtin_bit_cast(unsigned, d); m8 |= (((mm >> 15) & 1u) | ((mm >> 30) & 2u)) << (2 * w); }
    return m8;
}
__device__ __forceinline__ int append_bits(LAS int* list, int cnt, unsigned m8, int base) {
    for (;;) { const bool has = m8 != 0u; const unsigned long long mask = __ballot(has); if (!mask) break;
        const int pos = cnt + lanes_below(mask);
        if (has) { const int k = __builtin_ctz(m8); m8 &= m8 - 1u; if (pos < 1024) list[pos] = base + k; }
        cnt += __popcll(mask); }
    return cnt;
}
__device__ __forceinline__ int append_keys(LAS int* list, int cnt, unsigned m8, int base, const u32x4& v) {
    for (;;) { const bool has = m8 != 0u; const unsigned long long mask = __ballot(has); if (!mask) break;
        const int pos = cnt + lanes_below(mask);
        if (has) { const int k = __builtin_ctz(m8); m8 &= m8 - 1u;
            const unsigned dw = (k & 4) ? ((k & 2) ? v.w : v.z) : ((k & 2) ? v.y : v.x); const unsigned h = (k & 1) ? (dw >> 16) : (dw & 0xffffu);
            if (pos < 1024) list[pos] = (int)((h << 16) | (unsigned)(base + k)); }
        cnt += __popcll(mask); }
    return cnt;
}
__device__ __forceinline__ void select_row(LAS unsigned char* wl, const unsigned short* SCORES, const unsigned short* SEGMAX, int t, int lane) {
    LAS int* selw = (LAS int*)wl; LAS int* segl = (LAS int*)(wl + 1024); LAS int* cidx = (LAS int*)(wl + 5120);
    const float NINF = -__builtin_inff();
    const unsigned short* row = SCORES + (size_t)t * S; const int n = t + 1;
    float c[16]; int N;
    if (n <= 1024) {
#pragma unroll
        for (int j = 0; j < 16; ++j) { const int i = lane + 64 * j; c[j] = i < n ? h2f(row[i]) : NINF; }
        N = -1;
    } else {
        const int m = n >> 4; float s[16];
#pragma unroll
        for (int j = 0; j < 16; ++j) { const int i = lane + 64 * j; s[j] = i < m ? h2f(row[16 * i + 7]) : NINF; }
        const u32x4 NEG = (u32x4){0xfc00fc00u, 0xfc00fc00u, 0xfc00fc00u, 0xfc00fc00u};
        const unsigned short* smrow = SEGMAX + (size_t)t * 2048; const int nseg = (t >> 3) + 1;
        u32x4 sv[4];
#pragma unroll
        for (int u = 0; u < 4; ++u) { const int e8 = 8 * (lane + 64 * u); sv[u] = (e8 < nseg) ? *(const u32x4*)(smrow + e8) : NEG; }
        int K = 26, cnt = 0;
        for (;;) {
            const float tlo = (K >= m) ? NINF : wave_kth<16, false>(s, K);
            cnt = 0;
            const int nq = (n + 511) >> 9;
            if (tlo > 0.f) {
                const unsigned T16 = pk_f16(tlo, tlo);
                int ns = 0;
                {
#pragma unroll
                    for (int u = 0; u < 4; ++u) if (512 * u < nseg) { const int e8 = 8 * (lane + 64 * u); unsigned m8 = ge_mask8(sv[u], T16);
                        const int nv = nseg - e8; if (nv < 8) m8 &= nv > 0 ? ((1u << nv) - 1u) : 0u;
                        ns = append_bits(segl, ns, m8, e8); }
                }
                if (ns > 1024) ns = 1024;
                for (int j0 = 0; j0 < ns; j0 += 512) {
                    u32x4 v[8]; int sg[8];
#pragma unroll
                    for (int u = 0; u < 8; ++u) { const int i = j0 + lane + 64 * u; sg[u] = i < ns ? segl[i] : -1; v[u] = sg[u] >= 0 ? *(const u32x4*)(row + 8 * sg[u]) : NEG; }
#pragma unroll
                    for (int u = 0; u < 8; ++u) if (j0 + 64 * u < ns) { const int e = 8 * sg[u]; unsigned m8 = sg[u] >= 0 ? ge_mask8(v[u], T16) : 0u;
                        const int nv = t + 1 - e; if (nv < 8) m8 &= nv > 0 ? ((1u << nv) - 1u) : 0u;
                        cnt = append_keys(cidx, cnt, m8, e, v[u]); }
                }
            } else {
                for (int q0 = 0; q0 < nq; q0 += 4) {
                    u32x4 v[4];
#pragma unroll
                    for (int u = 0; u < 4; ++u) { const int e = 8 * (lane + 64 * (q0 + u)); v[u] = (e <= t) ? *(const u32x4*)(row + e) : (u32x4){0xfc00fc00u, 0xfc00fc00u, 0xfc00fc00u, 0xfc00fc00u}; }
#pragma unroll
                    for (int u = 0; u < 4; ++u) { const int e = 8 * (lane + 64 * (q0 + u));
#pragma unroll
                        for (int k = 0; k < 8; ++k) { const float x = (k & 1) ? h2f_hi(v[u][k >> 1]) : h2f_lo(v[u][k >> 1]);
                            const bool pred = (e + k <= t) && (x >= tlo); const unsigned long long mask = __ballot(pred);
                            if (mask) { const int pos = cnt + lanes_below(mask); const unsigned hb = (k & 1) ? (v[u][k >> 1] >> 16) : (v[u][k >> 1] & 0xffffu);
                                if (pred && pos < 1024) cidx[pos] = (int)((hb << 16) | (unsigned)(e + k)); cnt += __popcll(mask); } } }
                }
            }
            if (cnt >= 256 || K >= m) break;
            K *= 2;
        }
        N = cnt < 1024 ? cnt : 1024;
#pragma unroll
        for (int j = 0; j < 16; ++j) { const int i = lane + 64 * j; c[j] = i < N ? h2f((unsigned short)((unsigned)cidx[i] >> 16)) : NINF; }
    }
    float tau;
    if (N >= 0 && N <= 512) { const float c8[8] = {c[0], c[1], c[2], c[3], c[4], c[5], c[6], c[7]}; tau = wave_kth<8, true>(c8, 256); }
    else tau = wave_kth16(c, 256);
    int base = 0;
#pragma unroll
    for (int j = 0; j < 16; ++j) { const bool pred = c[j] >= tau; const unsigned long long mask = __ballot(pred);
        if (mask) { const int pos = base + lanes_below(mask); if (pred && pos < 256) selw[pos] = (N < 0) ? (lane + 64 * j) : (cidx[lane + 64 * j] & 0xffff); base += __popcll(mask); } }
}

__device__ __forceinline__ void attn_query(LAS unsigned char* wl, const bf16_t* PROJ, const unsigned char* KC, const unsigned char* VC, unsigned char* ATT, int t, int lane) {
    LAS int* selw = (LAS int*)wl; LAS float* L = (LAS float*)(wl + 1024);
    const int nsel = t < 255 ? t + 1 : 256;
    const int fr = lane & 15, fq = lane >> 4;
    constexpr float QS = 8.0f;
    long qh[2][4], ql[2][4];
#pragma unroll
    for (int g = 0; g < 2; ++g)
#pragma unroll
        for (int ks = 0; ks < 4; ++ks) {
            u32x4 z = (u32x4){0u, 0u, 0u, 0u};
            if (fr < 4) z = *(const u32x4*)(PROJ + (size_t)t * DINP + CQ + (4 * g + fr) * 128 + 32 * ks + 8 * fq);
            float qv[8], rv[8];
#pragma unroll
            for (int e = 0; e < 4; ++e) { qv[2 * e] = bf_lo(z[e]) * QS; qv[2 * e + 1] = bf_hi(z[e]) * QS; }
            const unsigned h0 = pack4_fp8(qv[0], qv[1], qv[2], qv[3]), h1 = pack4_fp8(qv[4], qv[5], qv[6], qv[7]);
            rv[0] = qv[0] - __builtin_amdgcn_cvt_f32_fp8((int)h0, 0); rv[1] = qv[1] - __builtin_amdgcn_cvt_f32_fp8((int)h0, 1); rv[2] = qv[2] - __builtin_amdgcn_cvt_f32_fp8((int)h0, 2); rv[3] = qv[3] - __builtin_amdgcn_cvt_f32_fp8((int)h0, 3);
            rv[4] = qv[4] - __builtin_amdgcn_cvt_f32_fp8((int)h1, 0); rv[5] = qv[5] - __builtin_amdgcn_cvt_f32_fp8((int)h1, 1); rv[6] = qv[6] - __builtin_amdgcn_cvt_f32_fp8((int)h1, 2); rv[7] = qv[7] - __builtin_amdgcn_cvt_f32_fp8((int)h1, 3);
            const unsigned l0 = pack4_fp8(rv[0] * 16.0f, rv[1] * 16.0f, rv[2] * 16.0f, rv[3] * 16.0f), l1 = pack4_fp8(rv[4] * 16.0f, rv[5] * 16.0f, rv[6] * 16.0f, rv[7] * 16.0f);
            qh[g][ks] = (long)(((unsigned long long)h1 << 32) | h0); ql[g][ks] = (long)(((unsigned long long)l1 << 32) | l0);
        }
    const float scale = 0.08838834764831845f / QS;
    const int nkt = (nsel + 15) >> 4;
    {
        LAS unsigned char* KT = wl + 9216;
        const int q4_ = lane >> 4, l15_ = lane & 15;
        u32x4 kw[3][4];
#define QK_LOAD(buf, kt) do { _Pragma("unroll") for (int u = 0; u < 4; ++u) { const unsigned off_ = (unsigned)selw[16 * (kt) + 4 * u + q4_] * 256u + 16u * (unsigned)l15_; kw[buf][u] = *(const u32x4*)((const char*)KC + off_); } } while (0)
#define QK_COMP(buf, kt) do { _Pragma("unroll") for (int u = 0; u < 4; ++u) *(LAS u32x4*)(KT + (4 * u + q4_) * 272 + 16 * l15_) = kw[buf][u];     \
        _Pragma("unroll") for (int g = 0; g < 2; ++g) { f32x4 acch = (f32x4){0.f, 0.f, 0.f, 0.f}, accl = (f32x4){0.f, 0.f, 0.f, 0.f}; \
            _Pragma("unroll") for (int ks = 0; ks < 4; ++ks) { const long kf_ = *(const LAS long*)(KT + fr * 272 + g * 128 + 32 * ks + 8 * fq); \
                acch = __builtin_amdgcn_mfma_f32_16x16x32_fp8_fp8(qh[g][ks], kf_, acch, 0, 0, 0); accl = __builtin_amdgcn_mfma_f32_16x16x32_fp8_fp8(ql[g][ks], kf_, accl, 0, 0, 0); } \
            if (fq == 0) { _Pragma("unroll") for (int r = 0; r < 4; ++r) L[(4 * g + r) * 256 + 16 * (kt) + fr] = (16 * (kt) + fr < nsel) ? (acch[r] + accl[r] * 0.0625f) * scale : -__builtin_inff(); } } } while (0)
        QK_LOAD(0, 0); if (1 < nkt) QK_LOAD(1, 1);
        for (int kt = 0; kt < nkt; kt += 3) {
            if (kt + 2 < nkt) QK_LOAD(2, kt + 2);
            __builtin_amdgcn_sched_barrier(0);
            QK_COMP(0, kt);
            if (kt + 1 < nkt) { if (kt + 3 < nkt) QK_LOAD(0, kt + 3); __builtin_amdgcn_sched_barrier(0); QK_COMP(1, kt + 1); }
            if (kt + 2 < nkt) { if (kt + 4 < nkt) QK_LOAD(1, kt + 4); __builtin_amdgcn_sched_barrier(0); QK_COMP(2, kt + 2); }
        }
#undef QK_LOAD
#undef QK_COMP
        if (fq == 0) { for (int kt = nkt; kt < 16; ++kt) {
#pragma unroll
            for (int r = 0; r < 8; ++r) L[r * 256 + 16 * kt + fr] = -__builtin_inff(); } }
    }
    float p[8][4];
#pragma unroll
    for (int hd = 0; hd < 8; ++hd) { float m = -__builtin_inff();
#pragma unroll
        for (int i = 0; i < 4; ++i) { p[hd][i] = L[hd * 256 + 4 * lane + i]; m = fmaxf(m, p[hd][i]); }
        m = wave_max(m); float s = 0.f;
#pragma unroll
        for (int i = 0; i < 4; ++i) { p[hd][i] = __expf(p[hd][i] - m); s += p[hd][i]; }
        s = 1.0f / wave_sum(s);
#pragma unroll
        for (int i = 0; i < 4; ++i) p[hd][i] *= s; }
    constexpr float PS = 256.0f;
    LAS unsigned* Ph = (LAS unsigned*)(wl + 1024); LAS unsigned* Pl = (LAS unsigned*)(wl + 1024 + 2048);
#pragma unroll
    for (int hd = 0; hd < 8; ++hd) {
        const float a0 = p[hd][0] * PS, a1 = p[hd][1] * PS, a2 = p[hd][2] * PS, a3 = p[hd][3] * PS;
        const unsigned h = pack4_fp8(a0, a1, a2, a3);
        const unsigned l = pack4_fp8(a0 - __builtin_amdgcn_cvt_f32_fp8((int)h, 0), a1 - __builtin_amdgcn_cvt_f32_fp8((int)h, 1), a2 - __builtin_amdgcn_cvt_f32_fp8((int)h, 2), a3 - __builtin_amdgcn_cvt_f32_fp8((int)h, 3));
        Ph[hd * 64 + lane] = h; Pl[hd * 64 + lane] = l;
    }
    LAS unsigned char* VT = wl + 9216;
    const int ii = lane & 15, kq = lane >> 4;
    f32x4 acc[16];
#pragma unroll
    for (int nt = 0; nt < 16; ++nt) acc[nt] = (f32x4){0.f, 0.f, 0.f, 0.f};
    const int nch = (nsel + 15) >> 4;
    u32x4 vw[3][4];
#define PV_LOAD(buf, c) do { _Pragma("unroll") for (int u = 0; u < 4; ++u) { const unsigned off_ = (unsigned)selw[16 * (c) + 4 * u + kq] * 256u + 16u * (unsigned)ii; vw[buf][u] = *(const u32x4*)((const char*)VC + off_); } } while (0)
#define PV_COMP(buf, c) do { _Pragma("unroll") for (int u = 0; u < 4; ++u) { LAS u32x2* d_ = (LAS u32x2*)(VT + (16 * ((c) & 1) + 4 * u + kq) * 264 + 16 * ii); d_[0] = (u32x2){vw[buf][u].x, vw[buf][u].y}; d_[1] = (u32x2){vw[buf][u].z, vw[buf][u].w}; } \
        if (((c) & 1) || (c) == nch - 1) { \
            if (!((c) & 1)) { _Pragma("unroll") for (int u = 0; u < 4; ++u) { LAS u32x2* d_ = (LAS u32x2*)(VT + (16 + 4 * u + kq) * 264 + 16 * ii); d_[0] = (u32x2){0u, 0u}; d_[1] = (u32x2){0u, 0u}; } } \
            long pa[2]; _Pragma("unroll") for (int g = 0; g < 2; ++g) { const int po_ = (g * 4 + (ii & 3)) * 256 + 32 * ((c) >> 1) + 8 * kq;     \
                const long h_ = *(const LAS long*)((const LAS unsigned char*)Ph + po_ + ((ii & 4) ? 2048 : 0)); pa[g] = ii < 8 ? h_ : 0l; } \
            _Pragma("unroll") for (int nt = 0; nt < 16; ++nt) { const v2i32 t_ = __builtin_amdgcn_ds_read_tr8_b64_v2i32((LAS v2i32*)(VT + (8 * kq + (ii >> 1)) * 264 + 16 * nt + 8 * (ii & 1))); \
                const long b_ = __builtin_bit_cast(long, t_); \
                acc[nt] = __builtin_amdgcn_mfma_f32_16x16x32_fp8_fp8(pa[nt >> 3], b_, acc[nt], 0, 0, 0); } } } while (0)
    PV_LOAD(0, 0); if (1 < nch) PV_LOAD(1, 1);
    for (int c = 0; c < nch; c += 3) {
        if (c + 2 < nch) PV_LOAD(2, c + 2);
        __builtin_amdgcn_sched_barrier(0);
        PV_COMP(0, c);
        if (c + 1 < nch) { if (c + 3 < nch) PV_LOAD(0, c + 3); __builtin_amdgcn_sched_barrier(0); PV_COMP(1, c + 1); }
        if (c + 2 < nch) { if (c + 4 < nch) PV_LOAD(1, c + 4); __builtin_amdgcn_sched_barrier(0); PV_COMP(2, c + 2); }
    }
#undef PV_LOAD
#undef PV_COMP
    LAS float* OB = (LAS float*)(wl + 1024 + 4096);
    LAS float* OB2 = (LAS float*)(wl + 1024);
    if (kq < 2) {
        LAS float* ob = kq == 0 ? OB : OB2;
#pragma unroll
        for (int nt = 0; nt < 16; ++nt)
#pragma unroll
            for (int r = 0; r < 4; ++r) ob[(4 * (nt >> 3) + r) * 128 + 16 * (nt & 7) + ii] = acc[nt][r];
    }
    {
        const f32x4 a0 = *(const LAS f32x4*)(OB + 16 * lane) + *(const LAS f32x4*)(OB2 + 16 * lane), a1 = *(const LAS f32x4*)(OB + 16 * lane + 4) + *(const LAS f32x4*)(OB2 + 16 * lane + 4),
                    a2 = *(const LAS f32x4*)(OB + 16 * lane + 8) + *(const LAS f32x4*)(OB2 + 16 * lane + 8), a3 = *(const LAS f32x4*)(OB + 16 * lane + 12) + *(const LAS f32x4*)(OB2 + 16 * lane + 12);
        const f32x4 b0 = a0 * (OP8_SCALE / PS), b1 = a1 * (OP8_SCALE / PS), b2 = a2 * (OP8_SCALE / PS), b3 = a3 * (OP8_SCALE / PS);
        *(u32x4*)(ATT + (size_t)t * 1024 + 16 * lane) = (u32x4){pack4_fp8(b0[0], b0[1], b0[2], b0[3]), pack4_fp8(b1[0], b1[1], b1[2], b1[3]), pack4_fp8(b2[0], b2[1], b2[2], b2[3]), pack4_fp8(b3[0], b3[1], b3[2], b3[3])};
    }
}


__device__ __forceinline__ void convert_item8(const float* __restrict__ W, int K, int N, int ld, unsigned char* WT, int mode, int item, int lane, LAS unsigned char* scr) {
    const int nblk = N >> 6; const int kb = item / nblk, nb = item - kb * nblk; const int k0 = kb * 256, n0 = nb * 64;
    const int c4 = lane & 15, kr = lane >> 4;
    const float* src = W + (size_t)(k0 + 4 * kr) * ld + n0 + 4 * c4;
#pragma unroll 4
    for (int i = 0; i < 16; ++i) {
        f32x4 v[4];
#pragma unroll
        for (int r = 0; r < 4; ++r) v[r] = __builtin_nontemporal_load((const f32x4*)(src + (size_t)(16 * i + r) * ld));
        const int kk = 16 * i + 4 * kr;
#pragma unroll
        for (int e = 0; e < 4; ++e) *(LAS unsigned*)(scr + (4 * c4 + e) * 272 + kk) = pack4_fp8(v[0][e] * W8_SCALE, v[1][e] * W8_SCALE, v[2][e] * W8_SCALE, v[3][e] * W8_SCALE);
    }
    LDS_WAIT(); asm volatile("" ::: "memory");
#pragma unroll 4
    for (int j = 0; j < 16; ++j) {
        const int q = j * 64 + lane, n = q >> 4, ch = q & 15;
        const u32x4 v = *(const LAS u32x4*)(scr + n * 272 + ch * 16);
        *(u32x4*)(WT + (size_t)dest_row(mode, n0 + n) * K + k0 + ch * 16) = v;
    }
    LDS_WAIT(); asm volatile("" ::: "memory");
}

struct Conv8Job { const float* W; unsigned char* WT; int N; int mode; size_t w_estride, wt_estride; int items_per_e; };
constexpr int C8_PITCH = 272, C8_IMG = 256 * C8_PITCH;
__device__ __forceinline__ void conv8_load(const Conv8Job& jb, int item, int h, int wave, int lane, f32x4 (&v)[16]) {
    const int e = item / jb.items_per_e, r = item - e * jb.items_per_e; const int nblk = jb.N >> 8; const int kb = r / nblk, nb = r - kb * nblk;
    const float* src = jb.W + (size_t)e * jb.w_estride + (size_t)(kb * 256 + 32 * wave + 16 * h) * jb.N + nb * 256 + 4 * lane;
#pragma unroll
    for (int i = 0; i < 16; ++i) v[i] = __builtin_nontemporal_load((const f32x4*)(src + (size_t)i * jb.N));
}
__device__ __forceinline__ void conv8_to_lds(LAS unsigned char* img, int h, int wave, int lane, const f32x4 (&v)[16]) {
#pragma unroll
    for (int e = 0; e < 4; ++e) { u32x4 w;
#pragma unroll
        for (int g = 0; g < 4; ++g) w[g] = pack4_fp8(v[4 * g][e] * W8_SCALE, v[4 * g + 1][e] * W8_SCALE, v[4 * g + 2][e] * W8_SCALE, v[4 * g + 3][e] * W8_SCALE);
        *(LAS u32x4*)(img + (4 * lane + e) * C8_PITCH + 32 * wave + 16 * h) = w; }
}
__device__ __forceinline__ void conv8_store(const Conv8Job& jb, int item, const LAS unsigned char* img, int tid) {
    const int e = item / jb.items_per_e, r = item - e * jb.items_per_e; const int nblk = jb.N >> 8; const int kb = r / nblk, nb = r - kb * nblk;
    unsigned char* dst = jb.WT + (size_t)e * jb.wt_estride + kb * 256;
#pragma unroll
    for (int j = 0; j < 8; ++j) { const int q = j * 512 + tid, n = q >> 4, ch = q & 15;
        __builtin_nontemporal_store(*(const LAS u32x4*)(img + n * C8_PITCH + ch * 16), (u32x4*)(dst + (size_t)dest_row(jb.mode, nb * 256 + n) * 2048 + ch * 16)); }
}
__device__ __forceinline__ void conv8_run(LAS unsigned char* lds, const Conv8Job& jb, int n_items, int wg, int G, int tid, int wave, int lane) {
    if (wg >= n_items) return;
    f32x4 a[16], b[16]; int par = 0;
    conv8_load(jb, wg, 0, wave, lane, a); conv8_load(jb, wg, 1, wave, lane, b);
    for (int it = wg; it < n_items; it += G, par ^= 1) {
        LAS unsigned char* img = lds + par * C8_IMG;
        const int nx = (it + G < n_items) ? it + G : it;
        conv8_to_lds(img, 0, wave, lane, a); __builtin_amdgcn_sched_barrier(0);
        conv8_load(jb, nx, 0, wave, lane, a); __builtin_amdgcn_sched_barrier(0);
        conv8_to_lds(img, 1, wave, lane, b); __builtin_amdgcn_sched_barrier(0);
        conv8_load(jb, nx, 1, wave, lane, b); __builtin_amdgcn_sched_barrier(0);
        __syncthreads();
        conv8_store(jb, it, img, tid);
    }
    __syncthreads();
}

__global__ void __launch_bounds__(NTHR, 2) fwd_kernel(Args args) {
    extern __shared__ __attribute__((aligned(16))) unsigned char lds_raw[];
    LAS unsigned char* lds = (LAS unsigned char*)lds_raw;
    volatile LAS unsigned* MISC = (volatile LAS unsigned*)(lds + LDS_MISC);
    const int tid = threadIdx.x, lane = tid & 63, wave = __builtin_amdgcn_readfirstlane(tid >> 6);
    const int G = gridDim.x, wg = blockIdx.x;
    unsigned char* ws = args.ws;
    unsigned* ctl = (unsigned*)(ws + WS_CTL);
    const int lo = args.ph_lo, hi = args.ph_hi;
    const float* x = (const float*)args.in[0]; const float* cvec = (const float*)args.in[1]; const int* positions = (const int*)args.in[2];
    const float* w_ada = (const float*)args.in[3]; const float* b_ada = (const float*)args.in[4]; const float* norm1_g = (const float*)args.in[5];
    const float* w_in = (const float*)args.in[6]; const float* idx_knorm_g = (const float*)args.in[7]; const float* idx_knorm_b = (const float*)args.in[8];
    const float* lb_logits = (const float*)args.in[9]; const float* hgrn_norm_g = (const float*)args.in[10];
    const float* w_proj_att = (const float*)args.in[11]; const float* w_proj_hgrn = (const float*)args.in[12]; const float* w_out = (const float*)args.in[13];
    const float* norm2_g = (const float*)args.in[14]; const float* w_router = (const float*)args.in[15]; const float* b_router = (const float*)args.in[16];
    const float* w1 = (const float*)args.in[17]; const float* b1 = (const float*)args.in[18]; const float* w2 = (const float*)args.in[19]; const float* b2 = (const float*)args.in[20];
    const float* final_g = (const float*)args.in[21];
    float* out = args.out;
    float* MOD = (float*)(ws + WS_MOD); int* TOPE = (int*)(ws + WS_TOPE); float* GATE = (float*)(ws + WS_GATE); int* SLOT = (int*)(ws + WS_SLOT);
    bf16_t* WIN_T = (bf16_t*)(ws + WS_WIN_T); bf16_t* WA_T = (bf16_t*)(ws + WS_WA_T); bf16_t* WH_T = (bf16_t*)(ws + WS_WH_T); bf16_t* WO_T = (bf16_t*)(ws + WS_WO_T);
    unsigned char* WIN_T8 = ws + WS_WIN_T + 8 * MiB;
    unsigned char* HA8 = ws + WS_SCORES;
    unsigned char* W1_T = ws + WS_W1_T; unsigned char* W2_T = ws + WS_W2_T;
    bf16_t* HB = (bf16_t*)(ws + WS_H); bf16_t* PROJ = (bf16_t*)(ws + WS_PROJ);
    bf16_t* DELTA = (bf16_t*)(ws + WS_ATT);
    unsigned char* ACT = ws + WS_ACT; bf16_t* YB = (bf16_t*)(ws + WS_YB);
    int* TOKS = (int*)(ws + WS_TOKS);
    unsigned char* H8 = ws + WS_H;
    bf16_t* KI = (bf16_t*)(ws + WS_KI); unsigned char* KC = ws + WS_KC; unsigned char* VC = ws + WS_VC;
    bf16_t* ST = (bf16_t*)(ws + WS_ST); float* DC = (float*)(ws + WS_DC);
    unsigned char* ATT = ws + WS_ATT; unsigned char* REC = ATT + (size_t)S * 1024;        bf16_t* MERGED = (bf16_t*)(ws + WS_MERGED); unsigned short* SCORES = (unsigned short*)(ws + WS_SCORES);
    unsigned short* SEGMAX = (unsigned short*)(ws + WS_X1);

    for (int u = tid; u < 128; u += NTHR) MISC[u] = 0u;
    __syncthreads();
    const bool one_launch = (hi - lo) > 1;
    XcdBarrier bar; bar.bar = ctl + CW_BAR; bar.x = 0; bar.st = MISC + 8;
    if (one_launch) bar = xcd_barrier_post(ctl + CW_BAR, MISC + 8);
#define IN(k) (lo <= (k) && (k) < hi)
#define SEAM(k) do { if (IN(k) && IN((k) + 1)) xcd_barrier(bar); } while (0)


    if (IN(PH_PRO)) {
        for (int cb = wg; cb < 256; cb += G) {
            LAS float* red = (LAS float*)lds;
            const int c4 = tid % 12, kg = tid / 12;
            f32x4 acc = (f32x4){0.f, 0.f, 0.f, 0.f};
            if (kg < 42) {
                const float* wp = w_ada + (size_t)cb * 48 + 4 * c4;
#pragma unroll 7
                for (int j = 0; j < 49; ++j) { const int k = kg + 42 * j; if (k < D) { const f32x4 v = __builtin_nontemporal_load((const f32x4*)(wp + (size_t)k * (6 * D))); acc += siluf_(cvec[k]) * v; } }
                *(LAS f32x4*)(red + kg * 48 + 4 * c4) = acc;
            }
            __syncthreads();
            if (tid < 48) { float s = b_ada[cb * 48 + tid];
#pragma unroll 6
                for (int q = 0; q < 42; ++q) s += red[q * 48 + tid];
                MOD[cb * 48 + tid] = s; }
            __syncthreads();
        }
        LAS unsigned char* scr = lds + wave * 17408;
        const int gw = wg * NWAVES + wave, NGW = G * NWAVES;
        {
            constexpr int NB_IN = (1104 + 63) / 64;
            for (int it = gw; it < 16 * NB_IN; it += NGW) convert_item(w_in + 1536, 2048, 1104, DIN, WIN_T, 0, it, lane, scr);
            for (int it = gw; it < 4 * 32; it += NGW) convert_item8(w_proj_att, 1024, 2048, 2048, (unsigned char*)WA_T, 0, it, lane, scr);
            for (int it = gw; it < 4 * 32; it += NGW) convert_item8(w_proj_hgrn, 1024, 2048, 2048, (unsigned char*)WA_T + (size_t)2048 * 1024, 0, it, lane, scr);
            for (int it = gw; it < 8 * 32; it += NGW) convert_item8(w_out, 2048, 2048, 2048, (unsigned char*)WO_T, 0, it, lane, scr);
            for (int it = gw; it < 8 * 24; it += NGW) convert_item8(w_in, 2048, 1536, DIN, WIN_T8, 0, it, lane, scr);
            for (int it = gw; it < 8 * 128; it += NGW) convert_item8(w_in + 2640, 2048, 8192, DIN, WIN_T8 + (size_t)1536 * 2048, 0, it, lane, scr);
            for (size_t i = (size_t)wg * NTHR + tid; i < (size_t)176 * 2048 * 2 / 16; i += (size_t)G * NTHR) ((u32x4*)(WIN_T + (size_t)1104 * 2048))[i] = (u32x4){0u, 0u, 0u, 0u};
        }
    }
    SEAM(PH_PRO);

    {
    if (IN(PH_H)) {
        const float* sh1 = MOD; const float* sc1 = MOD + D;
        const int gw = wg * NWAVES + wave, NGW = G * NWAVES;
        f32x4 gs[8], sh[8];
#pragma unroll
        for (int j = 0; j < 8; ++j) { const int c = 4 * lane + 256 * j; const f32x4 g = *(const f32x4*)(norm1_g + c), sc = *(const f32x4*)(sc1 + c); sh[j] = *(const f32x4*)(sh1 + c);
#pragma unroll
            for (int e = 0; e < 4; ++e) gs[j][e] = g[e] * (1.0f + sc[e]); }
        for (int t = gw; t < S; t += NGW) {
            const f32x4* xr = (const f32x4*)(x + (size_t)t * D) + lane;
            f32x4 v[8]; float ss = 0.f;
#pragma unroll
            for (int j = 0; j < 8; ++j) { v[j] = xr[64 * j]; ss += (v[j][0] * v[j][0] + v[j][1] * v[j][1]) + (v[j][2] * v[j][2] + v[j][3] * v[j][3]); }
            const float rstd = rsqrtf(wave_sum(ss) * (1.0f / D) + NORM_EPS);
#pragma unroll
            for (int j = 0; j < 8; ++j) { const f32x4 h = v[j] * rstd * gs[j] + sh[j]; u32x2 w; w.x = cvt_pk_bf16(h[0], h[1]); w.y = cvt_pk_bf16(h[2], h[3]);
                *(u32x2*)(HB + (size_t)t * D + 4 * lane + 256 * j) = w;
                *(unsigned*)(HA8 + (size_t)t * D + 4 * lane + 256 * j) = pack4_fp8(h[0], h[1], h[2], h[3]); }
        }
    }
    SEAM(PH_H);
    if (IN(PH_INPROJ)) {
        const int XC = (G == 256) ? XCONV : 0;
        const Conv8Job j1{w1, W1_T, 4096, 2, (size_t)2048 * 4096, (size_t)4096 * 2048, 8 * 16};
        const Conv8Job j2{w2, W2_T, 2048, 0, (size_t)2048 * 2048, (size_t)2048 * 2048, 8 * 8};
        if (G != 256) { conv8_run(lds, j1, NEXP * 8 * 16, wg, G, tid, wave, lane); conv8_run(lds, j2, NEXP * 8 * 8, wg, G, tid, wave, lane); }
        if (wg < XC) { conv8_run(lds, j1, NEXP * 8 * 16, wg, XC, tid, wave, lane); conv8_run(lds, j2, NEXP * 8 * 8, wg, XC, tid, wave, lane); }
        else {
            const int Gg = G - XC, cg = wg - XC;
            {
                pg8::Gemm g8{HA8, WIN_T8, 2048, 0, nullptr, 0}; pg8::StaticOrder S8; S8.init(S, 9728, Gg, cg);
                const int full8 = 2432 / Gg, rem8 = 2432 - full8 * Gg;
                if (Gg == 256) S8.skew(8, (wg >= 128 && wg < 192) ? -1 : (wg < 128 ? wg : wg - 64), 192);
                else if (rem8 > 0) S8.skew(full8, cg < rem8 ? cg : -1, rem8);
                pg8::EpiBf16 E8{PROJ, DINP, nullptr, 0, 1.0f / W8_SCALE, 6, 1280};
                pg8::gemm_phase<pg8::EpiBf16, pg8::StaticOrder, true>(lds, g8, S8, E8);
            }
            {
                pg8::Gemm g{HB, WIN_T, 2048, 0, nullptr, 0}; pg8::StaticOrder So; So.init(S, 1280, Gg, Gg == 256 ? (wg + 128) % G : (cg + Gg - (2432 % Gg)) % Gg);
                pg8::EpiBf16 E{PROJ + CQI, DINP, nullptr, 0, 1.0f, 1 << 30, 0};
                pg8::gemm_phase<pg8::EpiBf16, pg8::StaticOrder>(lds, g, So, E);
            }
        }
    }
    SEAM(PH_INPROJ);
    if (IN(PH_POST)) {
        const int gw = wg * NWAVES + wave, NGW = G * NWAVES;
        const float inv16 = powf(500000.0f, -(float)(lane & 15) * (1.0f / 16.0f)), inv8 = powf(500000.0f, -(float)(lane & 7) * (1.0f / 8.0f));
        for (int t = gw; t < S; t += NGW) post_token(PROJ, KI, KC, VC, positions, idx_knorm_g, idx_knorm_b, inv16, inv8, t, lane);
        __syncthreads();
        for (int u = wg; u < 2048; u += G) hgrn_l1(lds, PROJ, lb_logits, ST, DC, u >> 3, u & 7, tid, wave, lane);
    }
    SEAM(PH_POST);
    if (IN(PH_SCORE)) {
        for (int idx = wg * NTHR + tid; idx < 8 * 128 * 128; idx += G * NTHR) {
            const int h = idx >> 14, d = idx & 127; float s = 0.f;
            bf16_t* sp = ST + idx; const float* dp = DC + h * 128 + d;
            for (int c = 0; c < 256; c += 16) {
                float l[16], dc[16];
#pragma unroll
                for (int i = 0; i < 16; ++i) { l[i] = bf2f(sp[(size_t)(c + i) * 131072]); dc[i] = dp[(size_t)(c + i) * 1024]; }
#pragma unroll
                for (int i = 0; i < 16; ++i) { sp[(size_t)(c + i) * 131072] = f2bf(s); s = dc[i] * s + l[i]; }
            }
        }
        {
            const int XS = (G == 256) ? XSCORE : 0;
            if (wg < XS) {
                const Conv8Job j1{w1, W1_T, 4096, 2, (size_t)2048 * 4096, (size_t)4096 * 2048, 8 * 16};
                const Conv8Job j2{w2, W2_T, 2048, 0, (size_t)2048 * 2048, (size_t)2048 * 2048, 8 * 8};
                __syncthreads();
                conv8_run(lds, j1, NEXP * 8 * 16, wg, XS, tid, wave, lane); conv8_run(lds, j2, NEXP * 8 * 8, wg, XS, tid, wave, lane);
            }
            for (;;) {
                if (tid == 0) MISC[100] = __hip_atomic_fetch_add(ctl + CW_SCQ, 1u, __ATOMIC_RELAXED, __HIP_MEMORY_SCOPE_AGENT);
                __syncthreads();
                const int item = (int)MISC[100];
                __syncthreads();
                if (item >= 252 * 6) break;
                int j, lo, hi;
                if (item < 504) { j = item >> 1; const int T = ((8 + j) >> 2) + ((511 - j) >> 2) + 2; const int p = item & 1; lo = p * T / 3; hi = (p + 1) * T / 3; }
                else { const int i2 = item - 504; j = i2 >> 2; const int T = ((8 + j) >> 2) + ((511 - j) >> 2) + 2; const int p = i2 & 3, b = 2 * T / 3; lo = b + p * (T - b) / 4; hi = b + (p + 1) * (T - b) / 4; }
                const int qa = 8 + j, qb2 = 511 - j, na = (qa >> 2) + 1;
                const int a0 = lo < na ? lo : na, a1 = hi < na ? hi : na, b0 = (lo > na ? lo : na) - na, b1 = (hi > na ? hi : na) - na;
                if (a1 > a0) score_block(lds, PROJ, KI, SCORES, SEGMAX, qa, a0, a1, tid, wave, lane);
                if (b1 > b0) score_block(lds, PROJ, KI, SCORES, SEGMAX, qb2, b0, b1, tid, wave, lane);
            }
        }
    }
    SEAM(PH_SCORE);
    if (IN(PH_ATTN)) {
        const int gw = wg * NWAVES + wave, NGW = G * NWAVES;
        for (int u = wg; u < 2048; u += G) hgrn_l3(lds, PROJ, lb_logits, ST, hgrn_norm_g, REC, u >> 3, u & 7, tid, wave, lane);
        {
            for (;;) {
                unsigned tq = 0; if (lane == 0) tq = __hip_atomic_fetch_add(ctl + CW_ATQ, 1u, __ATOMIC_RELAXED, __HIP_MEMORY_SCOPE_AGENT);
                tq = (unsigned)__builtin_amdgcn_readfirstlane((int)tq);
                if (tq >= (unsigned)S) break;
                const int t = S - 1 - (int)tq;
                LAS unsigned char* wl = lds + wave * 17664;
                if (t >= 256) select_row(wl, SCORES, SEGMAX, t, lane);
                else {
#pragma unroll
                    for (int i = 0; i < 4; ++i) { const int idx = lane + 64 * i; ((LAS int*)wl)[idx] = idx <= t ? idx : 0; }
                }
                attn_query(wl, PROJ, KC, VC, ATT, t, lane);
            }
        }
    }
    SEAM(PH_ATTN);
    if (IN(PH_OP1)) {
        pg8::Gemm g{ATT, WA_T, 1024, (size_t)2048 * 1024, nullptr, (size_t)S * 1024};
        pg8::TwoPartOrder So; So.init(S, 2048, G, wg);
        pg8::EpiGate2 E{(unsigned char*)MERGED, PROJ + CGA, PROJ + CGR};
        pg8::gemm_phase<pg8::EpiGate2, pg8::TwoPartOrder, true>(lds, g, So, E);
    }
    SEAM(PH_OP2);
    if (IN(PH_WOUT)) {
        pg8::Gemm g{MERGED, WO_T, 2048, 0, nullptr, 0}; pg8::StaticOrder So; So.init(S, 2048, G, wg);
        pg8::EpiDelta E{MOD + 2 * D, DELTA, 1.0f / (W8_SCALE * MRG8_SCALE)};
        pg8::gemm_phase<pg8::EpiDelta, pg8::StaticOrder, true>(lds, g, So, E);
    }
    SEAM(PH_WOUT);
    }

    if (IN(PH_ROUTER)) {
        LAS float* hs = (LAS float*)lds;
        volatile LAS unsigned* lcnt = MISC + 32;
        const float* sh2 = MOD + 3 * D; const float* sc2 = MOD + 4 * D;
        if (tid < 32) lcnt[tid] = 0u;
        __syncthreads();
        for (int grp = wg; grp < S / 16; grp += G) {
#pragma unroll 1
            for (int q = 0; q < 2; ++q) {
                const int tl = 2 * wave + q, t = grp * 16 + tl;
                const f32x4* xr = (const f32x4*)(x + (size_t)t * D) + lane; const u32x2* dr = (const u32x2*)(DELTA + (size_t)t * D) + lane;
                f32x4 v[8]; float ss = 0.f;
#pragma unroll
                for (int j = 0; j < 8; ++j) { const u32x2 dw = dr[64 * j]; v[j] = xr[64 * j] + (f32x4){bf_lo(dw.x), bf_hi(dw.x), bf_lo(dw.y), bf_hi(dw.y)};
                    ss += (v[j][0] * v[j][0] + v[j][1] * v[j][1]) + (v[j][2] * v[j][2] + v[j][3] * v[j][3]); }
#pragma unroll
                for (int j = 0; j < 8; ++j) { u32x2 w; w.x = cvt_pk_bf16(v[j][0], v[j][1]); w.y = cvt_pk_bf16(v[j][2], v[j][3]); ((u32x2*)(DELTA + (size_t)t * D) + lane)[64 * j] = w; }
                const float rstd = rsqrtf(wave_sum(ss) * (1.0f / D) + NORM_EPS);
#pragma unroll
                for (int j = 0; j < 8; ++j) {
                    const int c = 4 * lane + 256 * j;
                    const f32x4 g = *(const f32x4*)(norm2_g + c), sc = *(const f32x4*)(sc2 + c), sh = *(const f32x4*)(sh2 + c);
                    f32x4 h;
#pragma unroll
                    for (int e = 0; e < 4; ++e) h[e] = v[j][e] * rstd * g[e] * (1.0f + sc[e]) + sh[e];
                    *(LAS f32x4*)(hs + tl * 2048 + c) = h;
                    *(unsigned*)(H8 + (size_t)t * D + c) = pack4_fp8(h[0], h[1], h[2], h[3]);
                }
            }
            __syncthreads();
            {
                LAS float* part = (LAS float*)(lds + 131072);
                const int fr = lane & 15, fq = lane >> 4;
                f32x4 acc0 = (f32x4){0.f, 0.f, 0.f, 0.f}, acc1 = acc0;
                const LAS float* hrow = hs + fr * 2048 + wave * 256 + 4 * fq; const float* wrp = w_router + (size_t)(wave * 256 + 4 * fq) * 32 + fr;
#pragma unroll 2
                for (int i = 0; i < 16; ++i) {
                    const f32x4 a4 = *(const LAS f32x4*)(hrow + 16 * i);
                    float b0[4], b1[4];
#pragma unroll
                    for (int s = 0; s < 4; ++s) { b0[s] = wrp[(size_t)(16 * i + s) * 32]; b1[s] = wrp[(size_t)(16 * i + s) * 32 + 16]; }
#pragma unroll
                    for (int s = 0; s < 4; ++s) { acc0 = __builtin_amdgcn_mfma_f32_16x16x4f32(a4[s], b0[s], acc0, 0, 0, 0); acc1 = __builtin_amdgcn_mfma_f32_16x16x4f32(a4[s], b1[s], acc1, 0, 0, 0); }
                }
#pragma unroll
                for (int r = 0; r < 4; ++r) { part[(wave * 16 + 4 * fq + r) * 32 + fr] = acc0[r]; part[(wave * 16 + 4 * fq + r) * 32 + 16 + fr] = acc1[r]; }
                __syncthreads();
                const int tl = tid >> 5, e = tid & 31, t = grp * 16 + tl;
                float v = b_router[e];
#pragma unroll
                for (int w = 0; w < 8; ++w) v += part[(w * 16 + tl) * 32 + e];
                float tv[4]; int ti[4];
#pragma unroll
                for (int k = 0; k < 4; ++k) {
                    float bv = v; int bi = e;
#pragma unroll
                    for (int o = 16; o >= 1; o >>= 1) { const float ov = __shfl_xor(bv, o); const int oi = __shfl_xor(bi, o); if (ov > bv || (ov == bv && oi < bi)) { bv = ov; bi = oi; } }
                    tv[k] = bv; ti[k] = bi; if (e == bi) v = -__builtin_inff();
                }
                if (e == 0) {
                    const float e1 = __expf(tv[1] - tv[0]), e2 = __expf(tv[2] - tv[0]), e3 = __expf(tv[3] - tv[0]); const float inv = 1.0f / (1.0f + e1 + e2 + e3);
                    *(int4*)(TOPE + (size_t)t * 4) = make_int4(ti[0], ti[1], ti[2], ti[3]);
                    *(f32x4*)(GATE + (size_t)t * 4) = (f32x4){inv, e1 * inv, e2 * inv, e3 * inv};
#pragma unroll
                    for (int k = 0; k < 4; ++k) __hip_atomic_fetch_add((LAS unsigned*)&lcnt[ti[k]], 1u, __ATOMIC_RELAXED, __HIP_MEMORY_SCOPE_WORKGROUP);
                }
            }
            __syncthreads();
        }
        if (tid < 32) { const unsigned c = lcnt[tid]; if (c) __hip_atomic_fetch_add(ctl + CW_CNT + tid, c, __ATOMIC_RELAXED, __HIP_MEMORY_SCOPE_AGENT); }
    }
    SEAM(PH_ROUTER);

    if (IN(PH_SCATTER)) {
        volatile LAS unsigned* lcnt = MISC + 32; volatile LAS unsigned* lbase = MISC + 64; LAS int* pstart = (LAS int*)(lds + 1024); LAS int* pcnt = (LAS int*)(lds + 1280);
        if (tid == 0) { int p = 0; for (int e = 0; e < NEXP; ++e) { const int c = (int)__hip_atomic_load(ctl + CW_CNT + e, __ATOMIC_RELAXED, __HIP_MEMORY_SCOPE_AGENT); pstart[e] = p; pcnt[e] = c; p += (c + 255) & ~255; } }
        if (tid < 32) lcnt[tid] = 0u;
        __syncthreads();
        if (wg < NEXP) { const int e = wg; for (int s = pstart[e] + pcnt[e] + tid; s < pstart[e] + ((pcnt[e] + 255) & ~255); s += NTHR) TOKS[s] = 0; }
        for (int blk = wg; blk < S / 64; blk += G) {
            int e = 0, lrank = 0;
            if (tid < 256) { e = TOPE[(size_t)blk * 256 + tid]; lrank = (int)__hip_atomic_fetch_add((LAS unsigned*)&lcnt[e], 1u, __ATOMIC_RELAXED, __HIP_MEMORY_SCOPE_WORKGROUP); }
            __syncthreads();
            if (tid < 32) { const unsigned c = lcnt[tid]; lbase[tid] = c ? __hip_atomic_fetch_add(ctl + CW_FILL + tid, c, __ATOMIC_RELAXED, __HIP_MEMORY_SCOPE_AGENT) : 0u; }
            __syncthreads();
            if (tid < 256) { const int slot = pstart[e] + (int)lbase[e] + lrank; SLOT[(size_t)blk * 256 + tid] = slot; TOKS[slot] = blk * 64 + (tid >> 2); }
            __syncthreads();
            if (tid < 32) lcnt[tid] = 0u;
            __syncthreads();
        }
    }
    SEAM(PH_SCATTER);

    if (IN(PH_MOE1) || IN(PH_MOE2)) {
        LAS int* panel_e = (LAS int*)(lds + 131072 + 2048);
        LAS int* npan = (LAS int*)(lds + 131072 + 2048 + 2048);
        __syncthreads();
        if (tid == 0) { int p = 0; for (int e = 0; e < NEXP; ++e) { const int np = (int)((__hip_atomic_load(ctl + CW_CNT + e, __ATOMIC_RELAXED, __HIP_MEMORY_SCOPE_AGENT) + 255u) >> 8); for (int q = 0; q < np; ++q) panel_e[p + q] = e; p += np; } npan[0] = p; }
        __syncthreads();
        const int nPanels = npan[0];
        if (IN(PH_MOE1)) {
            pg8::Gemm g{H8, W1_T, 2048, (size_t)4096 * 2048, TOKS, 0}; pg8::MoeOrder So; So.init(nPanels, 16, G, wg, panel_e);
            pg8::EpiSwiglu E{ACT, b1};
            pg8::gemm_phase<pg8::EpiSwiglu, pg8::MoeOrder, true>(lds, g, So, E);
        }
        SEAM(PH_MOE1);
        if (IN(PH_MOE2)) {
            pg8::Gemm g{ACT, W2_T, 2048, (size_t)2048 * 2048, nullptr, 0}; pg8::MoeOrder So; So.init(nPanels, 8, G, wg, panel_e);
            pg8::EpiBf16 E{YB, 2048, b2, 2048, 1.0f / (W8_SCALE * ACT8_SCALE), 1 << 30, 0};
            pg8::gemm_phase<pg8::EpiBf16, pg8::MoeOrder, true>(lds, g, So, E);
        }
    }
    SEAM(PH_MOE2);

    if (IN(PH_FINAL)) {
        const float* gt2 = MOD + 5 * D;
        const int gw = wg * NWAVES + wave, NGW = G * NWAVES;
        for (int t = gw; t < S; t += NGW) {
            const u32x2* dr = (const u32x2*)(DELTA + (size_t)t * D) + lane;
            f32x4 v[8];
#pragma unroll
            for (int j = 0; j < 8; ++j) { const u32x2 dw = dr[64 * j]; v[j] = (f32x4){bf_lo(dw.x), bf_hi(dw.x), bf_lo(dw.y), bf_hi(dw.y)}; }
            {
                f32x4 m[8];
#pragma unroll
                for (int j = 0; j < 8; ++j) m[j] = (f32x4){0.f, 0.f, 0.f, 0.f};
                const int4 sl = *(const int4*)(SLOT + (size_t)t * 4); const f32x4 gt = *(const f32x4*)(GATE + (size_t)t * 4);
                const int sls[4] = {sl.x, sl.y, sl.z, sl.w};
#pragma unroll
                for (int k = 0; k < 4; ++k) {
                    const u32x2* yr = (const u32x2*)(YB + (size_t)sls[k] * D) + lane; const float gk = gt[k];
#pragma unroll
                    for (int j = 0; j < 8; ++j) { const u32x2 w = yr[64 * j]; m[j][0] += gk * bf_lo(w.x); m[j][1] += gk * bf_hi(w.x); m[j][2] += gk * bf_lo(w.y); m[j][3] += gk * bf_hi(w.y); }
                }
#pragma unroll
                for (int j = 0; j < 8; ++j) { const f32x4 g2 = *(const f32x4*)(gt2 + 4 * lane + 256 * j); v[j] = v[j] + g2 * m[j]; }
            }
            float ss = 0.f;
#pragma unroll
            for (int j = 0; j < 8; ++j) ss += (v[j][0] * v[j][0] + v[j][1] * v[j][1]) + (v[j][2] * v[j][2] + v[j][3] * v[j][3]);
            const float rstd = rsqrtf(wave_sum(ss) * (1.0f / D) + NORM_EPS);
            f32x4* orow = (f32x4*)(out + (size_t)t * D) + lane;
#pragma unroll
            for (int j = 0; j < 8; ++j) { const f32x4 fg = *(const f32x4*)(final_g + 4 * lane + 256 * j); orow[64 * j] = v[j] * rstd * fg; }
        }
    }
#undef IN
#undef SEAM
}

#ifndef MK_ONE_LAUNCH
#define MK_ONE_LAUNCH 1
#endif
extern "C" void kernel_launch(void* const* d_in, const int* in_sizes, int n_in, void* d_out, int out_size, void* d_ws, size_t ws_size, hipStream_t stream) {
    static int grid = 0;
    if (grid == 0) {
        if (n_in != 22 || out_size != S * D || ws_size < WS_END) { fprintf(stderr, "kernel_launch: unexpected shapes: n_in %d out %d ws %zu (need %zu)\n", n_in, out_size, ws_size, (size_t)WS_END); grid = -1; return; }
        int dev = 0, cus = 0, per_cu = 0;
        if (hipGetDevice(&dev) != hipSuccess || hipDeviceGetAttribute(&cus, hipDeviceAttributeMultiprocessorCount, dev) != hipSuccess) { grid = -1; return; }
        if (hipFuncSetAttribute((const void*)fwd_kernel, hipFuncAttributeMaxDynamicSharedMemorySize, LDS_BYTES) != hipSuccess) { fprintf(stderr, "kernel_launch: hipFuncSetAttribute failed\n"); grid = -1; return; }
        if (hipOccupancyMaxActiveBlocksPerMultiprocessor(&per_cu, (const void*)fwd_kernel, NTHR, LDS_BYTES) != hipSuccess || per_cu < 1) { fprintf(stderr, "kernel_launch: occupancy query says %d\n", per_cu); (void)hipGetLastError(); grid = -1; return; }
        grid = cus;
    }
    if (grid < 0) return;
    (void)in_sizes;
    hipMemsetAsync((char*)d_ws + WS_CTL, 0, CTL_BYTES, stream);
    Args a{};
    for (int i = 0; i < 22; ++i) a.in[i] = d_in[i];
    a.out = (float*)d_out; a.ws = (unsigned char*)d_ws; a.flags = 0; a.pad = 0;
#if MK_ONE_LAUNCH
    a.ph_lo = 0; a.ph_hi = NPH;
    hipLaunchKernelGGL(fwd_kernel, dim3(grid), dim3(NTHR), LDS_BYTES, stream, a);
#else
    for (int p = 0; p < NPH; ++p) { a.ph_lo = p; a.ph_hi = p + 1; hipLaunchKernelGGL(fwd_kernel, dim3(grid), dim3(NTHR), LDS_BYTES, stream, a); }
#endif
}
```

```cpp
#include <hip/hip_runtime.h>
#include <cstdio>
#include <cstdint>

#define GAS __attribute__((address_space(1)))
#define LAS __attribute__((address_space(3)))
typedef unsigned short bf16_t;
typedef short bf16x8 __attribute__((ext_vector_type(8)));
typedef float f32x4 __attribute__((ext_vector_type(4)));
typedef float f32x2 __attribute__((ext_vector_type(2)));
typedef float f32x16 __attribute__((ext_vector_type(16)));
typedef unsigned u32x4 __attribute__((ext_vector_type(4)));
typedef unsigned u32x2 __attribute__((ext_vector_type(2)));
typedef int i32x4 __attribute__((ext_vector_type(4)));
typedef int i32x8 __attribute__((ext_vector_type(8)));
typedef short s16x4 __attribute__((ext_vector_type(4)));
typedef short s16x2 __attribute__((ext_vector_type(2)));
typedef int v2i32 __attribute__((ext_vector_type(2)));

constexpr int S = 16384, D = 2048, DIN = 10832, DINP = 11008, NEXP = 32, DFF = 2048;
constexpr int NWAVES = 8, NTHR = 512;
constexpr int CQ = 0, CK = 1024, CV = 1280, CQI = 1536, CKI = 2560, CWI = 2624, CHQ = 2816, CHF = 3840, CHI = 4864, CHG = 5888, CGA = 6912, CGR = 8960;
constexpr int PMAX = 65536 + NEXP * 256;
constexpr float NORM_EPS = 1e-5f;

constexpr size_t MiB = 1u << 20;
constexpr size_t al256(size_t x) { return (x + 255) & ~(size_t)255; }
constexpr size_t WS_CTL = 0, CTL_BYTES = 1 * MiB;
constexpr size_t WS_MOD = WS_CTL + CTL_BYTES;
constexpr size_t WS_TOPE = WS_MOD + 64 * 1024;
constexpr size_t WS_GATE = WS_TOPE + (size_t)S * 16;
constexpr size_t WS_SLOT = WS_GATE + (size_t)S * 16;
constexpr size_t WS_WIN_T = WS_SLOT + (size_t)S * 16;
constexpr size_t WS_WA_T = WS_WIN_T + (size_t)DINP * D * 2;
constexpr size_t WS_WH_T = WS_WA_T + (size_t)2048 * 1024 * 2;
constexpr size_t WS_WO_T = WS_WH_T + (size_t)2048 * 1024 * 2;
constexpr size_t WS_W1_T = WS_WO_T + (size_t)2048 * 2048 * 2;
constexpr size_t WS_W2_T = WS_W1_T + (size_t)NEXP * 4096 * 2048 * 2;
constexpr size_t WS_H = WS_W2_T + (size_t)NEXP * 2048 * 2048 * 2;
constexpr size_t WS_PROJ = WS_H + (size_t)S * D * 2;
constexpr size_t WS_KI = WS_PROJ + (size_t)S * DINP * 2;
constexpr size_t WS_KC = WS_KI + (size_t)S * 64 * 2;
constexpr size_t WS_VC = WS_KC + (size_t)S * 256 * 2;
constexpr size_t WS_ST = WS_VC + (size_t)S * 256 * 2;
constexpr size_t WS_DC = WS_ST + (size_t)256 * 8 * 128 * 128 * 4;
constexpr size_t WS_SEL = WS_DC + (size_t)256 * 8 * 128 * 4;
constexpr size_t WS_ATT = WS_SEL + (size_t)S * 256 * 4;
constexpr size_t WS_REC = WS_ATT + (size_t)S * 1024 * 2;
constexpr size_t WS_MERGED = WS_REC + (size_t)S * 1024 * 2;
constexpr size_t WS_X1 = WS_MERGED + (size_t)S * 2048 * 2;
constexpr size_t WS_SCORES = WS_X1 + (size_t)S * 2048 * 4;
constexpr size_t WS_XB = WS_SCORES;
constexpr size_t WS_ACT = WS_XB + (size_t)PMAX * 2048 * 2;
constexpr size_t WS_YB = WS_ACT + (size_t)PMAX * 2048 * 2;
constexpr size_t WS_END = WS_SCORES + (size_t)S * S * 4;
static_assert(WS_YB + (size_t)PMAX * 2048 * 2 <= WS_END, "MoE buffers overlay the score matrix");
static_assert(WS_END <= (size_t)4096 * MiB, "workspace");
constexpr int CW_BAR = 4096, CW_CNT = 8192, CW_FILL = 8448;
constexpr size_t WS_TOKS = WS_SEL;

constexpr int LDS_BYTES = 155648;
constexpr int LDS_MISC = LDS_BYTES - 512;

__device__ __forceinline__ unsigned cvt_pk_bf16(float lo, float hi) { unsigned r; asm volatile("v_cvt_pk_bf16_f32 %0, %1, %2" : "=v"(r) : "v"(lo), "v"(hi)); return r; }
__device__ __forceinline__ float bf_lo(unsigned u) { return __uint_as_float(u << 16); }
__device__ __forceinline__ float bf_hi(unsigned u) { return __uint_as_float(u & 0xffff0000u); }
__device__ __forceinline__ float bf2f(bf16_t b) { return __uint_as_float(((unsigned)b) << 16); }
__device__ __forceinline__ float wave_sum(float v) {
#define DPPS(ctrl, rmask) { const int s_ = __builtin_amdgcn_update_dpp(0, __float_as_int(v), ctrl, rmask, 0xF, false); v += __int_as_float(s_); }
    DPPS(0x111, 0xF) DPPS(0x112, 0xF) DPPS(0x114, 0xF) DPPS(0x118, 0xF) DPPS(0x142, 0xA) DPPS(0x143, 0xC)
#undef DPPS
    return __int_as_float(__builtin_amdgcn_readlane(__float_as_int(v), 63));
}
__device__ __forceinline__ float wave_max(float v) {
#define DPPM(ctrl, rmask) { const int o_ = __float_as_int(v); const int s_ = __builtin_amdgcn_update_dpp(o_, o_, ctrl, rmask, 0xF, false); v = fmaxf(v, __int_as_float(s_)); }
    DPPM(0x111, 0xF) DPPM(0x112, 0xF) DPPM(0x114, 0xF) DPPM(0x118, 0xF) DPPM(0x142, 0xA) DPPM(0x143, 0xC)
#undef DPPM
    return __int_as_float(__builtin_amdgcn_readlane(__float_as_int(v), 63));
}
__device__ __forceinline__ float sigmoidf_(float x) { return __builtin_amdgcn_rcpf(1.0f + __expf(-x)); }
__device__ __forceinline__ float siluf_(float x) { return x * __builtin_amdgcn_rcpf(1.0f + __expf(-x)); }
__device__ __forceinline__ unsigned pack4_fp8(float a, float b, float c, float d) { int w = 0; w = __builtin_amdgcn_cvt_pk_fp8_f32(a, b, w, false); w = __builtin_amdgcn_cvt_pk_fp8_f32(c, d, w, true); return (unsigned)w; }
constexpr float W8_SCALE = 64.0f, ACT8_SCALE = 4.0f, MRG8_SCALE = 8.0f, OP8_SCALE = 16.0f;
__device__ __forceinline__ float relu_i(float x) { const int i = __float_as_int(x); return __int_as_float(i > 0 ? i : 0); }
__device__ __forceinline__ void fp8x16_to_bf16(const u32x4& w, u32x4& lo, u32x4& hi) {
    unsigned o[8];
#pragma unroll
    for (int q = 0; q < 4; ++q) { const unsigned wq = w[q]; const f32x2 a = __builtin_amdgcn_cvt_pk_f32_fp8((int)wq, false), b = __builtin_amdgcn_cvt_pk_f32_fp8((int)wq, true);
        o[2 * q] = cvt_pk_bf16(a[0], a[1]); o[2 * q + 1] = cvt_pk_bf16(b[0], b[1]); }
    lo = (u32x4){o[0], o[1], o[2], o[3]}; hi = (u32x4){o[4], o[5], o[6], o[7]};
}
__device__ __forceinline__ unsigned char fp8_1(float x) { return (unsigned char)(__builtin_amdgcn_cvt_pk_fp8_f32(x, x, 0, false) & 0xff); }
#define LDS_WAIT() asm volatile("s_waitcnt lgkmcnt(0)" ::: "memory")
#define VM_WAIT() asm volatile("s_waitcnt vmcnt(0)" ::: "memory")

#define XB_TMO      128
#define XB_XCNT(j)  (256  + 64 * (j))
#define XB_XSUB(j)  (1280 + 64 * (j))
#define XB_XGEN(j)  (2304 + 64 * (j))
#define XB_TOP      3328
#define XB_TOPGEN   3392
#define XCD_BAR_WORDS 3456
#define XB_SPIN_CAP (1u << 22)

__device__ __forceinline__ unsigned xb_ld(unsigned* p)              { return __hip_atomic_load(p, __ATOMIC_RELAXED, __HIP_MEMORY_SCOPE_AGENT); }
__device__ __forceinline__ unsigned xb_add(unsigned* p, unsigned v) { return __hip_atomic_fetch_add(p, v, __ATOMIC_RELAXED, __HIP_MEMORY_SCOPE_AGENT); }
__device__ __forceinline__ unsigned xb_xcc_id() { return (unsigned)__builtin_amdgcn_s_getreg((3 << 11) | 20) & 0xFu; }
#define XB_SPIN(cond, bar) do { unsigned _sp = 0; while (cond) { __builtin_amdgcn_s_sleep(1); \
    if ((++_sp & 255u) == 0u) { if (xb_ld(&(bar)[XB_TMO])) break; if (_sp > XB_SPIN_CAP) { atomicAdd(&(bar)[XB_TMO], 1u); break; } } } } while (0)

struct XcdBarrier { unsigned* bar; unsigned x; volatile LAS unsigned* st; };

__device__ __forceinline__ XcdBarrier xcd_barrier_post(unsigned* bar, volatile LAS unsigned* st) {
    XcdBarrier b; b.bar = bar; b.x = xb_xcc_id(); b.st = st;
    if (threadIdx.x == 0) (void)xb_add(&bar[XB_XCNT(b.x)], 1u);
    return b;
}
__device__ __forceinline__ void xcd_barrier_complete(unsigned* bar, unsigned x, unsigned& nloc, unsigned& nx) {
    const unsigned G = gridDim.x * gridDim.y * gridDim.z;
    unsigned sum, cnt, mine, sp = 0u;
    for (;;) {
        sum = 0u; cnt = 0u; mine = 0u;
#pragma unroll
        for (unsigned j = 0; j < 16; ++j) { const unsigned c = xb_ld(&bar[XB_XCNT(j)]); sum += c; cnt += (c > 0u) ? 1u : 0u; mine = (j == x) ? c : mine; }
        if (sum == G) break;
        __builtin_amdgcn_s_sleep(1);
        if ((++sp & 255u) == 0u) { if (xb_ld(&bar[XB_TMO])) break; if (sp > XB_SPIN_CAP) { atomicAdd(&bar[XB_TMO], 1u); break; } }
    }
    nloc = mine > 0u ? mine : 1u; nx = cnt > 0u ? cnt : 1u;
}
__device__ __forceinline__ void xcd_barrier(const XcdBarrier& b) {
    asm volatile("s_waitcnt vmcnt(0)" ::: "memory");
    __syncthreads();
    if (threadIdx.x == 0) {
        unsigned* bar = b.bar;
        __builtin_amdgcn_s_waitcnt(0);
        unsigned nloc = b.st[0], nx = b.st[1];
        if (nloc == 0u) { xcd_barrier_complete(bar, b.x, nloc, nx); b.st[0] = nloc; b.st[1] = nx; }
        const unsigned old = xb_add(&bar[XB_XSUB(b.x)], 1u);
        const unsigned gen = old / nloc;
        if (old + 1u == (gen + 1u) * nloc) {
            __builtin_amdgcn_fence(__ATOMIC_RELEASE, "agent");
            asm volatile("s_waitcnt vmcnt(0)" ::: "memory");
            const unsigned og = xb_add(&bar[XB_TOP], 1u);
            const unsigned tg = og / nx;
            if (og + 1u == (tg + 1u) * nx) xb_add(&bar[XB_TOPGEN], 1u);
            else XB_SPIN(xb_ld(&bar[XB_TOPGEN]) == tg, bar);
            __builtin_amdgcn_fence(__ATOMIC_ACQUIRE, "agent");
            xb_add(&bar[XB_XGEN(b.x)], 1u);
            asm volatile("s_waitcnt vmcnt(0)" ::: "memory");
        } else {
            XB_SPIN(xb_ld(&bar[XB_XGEN(b.x)]) == gen, bar);
            __builtin_amdgcn_fence(__ATOMIC_ACQUIRE, "agent");
            asm volatile("s_waitcnt vmcnt(0)" ::: "memory");
        }
    }
    __syncthreads();
}

namespace pg8 {
constexpr int BM = 256, BK = 64, HALF = 128, HTB = HALF * BK * 2, STAGE_BYTES = 8 * HTB, NXCD = 8, WGM = 8;
__host__ __device__ __forceinline__ int lds_byte(int r, int c) { const int st = (r >> 4) * 2 + (c >> 5), rr = r & 15, cc = c & 31, ob = rr * 64 + cc * 2; return st * 1024 + (ob ^ (((ob >> 9) & 1) << 5)); }
__host__ __device__ __forceinline__ void stage_rc(int b, int& R, int& C) { const int st = b / 1024, sb = b % 1024, swz = sb ^ (((sb >> 9) & 1) << 5); R = (st >> 1) * 16 + swz / 64; C = (st & 1) * 32 + (swz % 64) / 2; }
__host__ __device__ __forceinline__ int perm32(int rho) { const int n = rho >> 4, i = rho & 15; return 8 * (i >> 2) + 4 * n + (i & 3); }

struct Unit { int pm, pn, e; };
struct Gemm { const void* A; const void* Bt; int K; size_t estride; const int* arow; size_t astride; };

struct StaticOrder {
    int nM, nN, nwg, G, c, i, full, erank, en;
    __device__ void init(int M, int N, int G_, int c_) { nM = M / BM; nN = N / BM; nwg = nM * nN; G = G_; c = c_; i = 0; full = 1 << 30; erank = -1; en = 1; }
    __device__ void skew(int full_, int erank_, int en_) { full = full_; erank = erank_; en = en_; }
    __device__ bool next(Unit& u) {
        long L;
        if (i < full) L = (long)i * G + c; else { if (erank < 0) return false; L = (long)full * G + (long)(i - full) * en + erank; }
        ++i; if (L >= nwg) return false;
        int wgid = (int)L; { const int q = nwg / NXCD, r = nwg % NXCD, xcd = wgid % NXCD, off = wgid / NXCD; wgid = (xcd < r ? xcd * (q + 1) : r * (q + 1) + (xcd - r) * q) + off; }
        const int nig = WGM * nN, gid = wgid / nig, fm = gid * WGM, gsz = (nM - fm) < WGM ? (nM - fm) : WGM;
        u.pm = fm + ((wgid % nig) % gsz); u.pn = (wgid % nig) / gsz; u.e = 0; return true;
    }
};
struct MoeOrder {
    int nPanels, nN, G, c, i; const LAS int* panel_e;
    __device__ void init(int nPanels_, int nN_, int G_, int c_, const LAS int* pe) { nPanels = nPanels_; nN = nN_; G = G_; c = c_; i = 0; panel_e = pe; }
    __device__ bool next(Unit& u) {
        const int PB = 256 / nN;
        const int nblk = (nPanels + PB - 1) / PB;
        for (;;) {
            const long L = (long)i * G + c; ++i;
            const int blk = (int)(L >> 8), r = (int)(L & 255), x = r & 7, j = r >> 3;
            if (blk >= nblk) return false;
            int pm, pn;
            if (nN == 16) { pm = blk * 16 + 4 * (x >> 1) + (j & 3); pn = 8 * (x & 1) + (j >> 2); }
            else          { pm = blk * 32 + 4 * x + (j & 3);        pn = j >> 2; }
            if (pm < nPanels) { u.pm = pm; u.pn = pn; u.e = panel_e[pm]; return true; }
        }
    }
};

template <class Epi, class Sched, bool FP8 = false>
__device__ __forceinline__ void gemm_phase(LAS unsigned char* lds, const Gemm g, Sched& S, const Epi& E) {
    const int tid = threadIdx.x, wid = __builtin_amdgcn_readfirstlane(tid >> 6), lane = tid & 63, wr = wid >> 2, wc = wid & 3, fr = lane & 15, fq = lane >> 4;
    const int K = g.K; const int pitch = FP8 ? K : 2 * K; const int nt = pitch / 128;
    unsigned voffA[2], voffB[2];
#pragma unroll
    for (int i = 0; i < 2; ++i) { int R, C; stage_rc(tid * 16 + i * 8192, R, C); const int Rb = Epi::PERM ? ((R & ~31) + perm32(R & 31)) : R;
        voffA[i] = (unsigned)(R * pitch + C * 2); voffB[i] = (unsigned)(Rb * pitch + C * 2); }
    const size_t kstep = (size_t)(BK * 2);
    const size_t hstep = (size_t)HALF * pitch;
    const size_t tstep = 2 * hstep;
    int RA[2], CA[2];
#pragma unroll
    for (int i = 0; i < 2; ++i) stage_rc(tid * 16 + i * 8192, RA[i], CA[i]);
    const bool gather = g.arow != nullptr;
    const size_t hsA = gather ? 0 : hstep;
    unsigned vA0[2] = {voffA[0], voffA[1]}, vA1[2] = {voffA[0], voffA[1]}, nA0[2] = {voffA[0], voffA[1]}, nA1[2] = {voffA[0], voffA[1]};
#define PG8_AOFF(dst0, dst1, u) do { if (gather) { _Pragma("unroll") for (int i = 0; i < 2; ++i) { \
        dst0[i] = (unsigned)g.arow[(u).pm * 256 + RA[i]] * (unsigned)pitch + (unsigned)(CA[i] * 2); dst1[i] = (unsigned)g.arow[(u).pm * 256 + 128 + RA[i]] * (unsigned)pitch + (unsigned)(CA[i] * 2); } } } while (0)
    const unsigned ldsw = (unsigned)wid * 1024u;
    const int aoff = lds_byte(wr * 64 + fr, fq * 8), boff = lds_byte(wc * 32 + fr, fq * 8);
#define PG8_SA(b, h) (((b) * 2 + (h)) * HTB)
#define PG8_SB(b, h) ((4 + (b) * 2 + (h)) * HTB)
#define PG8_STAGE(bufoff, gbase, voff) do { _Pragma("unroll") for (int _i = 0; _i < 2; ++_i) \
        __builtin_amdgcn_global_load_lds((const unsigned*)((const char*)(gbase) + (voff)[_i]), (LAS unsigned*)(lds + (bufoff) + ldsw + _i * 8192), 16, 0, 0); } while (0)
#define PG8_LD8(p) __builtin_shufflevector(*(const LAS i32x4*)(p), *(const LAS i32x4*)((p) + 1024), 0, 1, 2, 3, 4, 5, 6, 7)
#define PG8_LDA(dst, b, h) do { _Pragma("unroll") for (int m = 0; m < 4; ++m) { if constexpr (FP8) dst##8[m] = PG8_LD8(lds + PG8_SA(b, h) + aoff + m * 2048); \
        else { _Pragma("unroll") for (int k = 0; k < 2; ++k) dst[m][k] = *(const LAS bf16x8*)(lds + PG8_SA(b, h) + aoff + m * 2048 + k * 1024); } } } while (0)
#define PG8_LDB(dst, b, h) do { _Pragma("unroll") for (int n = 0; n < 2; ++n) { if constexpr (FP8) dst##8[n] = PG8_LD8(lds + PG8_SB(b, h) + boff + n * 2048); \
        else { _Pragma("unroll") for (int k = 0; k < 2; ++k) dst[n][k] = *(const LAS bf16x8*)(lds + PG8_SB(b, h) + boff + n * 2048 + k * 1024); } } } while (0)
#define PG8_MMA(ai, bj, At, Bt) do { __builtin_amdgcn_s_setprio(1); _Pragma("unroll") for (int m = 0; m < 4; ++m) _Pragma("unroll") for (int n = 0; n < 2; ++n) { \
        if constexpr (FP8) asm volatile("v_mfma_scale_f32_16x16x128_f8f6f4 %0, %1, %2, %0, %3, %3 op_sel_hi:[0,0,0]" : "+v"(acc[ai][bj][m][n]) : "v"(Bt##8[n]), "v"(At##8[m]), "v"(scl1)); \
        else { _Pragma("unroll") for (int k = 0; k < 2; ++k) acc[ai][bj][m][n] = __builtin_amdgcn_mfma_f32_16x16x32_bf16(Bt[n][k], At[m][k], acc[ai][bj][m][n], 0, 0, 0); } } \
        __builtin_amdgcn_s_setprio(0); } while (0)
#define PG8_WAIT_V(n) asm volatile("s_waitcnt vmcnt(" #n ")" ::: "memory")
#define PG8_WAIT_L(n) asm volatile("s_waitcnt lgkmcnt(" #n ")" ::: "memory")
#define PG8_BAR __builtin_amdgcn_s_barrier()
#define PG8_SCHED __builtin_amdgcn_sched_barrier(0)
    Unit cur, nxt;
    if (!S.next(cur)) return;
    const unsigned scl1 = 0x7f7f7f7fu;
    f32x4 acc[2][2][4][2];
#pragma unroll
    for (int a = 0; a < 2; ++a)
#pragma unroll
        for (int b = 0; b < 2; ++b)
#pragma unroll
            for (int m = 0; m < 4; ++m)
#pragma unroll
                for (int n = 0; n < 2; ++n) acc[a][b][m][n] = (f32x4){0.f, 0.f, 0.f, 0.f};
    bf16x8 At[4][2], B0[2][2], B1[2][2]; i32x8 At8[4], B08[2], B18[2];
    const char* cA = (const char*)g.A + (size_t)cur.e * g.astride + (gather ? (size_t)0 : (size_t)cur.pm * tstep); const char* cB = (const char*)g.Bt + (size_t)cur.e * g.estride + (size_t)cur.pn * tstep;
    PG8_AOFF(vA0, vA1, cur);
    PG8_STAGE(PG8_SB(0, 0), cB, voffB); PG8_STAGE(PG8_SB(0, 1), cB + hstep, voffB); PG8_STAGE(PG8_SA(0, 0), cA, vA0); PG8_STAGE(PG8_SA(0, 1), cA + hsA, vA1);
    if (wr == 1) PG8_BAR;
    PG8_WAIT_V(2); PG8_BAR;
    PG8_STAGE(PG8_SB(1, 0), cB + kstep, voffB); PG8_STAGE(PG8_SA(1, 0), cA + kstep, vA0); PG8_STAGE(PG8_SB(1, 1), cB + hstep + kstep, voffB);
    PG8_WAIT_V(6); PG8_BAR;
    for (;;) {
        const bool has_next = S.next(nxt);
        const char* nA = has_next ? (const char*)g.A + (size_t)nxt.e * g.astride + (gather ? (size_t)0 : (size_t)nxt.pm * tstep) : cA;
        if (has_next) PG8_AOFF(nA0, nA1, nxt);
        const char* nB = has_next ? (const char*)g.Bt + (size_t)nxt.e * g.estride + (size_t)nxt.pn * tstep : cB;
        for (int t = 0; t < nt; t += 2) {
            const bool last = (t == nt - 2);
            const char* a1 = cA + (size_t)(t + 1) * kstep;
            const char* a2 = last ? nA : cA + (size_t)(t + 2) * kstep; const char* b2 = last ? nB : cB + (size_t)(t + 2) * kstep;
            const char* a3 = a2 + kstep; const char* b3 = b2 + kstep;
            PG8_LDB(B0, 0, 0); PG8_LDB(B1, 0, 1); PG8_SCHED; PG8_LDA(At, 0, 0); PG8_STAGE(PG8_SA(1, 1), a1 + hsA, vA1);
            if (last && has_next) { vA0[0] = nA0[0]; vA0[1] = nA0[1]; vA1[0] = nA1[0]; vA1[1] = nA1[1]; }
            PG8_WAIT_V(8); PG8_WAIT_L(0); PG8_BAR; PG8_MMA(0, 0, At, B0); PG8_MMA(0, 1, At, B1); PG8_BAR; PG8_SCHED;
            PG8_LDA(At, 0, 1); PG8_STAGE(PG8_SB(0, 0), b2, voffB); PG8_STAGE(PG8_SB(0, 1), b2 + hstep, voffB); PG8_STAGE(PG8_SA(0, 0), a2, vA0);
            PG8_WAIT_V(8); PG8_WAIT_L(0); PG8_BAR; PG8_MMA(1, 0, At, B0); PG8_MMA(1, 1, At, B1); PG8_BAR; PG8_SCHED;
            PG8_LDB(B0, 1, 0); PG8_LDB(B1, 1, 1); PG8_SCHED; PG8_LDA(At, 1, 0); PG8_STAGE(PG8_SA(0, 1), a2 + hsA, vA1);
            PG8_WAIT_V(8); PG8_WAIT_L(0); PG8_BAR; PG8_MMA(0, 0, At, B0); PG8_MMA(0, 1, At, B1); PG8_BAR; PG8_SCHED;
            PG8_LDA(At, 1, 1); PG8_STAGE(PG8_SB(1, 0), b3, voffB); PG8_STAGE(PG8_SB(1, 1), b3 + hstep, voffB); PG8_STAGE(PG8_SA(1, 0), a3, vA0);
            PG8_WAIT_V(8); PG8_WAIT_L(0); PG8_BAR; PG8_MMA(1, 0, At, B0); PG8_MMA(1, 1, At, B1); PG8_BAR; PG8_SCHED;
        }
        if (wr == 0) PG8_BAR;
        if constexpr (FP8) {
#pragma unroll
            for (int a = 0; a < 2; ++a)
#pragma unroll
                for (int b = 0; b < 2; ++b) asm volatile("s_nop 15" : "+v"(acc[a][b][0][0]), "+v"(acc[a][b][0][1]), "+v"(acc[a][b][1][0]), "+v"(acc[a][b][1][1]), "+v"(acc[a][b][2][0]), "+v"(acc[a][b][2][1]), "+v"(acc[a][b][3][0]), "+v"(acc[a][b][3][1]));
        }
        const bool keep_acc = E(acc, cur, wr, wc, fr, fq);
        if (!has_next) break;
        if (!keep_acc)
#pragma unroll
        for (int a = 0; a < 2; ++a)
#pragma unroll
            for (int b = 0; b < 2; ++b)
#pragma unroll
                for (int m = 0; m < 4; ++m)
#pragma unroll
                    for (int n = 0; n < 2; ++n) acc[a][b][m][n] = (f32x4){0.f, 0.f, 0.f, 0.f};
        cur = nxt; cA = nA; cB = nB;
        if (wr == 1) PG8_BAR;
    }
    PG8_WAIT_V(0);
    PG8_BAR;
#undef PG8_AOFF
#undef PG8_SA
#undef PG8_SB
#undef PG8_STAGE
#undef PG8_LDA
#undef PG8_LDB
#undef PG8_MMA
#undef PG8_LD8
#undef PG8_WAIT_V
#undef PG8_WAIT_L
#undef PG8_BAR
#undef PG8_SCHED
}

struct EpiBf16 {
    static constexpr bool PERM = true;
    bf16_t* O; int ldc; const float* bias; int bias_estride; float ascale; int skip_from, skip_cols;
    __device__ __forceinline__ bool operator()(const f32x4 (&acc)[2][2][4][2], const Unit& u, int wr, int wc, int fr, int fq) const {
        const int row0 = u.pm * BM + wr * 64 + fr; const int col0 = u.pn * BM + wc * 32 + 8 * fq + (u.pn >= skip_from ? skip_cols : 0);
        f32x4 bv[2][2];
#pragma unroll
        for (int bj = 0; bj < 2; ++bj)
#pragma unroll
            for (int n = 0; n < 2; ++n) bv[bj][n] = bias ? *(const f32x4*)(bias + (size_t)u.e * bias_estride + col0 + bj * HALF + 4 * n) : (f32x4){0.f, 0.f, 0.f, 0.f};
#pragma unroll
        for (int ai = 0; ai < 2; ++ai)
#pragma unroll
            for (int m = 0; m < 4; ++m) { bf16_t* rowp = O + (size_t)(row0 + ai * HALF + m * 16) * ldc + col0;
#pragma unroll
                for (int bj = 0; bj < 2; ++bj) { const f32x4 v0 = acc[ai][bj][m][0] * ascale + bv[bj][0], v1 = acc[ai][bj][m][1] * ascale + bv[bj][1];
                    u32x4 w; w.x = cvt_pk_bf16(v0[0], v0[1]); w.y = cvt_pk_bf16(v0[2], v0[3]); w.z = cvt_pk_bf16(v1[0], v1[1]); w.w = cvt_pk_bf16(v1[2], v1[3]);
                    *(u32x4*)(rowp + bj * HALF) = w; } }
        return false;
    }
};
__device__ __forceinline__ float swiglu1(float ug, float ul) {
    ug = fminf(ug, 7.0f); ul = fminf(fmaxf(ul, -7.0f), 7.0f);
    return ug * __builtin_amdgcn_rcpf(1.0f + __expf(-1.702f * ug)) * (ul + 1.0f);
}
struct EpiSwiglu {
    static constexpr bool PERM = true;
    unsigned char* O; const float* b1;
    __device__ __forceinline__ bool operator()(const f32x4 (&acc)[2][2][4][2], const Unit& u, int wr, int wc, int fr, int fq) const {
        const int row0 = u.pm * BM + wr * 64 + fr; const int c0 = u.pn * 128 + wc * 32 + 8 * fq;
        const float* bg = b1 + (size_t)u.e * 4096 + c0; const float* bl = bg + 2048;
        f32x4 bgv[2], blv[2];
#pragma unroll
        for (int n = 0; n < 2; ++n) { bgv[n] = *(const f32x4*)(bg + 4 * n); blv[n] = *(const f32x4*)(bl + 4 * n); }
#pragma unroll
        for (int ai = 0; ai < 2; ++ai)
#pragma unroll
            for (int m = 0; m < 4; ++m) {
                float a[8];
#pragma unroll
                for (int n = 0; n < 2; ++n)
#pragma unroll
                    for (int j = 0; j < 4; ++j) a[4 * n + j] = ACT8_SCALE * swiglu1(acc[ai][0][m][n][j] * (1.0f / W8_SCALE) + bgv[n][j], acc[ai][1][m][n][j] * (1.0f / W8_SCALE) + blv[n][j]);
                u32x2 w; w.x = pack4_fp8(a[0], a[1], a[2], a[3]); w.y = pack4_fp8(a[4], a[5], a[6], a[7]);
                *(u32x2*)(O + (size_t)(row0 + ai * HALF + m * 16) * 2048 + c0) = w;
            }
        return false;
    }
};

struct TwoPartOrder {
    StaticOrder so; Unit held; int part;
    __device__ void init(int M, int N, int G_, int c_) { so.init(M, N, G_, c_); part = 0; }
    __device__ bool next(Unit& u) { if (part == 1) { u = held; u.e = 1; part = 0; return true; } if (!so.next(held)) return false; u = held; u.e = 0; part = 1; return true; }
};
struct EpiGate2 {
    static constexpr bool PERM = true;
    unsigned char* O; const bf16_t* Ga; const bf16_t* Gr;
    __device__ __forceinline__ bool operator()(f32x4 (&acc)[2][2][4][2], const Unit& u, int wr, int wc, int fr, int fq) const {
        const int row0 = u.pm * BM + wr * 64 + fr; const int col0 = u.pn * BM + wc * 32 + 8 * fq;
#pragma unroll
        for (int ai = 0; ai < 2; ++ai)
#pragma unroll
            for (int m = 0; m < 4; ++m) { const size_t row = (size_t)(row0 + ai * HALF + m * 16);
#pragma unroll
                for (int bj = 0; bj < 2; ++bj) { const int c = col0 + bj * HALF;
                    const u32x4 gr = *(const u32x4*)(Gr + row * DINP + c);
                    if (u.e == 0) {
                        const u32x4 ga = *(const u32x4*)(Ga + row * DINP + c);
#pragma unroll
                        for (int q = 0; q < 4; ++q) {
                            const float r0 = (1.0f + __expf(-bf_lo(gr[q]))) * __builtin_amdgcn_rcpf(1.0f + __expf(-bf_lo(ga[q]))), r1 = (1.0f + __expf(-bf_hi(gr[q]))) * __builtin_amdgcn_rcpf(1.0f + __expf(-bf_hi(ga[q])));
                            acc[ai][bj][m][q >> 1][(2 * q) & 3] *= r0; acc[ai][bj][m][q >> 1][(2 * q + 1) & 3] *= r1; }
                    } else {
                        float r[8];
#pragma unroll
                        for (int q = 0; q < 4; ++q) { r[2 * q] = sigmoidf_(bf_lo(gr[q])) * acc[ai][bj][m][q >> 1][(2 * q) & 3]; r[2 * q + 1] = sigmoidf_(bf_hi(gr[q])) * acc[ai][bj][m][q >> 1][(2 * q + 1) & 3]; }
                        u32x2 w; constexpr float osc = MRG8_SCALE / (W8_SCALE * OP8_SCALE); w.x = pack4_fp8(r[0] * osc, r[1] * osc, r[2] * osc, r[3] * osc); w.y = pack4_fp8(r[4] * osc, r[5] * osc, r[6] * osc, r[7] * osc);
                        *(u32x2*)(O + row * 2048 + c) = w; } } }
        return u.e == 0;
    }
};
struct EpiDelta {
    static constexpr bool PERM = true;
    const float* gt; bf16_t* DL; float ascale;
    __device__ __forceinline__ bool operator()(const f32x4 (&acc)[2][2][4][2], const Unit& u, int wr, int wc, int fr, int fq) const {
        const int row0 = u.pm * BM + wr * 64 + fr; const int col0 = u.pn * BM + wc * 32 + 8 * fq;
        f32x4 g[2][2];
#pragma unroll
        for (int bj = 0; bj < 2; ++bj)
#pragma unroll
            for (int n = 0; n < 2; ++n) g[bj][n] = *(const f32x4*)(gt + col0 + bj * HALF + 4 * n);
#pragma unroll
        for (int ai = 0; ai < 2; ++ai)
#pragma unroll
            for (int m = 0; m < 4; ++m) { bf16_t* rowp = DL + (size_t)(row0 + ai * HALF + m * 16) * 2048 + col0;
#pragma unroll
                for (int bj = 0; bj < 2; ++bj) { const f32x4 v0 = acc[ai][bj][m][0] * ascale * g[bj][0], v1 = acc[ai][bj][m][1] * ascale * g[bj][1];
                    u32x4 w; w.x = cvt_pk_bf16(v0[0], v0[1]); w.y = cvt_pk_bf16(v0[2], v0[3]); w.z = cvt_pk_bf16(v1[0], v1[1]); w.w = cvt_pk_bf16(v1[2], v1[3]);
                    *(u32x4*)(rowp + bj * HALF) = w; } }
        return false;
    }
};
}

struct Args { const void* in[22]; float* out; unsigned char* ws; int ph_lo, ph_hi, flags, pad; };
constexpr int XCONV = 0, XSCORE = 96;
constexpr int CW_SCQ = 12288, SCP = 5, CW_ATQ = 12352;
enum { PH_PRO = 0, PH_H, PH_INPROJ, PH_POST, PH_SCORE, PH_SELECT, PH_ATTN, PH_OP1, PH_OP2, PH_WOUT, PH_ROUTER, PH_SCATTER, PH_MOE1, PH_MOE2, PH_FINAL, NPH };

__device__ __forceinline__ int dest_row(int mode, int n) {
    if (mode == 1) return n < 2640 ? n : n + 176;
    if (mode == 2) { const int g = n >> 11, c = n & 2047; return (c >> 7) * 256 + g * 128 + (c & 127); }
    return n;
}
__device__ __forceinline__ void convert_item(const float* __restrict__ W, int K, int N, int ld, bf16_t* WT, int mode, int item, int lane, LAS unsigned char* scr) {
    const int nblk = (N + 63) >> 6; const int kb = item / nblk, nb = item - kb * nblk; const int k0 = kb * 128, n0 = nb * 64;
    const int c4 = lane & 15, kr = lane >> 4;
    const bool ok = (n0 + 4 * c4) < N;
    const float* src = W + (size_t)(k0 + 2 * kr) * ld + n0 + 4 * c4;
#pragma unroll 4
    for (int i = 0; i < 16; ++i) {
        f32x4 v0 = (f32x4){0.f, 0.f, 0.f, 0.f}, v1 = v0;
        if (ok) { v0 = *(const f32x4*)(src + (size_t)(8 * i) * ld); v1 = *(const f32x4*)(src + (size_t)(8 * i + 1) * ld); }
        const int kk = 8 * i + 2 * kr;
#pragma unroll
        for (int e = 0; e < 4; ++e) *(LAS unsigned*)(scr + (4 * c4 + e) * 272 + kk * 2) = cvt_pk_bf16(v0[e], v1[e]);
    }
    LDS_WAIT(); asm volatile("" ::: "memory");
#pragma unroll 4
    for (int j = 0; j < 16; ++j) {
        const int q = j * 64 + lane, n = q >> 4, ch = q & 15;
        const u32x4 v = *(const LAS u32x4*)(scr + n * 272 + ch * 16);
        if (n0 + n < N) *(u32x4*)(WT + (size_t)dest_row(mode, n0 + n) * K + k0 + ch * 8) = v;
    }
    LDS_WAIT(); asm volatile("" ::: "memory");
}


__device__ __forceinline__ bf16_t f2bf(float f) { unsigned u = __float_as_uint(f); return (bf16_t)((u + 0x7fffu + ((u >> 16) & 1u)) >> 16); }
__device__ __forceinline__ float bfx(const u32x4& w, int i) { const unsigned u = w[i >> 1]; return (i & 1) ? bf_hi(u) : bf_lo(u); }
__device__ __forceinline__ void rope_sc(float pos, float inv, float& sn, float& cs) {
    const float ang = pos * inv;
    const double a = (double)ang; const double n = __builtin_rint(a * 0.15915494309189535); const float r = (float)(a - n * 6.283185307179586);
    sn = __sinf(r); cs = __cosf(r);
}
__device__ __forceinline__ void post_token(bf16_t* PROJ, bf16_t* KI, unsigned char* KC, unsigned char* VC, const int* positions, const float* kng, const float* knb, float inv16, float inv8, int t, int lane) {
    const float pos = (float)positions[t];
    bf16_t* row = PROJ + (size_t)t * DINP;
    float sn, cs, sn8, cs8;
    rope_sc(pos, inv16, sn, cs); rope_sc(pos, inv8, sn8, cs8);
#pragma unroll
    for (int i = 0; i < 2; ++i) {
        const int pp = lane + 64 * i, hd = pp >> 4, ii = pp & 15;
        bf16_t* p = row + CQ + hd * 128 + ii; const float a = bf2f(p[0]), b = bf2f(p[16]);
        p[0] = f2bf(a * cs - b * sn); p[16] = f2bf(b * cs + a * sn);
    }
#pragma unroll
    for (int i = 0; i < 2; ++i) {
        const int pp = lane + 64 * i, hd = pp >> 3, ii = pp & 7;
        bf16_t* p = row + CQI + hd * 64 + ii; const float a = bf2f(p[0]), b = bf2f(p[8]);
        p[0] = f2bf(a * cs8 - b * sn8); p[8] = f2bf(b * cs8 + a * sn8);
    }
    if (lane < 32) {
        const int g = lane >> 4, ii = lane & 15;
        const bf16_t* p = row + CK + g * 128 + ii; const float a = bf2f(p[0]), b = bf2f(p[16]);
        unsigned char* o = KC + (size_t)t * 256 + g * 128 + ii; o[0] = fp8_1(a * cs - b * sn); o[16] = fp8_1(b * cs + a * sn);
    }
#pragma unroll
    for (int i = 0; i < 3; ++i) { const int idx = lane + 64 * i, g = idx / 96, r = idx - g * 96; KC[(size_t)t * 256 + g * 128 + 32 + r] = fp8_1(bf2f(row[CK + g * 128 + 32 + r])); }
    { const u32x2 w = *(const u32x2*)(row + CV + 4 * lane); *(unsigned*)(VC + (size_t)t * 256 + 4 * lane) = pack4_fp8(bf_lo(w.x), bf_hi(w.x), bf_lo(w.y), bf_hi(w.y)); }
    {
        const float v = bf2f(row[CKI + lane]);
        const float mean = wave_sum(v) * (1.0f / 64.0f); const float d = v - mean; const float var = wave_sum(d * d) * (1.0f / 64.0f);
        const float y = d * rsqrtf(var + NORM_EPS) * kng[lane] + knb[lane];
        const float other = __shfl_xor(y, 8);
        float o = y;
        if (lane < 8) o = y * cs8 - other * sn8; else if (lane < 16) o = y * cs8 + other * sn8;
        KI[(size_t)t * 64 + lane] = f2bf(o);
    }
}

constexpr int HG_GB = 0, HG_Q1 = 33792, HG_Q2 = 51200, HG_K2 = 68608, HG_VT = 86016, HG_PB = 104448, HG_LB = 113664;
__device__ __forceinline__ void hgrn_cumsum(LAS unsigned char* lds, const u32x4& w0, const u32x4& w1, float l0, float l1, int tid) {
    LAS float* GB = (LAS float*)(lds + HG_GB); LAS float* LB = (LAS float*)(lds + HG_LB); LAS float* SEG = (LAS float*)(lds + HG_LB + 512);
    if (tid < 128) LB[tid] = 1.0f / (1.0f + expf(l1 - l0));
    __syncthreads();
    const int t = tid >> 3, dseg = tid & 7;
#pragma unroll
    for (int i = 0; i < 16; ++i) { const float z = i < 8 ? bfx(w0, i) : bfx(w1, i - 8); const float lb = LB[16 * dseg + i]; GB[t * 128 + 16 * dseg + i] = __logf(lb + (1.0f - lb) * sigmoidf_(z)); }
    __syncthreads();
    const int d = tid & 127, tq = tid >> 7;
    float z[16];
#pragma unroll
    for (int i = 0; i < 16; ++i) z[i] = GB[(16 * tq + i) * 128 + d];
    float a = 0.f;
#pragma unroll
    for (int i = 0; i < 16; ++i) { a += z[i]; z[i] = a; }
    SEG[tq * 128 + d] = a;
    __syncthreads();
    float pre = 0.f;
    for (int q = 0; q < tq; ++q) pre += SEG[q * 128 + d];
#pragma unroll
    for (int i = 0; i < 16; ++i) GB[(16 * tq + i) * 128 + d] = z[i] + pre;
    __syncthreads();
}
__device__ __forceinline__ void hgrn_vt(LAS unsigned char* lds, const u32x4& a, const u32x4& b, int tid) {
    const int s2 = tid & 31, eg = tid >> 5;
#pragma unroll
    for (int i = 0; i < 8; ++i) { const unsigned lo = (i & 1) ? (a[i >> 1] >> 16) : (a[i >> 1] & 0xffffu), hi = (i & 1) ? (b[i >> 1] >> 16) : (b[i >> 1] & 0xffffu);
        *(LAS unsigned*)(lds + HG_VT + (8 * eg + i) * 144 + s2 * 4) = lo | (hi << 16); }
}
__device__ __forceinline__ void hgrn_l1(LAS unsigned char* lds, const bf16_t* PROJ, const float* lb_logits, bf16_t* ST, float* DC, int c, int h, int tid, int wave, int lane) {
    const int t = tid >> 3, dseg = tid & 7, s2 = tid & 31, dg = tid >> 5;
    const bf16_t* pf = PROJ + (size_t)(c * 64 + t) * DINP + CHF + h * 128 + 16 * dseg;
    const bf16_t* pk = PROJ + (size_t)(c * 64 + 2 * s2) * DINP + CHF + h * 128 + 8 * dg;
    const u32x4 w0 = *(const u32x4*)pf, w1 = *(const u32x4*)(pf + 8);
    const u32x4 ka = *(const u32x4*)pk, kb = *(const u32x4*)(pk + DINP);
    const u32x4 va = *(const u32x4*)(pk - CHF + CHI), vb = *(const u32x4*)(pk - CHF + CHI + DINP);
    const float l0 = lb_logits[h * 128 + (tid & 127)], l1 = lb_logits[1024 + h * 128 + (tid & 127)];
    hgrn_cumsum(lds, w0, w1, l0, l1, tid);
    const LAS float* GB = (const LAS float*)(lds + HG_GB); const LAS float* LB = (const LAS float*)(lds + HG_LB);
    {
#pragma unroll
        for (int i = 0; i < 8; ++i) { const int d = 8 * dg + i; const float lb = LB[d], b63 = GB[63 * 128 + d];
            const float k0 = (1.0f - lb) * (1.0f - sigmoidf_(bfx(ka, i))), k1 = (1.0f - lb) * (1.0f - sigmoidf_(bfx(kb, i)));
            const float v0 = k0 * __expf(b63 - GB[(2 * s2) * 128 + d]), v1 = k1 * __expf(b63 - GB[(2 * s2 + 1) * 128 + d]);
            *(LAS unsigned*)(lds + HG_Q1 + d * 144 + s2 * 4) = cvt_pk_bf16(v0, v1); }
    }
    hgrn_vt(lds, va, vb, tid);
    __syncthreads();
    const int fr = lane & 15, fq = lane >> 4;
    bf16x8 af[2];
#pragma unroll
    for (int ks = 0; ks < 2; ++ks) af[ks] = *(const LAS bf16x8*)(lds + HG_VT + (16 * wave + fr) * 144 + (32 * ks + 8 * fq) * 2);
    bf16_t* dst = ST + ((size_t)(c * 8 + h) * 128) * 128;
#pragma unroll 2
    for (int dt = 0; dt < 8; ++dt) {
        f32x4 acc = (f32x4){0.f, 0.f, 0.f, 0.f};
#pragma unroll
        for (int ks = 0; ks < 2; ++ks) { const bf16x8 bfr = *(const LAS bf16x8*)(lds + HG_Q1 + (16 * dt + fr) * 144 + (32 * ks + 8 * fq) * 2); acc = __builtin_amdgcn_mfma_f32_16x16x32_bf16(af[ks], bfr, acc, 0, 0, 0); }
#pragma unroll
        for (int r = 0; r < 4; ++r) dst[(size_t)(16 * wave + 4 * fq + r) * 128 + 16 * dt + fr] = f2bf(acc[r]);
    }
    if (tid < 128) DC[(size_t)(c * 8 + h) * 128 + tid] = __expf(GB[63 * 128 + tid]);
    __syncthreads();
}
__device__ __forceinline__ void hgrn_l3(LAS unsigned char* lds, const bf16_t* PROJ, const float* lb_logits, const bf16_t* ST, const float* norm_g, unsigned char* REC, int c, int h, int tid, int wave, int lane) {
    const int t = tid >> 3, dseg = tid & 7, s2 = tid & 31, eg = tid >> 5, fr = lane & 15, fq = lane >> 4;
    const bf16_t* pf = PROJ + (size_t)(c * 64 + t) * DINP + CHF + h * 128 + 16 * dseg;
    const u32x4 f0 = *(const u32x4*)pf, f1 = *(const u32x4*)(pf + 8), q0 = *(const u32x4*)(pf - CHF + CHQ), q1 = *(const u32x4*)(pf - CHF + CHQ + 8);
    const u32x4 g0 = *(const u32x4*)(pf - CHF + CHG), g1 = *(const u32x4*)(pf - CHF + CHG + 8);
    const bf16_t* pv = PROJ + (size_t)(c * 64 + 2 * s2) * DINP + CHI + h * 128 + 8 * eg;
    const u32x4 va = *(const u32x4*)pv, vb = *(const u32x4*)(pv + DINP);
    const bf16_t* sp = ST + ((size_t)(c * 8 + h) * 128 + 16 * wave + fr) * 128 + 8 * fq;
    u32x4 sx[4];
#pragma unroll
    for (int ks = 0; ks < 4; ++ks) sx[ks] = *(const u32x4*)(sp + 32 * ks);
    const float l0 = lb_logits[h * 128 + (tid & 127)], l1 = lb_logits[1024 + h * 128 + (tid & 127)];
    hgrn_cumsum(lds, f0, f1, l0, l1, tid);
    const LAS float* GB = (const LAS float*)(lds + HG_GB); const LAS float* LB = (const LAS float*)(lds + HG_LB);
    {
        unsigned o1[8], o2[8], o3[8];
#pragma unroll
        for (int i = 0; i < 16; i += 2) {
            float a1[2], a2[2], a3[2];
#pragma unroll
            for (int j = 0; j < 2; ++j) { const int d = 16 * dseg + i + j; const float lb = LB[d], b = GB[t * 128 + d], br = GB[31 * 128 + d];
                const float z = (i + j) < 8 ? bfx(f0, i + j) : bfx(f1, i + j - 8), qv = (i + j) < 8 ? bfx(q0, i + j) : bfx(q1, i + j - 8);
                const float k = (1.0f - lb) * (1.0f - sigmoidf_(z)), q = siluf_(qv);
                a1[j] = q * __expf(b); a2[j] = q * __expf(b - br); a3[j] = k * __expf(br - b); }
            o1[i >> 1] = cvt_pk_bf16(a1[0], a1[1]); o2[i >> 1] = cvt_pk_bf16(a2[0], a2[1]); o3[i >> 1] = cvt_pk_bf16(a3[0], a3[1]);
        }
        LAS u32x4* d1 = (LAS u32x4*)(lds + HG_Q1 + t * 272 + dseg * 32); LAS u32x4* d2 = (LAS u32x4*)(lds + HG_Q2 + t * 272 + dseg * 32); LAS u32x4* d3 = (LAS u32x4*)(lds + HG_K2 + t * 272 + dseg * 32);
        d1[0] = (u32x4){o1[0], o1[1], o1[2], o1[3]}; d1[1] = (u32x4){o1[4], o1[5], o1[6], o1[7]};
        d2[0] = (u32x4){o2[0], o2[1], o2[2], o2[3]}; d2[1] = (u32x4){o2[4], o2[5], o2[6], o2[7]};
        d3[0] = (u32x4){o3[0], o3[1], o3[2], o3[3]}; d3[1] = (u32x4){o3[4], o3[5], o3[6], o3[7]};
    }
    hgrn_vt(lds, va, vb, tid);
    __syncthreads();
#pragma unroll
    for (int q = 0; q < 2; ++q) {
        const int tile = 2 * wave + q, tt = tile >> 2, stl = tile & 3;
        f32x4 acc = (f32x4){0.f, 0.f, 0.f, 0.f};
#pragma unroll
        for (int ks = 0; ks < 4; ++ks) { const bf16x8 a = *(const LAS bf16x8*)(lds + HG_Q2 + (16 * tt + fr) * 272 + (32 * ks + 8 * fq) * 2), b = *(const LAS bf16x8*)(lds + HG_K2 + (16 * stl + fr) * 272 + (32 * ks + 8 * fq) * 2);
            acc = __builtin_amdgcn_mfma_f32_16x16x32_bf16(a, b, acc, 0, 0, 0); }
#pragma unroll
        for (int r = 0; r < 4; ++r) { const int tr_ = 16 * tt + 4 * fq + r, s = 16 * stl + fr; *(LAS bf16_t*)(lds + HG_PB + tr_ * 144 + s * 2) = f2bf(s <= tr_ ? acc[r] : 0.f); }
    }
    __syncthreads();
    {
        bf16x8 b1[2], b2[4];
#pragma unroll
        for (int ks = 0; ks < 2; ++ks) b1[ks] = *(const LAS bf16x8*)(lds + HG_VT + (16 * wave + fr) * 144 + (32 * ks + 8 * fq) * 2);
#pragma unroll
        for (int ks = 0; ks < 4; ++ks) b2[ks] = __builtin_bit_cast(bf16x8, sx[ks]);
        LAS float* OB = (LAS float*)(lds + HG_GB);
#pragma unroll
        for (int tt = 0; tt < 4; ++tt) {
            f32x4 acc = (f32x4){0.f, 0.f, 0.f, 0.f};
#pragma unroll
            for (int ks = 0; ks < 2; ++ks) { const bf16x8 a = *(const LAS bf16x8*)(lds + HG_PB + (16 * tt + fr) * 144 + (32 * ks + 8 * fq) * 2); acc = __builtin_amdgcn_mfma_f32_16x16x32_bf16(a, b1[ks], acc, 0, 0, 0); }
#pragma unroll
            for (int ks = 0; ks < 4; ++ks) { const bf16x8 a = *(const LAS bf16x8*)(lds + HG_Q1 + (16 * tt + fr) * 272 + (32 * ks + 8 * fq) * 2); acc = __builtin_amdgcn_mfma_f32_16x16x32_bf16(a, b2[ks], acc, 0, 0, 0); }
#pragma unroll
            for (int r = 0; r < 4; ++r) OB[(16 * tt + 4 * fq + r) * 132 + 16 * wave + fr] = acc[r];
        }
    }
    __syncthreads();
    {
        const int es = dseg; const LAS float* OB = (const LAS float*)(lds + HG_GB);
        float o[16]; float ss = 0.f;
#pragma unroll
        for (int i = 0; i < 16; ++i) { o[i] = OB[t * 132 + 16 * es + i]; ss += o[i] * o[i]; }
        ss += __shfl_xor(ss, 1); ss += __shfl_xor(ss, 2); ss += __shfl_xor(ss, 4);
        const float rstd = rsqrtf(ss * (1.0f / 128.0f) + NORM_EPS);
        float rv[16];
#pragma unroll
        for (int i = 0; i < 16; ++i) { const float ga = i < 8 ? bfx(g0, i) : bfx(g1, i - 8); rv[i] = o[i] * (rstd * OP8_SCALE) * norm_g[16 * es + i] * siluf_(ga); }
        *(u32x4*)(REC + (size_t)(c * 64 + t) * 1024 + h * 128 + 16 * es) = (u32x4){pack4_fp8(rv[0], rv[1], rv[2], rv[3]), pack4_fp8(rv[4], rv[5], rv[6], rv[7]), pack4_fp8(rv[8], rv[9], rv[10], rv[11]), pack4_fp8(rv[12], rv[13], rv[14], rv[15])};
    }
    __syncthreads();
}

constexpr int SC_KT = 0, SC_SB = 36864, SC_SPITCH = 132;
__device__ __forceinline__ unsigned pk_f16(float a, float b) { return __builtin_bit_cast(unsigned, __builtin_amdgcn_cvt_pkrtz(a, b)); }
__device__ __forceinline__ void score_flush(LAS unsigned char* lds, unsigned short* SCORES, unsigned short* SEGMAX, int t0, int kt, int tid) {
    const LAS float* sb = (const LAS float*)(lds + SC_SB + (kt & 1) * (32 * SC_SPITCH * 4));
    const int row = tid >> 4, seg = tid & 15;
    const f32x4 a = *(const LAS f32x4*)(sb + row * SC_SPITCH + seg * 8), b = *(const LAS f32x4*)(sb + row * SC_SPITCH + seg * 8 + 4);
    unsigned short* dst = SCORES + (size_t)(t0 + row) * S + kt * 128 + seg * 8;
    *(u32x4*)dst = (u32x4){pk_f16(a[0], a[1]), pk_f16(a[2], a[3]), pk_f16(b[0], b[1]), pk_f16(b[2], b[3])};
    const float mx = fmaxf(fmaxf(fmaxf(a[0], a[1]), fmaxf(a[2], a[3])), fmaxf(fmaxf(b[0], b[1]), fmaxf(b[2], b[3])));
    SEGMAX[(size_t)(t0 + row) * 2048 + kt * 16 + seg] = (unsigned short)(pk_f16(mx, mx) & 0xffffu);
}
__device__ __forceinline__ void score_block(LAS unsigned char* lds, const bf16_t* PROJ, const bf16_t* KI, unsigned short* SCORES, unsigned short* SEGMAX, int qb, int kt0, int kt1, int tid, int wave, int lane) {
    const int t0 = qb * 32;
    const int r = lane & 31, hh = lane >> 5;
    bf16x8 Af[2][4]; float wv[2][16]; f32x2 wv2[2][8];
#pragma unroll
    for (int p = 0; p < 2; ++p) {
        const int tq = t0 + 4 * wave + 2 * p + (r >> 4); const bf16_t* qrow = PROJ + (size_t)tq * DINP + CQI + (r & 15) * 64 + 8 * hh;
#pragma unroll
        for (int ks = 0; ks < 4; ++ks) Af[p][ks] = *(const bf16x8*)(qrow + 16 * ks);
#pragma unroll
        for (int qq = 0; qq < 2; ++qq) {
            const bf16_t* wp = PROJ + (size_t)(t0 + 4 * wave + 2 * p + qq) * DINP + CWI + 4 * hh;
            const u32x2 wa = *(const u32x2*)wp, wb = *(const u32x2*)(wp + 8);
            wv[p][8 * qq + 0] = bf_lo(wa.x) * (1.0f / 32.0f); wv[p][8 * qq + 1] = bf_hi(wa.x) * (1.0f / 32.0f); wv[p][8 * qq + 2] = bf_lo(wa.y) * (1.0f / 32.0f); wv[p][8 * qq + 3] = bf_hi(wa.y) * (1.0f / 32.0f);
            wv[p][8 * qq + 4] = bf_lo(wb.x) * (1.0f / 32.0f); wv[p][8 * qq + 5] = bf_hi(wb.x) * (1.0f / 32.0f); wv[p][8 * qq + 6] = bf_lo(wb.y) * (1.0f / 32.0f); wv[p][8 * qq + 7] = bf_hi(wb.y) * (1.0f / 32.0f);
        }
#pragma unroll
        for (int i = 0; i < 8; ++i) wv2[p][i] = (f32x2){wv[p][2 * i], wv[p][2 * i + 1]};
    }
    const u32x2 tagsw = __builtin_amdgcn_permlane32_swap(0u, 1u, false, false); const int qsel = (int)tagsw[0];
    u32x4 stg[2];
#pragma unroll
    for (int i = 0; i < 2; ++i) { const int q = tid + 512 * i; stg[i] = *(const u32x4*)(KI + (size_t)(kt0 * 128 + (q >> 3)) * 64 + (q & 7) * 8); }
#pragma unroll
    for (int i = 0; i < 2; ++i) { const int q = tid + 512 * i; *(LAS u32x4*)(lds + SC_KT + (kt0 & 1) * 18432 + (q >> 3) * 144 + (q & 7) * 16) = stg[i]; }
    __syncthreads();
    for (int kt = kt0; kt < kt1; ++kt) {
        const LAS unsigned char* buf = lds + SC_KT + (kt & 1) * 18432;
        LAS float* sb = (LAS float*)(lds + SC_SB + (kt & 1) * (32 * SC_SPITCH * 4));
        if (kt + 1 < kt1) {
#pragma unroll
            for (int i = 0; i < 2; ++i) { const int q = tid + 512 * i; stg[i] = *(const u32x4*)(KI + (size_t)((kt + 1) * 128 + (q >> 3)) * 64 + (q & 7) * 8); }
        }
        __builtin_amdgcn_sched_barrier(0);
        if (kt > kt0) score_flush(lds, SCORES, SEGMAX, t0, kt - 1, tid);
        {
        f32x16 accP[2], accC[2];
#define SC_MFMA(cb) do { bf16x8 Bf[4]; _Pragma("unroll") for (int ks = 0; ks < 4; ++ks) Bf[ks] = *(const LAS bf16x8*)(buf + (32 * (cb) + r) * 144 + (16 * ks + 8 * hh) * 2); \
            _Pragma("unroll") for (int p = 0; p < 2; ++p) { _Pragma("unroll") for (int i = 0; i < 16; ++i) accC[p][i] = 0.f; \
                _Pragma("unroll") for (int ks = 0; ks < 4; ++ks) accC[p] = __builtin_amdgcn_mfma_f32_32x32x16_bf16(Af[p][ks], Bf[ks], accC[p], 0, 0, 0); } } while (0)
#define SC_RED(acc, cb) do { _Pragma("unroll") for (int p = 0; p < 2; ++p) { f32x2 s0 = {0.f, 0.f}, s1 = {0.f, 0.f}; \
            _Pragma("unroll") for (int reg = 0; reg < 8; reg += 2) { const f32x2 r0 = {relu_i(acc[p][reg]), relu_i(acc[p][reg + 1])}; const f32x2 r1 = {relu_i(acc[p][reg + 8]), relu_i(acc[p][reg + 9])}; \
                s0 = __builtin_elementwise_fma(wv2[p][reg >> 1], r0, s0); s1 = __builtin_elementwise_fma(wv2[p][4 + (reg >> 1)], r1, s1); } \
            const float p0 = s0[0] + s0[1], p1 = s1[0] + s1[1]; \
            const u32x2 sw = __builtin_amdgcn_permlane32_swap(__float_as_uint(p0), __float_as_uint(p1), false, false); \
            sb[(4 * wave + 2 * p + qsel) * SC_SPITCH + 32 * (cb) + r] = __uint_as_float(sw[0]) + __uint_as_float(sw[1]); } } while (0)
#define SC_INTERLEAVE() do { _Pragma("unroll") for (int i = 0; i < 8; ++i) { __builtin_amdgcn_sched_group_barrier(0x008, 1, 0); __builtin_amdgcn_sched_group_barrier(0x002, 8, 0); } } while (0)
        SC_MFMA(0);
        accP[0] = accC[0]; accP[1] = accC[1]; SC_MFMA(1); SC_RED(accP, 0); SC_INTERLEAVE();
        accP[0] = accC[0]; accP[1] = accC[1]; SC_MFMA(2); SC_RED(accP, 1); SC_INTERLEAVE();
        accP[0] = accC[0]; accP[1] = accC[1]; SC_MFMA(3); SC_RED(accP, 2); SC_INTERLEAVE();
        SC_RED(accC, 3);
#undef SC_MFMA
#undef SC_RED
#undef SC_INTERLEAVE
        }
        if (kt + 1 < kt1) {
#pragma unroll
            for (int i = 0; i < 2; ++i) { const int q = tid + 512 * i; *(LAS u32x4*)(lds + SC_KT + ((kt + 1) & 1) * 18432 + (q >> 3) * 144 + (q & 7) * 16) = stg[i]; }
        }
        __syncthreads();
    }
    score_flush(lds, SCORES, SEGMAX, t0, kt1 - 1, tid);
    __syncthreads();
}

template <int NV, bool EXACT>
__device__ __forceinline__ float wave_kth(const float (&v)[NV], int K) {
    const float NINF = -__builtin_inff();
    float mx = NINF, mn = __builtin_inff();
#pragma unroll
    for (int j = 0; j < NV; ++j) { mx = fmaxf(mx, v[j]); mn = fminf(mn, v[j] == NINF ? __builtin_inff() : v[j]); }
    mx = wave_max(mx); mn = -wave_max(-mn);
    int c = 0;
#pragma unroll
    for (int j = 0; j < NV; ++j) c += __popcll(__ballot(v[j] >= mx));
    if (c >= K) return mx;
    float lo = mn, hi = mx, tau = mn;
    for (int it = 0; it < 64; ++it) {
        const float mid = 0.5f * (lo + hi);
        if (!(mid > lo && mid < hi)) { tau = lo; break; }
        c = 0;
#pragma unroll
        for (int j = 0; j < NV; ++j) c += __popcll(__ballot(v[j] >= mid));
        if (c == K || (!EXACT && c > K && c <= K + (K >> 2))) { tau = mid; break; }
        if (c > K) lo = mid; else hi = mid;
        tau = lo;
    }
    return tau;
}
__device__ __forceinline__ float wave_kth16(const float (&v)[16], int K) { return wave_kth<16, true>(v, K); }
__device__ __forceinline__ int lanes_below(unsigned long long mask) { return (int)__builtin_amdgcn_mbcnt_hi((unsigned)(mask >> 32), __builtin_amdgcn_mbcnt_lo((unsigned)mask, 0u)); }
__device__ __forceinline__ float h2f(unsigned short h) { return (float)__builtin_bit_cast(_Float16, h); }
__device__ __forceinline__ float h2f_lo(unsigned u) { return h2f((unsigned short)(u & 0xffffu)); }
__device__ __forceinline__ float h2f_hi(unsigned u) { return h2f((unsigned short)(u >> 16)); }
__device__ __forceinline__ unsigned ge_mask8(const u32x4& v, unsigned T16) {
    unsigned m8 = 0;
#pragma unroll
    for (int w = 0; w < 4; ++w) { const unsigned vw_ = v[w];
        const s16x2 d = __builtin_elementwise_sub_sat(__builtin_bit_cast(s16x2, vw_), __builtin_bit_cast(s16x2, T16));
        const unsigned mm = ~__builtin_bit_cast(unsigned, d); m8 |= (((mm >> 15) & 1u) | ((mm >> 30) & 2u)) << (2 * w); }
    return m8;
}
__device__ __forceinline__ int append_bits(LAS int* list, int cnt, unsigned m8, int base) {
    for (;;) { const bool has = m8 != 0u; const unsigned long long mask = __ballot(has); if (!mask) break;
        const int pos = cnt + lanes_below(mask);
        if (has) { const int k = __builtin_ctz(m8); m8 &= m8 - 1u; if (pos < 1024) list[pos] = base + k; }
        cnt += __popcll(mask); }
    return cnt;
}
__device__ __forceinline__ int append_keys(LAS int* list, int cnt, unsigned m8, int base, const u32x4& v) {
    for (;;) { const bool has = m8 != 0u; const unsigned long long mask = __ballot(has); if (!mask) break;
        const int pos = cnt + lanes_below(mask);
        if (has) { const int k = __builtin_ctz(m8); m8 &= m8 - 1u;
            const unsigned dw = (k & 4) ? ((k & 2) ? v.w : v.z) : ((k & 2) ? v.y : v.x); const unsigned h = (k & 1) ? (dw >> 16) : (dw & 0xffffu);
            if (pos < 1024) list[pos] = (int)((h << 16) | (unsigned)(base + k)); }
        cnt += __popcll(mask); }
    return cnt;
}
__device__ __forceinline__ void select_row(LAS unsigned char* wl, const unsigned short* SCORES, const unsigned short* SEGMAX, int t, int lane) {
    LAS int* selw = (LAS int*)wl; LAS int* segl = (LAS int*)(wl + 1024); LAS int* cidx = (LAS int*)(wl + 5120);
    const float NINF = -__builtin_inff();
    const unsigned short* row = SCORES + (size_t)t * S; const int n = t + 1;
    float c[16]; int N;
    if (n <= 1024) {
#pragma unroll
        for (int j = 0; j < 16; ++j) { const int i = lane + 64 * j; c[j] = i < n ? h2f(row[i]) : NINF; }
        N = -1;
    } else {
        const int m = n >> 4; float s[16];
#pragma unroll
        for (int j = 0; j < 16; ++j) { const int i = lane + 64 * j; s[j] = i < m ? h2f(row[16 * i + 7]) : NINF; }
        const u32x4 NEG = (u32x4){0xfc00fc00u, 0xfc00fc00u, 0xfc00fc00u, 0xfc00fc00u};
        const unsigned short* smrow = SEGMAX + (size_t)t * 2048; const int nseg = (t >> 3) + 1;
        u32x4 sv[4];
#pragma unroll
        for (int u = 0; u < 4; ++u) { const int e8 = 8 * (lane + 64 * u); sv[u] = (e8 < nseg) ? *(const u32x4*)(smrow + e8) : NEG; }
        int K = 26, cnt = 0;
        for (;;) {
            const float tlo = (K >= m) ? NINF : wave_kth<16, false>(s, K);
            cnt = 0;
            const int nq = (n + 511) >> 9;
            if (tlo > 0.f) {
                const unsigned T16 = pk_f16(tlo, tlo);
                int ns = 0;
                {
#pragma unroll
                    for (int u = 0; u < 4; ++u) if (512 * u < nseg) { const int e8 = 8 * (lane + 64 * u); unsigned m8 = ge_mask8(sv[u], T16);
                        const int nv = nseg - e8; if (nv < 8) m8 &= nv > 0 ? ((1u << nv) - 1u) : 0u;
                        ns = append_bits(segl, ns, m8, e8); }
                }
                if (ns > 1024) ns = 1024;
                for (int j0 = 0; j0 < ns; j0 += 512) {
                    u32x4 v[8]; int sg[8];
#pragma unroll
                    for (int u = 0; u < 8; ++u) { const int i = j0 + lane + 64 * u; sg[u] = i < ns ? segl[i] : -1; v[u] = sg[u] >= 0 ? *(const u32x4*)(row + 8 * sg[u]) : NEG; }
#pragma unroll
                    for (int u = 0; u < 8; ++u) if (j0 + 64 * u < ns) { const int e = 8 * sg[u]; unsigned m8 = sg[u] >= 0 ? ge_mask8(v[u], T16) : 0u;
                        const int nv = t + 1 - e; if (nv < 8) m8 &= nv > 0 ? ((1u << nv) - 1u) : 0u;
                        cnt = append_keys(cidx, cnt, m8, e, v[u]); }
                }
            } else {
                for (int q0 = 0; q0 < nq; q0 += 4) {
                    u32x4 v[4];
#pragma unroll
                    for (int u = 0; u < 4; ++u) { const int e = 8 * (lane + 64 * (q0 + u)); v[u] = (e <= t) ? *(const u32x4*)(row + e) : (u32x4){0xfc00fc00u, 0xfc00fc00u, 0xfc00fc00u, 0xfc00fc00u}; }
#pragma unroll
                    for (int u = 0; u < 4; ++u) { const int e = 8 * (lane + 64 * (q0 + u));
#pragma unroll
                        for (int k = 0; k < 8; ++k) { const float x = (k & 1) ? h2f_hi(v[u][k >> 1]) : h2f_lo(v[u][k >> 1]);
                            const bool pred = (e + k <= t) && (x >= tlo); const unsigned long long mask = __ballot(pred);
                            if (mask) { const int pos = cnt + lanes_below(mask); const unsigned hb = (k & 1) ? (v[u][k >> 1] >> 16) : (v[u][k >> 1] & 0xffffu);
                                if (pred && pos < 1024) cidx[pos] = (int)((hb << 16) | (unsigned)(e + k)); cnt += __popcll(mask); } } }
                }
            }
            if (cnt >= 256 || K >= m) break;
            K *= 2;
        }
        N = cnt < 1024 ? cnt : 1024;
#pragma unroll
        for (int j = 0; j < 16; ++j) { const int i = lane + 64 * j; c[j] = i < N ? h2f((unsigned short)((unsigned)cidx[i] >> 16)) : NINF; }
    }
    float tau;
    if (N >= 0 && N <= 512) { const float c8[8] = {c[0], c[1], c[2], c[3], c[4], c[5], c[6], c[7]}; tau = wave_kth<8, true>(c8, 256); }
    else tau = wave_kth16(c, 256);
    int base = 0;
#pragma unroll
    for (int j = 0; j < 16; ++j) { const bool pred = c[j] >= tau; const unsigned long long mask = __ballot(pred);
        if (mask) { const int pos = base + lanes_below(mask); if (pred && pos < 256) selw[pos] = (N < 0) ? (lane + 64 * j) : (cidx[lane + 64 * j] & 0xffff); base += __popcll(mask); } }
}

__device__ __forceinline__ void attn_query(LAS unsigned char* wl, const bf16_t* PROJ, const unsigned char* KC, const unsigned char* VC, unsigned char* ATT, int t, int lane) {
    LAS int* selw = (LAS int*)wl; LAS float* L = (LAS float*)(wl + 1024);
    const int nsel = t < 255 ? t + 1 : 256;
    const int fr = lane & 15, fq = lane >> 4;
    constexpr float QS = 8.0f;
    long qh[2][4], ql[2][4];
#pragma unroll
    for (int g = 0; g < 2; ++g)
#pragma unroll
        for (int ks = 0; ks < 4; ++ks) {
            u32x4 z = (u32x4){0u, 0u, 0u, 0u};
            if (fr < 4) z = *(const u32x4*)(PROJ + (size_t)t * DINP + CQ + (4 * g + fr) * 128 + 32 * ks + 8 * fq);
            float qv[8], rv[8];
#pragma unroll
            for (int e = 0; e < 4; ++e) { qv[2 * e] = bf_lo(z[e]) * QS; qv[2 * e + 1] = bf_hi(z[e]) * QS; }
            const unsigned h0 = pack4_fp8(qv[0], qv[1], qv[2], qv[3]), h1 = pack4_fp8(qv[4], qv[5], qv[6], qv[7]);
            rv[0] = qv[0] - __builtin_amdgcn_cvt_f32_fp8((int)h0, 0); rv[1] = qv[1] - __builtin_amdgcn_cvt_f32_fp8((int)h0, 1); rv[2] = qv[2] - __builtin_amdgcn_cvt_f32_fp8((int)h0, 2); rv[3] = qv[3] - __builtin_amdgcn_cvt_f32_fp8((int)h0, 3);
            rv[4] = qv[4] - __builtin_amdgcn_cvt_f32_fp8((int)h1, 0); rv[5] = qv[5] - __builtin_amdgcn_cvt_f32_fp8((int)h1, 1); rv[6] = qv[6] - __builtin_amdgcn_cvt_f32_fp8((int)h1, 2); rv[7] = qv[7] - __builtin_amdgcn_cvt_f32_fp8((int)h1, 3);
            const unsigned l0 = pack4_fp8(rv[0] * 16.0f, rv[1] * 16.0f, rv[2] * 16.0f, rv[3] * 16.0f), l1 = pack4_fp8(rv[4] * 16.0f, rv[5] * 16.0f, rv[6] * 16.0f, rv[7] * 16.0f);
            qh[g][ks] = (long)(((unsigned long long)h1 << 32) | h0); ql[g][ks] = (long)(((unsigned long long)l1 << 32) | l0);
        }
    const float scale = 0.08838834764831845f / QS;
    const int nkt = (nsel + 15) >> 4;
    {
        LAS unsigned char* KT = wl + 9216;
        const int q4_ = lane >> 4, l15_ = lane & 15;
        u32x4 kw[3][4];
#define QK_LOAD(buf, kt) do { _Pragma("unroll") for (int u = 0; u < 4; ++u) { const unsigned off_ = (unsigned)selw[16 * (kt) + 4 * u + q4_] * 256u + 16u * (unsigned)l15_; kw[buf][u] = *(const u32x4*)((const char*)KC + off_); } } while (0)
#define QK_COMP(buf, kt) do { _Pragma("unroll") for (int u = 0; u < 4; ++u) *(LAS u32x4*)(KT + (4 * u + q4_) * 272 + 16 * l15_) = kw[buf][u];     \
        _Pragma("unroll") for (int g = 0; g < 2; ++g) { f32x4 acch = (f32x4){0.f, 0.f, 0.f, 0.f}, accl = (f32x4){0.f, 0.f, 0.f, 0.f}; \
            _Pragma("unroll") for (int ks = 0; ks < 4; ++ks) { const long kf_ = *(const LAS long*)(KT + fr * 272 + g * 128 + 32 * ks + 8 * fq); \
                acch = __builtin_amdgcn_mfma_f32_16x16x32_fp8_fp8(qh[g][ks], kf_, acch, 0, 0, 0); accl = __builtin_amdgcn_mfma_f32_16x16x32_fp8_fp8(ql[g][ks], kf_, accl, 0, 0, 0); } \
            if (fq == 0) { _Pragma("unroll") for (int r = 0; r < 4; ++r) L[(4 * g + r) * 256 + 16 * (kt) + fr] = (16 * (kt) + fr < nsel) ? (acch[r] + accl[r] * 0.0625f) * scale : -__builtin_inff(); } } } while (0)
        QK_LOAD(0, 0); if (1 < nkt) QK_LOAD(1, 1);
        for (int kt = 0; kt < nkt; kt += 3) {
            if (kt + 2 < nkt) QK_LOAD(2, kt + 2);
            __builtin_amdgcn_sched_barrier(0);
            QK_COMP(0, kt);
            if (kt + 1 < nkt) { if (kt + 3 < nkt) QK_LOAD(0, kt + 3); __builtin_amdgcn_sched_barrier(0); QK_COMP(1, kt + 1); }
            if (kt + 2 < nkt) { if (kt + 4 < nkt) QK_LOAD(1, kt + 4); __builtin_amdgcn_sched_barrier(0); QK_COMP(2, kt + 2); }
        }
#undef QK_LOAD
#undef QK_COMP
        if (fq == 0) { for (int kt = nkt; kt < 16; ++kt) {
#pragma unroll
            for (int r = 0; r < 8; ++r) L[r * 256 + 16 * kt + fr] = -__builtin_inff(); } }
    }
    float p[8][4];
#pragma unroll
    for (int hd = 0; hd < 8; ++hd) { float m = -__builtin_inff();
#pragma unroll
        for (int i = 0; i < 4; ++i) { p[hd][i] = L[hd * 256 + 4 * lane + i]; m = fmaxf(m, p[hd][i]); }
        m = wave_max(m); float s = 0.f;
#pragma unroll
        for (int i = 0; i < 4; ++i) { p[hd][i] = __expf(p[hd][i] - m); s += p[hd][i]; }
        s = __builtin_amdgcn_rcpf(wave_sum(s));
#pragma unroll
        for (int i = 0; i < 4; ++i) p[hd][i] *= s; }
    constexpr float PS = 256.0f;
    LAS unsigned* Ph = (LAS unsigned*)(wl + 1024); LAS unsigned* Pl = (LAS unsigned*)(wl + 1024 + 2048);
#pragma unroll
    for (int hd = 0; hd < 8; ++hd) {
        const float a0 = p[hd][0] * PS, a1 = p[hd][1] * PS, a2 = p[hd][2] * PS, a3 = p[hd][3] * PS;
        const unsigned h = pack4_fp8(a0, a1, a2, a3);
        const unsigned l = pack4_fp8(a0 - __builtin_amdgcn_cvt_f32_fp8((int)h, 0), a1 - __builtin_amdgcn_cvt_f32_fp8((int)h, 1), a2 - __builtin_amdgcn_cvt_f32_fp8((int)h, 2), a3 - __builtin_amdgcn_cvt_f32_fp8((int)h, 3));
        Ph[hd * 64 + lane] = h; Pl[hd * 64 + lane] = l;
    }
    LAS unsigned char* VT = wl + 9216;
    const int ii = lane & 15, kq = lane >> 4;
    f32x4 acc[16];
#pragma unroll
    for (int nt = 0; nt < 16; ++nt) acc[nt] = (f32x4){0.f, 0.f, 0.f, 0.f};
    const int nch = (nsel + 15) >> 4;
    u32x4 vw[3][4];
#define PV_LOAD(buf, c) do { _Pragma("unroll") for (int u = 0; u < 4; ++u) { const unsigned off_ = (unsigned)selw[16 * (c) + 4 * u + kq] * 256u + 16u * (unsigned)ii; vw[buf][u] = *(const u32x4*)((const char*)VC + off_); } } while (0)
#define PV_COMP(buf, c) do { _Pragma("unroll") for (int u = 0; u < 4; ++u) { LAS u32x2* d_ = (LAS u32x2*)(VT + (16 * ((c) & 1) + 4 * u + kq) * 264 + 16 * ii); d_[0] = (u32x2){vw[buf][u].x, vw[buf][u].y}; d_[1] = (u32x2){vw[buf][u].z, vw[buf][u].w}; } \
        if (((c) & 1) || (c) == nch - 1) { \
            if (!((c) & 1)) { _Pragma("unroll") for (int u = 0; u < 4; ++u) { LAS u32x2* d_ = (LAS u32x2*)(VT + (16 + 4 * u + kq) * 264 + 16 * ii); d_[0] = (u32x2){0u, 0u}; d_[1] = (u32x2){0u, 0u}; } } \
            long pa[2]; _Pragma("unroll") for (int g = 0; g < 2; ++g) { const int po_ = (g * 4 + (ii & 3)) * 256 + 32 * ((c) >> 1) + 8 * kq;     \
                const long h_ = *(const LAS long*)((const LAS unsigned char*)Ph + po_ + ((ii & 4) ? 2048 : 0)); pa[g] = ii < 8 ? h_ : 0l; } \
            _Pragma("unroll") for (int nt = 0; nt < 16; ++nt) { const v2i32 t_ = __builtin_amdgcn_ds_read_tr8_b64_v2i32((LAS v2i32*)(VT + (8 * kq + (ii >> 1)) * 264 + 16 * nt + 8 * (ii & 1))); \
                const long b_ = __builtin_bit_cast(long, t_); \
                acc[nt] = __builtin_amdgcn_mfma_f32_16x16x32_fp8_fp8(pa[nt >> 3], b_, acc[nt], 0, 0, 0); } } } while (0)
    PV_LOAD(0, 0); if (1 < nch) PV_LOAD(1, 1);
    for (int c = 0; c < nch; c += 3) {
        if (c + 2 < nch) PV_LOAD(2, c + 2);
        __builtin_amdgcn_sched_barrier(0);
        PV_COMP(0, c);
        if (c + 1 < nch) { if (c + 3 < nch) PV_LOAD(0, c + 3); __builtin_amdgcn_sched_barrier(0); PV_COMP(1, c + 1); }
        if (c + 2 < nch) { if (c + 4 < nch) PV_LOAD(1, c + 4); __builtin_amdgcn_sched_barrier(0); PV_COMP(2, c + 2); }
    }
#undef PV_LOAD
#undef PV_COMP
    LAS float* OB = (LAS float*)(wl + 1024 + 4096);
    LAS float* OB2 = (LAS float*)(wl + 1024);
    if (kq < 2) {
        LAS float* ob = kq == 0 ? OB : OB2;
#pragma unroll
        for (int nt = 0; nt < 16; ++nt)
#pragma unroll
            for (int r = 0; r < 4; ++r) ob[(4 * (nt >> 3) + r) * 128 + 16 * (nt & 7) + ii] = acc[nt][r];
    }
    {
        const f32x4 a0 = *(const LAS f32x4*)(OB + 16 * lane) + *(const LAS f32x4*)(OB2 + 16 * lane), a1 = *(const LAS f32x4*)(OB + 16 * lane + 4) + *(const LAS f32x4*)(OB2 + 16 * lane + 4),
                    a2 = *(const LAS f32x4*)(OB + 16 * lane + 8) + *(const LAS f32x4*)(OB2 + 16 * lane + 8), a3 = *(const LAS f32x4*)(OB + 16 * lane + 12) + *(const LAS f32x4*)(OB2 + 16 * lane + 12);
        const f32x4 b0 = a0 * (OP8_SCALE / PS), b1 = a1 * (OP8_SCALE / PS), b2 = a2 * (OP8_SCALE / PS), b3 = a3 * (OP8_SCALE / PS);
        *(u32x4*)(ATT + (size_t)t * 1024 + 16 * lane) = (u32x4){pack4_fp8(b0[0], b0[1], b0[2], b0[3]), pack4_fp8(b1[0], b1[1], b1[2], b1[3]), pack4_fp8(b2[0], b2[1], b2[2], b2[3]), pack4_fp8(b3[0], b3[1], b3[2], b3[3])};
    }
}


__device__ __forceinline__ void convert_item8(const float* __restrict__ W, int K, int N, int ld, unsigned char* WT, int mode, int item, int lane, LAS unsigned char* scr) {
    const int nblk = N >> 6; const int kb = item / nblk, nb = item - kb * nblk; const int k0 = kb * 256, n0 = nb * 64;
    const int c4 = lane & 15, kr = lane >> 4;
    const float* src = W + (size_t)(k0 + 4 * kr) * ld + n0 + 4 * c4;
#pragma unroll 4
    for (int i = 0; i < 16; ++i) {
        f32x4 v[4];
#pragma unroll
        for (int r = 0; r < 4; ++r) v[r] = __builtin_nontemporal_load((const f32x4*)(src + (size_t)(16 * i + r) * ld));
        const int kk = 16 * i + 4 * kr;
#pragma unroll
        for (int e = 0; e < 4; ++e) *(LAS unsigned*)(scr + (4 * c4 + e) * 272 + kk) = pack4_fp8(v[0][e] * W8_SCALE, v[1][e] * W8_SCALE, v[2][e] * W8_SCALE, v[3][e] * W8_SCALE);
    }
    LDS_WAIT(); asm volatile("" ::: "memory");
#pragma unroll 4
    for (int j = 0; j < 16; ++j) {
        const int q = j * 64 + lane, n = q >> 4, ch = q & 15;
        const u32x4 v = *(const LAS u32x4*)(scr + n * 272 + ch * 16);
        *(u32x4*)(WT + (size_t)dest_row(mode, n0 + n) * K + k0 + ch * 16) = v;
    }
    LDS_WAIT(); asm volatile("" ::: "memory");
}

struct Conv8Job { const float* W; unsigned char* WT; int N; int mode; size_t w_estride, wt_estride; int items_per_e; };
constexpr int C8_PITCH = 272, C8_IMG = 256 * C8_PITCH;
__device__ __forceinline__ void conv8_load(const Conv8Job& jb, int item, int h, int wave, int lane, f32x4 (&v)[16]) {
    const int e = item / jb.items_per_e, r = item - e * jb.items_per_e; const int nblk = jb.N >> 8; const int kb = r / nblk, nb = r - kb * nblk;
    const float* src = jb.W + (size_t)e * jb.w_estride + (size_t)(kb * 256 + 32 * wave + 16 * h) * jb.N + nb * 256 + 4 * lane;
#pragma unroll
    for (int i = 0; i < 16; ++i) v[i] = __builtin_nontemporal_load((const f32x4*)(src + (size_t)i * jb.N));
}
__device__ __forceinline__ void conv8_to_lds(LAS unsigned char* img, int h, int wave, int lane, const f32x4 (&v)[16]) {
#pragma unroll
    for (int e = 0; e < 4; ++e) { u32x4 w;
#pragma unroll
        for (int g = 0; g < 4; ++g) w[g] = pack4_fp8(v[4 * g][e] * W8_SCALE, v[4 * g + 1][e] * W8_SCALE, v[4 * g + 2][e] * W8_SCALE, v[4 * g + 3][e] * W8_SCALE);
        *(LAS u32x4*)(img + (4 * lane + e) * C8_PITCH + 32 * wave + 16 * h) = w; }
}
__device__ __forceinline__ void conv8_store(const Conv8Job& jb, int item, const LAS unsigned char* img, int tid) {
    const int e = item / jb.items_per_e, r = item - e * jb.items_per_e; const int nblk = jb.N >> 8; const int kb = r / nblk, nb = r - kb * nblk;
    unsigned char* dst = jb.WT + (size_t)e * jb.wt_estride + kb * 256;
#pragma unroll
    for (int j = 0; j < 8; ++j) { const int q = j * 512 + tid, n = q >> 4, ch = q & 15;
        __builtin_nontemporal_store(*(const LAS u32x4*)(img + n * C8_PITCH + ch * 16), (u32x4*)(dst + (size_t)dest_row(jb.mode, nb * 256 + n) * 2048 + ch * 16)); }
}
__device__ __forceinline__ void conv8_run(LAS unsigned char* lds, const Conv8Job& jb, int n_items, int wg, int G, int tid, int wave, int lane) {
    if (wg >= n_items) return;
    f32x4 a[16], b[16]; int par = 0;
    conv8_load(jb, wg, 0, wave, lane, a); conv8_load(jb, wg, 1, wave, lane, b);
    for (int it = wg; it < n_items; it += G, par ^= 1) {
        LAS unsigned char* img = lds + par * C8_IMG;
        const int nx = (it + G < n_items) ? it + G : it;
        conv8_to_lds(img, 0, wave, lane, a); __builtin_amdgcn_sched_barrier(0);
        conv8_load(jb, nx, 0, wave, lane, a); __builtin_amdgcn_sched_barrier(0);
        conv8_to_lds(img, 1, wave, lane, b); __builtin_amdgcn_sched_barrier(0);
        conv8_load(jb, nx, 1, wave, lane, b); __builtin_amdgcn_sched_barrier(0);
        __syncthreads();
        conv8_store(jb, it, img, tid);
    }
    __syncthreads();
}

__global__ void __launch_bounds__(NTHR, 2) fwd_kernel(Args args) {
    extern __shared__ __attribute__((aligned(16))) unsigned char lds_raw[];
    LAS unsigned char* lds = (LAS unsigned char*)lds_raw;
    volatile LAS unsigned* MISC = (volatile LAS unsigned*)(lds + LDS_MISC);
    const int tid = threadIdx.x, lane = tid & 63, wave = __builtin_amdgcn_readfirstlane(tid >> 6);
    const int G = gridDim.x, wg = blockIdx.x;
    unsigned char* ws = args.ws;
    unsigned* ctl = (unsigned*)(ws + WS_CTL);
    const int lo = args.ph_lo, hi = args.ph_hi;
    const float* x = (const float*)args.in[0]; const float* cvec = (const float*)args.in[1]; const int* positions = (const int*)args.in[2];
    const float* w_ada = (const float*)args.in[3]; const float* b_ada = (const float*)args.in[4]; const float* norm1_g = (const float*)args.in[5];
    const float* w_in = (const float*)args.in[6]; const float* idx_knorm_g = (const float*)args.in[7]; const float* idx_knorm_b = (const float*)args.in[8];
    const float* lb_logits = (const float*)args.in[9]; const float* hgrn_norm_g = (const float*)args.in[10];
    const float* w_proj_att = (const float*)args.in[11]; const float* w_proj_hgrn = (const float*)args.in[12]; const float* w_out = (const float*)args.in[13];
    const float* norm2_g = (const float*)args.in[14]; const float* w_router = (const float*)args.in[15]; const float* b_router = (const float*)args.in[16];
    const float* w1 = (const float*)args.in[17]; const float* b1 = (const float*)args.in[18]; const float* w2 = (const float*)args.in[19]; const float* b2 = (const float*)args.in[20];
    const float* final_g = (const float*)args.in[21];
    float* out = args.out;
    float* MOD = (float*)(ws + WS_MOD); int* TOPE = (int*)(ws + WS_TOPE); float* GATE = (float*)(ws + WS_GATE); int* SLOT = (int*)(ws + WS_SLOT);
    bf16_t* WIN_T = (bf16_t*)(ws + WS_WIN_T); bf16_t* WA_T = (bf16_t*)(ws + WS_WA_T); bf16_t* WH_T = (bf16_t*)(ws + WS_WH_T); bf16_t* WO_T = (bf16_t*)(ws + WS_WO_T);
    unsigned char* WIN_T8 = ws + WS_WIN_T + 8 * MiB;
    unsigned char* HA8 = ws + WS_SCORES;
    unsigned char* W1_T = ws + WS_W1_T; unsigned char* W2_T = ws + WS_W2_T;
    bf16_t* HB = (bf16_t*)(ws + WS_H); bf16_t* PROJ = (bf16_t*)(ws + WS_PROJ);
    bf16_t* DELTA = (bf16_t*)(ws + WS_ATT);
    unsigned char* ACT = ws + WS_ACT; bf16_t* YB = (bf16_t*)(ws + WS_YB);
    int* TOKS = (int*)(ws + WS_TOKS);
    unsigned char* H8 = ws + WS_H;
    bf16_t* KI = (bf16_t*)(ws + WS_KI); unsigned char* KC = ws + WS_KC; unsigned char* VC = ws + WS_VC;
    bf16_t* ST = (bf16_t*)(ws + WS_ST); float* DC = (float*)(ws + WS_DC);
    unsigned char* ATT = ws + WS_ATT; unsigned char* REC = ATT + (size_t)S * 1024;        bf16_t* MERGED = (bf16_t*)(ws + WS_MERGED); unsigned short* SCORES = (unsigned short*)(ws + WS_SCORES);
    unsigned short* SEGMAX = (unsigned short*)(ws + WS_X1);

    for (int u = tid; u < 128; u += NTHR) MISC[u] = 0u;
    __syncthreads();
    const bool one_launch = (hi - lo) > 1;
    XcdBarrier bar; bar.bar = ctl + CW_BAR; bar.x = 0; bar.st = MISC + 8;
    if (one_launch) bar = xcd_barrier_post(ctl + CW_BAR, MISC + 8);
#define IN(k) (lo <= (k) && (k) < hi)
#define SEAM(k) do { if (IN(k) && IN((k) + 1)) xcd_barrier(bar); } while (0)


    if (IN(PH_PRO)) {
        for (int cb = wg; cb < 256; cb += G) {
            LAS float* red = (LAS float*)lds;
            const int c4 = tid % 12, kg = tid / 12;
            f32x4 acc = (f32x4){0.f, 0.f, 0.f, 0.f};
            if (kg < 42) {
                const float* wp = w_ada + (size_t)cb * 48 + 4 * c4;
#pragma unroll 7
                for (int j = 0; j < 49; ++j) { const int k = kg + 42 * j; if (k < D) { const f32x4 v = __builtin_nontemporal_load((const f32x4*)(wp + (size_t)k * (6 * D))); acc += siluf_(cvec[k]) * v; } }
                *(LAS f32x4*)(red + kg * 48 + 4 * c4) = acc;
            }
            __syncthreads();
            if (tid < 48) { float s = b_ada[cb * 48 + tid];
#pragma unroll 6
                for (int q = 0; q < 42; ++q) s += red[q * 48 + tid];
                MOD[cb * 48 + tid] = s; }
            __syncthreads();
        }
        LAS unsigned char* scr = lds + wave * 17408;
        const int gw = wg * NWAVES + wave, NGW = G * NWAVES;
        {
            constexpr int NB_IN = (1104 + 63) / 64;
            for (int it = gw; it < 16 * NB_IN; it += NGW) convert_item(w_in + 1536, 2048, 1104, DIN, WIN_T, 0, it, lane, scr);
            for (int it = gw; it < 4 * 32; it += NGW) convert_item8(w_proj_att, 1024, 2048, 2048, (unsigned char*)WA_T, 0, it, lane, scr);
            for (int it = gw; it < 4 * 32; it += NGW) convert_item8(w_proj_hgrn, 1024, 2048, 2048, (unsigned char*)WA_T + (size_t)2048 * 1024, 0, it, lane, scr);
            for (int it = gw; it < 8 * 32; it += NGW) convert_item8(w_out, 2048, 2048, 2048, (unsigned char*)WO_T, 0, it, lane, scr);
            for (int it = gw; it < 8 * 24; it += NGW) convert_item8(w_in, 2048, 1536, DIN, WIN_T8, 0, it, lane, scr);
            for (int it = gw; it < 8 * 128; it += NGW) convert_item8(w_in + 2640, 2048, 8192, DIN, WIN_T8 + (size_t)1536 * 2048, 0, it, lane, scr);
            for (size_t i = (size_t)wg * NTHR + tid; i < (size_t)176 * 2048 * 2 / 16; i += (size_t)G * NTHR) ((u32x4*)(WIN_T + (size_t)1104 * 2048))[i] = (u32x4){0u, 0u, 0u, 0u};
        }
    }
    SEAM(PH_PRO);

    {
    if (IN(PH_H)) {
        const float* sh1 = MOD; const float* sc1 = MOD + D;
        const int gw = wg * NWAVES + wave, NGW = G * NWAVES;
        f32x4 gs[8], sh[8];
#pragma unroll
        for (int j = 0; j < 8; ++j) { const int c = 4 * lane + 256 * j; const f32x4 g = *(const f32x4*)(norm1_g + c), sc = *(const f32x4*)(sc1 + c); sh[j] = *(const f32x4*)(sh1 + c);
#pragma unroll
            for (int e = 0; e < 4; ++e) gs[j][e] = g[e] * (1.0f + sc[e]); }
        for (int t = gw; t < S; t += NGW) {
            const f32x4* xr = (const f32x4*)(x + (size_t)t * D) + lane;
            f32x4 v[8]; float ss = 0.f;
#pragma unroll
            for (int j = 0; j < 8; ++j) { v[j] = xr[64 * j]; ss += (v[j][0] * v[j][0] + v[j][1] * v[j][1]) + (v[j][2] * v[j][2] + v[j][3] * v[j][3]); }
            const float rstd = rsqrtf(wave_sum(ss) * (1.0f / D) + NORM_EPS);
#pragma unroll
            for (int j = 0; j < 8; ++j) { const f32x4 h = v[j] * rstd * gs[j] + sh[j]; u32x2 w; w.x = cvt_pk_bf16(h[0], h[1]); w.y = cvt_pk_bf16(h[2], h[3]);
                *(u32x2*)(HB + (size_t)t * D + 4 * lane + 256 * j) = w;
                *(unsigned*)(HA8 + (size_t)t * D + 4 * lane + 256 * j) = pack4_fp8(h[0], h[1], h[2], h[3]); }
        }
    }
    SEAM(PH_H);
    if (IN(PH_INPROJ)) {
        const int XC = (G == 256) ? XCONV : 0;
        const Conv8Job j1{w1, W1_T, 4096, 2, (size_t)2048 * 4096, (size_t)4096 * 2048, 8 * 16};
        const Conv8Job j2{w2, W2_T, 2048, 0, (size_t)2048 * 2048, (size_t)2048 * 2048, 8 * 8};
        if (G != 256) { conv8_run(lds, j1, NEXP * 8 * 16, wg, G, tid, wave, lane); conv8_run(lds, j2, NEXP * 8 * 8, wg, G, tid, wave, lane); }
        if (wg < XC) { conv8_run(lds, j1, NEXP * 8 * 16, wg, XC, tid, wave, lane); conv8_run(lds, j2, NEXP * 8 * 8, wg, XC, tid, wave, lane); }
        else {
            const int Gg = G - XC, cg = wg - XC;
            {
                pg8::Gemm g8{HA8, WIN_T8, 2048, 0, nullptr, 0}; pg8::StaticOrder S8; S8.init(S, 9728, Gg, cg);
                const int full8 = 2432 / Gg, rem8 = 2432 - full8 * Gg;
                if (Gg == 256) S8.skew(8, (wg >= 128 && wg < 192) ? -1 : (wg < 128 ? wg : wg - 64), 192);
                else if (rem8 > 0) S8.skew(full8, cg < rem8 ? cg : -1, rem8);
                pg8::EpiBf16 E8{PROJ, DINP, nullptr, 0, 1.0f / W8_SCALE, 6, 1280};
                pg8::gemm_phase<pg8::EpiBf16, pg8::StaticOrder, true>(lds, g8, S8, E8);
            }
            {
                pg8::Gemm g{HB, WIN_T, 2048, 0, nullptr, 0}; pg8::StaticOrder So; So.init(S, 1280, Gg, Gg == 256 ? (wg + 128) % G : (cg + Gg - (2432 % Gg)) % Gg);
                pg8::EpiBf16 E{PROJ + CQI, DINP, nullptr, 0, 1.0f, 1 << 30, 0};
                pg8::gemm_phase<pg8::EpiBf16, pg8::StaticOrder>(lds, g, So, E);
            }
        }
    }
    SEAM(PH_INPROJ);
    if (IN(PH_POST)) {
        const int gw = wg * NWAVES + wave, NGW = G * NWAVES;
        const float inv16 = powf(500000.0f, -(float)(lane & 15) * (1.0f / 16.0f)), inv8 = powf(500000.0f, -(float)(lane & 7) * (1.0f / 8.0f));
        for (int t = gw; t < S; t += NGW) post_token(PROJ, KI, KC, VC, positions, idx_knorm_g, idx_knorm_b, inv16, inv8, t, lane);
        __syncthreads();
        for (int u = wg; u < 2048; u += G) hgrn_l1(lds, PROJ, lb_logits, ST, DC, u >> 3, u & 7, tid, wave, lane);
    }
    SEAM(PH_POST);
    if (IN(PH_SCORE)) {
        for (int idx = wg * NTHR + tid; idx < 8 * 128 * 128; idx += G * NTHR) {
            const int h = idx >> 14, d = idx & 127; float s = 0.f;
            bf16_t* sp = ST + idx; const float* dp = DC + h * 128 + d;
            for (int c = 0; c < 256; c += 16) {
                float l[16], dc[16];
#pragma unroll
                for (int i = 0; i < 16; ++i) { l[i] = bf2f(sp[(size_t)(c + i) * 131072]); dc[i] = dp[(size_t)(c + i) * 1024]; }
#pragma unroll
                for (int i = 0; i < 16; ++i) { sp[(size_t)(c + i) * 131072] = f2bf(s); s = dc[i] * s + l[i]; }
            }
        }
        {
            const int XS = (G == 256) ? XSCORE : 0;
            if (wg < XS) {
                const Conv8Job j1{w1, W1_T, 4096, 2, (size_t)2048 * 4096, (size_t)4096 * 2048, 8 * 16};
                const Conv8Job j2{w2, W2_T, 2048, 0, (size_t)2048 * 2048, (size_t)2048 * 2048, 8 * 8};
                __syncthreads();
                conv8_run(lds, j1, NEXP * 8 * 16, wg, XS, tid, wave, lane); conv8_run(lds, j2, NEXP * 8 * 8, wg, XS, tid, wave, lane);
            }
            for (;;) {
                if (tid == 0) MISC[100] = __hip_atomic_fetch_add(ctl + CW_SCQ, 1u, __ATOMIC_RELAXED, __HIP_MEMORY_SCOPE_AGENT);
                __syncthreads();
                const int item = (int)MISC[100];
                __syncthreads();
                if (item >= 252 * 6) break;
                int j, lo, hi;
                if (item < 504) { j = item >> 1; const int T = ((8 + j) >> 2) + ((511 - j) >> 2) + 2; const int p = item & 1; lo = p * T / 3; hi = (p + 1) * T / 3; }
                else { const int i2 = item - 504; j = i2 >> 2; const int T = ((8 + j) >> 2) + ((511 - j) >> 2) + 2; const int p = i2 & 3, b = 2 * T / 3; lo = b + p * (T - b) / 4; hi = b + (p + 1) * (T - b) / 4; }
                const int qa = 8 + j, qb2 = 511 - j, na = (qa >> 2) + 1;
                const int a0 = lo < na ? lo : na, a1 = hi < na ? hi : na, b0 = (lo > na ? lo : na) - na, b1 = (hi > na ? hi : na) - na;
                if (a1 > a0) score_block(lds, PROJ, KI, SCORES, SEGMAX, qa, a0, a1, tid, wave, lane);
                if (b1 > b0) score_block(lds, PROJ, KI, SCORES, SEGMAX, qb2, b0, b1, tid, wave, lane);
            }
        }
    }
    SEAM(PH_SCORE);
    if (IN(PH_ATTN)) {
        const int gw = wg * NWAVES + wave, NGW = G * NWAVES;
        for (int u = wg; u < 2048; u += G) hgrn_l3(lds, PROJ, lb_logits, ST, hgrn_norm_g, REC, u >> 3, u & 7, tid, wave, lane);
        {
            for (;;) {
                unsigned tq = 0; if (lane == 0) tq = __hip_atomic_fetch_add(ctl + CW_ATQ, 1u, __ATOMIC_RELAXED, __HIP_MEMORY_SCOPE_AGENT);
                tq = (unsigned)__builtin_amdgcn_readfirstlane((int)tq);
                if (tq >= (unsigned)S) break;
                const int t = S - 1 - (int)tq;
                LAS unsigned char* wl = lds + wave * 17664;
                if (t >= 256) select_row(wl, SCORES, SEGMAX, t, lane);
                else {
#pragma unroll
                    for (int i = 0; i < 4; ++i) { const int idx = lane + 64 * i; ((LAS int*)wl)[idx] = idx <= t ? idx : 0; }
                }
                attn_query(wl, PROJ, KC, VC, ATT, t, lane);
            }
        }
    }
    SEAM(PH_ATTN);
    if (IN(PH_OP1)) {
        pg8::Gemm g{ATT, WA_T, 1024, (size_t)2048 * 1024, nullptr, (size_t)S * 1024};
        pg8::TwoPartOrder So; So.init(S, 2048, G, wg);
        pg8::EpiGate2 E{(unsigned char*)MERGED, PROJ + CGA, PROJ + CGR};
        pg8::gemm_phase<pg8::EpiGate2, pg8::TwoPartOrder, true>(lds, g, So, E);
    }
    SEAM(PH_OP2);
    if (IN(PH_WOUT)) {
        pg8::Gemm g{MERGED, WO_T, 2048, 0, nullptr, 0}; pg8::StaticOrder So; So.init(S, 2048, G, wg);
        pg8::EpiDelta E{MOD + 2 * D, DELTA, 1.0f / (W8_SCALE * MRG8_SCALE)};
        pg8::gemm_phase<pg8::EpiDelta, pg8::StaticOrder, true>(lds, g, So, E);
    }
    SEAM(PH_WOUT);
    }

    if (IN(PH_ROUTER)) {
        LAS float* hs = (LAS float*)lds;
        volatile LAS unsigned* lcnt = MISC + 32;
        const float* sh2 = MOD + 3 * D; const float* sc2 = MOD + 4 * D;
        if (tid < 32) lcnt[tid] = 0u;
        __syncthreads();
        for (int grp = wg; grp < S / 16; grp += G) {
#pragma unroll 1
            for (int q = 0; q < 2; ++q) {
                const int tl = 2 * wave + q, t = grp * 16 + tl;
                const f32x4* xr = (const f32x4*)(x + (size_t)t * D) + lane; const u32x2* dr = (const u32x2*)(DELTA + (size_t)t * D) + lane;
                f32x4 v[8]; float ss = 0.f;
#pragma unroll
                for (int j = 0; j < 8; ++j) { const u32x2 dw = dr[64 * j]; v[j] = xr[64 * j] + (f32x4){bf_lo(dw.x), bf_hi(dw.x), bf_lo(dw.y), bf_hi(dw.y)};
                    ss += (v[j][0] * v[j][0] + v[j][1] * v[j][1]) + (v[j][2] * v[j][2] + v[j][3] * v[j][3]); }
#pragma unroll
                for (int j = 0; j < 8; ++j) { u32x2 w; w.x = cvt_pk_bf16(v[j][0], v[j][1]); w.y = cvt_pk_bf16(v[j][2], v[j][3]); ((u32x2*)(DELTA + (size_t)t * D) + lane)[64 * j] = w; }
                const float rstd = rsqrtf(wave_sum(ss) * (1.0f / D) + NORM_EPS);
#pragma unroll
                for (int j = 0; j < 8; ++j) {
                    const int c = 4 * lane + 256 * j;
                    const f32x4 g = *(const f32x4*)(norm2_g + c), sc = *(const f32x4*)(sc2 + c), sh = *(const f32x4*)(sh2 + c);
                    f32x4 h;
#pragma unroll
                    for (int e = 0; e < 4; ++e) h[e] = v[j][e] * rstd * g[e] * (1.0f + sc[e]) + sh[e];
                    *(LAS f32x4*)(hs + tl * 2048 + c) = h;
                    *(unsigned*)(H8 + (size_t)t * D + c) = pack4_fp8(h[0], h[1], h[2], h[3]);
                }
            }
            __syncthreads();
            {
                LAS float* part = (LAS float*)(lds + 131072);
                const int fr = lane & 15, fq = lane >> 4;
                f32x4 acc0 = (f32x4){0.f, 0.f, 0.f, 0.f}, acc1 = acc0;
                const LAS float* hrow = hs + fr * 2048 + wave * 256 + 4 * fq; const float* wrp = w_router + (size_t)(wave * 256 + 4 * fq) * 32 + fr;
#pragma unroll 2
                for (int i = 0; i < 16; ++i) {
                    const f32x4 a4 = *(const LAS f32x4*)(hrow + 16 * i);
                    float b0[4], b1[4];
#pragma unroll
                    for (int s = 0; s < 4; ++s) { b0[s] = wrp[(size_t)(16 * i + s) * 32]; b1[s] = wrp[(size_t)(16 * i + s) * 32 + 16]; }
#pragma unroll
                    for (int s = 0; s < 4; ++s) { acc0 = __builtin_amdgcn_mfma_f32_16x16x4f32(a4[s], b0[s], acc0, 0, 0, 0); acc1 = __builtin_amdgcn_mfma_f32_16x16x4f32(a4[s], b1[s], acc1, 0, 0, 0); }
                }
#pragma unroll
                for (int r = 0; r < 4; ++r) { part[(wave * 16 + 4 * fq + r) * 32 + fr] = acc0[r]; part[(wave * 16 + 4 * fq + r) * 32 + 16 + fr] = acc1[r]; }
                __syncthreads();
                const int tl = tid >> 5, e = tid & 31, t = grp * 16 + tl;
                float v = b_router[e];
#pragma unroll
                for (int w = 0; w < 8; ++w) v += part[(w * 16 + tl) * 32 + e];
                float tv[4]; int ti[4];
#pragma unroll
                for (int k = 0; k < 4; ++k) {
                    float bv = v; int bi = e;
#pragma unroll
                    for (int o = 16; o >= 1; o >>= 1) { const float ov = __shfl_xor(bv, o); const int oi = __shfl_xor(bi, o); if (ov > bv || (ov == bv && oi < bi)) { bv = ov; bi = oi; } }
                    tv[k] = bv; ti[k] = bi; if (e == bi) v = -__builtin_inff();
                }
                if (e == 0) {
                    const float e1 = __expf(tv[1] - tv[0]), e2 = __expf(tv[2] - tv[0]), e3 = __expf(tv[3] - tv[0]); const float inv = 1.0f / (1.0f + e1 + e2 + e3);
                    *(int4*)(TOPE + (size_t)t * 4) = make_int4(ti[0], ti[1], ti[2], ti[3]);
                    *(f32x4*)(GATE + (size_t)t * 4) = (f32x4){inv, e1 * inv, e2 * inv, e3 * inv};
#pragma unroll
                    for (int k = 0; k < 4; ++k) __hip_atomic_fetch_add((LAS unsigned*)&lcnt[ti[k]], 1u, __ATOMIC_RELAXED, __HIP_MEMORY_SCOPE_WORKGROUP);
                }
            }
            __syncthreads();
        }
        if (tid < 32) { const unsigned c = lcnt[tid]; if (c) __hip_atomic_fetch_add(ctl + CW_CNT + tid, c, __ATOMIC_RELAXED, __HIP_MEMORY_SCOPE_AGENT); }
    }
    SEAM(PH_ROUTER);

    if (IN(PH_SCATTER)) {
        volatile LAS unsigned* lcnt = MISC + 32; volatile LAS unsigned* lbase = MISC + 64; LAS int* pstart = (LAS int*)(lds + 1024); LAS int* pcnt = (LAS int*)(lds + 1280);
        if (tid == 0) { int p = 0; for (int e = 0; e < NEXP; ++e) { const int c = (int)__hip_atomic_load(ctl + CW_CNT + e, __ATOMIC_RELAXED, __HIP_MEMORY_SCOPE_AGENT); pstart[e] = p; pcnt[e] = c; p += (c + 255) & ~255; } }
        if (tid < 32) lcnt[tid] = 0u;
        __syncthreads();
        if (wg < NEXP) { const int e = wg; for (int s = pstart[e] + pcnt[e] + tid; s < pstart[e] + ((pcnt[e] + 255) & ~255); s += NTHR) TOKS[s] = 0; }
        for (int blk = wg; blk < S / 64; blk += G) {
            int e = 0, lrank = 0;
            if (tid < 256) { e = TOPE[(size_t)blk * 256 + tid]; lrank = (int)__hip_atomic_fetch_add((LAS unsigned*)&lcnt[e], 1u, __ATOMIC_RELAXED, __HIP_MEMORY_SCOPE_WORKGROUP); }
            __syncthreads();
            if (tid < 32) { const unsigned c = lcnt[tid]; lbase[tid] = c ? __hip_atomic_fetch_add(ctl + CW_FILL + tid, c, __ATOMIC_RELAXED, __HIP_MEMORY_SCOPE_AGENT) : 0u; }
            __syncthreads();
            if (tid < 256) { const int slot = pstart[e] + (int)lbase[e] + lrank; SLOT[(size_t)blk * 256 + tid] = slot; TOKS[slot] = blk * 64 + (tid >> 2); }
            __syncthreads();
            if (tid < 32) lcnt[tid] = 0u;
            __syncthreads();
        }
    }
    SEAM(PH_SCATTER);

    if (IN(PH_MOE1) || IN(PH_MOE2)) {
        LAS int* panel_e = (LAS int*)(lds + 131072 + 2048);
        LAS int* npan = (LAS int*)(lds + 131072 + 2048 + 2048);
        __syncthreads();
        if (tid == 0) { int p = 0; for (int e = 0; e < NEXP; ++e) { const int np = (int)((__hip_atomic_load(ctl + CW_CNT + e, __ATOMIC_RELAXED, __HIP_MEMORY_SCOPE_AGENT) + 255u) >> 8); for (int q = 0; q < np; ++q) panel_e[p + q] = e; p += np; } npan[0] = p; }
        __syncthreads();
        const int nPanels = npan[0];
        if (IN(PH_MOE1)) {
            pg8::Gemm g{H8, W1_T, 2048, (size_t)4096 * 2048, TOKS, 0}; pg8::MoeOrder So; So.init(nPanels, 16, G, wg, panel_e);
            pg8::EpiSwiglu E{ACT, b1};
            pg8::gemm_phase<pg8::EpiSwiglu, pg8::MoeOrder, true>(lds, g, So, E);
        }
        SEAM(PH_MOE1);
        if (IN(PH_MOE2)) {
            pg8::Gemm g{ACT, W2_T, 2048, (size_t)2048 * 2048, nullptr, 0}; pg8::MoeOrder So; So.init(nPanels, 8, G, wg, panel_e);
            pg8::EpiBf16 E{YB, 2048, b2, 2048, 1.0f / (W8_SCALE * ACT8_SCALE), 1 << 30, 0};
            pg8::gemm_phase<pg8::EpiBf16, pg8::MoeOrder, true>(lds, g, So, E);
        }
    }
    SEAM(PH_MOE2);

    if (IN(PH_FINAL)) {
        const float* gt2 = MOD + 5 * D;
        const int gw = wg * NWAVES + wave, NGW = G * NWAVES;
        for (int t = gw; t < S; t += NGW) {
            const u32x2* dr = (const u32x2*)(DELTA + (size_t)t * D) + lane;
            f32x4 v[8];
#pragma unroll
            for (int j = 0; j < 8; ++j) { const u32x2 dw = dr[64 * j]; v[j] = (f32x4){bf_lo(dw.x), bf_hi(dw.x), bf_lo(dw.y), bf_hi(dw.y)}; }
            {
                f32x4 m[8];
#pragma unroll
                for (int j = 0; j < 8; ++j) m[j] = (f32x4){0.f, 0.f, 0.f, 0.f};
                const int4 sl = *(const int4*)(SLOT + (size_t)t * 4); const f32x4 gt = *(const f32x4*)(GATE + (size_t)t * 4);
                const int sls[4] = {sl.x, sl.y, sl.z, sl.w};
#pragma unroll
                for (int k = 0; k < 4; ++k) {
                    const u32x2* yr = (const u32x2*)(YB + (size_t)sls[k] * D) + lane; const float gk = gt[k];
#pragma unroll
                    for (int j = 0; j < 8; ++j) { const u32x2 w = yr[64 * j]; m[j][0] += gk * bf_lo(w.x); m[j][1] += gk * bf_hi(w.x); m[j][2] += gk * bf_lo(w.y); m[j][3] += gk * bf_hi(w.y); }
                }
#pragma unroll
                for (int j = 0; j < 8; ++j) { const f32x4 g2 = *(const f32x4*)(gt2 + 4 * lane + 256 * j); v[j] = v[j] + g2 * m[j]; }
            }
            float ss = 0.f;
#pragma unroll
            for (int j = 0; j < 8; ++j) ss += (v[j][0] * v[j][0] + v[j][1] * v[j][1]) + (v[j][2] * v[j][2] + v[j][3] * v[j][3]);
            const float rstd = rsqrtf(wave_sum(ss) * (1.0f / D) + NORM_EPS);
            f32x4* orow = (f32x4*)(out + (size_t)t * D) + lane;
#pragma unroll
            for (int j = 0; j < 8; ++j) { const f32x4 fg = *(const f32x4*)(final_g + 4 * lane + 256 * j); orow[64 * j] = v[j] * rstd * fg; }
        }
    }
#undef IN
#undef SEAM
}

#ifndef MK_ONE_LAUNCH
#define MK_ONE_LAUNCH 1
#endif
extern "C" void kernel_launch(void* const* d_in, const int* in_sizes, int n_in, void* d_out, int out_size, void* d_ws, size_t ws_size, hipStream_t stream) {
    static int grid = 0;
    if (grid == 0) {
        if (n_in != 22 || out_size != S * D || ws_size < WS_END) { fprintf(stderr, "kernel_launch: unexpected shapes: n_in %d out %d ws %zu (need %zu)\n", n_in, out_size, ws_size, (size_t)WS_END); grid = -1; return; }
        int dev = 0, cus = 0, per_cu = 0;
        if (hipGetDevice(&dev) != hipSuccess || hipDeviceGetAttribute(&cus, hipDeviceAttributeMultiprocessorCount, dev) != hipSuccess) { grid = -1; return; }
        if (hipFuncSetAttribute((const void*)fwd_kernel, hipFuncAttributeMaxDynamicSharedMemorySize, LDS_BYTES) != hipSuccess) { fprintf(stderr, "kernel_launch: hipFuncSetAttribute failed\n"); grid = -1; return; }
        if (hipOccupancyMaxActiveBlocksPerMultiprocessor(&per_cu, (const void*)fwd_kernel, NTHR, LDS_BYTES) != hipSuccess || per_cu < 1) { fprintf(stderr, "kernel_launch: occupancy query says %d\n", per_cu); (void)hipGetLastError(); grid = -1; return; }
        grid = cus;
    }
    if (grid < 0) return;
    (void)in_sizes;
    hipMemsetAsync((char*)d_ws + WS_CTL, 0, CTL_BYTES, stream);
    Args a{};
    for (int i = 0; i < 22; ++i) a.in[i] = d_in[i];
    a.out = (float*)d_out; a.ws = (unsigned char*)d_ws; a.flags = 0; a.pad = 0;
#if MK_ONE_LAUNCH
    a.ph_lo = 0; a.ph_hi = NPH;
    hipLaunchKernelGGL(fwd_kernel, dim3(grid), dim3(NTHR), LDS_BYTES, stream, a);
#else
    for (int p = 0; p < NPH; ++p) { a.ph_lo = p; a.ph_hi = p + 1; hipLaunchKernelGGL(fwd_kernel, dim3(grid), dim3(NTHR), LDS_BYTES, stream, a); }
#endif
}
```

```cpp
#include <hip/hip_runtime.h>
#include <cstdio>
#include <cstdint>

#define GAS __attribute__((address_space(1)))
#define LAS __attribute__((address_space(3)))
typedef unsigned short bf16_t;
typedef short bf16x8 __attribute__((ext_vector_type(8)));
typedef float f32x4 __attribute__((ext_vector_type(4)));
typedef float f32x2 __attribute__((ext_vector_type(2)));
typedef float f32x16 __attribute__((ext_vector_type(16)));
typedef unsigned u32x4 __attribute__((ext_vector_type(4)));
typedef unsigned u32x2 __attribute__((ext_vector_type(2)));
typedef int i32x4 __attribute__((ext_vector_type(4)));
typedef int i32x8 __attribute__((ext_vector_type(8)));
typedef short s16x4 __attribute__((ext_vector_type(4)));
typedef short s16x2 __attribute__((ext_vector_type(2)));
typedef int v2i32 __attribute__((ext_vector_type(2)));

constexpr int S = 16384, D = 2048, DIN = 10832, DINP = 11008, NEXP = 32, DFF = 2048;
constexpr int NWAVES = 8, NTHR = 512;
constexpr int CQ = 0, CK = 1024, CV = 1280, CQI = 1536, CKI = 2560, CWI = 2624, CHQ = 2816, CHF = 3840, CHI = 4864, CHG = 5888, CGA = 6912, CGR = 8960;
constexpr int PMAX = 65536 + NEXP * 256;
constexpr float NORM_EPS = 1e-5f;

constexpr size_t MiB = 1u << 20;
constexpr size_t al256(size_t x) { return (x + 255) & ~(size_t)255; }
constexpr size_t WS_CTL = 0, CTL_BYTES = 1 * MiB;
constexpr size_t WS_MOD = WS_CTL + CTL_BYTES;
constexpr size_t WS_TOPE = WS_MOD + 64 * 1024;
constexpr size_t WS_GATE = WS_TOPE + (size_t)S * 16;
constexpr size_t WS_SLOT = WS_GATE + (size_t)S * 16;
constexpr size_t WS_WIN_T = WS_SLOT + (size_t)S * 16;
constexpr size_t WS_WA_T = WS_WIN_T + (size_t)DINP * D * 2;
constexpr size_t WS_WH_T = WS_WA_T + (size_t)2048 * 1024 * 2;
constexpr size_t WS_WO_T = WS_WH_T + (size_t)2048 * 1024 * 2;
constexpr size_t WS_W1_T = WS_WO_T + (size_t)2048 * 2048 * 2;
constexpr size_t WS_W2_T = WS_W1_T + (size_t)NEXP * 4096 * 2048 * 2;
constexpr size_t WS_H = WS_W2_T + (size_t)NEXP * 2048 * 2048 * 2;
constexpr size_t WS_PROJ = WS_H + (size_t)S * D * 2;
constexpr size_t WS_KI = WS_PROJ + (size_t)S * DINP * 2;
constexpr size_t WS_KC = WS_KI + (size_t)S * 64 * 2;
constexpr size_t WS_VC = WS_KC + (size_t)S * 256 * 2;
constexpr size_t WS_ST = WS_VC + (size_t)S * 256 * 2;
constexpr size_t WS_DC = WS_ST + (size_t)256 * 8 * 128 * 128 * 4;
constexpr size_t WS_SEL = WS_DC + (size_t)256 * 8 * 128 * 4;
constexpr size_t WS_ATT = WS_SEL + (size_t)S * 256 * 4;
constexpr size_t WS_REC = WS_ATT + (size_t)S * 1024 * 2;
constexpr size_t WS_MERGED = WS_REC + (size_t)S * 1024 * 2;
constexpr size_t WS_X1 = WS_MERGED + (size_t)S * 2048 * 2;
constexpr size_t WS_SCORES = WS_X1 + (size_t)S * 2048 * 4;
constexpr size_t WS_XB = WS_SCORES;
constexpr size_t WS_ACT = WS_XB + (size_t)PMAX * 2048 * 2;
constexpr size_t WS_YB = WS_ACT + (size_t)PMAX * 2048 * 2;
constexpr size_t WS_END = WS_SCORES + (size_t)S * S * 4;
static_assert(WS_YB + (size_t)PMAX * 2048 * 2 <= WS_END, "MoE buffers overlay the score matrix");
static_assert(WS_END <= (size_t)4096 * MiB, "workspace");
constexpr int CW_BAR = 4096, CW_CNT = 8192, CW_FILL = 8448;
constexpr size_t WS_TOKS = WS_SEL;

constexpr int LDS_BYTES = 155648;
constexpr int LDS_MISC = LDS_BYTES - 512;

__device__ __forceinline__ unsigned cvt_pk_bf16(float lo, float hi) { unsigned r; asm volatile("v_cvt_pk_bf16_f32 %0, %1, %2" : "=v"(r) : "v"(lo), "v"(hi)); return r; }
__device__ __forceinline__ float bf_lo(unsigned u) { return __uint_as_float(u << 16); }
__device__ __forceinline__ float bf_hi(unsigned u) { return __uint_as_float(u & 0xffff0000u); }
__device__ __forceinline__ float bf2f(bf16_t b) { return __uint_as_float(((unsigned)b) << 16); }
__device__ __forceinline__ float wave_sum(float v) {
#define DPPS(ctrl, rmask) { const int s_ = __builtin_amdgcn_update_dpp(0, __float_as_int(v), ctrl, rmask, 0xF, false); v += __int_as_float(s_); }
    DPPS(0x111, 0xF) DPPS(0x112, 0xF) DPPS(0x114, 0xF) DPPS(0x118, 0xF) DPPS(0x142, 0xA) DPPS(0x143, 0xC)
#undef DPPS
    return __int_as_float(__builtin_amdgcn_readlane(__float_as_int(v), 63));
}
__device__ __forceinline__ float wave_max(float v) {
#define DPPM(ctrl, rmask) { const int o_ = __float_as_int(v); const int s_ = __builtin_amdgcn_update_dpp(o_, o_, ctrl, rmask, 0xF, false); v = fmaxf(v, __int_as_float(s_)); }
    DPPM(0x111, 0xF) DPPM(0x112, 0xF) DPPM(0x114, 0xF) DPPM(0x118, 0xF) DPPM(0x142, 0xA) DPPM(0x143, 0xC)
#undef DPPM
    return __int_as_float(__builtin_amdgcn_readlane(__float_as_int(v), 63));
}
__device__ __forceinline__ float sigmoidf_(float x) { return __builtin_amdgcn_rcpf(1.0f + __expf(-x)); }
__device__ __forceinline__ float siluf_(float x) { return x * __builtin_amdgcn_rcpf(1.0f + __expf(-x)); }
__device__ __forceinline__ unsigned pack4_fp8(float a, float b, float c, float d) { int w = 0; w = __builtin_amdgcn_cvt_pk_fp8_f32(a, b, w, false); w = __builtin_amdgcn_cvt_pk_fp8_f32(c, d, w, true); return (unsigned)w; }
constexpr float W8_SCALE = 64.0f, ACT8_SCALE = 4.0f, MRG8_SCALE = 8.0f, OP8_SCALE = 16.0f;
__device__ __forceinline__ float relu_i(float x) { const int i = __float_as_int(x); return __int_as_float(i > 0 ? i : 0); }
__device__ __forceinline__ void fp8x16_to_bf16(const u32x4& w, u32x4& lo, u32x4& hi) {
    unsigned o[8];
#pragma unroll
    for (int q = 0; q < 4; ++q) { const unsigned wq = w[q]; const f32x2 a = __builtin_amdgcn_cvt_pk_f32_fp8((int)wq, false), b = __builtin_amdgcn_cvt_pk_f32_fp8((int)wq, true);
        o[2 * q] = cvt_pk_bf16(a[0], a[1]); o[2 * q + 1] = cvt_pk_bf16(b[0], b[1]); }
    lo = (u32x4){o[0], o[1], o[2], o[3]}; hi = (u32x4){o[4], o[5], o[6], o[7]};
}
__device__ __forceinline__ unsigned char fp8_1(float x) { return (unsigned char)(__builtin_amdgcn_cvt_pk_fp8_f32(x, x, 0, false) & 0xff); }
#define LDS_WAIT() asm volatile("s_waitcnt lgkmcnt(0)" ::: "memory")
#define VM_WAIT() asm volatile("s_waitcnt vmcnt(0)" ::: "memory")

#define XB_TMO      128
#define XB_XCNT(j)  (256  + 64 * (j))
#define XB_XSUB(j)  (1280 + 64 * (j))
#define XB_XGEN(j)  (2304 + 64 * (j))
#define XB_TOP      3328
#define XB_TOPGEN   3392
#define XCD_BAR_WORDS 3456
#define XB_SPIN_CAP (1u << 22)

__device__ __forceinline__ unsigned xb_ld(unsigned* p)              { return __hip_atomic_load(p, __ATOMIC_RELAXED, __HIP_MEMORY_SCOPE_AGENT); }
__device__ __forceinline__ unsigned xb_add(unsigned* p, unsigned v) { return __hip_atomic_fetch_add(p, v, __ATOMIC_RELAXED, __HIP_MEMORY_SCOPE_AGENT); }
__device__ __forceinline__ unsigned xb_xcc_id() { return (unsigned)__builtin_amdgcn_s_getreg((3 << 11) | 20) & 0xFu; }
#define XB_SPIN(cond, bar) do { unsigned _sp = 0; while (cond) { __builtin_amdgcn_s_sleep(1); \
    if ((++_sp & 255u) == 0u) { if (xb_ld(&(bar)[XB_TMO])) break; if (_sp > XB_SPIN_CAP) { atomicAdd(&(bar)[XB_TMO], 1u); break; } } } } while (0)

struct XcdBarrier { unsigned* bar; unsigned x; volatile LAS unsigned* st; };

__device__ __forceinline__ XcdBarrier xcd_barrier_post(unsigned* bar, volatile LAS unsigned* st) {
    XcdBarrier b; b.bar = bar; b.x = xb_xcc_id(); b.st = st;
    if (threadIdx.x == 0) (void)xb_add(&bar[XB_XCNT(b.x)], 1u);
    return b;
}
__device__ __forceinline__ void xcd_barrier_complete(unsigned* bar, unsigned x, unsigned& nloc, unsigned& nx) {
    const unsigned G = gridDim.x * gridDim.y * gridDim.z;
    unsigned sum, cnt, mine, sp = 0u;
    for (;;) {
        sum = 0u; cnt = 0u; mine = 0u;
#pragma unroll
        for (unsigned j = 0; j < 16; ++j) { const unsigned c = xb_ld(&bar[XB_XCNT(j)]); sum += c; cnt += (c > 0u) ? 1u : 0u; mine = (j == x) ? c : mine; }
        if (sum == G) break;
        __builtin_amdgcn_s_sleep(1);
        if ((++sp & 255u) == 0u) { if (xb_ld(&bar[XB_TMO])) break; if (sp > XB_SPIN_CAP) { atomicAdd(&bar[XB_TMO], 1u); break; } }
    }
    nloc = mine > 0u ? mine : 1u; nx = cnt > 0u ? cnt : 1u;
}
__device__ __forceinline__ void xcd_barrier(const XcdBarrier& b) {
    asm volatile("s_waitcnt vmcnt(0)" ::: "memory");
    __syncthreads();
    if (threadIdx.x == 0) {
        unsigned* bar = b.bar;
        __builtin_amdgcn_s_waitcnt(0);
        unsigned nloc = b.st[0], nx = b.st[1];
        if (nloc == 0u) { xcd_barrier_complete(bar, b.x, nloc, nx); b.st[0] = nloc; b.st[1] = nx; }
        const unsigned old = xb_add(&bar[XB_XSUB(b.x)], 1u);
        const unsigned gen = old / nloc;
        if (old + 1u == (gen + 1u) * nloc) {
            __builtin_amdgcn_fence(__ATOMIC_RELEASE, "agent");
            asm volatile("s_waitcnt vmcnt(0)" ::: "memory");
            const unsigned og = xb_add(&bar[XB_TOP], 1u);
            const unsigned tg = og / nx;
            if (og + 1u == (tg + 1u) * nx) xb_add(&bar[XB_TOPGEN], 1u);
            else XB_SPIN(xb_ld(&bar[XB_TOPGEN]) == tg, bar);
            __builtin_amdgcn_fence(__ATOMIC_ACQUIRE, "agent");
            xb_add(&bar[XB_XGEN(b.x)], 1u);
            asm volatile("s_waitcnt vmcnt(0)" ::: "memory");
        } else {
            XB_SPIN(xb_ld(&bar[XB_XGEN(b.x)]) == gen, bar);
            __builtin_amdgcn_fence(__ATOMIC_ACQUIRE, "agent");
            asm volatile("s_waitcnt vmcnt(0)" ::: "memory");
        }
    }
    __syncthreads();
}

namespace pg8 {
constexpr int BM = 256, BK = 64, HALF = 128, HTB = HALF * BK * 2, STAGE_BYTES = 8 * HTB, NXCD = 8, WGM = 8;
__host__ __device__ __forceinline__ int lds_byte(int r, int c) { const int st = (r >> 4) * 2 + (c >> 5), rr = r & 15, cc = c & 31, ob = rr * 64 + cc * 2; return st * 1024 + (ob ^ (((ob >> 9) & 1) << 5)); }
__host__ __device__ __forceinline__ void stage_rc(int b, int& R, int& C) { const int st = b / 1024, sb = b % 1024, swz = sb ^ (((sb >> 9) & 1) << 5); R = (st >> 1) * 16 + swz / 64; C = (st & 1) * 32 + (swz % 64) / 2; }
__host__ __device__ __forceinline__ int perm32(int rho) { const int n = rho >> 4, i = rho & 15; return 8 * (i >> 2) + 4 * n + (i & 3); }

struct Unit { int pm, pn, e; };
struct Gemm { const void* A; const void* Bt; int K; size_t estride; const int* arow; size_t astride; };

struct StaticOrder {
    int nM, nN, nwg, G, c, i, full, erank, en;
    __device__ void init(int M, int N, int G_, int c_) { nM = M / BM; nN = N / BM; nwg = nM * nN; G = G_; c = c_; i = 0; full = 1 << 30; erank = -1; en = 1; }
    __device__ void skew(int full_, int erank_, int en_) { full = full_; erank = erank_; en = en_; }
    __device__ bool next(Unit& u) {
        long L;
        if (i < full) L = (long)i * G + c; else { if (erank < 0) return false; L = (long)full * G + (long)(i - full) * en + erank; }
        ++i; if (L >= nwg) return false;
        int wgid = (int)L; { const int q = nwg / NXCD, r = nwg % NXCD, xcd = wgid % NXCD, off = wgid / NXCD; wgid = (xcd < r ? xcd * (q + 1) : r * (q + 1) + (xcd - r) * q) + off; }
        const int nig = WGM * nN, gid = wgid / nig, fm = gid * WGM, gsz = (nM - fm) < WGM ? (nM - fm) : WGM;
        u.pm = fm + ((wgid % nig) % gsz); u.pn = (wgid % nig) / gsz; u.e = 0; return true;
    }
};
struct MoeOrder {
    int nPanels, nN, G, c, i; const LAS int* panel_e;
    __device__ void init(int nPanels_, int nN_, int G_, int c_, const LAS int* pe) { nPanels = nPanels_; nN = nN_; G = G_; c = c_; i = 0; panel_e = pe; }
    __device__ bool next(Unit& u) {
        const int PB = 256 / nN;
        const int nblk = (nPanels + PB - 1) / PB;
        for (;;) {
            const long L = (long)i * G + c; ++i;
            const int blk = (int)(L >> 8), r = (int)(L & 255), x = r & 7, j = r >> 3;
            if (blk >= nblk) return false;
            int pm, pn;
            if (nN == 16) { pm = blk * 16 + 4 * (x >> 1) + (j & 3); pn = 8 * (x & 1) + (j >> 2); }
            else          { pm = blk * 32 + 4 * x + (j & 3);        pn = j >> 2; }
            if (pm < nPanels) { u.pm = pm; u.pn = pn; u.e = panel_e[pm]; return true; }
        }
    }
};

template <class Epi, class Sched, bool FP8 = false>
__device__ __forceinline__ void gemm_phase(LAS unsigned char* lds, const Gemm g, Sched& S, const Epi& E) {
    const int tid = threadIdx.x, wid = __builtin_amdgcn_readfirstlane(tid >> 6), lane = tid & 63, wr = wid >> 2, wc = wid & 3, fr = lane & 15, fq = lane >> 4;
    const int K = g.K; const int pitch = FP8 ? K : 2 * K; const int nt = pitch / 128;
    unsigned voffA[2], voffB[2];
#pragma unroll
    for (int i = 0; i < 2; ++i) { int R, C; stage_rc(tid * 16 + i * 8192, R, C); const int Rb = Epi::PERM ? ((R & ~31) + perm32(R & 31)) : R;
        voffA[i] = (unsigned)(R * pitch + C * 2); voffB[i] = (unsigned)(Rb * pitch + C * 2); }
    const size_t kstep = (size_t)(BK * 2);
    const size_t hstep = (size_t)HALF * pitch;
    const size_t tstep = 2 * hstep;
    int RA[2], CA[2];
#pragma unroll
    for (int i = 0; i < 2; ++i) stage_rc(tid * 16 + i * 8192, RA[i], CA[i]);
    const bool gather = g.arow != nullptr;
    const size_t hsA = gather ? 0 : hstep;
    unsigned vA0[2] = {voffA[0], voffA[1]}, vA1[2] = {voffA[0], voffA[1]}, nA0[2] = {voffA[0], voffA[1]}, nA1[2] = {voffA[0], voffA[1]};
#define PG8_AOFF(dst0, dst1, u) do { if (gather) { _Pragma("unroll") for (int i = 0; i < 2; ++i) { \
        dst0[i] = (unsigned)g.arow[(u).pm * 256 + RA[i]] * (unsigned)pitch + (unsigned)(CA[i] * 2); dst1[i] = (unsigned)g.arow[(u).pm * 256 + 128 + RA[i]] * (unsigned)pitch + (unsigned)(CA[i] * 2); } } } while (0)
    const unsigned ldsw = (unsigned)wid * 1024u;
    const int aoff = lds_byte(wr * 64 + fr, fq * 8), boff = lds_byte(wc * 32 + fr, fq * 8);
#define PG8_SA(b, h) (((b) * 2 + (h)) * HTB)
#define PG8_SB(b, h) ((4 + (b) * 2 + (h)) * HTB)
#define PG8_STAGE(bufoff, gbase, voff) do { _Pragma("unroll") for (int _i = 0; _i < 2; ++_i) \
        __builtin_amdgcn_global_load_lds((const unsigned*)((const char*)(gbase) + (voff)[_i]), (LAS unsigned*)(lds + (bufoff) + ldsw + _i * 8192), 16, 0, 0); } while (0)
#define PG8_LD8(p) __builtin_shufflevector(*(const LAS i32x4*)(p), *(const LAS i32x4*)((p) + 1024), 0, 1, 2, 3, 4, 5, 6, 7)
#define PG8_LDA(dst, b, h) do { _Pragma("unroll") for (int m = 0; m < 4; ++m) { if constexpr (FP8) dst##8[m] = PG8_LD8(lds + PG8_SA(b, h) + aoff + m * 2048); \
        else { _Pragma("unroll") for (int k = 0; k < 2; ++k) dst[m][k] = *(const LAS bf16x8*)(lds + PG8_SA(b, h) + aoff + m * 2048 + k * 1024); } } } while (0)
#define PG8_LDB(dst, b, h) do { _Pragma("unroll") for (int n = 0; n < 2; ++n) { if constexpr (FP8) dst##8[n] = PG8_LD8(lds + PG8_SB(b, h) + boff + n * 2048); \
        else { _Pragma("unroll") for (int k = 0; k < 2; ++k) dst[n][k] = *(const LAS bf16x8*)(lds + PG8_SB(b, h) + boff + n * 2048 + k * 1024); } } } while (0)
#define PG8_MMA(ai, bj, At, Bt) do { __builtin_amdgcn_s_setprio(1); _Pragma("unroll") for (int m = 0; m < 4; ++m) _Pragma("unroll") for (int n = 0; n < 2; ++n) { \
        if constexpr (FP8) asm volatile("v_mfma_scale_f32_16x16x128_f8f6f4 %0, %1, %2, %0, %3, %3 op_sel_hi:[0,0,0]" : "+v"(acc[ai][bj][m][n]) : "v"(Bt##8[n]), "v"(At##8[m]), "v"(scl1)); \
        else { _Pragma("unroll") for (int k = 0; k < 2; ++k) acc[ai][bj][m][n] = __builtin_amdgcn_mfma_f32_16x16x32_bf16(Bt[n][k], At[m][k], acc[ai][bj][m][n], 0, 0, 0); } } \
        __builtin_amdgcn_s_setprio(0); } while (0)
#define PG8_WAIT_V(n) asm volatile("s_waitcnt vmcnt(" #n ")" ::: "memory")
#define PG8_WAIT_L(n) asm volatile("s_waitcnt lgkmcnt(" #n ")" ::: "memory")
#define PG8_BAR __builtin_amdgcn_s_barrier()
#define PG8_SCHED __builtin_amdgcn_sched_barrier(0)
    Unit cur, nxt;
    if (!S.next(cur)) return;
    const unsigned scl1 = 0x7f7f7f7fu;
    f32x4 acc[2][2][4][2];
#pragma unroll
    for (int a = 0; a < 2; ++a)
#pragma unroll
        for (int b = 0; b < 2; ++b)
#pragma unroll
            for (int m = 0; m < 4; ++m)
#pragma unroll
                for (int n = 0; n < 2; ++n) acc[a][b][m][n] = (f32x4){0.f, 0.f, 0.f, 0.f};
    bf16x8 At[4][2], B0[2][2], B1[2][2]; i32x8 At8[4], B08[2], B18[2];
    const char* cA = (const char*)g.A + (size_t)cur.e * g.astride + (gather ? (size_t)0 : (size_t)cur.pm * tstep); const char* cB = (const char*)g.Bt + (size_t)cur.e * g.estride + (size_t)cur.pn * tstep;
    PG8_AOFF(vA0, vA1, cur);
    PG8_STAGE(PG8_SB(0, 0), cB, voffB); PG8_STAGE(PG8_SB(0, 1), cB + hstep, voffB); PG8_STAGE(PG8_SA(0, 0), cA, vA0); PG8_STAGE(PG8_SA(0, 1), cA + hsA, vA1);
    if (wr == 1) PG8_BAR;
    PG8_WAIT_V(2); PG8_BAR;
    PG8_STAGE(PG8_SB(1, 0), cB + kstep, voffB); PG8_STAGE(PG8_SA(1, 0), cA + kstep, vA0); PG8_STAGE(PG8_SB(1, 1), cB + hstep + kstep, voffB);
    PG8_WAIT_V(6); PG8_BAR;
    for (;;) {
        const bool has_next = S.next(nxt);
        const char* nA = has_next ? (const char*)g.A + (size_t)nxt.e * g.astride + (gather ? (size_t)0 : (size_t)nxt.pm * tstep) : cA;
        if (has_next) PG8_AOFF(nA0, nA1, nxt);
        const char* nB = has_next ? (const char*)g.Bt + (size_t)nxt.e * g.estride + (size_t)nxt.pn * tstep : cB;
        for (int t = 0; t < nt; t += 2) {
            const bool last = (t == nt - 2);
            const char* a1 = cA + (size_t)(t + 1) * kstep;
            const char* a2 = last ? nA : cA + (size_t)(t + 2) * kstep; const char* b2 = last ? nB : cB + (size_t)(t + 2) * kstep;
            const char* a3 = a2 + kstep; const char* b3 = b2 + kstep;
            PG8_LDB(B0, 0, 0); PG8_LDB(B1, 0, 1); PG8_SCHED; PG8_LDA(At, 0, 0); PG8_STAGE(PG8_SA(1, 1), a1 + hsA, vA1);
            if (last && has_next) { vA0[0] = nA0[0]; vA0[1] = nA0[1]; vA1[0] = nA1[0]; vA1[1] = nA1[1]; }
            PG8_WAIT_V(8); PG8_WAIT_L(0); PG8_BAR; PG8_MMA(0, 0, At, B0); PG8_MMA(0, 1, At, B1); PG8_BAR; PG8_SCHED;
            PG8_LDA(At, 0, 1); PG8_STAGE(PG8_SB(0, 0), b2, voffB); PG8_STAGE(PG8_SB(0, 1), b2 + hstep, voffB); PG8_STAGE(PG8_SA(0, 0), a2, vA0);
            PG8_WAIT_V(8); PG8_WAIT_L(0); PG8_BAR; PG8_MMA(1, 0, At, B0); PG8_MMA(1, 1, At, B1); PG8_BAR; PG8_SCHED;
            PG8_LDB(B0, 1, 0); PG8_LDB(B1, 1, 1); PG8_SCHED; PG8_LDA(At, 1, 0); PG8_STAGE(PG8_SA(0, 1), a2 + hsA, vA1);
            PG8_WAIT_V(8); PG8_WAIT_L(0); PG8_BAR; PG8_MMA(0, 0, At, B0); PG8_MMA(0, 1, At, B1); PG8_BAR; PG8_SCHED;
            PG8_LDA(At, 1, 1); PG8_STAGE(PG8_SB(1, 0), b3, voffB); PG8_STAGE(PG8_SB(1, 1), b3 + hstep, voffB); PG8_STAGE(PG8_SA(1, 0), a3, vA0);
            PG8_WAIT_V(8); PG8_WAIT_L(0); PG8_BAR; PG8_MMA(1, 0, At, B0); PG8_MMA(1, 1, At, B1); PG8_BAR; PG8_SCHED;
        }
        if (wr == 0) PG8_BAR;
        if constexpr (FP8) {
#pragma unroll
            for (int a = 0; a < 2; ++a)
#pragma unroll
                for (int b = 0; b < 2; ++b) asm volatile("s_nop 15" : "+v"(acc[a][b][0][0]), "+v"(acc[a][b][0][1]), "+v"(acc[a][b][1][0]), "+v"(acc[a][b][1][1]), "+v"(acc[a][b][2][0]), "+v"(acc[a][b][2][1]), "+v"(acc[a][b][3][0]), "+v"(acc[a][b][3][1]));
        }
        const bool keep_acc = E(acc, cur, wr, wc, fr, fq);
        if (!has_next) break;
        if (!keep_acc)
#pragma unroll
        for (int a = 0; a < 2; ++a)
#pragma unroll
            for (int b = 0; b < 2; ++b)
#pragma unroll
                for (int m = 0; m < 4; ++m)
#pragma unroll
                    for (int n = 0; n < 2; ++n) acc[a][b][m][n] = (f32x4){0.f, 0.f, 0.f, 0.f};
        cur = nxt; cA = nA; cB = nB;
        if (wr == 1) PG8_BAR;
    }
    PG8_WAIT_V(0);
    PG8_BAR;
#undef PG8_AOFF
#undef PG8_SA
#undef PG8_SB
#undef PG8_STAGE
#undef PG8_LDA
#undef PG8_LDB
#undef PG8_MMA
#undef PG8_LD8
#undef PG8_WAIT_V
#undef PG8_WAIT_L
#undef PG8_BAR
#undef PG8_SCHED
}

struct EpiBf16 {
    static constexpr bool PERM = true;
    bf16_t* O; int ldc; const float* bias; int bias_estride; float ascale; int skip_from, skip_cols;
    __device__ __forceinline__ bool operator()(const f32x4 (&acc)[2][2][4][2], const Unit& u, int wr, int wc, int fr, int fq) const {
        const int row0 = u.pm * BM + wr * 64 + fr; const int col0 = u.pn * BM + wc * 32 + 8 * fq + (u.pn >= skip_from ? skip_cols : 0);
        f32x4 bv[2][2];
#pragma unroll
        for (int bj = 0; bj < 2; ++bj)
#pragma unroll
            for (int n = 0; n < 2; ++n) bv[bj][n] = bias ? *(const f32x4*)(bias + (size_t)u.e * bias_estride + col0 + bj * HALF + 4 * n) : (f32x4){0.f, 0.f, 0.f, 0.f};
#pragma unroll
        for (int ai = 0; ai < 2; ++ai)
#pragma unroll
            for (int m = 0; m < 4; ++m) { bf16_t* rowp = O + (size_t)(row0 + ai * HALF + m * 16) * ldc + col0;
#pragma unroll
                for (int bj = 0; bj < 2; ++bj) { const f32x4 v0 = acc[ai][bj][m][0] * ascale + bv[bj][0], v1 = acc[ai][bj][m][1] * ascale + bv[bj][1];
                    u32x4 w; w.x = cvt_pk_bf16(v0[0], v0[1]); w.y = cvt_pk_bf16(v0[2], v0[3]); w.z = cvt_pk_bf16(v1[0], v1[1]); w.w = cvt_pk_bf16(v1[2], v1[3]);
                    *(u32x4*)(rowp + bj * HALF) = w; } }
        return false;
    }
};
__device__ __forceinline__ float swiglu1(float ug, float ul) {
    ug = fminf(ug, 7.0f); ul = fminf(fmaxf(ul, -7.0f), 7.0f);
    return ug * __builtin_amdgcn_rcpf(1.0f + __expf(-1.702f * ug)) * (ul + 1.0f);
}
struct EpiSwiglu {
    static constexpr bool PERM = true;
    unsigned char* O; const float* b1;
    __device__ __forceinline__ bool operator()(const f32x4 (&acc)[2][2][4][2], const Unit& u, int wr, int wc, int fr, int fq) const {
        const int row0 = u.pm * BM + wr * 64 + fr; const int c0 = u.pn * 128 + wc * 32 + 8 * fq;
        const float* bg = b1 + (size_t)u.e * 4096 + c0; const float* bl = bg + 2048;
        f32x4 bgv[2], blv[2];
#pragma unroll
        for (int n = 0; n < 2; ++n) { bgv[n] = *(const f32x4*)(bg + 4 * n); blv[n] = *(const f32x4*)(bl + 4 * n); }
#pragma unroll
        for (int ai = 0; ai < 2; ++ai)
#pragma unroll
            for (int m = 0; m < 4; ++m) {
                float a[8];
#pragma unroll
                for (int n = 0; n < 2; ++n)
#pragma unroll
                    for (int j = 0; j < 4; ++j) a[4 * n + j] = ACT8_SCALE * swiglu1(acc[ai][0][m][n][j] * (1.0f / W8_SCALE) + bgv[n][j], acc[ai][1][m][n][j] * (1.0f / W8_SCALE) + blv[n][j]);
                u32x2 w; w.x = pack4_fp8(a[0], a[1], a[2], a[3]); w.y = pack4_fp8(a[4], a[5], a[6], a[7]);
                *(u32x2*)(O + (size_t)(row0 + ai * HALF + m * 16) * 2048 + c0) = w;
            }
        return false;
    }
};

struct TwoPartOrder {
    StaticOrder so; Unit held; int part;
    __device__ void init(int M, int N, int G_, int c_) { so.init(M, N, G_, c_); part = 0; }
    __device__ bool next(Unit& u) { if (part == 1) { u = held; u.e = 1; part = 0; return true; } if (!so.next(held)) return false; u = held; u.e = 0; part = 1; return true; }
};
struct EpiGate2 {
    static constexpr bool PERM = true;
    unsigned char* O; const bf16_t* Ga; const bf16_t* Gr;
    __device__ __forceinline__ bool operator()(f32x4 (&acc)[2][2][4][2], const Unit& u, int wr, int wc, int fr, int fq) const {
        const int row0 = u.pm * BM + wr * 64 + fr; const int col0 = u.pn * BM + wc * 32 + 8 * fq;
#pragma unroll
        for (int ai = 0; ai < 2; ++ai)
#pragma unroll
            for (int m = 0; m < 4; ++m) { const size_t row = (size_t)(row0 + ai * HALF + m * 16);
#pragma unroll
                for (int bj = 0; bj < 2; ++bj) { const int c = col0 + bj * HALF;
                    const u32x4 gr = *(const u32x4*)(Gr + row * DINP + c);
                    if (u.e == 0) {
                        const u32x4 ga = *(const u32x4*)(Ga + row * DINP + c);
#pragma unroll
                        for (int q = 0; q < 4; ++q) {
                            const float r0 = (1.0f + __expf(-bf_lo(gr[q]))) * __builtin_amdgcn_rcpf(1.0f + __expf(-bf_lo(ga[q]))), r1 = (1.0f + __expf(-bf_hi(gr[q]))) * __builtin_amdgcn_rcpf(1.0f + __expf(-bf_hi(ga[q])));
                            acc[ai][bj][m][q >> 1][(2 * q) & 3] *= r0; acc[ai][bj][m][q >> 1][(2 * q + 1) & 3] *= r1; }
                    } else {
                        float r[8];
#pragma unroll
                        for (int q = 0; q < 4; ++q) { r[2 * q] = sigmoidf_(bf_lo(gr[q])) * acc[ai][bj][m][q >> 1][(2 * q) & 3]; r[2 * q + 1] = sigmoidf_(bf_hi(gr[q])) * acc[ai][bj][m][q >> 1][(2 * q + 1) & 3]; }
                        u32x2 w; constexpr float osc = MRG8_SCALE / (W8_SCALE * OP8_SCALE); w.x = pack4_fp8(r[0] * osc, r[1] * osc, r[2] * osc, r[3] * osc); w.y = pack4_fp8(r[4] * osc, r[5] * osc, r[6] * osc, r[7] * osc);
                        *(u32x2*)(O + row * 2048 + c) = w; } } }
        return u.e == 0;
    }
};
struct EpiDelta {
    static constexpr bool PERM = true;
    const float* gt; bf16_t* DL; float ascale;
    __device__ __forceinline__ bool operator()(const f32x4 (&acc)[2][2][4][2], const Unit& u, int wr, int wc, int fr, int fq) const {
        const int row0 = u.pm * BM + wr * 64 + fr; const int col0 = u.pn * BM + wc * 32 + 8 * fq;
        f32x4 g[2][2];
#pragma unroll
        for (int bj = 0; bj < 2; ++bj)
#pragma unroll
            for (int n = 0; n < 2; ++n) g[bj][n] = *(const f32x4*)(gt + col0 + bj * HALF + 4 * n);
#pragma unroll
        for (int ai = 0; ai < 2; ++ai)
#pragma unroll
            for (int m = 0; m < 4; ++m) { bf16_t* rowp = DL + (size_t)(row0 + ai * HALF + m * 16) * 2048 + col0;
#pragma unroll
                for (int bj = 0; bj < 2; ++bj) { const f32x4 v0 = acc[ai][bj][m][0] * ascale * g[bj][0], v1 = acc[ai][bj][m][1] * ascale * g[bj][1];
                    u32x4 w; w.x = cvt_pk_bf16(v0[0], v0[1]); w.y = cvt_pk_bf16(v0[2], v0[3]); w.z = cvt_pk_bf16(v1[0], v1[1]); w.w = cvt_pk_bf16(v1[2], v1[3]);
                    *(u32x4*)(rowp + bj * HALF) = w; } }
        return false;
    }
};
}

struct Args { const void* in[22]; float* out; unsigned char* ws; int ph_lo, ph_hi, flags, pad; };
constexpr int XCONV = 0, XSCORE = 96;
constexpr int CW_SCQ = 12288, SCP = 5, CW_ATQ = 12352;
enum { PH_PRO = 0, PH_H, PH_INPROJ, PH_POST, PH_SCORE, PH_SELECT, PH_ATTN, PH_OP1, PH_OP2, PH_WOUT, PH_ROUTER, PH_SCATTER, PH_MOE1, PH_MOE2, PH_FINAL, NPH };

__device__ __forceinline__ int dest_row(int mode, int n) {
    if (mode == 1) return n < 2640 ? n : n + 176;
    if (mode == 2) { const int g = n >> 11, c = n & 2047; return (c >> 7) * 256 + g * 128 + (c & 127); }
    return n;
}
__device__ __forceinline__ void convert_item(const float* __restrict__ W, int K, int N, int ld, bf16_t* WT, int mode, int item, int lane, LAS unsigned char* scr) {
    const int nblk = (N + 63) >> 6; const int kb = item / nblk, nb = item - kb * nblk; const int k0 = kb * 128, n0 = nb * 64;
    const int c4 = lane & 15, kr = lane >> 4;
    const bool ok = (n0 + 4 * c4) < N;
    const float* src = W + (size_t)(k0 + 2 * kr) * ld + n0 + 4 * c4;
#pragma unroll 4
    for (int i = 0; i < 16; ++i) {
        f32x4 v0 = (f32x4){0.f, 0.f, 0.f, 0.f}, v1 = v0;
        if (ok) { v0 = *(const f32x4*)(src + (size_t)(8 * i) * ld); v1 = *(const f32x4*)(src + (size_t)(8 * i + 1) * ld); }
        const int kk = 8 * i + 2 * kr;
#pragma unroll
        for (int e = 0; e < 4; ++e) *(LAS unsigned*)(scr + (4 * c4 + e) * 272 + kk * 2) = cvt_pk_bf16(v0[e], v1[e]);
    }
    LDS_WAIT(); asm volatile("" ::: "memory");
#pragma unroll 4
    for (int j = 0; j < 16; ++j) {
        const int q = j * 64 + lane, n = q >> 4, ch = q & 15;
        const u32x4 v = *(const LAS u32x4*)(scr + n * 272 + ch * 16);
        if (n0 + n < N) *(u32x4*)(WT + (size_t)dest_row(mode, n0 + n) * K + k0 + ch * 8) = v;
    }
    LDS_WAIT(); asm volatile("" ::: "memory");
}


__device__ __forceinline__ bf16_t f2bf(float f) { unsigned u = __float_as_uint(f); return (bf16_t)((u + 0x7fffu + ((u >> 16) & 1u)) >> 16); }
__device__ __forceinline__ float bfx(const u32x4& w, int i) { const unsigned u = w[i >> 1]; return (i & 1) ? bf_hi(u) : bf_lo(u); }
__device__ __forceinline__ void rope_sc(float pos, float inv, float& sn, float& cs) {
    const float ang = pos * inv;
    const double a = (double)ang; const double n = __builtin_rint(a * 0.15915494309189535); const float r = (float)(a - n * 6.283185307179586);
    sn = __sinf(r); cs = __cosf(r);
}
__device__ __forceinline__ void post_token(bf16_t* PROJ, bf16_t* KI, unsigned char* KC, unsigned char* VC, const int* positions, const float* kng, const float* knb, float inv16, float inv8, int t, int lane) {
    const float pos = (float)positions[t];
    bf16_t* row = PROJ + (size_t)t * DINP;
    float sn, cs, sn8, cs8;
    rope_sc(pos, inv16, sn, cs); rope_sc(pos, inv8, sn8, cs8);
#pragma unroll
    for (int i = 0; i < 2; ++i) {
        const int pp = lane + 64 * i, hd = pp >> 4, ii = pp & 15;
        bf16_t* p = row + CQ + hd * 128 + ii; const float a = bf2f(p[0]), b = bf2f(p[16]);
        p[0] = f2bf(a * cs - b * sn); p[16] = f2bf(b * cs + a * sn);
    }
#pragma unroll
    for (int i = 0; i < 2; ++i) {
        const int pp = lane + 64 * i, hd = pp >> 3, ii = pp & 7;
        bf16_t* p = row + CQI + hd * 64 + ii; const float a = bf2f(p[0]), b = bf2f(p[8]);
        p[0] = f2bf(a * cs8 - b * sn8); p[8] = f2bf(b * cs8 + a * sn8);
    }
    if (lane < 32) {
        const int g = lane >> 4, ii = lane & 15;
        const bf16_t* p = row + CK + g * 128 + ii; const float a = bf2f(p[0]), b = bf2f(p[16]);
        unsigned char* o = KC + (size_t)t * 256 + g * 128 + ii; o[0] = fp8_1(a * cs - b * sn); o[16] = fp8_1(b * cs + a * sn);
    }
#pragma unroll
    for (int i = 0; i < 3; ++i) { const int idx = lane + 64 * i, g = idx / 96, r = idx - g * 96; KC[(size_t)t * 256 + g * 128 + 32 + r] = fp8_1(bf2f(row[CK + g * 128 + 32 + r])); }
    { const u32x2 w = *(const u32x2*)(row + CV + 4 * lane); *(unsigned*)(VC + (size_t)t * 256 + 4 * lane) = pack4_fp8(bf_lo(w.x), bf_hi(w.x), bf_lo(w.y), bf_hi(w.y)); }
    {
        const float v = bf2f(row[CKI + lane]);
        const float mean = wave_sum(v) * (1.0f / 64.0f); const float d = v - mean; const float var = wave_sum(d * d) * (1.0f / 64.0f);
        const float y = d * rsqrtf(var + NORM_EPS) * kng[lane] + knb[lane];
        const float other = __shfl_xor(y, 8);
        float o = y;
        if (lane < 8) o = y * cs8 - other * sn8; else if (lane < 16) o = y * cs8 + other * sn8;
        KI[(size_t)t * 64 + lane] = f2bf(o);
    }
}

constexpr int HG_GB = 0, HG_Q1 = 33792, HG_Q2 = 51200, HG_K2 = 68608, HG_VT = 86016, HG_PB = 104448, HG_LB = 113664;
__device__ __forceinline__ void hgrn_cumsum(LAS unsigned char* lds, const u32x4& w0, const u32x4& w1, float l0, float l1, int tid) {
    LAS float* GB = (LAS float*)(lds + HG_GB); LAS float* LB = (LAS float*)(lds + HG_LB); LAS float* SEG = (LAS float*)(lds + HG_LB + 512);
    if (tid < 128) LB[tid] = 1.0f / (1.0f + expf(l1 - l0));
    __syncthreads();
    const int t = tid >> 3, dseg = tid & 7;
#pragma unroll
    for (int i = 0; i < 16; ++i) { const float z = i < 8 ? bfx(w0, i) : bfx(w1, i - 8); const float lb = LB[16 * dseg + i]; GB[t * 128 + 16 * dseg + i] = __logf(lb + (1.0f - lb) * sigmoidf_(z)); }
    __syncthreads();
    const int d = tid & 127, tq = tid >> 7;
    float z[16];
#pragma unroll
    for (int i = 0; i < 16; ++i) z[i] = GB[(16 * tq + i) * 128 + d];
    float a = 0.f;
#pragma unroll
    for (int i = 0; i < 16; ++i) { a += z[i]; z[i] = a; }
    SEG[tq * 128 + d] = a;
    __syncthreads();
    float pre = 0.f;
    for (int q = 0; q < tq; ++q) pre += SEG[q * 128 + d];
#pragma unroll
    for (int i = 0; i < 16; ++i) GB[(16 * tq + i) * 128 + d] = z[i] + pre;
    __syncthreads();
}
__device__ __forceinline__ void hgrn_vt(LAS unsigned char* lds, const u32x4& a, const u32x4& b, int tid) {
    const int s2 = tid & 31, eg = tid >> 5;
#pragma unroll
    for (int i = 0; i < 8; ++i) { const unsigned lo = (i & 1) ? (a[i >> 1] >> 16) : (a[i >> 1] & 0xffffu), hi = (i & 1) ? (b[i >> 1] >> 16) : (b[i >> 1] & 0xffffu);
        *(LAS unsigned*)(lds + HG_VT + (8 * eg + i) * 144 + s2 * 4) = lo | (hi << 16); }
}
__device__ __forceinline__ void hgrn_l1(LAS unsigned char* lds, const bf16_t* PROJ, const float* lb_logits, bf16_t* ST, float* DC, int c, int h, int tid, int wave, int lane) {
    const int t = tid >> 3, dseg = tid & 7, s2 = tid & 31, dg = tid >> 5;
    const bf16_t* pf = PROJ + (size_t)(c * 64 + t) * DINP + CHF + h * 128 + 16 * dseg;
    const bf16_t* pk = PROJ + (size_t)(c * 64 + 2 * s2) * DINP + CHF + h * 128 + 8 * dg;
    const u32x4 w0 = *(const u32x4*)pf, w1 = *(const u32x4*)(pf + 8);
    const u32x4 ka = *(const u32x4*)pk, kb = *(const u32x4*)(pk + DINP);
    const u32x4 va = *(const u32x4*)(pk - CHF + CHI), vb = *(const u32x4*)(pk - CHF + CHI + DINP);
    const float l0 = lb_logits[h * 128 + (tid & 127)], l1 = lb_logits[1024 + h * 128 + (tid & 127)];
    hgrn_cumsum(lds, w0, w1, l0, l1, tid);
    const LAS float* GB = (const LAS float*)(lds + HG_GB); const LAS float* LB = (const LAS float*)(lds + HG_LB);
    {
#pragma unroll
        for (int i = 0; i < 8; ++i) { const int d = 8 * dg + i; const float lb = LB[d], b63 = GB[63 * 128 + d];
            const float k0 = (1.0f - lb) * (1.0f - sigmoidf_(bfx(ka, i))), k1 = (1.0f - lb) * (1.0f - sigmoidf_(bfx(kb, i)));
            const float v0 = k0 * __expf(b63 - GB[(2 * s2) * 128 + d]), v1 = k1 * __expf(b63 - GB[(2 * s2 + 1) * 128 + d]);
            *(LAS unsigned*)(lds + HG_Q1 + d * 144 + s2 * 4) = cvt_pk_bf16(v0, v1); }
    }
    hgrn_vt(lds, va, vb, tid);
    __syncthreads();
    const int fr = lane & 15, fq = lane >> 4;
    bf16x8 af[2];
#pragma unroll
    for (int ks = 0; ks < 2; ++ks) af[ks] = *(const LAS bf16x8*)(lds + HG_VT + (16 * wave + fr) * 144 + (32 * ks + 8 * fq) * 2);
    bf16_t* dst = ST + ((size_t)(c * 8 + h) * 128) * 128;
#pragma unroll 2
    for (int dt = 0; dt < 8; ++dt) {
        f32x4 acc = (f32x4){0.f, 0.f, 0.f, 0.f};
#pragma unroll
        for (int ks = 0; ks < 2; ++ks) { const bf16x8 bfr = *(const LAS bf16x8*)(lds + HG_Q1 + (16 * dt + fr) * 144 + (32 * ks + 8 * fq) * 2); acc = __builtin_amdgcn_mfma_f32_16x16x32_bf16(af[ks], bfr, acc, 0, 0, 0); }
#pragma unroll
        for (int r = 0; r < 4; ++r) dst[(size_t)(16 * wave + 4 * fq + r) * 128 + 16 * dt + fr] = f2bf(acc[r]);
    }
    if (tid < 128) DC[(size_t)(c * 8 + h) * 128 + tid] = __expf(GB[63 * 128 + tid]);
    __syncthreads();
}
__device__ __forceinline__ void hgrn_l3(LAS unsigned char* lds, const bf16_t* PROJ, const float* lb_logits, const bf16_t* ST, const float* norm_g, unsigned char* REC, int c, int h, int tid, int wave, int lane) {
    const int t = tid >> 3, dseg = tid & 7, s2 = tid & 31, eg = tid >> 5, fr = lane & 15, fq = lane >> 4;
    const bf16_t* pf = PROJ + (size_t)(c * 64 + t) * DINP + CHF + h * 128 + 16 * dseg;
    const u32x4 f0 = *(const u32x4*)pf, f1 = *(const u32x4*)(pf + 8), q0 = *(const u32x4*)(pf - CHF + CHQ), q1 = *(const u32x4*)(pf - CHF + CHQ + 8);
    const u32x4 g0 = *(const u32x4*)(pf - CHF + CHG), g1 = *(const u32x4*)(pf - CHF + CHG + 8);
    const bf16_t* pv = PROJ + (size_t)(c * 64 + 2 * s2) * DINP + CHI + h * 128 + 8 * eg;
    const u32x4 va = *(const u32x4*)pv, vb = *(const u32x4*)(pv + DINP);
    const bf16_t* sp = ST + ((size_t)(c * 8 + h) * 128 + 16 * wave + fr) * 128 + 8 * fq;
    u32x4 sx[4];
#pragma unroll
    for (int ks = 0; ks < 4; ++ks) sx[ks] = *(const u32x4*)(sp + 32 * ks);
    const float l0 = lb_logits[h * 128 + (tid & 127)], l1 = lb_logits[1024 + h * 128 + (tid & 127)];
    hgrn_cumsum(lds, f0, f1, l0, l1, tid);
    const LAS float* GB = (const LAS float*)(lds + HG_GB); const LAS float* LB = (const LAS float*)(lds + HG_LB);
    {
        unsigned o1[8], o2[8], o3[8];
#pragma unroll
        for (int i = 0; i < 16; i += 2) {
            float a1[2], a2[2], a3[2];
#pragma unroll
            for (int j = 0; j < 2; ++j) { const int d = 16 * dseg + i + j; const float lb = LB[d], b = GB[t * 128 + d], br = GB[31 * 128 + d];
                const float z = (i + j) < 8 ? bfx(f0, i + j) : bfx(f1, i + j - 8), qv = (i + j) < 8 ? bfx(q0, i + j) : bfx(q1, i + j - 8);
                const float k = (1.0f - lb) * (1.0f - sigmoidf_(z)), q = siluf_(qv);
                a1[j] = q * __expf(b); a2[j] = q * __expf(b - br); a3[j] = k * __expf(br - b); }
            o1[i >> 1] = cvt_pk_bf16(a1[0], a1[1]); o2[i >> 1] = cvt_pk_bf16(a2[0], a2[1]); o3[i >> 1] = cvt_pk_bf16(a3[0], a3[1]);
        }
        LAS u32x4* d1 = (LAS u32x4*)(lds + HG_Q1 + t * 272 + dseg * 32); LAS u32x4* d2 = (LAS u32x4*)(lds + HG_Q2 + t * 272 + dseg * 32); LAS u32x4* d3 = (LAS u32x4*)(lds + HG_K2 + t * 272 + dseg * 32);
        d1[0] = (u32x4){o1[0], o1[1], o1[2], o1[3]}; d1[1] = (u32x4){o1[4], o1[5], o1[6], o1[7]};
        d2[0] = (u32x4){o2[0], o2[1], o2[2], o2[3]}; d2[1] = (u32x4){o2[4], o2[5], o2[6], o2[7]};
        d3[0] = (u32x4){o3[0], o3[1], o3[2], o3[3]}; d3[1] = (u32x4){o3[4], o3[5], o3[6], o3[7]};
    }
    hgrn_vt(lds, va, vb, tid);
    __syncthreads();
#pragma unroll
    for (int q = 0; q < 2; ++q) {
        const int tile = 2 * wave + q, tt = tile >> 2, stl = tile & 3;
        f32x4 acc = (f32x4){0.f, 0.f, 0.f, 0.f};
#pragma unroll
        for (int ks = 0; ks < 4; ++ks) { const bf16x8 a = *(const LAS bf16x8*)(lds + HG_Q2 + (16 * tt + fr) * 272 + (32 * ks + 8 * fq) * 2), b = *(const LAS bf16x8*)(lds + HG_K2 + (16 * stl + fr) * 272 + (32 * ks + 8 * fq) * 2);
            acc = __builtin_amdgcn_mfma_f32_16x16x32_bf16(a, b, acc, 0, 0, 0); }
#pragma unroll
        for (int r = 0; r < 4; ++r) { const int tr_ = 16 * tt + 4 * fq + r, s = 16 * stl + fr; *(LAS bf16_t*)(lds + HG_PB + tr_ * 144 + s * 2) = f2bf(s <= tr_ ? acc[r] : 0.f); }
    }
    __syncthreads();
    {
        bf16x8 b1[2], b2[4];
#pragma unroll
        for (int ks = 0; ks < 2; ++ks) b1[ks] = *(const LAS bf16x8*)(lds + HG_VT + (16 * wave + fr) * 144 + (32 * ks + 8 * fq) * 2);
#pragma unroll
        for (int ks = 0; ks < 4; ++ks) b2[ks] = __builtin_bit_cast(bf16x8, sx[ks]);
        LAS float* OB = (LAS float*)(lds + HG_GB);
#pragma unroll
        for (int tt = 0; tt < 4; ++tt) {
            f32x4 acc = (f32x4){0.f, 0.f, 0.f, 0.f};
#pragma unroll
            for (int ks = 0; ks < 2; ++ks) { const bf16x8 a = *(const LAS bf16x8*)(lds + HG_PB + (16 * tt + fr) * 144 + (32 * ks + 8 * fq) * 2); acc = __builtin_amdgcn_mfma_f32_16x16x32_bf16(a, b1[ks], acc, 0, 0, 0); }
#pragma unroll
            for (int ks = 0; ks < 4; ++ks) { const bf16x8 a = *(const LAS bf16x8*)(lds + HG_Q1 + (16 * tt + fr) * 272 + (32 * ks + 8 * fq) * 2); acc = __builtin_amdgcn_mfma_f32_16x16x32_bf16(a, b2[ks], acc, 0, 0, 0); }
#pragma unroll
            for (int r = 0; r < 4; ++r) OB[(16 * tt + 4 * fq + r) * 132 + 16 * wave + fr] = acc[r];
        }
    }
    __syncthreads();
    {
        const int es = dseg; const LAS float* OB = (const LAS float*)(lds + HG_GB);
        float o[16]; float ss = 0.f;
#pragma unroll
        for (int i = 0; i < 16; ++i) { o[i] = OB[t * 132 + 16 * es + i]; ss += o[i] * o[i]; }
        ss += __shfl_xor(ss, 1); ss += __shfl_xor(ss, 2); ss += __shfl_xor(ss, 4);
        const float rstd = rsqrtf(ss * (1.0f / 128.0f) + NORM_EPS);
        float rv[16];
#pragma unroll
        for (int i = 0; i < 16; ++i) { const float ga = i < 8 ? bfx(g0, i) : bfx(g1, i - 8); rv[i] = o[i] * (rstd * OP8_SCALE) * norm_g[16 * es + i] * siluf_(ga); }
        *(u32x4*)(REC + (size_t)(c * 64 + t) * 1024 + h * 128 + 16 * es) = (u32x4){pack4_fp8(rv[0], rv[1], rv[2], rv[3]), pack4_fp8(rv[4], rv[5], rv[6], rv[7]), pack4_fp8(rv[8], rv[9], rv[10], rv[11]), pack4_fp8(rv[12], rv[13], rv[14], rv[15])};
    }
    __syncthreads();
}

constexpr int SC_KT = 0, SC_SB = 36864, SC_SPITCH = 132;
__device__ __forceinline__ unsigned pk_f16(float a, float b) { return __builtin_bit_cast(unsigned, __builtin_amdgcn_cvt_pkrtz(a, b)); }
__device__ __forceinline__ void score_flush(LAS unsigned char* lds, unsigned short* SCORES, unsigned short* SEGMAX, int t0, int kt, int tid) {
    const LAS float* sb = (const LAS float*)(lds + SC_SB + (kt & 1) * (32 * SC_SPITCH * 4));
    const int row = tid >> 4, seg = tid & 15;
    const f32x4 a = *(const LAS f32x4*)(sb + row * SC_SPITCH + seg * 8), b = *(const LAS f32x4*)(sb + row * SC_SPITCH + seg * 8 + 4);
    unsigned short* dst = SCORES + (size_t)(t0 + row) * S + kt * 128 + seg * 8;
    *(u32x4*)dst = (u32x4){pk_f16(a[0], a[1]), pk_f16(a[2], a[3]), pk_f16(b[0], b[1]), pk_f16(b[2], b[3])};
    const float mx = fmaxf(fmaxf(fmaxf(a[0], a[1]), fmaxf(a[2], a[3])), fmaxf(fmaxf(b[0], b[1]), fmaxf(b[2], b[3])));
    SEGMAX[(size_t)(t0 + row) * 2048 + kt * 16 + seg] = (unsigned short)(pk_f16(mx, mx) & 0xffffu);
}
__device__ __forceinline__ void score_block(LAS unsigned char* lds, const bf16_t* PROJ, const bf16_t* KI, unsigned short* SCORES, unsigned short* SEGMAX, int qb, int kt0, int kt1, int tid, int wave, int lane) {
    const int t0 = qb * 32;
    const int r = lane & 31, hh = lane >> 5;
    bf16x8 Af[2][4]; float wv[2][16]; f32x2 wv2[2][8];
#pragma unroll
    for (int p = 0; p < 2; ++p) {
        const int tq = t0 + 4 * wave + 2 * p + (r >> 4); const bf16_t* qrow = PROJ + (size_t)tq * DINP + CQI + (r & 15) * 64 + 8 * hh;
#pragma unroll
        for (int ks = 0; ks < 4; ++ks) Af[p][ks] = *(const bf16x8*)(qrow + 16 * ks);
#pragma unroll
        for (int qq = 0; qq < 2; ++qq) {
            const bf16_t* wp = PROJ + (size_t)(t0 + 4 * wave + 2 * p + qq) * DINP + CWI + 4 * hh;
            const u32x2 wa = *(const u32x2*)wp, wb = *(const u32x2*)(wp + 8);
            wv[p][8 * qq + 0] = bf_lo(wa.x) * (1.0f / 32.0f); wv[p][8 * qq + 1] = bf_hi(wa.x) * (1.0f / 32.0f); wv[p][8 * qq + 2] = bf_lo(wa.y) * (1.0f / 32.0f); wv[p][8 * qq + 3] = bf_hi(wa.y) * (1.0f / 32.0f);
            wv[p][8 * qq + 4] = bf_lo(wb.x) * (1.0f / 32.0f); wv[p][8 * qq + 5] = bf_hi(wb.x) * (1.0f / 32.0f); wv[p][8 * qq + 6] = bf_lo(wb.y) * (1.0f / 32.0f); wv[p][8 * qq + 7] = bf_hi(wb.y) * (1.0f / 32.0f);
        }
#pragma unroll
        for (int i = 0; i < 8; ++i) wv2[p][i] = (f32x2){wv[p][2 * i], wv[p][2 * i + 1]};
    }
    const u32x2 tagsw = __builtin_amdgcn_permlane32_swap(0u, 1u, false, false); const int qsel = (int)tagsw[0];
    u32x4 stg[2];
#pragma unroll
    for (int i = 0; i < 2; ++i) { const int q = tid + 512 * i; stg[i] = *(const u32x4*)(KI + (size_t)(kt0 * 128 + (q >> 3)) * 64 + (q & 7) * 8); }
#pragma unroll
    for (int i = 0; i < 2; ++i) { const int q = tid + 512 * i; *(LAS u32x4*)(lds + SC_KT + (kt0 & 1) * 18432 + (q >> 3) * 144 + (q & 7) * 16) = stg[i]; }
    __syncthreads();
    for (int kt = kt0; kt < kt1; ++kt) {
        const LAS unsigned char* buf = lds + SC_KT + (kt & 1) * 18432;
        LAS float* sb = (LAS float*)(lds + SC_SB + (kt & 1) * (32 * SC_SPITCH * 4));
        if (kt + 1 < kt1) {
#pragma unroll
            for (int i = 0; i < 2; ++i) { const int q = tid + 512 * i; stg[i] = *(const u32x4*)(KI + (size_t)((kt + 1) * 128 + (q >> 3)) * 64 + (q & 7) * 8); }
        }
        __builtin_amdgcn_sched_barrier(0);
        if (kt > kt0) score_flush(lds, SCORES, SEGMAX, t0, kt - 1, tid);
        {
        f32x16 accP[2], accC[2];
#define SC_MFMA(cb) do { bf16x8 Bf[4]; _Pragma("unroll") for (int ks = 0; ks < 4; ++ks) Bf[ks] = *(const LAS bf16x8*)(buf + (32 * (cb) + r) * 144 + (16 * ks + 8 * hh) * 2); \
            _Pragma("unroll") for (int p = 0; p < 2; ++p) { _Pragma("unroll") for (int i = 0; i < 16; ++i) accC[p][i] = 0.f; \
                _Pragma("unroll") for (int ks = 0; ks < 4; ++ks) accC[p] = __builtin_amdgcn_mfma_f32_32x32x16_bf16(Af[p][ks], Bf[ks], accC[p], 0, 0, 0); } } while (0)
#define SC_RED(acc, cb) do { _Pragma("unroll") for (int p = 0; p < 2; ++p) { f32x2 s0 = {0.f, 0.f}, s1 = {0.f, 0.f}; \
            _Pragma("unroll") for (int reg = 0; reg < 8; reg += 2) { const f32x2 r0 = {relu_i(acc[p][reg]), relu_i(acc[p][reg + 1])}; const f32x2 r1 = {relu_i(acc[p][reg + 8]), relu_i(acc[p][reg + 9])}; \
                s0 = __builtin_elementwise_fma(wv2[p][reg >> 1], r0, s0); s1 = __builtin_elementwise_fma(wv2[p][4 + (reg >> 1)], r1, s1); } \
            const float p0 = s0[0] + s0[1], p1 = s1[0] + s1[1]; \
            const u32x2 sw = __builtin_amdgcn_permlane32_swap(__float_as_uint(p0), __float_as_uint(p1), false, false); \
            sb[(4 * wave + 2 * p + qsel) * SC_SPITCH + 32 * (cb) + r] = __uint_as_float(sw[0]) + __uint_as_float(sw[1]); } } while (0)
#define SC_INTERLEAVE() do { _Pragma("unroll") for (int i = 0; i < 8; ++i) { __builtin_amdgcn_sched_group_barrier(0x008, 1, 0); __builtin_amdgcn_sched_group_barrier(0x002, 8, 0); } } while (0)
        SC_MFMA(0);
        accP[0] = accC[0]; accP[1] = accC[1]; SC_MFMA(1); SC_RED(accP, 0); SC_INTERLEAVE();
        accP[0] = accC[0]; accP[1] = accC[1]; SC_MFMA(2); SC_RED(accP, 1); SC_INTERLEAVE();
        accP[0] = accC[0]; accP[1] = accC[1]; SC_MFMA(3); SC_RED(accP, 2); SC_INTERLEAVE();
        SC_RED(accC, 3);
#undef SC_MFMA
#undef SC_RED
#undef SC_INTERLEAVE
        }
        if (kt + 1 < kt1) {
#pragma unroll
            for (int i = 0; i < 2; ++i) { const int q = tid + 512 * i; *(LAS u32x4*)(lds + SC_KT + ((kt + 1) & 1) * 18432 + (q >> 3) * 144 + (q & 7) * 16) = stg[i]; }
        }
        __syncthreads();
    }
    score_flush(lds, SCORES, SEGMAX, t0, kt1 - 1, tid);
    __syncthreads();
}

template <int NV, bool EXACT, int TOL = 2>
__device__ __forceinline__ float wave_kth(const float (&v)[NV], int K) {
    const float NINF = -__builtin_inff();
    float mx = NINF, mn = __builtin_inff();
#pragma unroll
    for (int j = 0; j < NV; ++j) { mx = fmaxf(mx, v[j]); mn = fminf(mn, v[j] == NINF ? __builtin_inff() : v[j]); }
    mx = wave_max(mx); mn = -wave_max(-mn);
    int c = 0;
#pragma unroll
    for (int j = 0; j < NV; ++j) c += __popcll(__ballot(v[j] >= mx));
    if (c >= K) return mx;
    float lo = mn, hi = mx, tau = mn;
    for (int it = 0; it < 64; ++it) {
        const float mid = 0.5f * (lo + hi);
        if (!(mid > lo && mid < hi)) { tau = lo; break; }
        c = 0;
#pragma unroll
        for (int j = 0; j < NV; ++j) c += __popcll(__ballot(v[j] >= mid));
        if (c == K || (!EXACT && c > K && c <= K + (K >> TOL))) { tau = mid; break; }
        if (c > K) lo = mid; else hi = mid;
        tau = lo;
    }
    return tau;
}
__device__ __forceinline__ float wave_kth16(const float (&v)[16], int K) { return wave_kth<16, true>(v, K); }
__device__ __forceinline__ int lanes_below(unsigned long long mask) { return (int)__builtin_amdgcn_mbcnt_hi((unsigned)(mask >> 32), __builtin_amdgcn_mbcnt_lo((unsigned)mask, 0u)); }
__device__ __forceinline__ float h2f(unsigned short h) { return (float)__builtin_bit_cast(_Float16, h); }
__device__ __forceinline__ float h2f_lo(unsigned u) { return h2f((unsigned short)(u & 0xffffu)); }
__device__ __forceinline__ float h2f_hi(unsigned u) { return h2f((unsigned short)(u >> 16)); }
__device__ __forceinline__ unsigned ge_mask8(const u32x4& v, unsigned T16) {
    unsigned m8 = 0;
#pragma unroll
    for (int w = 0; w < 4; ++w) { const unsigned vw_ = v[w];
        const s16x2 d = __builtin_elementwise_sub_sat(__builtin_bit_cast(s16x2, vw_), __builtin_bit_cast(s16x2, T16));
        const unsigned mm = ~__builtin_bit_cast(unsigned, d); m8 |= (((mm >> 15) & 1u) | ((mm >> 30) & 2u)) << (2 * w); }
    return m8;
}
__device__ __forceinline__ int append_bits(LAS int* list, int cnt, unsigned m8, int base) {
    for (;;) { const bool has = m8 != 0u; const unsigned long long mask = __ballot(has); if (!mask) break;
        const int pos = cnt + lanes_below(mask);
        if (has) { const int k = __builtin_ctz(m8); m8 &= m8 - 1u; if (pos < 1024) list[pos] = base + k; }
        cnt += __popcll(mask); }
    return cnt;
}
__device__ __forceinline__ int append_keys(LAS int* list, int cnt, unsigned m8, int base, const u32x4& v) {
    for (;;) { const bool has = m8 != 0u; const unsigned long long mask = __ballot(has); if (!mask) break;
        const int pos = cnt + lanes_below(mask);
        if (has) { const int k = __builtin_ctz(m8); m8 &= m8 - 1u;
            const unsigned dw = (k & 4) ? ((k & 2) ? v.w : v.z) : ((k & 2) ? v.y : v.x); const unsigned h = (k & 1) ? (dw >> 16) : (dw & 0xffffu);
            if (pos < 1024) list[pos] = (int)((h << 16) | (unsigned)(base + k)); }
        cnt += __popcll(mask); }
    return cnt;
}
__device__ __forceinline__ void select_row(LAS unsigned char* wl, const unsigned short* SCORES, const unsigned short* SEGMAX, int t, int lane) {
    LAS int* selw = (LAS int*)wl; LAS int* segl = (LAS int*)(wl + 1024); LAS int* cidx = (LAS int*)(wl + 5120);
    const float NINF = -__builtin_inff();
    const unsigned short* row = SCORES + (size_t)t * S; const int n = t + 1;
    float c[16]; int N;
    if (n <= 1024) {
#pragma unroll
        for (int j = 0; j < 16; ++j) { const int i = lane + 64 * j; c[j] = i < n ? h2f(row[i]) : NINF; }
        N = -1;
    } else {
        const u32x4 NEG = (u32x4){0xfc00fc00u, 0xfc00fc00u, 0xfc00fc00u, 0xfc00fc00u};
        const unsigned short* smrow = SEGMAX + (size_t)t * 2048; const int nseg = (t >> 3) + 1;
        const bool segpath = nseg >= 512;
        float s[16], s8[8];
        if (!segpath) {
#pragma unroll
            for (int j = 0; j < 16; ++j) { const int i = lane + 64 * j; s[j] = i < (n >> 4) ? h2f(row[16 * i + 7]) : NINF; }
        }
        u32x4 sv[4];
#pragma unroll
        for (int u = 0; u < 4; ++u) { const int e8 = 8 * (lane + 64 * u); sv[u] = (e8 < nseg) ? *(const u32x4*)(smrow + e8) : NEG; }
#pragma unroll
        for (int u = 0; u < 4; ++u) { const int e8 = 8 * (lane + 64 * u); s8[2 * u] = h2f_lo(sv[u].x); s8[2 * u + 1] = (e8 + 4 < nseg) ? h2f_lo(sv[u].z) : NINF; }
        const int m = segpath ? (nseg >> 2) : (n >> 4);
        int K = segpath ? 85 : 26, cnt = 0;
        for (;;) {
            const float tlo = (K >= m) ? NINF : (segpath ? wave_kth<8, false, 3>(s8, K) : wave_kth<16, false, 2>(s, K));
            cnt = 0;
            const int nq = (n + 511) >> 9;
            if (tlo > 0.f) {
                const unsigned T16 = pk_f16(tlo, tlo);
                int ns = 0;
                {
#pragma unroll
                    for (int u = 0; u < 4; ++u) if (512 * u < nseg) { const int e8 = 8 * (lane + 64 * u); unsigned m8 = ge_mask8(sv[u], T16);
                        const int nv = nseg - e8; if (nv < 8) m8 &= nv > 0 ? ((1u << nv) - 1u) : 0u;
                        ns = append_bits(segl, ns, m8, e8); }
                }
                if (ns > 1024) ns = 1024;
                for (int j0 = 0; j0 < ns; j0 += 512) {
                    u32x4 v[8]; int sg[8];
#pragma unroll
                    for (int u = 0; u < 8; ++u) { const int i = j0 + lane + 64 * u; sg[u] = i < ns ? segl[i] : -1; v[u] = sg[u] >= 0 ? *(const u32x4*)(row + 8 * sg[u]) : NEG; }
#pragma unroll
                    for (int u = 0; u < 8; ++u) if (j0 + 64 * u < ns) { const int e = 8 * sg[u]; unsigned m8 = sg[u] >= 0 ? ge_mask8(v[u], T16) : 0u;
                        const int nv = t + 1 - e; if (nv < 8) m8 &= nv > 0 ? ((1u << nv) - 1u) : 0u;
                        cnt = append_keys(cidx, cnt, m8, e, v[u]); }
                }
            } else {
                for (int q0 = 0; q0 < nq; q0 += 4) {
                    u32x4 v[4];
#pragma unroll
                    for (int u = 0; u < 4; ++u) { const int e = 8 * (lane + 64 * (q0 + u)); v[u] = (e <= t) ? *(const u32x4*)(row + e) : (u32x4){0xfc00fc00u, 0xfc00fc00u, 0xfc00fc00u, 0xfc00fc00u}; }
#pragma unroll
                    for (int u = 0; u < 4; ++u) { const int e = 8 * (lane + 64 * (q0 + u));
#pragma unroll
                        for (int k = 0; k < 8; ++k) { const float x = (k & 1) ? h2f_hi(v[u][k >> 1]) : h2f_lo(v[u][k >> 1]);
                            const bool pred = (e + k <= t) && (x >= tlo); const unsigned long long mask = __ballot(pred);
                            if (mask) { const int pos = cnt + lanes_below(mask); const unsigned hb = (k & 1) ? (v[u][k >> 1] >> 16) : (v[u][k >> 1] & 0xffffu);
                                if (pred && pos < 1024) cidx[pos] = (int)((hb << 16) | (unsigned)(e + k)); cnt += __popcll(mask); } } }
                }
            }
            if (cnt >= 256 || K >= m) break;
            K *= 2;
        }
        N = cnt < 1024 ? cnt : 1024;
#pragma unroll
        for (int j = 0; j < 16; ++j) { const int i = lane + 64 * j; c[j] = i < N ? h2f((unsigned short)((unsigned)cidx[i] >> 16)) : NINF; }
    }
    float tau;
    if (N >= 0 && N <= 512) { const float c8[8] = {c[0], c[1], c[2], c[3], c[4], c[5], c[6], c[7]}; tau = wave_kth<8, true>(c8, 256); }
    else tau = wave_kth16(c, 256);
    int base = 0;
#pragma unroll
    for (int j = 0; j < 16; ++j) { const bool pred = c[j] >= tau; const unsigned long long mask = __ballot(pred);
        if (mask) { const int pos = base + lanes_below(mask); if (pred && pos < 256) selw[pos] = (N < 0) ? (lane + 64 * j) : (cidx[lane + 64 * j] & 0xffff); base += __popcll(mask); } }
}

__device__ __forceinline__ void attn_query(LAS unsigned char* wl, const bf16_t* PROJ, const unsigned char* KC, const unsigned char* VC, unsigned char* ATT, int t, int lane) {
    LAS int* selw = (LAS int*)wl; LAS float* L = (LAS float*)(wl + 1024);
    const int nsel = t < 255 ? t + 1 : 256;
    const int fr = lane & 15, fq = lane >> 4;
    constexpr float QS = 8.0f;
    long qh[2][4], ql[2][4];
#pragma unroll
    for (int g = 0; g < 2; ++g)
#pragma unroll
        for (int ks = 0; ks < 4; ++ks) {
            u32x4 z = (u32x4){0u, 0u, 0u, 0u};
            if (fr < 4) z = *(const u32x4*)(PROJ + (size_t)t * DINP + CQ + (4 * g + fr) * 128 + 32 * ks + 8 * fq);
            float qv[8], rv[8];
#pragma unroll
            for (int e = 0; e < 4; ++e) { qv[2 * e] = bf_lo(z[e]) * QS; qv[2 * e + 1] = bf_hi(z[e]) * QS; }
            const unsigned h0 = pack4_fp8(qv[0], qv[1], qv[2], qv[3]), h1 = pack4_fp8(qv[4], qv[5], qv[6], qv[7]);
            rv[0] = qv[0] - __builtin_amdgcn_cvt_f32_fp8((int)h0, 0); rv[1] = qv[1] - __builtin_amdgcn_cvt_f32_fp8((int)h0, 1); rv[2] = qv[2] - __builtin_amdgcn_cvt_f32_fp8((int)h0, 2); rv[3] = qv[3] - __builtin_amdgcn_cvt_f32_fp8((int)h0, 3);
            rv[4] = qv[4] - __builtin_amdgcn_cvt_f32_fp8((int)h1, 0); rv[5] = qv[5] - __builtin_amdgcn_cvt_f32_fp8((int)h1, 1); rv[6] = qv[6] - __builtin_amdgcn_cvt_f32_fp8((int)h1, 2); rv[7] = qv[7] - __builtin_amdgcn_cvt_f32_fp8((int)h1, 3);
            const unsigned l0 = pack4_fp8(rv[0] * 16.0f, rv[1] * 16.0f, rv[2] * 16.0f, rv[3] * 16.0f), l1 = pack4_fp8(rv[4] * 16.0f, rv[5] * 16.0f, rv[6] * 16.0f, rv[7] * 16.0f);
            qh[g][ks] = (long)(((unsigned long long)h1 << 32) | h0); ql[g][ks] = (long)(((unsigned long long)l1 << 32) | l0);
        }
    const float scale = 0.08838834764831845f / QS;
    const int nkt = (nsel + 15) >> 4;
    {
        LAS unsigned char* KT = wl + 9216;
        const int q4_ = lane >> 4, l15_ = lane & 15;
        u32x4 kw[3][4];
#define QK_LOAD(buf, kt) do { _Pragma("unroll") for (int u = 0; u < 4; ++u) { const unsigned off_ = (unsigned)selw[16 * (kt) + 4 * u + q4_] * 256u + 16u * (unsigned)l15_; kw[buf][u] = *(const u32x4*)((const char*)KC + off_); } } while (0)
#define QK_COMP(buf, kt) do { _Pragma("unroll") for (int u = 0; u < 4; ++u) *(LAS u32x4*)(KT + (4 * u + q4_) * 272 + 16 * l15_) = kw[buf][u];     \
        _Pragma("unroll") for (int g = 0; g < 2; ++g) { f32x4 acch = (f32x4){0.f, 0.f, 0.f, 0.f}, accl = (f32x4){0.f, 0.f, 0.f, 0.f}; \
            _Pragma("unroll") for (int ks = 0; ks < 4; ++ks) { const long kf_ = *(const LAS long*)(KT + fr * 272 + g * 128 + 32 * ks + 8 * fq); \
                acch = __builtin_amdgcn_mfma_f32_16x16x32_fp8_fp8(qh[g][ks], kf_, acch, 0, 0, 0); accl = __builtin_amdgcn_mfma_f32_16x16x32_fp8_fp8(ql[g][ks], kf_, accl, 0, 0, 0); } \
            if (fq == 0) { _Pragma("unroll") for (int r = 0; r < 4; ++r) L[(4 * g + r) * 256 + 16 * (kt) + fr] = (16 * (kt) + fr < nsel) ? (acch[r] + accl[r] * 0.0625f) * scale : -__builtin_inff(); } } } while (0)
        QK_LOAD(0, 0); if (1 < nkt) QK_LOAD(1, 1);
        for (int kt = 0; kt < nkt; kt += 3) {
            if (kt + 2 < nkt) QK_LOAD(2, kt + 2);
            __builtin_amdgcn_sched_barrier(0);
            QK_COMP(0, kt);
            if (kt + 1 < nkt) { if (kt + 3 < nkt) QK_LOAD(0, kt + 3); __builtin_amdgcn_sched_barrier(0); QK_COMP(1, kt + 1); }
            if (kt + 2 < nkt) { if (kt + 4 < nkt) QK_LOAD(1, kt + 4); __builtin_amdgcn_sched_barrier(0); QK_COMP(2, kt + 2); }
        }
#undef QK_LOAD
#undef QK_COMP
        if (fq == 0) { for (int kt = nkt; kt < 16; ++kt) {
#pragma unroll
            for (int r = 0; r < 8; ++r) L[r * 256 + 16 * kt + fr] = -__builtin_inff(); } }
    }
    float p[8][4];
#pragma unroll
    for (int hd = 0; hd < 8; ++hd) { float m = -__builtin_inff();
#pragma unroll
        for (int i = 0; i < 4; ++i) { p[hd][i] = L[hd * 256 + 4 * lane + i]; m = fmaxf(m, p[hd][i]); }
        m = wave_max(m); float s = 0.f;
#pragma unroll
        for (int i = 0; i < 4; ++i) { p[hd][i] = __expf(p[hd][i] - m); s += p[hd][i]; }
        s = __builtin_amdgcn_rcpf(wave_sum(s));
#pragma unroll
        for (int i = 0; i < 4; ++i) p[hd][i] *= s; }
    constexpr float PS = 256.0f;
    LAS unsigned* Ph = (LAS unsigned*)(wl + 1024); LAS unsigned* Pl = (LAS unsigned*)(wl + 1024 + 2048);
#pragma unroll
    for (int hd = 0; hd < 8; ++hd) {
        const float a0 = p[hd][0] * PS, a1 = p[hd][1] * PS, a2 = p[hd][2] * PS, a3 = p[hd][3] * PS;
        const unsigned h = pack4_fp8(a0, a1, a2, a3);
        const unsigned l = pack4_fp8(a0 - __builtin_amdgcn_cvt_f32_fp8((int)h, 0), a1 - __builtin_amdgcn_cvt_f32_fp8((int)h, 1), a2 - __builtin_amdgcn_cvt_f32_fp8((int)h, 2), a3 - __builtin_amdgcn_cvt_f32_fp8((int)h, 3));
        Ph[hd * 64 + lane] = h; Pl[hd * 64 + lane] = l;
    }
    LAS unsigned char* VT = wl + 9216;
    const int ii = lane & 15, kq = lane >> 4;
    f32x4 acc[16];
#pragma unroll
    for (int nt = 0; nt < 16; ++nt) acc[nt] = (f32x4){0.f, 0.f, 0.f, 0.f};
    const int nch = (nsel + 15) >> 4;
    u32x4 vw[3][4];
#define PV_LOAD(buf, c) do { _Pragma("unroll") for (int u = 0; u < 4; ++u) { const unsigned off_ = (unsigned)selw[16 * (c) + 4 * u + kq] * 256u + 16u * (unsigned)ii; vw[buf][u] = *(const u32x4*)((const char*)VC + off_); } } while (0)
#define PV_COMP(buf, c) do { _Pragma("unroll") for (int u = 0; u < 4; ++u) { LAS u32x2* d_ = (LAS u32x2*)(VT + (16 * ((c) & 1) + 4 * u + kq) * 264 + 16 * ii); d_[0] = (u32x2){vw[buf][u].x, vw[buf][u].y}; d_[1] = (u32x2){vw[buf][u].z, vw[buf][u].w}; } \
        if (((c) & 1) || (c) == nch - 1) { \
            if (!((c) & 1)) { _Pragma("unroll") for (int u = 0; u < 4; ++u) { LAS u32x2* d_ = (LAS u32x2*)(VT + (16 + 4 * u + kq) * 264 + 16 * ii); d_[0] = (u32x2){0u, 0u}; d_[1] = (u32x2){0u, 0u}; } } \
            long pa[2]; _Pragma("unroll") for (int g = 0; g < 2; ++g) { const int po_ = (g * 4 + (ii & 3)) * 256 + 32 * ((c) >> 1) + 8 * kq;     \
                const long h_ = *(const LAS long*)((const LAS unsigned char*)Ph + po_ + ((ii & 4) ? 2048 : 0)); pa[g] = ii < 8 ? h_ : 0l; } \
            _Pragma("unroll") for (int nt = 0; nt < 16; ++nt) { const v2i32 t_ = __builtin_amdgcn_ds_read_tr8_b64_v2i32((LAS v2i32*)(VT + (8 * kq + (ii >> 1)) * 264 + 16 * nt + 8 * (ii & 1))); \
                const long b_ = __builtin_bit_cast(long, t_); \
                acc[nt] = __builtin_amdgcn_mfma_f32_16x16x32_fp8_fp8(pa[nt >> 3], b_, acc[nt], 0, 0, 0); } } } while (0)
    PV_LOAD(0, 0); if (1 < nch) PV_LOAD(1, 1);
    for (int c = 0; c < nch; c += 3) {
        if (c + 2 < nch) PV_LOAD(2, c + 2);
        __builtin_amdgcn_sched_barrier(0);
        PV_COMP(0, c);
        if (c + 1 < nch) { if (c + 3 < nch) PV_LOAD(0, c + 3); __builtin_amdgcn_sched_barrier(0); PV_COMP(1, c + 1); }
        if (c + 2 < nch) { if (c + 4 < nch) PV_LOAD(1, c + 4); __builtin_amdgcn_sched_barrier(0); PV_COMP(2, c + 2); }
    }
#undef PV_LOAD
#undef PV_COMP
    LAS float* OB = (LAS float*)(wl + 1024 + 4096);
    LAS float* OB2 = (LAS float*)(wl + 1024);
    if (kq < 2) {
        LAS float* ob = kq == 0 ? OB : OB2;
#pragma unroll
        for (int nt = 0; nt < 16; ++nt)
#pragma unroll
            for (int r = 0; r < 4; ++r) ob[(4 * (nt >> 3) + r) * 128 + 16 * (nt & 7) + ii] = acc[nt][r];
    }
    {
        const f32x4 a0 = *(const LAS f32x4*)(OB + 16 * lane) + *(const LAS f32x4*)(OB2 + 16 * lane), a1 = *(const LAS f32x4*)(OB + 16 * lane + 4) + *(const LAS f32x4*)(OB2 + 16 * lane + 4),
                    a2 = *(const LAS f32x4*)(OB + 16 * lane + 8) + *(const LAS f32x4*)(OB2 + 16 * lane + 8), a3 = *(const LAS f32x4*)(OB + 16 * lane + 12) + *(const LAS f32x4*)(OB2 + 16 * lane + 12);
        const f32x4 b0 = a0 * (OP8_SCALE / PS), b1 = a1 * (OP8_SCALE / PS), b2 = a2 * (OP8_SCALE / PS), b3 = a3 * (OP8_SCALE / PS);
        *(u32x4*)(ATT + (size_t)t * 1024 + 16 * lane) = (u32x4){pack4_fp8(b0[0], b0[1], b0[2], b0[3]), pack4_fp8(b1[0], b1[1], b1[2], b1[3]), pack4_fp8(b2[0], b2[1], b2[2], b2[3]), pack4_fp8(b3[0], b3[1], b3[2], b3[3])};
    }
}


__device__ __forceinline__ void convert_item8(const float* __restrict__ W, int K, int N, int ld, unsigned char* WT, int mode, int item, int lane, LAS unsigned char* scr) {
    const int nblk = N >> 6; const int kb = item / nblk, nb = item - kb * nblk; const int k0 = kb * 256, n0 = nb * 64;
    const int c4 = lane & 15, kr = lane >> 4;
    const float* src = W + (size_t)(k0 + 4 * kr) * ld + n0 + 4 * c4;
#pragma unroll 4
    for (int i = 0; i < 16; ++i) {
        f32x4 v[4];
#pragma unroll
        for (int r = 0; r < 4; ++r) v[r] = __builtin_nontemporal_load((const f32x4*)(src + (size_t)(16 * i + r) * ld));
        const int kk = 16 * i + 4 * kr;
#pragma unroll
        for (int e = 0; e < 4; ++e) *(LAS unsigned*)(scr + (4 * c4 + e) * 272 + kk) = pack4_fp8(v[0][e] * W8_SCALE, v[1][e] * W8_SCALE, v[2][e] * W8_SCALE, v[3][e] * W8_SCALE);
    }
    LDS_WAIT(); asm volatile("" ::: "memory");
#pragma unroll 4
    for (int j = 0; j < 16; ++j) {
        const int q = j * 64 + lane, n = q >> 4, ch = q & 15;
        const u32x4 v = *(const LAS u32x4*)(scr + n * 272 + ch * 16);
        *(u32x4*)(WT + (size_t)dest_row(mode, n0 + n) * K + k0 + ch * 16) = v;
    }
    LDS_WAIT(); asm volatile("" ::: "memory");
}

struct Conv8Job { const float* W; unsigned char* WT; int N; int mode; size_t w_estride, wt_estride; int items_per_e; };
constexpr int C8_PITCH = 272, C8_IMG = 256 * C8_PITCH;
__device__ __forceinline__ void conv8_load(const Conv8Job& jb, int item, int h, int wave, int lane, f32x4 (&v)[16]) {
    const int e = item / jb.items_per_e, r = item - e * jb.items_per_e; const int nblk = jb.N >> 8; const int kb = r / nblk, nb = r - kb * nblk;
    const float* src = jb.W + (size_t)e * jb.w_estride + (size_t)(kb * 256 + 32 * wave + 16 * h) * jb.N + nb * 256 + 4 * lane;
#pragma unroll
    for (int i = 0; i < 16; ++i) v[i] = __builtin_nontemporal_load((const f32x4*)(src + (size_t)i * jb.N));
}
__device__ __forceinline__ void conv8_to_lds(LAS unsigned char* img, int h, int wave, int lane, const f32x4 (&v)[16]) {
#pragma unroll
    for (int e = 0; e < 4; ++e) { u32x4 w;
#pragma unroll
        for (int g = 0; g < 4; ++g) w[g] = pack4_fp8(v[4 * g][e] * W8_SCALE, v[4 * g + 1][e] * W8_SCALE, v[4 * g + 2][e] * W8_SCALE, v[4 * g + 3][e] * W8_SCALE);
        *(LAS u32x4*)(img + (4 * lane + e) * C8_PITCH + 32 * wave + 16 * h) = w; }
}
__device__ __forceinline__ void conv8_store(const Conv8Job& jb, int item, const LAS unsigned char* img, int tid) {
    const int e = item / jb.items_per_e, r = item - e * jb.items_per_e; const int nblk = jb.N >> 8; const int kb = r / nblk, nb = r - kb * nblk;
    unsigned char* dst = jb.WT + (size_t)e * jb.wt_estride + kb * 256;
#pragma unroll
    for (int j = 0; j < 8; ++j) { const int q = j * 512 + tid, n = q >> 4, ch = q & 15;
        __builtin_nontemporal_store(*(const LAS u32x4*)(img + n * C8_PITCH + ch * 16), (u32x4*)(dst + (size_t)dest_row(jb.mode, nb * 256 + n) * 2048 + ch * 16)); }
}
__device__ __forceinline__ void conv8_run(LAS unsigned char* lds, const Conv8Job& jb, int n_items, int wg, int G, int tid, int wave, int lane) {
    if (wg >= n_items) return;
    f32x4 a[16], b[16]; int par = 0;
    conv8_load(jb, wg, 0, wave, lane, a); conv8_load(jb, wg, 1, wave, lane, b);
    for (int it = wg; it < n_items; it += G, par ^= 1) {
        LAS unsigned char* img = lds + par * C8_IMG;
        const int nx = (it + G < n_items) ? it + G : it;
        conv8_to_lds(img, 0, wave, lane, a); __builtin_amdgcn_sched_barrier(0);
        conv8_load(jb, nx, 0, wave, lane, a); __builtin_amdgcn_sched_barrier(0);
        conv8_to_lds(img, 1, wave, lane, b); __builtin_amdgcn_sched_barrier(0);
        conv8_load(jb, nx, 1, wave, lane, b); __builtin_amdgcn_sched_barrier(0);
        __syncthreads();
        conv8_store(jb, it, img, tid);
    }
    __syncthreads();
}

__global__ void __launch_bounds__(NTHR, 2) fwd_kernel(Args args) {
    extern __shared__ __attribute__((aligned(16))) unsigned char lds_raw[];
    LAS unsigned char* lds = (LAS unsigned char*)lds_raw;
    volatile LAS unsigned* MISC = (volatile LAS unsigned*)(lds + LDS_MISC);
    const int tid = threadIdx.x, lane = tid & 63, wave = __builtin_amdgcn_readfirstlane(tid >> 6);
    const int G = gridDim.x, wg = blockIdx.x;
    unsigned char* ws = args.ws;
    unsigned* ctl = (unsigned*)(ws + WS_CTL);
    const int lo = args.ph_lo, hi = args.ph_hi;
    const float* x = (const float*)args.in[0]; const float* cvec = (const float*)args.in[1]; const int* positions = (const int*)args.in[2];
    const float* w_ada = (const float*)args.in[3]; const float* b_ada = (const float*)args.in[4]; const float* norm1_g = (const float*)args.in[5];
    const float* w_in = (const float*)args.in[6]; const float* idx_knorm_g = (const float*)args.in[7]; const float* idx_knorm_b = (const float*)args.in[8];
    const float* lb_logits = (const float*)args.in[9]; const float* hgrn_norm_g = (const float*)args.in[10];
    const float* w_proj_att = (const float*)args.in[11]; const float* w_proj_hgrn = (const float*)args.in[12]; const float* w_out = (const float*)args.in[13];
    const float* norm2_g = (const float*)args.in[14]; const float* w_router = (const float*)args.in[15]; const float* b_router = (const float*)args.in[16];
    const float* w1 = (const float*)args.in[17]; const float* b1 = (const float*)args.in[18]; const float* w2 = (const float*)args.in[19]; const float* b2 = (const float*)args.in[20];
    const float* final_g = (const float*)args.in[21];
    float* out = args.out;
    float* MOD = (float*)(ws + WS_MOD); int* TOPE = (int*)(ws + WS_TOPE); float* GATE = (float*)(ws + WS_GATE); int* SLOT = (int*)(ws + WS_SLOT);
    bf16_t* WIN_T = (bf16_t*)(ws + WS_WIN_T); bf16_t* WA_T = (bf16_t*)(ws + WS_WA_T); bf16_t* WH_T = (bf16_t*)(ws + WS_WH_T); bf16_t* WO_T = (bf16_t*)(ws + WS_WO_T);
    unsigned char* WIN_T8 = ws + WS_WIN_T + 8 * MiB;
    unsigned char* HA8 = ws + WS_SCORES;
    unsigned char* W1_T = ws + WS_W1_T; unsigned char* W2_T = ws + WS_W2_T;
    bf16_t* HB = (bf16_t*)(ws + WS_H); bf16_t* PROJ = (bf16_t*)(ws + WS_PROJ);
    bf16_t* DELTA = (bf16_t*)(ws + WS_ATT);
    unsigned char* ACT = ws + WS_ACT; bf16_t* YB = (bf16_t*)(ws + WS_YB);
    int* TOKS = (int*)(ws + WS_TOKS);
    unsigned char* H8 = ws + WS_H;
    bf16_t* KI = (bf16_t*)(ws + WS_KI); unsigned char* KC = ws + WS_KC; unsigned char* VC = ws + WS_VC;
    bf16_t* ST = (bf16_t*)(ws + WS_ST); float* DC = (float*)(ws + WS_DC);
    unsigned char* ATT = ws + WS_ATT; unsigned char* REC = ATT + (size_t)S * 1024;        bf16_t* MERGED = (bf16_t*)(ws + WS_MERGED); unsigned short* SCORES = (unsigned short*)(ws + WS_SCORES);
    unsigned short* SEGMAX = (unsigned short*)(ws + WS_X1);

    for (int u = tid; u < 128; u += NTHR) MISC[u] = 0u;
    __syncthreads();
    const bool one_launch = (hi - lo) > 1;
    XcdBarrier bar; bar.bar = ctl + CW_BAR; bar.x = 0; bar.st = MISC + 8;
    if (one_launch) bar = xcd_barrier_post(ctl + CW_BAR, MISC + 8);
#define IN(k) (lo <= (k) && (k) < hi)
#define SEAM(k) do { if (IN(k) && IN((k) + 1)) xcd_barrier(bar); } while (0)


    if (IN(PH_PRO)) {
        for (int cb = wg; cb < 256; cb += G) {
            LAS float* red = (LAS float*)lds;
            const int c4 = tid % 12, kg = tid / 12;
            f32x4 acc = (f32x4){0.f, 0.f, 0.f, 0.f};
            if (kg < 42) {
                const float* wp = w_ada + (size_t)cb * 48 + 4 * c4;
#pragma unroll 7
                for (int j = 0; j < 49; ++j) { const int k = kg + 42 * j; if (k < D) { const f32x4 v = __builtin_nontemporal_load((const f32x4*)(wp + (size_t)k * (6 * D))); acc += siluf_(cvec[k]) * v; } }
                *(LAS f32x4*)(red + kg * 48 + 4 * c4) = acc;
            }
            __syncthreads();
            if (tid < 48) { float s = b_ada[cb * 48 + tid];
#pragma unroll 6
                for (int q = 0; q < 42; ++q) s += red[q * 48 + tid];
                MOD[cb * 48 + tid] = s; }
            __syncthreads();
        }
        LAS unsigned char* scr = lds + wave * 17408;
        const int gw = wg * NWAVES + wave, NGW = G * NWAVES;
        {
            constexpr int NB_IN = (1104 + 63) / 64;
            for (int it = gw; it < 16 * NB_IN; it += NGW) convert_item(w_in + 1536, 2048, 1104, DIN, WIN_T, 0, it, lane, scr);
            for (int it = gw; it < 4 * 32; it += NGW) convert_item8(w_proj_att, 1024, 2048, 2048, (unsigned char*)WA_T, 0, it, lane, scr);
            for (int it = gw; it < 4 * 32; it += NGW) convert_item8(w_proj_hgrn, 1024, 2048, 2048, (unsigned char*)WA_T + (size_t)2048 * 1024, 0, it, lane, scr);
            for (int it = gw; it < 8 * 32; it += NGW) convert_item8(w_out, 2048, 2048, 2048, (unsigned char*)WO_T, 0, it, lane, scr);
            for (int it = gw; it < 8 * 24; it += NGW) convert_item8(w_in, 2048, 1536, DIN, WIN_T8, 0, it, lane, scr);
            for (int it = gw; it < 8 * 128; it += NGW) convert_item8(w_in + 2640, 2048, 8192, DIN, WIN_T8 + (size_t)1536 * 2048, 0, it, lane, scr);
            for (size_t i = (size_t)wg * NTHR + tid; i < (size_t)176 * 2048 * 2 / 16; i += (size_t)G * NTHR) ((u32x4*)(WIN_T + (size_t)1104 * 2048))[i] = (u32x4){0u, 0u, 0u, 0u};
        }
    }
    SEAM(PH_PRO);

    {
    if (IN(PH_H)) {
        const float* sh1 = MOD; const float* sc1 = MOD + D;
        const int gw = wg * NWAVES + wave, NGW = G * NWAVES;
        f32x4 gs[8], sh[8];
#pragma unroll
        for (int j = 0; j < 8; ++j) { const int c = 4 * lane + 256 * j; const f32x4 g = *(const f32x4*)(norm1_g + c), sc = *(const f32x4*)(sc1 + c); sh[j] = *(const f32x4*)(sh1 + c);
#pragma unroll
            for (int e = 0; e < 4; ++e) gs[j][e] = g[e] * (1.0f + sc[e]); }
        for (int t = gw; t < S; t += NGW) {
            const f32x4* xr = (const f32x4*)(x + (size_t)t * D) + lane;
            f32x4 v[8]; float ss = 0.f;
#pragma unroll
            for (int j = 0; j < 8; ++j) { v[j] = xr[64 * j]; ss += (v[j][0] * v[j][0] + v[j][1] * v[j][1]) + (v[j][2] * v[j][2] + v[j][3] * v[j][3]); }
            const float rstd = rsqrtf(wave_sum(ss) * (1.0f / D) + NORM_EPS);
#pragma unroll
            for (int j = 0; j < 8; ++j) { const f32x4 h = v[j] * rstd * gs[j] + sh[j]; u32x2 w; w.x = cvt_pk_bf16(h[0], h[1]); w.y = cvt_pk_bf16(h[2], h[3]);
                *(u32x2*)(HB + (size_t)t * D + 4 * lane + 256 * j) = w;
                *(unsigned*)(HA8 + (size_t)t * D + 4 * lane + 256 * j) = pack4_fp8(h[0], h[1], h[2], h[3]); }
        }
    }
    SEAM(PH_H);
    if (IN(PH_INPROJ)) {
        const int XC = (G == 256) ? XCONV : 0;
        const Conv8Job j1{w1, W1_T, 4096, 2, (size_t)2048 * 4096, (size_t)4096 * 2048, 8 * 16};
        const Conv8Job j2{w2, W2_T, 2048, 0, (size_t)2048 * 2048, (size_t)2048 * 2048, 8 * 8};
        if (G != 256) { conv8_run(lds, j1, NEXP * 8 * 16, wg, G, tid, wave, lane); conv8_run(lds, j2, NEXP * 8 * 8, wg, G, tid, wave, lane); }
        if (wg < XC) { conv8_run(lds, j1, NEXP * 8 * 16, wg, XC, tid, wave, lane); conv8_run(lds, j2, NEXP * 8 * 8, wg, XC, tid, wave, lane); }
        else {
            const int Gg = G - XC, cg = wg - XC;
            {
                pg8::Gemm g8{HA8, WIN_T8, 2048, 0, nullptr, 0}; pg8::StaticOrder S8; S8.init(S, 9728, Gg, cg);
                const int full8 = 2432 / Gg, rem8 = 2432 - full8 * Gg;
                if (Gg == 256) S8.skew(8, (wg >= 128 && wg < 192) ? -1 : (wg < 128 ? wg : wg - 64), 192);
                else if (rem8 > 0) S8.skew(full8, cg < rem8 ? cg : -1, rem8);
                pg8::EpiBf16 E8{PROJ, DINP, nullptr, 0, 1.0f / W8_SCALE, 6, 1280};
                pg8::gemm_phase<pg8::EpiBf16, pg8::StaticOrder, true>(lds, g8, S8, E8);
            }
            {
                pg8::Gemm g{HB, WIN_T, 2048, 0, nullptr, 0}; pg8::StaticOrder So; So.init(S, 1280, Gg, Gg == 256 ? (wg + 128) % G : (cg + Gg - (2432 % Gg)) % Gg);
                pg8::EpiBf16 E{PROJ + CQI, DINP, nullptr, 0, 1.0f, 1 << 30, 0};
                pg8::gemm_phase<pg8::EpiBf16, pg8::StaticOrder>(lds, g, So, E);
            }
        }
    }
    SEAM(PH_INPROJ);
    if (IN(PH_POST)) {
        const int gw = wg * NWAVES + wave, NGW = G * NWAVES;
        const float inv16 = powf(500000.0f, -(float)(lane & 15) * (1.0f / 16.0f)), inv8 = powf(500000.0f, -(float)(lane & 7) * (1.0f / 8.0f));
        for (int t = gw; t < S; t += NGW) post_token(PROJ, KI, KC, VC, positions, idx_knorm_g, idx_knorm_b, inv16, inv8, t, lane);
        __syncthreads();
        for (int u = wg; u < 2048; u += G) hgrn_l1(lds, PROJ, lb_logits, ST, DC, u >> 3, u & 7, tid, wave, lane);
    }
    SEAM(PH_POST);
    if (IN(PH_SCORE)) {
        for (int idx = wg * NTHR + tid; idx < 8 * 128 * 128; idx += G * NTHR) {
            const int h = idx >> 14, d = idx & 127; float s = 0.f;
            bf16_t* sp = ST + idx; const float* dp = DC + h * 128 + d;
            for (int c = 0; c < 256; c += 16) {
                float l[16], dc[16];
#pragma unroll
                for (int i = 0; i < 16; ++i) { l[i] = bf2f(sp[(size_t)(c + i) * 131072]); dc[i] = dp[(size_t)(c + i) * 1024]; }
#pragma unroll
                for (int i = 0; i < 16; ++i) { sp[(size_t)(c + i) * 131072] = f2bf(s); s = dc[i] * s + l[i]; }
            }
        }
        {
            const int XS = (G == 256) ? XSCORE : 0;
            if (wg < XS) {
                const Conv8Job j1{w1, W1_T, 4096, 2, (size_t)2048 * 4096, (size_t)4096 * 2048, 8 * 16};
                const Conv8Job j2{w2, W2_T, 2048, 0, (size_t)2048 * 2048, (size_t)2048 * 2048, 8 * 8};
                __syncthreads();
                conv8_run(lds, j1, NEXP * 8 * 16, wg, XS, tid, wave, lane); conv8_run(lds, j2, NEXP * 8 * 8, wg, XS, tid, wave, lane);
            }
            for (;;) {
                if (tid == 0) MISC[100] = __hip_atomic_fetch_add(ctl + CW_SCQ, 1u, __ATOMIC_RELAXED, __HIP_MEMORY_SCOPE_AGENT);
                __syncthreads();
                const int item = (int)MISC[100];
                __syncthreads();
                if (item >= 252 * 6) break;
                int j, lo, hi;
                if (item < 504) { j = item >> 1; const int T = ((8 + j) >> 2) + ((511 - j) >> 2) + 2; const int p = item & 1; lo = p * T / 3; hi = (p + 1) * T / 3; }
                else { const int i2 = item - 504; j = i2 >> 2; const int T = ((8 + j) >> 2) + ((511 - j) >> 2) + 2; const int p = i2 & 3, b = 2 * T / 3; lo = b + p * (T - b) / 4; hi = b + (p + 1) * (T - b) / 4; }
                const int qa = 8 + j, qb2 = 511 - j, na = (qa >> 2) + 1;
                const int a0 = lo < na ? lo : na, a1 = hi < na ? hi : na, b0 = (lo > na ? lo : na) - na, b1 = (hi > na ? hi : na) - na;
                if (a1 > a0) score_block(lds, PROJ, KI, SCORES, SEGMAX, qa, a0, a1, tid, wave, lane);
                if (b1 > b0) score_block(lds, PROJ, KI, SCORES, SEGMAX, qb2, b0, b1, tid, wave, lane);
            }
        }
    }
    SEAM(PH_SCORE);
    if (IN(PH_ATTN)) {
        const int gw = wg * NWAVES + wave, NGW = G * NWAVES;
        for (int u = wg; u < 2048; u += G) hgrn_l3(lds, PROJ, lb_logits, ST, hgrn_norm_g, REC, u >> 3, u & 7, tid, wave, lane);
        {
            for (;;) {
                unsigned tq = 0; if (lane == 0) tq = __hip_atomic_fetch_add(ctl + CW_ATQ, 1u, __ATOMIC_RELAXED, __HIP_MEMORY_SCOPE_AGENT);
                tq = (unsigned)__builtin_amdgcn_readfirstlane((int)tq);
                if (tq >= (unsigned)S) break;
                const int t = S - 1 - (int)tq;
                LAS unsigned char* wl = lds + wave * 17664;
                if (t >= 256) select_row(wl, SCORES, SEGMAX, t, lane);
                else {
#pragma unroll
                    for (int i = 0; i < 4; ++i) { const int idx = lane + 64 * i; ((LAS int*)wl)[idx] = idx <= t ? idx : 0; }
                }
                attn_query(wl, PROJ, KC, VC, ATT, t, lane);
            }
        }
    }
    SEAM(PH_ATTN);
    if (IN(PH_OP1)) {
        pg8::Gemm g{ATT, WA_T, 1024, (size_t)2048 * 1024, nullptr, (size_t)S * 1024};
        pg8::TwoPartOrder So; So.init(S, 2048, G, wg);
        pg8::EpiGate2 E{(unsigned char*)MERGED, PROJ + CGA, PROJ + CGR};
        pg8::gemm_phase<pg8::EpiGate2, pg8::TwoPartOrder, true>(lds, g, So, E);
    }
    SEAM(PH_OP2);
    if (IN(PH_WOUT)) {
        pg8::Gemm g{MERGED, WO_T, 2048, 0, nullptr, 0}; pg8::StaticOrder So; So.init(S, 2048, G, wg);
        pg8::EpiDelta E{MOD + 2 * D, DELTA, 1.0f / (W8_SCALE * MRG8_SCALE)};
        pg8::gemm_phase<pg8::EpiDelta, pg8::StaticOrder, true>(lds, g, So, E);
    }
    SEAM(PH_WOUT);
    }

    if (IN(PH_ROUTER)) {
        LAS float* hs = (LAS float*)lds;
        volatile LAS unsigned* lcnt = MISC + 32;
        const float* sh2 = MOD + 3 * D; const float* sc2 = MOD + 4 * D;
        if (tid < 32) lcnt[tid] = 0u;
        __syncthreads();
        for (int grp = wg; grp < S / 16; grp += G) {
#pragma unroll 1
            for (int q = 0; q < 2; ++q) {
                const int tl = 2 * wave + q, t = grp * 16 + tl;
                const f32x4* xr = (const f32x4*)(x + (size_t)t * D) + lane; const u32x2* dr = (const u32x2*)(DELTA + (size_t)t * D) + lane;
                f32x4 v[8]; float ss = 0.f;
#pragma unroll
                for (int j = 0; j < 8; ++j) { const u32x2 dw = dr[64 * j]; v[j] = xr[64 * j] + (f32x4){bf_lo(dw.x), bf_hi(dw.x), bf_lo(dw.y), bf_hi(dw.y)};
                    ss += (v[j][0] * v[j][0] + v[j][1] * v[j][1]) + (v[j][2] * v[j][2] + v[j][3] * v[j][3]); }
#pragma unroll
                for (int j = 0; j < 8; ++j) { u32x2 w; w.x = cvt_pk_bf16(v[j][0], v[j][1]); w.y = cvt_pk_bf16(v[j][2], v[j][3]); ((u32x2*)(DELTA + (size_t)t * D) + lane)[64 * j] = w; }
                const float rstd = rsqrtf(wave_sum(ss) * (1.0f / D) + NORM_EPS);
#pragma unroll
                for (int j = 0; j < 8; ++j) {
                    const int c = 4 * lane + 256 * j;
                    const f32x4 g = *(const f32x4*)(norm2_g + c), sc = *(const f32x4*)(sc2 + c), sh = *(const f32x4*)(sh2 + c);
                    f32x4 h;
#pragma unroll
                    for (int e = 0; e < 4; ++e) h[e] = v[j][e] * rstd * g[e] * (1.0f + sc[e]) + sh[e];
                    *(LAS f32x4*)(hs + tl * 2048 + c) = h;
                    *(unsigned*)(H8 + (size_t)t * D + c) = pack4_fp8(h[0], h[1], h[2], h[3]);
                }
            }
            __syncthreads();
            {
                LAS float* part = (LAS float*)(lds + 131072);
                const int fr = lane & 15, fq = lane >> 4;
                f32x4 acc0 = (f32x4){0.f, 0.f, 0.f, 0.f}, acc1 = acc0;
                const LAS float* hrow = hs + fr * 2048 + wave * 256 + 4 * fq; const float* wrp = w_router + (size_t)(wave * 256 + 4 * fq) * 32 + fr;
#pragma unroll 2
                for (int i = 0; i < 16; ++i) {
                    const f32x4 a4 = *(const LAS f32x4*)(hrow + 16 * i);
                    float b0[4], b1[4];
#pragma unroll
                    for (int s = 0; s < 4; ++s) { b0[s] = wrp[(size_t)(16 * i + s) * 32]; b1[s] = wrp[(size_t)(16 * i + s) * 32 + 16]; }
#pragma unroll
                    for (int s = 0; s < 4; ++s) { acc0 = __builtin_amdgcn_mfma_f32_16x16x4f32(a4[s], b0[s], acc0, 0, 0, 0); acc1 = __builtin_amdgcn_mfma_f32_16x16x4f32(a4[s], b1[s], acc1, 0, 0, 0); }
                }
#pragma unroll
                for (int r = 0; r < 4; ++r) { part[(wave * 16 + 4 * fq + r) * 32 + fr] = acc0[r]; part[(wave * 16 + 4 * fq + r) * 32 + 16 + fr] = acc1[r]; }
                __syncthreads();
                const int tl = tid >> 5, e = tid & 31, t = grp * 16 + tl;
                float v = b_router[e];
#pragma unroll
                for (int w = 0; w < 8; ++w) v += part[(w * 16 + tl) * 32 + e];
                float tv[4]; int ti[4];
#pragma unroll
                for (int k = 0; k < 4; ++k) {
                    float bv = v; int bi = e;
#pragma unroll
                    for (int o = 16; o >= 1; o >>= 1) { const float ov = __shfl_xor(bv, o); const int oi = __shfl_xor(bi, o); if (ov > bv || (ov == bv && oi < bi)) { bv = ov; bi = oi; } }
                    tv[k] = bv; ti[k] = bi; if (e == bi) v = -__builtin_inff();
                }
                if (e == 0) {
                    const float e1 = __expf(tv[1] - tv[0]), e2 = __expf(tv[2] - tv[0]), e3 = __expf(tv[3] - tv[0]); const float inv = 1.0f / (1.0f + e1 + e2 + e3);
                    *(int4*)(TOPE + (size_t)t * 4) = make_int4(ti[0], ti[1], ti[2], ti[3]);
                    *(f32x4*)(GATE + (size_t)t * 4) = (f32x4){inv, e1 * inv, e2 * inv, e3 * inv};
#pragma unroll
                    for (int k = 0; k < 4; ++k) __hip_atomic_fetch_add((LAS unsigned*)&lcnt[ti[k]], 1u, __ATOMIC_RELAXED, __HIP_MEMORY_SCOPE_WORKGROUP);
                }
            }
            __syncthreads();
        }
        if (tid < 32) { const unsigned c = lcnt[tid]; if (c) __hip_atomic_fetch_add(ctl + CW_CNT + tid, c, __ATOMIC_RELAXED, __HIP_MEMORY_SCOPE_AGENT); }
    }
    SEAM(PH_ROUTER);

    if (IN(PH_SCATTER)) {
        volatile LAS unsigned* lcnt = MISC + 32; volatile LAS unsigned* lbase = MISC + 64; LAS int* pstart = (LAS int*)(lds + 1024); LAS int* pcnt = (LAS int*)(lds + 1280);
        if (tid == 0) { int p = 0; for (int e = 0; e < NEXP; ++e) { const int c = (int)__hip_atomic_load(ctl + CW_CNT + e, __ATOMIC_RELAXED, __HIP_MEMORY_SCOPE_AGENT); pstart[e] = p; pcnt[e] = c; p += (c + 255) & ~255; } }
        if (tid < 32) lcnt[tid] = 0u;
        __syncthreads();
        if (wg < NEXP) { const int e = wg; for (int s = pstart[e] + pcnt[e] + tid; s < pstart[e] + ((pcnt[e] + 255) & ~255); s += NTHR) TOKS[s] = 0; }
        for (int blk = wg; blk < S / 64; blk += G) {
            int e = 0, lrank = 0;
            if (tid < 256) { e = TOPE[(size_t)blk * 256 + tid]; lrank = (int)__hip_atomic_fetch_add((LAS unsigned*)&lcnt[e], 1u, __ATOMIC_RELAXED, __HIP_MEMORY_SCOPE_WORKGROUP); }
            __syncthreads();
            if (tid < 32) { const unsigned c = lcnt[tid]; lbase[tid] = c ? __hip_atomic_fetch_add(ctl + CW_FILL + tid, c, __ATOMIC_RELAXED, __HIP_MEMORY_SCOPE_AGENT) : 0u; }
            __syncthreads();
            if (tid < 256) { const int slot = pstart[e] + (int)lbase[e] + lrank; SLOT[(size_t)blk * 256 + tid] = slot; TOKS[slot] = blk * 64 + (tid >> 2); }
            __syncthreads();
            if (tid < 32) lcnt[tid] = 0u;
            __syncthreads();
        }
    }
    SEAM(PH_SCATTER);

    if (IN(PH_MOE1) || IN(PH_MOE2)) {
        LAS int* panel_e = (LAS int*)(lds + 131072 + 2048);
        LAS int* npan = (LAS int*)(lds + 131072 + 2048 + 2048);
        __syncthreads();
        if (tid == 0) { int p = 0; for (int e = 0; e < NEXP; ++e) { const int np = (int)((__hip_atomic_load(ctl + CW_CNT + e, __ATOMIC_RELAXED, __HIP_MEMORY_SCOPE_AGENT) + 255u) >> 8); for (int q = 0; q < np; ++q) panel_e[p + q] = e; p += np; } npan[0] = p; }
        __syncthreads();
        const int nPanels = npan[0];
        if (IN(PH_MOE1)) {
            pg8::Gemm g{H8, W1_T, 2048, (size_t)4096 * 2048, TOKS, 0}; pg8::MoeOrder So; So.init(nPanels, 16, G, wg, panel_e);
            pg8::EpiSwiglu E{ACT, b1};
            pg8::gemm_phase<pg8::EpiSwiglu, pg8::MoeOrder, true>(lds, g, So, E);
        }
        SEAM(PH_MOE1);
        if (IN(PH_MOE2)) {
            pg8::Gemm g{ACT, W2_T, 2048, (size_t)2048 * 2048, nullptr, 0}; pg8::MoeOrder So; So.init(nPanels, 8, G, wg, panel_e);
            pg8::EpiBf16 E{YB, 2048, b2, 2048, 1.0f / (W8_SCALE * ACT8_SCALE), 1 << 30, 0};
            pg8::gemm_phase<pg8::EpiBf16, pg8::MoeOrder, true>(lds, g, So, E);
        }
    }
    SEAM(PH_MOE2);

    if (IN(PH_FINAL)) {
        const float* gt2 = MOD + 5 * D;
        const int gw = wg * NWAVES + wave, NGW = G * NWAVES;
        for (int t = gw; t < S; t += NGW) {
            const u32x2* dr = (const u32x2*)(DELTA + (size_t)t * D) + lane;
            f32x4 v[8];
#pragma unroll
            for (int j = 0; j < 8; ++j) { const u32x2 dw = dr[64 * j]; v[j] = (f32x4){bf_lo(dw.x), bf_hi(dw.x), bf_lo(dw.y), bf_hi(dw.y)}; }
            {
                f32x4 m[8];
#pragma unroll
                for (int j = 0; j < 8; ++j) m[j] = (f32x4){0.f, 0.f, 0.f, 0.f};
                const int4 sl = *(const int4*)(SLOT + (size_t)t * 4); const f32x4 gt = *(const f32x4*)(GATE + (size_t)t * 4);
                const int sls[4] = {sl.x, sl.y, sl.z, sl.w};
#pragma unroll
                for (int k = 0; k < 4; ++k) {
                    const u32x2* yr = (const u32x2*)(YB + (size_t)sls[k] * D) + lane; const float gk = gt[k];
#pragma unroll
                    for (int j = 0; j < 8; ++j) { const u32x2 w = yr[64 * j]; m[j][0] += gk * bf_lo(w.x); m[j][1] += gk * bf_hi(w.x); m[j][2] += gk * bf_lo(w.y); m[j][3] += gk * bf_hi(w.y); }
                }
#pragma unroll
                for (int j = 0; j < 8; ++j) { const f32x4 g2 = *(const f32x4*)(gt2 + 4 * lane + 256 * j); v[j] = v[j] + g2 * m[j]; }
            }
            float ss = 0.f;
#pragma unroll
            for (int j = 0; j < 8; ++j) ss += (v[j][0] * v[j][0] + v[j][1] * v[j][1]) + (v[j][2] * v[j][2] + v[j][3] * v[j][3]);
            const float rstd = rsqrtf(wave_sum(ss) * (1.0f / D) + NORM_EPS);
            f32x4* orow = (f32x4*)(out + (size_t)t * D) + lane;
#pragma unroll
            for (int j = 0; j < 8; ++j) { const f32x4 fg = *(const f32x4*)(final_g + 4 * lane + 256 * j); orow[64 * j] = v[j] * rstd * fg; }
        }
    }
#undef IN
#undef SEAM
}

#ifndef MK_ONE_LAUNCH
#define MK_ONE_LAUNCH 1
#endif
extern "C" void kernel_launch(void* const* d_in, const int* in_sizes, int n_in, void* d_out, int out_size, void* d_ws, size_t ws_size, hipStream_t stream) {
    static int grid = 0;
    if (grid == 0) {
        if (n_in != 22 || out_size != S * D || ws_size < WS_END) { fprintf(stderr, "kernel_launch: unexpected shapes: n_in %d out %d ws %zu (need %zu)\n", n_in, out_size, ws_size, (size_t)WS_END); grid = -1; return; }
        int dev = 0, cus = 0, per_cu = 0;
        if (hipGetDevice(&dev) != hipSuccess || hipDeviceGetAttribute(&cus, hipDeviceAttributeMultiprocessorCount, dev) != hipSuccess) { grid = -1; return; }
        if (hipFuncSetAttribute((const void*)fwd_kernel, hipFuncAttributeMaxDynamicSharedMemorySize, LDS_BYTES) != hipSuccess) { fprintf(stderr, "kernel_launch: hipFuncSetAttribute failed\n"); grid = -1; return; }
        if (hipOccupancyMaxActiveBlocksPerMultiprocessor(&per_cu, (const void*)fwd_kernel, NTHR, LDS_BYTES) != hipSuccess || per_cu < 1) { fprintf(stderr, "kernel_launch: occupancy query says %d\n", per_cu); (void)hipGetLastError(); grid = -1; return; }
        grid = cus;
    }
    if (grid < 0) return;
    (void)in_sizes;
    hipMemsetAsync((char*)d_ws + WS_CTL, 0, CTL_BYTES, stream);
    Args a{};
    for (int i = 0; i < 22; ++i) a.in[i] = d_in[i];
    a.out = (float*)d_out; a.ws = (unsigned char*)d_ws; a.flags = 0; a.pad = 0;
#if MK_ONE_LAUNCH
    a.ph_lo = 0; a.ph_hi = NPH;
    hipLaunchKernelGGL(fwd_kernel, dim3(grid), dim3(NTHR), LDS_BYTES, stream, a);
#else
    for (int p = 0; p < NPH; ++p) { a.ph_lo = p; a.ph_hi = p + 1; hipLaunchKernelGGL(fwd_kernel, dim3(grid), dim3(NTHR), LDS_BYTES, stream, a); }
#endif
}
```

```cpp
#include <hip/hip_runtime.h>
#include <cstdio>
#include <cstdint>

#define GAS __attribute__((address_space(1)))
#define LAS __attribute__((address_space(3)))
typedef unsigned short bf16_t;
typedef short bf16x8 __attribute__((ext_vector_type(8)));
typedef float f32x4 __attribute__((ext_vector_type(4)));
typedef float f32x2 __attribute__((ext_vector_type(2)));
typedef float f32x16 __attribute__((ext_vector_type(16)));
typedef unsigned u32x4 __attribute__((ext_vector_type(4)));
typedef unsigned u32x2 __attribute__((ext_vector_type(2)));
typedef int i32x4 __attribute__((ext_vector_type(4)));
typedef int i32x8 __attribute__((ext_vector_type(8)));
typedef short s16x4 __attribute__((ext_vector_type(4)));
typedef short s16x2 __attribute__((ext_vector_type(2)));
typedef int v2i32 __attribute__((ext_vector_type(2)));

constexpr int S = 16384, D = 2048, DIN = 10832, DINP = 11008, NEXP = 32, DFF = 2048;
constexpr int NWAVES = 8, NTHR = 512;
constexpr int CQ = 0, CK = 1024, CV = 1280, CQI = 1536, CKI = 2560, CWI = 2624, CHQ = 2816, CHF = 3840, CHI = 4864, CHG = 5888, CGA = 6912, CGR = 8960;
constexpr int PMAX = 65536 + NEXP * 256;
constexpr float NORM_EPS = 1e-5f;

constexpr size_t MiB = 1u << 20;
constexpr size_t al256(size_t x) { return (x + 255) & ~(size_t)255; }
constexpr size_t WS_CTL = 0, CTL_BYTES = 1 * MiB;
constexpr size_t WS_MOD = WS_CTL + CTL_BYTES;
constexpr size_t WS_TOPE = WS_MOD + 64 * 1024;
constexpr size_t WS_GATE = WS_TOPE + (size_t)S * 16;
constexpr size_t WS_SLOT = WS_GATE + (size_t)S * 16;
constexpr size_t WS_WIN_T = WS_SLOT + (size_t)S * 16;
constexpr size_t WS_WA_T = WS_WIN_T + (size_t)DINP * D * 2;
constexpr size_t WS_WH_T = WS_WA_T + (size_t)2048 * 1024 * 2;
constexpr size_t WS_WO_T = WS_WH_T + (size_t)2048 * 1024 * 2;
constexpr size_t WS_W1_T = WS_WO_T + (size_t)2048 * 2048 * 2;
constexpr size_t WS_W2_T = WS_W1_T + (size_t)NEXP * 4096 * 2048 * 2;
constexpr size_t WS_H = WS_W2_T + (size_t)NEXP * 2048 * 2048 * 2;
constexpr size_t WS_PROJ = WS_H + (size_t)S * D * 2;
constexpr size_t WS_KI = WS_PROJ + (size_t)S * DINP * 2;
constexpr size_t WS_KC = WS_KI + (size_t)S * 64 * 2;
constexpr size_t WS_VC = WS_KC + (size_t)S * 256 * 2;
constexpr size_t WS_ST = WS_VC + (size_t)S * 256 * 2;
constexpr size_t WS_DC = WS_ST + (size_t)256 * 8 * 128 * 128 * 4;
constexpr size_t WS_SEL = WS_DC + (size_t)256 * 8 * 128 * 4;
constexpr size_t WS_ATT = WS_SEL + (size_t)S * 256 * 4;
constexpr size_t WS_REC = WS_ATT + (size_t)S * 1024 * 2;
constexpr size_t WS_MERGED = WS_REC + (size_t)S * 1024 * 2;
constexpr size_t WS_X1 = WS_MERGED + (size_t)S * 2048 * 2;
constexpr size_t WS_SCORES = WS_X1 + (size_t)S * 2048 * 4;
constexpr size_t WS_XB = WS_SCORES;
constexpr size_t WS_ACT = WS_XB + (size_t)PMAX * 2048 * 2;
constexpr size_t WS_YB = WS_ACT + (size_t)PMAX * 2048 * 2;
constexpr size_t WS_END = WS_SCORES + (size_t)S * S * 4;
static_assert(WS_YB + (size_t)PMAX * 2048 * 2 <= WS_END, "MoE buffers overlay the score matrix");
static_assert(WS_END <= (size_t)4096 * MiB, "workspace");
constexpr int CW_BAR = 4096, CW_CNT = 8192, CW_FILL = 8448;
constexpr size_t WS_TOKS = WS_SEL;

constexpr int LDS_BYTES = 155648;
constexpr int LDS_MISC = LDS_BYTES - 512;

__device__ __forceinline__ unsigned cvt_pk_bf16(float lo, float hi) { unsigned r; asm volatile("v_cvt_pk_bf16_f32 %0, %1, %2" : "=v"(r) : "v"(lo), "v"(hi)); return r; }
__device__ __forceinline__ float bf_lo(unsigned u) { return __uint_as_float(u << 16); }
__device__ __forceinline__ float bf_hi(unsigned u) { return __uint_as_float(u & 0xffff0000u); }
__device__ __forceinline__ float bf2f(bf16_t b) { return __uint_as_float(((unsigned)b) << 16); }
__device__ __forceinline__ float wave_sum(float v) {
#define DPPS(ctrl, rmask) { const int s_ = __builtin_amdgcn_update_dpp(0, __float_as_int(v), ctrl, rmask, 0xF, false); v += __int_as_float(s_); }
    DPPS(0x111, 0xF) DPPS(0x112, 0xF) DPPS(0x114, 0xF) DPPS(0x118, 0xF) DPPS(0x142, 0xA) DPPS(0x143, 0xC)
#undef DPPS
    return __int_as_float(__builtin_amdgcn_readlane(__float_as_int(v), 63));
}
__device__ __forceinline__ float wave_max(float v) {
#define DPPM(ctrl, rmask) { const int o_ = __float_as_int(v); const int s_ = __builtin_amdgcn_update_dpp(o_, o_, ctrl, rmask, 0xF, false); v = fmaxf(v, __int_as_float(s_)); }
    DPPM(0x111, 0xF) DPPM(0x112, 0xF) DPPM(0x114, 0xF) DPPM(0x118, 0xF) DPPM(0x142, 0xA) DPPM(0x143, 0xC)
#undef DPPM
    return __int_as_float(__builtin_amdgcn_readlane(__float_as_int(v), 63));
}
__device__ __forceinline__ float sigmoidf_(float x) { return __builtin_amdgcn_rcpf(1.0f + __expf(-x)); }
__device__ __forceinline__ float siluf_(float x) { return x * __builtin_amdgcn_rcpf(1.0f + __expf(-x)); }
__device__ __forceinline__ unsigned pack4_fp8(float a, float b, float c, float d) { int w = 0; w = __builtin_amdgcn_cvt_pk_fp8_f32(a, b, w, false); w = __builtin_amdgcn_cvt_pk_fp8_f32(c, d, w, true); return (unsigned)w; }
constexpr float W8_SCALE = 64.0f, ACT8_SCALE = 4.0f, MRG8_SCALE = 8.0f, OP8_SCALE = 16.0f;
__device__ __forceinline__ float relu_i(float x) { const int i = __float_as_int(x); return __int_as_float(i > 0 ? i : 0); }
__device__ __forceinline__ void fp8x16_to_bf16(const u32x4& w, u32x4& lo, u32x4& hi) {
    unsigned o[8];
#pragma unroll
    for (int q = 0; q < 4; ++q) { const unsigned wq = w[q]; const f32x2 a = __builtin_amdgcn_cvt_pk_f32_fp8((int)wq, false), b = __builtin_amdgcn_cvt_pk_f32_fp8((int)wq, true);
        o[2 * q] = cvt_pk_bf16(a[0], a[1]); o[2 * q + 1] = cvt_pk_bf16(b[0], b[1]); }
    lo = (u32x4){o[0], o[1], o[2], o[3]}; hi = (u32x4){o[4], o[5], o[6], o[7]};
}
__device__ __forceinline__ unsigned char fp8_1(float x) { return (unsigned char)(__builtin_amdgcn_cvt_pk_fp8_f32(x, x, 0, false) & 0xff); }
#define LDS_WAIT() asm volatile("s_waitcnt lgkmcnt(0)" ::: "memory")
#define VM_WAIT() asm volatile("s_waitcnt vmcnt(0)" ::: "memory")

#define XB_TMO      128
#define XB_XCNT(j)  (256  + 64 * (j))
#define XB_XSUB(j)  (1280 + 64 * (j))
#define XB_XGEN(j)  (2304 + 64 * (j))
#define XB_TOP      3328
#define XB_TOPGEN   3392
#define XCD_BAR_WORDS 3456
#define XB_SPIN_CAP (1u << 22)

__device__ __forceinline__ unsigned xb_ld(unsigned* p)              { return __hip_atomic_load(p, __ATOMIC_RELAXED, __HIP_MEMORY_SCOPE_AGENT); }
__device__ __forceinline__ unsigned xb_add(unsigned* p, unsigned v) { return __hip_atomic_fetch_add(p, v, __ATOMIC_RELAXED, __HIP_MEMORY_SCOPE_AGENT); }
__device__ __forceinline__ unsigned xb_xcc_id() { return (unsigned)__builtin_amdgcn_s_getreg((3 << 11) | 20) & 0xFu; }
#define XB_SPIN(cond, bar) do { unsigned _sp = 0; while (cond) { __builtin_amdgcn_s_sleep(1); \
    if ((++_sp & 255u) == 0u) { if (xb_ld(&(bar)[XB_TMO])) break; if (_sp > XB_SPIN_CAP) { atomicAdd(&(bar)[XB_TMO], 1u); break; } } } } while (0)

struct XcdBarrier { unsigned* bar; unsigned x; volatile LAS unsigned* st; };

__device__ __forceinline__ XcdBarrier xcd_barrier_post(unsigned* bar, volatile LAS unsigned* st) {
    XcdBarrier b; b.bar = bar; b.x = xb_xcc_id(); b.st = st;
    if (threadIdx.x == 0) (void)xb_add(&bar[XB_XCNT(b.x)], 1u);
    return b;
}
__device__ __forceinline__ void xcd_barrier_complete(unsigned* bar, unsigned x, unsigned& nloc, unsigned& nx) {
    const unsigned G = gridDim.x * gridDim.y * gridDim.z;
    unsigned sum, cnt, mine, sp = 0u;
    for (;;) {
        sum = 0u; cnt = 0u; mine = 0u;
#pragma unroll
        for (unsigned j = 0; j < 16; ++j) { const unsigned c = xb_ld(&bar[XB_XCNT(j)]); sum += c; cnt += (c > 0u) ? 1u : 0u; mine = (j == x) ? c : mine; }
        if (sum == G) break;
        __builtin_amdgcn_s_sleep(1);
        if ((++sp & 255u) == 0u) { if (xb_ld(&bar[XB_TMO])) break; if (sp > XB_SPIN_CAP) { atomicAdd(&bar[XB_TMO], 1u); break; } }
    }
    nloc = mine > 0u ? mine : 1u; nx = cnt > 0u ? cnt : 1u;
}
__device__ __forceinline__ void xcd_barrier(const XcdBarrier& b) {
    asm volatile("s_waitcnt vmcnt(0)" ::: "memory");
    __syncthreads();
    if (threadIdx.x == 0) {
        unsigned* bar = b.bar;
        __builtin_amdgcn_s_waitcnt(0);
        unsigned nloc = b.st[0], nx = b.st[1];
        if (nloc == 0u) { xcd_barrier_complete(bar, b.x, nloc, nx); b.st[0] = nloc; b.st[1] = nx; }
        const unsigned old = xb_add(&bar[XB_XSUB(b.x)], 1u);
        const unsigned gen = old / nloc;
        if (old + 1u == (gen + 1u) * nloc) {
            __builtin_amdgcn_fence(__ATOMIC_RELEASE, "agent");
            asm volatile("s_waitcnt vmcnt(0)" ::: "memory");
            const unsigned og = xb_add(&bar[XB_TOP], 1u);
            const unsigned tg = og / nx;
            if (og + 1u == (tg + 1u) * nx) xb_add(&bar[XB_TOPGEN], 1u);
            else XB_SPIN(xb_ld(&bar[XB_TOPGEN]) == tg, bar);
            __builtin_amdgcn_fence(__ATOMIC_ACQUIRE, "agent");
            xb_add(&bar[XB_XGEN(b.x)], 1u);
            asm volatile("s_waitcnt vmcnt(0)" ::: "memory");
        } else {
            XB_SPIN(xb_ld(&bar[XB_XGEN(b.x)]) == gen, bar);
            __builtin_amdgcn_fence(__ATOMIC_ACQUIRE, "agent");
            asm volatile("s_waitcnt vmcnt(0)" ::: "memory");
        }
    }
    __syncthreads();
}

namespace pg8 {
constexpr int BM = 256, BK = 64, HALF = 128, HTB = HALF * BK * 2, STAGE_BYTES = 8 * HTB, NXCD = 8, WGM = 8;
__host__ __device__ __forceinline__ int lds_byte(int r, int c) { const int st = (r >> 4) * 2 + (c >> 5), rr = r & 15, cc = c & 31, ob = rr * 64 + cc * 2; return st * 1024 + (ob ^ (((ob >> 9) & 1) << 5)); }
__host__ __device__ __forceinline__ void stage_rc(int b, int& R, int& C) { const int st = b / 1024, sb = b % 1024, swz = sb ^ (((sb >> 9) & 1) << 5); R = (st >> 1) * 16 + swz / 64; C = (st & 1) * 32 + (swz % 64) / 2; }
__host__ __device__ __forceinline__ int perm32(int rho) { const int n = rho >> 4, i = rho & 15; return 8 * (i >> 2) + 4 * n + (i & 3); }

struct Unit { int pm, pn, e; };
struct Gemm { const void* A; const void* Bt; int K; size_t estride; const int* arow; size_t astride; };

struct StaticOrder {
    int nM, nN, nwg, G, c, i, full, erank, en;
    __device__ void init(int M, int N, int G_, int c_) { nM = M / BM; nN = N / BM; nwg = nM * nN; G = G_; c = c_; i = 0; full = 1 << 30; erank = -1; en = 1; }
    __device__ void skew(int full_, int erank_, int en_) { full = full_; erank = erank_; en = en_; }
    __device__ bool next(Unit& u) {
        long L;
        if (i < full) L = (long)i * G + c; else { if (erank < 0) return false; L = (long)full * G + (long)(i - full) * en + erank; }
        ++i; if (L >= nwg) return false;
        int wgid = (int)L; { const int q = nwg / NXCD, r = nwg % NXCD, xcd = wgid % NXCD, off = wgid / NXCD; wgid = (xcd < r ? xcd * (q + 1) : r * (q + 1) + (xcd - r) * q) + off; }
        const int nig = WGM * nN, gid = wgid / nig, fm = gid * WGM, gsz = (nM - fm) < WGM ? (nM - fm) : WGM;
        u.pm = fm + ((wgid % nig) % gsz); u.pn = (wgid % nig) / gsz; u.e = 0; return true;
    }
};
struct MoeOrder {
    int nPanels, nN, G, c, i; const LAS int* panel_e;
    __device__ void init(int nPanels_, int nN_, int G_, int c_, const LAS int* pe) { nPanels = nPanels_; nN = nN_; G = G_; c = c_; i = 0; panel_e = pe; }
    __device__ bool next(Unit& u) {
        const int PB = 256 / nN;
        const int nblk = (nPanels + PB - 1) / PB;
        for (;;) {
            const long L = (long)i * G + c; ++i;
            const int blk = (int)(L >> 8), r = (int)(L & 255), x = r & 7, j = r >> 3;
            if (blk >= nblk) return false;
            int pm, pn;
            if (nN == 16) { pm = blk * 16 + 4 * (x >> 1) + (j & 3); pn = 8 * (x & 1) + (j >> 2); }
            else          { pm = blk * 32 + 4 * x + (j & 3);        pn = j >> 2; }
            if (pm < nPanels) { u.pm = pm; u.pn = pn; u.e = panel_e[pm]; return true; }
        }
    }
};

template <class Epi, class Sched, bool FP8 = false>
__device__ __forceinline__ void gemm_phase(LAS unsigned char* lds, const Gemm g, Sched& S, const Epi& E) {
    const int tid = threadIdx.x, wid = __builtin_amdgcn_readfirstlane(tid >> 6), lane = tid & 63, wr = wid >> 2, wc = wid & 3, fr = lane & 15, fq = lane >> 4;
    const int K = g.K; const int pitch = FP8 ? K : 2 * K; const int nt = pitch / 128;
    unsigned voffA[2], voffB[2];
#pragma unroll
    for (int i = 0; i < 2; ++i) { int R, C; stage_rc(tid * 16 + i * 8192, R, C); const int Rb = Epi::PERM ? ((R & ~31) + perm32(R & 31)) : R;
        voffA[i] = (unsigned)(R * pitch + C * 2); voffB[i] = (unsigned)(Rb * pitch + C * 2); }
    const size_t kstep = (size_t)(BK * 2);
    const size_t hstep = (size_t)HALF * pitch;
    const size_t tstep = 2 * hstep;
    int RA[2], CA[2];
#pragma unroll
    for (int i = 0; i < 2; ++i) stage_rc(tid * 16 + i * 8192, RA[i], CA[i]);
    const bool gather = g.arow != nullptr;
    const size_t hsA = gather ? 0 : hstep;
    unsigned vA0[2] = {voffA[0], voffA[1]}, vA1[2] = {voffA[0], voffA[1]}, nA0[2] = {voffA[0], voffA[1]}, nA1[2] = {voffA[0], voffA[1]};
#define PG8_AOFF(dst0, dst1, u) do { if (gather) { _Pragma("unroll") for (int i = 0; i < 2; ++i) { \
        dst0[i] = (unsigned)g.arow[(u).pm * 256 + RA[i]] * (unsigned)pitch + (unsigned)(CA[i] * 2); dst1[i] = (unsigned)g.arow[(u).pm * 256 + 128 + RA[i]] * (unsigned)pitch + (unsigned)(CA[i] * 2); } } } while (0)
    const unsigned ldsw = (unsigned)wid * 1024u;
    const int aoff = lds_byte(wr * 64 + fr, fq * 8), boff = lds_byte(wc * 32 + fr, fq * 8);
#define PG8_SA(b, h) (((b) * 2 + (h)) * HTB)
#define PG8_SB(b, h) ((4 + (b) * 2 + (h)) * HTB)
#define PG8_STAGE(bufoff, gbase, voff) do { _Pragma("unroll") for (int _i = 0; _i < 2; ++_i) \
        __builtin_amdgcn_global_load_lds((const unsigned*)((const char*)(gbase) + (voff)[_i]), (LAS unsigned*)(lds + (bufoff) + ldsw + _i * 8192), 16, 0, 0); } while (0)
#define PG8_LD8(p) __builtin_shufflevector(*(const LAS i32x4*)(p), *(const LAS i32x4*)((p) + 1024), 0, 1, 2, 3, 4, 5, 6, 7)
#define PG8_LDA(dst, b, h) do { _Pragma("unroll") for (int m = 0; m < 4; ++m) { if constexpr (FP8) dst##8[m] = PG8_LD8(lds + PG8_SA(b, h) + aoff + m * 2048); \
        else { _Pragma("unroll") for (int k = 0; k < 2; ++k) dst[m][k] = *(const LAS bf16x8*)(lds + PG8_SA(b, h) + aoff + m * 2048 + k * 1024); } } } while (0)
#define PG8_LDB(dst, b, h) do { _Pragma("unroll") for (int n = 0; n < 2; ++n) { if constexpr (FP8) dst##8[n] = PG8_LD8(lds + PG8_SB(b, h) + boff + n * 2048); \
        else { _Pragma("unroll") for (int k = 0; k < 2; ++k) dst[n][k] = *(const LAS bf16x8*)(lds + PG8_SB(b, h) + boff + n * 2048 + k * 1024); } } } while (0)
#define PG8_MMA(ai, bj, At, Bt) do { __builtin_amdgcn_s_setprio(1); _Pragma("unroll") for (int m = 0; m < 4; ++m) _Pragma("unroll") for (int n = 0; n < 2; ++n) { \
        if constexpr (FP8) asm volatile("v_mfma_scale_f32_16x16x128_f8f6f4 %0, %1, %2, %0, %3, %3 op_sel_hi:[0,0,0]" : "+v"(acc[ai][bj][m][n]) : "v"(Bt##8[n]), "v"(At##8[m]), "v"(scl1)); \
        else { _Pragma("unroll") for (int k = 0; k < 2; ++k) acc[ai][bj][m][n] = __builtin_amdgcn_mfma_f32_16x16x32_bf16(Bt[n][k], At[m][k], acc[ai][bj][m][n], 0, 0, 0); } } \
        __builtin_amdgcn_s_setprio(0); } while (0)
#define PG8_WAIT_V(n) asm volatile("s_waitcnt vmcnt(" #n ")" ::: "memory")
#define PG8_WAIT_L(n) asm volatile("s_waitcnt lgkmcnt(" #n ")" ::: "memory")
#define PG8_BAR __builtin_amdgcn_s_barrier()
#define PG8_SCHED __builtin_amdgcn_sched_barrier(0)
    Unit cur, nxt;
    if (!S.next(cur)) return;
    const unsigned scl1 = 0x7f7f7f7fu;
    f32x4 acc[2][2][4][2];
#pragma unroll
    for (int a = 0; a < 2; ++a)
#pragma unroll
        for (int b = 0; b < 2; ++b)
#pragma unroll
            for (int m = 0; m < 4; ++m)
#pragma unroll
                for (int n = 0; n < 2; ++n) acc[a][b][m][n] = (f32x4){0.f, 0.f, 0.f, 0.f};
    bf16x8 At[4][2], B0[2][2], B1[2][2]; i32x8 At8[4], B08[2], B18[2];
    const char* cA = (const char*)g.A + (size_t)cur.e * g.astride + (gather ? (size_t)0 : (size_t)cur.pm * tstep); const char* cB = (const char*)g.Bt + (size_t)cur.e * g.estride + (size_t)cur.pn * tstep;
    PG8_AOFF(vA0, vA1, cur);
    PG8_STAGE(PG8_SB(0, 0), cB, voffB); PG8_STAGE(PG8_SB(0, 1), cB + hstep, voffB); PG8_STAGE(PG8_SA(0, 0), cA, vA0); PG8_STAGE(PG8_SA(0, 1), cA + hsA, vA1);
    if (wr == 1) PG8_BAR;
    PG8_WAIT_V(2); PG8_BAR;
    PG8_STAGE(PG8_SB(1, 0), cB + kstep, voffB); PG8_STAGE(PG8_SA(1, 0), cA + kstep, vA0); PG8_STAGE(PG8_SB(1, 1), cB + hstep + kstep, voffB);
    PG8_WAIT_V(6); PG8_BAR;
    for (;;) {
        const bool has_next = S.next(nxt);
        const char* nA = has_next ? (const char*)g.A + (size_t)nxt.e * g.astride + (gather ? (size_t)0 : (size_t)nxt.pm * tstep) : cA;
        if (has_next) PG8_AOFF(nA0, nA1, nxt);
        const char* nB = has_next ? (const char*)g.Bt + (size_t)nxt.e * g.estride + (size_t)nxt.pn * tstep : cB;
        for (int t = 0; t < nt; t += 2) {
            const bool last = (t == nt - 2);
            const char* a1 = cA + (size_t)(t + 1) * kstep;
            const char* a2 = last ? nA : cA + (size_t)(t + 2) * kstep; const char* b2 = last ? nB : cB + (size_t)(t + 2) * kstep;
            const char* a3 = a2 + kstep; const char* b3 = b2 + kstep;
            PG8_LDB(B0, 0, 0); PG8_LDB(B1, 0, 1); PG8_SCHED; PG8_LDA(At, 0, 0); PG8_STAGE(PG8_SA(1, 1), a1 + hsA, vA1);
            if (last && has_next) { vA0[0] = nA0[0]; vA0[1] = nA0[1]; vA1[0] = nA1[0]; vA1[1] = nA1[1]; }
            PG8_WAIT_V(8); PG8_WAIT_L(0); PG8_BAR; PG8_MMA(0, 0, At, B0); PG8_MMA(0, 1, At, B1); PG8_BAR; PG8_SCHED;
            PG8_LDA(At, 0, 1); PG8_STAGE(PG8_SB(0, 0), b2, voffB); PG8_STAGE(PG8_SB(0, 1), b2 + hstep, voffB); PG8_STAGE(PG8_SA(0, 0), a2, vA0);
            PG8_WAIT_V(8); PG8_WAIT_L(0); PG8_BAR; PG8_MMA(1, 0, At, B0); PG8_MMA(1, 1, At, B1); PG8_BAR; PG8_SCHED;
            PG8_LDB(B0, 1, 0); PG8_LDB(B1, 1, 1); PG8_SCHED; PG8_LDA(At, 1, 0); PG8_STAGE(PG8_SA(0, 1), a2 + hsA, vA1);
            PG8_WAIT_V(8); PG8_WAIT_L(0); PG8_BAR; PG8_MMA(0, 0, At, B0); PG8_MMA(0, 1, At, B1); PG8_BAR; PG8_SCHED;
            PG8_LDA(At, 1, 1); PG8_STAGE(PG8_SB(1, 0), b3, voffB); PG8_STAGE(PG8_SB(1, 1), b3 + hstep, voffB); PG8_STAGE(PG8_SA(1, 0), a3, vA0);
            PG8_WAIT_V(8); PG8_WAIT_L(0); PG8_BAR; PG8_MMA(1, 0, At, B0); PG8_MMA(1, 1, At, B1); PG8_BAR; PG8_SCHED;
        }
        if (wr == 0) PG8_BAR;
        if constexpr (FP8) {
#pragma unroll
            for (int a = 0; a < 2; ++a)
#pragma unroll
                for (int b = 0; b < 2; ++b) asm volatile("s_nop 15" : "+v"(acc[a][b][0][0]), "+v"(acc[a][b][0][1]), "+v"(acc[a][b][1][0]), "+v"(acc[a][b][1][1]), "+v"(acc[a][b][2][0]), "+v"(acc[a][b][2][1]), "+v"(acc[a][b][3][0]), "+v"(acc[a][b][3][1]));
        }
        const bool keep_acc = E(acc, cur, wr, wc, fr, fq);
        if (!has_next) break;
        if (!keep_acc)
#pragma unroll
        for (int a = 0; a < 2; ++a)
#pragma unroll
            for (int b = 0; b < 2; ++b)
#pragma unroll
                for (int m = 0; m < 4; ++m)
#pragma unroll
                    for (int n = 0; n < 2; ++n) acc[a][b][m][n] = (f32x4){0.f, 0.f, 0.f, 0.f};
        cur = nxt; cA = nA; cB = nB;
        if (wr == 1) PG8_BAR;
    }
    PG8_WAIT_V(0);
    PG8_BAR;
#undef PG8_AOFF
#undef PG8_SA
#undef PG8_SB
#undef PG8_STAGE
#undef PG8_LDA
#undef PG8_LDB
#undef PG8_MMA
#undef PG8_LD8
#undef PG8_WAIT_V
#undef PG8_WAIT_L
#undef PG8_BAR
#undef PG8_SCHED
}

struct EpiBf16 {
    static constexpr bool PERM = true;
    bf16_t* O; int ldc; const float* bias; int bias_estride; float ascale; int skip_from, skip_cols;
    __device__ __forceinline__ bool operator()(const f32x4 (&acc)[2][2][4][2], const Unit& u, int wr, int wc, int fr, int fq) const {
        const int row0 = u.pm * BM + wr * 64 + fr; const int col0 = u.pn * BM + wc * 32 + 8 * fq + (u.pn >= skip_from ? skip_cols : 0);
        f32x4 bv[2][2];
#pragma unroll
        for (int bj = 0; bj < 2; ++bj)
#pragma unroll
            for (int n = 0; n < 2; ++n) bv[bj][n] = bias ? *(const f32x4*)(bias + (size_t)u.e * bias_estride + col0 + bj * HALF + 4 * n) : (f32x4){0.f, 0.f, 0.f, 0.f};
#pragma unroll
        for (int ai = 0; ai < 2; ++ai)
#pragma unroll
            for (int m = 0; m < 4; ++m) { bf16_t* rowp = O + (size_t)(row0 + ai * HALF + m * 16) * ldc + col0;
#pragma unroll
                for (int bj = 0; bj < 2; ++bj) { const f32x4 v0 = acc[ai][bj][m][0] * ascale + bv[bj][0], v1 = acc[ai][bj][m][1] * ascale + bv[bj][1];
                    u32x4 w; w.x = cvt_pk_bf16(v0[0], v0[1]); w.y = cvt_pk_bf16(v0[2], v0[3]); w.z = cvt_pk_bf16(v1[0], v1[1]); w.w = cvt_pk_bf16(v1[2], v1[3]);
                    *(u32x4*)(rowp + bj * HALF) = w; } }
        return false;
    }
};
__device__ __forceinline__ float swiglu1(float ug, float ul) {
    ug = fminf(ug, 7.0f); ul = fminf(fmaxf(ul, -7.0f), 7.0f);
    return ug * __builtin_amdgcn_rcpf(1.0f + __expf(-1.702f * ug)) * (ul + 1.0f);
}
struct EpiSwiglu {
    static constexpr bool PERM = true;
    unsigned char* O; const float* b1;
    __device__ __forceinline__ bool operator()(const f32x4 (&acc)[2][2][4][2], const Unit& u, int wr, int wc, int fr, int fq) const {
        const int row0 = u.pm * BM + wr * 64 + fr; const int c0 = u.pn * 128 + wc * 32 + 8 * fq;
        const float* bg = b1 + (size_t)u.e * 4096 + c0; const float* bl = bg + 2048;
        f32x4 bgv[2], blv[2];
#pragma unroll
        for (int n = 0; n < 2; ++n) { bgv[n] = *(const f32x4*)(bg + 4 * n); blv[n] = *(const f32x4*)(bl + 4 * n); }
#pragma unroll
        for (int ai = 0; ai < 2; ++ai)
#pragma unroll
            for (int m = 0; m < 4; ++m) {
                float a[8];
#pragma unroll
                for (int n = 0; n < 2; ++n)
#pragma unroll
                    for (int j = 0; j < 4; ++j) a[4 * n + j] = ACT8_SCALE * swiglu1(acc[ai][0][m][n][j] * (1.0f / W8_SCALE) + bgv[n][j], acc[ai][1][m][n][j] * (1.0f / W8_SCALE) + blv[n][j]);
                u32x2 w; w.x = pack4_fp8(a[0], a[1], a[2], a[3]); w.y = pack4_fp8(a[4], a[5], a[6], a[7]);
                *(u32x2*)(O + (size_t)(row0 + ai * HALF + m * 16) * 2048 + c0) = w;
            }
        return false;
    }
};

struct TwoPartOrder {
    StaticOrder so; Unit held; int part;
    __device__ void init(int M, int N, int G_, int c_) { so.init(M, N, G_, c_); part = 0; }
    __device__ bool next(Unit& u) { if (part == 1) { u = held; u.e = 1; part = 0; return true; } if (!so.next(held)) return false; u = held; u.e = 0; part = 1; return true; }
};
struct EpiGate2 {
    static constexpr bool PERM = true;
    unsigned char* O; const bf16_t* Ga; const bf16_t* Gr;
    __device__ __forceinline__ bool operator()(f32x4 (&acc)[2][2][4][2], const Unit& u, int wr, int wc, int fr, int fq) const {
        const int row0 = u.pm * BM + wr * 64 + fr; const int col0 = u.pn * BM + wc * 32 + 8 * fq;
#pragma unroll
        for (int ai = 0; ai < 2; ++ai)
#pragma unroll
            for (int m = 0; m < 4; ++m) { const size_t row = (size_t)(row0 + ai * HALF + m * 16);
#pragma unroll
                for (int bj = 0; bj < 2; ++bj) { const int c = col0 + bj * HALF;
                    const u32x4 gr = *(const u32x4*)(Gr + row * DINP + c);
                    if (u.e == 0) {
                        const u32x4 ga = *(const u32x4*)(Ga + row * DINP + c);
#pragma unroll
                        for (int q = 0; q < 4; ++q) {
                            const float r0 = (1.0f + __expf(-bf_lo(gr[q]))) * __builtin_amdgcn_rcpf(1.0f + __expf(-bf_lo(ga[q]))), r1 = (1.0f + __expf(-bf_hi(gr[q]))) * __builtin_amdgcn_rcpf(1.0f + __expf(-bf_hi(ga[q])));
                            acc[ai][bj][m][q >> 1][(2 * q) & 3] *= r0; acc[ai][bj][m][q >> 1][(2 * q + 1) & 3] *= r1; }
                    } else {
                        float r[8];
#pragma unroll
                        for (int q = 0; q < 4; ++q) { r[2 * q] = sigmoidf_(bf_lo(gr[q])) * acc[ai][bj][m][q >> 1][(2 * q) & 3]; r[2 * q + 1] = sigmoidf_(bf_hi(gr[q])) * acc[ai][bj][m][q >> 1][(2 * q + 1) & 3]; }
                        u32x2 w; constexpr float osc = MRG8_SCALE / (W8_SCALE * OP8_SCALE); w.x = pack4_fp8(r[0] * osc, r[1] * osc, r[2] * osc, r[3] * osc); w.y = pack4_fp8(r[4] * osc, r[5] * osc, r[6] * osc, r[7] * osc);
                        *(u32x2*)(O + row * 2048 + c) = w; } } }
        return u.e == 0;
    }
};
struct EpiDelta {
    static constexpr bool PERM = true;
    const float* gt; bf16_t* DL; float ascale;
    __device__ __forceinline__ bool operator()(const f32x4 (&acc)[2][2][4][2], const Unit& u, int wr, int wc, int fr, int fq) const {
        const int row0 = u.pm * BM + wr * 64 + fr; const int col0 = u.pn * BM + wc * 32 + 8 * fq;
        f32x4 g[2][2];
#pragma unroll
        for (int bj = 0; bj < 2; ++bj)
#pragma unroll
            for (int n = 0; n < 2; ++n) g[bj][n] = *(const f32x4*)(gt + col0 + bj * HALF + 4 * n);
#pragma unroll
        for (int ai = 0; ai < 2; ++ai)
#pragma unroll
            for (int m = 0; m < 4; ++m) { bf16_t* rowp = DL + (size_t)(row0 + ai * HALF + m * 16) * 2048 + col0;
#pragma unroll
                for (int bj = 0; bj < 2; ++bj) { const f32x4 v0 = acc[ai][bj][m][0] * ascale * g[bj][0], v1 = acc[ai][bj][m][1] * ascale * g[bj][1];
                    u32x4 w; w.x = cvt_pk_bf16(v0[0], v0[1]); w.y = cvt_pk_bf16(v0[2], v0[3]); w.z = cvt_pk_bf16(v1[0], v1[1]); w.w = cvt_pk_bf16(v1[2], v1[3]);
                    *(u32x4*)(rowp + bj * HALF) = w; } }
        return false;
    }
};
}

struct Args { const void* in[22]; float* out; unsigned char* ws; int ph_lo, ph_hi, flags, pad; };
constexpr int XCONV = 0, XSCORE = 96;
constexpr int CW_SCQ = 12288, SCP = 5, CW_ATQ = 12352;
enum { PH_PRO = 0, PH_H, PH_INPROJ, PH_POST, PH_SCORE, PH_SELECT, PH_ATTN, PH_OP1, PH_OP2, PH_WOUT, PH_ROUTER, PH_SCATTER, PH_MOE1, PH_MOE2, PH_FINAL, NPH };

__device__ __forceinline__ int dest_row(int mode, int n) {
    if (mode == 1) return n < 2640 ? n : n + 176;
    if (mode == 2) { const int g = n >> 11, c = n & 2047; return (c >> 7) * 256 + g * 128 + (c & 127); }
    return n;
}
__device__ __forceinline__ void convert_item(const float* __restrict__ W, int K, int N, int ld, bf16_t* WT, int mode, int item, int lane, LAS unsigned char* scr) {
    const int nblk = (N + 63) >> 6; const int kb = item / nblk, nb = item - kb * nblk; const int k0 = kb * 128, n0 = nb * 64;
    const int c4 = lane & 15, kr = lane >> 4;
    const bool ok = (n0 + 4 * c4) < N;
    const float* src = W + (size_t)(k0 + 2 * kr) * ld + n0 + 4 * c4;
#pragma unroll 4
    for (int i = 0; i < 16; ++i) {
        f32x4 v0 = (f32x4){0.f, 0.f, 0.f, 0.f}, v1 = v0;
        if (ok) { v0 = *(const f32x4*)(src + (size_t)(8 * i) * ld); v1 = *(const f32x4*)(src + (size_t)(8 * i + 1) * ld); }
        const int kk = 8 * i + 2 * kr;
#pragma unroll
        for (int e = 0; e < 4; ++e) *(LAS unsigned*)(scr + (4 * c4 + e) * 272 + kk * 2) = cvt_pk_bf16(v0[e], v1[e]);
    }
    LDS_WAIT(); asm volatile("" ::: "memory");
#pragma unroll 4
    for (int j = 0; j < 16; ++j) {
        const int q = j * 64 + lane, n = q >> 4, ch = q & 15;
        const u32x4 v = *(const LAS u32x4*)(scr + n * 272 + ch * 16);
        if (n0 + n < N) *(u32x4*)(WT + (size_t)dest_row(mode, n0 + n) * K + k0 + ch * 8) = v;
    }
    LDS_WAIT(); asm volatile("" ::: "memory");
}


__device__ __forceinline__ bf16_t f2bf(float f) { unsigned u = __float_as_uint(f); return (bf16_t)((u + 0x7fffu + ((u >> 16) & 1u)) >> 16); }
__device__ __forceinline__ float bfx(const u32x4& w, int i) { const unsigned u = w[i >> 1]; return (i & 1) ? bf_hi(u) : bf_lo(u); }
__device__ __forceinline__ void rope_sc(float pos, float inv, float& sn, float& cs) {
    const float ang = pos * inv;
    const double a = (double)ang; const double n = __builtin_rint(a * 0.15915494309189535); const float r = (float)(a - n * 6.283185307179586);
    sn = __sinf(r); cs = __cosf(r);
}
__device__ __forceinline__ void post_token(bf16_t* PROJ, bf16_t* KI, unsigned char* KC, unsigned char* VC, const int* positions, const float* kng, const float* knb, float inv16, float inv8, int t, int lane) {
    const float pos = (float)positions[t];
    bf16_t* row = PROJ + (size_t)t * DINP;
    float sn, cs, sn8, cs8;
    rope_sc(pos, inv16, sn, cs); rope_sc(pos, inv8, sn8, cs8);
#pragma unroll
    for (int i = 0; i < 2; ++i) {
        const int pp = lane + 64 * i, hd = pp >> 4, ii = pp & 15;
        bf16_t* p = row + CQ + hd * 128 + ii; const float a = bf2f(p[0]), b = bf2f(p[16]);
        p[0] = f2bf(a * cs - b * sn); p[16] = f2bf(b * cs + a * sn);
    }
#pragma unroll
    for (int i = 0; i < 2; ++i) {
        const int pp = lane + 64 * i, hd = pp >> 3, ii = pp & 7;
        bf16_t* p = row + CQI + hd * 64 + ii; const float a = bf2f(p[0]), b = bf2f(p[8]);
        p[0] = f2bf(a * cs8 - b * sn8); p[8] = f2bf(b * cs8 + a * sn8);
    }
    if (lane < 32) {
        const int g = lane >> 4, ii = lane & 15;
        const bf16_t* p = row + CK + g * 128 + ii; const float a = bf2f(p[0]), b = bf2f(p[16]);
        unsigned char* o = KC + (size_t)t * 256 + g * 128 + ii; o[0] = fp8_1(a * cs - b * sn); o[16] = fp8_1(b * cs + a * sn);
    }
#pragma unroll
    for (int i = 0; i < 3; ++i) { const int idx = lane + 64 * i, g = idx / 96, r = idx - g * 96; KC[(size_t)t * 256 + g * 128 + 32 + r] = fp8_1(bf2f(row[CK + g * 128 + 32 + r])); }
    { const u32x2 w = *(const u32x2*)(row + CV + 4 * lane); *(unsigned*)(VC + (size_t)t * 256 + 4 * lane) = pack4_fp8(bf_lo(w.x), bf_hi(w.x), bf_lo(w.y), bf_hi(w.y)); }
    {
        const float v = bf2f(row[CKI + lane]);
        const float mean = wave_sum(v) * (1.0f / 64.0f); const float d = v - mean; const float var = wave_sum(d * d) * (1.0f / 64.0f);
        const float y = d * rsqrtf(var + NORM_EPS) * kng[lane] + knb[lane];
        const float other = __shfl_xor(y, 8);
        float o = y;
        if (lane < 8) o = y * cs8 - other * sn8; else if (lane < 16) o = y * cs8 + other * sn8;
        KI[(size_t)t * 64 + lane] = f2bf(o);
    }
}

constexpr int HG_GB = 0, HG_Q1 = 33792, HG_Q2 = 51200, HG_K2 = 68608, HG_VT = 86016, HG_PB = 104448, HG_LB = 113664;
__device__ __forceinline__ void hgrn_cumsum(LAS unsigned char* lds, const u32x4& w0, const u32x4& w1, float l0, float l1, int tid) {
    LAS float* GB = (LAS float*)(lds + HG_GB); LAS float* LB = (LAS float*)(lds + HG_LB); LAS float* SEG = (LAS float*)(lds + HG_LB + 512);
    if (tid < 128) LB[tid] = 1.0f / (1.0f + expf(l1 - l0));
    __syncthreads();
    const int t = tid >> 3, dseg = tid & 7;
#pragma unroll
    for (int i = 0; i < 16; ++i) { const float z = i < 8 ? bfx(w0, i) : bfx(w1, i - 8); const float lb = LB[16 * dseg + i]; GB[t * 128 + 16 * dseg + i] = __logf(lb + (1.0f - lb) * sigmoidf_(z)); }
    __syncthreads();
    const int d = tid & 127, tq = tid >> 7;
    float z[16];
#pragma unroll
    for (int i = 0; i < 16; ++i) z[i] = GB[(16 * tq + i) * 128 + d];
    float a = 0.f;
#pragma unroll
    for (int i = 0; i < 16; ++i) { a += z[i]; z[i] = a; }
    SEG[tq * 128 + d] = a;
    __syncthreads();
    float pre = 0.f;
    for (int q = 0; q < tq; ++q) pre += SEG[q * 128 + d];
#pragma unroll
    for (int i = 0; i < 16; ++i) GB[(16 * tq + i) * 128 + d] = z[i] + pre;
    __syncthreads();
}
__device__ __forceinline__ void hgrn_vt(LAS unsigned char* lds, const u32x4& a, const u32x4& b, int tid) {
    const int s2 = tid & 31, eg = tid >> 5;
#pragma unroll
    for (int i = 0; i < 8; ++i) { const unsigned lo = (i & 1) ? (a[i >> 1] >> 16) : (a[i >> 1] & 0xffffu), hi = (i & 1) ? (b[i >> 1] >> 16) : (b[i >> 1] & 0xffffu);
        *(LAS unsigned*)(lds + HG_VT + (8 * eg + i) * 144 + s2 * 4) = lo | (hi << 16); }
}
__device__ __forceinline__ void hgrn_l1(LAS unsigned char* lds, const bf16_t* PROJ, const float* lb_logits, bf16_t* ST, float* DC, int c, int h, int tid, int wave, int lane) {
    const int t = tid >> 3, dseg = tid & 7, s2 = tid & 31, dg = tid >> 5;
    const bf16_t* pf = PROJ + (size_t)(c * 64 + t) * DINP + CHF + h * 128 + 16 * dseg;
    const bf16_t* pk = PROJ + (size_t)(c * 64 + 2 * s2) * DINP + CHF + h * 128 + 8 * dg;
    const u32x4 w0 = *(const u32x4*)pf, w1 = *(const u32x4*)(pf + 8);
    const u32x4 ka = *(const u32x4*)pk, kb = *(const u32x4*)(pk + DINP);
    const u32x4 va = *(const u32x4*)(pk - CHF + CHI), vb = *(const u32x4*)(pk - CHF + CHI + DINP);
    const float l0 = lb_logits[h * 128 + (tid & 127)], l1 = lb_logits[1024 + h * 128 + (tid & 127)];
    hgrn_cumsum(lds, w0, w1, l0, l1, tid);
    const LAS float* GB = (const LAS float*)(lds + HG_GB); const LAS float* LB = (const LAS float*)(lds + HG_LB);
    {
#pragma unroll
        for (int i = 0; i < 8; ++i) { const int d = 8 * dg + i; const float lb = LB[d], b63 = GB[63 * 128 + d];
            const float k0 = (1.0f - lb) * (1.0f - sigmoidf_(bfx(ka, i))), k1 = (1.0f - lb) * (1.0f - sigmoidf_(bfx(kb, i)));
            const float v0 = k0 * __expf(b63 - GB[(2 * s2) * 128 + d]), v1 = k1 * __expf(b63 - GB[(2 * s2 + 1) * 128 + d]);
            *(LAS unsigned*)(lds + HG_Q1 + d * 144 + s2 * 4) = cvt_pk_bf16(v0, v1); }
    }
    hgrn_vt(lds, va, vb, tid);
    __syncthreads();
    const int fr = lane & 15, fq = lane >> 4;
    bf16x8 af[2];
#pragma unroll
    for (int ks = 0; ks < 2; ++ks) af[ks] = *(const LAS bf16x8*)(lds + HG_VT + (16 * wave + fr) * 144 + (32 * ks + 8 * fq) * 2);
    bf16_t* dst = ST + ((size_t)(c * 8 + h) * 128) * 128;
#pragma unroll 2
    for (int dt = 0; dt < 8; ++dt) {
        f32x4 acc = (f32x4){0.f, 0.f, 0.f, 0.f};
#pragma unroll
        for (int ks = 0; ks < 2; ++ks) { const bf16x8 bfr = *(const LAS bf16x8*)(lds + HG_Q1 + (16 * dt + fr) * 144 + (32 * ks + 8 * fq) * 2); acc = __builtin_amdgcn_mfma_f32_16x16x32_bf16(af[ks], bfr, acc, 0, 0, 0); }
#pragma unroll
        for (int r = 0; r < 4; ++r) dst[(size_t)(16 * wave + 4 * fq + r) * 128 + 16 * dt + fr] = f2bf(acc[r]);
    }
    if (tid < 128) DC[(size_t)(c * 8 + h) * 128 + tid] = __expf(GB[63 * 128 + tid]);
    __syncthreads();
}
__device__ __forceinline__ void hgrn_l3(LAS unsigned char* lds, const bf16_t* PROJ, const float* lb_logits, const bf16_t* ST, const float* norm_g, unsigned char* REC, int c, int h, int tid, int wave, int lane) {
    const int t = tid >> 3, dseg = tid & 7, s2 = tid & 31, eg = tid >> 5, fr = lane & 15, fq = lane >> 4;
    const bf16_t* pf = PROJ + (size_t)(c * 64 + t) * DINP + CHF + h * 128 + 16 * dseg;
    const u32x4 f0 = *(const u32x4*)pf, f1 = *(const u32x4*)(pf + 8), q0 = *(const u32x4*)(pf - CHF + CHQ), q1 = *(const u32x4*)(pf - CHF + CHQ + 8);
    const u32x4 g0 = *(const u32x4*)(pf - CHF + CHG), g1 = *(const u32x4*)(pf - CHF + CHG + 8);
    const bf16_t* pv = PROJ + (size_t)(c * 64 + 2 * s2) * DINP + CHI + h * 128 + 8 * eg;
    const u32x4 va = *(const u32x4*)pv, vb = *(const u32x4*)(pv + DINP);
    const bf16_t* sp = ST + ((size_t)(c * 8 + h) * 128 + 16 * wave + fr) * 128 + 8 * fq;
    u32x4 sx[4];
#pragma unroll
    for (int ks = 0; ks < 4; ++ks) sx[ks] = *(const u32x4*)(sp + 32 * ks);
    const float l0 = lb_logits[h * 128 + (tid & 127)], l1 = lb_logits[1024 + h * 128 + (tid & 127)];
    hgrn_cumsum(lds, f0, f1, l0, l1, tid);
    const LAS float* GB = (const LAS float*)(lds + HG_GB); const LAS float* LB = (const LAS float*)(lds + HG_LB);
    {
        unsigned o1[8], o2[8], o3[8];
#pragma unroll
        for (int i = 0; i < 16; i += 2) {
            float a1[2], a2[2], a3[2];
#pragma unroll
            for (int j = 0; j < 2; ++j) { const int d = 16 * dseg + i + j; const float lb = LB[d], b = GB[t * 128 + d], br = GB[31 * 128 + d];
                const float z = (i + j) < 8 ? bfx(f0, i + j) : bfx(f1, i + j - 8), qv = (i + j) < 8 ? bfx(q0, i + j) : bfx(q1, i + j - 8);
                const float k = (1.0f - lb) * (1.0f - sigmoidf_(z)), q = siluf_(qv);
                a1[j] = q * __expf(b); a2[j] = q * __expf(b - br); a3[j] = k * __expf(br - b); }
            o1[i >> 1] = cvt_pk_bf16(a1[0], a1[1]); o2[i >> 1] = cvt_pk_bf16(a2[0], a2[1]); o3[i >> 1] = cvt_pk_bf16(a3[0], a3[1]);
        }
        LAS u32x4* d1 = (LAS u32x4*)(lds + HG_Q1 + t * 272 + dseg * 32); LAS u32x4* d2 = (LAS u32x4*)(lds + HG_Q2 + t * 272 + dseg * 32); LAS u32x4* d3 = (LAS u32x4*)(lds + HG_K2 + t * 272 + dseg * 32);
        d1[0] = (u32x4){o1[0], o1[1], o1[2], o1[3]}; d1[1] = (u32x4){o1[4], o1[5], o1[6], o1[7]};
        d2[0] = (u32x4){o2[0], o2[1], o2[2], o2[3]}; d2[1] = (u32x4){o2[4], o2[5], o2[6], o2[7]};
        d3[0] = (u32x4){o3[0], o3[1], o3[2], o3[3]}; d3[1] = (u32x4){o3[4], o3[5], o3[6], o3[7]};
    }
    hgrn_vt(lds, va, vb, tid);
    __syncthreads();
#pragma unroll
    for (int q = 0; q < 2; ++q) {
        const int tile = 2 * wave + q, tt = tile >> 2, stl = tile & 3;
        f32x4 acc = (f32x4){0.f, 0.f, 0.f, 0.f};
#pragma unroll
        for (int ks = 0; ks < 4; ++ks) { const bf16x8 a = *(const LAS bf16x8*)(lds + HG_Q2 + (16 * tt + fr) * 272 + (32 * ks + 8 * fq) * 2), b = *(const LAS bf16x8*)(lds + HG_K2 + (16 * stl + fr) * 272 + (32 * ks + 8 * fq) * 2);
            acc = __builtin_amdgcn_mfma_f32_16x16x32_bf16(a, b, acc, 0, 0, 0); }
#pragma unroll
        for (int r = 0; r < 4; ++r) { const int tr_ = 16 * tt + 4 * fq + r, s = 16 * stl + fr; *(LAS bf16_t*)(lds + HG_PB + tr_ * 144 + s * 2) = f2bf(s <= tr_ ? acc[r] : 0.f); }
    }
    __syncthreads();
    {
        bf16x8 b1[2], b2[4];
#pragma unroll
        for (int ks = 0; ks < 2; ++ks) b1[ks] = *(const LAS bf16x8*)(lds + HG_VT + (16 * wave + fr) * 144 + (32 * ks + 8 * fq) * 2);
#pragma unroll
        for (int ks = 0; ks < 4; ++ks) b2[ks] = __builtin_bit_cast(bf16x8, sx[ks]);
        LAS float* OB = (LAS float*)(lds + HG_GB);
#pragma unroll
        for (int tt = 0; tt < 4; ++tt) {
            f32x4 acc = (f32x4){0.f, 0.f, 0.f, 0.f};
#pragma unroll
            for (int ks = 0; ks < 2; ++ks) { const bf16x8 a = *(const LAS bf16x8*)(lds + HG_PB + (16 * tt + fr) * 144 + (32 * ks + 8 * fq) * 2); acc = __builtin_amdgcn_mfma_f32_16x16x32_bf16(a, b1[ks], acc, 0, 0, 0); }
#pragma unroll
            for (int ks = 0; ks < 4; ++ks) { const bf16x8 a = *(const LAS bf16x8*)(lds + HG_Q1 + (16 * tt + fr) * 272 + (32 * ks + 8 * fq) * 2); acc = __builtin_amdgcn_mfma_f32_16x16x32_bf16(a, b2[ks], acc, 0, 0, 0); }
#pragma unroll
            for (int r = 0; r < 4; ++r) OB[(16 * tt + 4 * fq + r) * 132 + 16 * wave + fr] = acc[r];
        }
    }
    __syncthreads();
    {
        const int es = dseg; const LAS float* OB = (const LAS float*)(lds + HG_GB);
        float o[16]; float ss = 0.f;
#pragma unroll
        for (int i = 0; i < 16; ++i) { o[i] = OB[t * 132 + 16 * es + i]; ss += o[i] * o[i]; }
        ss += __shfl_xor(ss, 1); ss += __shfl_xor(ss, 2); ss += __shfl_xor(ss, 4);
        const float rstd = rsqrtf(ss * (1.0f / 128.0f) + NORM_EPS);
        float rv[16];
#pragma unroll
        for (int i = 0; i < 16; ++i) { const float ga = i < 8 ? bfx(g0, i) : bfx(g1, i - 8); rv[i] = o[i] * (rstd * OP8_SCALE) * norm_g[16 * es + i] * siluf_(ga); }
        *(u32x4*)(REC + (size_t)(c * 64 + t) * 1024 + h * 128 + 16 * es) = (u32x4){pack4_fp8(rv[0], rv[1], rv[2], rv[3]), pack4_fp8(rv[4], rv[5], rv[6], rv[7]), pack4_fp8(rv[8], rv[9], rv[10], rv[11]), pack4_fp8(rv[12], rv[13], rv[14], rv[15])};
    }
    __syncthreads();
}

constexpr int SC_KT = 0, SC_SB = 36864, SC_SPITCH = 132;
__device__ __forceinline__ unsigned pk_f16(float a, float b) { return __builtin_bit_cast(unsigned, __builtin_amdgcn_cvt_pkrtz(a, b)); }
__device__ __forceinline__ void score_flush(LAS unsigned char* lds, unsigned short* SCORES, unsigned short* SEGMAX, int t0, int kt, int tid) {
    const LAS float* sb = (const LAS float*)(lds + SC_SB + (kt & 1) * (32 * SC_SPITCH * 4));
    const int row = tid >> 4, seg = tid & 15;
    const f32x4 a = *(const LAS f32x4*)(sb + row * SC_SPITCH + seg * 8), b = *(const LAS f32x4*)(sb + row * SC_SPITCH + seg * 8 + 4);
    unsigned short* dst = SCORES + (size_t)(t0 + row) * S + kt * 128 + seg * 8;
    *(u32x4*)dst = (u32x4){pk_f16(a[0], a[1]), pk_f16(a[2], a[3]), pk_f16(b[0], b[1]), pk_f16(b[2], b[3])};
    const float mx = fmaxf(fmaxf(fmaxf(a[0], a[1]), fmaxf(a[2], a[3])), fmaxf(fmaxf(b[0], b[1]), fmaxf(b[2], b[3])));
    SEGMAX[(size_t)(t0 + row) * 2048 + kt * 16 + seg] = (unsigned short)(pk_f16(mx, mx) & 0xffffu);
}
__device__ __forceinline__ void score_block(LAS unsigned char* lds, const bf16_t* PROJ, const bf16_t* KI, unsigned short* SCORES, unsigned short* SEGMAX, int qb, int kt0, int kt1, int tid, int wave, int lane) {
    const int t0 = qb * 32;
    const int r = lane & 31, hh = lane >> 5;
    bf16x8 Af[2][4]; float wv[2][16]; f32x2 wv2[2][8];
#pragma unroll
    for (int p = 0; p < 2; ++p) {
        const int tq = t0 + 4 * wave + 2 * p + (r >> 4); const bf16_t* qrow = PROJ + (size_t)tq * DINP + CQI + (r & 15) * 64 + 8 * hh;
#pragma unroll
        for (int ks = 0; ks < 4; ++ks) Af[p][ks] = *(const bf16x8*)(qrow + 16 * ks);
#pragma unroll
        for (int qq = 0; qq < 2; ++qq) {
            const bf16_t* wp = PROJ + (size_t)(t0 + 4 * wave + 2 * p + qq) * DINP + CWI + 4 * hh;
            const u32x2 wa = *(const u32x2*)wp, wb = *(const u32x2*)(wp + 8);
            wv[p][8 * qq + 0] = bf_lo(wa.x) * (1.0f / 32.0f); wv[p][8 * qq + 1] = bf_hi(wa.x) * (1.0f / 32.0f); wv[p][8 * qq + 2] = bf_lo(wa.y) * (1.0f / 32.0f); wv[p][8 * qq + 3] = bf_hi(wa.y) * (1.0f / 32.0f);
            wv[p][8 * qq + 4] = bf_lo(wb.x) * (1.0f / 32.0f); wv[p][8 * qq + 5] = bf_hi(wb.x) * (1.0f / 32.0f); wv[p][8 * qq + 6] = bf_lo(wb.y) * (1.0f / 32.0f); wv[p][8 * qq + 7] = bf_hi(wb.y) * (1.0f / 32.0f);
        }
#pragma unroll
        for (int i = 0; i < 8; ++i) wv2[p][i] = (f32x2){wv[p][2 * i], wv[p][2 * i + 1]};
    }
    const u32x2 tagsw = __builtin_amdgcn_permlane32_swap(0u, 1u, false, false); const int qsel = (int)tagsw[0];
    u32x4 stg[2];
#pragma unroll
    for (int i = 0; i < 2; ++i) { const int q = tid + 512 * i; stg[i] = *(const u32x4*)(KI + (size_t)(kt0 * 128 + (q >> 3)) * 64 + (q & 7) * 8); }
#pragma unroll
    for (int i = 0; i < 2; ++i) { const int q = tid + 512 * i; *(LAS u32x4*)(lds + SC_KT + (kt0 & 1) * 18432 + (q >> 3) * 144 + (q & 7) * 16) = stg[i]; }
    __syncthreads();
    for (int kt = kt0; kt < kt1; ++kt) {
        const LAS unsigned char* buf = lds + SC_KT + (kt & 1) * 18432;
        LAS float* sb = (LAS float*)(lds + SC_SB + (kt & 1) * (32 * SC_SPITCH * 4));
        if (kt + 1 < kt1) {
#pragma unroll
            for (int i = 0; i < 2; ++i) { const int q = tid + 512 * i; stg[i] = *(const u32x4*)(KI + (size_t)((kt + 1) * 128 + (q >> 3)) * 64 + (q & 7) * 8); }
        }
        __builtin_amdgcn_sched_barrier(0);
        if (kt > kt0) score_flush(lds, SCORES, SEGMAX, t0, kt - 1, tid);
        {
        f32x16 accP[2], accC[2];
#define SC_MFMA(cb) do { bf16x8 Bf[4]; _Pragma("unroll") for (int ks = 0; ks < 4; ++ks) Bf[ks] = *(const LAS bf16x8*)(buf + (32 * (cb) + r) * 144 + (16 * ks + 8 * hh) * 2); \
            _Pragma("unroll") for (int p = 0; p < 2; ++p) { _Pragma("unroll") for (int i = 0; i < 16; ++i) accC[p][i] = 0.f; \
                _Pragma("unroll") for (int ks = 0; ks < 4; ++ks) accC[p] = __builtin_amdgcn_mfma_f32_32x32x16_bf16(Af[p][ks], Bf[ks], accC[p], 0, 0, 0); } } while (0)
#define SC_RED(acc, cb) do { _Pragma("unroll") for (int p = 0; p < 2; ++p) { f32x2 s0 = {0.f, 0.f}, s1 = {0.f, 0.f}; \
            _Pragma("unroll") for (int reg = 0; reg < 8; reg += 2) { const f32x2 r0 = {relu_i(acc[p][reg]), relu_i(acc[p][reg + 1])}; const f32x2 r1 = {relu_i(acc[p][reg + 8]), relu_i(acc[p][reg + 9])}; \
                s0 = __builtin_elementwise_fma(wv2[p][reg >> 1], r0, s0); s1 = __builtin_elementwise_fma(wv2[p][4 + (reg >> 1)], r1, s1); } \
            const float p0 = s0[0] + s0[1], p1 = s1[0] + s1[1]; \
            const u32x2 sw = __builtin_amdgcn_permlane32_swap(__float_as_uint(p0), __float_as_uint(p1), false, false); \
            sb[(4 * wave + 2 * p + qsel) * SC_SPITCH + 32 * (cb) + r] = __uint_as_float(sw[0]) + __uint_as_float(sw[1]); } } while (0)
#define SC_INTERLEAVE() do { _Pragma("unroll") for (int i = 0; i < 8; ++i) { __builtin_amdgcn_sched_group_barrier(0x008, 1, 0); __builtin_amdgcn_sched_group_barrier(0x002, 8, 0); } } while (0)
        SC_MFMA(0);
        accP[0] = accC[0]; accP[1] = accC[1]; SC_MFMA(1); SC_RED(accP, 0); SC_INTERLEAVE();
        accP[0] = accC[0]; accP[1] = accC[1]; SC_MFMA(2); SC_RED(accP, 1); SC_INTERLEAVE();
        accP[0] = accC[0]; accP[1] = accC[1]; SC_MFMA(3); SC_RED(accP, 2); SC_INTERLEAVE();
        SC_RED(accC, 3);
#undef SC_MFMA
#undef SC_RED
#undef SC_INTERLEAVE
        }
        if (kt + 1 < kt1) {
#pragma unroll
            for (int i = 0; i < 2; ++i) { const int q = tid + 512 * i; *(LAS u32x4*)(lds + SC_KT + ((kt + 1) & 1) * 18432 + (q >> 3) * 144 + (q & 7) * 16) = stg[i]; }
        }
        __syncthreads();
    }
    score_flush(lds, SCORES, SEGMAX, t0, kt1 - 1, tid);
    __syncthreads();
}

template <int NV, bool EXACT, int TOL = 2>
__device__ __forceinline__ float wave_kth(const float (&v)[NV], int K) {
    const float NINF = -__builtin_inff();
    float mx = NINF, mn = __builtin_inff();
#pragma unroll
    for (int j = 0; j < NV; ++j) { mx = fmaxf(mx, v[j]); mn = fminf(mn, v[j] == NINF ? __builtin_inff() : v[j]); }
    mx = wave_max(mx); mn = -wave_max(-mn);
    int c = 0;
#pragma unroll
    for (int j = 0; j < NV; ++j) c += __popcll(__ballot(v[j] >= mx));
    if (c >= K) return mx;
    float lo = mn, hi = mx, tau = mn;
    for (int it = 0; it < 64; ++it) {
        const float mid = 0.5f * (lo + hi);
        if (!(mid > lo && mid < hi)) { tau = lo; break; }
        c = 0;
#pragma unroll
        for (int j = 0; j < NV; ++j) c += __popcll(__ballot(v[j] >= mid));
        if (c == K || (!EXACT && c > K && c <= K + (K >> TOL))) { tau = mid; break; }
        if (c > K) lo = mid; else hi = mid;
        tau = lo;
    }
    return tau;
}
__device__ __forceinline__ float wave_kth16(const float (&v)[16], int K) { return wave_kth<16, true>(v, K); }
__device__ __forceinline__ int lanes_below(unsigned long long mask) { return (int)__builtin_amdgcn_mbcnt_hi((unsigned)(mask >> 32), __builtin_amdgcn_mbcnt_lo((unsigned)mask, 0u)); }
__device__ __forceinline__ float h2f(unsigned short h) { return (float)__builtin_bit_cast(_Float16, h); }
__device__ __forceinline__ float h2f_lo(unsigned u) { return h2f((unsigned short)(u & 0xffffu)); }
__device__ __forceinline__ float h2f_hi(unsigned u) { return h2f((unsigned short)(u >> 16)); }
__device__ __forceinline__ unsigned ge_mask8(const u32x4& v, unsigned T16) {
    unsigned m8 = 0;
#pragma unroll
    for (int w = 0; w < 4; ++w) { const unsigned vw_ = v[w];
        const s16x2 d = __builtin_elementwise_sub_sat(__builtin_bit_cast(s16x2, vw_), __builtin_bit_cast(s16x2, T16));
        const unsigned mm = ~__builtin_bit_cast(unsigned, d); m8 |= (((mm >> 15) & 1u) | ((mm >> 30) & 2u)) << (2 * w); }
    return m8;
}
__device__ __forceinline__ int append_bits(LAS int* list, int cnt, unsigned m8, int base) {
    for (;;) { const bool has = m8 != 0u; const unsigned long long mask = __ballot(has); if (!mask) break;
        const int pos = cnt + lanes_below(mask);
        if (has) { const int k = __builtin_ctz(m8); m8 &= m8 - 1u; if (pos < 1024) list[pos] = base + k; }
        cnt += __popcll(mask); }
    return cnt;
}
__device__ __forceinline__ int append_keys(LAS int* list, int cnt, unsigned m8, int base, const u32x4& v) {
    for (;;) { const bool has = m8 != 0u; const unsigned long long mask = __ballot(has); if (!mask) break;
        const int pos = cnt + lanes_below(mask);
        if (has) { const int k = __builtin_ctz(m8); m8 &= m8 - 1u;
            const unsigned dw = (k & 4) ? ((k & 2) ? v.w : v.z) : ((k & 2) ? v.y : v.x); const unsigned h = (k & 1) ? (dw >> 16) : (dw & 0xffffu);
            if (pos < 1024) list[pos] = (int)((h << 16) | (unsigned)(base + k)); }
        cnt += __popcll(mask); }
    return cnt;
}
__device__ __forceinline__ void select_row(LAS unsigned char* wl, const unsigned short* SCORES, const unsigned short* SEGMAX, int t, int lane) {
    LAS int* selw = (LAS int*)wl; LAS int* segl = (LAS int*)(wl + 1024); LAS int* cidx = (LAS int*)(wl + 5120);
    const float NINF = -__builtin_inff();
    const unsigned short* row = SCORES + (size_t)t * S; const int n = t + 1;
    float c[16]; int N;
    if (n <= 1024) {
#pragma unroll
        for (int j = 0; j < 16; ++j) { const int i = lane + 64 * j; c[j] = i < n ? h2f(row[i]) : NINF; }
        N = -1;
    } else {
        const u32x4 NEG = (u32x4){0xfc00fc00u, 0xfc00fc00u, 0xfc00fc00u, 0xfc00fc00u};
        const unsigned short* smrow = SEGMAX + (size_t)t * 2048; const int nseg = (t >> 3) + 1;
        const bool segpath = nseg >= 512;
        float s[16], s8[8];
        if (!segpath) {
#pragma unroll
            for (int j = 0; j < 16; ++j) { const int i = lane + 64 * j; s[j] = i < (n >> 4) ? h2f(row[16 * i + 7]) : NINF; }
        }
        u32x4 sv[4];
#pragma unroll
        for (int u = 0; u < 4; ++u) { const int e8 = 8 * (lane + 64 * u); sv[u] = (e8 < nseg) ? *(const u32x4*)(smrow + e8) : NEG; }
#pragma unroll
        for (int u = 0; u < 4; ++u) { const int e8 = 8 * (lane + 64 * u); s8[2 * u] = h2f_lo(sv[u].x); s8[2 * u + 1] = (e8 + 4 < nseg) ? h2f_lo(sv[u].z) : NINF; }
        const int m = segpath ? (nseg >> 2) : (n >> 4);
        int K = segpath ? 85 : 26, cnt = 0;
        for (;;) {
            const float tlo = (K >= m) ? NINF : (segpath ? wave_kth<8, false, 3>(s8, K) : wave_kth<16, false, 2>(s, K));
            cnt = 0;
            const int nq = (n + 511) >> 9;
            if (tlo > 0.f) {
                const unsigned T16 = pk_f16(tlo, tlo);
                int ns = 0;
                {
#pragma unroll
                    for (int u = 0; u < 4; ++u) if (512 * u < nseg) { const int e8 = 8 * (lane + 64 * u); unsigned m8 = ge_mask8(sv[u], T16);
                        const int nv = nseg - e8; if (nv < 8) m8 &= nv > 0 ? ((1u << nv) - 1u) : 0u;
                        ns = append_bits(segl, ns, m8, e8); }
                }
                if (ns > 1024) ns = 1024;
                for (int j0 = 0; j0 < ns; j0 += 512) {
                    u32x4 v[8]; int sg[8];
#pragma unroll
                    for (int u = 0; u < 8; ++u) { const int i = j0 + lane + 64 * u; sg[u] = i < ns ? segl[i] : -1; v[u] = sg[u] >= 0 ? *(const u32x4*)(row + 8 * sg[u]) : NEG; }
#pragma unroll
                    for (int u = 0; u < 8; ++u) if (j0 + 64 * u < ns) { const int e = 8 * sg[u]; unsigned m8 = sg[u] >= 0 ? ge_mask8(v[u], T16) : 0u;
                        const int nv = t + 1 - e; if (nv < 8) m8 &= nv > 0 ? ((1u << nv) - 1u) : 0u;
                        cnt = append_keys(cidx, cnt, m8, e, v[u]); }
                }
            } else {
                for (int q0 = 0; q0 < nq; q0 += 4) {
                    u32x4 v[4];
#pragma unroll
                    for (int u = 0; u < 4; ++u) { const int e = 8 * (lane + 64 * (q0 + u)); v[u] = (e <= t) ? *(const u32x4*)(row + e) : (u32x4){0xfc00fc00u, 0xfc00fc00u, 0xfc00fc00u, 0xfc00fc00u}; }
#pragma unroll
                    for (int u = 0; u < 4; ++u) { const int e = 8 * (lane + 64 * (q0 + u));
#pragma unroll
                        for (int k = 0; k < 8; ++k) { const float x = (k & 1) ? h2f_hi(v[u][k >> 1]) : h2f_lo(v[u][k >> 1]);
                            const bool pred = (e + k <= t) && (x >= tlo); const unsigned long long mask = __ballot(pred);
                            if (mask) { const int pos = cnt + lanes_below(mask); const unsigned hb = (k & 1) ? (v[u][k >> 1] >> 16) : (v[u][k >> 1] & 0xffffu);
                                if (pred && pos < 1024) cidx[pos] = (int)((hb << 16) | (unsigned)(e + k)); cnt += __popcll(mask); } } }
                }
            }
            if (cnt >= 256 || K >= m) break;
            K *= 2;
        }
        N = cnt < 1024 ? cnt : 1024;
#pragma unroll
        for (int j = 0; j < 16; ++j) { const int i = lane + 64 * j; c[j] = i < N ? h2f((unsigned short)((unsigned)cidx[i] >> 16)) : NINF; }
    }
    float tau;
    if (N >= 0 && N <= 512) { const float c8[8] = {c[0], c[1], c[2], c[3], c[4], c[5], c[6], c[7]}; tau = wave_kth<8, true>(c8, 256); }
    else tau = wave_kth16(c, 256);
    int base = 0;
#pragma unroll
    for (int j = 0; j < 16; ++j) { const bool pred = c[j] >= tau; const unsigned long long mask = __ballot(pred);
        if (mask) { const int pos = base + lanes_below(mask); if (pred && pos < 256) selw[pos] = (N < 0) ? (lane + 64 * j) : (cidx[lane + 64 * j] & 0xffff); base += __popcll(mask); } }
}

__device__ __forceinline__ void attn_query(LAS unsigned char* wl, const bf16_t* PROJ, const unsigned char* KC, const unsigned char* VC, unsigned char* ATT, int t, int lane) {
    LAS int* selw = (LAS int*)wl; LAS float* L = (LAS float*)(wl + 1024);
    const int nsel = t < 255 ? t + 1 : 256;
    const int fr = lane & 15, fq = lane >> 4;
    constexpr float QS = 8.0f;
    long qh[2][4], ql[2][4];
#pragma unroll
    for (int g = 0; g < 2; ++g)
#pragma unroll
        for (int ks = 0; ks < 4; ++ks) {
            u32x4 z = (u32x4){0u, 0u, 0u, 0u};
            if (fr < 4) z = *(const u32x4*)(PROJ + (size_t)t * DINP + CQ + (4 * g + fr) * 128 + 32 * ks + 8 * fq);
            float qv[8], rv[8];
#pragma unroll
            for (int e = 0; e < 4; ++e) { qv[2 * e] = bf_lo(z[e]) * QS; qv[2 * e + 1] = bf_hi(z[e]) * QS; }
            const unsigned h0 = pack4_fp8(qv[0], qv[1], qv[2], qv[3]), h1 = pack4_fp8(qv[4], qv[5], qv[6], qv[7]);
            rv[0] = qv[0] - __builtin_amdgcn_cvt_f32_fp8((int)h0, 0); rv[1] = qv[1] - __builtin_amdgcn_cvt_f32_fp8((int)h0, 1); rv[2] = qv[2] - __builtin_amdgcn_cvt_f32_fp8((int)h0, 2); rv[3] = qv[3] - __builtin_amdgcn_cvt_f32_fp8((int)h0, 3);
            rv[4] = qv[4] - __builtin_amdgcn_cvt_f32_fp8((int)h1, 0); rv[5] = qv[5] - __builtin_amdgcn_cvt_f32_fp8((int)h1, 1); rv[6] = qv[6] - __builtin_amdgcn_cvt_f32_fp8((int)h1, 2); rv[7] = qv[7] - __builtin_amdgcn_cvt_f32_fp8((int)h1, 3);
            const unsigned l0 = pack4_fp8(rv[0] * 16.0f, rv[1] * 16.0f, rv[2] * 16.0f, rv[3] * 16.0f), l1 = pack4_fp8(rv[4] * 16.0f, rv[5] * 16.0f, rv[6] * 16.0f, rv[7] * 16.0f);
            qh[g][ks] = (long)(((unsigned long long)h1 << 32) | h0); ql[g][ks] = (long)(((unsigned long long)l1 << 32) | l0);
        }
    const float scale = 0.08838834764831845f / QS;
    const int nkt = (nsel + 15) >> 4;
    {
        LAS unsigned char* KT = wl + 9216;
        const int q4_ = lane >> 4, l15_ = lane & 15;
        u32x4 kw[4][4];
#define QK_LOAD(buf, kt) do { _Pragma("unroll") for (int u = 0; u < 4; ++u) { const unsigned off_ = (unsigned)selw[16 * (kt) + 4 * u + q4_] * 256u + 16u * (unsigned)l15_; kw[buf][u] = *(const u32x4*)((const char*)KC + off_); } } while (0)
#define QK_COMP(buf, kt) do { _Pragma("unroll") for (int u = 0; u < 4; ++u) *(LAS u32x4*)(KT + (4 * u + q4_) * 272 + 16 * l15_) = kw[buf][u];     \
        _Pragma("unroll") for (int g = 0; g < 2; ++g) { f32x4 acch = (f32x4){0.f, 0.f, 0.f, 0.f}, accl = (f32x4){0.f, 0.f, 0.f, 0.f}; \
            _Pragma("unroll") for (int ks = 0; ks < 4; ++ks) { const long kf_ = *(const LAS long*)(KT + fr * 272 + g * 128 + 32 * ks + 8 * fq); \
                acch = __builtin_amdgcn_mfma_f32_16x16x32_fp8_fp8(qh[g][ks], kf_, acch, 0, 0, 0); accl = __builtin_amdgcn_mfma_f32_16x16x32_fp8_fp8(ql[g][ks], kf_, accl, 0, 0, 0); } \
            if (fq == 0) { _Pragma("unroll") for (int r = 0; r < 4; ++r) L[(4 * g + r) * 256 + 16 * (kt) + fr] = (16 * (kt) + fr < nsel) ? (acch[r] + accl[r] * 0.0625f) * scale : -__builtin_inff(); } } } while (0)
        QK_LOAD(0, 0); if (1 < nkt) QK_LOAD(1, 1); if (2 < nkt) QK_LOAD(2, 2);
        for (int kt = 0; kt < nkt; kt += 4) {
            if (kt + 3 < nkt) QK_LOAD(3, kt + 3);
            __builtin_amdgcn_sched_barrier(0);
            QK_COMP(0, kt);
            if (kt + 1 < nkt) { if (kt + 4 < nkt) QK_LOAD(0, kt + 4); __builtin_amdgcn_sched_barrier(0); QK_COMP(1, kt + 1); }
            if (kt + 2 < nkt) { if (kt + 5 < nkt) QK_LOAD(1, kt + 5); __builtin_amdgcn_sched_barrier(0); QK_COMP(2, kt + 2); }
            if (kt + 3 < nkt) { if (kt + 6 < nkt) QK_LOAD(2, kt + 6); __builtin_amdgcn_sched_barrier(0); QK_COMP(3, kt + 3); }
        }
#undef QK_LOAD
#undef QK_COMP
        if (fq == 0) { for (int kt = nkt; kt < 16; ++kt) {
#pragma unroll
            for (int r = 0; r < 8; ++r) L[r * 256 + 16 * kt + fr] = -__builtin_inff(); } }
    }
    float p[8][4];
#pragma unroll
    for (int hd = 0; hd < 8; ++hd) { float m = -__builtin_inff();
#pragma unroll
        for (int i = 0; i < 4; ++i) { p[hd][i] = L[hd * 256 + 4 * lane + i]; m = fmaxf(m, p[hd][i]); }
        m = wave_max(m); float s = 0.f;
#pragma unroll
        for (int i = 0; i < 4; ++i) { p[hd][i] = __expf(p[hd][i] - m); s += p[hd][i]; }
        s = __builtin_amdgcn_rcpf(wave_sum(s));
#pragma unroll
        for (int i = 0; i < 4; ++i) p[hd][i] *= s; }
    constexpr float PS = 256.0f;
    LAS unsigned* Ph = (LAS unsigned*)(wl + 1024); LAS unsigned* Pl = (LAS unsigned*)(wl + 1024 + 2048);
#pragma unroll
    for (int hd = 0; hd < 8; ++hd) {
        const float a0 = p[hd][0] * PS, a1 = p[hd][1] * PS, a2 = p[hd][2] * PS, a3 = p[hd][3] * PS;
        const unsigned h = pack4_fp8(a0, a1, a2, a3);
        const unsigned l = pack4_fp8(a0 - __builtin_amdgcn_cvt_f32_fp8((int)h, 0), a1 - __builtin_amdgcn_cvt_f32_fp8((int)h, 1), a2 - __builtin_amdgcn_cvt_f32_fp8((int)h, 2), a3 - __builtin_amdgcn_cvt_f32_fp8((int)h, 3));
        Ph[hd * 64 + lane] = h; Pl[hd * 64 + lane] = l;
    }
    LAS unsigned char* VT = wl + 9216;
    const int ii = lane & 15, kq = lane >> 4;
    f32x4 acc[16];
#pragma unroll
    for (int nt = 0; nt < 16; ++nt) acc[nt] = (f32x4){0.f, 0.f, 0.f, 0.f};
    const int nch = (nsel + 15) >> 4;
    u32x4 vw[4][4];
#define PV_LOAD(buf, c) do { _Pragma("unroll") for (int u = 0; u < 4; ++u) { const unsigned off_ = (unsigned)selw[16 * (c) + 4 * u + kq] * 256u + 16u * (unsigned)ii; vw[buf][u] = *(const u32x4*)((const char*)VC + off_); } } while (0)
#define PV_COMP(buf, c) do { _Pragma("unroll") for (int u = 0; u < 4; ++u) { LAS u32x2* d_ = (LAS u32x2*)(VT + (16 * ((c) & 1) + 4 * u + kq) * 264 + 16 * ii); d_[0] = (u32x2){vw[buf][u].x, vw[buf][u].y}; d_[1] = (u32x2){vw[buf][u].z, vw[buf][u].w}; } \
        if (((c) & 1) || (c) == nch - 1) { \
            if (!((c) & 1)) { _Pragma("unroll") for (int u = 0; u < 4; ++u) { LAS u32x2* d_ = (LAS u32x2*)(VT + (16 + 4 * u + kq) * 264 + 16 * ii); d_[0] = (u32x2){0u, 0u}; d_[1] = (u32x2){0u, 0u}; } } \
            long pa[2]; _Pragma("unroll") for (int g = 0; g < 2; ++g) { const int po_ = (g * 4 + (ii & 3)) * 256 + 32 * ((c) >> 1) + 8 * kq;     \
                const long h_ = *(const LAS long*)((const LAS unsigned char*)Ph + po_ + ((ii & 4) ? 2048 : 0)); pa[g] = ii < 8 ? h_ : 0l; } \
            _Pragma("unroll") for (int nt = 0; nt < 16; ++nt) { const v2i32 t_ = __builtin_amdgcn_ds_read_tr8_b64_v2i32((LAS v2i32*)(VT + (8 * kq + (ii >> 1)) * 264 + 16 * nt + 8 * (ii & 1))); \
                const long b_ = __builtin_bit_cast(long, t_); \
                acc[nt] = __builtin_amdgcn_mfma_f32_16x16x32_fp8_fp8(pa[nt >> 3], b_, acc[nt], 0, 0, 0); } } } while (0)
    PV_LOAD(0, 0); if (1 < nch) PV_LOAD(1, 1); if (2 < nch) PV_LOAD(2, 2);
    for (int c = 0; c < nch; c += 4) {
        if (c + 3 < nch) PV_LOAD(3, c + 3);
        __builtin_amdgcn_sched_barrier(0);
        PV_COMP(0, c);
        if (c + 1 < nch) { if (c + 4 < nch) PV_LOAD(0, c + 4); __builtin_amdgcn_sched_barrier(0); PV_COMP(1, c + 1); }
        if (c + 2 < nch) { if (c + 5 < nch) PV_LOAD(1, c + 5); __builtin_amdgcn_sched_barrier(0); PV_COMP(2, c + 2); }
        if (c + 3 < nch) { if (c + 6 < nch) PV_LOAD(2, c + 6); __builtin_amdgcn_sched_barrier(0); PV_COMP(3, c + 3); }
    }
#undef PV_LOAD
#undef PV_COMP
    LAS float* OB = (LAS float*)(wl + 1024 + 4096);
    LAS float* OB2 = (LAS float*)(wl + 1024);
    if (kq < 2) {
        LAS float* ob = kq == 0 ? OB : OB2;
#pragma unroll
        for (int nt = 0; nt < 16; ++nt)
#pragma unroll
            for (int r = 0; r < 4; ++r) ob[(4 * (nt >> 3) + r) * 128 + 16 * (nt & 7) + ii] = acc[nt][r];
    }
    {
        const f32x4 a0 = *(const LAS f32x4*)(OB + 16 * lane) + *(const LAS f32x4*)(OB2 + 16 * lane), a1 = *(const LAS f32x4*)(OB + 16 * lane + 4) + *(const LAS f32x4*)(OB2 + 16 * lane + 4),
                    a2 = *(const LAS f32x4*)(OB + 16 * lane + 8) + *(const LAS f32x4*)(OB2 + 16 * lane + 8), a3 = *(const LAS f32x4*)(OB + 16 * lane + 12) + *(const LAS f32x4*)(OB2 + 16 * lane + 12);
        const f32x4 b0 = a0 * (OP8_SCALE / PS), b1 = a1 * (OP8_SCALE / PS), b2 = a2 * (OP8_SCALE / PS), b3 = a3 * (OP8_SCALE / PS);
        *(u32x4*)(ATT + (size_t)t * 1024 + 16 * lane) = (u32x4){pack4_fp8(b0[0], b0[1], b0[2], b0[3]), pack4_fp8(b1[0], b1[1], b1[2], b1[3]), pack4_fp8(b2[0], b2[1], b2[2], b2[3]), pack4_fp8(b3[0], b3[1], b3[2], b3[3])};
    }
}


__device__ __forceinline__ void convert_item8(const float* __restrict__ W, int K, int N, int ld, unsigned char* WT, int mode, int item, int lane, LAS unsigned char* scr) {
    const int nblk = N >> 6; const int kb = item / nblk, nb = item - kb * nblk; const int k0 = kb * 256, n0 = nb * 64;
    const int c4 = lane & 15, kr = lane >> 4;
    const float* src = W + (size_t)(k0 + 4 * kr) * ld + n0 + 4 * c4;
#pragma unroll 4
    for (int i = 0; i < 16; ++i) {
        f32x4 v[4];
#pragma unroll
        for (int r = 0; r < 4; ++r) v[r] = __builtin_nontemporal_load((const f32x4*)(src + (size_t)(16 * i + r) * ld));
        const int kk = 16 * i + 4 * kr;
#pragma unroll
        for (int e = 0; e < 4; ++e) *(LAS unsigned*)(scr + (4 * c4 + e) * 272 + kk) = pack4_fp8(v[0][e] * W8_SCALE, v[1][e] * W8_SCALE, v[2][e] * W8_SCALE, v[3][e] * W8_SCALE);
    }
    LDS_WAIT(); asm volatile("" ::: "memory");
#pragma unroll 4
    for (int j = 0; j < 16; ++j) {
        const int q = j * 64 + lane, n = q >> 4, ch = q & 15;
        const u32x4 v = *(const LAS u32x4*)(scr + n * 272 + ch * 16);
        *(u32x4*)(WT + (size_t)dest_row(mode, n0 + n) * K + k0 + ch * 16) = v;
    }
    LDS_WAIT(); asm volatile("" ::: "memory");
}

struct Conv8Job { const float* W; unsigned char* WT; int N; int mode; size_t w_estride, wt_estride; int items_per_e; };
constexpr int C8_PITCH = 272, C8_IMG = 256 * C8_PITCH;
__device__ __forceinline__ void conv8_load(const Conv8Job& jb, int item, int h, int wave, int lane, f32x4 (&v)[16]) {
    const int e = item / jb.items_per_e, r = item - e * jb.items_per_e; const int nblk = jb.N >> 8; const int kb = r / nblk, nb = r - kb * nblk;
    const float* src = jb.W + (size_t)e * jb.w_estride + (size_t)(kb * 256 + 32 * wave + 16 * h) * jb.N + nb * 256 + 4 * lane;
#pragma unroll
    for (int i = 0; i < 16; ++i) v[i] = __builtin_nontemporal_load((const f32x4*)(src + (size_t)i * jb.N));
}
__device__ __forceinline__ void conv8_to_lds(LAS unsigned char* img, int h, int wave, int lane, const f32x4 (&v)[16]) {
#pragma unroll
    for (int e = 0; e < 4; ++e) { u32x4 w;
#pragma unroll
        for (int g = 0; g < 4; ++g) w[g] = pack4_fp8(v[4 * g][e] * W8_SCALE, v[4 * g + 1][e] * W8_SCALE, v[4 * g + 2][e] * W8_SCALE, v[4 * g + 3][e] * W8_SCALE);
        *(LAS u32x4*)(img + (4 * lane + e) * C8_PITCH + 32 * wave + 16 * h) = w; }
}
__device__ __forceinline__ void conv8_store(const Conv8Job& jb, int item, const LAS unsigned char* img, int tid) {
    const int e = item / jb.items_per_e, r = item - e * jb.items_per_e; const int nblk = jb.N >> 8; const int kb = r / nblk, nb = r - kb * nblk;
    unsigned char* dst = jb.WT + (size_t)e * jb.wt_estride + kb * 256;
#pragma unroll
    for (int j = 0; j < 8; ++j) { const int q = j * 512 + tid, n = q >> 4, ch = q & 15;
        __builtin_nontemporal_store(*(const LAS u32x4*)(img + n * C8_PITCH + ch * 16), (u32x4*)(dst + (size_t)dest_row(jb.mode, nb * 256 + n) * 2048 + ch * 16)); }
}
__device__ __forceinline__ void conv8_run(LAS unsigned char* lds, const Conv8Job& jb, int n_items, int wg, int G, int tid, int wave, int lane) {
    if (wg >= n_items) return;
    f32x4 a[16], b[16]; int par = 0;
    conv8_load(jb, wg, 0, wave, lane, a); conv8_load(jb, wg, 1, wave, lane, b);
    for (int it = wg; it < n_items; it += G, par ^= 1) {
        LAS unsigned char* img = lds + par * C8_IMG;
        const int nx = (it + G < n_items) ? it + G : it;
        conv8_to_lds(img, 0, wave, lane, a); __builtin_amdgcn_sched_barrier(0);
        conv8_load(jb, nx, 0, wave, lane, a); __builtin_amdgcn_sched_barrier(0);
        conv8_to_lds(img, 1, wave, lane, b); __builtin_amdgcn_sched_barrier(0);
        conv8_load(jb, nx, 1, wave, lane, b); __builtin_amdgcn_sched_barrier(0);
        __syncthreads();
        conv8_store(jb, it, img, tid);
    }
    __syncthreads();
}

__global__ void __launch_bounds__(NTHR, 2) fwd_kernel(Args args) {
    extern __shared__ __attribute__((aligned(16))) unsigned char lds_raw[];
    LAS unsigned char* lds = (LAS unsigned char*)lds_raw;
    volatile LAS unsigned* MISC = (volatile LAS unsigned*)(lds + LDS_MISC);
    const int tid = threadIdx.x, lane = tid & 63, wave = __builtin_amdgcn_readfirstlane(tid >> 6);
    const int G = gridDim.x, wg = blockIdx.x;
    unsigned char* ws = args.ws;
    unsigned* ctl = (unsigned*)(ws + WS_CTL);
    const int lo = args.ph_lo, hi = args.ph_hi;
    const float* x = (const float*)args.in[0]; const float* cvec = (const float*)args.in[1]; const int* positions = (const int*)args.in[2];
    const float* w_ada = (const float*)args.in[3]; const float* b_ada = (const float*)args.in[4]; const float* norm1_g = (const float*)args.in[5];
    const float* w_in = (const float*)args.in[6]; const float* idx_knorm_g = (const float*)args.in[7]; const float* idx_knorm_b = (const float*)args.in[8];
    const float* lb_logits = (const float*)args.in[9]; const float* hgrn_norm_g = (const float*)args.in[10];
    const float* w_proj_att = (const float*)args.in[11]; const float* w_proj_hgrn = (const float*)args.in[12]; const float* w_out = (const float*)args.in[13];
    const float* norm2_g = (const float*)args.in[14]; const float* w_router = (const float*)args.in[15]; const float* b_router = (const float*)args.in[16];
    const float* w1 = (const float*)args.in[17]; const float* b1 = (const float*)args.in[18]; const float* w2 = (const float*)args.in[19]; const float* b2 = (const float*)args.in[20];
    const float* final_g = (const float*)args.in[21];
    float* out = args.out;
    float* MOD = (float*)(ws + WS_MOD); int* TOPE = (int*)(ws + WS_TOPE); float* GATE = (float*)(ws + WS_GATE); int* SLOT = (int*)(ws + WS_SLOT);
    bf16_t* WIN_T = (bf16_t*)(ws + WS_WIN_T); bf16_t* WA_T = (bf16_t*)(ws + WS_WA_T); bf16_t* WH_T = (bf16_t*)(ws + WS_WH_T); bf16_t* WO_T = (bf16_t*)(ws + WS_WO_T);
    unsigned char* WIN_T8 = ws + WS_WIN_T + 8 * MiB;
    unsigned char* HA8 = ws + WS_SCORES;
    unsigned char* W1_T = ws + WS_W1_T; unsigned char* W2_T = ws + WS_W2_T;
    bf16_t* HB = (bf16_t*)(ws + WS_H); bf16_t* PROJ = (bf16_t*)(ws + WS_PROJ);
    bf16_t* DELTA = (bf16_t*)(ws + WS_ATT);
    unsigned char* ACT = ws + WS_ACT; bf16_t* YB = (bf16_t*)(ws + WS_YB);
    int* TOKS = (int*)(ws + WS_TOKS);
    unsigned char* H8 = ws + WS_H;
    bf16_t* KI = (bf16_t*)(ws + WS_KI); unsigned char* KC = ws + WS_KC; unsigned char* VC = ws + WS_VC;
    bf16_t* ST = (bf16_t*)(ws + WS_ST); float* DC = (float*)(ws + WS_DC);
    unsigned char* ATT = ws + WS_ATT; unsigned char* REC = ATT + (size_t)S * 1024;        bf16_t* MERGED = (bf16_t*)(ws + WS_MERGED); unsigned short* SCORES = (unsigned short*)(ws + WS_SCORES);
    unsigned short* SEGMAX = (unsigned short*)(ws + WS_X1);

    for (int u = tid; u < 128; u += NTHR) MISC[u] = 0u;
    __syncthreads();
    const bool one_launch = (hi - lo) > 1;
    XcdBarrier bar; bar.bar = ctl + CW_BAR; bar.x = 0; bar.st = MISC + 8;
    if (one_launch) bar = xcd_barrier_post(ctl + CW_BAR, MISC + 8);
#define IN(k) (lo <= (k) && (k) < hi)
#define SEAM(k) do { if (IN(k) && IN((k) + 1)) xcd_barrier(bar); } while (0)


    if (IN(PH_PRO)) {
        for (int cb = wg; cb < 256; cb += G) {
            LAS float* red = (LAS float*)lds;
            const int c4 = tid % 12, kg = tid / 12;
            f32x4 acc = (f32x4){0.f, 0.f, 0.f, 0.f};
            if (kg < 42) {
                const float* wp = w_ada + (size_t)cb * 48 + 4 * c4;
#pragma unroll 7
                for (int j = 0; j < 49; ++j) { const int k = kg + 42 * j; if (k < D) { const f32x4 v = __builtin_nontemporal_load((const f32x4*)(wp + (size_t)k * (6 * D))); acc += siluf_(cvec[k]) * v; } }
                *(LAS f32x4*)(red + kg * 48 + 4 * c4) = acc;
            }
            __syncthreads();
            if (tid < 48) { float s = b_ada[cb * 48 + tid];
#pragma unroll 6
                for (int q = 0; q < 42; ++q) s += red[q * 48 + tid];
                MOD[cb * 48 + tid] = s; }
            __syncthreads();
        }
        LAS unsigned char* scr = lds + wave * 17408;
        const int gw = wg * NWAVES + wave, NGW = G * NWAVES;
        {
            constexpr int NB_IN = (1104 + 63) / 64;
            for (int it = gw; it < 16 * NB_IN; it += NGW) convert_item(w_in + 1536, 2048, 1104, DIN, WIN_T, 0, it, lane, scr);
            for (int it = gw; it < 4 * 32; it += NGW) convert_item8(w_proj_att, 1024, 2048, 2048, (unsigned char*)WA_T, 0, it, lane, scr);
            for (int it = gw; it < 4 * 32; it += NGW) convert_item8(w_proj_hgrn, 1024, 2048, 2048, (unsigned char*)WA_T + (size_t)2048 * 1024, 0, it, lane, scr);
            for (int it = gw; it < 8 * 32; it += NGW) convert_item8(w_out, 2048, 2048, 2048, (unsigned char*)WO_T, 0, it, lane, scr);
            for (int it = gw; it < 8 * 24; it += NGW) convert_item8(w_in, 2048, 1536, DIN, WIN_T8, 0, it, lane, scr);
            for (int it = gw; it < 8 * 128; it += NGW) convert_item8(w_in + 2640, 2048, 8192, DIN, WIN_T8 + (size_t)1536 * 2048, 0, it, lane, scr);
            for (size_t i = (size_t)wg * NTHR + tid; i < (size_t)176 * 2048 * 2 / 16; i += (size_t)G * NTHR) ((u32x4*)(WIN_T + (size_t)1104 * 2048))[i] = (u32x4){0u, 0u, 0u, 0u};
        }
    }
    SEAM(PH_PRO);

    {
    if (IN(PH_H)) {
        const float* sh1 = MOD; const float* sc1 = MOD + D;
        const int gw = wg * NWAVES + wave, NGW = G * NWAVES;
        f32x4 gs[8], sh[8];
#pragma unroll
        for (int j = 0; j < 8; ++j) { const int c = 4 * lane + 256 * j; const f32x4 g = *(const f32x4*)(norm1_g + c), sc = *(const f32x4*)(sc1 + c); sh[j] = *(const f32x4*)(sh1 + c);
#pragma unroll
            for (int e = 0; e < 4; ++e) gs[j][e] = g[e] * (1.0f + sc[e]); }
        for (int t = gw; t < S; t += NGW) {
            const f32x4* xr = (const f32x4*)(x + (size_t)t * D) + lane;
            f32x4 v[8]; float ss = 0.f;
#pragma unroll
            for (int j = 0; j < 8; ++j) { v[j] = xr[64 * j]; ss += (v[j][0] * v[j][0] + v[j][1] * v[j][1]) + (v[j][2] * v[j][2] + v[j][3] * v[j][3]); }
            const float rstd = rsqrtf(wave_sum(ss) * (1.0f / D) + NORM_EPS);
#pragma unroll
            for (int j = 0; j < 8; ++j) { const f32x4 h = v[j] * rstd * gs[j] + sh[j]; u32x2 w; w.x = cvt_pk_bf16(h[0], h[1]); w.y = cvt_pk_bf16(h[2], h[3]);
                *(u32x2*)(HB + (size_t)t * D + 4 * lane + 256 * j) = w;
                *(unsigned*)(HA8 + (size_t)t * D + 4 * lane + 256 * j) = pack4_fp8(h[0], h[1], h[2], h[3]); }
        }
    }
    SEAM(PH_H);
    if (IN(PH_INPROJ)) {
        const int XC = (G == 256) ? XCONV : 0;
        const Conv8Job j1{w1, W1_T, 4096, 2, (size_t)2048 * 4096, (size_t)4096 * 2048, 8 * 16};
        const Conv8Job j2{w2, W2_T, 2048, 0, (size_t)2048 * 2048, (size_t)2048 * 2048, 8 * 8};
        if (G != 256) { conv8_run(lds, j1, NEXP * 8 * 16, wg, G, tid, wave, lane); conv8_run(lds, j2, NEXP * 8 * 8, wg, G, tid, wave, lane); }
        if (wg < XC) { conv8_run(lds, j1, NEXP * 8 * 16, wg, XC, tid, wave, lane); conv8_run(lds, j2, NEXP * 8 * 8, wg, XC, tid, wave, lane); }
        else {
            const int Gg = G - XC, cg = wg - XC;
            {
                pg8::Gemm g8{HA8, WIN_T8, 2048, 0, nullptr, 0}; pg8::StaticOrder S8; S8.init(S, 9728, Gg, cg);
                const int full8 = 2432 / Gg, rem8 = 2432 - full8 * Gg;
                if (Gg == 256) S8.skew(8, (wg >= 128 && wg < 192) ? -1 : (wg < 128 ? wg : wg - 64), 192);
                else if (rem8 > 0) S8.skew(full8, cg < rem8 ? cg : -1, rem8);
                pg8::EpiBf16 E8{PROJ, DINP, nullptr, 0, 1.0f / W8_SCALE, 6, 1280};
                pg8::gemm_phase<pg8::EpiBf16, pg8::StaticOrder, true>(lds, g8, S8, E8);
            }
            {
                pg8::Gemm g{HB, WIN_T, 2048, 0, nullptr, 0}; pg8::StaticOrder So; So.init(S, 1280, Gg, Gg == 256 ? (wg + 128) % G : (cg + Gg - (2432 % Gg)) % Gg);
                pg8::EpiBf16 E{PROJ + CQI, DINP, nullptr, 0, 1.0f, 1 << 30, 0};
                pg8::gemm_phase<pg8::EpiBf16, pg8::StaticOrder>(lds, g, So, E);
            }
        }
    }
    SEAM(PH_INPROJ);
    if (IN(PH_POST)) {
        const int gw = wg * NWAVES + wave, NGW = G * NWAVES;
        const float inv16 = powf(500000.0f, -(float)(lane & 15) * (1.0f / 16.0f)), inv8 = powf(500000.0f, -(float)(lane & 7) * (1.0f / 8.0f));
        for (int t = gw; t < S; t += NGW) post_token(PROJ, KI, KC, VC, positions, idx_knorm_g, idx_knorm_b, inv16, inv8, t, lane);
        __syncthreads();
        for (int u = wg; u < 2048; u += G) hgrn_l1(lds, PROJ, lb_logits, ST, DC, u >> 3, u & 7, tid, wave, lane);
    }
    SEAM(PH_POST);
    if (IN(PH_SCORE)) {
        for (int idx = wg * NTHR + tid; idx < 8 * 128 * 128; idx += G * NTHR) {
            const int h = idx >> 14, d = idx & 127; float s = 0.f;
            bf16_t* sp = ST + idx; const float* dp = DC + h * 128 + d;
            for (int c = 0; c < 256; c += 16) {
                float l[16], dc[16];
#pragma unroll
                for (int i = 0; i < 16; ++i) { l[i] = bf2f(sp[(size_t)(c + i) * 131072]); dc[i] = dp[(size_t)(c + i) * 1024]; }
#pragma unroll
                for (int i = 0; i < 16; ++i) { sp[(size_t)(c + i) * 131072] = f2bf(s); s = dc[i] * s + l[i]; }
            }
        }
        {
            const int XS = (G == 256) ? XSCORE : 0;
            if (wg < XS) {
                const Conv8Job j1{w1, W1_T, 4096, 2, (size_t)2048 * 4096, (size_t)4096 * 2048, 8 * 16};
                const Conv8Job j2{w2, W2_T, 2048, 0, (size_t)2048 * 2048, (size_t)2048 * 2048, 8 * 8};
                __syncthreads();
                conv8_run(lds, j1, NEXP * 8 * 16, wg, XS, tid, wave, lane); conv8_run(lds, j2, NEXP * 8 * 8, wg, XS, tid, wave, lane);
            }
            for (;;) {
                if (tid == 0) MISC[100] = __hip_atomic_fetch_add(ctl + CW_SCQ, 1u, __ATOMIC_RELAXED, __HIP_MEMORY_SCOPE_AGENT);
                __syncthreads();
                const int item = (int)MISC[100];
                __syncthreads();
                if (item >= 252 * 6) break;
                int j, lo, hi;
                if (item < 504) { j = item >> 1; const int T = ((8 + j) >> 2) + ((511 - j) >> 2) + 2; const int p = item & 1; lo = p * T / 3; hi = (p + 1) * T / 3; }
                else { const int i2 = item - 504; j = i2 >> 2; const int T = ((8 + j) >> 2) + ((511 - j) >> 2) + 2; const int p = i2 & 3, b = 2 * T / 3; lo = b + p * (T - b) / 4; hi = b + (p + 1) * (T - b) / 4; }
                const int qa = 8 + j, qb2 = 511 - j, na = (qa >> 2) + 1;
                const int a0 = lo < na ? lo : na, a1 = hi < na ? hi : na, b0 = (lo > na ? lo : na) - na, b1 = (hi > na ? hi : na) - na;
                if (a1 > a0) score_block(lds, PROJ, KI, SCORES, SEGMAX, qa, a0, a1, tid, wave, lane);
                if (b1 > b0) score_block(lds, PROJ, KI, SCORES, SEGMAX, qb2, b0, b1, tid, wave, lane);
            }
        }
    }
    SEAM(PH_SCORE);
    if (IN(PH_ATTN)) {
        const int gw = wg * NWAVES + wave, NGW = G * NWAVES;
        for (int u = wg; u < 2048; u += G) hgrn_l3(lds, PROJ, lb_logits, ST, hgrn_norm_g, REC, u >> 3, u & 7, tid, wave, lane);
        {
            for (;;) {
                unsigned tq = 0; if (lane == 0) tq = __hip_atomic_fetch_add(ctl + CW_ATQ, 1u, __ATOMIC_RELAXED, __HIP_MEMORY_SCOPE_AGENT);
                tq = (unsigned)__builtin_amdgcn_readfirstlane((int)tq);
                if (tq >= (unsigned)S) break;
                const int t = S - 1 - (int)tq;
                LAS unsigned char* wl = lds + wave * 17664;
                if (t >= 256) select_row(wl, SCORES, SEGMAX, t, lane);
                else {
#pragma unroll
                    for (int i = 0; i < 4; ++i) { const int idx = lane + 64 * i; ((LAS int*)wl)[idx] = idx <= t ? idx : 0; }
                }
                attn_query(wl, PROJ, KC, VC, ATT, t, lane);
            }
        }
    }
    SEAM(PH_ATTN);
    if (IN(PH_OP1)) {
        pg8::Gemm g{ATT, WA_T, 1024, (size_t)2048 * 1024, nullptr, (size_t)S * 1024};
        pg8::TwoPartOrder So; So.init(S, 2048, G, wg);
        pg8::EpiGate2 E{(unsigned char*)MERGED, PROJ + CGA, PROJ + CGR};
        pg8::gemm_phase<pg8::EpiGate2, pg8::TwoPartOrder, true>(lds, g, So, E);
    }
    SEAM(PH_OP2);
    if (IN(PH_WOUT)) {
        pg8::Gemm g{MERGED, WO_T, 2048, 0, nullptr, 0}; pg8::StaticOrder So; So.init(S, 2048, G, wg);
        pg8::EpiDelta E{MOD + 2 * D, DELTA, 1.0f / (W8_SCALE * MRG8_SCALE)};
        pg8::gemm_phase<pg8::EpiDelta, pg8::StaticOrder, true>(lds, g, So, E);
    }
    SEAM(PH_WOUT);
    }

    if (IN(PH_ROUTER)) {
        LAS float* hs = (LAS float*)lds;
        volatile LAS unsigned* lcnt = MISC + 32;
        const float* sh2 = MOD + 3 * D; const float* sc2 = MOD + 4 * D;
        if (tid < 32) lcnt[tid] = 0u;
        __syncthreads();
        for (int grp = wg; grp < S / 16; grp += G) {
#pragma unroll 1
            for (int q = 0; q < 2; ++q) {
                const int tl = 2 * wave + q, t = grp * 16 + tl;
                const f32x4* xr = (const f32x4*)(x + (size_t)t * D) + lane; const u32x2* dr = (const u32x2*)(DELTA + (size_t)t * D) + lane;
                f32x4 v[8]; float ss = 0.f;
#pragma unroll
                for (int j = 0; j < 8; ++j) { const u32x2 dw = dr[64 * j]; v[j] = xr[64 * j] + (f32x4){bf_lo(dw.x), bf_hi(dw.x), bf_lo(dw.y), bf_hi(dw.y)};
                    ss += (v[j][0] * v[j][0] + v[j][1] * v[j][1]) + (v[j][2] * v[j][2] + v[j][3] * v[j][3]); }
#pragma unroll
                for (int j = 0; j < 8; ++j) { u32x2 w; w.x = cvt_pk_bf16(v[j][0], v[j][1]); w.y = cvt_pk_bf16(v[j][2], v[j][3]); ((u32x2*)(DELTA + (size_t)t * D) + lane)[64 * j] = w; }
                const float rstd = rsqrtf(wave_sum(ss) * (1.0f / D) + NORM_EPS);
#pragma unroll
                for (int j = 0; j < 8; ++j) {
                    const int c = 4 * lane + 256 * j;
                    const f32x4 g = *(const f32x4*)(norm2_g + c), sc = *(const f32x4*)(sc2 + c), sh = *(const f32x4*)(sh2 + c);
                    f32x4 h;
#pragma unroll
                    for (int e = 0; e < 4; ++e) h[e] = v[j][e] * rstd * g[e] * (1.0f + sc[e]) + sh[e];
                    *(LAS f32x4*)(hs + tl * 2048 + c) = h;
                    *(unsigned*)(H8 + (size_t)t * D + c) = pack4_fp8(h[0], h[1], h[2], h[3]);
                }
            }
            __syncthreads();
            {
                LAS float* part = (LAS float*)(lds + 131072);
                const int fr = lane & 15, fq = lane >> 4;
                f32x4 acc0 = (f32x4){0.f, 0.f, 0.f, 0.f}, acc1 = acc0;
                const LAS float* hrow = hs + fr * 2048 + wave * 256 + 4 * fq; const float* wrp = w_router + (size_t)(wave * 256 + 4 * fq) * 32 + fr;
#pragma unroll 2
                for (int i = 0; i < 16; ++i) {
                    const f32x4 a4 = *(const LAS f32x4*)(hrow + 16 * i);
                    float b0[4], b1[4];
#pragma unroll
                    for (int s = 0; s < 4; ++s) { b0[s] = wrp[(size_t)(16 * i + s) * 32]; b1[s] = wrp[(size_t)(16 * i + s) * 32 + 16]; }
#pragma unroll
                    for (int s = 0; s < 4; ++s) { acc0 = __builtin_amdgcn_mfma_f32_16x16x4f32(a4[s], b0[s], acc0, 0, 0, 0); acc1 = __builtin_amdgcn_mfma_f32_16x16x4f32(a4[s], b1[s], acc1, 0, 0, 0); }
                }
#pragma unroll
                for (int r = 0; r < 4; ++r) { part[(wave * 16 + 4 * fq + r) * 32 + fr] = acc0[r]; part[(wave * 16 + 4 * fq + r) * 32 + 16 + fr] = acc1[r]; }
                __syncthreads();
                const int tl = tid >> 5, e = tid & 31, t = grp * 16 + tl;
                float v = b_router[e];
#pragma unroll
                for (int w = 0; w < 8; ++w) v += part[(w * 16 + tl) * 32 + e];
                float tv[4]; int ti[4];
#pragma unroll
                for (int k = 0; k < 4; ++k) {
                    float bv = v; int bi = e;
#pragma unroll
                    for (int o = 16; o >= 1; o >>= 1) { const float ov = __shfl_xor(bv, o); const int oi = __shfl_xor(bi, o); if (ov > bv || (ov == bv && oi < bi)) { bv = ov; bi = oi; } }
                    tv[k] = bv; ti[k] = bi; if (e == bi) v = -__builtin_inff();
                }
                if (e == 0) {
                    const float e1 = __expf(tv[1] - tv[0]), e2 = __expf(tv[2] - tv[0]), e3 = __expf(tv[3] - tv[0]); const float inv = 1.0f / (1.0f + e1 + e2 + e3);
                    *(int4*)(TOPE + (size_t)t * 4) = make_int4(ti[0], ti[1], ti[2], ti[3]);
                    *(f32x4*)(GATE + (size_t)t * 4) = (f32x4){inv, e1 * inv, e2 * inv, e3 * inv};
#pragma unroll
                    for (int k = 0; k < 4; ++k) __hip_atomic_fetch_add((LAS unsigned*)&lcnt[ti[k]], 1u, __ATOMIC_RELAXED, __HIP_MEMORY_SCOPE_WORKGROUP);
                }
            }
            __syncthreads();
        }
        if (tid < 32) { const unsigned c = lcnt[tid]; if (c) __hip_atomic_fetch_add(ctl + CW_CNT + tid, c, __ATOMIC_RELAXED, __HIP_MEMORY_SCOPE_AGENT); }
    }
    SEAM(PH_ROUTER);

    if (IN(PH_SCATTER)) {
        volatile LAS unsigned* lcnt = MISC + 32; volatile LAS unsigned* lbase = MISC + 64; LAS int* pstart = (LAS int*)(lds + 1024); LAS int* pcnt = (LAS int*)(lds + 1280);
        if (tid == 0) { int p = 0; for (int e = 0; e < NEXP; ++e) { const int c = (int)__hip_atomic_load(ctl + CW_CNT + e, __ATOMIC_RELAXED, __HIP_MEMORY_SCOPE_AGENT); pstart[e] = p; pcnt[e] = c; p += (c + 255) & ~255; } }
        if (tid < 32) lcnt[tid] = 0u;
        __syncthreads();
        if (wg < NEXP) { const int e = wg; for (int s = pstart[e] + pcnt[e] + tid; s < pstart[e] + ((pcnt[e] + 255) & ~255); s += NTHR) TOKS[s] = 0; }
        for (int blk = wg; blk < S / 64; blk += G) {
            int e = 0, lrank = 0;
            if (tid < 256) { e = TOPE[(size_t)blk * 256 + tid]; lrank = (int)__hip_atomic_fetch_add((LAS unsigned*)&lcnt[e], 1u, __ATOMIC_RELAXED, __HIP_MEMORY_SCOPE_WORKGROUP); }
            __syncthreads();
            if (tid < 32) { const unsigned c = lcnt[tid]; lbase[tid] = c ? __hip_atomic_fetch_add(ctl + CW_FILL + tid, c, __ATOMIC_RELAXED, __HIP_MEMORY_SCOPE_AGENT) : 0u; }
            __syncthreads();
            if (tid < 256) { const int slot = pstart[e] + (int)lbase[e] + lrank; SLOT[(size_t)blk * 256 + tid] = slot; TOKS[slot] = blk * 64 + (tid >> 2); }
            __syncthreads();
            if (tid < 32) lcnt[tid] = 0u;
            __syncthreads();
        }
    }
    SEAM(PH_SCATTER);

    if (IN(PH_MOE1) || IN(PH_MOE2)) {
        LAS int* panel_e = (LAS int*)(lds + 131072 + 2048);
        LAS int* npan = (LAS int*)(lds + 131072 + 2048 + 2048);
        __syncthreads();
        if (tid == 0) { int p = 0; for (int e = 0; e < NEXP; ++e) { const int np = (int)((__hip_atomic_load(ctl + CW_CNT + e, __ATOMIC_RELAXED, __HIP_MEMORY_SCOPE_AGENT) + 255u) >> 8); for (int q = 0; q < np; ++q) panel_e[p + q] = e; p += np; } npan[0] = p; }
        __syncthreads();
        const int nPanels = npan[0];
        if (IN(PH_MOE1)) {
            pg8::Gemm g{H8, W1_T, 2048, (size_t)4096 * 2048, TOKS, 0}; pg8::MoeOrder So; So.init(nPanels, 16, G, wg, panel_e);
            pg8::EpiSwiglu E{ACT, b1};
            pg8::gemm_phase<pg8::EpiSwiglu, pg8::MoeOrder, true>(lds, g, So, E);
        }
        SEAM(PH_MOE1);
        if (IN(PH_MOE2)) {
            pg8::Gemm g{ACT, W2_T, 2048, (size_t)2048 * 2048, nullptr, 0}; pg8::MoeOrder So; So.init(nPanels, 8, G, wg, panel_e);
            pg8::EpiBf16 E{YB, 2048, b2, 2048, 1.0f / (W8_SCALE * ACT8_SCALE), 1 << 30, 0};
            pg8::gemm_phase<pg8::EpiBf16, pg8::MoeOrder, true>(lds, g, So, E);
        }
    }
    SEAM(PH_MOE2);

    if (IN(PH_FINAL)) {
        const float* gt2 = MOD + 5 * D;
        const int gw = wg * NWAVES + wave, NGW = G * NWAVES;
        for (int t = gw; t < S; t += NGW) {
            const u32x2* dr = (const u32x2*)(DELTA + (size_t)t * D) + lane;
            f32x4 v[8];
#pragma unroll
            for (int j = 0; j < 8; ++j) { const u32x2 dw = dr[64 * j]; v[j] = (f32x4){bf_lo(dw.x), bf_hi(dw.x), bf_lo(dw.y), bf_hi(dw.y)}; }
            {
                f32x4 m[8];
#pragma unroll
                for (int j = 0; j < 8; ++j) m[j] = (f32x4){0.f, 0.f, 0.f, 0.f};
                const int4 sl = *(const int4*)(SLOT + (size_t)t * 4); const f32x4 gt = *(const f32x4*)(GATE + (size_t)t * 4);
                const int sls[4] = {sl.x, sl.y, sl.z, sl.w};
#pragma unroll
                for (int k = 0; k < 4; ++k) {
                    const u32x2* yr = (const u32x2*)(YB + (size_t)sls[k] * D) + lane; const float gk = gt[k];
#pragma unroll
                    for (int j = 0; j < 8; ++j) { const u32x2 w = yr[64 * j]; m[j][0] += gk * bf_lo(w.x); m[j][1] += gk * bf_hi(w.x); m[j][2] += gk * bf_lo(w.y); m[j][3] += gk * bf_hi(w.y); }
                }
#pragma unroll
                for (int j = 0; j < 8; ++j) { const f32x4 g2 = *(const f32x4*)(gt2 + 4 * lane + 256 * j); v[j] = v[j] + g2 * m[j]; }
            }
            float ss = 0.f;
#pragma unroll
            for (int j = 0; j < 8; ++j) ss += (v[j][0] * v[j][0] + v[j][1] * v[j][1]) + (v[j][2] * v[j][2] + v[j][3] * v[j][3]);
            const float rstd = rsqrtf(wave_sum(ss) * (1.0f / D) + NORM_EPS);
            f32x4* orow = (f32x4*)(out + (size_t)t * D) + lane;
#pragma unroll
            for (int j = 0; j < 8; ++j) { const f32x4 fg = *(const f32x4*)(final_g + 4 * lane + 256 * j); orow[64 * j] = v[j] * rstd * fg; }
        }
    }
#undef IN
#undef SEAM
}

#ifndef MK_ONE_LAUNCH
#define MK_ONE_LAUNCH 1
#endif
extern "C" void kernel_launch(void* const* d_in, const int* in_sizes, int n_in, void* d_out, int out_size, void* d_ws, size_t ws_size, hipStream_t stream) {
    static int grid = 0;
    if (grid == 0) {
        if (n_in != 22 || out_size != S * D || ws_size < WS_END) { fprintf(stderr, "kernel_launch: unexpected shapes: n_in %d out %d ws %zu (need %zu)\n", n_in, out_size, ws_size, (size_t)WS_END); grid = -1; return; }
        int dev = 0, cus = 0, per_cu = 0;
        if (hipGetDevice(&dev) != hipSuccess || hipDeviceGetAttribute(&cus, hipDeviceAttributeMultiprocessorCount, dev) != hipSuccess) { grid = -1; return; }
        if (hipFuncSetAttribute((const void*)fwd_kernel, hipFuncAttributeMaxDynamicSharedMemorySize, LDS_BYTES) != hipSuccess) { fprintf(stderr, "kernel_launch: hipFuncSetAttribute failed\n"); grid = -1; return; }
        if (hipOccupancyMaxActiveBlocksPerMultiprocessor(&per_cu, (const void*)fwd_kernel, NTHR, LDS_BYTES) != hipSuccess || per_cu < 1) { fprintf(stderr, "kernel_launch: occupancy query says %d\n", per_cu); (void)hipGetLastError(); grid = -1; return; }
        grid = cus;
    }
    if (grid < 0) return;
    (void)in_sizes;
    hipMemsetAsync((char*)d_ws + WS_CTL, 0, CTL_BYTES, stream);
    Args a{};
    for (int i = 0; i < 22; ++i) a.in[i] = d_in[i];
    a.out = (float*)d_out; a.ws = (unsigned char*)d_ws; a.flags = 0; a.pad = 0;
#if MK_ONE_LAUNCH
    a.ph_lo = 0; a.ph_hi = NPH;
    hipLaunchKernelGGL(fwd_kernel, dim3(grid), dim3(NTHR), LDS_BYTES, stream, a);
#else
    for (int p = 0; p < NPH; ++p) { a.ph_lo = p; a.ph_hi = p + 1; hipLaunchKernelGGL(fwd_kernel, dim3(grid), dim3(NTHR), LDS_BYTES, stream, a); }
#endif
}
```

```cpp
#include <hip/hip_runtime.h>
#include <cstdio>
#include <cstdint>

#define GAS __attribute__((address_space(1)))
#define LAS __attribute__((address_space(3)))
typedef unsigned short bf16_t;
typedef short bf16x8 __attribute__((ext_vector_type(8)));
typedef float f32x4 __attribute__((ext_vector_type(4)));
typedef float f32x2 __attribute__((ext_vector_type(2)));
typedef float f32x16 __attribute__((ext_vector_type(16)));
typedef unsigned u32x4 __attribute__((ext_vector_type(4)));
typedef unsigned u32x2 __attribute__((ext_vector_type(2)));
typedef int i32x4 __attribute__((ext_vector_type(4)));
typedef int i32x8 __attribute__((ext_vector_type(8)));
typedef short s16x4 __attribute__((ext_vector_type(4)));
typedef short s16x2 __attribute__((ext_vector_type(2)));
typedef int v2i32 __attribute__((ext_vector_type(2)));

constexpr int S = 16384, D = 2048, DIN = 10832, DINP = 11008, NEXP = 32, DFF = 2048;
constexpr int NWAVES = 8, NTHR = 512;
constexpr int CQ = 0, CK = 1024, CV = 1280, CQI = 1536, CKI = 2560, CWI = 2624, CHQ = 2816, CHF = 3840, CHI = 4864, CHG = 5888, CGA = 6912, CGR = 8960;
constexpr int PMAX = 65536 + NEXP * 256;
constexpr float NORM_EPS = 1e-5f;

constexpr size_t MiB = 1u << 20;
constexpr size_t al256(size_t x) { return (x + 255) & ~(size_t)255; }
constexpr size_t WS_CTL = 0, CTL_BYTES = 1 * MiB;
constexpr size_t WS_MOD = WS_CTL + CTL_BYTES;
constexpr size_t WS_TOPE = WS_MOD + 64 * 1024;
constexpr size_t WS_GATE = WS_TOPE + (size_t)S * 16;
constexpr size_t WS_SLOT = WS_GATE + (size_t)S * 16;
constexpr size_t WS_WIN_T = WS_SLOT + (size_t)S * 16;
constexpr size_t WS_WA_T = WS_WIN_T + (size_t)DINP * D * 2;
constexpr size_t WS_WH_T = WS_WA_T + (size_t)2048 * 1024 * 2;
constexpr size_t WS_WO_T = WS_WH_T + (size_t)2048 * 1024 * 2;
constexpr size_t WS_W1_T = WS_WO_T + (size_t)2048 * 2048 * 2;
constexpr size_t WS_W2_T = WS_W1_T + (size_t)NEXP * 4096 * 2048 * 2;
constexpr size_t WS_H = WS_W2_T + (size_t)NEXP * 2048 * 2048 * 2;
constexpr size_t WS_PROJ = WS_H + (size_t)S * D * 2;
constexpr size_t WS_KI = WS_PROJ + (size_t)S * DINP * 2;
constexpr size_t WS_KC = WS_KI + (size_t)S * 64 * 2;
constexpr size_t WS_VC = WS_KC + (size_t)S * 256 * 2;
constexpr size_t WS_ST = WS_VC + (size_t)S * 256 * 2;
constexpr size_t WS_DC = WS_ST + (size_t)256 * 8 * 128 * 128 * 4;
constexpr size_t WS_SEL = WS_DC + (size_t)256 * 8 * 128 * 4;
constexpr size_t WS_ATT = WS_SEL + (size_t)S * 256 * 4;
constexpr size_t WS_REC = WS_ATT + (size_t)S * 1024 * 2;
constexpr size_t WS_MERGED = WS_REC + (size_t)S * 1024 * 2;
constexpr size_t WS_X1 = WS_MERGED + (size_t)S * 2048 * 2;
constexpr size_t WS_SCORES = WS_X1 + (size_t)S * 2048 * 4;
constexpr size_t WS_XB = WS_SCORES;
constexpr size_t WS_ACT = WS_XB + (size_t)PMAX * 2048 * 2;
constexpr size_t WS_YB = WS_ACT + (size_t)PMAX * 2048 * 2;
constexpr size_t WS_END = WS_SCORES + (size_t)S * S * 4;
static_assert(WS_YB + (size_t)PMAX * 2048 * 2 <= WS_END, "MoE buffers overlay the score matrix");
static_assert(WS_END <= (size_t)4096 * MiB, "workspace");
constexpr int CW_BAR = 4096, CW_CNT = 8192, CW_FILL = 8448;
constexpr size_t WS_TOKS = WS_SEL;

constexpr int LDS_BYTES = 155648;
constexpr int LDS_MISC = LDS_BYTES - 512;

__device__ __forceinline__ unsigned cvt_pk_bf16(float lo, float hi) { unsigned r; asm volatile("v_cvt_pk_bf16_f32 %0, %1, %2" : "=v"(r) : "v"(lo), "v"(hi)); return r; }
__device__ __forceinline__ float bf_lo(unsigned u) { return __uint_as_float(u << 16); }
__device__ __forceinline__ float bf_hi(unsigned u) { return __uint_as_float(u & 0xffff0000u); }
__device__ __forceinline__ float bf2f(bf16_t b) { return __uint_as_float(((unsigned)b) << 16); }
__device__ __forceinline__ float wave_sum(float v) {
#define DPPS(ctrl, rmask) { const int s_ = __builtin_amdgcn_update_dpp(0, __float_as_int(v), ctrl, rmask, 0xF, false); v += __int_as_float(s_); }
    DPPS(0x111, 0xF) DPPS(0x112, 0xF) DPPS(0x114, 0xF) DPPS(0x118, 0xF) DPPS(0x142, 0xA) DPPS(0x143, 0xC)
#undef DPPS
    return __int_as_float(__builtin_amdgcn_readlane(__float_as_int(v), 63));
}
__device__ __forceinline__ float wave_max(float v) {
#define DPPM(ctrl, rmask) { const int o_ = __float_as_int(v); const int s_ = __builtin_amdgcn_update_dpp(o_, o_, ctrl, rmask, 0xF, false); v = fmaxf(v, __int_as_float(s_)); }
    DPPM(0x111, 0xF) DPPM(0x112, 0xF) DPPM(0x114, 0xF) DPPM(0x118, 0xF) DPPM(0x142, 0xA) DPPM(0x143, 0xC)
#undef DPPM
    return __int_as_float(__builtin_amdgcn_readlane(__float_as_int(v), 63));
}
__device__ __forceinline__ float sigmoidf_(float x) { return __builtin_amdgcn_rcpf(1.0f + __expf(-x)); }
__device__ __forceinline__ float siluf_(float x) { return x * __builtin_amdgcn_rcpf(1.0f + __expf(-x)); }
__device__ __forceinline__ unsigned pack4_fp8(float a, float b, float c, float d) { int w = 0; w = __builtin_amdgcn_cvt_pk_fp8_f32(a, b, w, false); w = __builtin_amdgcn_cvt_pk_fp8_f32(c, d, w, true); return (unsigned)w; }
constexpr float W8_SCALE = 64.0f, ACT8_SCALE = 4.0f, MRG8_SCALE = 8.0f, OP8_SCALE = 16.0f;
__device__ __forceinline__ float relu_i(float x) { const int i = __float_as_int(x); return __int_as_float(i > 0 ? i : 0); }
__device__ __forceinline__ void fp8x16_to_bf16(const u32x4& w, u32x4& lo, u32x4& hi) {
    unsigned o[8];
#pragma unroll
    for (int q = 0; q < 4; ++q) { const unsigned wq = w[q]; const f32x2 a = __builtin_amdgcn_cvt_pk_f32_fp8((int)wq, false), b = __builtin_amdgcn_cvt_pk_f32_fp8((int)wq, true);
        o[2 * q] = cvt_pk_bf16(a[0], a[1]); o[2 * q + 1] = cvt_pk_bf16(b[0], b[1]); }
    lo = (u32x4){o[0], o[1], o[2], o[3]}; hi = (u32x4){o[4], o[5], o[6], o[7]};
}
__device__ __forceinline__ unsigned char fp8_1(float x) { return (unsigned char)(__builtin_amdgcn_cvt_pk_fp8_f32(x, x, 0, false) & 0xff); }
#define LDS_WAIT() asm volatile("s_waitcnt lgkmcnt(0)" ::: "memory")
#define VM_WAIT() asm volatile("s_waitcnt vmcnt(0)" ::: "memory")

#define XB_TMO      128
#define XB_XCNT(j)  (256  + 64 * (j))
#define XB_XSUB(j)  (1280 + 64 * (j))
#define XB_XGEN(j)  (2304 + 64 * (j))
#define XB_TOP      3328
#define XB_TOPGEN   3392
#define XCD_BAR_WORDS 3456
#define XB_SPIN_CAP (1u << 22)

__device__ __forceinline__ unsigned xb_ld(unsigned* p)              { return __hip_atomic_load(p, __ATOMIC_RELAXED, __HIP_MEMORY_SCOPE_AGENT); }
__device__ __forceinline__ unsigned xb_add(unsigned* p, unsigned v) { return __hip_atomic_fetch_add(p, v, __ATOMIC_RELAXED, __HIP_MEMORY_SCOPE_AGENT); }
__device__ __forceinline__ unsigned xb_xcc_id() { return (unsigned)__builtin_amdgcn_s_getreg((3 << 11) | 20) & 0xFu; }
#define XB_SPIN(cond, bar) do { unsigned _sp = 0; while (cond) { __builtin_amdgcn_s_sleep(1); \
    if ((++_sp & 255u) == 0u) { if (xb_ld(&(bar)[XB_TMO])) break; if (_sp > XB_SPIN_CAP) { atomicAdd(&(bar)[XB_TMO], 1u); break; } } } } while (0)

struct XcdBarrier { unsigned* bar; unsigned x; volatile LAS unsigned* st; };

__device__ __forceinline__ XcdBarrier xcd_barrier_post(unsigned* bar, volatile LAS unsigned* st) {
    XcdBarrier b; b.bar = bar; b.x = xb_xcc_id(); b.st = st;
    if (threadIdx.x == 0) (void)xb_add(&bar[XB_XCNT(b.x)], 1u);
    return b;
}
__device__ __forceinline__ void xcd_barrier_complete(unsigned* bar, unsigned x, unsigned& nloc, unsigned& nx) {
    const unsigned G = gridDim.x * gridDim.y * gridDim.z;
    unsigned sum, cnt, mine, sp = 0u;
    for (;;) {
        sum = 0u; cnt = 0u; mine = 0u;
#pragma unroll
        for (unsigned j = 0; j < 16; ++j) { const unsigned c = xb_ld(&bar[XB_XCNT(j)]); sum += c; cnt += (c > 0u) ? 1u : 0u; mine = (j == x) ? c : mine; }
        if (sum == G) break;
        __builtin_amdgcn_s_sleep(1);
        if ((++sp & 255u) == 0u) { if (xb_ld(&bar[XB_TMO])) break; if (sp > XB_SPIN_CAP) { atomicAdd(&bar[XB_TMO], 1u); break; } }
    }
    nloc = mine > 0u ? mine : 1u; nx = cnt > 0u ? cnt : 1u;
}
__device__ __forceinline__ void xcd_barrier(const XcdBarrier& b) {
    asm volatile("s_waitcnt vmcnt(0)" ::: "memory");
    __syncthreads();
    if (threadIdx.x == 0) {
        unsigned* bar = b.bar;
        __builtin_amdgcn_s_waitcnt(0);
        unsigned nloc = b.st[0], nx = b.st[1];
        if (nloc == 0u) { xcd_barrier_complete(bar, b.x, nloc, nx); b.st[0] = nloc; b.st[1] = nx; }
        const unsigned old = xb_add(&bar[XB_XSUB(b.x)], 1u);
        const unsigned gen = old / nloc;
        if (old + 1u == (gen + 1u) * nloc) {
            __builtin_amdgcn_fence(__ATOMIC_RELEASE, "agent");
            asm volatile("s_waitcnt vmcnt(0)" ::: "memory");
            const unsigned og = xb_add(&bar[XB_TOP], 1u);
            const unsigned tg = og / nx;
            if (og + 1u == (tg + 1u) * nx) xb_add(&bar[XB_TOPGEN], 1u);
            else XB_SPIN(xb_ld(&bar[XB_TOPGEN]) == tg, bar);
            __builtin_amdgcn_fence(__ATOMIC_ACQUIRE, "agent");
            xb_add(&bar[XB_XGEN(b.x)], 1u);
            asm volatile("s_waitcnt vmcnt(0)" ::: "memory");
        } else {
            XB_SPIN(xb_ld(&bar[XB_XGEN(b.x)]) == gen, bar);
            __builtin_amdgcn_fence(__ATOMIC_ACQUIRE, "agent");
            asm volatile("s_waitcnt vmcnt(0)" ::: "memory");
        }
    }
    __syncthreads();
}

namespace pg8 {
constexpr int BM = 256, BK = 64, HALF = 128, HTB = HALF * BK * 2, STAGE_BYTES = 8 * HTB, NXCD = 8, WGM = 8;
__host__ __device__ __forceinline__ int lds_byte(int r, int c) { const int st = (r >> 4) * 2 + (c >> 5), rr = r & 15, cc = c & 31, ob = rr * 64 + cc * 2; return st * 1024 + (ob ^ (((ob >> 9) & 1) << 5)); }
__host__ __device__ __forceinline__ void stage_rc(int b, int& R, int& C) { const int st = b / 1024, sb = b % 1024, swz = sb ^ (((sb >> 9) & 1) << 5); R = (st >> 1) * 16 + swz / 64; C = (st & 1) * 32 + (swz % 64) / 2; }
__host__ __device__ __forceinline__ int perm32(int rho) { const int n = rho >> 4, i = rho & 15; return 8 * (i >> 2) + 4 * n + (i & 3); }

struct Unit { int pm, pn, e; };
struct Gemm { const void* A; const void* Bt; int K; size_t estride; const int* arow; size_t astride; };

struct StaticOrder {
    int nM, nN, nwg, G, c, i, full, erank, en;
    __device__ void init(int M, int N, int G_, int c_) { nM = M / BM; nN = N / BM; nwg = nM * nN; G = G_; c = c_; i = 0; full = 1 << 30; erank = -1; en = 1; }
    __device__ void skew(int full_, int erank_, int en_) { full = full_; erank = erank_; en = en_; }
    __device__ bool next(Unit& u) {
        long L;
        if (i < full) L = (long)i * G + c; else { if (erank < 0) return false; L = (long)full * G + (long)(i - full) * en + erank; }
        ++i; if (L >= nwg) return false;
        int wgid = (int)L; { const int q = nwg / NXCD, r = nwg % NXCD, xcd = wgid % NXCD, off = wgid / NXCD; wgid = (xcd < r ? xcd * (q + 1) : r * (q + 1) + (xcd - r) * q) + off; }
        const int nig = WGM * nN, gid = wgid / nig, fm = gid * WGM, gsz = (nM - fm) < WGM ? (nM - fm) : WGM;
        u.pm = fm + ((wgid % nig) % gsz); u.pn = (wgid % nig) / gsz; u.e = 0; return true;
    }
};
struct MoeOrder {
    int nPanels, nN, G, c, i; const LAS int* panel_e;
    __device__ void init(int nPanels_, int nN_, int G_, int c_, const LAS int* pe) { nPanels = nPanels_; nN = nN_; G = G_; c = c_; i = 0; panel_e = pe; }
    __device__ bool next(Unit& u) {
        const int PB = 256 / nN;
        const int nblk = (nPanels + PB - 1) / PB;
        for (;;) {
            const long L = (long)i * G + c; ++i;
            const int blk = (int)(L >> 8), r = (int)(L & 255), x = r & 7, j = r >> 3;
            if (blk >= nblk) return false;
            int pm, pn;
            if (nN == 16) { pm = blk * 16 + 4 * (x >> 1) + (j & 3); pn = 8 * (x & 1) + (j >> 2); }
            else          { pm = blk * 32 + 4 * x + (j & 3);        pn = j >> 2; }
            if (pm < nPanels) { u.pm = pm; u.pn = pn; u.e = panel_e[pm]; return true; }
        }
    }
};

template <class Epi, class Sched, bool FP8 = false>
__device__ __forceinline__ void gemm_phase(LAS unsigned char* lds, const Gemm g, Sched& S, const Epi& E) {
    const int tid = threadIdx.x, wid = __builtin_amdgcn_readfirstlane(tid >> 6), lane = tid & 63, wr = wid >> 2, wc = wid & 3, fr = lane & 15, fq = lane >> 4;
    const int K = g.K; const int pitch = FP8 ? K : 2 * K; const int nt = pitch / 128;
    unsigned voffA[2], voffB[2];
#pragma unroll
    for (int i = 0; i < 2; ++i) { int R, C; stage_rc(tid * 16 + i * 8192, R, C); const int Rb = Epi::PERM ? ((R & ~31) + perm32(R & 31)) : R;
        voffA[i] = (unsigned)(R * pitch + C * 2); voffB[i] = (unsigned)(Rb * pitch + C * 2); }
    const size_t kstep = (size_t)(BK * 2);
    const size_t hstep = (size_t)HALF * pitch;
    const size_t tstep = 2 * hstep;
    int RA[2], CA[2];
#pragma unroll
    for (int i = 0; i < 2; ++i) stage_rc(tid * 16 + i * 8192, RA[i], CA[i]);
    const bool gather = g.arow != nullptr;
    const size_t hsA = gather ? 0 : hstep;
    unsigned vA0[2] = {voffA[0], voffA[1]}, vA1[2] = {voffA[0], voffA[1]}, nA0[2] = {voffA[0], voffA[1]}, nA1[2] = {voffA[0], voffA[1]};
#define PG8_AOFF(dst0, dst1, u) do { if (gather) { _Pragma("unroll") for (int i = 0; i < 2; ++i) { \
        dst0[i] = (unsigned)g.arow[(u).pm * 256 + RA[i]] * (unsigned)pitch + (unsigned)(CA[i] * 2); dst1[i] = (unsigned)g.arow[(u).pm * 256 + 128 + RA[i]] * (unsigned)pitch + (unsigned)(CA[i] * 2); } } } while (0)
    const unsigned ldsw = (unsigned)wid * 1024u;
    const int aoff = lds_byte(wr * 64 + fr, fq * 8), boff = lds_byte(wc * 32 + fr, fq * 8);
#define PG8_SA(b, h) (((b) * 2 + (h)) * HTB)
#define PG8_SB(b, h) ((4 + (b) * 2 + (h)) * HTB)
#define PG8_STAGE(bufoff, gbase, voff) do { _Pragma("unroll") for (int _i = 0; _i < 2; ++_i) \
        __builtin_amdgcn_global_load_lds((const unsigned*)((const char*)(gbase) + (voff)[_i]), (LAS unsigned*)(lds + (bufoff) + ldsw + _i * 8192), 16, 0, 0); } while (0)
#define PG8_LD8(p) __builtin_shufflevector(*(const LAS i32x4*)(p), *(const LAS i32x4*)((p) + 1024), 0, 1, 2, 3, 4, 5, 6, 7)
#define PG8_LDA(dst, b, h) do { _Pragma("unroll") for (int m = 0; m < 4; ++m) { if constexpr (FP8) dst##8[m] = PG8_LD8(lds + PG8_SA(b, h) + aoff + m * 2048); \
        else { _Pragma("unroll") for (int k = 0; k < 2; ++k) dst[m][k] = *(const LAS bf16x8*)(lds + PG8_SA(b, h) + aoff + m * 2048 + k * 1024); } } } while (0)
#define PG8_LDB(dst, b, h) do { _Pragma("unroll") for (int n = 0; n < 2; ++n) { if constexpr (FP8) dst##8[n] = PG8_LD8(lds + PG8_SB(b, h) + boff + n * 2048); \
        else { _Pragma("unroll") for (int k = 0; k < 2; ++k) dst[n][k] = *(const LAS bf16x8*)(lds + PG8_SB(b, h) + boff + n * 2048 + k * 1024); } } } while (0)
#define PG8_MMA(ai, bj, At, Bt) do { __builtin_amdgcn_s_setprio(1); _Pragma("unroll") for (int m = 0; m < 4; ++m) _Pragma("unroll") for (int n = 0; n < 2; ++n) { \
        if constexpr (FP8) asm volatile("v_mfma_scale_f32_16x16x128_f8f6f4 %0, %1, %2, %0, %3, %3 op_sel_hi:[0,0,0]" : "+v"(acc[ai][bj][m][n]) : "v"(Bt##8[n]), "v"(At##8[m]), "v"(scl1)); \
        else { _Pragma("unroll") for (int k = 0; k < 2; ++k) acc[ai][bj][m][n] = __builtin_amdgcn_mfma_f32_16x16x32_bf16(Bt[n][k], At[m][k], acc[ai][bj][m][n], 0, 0, 0); } } \
        __builtin_amdgcn_s_setprio(0); } while (0)
#define PG8_WAIT_V(n) asm volatile("s_waitcnt vmcnt(" #n ")" ::: "memory")
#define PG8_WAIT_L(n) asm volatile("s_waitcnt lgkmcnt(" #n ")" ::: "memory")
#define PG8_BAR __builtin_amdgcn_s_barrier()
#define PG8_SCHED __builtin_amdgcn_sched_barrier(0)
    Unit cur, nxt;
    if (!S.next(cur)) return;
    const unsigned scl1 = 0x7f7f7f7fu;
    f32x4 acc[2][2][4][2];
#pragma unroll
    for (int a = 0; a < 2; ++a)
#pragma unroll
        for (int b = 0; b < 2; ++b)
#pragma unroll
            for (int m = 0; m < 4; ++m)
#pragma unroll
                for (int n = 0; n < 2; ++n) acc[a][b][m][n] = (f32x4){0.f, 0.f, 0.f, 0.f};
    bf16x8 At[4][2], B0[2][2], B1[2][2]; i32x8 At8[4], B08[2], B18[2];
    const char* cA = (const char*)g.A + (size_t)cur.e * g.astride + (gather ? (size_t)0 : (size_t)cur.pm * tstep); const char* cB = (const char*)g.Bt + (size_t)cur.e * g.estride + (size_t)cur.pn * tstep;
    PG8_AOFF(vA0, vA1, cur);
    PG8_STAGE(PG8_SB(0, 0), cB, voffB); PG8_STAGE(PG8_SB(0, 1), cB + hstep, voffB); PG8_STAGE(PG8_SA(0, 0), cA, vA0); PG8_STAGE(PG8_SA(0, 1), cA + hsA, vA1);
    if (wr == 1) PG8_BAR;
    PG8_WAIT_V(2); PG8_BAR;
    PG8_STAGE(PG8_SB(1, 0), cB + kstep, voffB); PG8_STAGE(PG8_SA(1, 0), cA + kstep, vA0); PG8_STAGE(PG8_SB(1, 1), cB + hstep + kstep, voffB);
    PG8_WAIT_V(6); PG8_BAR;
    for (;;) {
        const bool has_next = S.next(nxt);
        const char* nA = has_next ? (const char*)g.A + (size_t)nxt.e * g.astride + (gather ? (size_t)0 : (size_t)nxt.pm * tstep) : cA;
        if (has_next) PG8_AOFF(nA0, nA1, nxt);
        const char* nB = has_next ? (const char*)g.Bt + (size_t)nxt.e * g.estride + (size_t)nxt.pn * tstep : cB;
        for (int t = 0; t < nt; t += 2) {
            const bool last = (t == nt - 2);
            const char* a1 = cA + (size_t)(t + 1) * kstep;
            const char* a2 = last ? nA : cA + (size_t)(t + 2) * kstep; const char* b2 = last ? nB : cB + (size_t)(t + 2) * kstep;
            const char* a3 = a2 + kstep; const char* b3 = b2 + kstep;
            PG8_LDB(B0, 0, 0); PG8_LDB(B1, 0, 1); PG8_SCHED; PG8_LDA(At, 0, 0); PG8_STAGE(PG8_SA(1, 1), a1 + hsA, vA1);
            if (last && has_next) { vA0[0] = nA0[0]; vA0[1] = nA0[1]; vA1[0] = nA1[0]; vA1[1] = nA1[1]; }
            PG8_WAIT_V(8); PG8_WAIT_L(0); PG8_BAR; PG8_MMA(0, 0, At, B0); PG8_MMA(0, 1, At, B1); PG8_BAR; PG8_SCHED;
            PG8_LDA(At, 0, 1); PG8_STAGE(PG8_SB(0, 0), b2, voffB); PG8_STAGE(PG8_SB(0, 1), b2 + hstep, voffB); PG8_STAGE(PG8_SA(0, 0), a2, vA0);
            PG8_WAIT_V(8); PG8_WAIT_L(0); PG8_BAR; PG8_MMA(1, 0, At, B0); PG8_MMA(1, 1, At, B1); PG8_BAR; PG8_SCHED;
            PG8_LDB(B0, 1, 0); PG8_LDB(B1, 1, 1); PG8_SCHED; PG8_LDA(At, 1, 0); PG8_STAGE(PG8_SA(0, 1), a2 + hsA, vA1);
            PG8_WAIT_V(8); PG8_WAIT_L(0); PG8_BAR; PG8_MMA(0, 0, At, B0); PG8_MMA(0, 1, At, B1); PG8_BAR; PG8_SCHED;
            PG8_LDA(At, 1, 1); PG8_STAGE(PG8_SB(1, 0), b3, voffB); PG8_STAGE(PG8_SB(1, 1), b3 + hstep, voffB); PG8_STAGE(PG8_SA(1, 0), a3, vA0);
            PG8_WAIT_V(8); PG8_WAIT_L(0); PG8_BAR; PG8_MMA(1, 0, At, B0); PG8_MMA(1, 1, At, B1); PG8_BAR; PG8_SCHED;
        }
        if (wr == 0) PG8_BAR;
        if constexpr (FP8) {
#pragma unroll
            for (int a = 0; a < 2; ++a)
#pragma unroll
                for (int b = 0; b < 2; ++b) asm volatile("s_nop 15" : "+v"(acc[a][b][0][0]), "+v"(acc[a][b][0][1]), "+v"(acc[a][b][1][0]), "+v"(acc[a][b][1][1]), "+v"(acc[a][b][2][0]), "+v"(acc[a][b][2][1]), "+v"(acc[a][b][3][0]), "+v"(acc[a][b][3][1]));
        }
        const bool keep_acc = E(acc, cur, wr, wc, fr, fq);
        if (!has_next) break;
        if (!keep_acc)
#pragma unroll
        for (int a = 0; a < 2; ++a)
#pragma unroll
            for (int b = 0; b < 2; ++b)
#pragma unroll
                for (int m = 0; m < 4; ++m)
#pragma unroll
                    for (int n = 0; n < 2; ++n) acc[a][b][m][n] = (f32x4){0.f, 0.f, 0.f, 0.f};
        cur = nxt; cA = nA; cB = nB;
        if (wr == 1) PG8_BAR;
    }
    PG8_WAIT_V(0);
    PG8_BAR;
#undef PG8_AOFF
#undef PG8_SA
#undef PG8_SB
#undef PG8_STAGE
#undef PG8_LDA
#undef PG8_LDB
#undef PG8_MMA
#undef PG8_LD8
#undef PG8_WAIT_V
#undef PG8_WAIT_L
#undef PG8_BAR
#undef PG8_SCHED
}

struct EpiBf16 {
    static constexpr bool PERM = true;
    bf16_t* O; int ldc; const float* bias; int bias_estride; float ascale; int skip_from, skip_cols;
    __device__ __forceinline__ bool operator()(const f32x4 (&acc)[2][2][4][2], const Unit& u, int wr, int wc, int fr, int fq) const {
        const int row0 = u.pm * BM + wr * 64 + fr; const int col0 = u.pn * BM + wc * 32 + 8 * fq + (u.pn >= skip_from ? skip_cols : 0);
        f32x4 bv[2][2];
#pragma unroll
        for (int bj = 0; bj < 2; ++bj)
#pragma unroll
            for (int n = 0; n < 2; ++n) bv[bj][n] = bias ? *(const f32x4*)(bias + (size_t)u.e * bias_estride + col0 + bj * HALF + 4 * n) : (f32x4){0.f, 0.f, 0.f, 0.f};
#pragma unroll
        for (int ai = 0; ai < 2; ++ai)
#pragma unroll
            for (int m = 0; m < 4; ++m) { bf16_t* rowp = O + (size_t)(row0 + ai * HALF + m * 16) * ldc + col0;
#pragma unroll
                for (int bj = 0; bj < 2; ++bj) { const f32x4 v0 = acc[ai][bj][m][0] * ascale + bv[bj][0], v1 = acc[ai][bj][m][1] * ascale + bv[bj][1];
                    u32x4 w; w.x = cvt_pk_bf16(v0[0], v0[1]); w.y = cvt_pk_bf16(v0[2], v0[3]); w.z = cvt_pk_bf16(v1[0], v1[1]); w.w = cvt_pk_bf16(v1[2], v1[3]);
                    *(u32x4*)(rowp + bj * HALF) = w; } }
        return false;
    }
};
__device__ __forceinline__ float swiglu1(float ug, float ul) {
    ug = fminf(ug, 7.0f); ul = fminf(fmaxf(ul, -7.0f), 7.0f);
    return ug * __builtin_amdgcn_rcpf(1.0f + __expf(-1.702f * ug)) * (ul + 1.0f);
}
struct EpiSwiglu {
    static constexpr bool PERM = true;
    unsigned char* O; const float* b1;
    __device__ __forceinline__ bool operator()(const f32x4 (&acc)[2][2][4][2], const Unit& u, int wr, int wc, int fr, int fq) const {
        const int row0 = u.pm * BM + wr * 64 + fr; const int c0 = u.pn * 128 + wc * 32 + 8 * fq;
        const float* bg = b1 + (size_t)u.e * 4096 + c0; const float* bl = bg + 2048;
        f32x4 bgv[2], blv[2];
#pragma unroll
        for (int n = 0; n < 2; ++n) { bgv[n] = *(const f32x4*)(bg + 4 * n); blv[n] = *(const f32x4*)(bl + 4 * n); }
#pragma unroll
        for (int ai = 0; ai < 2; ++ai)
#pragma unroll
            for (int m = 0; m < 4; ++m) {
                float a[8];
#pragma unroll
                for (int n = 0; n < 2; ++n)
#pragma unroll
                    for (int j = 0; j < 4; ++j) a[4 * n + j] = ACT8_SCALE * swiglu1(acc[ai][0][m][n][j] * (1.0f / W8_SCALE) + bgv[n][j], acc[ai][1][m][n][j] * (1.0f / W8_SCALE) + blv[n][j]);
                u32x2 w; w.x = pack4_fp8(a[0], a[1], a[2], a[3]); w.y = pack4_fp8(a[4], a[5], a[6], a[7]);
                *(u32x2*)(O + (size_t)(row0 + ai * HALF + m * 16) * 2048 + c0) = w;
            }
        return false;
    }
};

struct TwoPartOrder {
    StaticOrder so; Unit held; int part;
    __device__ void init(int M, int N, int G_, int c_) { so.init(M, N, G_, c_); part = 0; }
    __device__ bool next(Unit& u) { if (part == 1) { u = held; u.e = 1; part = 0; return true; } if (!so.next(held)) return false; u = held; u.e = 0; part = 1; return true; }
};
struct EpiGate2 {
    static constexpr bool PERM = true;
    unsigned char* O; const bf16_t* Ga; const bf16_t* Gr;
    __device__ __forceinline__ bool operator()(f32x4 (&acc)[2][2][4][2], const Unit& u, int wr, int wc, int fr, int fq) const {
        const int row0 = u.pm * BM + wr * 64 + fr; const int col0 = u.pn * BM + wc * 32 + 8 * fq;
#pragma unroll
        for (int ai = 0; ai < 2; ++ai)
#pragma unroll
            for (int m = 0; m < 4; ++m) { const size_t row = (size_t)(row0 + ai * HALF + m * 16);
#pragma unroll
                for (int bj = 0; bj < 2; ++bj) { const int c = col0 + bj * HALF;
                    const u32x4 gr = *(const u32x4*)(Gr + row * DINP + c);
                    if (u.e == 0) {
                        const u32x4 ga = *(const u32x4*)(Ga + row * DINP + c);
#pragma unroll
                        for (int q = 0; q < 4; ++q) {
                            const float r0 = (1.0f + __expf(-bf_lo(gr[q]))) * __builtin_amdgcn_rcpf(1.0f + __expf(-bf_lo(ga[q]))), r1 = (1.0f + __expf(-bf_hi(gr[q]))) * __builtin_amdgcn_rcpf(1.0f + __expf(-bf_hi(ga[q])));
                            acc[ai][bj][m][q >> 1][(2 * q) & 3] *= r0; acc[ai][bj][m][q >> 1][(2 * q + 1) & 3] *= r1; }
                    } else {
                        float r[8];
#pragma unroll
                        for (int q = 0; q < 4; ++q) { r[2 * q] = sigmoidf_(bf_lo(gr[q])) * acc[ai][bj][m][q >> 1][(2 * q) & 3]; r[2 * q + 1] = sigmoidf_(bf_hi(gr[q])) * acc[ai][bj][m][q >> 1][(2 * q + 1) & 3]; }
                        u32x2 w; constexpr float osc = MRG8_SCALE / (W8_SCALE * OP8_SCALE); w.x = pack4_fp8(r[0] * osc, r[1] * osc, r[2] * osc, r[3] * osc); w.y = pack4_fp8(r[4] * osc, r[5] * osc, r[6] * osc, r[7] * osc);
                        *(u32x2*)(O + row * 2048 + c) = w; } } }
        return u.e == 0;
    }
};
struct EpiDelta {
    static constexpr bool PERM = true;
    const float* gt; bf16_t* DL; float ascale;
    __device__ __forceinline__ bool operator()(const f32x4 (&acc)[2][2][4][2], const Unit& u, int wr, int wc, int fr, int fq) const {
        const int row0 = u.pm * BM + wr * 64 + fr; const int col0 = u.pn * BM + wc * 32 + 8 * fq;
        f32x4 g[2][2];
#pragma unroll
        for (int bj = 0; bj < 2; ++bj)
#pragma unroll
            for (int n = 0; n < 2; ++n) g[bj][n] = *(const f32x4*)(gt + col0 + bj * HALF + 4 * n);
#pragma unroll
        for (int ai = 0; ai < 2; ++ai)
#pragma unroll
            for (int m = 0; m < 4; ++m) { bf16_t* rowp = DL + (size_t)(row0 + ai * HALF + m * 16) * 2048 + col0;
#pragma unroll
                for (int bj = 0; bj < 2; ++bj) { const f32x4 v0 = acc[ai][bj][m][0] * ascale * g[bj][0], v1 = acc[ai][bj][m][1] * ascale * g[bj][1];
                    u32x4 w; w.x = cvt_pk_bf16(v0[0], v0[1]); w.y = cvt_pk_bf16(v0[2], v0[3]); w.z = cvt_pk_bf16(v1[0], v1[1]); w.w = cvt_pk_bf16(v1[2], v1[3]);
                    *(u32x4*)(rowp + bj * HALF) = w; } }
        return false;
    }
};
}

struct Args { const void* in[22]; float* out; unsigned char* ws; int ph_lo, ph_hi, flags, pad; };
constexpr int XCONV = 0, XSCORE = 96;
constexpr int CW_SCQ = 12288, SCP = 5, CW_ATQ = 12352;
enum { PH_PRO = 0, PH_H, PH_INPROJ, PH_POST, PH_SCORE, PH_SELECT, PH_ATTN, PH_OP1, PH_OP2, PH_WOUT, PH_ROUTER, PH_SCATTER, PH_MOE1, PH_MOE2, PH_FINAL, NPH };

__device__ __forceinline__ int dest_row(int mode, int n) {
    if (mode == 1) return n < 2640 ? n : n + 176;
    if (mode == 2) { const int g = n >> 11, c = n & 2047; return (c >> 7) * 256 + g * 128 + (c & 127); }
    return n;
}
__device__ __forceinline__ void convert_item(const float* __restrict__ W, int K, int N, int ld, bf16_t* WT, int mode, int item, int lane, LAS unsigned char* scr) {
    const int nblk = (N + 63) >> 6; const int kb = item / nblk, nb = item - kb * nblk; const int k0 = kb * 128, n0 = nb * 64;
    const int c4 = lane & 15, kr = lane >> 4;
    const bool ok = (n0 + 4 * c4) < N;
    const float* src = W + (size_t)(k0 + 2 * kr) * ld + n0 + 4 * c4;
#pragma unroll 4
    for (int i = 0; i < 16; ++i) {
        f32x4 v0 = (f32x4){0.f, 0.f, 0.f, 0.f}, v1 = v0;
        if (ok) { v0 = *(const f32x4*)(src + (size_t)(8 * i) * ld); v1 = *(const f32x4*)(src + (size_t)(8 * i + 1) * ld); }
        const int kk = 8 * i + 2 * kr;
#pragma unroll
        for (int e = 0; e < 4; ++e) *(LAS unsigned*)(scr + (4 * c4 + e) * 272 + kk * 2) = cvt_pk_bf16(v0[e], v1[e]);
    }
    LDS_WAIT(); asm volatile("" ::: "memory");
#pragma unroll 4
    for (int j = 0; j < 16; ++j) {
        const int q = j * 64 + lane, n = q >> 4, ch = q & 15;
        const u32x4 v = *(const LAS u32x4*)(scr + n * 272 + ch * 16);
        if (n0 + n < N) *(u32x4*)(WT + (size_t)dest_row(mode, n0 + n) * K + k0 + ch * 8) = v;
    }
    LDS_WAIT(); asm volatile("" ::: "memory");
}


__device__ __forceinline__ bf16_t f2bf(float f) { unsigned u = __float_as_uint(f); return (bf16_t)((u + 0x7fffu + ((u >> 16) & 1u)) >> 16); }
__device__ __forceinline__ float bfx(const u32x4& w, int i) { const unsigned u = w[i >> 1]; return (i & 1) ? bf_hi(u) : bf_lo(u); }
__device__ __forceinline__ void rope_sc(float pos, float inv, float& sn, float& cs) {
    const float ang = pos * inv;
    const double a = (double)ang; const double n = __builtin_rint(a * 0.15915494309189535); const float r = (float)(a - n * 6.283185307179586);
    sn = __sinf(r); cs = __cosf(r);
}
__device__ __forceinline__ void post_token(bf16_t* PROJ, bf16_t* KI, unsigned char* KC, unsigned char* VC, const int* positions, const float* kng, const float* knb, float inv16, float inv8, int t, int lane) {
    const float pos = (float)positions[t];
    bf16_t* row = PROJ + (size_t)t * DINP;
    float sn, cs, sn8, cs8;
    rope_sc(pos, inv16, sn, cs); rope_sc(pos, inv8, sn8, cs8);
#pragma unroll
    for (int i = 0; i < 2; ++i) {
        const int pp = lane + 64 * i, hd = pp >> 4, ii = pp & 15;
        bf16_t* p = row + CQ + hd * 128 + ii; const float a = bf2f(p[0]), b = bf2f(p[16]);
        p[0] = f2bf(a * cs - b * sn); p[16] = f2bf(b * cs + a * sn);
    }
#pragma unroll
    for (int i = 0; i < 2; ++i) {
        const int pp = lane + 64 * i, hd = pp >> 3, ii = pp & 7;
        bf16_t* p = row + CQI + hd * 64 + ii; const float a = bf2f(p[0]), b = bf2f(p[8]);
        p[0] = f2bf(a * cs8 - b * sn8); p[8] = f2bf(b * cs8 + a * sn8);
    }
    if (lane < 32) {
        const int g = lane >> 4, ii = lane & 15;
        const bf16_t* p = row + CK + g * 128 + ii; const float a = bf2f(p[0]), b = bf2f(p[16]);
        unsigned char* o = KC + (size_t)t * 256 + g * 128 + ii; o[0] = fp8_1(a * cs - b * sn); o[16] = fp8_1(b * cs + a * sn);
    }
#pragma unroll
    for (int i = 0; i < 3; ++i) { const int idx = lane + 64 * i, g = idx / 96, r = idx - g * 96; KC[(size_t)t * 256 + g * 128 + 32 + r] = fp8_1(bf2f(row[CK + g * 128 + 32 + r])); }
    { const u32x2 w = *(const u32x2*)(row + CV + 4 * lane); *(unsigned*)(VC + (size_t)t * 256 + 4 * lane) = pack4_fp8(bf_lo(w.x), bf_hi(w.x), bf_lo(w.y), bf_hi(w.y)); }
    {
        const float v = bf2f(row[CKI + lane]);
        const float mean = wave_sum(v) * (1.0f / 64.0f); const float d = v - mean; const float var = wave_sum(d * d) * (1.0f / 64.0f);
        const float y = d * rsqrtf(var + NORM_EPS) * kng[lane] + knb[lane];
        const float other = __shfl_xor(y, 8);
        float o = y;
        if (lane < 8) o = y * cs8 - other * sn8; else if (lane < 16) o = y * cs8 + other * sn8;
        KI[(size_t)t * 64 + lane] = f2bf(o);
    }
}

constexpr int HG_GB = 0, HG_Q1 = 33792, HG_Q2 = 51200, HG_K2 = 68608, HG_VT = 86016, HG_PB = 104448, HG_LB = 113664;
__device__ __forceinline__ void hgrn_cumsum(LAS unsigned char* lds, const u32x4& w0, const u32x4& w1, float l0, float l1, int tid) {
    LAS float* GB = (LAS float*)(lds + HG_GB); LAS float* LB = (LAS float*)(lds + HG_LB); LAS float* SEG = (LAS float*)(lds + HG_LB + 512);
    if (tid < 128) LB[tid] = 1.0f / (1.0f + expf(l1 - l0));
    __syncthreads();
    const int t = tid >> 3, dseg = tid & 7;
#pragma unroll
    for (int i = 0; i < 16; ++i) { const float z = i < 8 ? bfx(w0, i) : bfx(w1, i - 8); const float lb = LB[16 * dseg + i]; GB[t * 128 + 16 * dseg + i] = __logf(lb + (1.0f - lb) * sigmoidf_(z)); }
    __syncthreads();
    const int d = tid & 127, tq = tid >> 7;
    float z[16];
#pragma unroll
    for (int i = 0; i < 16; ++i) z[i] = GB[(16 * tq + i) * 128 + d];
    float a = 0.f;
#pragma unroll
    for (int i = 0; i < 16; ++i) { a += z[i]; z[i] = a; }
    SEG[tq * 128 + d] = a;
    __syncthreads();
    float pre = 0.f;
    for (int q = 0; q < tq; ++q) pre += SEG[q * 128 + d];
#pragma unroll
    for (int i = 0; i < 16; ++i) GB[(16 * tq + i) * 128 + d] = z[i] + pre;
    __syncthreads();
}
__device__ __forceinline__ void hgrn_vt(LAS unsigned char* lds, const u32x4& a, const u32x4& b, int tid) {
    const int s2 = tid & 31, eg = tid >> 5;
#pragma unroll
    for (int i = 0; i < 8; ++i) { const unsigned lo = (i & 1) ? (a[i >> 1] >> 16) : (a[i >> 1] & 0xffffu), hi = (i & 1) ? (b[i >> 1] >> 16) : (b[i >> 1] & 0xffffu);
        *(LAS unsigned*)(lds + HG_VT + (8 * eg + i) * 144 + s2 * 4) = lo | (hi << 16); }
}
__device__ __forceinline__ void hgrn_l1(LAS unsigned char* lds, const bf16_t* PROJ, const float* lb_logits, bf16_t* ST, float* DC, int c, int h, int tid, int wave, int lane) {
    const int t = tid >> 3, dseg = tid & 7, s2 = tid & 31, dg = tid >> 5;
    const bf16_t* pf = PROJ + (size_t)(c * 64 + t) * DINP + CHF + h * 128 + 16 * dseg;
    const bf16_t* pk = PROJ + (size_t)(c * 64 + 2 * s2) * DINP + CHF + h * 128 + 8 * dg;
    const u32x4 w0 = *(const u32x4*)pf, w1 = *(const u32x4*)(pf + 8);
    const u32x4 ka = *(const u32x4*)pk, kb = *(const u32x4*)(pk + DINP);
    const u32x4 va = *(const u32x4*)(pk - CHF + CHI), vb = *(const u32x4*)(pk - CHF + CHI + DINP);
    const float l0 = lb_logits[h * 128 + (tid & 127)], l1 = lb_logits[1024 + h * 128 + (tid & 127)];
    hgrn_cumsum(lds, w0, w1, l0, l1, tid);
    const LAS float* GB = (const LAS float*)(lds + HG_GB); const LAS float* LB = (const LAS float*)(lds + HG_LB);
    {
#pragma unroll
        for (int i = 0; i < 8; ++i) { const int d = 8 * dg + i; const float lb = LB[d], b63 = GB[63 * 128 + d];
            const float k0 = (1.0f - lb) * (1.0f - sigmoidf_(bfx(ka, i))), k1 = (1.0f - lb) * (1.0f - sigmoidf_(bfx(kb, i)));
            const float v0 = k0 * __expf(b63 - GB[(2 * s2) * 128 + d]), v1 = k1 * __expf(b63 - GB[(2 * s2 + 1) * 128 + d]);
            *(LAS unsigned*)(lds + HG_Q1 + d * 144 + s2 * 4) = cvt_pk_bf16(v0, v1); }
    }
    hgrn_vt(lds, va, vb, tid);
    __syncthreads();
    const int fr = lane & 15, fq = lane >> 4;
    bf16x8 af[2];
#pragma unroll
    for (int ks = 0; ks < 2; ++ks) af[ks] = *(const LAS bf16x8*)(lds + HG_VT + (16 * wave + fr) * 144 + (32 * ks + 8 * fq) * 2);
    bf16_t* dst = ST + ((size_t)(c * 8 + h) * 128) * 128;
#pragma unroll 2
    for (int dt = 0; dt < 8; ++dt) {
        f32x4 acc = (f32x4){0.f, 0.f, 0.f, 0.f};
#pragma unroll
        for (int ks = 0; ks < 2; ++ks) { const bf16x8 bfr = *(const LAS bf16x8*)(lds + HG_Q1 + (16 * dt + fr) * 144 + (32 * ks + 8 * fq) * 2); acc = __builtin_amdgcn_mfma_f32_16x16x32_bf16(af[ks], bfr, acc, 0, 0, 0); }
#pragma unroll
        for (int r = 0; r < 4; ++r) dst[(size_t)(16 * wave + 4 * fq + r) * 128 + 16 * dt + fr] = f2bf(acc[r]);
    }
    if (tid < 128) DC[(size_t)(c * 8 + h) * 128 + tid] = __expf(GB[63 * 128 + tid]);
    __syncthreads();
}
__device__ __forceinline__ void hgrn_l3(LAS unsigned char* lds, const bf16_t* PROJ, const float* lb_logits, const bf16_t* ST, const float* norm_g, unsigned char* REC, int c, int h, int tid, int wave, int lane) {
    const int t = tid >> 3, dseg = tid & 7, s2 = tid & 31, eg = tid >> 5, fr = lane & 15, fq = lane >> 4;
    const bf16_t* pf = PROJ + (size_t)(c * 64 + t) * DINP + CHF + h * 128 + 16 * dseg;
    const u32x4 f0 = *(const u32x4*)pf, f1 = *(const u32x4*)(pf + 8), q0 = *(const u32x4*)(pf - CHF + CHQ), q1 = *(const u32x4*)(pf - CHF + CHQ + 8);
    const u32x4 g0 = *(const u32x4*)(pf - CHF + CHG), g1 = *(const u32x4*)(pf - CHF + CHG + 8);
    const bf16_t* pv = PROJ + (size_t)(c * 64 + 2 * s2) * DINP + CHI + h * 128 + 8 * eg;
    const u32x4 va = *(const u32x4*)pv, vb = *(const u32x4*)(pv + DINP);
    const bf16_t* sp = ST + ((size_t)(c * 8 + h) * 128 + 16 * wave + fr) * 128 + 8 * fq;
    u32x4 sx[4];
#pragma unroll
    for (int ks = 0; ks < 4; ++ks) sx[ks] = *(const u32x4*)(sp + 32 * ks);
    const float l0 = lb_logits[h * 128 + (tid & 127)], l1 = lb_logits[1024 + h * 128 + (tid & 127)];
    hgrn_cumsum(lds, f0, f1, l0, l1, tid);
    const LAS float* GB = (const LAS float*)(lds + HG_GB); const LAS float* LB = (const LAS float*)(lds + HG_LB);
    {
        unsigned o1[8], o2[8], o3[8];
#pragma unroll
        for (int i = 0; i < 16; i += 2) {
            float a1[2], a2[2], a3[2];
#pragma unroll
            for (int j = 0; j < 2; ++j) { const int d = 16 * dseg + i + j; const float lb = LB[d], b = GB[t * 128 + d], br = GB[31 * 128 + d];
                const float z = (i + j) < 8 ? bfx(f0, i + j) : bfx(f1, i + j - 8), qv = (i + j) < 8 ? bfx(q0, i + j) : bfx(q1, i + j - 8);
                const float k = (1.0f - lb) * (1.0f - sigmoidf_(z)), q = siluf_(qv);
                a1[j] = q * __expf(b); a2[j] = q * __expf(b - br); a3[j] = k * __expf(br - b); }
            o1[i >> 1] = cvt_pk_bf16(a1[0], a1[1]); o2[i >> 1] = cvt_pk_bf16(a2[0], a2[1]); o3[i >> 1] = cvt_pk_bf16(a3[0], a3[1]);
        }
        LAS u32x4* d1 = (LAS u32x4*)(lds + HG_Q1 + t * 272 + dseg * 32); LAS u32x4* d2 = (LAS u32x4*)(lds + HG_Q2 + t * 272 + dseg * 32); LAS u32x4* d3 = (LAS u32x4*)(lds + HG_K2 + t * 272 + dseg * 32);
        d1[0] = (u32x4){o1[0], o1[1], o1[2], o1[3]}; d1[1] = (u32x4){o1[4], o1[5], o1[6], o1[7]};
        d2[0] = (u32x4){o2[0], o2[1], o2[2], o2[3]}; d2[1] = (u32x4){o2[4], o2[5], o2[6], o2[7]};
        d3[0] = (u32x4){o3[0], o3[1], o3[2], o3[3]}; d3[1] = (u32x4){o3[4], o3[5], o3[6], o3[7]};
    }
    hgrn_vt(lds, va, vb, tid);
    __syncthreads();
#pragma unroll
    for (int q = 0; q < 2; ++q) {
        const int tile = 2 * wave + q, tt = tile >> 2, stl = tile & 3;
        f32x4 acc = (f32x4){0.f, 0.f, 0.f, 0.f};
#pragma unroll
        for (int ks = 0; ks < 4; ++ks) { const bf16x8 a = *(const LAS bf16x8*)(lds + HG_Q2 + (16 * tt + fr) * 272 + (32 * ks + 8 * fq) * 2), b = *(const LAS bf16x8*)(lds + HG_K2 + (16 * stl + fr) * 272 + (32 * ks + 8 * fq) * 2);
            acc = __builtin_amdgcn_mfma_f32_16x16x32_bf16(a, b, acc, 0, 0, 0); }
#pragma unroll
        for (int r = 0; r < 4; ++r) { const int tr_ = 16 * tt + 4 * fq + r, s = 16 * stl + fr; *(LAS bf16_t*)(lds + HG_PB + tr_ * 144 + s * 2) = f2bf(s <= tr_ ? acc[r] : 0.f); }
    }
    __syncthreads();
    {
        bf16x8 b1[2], b2[4];
#pragma unroll
        for (int ks = 0; ks < 2; ++ks) b1[ks] = *(const LAS bf16x8*)(lds + HG_VT + (16 * wave + fr) * 144 + (32 * ks + 8 * fq) * 2);
#pragma unroll
        for (int ks = 0; ks < 4; ++ks) b2[ks] = __builtin_bit_cast(bf16x8, sx[ks]);
        LAS float* OB = (LAS float*)(lds + HG_GB);
#pragma unroll
        for (int tt = 0; tt < 4; ++tt) {
            f32x4 acc = (f32x4){0.f, 0.f, 0.f, 0.f};
#pragma unroll
            for (int ks = 0; ks < 2; ++ks) { const bf16x8 a = *(const LAS bf16x8*)(lds + HG_PB + (16 * tt + fr) * 144 + (32 * ks + 8 * fq) * 2); acc = __builtin_amdgcn_mfma_f32_16x16x32_bf16(a, b1[ks], acc, 0, 0, 0); }
#pragma unroll
            for (int ks = 0; ks < 4; ++ks) { const bf16x8 a = *(const LAS bf16x8*)(lds + HG_Q1 + (16 * tt + fr) * 272 + (32 * ks + 8 * fq) * 2); acc = __builtin_amdgcn_mfma_f32_16x16x32_bf16(a, b2[ks], acc, 0, 0, 0); }
#pragma unroll
            for (int r = 0; r < 4; ++r) OB[(16 * tt + 4 * fq + r) * 132 + 16 * wave + fr] = acc[r];
        }
    }
    __syncthreads();
    {
        const int es = dseg; const LAS float* OB = (const LAS float*)(lds + HG_GB);
        float o[16]; float ss = 0.f;
#pragma unroll
        for (int i = 0; i < 16; ++i) { o[i] = OB[t * 132 + 16 * es + i]; ss += o[i] * o[i]; }
        ss += __shfl_xor(ss, 1); ss += __shfl_xor(ss, 2); ss += __shfl_xor(ss, 4);
        const float rstd = rsqrtf(ss * (1.0f / 128.0f) + NORM_EPS);
        float rv[16];
#pragma unroll
        for (int i = 0; i < 16; ++i) { const float ga = i < 8 ? bfx(g0, i) : bfx(g1, i - 8); rv[i] = o[i] * (rstd * OP8_SCALE) * norm_g[16 * es + i] * siluf_(ga); }
        *(u32x4*)(REC + (size_t)(c * 64 + t) * 1024 + h * 128 + 16 * es) = (u32x4){pack4_fp8(rv[0], rv[1], rv[2], rv[3]), pack4_fp8(rv[4], rv[5], rv[6], rv[7]), pack4_fp8(rv[8], rv[9], rv[10], rv[11]), pack4_fp8(rv[12], rv[13], rv[14], rv[15])};
    }
    __syncthreads();
}

constexpr int SC_KT = 0, SC_SB = 36864, SC_SPITCH = 132;
__device__ __forceinline__ unsigned pk_f16(float a, float b) { return __builtin_bit_cast(unsigned, __builtin_amdgcn_cvt_pkrtz(a, b)); }
__device__ __forceinline__ void score_flush(LAS unsigned char* lds, unsigned short* SCORES, unsigned short* SEGMAX, int t0, int kt, int tid) {
    const LAS float* sb = (const LAS float*)(lds + SC_SB + (kt & 1) * (32 * SC_SPITCH * 4));
    const int row = tid >> 4, seg = tid & 15;
    const f32x4 a = *(const LAS f32x4*)(sb + row * SC_SPITCH + seg * 8), b = *(const LAS f32x4*)(sb + row * SC_SPITCH + seg * 8 + 4);
    unsigned short* dst = SCORES + (size_t)(t0 + row) * S + kt * 128 + seg * 8;
    *(u32x4*)dst = (u32x4){pk_f16(a[0], a[1]), pk_f16(a[2], a[3]), pk_f16(b[0], b[1]), pk_f16(b[2], b[3])};
    const float mx = fmaxf(fmaxf(fmaxf(a[0], a[1]), fmaxf(a[2], a[3])), fmaxf(fmaxf(b[0], b[1]), fmaxf(b[2], b[3])));
    SEGMAX[(size_t)(t0 + row) * 2048 + kt * 16 + seg] = (unsigned short)(pk_f16(mx, mx) & 0xffffu);
}
__device__ __forceinline__ void score_block(LAS unsigned char* lds, const bf16_t* PROJ, const bf16_t* KI, unsigned short* SCORES, unsigned short* SEGMAX, int qb, int kt0, int kt1, int tid, int wave, int lane) {
    const int t0 = qb * 32;
    const int r = lane & 31, hh = lane >> 5;
    bf16x8 Af[2][4]; float wv[2][16]; f32x2 wv2[2][8];
#pragma unroll
    for (int p = 0; p < 2; ++p) {
        const int tq = t0 + 4 * wave + 2 * p + (r >> 4); const bf16_t* qrow = PROJ + (size_t)tq * DINP + CQI + (r & 15) * 64 + 8 * hh;
#pragma unroll
        for (int ks = 0; ks < 4; ++ks) Af[p][ks] = *(const bf16x8*)(qrow + 16 * ks);
#pragma unroll
        for (int qq = 0; qq < 2; ++qq) {
            const bf16_t* wp = PROJ + (size_t)(t0 + 4 * wave + 2 * p + qq) * DINP + CWI + 4 * hh;
            const u32x2 wa = *(const u32x2*)wp, wb = *(const u32x2*)(wp + 8);
            wv[p][8 * qq + 0] = bf_lo(wa.x) * (1.0f / 32.0f); wv[p][8 * qq + 1] = bf_hi(wa.x) * (1.0f / 32.0f); wv[p][8 * qq + 2] = bf_lo(wa.y) * (1.0f / 32.0f); wv[p][8 * qq + 3] = bf_hi(wa.y) * (1.0f / 32.0f);
            wv[p][8 * qq + 4] = bf_lo(wb.x) * (1.0f / 32.0f); wv[p][8 * qq + 5] = bf_hi(wb.x) * (1.0f / 32.0f); wv[p][8 * qq + 6] = bf_lo(wb.y) * (1.0f / 32.0f); wv[p][8 * qq + 7] = bf_hi(wb.y) * (1.0f / 32.0f);
        }
#pragma unroll
        for (int i = 0; i < 8; ++i) wv2[p][i] = (f32x2){wv[p][2 * i], wv[p][2 * i + 1]};
    }
    const u32x2 tagsw = __builtin_amdgcn_permlane32_swap(0u, 1u, false, false); const int qsel = (int)tagsw[0];
    u32x4 stg[2];
#pragma unroll
    for (int i = 0; i < 2; ++i) { const int q = tid + 512 * i; stg[i] = *(const u32x4*)(KI + (size_t)(kt0 * 128 + (q >> 3)) * 64 + (q & 7) * 8); }
#pragma unroll
    for (int i = 0; i < 2; ++i) { const int q = tid + 512 * i; *(LAS u32x4*)(lds + SC_KT + (kt0 & 1) * 18432 + (q >> 3) * 144 + (q & 7) * 16) = stg[i]; }
    __syncthreads();
    for (int kt = kt0; kt < kt1; ++kt) {
        const LAS unsigned char* buf = lds + SC_KT + (kt & 1) * 18432;
        LAS float* sb = (LAS float*)(lds + SC_SB + (kt & 1) * (32 * SC_SPITCH * 4));
        if (kt + 1 < kt1) {
#pragma unroll
            for (int i = 0; i < 2; ++i) { const int q = tid + 512 * i; stg[i] = *(const u32x4*)(KI + (size_t)((kt + 1) * 128 + (q >> 3)) * 64 + (q & 7) * 8); }
        }
        __builtin_amdgcn_sched_barrier(0);
        if (kt > kt0) score_flush(lds, SCORES, SEGMAX, t0, kt - 1, tid);
        {
        f32x16 accP[2], accC[2];
#define SC_MFMA(cb) do { bf16x8 Bf[4]; _Pragma("unroll") for (int ks = 0; ks < 4; ++ks) Bf[ks] = *(const LAS bf16x8*)(buf + (32 * (cb) + r) * 144 + (16 * ks + 8 * hh) * 2); \
            _Pragma("unroll") for (int p = 0; p < 2; ++p) { _Pragma("unroll") for (int i = 0; i < 16; ++i) accC[p][i] = 0.f; \
                _Pragma("unroll") for (int ks = 0; ks < 4; ++ks) accC[p] = __builtin_amdgcn_mfma_f32_32x32x16_bf16(Af[p][ks], Bf[ks], accC[p], 0, 0, 0); } } while (0)
#define SC_RED(acc, cb) do { _Pragma("unroll") for (int p = 0; p < 2; ++p) { f32x2 s0 = {0.f, 0.f}, s1 = {0.f, 0.f}; \
            _Pragma("unroll") for (int reg = 0; reg < 8; reg += 2) { const f32x2 r0 = {relu_i(acc[p][reg]), relu_i(acc[p][reg + 1])}; const f32x2 r1 = {relu_i(acc[p][reg + 8]), relu_i(acc[p][reg + 9])}; \
                s0 = __builtin_elementwise_fma(wv2[p][reg >> 1], r0, s0); s1 = __builtin_elementwise_fma(wv2[p][4 + (reg >> 1)], r1, s1); } \
            const float p0 = s0[0] + s0[1], p1 = s1[0] + s1[1]; \
            const u32x2 sw = __builtin_amdgcn_permlane32_swap(__float_as_uint(p0), __float_as_uint(p1), false, false); \
            sb[(4 * wave + 2 * p + qsel) * SC_SPITCH + 32 * (cb) + r] = __uint_as_float(sw[0]) + __uint_as_float(sw[1]); } } while (0)
#define SC_INTERLEAVE() do { _Pragma("unroll") for (int i = 0; i < 8; ++i) { __builtin_amdgcn_sched_group_barrier(0x008, 1, 0); __builtin_amdgcn_sched_group_barrier(0x002, 8, 0); } } while (0)
        SC_MFMA(0);
        accP[0] = accC[0]; accP[1] = accC[1]; SC_MFMA(1); SC_RED(accP, 0); SC_INTERLEAVE();
        accP[0] = accC[0]; accP[1] = accC[1]; SC_MFMA(2); SC_RED(accP, 1); SC_INTERLEAVE();
        accP[0] = accC[0]; accP[1] = accC[1]; SC_MFMA(3); SC_RED(accP, 2); SC_INTERLEAVE();
        SC_RED(accC, 3);
#undef SC_MFMA
#undef SC_RED
#undef SC_INTERLEAVE
        }
        if (kt + 1 < kt1) {
#pragma unroll
            for (int i = 0; i < 2; ++i) { const int q = tid + 512 * i; *(LAS u32x4*)(lds + SC_KT + ((kt + 1) & 1) * 18432 + (q >> 3) * 144 + (q & 7) * 16) = stg[i]; }
        }
        __syncthreads();
    }
    score_flush(lds, SCORES, SEGMAX, t0, kt1 - 1, tid);
    __syncthreads();
}

template <int NV, bool EXACT, int TOL = 2>
__device__ __forceinline__ float wave_kth(const float (&v)[NV], int K) {
    const float NINF = -__builtin_inff();
    float mx = NINF, mn = __builtin_inff();
#pragma unroll
    for (int j = 0; j < NV; ++j) { mx = fmaxf(mx, v[j]); mn = fminf(mn, v[j] == NINF ? __builtin_inff() : v[j]); }
    mx = wave_max(mx); mn = -wave_max(-mn);
    int c = 0;
#pragma unroll
    for (int j = 0; j < NV; ++j) c += __popcll(__ballot(v[j] >= mx));
    if (c >= K) return mx;
    float lo = mn, hi = mx, tau = mn;
    for (int it = 0; it < 64; ++it) {
        const float mid = 0.5f * (lo + hi);
        if (!(mid > lo && mid < hi)) { tau = lo; break; }
        c = 0;
#pragma unroll
        for (int j = 0; j < NV; ++j) c += __popcll(__ballot(v[j] >= mid));
        if (c == K || (!EXACT && c > K && c <= K + (K >> TOL))) { tau = mid; break; }
        if (c > K) lo = mid; else hi = mid;
        tau = lo;
    }
    return tau;
}
__device__ __forceinline__ float wave_kth16(const float (&v)[16], int K) { return wave_kth<16, true>(v, K); }
__device__ __forceinline__ int lanes_below(unsigned long long mask) { return (int)__builtin_amdgcn_mbcnt_hi((unsigned)(mask >> 32), __builtin_amdgcn_mbcnt_lo((unsigned)mask, 0u)); }
__device__ __forceinline__ float h2f(unsigned short h) { return (float)__builtin_bit_cast(_Float16, h); }
__device__ __forceinline__ float h2f_lo(unsigned u) { return h2f((unsigned short)(u & 0xffffu)); }
__device__ __forceinline__ float h2f_hi(unsigned u) { return h2f((unsigned short)(u >> 16)); }
__device__ __forceinline__ unsigned ge_mask8(const u32x4& v, unsigned T16) {
    unsigned m8 = 0;
#pragma unroll
    for (int w = 0; w < 4; ++w) { const unsigned vw_ = v[w];
        const s16x2 d = __builtin_elementwise_sub_sat(__builtin_bit_cast(s16x2, vw_), __builtin_bit_cast(s16x2, T16));
        const unsigned mm = ~__builtin_bit_cast(unsigned, d); m8 |= (((mm >> 15) & 1u) | ((mm >> 30) & 2u)) << (2 * w); }
    return m8;
}
__device__ __forceinline__ int append_bits(LAS int* list, int cnt, unsigned m8, int base) {
    for (;;) { const bool has = m8 != 0u; const unsigned long long mask = __ballot(has); if (!mask) break;
        const int pos = cnt + lanes_below(mask);
        if (has) { const int k = __builtin_ctz(m8); m8 &= m8 - 1u; if (pos < 1024) list[pos] = base + k; }
        cnt += __popcll(mask); }
    return cnt;
}
__device__ __forceinline__ int append_keys(LAS int* list, int cnt, unsigned m8, int base, const u32x4& v) {
    for (;;) { const bool has = m8 != 0u; const unsigned long long mask = __ballot(has); if (!mask) break;
        const int pos = cnt + lanes_below(mask);
        if (has) { const int k = __builtin_ctz(m8); m8 &= m8 - 1u;
            const unsigned dw = (k & 4) ? ((k & 2) ? v.w : v.z) : ((k & 2) ? v.y : v.x); const unsigned h = (k & 1) ? (dw >> 16) : (dw & 0xffffu);
            if (pos < 1024) list[pos] = (int)((h << 16) | (unsigned)(base + k)); }
        cnt += __popcll(mask); }
    return cnt;
}
__device__ __forceinline__ void select_row(LAS unsigned char* wl, const unsigned short* SCORES, const unsigned short* SEGMAX, int t, int lane) {
    LAS int* selw = (LAS int*)wl; LAS int* segl = (LAS int*)(wl + 1024); LAS int* cidx = (LAS int*)(wl + 5120);
    const float NINF = -__builtin_inff();
    const unsigned short* row = SCORES + (size_t)t * S; const int n = t + 1;
    float c[16]; int N;
    if (n <= 1024) {
#pragma unroll
        for (int j = 0; j < 16; ++j) { const int i = lane + 64 * j; c[j] = i < n ? h2f(row[i]) : NINF; }
        N = -1;
    } else {
        const u32x4 NEG = (u32x4){0xfc00fc00u, 0xfc00fc00u, 0xfc00fc00u, 0xfc00fc00u};
        const unsigned short* smrow = SEGMAX + (size_t)t * 2048; const int nseg = (t >> 3) + 1;
        const bool segpath = nseg >= 512;
        float s[16], s8[8];
        if (!segpath) {
#pragma unroll
            for (int j = 0; j < 16; ++j) { const int i = lane + 64 * j; s[j] = i < (n >> 4) ? h2f(row[16 * i + 7]) : NINF; }
        }
        u32x4 sv[4];
#pragma unroll
        for (int u = 0; u < 4; ++u) { const int e8 = 8 * (lane + 64 * u); sv[u] = (e8 < nseg) ? *(const u32x4*)(smrow + e8) : NEG; }
#pragma unroll
        for (int u = 0; u < 4; ++u) { const int e8 = 8 * (lane + 64 * u); s8[2 * u] = h2f_lo(sv[u].x); s8[2 * u + 1] = (e8 + 4 < nseg) ? h2f_lo(sv[u].z) : NINF; }
        const int m = segpath ? (nseg >> 2) : (n >> 4);
        int K = segpath ? 85 : 26, cnt = 0;
        for (;;) {
            const float tlo = (K >= m) ? NINF : (segpath ? wave_kth<8, false, 3>(s8, K) : wave_kth<16, false, 2>(s, K));
            cnt = 0;
            const int nq = (n + 511) >> 9;
            if (tlo > 0.f) {
                const unsigned T16 = pk_f16(tlo, tlo);
                int ns = 0;
                {
#pragma unroll
                    for (int u = 0; u < 4; ++u) if (512 * u < nseg) { const int e8 = 8 * (lane + 64 * u); unsigned m8 = ge_mask8(sv[u], T16);
                        const int nv = nseg - e8; if (nv < 8) m8 &= nv > 0 ? ((1u << nv) - 1u) : 0u;
                        ns = append_bits(segl, ns, m8, e8); }
                }
                if (ns > 1024) ns = 1024;
                for (int j0 = 0; j0 < ns; j0 += 512) {
                    u32x4 v[8]; int sg[8];
#pragma unroll
                    for (int u = 0; u < 8; ++u) { const int i = j0 + lane + 64 * u; sg[u] = i < ns ? segl[i] : -1; v[u] = sg[u] >= 0 ? *(const u32x4*)(row + 8 * sg[u]) : NEG; }
#pragma unroll
                    for (int u = 0; u < 8; ++u) if (j0 + 64 * u < ns) { const int e = 8 * sg[u]; unsigned m8 = sg[u] >= 0 ? ge_mask8(v[u], T16) : 0u;
                        const int nv = t + 1 - e; if (nv < 8) m8 &= nv > 0 ? ((1u << nv) - 1u) : 0u;
                        cnt = append_keys(cidx, cnt, m8, e, v[u]); }
                }
            } else {
                for (int q0 = 0; q0 < nq; q0 += 4) {
                    u32x4 v[4];
#pragma unroll
                    for (int u = 0; u < 4; ++u) { const int e = 8 * (lane + 64 * (q0 + u)); v[u] = (e <= t) ? *(const u32x4*)(row + e) : (u32x4){0xfc00fc00u, 0xfc00fc00u, 0xfc00fc00u, 0xfc00fc00u}; }
#pragma unroll
                    for (int u = 0; u < 4; ++u) { const int e = 8 * (lane + 64 * (q0 + u));
#pragma unroll
                        for (int k = 0; k < 8; ++k) { const float x = (k & 1) ? h2f_hi(v[u][k >> 1]) : h2f_lo(v[u][k >> 1]);
                            const bool pred = (e + k <= t) && (x >= tlo); const unsigned long long mask = __ballot(pred);
                            if (mask) { const int pos = cnt + lanes_below(mask); const unsigned hb = (k & 1) ? (v[u][k >> 1] >> 16) : (v[u][k >> 1] & 0xffffu);
                                if (pred && pos < 1024) cidx[pos] = (int)((hb << 16) | (unsigned)(e + k)); cnt += __popcll(mask); } } }
                }
            }
            if (cnt >= 256 || K >= m) break;
            K *= 2;
        }
        N = cnt < 1024 ? cnt : 1024;
#pragma unroll
        for (int j = 0; j < 16; ++j) { const int i = lane + 64 * j; c[j] = i < N ? h2f((unsigned short)((unsigned)cidx[i] >> 16)) : NINF; }
    }
    float tau;
    if (N >= 0 && N <= 512) { const float c8[8] = {c[0], c[1], c[2], c[3], c[4], c[5], c[6], c[7]}; tau = wave_kth<8, true>(c8, 256); }
    else tau = wave_kth16(c, 256);
    int base = 0;
#pragma unroll
    for (int j = 0; j < 16; ++j) { const bool pred = c[j] >= tau; const unsigned long long mask = __ballot(pred);
        if (mask) { const int pos = base + lanes_below(mask); if (pred && pos < 256) selw[pos] = (N < 0) ? (lane + 64 * j) : (cidx[lane + 64 * j] & 0xffff); base += __popcll(mask); } }
}

__device__ __forceinline__ void attn_query(LAS unsigned char* wl, const bf16_t* PROJ, const unsigned char* KC, const unsigned char* VC, unsigned char* ATT, int t, int lane) {
    LAS int* selw = (LAS int*)wl; LAS float* L = (LAS float*)(wl + 1024);
    const int nsel = t < 255 ? t + 1 : 256;
    const int fr = lane & 15, fq = lane >> 4;
    constexpr float QS = 8.0f;
    long qh[2][4], ql[2][4];
#pragma unroll
    for (int g = 0; g < 2; ++g)
#pragma unroll
        for (int ks = 0; ks < 4; ++ks) {
            u32x4 z = (u32x4){0u, 0u, 0u, 0u};
            if (fr < 4) z = *(const u32x4*)(PROJ + (size_t)t * DINP + CQ + (4 * g + fr) * 128 + 32 * ks + 8 * fq);
            float qv[8], rv[8];
#pragma unroll
            for (int e = 0; e < 4; ++e) { qv[2 * e] = bf_lo(z[e]) * QS; qv[2 * e + 1] = bf_hi(z[e]) * QS; }
            const unsigned h0 = pack4_fp8(qv[0], qv[1], qv[2], qv[3]), h1 = pack4_fp8(qv[4], qv[5], qv[6], qv[7]);
            rv[0] = qv[0] - __builtin_amdgcn_cvt_f32_fp8((int)h0, 0); rv[1] = qv[1] - __builtin_amdgcn_cvt_f32_fp8((int)h0, 1); rv[2] = qv[2] - __builtin_amdgcn_cvt_f32_fp8((int)h0, 2); rv[3] = qv[3] - __builtin_amdgcn_cvt_f32_fp8((int)h0, 3);
            rv[4] = qv[4] - __builtin_amdgcn_cvt_f32_fp8((int)h1, 0); rv[5] = qv[5] - __builtin_amdgcn_cvt_f32_fp8((int)h1, 1); rv[6] = qv[6] - __builtin_amdgcn_cvt_f32_fp8((int)h1, 2); rv[7] = qv[7] - __builtin_amdgcn_cvt_f32_fp8((int)h1, 3);
            const unsigned l0 = pack4_fp8(rv[0] * 16.0f, rv[1] * 16.0f, rv[2] * 16.0f, rv[3] * 16.0f), l1 = pack4_fp8(rv[4] * 16.0f, rv[5] * 16.0f, rv[6] * 16.0f, rv[7] * 16.0f);
            qh[g][ks] = (long)(((unsigned long long)h1 << 32) | h0); ql[g][ks] = (long)(((unsigned long long)l1 << 32) | l0);
        }
    const float scale = 0.08838834764831845f / QS;
    const int nkt = (nsel + 15) >> 4;
    {
        LAS unsigned char* KT = wl + 9216;
        const int q4_ = lane >> 4, l15_ = lane & 15;
        u32x4 kw[4][4];
#define QK_LOAD(buf, kt) do { _Pragma("unroll") for (int u = 0; u < 4; ++u) { const unsigned off_ = (unsigned)selw[16 * (kt) + 4 * u + q4_] * 256u + 16u * (unsigned)l15_; kw[buf][u] = *(const u32x4*)((const char*)KC + off_); } } while (0)
#define QK_COMP(buf, kt) do { _Pragma("unroll") for (int u = 0; u < 4; ++u) *(LAS u32x4*)(KT + (4 * u + q4_) * 272 + 16 * l15_) = kw[buf][u];     \
        _Pragma("unroll") for (int g = 0; g < 2; ++g) { f32x4 acch = (f32x4){0.f, 0.f, 0.f, 0.f}, accl = (f32x4){0.f, 0.f, 0.f, 0.f}; \
            _Pragma("unroll") for (int ks = 0; ks < 4; ++ks) { const long kf_ = *(const LAS long*)(KT + fr * 272 + g * 128 + 32 * ks + 8 * fq); \
                acch = __builtin_amdgcn_mfma_f32_16x16x32_fp8_fp8(qh[g][ks], kf_, acch, 0, 0, 0); accl = __builtin_amdgcn_mfma_f32_16x16x32_fp8_fp8(ql[g][ks], kf_, accl, 0, 0, 0); } \
            if (fq == 0) { _Pragma("unroll") for (int r = 0; r < 4; ++r) L[(4 * g + r) * 256 + 16 * (kt) + fr] = (16 * (kt) + fr < nsel) ? (acch[r] + accl[r] * 0.0625f) * scale : -__builtin_inff(); } } } while (0)
        QK_LOAD(0, 0); if (1 < nkt) QK_LOAD(1, 1); if (2 < nkt) QK_LOAD(2, 2);
        for (int kt = 0; kt < nkt; kt += 4) {
            if (kt + 3 < nkt) QK_LOAD(3, kt + 3);
            __builtin_amdgcn_sched_barrier(0);
            QK_COMP(0, kt);
            if (kt + 1 < nkt) { if (kt + 4 < nkt) QK_LOAD(0, kt + 4); __builtin_amdgcn_sched_barrier(0); QK_COMP(1, kt + 1); }
            if (kt + 2 < nkt) { if (kt + 5 < nkt) QK_LOAD(1, kt + 5); __builtin_amdgcn_sched_barrier(0); QK_COMP(2, kt + 2); }
            if (kt + 3 < nkt) { if (kt + 6 < nkt) QK_LOAD(2, kt + 6); __builtin_amdgcn_sched_barrier(0); QK_COMP(3, kt + 3); }
        }
#undef QK_LOAD
#undef QK_COMP
        if (fq == 0) { for (int kt = nkt; kt < 16; ++kt) {
#pragma unroll
            for (int r = 0; r < 8; ++r) L[r * 256 + 16 * kt + fr] = -__builtin_inff(); } }
    }
    float p[8][4];
#pragma unroll
    for (int hd = 0; hd < 8; ++hd) { float m = -__builtin_inff();
#pragma unroll
        for (int i = 0; i < 4; ++i) { p[hd][i] = L[hd * 256 + 4 * lane + i]; m = fmaxf(m, p[hd][i]); }
        m = wave_max(m); float s = 0.f;
#pragma unroll
        for (int i = 0; i < 4; ++i) { p[hd][i] = __expf(p[hd][i] - m); s += p[hd][i]; }
        s = __builtin_amdgcn_rcpf(wave_sum(s));
#pragma unroll
        for (int i = 0; i < 4; ++i) p[hd][i] *= s; }
    constexpr float PS = 256.0f;
    LAS unsigned* Ph = (LAS unsigned*)(wl + 1024); LAS unsigned* Pl = (LAS unsigned*)(wl + 1024 + 2048);
#pragma unroll
    for (int hd = 0; hd < 8; ++hd) {
        const float a0 = p[hd][0] * PS, a1 = p[hd][1] * PS, a2 = p[hd][2] * PS, a3 = p[hd][3] * PS;
        const unsigned h = pack4_fp8(a0, a1, a2, a3);
        const unsigned l = pack4_fp8(a0 - __builtin_amdgcn_cvt_f32_fp8((int)h, 0), a1 - __builtin_amdgcn_cvt_f32_fp8((int)h, 1), a2 - __builtin_amdgcn_cvt_f32_fp8((int)h, 2), a3 - __builtin_amdgcn_cvt_f32_fp8((int)h, 3));
        Ph[hd * 64 + lane] = h; Pl[hd * 64 + lane] = l;
    }
    LAS unsigned char* VT = wl + 9216;
    const int ii = lane & 15, kq = lane >> 4;
    f32x4 acc[16];
#pragma unroll
    for (int nt = 0; nt < 16; ++nt) acc[nt] = (f32x4){0.f, 0.f, 0.f, 0.f};
    const int nch = (nsel + 15) >> 4;
    u32x4 vw[4][4];
#define PV_LOAD(buf, c) do { _Pragma("unroll") for (int u = 0; u < 4; ++u) { const unsigned off_ = (unsigned)selw[16 * (c) + 4 * u + kq] * 256u + 16u * (unsigned)ii; vw[buf][u] = *(const u32x4*)((const char*)VC + off_); } } while (0)
#define PV_COMP(buf, c) do { _Pragma("unroll") for (int u = 0; u < 4; ++u) { LAS u32x2* d_ = (LAS u32x2*)(VT + (16 * ((c) & 1) + 4 * u + kq) * 264 + 16 * ii); d_[0] = (u32x2){vw[buf][u].x, vw[buf][u].y}; d_[1] = (u32x2){vw[buf][u].z, vw[buf][u].w}; } \
        if (((c) & 1) || (c) == nch - 1) { \
            if (!((c) & 1)) { _Pragma("unroll") for (int u = 0; u < 4; ++u) { LAS u32x2* d_ = (LAS u32x2*)(VT + (16 + 4 * u + kq) * 264 + 16 * ii); d_[0] = (u32x2){0u, 0u}; d_[1] = (u32x2){0u, 0u}; } } \
            long pa[2]; _Pragma("unroll") for (int g = 0; g < 2; ++g) { const int po_ = (g * 4 + (ii & 3)) * 256 + 32 * ((c) >> 1) + 8 * kq;     \
                const long h_ = *(const LAS long*)((const LAS unsigned char*)Ph + po_ + ((ii & 4) ? 2048 : 0)); pa[g] = ii < 8 ? h_ : 0l; } \
            _Pragma("unroll") for (int nt = 0; nt < 16; ++nt) { const v2i32 t_ = __builtin_amdgcn_ds_read_tr8_b64_v2i32((LAS v2i32*)(VT + (8 * kq + (ii >> 1)) * 264 + 16 * nt + 8 * (ii & 1))); \
                const long b_ = __builtin_bit_cast(long, t_); \
                acc[nt] = __builtin_amdgcn_mfma_f32_16x16x32_fp8_fp8(pa[nt >> 3], b_, acc[nt], 0, 0, 0); } } } while (0)
    PV_LOAD(0, 0); if (1 < nch) PV_LOAD(1, 1); if (2 < nch) PV_LOAD(2, 2);
    for (int c = 0; c < nch; c += 4) {
        if (c + 3 < nch) PV_LOAD(3, c + 3);
        __builtin_amdgcn_sched_barrier(0);
        PV_COMP(0, c);
        if (c + 1 < nch) { if (c + 4 < nch) PV_LOAD(0, c + 4); __builtin_amdgcn_sched_barrier(0); PV_COMP(1, c + 1); }
        if (c + 2 < nch) { if (c + 5 < nch) PV_LOAD(1, c + 5); __builtin_amdgcn_sched_barrier(0); PV_COMP(2, c + 2); }
        if (c + 3 < nch) { if (c + 6 < nch) PV_LOAD(2, c + 6); __builtin_amdgcn_sched_barrier(0); PV_COMP(3, c + 3); }
    }
#undef PV_LOAD
#undef PV_COMP
    LAS float* OB = (LAS float*)(wl + 1024 + 4096);
    LAS float* OB2 = (LAS float*)(wl + 1024);
    if (kq < 2) {
        LAS float* ob = kq == 0 ? OB : OB2;
#pragma unroll
        for (int nt = 0; nt < 16; ++nt)
#pragma unroll
            for (int r = 0; r < 4; ++r) ob[(4 * (nt >> 3) + r) * 128 + 16 * (nt & 7) + ii] = acc[nt][r];
    }
    {
        const f32x4 a0 = *(const LAS f32x4*)(OB + 16 * lane) + *(const LAS f32x4*)(OB2 + 16 * lane), a1 = *(const LAS f32x4*)(OB + 16 * lane + 4) + *(const LAS f32x4*)(OB2 + 16 * lane + 4),
                    a2 = *(const LAS f32x4*)(OB + 16 * lane + 8) + *(const LAS f32x4*)(OB2 + 16 * lane + 8), a3 = *(const LAS f32x4*)(OB + 16 * lane + 12) + *(const LAS f32x4*)(OB2 + 16 * lane + 12);
        const f32x4 b0 = a0 * (OP8_SCALE / PS), b1 = a1 * (OP8_SCALE / PS), b2 = a2 * (OP8_SCALE / PS), b3 = a3 * (OP8_SCALE / PS);
        *(u32x4*)(ATT + (size_t)t * 1024 + 16 * lane) = (u32x4){pack4_fp8(b0[0], b0[1], b0[2], b0[3]), pack4_fp8(b1[0], b1[1], b1[2], b1[3]), pack4_fp8(b2[0], b2[1], b2[2], b2[3]), pack4_fp8(b3[0], b3[1], b3[2], b3[3])};
    }
}


__device__ __forceinline__ void convert_item8(const float* __restrict__ W, int K, int N, int ld, unsigned char* WT, int mode, int item, int lane, LAS unsigned char* scr) {
    const int nblk = N >> 6; const int kb = item / nblk, nb = item - kb * nblk; const int k0 = kb * 256, n0 = nb * 64;
    const int c4 = lane & 15, kr = lane >> 4;
    const float* src = W + (size_t)(k0 + 4 * kr) * ld + n0 + 4 * c4;
#pragma unroll 4
    for (int i = 0; i < 16; ++i) {
        f32x4 v[4];
#pragma unroll
        for (int r = 0; r < 4; ++r) v[r] = __builtin_nontemporal_load((const f32x4*)(src + (size_t)(16 * i + r) * ld));
        const int kk = 16 * i + 4 * kr;
#pragma unroll
        for (int e = 0; e < 4; ++e) *(LAS unsigned*)(scr + (4 * c4 + e) * 272 + kk) = pack4_fp8(v[0][e] * W8_SCALE, v[1][e] * W8_SCALE, v[2][e] * W8_SCALE, v[3][e] * W8_SCALE);
    }
    LDS_WAIT(); asm volatile("" ::: "memory");
#pragma unroll 4
    for (int j = 0; j < 16; ++j) {
        const int q = j * 64 + lane, n = q >> 4, ch = q & 15;
        const u32x4 v = *(const LAS u32x4*)(scr + n * 272 + ch * 16);
        *(u32x4*)(WT + (size_t)dest_row(mode, n0 + n) * K + k0 + ch * 16) = v;
    }
    LDS_WAIT(); asm volatile("" ::: "memory");
}

struct Conv8Job { const float* W; unsigned char* WT; int N; int mode; size_t w_estride, wt_estride; int items_per_e; };
constexpr int C8_PITCH = 272, C8_IMG = 256 * C8_PITCH;
__device__ __forceinline__ void conv8_load(const Conv8Job& jb, int item, int h, int wave, int lane, f32x4 (&v)[16]) {
    const int e = item / jb.items_per_e, r = item - e * jb.items_per_e; const int nblk = jb.N >> 8; const int kb = r / nblk, nb = r - kb * nblk;
    const float* src = jb.W + (size_t)e * jb.w_estride + (size_t)(kb * 256 + 32 * wave + 16 * h) * jb.N + nb * 256 + 4 * lane;
#pragma unroll
    for (int i = 0; i < 16; ++i) v[i] = __builtin_nontemporal_load((const f32x4*)(src + (size_t)i * jb.N));
}
__device__ __forceinline__ void conv8_to_lds(LAS unsigned char* img, int h, int wave, int lane, const f32x4 (&v)[16]) {
#pragma unroll
    for (int e = 0; e < 4; ++e) { u32x4 w;
#pragma unroll
        for (int g = 0; g < 4; ++g) w[g] = pack4_fp8(v[4 * g][e] * W8_SCALE, v[4 * g + 1][e] * W8_SCALE, v[4 * g + 2][e] * W8_SCALE, v[4 * g + 3][e] * W8_SCALE);
        *(LAS u32x4*)(img + (4 * lane + e) * C8_PITCH + 32 * wave + 16 * h) = w; }
}
__device__ __forceinline__ void conv8_store(const Conv8Job& jb, int item, const LAS unsigned char* img, int tid) {
    const int e = item / jb.items_per_e, r = item - e * jb.items_per_e; const int nblk = jb.N >> 8; const int kb = r / nblk, nb = r - kb * nblk;
    unsigned char* dst = jb.WT + (size_t)e * jb.wt_estride + kb * 256;
#pragma unroll
    for (int j = 0; j < 8; ++j) { const int q = j * 512 + tid, n = q >> 4, ch = q & 15;
        __builtin_nontemporal_store(*(const LAS u32x4*)(img + n * C8_PITCH + ch * 16), (u32x4*)(dst + (size_t)dest_row(jb.mode, nb * 256 + n) * 2048 + ch * 16)); }
}
__device__ __forceinline__ void conv8_run(LAS unsigned char* lds, const Conv8Job& jb, int n_items, int wg, int G, int tid, int wave, int lane) {
    if (wg >= n_items) return;
    f32x4 a[16], b[16]; int par = 0;
    conv8_load(jb, wg, 0, wave, lane, a); conv8_load(jb, wg, 1, wave, lane, b);
    for (int it = wg; it < n_items; it += G, par ^= 1) {
        LAS unsigned char* img = lds + par * C8_IMG;
        const int nx = (it + G < n_items) ? it + G : it;
        conv8_to_lds(img, 0, wave, lane, a); __builtin_amdgcn_sched_barrier(0);
        conv8_load(jb, nx, 0, wave, lane, a); __builtin_amdgcn_sched_barrier(0);
        conv8_to_lds(img, 1, wave, lane, b); __builtin_amdgcn_sched_barrier(0);
        conv8_load(jb, nx, 1, wave, lane, b); __builtin_amdgcn_sched_barrier(0);
        __syncthreads();
        conv8_store(jb, it, img, tid);
    }
    __syncthreads();
}

__global__ void __launch_bounds__(NTHR, 2) fwd_kernel(Args args) {
    extern __shared__ __attribute__((aligned(16))) unsigned char lds_raw[];
    LAS unsigned char* lds = (LAS unsigned char*)lds_raw;
    volatile LAS unsigned* MISC = (volatile LAS unsigned*)(lds + LDS_MISC);
    const int tid = threadIdx.x, lane = tid & 63, wave = __builtin_amdgcn_readfirstlane(tid >> 6);
    const int G = gridDim.x, wg = blockIdx.x;
    unsigned char* ws = args.ws;
    unsigned* ctl = (unsigned*)(ws + WS_CTL);
    const int lo = args.ph_lo, hi = args.ph_hi;
    const float* x = (const float*)args.in[0]; const float* cvec = (const float*)args.in[1]; const int* positions = (const int*)args.in[2];
    const float* w_ada = (const float*)args.in[3]; const float* b_ada = (const float*)args.in[4]; const float* norm1_g = (const float*)args.in[5];
    const float* w_in = (const float*)args.in[6]; const float* idx_knorm_g = (const float*)args.in[7]; const float* idx_knorm_b = (const float*)args.in[8];
    const float* lb_logits = (const float*)args.in[9]; const float* hgrn_norm_g = (const float*)args.in[10];
    const float* w_proj_att = (const float*)args.in[11]; const float* w_proj_hgrn = (const float*)args.in[12]; const float* w_out = (const float*)args.in[13];
    const float* norm2_g = (const float*)args.in[14]; const float* w_router = (const float*)args.in[15]; const float* b_router = (const float*)args.in[16];
    const float* w1 = (const float*)args.in[17]; const float* b1 = (const float*)args.in[18]; const float* w2 = (const float*)args.in[19]; const float* b2 = (const float*)args.in[20];
    const float* final_g = (const float*)args.in[21];
    float* out = args.out;
    float* MOD = (float*)(ws + WS_MOD); int* TOPE = (int*)(ws + WS_TOPE); float* GATE = (float*)(ws + WS_GATE); int* SLOT = (int*)(ws + WS_SLOT);
    bf16_t* WIN_T = (bf16_t*)(ws + WS_WIN_T); bf16_t* WA_T = (bf16_t*)(ws + WS_WA_T); bf16_t* WH_T = (bf16_t*)(ws + WS_WH_T); bf16_t* WO_T = (bf16_t*)(ws + WS_WO_T);
    unsigned char* WIN_T8 = ws + WS_WIN_T + 8 * MiB;
    unsigned char* HA8 = ws + WS_SCORES;
    unsigned char* W1_T = ws + WS_W1_T; unsigned char* W2_T = ws + WS_W2_T;
    bf16_t* HB = (bf16_t*)(ws + WS_H); bf16_t* PROJ = (bf16_t*)(ws + WS_PROJ);
    bf16_t* DELTA = (bf16_t*)(ws + WS_ATT);
    unsigned char* ACT = ws + WS_ACT; bf16_t* YB = (bf16_t*)(ws + WS_YB);
    int* TOKS = (int*)(ws + WS_TOKS);
    unsigned char* H8 = ws + WS_H;
    bf16_t* KI = (bf16_t*)(ws + WS_KI); unsigned char* KC = ws + WS_KC; unsigned char* VC = ws + WS_VC;
    bf16_t* ST = (bf16_t*)(ws + WS_ST); float* DC = (float*)(ws + WS_DC);
    unsigned char* ATT = ws + WS_ATT; unsigned char* REC = ATT + (size_t)S * 1024;        bf16_t* MERGED = (bf16_t*)(ws + WS_MERGED); unsigned short* SCORES = (unsigned short*)(ws + WS_SCORES);
    unsigned short* SEGMAX = (unsigned short*)(ws + WS_X1);

    for (int u = tid; u < 128; u += NTHR) MISC[u] = 0u;
    __syncthreads();
    const bool one_launch = (hi - lo) > 1;
    XcdBarrier bar; bar.bar = ctl + CW_BAR; bar.x = 0; bar.st = MISC + 8;
    if (one_launch) bar = xcd_barrier_post(ctl + CW_BAR, MISC + 8);
#define IN(k) (lo <= (k) && (k) < hi)
#define SEAM(k) do { if (IN(k) && IN((k) + 1)) xcd_barrier(bar); } while (0)


    if (IN(PH_PRO)) {
        for (int cb = wg; cb < 256; cb += G) {
            LAS float* red = (LAS float*)lds;
            const int c4 = tid % 12, kg = tid / 12;
            f32x4 acc = (f32x4){0.f, 0.f, 0.f, 0.f};
            if (kg < 42) {
                const float* wp = w_ada + (size_t)cb * 48 + 4 * c4;
#pragma unroll 7
                for (int j = 0; j < 49; ++j) { const int k = kg + 42 * j; if (k < D) { const f32x4 v = __builtin_nontemporal_load((const f32x4*)(wp + (size_t)k * (6 * D))); acc += siluf_(cvec[k]) * v; } }
                *(LAS f32x4*)(red + kg * 48 + 4 * c4) = acc;
            }
            __syncthreads();
            if (tid < 48) { float s = b_ada[cb * 48 + tid];
#pragma unroll 6
                for (int q = 0; q < 42; ++q) s += red[q * 48 + tid];
                MOD[cb * 48 + tid] = s; }
            __syncthreads();
        }
        LAS unsigned char* scr = lds + wave * 17408;
        const int gw = wg * NWAVES + wave, NGW = G * NWAVES;
        {
            constexpr int NB_IN = (1104 + 63) / 64, Q0 = 16 * NB_IN, Q1 = Q0 + 4 * 32, Q2 = Q1 + 4 * 32, Q3 = Q2 + 8 * 32, Q4 = Q3 + 8 * 24, Q5 = Q4 + 8 * 128;
            for (int q = gw; q < Q5; q += NGW) {
                if (q < Q0)      convert_item(w_in + 1536, 2048, 1104, DIN, WIN_T, 0, q, lane, scr);
                else if (q < Q1) convert_item8(w_proj_att, 1024, 2048, 2048, (unsigned char*)WA_T, 0, q - Q0, lane, scr);
                else if (q < Q2) convert_item8(w_proj_hgrn, 1024, 2048, 2048, (unsigned char*)WA_T + (size_t)2048 * 1024, 0, q - Q1, lane, scr);
                else if (q < Q3) convert_item8(w_out, 2048, 2048, 2048, (unsigned char*)WO_T, 0, q - Q2, lane, scr);
                else if (q < Q4) convert_item8(w_in, 2048, 1536, DIN, WIN_T8, 0, q - Q3, lane, scr);
                else             convert_item8(w_in + 2640, 2048, 8192, DIN, WIN_T8 + (size_t)1536 * 2048, 0, q - Q4, lane, scr);
            }
            for (size_t i = (size_t)wg * NTHR + tid; i < (size_t)176 * 2048 * 2 / 16; i += (size_t)G * NTHR) ((u32x4*)(WIN_T + (size_t)1104 * 2048))[i] = (u32x4){0u, 0u, 0u, 0u};
        }
    }
    SEAM(PH_PRO);

    {
    if (IN(PH_H)) {
        const float* sh1 = MOD; const float* sc1 = MOD + D;
        const int gw = wg * NWAVES + wave, NGW = G * NWAVES;
        f32x4 gs[8], sh[8];
#pragma unroll
        for (int j = 0; j < 8; ++j) { const int c = 4 * lane + 256 * j; const f32x4 g = *(const f32x4*)(norm1_g + c), sc = *(const f32x4*)(sc1 + c); sh[j] = *(const f32x4*)(sh1 + c);
#pragma unroll
            for (int e = 0; e < 4; ++e) gs[j][e] = g[e] * (1.0f + sc[e]); }
        for (int t = gw; t < S; t += NGW) {
            const f32x4* xr = (const f32x4*)(x + (size_t)t * D) + lane;
            f32x4 v[8]; float ss = 0.f;
#pragma unroll
            for (int j = 0; j < 8; ++j) { v[j] = xr[64 * j]; ss += (v[j][0] * v[j][0] + v[j][1] * v[j][1]) + (v[j][2] * v[j][2] + v[j][3] * v[j][3]); }
            const float rstd = rsqrtf(wave_sum(ss) * (1.0f / D) + NORM_EPS);
#pragma unroll
            for (int j = 0; j < 8; ++j) { const f32x4 h = v[j] * rstd * gs[j] + sh[j]; u32x2 w; w.x = cvt_pk_bf16(h[0], h[1]); w.y = cvt_pk_bf16(h[2], h[3]);
                *(u32x2*)(HB + (size_t)t * D + 4 * lane + 256 * j) = w;
                *(unsigned*)(HA8 + (size_t)t * D + 4 * lane + 256 * j) = pack4_fp8(h[0], h[1], h[2], h[3]); }
        }
    }
    SEAM(PH_H);
    if (IN(PH_INPROJ)) {
        const int XC = (G == 256) ? XCONV : 0;
        const Conv8Job j1{w1, W1_T, 4096, 2, (size_t)2048 * 4096, (size_t)4096 * 2048, 8 * 16};
        const Conv8Job j2{w2, W2_T, 2048, 0, (size_t)2048 * 2048, (size_t)2048 * 2048, 8 * 8};
        if (G != 256) { conv8_run(lds, j1, NEXP * 8 * 16, wg, G, tid, wave, lane); conv8_run(lds, j2, NEXP * 8 * 8, wg, G, tid, wave, lane); }
        if (wg < XC) { conv8_run(lds, j1, NEXP * 8 * 16, wg, XC, tid, wave, lane); conv8_run(lds, j2, NEXP * 8 * 8, wg, XC, tid, wave, lane); }
        else {
            const int Gg = G - XC, cg = wg - XC;
            {
                pg8::Gemm g8{HA8, WIN_T8, 2048, 0, nullptr, 0}; pg8::StaticOrder S8; S8.init(S, 9728, Gg, cg);
                const int full8 = 2432 / Gg, rem8 = 2432 - full8 * Gg;
                if (Gg == 256) S8.skew(8, (wg >= 128 && wg < 192) ? -1 : (wg < 128 ? wg : wg - 64), 192);
                else if (rem8 > 0) S8.skew(full8, cg < rem8 ? cg : -1, rem8);
                pg8::EpiBf16 E8{PROJ, DINP, nullptr, 0, 1.0f / W8_SCALE, 6, 1280};
                pg8::gemm_phase<pg8::EpiBf16, pg8::StaticOrder, true>(lds, g8, S8, E8);
            }
            {
                pg8::Gemm g{HB, WIN_T, 2048, 0, nullptr, 0}; pg8::StaticOrder So; So.init(S, 1280, Gg, Gg == 256 ? (wg + 128) % G : (cg + Gg - (2432 % Gg)) % Gg);
                pg8::EpiBf16 E{PROJ + CQI, DINP, nullptr, 0, 1.0f, 1 << 30, 0};
                pg8::gemm_phase<pg8::EpiBf16, pg8::StaticOrder>(lds, g, So, E);
            }
        }
    }
    SEAM(PH_INPROJ);
    if (IN(PH_POST)) {
        const int gw = wg * NWAVES + wave, NGW = G * NWAVES;
        const float inv16 = powf(500000.0f, -(float)(lane & 15) * (1.0f / 16.0f)), inv8 = powf(500000.0f, -(float)(lane & 7) * (1.0f / 8.0f));
        for (int t = gw; t < S; t += NGW) post_token(PROJ, KI, KC, VC, positions, idx_knorm_g, idx_knorm_b, inv16, inv8, t, lane);
        __syncthreads();
        for (int u = wg; u < 2048; u += G) hgrn_l1(lds, PROJ, lb_logits, ST, DC, u >> 3, u & 7, tid, wave, lane);
    }
    SEAM(PH_POST);
    if (IN(PH_SCORE)) {
        for (int idx = wg * NTHR + tid; idx < 8 * 128 * 128; idx += G * NTHR) {
            const int h = idx >> 14, d = idx & 127; float s = 0.f;
            bf16_t* sp = ST + idx; const float* dp = DC + h * 128 + d;
            for (int c = 0; c < 256; c += 16) {
                float l[16], dc[16];
#pragma unroll
                for (int i = 0; i < 16; ++i) { l[i] = bf2f(sp[(size_t)(c + i) * 131072]); dc[i] = dp[(size_t)(c + i) * 1024]; }
#pragma unroll
                for (int i = 0; i < 16; ++i) { sp[(size_t)(c + i) * 131072] = f2bf(s); s = dc[i] * s + l[i]; }
            }
        }
        {
            const int XS = (G == 256) ? XSCORE : 0;
            if (wg < XS) {
                const Conv8Job j1{w1, W1_T, 4096, 2, (size_t)2048 * 4096, (size_t)4096 * 2048, 8 * 16};
                const Conv8Job j2{w2, W2_T, 2048, 0, (size_t)2048 * 2048, (size_t)2048 * 2048, 8 * 8};
                __syncthreads();
                conv8_run(lds, j1, NEXP * 8 * 16, wg, XS, tid, wave, lane); conv8_run(lds, j2, NEXP * 8 * 8, wg, XS, tid, wave, lane);
            }
            for (;;) {
                if (tid == 0) MISC[100] = __hip_atomic_fetch_add(ctl + CW_SCQ, 1u, __ATOMIC_RELAXED, __HIP_MEMORY_SCOPE_AGENT);
                __syncthreads();
                const int item = (int)MISC[100];
                __syncthreads();
                if (item >= 252 * 6) break;
                int j, lo, hi;
                if (item < 504) { j = item >> 1; const int T = ((8 + j) >> 2) + ((511 - j) >> 2) + 2; const int p = item & 1; lo = p * T / 3; hi = (p + 1) * T / 3; }
                else { const int i2 = item - 504; j = i2 >> 2; const int T = ((8 + j) >> 2) + ((511 - j) >> 2) + 2; const int p = i2 & 3, b = 2 * T / 3; lo = b + p * (T - b) / 4; hi = b + (p + 1) * (T - b) / 4; }
                const int qa = 8 + j, qb2 = 511 - j, na = (qa >> 2) + 1;
                const int a0 = lo < na ? lo : na, a1 = hi < na ? hi : na, b0 = (lo > na ? lo : na) - na, b1 = (hi > na ? hi : na) - na;
                if (a1 > a0) score_block(lds, PROJ, KI, SCORES, SEGMAX, qa, a0, a1, tid, wave, lane);
                if (b1 > b0) score_block(lds, PROJ, KI, SCORES, SEGMAX, qb2, b0, b1, tid, wave, lane);
            }
        }
    }
    SEAM(PH_SCORE);
    if (IN(PH_ATTN)) {
        const int gw = wg * NWAVES + wave, NGW = G * NWAVES;
        for (int u = wg; u < 2048; u += G) hgrn_l3(lds, PROJ, lb_logits, ST, hgrn_norm_g, REC, u >> 3, u & 7, tid, wave, lane);
        {
            for (;;) {
                unsigned tq = 0; if (lane == 0) tq = __hip_atomic_fetch_add(ctl + CW_ATQ, 1u, __ATOMIC_RELAXED, __HIP_MEMORY_SCOPE_AGENT);
                tq = (unsigned)__builtin_amdgcn_readfirstlane((int)tq);
                if (tq >= (unsigned)S) break;
                const int t = S - 1 - (int)tq;
                LAS unsigned char* wl = lds + wave * 17664;
                if (t >= 256) select_row(wl, SCORES, SEGMAX, t, lane);
                else {
#pragma unroll
                    for (int i = 0; i < 4; ++i) { const int idx = lane + 64 * i; ((LAS int*)wl)[idx] = idx <= t ? idx : 0; }
                }
                attn_query(wl, PROJ, KC, VC, ATT, t, lane);
            }
        }
    }
    SEAM(PH_ATTN);
    if (IN(PH_OP1)) {
        pg8::Gemm g{ATT, WA_T, 1024, (size_t)2048 * 1024, nullptr, (size_t)S * 1024};
        pg8::TwoPartOrder So; So.init(S, 2048, G, wg);
        pg8::EpiGate2 E{(unsigned char*)MERGED, PROJ + CGA, PROJ + CGR};
        pg8::gemm_phase<pg8::EpiGate2, pg8::TwoPartOrder, true>(lds, g, So, E);
    }
    SEAM(PH_OP2);
    if (IN(PH_WOUT)) {
        pg8::Gemm g{MERGED, WO_T, 2048, 0, nullptr, 0}; pg8::StaticOrder So; So.init(S, 2048, G, wg);
        pg8::EpiDelta E{MOD + 2 * D, DELTA, 1.0f / (W8_SCALE * MRG8_SCALE)};
        pg8::gemm_phase<pg8::EpiDelta, pg8::StaticOrder, true>(lds, g, So, E);
    }
    SEAM(PH_WOUT);
    }

    if (IN(PH_ROUTER)) {
        LAS float* hs = (LAS float*)lds;
        volatile LAS unsigned* lcnt = MISC + 32;
        const float* sh2 = MOD + 3 * D; const float* sc2 = MOD + 4 * D;
        if (tid < 32) lcnt[tid] = 0u;
        __syncthreads();
        for (int grp = wg; grp < S / 16; grp += G) {
#pragma unroll 1
            for (int q = 0; q < 2; ++q) {
                const int tl = 2 * wave + q, t = grp * 16 + tl;
                const f32x4* xr = (const f32x4*)(x + (size_t)t * D) + lane; const u32x2* dr = (const u32x2*)(DELTA + (size_t)t * D) + lane;
                f32x4 v[8]; float ss = 0.f;
#pragma unroll
                for (int j = 0; j < 8; ++j) { const u32x2 dw = dr[64 * j]; v[j] = xr[64 * j] + (f32x4){bf_lo(dw.x), bf_hi(dw.x), bf_lo(dw.y), bf_hi(dw.y)};
                    ss += (v[j][0] * v[j][0] + v[j][1] * v[j][1]) + (v[j][2] * v[j][2] + v[j][3] * v[j][3]); }
#pragma unroll
                for (int j = 0; j < 8; ++j) { u32x2 w; w.x = cvt_pk_bf16(v[j][0], v[j][1]); w.y = cvt_pk_bf16(v[j][2], v[j][3]); ((u32x2*)(DELTA + (size_t)t * D) + lane)[64 * j] = w; }
                const float rstd = rsqrtf(wave_sum(ss) * (1.0f / D) + NORM_EPS);
#pragma unroll
                for (int j = 0; j < 8; ++j) {
                    const int c = 4 * lane + 256 * j;
                    const f32x4 g = *(const f32x4*)(norm2_g + c), sc = *(const f32x4*)(sc2 + c), sh = *(const f32x4*)(sh2 + c);
                    f32x4 h;
#pragma unroll
                    for (int e = 0; e < 4; ++e) h[e] = v[j][e] * rstd * g[e] * (1.0f + sc[e]) + sh[e];
                    *(LAS f32x4*)(hs + tl * 2048 + c) = h;
                    *(unsigned*)(H8 + (size_t)t * D + c) = pack4_fp8(h[0], h[1], h[2], h[3]);
                }
            }
            __syncthreads();
            {
                LAS float* part = (LAS float*)(lds + 131072);
                const int fr = lane & 15, fq = lane >> 4;
                f32x4 acc0 = (f32x4){0.f, 0.f, 0.f, 0.f}, acc1 = acc0;
                const LAS float* hrow = hs + fr * 2048 + wave * 256 + 4 * fq; const float* wrp = w_router + (size_t)(wave * 256 + 4 * fq) * 32 + fr;
#pragma unroll 2
                for (int i = 0; i < 16; ++i) {
                    const f32x4 a4 = *(const LAS f32x4*)(hrow + 16 * i);
                    float b0[4], b1[4];
#pragma unroll
                    for (int s = 0; s < 4; ++s) { b0[s] = wrp[(size_t)(16 * i + s) * 32]; b1[s] = wrp[(size_t)(16 * i + s) * 32 + 16]; }
#pragma unroll
                    for (int s = 0; s < 4; ++s) { acc0 = __builtin_amdgcn_mfma_f32_16x16x4f32(a4[s], b0[s], acc0, 0, 0, 0); acc1 = __builtin_amdgcn_mfma_f32_16x16x4f32(a4[s], b1[s], acc1, 0, 0, 0); }
                }
#pragma unroll
                for (int r = 0; r < 4; ++r) { part[(wave * 16 + 4 * fq + r) * 32 + fr] = acc0[r]; part[(wave * 16 + 4 * fq + r) * 32 + 16 + fr] = acc1[r]; }
                __syncthreads();
                const int tl = tid >> 5, e = tid & 31, t = grp * 16 + tl;
                float v = b_router[e];
#pragma unroll
                for (int w = 0; w < 8; ++w) v += part[(w * 16 + tl) * 32 + e];
                float tv[4]; int ti[4];
#pragma unroll
                for (int k = 0; k < 4; ++k) {
                    float bv = v; int bi = e;
#pragma unroll
                    for (int o = 16; o >= 1; o >>= 1) { const float ov = __shfl_xor(bv, o); const int oi = __shfl_xor(bi, o); if (ov > bv || (ov == bv && oi < bi)) { bv = ov; bi = oi; } }
                    tv[k] = bv; ti[k] = bi; if (e == bi) v = -__builtin_inff();
                }
                if (e == 0) {
                    const float e1 = __expf(tv[1] - tv[0]), e2 = __expf(tv[2] - tv[0]), e3 = __expf(tv[3] - tv[0]); const float inv = 1.0f / (1.0f + e1 + e2 + e3);
                    *(int4*)(TOPE + (size_t)t * 4) = make_int4(ti[0], ti[1], ti[2], ti[3]);
                    *(f32x4*)(GATE + (size_t)t * 4) = (f32x4){inv, e1 * inv, e2 * inv, e3 * inv};
#pragma unroll
                    for (int k = 0; k < 4; ++k) __hip_atomic_fetch_add((LAS unsigned*)&lcnt[ti[k]], 1u, __ATOMIC_RELAXED, __HIP_MEMORY_SCOPE_WORKGROUP);
                }
            }
            __syncthreads();
        }
        if (tid < 32) { const unsigned c = lcnt[tid]; if (c) __hip_atomic_fetch_add(ctl + CW_CNT + tid, c, __ATOMIC_RELAXED, __HIP_MEMORY_SCOPE_AGENT); }
    }
    SEAM(PH_ROUTER);

    if (IN(PH_SCATTER)) {
        volatile LAS unsigned* lcnt = MISC + 32; volatile LAS unsigned* lbase = MISC + 64; LAS int* pstart = (LAS int*)(lds + 1024); LAS int* pcnt = (LAS int*)(lds + 1280);
        if (tid == 0) { int p = 0; for (int e = 0; e < NEXP; ++e) { const int c = (int)__hip_atomic_load(ctl + CW_CNT + e, __ATOMIC_RELAXED, __HIP_MEMORY_SCOPE_AGENT); pstart[e] = p; pcnt[e] = c; p += (c + 255) & ~255; } }
        if (tid < 32) lcnt[tid] = 0u;
        __syncthreads();
        if (wg < NEXP) { const int e = wg; for (int s = pstart[e] + pcnt[e] + tid; s < pstart[e] + ((pcnt[e] + 255) & ~255); s += NTHR) TOKS[s] = 0; }
        for (int blk = wg; blk < S / 64; blk += G) {
            int e = 0, lrank = 0;
            if (tid < 256) { e = TOPE[(size_t)blk * 256 + tid]; lrank = (int)__hip_atomic_fetch_add((LAS unsigned*)&lcnt[e], 1u, __ATOMIC_RELAXED, __HIP_MEMORY_SCOPE_WORKGROUP); }
            __syncthreads();
            if (tid < 32) { const unsigned c = lcnt[tid]; lbase[tid] = c ? __hip_atomic_fetch_add(ctl + CW_FILL + tid, c, __ATOMIC_RELAXED, __HIP_MEMORY_SCOPE_AGENT) : 0u; }
            __syncthreads();
            if (tid < 256) { const int slot = pstart[e] + (int)lbase[e] + lrank; SLOT[(size_t)blk * 256 + tid] = slot; TOKS[slot] = blk * 64 + (tid >> 2); }
            __syncthreads();
            if (tid < 32) lcnt[tid] = 0u;
            __syncthreads();
        }
    }
    SEAM(PH_SCATTER);

    if (IN(PH_MOE1) || IN(PH_MOE2)) {
        LAS int* panel_e = (LAS int*)(lds + 131072 + 2048);
        LAS int* npan = (LAS int*)(lds + 131072 + 2048 + 2048);
        __syncthreads();
        if (tid == 0) { int p = 0; for (int e = 0; e < NEXP; ++e) { const int np = (int)((__hip_atomic_load(ctl + CW_CNT + e, __ATOMIC_RELAXED, __HIP_MEMORY_SCOPE_AGENT) + 255u) >> 8); for (int q = 0; q < np; ++q) panel_e[p + q] = e; p += np; } npan[0] = p; }
        __syncthreads();
        const int nPanels = npan[0];
        if (IN(PH_MOE1)) {
            pg8::Gemm g{H8, W1_T, 2048, (size_t)4096 * 2048, TOKS, 0}; pg8::MoeOrder So; So.init(nPanels, 16, G, wg, panel_e);
            pg8::EpiSwiglu E{ACT, b1};
            pg8::gemm_phase<pg8::EpiSwiglu, pg8::MoeOrder, true>(lds, g, So, E);
        }
        SEAM(PH_MOE1);
        if (IN(PH_MOE2)) {
            pg8::Gemm g{ACT, W2_T, 2048, (size_t)2048 * 2048, nullptr, 0}; pg8::MoeOrder So; So.init(nPanels, 8, G, wg, panel_e);
            pg8::EpiBf16 E{YB, 2048, b2, 2048, 1.0f / (W8_SCALE * ACT8_SCALE), 1 << 30, 0};
            pg8::gemm_phase<pg8::EpiBf16, pg8::MoeOrder, true>(lds, g, So, E);
        }
    }
    SEAM(PH_MOE2);

    if (IN(PH_FINAL)) {
        const float* gt2 = MOD + 5 * D;
        const int gw = wg * NWAVES + wave, NGW = G * NWAVES;
        for (int t = gw; t < S; t += NGW) {
            const u32x2* dr = (const u32x2*)(DELTA + (size_t)t * D) + lane;
            f32x4 v[8];
#pragma unroll
            for (int j = 0; j < 8; ++j) { const u32x2 dw = dr[64 * j]; v[j] = (f32x4){bf_lo(dw.x), bf_hi(dw.x), bf_lo(dw.y), bf_hi(dw.y)}; }
            {
                f32x4 m[8];
#pragma unroll
                for (int j = 0; j < 8; ++j) m[j] = (f32x4){0.f, 0.f, 0.f, 0.f};
                const int4 sl = *(const int4*)(SLOT + (size_t)t * 4); const f32x4 gt = *(const f32x4*)(GATE + (size_t)t * 4);
                const int sls[4] = {sl.x, sl.y, sl.z, sl.w};
#pragma unroll
                for (int k = 0; k < 4; ++k) {
                    const u32x2* yr = (const u32x2*)(YB + (size_t)sls[k] * D) + lane; const float gk = gt[k];
#pragma unroll
                    for (int j = 0; j < 8; ++j) { const u32x2 w = yr[64 * j]; m[j][0] += gk * bf_lo(w.x); m[j][1] += gk * bf_hi(w.x); m[j][2] += gk * bf_lo(w.y); m[j][3] += gk * bf_hi(w.y); }
                }
#pragma unroll
                for (int j = 0; j < 8; ++j) { const f32x4 g2 = *(const f32x4*)(gt2 + 4 * lane + 256 * j); v[j] = v[j] + g2 * m[j]; }
            }
            float ss = 0.f;
#pragma unroll
            for (int j = 0; j < 8; ++j) ss += (v[j][0] * v[j][0] + v[j][1] * v[j][1]) + (v[j][2] * v[j][2] + v[j][3] * v[j][3]);
            const float rstd = rsqrtf(wave_sum(ss) * (1.0f / D) + NORM_EPS);
            f32x4* orow = (f32x4*)(out + (size_t)t * D) + lane;
#pragma unroll
            for (int j = 0; j < 8; ++j) { const f32x4 fg = *(const f32x4*)(final_g + 4 * lane + 256 * j); orow[64 * j] = v[j] * rstd * fg; }
        }
    }
#undef IN
#undef SEAM
}

#ifndef MK_ONE_LAUNCH
#define MK_ONE_LAUNCH 1
#endif
extern "C" void kernel_launch(void* const* d_in, const int* in_sizes, int n_in, void* d_out, int out_size, void* d_ws, size_t ws_size, hipStream_t stream) {
    static int grid = 0;
    if (grid == 0) {
        if (n_in != 22 || out_size != S * D || ws_size < WS_END) { fprintf(stderr, "kernel_launch: unexpected shapes: n_in %d out %d ws %zu (need %zu)\n", n_in, out_size, ws_size, (size_t)WS_END); grid = -1; return; }
        int dev = 0, cus = 0, per_cu = 0;
        if (hipGetDevice(&dev) != hipSuccess || hipDeviceGetAttribute(&cus, hipDeviceAttributeMultiprocessorCount, dev) != hipSuccess) { grid = -1; return; }
        if (hipFuncSetAttribute((const void*)fwd_kernel, hipFuncAttributeMaxDynamicSharedMemorySize, LDS_BYTES) != hipSuccess) { fprintf(stderr, "kernel_launch: hipFuncSetAttribute failed\n"); grid = -1; return; }
        if (hipOccupancyMaxActiveBlocksPerMultiprocessor(&per_cu, (const void*)fwd_kernel, NTHR, LDS_BYTES) != hipSuccess || per_cu < 1) { fprintf(stderr, "kernel_launch: occupancy query says %d\n", per_cu); (void)hipGetLastError(); grid = -1; return; }
        grid = cus;
    }
    if (grid < 0) return;
    (void)in_sizes;
    hipMemsetAsync((char*)d_ws + WS_CTL, 0, CTL_BYTES, stream);
    Args a{};
    for (int i = 0; i < 22; ++i) a.in[i] = d_in[i];
    a.out = (float*)d_out; a.ws = (unsigned char*)d_ws; a.flags = 0; a.pad = 0;
#if MK_ONE_LAUNCH
    a.ph_lo = 0; a.ph_hi = NPH;
    hipLaunchKernelGGL(fwd_kernel, dim3(grid), dim3(NTHR), LDS_BYTES, stream, a);
#else
    for (int p = 0; p < NPH; ++p) { a.ph_lo = p; a.ph_hi = p + 1; hipLaunchKernelGGL(fwd_kernel, dim3(grid), dim3(NTHR), LDS_BYTES, stream, a); }
#endif
}
```

```cpp
#include <hip/hip_runtime.h>
#include <cstdio>
#include <cstdint>

#define GAS __attribute__((address_space(1)))
#define LAS __attribute__((address_space(3)))
typedef unsigned short bf16_t;
typedef short bf16x8 __attribute__((ext_vector_type(8)));
typedef float f32x4 __attribute__((ext_vector_type(4)));
typedef float f32x2 __attribute__((ext_vector_type(2)));
typedef float f32x16 __attribute__((ext_vector_type(16)));
typedef unsigned u32x4 __attribute__((ext_vector_type(4)));
typedef unsigned u32x2 __attribute__((ext_vector_type(2)));
typedef int i32x4 __attribute__((ext_vector_type(4)));
typedef int i32x8 __attribute__((ext_vector_type(8)));
typedef short s16x4 __attribute__((ext_vector_type(4)));
typedef short s16x2 __attribute__((ext_vector_type(2)));
typedef int v2i32 __attribute__((ext_vector_type(2)));

constexpr int S = 16384, D = 2048, DIN = 10832, DINP = 11008, NEXP = 32, DFF = 2048;
constexpr int NWAVES = 8, NTHR = 512;
constexpr int CQ = 0, CK = 1024, CV = 1280, CQI = 1536, CKI = 2560, CWI = 2624, CHQ = 2816, CHF = 3840, CHI = 4864, CHG = 5888, CGA = 6912, CGR = 8960;
constexpr int PMAX = 65536 + NEXP * 256;
constexpr float NORM_EPS = 1e-5f;

constexpr size_t MiB = 1u << 20;
constexpr size_t al256(size_t x) { return (x + 255) & ~(size_t)255; }
constexpr size_t WS_CTL = 0, CTL_BYTES = 1 * MiB;
constexpr size_t WS_MOD = WS_CTL + CTL_BYTES;
constexpr size_t WS_TOPE = WS_MOD + 64 * 1024;
constexpr size_t WS_GATE = WS_TOPE + (size_t)S * 16;
constexpr size_t WS_SLOT = WS_GATE + (size_t)S * 16;
constexpr size_t WS_WIN_T = WS_SLOT + (size_t)S * 16;
constexpr size_t WS_WA_T = WS_WIN_T + (size_t)DINP * D * 2;
constexpr size_t WS_WH_T = WS_WA_T + (size_t)2048 * 1024 * 2;
constexpr size_t WS_WO_T = WS_WH_T + (size_t)2048 * 1024 * 2;
constexpr size_t WS_W1_T = WS_WO_T + (size_t)2048 * 2048 * 2;
constexpr size_t WS_W2_T = WS_W1_T + (size_t)NEXP * 4096 * 2048 * 2;
constexpr size_t WS_H = WS_W2_T + (size_t)NEXP * 2048 * 2048 * 2;
constexpr size_t WS_PROJ = WS_H + (size_t)S * D * 2;
constexpr size_t WS_KI = WS_PROJ + (size_t)S * DINP * 2;
constexpr size_t WS_KC = WS_KI + (size_t)S * 64 * 2;
constexpr size_t WS_VC = WS_KC + (size_t)S * 256 * 2;
constexpr size_t WS_ST = WS_VC + (size_t)S * 256 * 2;
constexpr size_t WS_DC = WS_ST + (size_t)256 * 8 * 128 * 128 * 4;
constexpr size_t WS_SEL = WS_DC + (size_t)256 * 8 * 128 * 4;
constexpr size_t WS_ATT = WS_SEL + (size_t)S * 256 * 4;
constexpr size_t WS_REC = WS_ATT + (size_t)S * 1024 * 2;
constexpr size_t WS_MERGED = WS_REC + (size_t)S * 1024 * 2;
constexpr size_t WS_X1 = WS_MERGED + (size_t)S * 2048 * 2;
constexpr size_t WS_SCORES = WS_X1 + (size_t)S * 2048 * 4;
constexpr size_t WS_XB = WS_SCORES;
constexpr size_t WS_ACT = WS_XB + (size_t)PMAX * 2048 * 2;
constexpr size_t WS_YB = WS_ACT + (size_t)PMAX * 2048 * 2;
constexpr size_t WS_END = WS_SCORES + (size_t)S * S * 4;
static_assert(WS_YB + (size_t)PMAX * 2048 * 2 <= WS_END, "MoE buffers overlay the score matrix");
static_assert(WS_END <= (size_t)4096 * MiB, "workspace");
constexpr int CW_BAR = 4096, CW_CNT = 8192, CW_FILL = 8448;
constexpr size_t WS_TOKS = WS_SEL;

constexpr int LDS_BYTES = 155648;
constexpr int LDS_MISC = LDS_BYTES - 512;

__device__ __forceinline__ unsigned cvt_pk_bf16(float lo, float hi) { unsigned r; asm volatile("v_cvt_pk_bf16_f32 %0, %1, %2" : "=v"(r) : "v"(lo), "v"(hi)); return r; }
__device__ __forceinline__ float bf_lo(unsigned u) { return __uint_as_float(u << 16); }
__device__ __forceinline__ float bf_hi(unsigned u) { return __uint_as_float(u & 0xffff0000u); }
__device__ __forceinline__ float bf2f(bf16_t b) { return __uint_as_float(((unsigned)b) << 16); }
__device__ __forceinline__ float wave_sum(float v) {
#define DPPS(ctrl, rmask) { const int s_ = __builtin_amdgcn_update_dpp(0, __float_as_int(v), ctrl, rmask, 0xF, false); v += __int_as_float(s_); }
    DPPS(0x111, 0xF) DPPS(0x112, 0xF) DPPS(0x114, 0xF) DPPS(0x118, 0xF) DPPS(0x142, 0xA) DPPS(0x143, 0xC)
#undef DPPS
    return __int_as_float(__builtin_amdgcn_readlane(__float_as_int(v), 63));
}
__device__ __forceinline__ float wave_max(float v) {
#define DPPM(ctrl, rmask) { const int o_ = __float_as_int(v); const int s_ = __builtin_amdgcn_update_dpp(o_, o_, ctrl, rmask, 0xF, false); v = fmaxf(v, __int_as_float(s_)); }
    DPPM(0x111, 0xF) DPPM(0x112, 0xF) DPPM(0x114, 0xF) DPPM(0x118, 0xF) DPPM(0x142, 0xA) DPPM(0x143, 0xC)
#undef DPPM
    return __int_as_float(__builtin_amdgcn_readlane(__float_as_int(v), 63));
}
__device__ __forceinline__ float sigmoidf_(float x) { return __builtin_amdgcn_rcpf(1.0f + __expf(-x)); }
__device__ __forceinline__ float siluf_(float x) { return x * __builtin_amdgcn_rcpf(1.0f + __expf(-x)); }
__device__ __forceinline__ unsigned pack4_fp8(float a, float b, float c, float d) { int w = 0; w = __builtin_amdgcn_cvt_pk_fp8_f32(a, b, w, false); w = __builtin_amdgcn_cvt_pk_fp8_f32(c, d, w, true); return (unsigned)w; }
constexpr float W8_SCALE = 64.0f, ACT8_SCALE = 4.0f, MRG8_SCALE = 8.0f, OP8_SCALE = 16.0f;
__device__ __forceinline__ float relu_i(float x) { const int i = __float_as_int(x); return __int_as_float(i > 0 ? i : 0); }
__device__ __forceinline__ void fp8x16_to_bf16(const u32x4& w, u32x4& lo, u32x4& hi) {
    unsigned o[8];
#pragma unroll
    for (int q = 0; q < 4; ++q) { const unsigned wq = w[q]; const f32x2 a = __builtin_amdgcn_cvt_pk_f32_fp8((int)wq, false), b = __builtin_amdgcn_cvt_pk_f32_fp8((int)wq, true);
        o[2 * q] = cvt_pk_bf16(a[0], a[1]); o[2 * q + 1] = cvt_pk_bf16(b[0], b[1]); }
    lo = (u32x4){o[0], o[1], o[2], o[3]}; hi = (u32x4){o[4], o[5], o[6], o[7]};
}
__device__ __forceinline__ unsigned char fp8_1(float x) { return (unsigned char)(__builtin_amdgcn_cvt_pk_fp8_f32(x, x, 0, false) & 0xff); }
#define LDS_WAIT() asm volatile("s_waitcnt lgkmcnt(0)" ::: "memory")
#define VM_WAIT() asm volatile("s_waitcnt vmcnt(0)" ::: "memory")

#define XB_TMO      128
#define XB_XCNT(j)  (256  + 64 * (j))
#define XB_XSUB(j)  (1280 + 64 * (j))
#define XB_XGEN(j)  (2304 + 64 * (j))
#define XB_TOP      3328
#define XB_TOPGEN   3392
#define XCD_BAR_WORDS 3456
#define XB_SPIN_CAP (1u << 22)

__device__ __forceinline__ unsigned xb_ld(unsigned* p)              { return __hip_atomic_load(p, __ATOMIC_RELAXED, __HIP_MEMORY_SCOPE_AGENT); }
__device__ __forceinline__ unsigned xb_add(unsigned* p, unsigned v) { return __hip_atomic_fetch_add(p, v, __ATOMIC_RELAXED, __HIP_MEMORY_SCOPE_AGENT); }
__device__ __forceinline__ unsigned xb_xcc_id() { return (unsigned)__builtin_amdgcn_s_getreg((3 << 11) | 20) & 0xFu; }
#define XB_SPIN(cond, bar) do { unsigned _sp = 0; while (cond) { __builtin_amdgcn_s_sleep(1); \
    if ((++_sp & 255u) == 0u) { if (xb_ld(&(bar)[XB_TMO])) break; if (_sp > XB_SPIN_CAP) { atomicAdd(&(bar)[XB_TMO], 1u); break; } } } } while (0)

struct XcdBarrier { unsigned* bar; unsigned x; volatile LAS unsigned* st; };

__device__ __forceinline__ XcdBarrier xcd_barrier_post(unsigned* bar, volatile LAS unsigned* st) {
    XcdBarrier b; b.bar = bar; b.x = xb_xcc_id(); b.st = st;
    if (threadIdx.x == 0) (void)xb_add(&bar[XB_XCNT(b.x)], 1u);
    return b;
}
__device__ __forceinline__ void xcd_barrier_complete(unsigned* bar, unsigned x, unsigned& nloc, unsigned& nx) {
    const unsigned G = gridDim.x * gridDim.y * gridDim.z;
    unsigned sum, cnt, mine, sp = 0u;
    for (;;) {
        sum = 0u; cnt = 0u; mine = 0u;
#pragma unroll
        for (unsigned j = 0; j < 16; ++j) { const unsigned c = xb_ld(&bar[XB_XCNT(j)]); sum += c; cnt += (c > 0u) ? 1u : 0u; mine = (j == x) ? c : mine; }
        if (sum == G) break;
        __builtin_amdgcn_s_sleep(1);
        if ((++sp & 255u) == 0u) { if (xb_ld(&bar[XB_TMO])) break; if (sp > XB_SPIN_CAP) { atomicAdd(&bar[XB_TMO], 1u); break; } }
    }
    nloc = mine > 0u ? mine : 1u; nx = cnt > 0u ? cnt : 1u;
}
__device__ __forceinline__ void xcd_barrier(const XcdBarrier& b) {
    asm volatile("s_waitcnt vmcnt(0)" ::: "memory");
    __syncthreads();
    if (threadIdx.x == 0) {
        unsigned* bar = b.bar;
        __builtin_amdgcn_s_waitcnt(0);
        unsigned nloc = b.st[0], nx = b.st[1];
        if (nloc == 0u) { xcd_barrier_complete(bar, b.x, nloc, nx); b.st[0] = nloc; b.st[1] = nx; }
        const unsigned old = xb_add(&bar[XB_XSUB(b.x)], 1u);
        const unsigned gen = old / nloc;
        if (old + 1u == (gen + 1u) * nloc) {
            __builtin_amdgcn_fence(__ATOMIC_RELEASE, "agent");
            asm volatile("s_waitcnt vmcnt(0)" ::: "memory");
            const unsigned og = xb_add(&bar[XB_TOP], 1u);
            const unsigned tg = og / nx;
            if (og + 1u == (tg + 1u) * nx) xb_add(&bar[XB_TOPGEN], 1u);
            else XB_SPIN(xb_ld(&bar[XB_TOPGEN]) == tg, bar);
            __builtin_amdgcn_fence(__ATOMIC_ACQUIRE, "agent");
            xb_add(&bar[XB_XGEN(b.x)], 1u);
            asm volatile("s_waitcnt vmcnt(0)" ::: "memory");
        } else {
            XB_SPIN(xb_ld(&bar[XB_XGEN(b.x)]) == gen, bar);
            __builtin_amdgcn_fence(__ATOMIC_ACQUIRE, "agent");
            asm volatile("s_waitcnt vmcnt(0)" ::: "memory");
        }
    }
    __syncthreads();
}

namespace pg8 {
constexpr int BM = 256, BK = 64, HALF = 128, HTB = HALF * BK * 2, STAGE_BYTES = 8 * HTB, NXCD = 8, WGM = 8;
__host__ __device__ __forceinline__ int lds_byte(int r, int c) { const int st = (r >> 4) * 2 + (c >> 5), rr = r & 15, cc = c & 31, ob = rr * 64 + cc * 2; return st * 1024 + (ob ^ (((ob >> 9) & 1) << 5)); }
__host__ __device__ __forceinline__ void stage_rc(int b, int& R, int& C) { const int st = b / 1024, sb = b % 1024, swz = sb ^ (((sb >> 9) & 1) << 5); R = (st >> 1) * 16 + swz / 64; C = (st & 1) * 32 + (swz % 64) / 2; }
__host__ __device__ __forceinline__ int perm32(int rho) { const int n = rho >> 4, i = rho & 15; return 8 * (i >> 2) + 4 * n + (i & 3); }

struct Unit { int pm, pn, e; };
struct Gemm { const void* A; const void* Bt; int K; size_t estride; const int* arow; size_t astride; };

struct StaticOrder {
    int nM, nN, nwg, G, c, i, full, erank, en;
    __device__ void init(int M, int N, int G_, int c_) { nM = M / BM; nN = N / BM; nwg = nM * nN; G = G_; c = c_; i = 0; full = 1 << 30; erank = -1; en = 1; }
    __device__ void skew(int full_, int erank_, int en_) { full = full_; erank = erank_; en = en_; }
    __device__ bool next(Unit& u) {
        long L;
        if (i < full) L = (long)i * G + c; else { if (erank < 0) return false; L = (long)full * G + (long)(i - full) * en + erank; }
        ++i; if (L >= nwg) return false;
        int wgid = (int)L; { const int q = nwg / NXCD, r = nwg % NXCD, xcd = wgid % NXCD, off = wgid / NXCD; wgid = (xcd < r ? xcd * (q + 1) : r * (q + 1) + (xcd - r) * q) + off; }
        const int nig = WGM * nN, gid = wgid / nig, fm = gid * WGM, gsz = (nM - fm) < WGM ? (nM - fm) : WGM;
        u.pm = fm + ((wgid % nig) % gsz); u.pn = (wgid % nig) / gsz; u.e = 0; return true;
    }
};
struct MoeOrder {
    int nPanels, nN, G, c, i; const LAS int* panel_e;
    __device__ void init(int nPanels_, int nN_, int G_, int c_, const LAS int* pe) { nPanels = nPanels_; nN = nN_; G = G_; c = c_; i = 0; panel_e = pe; }
    __device__ bool next(Unit& u) {
        const int PB = 256 / nN;
        const int nblk = (nPanels + PB - 1) / PB;
        for (;;) {
            const long L = (long)i * G + c; ++i;
            const int blk = (int)(L >> 8), r = (int)(L & 255), x = r & 7, j = r >> 3;
            if (blk >= nblk) return false;
            int pm, pn;
            if (nN == 16) { pm = blk * 16 + 4 * (x >> 1) + (j & 3); pn = 8 * (x & 1) + (j >> 2); }
            else          { pm = blk * 32 + 4 * x + (j & 3);        pn = j >> 2; }
            if (pm < nPanels) { u.pm = pm; u.pn = pn; u.e = panel_e[pm]; return true; }
        }
    }
};

template <class Epi, class Sched, bool FP8 = false>
__device__ __forceinline__ void gemm_phase(LAS unsigned char* lds, const Gemm g, Sched& S, const Epi& E) {
    const int tid = threadIdx.x, wid = __builtin_amdgcn_readfirstlane(tid >> 6), lane = tid & 63, wr = wid >> 2, wc = wid & 3, fr = lane & 15, fq = lane >> 4;
    const int K = g.K; const int pitch = FP8 ? K : 2 * K; const int nt = pitch / 128;
    unsigned voffA[2], voffB[2];
#pragma unroll
    for (int i = 0; i < 2; ++i) { int R, C; stage_rc(tid * 16 + i * 8192, R, C); const int Rb = Epi::PERM ? ((R & ~31) + perm32(R & 31)) : R;
        voffA[i] = (unsigned)(R * pitch + C * 2); voffB[i] = (unsigned)(Rb * pitch + C * 2); }
    const size_t kstep = (size_t)(BK * 2);
    const size_t hstep = (size_t)HALF * pitch;
    const size_t tstep = 2 * hstep;
    int RA[2], CA[2];
#pragma unroll
    for (int i = 0; i < 2; ++i) stage_rc(tid * 16 + i * 8192, RA[i], CA[i]);
    const bool gather = g.arow != nullptr;
    const size_t hsA = gather ? 0 : hstep;
    unsigned vA0[2] = {voffA[0], voffA[1]}, vA1[2] = {voffA[0], voffA[1]}, nA0[2] = {voffA[0], voffA[1]}, nA1[2] = {voffA[0], voffA[1]};
#define PG8_AOFF(dst0, dst1, u) do { if (gather) { _Pragma("unroll") for (int i = 0; i < 2; ++i) { \
        dst0[i] = (unsigned)g.arow[(u).pm * 256 + RA[i]] * (unsigned)pitch + (unsigned)(CA[i] * 2); dst1[i] = (unsigned)g.arow[(u).pm * 256 + 128 + RA[i]] * (unsigned)pitch + (unsigned)(CA[i] * 2); } } } while (0)
    const unsigned ldsw = (unsigned)wid * 1024u;
    const int aoff = lds_byte(wr * 64 + fr, fq * 8), boff = lds_byte(wc * 32 + fr, fq * 8);
#define PG8_SA(b, h) (((b) * 2 + (h)) * HTB)
#define PG8_SB(b, h) ((4 + (b) * 2 + (h)) * HTB)
#define PG8_STAGE(bufoff, gbase, voff) do { _Pragma("unroll") for (int _i = 0; _i < 2; ++_i) \
        __builtin_amdgcn_global_load_lds((const unsigned*)((const char*)(gbase) + (voff)[_i]), (LAS unsigned*)(lds + (bufoff) + ldsw + _i * 8192), 16, 0, 0); } while (0)
#define PG8_LD8(p) __builtin_shufflevector(*(const LAS i32x4*)(p), *(const LAS i32x4*)((p) + 1024), 0, 1, 2, 3, 4, 5, 6, 7)
#define PG8_LDA(dst, b, h) do { _Pragma("unroll") for (int m = 0; m < 4; ++m) { if constexpr (FP8) dst##8[m] = PG8_LD8(lds + PG8_SA(b, h) + aoff + m * 2048); \
        else { _Pragma("unroll") for (int k = 0; k < 2; ++k) dst[m][k] = *(const LAS bf16x8*)(lds + PG8_SA(b, h) + aoff + m * 2048 + k * 1024); } } } while (0)
#define PG8_LDB(dst, b, h) do { _Pragma("unroll") for (int n = 0; n < 2; ++n) { if constexpr (FP8) dst##8[n] = PG8_LD8(lds + PG8_SB(b, h) + boff + n * 2048); \
        else { _Pragma("unroll") for (int k = 0; k < 2; ++k) dst[n][k] = *(const LAS bf16x8*)(lds + PG8_SB(b, h) + boff + n * 2048 + k * 1024); } } } while (0)
#define PG8_MMA(ai, bj, At, Bt) do { __builtin_amdgcn_s_setprio(1); _Pragma("unroll") for (int m = 0; m < 4; ++m) _Pragma("unroll") for (int n = 0; n < 2; ++n) { \
        if constexpr (FP8) asm volatile("v_mfma_scale_f32_16x16x128_f8f6f4 %0, %1, %2, %0, %3, %3 op_sel_hi:[0,0,0]" : "+v"(acc[ai][bj][m][n]) : "v"(Bt##8[n]), "v"(At##8[m]), "v"(scl1)); \
        else { _Pragma("unroll") for (int k = 0; k < 2; ++k) acc[ai][bj][m][n] = __builtin_amdgcn_mfma_f32_16x16x32_bf16(Bt[n][k], At[m][k], acc[ai][bj][m][n], 0, 0, 0); } } \
        __builtin_amdgcn_s_setprio(0); } while (0)
#define PG8_WAIT_V(n) asm volatile("s_waitcnt vmcnt(" #n ")" ::: "memory")
#define PG8_WAIT_L(n) asm volatile("s_waitcnt lgkmcnt(" #n ")" ::: "memory")
#define PG8_BAR __builtin_amdgcn_s_barrier()
#define PG8_SCHED __builtin_amdgcn_sched_barrier(0)
    Unit cur, nxt;
    if (!S.next(cur)) return;
    const unsigned scl1 = 0x7f7f7f7fu;
    f32x4 acc[2][2][4][2];
#pragma unroll
    for (int a = 0; a < 2; ++a)
#pragma unroll
        for (int b = 0; b < 2; ++b)
#pragma unroll
            for (int m = 0; m < 4; ++m)
#pragma unroll
                for (int n = 0; n < 2; ++n) acc[a][b][m][n] = (f32x4){0.f, 0.f, 0.f, 0.f};
    bf16x8 At[4][2], B0[2][2], B1[2][2]; i32x8 At8[4], B08[2], B18[2];
    const char* cA = (const char*)g.A + (size_t)cur.e * g.astride + (gather ? (size_t)0 : (size_t)cur.pm * tstep); const char* cB = (const char*)g.Bt + (size_t)cur.e * g.estride + (size_t)cur.pn * tstep;
    PG8_AOFF(vA0, vA1, cur);
    PG8_STAGE(PG8_SB(0, 0), cB, voffB); PG8_STAGE(PG8_SB(0, 1), cB + hstep, voffB); PG8_STAGE(PG8_SA(0, 0), cA, vA0); PG8_STAGE(PG8_SA(0, 1), cA + hsA, vA1);
    if (wr == 1) PG8_BAR;
    PG8_WAIT_V(2); PG8_BAR;
    PG8_STAGE(PG8_SB(1, 0), cB + kstep, voffB); PG8_STAGE(PG8_SA(1, 0), cA + kstep, vA0); PG8_STAGE(PG8_SB(1, 1), cB + hstep + kstep, voffB);
    PG8_WAIT_V(6); PG8_BAR;
    for (;;) {
        const bool has_next = S.next(nxt);
        const char* nA = has_next ? (const char*)g.A + (size_t)nxt.e * g.astride + (gather ? (size_t)0 : (size_t)nxt.pm * tstep) : cA;
        if (has_next) PG8_AOFF(nA0, nA1, nxt);
        const char* nB = has_next ? (const char*)g.Bt + (size_t)nxt.e * g.estride + (size_t)nxt.pn * tstep : cB;
        for (int t = 0; t < nt; t += 2) {
            const bool last = (t == nt - 2);
            const char* a1 = cA + (size_t)(t + 1) * kstep;
            const char* a2 = last ? nA : cA + (size_t)(t + 2) * kstep; const char* b2 = last ? nB : cB + (size_t)(t + 2) * kstep;
            const char* a3 = a2 + kstep; const char* b3 = b2 + kstep;
            PG8_LDB(B0, 0, 0); PG8_LDB(B1, 0, 1); PG8_SCHED; PG8_LDA(At, 0, 0); PG8_STAGE(PG8_SA(1, 1), a1 + hsA, vA1);
            if (last && has_next) { vA0[0] = nA0[0]; vA0[1] = nA0[1]; vA1[0] = nA1[0]; vA1[1] = nA1[1]; }
            PG8_WAIT_V(8); PG8_WAIT_L(0); PG8_BAR; PG8_MMA(0, 0, At, B0); PG8_MMA(0, 1, At, B1); PG8_BAR; PG8_SCHED;
            PG8_LDA(At, 0, 1); PG8_STAGE(PG8_SB(0, 0), b2, voffB); PG8_STAGE(PG8_SB(0, 1), b2 + hstep, voffB); PG8_STAGE(PG8_SA(0, 0), a2, vA0);
            PG8_WAIT_V(8); PG8_WAIT_L(0); PG8_BAR; PG8_MMA(1, 0, At, B0); PG8_MMA(1, 1, At, B1); PG8_BAR; PG8_SCHED;
            PG8_LDB(B0, 1, 0); PG8_LDB(B1, 1, 1); PG8_SCHED; PG8_LDA(At, 1, 0); PG8_STAGE(PG8_SA(0, 1), a2 + hsA, vA1);
            PG8_WAIT_V(8); PG8_WAIT_L(0); PG8_BAR; PG8_MMA(0, 0, At, B0); PG8_MMA(0, 1, At, B1); PG8_BAR; PG8_SCHED;
            PG8_LDA(At, 1, 1); PG8_STAGE(PG8_SB(1, 0), b3, voffB); PG8_STAGE(PG8_SB(1, 1), b3 + hstep, voffB); PG8_STAGE(PG8_SA(1, 0), a3, vA0);
            PG8_WAIT_V(8); PG8_WAIT_L(0); PG8_BAR; PG8_MMA(1, 0, At, B0); PG8_MMA(1, 1, At, B1); PG8_BAR; PG8_SCHED;
        }
        if (wr == 0) PG8_BAR;
        if constexpr (FP8) {
#pragma unroll
            for (int a = 0; a < 2; ++a)
#pragma unroll
                for (int b = 0; b < 2; ++b) asm volatile("s_nop 15" : "+v"(acc[a][b][0][0]), "+v"(acc[a][b][0][1]), "+v"(acc[a][b][1][0]), "+v"(acc[a][b][1][1]), "+v"(acc[a][b][2][0]), "+v"(acc[a][b][2][1]), "+v"(acc[a][b][3][0]), "+v"(acc[a][b][3][1]));
        }
        const bool keep_acc = E(acc, cur, wr, wc, fr, fq);
        if (!has_next) break;
        if (!keep_acc)
#pragma unroll
        for (int a = 0; a < 2; ++a)
#pragma unroll
            for (int b = 0; b < 2; ++b)
#pragma unroll
                for (int m = 0; m < 4; ++m)
#pragma unroll
                    for (int n = 0; n < 2; ++n) acc[a][b][m][n] = (f32x4){0.f, 0.f, 0.f, 0.f};
        cur = nxt; cA = nA; cB = nB;
        if (wr == 1) PG8_BAR;
    }
    PG8_WAIT_V(0);
    PG8_BAR;
#undef PG8_AOFF
#undef PG8_SA
#undef PG8_SB
#undef PG8_STAGE
#undef PG8_LDA
#undef PG8_LDB
#undef PG8_MMA
#undef PG8_LD8
#undef PG8_WAIT_V
#undef PG8_WAIT_L
#undef PG8_BAR
#undef PG8_SCHED
}

struct EpiBf16 {
    static constexpr bool PERM = true;
    bf16_t* O; int ldc; const float* bias; int bias_estride; float ascale; int skip_from, skip_cols;
    __device__ __forceinline__ bool operator()(const f32x4 (&acc)[2][2][4][2], const Unit& u, int wr, int wc, int fr, int fq) const {
        const int row0 = u.pm * BM + wr * 64 + fr; const int col0 = u.pn * BM + wc * 32 + 8 * fq + (u.pn >= skip_from ? skip_cols : 0);
        f32x4 bv[2][2];
#pragma unroll
        for (int bj = 0; bj < 2; ++bj)
#pragma unroll
            for (int n = 0; n < 2; ++n) bv[bj][n] = bias ? *(const f32x4*)(bias + (size_t)u.e * bias_estride + col0 + bj * HALF + 4 * n) : (f32x4){0.f, 0.f, 0.f, 0.f};
#pragma unroll
        for (int ai = 0; ai < 2; ++ai)
#pragma unroll
            for (int m = 0; m < 4; ++m) { bf16_t* rowp = O + (size_t)(row0 + ai * HALF + m * 16) * ldc + col0;
#pragma unroll
                for (int bj = 0; bj < 2; ++bj) { const f32x4 v0 = acc[ai][bj][m][0] * ascale + bv[bj][0], v1 = acc[ai][bj][m][1] * ascale + bv[bj][1];
                    u32x4 w; w.x = cvt_pk_bf16(v0[0], v0[1]); w.y = cvt_pk_bf16(v0[2], v0[3]); w.z = cvt_pk_bf16(v1[0], v1[1]); w.w = cvt_pk_bf16(v1[2], v1[3]);
                    *(u32x4*)(rowp + bj * HALF) = w; } }
        return false;
    }
};
__device__ __forceinline__ float swiglu1(float ug, float ul) {
    ug = fminf(ug, 7.0f); ul = fminf(fmaxf(ul, -7.0f), 7.0f);
    return ug * __builtin_amdgcn_rcpf(1.0f + __expf(-1.702f * ug)) * (ul + 1.0f);
}
struct EpiSwiglu {
    static constexpr bool PERM = true;
    unsigned char* O; const float* b1;
    __device__ __forceinline__ bool operator()(const f32x4 (&acc)[2][2][4][2], const Unit& u, int wr, int wc, int fr, int fq) const {
        const int row0 = u.pm * BM + wr * 64 + fr; const int c0 = u.pn * 128 + wc * 32 + 8 * fq;
        const float* bg = b1 + (size_t)u.e * 4096 + c0; const float* bl = bg + 2048;
        f32x4 bgv[2], blv[2];
#pragma unroll
        for (int n = 0; n < 2; ++n) { bgv[n] = *(const f32x4*)(bg + 4 * n); blv[n] = *(const f32x4*)(bl + 4 * n); }
#pragma unroll
        for (int ai = 0; ai < 2; ++ai)
#pragma unroll
            for (int m = 0; m < 4; ++m) {
                float a[8];
#pragma unroll
                for (int n = 0; n < 2; ++n)
#pragma unroll
                    for (int j = 0; j < 4; ++j) a[4 * n + j] = ACT8_SCALE * swiglu1(acc[ai][0][m][n][j] * (1.0f / W8_SCALE) + bgv[n][j], acc[ai][1][m][n][j] * (1.0f / W8_SCALE) + blv[n][j]);
                u32x2 w; w.x = pack4_fp8(a[0], a[1], a[2], a[3]); w.y = pack4_fp8(a[4], a[5], a[6], a[7]);
                *(u32x2*)(O + (size_t)(row0 + ai * HALF + m * 16) * 2048 + c0) = w;
            }
        return false;
    }
};

struct TwoPartOrder {
    StaticOrder so; Unit held; int part;
    __device__ void init(int M, int N, int G_, int c_) { so.init(M, N, G_, c_); part = 0; }
    __device__ bool next(Unit& u) { if (part == 1) { u = held; u.e = 1; part = 0; return true; } if (!so.next(held)) return false; u = held; u.e = 0; part = 1; return true; }
};
struct EpiGate2 {
    static constexpr bool PERM = true;
    unsigned char* O; const bf16_t* Ga; const bf16_t* Gr;
    __device__ __forceinline__ bool operator()(f32x4 (&acc)[2][2][4][2], const Unit& u, int wr, int wc, int fr, int fq) const {
        const int row0 = u.pm * BM + wr * 64 + fr; const int col0 = u.pn * BM + wc * 32 + 8 * fq;
#pragma unroll
        for (int ai = 0; ai < 2; ++ai)
#pragma unroll
            for (int m = 0; m < 4; ++m) { const size_t row = (size_t)(row0 + ai * HALF + m * 16);
#pragma unroll
                for (int bj = 0; bj < 2; ++bj) { const int c = col0 + bj * HALF;
                    const u32x4 gr = *(const u32x4*)(Gr + row * DINP + c);
                    if (u.e == 0) {
                        const u32x4 ga = *(const u32x4*)(Ga + row * DINP + c);
#pragma unroll
                        for (int q = 0; q < 4; ++q) {
                            const float r0 = (1.0f + __expf(-bf_lo(gr[q]))) * __builtin_amdgcn_rcpf(1.0f + __expf(-bf_lo(ga[q]))), r1 = (1.0f + __expf(-bf_hi(gr[q]))) * __builtin_amdgcn_rcpf(1.0f + __expf(-bf_hi(ga[q])));
                            acc[ai][bj][m][q >> 1][(2 * q) & 3] *= r0; acc[ai][bj][m][q >> 1][(2 * q + 1) & 3] *= r1; }
                    } else {
                        float r[8];
#pragma unroll
                        for (int q = 0; q < 4; ++q) { r[2 * q] = sigmoidf_(bf_lo(gr[q])) * acc[ai][bj][m][q >> 1][(2 * q) & 3]; r[2 * q + 1] = sigmoidf_(bf_hi(gr[q])) * acc[ai][bj][m][q >> 1][(2 * q + 1) & 3]; }
                        u32x2 w; constexpr float osc = MRG8_SCALE / (W8_SCALE * OP8_SCALE); w.x = pack4_fp8(r[0] * osc, r[1] * osc, r[2] * osc, r[3] * osc); w.y = pack4_fp8(r[4] * osc, r[5] * osc, r[6] * osc, r[7] * osc);
                        *(u32x2*)(O + row * 2048 + c) = w; } } }
        return u.e == 0;
    }
};
struct EpiDelta {
    static constexpr bool PERM = true;
    const float* gt; bf16_t* DL; float ascale;
    __device__ __forceinline__ bool operator()(const f32x4 (&acc)[2][2][4][2], const Unit& u, int wr, int wc, int fr, int fq) const {
        const int row0 = u.pm * BM + wr * 64 + fr; const int col0 = u.pn * BM + wc * 32 + 8 * fq;
        f32x4 g[2][2];
#pragma unroll
        for (int bj = 0; bj < 2; ++bj)
#pragma unroll
            for (int n = 0; n < 2; ++n) g[bj][n] = *(const f32x4*)(gt + col0 + bj * HALF + 4 * n);
#pragma unroll
        for (int ai = 0; ai < 2; ++ai)
#pragma unroll
            for (int m = 0; m < 4; ++m) { bf16_t* rowp = DL + (size_t)(row0 + ai * HALF + m * 16) * 2048 + col0;
#pragma unroll
                for (int bj = 0; bj < 2; ++bj) { const f32x4 v0 = acc[ai][bj][m][0] * ascale * g[bj][0], v1 = acc[ai][bj][m][1] * ascale * g[bj][1];
                    u32x4 w; w.x = cvt_pk_bf16(v0[0], v0[1]); w.y = cvt_pk_bf16(v0[2], v0[3]); w.z = cvt_pk_bf16(v1[0], v1[1]); w.w = cvt_pk_bf16(v1[2], v1[3]);
                    *(u32x4*)(rowp + bj * HALF) = w; } }
        return false;
    }
};
}

struct Args { const void* in[22]; float* out; unsigned char* ws; int ph_lo, ph_hi, flags, pad; };
constexpr int XCONV = 0, XSCORE = 96;
constexpr int CW_SCQ = 12288, SCP = 5, CW_ATQ = 12352;
enum { PH_PRO = 0, PH_H, PH_INPROJ, PH_POST, PH_SCORE, PH_SELECT, PH_ATTN, PH_OP1, PH_OP2, PH_WOUT, PH_ROUTER, PH_SCATTER, PH_MOE1, PH_MOE2, PH_FINAL, NPH };

__device__ __forceinline__ int dest_row(int mode, int n) {
    if (mode == 1) return n < 2640 ? n : n + 176;
    if (mode == 2) { const int g = n >> 11, c = n & 2047; return (c >> 7) * 256 + g * 128 + (c & 127); }
    return n;
}
__device__ __forceinline__ void convert_item(const float* __restrict__ W, int K, int N, int ld, bf16_t* WT, int mode, int item, int lane, LAS unsigned char* scr) {
    const int nblk = (N + 63) >> 6; const int kb = item / nblk, nb = item - kb * nblk; const int k0 = kb * 128, n0 = nb * 64;
    const int c4 = lane & 15, kr = lane >> 4;
    const bool ok = (n0 + 4 * c4) < N;
    const float* src = W + (size_t)(k0 + 2 * kr) * ld + n0 + 4 * c4;
#pragma unroll 4
    for (int i = 0; i < 16; ++i) {
        f32x4 v0 = (f32x4){0.f, 0.f, 0.f, 0.f}, v1 = v0;
        if (ok) { v0 = *(const f32x4*)(src + (size_t)(8 * i) * ld); v1 = *(const f32x4*)(src + (size_t)(8 * i + 1) * ld); }
        const int kk = 8 * i + 2 * kr;
#pragma unroll
        for (int e = 0; e < 4; ++e) *(LAS unsigned*)(scr + (4 * c4 + e) * 272 + kk * 2) = cvt_pk_bf16(v0[e], v1[e]);
    }
    LDS_WAIT(); asm volatile("" ::: "memory");
#pragma unroll 4
    for (int j = 0; j < 16; ++j) {
        const int q = j * 64 + lane, n = q >> 4, ch = q & 15;
        const u32x4 v = *(const LAS u32x4*)(scr + n * 272 + ch * 16);
        if (n0 + n < N) *(u32x4*)(WT + (size_t)dest_row(mode, n0 + n) * K + k0 + ch * 8) = v;
    }
    LDS_WAIT(); asm volatile("" ::: "memory");
}


__device__ __forceinline__ bf16_t f2bf(float f) { unsigned u = __float_as_uint(f); return (bf16_t)((u + 0x7fffu + ((u >> 16) & 1u)) >> 16); }
__device__ __forceinline__ float bfx(const u32x4& w, int i) { const unsigned u = w[i >> 1]; return (i & 1) ? bf_hi(u) : bf_lo(u); }
__device__ __forceinline__ void rope_sc(float pos, float inv, float& sn, float& cs) {
    const float ang = pos * inv;
    const double a = (double)ang; const double n = __builtin_rint(a * 0.15915494309189535); const float r = (float)(a - n * 6.283185307179586);
    sn = __sinf(r); cs = __cosf(r);
}
__device__ __forceinline__ void post_token(bf16_t* PROJ, bf16_t* KI, unsigned char* KC, unsigned char* VC, const int* positions, const float* kng, const float* knb, float inv16, float inv8, int t, int lane) {
    const float pos = (float)positions[t];
    bf16_t* row = PROJ + (size_t)t * DINP;
    float sn, cs, sn8, cs8;
    rope_sc(pos, inv16, sn, cs); rope_sc(pos, inv8, sn8, cs8);
#pragma unroll
    for (int i = 0; i < 2; ++i) {
        const int pp = lane + 64 * i, hd = pp >> 4, ii = pp & 15;
        bf16_t* p = row + CQ + hd * 128 + ii; const float a = bf2f(p[0]), b = bf2f(p[16]);
        p[0] = f2bf(a * cs - b * sn); p[16] = f2bf(b * cs + a * sn);
    }
#pragma unroll
    for (int i = 0; i < 2; ++i) {
        const int pp = lane + 64 * i, hd = pp >> 3, ii = pp & 7;
        bf16_t* p = row + CQI + hd * 64 + ii; const float a = bf2f(p[0]), b = bf2f(p[8]);
        p[0] = f2bf(a * cs8 - b * sn8); p[8] = f2bf(b * cs8 + a * sn8);
    }
    if (lane < 32) {
        const int g = lane >> 4, ii = lane & 15;
        const bf16_t* p = row + CK + g * 128 + ii; const float a = bf2f(p[0]), b = bf2f(p[16]);
        unsigned char* o = KC + (size_t)t * 256 + g * 128 + ii; o[0] = fp8_1(a * cs - b * sn); o[16] = fp8_1(b * cs + a * sn);
    }
#pragma unroll
    for (int i = 0; i < 3; ++i) { const int idx = lane + 64 * i, g = idx / 96, r = idx - g * 96; KC[(size_t)t * 256 + g * 128 + 32 + r] = fp8_1(bf2f(row[CK + g * 128 + 32 + r])); }
    { const u32x2 w = *(const u32x2*)(row + CV + 4 * lane); *(unsigned*)(VC + (size_t)t * 256 + 4 * lane) = pack4_fp8(bf_lo(w.x), bf_hi(w.x), bf_lo(w.y), bf_hi(w.y)); }
    {
        const float v = bf2f(row[CKI + lane]);
        const float mean = wave_sum(v) * (1.0f / 64.0f); const float d = v - mean; const float var = wave_sum(d * d) * (1.0f / 64.0f);
        const float y = d * rsqrtf(var + NORM_EPS) * kng[lane] + knb[lane];
        const float other = __shfl_xor(y, 8);
        float o = y;
        if (lane < 8) o = y * cs8 - other * sn8; else if (lane < 16) o = y * cs8 + other * sn8;
        KI[(size_t)t * 64 + lane] = f2bf(o);
    }
}

constexpr int GBP = 129;
constexpr int HG_GB = 0, HG_Q1 = 33792, HG_Q2 = 51200, HG_K2 = 68608, HG_VT = 86016, HG_PB = 104448, HG_LB = 113664;
__device__ __forceinline__ void hgrn_cumsum(LAS unsigned char* lds, const u32x4& w0, const u32x4& w1, float l0, float l1, int tid) {
    LAS float* GB = (LAS float*)(lds + HG_GB); LAS float* LB = (LAS float*)(lds + HG_LB); LAS float* SEG = (LAS float*)(lds + HG_LB + 512);
    if (tid < 128) LB[tid] = 1.0f / (1.0f + expf(l1 - l0));
    __syncthreads();
    const int t = tid >> 3, dseg = tid & 7;
#pragma unroll
    for (int i = 0; i < 16; ++i) { const float z = i < 8 ? bfx(w0, i) : bfx(w1, i - 8); const float lb = LB[16 * dseg + i]; GB[t * GBP + 16 * dseg + i] = __logf(lb + (1.0f - lb) * sigmoidf_(z)); }
    __syncthreads();
    const int d = tid & 127, tq = tid >> 7;
    float z[16];
#pragma unroll
    for (int i = 0; i < 16; ++i) z[i] = GB[(16 * tq + i) * GBP + d];
    float a = 0.f;
#pragma unroll
    for (int i = 0; i < 16; ++i) { a += z[i]; z[i] = a; }
    SEG[tq * 128 + d] = a;
    __syncthreads();
    float pre = 0.f;
    for (int q = 0; q < tq; ++q) pre += SEG[q * 128 + d];
#pragma unroll
    for (int i = 0; i < 16; ++i) GB[(16 * tq + i) * GBP + d] = z[i] + pre;
    __syncthreads();
}
__device__ __forceinline__ void hgrn_vt(LAS unsigned char* lds, const u32x4& a, const u32x4& b, int tid) {
    const int s2 = tid & 31, eg = tid >> 5;
#pragma unroll
    for (int i = 0; i < 8; ++i) { const unsigned lo = (i & 1) ? (a[i >> 1] >> 16) : (a[i >> 1] & 0xffffu), hi = (i & 1) ? (b[i >> 1] >> 16) : (b[i >> 1] & 0xffffu);
        *(LAS unsigned*)(lds + HG_VT + (8 * eg + i) * 144 + s2 * 4) = lo | (hi << 16); }
}
__device__ __forceinline__ void hgrn_l1(LAS unsigned char* lds, const bf16_t* PROJ, const float* lb_logits, bf16_t* ST, float* DC, int c, int h, int tid, int wave, int lane) {
    const int t = tid >> 3, dseg = tid & 7, s2 = tid & 31, dg = tid >> 5;
    const bf16_t* pf = PROJ + (size_t)(c * 64 + t) * DINP + CHF + h * 128 + 16 * dseg;
    const bf16_t* pk = PROJ + (size_t)(c * 64 + 2 * s2) * DINP + CHF + h * 128 + 8 * dg;
    const u32x4 w0 = *(const u32x4*)pf, w1 = *(const u32x4*)(pf + 8);
    const u32x4 ka = *(const u32x4*)pk, kb = *(const u32x4*)(pk + DINP);
    const u32x4 va = *(const u32x4*)(pk - CHF + CHI), vb = *(const u32x4*)(pk - CHF + CHI + DINP);
    const float l0 = lb_logits[h * 128 + (tid & 127)], l1 = lb_logits[1024 + h * 128 + (tid & 127)];
    hgrn_cumsum(lds, w0, w1, l0, l1, tid);
    const LAS float* GB = (const LAS float*)(lds + HG_GB); const LAS float* LB = (const LAS float*)(lds + HG_LB);
    {
#pragma unroll
        for (int i = 0; i < 8; ++i) { const int d = 8 * dg + i; const float lb = LB[d], b63 = GB[63 * GBP + d];
            const float k0 = (1.0f - lb) * (1.0f - sigmoidf_(bfx(ka, i))), k1 = (1.0f - lb) * (1.0f - sigmoidf_(bfx(kb, i)));
            const float v0 = k0 * __expf(b63 - GB[(2 * s2) * GBP + d]), v1 = k1 * __expf(b63 - GB[(2 * s2 + 1) * GBP + d]);
            *(LAS unsigned*)(lds + HG_Q1 + d * 144 + s2 * 4) = cvt_pk_bf16(v0, v1); }
    }
    hgrn_vt(lds, va, vb, tid);
    __syncthreads();
    const int fr = lane & 15, fq = lane >> 4;
    bf16x8 af[2];
#pragma unroll
    for (int ks = 0; ks < 2; ++ks) af[ks] = *(const LAS bf16x8*)(lds + HG_VT + (16 * wave + fr) * 144 + (32 * ks + 8 * fq) * 2);
    bf16_t* dst = ST + ((size_t)(c * 8 + h) * 128) * 128;
#pragma unroll 2
    for (int dt = 0; dt < 8; ++dt) {
        f32x4 acc = (f32x4){0.f, 0.f, 0.f, 0.f};
#pragma unroll
        for (int ks = 0; ks < 2; ++ks) { const bf16x8 bfr = *(const LAS bf16x8*)(lds + HG_Q1 + (16 * dt + fr) * 144 + (32 * ks + 8 * fq) * 2); acc = __builtin_amdgcn_mfma_f32_16x16x32_bf16(af[ks], bfr, acc, 0, 0, 0); }
#pragma unroll
        for (int r = 0; r < 4; ++r) dst[(size_t)(16 * wave + 4 * fq + r) * 128 + 16 * dt + fr] = f2bf(acc[r]);
    }
    if (tid < 128) DC[(size_t)(c * 8 + h) * 128 + tid] = __expf(GB[63 * GBP + tid]);
    __syncthreads();
}
__device__ __forceinline__ void hgrn_l3(LAS unsigned char* lds, const bf16_t* PROJ, const float* lb_logits, const bf16_t* ST, const float* norm_g, unsigned char* REC, int c, int h, int tid, int wave, int lane) {
    const int t = tid >> 3, dseg = tid & 7, s2 = tid & 31, eg = tid >> 5, fr = lane & 15, fq = lane >> 4;
    const bf16_t* pf = PROJ + (size_t)(c * 64 + t) * DINP + CHF + h * 128 + 16 * dseg;
    const u32x4 f0 = *(const u32x4*)pf, f1 = *(const u32x4*)(pf + 8), q0 = *(const u32x4*)(pf - CHF + CHQ), q1 = *(const u32x4*)(pf - CHF + CHQ + 8);
    const u32x4 g0 = *(const u32x4*)(pf - CHF + CHG), g1 = *(const u32x4*)(pf - CHF + CHG + 8);
    const bf16_t* pv = PROJ + (size_t)(c * 64 + 2 * s2) * DINP + CHI + h * 128 + 8 * eg;
    const u32x4 va = *(const u32x4*)pv, vb = *(const u32x4*)(pv + DINP);
    const bf16_t* sp = ST + ((size_t)(c * 8 + h) * 128 + 16 * wave + fr) * 128 + 8 * fq;
    u32x4 sx[4];
#pragma unroll
    for (int ks = 0; ks < 4; ++ks) sx[ks] = *(const u32x4*)(sp + 32 * ks);
    const float l0 = lb_logits[h * 128 + (tid & 127)], l1 = lb_logits[1024 + h * 128 + (tid & 127)];
    hgrn_cumsum(lds, f0, f1, l0, l1, tid);
    const LAS float* GB = (const LAS float*)(lds + HG_GB); const LAS float* LB = (const LAS float*)(lds + HG_LB);
    {
        unsigned o1[8], o2[8], o3[8];
#pragma unroll
        for (int i = 0; i < 16; i += 2) {
            float a1[2], a2[2], a3[2];
#pragma unroll
            for (int j = 0; j < 2; ++j) { const int d = 16 * dseg + i + j; const float lb = LB[d], b = GB[t * GBP + d], br = GB[31 * GBP + d];
                const float z = (i + j) < 8 ? bfx(f0, i + j) : bfx(f1, i + j - 8), qv = (i + j) < 8 ? bfx(q0, i + j) : bfx(q1, i + j - 8);
                const float k = (1.0f - lb) * (1.0f - sigmoidf_(z)), q = siluf_(qv);
                a1[j] = q * __expf(b); a2[j] = q * __expf(b - br); a3[j] = k * __expf(br - b); }
            o1[i >> 1] = cvt_pk_bf16(a1[0], a1[1]); o2[i >> 1] = cvt_pk_bf16(a2[0], a2[1]); o3[i >> 1] = cvt_pk_bf16(a3[0], a3[1]);
        }
        LAS u32x4* d1 = (LAS u32x4*)(lds + HG_Q1 + t * 272 + dseg * 32); LAS u32x4* d2 = (LAS u32x4*)(lds + HG_Q2 + t * 272 + dseg * 32); LAS u32x4* d3 = (LAS u32x4*)(lds + HG_K2 + t * 272 + dseg * 32);
        d1[0] = (u32x4){o1[0], o1[1], o1[2], o1[3]}; d1[1] = (u32x4){o1[4], o1[5], o1[6], o1[7]};
        d2[0] = (u32x4){o2[0], o2[1], o2[2], o2[3]}; d2[1] = (u32x4){o2[4], o2[5], o2[6], o2[7]};
        d3[0] = (u32x4){o3[0], o3[1], o3[2], o3[3]}; d3[1] = (u32x4){o3[4], o3[5], o3[6], o3[7]};
    }
    hgrn_vt(lds, va, vb, tid);
    __syncthreads();
#pragma unroll
    for (int q = 0; q < 2; ++q) {
        const int tile = 2 * wave + q, tt = tile >> 2, stl = tile & 3;
        f32x4 acc = (f32x4){0.f, 0.f, 0.f, 0.f};
#pragma unroll
        for (int ks = 0; ks < 4; ++ks) { const bf16x8 a = *(const LAS bf16x8*)(lds + HG_Q2 + (16 * tt + fr) * 272 + (32 * ks + 8 * fq) * 2), b = *(const LAS bf16x8*)(lds + HG_K2 + (16 * stl + fr) * 272 + (32 * ks + 8 * fq) * 2);
            acc = __builtin_amdgcn_mfma_f32_16x16x32_bf16(a, b, acc, 0, 0, 0); }
#pragma unroll
        for (int r = 0; r < 4; ++r) { const int tr_ = 16 * tt + 4 * fq + r, s = 16 * stl + fr; *(LAS bf16_t*)(lds + HG_PB + tr_ * 144 + s * 2) = f2bf(s <= tr_ ? acc[r] : 0.f); }
    }
    __syncthreads();
    {
        bf16x8 b1[2], b2[4];
#pragma unroll
        for (int ks = 0; ks < 2; ++ks) b1[ks] = *(const LAS bf16x8*)(lds + HG_VT + (16 * wave + fr) * 144 + (32 * ks + 8 * fq) * 2);
#pragma unroll
        for (int ks = 0; ks < 4; ++ks) b2[ks] = __builtin_bit_cast(bf16x8, sx[ks]);
        LAS float* OB = (LAS float*)(lds + HG_GB);
#pragma unroll
        for (int tt = 0; tt < 4; ++tt) {
            f32x4 acc = (f32x4){0.f, 0.f, 0.f, 0.f};
#pragma unroll
            for (int ks = 0; ks < 2; ++ks) { const bf16x8 a = *(const LAS bf16x8*)(lds + HG_PB + (16 * tt + fr) * 144 + (32 * ks + 8 * fq) * 2); acc = __builtin_amdgcn_mfma_f32_16x16x32_bf16(a, b1[ks], acc, 0, 0, 0); }
#pragma unroll
            for (int ks = 0; ks < 4; ++ks) { const bf16x8 a = *(const LAS bf16x8*)(lds + HG_Q1 + (16 * tt + fr) * 272 + (32 * ks + 8 * fq) * 2); acc = __builtin_amdgcn_mfma_f32_16x16x32_bf16(a, b2[ks], acc, 0, 0, 0); }
#pragma unroll
            for (int r = 0; r < 4; ++r) OB[(16 * tt + 4 * fq + r) * 132 + 16 * wave + fr] = acc[r];
        }
    }
    __syncthreads();
    {
        const int es = dseg; const LAS float* OB = (const LAS float*)(lds + HG_GB);
        float o[16]; float ss = 0.f;
#pragma unroll
        for (int i = 0; i < 16; ++i) { o[i] = OB[t * 132 + 16 * es + i]; ss += o[i] * o[i]; }
        ss += __shfl_xor(ss, 1); ss += __shfl_xor(ss, 2); ss += __shfl_xor(ss, 4);
        const float rstd = rsqrtf(ss * (1.0f / 128.0f) + NORM_EPS);
        float rv[16];
#pragma unroll
        for (int i = 0; i < 16; ++i) { const float ga = i < 8 ? bfx(g0, i) : bfx(g1, i - 8); rv[i] = o[i] * (rstd * OP8_SCALE) * norm_g[16 * es + i] * siluf_(ga); }
        *(u32x4*)(REC + (size_t)(c * 64 + t) * 1024 + h * 128 + 16 * es) = (u32x4){pack4_fp8(rv[0], rv[1], rv[2], rv[3]), pack4_fp8(rv[4], rv[5], rv[6], rv[7]), pack4_fp8(rv[8], rv[9], rv[10], rv[11]), pack4_fp8(rv[12], rv[13], rv[14], rv[15])};
    }
    __syncthreads();
}

constexpr int SC_KT = 0, SC_SB = 36864, SC_SPITCH = 132;
__device__ __forceinline__ unsigned pk_f16(float a, float b) { return __builtin_bit_cast(unsigned, __builtin_amdgcn_cvt_pkrtz(a, b)); }
__device__ __forceinline__ void score_flush(LAS unsigned char* lds, unsigned short* SCORES, unsigned short* SEGMAX, int t0, int kt, int tid) {
    const LAS float* sb = (const LAS float*)(lds + SC_SB + (kt & 1) * (32 * SC_SPITCH * 4));
    const int row = tid >> 4, seg = tid & 15;
    const f32x4 a = *(const LAS f32x4*)(sb + row * SC_SPITCH + seg * 8), b = *(const LAS f32x4*)(sb + row * SC_SPITCH + seg * 8 + 4);
    unsigned short* dst = SCORES + (size_t)(t0 + row) * S + kt * 128 + seg * 8;
    *(u32x4*)dst = (u32x4){pk_f16(a[0], a[1]), pk_f16(a[2], a[3]), pk_f16(b[0], b[1]), pk_f16(b[2], b[3])};
    const float mx = fmaxf(fmaxf(fmaxf(a[0], a[1]), fmaxf(a[2], a[3])), fmaxf(fmaxf(b[0], b[1]), fmaxf(b[2], b[3])));
    SEGMAX[(size_t)(t0 + row) * 2048 + kt * 16 + seg] = (unsigned short)(pk_f16(mx, mx) & 0xffffu);
}
__device__ __forceinline__ void score_block(LAS unsigned char* lds, const bf16_t* PROJ, const bf16_t* KI, unsigned short* SCORES, unsigned short* SEGMAX, int qb, int kt0, int kt1, int tid, int wave, int lane) {
    const int t0 = qb * 32;
    const int r = lane & 31, hh = lane >> 5;
    bf16x8 Af[2][4]; float wv[2][16]; f32x2 wv2[2][8];
#pragma unroll
    for (int p = 0; p < 2; ++p) {
        const int tq = t0 + 4 * wave + 2 * p + (r >> 4); const bf16_t* qrow = PROJ + (size_t)tq * DINP + CQI + (r & 15) * 64 + 8 * hh;
#pragma unroll
        for (int ks = 0; ks < 4; ++ks) Af[p][ks] = *(const bf16x8*)(qrow + 16 * ks);
#pragma unroll
        for (int qq = 0; qq < 2; ++qq) {
            const bf16_t* wp = PROJ + (size_t)(t0 + 4 * wave + 2 * p + qq) * DINP + CWI + 4 * hh;
            const u32x2 wa = *(const u32x2*)wp, wb = *(const u32x2*)(wp + 8);
            wv[p][8 * qq + 0] = bf_lo(wa.x) * (1.0f / 32.0f); wv[p][8 * qq + 1] = bf_hi(wa.x) * (1.0f / 32.0f); wv[p][8 * qq + 2] = bf_lo(wa.y) * (1.0f / 32.0f); wv[p][8 * qq + 3] = bf_hi(wa.y) * (1.0f / 32.0f);
            wv[p][8 * qq + 4] = bf_lo(wb.x) * (1.0f / 32.0f); wv[p][8 * qq + 5] = bf_hi(wb.x) * (1.0f / 32.0f); wv[p][8 * qq + 6] = bf_lo(wb.y) * (1.0f / 32.0f); wv[p][8 * qq + 7] = bf_hi(wb.y) * (1.0f / 32.0f);
        }
#pragma unroll
        for (int i = 0; i < 8; ++i) wv2[p][i] = (f32x2){wv[p][2 * i], wv[p][2 * i + 1]};
    }
    const u32x2 tagsw = __builtin_amdgcn_permlane32_swap(0u, 1u, false, false); const int qsel = (int)tagsw[0];
    u32x4 stg[2];
#pragma unroll
    for (int i = 0; i < 2; ++i) { const int q = tid + 512 * i; stg[i] = *(const u32x4*)(KI + (size_t)(kt0 * 128 + (q >> 3)) * 64 + (q & 7) * 8); }
#pragma unroll
    for (int i = 0; i < 2; ++i) { const int q = tid + 512 * i; *(LAS u32x4*)(lds + SC_KT + (kt0 & 1) * 18432 + (q >> 3) * 144 + (q & 7) * 16) = stg[i]; }
    __syncthreads();
    for (int kt = kt0; kt < kt1; ++kt) {
        const LAS unsigned char* buf = lds + SC_KT + (kt & 1) * 18432;
        LAS float* sb = (LAS float*)(lds + SC_SB + (kt & 1) * (32 * SC_SPITCH * 4));
        if (kt + 1 < kt1) {
#pragma unroll
            for (int i = 0; i < 2; ++i) { const int q = tid + 512 * i; stg[i] = *(const u32x4*)(KI + (size_t)((kt + 1) * 128 + (q >> 3)) * 64 + (q & 7) * 8); }
        }
        __builtin_amdgcn_sched_barrier(0);
        if (kt > kt0) score_flush(lds, SCORES, SEGMAX, t0, kt - 1, tid);
        {
        f32x16 accP[2], accC[2];
#define SC_MFMA(cb) do { bf16x8 Bf[4]; _Pragma("unroll") for (int ks = 0; ks < 4; ++ks) Bf[ks] = *(const LAS bf16x8*)(buf + (32 * (cb) + r) * 144 + (16 * ks + 8 * hh) * 2); \
            _Pragma("unroll") for (int p = 0; p < 2; ++p) { _Pragma("unroll") for (int i = 0; i < 16; ++i) accC[p][i] = 0.f; \
                _Pragma("unroll") for (int ks = 0; ks < 4; ++ks) accC[p] = __builtin_amdgcn_mfma_f32_32x32x16_bf16(Af[p][ks], Bf[ks], accC[p], 0, 0, 0); } } while (0)
#define SC_RED(acc, cb) do { _Pragma("unroll") for (int p = 0; p < 2; ++p) { f32x2 s0 = {0.f, 0.f}, s1 = {0.f, 0.f}; \
            _Pragma("unroll") for (int reg = 0; reg < 8; reg += 2) { const f32x2 r0 = {relu_i(acc[p][reg]), relu_i(acc[p][reg + 1])}; const f32x2 r1 = {relu_i(acc[p][reg + 8]), relu_i(acc[p][reg + 9])}; \
                s0 = __builtin_elementwise_fma(wv2[p][reg >> 1], r0, s0); s1 = __builtin_elementwise_fma(wv2[p][4 + (reg >> 1)], r1, s1); } \
            const float p0 = s0[0] + s0[1], p1 = s1[0] + s1[1]; \
            const u32x2 sw = __builtin_amdgcn_permlane32_swap(__float_as_uint(p0), __float_as_uint(p1), false, false); \
            sb[(4 * wave + 2 * p + qsel) * SC_SPITCH + 32 * (cb) + r] = __uint_as_float(sw[0]) + __uint_as_float(sw[1]); } } while (0)
#define SC_INTERLEAVE() do { _Pragma("unroll") for (int i = 0; i < 8; ++i) { __builtin_amdgcn_sched_group_barrier(0x008, 1, 0); __builtin_amdgcn_sched_group_barrier(0x002, 8, 0); } } while (0)
        SC_MFMA(0);
        accP[0] = accC[0]; accP[1] = accC[1]; SC_MFMA(1); SC_RED(accP, 0); SC_INTERLEAVE();
        accP[0] = accC[0]; accP[1] = accC[1]; SC_MFMA(2); SC_RED(accP, 1); SC_INTERLEAVE();
        accP[0] = accC[0]; accP[1] = accC[1]; SC_MFMA(3); SC_RED(accP, 2); SC_INTERLEAVE();
        SC_RED(accC, 3);
#undef SC_MFMA
#undef SC_RED
#undef SC_INTERLEAVE
        }
        if (kt + 1 < kt1) {
#pragma unroll
            for (int i = 0; i < 2; ++i) { const int q = tid + 512 * i; *(LAS u32x4*)(lds + SC_KT + ((kt + 1) & 1) * 18432 + (q >> 3) * 144 + (q & 7) * 16) = stg[i]; }
        }
        __syncthreads();
    }
    score_flush(lds, SCORES, SEGMAX, t0, kt1 - 1, tid);
    __syncthreads();
}

template <int NV, bool EXACT, int TOL = 2>
__device__ __forceinline__ float wave_kth(const float (&v)[NV], int K) {
    const float NINF = -__builtin_inff();
    float mx = NINF, mn = __builtin_inff();
#pragma unroll
    for (int j = 0; j < NV; ++j) { mx = fmaxf(mx, v[j]); mn = fminf(mn, v[j] == NINF ? __builtin_inff() : v[j]); }
    mx = wave_max(mx); mn = -wave_max(-mn);
    int c = 0;
#pragma unroll
    for (int j = 0; j < NV; ++j) c += __popcll(__ballot(v[j] >= mx));
    if (c >= K) return mx;
    float lo = mn, hi = mx, tau = mn;
    for (int it = 0; it < 64; ++it) {
        const float mid = 0.5f * (lo + hi);
        if (!(mid > lo && mid < hi)) { tau = lo; break; }
        c = 0;
#pragma unroll
        for (int j = 0; j < NV; ++j) c += __popcll(__ballot(v[j] >= mid));
        if (c == K || (!EXACT && c > K && c <= K + (K >> TOL))) { tau = mid; break; }
        if (c > K) lo = mid; else hi = mid;
        tau = lo;
    }
    return tau;
}
__device__ __forceinline__ float wave_kth16(const float (&v)[16], int K) { return wave_kth<16, true>(v, K); }
__device__ __forceinline__ int lanes_below(unsigned long long mask) { return (int)__builtin_amdgcn_mbcnt_hi((unsigned)(mask >> 32), __builtin_amdgcn_mbcnt_lo((unsigned)mask, 0u)); }
__device__ __forceinline__ float h2f(unsigned short h) { return (float)__builtin_bit_cast(_Float16, h); }
__device__ __forceinline__ float h2f_lo(unsigned u) { return h2f((unsigned short)(u & 0xffffu)); }
__device__ __forceinline__ float h2f_hi(unsigned u) { return h2f((unsigned short)(u >> 16)); }
__device__ __forceinline__ unsigned ge_mask8(const u32x4& v, unsigned T16) {
    unsigned m8 = 0;
#pragma unroll
    for (int w = 0; w < 4; ++w) { const unsigned vw_ = v[w];
        const s16x2 d = __builtin_elementwise_sub_sat(__builtin_bit_cast(s16x2, vw_), __builtin_bit_cast(s16x2, T16));
        const unsigned mm = ~__builtin_bit_cast(unsigned, d); m8 |= (((mm >> 15) & 1u) | ((mm >> 30) & 2u)) << (2 * w); }
    return m8;
}
__device__ __forceinline__ int append_bits(LAS int* list, int cnt, unsigned m8, int base) {
    for (;;) { const bool has = m8 != 0u; const unsigned long long mask = __ballot(has); if (!mask) break;
        const int pos = cnt + lanes_below(mask);
        if (has) { const int k = __builtin_ctz(m8); m8 &= m8 - 1u; if (pos < 1024) list[pos] = base + k; }
        cnt += __popcll(mask); }
    return cnt;
}
__device__ __forceinline__ int append_keys(LAS int* list, int cnt, unsigned m8, int base, const u32x4& v) {
    for (;;) { const bool has = m8 != 0u; const unsigned long long mask = __ballot(has); if (!mask) break;
        const int pos = cnt + lanes_below(mask);
        if (has) { const int k = __builtin_ctz(m8); m8 &= m8 - 1u;
            const unsigned dw = (k & 4) ? ((k & 2) ? v.w : v.z) : ((k & 2) ? v.y : v.x); const unsigned h = (k & 1) ? (dw >> 16) : (dw & 0xffffu);
            if (pos < 1024) list[pos] = (int)((h << 16) | (unsigned)(base + k)); }
        cnt += __popcll(mask); }
    return cnt;
}
__device__ __forceinline__ void select_row(LAS unsigned char* wl, const unsigned short* SCORES, const unsigned short* SEGMAX, int t, int lane) {
    LAS int* selw = (LAS int*)wl; LAS int* segl = (LAS int*)(wl + 1024); LAS int* cidx = (LAS int*)(wl + 5120);
    const float NINF = -__builtin_inff();
    const unsigned short* row = SCORES + (size_t)t * S; const int n = t + 1;
    float c[16]; int N;
    if (n <= 1024) {
#pragma unroll
        for (int j = 0; j < 16; ++j) { const int i = lane + 64 * j; c[j] = i < n ? h2f(row[i]) : NINF; }
        N = -1;
    } else {
        const u32x4 NEG = (u32x4){0xfc00fc00u, 0xfc00fc00u, 0xfc00fc00u, 0xfc00fc00u};
        const unsigned short* smrow = SEGMAX + (size_t)t * 2048; const int nseg = (t >> 3) + 1;
        const bool segpath = nseg >= 512;
        float s[16], s8[8];
        if (!segpath) {
#pragma unroll
            for (int j = 0; j < 16; ++j) { const int i = lane + 64 * j; s[j] = i < (n >> 4) ? h2f(row[16 * i + 7]) : NINF; }
        }
        u32x4 sv[4];
#pragma unroll
        for (int u = 0; u < 4; ++u) { const int e8 = 8 * (lane + 64 * u); sv[u] = (e8 < nseg) ? *(const u32x4*)(smrow + e8) : NEG; }
#pragma unroll
        for (int u = 0; u < 4; ++u) { const int e8 = 8 * (lane + 64 * u); s8[2 * u] = h2f_lo(sv[u].x); s8[2 * u + 1] = (e8 + 4 < nseg) ? h2f_lo(sv[u].z) : NINF; }
        const int m = segpath ? (nseg >> 2) : (n >> 4);
        int K = segpath ? 85 : 26, cnt = 0;
        for (;;) {
            const float tlo = (K >= m) ? NINF : (segpath ? wave_kth<8, false, 3>(s8, K) : wave_kth<16, false, 2>(s, K));
            cnt = 0;
            const int nq = (n + 511) >> 9;
            if (tlo > 0.f) {
                const unsigned T16 = pk_f16(tlo, tlo);
                int ns = 0;
                {
#pragma unroll
                    for (int u = 0; u < 4; ++u) if (512 * u < nseg) { const int e8 = 8 * (lane + 64 * u); unsigned m8 = ge_mask8(sv[u], T16);
                        const int nv = nseg - e8; if (nv < 8) m8 &= nv > 0 ? ((1u << nv) - 1u) : 0u;
                        ns = append_bits(segl, ns, m8, e8); }
                }
                if (ns > 1024) ns = 1024;
                for (int j0 = 0; j0 < ns; j0 += 512) {
                    u32x4 v[8]; int sg[8];
#pragma unroll
                    for (int u = 0; u < 8; ++u) { const int i = j0 + lane + 64 * u; sg[u] = i < ns ? segl[i] : -1; v[u] = sg[u] >= 0 ? *(const u32x4*)(row + 8 * sg[u]) : NEG; }
#pragma unroll
                    for (int u = 0; u < 8; ++u) if (j0 + 64 * u < ns) { const int e = 8 * sg[u]; unsigned m8 = sg[u] >= 0 ? ge_mask8(v[u], T16) : 0u;
                        const int nv = t + 1 - e; if (nv < 8) m8 &= nv > 0 ? ((1u << nv) - 1u) : 0u;
                        cnt = append_keys(cidx, cnt, m8, e, v[u]); }
                }
            } else {
                for (int q0 = 0; q0 < nq; q0 += 4) {
                    u32x4 v[4];
#pragma unroll
                    for (int u = 0; u < 4; ++u) { const int e = 8 * (lane + 64 * (q0 + u)); v[u] = (e <= t) ? *(const u32x4*)(row + e) : (u32x4){0xfc00fc00u, 0xfc00fc00u, 0xfc00fc00u, 0xfc00fc00u}; }
#pragma unroll
                    for (int u = 0; u < 4; ++u) { const int e = 8 * (lane + 64 * (q0 + u));
#pragma unroll
                        for (int k = 0; k < 8; ++k) { const float x = (k & 1) ? h2f_hi(v[u][k >> 1]) : h2f_lo(v[u][k >> 1]);
                            const bool pred = (e + k <= t) && (x >= tlo); const unsigned long long mask = __ballot(pred);
                            if (mask) { const int pos = cnt + lanes_below(mask); const unsigned hb = (k & 1) ? (v[u][k >> 1] >> 16) : (v[u][k >> 1] & 0xffffu);
                                if (pred && pos < 1024) cidx[pos] = (int)((hb << 16) | (unsigned)(e + k)); cnt += __popcll(mask); } } }
                }
            }
            if (cnt >= 256 || K >= m) break;
            K *= 2;
        }
        N = cnt < 1024 ? cnt : 1024;
#pragma unroll
        for (int j = 0; j < 16; ++j) { const int i = lane + 64 * j; c[j] = i < N ? h2f((unsigned short)((unsigned)cidx[i] >> 16)) : NINF; }
    }
    float tau;
    if (N >= 0 && N <= 512) { const float c8[8] = {c[0], c[1], c[2], c[3], c[4], c[5], c[6], c[7]}; tau = wave_kth<8, true>(c8, 256); }
    else tau = wave_kth16(c, 256);
    int base = 0;
#pragma unroll
    for (int j = 0; j < 16; ++j) { const bool pred = c[j] >= tau; const unsigned long long mask = __ballot(pred);
        if (mask) { const int pos = base + lanes_below(mask); if (pred && pos < 256) selw[pos] = (N < 0) ? (lane + 64 * j) : (cidx[lane + 64 * j] & 0xffff); base += __popcll(mask); } }
}

__device__ __forceinline__ void attn_query(LAS unsigned char* wl, const bf16_t* PROJ, const unsigned char* KC, const unsigned char* VC, unsigned char* ATT, int t, int lane) {
    LAS int* selw = (LAS int*)wl; LAS float* L = (LAS float*)(wl + 1024);
    const int nsel = t < 255 ? t + 1 : 256;
    const int fr = lane & 15, fq = lane >> 4;
    constexpr float QS = 8.0f;
    long qh[2][4], ql[2][4];
#pragma unroll
    for (int g = 0; g < 2; ++g)
#pragma unroll
        for (int ks = 0; ks < 4; ++ks) {
            u32x4 z = (u32x4){0u, 0u, 0u, 0u};
            if (fr < 4) z = *(const u32x4*)(PROJ + (size_t)t * DINP + CQ + (4 * g + fr) * 128 + 32 * ks + 8 * fq);
            float qv[8], rv[8];
#pragma unroll
            for (int e = 0; e < 4; ++e) { qv[2 * e] = bf_lo(z[e]) * QS; qv[2 * e + 1] = bf_hi(z[e]) * QS; }
            const unsigned h0 = pack4_fp8(qv[0], qv[1], qv[2], qv[3]), h1 = pack4_fp8(qv[4], qv[5], qv[6], qv[7]);
            rv[0] = qv[0] - __builtin_amdgcn_cvt_f32_fp8((int)h0, 0); rv[1] = qv[1] - __builtin_amdgcn_cvt_f32_fp8((int)h0, 1); rv[2] = qv[2] - __builtin_amdgcn_cvt_f32_fp8((int)h0, 2); rv[3] = qv[3] - __builtin_amdgcn_cvt_f32_fp8((int)h0, 3);
            rv[4] = qv[4] - __builtin_amdgcn_cvt_f32_fp8((int)h1, 0); rv[5] = qv[5] - __builtin_amdgcn_cvt_f32_fp8((int)h1, 1); rv[6] = qv[6] - __builtin_amdgcn_cvt_f32_fp8((int)h1, 2); rv[7] = qv[7] - __builtin_amdgcn_cvt_f32_fp8((int)h1, 3);
            const unsigned l0 = pack4_fp8(rv[0] * 16.0f, rv[1] * 16.0f, rv[2] * 16.0f, rv[3] * 16.0f), l1 = pack4_fp8(rv[4] * 16.0f, rv[5] * 16.0f, rv[6] * 16.0f, rv[7] * 16.0f);
            qh[g][ks] = (long)(((unsigned long long)h1 << 32) | h0); ql[g][ks] = (long)(((unsigned long long)l1 << 32) | l0);
        }
    const float scale = 0.08838834764831845f / QS;
    const int nkt = (nsel + 15) >> 4;
    {
        LAS unsigned char* KT = wl + 9216;
        const int q4_ = lane >> 4, l15_ = lane & 15;
        u32x4 kw[5][4];
#define QK_LOAD(buf, kt) do { _Pragma("unroll") for (int u = 0; u < 4; ++u) { const unsigned off_ = (unsigned)selw[16 * (kt) + 4 * u + q4_] * 256u + 16u * (unsigned)l15_; kw[buf][u] = *(const u32x4*)((const char*)KC + off_); } } while (0)
#define QK_COMP(buf, kt) do { _Pragma("unroll") for (int u = 0; u < 4; ++u) *(LAS u32x4*)(KT + (4 * u + q4_) * 272 + 16 * l15_) = kw[buf][u];     \
        _Pragma("unroll") for (int g = 0; g < 2; ++g) { f32x4 acch = (f32x4){0.f, 0.f, 0.f, 0.f}, accl = (f32x4){0.f, 0.f, 0.f, 0.f}; \
            _Pragma("unroll") for (int ks = 0; ks < 4; ++ks) { const long kf_ = *(const LAS long*)(KT + fr * 272 + g * 128 + 32 * ks + 8 * fq); \
                acch = __builtin_amdgcn_mfma_f32_16x16x32_fp8_fp8(qh[g][ks], kf_, acch, 0, 0, 0); accl = __builtin_amdgcn_mfma_f32_16x16x32_fp8_fp8(ql[g][ks], kf_, accl, 0, 0, 0); } \
            if (fq == 0) { _Pragma("unroll") for (int r = 0; r < 4; ++r) L[(4 * g + r) * 256 + 16 * (kt) + fr] = (16 * (kt) + fr < nsel) ? (acch[r] + accl[r] * 0.0625f) * scale : -__builtin_inff(); } } } while (0)
        QK_LOAD(0, 0); if (1 < nkt) QK_LOAD(1, 1); if (2 < nkt) QK_LOAD(2, 2); if (3 < nkt) QK_LOAD(3, 3);
        for (int kt = 0; kt < nkt; kt += 5) {
            if (kt + 4 < nkt) QK_LOAD(4, kt + 4);
            __builtin_amdgcn_sched_barrier(0);
            QK_COMP(0, kt);
            if (kt + 1 < nkt) { if (kt + 5 < nkt) QK_LOAD(0, kt + 5); __builtin_amdgcn_sched_barrier(0); QK_COMP(1, kt + 1); }
            if (kt + 2 < nkt) { if (kt + 6 < nkt) QK_LOAD(1, kt + 6); __builtin_amdgcn_sched_barrier(0); QK_COMP(2, kt + 2); }
            if (kt + 3 < nkt) { if (kt + 7 < nkt) QK_LOAD(2, kt + 7); __builtin_amdgcn_sched_barrier(0); QK_COMP(3, kt + 3); }
            if (kt + 4 < nkt) { if (kt + 8 < nkt) QK_LOAD(3, kt + 8); __builtin_amdgcn_sched_barrier(0); QK_COMP(4, kt + 4); }
        }
#undef QK_LOAD
#undef QK_COMP
        if (fq == 0) { for (int kt = nkt; kt < 16; ++kt) {
#pragma unroll
            for (int r = 0; r < 8; ++r) L[r * 256 + 16 * kt + fr] = -__builtin_inff(); } }
    }
    float p[8][4];
#pragma unroll
    for (int hd = 0; hd < 8; ++hd) { float m = -__builtin_inff();
#pragma unroll
        for (int i = 0; i < 4; ++i) { p[hd][i] = L[hd * 256 + 4 * lane + i]; m = fmaxf(m, p[hd][i]); }
        m = wave_max(m); float s = 0.f;
#pragma unroll
        for (int i = 0; i < 4; ++i) { p[hd][i] = __expf(p[hd][i] - m); s += p[hd][i]; }
        s = __builtin_amdgcn_rcpf(wave_sum(s));
#pragma unroll
        for (int i = 0; i < 4; ++i) p[hd][i] *= s; }
    constexpr float PS = 256.0f;
    LAS unsigned* Ph = (LAS unsigned*)(wl + 1024); LAS unsigned* Pl = (LAS unsigned*)(wl + 1024 + 2048);
#pragma unroll
    for (int hd = 0; hd < 8; ++hd) {
        const float a0 = p[hd][0] * PS, a1 = p[hd][1] * PS, a2 = p[hd][2] * PS, a3 = p[hd][3] * PS;
        const unsigned h = pack4_fp8(a0, a1, a2, a3);
        const unsigned l = pack4_fp8(a0 - __builtin_amdgcn_cvt_f32_fp8((int)h, 0), a1 - __builtin_amdgcn_cvt_f32_fp8((int)h, 1), a2 - __builtin_amdgcn_cvt_f32_fp8((int)h, 2), a3 - __builtin_amdgcn_cvt_f32_fp8((int)h, 3));
        Ph[hd * 64 + lane] = h; Pl[hd * 64 + lane] = l;
    }
    LAS unsigned char* VT = wl + 9216;
    const int ii = lane & 15, kq = lane >> 4;
    f32x4 acc[16];
#pragma unroll
    for (int nt = 0; nt < 16; ++nt) acc[nt] = (f32x4){0.f, 0.f, 0.f, 0.f};
    const int nch = (nsel + 15) >> 4;
    u32x4 vw[4][4];
#define PV_LOAD(buf, c) do { _Pragma("unroll") for (int u = 0; u < 4; ++u) { const unsigned off_ = (unsigned)selw[16 * (c) + 4 * u + kq] * 256u + 16u * (unsigned)ii; vw[buf][u] = *(const u32x4*)((const char*)VC + off_); } } while (0)
#define PV_COMP(buf, c) do { _Pragma("unroll") for (int u = 0; u < 4; ++u) { LAS u32x2* d_ = (LAS u32x2*)(VT + (16 * ((c) & 1) + 4 * u + kq) * 264 + 16 * ii); d_[0] = (u32x2){vw[buf][u].x, vw[buf][u].y}; d_[1] = (u32x2){vw[buf][u].z, vw[buf][u].w}; } \
        if (((c) & 1) || (c) == nch - 1) { \
            if (!((c) & 1)) { _Pragma("unroll") for (int u = 0; u < 4; ++u) { LAS u32x2* d_ = (LAS u32x2*)(VT + (16 + 4 * u + kq) * 264 + 16 * ii); d_[0] = (u32x2){0u, 0u}; d_[1] = (u32x2){0u, 0u}; } } \
            long pa[2]; _Pragma("unroll") for (int g = 0; g < 2; ++g) { const int po_ = (g * 4 + (ii & 3)) * 256 + 32 * ((c) >> 1) + 8 * kq;     \
                const long h_ = *(const LAS long*)((const LAS unsigned char*)Ph + po_ + ((ii & 4) ? 2048 : 0)); pa[g] = ii < 8 ? h_ : 0l; } \
            _Pragma("unroll") for (int nt = 0; nt < 16; ++nt) { const v2i32 t_ = __builtin_amdgcn_ds_read_tr8_b64_v2i32((LAS v2i32*)(VT + (8 * kq + (ii >> 1)) * 264 + 16 * nt + 8 * (ii & 1))); \
                const long b_ = __builtin_bit_cast(long, t_); \
                acc[nt] = __builtin_amdgcn_mfma_f32_16x16x32_fp8_fp8(pa[nt >> 3], b_, acc[nt], 0, 0, 0); } } } while (0)
    PV_LOAD(0, 0); if (1 < nch) PV_LOAD(1, 1); if (2 < nch) PV_LOAD(2, 2);
    for (int c = 0; c < nch; c += 4) {
        if (c + 3 < nch) PV_LOAD(3, c + 3);
        __builtin_amdgcn_sched_barrier(0);
        PV_COMP(0, c);
        if (c + 1 < nch) { if (c + 4 < nch) PV_LOAD(0, c + 4); __builtin_amdgcn_sched_barrier(0); PV_COMP(1, c + 1); }
        if (c + 2 < nch) { if (c + 5 < nch) PV_LOAD(1, c + 5); __builtin_amdgcn_sched_barrier(0); PV_COMP(2, c + 2); }
        if (c + 3 < nch) { if (c + 6 < nch) PV_LOAD(2, c + 6); __builtin_amdgcn_sched_barrier(0); PV_COMP(3, c + 3); }
    }
#undef PV_LOAD
#undef PV_COMP
    LAS float* OB = (LAS float*)(wl + 1024 + 4096);
    LAS float* OB2 = (LAS float*)(wl + 1024);
    if (kq < 2) {
        LAS float* ob = kq == 0 ? OB : OB2;
#pragma unroll
        for (int nt = 0; nt < 16; ++nt)
#pragma unroll
            for (int r = 0; r < 4; ++r) ob[(4 * (nt >> 3) + r) * 128 + 16 * (nt & 7) + ii] = acc[nt][r];
    }
    {
        const f32x4 a0 = *(const LAS f32x4*)(OB + 16 * lane) + *(const LAS f32x4*)(OB2 + 16 * lane), a1 = *(const LAS f32x4*)(OB + 16 * lane + 4) + *(const LAS f32x4*)(OB2 + 16 * lane + 4),
                    a2 = *(const LAS f32x4*)(OB + 16 * lane + 8) + *(const LAS f32x4*)(OB2 + 16 * lane + 8), a3 = *(const LAS f32x4*)(OB + 16 * lane + 12) + *(const LAS f32x4*)(OB2 + 16 * lane + 12);
        const f32x4 b0 = a0 * (OP8_SCALE / PS), b1 = a1 * (OP8_SCALE / PS), b2 = a2 * (OP8_SCALE / PS), b3 = a3 * (OP8_SCALE / PS);
        *(u32x4*)(ATT + (size_t)t * 1024 + 16 * lane) = (u32x4){pack4_fp8(b0[0], b0[1], b0[2], b0[3]), pack4_fp8(b1[0], b1[1], b1[2], b1[3]), pack4_fp8(b2[0], b2[1], b2[2], b2[3]), pack4_fp8(b3[0], b3[1], b3[2], b3[3])};
    }
}


__device__ __forceinline__ void convert_item8(const float* __restrict__ W, int K, int N, int ld, unsigned char* WT, int mode, int item, int lane, LAS unsigned char* scr) {
    const int nblk = (N + 63) >> 6; const int kb = item / nblk, nb = item - kb * nblk; const int k0 = kb * 256, n0 = nb * 64;
    const int c4 = lane & 15, kr = lane >> 4;
    const float* src = W + (size_t)(k0 + 4 * kr) * ld + n0 + 4 * c4;
#pragma unroll 4
    for (int i = 0; i < 16; ++i) {
        f32x4 v[4];
#pragma unroll
        for (int r = 0; r < 4; ++r) v[r] = __builtin_nontemporal_load((const f32x4*)(src + (size_t)(16 * i + r) * ld));
        const int kk = 16 * i + 4 * kr;
#pragma unroll
        for (int e = 0; e < 4; ++e) *(LAS unsigned*)(scr + (4 * c4 + e) * 272 + kk) = pack4_fp8(v[0][e] * W8_SCALE, v[1][e] * W8_SCALE, v[2][e] * W8_SCALE, v[3][e] * W8_SCALE);
    }
    LDS_WAIT(); asm volatile("" ::: "memory");
#pragma unroll 4
    for (int j = 0; j < 16; ++j) {
        const int q = j * 64 + lane, n = q >> 4, ch = q & 15;
        const u32x4 v = *(const LAS u32x4*)(scr + n * 272 + ch * 16);
        if (n0 + n < N) *(u32x4*)(WT + (size_t)dest_row(mode, n0 + n) * K + k0 + ch * 16) = v;
    }
    LDS_WAIT(); asm volatile("" ::: "memory");
}

struct Conv8Job { const float* W; unsigned char* WT; int N; int mode; size_t w_estride, wt_estride; int items_per_e; };
constexpr int C8_PITCH = 272, C8_IMG = 256 * C8_PITCH;
__device__ __forceinline__ void conv8_load(const Conv8Job& jb, int item, int h, int wave, int lane, f32x4 (&v)[16]) {
    const int e = item / jb.items_per_e, r = item - e * jb.items_per_e; const int nblk = jb.N >> 8; const int kb = r / nblk, nb = r - kb * nblk;
    const float* src = jb.W + (size_t)e * jb.w_estride + (size_t)(kb * 256 + 32 * wave + 16 * h) * jb.N + nb * 256 + 4 * lane;
#pragma unroll
    for (int i = 0; i < 16; ++i) v[i] = __builtin_nontemporal_load((const f32x4*)(src + (size_t)i * jb.N));
}
__device__ __forceinline__ void conv8_to_lds(LAS unsigned char* img, int h, int wave, int lane, const f32x4 (&v)[16]) {
#pragma unroll
    for (int e = 0; e < 4; ++e) { u32x4 w;
#pragma unroll
        for (int g = 0; g < 4; ++g) w[g] = pack4_fp8(v[4 * g][e] * W8_SCALE, v[4 * g + 1][e] * W8_SCALE, v[4 * g + 2][e] * W8_SCALE, v[4 * g + 3][e] * W8_SCALE);
        *(LAS u32x4*)(img + (4 * lane + e) * C8_PITCH + 32 * wave + 16 * h) = w; }
}
__device__ __forceinline__ void conv8_store(const Conv8Job& jb, int item, const LAS unsigned char* img, int tid) {
    const int e = item / jb.items_per_e, r = item - e * jb.items_per_e; const int nblk = jb.N >> 8; const int kb = r / nblk, nb = r - kb * nblk;
    unsigned char* dst = jb.WT + (size_t)e * jb.wt_estride + kb * 256;
#pragma unroll
    for (int j = 0; j < 8; ++j) { const int q = j * 512 + tid, n = q >> 4, ch = q & 15;
        __builtin_nontemporal_store(*(const LAS u32x4*)(img + n * C8_PITCH + ch * 16), (u32x4*)(dst + (size_t)dest_row(jb.mode, nb * 256 + n) * 2048 + ch * 16)); }
}
__device__ __forceinline__ void conv8_run(LAS unsigned char* lds, const Conv8Job& jb, int n_items, int wg, int G, int tid, int wave, int lane) {
    if (wg >= n_items) return;
    f32x4 a[16], b[16]; int par = 0;
    conv8_load(jb, wg, 0, wave, lane, a); conv8_load(jb, wg, 1, wave, lane, b);
    for (int it = wg; it < n_items; it += G, par ^= 1) {
        LAS unsigned char* img = lds + par * C8_IMG;
        const int nx = (it + G < n_items) ? it + G : it;
        conv8_to_lds(img, 0, wave, lane, a); __builtin_amdgcn_sched_barrier(0);
        conv8_load(jb, nx, 0, wave, lane, a); __builtin_amdgcn_sched_barrier(0);
        conv8_to_lds(img, 1, wave, lane, b); __builtin_amdgcn_sched_barrier(0);
        conv8_load(jb, nx, 1, wave, lane, b); __builtin_amdgcn_sched_barrier(0);
        __syncthreads();
        conv8_store(jb, it, img, tid);
    }
    __syncthreads();
}

__global__ void __launch_bounds__(NTHR, 2) fwd_kernel(Args args) {
    extern __shared__ __attribute__((aligned(16))) unsigned char lds_raw[];
    LAS unsigned char* lds = (LAS unsigned char*)lds_raw;
    volatile LAS unsigned* MISC = (volatile LAS unsigned*)(lds + LDS_MISC);
    const int tid = threadIdx.x, lane = tid & 63, wave = __builtin_amdgcn_readfirstlane(tid >> 6);
    const int G = gridDim.x, wg = blockIdx.x;
    unsigned char* ws = args.ws;
    unsigned* ctl = (unsigned*)(ws + WS_CTL);
    const int lo = args.ph_lo, hi = args.ph_hi;
    const float* x = (const float*)args.in[0]; const float* cvec = (const float*)args.in[1]; const int* positions = (const int*)args.in[2];
    const float* w_ada = (const float*)args.in[3]; const float* b_ada = (const float*)args.in[4]; const float* norm1_g = (const float*)args.in[5];
    const float* w_in = (const float*)args.in[6]; const float* idx_knorm_g = (const float*)args.in[7]; const float* idx_knorm_b = (const float*)args.in[8];
    const float* lb_logits = (const float*)args.in[9]; const float* hgrn_norm_g = (const float*)args.in[10];
    const float* w_proj_att = (const float*)args.in[11]; const float* w_proj_hgrn = (const float*)args.in[12]; const float* w_out = (const float*)args.in[13];
    const float* norm2_g = (const float*)args.in[14]; const float* w_router = (const float*)args.in[15]; const float* b_router = (const float*)args.in[16];
    const float* w1 = (const float*)args.in[17]; const float* b1 = (const float*)args.in[18]; const float* w2 = (const float*)args.in[19]; const float* b2 = (const float*)args.in[20];
    const float* final_g = (const float*)args.in[21];
    float* out = args.out;
    float* MOD = (float*)(ws + WS_MOD); int* TOPE = (int*)(ws + WS_TOPE); float* GATE = (float*)(ws + WS_GATE); int* SLOT = (int*)(ws + WS_SLOT);
    bf16_t* WIN_T = (bf16_t*)(ws + WS_WIN_T); bf16_t* WA_T = (bf16_t*)(ws + WS_WA_T); bf16_t* WH_T = (bf16_t*)(ws + WS_WH_T); bf16_t* WO_T = (bf16_t*)(ws + WS_WO_T);
    unsigned char* WIN_T8 = ws + WS_WIN_T + 8 * MiB;
    unsigned char* HA8 = ws + WS_SCORES;
    unsigned char* W1_T = ws + WS_W1_T; unsigned char* W2_T = ws + WS_W2_T;
    bf16_t* HB = (bf16_t*)(ws + WS_H); bf16_t* PROJ = (bf16_t*)(ws + WS_PROJ);
    bf16_t* DELTA = (bf16_t*)(ws + WS_ATT);
    unsigned char* ACT = ws + WS_ACT; bf16_t* YB = (bf16_t*)(ws + WS_YB);
    int* TOKS = (int*)(ws + WS_TOKS);
    unsigned char* H8 = ws + WS_H;
    bf16_t* KI = (bf16_t*)(ws + WS_KI); unsigned char* KC = ws + WS_KC; unsigned char* VC = ws + WS_VC;
    bf16_t* ST = (bf16_t*)(ws + WS_ST); float* DC = (float*)(ws + WS_DC);
    unsigned char* ATT = ws + WS_ATT; unsigned char* REC = ATT + (size_t)S * 1024;        bf16_t* MERGED = (bf16_t*)(ws + WS_MERGED); unsigned short* SCORES = (unsigned short*)(ws + WS_SCORES);
    unsigned short* SEGMAX = (unsigned short*)(ws + WS_X1);

    for (int u = tid; u < 128; u += NTHR) MISC[u] = 0u;
    __syncthreads();
    const bool one_launch = (hi - lo) > 1;
    XcdBarrier bar; bar.bar = ctl + CW_BAR; bar.x = 0; bar.st = MISC + 8;
    if (one_launch) bar = xcd_barrier_post(ctl + CW_BAR, MISC + 8);
#define IN(k) (lo <= (k) && (k) < hi)
#define SEAM(k) do { if (IN(k) && IN((k) + 1)) xcd_barrier(bar); } while (0)


    if (IN(PH_PRO)) {
        for (int cb = wg; cb < 256; cb += G) {
            LAS float* red = (LAS float*)lds;
            const int c4 = tid % 12, kg = tid / 12;
            f32x4 acc = (f32x4){0.f, 0.f, 0.f, 0.f};
            if (kg < 42) {
                const float* wp = w_ada + (size_t)cb * 48 + 4 * c4;
#pragma unroll 7
                for (int j = 0; j < 49; ++j) { const int k = kg + 42 * j; if (k < D) { const f32x4 v = __builtin_nontemporal_load((const f32x4*)(wp + (size_t)k * (6 * D))); acc += siluf_(cvec[k]) * v; } }
                *(LAS f32x4*)(red + kg * 48 + 4 * c4) = acc;
            }
            __syncthreads();
            if (tid < 48) { float s = b_ada[cb * 48 + tid];
#pragma unroll 6
                for (int q = 0; q < 42; ++q) s += red[q * 48 + tid];
                MOD[cb * 48 + tid] = s; }
            __syncthreads();
        }
        LAS unsigned char* scr = lds + wave * 17408;
        const int gw = wg * NWAVES + wave, NGW = G * NWAVES;
        {
            constexpr int NB_IN = (1104 + 63) / 64, Q0 = 8 * NB_IN, Q1 = Q0 + 4 * 32, Q2 = Q1 + 4 * 32, Q3 = Q2 + 8 * 32, Q4 = Q3 + 8 * 24, Q5 = Q4 + 8 * 128;
            for (int q = gw; q < Q5; q += NGW) {
                if (q < Q0)      convert_item8(w_in + 1536, 2048, 1104, DIN, WIN_T8 + (size_t)1536 * 2048, 0, q, lane, scr);
                else if (q < Q1) convert_item8(w_proj_att, 1024, 2048, 2048, (unsigned char*)WA_T, 0, q - Q0, lane, scr);
                else if (q < Q2) convert_item8(w_proj_hgrn, 1024, 2048, 2048, (unsigned char*)WA_T + (size_t)2048 * 1024, 0, q - Q1, lane, scr);
                else if (q < Q3) convert_item8(w_out, 2048, 2048, 2048, (unsigned char*)WO_T, 0, q - Q2, lane, scr);
                else if (q < Q4) convert_item8(w_in, 2048, 1536, DIN, WIN_T8, 0, q - Q3, lane, scr);
                else             convert_item8(w_in + 2640, 2048, 8192, DIN, WIN_T8 + (size_t)2816 * 2048, 0, q - Q4, lane, scr);
            }
            for (size_t i = (size_t)wg * NTHR + tid; i < (size_t)176 * 2048 / 16; i += (size_t)G * NTHR) ((u32x4*)(WIN_T8 + (size_t)2640 * 2048))[i] = (u32x4){0u, 0u, 0u, 0u};
        }
    }
    SEAM(PH_PRO);

    {
    if (IN(PH_H)) {
        const float* sh1 = MOD; const float* sc1 = MOD + D;
        const int gw = wg * NWAVES + wave, NGW = G * NWAVES;
        f32x4 gs[8], sh[8];
#pragma unroll
        for (int j = 0; j < 8; ++j) { const int c = 4 * lane + 256 * j; const f32x4 g = *(const f32x4*)(norm1_g + c), sc = *(const f32x4*)(sc1 + c); sh[j] = *(const f32x4*)(sh1 + c);
#pragma unroll
            for (int e = 0; e < 4; ++e) gs[j][e] = g[e] * (1.0f + sc[e]); }
        for (int t = gw; t < S; t += NGW) {
            const f32x4* xr = (const f32x4*)(x + (size_t)t * D) + lane;
            f32x4 v[8]; float ss = 0.f;
#pragma unroll
            for (int j = 0; j < 8; ++j) { v[j] = xr[64 * j]; ss += (v[j][0] * v[j][0] + v[j][1] * v[j][1]) + (v[j][2] * v[j][2] + v[j][3] * v[j][3]); }
            const float rstd = rsqrtf(wave_sum(ss) * (1.0f / D) + NORM_EPS);
#pragma unroll
            for (int j = 0; j < 8; ++j) { const f32x4 h = v[j] * rstd * gs[j] + sh[j];
                *(unsigned*)(HA8 + (size_t)t * D + 4 * lane + 256 * j) = pack4_fp8(h[0], h[1], h[2], h[3]); }
        }
    }
    SEAM(PH_H);
    if (IN(PH_INPROJ)) {
        const int XC = (G == 256) ? XCONV : 0;
        const Conv8Job j1{w1, W1_T, 4096, 2, (size_t)2048 * 4096, (size_t)4096 * 2048, 8 * 16};
        const Conv8Job j2{w2, W2_T, 2048, 0, (size_t)2048 * 2048, (size_t)2048 * 2048, 8 * 8};
        if (G != 256) { conv8_run(lds, j1, NEXP * 8 * 16, wg, G, tid, wave, lane); conv8_run(lds, j2, NEXP * 8 * 8, wg, G, tid, wave, lane); }
        if (wg < XC) { conv8_run(lds, j1, NEXP * 8 * 16, wg, XC, tid, wave, lane); conv8_run(lds, j2, NEXP * 8 * 8, wg, XC, tid, wave, lane); }
        else {
            const int Gg = G - XC, cg = wg - XC;
            {
                pg8::Gemm g8{HA8, WIN_T8, 2048, 0, nullptr, 0}; pg8::StaticOrder S8; S8.init(S, DINP, Gg, cg);
                const int full8 = 2752 / Gg, rem8 = 2752 - full8 * Gg;
                if (rem8 > 0) S8.skew(full8, cg < rem8 ? cg : -1, rem8);
                pg8::EpiBf16 E8{PROJ, DINP, nullptr, 0, 1.0f / W8_SCALE, 1 << 30, 0};
                pg8::gemm_phase<pg8::EpiBf16, pg8::StaticOrder, true>(lds, g8, S8, E8);
            }
        }
    }
    SEAM(PH_INPROJ);
    if (IN(PH_POST)) {
        const int gw = wg * NWAVES + wave, NGW = G * NWAVES;
        const float inv16 = powf(500000.0f, -(float)(lane & 15) * (1.0f / 16.0f)), inv8 = powf(500000.0f, -(float)(lane & 7) * (1.0f / 8.0f));
        for (int t = gw; t < S; t += NGW) post_token(PROJ, KI, KC, VC, positions, idx_knorm_g, idx_knorm_b, inv16, inv8, t, lane);
        __syncthreads();
        for (int u = wg; u < 2048; u += G) hgrn_l1(lds, PROJ, lb_logits, ST, DC, u >> 3, u & 7, tid, wave, lane);
    }
    SEAM(PH_POST);
    if (IN(PH_SCORE)) {
        for (int idx = wg * NTHR + tid; idx < 8 * 128 * 128; idx += G * NTHR) {
            const int h = idx >> 14, d = idx & 127; float s = 0.f;
            bf16_t* sp = ST + idx; const float* dp = DC + h * 128 + d;
            for (int c = 0; c < 256; c += 16) {
                float l[16], dc[16];
#pragma unroll
                for (int i = 0; i < 16; ++i) { l[i] = bf2f(sp[(size_t)(c + i) * 131072]); dc[i] = dp[(size_t)(c + i) * 1024]; }
#pragma unroll
                for (int i = 0; i < 16; ++i) { sp[(size_t)(c + i) * 131072] = f2bf(s); s = dc[i] * s + l[i]; }
            }
        }
        {
            const int XS = (G == 256) ? XSCORE : 0;
            if (wg < XS) {
                const Conv8Job j1{w1, W1_T, 4096, 2, (size_t)2048 * 4096, (size_t)4096 * 2048, 8 * 16};
                const Conv8Job j2{w2, W2_T, 2048, 0, (size_t)2048 * 2048, (size_t)2048 * 2048, 8 * 8};
                __syncthreads();
                conv8_run(lds, j1, NEXP * 8 * 16, wg, XS, tid, wave, lane); conv8_run(lds, j2, NEXP * 8 * 8, wg, XS, tid, wave, lane);
            }
            for (;;) {
                if (tid == 0) MISC[100] = __hip_atomic_fetch_add(ctl + CW_SCQ, 1u, __ATOMIC_RELAXED, __HIP_MEMORY_SCOPE_AGENT);
                __syncthreads();
                const int item = (int)MISC[100];
                __syncthreads();
                if (item >= 252 * 6) break;
                int j, lo, hi;
                if (item < 504) { j = item >> 1; const int T = ((8 + j) >> 2) + ((511 - j) >> 2) + 2; const int p = item & 1; lo = p * T / 3; hi = (p + 1) * T / 3; }
                else { const int i2 = item - 504; j = i2 >> 2; const int T = ((8 + j) >> 2) + ((511 - j) >> 2) + 2; const int p = i2 & 3, b = 2 * T / 3; lo = b + p * (T - b) / 4; hi = b + (p + 1) * (T - b) / 4; }
                const int qa = 8 + j, qb2 = 511 - j, na = (qa >> 2) + 1;
                const int a0 = lo < na ? lo : na, a1 = hi < na ? hi : na, b0 = (lo > na ? lo : na) - na, b1 = (hi > na ? hi : na) - na;
                if (a1 > a0) score_block(lds, PROJ, KI, SCORES, SEGMAX, qa, a0, a1, tid, wave, lane);
                if (b1 > b0) score_block(lds, PROJ, KI, SCORES, SEGMAX, qb2, b0, b1, tid, wave, lane);
            }
        }
    }
    SEAM(PH_SCORE);
    if (IN(PH_ATTN)) {
        const int gw = wg * NWAVES + wave, NGW = G * NWAVES;
        for (int u = wg; u < 2048; u += G) hgrn_l3(lds, PROJ, lb_logits, ST, hgrn_norm_g, REC, u >> 3, u & 7, tid, wave, lane);
        {
            for (;;) {
                unsigned tq = 0; if (lane == 0) tq = __hip_atomic_fetch_add(ctl + CW_ATQ, 1u, __ATOMIC_RELAXED, __HIP_MEMORY_SCOPE_AGENT);
                tq = (unsigned)__builtin_amdgcn_readfirstlane((int)tq);
                if (tq >= (unsigned)S) break;
                const int t = S - 1 - (int)tq;
                LAS unsigned char* wl = lds + wave * 17664;
                if (t >= 256) select_row(wl, SCORES, SEGMAX, t, lane);
                else {
#pragma unroll
                    for (int i = 0; i < 4; ++i) { const int idx = lane + 64 * i; ((LAS int*)wl)[idx] = idx <= t ? idx : 0; }
                }
                attn_query(wl, PROJ, KC, VC, ATT, t, lane);
            }
        }
    }
    SEAM(PH_ATTN);
    if (IN(PH_OP1)) {
        pg8::Gemm g{ATT, WA_T, 1024, (size_t)2048 * 1024, nullptr, (size_t)S * 1024};
        pg8::TwoPartOrder So; So.init(S, 2048, G, wg);
        pg8::EpiGate2 E{(unsigned char*)MERGED, PROJ + CGA, PROJ + CGR};
        pg8::gemm_phase<pg8::EpiGate2, pg8::TwoPartOrder, true>(lds, g, So, E);
    }
    SEAM(PH_OP2);
    if (IN(PH_WOUT)) {
        pg8::Gemm g{MERGED, WO_T, 2048, 0, nullptr, 0}; pg8::StaticOrder So; So.init(S, 2048, G, wg);
        pg8::EpiDelta E{MOD + 2 * D, DELTA, 1.0f / (W8_SCALE * MRG8_SCALE)};
        pg8::gemm_phase<pg8::EpiDelta, pg8::StaticOrder, true>(lds, g, So, E);
    }
    SEAM(PH_WOUT);
    }

    if (IN(PH_ROUTER)) {
        LAS float* hs = (LAS float*)lds;
        volatile LAS unsigned* lcnt = MISC + 32;
        const float* sh2 = MOD + 3 * D; const float* sc2 = MOD + 4 * D;
        if (tid < 32) lcnt[tid] = 0u;
        __syncthreads();
        for (int grp = wg; grp < S / 16; grp += G) {
#pragma unroll 1
            for (int q = 0; q < 2; ++q) {
                const int tl = 2 * wave + q, t = grp * 16 + tl;
                const f32x4* xr = (const f32x4*)(x + (size_t)t * D) + lane; const u32x2* dr = (const u32x2*)(DELTA + (size_t)t * D) + lane;
                f32x4 v[8]; float ss = 0.f;
#pragma unroll
                for (int j = 0; j < 8; ++j) { const u32x2 dw = dr[64 * j]; v[j] = xr[64 * j] + (f32x4){bf_lo(dw.x), bf_hi(dw.x), bf_lo(dw.y), bf_hi(dw.y)};
                    ss += (v[j][0] * v[j][0] + v[j][1] * v[j][1]) + (v[j][2] * v[j][2] + v[j][3] * v[j][3]); }
#pragma unroll
                for (int j = 0; j < 8; ++j) { u32x2 w; w.x = cvt_pk_bf16(v[j][0], v[j][1]); w.y = cvt_pk_bf16(v[j][2], v[j][3]); ((u32x2*)(DELTA + (size_t)t * D) + lane)[64 * j] = w; }
                const float rstd = rsqrtf(wave_sum(ss) * (1.0f / D) + NORM_EPS);
#pragma unroll
                for (int j = 0; j < 8; ++j) {
                    const int c = 4 * lane + 256 * j;
                    const f32x4 g = *(const f32x4*)(norm2_g + c), sc = *(const f32x4*)(sc2 + c), sh = *(const f32x4*)(sh2 + c);
                    f32x4 h;
#pragma unroll
                    for (int e = 0; e < 4; ++e) h[e] = v[j][e] * rstd * g[e] * (1.0f + sc[e]) + sh[e];
                    *(LAS f32x4*)(hs + tl * 2048 + c) = h;
                    *(unsigned*)(H8 + (size_t)t * D + c) = pack4_fp8(h[0], h[1], h[2], h[3]);
                }
            }
            __syncthreads();
            {
                LAS float* part = (LAS float*)(lds + 131072);
                const int fr = lane & 15, fq = lane >> 4;
                f32x4 acc0 = (f32x4){0.f, 0.f, 0.f, 0.f}, acc1 = acc0;
                const LAS float* hrow = hs + fr * 2048 + wave * 256 + 4 * fq; const float* wrp = w_router + (size_t)(wave * 256 + 4 * fq) * 32 + fr;
#pragma unroll 2
                for (int i = 0; i < 16; ++i) {
                    const f32x4 a4 = *(const LAS f32x4*)(hrow + 16 * i);
                    float b0[4], b1[4];
#pragma unroll
                    for (int s = 0; s < 4; ++s) { b0[s] = wrp[(size_t)(16 * i + s) * 32]; b1[s] = wrp[(size_t)(16 * i + s) * 32 + 16]; }
#pragma unroll
                    for (int s = 0; s < 4; ++s) { acc0 = __builtin_amdgcn_mfma_f32_16x16x4f32(a4[s], b0[s], acc0, 0, 0, 0); acc1 = __builtin_amdgcn_mfma_f32_16x16x4f32(a4[s], b1[s], acc1, 0, 0, 0); }
                }
#pragma unroll
                for (int r = 0; r < 4; ++r) { part[(wave * 16 + 4 * fq + r) * 32 + fr] = acc0[r]; part[(wave * 16 + 4 * fq + r) * 32 + 16 + fr] = acc1[r]; }
                __syncthreads();
                const int tl = tid >> 5, e = tid & 31, t = grp * 16 + tl;
                float v = b_router[e];
#pragma unroll
                for (int w = 0; w < 8; ++w) v += part[(w * 16 + tl) * 32 + e];
                float tv[4]; int ti[4];
#pragma unroll
                for (int k = 0; k < 4; ++k) {
                    float bv = v; int bi = e;
#pragma unroll
                    for (int o = 16; o >= 1; o >>= 1) { const float ov = __shfl_xor(bv, o); const int oi = __shfl_xor(bi, o); if (ov > bv || (ov == bv && oi < bi)) { bv = ov; bi = oi; } }
                    tv[k] = bv; ti[k] = bi; if (e == bi) v = -__builtin_inff();
                }
                if (e == 0) {
                    const float e1 = __expf(tv[1] - tv[0]), e2 = __expf(tv[2] - tv[0]), e3 = __expf(tv[3] - tv[0]); const float inv = 1.0f / (1.0f + e1 + e2 + e3);
                    *(int4*)(TOPE + (size_t)t * 4) = make_int4(ti[0], ti[1], ti[2], ti[3]);
                    *(f32x4*)(GATE + (size_t)t * 4) = (f32x4){inv, e1 * inv, e2 * inv, e3 * inv};
#pragma unroll
                    for (int k = 0; k < 4; ++k) __hip_atomic_fetch_add((LAS unsigned*)&lcnt[ti[k]], 1u, __ATOMIC_RELAXED, __HIP_MEMORY_SCOPE_WORKGROUP);
                }
            }
            __syncthreads();
        }
        if (tid < 32) { const unsigned c = lcnt[tid]; if (c) __hip_atomic_fetch_add(ctl + CW_CNT + tid, c, __ATOMIC_RELAXED, __HIP_MEMORY_SCOPE_AGENT); }
    }
    SEAM(PH_ROUTER);

    if (IN(PH_SCATTER)) {
        volatile LAS unsigned* lcnt = MISC + 32; volatile LAS unsigned* lbase = MISC + 64; LAS int* pstart = (LAS int*)(lds + 1024); LAS int* pcnt = (LAS int*)(lds + 1280);
        if (tid < NEXP) pcnt[tid] = (int)__hip_atomic_load(ctl + CW_CNT + tid, __ATOMIC_RELAXED, __HIP_MEMORY_SCOPE_AGENT);
        if (tid < 32) lcnt[tid] = 0u;
        __syncthreads();
        if (tid == 0) { int p = 0; for (int e = 0; e < NEXP; ++e) { pstart[e] = p; p += (pcnt[e] + 255) & ~255; } }
        __syncthreads();
        if (wg < NEXP) { const int e = wg; for (int s = pstart[e] + pcnt[e] + tid; s < pstart[e] + ((pcnt[e] + 255) & ~255); s += NTHR) TOKS[s] = 0; }
        for (int blk = wg; blk < S / 64; blk += G) {
            int e = 0, lrank = 0;
            if (tid < 256) { e = TOPE[(size_t)blk * 256 + tid]; lrank = (int)__hip_atomic_fetch_add((LAS unsigned*)&lcnt[e], 1u, __ATOMIC_RELAXED, __HIP_MEMORY_SCOPE_WORKGROUP); }
            __syncthreads();
            if (tid < 32) { const unsigned c = lcnt[tid]; lbase[tid] = c ? __hip_atomic_fetch_add(ctl + CW_FILL + tid, c, __ATOMIC_RELAXED, __HIP_MEMORY_SCOPE_AGENT) : 0u; }
            __syncthreads();
            if (tid < 256) { const int slot = pstart[e] + (int)lbase[e] + lrank; SLOT[(size_t)blk * 256 + tid] = slot; TOKS[slot] = blk * 64 + (tid >> 2); }
            __syncthreads();
            if (tid < 32) lcnt[tid] = 0u;
            __syncthreads();
        }
    }
    SEAM(PH_SCATTER);

    if (IN(PH_MOE1) || IN(PH_MOE2)) {
        LAS int* panel_e = (LAS int*)(lds + 131072 + 2048);
        LAS int* npan = (LAS int*)(lds + 131072 + 2048 + 2048);
        __syncthreads();
        if (tid < NEXP) npan[1 + tid] = (int)((__hip_atomic_load(ctl + CW_CNT + tid, __ATOMIC_RELAXED, __HIP_MEMORY_SCOPE_AGENT) + 255u) >> 8);
        __syncthreads();
        if (tid == 0) { int p = 0; for (int e = 0; e < NEXP; ++e) { const int np = npan[1 + e]; for (int q = 0; q < np; ++q) panel_e[p + q] = e; p += np; } npan[0] = p; }
        __syncthreads();
        const int nPanels = npan[0];
        if (IN(PH_MOE1)) {
            pg8::Gemm g{H8, W1_T, 2048, (size_t)4096 * 2048, TOKS, 0}; pg8::MoeOrder So; So.init(nPanels, 16, G, wg, panel_e);
            pg8::EpiSwiglu E{ACT, b1};
            pg8::gemm_phase<pg8::EpiSwiglu, pg8::MoeOrder, true>(lds, g, So, E);
        }
        SEAM(PH_MOE1);
        if (IN(PH_MOE2)) {
            pg8::Gemm g{ACT, W2_T, 2048, (size_t)2048 * 2048, nullptr, 0}; pg8::MoeOrder So; So.init(nPanels, 8, G, wg, panel_e);
            pg8::EpiBf16 E{YB, 2048, b2, 2048, 1.0f / (W8_SCALE * ACT8_SCALE), 1 << 30, 0};
            pg8::gemm_phase<pg8::EpiBf16, pg8::MoeOrder, true>(lds, g, So, E);
        }
    }
    SEAM(PH_MOE2);

    if (IN(PH_FINAL)) {
        const float* gt2 = MOD + 5 * D;
        const int gw = wg * NWAVES + wave, NGW = G * NWAVES;
        for (int t = gw; t < S; t += NGW) {
            const u32x2* dr = (const u32x2*)(DELTA + (size_t)t * D) + lane;
            f32x4 v[8];
#pragma unroll
            for (int j = 0; j < 8; ++j) { const u32x2 dw = dr[64 * j]; v[j] = (f32x4){bf_lo(dw.x), bf_hi(dw.x), bf_lo(dw.y), bf_hi(dw.y)}; }
            {
                f32x4 m[8];
#pragma unroll
                for (int j = 0; j < 8; ++j) m[j] = (f32x4){0.f, 0.f, 0.f, 0.f};
                const int4 sl = *(const int4*)(SLOT + (size_t)t * 4); const f32x4 gt = *(const f32x4*)(GATE + (size_t)t * 4);
                const int sls[4] = {sl.x, sl.y, sl.z, sl.w};
#pragma unroll
                for (int k = 0; k < 4; ++k) {
                    const u32x2* yr = (const u32x2*)(YB + (size_t)sls[k] * D) + lane; const float gk = gt[k];
#pragma unroll
                    for (int j = 0; j < 8; ++j) { const u32x2 w = yr[64 * j]; m[j][0] += gk * bf_lo(w.x); m[j][1] += gk * bf_hi(w.x); m[j][2] += gk * bf_lo(w.y); m[j][3] += gk * bf_hi(w.y); }
                }
#pragma unroll
                for (int j = 0; j < 8; ++j) { const f32x4 g2 = *(const f32x4*)(gt2 + 4 * lane + 256 * j); v[j] = v[j] + g2 * m[j]; }
            }
            float ss = 0.f;
#pragma unroll
            for (int j = 0; j < 8; ++j) ss += (v[j][0] * v[j][0] + v[j][1] * v[j][1]) + (v[j][2] * v[j][2] + v[j][3] * v[j][3]);
            const float rstd = rsqrtf(wave_sum(ss) * (1.0f / D) + NORM_EPS);
            f32x4* orow = (f32x4*)(out + (size_t)t * D) + lane;
#pragma unroll
            for (int j = 0; j < 8; ++j) { const f32x4 fg = *(const f32x4*)(final_g + 4 * lane + 256 * j); orow[64 * j] = v[j] * rstd * fg; }
        }
    }
#undef IN
#undef SEAM
}

#ifndef MK_ONE_LAUNCH
#define MK_ONE_LAUNCH 1
#endif
extern "C" void kernel_launch(void* const* d_in, const int* in_sizes, int n_in, void* d_out, int out_size, void* d_ws, size_t ws_size, hipStream_t stream) {
    static int grid = 0;
    if (grid == 0) {
        if (n_in != 22 || out_size != S * D || ws_size < WS_END) { fprintf(stderr, "kernel_launch: unexpected shapes: n_in %d out %d ws %zu (need %zu)\n", n_in, out_size, ws_size, (size_t)WS_END); grid = -1; return; }
        int dev = 0, cus = 0, per_cu = 0;
        if (hipGetDevice(&dev) != hipSuccess || hipDeviceGetAttribute(&cus, hipDeviceAttributeMultiprocessorCount, dev) != hipSuccess) { grid = -1; return; }
        if (hipFuncSetAttribute((const void*)fwd_kernel, hipFuncAttributeMaxDynamicSharedMemorySize, LDS_BYTES) != hipSuccess) { fprintf(stderr, "kernel_launch: hipFuncSetAttribute failed\n"); grid = -1; return; }
        if (hipOccupancyMaxActiveBlocksPerMultiprocessor(&per_cu, (const void*)fwd_kernel, NTHR, LDS_BYTES) != hipSuccess || per_cu < 1) { fprintf(stderr, "kernel_launch: occupancy query says %d\n", per_cu); (void)hipGetLastError(); grid = -1; return; }
        grid = cus;
    }
    if (grid < 0) return;
    (void)in_sizes;
    hipMemsetAsync((char*)d_ws + WS_CTL, 0, CTL_BYTES, stream);
    Args a{};
    for (int i = 0; i < 22; ++i) a.in[i] = d_in[i];
    a.out = (float*)d_out; a.ws = (unsigned char*)d_ws; a.flags = 0; a.pad = 0;
#if MK_ONE_LAUNCH
    a.ph_lo = 0; a.ph_hi = NPH;
    hipLaunchKernelGGL(fwd_kernel, dim3(grid), dim3(NTHR), LDS_BYTES, stream, a);
#else
    for (int p = 0; p < NPH; ++p) { a.ph_lo = p; a.ph_hi = p + 1; hipLaunchKernelGGL(fwd_kernel, dim3(grid), dim3(NTHR), LDS_BYTES, stream, a); }
#endif
}
```
